# Optimizing an MI355X kernel written in HIP

```python
import math
import jax, jax.numpy as jnp
from jax import lax
import numpy as np

D_MODEL = 1024
BATCH = 2
SEQ = 8192
DEPTH = 2

N_MIXERS = 2
N_DSA_LAYERS = (DEPTH + 1) // 2
N_GLA_LAYERS = DEPTH // 2

DN_ALPHA = (2.0 * DEPTH) ** 0.25
DN_BETA = (8.0 * DEPTH) ** -0.25
LN_EPS = 1e-5
RMS_EPS = 1e-6

A_HEADS = 16
A_QK_DIM = 64
A_V_DIM = 64
A_LATENT = 256
IDX_HEADS = 8
IDX_DIM = 64
IDX_TOPK_MAX = 256
Q_BLOCK = 128
D_IN_A = A_HEADS * A_QK_DIM + A_LATENT + IDX_HEADS * IDX_DIM + IDX_DIM + IDX_HEADS

B_HEADS = 4
B_KEY_DIM = D_MODEL // 2
B_VAL_DIM = D_MODEL
B_KH = B_KEY_DIM // B_HEADS
B_VH = B_VAL_DIM // B_HEADS
B_GATE_RANK = 16
B_GATE_TAU = 16.0
B_CHUNK = 64
D_IN_B = 2 * B_KEY_DIM + B_VAL_DIM + B_GATE_RANK + B_VAL_DIM

N_EXPERTS = 32
TOP_K = 4
D_FF = D_MODEL
SWIGLU_LIMIT = 7.0
SWIGLU_ALPHA = 1.702
MOE_BLOCK = 256

kernel_name = "hybrid_dsa_gla_moe_deepnorm"


def layer_norm(x, g, b):
    xf = x.astype(jnp.float32)
    mu = jnp.mean(xf, axis=-1, keepdims=True)
    xc = xf - mu
    var = jnp.mean(xc * xc, axis=-1, keepdims=True)
    y = xc * lax.rsqrt(var + LN_EPS) * g.astype(jnp.float32) + b.astype(jnp.float32)
    return y.astype(x.dtype)


def rms_norm(x, g):
    xf = x.astype(jnp.float32)
    y = xf * lax.rsqrt(jnp.mean(xf * xf, axis=-1, keepdims=True) + RMS_EPS)
    return (y * g.astype(jnp.float32)).astype(x.dtype)


def dsa_mixer(x, w_in, kv_norm, w_uk, w_uv, w_out):
    Bsz, L, _ = x.shape
    proj = x @ w_in
    o1 = A_HEADS * A_QK_DIM
    o2 = o1 + A_LATENT
    o3 = o2 + IDX_HEADS * IDX_DIM
    o4 = o3 + IDX_DIM
    q, c, qi, ki, wi = jnp.split(proj, [o1, o2, o3, o4], axis=-1)
    q = q.reshape(Bsz, L, A_HEADS, A_QK_DIM)
    c = rms_norm(c, kv_norm)
    qi = qi.reshape(Bsz, L, IDX_HEADS, IDX_DIM)
    wi = wi * (IDX_HEADS ** -0.5)
    topk = min(IDX_TOPK_MAX, L // 4)
    nblk = L // Q_BLOCK
    key_pos = jnp.arange(L)

    def to_blocks(t):
        return jnp.moveaxis(t.reshape((Bsz, nblk, Q_BLOCK) + t.shape[2:]), 1, 0)

    def block_fn(args):
        q_b, qi_b, wi_b, blk = args
        qpos = blk * Q_BLOCK + jnp.arange(Q_BLOCK)
        s = jnp.einsum('bqhd,bsd->bqhs', qi_b, ki).astype(jnp.float32) * (IDX_DIM ** -0.5)
        score = jnp.einsum('bqh,bqhs->bqs', wi_b.astype(jnp.float32), jax.nn.relu(s))
        causal = key_pos[None, :] <= qpos[:, None]
        score = jnp.where(causal[None], score, -jnp.inf)
        _, idx = lax.top_k(score, topk)
        valid = idx <= qpos[None, :, None]
        c_sel = jax.vmap(lambda cb, ib: cb[ib])(c, idx)
        q_lat = jnp.einsum('bqhd,hdc->bqhc', q_b, w_uk)
        logits = jnp.einsum('bqhc,bqkc->bqhk', q_lat, c_sel).astype(jnp.float32) * (A_QK_DIM ** -0.5)
        logits = jnp.where(valid[:, :, None, :], logits, -jnp.inf)
        p = jax.nn.softmax(logits, axis=-1).astype(c_sel.dtype)
        return jnp.einsum('bqhk,bqkc->bqhc', p, c_sel)

    o = lax.map(block_fn, (to_blocks(q), to_blocks(qi), to_blocks(wi), jnp.arange(nblk)))
    o = jnp.moveaxis(o, 0, 1).reshape(Bsz, L, A_HEADS, A_LATENT)
    o = jnp.einsum('blhc,hcv->blhv', o, w_uv).reshape(Bsz, L, A_HEADS * A_V_DIM)
    return (o @ w_out).astype(x.dtype)


def gla_mixer(x, w_in, w_g2, g_bias, norm_g, w_out):
    Bsz, L, _ = x.shape
    proj = x @ w_in
    q, k, v, g_lr, r = jnp.split(
        proj, [B_KEY_DIM, 2 * B_KEY_DIM, 2 * B_KEY_DIM + B_VAL_DIM,
               2 * B_KEY_DIM + B_VAL_DIM + B_GATE_RANK], axis=-1)
    gate_logit = (g_lr @ w_g2 + g_bias).astype(jnp.float32)
    log_a = jax.nn.log_sigmoid(gate_logit) / B_GATE_TAU
    nC = L // B_CHUNK

    def to_chunks(t, hd):
        t = t.astype(jnp.float32).reshape(Bsz, nC, B_CHUNK, B_HEADS, hd)
        return jnp.transpose(t, (1, 0, 3, 2, 4))

    qc = to_chunks(q, B_KH) * (B_KH ** -0.5)
    kc = to_chunks(k, B_KH)
    vc = to_chunks(v, B_VH)
    ac = to_chunks(log_a, B_KH)
    tril = jnp.tril(jnp.ones((B_CHUNK, B_CHUNK), dtype=bool))

    def step(S, inp):
        qb, kb, vb, ab = inp
        bcum = jnp.cumsum(ab, axis=2)
        o_inter = jnp.einsum('bhid,bhde->bhie', qb * jnp.exp(bcum), S)
        diff = bcum[:, :, :, None, :] - bcum[:, :, None, :, :]
        decay = jnp.exp(jnp.where(tril[None, None, :, :, None], diff, -jnp.inf))
        A = jnp.einsum('bhijd,bhjd->bhij', qb[:, :, :, None, :] * decay, kb)
        o_intra = jnp.einsum('bhij,bhje->bhie', A, vb)
        b_last = bcum[:, :, -1:, :]
        S_new = jnp.exp(b_last[:, :, 0, :])[..., None] * S + jnp.einsum(
            'bhjd,bhje->bhde', kb * jnp.exp(b_last - bcum), vb)
        return S_new, o_inter + o_intra

    S0 = jnp.zeros((Bsz, B_HEADS, B_KH, B_VH), jnp.float32)
    _, o = lax.scan(step, S0, (qc, kc, vc, ac))
    o = jnp.transpose(o, (1, 0, 3, 2, 4)).reshape(Bsz, L, B_HEADS, B_VH)
    o = rms_norm(o, norm_g.reshape(B_HEADS, B_VH))
    o = o.reshape(Bsz, L, B_VAL_DIM) * jax.nn.silu(r.astype(jnp.float32))
    return (o.astype(x.dtype) @ w_out).astype(x.dtype)


def moe_ffn(x, w_router, b_router, w1, b1, w2, b2):
    Bsz, L, D = x.shape
    N = Bsz * L
    xt = x.reshape(N, D)
    logits = (xt @ w_router + b_router).astype(jnp.float32)
    top_vals, top_idx = lax.top_k(logits, TOP_K)
    gates = jax.nn.softmax(top_vals, axis=-1)
    NK = N * TOP_K
    flat_e = top_idx.reshape(-1)
    flat_tok = jnp.repeat(jnp.arange(N, dtype=jnp.int32), TOP_K)
    flat_gate = gates.reshape(-1)
    order = jnp.argsort(flat_e)
    se, stok, sgate = flat_e[order], flat_tok[order], flat_gate[order]
    counts = jnp.bincount(flat_e, length=N_EXPERTS)
    padded = ((counts + MOE_BLOCK - 1) // MOE_BLOCK) * MOE_BLOCK
    start = jnp.cumsum(counts) - counts
    pend = jnp.cumsum(padded)
    pstart = pend - padded
    dest = pstart[se] + (jnp.arange(NK) - start[se])
    n_blocks = -(-NK // MOE_BLOCK) + N_EXPERTS
    P = n_blocks * MOE_BLOCK
    row_tok = jnp.zeros((P,), jnp.int32).at[dest].set(stok)
    row_gate = jnp.zeros((P,), jnp.float32).at[dest].set(sgate)
    blk_e = jnp.minimum(jnp.searchsorted(pend, jnp.arange(n_blocks) * MOE_BLOCK, side='right'),
                        N_EXPERTS - 1)
    xs = xt[row_tok].reshape(n_blocks, MOE_BLOCK, D)

    def expert_block(args):
        xb, e = args
        h = xb @ w1[e] + b1[e]
        g, u = h[:, :D_FF], h[:, D_FF:]
        g = jnp.minimum(g, SWIGLU_LIMIT)
        u = jnp.clip(u, -SWIGLU_LIMIT, SWIGLU_LIMIT)
        glu = g * jax.nn.sigmoid(g * SWIGLU_ALPHA)
        return ((u + 1.0) * glu) @ w2[e] + b2[e]

    ys = lax.map(expert_block, (xs, blk_e)).reshape(P, D)
    y = jnp.zeros((N, D), x.dtype).at[row_tok].add((ys * row_gate[:, None].astype(ys.dtype)).astype(x.dtype))
    return y.reshape(Bsz, L, D)


def setup_inputs(seed: int = 0) -> dict:
    key = jax.random.key(seed)
    ks = jax.random.split(key, 24)
    f32 = jnp.float32
    nrm = lambda k, shape, s: jax.random.normal(k, shape, f32) * s
    D = D_MODEL
    LA, LB = N_DSA_LAYERS, N_GLA_LAYERS
    return {
        "x": nrm(ks[0], (BATCH, SEQ, D), 1.0),
        "a_w_in": nrm(ks[1], (LA, D, D_IN_A), D ** -0.5),
        "a_kv_norm": 1.0 + nrm(ks[2], (LA, A_LATENT), 0.01),
        "a_w_uk": nrm(ks[3], (LA, A_HEADS, A_QK_DIM, A_LATENT), A_LATENT ** -0.5),
        "a_w_uv": nrm(ks[4], (LA, A_HEADS, A_LATENT, A_V_DIM), A_LATENT ** -0.5 * DN_BETA),
        "a_w_out": nrm(ks[5], (LA, A_HEADS * A_V_DIM, D), (A_HEADS * A_V_DIM) ** -0.5 * DN_BETA),
        "b_w_in": nrm(ks[6], (LB, D, D_IN_B), D ** -0.5),
        "b_w_g2": nrm(ks[7], (LB, B_GATE_RANK, B_KEY_DIM), B_GATE_RANK ** -0.5),
        "b_g_bias": nrm(ks[8], (LB, B_KEY_DIM), 0.1),
        "b_norm": 1.0 + nrm(ks[9], (LB, B_VAL_DIM), 0.01),
        "b_w_out": nrm(ks[10], (LB, B_VAL_DIM, D), B_VAL_DIM ** -0.5 * DN_BETA),
        "m_w_router": nrm(ks[11], (DEPTH, D, N_EXPERTS), D ** -0.5),
        "m_b_router": nrm(ks[12], (DEPTH, N_EXPERTS), 0.01),
        "m_w1": nrm(ks[13], (DEPTH, N_EXPERTS, D, 2 * D_FF), D ** -0.5),
        "m_b1": nrm(ks[14], (DEPTH, N_EXPERTS, 2 * D_FF), 0.01),
        "m_w2": nrm(ks[15], (DEPTH, N_EXPERTS, D_FF, D), D_FF ** -0.5 * DN_BETA),
        "m_b2": nrm(ks[16], (DEPTH, N_EXPERTS, D), 0.01),
        "ln1_g": 1.0 + nrm(ks[17], (DEPTH, D), 0.01),
        "ln1_b": nrm(ks[18], (DEPTH, D), 0.01),
        "ln2_g": 1.0 + nrm(ks[19], (DEPTH, D), 0.01),
        "ln2_b": nrm(ks[20], (DEPTH, D), 0.01),
    }


def reference(x, a_w_in, a_kv_norm, a_w_uk, a_w_uv, a_w_out,
              b_w_in, b_w_g2, b_g_bias, b_norm, b_w_out,
              m_w_router, m_b_router, m_w1, m_b1, m_w2, m_b2,
              ln1_g, ln1_b, ln2_g, ln2_b):
    for i in range(DEPTH):
        j = i // N_MIXERS
        if i % N_MIXERS == 0:
            h = dsa_mixer(x, a_w_in[j], a_kv_norm[j], a_w_uk[j], a_w_uv[j], a_w_out[j])
        else:
            h = gla_mixer(x, b_w_in[j], b_w_g2[j], b_g_bias[j], b_norm[j], b_w_out[j])
        x = layer_norm(DN_ALPHA * x + h, ln1_g[i], ln1_b[i])
        f = moe_ffn(x, m_w_router[i], m_b_router[i], m_w1[i], m_b1[i], m_w2[i], m_b2[i])
        x = layer_norm(DN_ALPHA * x + f, ln2_g[i], ln2_b[i])
    return x
```

```cpp
#include <hip/hip_runtime.h>
#include <cstdio>
#include <cstdint>
#include <cstring>
namespace nv {
constexpr int NT = 16384, D = 1024, L = 8192, NB = 2;
constexpr int DINA = 1864, DINB = 3088;
constexpr int PMAX = 73728;
constexpr float ALPHA = 1.4142135623730951f;

struct GemmP {
  const float* A; int lda; const int* arow;
  const float* B; int ldb; float* C; int ldc; int M, N, K;
  const int* blk_e; const int* nblk_used; size_t bstride; const float* bias; size_t bias_stride;
};
inline GemmP mkg(const float* A, int lda, const int* arow, const float* B, int ldb, float* C, int ldc, int M, int N, int K, const int* blk_e, const int* nblk_used, size_t bstride, const float* bias, size_t bias_stride) {
  GemmP p; memset(&p, 0, sizeof(p)); p.A = A; p.lda = lda; p.arow = arow; p.B = B; p.ldb = ldb; p.C = C; p.ldc = ldc; p.M = M; p.N = N; p.K = K; p.blk_e = blk_e; p.nblk_used = nblk_used; p.bstride = bstride; p.bias = bias; p.bias_stride = bias_stride; return p; }
template <int MODE>
__global__ __launch_bounds__(256) void sgemm(GemmP p) {
  __shared__ float As[16][68];
  __shared__ float Bs[16][68];
  __shared__ float Bu[MODE == 1 ? 16 : 1][68];
  const int bm = blockIdx.y, bn = blockIdx.x, tid = threadIdx.x, tx = tid & 15, ty = tid >> 4;
  const float* B = p.B; const float* bias = p.bias;
  if (MODE != 0) { const int blk = (bm * 64) / 256; if (blk >= *p.nblk_used) return; const int e = p.blk_e[blk]; B += (size_t)e * p.bstride; bias += (size_t)e * p.bias_stride; }
  const int m0 = bm * 64, n0 = bn * 64;
  const int ar = tid >> 2, ak = (tid & 3) * 4;
  const int arow = p.arow ? p.arow[m0 + ar] : (m0 + ar);
  const float* Ap = p.A + (size_t)arow * p.lda + ak;
  const int bk = tid >> 4, bn4 = (tid & 15) * 4;
  const bool bok = (n0 + bn4) < p.N;
  float acc[4][4] = {}, accu[4][4] = {};
  for (int k0 = 0; k0 < p.K; k0 += 16) {
    const float4 av = *(const float4*)(Ap + k0);
    As[ak + 0][ar] = av.x; As[ak + 1][ar] = av.y; As[ak + 2][ar] = av.z; As[ak + 3][ar] = av.w;
    float4 bv = make_float4(0.f, 0.f, 0.f, 0.f);
    if (bok) bv = *(const float4*)(B + (size_t)(k0 + bk) * p.ldb + n0 + bn4);
    *(float4*)&Bs[bk][bn4] = bv;
    if (MODE == 1) { const float4 uv = *(const float4*)(B + (size_t)(k0 + bk) * p.ldb + 1024 + n0 + bn4); *(float4*)&Bu[bk][bn4] = uv; }
    __syncthreads();
#pragma unroll
    for (int kk = 0; kk < 16; ++kk) {
      const float4 a = *(const float4*)&As[kk][ty * 4];
      const float4 b = *(const float4*)&Bs[kk][tx * 4];
      const float aa[4] = {a.x, a.y, a.z, a.w}, bb[4] = {b.x, b.y, b.z, b.w};
#pragma unroll
      for (int i = 0; i < 4; ++i)
#pragma unroll
        for (int j = 0; j < 4; ++j) acc[i][j] = fmaf(aa[i], bb[j], acc[i][j]);
      if (MODE == 1) {
        const float4 u = *(const float4*)&Bu[kk][tx * 4]; const float uu[4] = {u.x, u.y, u.z, u.w};
#pragma unroll
        for (int i = 0; i < 4; ++i)
#pragma unroll
          for (int j = 0; j < 4; ++j) accu[i][j] = fmaf(aa[i], uu[j], accu[i][j]);
      }
    }
    __syncthreads();
  }
#pragma unroll
  for (int i = 0; i < 4; ++i) {
    const int m = m0 + ty * 4 + i;
#pragma unroll
    for (int j = 0; j < 4; ++j) {
      const int n = n0 + tx * 4 + j; if (n >= p.N) continue;
      float v = acc[i][j];
      if (MODE == 1) {
        float g = v + bias[n], u = accu[i][j] + bias[1024 + n];
        g = fminf(g, 7.f); u = fminf(fmaxf(u, -7.f), 7.f);
        const float glu = g / (1.f + expf(-1.702f * g));
        v = (u + 1.f) * glu;
      } else if (MODE == 2) v += bias[n];
      p.C[(size_t)m * p.ldc + n] = v;
    }
  }
}

__global__ __launch_bounds__(256) void cnorm_k(const float* projA, const float* g, float* cn) {
  const int row = blockIdx.x, tid = threadIdx.x; __shared__ float red[256];
  const float v = projA[(size_t)row * DINA + 1024 + tid];
  red[tid] = v * v; __syncthreads();
  for (int s = 128; s > 0; s >>= 1) { if (tid < s) red[tid] += red[tid + s]; __syncthreads(); }
  const float r = rsqrtf(red[0] * (1.f / 256.f) + 1e-6f);
  cn[(size_t)row * 256 + tid] = v * r * g[tid];
}

__global__ __launch_bounds__(256) void iscore_k(const float* projA, float* sc) {
  const int st = blockIdx.x, tt = blockIdx.y, b = blockIdx.z; if (st > tt) return;
  __shared__ float As[16][68]; __shared__ float Bs[16][68];
  const int tid = threadIdx.x, tx = tid & 15, ty = tid >> 4;
  const int t0 = tt * 64, s0 = st * 64;
  const int ar = tid >> 2, ak = (tid & 3) * 4;
  const float* Qp = projA + (size_t)(b * L + t0 + ar) * DINA + 1280 + ak;
  const float* Kp = projA + (size_t)(b * L + s0 + ar) * DINA + 1792 + ak;
  float score[4][4] = {};
  for (int h = 0; h < 8; ++h) {
    float acc[4][4] = {};
    for (int k0 = 0; k0 < 64; k0 += 16) {
      const float4 av = *(const float4*)(Qp + h * 64 + k0);
      As[ak + 0][ar] = av.x; As[ak + 1][ar] = av.y; As[ak + 2][ar] = av.z; As[ak + 3][ar] = av.w;
      const float4 bv = *(const float4*)(Kp + k0);
      Bs[ak + 0][ar] = bv.x; Bs[ak + 1][ar] = bv.y; Bs[ak + 2][ar] = bv.z; Bs[ak + 3][ar] = bv.w;
      __syncthreads();
#pragma unroll
      for (int kk = 0; kk < 16; ++kk) {
        const float4 a = *(const float4*)&As[kk][ty * 4]; const float4 bq = *(const float4*)&Bs[kk][tx * 4];
        const float aa[4] = {a.x, a.y, a.z, a.w}, bb[4] = {bq.x, bq.y, bq.z, bq.w};
#pragma unroll
        for (int i = 0; i < 4; ++i)
#pragma unroll
          for (int j = 0; j < 4; ++j) acc[i][j] = fmaf(aa[i], bb[j], acc[i][j]);
      }
      __syncthreads();
    }
#pragma unroll
    for (int i = 0; i < 4; ++i) {
      const float w = projA[(size_t)(b * L + t0 + ty * 4 + i) * DINA + 1856 + h] * 0.35355339059327373f;
#pragma unroll
      for (int j = 0; j < 4; ++j) score[i][j] += w * fmaxf(acc[i][j] * 0.125f, 0.f);
    }
  }
#pragma unroll
  for (int i = 0; i < 4; ++i)
#pragma unroll
    for (int j = 0; j < 4; ++j) sc[((size_t)(b * L + t0 + ty * 4 + i)) * L + s0 + tx * 4 + j] = score[i][j];
}

__device__ __forceinline__ unsigned f2key(float f) { f = f + 0.0f; const unsigned u = __float_as_uint(f); return (u & 0x80000000u) ? ~u : (u | 0x80000000u); }

__global__ __launch_bounds__(256) void topk_k(const float* sc, int* idx_out) {
  const int row = blockIdx.x, t = row % L, n = t + 1, tid = threadIdx.x;
  const float* s = sc + (size_t)row * L; int* out = idx_out + (size_t)row * 256;
  __shared__ unsigned hist[256]; __shared__ unsigned sh_prefix, sh_need; __shared__ int cnt;
  if (n <= 256) { out[tid] = tid < n ? tid : -1; return; }
  unsigned prefix = 0, need = 256;
  for (int pass = 3; pass >= 0; --pass) {
    const int shift = pass * 8;
    hist[tid] = 0; __syncthreads();
    for (int i = tid; i < n; i += 256) { const unsigned k = f2key(s[i]); const bool m = (pass == 3) || ((k >> (shift + 8)) == (prefix >> (shift + 8))); if (m) atomicAdd(&hist[(k >> shift) & 255u], 1u); }
    __syncthreads();
    if (tid == 0) { unsigned cum = 0; int d = 255; for (; d > 0; --d) { if (cum + hist[d] >= need) break; cum += hist[d]; } sh_prefix = prefix | ((unsigned)d << shift); sh_need = need - cum; }
    __syncthreads(); prefix = sh_prefix; need = sh_need; __syncthreads();
  }
  if (tid == 0) cnt = 0; __syncthreads();
  for (int i = tid; i < n; i += 256) { if (f2key(s[i]) > prefix) { const int pos = atomicAdd(&cnt, 1); out[pos] = i; } }
  __syncthreads();
  if (tid == 0) { int c = cnt; unsigned nd = need; for (int i = 0; i < n && nd > 0; ++i) if (f2key(s[i]) == prefix) { out[c++] = i; --nd; } }
}

__global__ __launch_bounds__(256) void dsa_attn_k(const float* projA, const float* cn, const int* idx, const float* w_uk, const float* w_uv, float* o2) {
  const int row = blockIdx.x, b = row / L, tid = threadIdx.x;
  __shared__ float qs[1024]; __shared__ float ql[16][256]; __shared__ float pr[16][257]; __shared__ float ol[16][256]; __shared__ float red[16]; __shared__ int sid[256];
  for (int i = tid; i < 1024; i += 256) qs[i] = projA[(size_t)row * DINA + i];
  sid[tid] = idx[(size_t)row * 256 + tid];
  __syncthreads();
  { const int c = tid;
    for (int h = 0; h < 16; ++h) { float a = 0.f; for (int d = 0; d < 64; ++d) a = fmaf(qs[h * 64 + d], w_uk[((size_t)h * 64 + d) * 256 + c], a); ql[h][c] = a; } }
  __syncthreads();
  { const int k = tid, key = sid[k];
    float lg[16];
    if (key >= 0) { const float* cr = cn + (size_t)(b * L + key) * 256;
      for (int h = 0; h < 16; ++h) lg[h] = 0.f;
      for (int c = 0; c < 256; ++c) { const float cv = cr[c]; for (int h = 0; h < 16; ++h) lg[h] = fmaf(ql[h][c], cv, lg[h]); }
      for (int h = 0; h < 16; ++h) pr[h][k] = lg[h] * 0.125f;
    } else for (int h = 0; h < 16; ++h) pr[h][k] = -INFINITY; }
  __syncthreads();
  if (tid < 16) { const int h = tid; float m = -INFINITY; for (int k = 0; k < 256; ++k) m = fmaxf(m, pr[h][k]); float su = 0.f; for (int k = 0; k < 256; ++k) { const float e = expf(pr[h][k] - m); pr[h][k] = e; su += e; } red[h] = 1.f / su; }
  __syncthreads();
  { const int c = tid; float a[16]; for (int h = 0; h < 16; ++h) a[h] = 0.f;
    for (int k = 0; k < 256; ++k) { const int key = sid[k]; if (key < 0) continue; const float cv = cn[(size_t)(b * L + key) * 256 + c]; for (int h = 0; h < 16; ++h) a[h] = fmaf(pr[h][k], cv, a[h]); }
    for (int h = 0; h < 16; ++h) ol[h][c] = a[h] * red[h]; }
  __syncthreads();
  for (int o = tid; o < 1024; o += 256) { const int h = o >> 6, v = o & 63; float a = 0.f; for (int c = 0; c < 256; ++c) a = fmaf(ol[h][c], w_uv[((size_t)h * 256 + c) * 64 + v], a); o2[(size_t)row * 1024 + o] = a; }
}

__global__ __launch_bounds__(256) void ln_res_k(const float* x, const float* h, const float* g, const float* bb, float* out) {
  const int row = blockIdx.x, tid = threadIdx.x; __shared__ float red[256];
  float v[4]; float s = 0.f;
  for (int j = 0; j < 4; ++j) { const int c = tid + 256 * j; v[j] = ALPHA * x[(size_t)row * D + c] + h[(size_t)row * D + c]; s += v[j]; }
  red[tid] = s; __syncthreads(); for (int st = 128; st > 0; st >>= 1) { if (tid < st) red[tid] += red[tid + st]; __syncthreads(); }
  const float mu = red[0] * (1.f / D); __syncthreads();
  float q = 0.f; for (int j = 0; j < 4; ++j) { v[j] -= mu; q += v[j] * v[j]; }
  red[tid] = q; __syncthreads(); for (int st = 128; st > 0; st >>= 1) { if (tid < st) red[tid] += red[tid + st]; __syncthreads(); }
  const float r = rsqrtf(red[0] * (1.f / D) + 1e-5f);
  for (int j = 0; j < 4; ++j) { const int c = tid + 256 * j; out[(size_t)row * D + c] = v[j] * r * g[c] + bb[c]; }
}

__global__ __launch_bounds__(64) void router_k(const float* x, const float* wr, const float* br, int* tok_e, float* tok_g, int* counts) {
  const int tok = blockIdx.x * 2 + (threadIdx.x >> 5), e = threadIdx.x & 31; __shared__ float lg[2][32];
  const float* xr = x + (size_t)tok * D; float a = 0.f;
  for (int d = 0; d < D; ++d) a = fmaf(xr[d], wr[d * 32 + e], a);
  lg[threadIdx.x >> 5][e] = a + br[e]; __syncthreads();
  if (e == 0) { float* l = lg[threadIdx.x >> 5]; int ei[4]; float ev[4];
    for (int k = 0; k < 4; ++k) { int bi = 0; float bv = -INFINITY; for (int j = 0; j < 32; ++j) if (l[j] > bv) { bv = l[j]; bi = j; } ei[k] = bi; ev[k] = bv; l[bi] = -INFINITY; }
    float su = 0.f, ex[4]; for (int k = 0; k < 4; ++k) { ex[k] = expf(ev[k] - ev[0]); su += ex[k]; }
    for (int k = 0; k < 4; ++k) { tok_e[tok * 4 + k] = ei[k]; tok_g[tok * 4 + k] = ex[k] / su; atomicAdd(&counts[ei[k]], 1); } }
}
__global__ __launch_bounds__(64) void moe_sort_k(const int* tok_e, const float* tok_g, const int* counts, int* row_tok, float* row_gate, int* slot_of, int* blk_e, int* nblk_used) {
  const int e = threadIdx.x; __shared__ int pstart[33]; __shared__ int stage[2048];
  if (e == 0) { int acc = 0; for (int j = 0; j < 32; ++j) { pstart[j] = acc; const int nb = (counts[j] + 255) / 256; for (int q = 0; q < nb; ++q) blk_e[acc / 256 + q] = j; acc += nb * 256; } pstart[32] = acc; *nblk_used = acc / 256; }
  __syncthreads();
  int pos = e < 32 ? pstart[e] : 0;
  for (int c0 = 0; c0 < NT * 4; c0 += 2048) {
    __syncthreads();
    for (int i = e; i < 2048; i += 64) stage[i] = tok_e[c0 + i];
    __syncthreads();
    if (e < 32) for (int i = 0; i < 2048; ++i) if (stage[i] == e) { const int gi = c0 + i; row_tok[pos] = gi >> 2; row_gate[pos] = tok_g[gi]; slot_of[gi] = pos; ++pos; }
  }
}
__global__ __launch_bounds__(256) void moe_combine_ln_k(const float* x1, const float* ys, const int* slot_of, const float* tok_g, const float* g, const float* bb, float* out) {
  const int row = blockIdx.x, tid = threadIdx.x; __shared__ float red[256];
  float v[4]; float s = 0.f;
  for (int j = 0; j < 4; ++j) { const int c = tid + 256 * j; float f = 0.f; for (int k = 0; k < 4; ++k) f += tok_g[row * 4 + k] * ys[(size_t)slot_of[row * 4 + k] * D + c]; v[j] = ALPHA * x1[(size_t)row * D + c] + f; s += v[j]; }
  red[tid] = s; __syncthreads(); for (int st = 128; st > 0; st >>= 1) { if (tid < st) red[tid] += red[tid + st]; __syncthreads(); }
  const float mu = red[0] * (1.f / D); __syncthreads();
  float q = 0.f; for (int j = 0; j < 4; ++j) { v[j] -= mu; q += v[j] * v[j]; }
  red[tid] = q; __syncthreads(); for (int st = 128; st > 0; st >>= 1) { if (tid < st) red[tid] += red[tid + st]; __syncthreads(); }
  const float r = rsqrtf(red[0] * (1.f / D) + 1e-5f);
  for (int j = 0; j < 4; ++j) { const int c = tid + 256 * j; out[(size_t)row * D + c] = v[j] * r * g[c] + bb[c]; }
}

__global__ __launch_bounds__(256) void gla_gate_k(const float* projB, const float* w_g2, const float* gb, float* adec) {
  const int row = blockIdx.x, tid = threadIdx.x; __shared__ float glr[16];
  if (tid < 16) glr[tid] = projB[(size_t)row * DINB + 2048 + tid]; __syncthreads();
  for (int c = tid; c < 512; c += 256) { float a = gb[c]; for (int j = 0; j < 16; ++j) a = fmaf(glr[j], w_g2[j * 512 + c], a);
    const float ls = fminf(a, 0.f) - log1pf(expf(-fabsf(a))); adec[(size_t)row * 512 + c] = expf(ls * (1.f / 16.f)); }
}
__global__ __launch_bounds__(256) void gla_scan_k(const float* projB, const float* adec, float* og) {
  const int b = blockIdx.x >> 2, h = blockIdx.x & 3, tid = threadIdx.x;
  __shared__ float qs[16][128], ks[16][128], as[16][128];
  float S[128];
#pragma unroll
  for (int d = 0; d < 128; ++d) S[d] = 0.f;
  for (int t0 = 0; t0 < L; t0 += 16) {
    __syncthreads();
    for (int i = tid; i < 16 * 128; i += 256) { const int tt = i >> 7, d = i & 127; const size_t r = (size_t)(b * L + t0 + tt);
      qs[tt][d] = projB[r * DINB + h * 128 + d] * 0.08838834764831845f; ks[tt][d] = projB[r * DINB + 512 + h * 128 + d]; as[tt][d] = adec[r * 512 + h * 128 + d]; }
    __syncthreads();
    for (int tt = 0; tt < 16; ++tt) { const size_t r = (size_t)(b * L + t0 + tt); const float v = projB[r * DINB + 1024 + h * 256 + tid]; float o = 0.f;
#pragma unroll
      for (int d = 0; d < 128; ++d) { S[d] = fmaf(as[tt][d], S[d], ks[tt][d] * v); o = fmaf(qs[tt][d], S[d], o); }
      og[r * 1024 + h * 256 + tid] = o; }
  }
}
__global__ __launch_bounds__(256) void gla_norm_k(const float* og, const float* projB, const float* ng, float* on) {
  const int row = blockIdx.x >> 2, h = blockIdx.x & 3, tid = threadIdx.x; __shared__ float red[256];
  const float v = og[(size_t)row * 1024 + h * 256 + tid]; red[tid] = v * v; __syncthreads();
  for (int s = 128; s > 0; s >>= 1) { if (tid < s) red[tid] += red[tid + s]; __syncthreads(); }
  const float r = rsqrtf(red[0] * (1.f / 256.f) + 1e-6f); const float rr = projB[(size_t)row * DINB + 2064 + h * 256 + tid];
  on[(size_t)row * 1024 + h * 256 + tid] = v * r * ng[h * 256 + tid] * (rr / (1.f + expf(-rr)));
}

struct Ws { float *projA, *cn, *sc, *o2, *h, *x1, *x2, *hb, *ys, *projB, *adec, *og, *on, *tok_g, *row_gate; int *idx, *tok_e, *slot_of, *row_tok, *blk_e, *counts; size_t total; };
inline Ws carve(void* ws) {
  Ws w; char* p = (char*)ws; auto take = [&](size_t bytes) { char* r = p; p += (bytes + 255) & ~(size_t)255; return r; };
  w.counts = (int*)take(64 * 4);
  w.projA = (float*)take((size_t)NT * DINA * 4); w.cn = (float*)take((size_t)NT * 256 * 4); w.sc = (float*)take((size_t)NB * L * L * 4);
  w.idx = (int*)take((size_t)NT * 256 * 4); w.o2 = (float*)take((size_t)NT * D * 4); w.h = (float*)take((size_t)NT * D * 4);
  w.x1 = (float*)take((size_t)NT * D * 4); w.x2 = (float*)take((size_t)NT * D * 4);
  w.tok_e = (int*)take(NT * 4 * 4); w.tok_g = (float*)take(NT * 4 * 4); w.slot_of = (int*)take(NT * 4 * 4);
  w.row_tok = (int*)take(PMAX * 4); w.row_gate = (float*)take(PMAX * 4); w.blk_e = (int*)take(512 * 4);
  w.hb = (float*)take((size_t)PMAX * D * 4); w.ys = (float*)take((size_t)PMAX * D * 4);
  char* q = (char*)w.sc; auto take2 = [&](size_t bytes) { char* r = q; q += (bytes + 255) & ~(size_t)255; return r; };
  w.projB = (float*)take2((size_t)NT * DINB * 4); w.adec = (float*)take2((size_t)NT * 512 * 4); w.og = (float*)take2((size_t)NT * D * 4); w.on = (float*)take2((size_t)NT * D * 4);
  w.total = (size_t)(p - (char*)ws); return w;
}

struct In { const float *x, *a_w_in, *a_kv_norm, *a_w_uk, *a_w_uv, *a_w_out, *b_w_in, *b_w_g2, *b_g_bias, *b_norm, *b_w_out, *m_w_router, *m_b_router, *m_w1, *m_b1, *m_w2, *m_b2, *ln1_g, *ln1_b, *ln2_g, *ln2_b; };

inline void moe_layer(const In& I, const Ws& w, int li, const float* x1, float* xout, hipStream_t st) {
  (void)hipMemsetAsync(w.counts, 0, 64 * 4, st); (void)hipMemsetAsync(w.row_tok, 0, PMAX * 4, st);
  router_k<<<NT / 2, 64, 0, st>>>(x1, I.m_w_router + (size_t)li * D * 32, I.m_b_router + li * 32, w.tok_e, w.tok_g, w.counts);
  moe_sort_k<<<1, 64, 0, st>>>(w.tok_e, w.tok_g, w.counts, w.row_tok, w.row_gate, w.slot_of, w.blk_e, w.counts + 32);
  const GemmP g1 = mkg(x1, D, w.row_tok, I.m_w1 + (size_t)li * 32 * D * 2048, 2048, w.hb, D, PMAX, 1024, D, w.blk_e, w.counts + 32, (size_t)D * 2048, I.m_b1 + (size_t)li * 32 * 2048, 2048);
  sgemm<1><<<dim3(1024 / 64, PMAX / 64), 256, 0, st>>>(g1);
  const GemmP g2 = mkg(w.hb, D, nullptr, I.m_w2 + (size_t)li * 32 * D * D, D, w.ys, D, PMAX, D, D, w.blk_e, w.counts + 32, (size_t)D * D, I.m_b2 + (size_t)li * 32 * D, (size_t)D);
  sgemm<2><<<dim3(1024 / 64, PMAX / 64), 256, 0, st>>>(g2);
  moe_combine_ln_k<<<NT, 256, 0, st>>>(x1, w.ys, w.slot_of, w.tok_g, I.ln2_g + li * D, I.ln2_b + li * D, xout);
}

inline void forward(const In& I, void* d_ws, float* out, hipStream_t st, int stop_after = 99) {
  const Ws w = carve(d_ws);
  const GemmP gp = mkg(I.x, D, nullptr, I.a_w_in, DINA, w.projA, DINA, NT, DINA, D, nullptr, nullptr, 0, nullptr, 0);
  sgemm<0><<<dim3((DINA + 63) / 64, NT / 64), 256, 0, st>>>(gp);
  cnorm_k<<<NT, 256, 0, st>>>(w.projA, I.a_kv_norm, w.cn);
  iscore_k<<<dim3(L / 64, L / 64, NB), 256, 0, st>>>(w.projA, w.sc);
  topk_k<<<NT, 256, 0, st>>>(w.sc, w.idx);
  dsa_attn_k<<<NT, 256, 0, st>>>(w.projA, w.cn, w.idx, I.a_w_uk, I.a_w_uv, w.o2);
  const GemmP go = mkg(w.o2, D, nullptr, I.a_w_out, D, w.h, D, NT, D, D, nullptr, nullptr, 0, nullptr, 0);
  sgemm<0><<<dim3(D / 64, NT / 64), 256, 0, st>>>(go);
  ln_res_k<<<NT, 256, 0, st>>>(I.x, w.h, I.ln1_g, I.ln1_b, w.x1);
  moe_layer(I, w, 0, w.x1, w.x2, st);
  const GemmP gb = mkg(w.x2, D, nullptr, I.b_w_in, DINB, w.projB, DINB, NT, DINB, D, nullptr, nullptr, 0, nullptr, 0);
  sgemm<0><<<dim3((DINB + 63) / 64, NT / 64), 256, 0, st>>>(gb);
  gla_gate_k<<<NT, 256, 0, st>>>(w.projB, I.b_w_g2, I.b_g_bias, w.adec);
  gla_scan_k<<<8, 256, 0, st>>>(w.projB, w.adec, w.og);
  gla_norm_k<<<NT * 4, 256, 0, st>>>(w.og, w.projB, I.b_norm, w.on);
  const GemmP go2 = mkg(w.on, D, nullptr, I.b_w_out, D, w.h, D, NT, D, D, nullptr, nullptr, 0, nullptr, 0);
  sgemm<0><<<dim3(D / 64, NT / 64), 256, 0, st>>>(go2);
  ln_res_k<<<NT, 256, 0, st>>>(w.x2, w.h, I.ln1_g + D, I.ln1_b + D, w.x1);
  moe_layer(I, w, 1, w.x1, out, st);
}
}
extern "C" void kernel_launch(void* const* d_in, const int* in_sizes, int n_in, void* d_out, int out_size, void* d_ws, size_t ws_size, hipStream_t stream) {
  nv::In I;
  const float** f = (const float**)&I;
  for (int i = 0; i < 21; ++i) f[i] = (const float*)d_in[i];
  const nv::Ws w = nv::carve(d_ws);
  if (n_in != 21 || w.total > ws_size) { fprintf(stderr, "kernel_launch: bad inputs (n_in %d) or workspace too small (%zu needed, %zu given)\n", n_in, w.total, ws_size); return; }
  nv::forward(I, d_ws, (float*)d_out, stream);
}
```

```cpp
#include <hip/hip_runtime.h>
#include <cstdio>
#include <cstdint>
#include <cstring>

#define GAS __attribute__((address_space(1)))
#define LAS __attribute__((address_space(3)))
#define NTHR 512
constexpr int LDS_BYTES = 147456;
constexpr int MISC_OFF = 131072 + 8192;

#define XB_TMO      128
#define XB_XCNT(j)  (256  + 64 * (j))
#define XB_XSUB(j)  (1280 + 64 * (j))
#define XB_XGEN(j)  (2304 + 64 * (j))
#define XB_TOP      3328
#define XB_TOPGEN   3392
#define XCD_BAR_WORDS 3456
#define XB_SPIN_CAP (1u << 25)
__device__ __forceinline__ unsigned xb_ld(unsigned* p)              { return __hip_atomic_load(p, __ATOMIC_RELAXED, __HIP_MEMORY_SCOPE_AGENT); }
__device__ __forceinline__ unsigned xb_add(unsigned* p, unsigned v) { return __hip_atomic_fetch_add(p, v, __ATOMIC_RELAXED, __HIP_MEMORY_SCOPE_AGENT); }
__device__ __forceinline__ unsigned xb_xcc_id() { return (unsigned)__builtin_amdgcn_s_getreg((3 << 11) | 20) & 0xFu; }
#define XB_SPIN(cond, bar) do { unsigned _sp = 0; while (cond) { __builtin_amdgcn_s_sleep(1); \
    if ((++_sp & 255u) == 0u) { if (xb_ld(&(bar)[XB_TMO])) break; if (_sp > XB_SPIN_CAP) { atomicAdd(&(bar)[XB_TMO], 1u); break; } } } } while (0)
struct XcdBarrier { unsigned* bar; unsigned x; volatile LAS unsigned* st; };
__device__ __forceinline__ XcdBarrier xcd_barrier_post(unsigned* bar, volatile LAS unsigned* st) {
    XcdBarrier b; b.bar = bar; b.x = xb_xcc_id(); b.st = st;
    if (threadIdx.x == 0) (void)xb_add(&bar[XB_XCNT(b.x)], 1u);
    return b;
}
__device__ __forceinline__ void xcd_barrier_complete(unsigned* bar, unsigned x, unsigned& nloc, unsigned& nx) {
    const unsigned G = gridDim.x * gridDim.y * gridDim.z;
    unsigned sum, cnt, mine, sp = 0u;
    for (;;) {
        sum = 0u; cnt = 0u; mine = 0u;
#pragma unroll
        for (unsigned j = 0; j < 16; ++j) { const unsigned c = xb_ld(&bar[XB_XCNT(j)]); sum += c; cnt += (c > 0u) ? 1u : 0u; mine = (j == x) ? c : mine; }
        if (sum == G) break;
        __builtin_amdgcn_s_sleep(1);
        if ((++sp & 255u) == 0u) { if (xb_ld(&bar[XB_TMO])) break; if (sp > XB_SPIN_CAP) { atomicAdd(&bar[XB_TMO], 1u); break; } }
    }
    nloc = mine > 0u ? mine : 1u; nx = cnt > 0u ? cnt : 1u;
}
__device__ __forceinline__ void xcd_barrier(const XcdBarrier& b) {
    asm volatile("s_waitcnt vmcnt(0)" ::: "memory");
    __syncthreads();
    if (threadIdx.x == 0) {
        unsigned* bar = b.bar;
        __builtin_amdgcn_s_waitcnt(0);
        unsigned nloc = b.st[0], nx = b.st[1];
        if (nloc == 0u) { xcd_barrier_complete(bar, b.x, nloc, nx); b.st[0] = nloc; b.st[1] = nx; }
        const unsigned old = xb_add(&bar[XB_XSUB(b.x)], 1u);
        const unsigned gen = old / nloc;
        if (old + 1u == (gen + 1u) * nloc) {
            __builtin_amdgcn_fence(__ATOMIC_RELEASE, "agent");
            asm volatile("s_waitcnt vmcnt(0)" ::: "memory");
            const unsigned og = xb_add(&bar[XB_TOP], 1u);
            const unsigned tg = og / nx;
            if (og + 1u == (tg + 1u) * nx) xb_add(&bar[XB_TOPGEN], 1u);
            else XB_SPIN(xb_ld(&bar[XB_TOPGEN]) == tg, bar);
            __builtin_amdgcn_fence(__ATOMIC_ACQUIRE, "agent");
            xb_add(&bar[XB_XGEN(b.x)], 1u);
            asm volatile("s_waitcnt vmcnt(0)" ::: "memory");
        } else {
            XB_SPIN(xb_ld(&bar[XB_XGEN(b.x)]) == gen, bar);
            __builtin_amdgcn_fence(__ATOMIC_ACQUIRE, "agent");
            asm volatile("s_waitcnt vmcnt(0)" ::: "memory");
        }
    }
    __syncthreads();
}

constexpr int NT = 16384, D = 1024, L = 8192, NB = 2;
constexpr int DINA = 1864, DINB = 3088;
constexpr int PMAX = 73728;
constexpr float ALPHA = 1.4142135623730951f;

struct In { const float *x, *a_w_in, *a_kv_norm, *a_w_uk, *a_w_uv, *a_w_out, *b_w_in, *b_w_g2, *b_g_bias, *b_norm, *b_w_out, *m_w_router, *m_b_router, *m_w1, *m_b1, *m_w2, *m_b2, *ln1_g, *ln1_b, *ln2_g, *ln2_b; };

__device__ __forceinline__ int TIDX() { int t = threadIdx.x; asm volatile("" : "+v"(t)); return t; }
__device__ __forceinline__ int BIDX() { int t = blockIdx.x; asm volatile("" : "+s"(t)); return t; }
__device__ __forceinline__ float wave_sum(float v) {
#pragma unroll
    for (int o = 1; o < 64; o <<= 1) v += __shfl_xor(v, o);
    return v;
}
namespace nvp {
#define WSYNC() asm volatile("s_waitcnt lgkmcnt(0)" ::: "memory")
struct GemmP {
  const float* A; int lda; const int* arow;
  const float* B; int ldb; float* C; int ldc; int M, N, K;
  const int* blk_e; const int* nblk_used; size_t bstride; const float* bias; size_t bias_stride;
};
__device__ __forceinline__ GemmP mkg(const float* A, int lda, const int* arow, const float* B, int ldb, float* C, int ldc, int M, int N, int K, const int* blk_e, const int* nblk_used, size_t bstride, const float* bias, size_t bias_stride) {
  GemmP p; p.A = A; p.lda = lda; p.arow = arow; p.B = B; p.ldb = ldb; p.C = C; p.ldc = ldc; p.M = M; p.N = N; p.K = K; p.blk_e = blk_e; p.nblk_used = nblk_used; p.bstride = bstride; p.bias = bias; p.bias_stride = bias_stride; return p; }

template <int MODE>
__device__ __forceinline__ void np_sgemm(const GemmP p, float* lds) {
  float (*As)[132] = (float (*)[132])lds;
  float (*Bs)[68] = (float (*)[68])(lds + 16 * 132);
  float (*Bu)[68] = (float (*)[68])(lds + 16 * 132 + 16 * 68);
  const int tid = TIDX(), tx = tid & 15, ty = tid >> 4;
  const int ntn = (p.N + 63) / 64, ntm = p.M / 128;
  const int ar = tid >> 2, ak = (tid & 3) * 4;
  const int bk = (tid & 255) >> 4, bn4 = (tid & 15) * 4;
  for (int t = BIDX(); t < ntm * ntn; t += gridDim.x) {
    const int bm = t / ntn, bn = t % ntn;
    const float* B = p.B; const float* bias = p.bias;
    if (MODE != 0) { const int blk = (bm * 128) / 256; if (blk >= *p.nblk_used) continue; const int e = p.blk_e[blk]; B += (size_t)e * p.bstride; bias += (size_t)e * p.bias_stride; }
    const int m0 = bm * 128, n0 = bn * 64;
    const int arow = p.arow ? p.arow[m0 + ar] : (m0 + ar);
    const float* Ap = p.A + (size_t)arow * p.lda + ak;
    const bool bok = (n0 + bn4) < p.N;
    float acc[4][4] = {}, accu[4][4] = {};
    for (int k0 = 0; k0 < p.K; k0 += 16) {
      const float4 av = *(const float4*)(Ap + k0);
      As[ak + 0][ar] = av.x; As[ak + 1][ar] = av.y; As[ak + 2][ar] = av.z; As[ak + 3][ar] = av.w;
      if (tid < 256) { float4 bv = make_float4(0.f, 0.f, 0.f, 0.f); if (bok) bv = *(const float4*)(B + (size_t)(k0 + bk) * p.ldb + n0 + bn4); *(float4*)&Bs[bk][bn4] = bv; }
      else if (MODE == 1) { const float4 uv = *(const float4*)(B + (size_t)(k0 + bk) * p.ldb + 1024 + n0 + bn4); *(float4*)&Bu[bk][bn4] = uv; }
      __syncthreads();
#pragma unroll
      for (int kk = 0; kk < 16; ++kk) {
        const float4 a = *(const float4*)&As[kk][ty * 4];
        const float4 b = *(const float4*)&Bs[kk][tx * 4];
        const float aa[4] = {a.x, a.y, a.z, a.w}, bb[4] = {b.x, b.y, b.z, b.w};
#pragma unroll
        for (int i = 0; i < 4; ++i)
#pragma unroll
          for (int j = 0; j < 4; ++j) acc[i][j] = fmaf(aa[i], bb[j], acc[i][j]);
        if (MODE == 1) {
          const float4 u = *(const float4*)&Bu[kk][tx * 4]; const float uu[4] = {u.x, u.y, u.z, u.w};
#pragma unroll
          for (int i = 0; i < 4; ++i)
#pragma unroll
            for (int j = 0; j < 4; ++j) accu[i][j] = fmaf(aa[i], uu[j], accu[i][j]);
        }
      }
      __syncthreads();
    }
#pragma unroll
    for (int i = 0; i < 4; ++i) {
      const int m = m0 + ty * 4 + i;
#pragma unroll
      for (int j = 0; j < 4; ++j) {
        const int n = n0 + tx * 4 + j; if (n >= p.N) continue;
        float v = acc[i][j];
        if (MODE == 1) {
          float g = v + bias[n], u = accu[i][j] + bias[1024 + n];
          g = fminf(g, 7.f); u = fminf(fmaxf(u, -7.f), 7.f);
          const float glu = g / (1.f + expf(-1.702f * g));
          v = (u + 1.f) * glu;
        } else if (MODE == 2) v += bias[n];
        p.C[(size_t)m * p.ldc + n] = v;
      }
    }
  }
}

#define GW_INIT const int lane = TIDX() & 63, wave = TIDX() >> 6, gw = BIDX() * 8 + wave, NGW = gridDim.x * 8; (void)lane; (void)wave; (void)gw; (void)NGW

__device__ __forceinline__ void np_cnorm(const float* projA, const float* g, float* cn) {
  GW_INIT;
  for (int row = gw; row < NT; row += NGW) {
    const float4 v = *(const float4*)(projA + (size_t)row * DINA + 1024 + lane * 4);
    const float ss = wave_sum(v.x * v.x + v.y * v.y + v.z * v.z + v.w * v.w);
    const float r = rsqrtf(ss * (1.f / 256.f) + 1e-6f); const float4 g4 = *(const float4*)(g + lane * 4);
    *(float4*)(cn + (size_t)row * 256 + lane * 4) = make_float4(v.x * r * g4.x, v.y * r * g4.y, v.z * r * g4.z, v.w * r * g4.w);
  }
}

__device__ __forceinline__ void np_iscore(const float* projA, float* sc, float* lds) {
  float (*As)[132] = (float (*)[132])lds;
  float (*Bs)[68] = (float (*)[68])(lds + 16 * 132);
  const int tid = TIDX(), tx = tid & 15, ty = tid >> 4;
  const int ar = tid >> 2, ak = (tid & 3) * 4;
  const int br = (tid & 255) >> 2;
  for (int u = BIDX(); u < NB * 64 * 128; u += gridDim.x) {
    const int b = u / (64 * 128), tt = (u / 128) % 64, st = u % 128;
    if (st > 2 * tt + 1) continue;
    const int t0 = tt * 128, s0 = st * 64;
    const float* Qp = projA + (size_t)(b * L + t0 + ar) * DINA + 1280 + ak;
    const float* Kp = projA + (size_t)(b * L + s0 + br) * DINA + 1792 + ak;
    float score[4][4] = {};
    for (int h = 0; h < 8; ++h) {
      float acc[4][4] = {};
      for (int k0 = 0; k0 < 64; k0 += 16) {
        const float4 av = *(const float4*)(Qp + h * 64 + k0);
        As[ak + 0][ar] = av.x; As[ak + 1][ar] = av.y; As[ak + 2][ar] = av.z; As[ak + 3][ar] = av.w;
        if (tid < 256) { const float4 bv = *(const float4*)(Kp + k0); Bs[ak + 0][br] = bv.x; Bs[ak + 1][br] = bv.y; Bs[ak + 2][br] = bv.z; Bs[ak + 3][br] = bv.w; }
        __syncthreads();
#pragma unroll
        for (int kk = 0; kk < 16; ++kk) {
          const float4 a = *(const float4*)&As[kk][ty * 4]; const float4 bq = *(const float4*)&Bs[kk][tx * 4];
          const float aa[4] = {a.x, a.y, a.z, a.w}, bb[4] = {bq.x, bq.y, bq.z, bq.w};
#pragma unroll
          for (int i = 0; i < 4; ++i)
#pragma unroll
            for (int j = 0; j < 4; ++j) acc[i][j] = fmaf(aa[i], bb[j], acc[i][j]);
        }
        __syncthreads();
      }
#pragma unroll
      for (int i = 0; i < 4; ++i) {
        const float w = projA[(size_t)(b * L + t0 + ty * 4 + i) * DINA + 1856 + h] * 0.35355339059327373f;
#pragma unroll
        for (int j = 0; j < 4; ++j) score[i][j] += w * fmaxf(acc[i][j] * 0.125f, 0.f);
      }
    }
#pragma unroll
    for (int i = 0; i < 4; ++i)
#pragma unroll
      for (int j = 0; j < 4; ++j) sc[((size_t)(b * L + t0 + ty * 4 + i)) * L + s0 + tx * 4 + j] = score[i][j];
  }
}

__device__ __forceinline__ unsigned f2key(float f) { f = f + 0.0f; const unsigned u = __float_as_uint(f); return (u & 0x80000000u) ? ~u : (u | 0x80000000u); }

__device__ __forceinline__ void np_topk(const float* sc, int* idx_out, char* lds) {
  GW_INIT;
  unsigned* hist = (unsigned*)(lds + wave * 1280); unsigned* cntw = hist + 256;
  for (int row = gw; row < NT; row += NGW) {
    const int t = row % L, n = t + 1;
    const float* s = sc + (size_t)row * L; int* out = idx_out + (size_t)row * 256;
    if (n <= 256) { for (int i = lane; i < 256; i += 64) out[i] = i < n ? i : -1; continue; }
    unsigned prefix = 0, need = 256;
    for (int pass = 3; pass >= 0; --pass) {
      const int shift = pass * 8;
      for (int i = lane; i < 256; i += 64) hist[i] = 0;
      WSYNC();
      for (int i = lane; i < n; i += 64) { const unsigned k = f2key(s[i]); const bool m = (pass == 3) || ((k >> (shift + 8)) == (prefix >> (shift + 8))); if (m) atomicAdd(&hist[(k >> shift) & 255u], 1u); }
      WSYNC();
      unsigned cum = 0; int d = 255; for (; d > 0; --d) { const unsigned hv = hist[d]; if (cum + hv >= need) break; cum += hv; }
      prefix |= ((unsigned)d << shift); need -= cum;
      WSYNC();
    }
    if (lane == 0) *cntw = 0; WSYNC();
    for (int i = lane; i < n; i += 64) { if (f2key(s[i]) > prefix) { const unsigned pos = atomicAdd(cntw, 1u); out[pos] = i; } }
    WSYNC();
    if (lane == 0) { unsigned c = *cntw; unsigned nd = need; for (int i = 0; i < n && nd > 0; ++i) if (f2key(s[i]) == prefix) { out[c++] = i; --nd; } }
    WSYNC();
  }
}

__device__ __forceinline__ void np_dsa_attn(const float* projA, const float* cn, const int* idx, const float* w_uk, const float* w_uv, float* o2, float* lds) {
  const int half = TIDX() >> 8, tid = TIDX() & 255;
  float* base = lds + half * 14336;
  float* qs = base; float (*ql)[256] = (float (*)[256])(base + 1024); float (*pr)[257] = (float (*)[257])(base + 1024 + 4096);
  float (*ol)[256] = (float (*)[256])(base + 1024 + 4096 + 4112); float* red = base + 1024 + 4096 + 4112 + 4096; int* sid = (int*)(red + 16);
  for (int r0 = BIDX() * 2; r0 < NT; r0 += gridDim.x * 2) {
    const int row = r0 + half, b = row / L;
    __syncthreads();
    for (int i = tid; i < 1024; i += 256) qs[i] = projA[(size_t)row * DINA + i];
    sid[tid] = idx[(size_t)row * 256 + tid];
    __syncthreads();
    { const int c = tid;
#pragma unroll 1
      for (int h = 0; h < 16; ++h) { float a = 0.f;
#pragma unroll 8
        for (int d = 0; d < 64; ++d) a = fmaf(qs[h * 64 + d], w_uk[((size_t)h * 64 + d) * 256 + c], a); ql[h][c] = a; } }
    __syncthreads();
    { const int k = tid, key = sid[k];
      float lg[16];
      if (key >= 0) { const float* cr = cn + (size_t)(b * L + key) * 256;
        for (int h = 0; h < 16; ++h) lg[h] = 0.f;
#pragma unroll 2
        for (int c = 0; c < 256; ++c) { const float cv = cr[c];
#pragma unroll
          for (int h = 0; h < 16; ++h) lg[h] = fmaf(ql[h][c], cv, lg[h]); }
#pragma unroll
        for (int h = 0; h < 16; ++h) pr[h][k] = lg[h] * 0.125f;
      } else {
#pragma unroll
        for (int h = 0; h < 16; ++h) pr[h][k] = -INFINITY; } }
    __syncthreads();
    if (tid < 16) { const int h = tid; float m = -INFINITY; for (int k = 0; k < 256; ++k) m = fmaxf(m, pr[h][k]); float su = 0.f; for (int k = 0; k < 256; ++k) { const float e = expf(pr[h][k] - m); pr[h][k] = e; su += e; } red[h] = 1.f / su; }
    __syncthreads();
    { const int c = tid; float a[16];
#pragma unroll
      for (int h = 0; h < 16; ++h) a[h] = 0.f;
#pragma unroll 2
      for (int k = 0; k < 256; ++k) { const int key = sid[k]; if (key < 0) continue; const float cv = cn[(size_t)(b * L + key) * 256 + c];
#pragma unroll
        for (int h = 0; h < 16; ++h) a[h] = fmaf(pr[h][k], cv, a[h]); }
#pragma unroll
      for (int h = 0; h < 16; ++h) ol[h][c] = a[h] * red[h]; }
    __syncthreads();
#pragma unroll 1
    for (int o = tid; o < 1024; o += 256) { const int h = o >> 6, v = o & 63; float a = 0.f;
#pragma unroll 8
      for (int c = 0; c < 256; ++c) a = fmaf(ol[h][c], w_uv[((size_t)h * 256 + c) * 64 + v], a); o2[(size_t)row * 1024 + o] = a; }
  }
  __syncthreads();
}

__device__ __forceinline__ void np_ln_res(const float* x, const float* h, const float* g, const float* bb, float* out) {
  GW_INIT;
  for (int row = gw; row < NT; row += NGW) {
    float4 v[4]; float s = 0.f;
#pragma unroll
    for (int j = 0; j < 4; ++j) { const float4 a = *(const float4*)(x + (size_t)row * D + lane * 4 + 256 * j), hh = *(const float4*)(h + (size_t)row * D + lane * 4 + 256 * j);
      v[j] = make_float4(ALPHA * a.x + hh.x, ALPHA * a.y + hh.y, ALPHA * a.z + hh.z, ALPHA * a.w + hh.w); s += (v[j].x + v[j].y) + (v[j].z + v[j].w); }
    const float mu = wave_sum(s) * (1.f / D); float q = 0.f;
#pragma unroll
    for (int j = 0; j < 4; ++j) { v[j].x -= mu; v[j].y -= mu; v[j].z -= mu; v[j].w -= mu; q += (v[j].x * v[j].x + v[j].y * v[j].y) + (v[j].z * v[j].z + v[j].w * v[j].w); }
    const float r = rsqrtf(wave_sum(q) * (1.f / D) + 1e-5f);
#pragma unroll
    for (int j = 0; j < 4; ++j) { const int c = lane * 4 + 256 * j; const float4 g4 = *(const float4*)(g + c), b4 = *(const float4*)(bb + c);
      *(float4*)(out + (size_t)row * D + c) = make_float4(v[j].x * r * g4.x + b4.x, v[j].y * r * g4.y + b4.y, v[j].z * r * g4.z + b4.z, v[j].w * r * g4.w + b4.w); }
  }
}

__device__ __forceinline__ void np_router(const float* x, const float* wr, const float* br, int* tok_e, float* tok_g, int* counts, int* row_tok, char* lds) {
  GW_INIT;
  for (int i = BIDX() * NTHR + TIDX(); i < PMAX; i += gridDim.x * NTHR) row_tok[i] = 0;
  float* lg = (float*)(lds + wave * 256);
  const int e = lane & 31, hf = lane >> 5;
  for (int tok = gw; tok < NT; tok += NGW) {
    const float* xr = x + (size_t)tok * D + hf * 512; const float* wp = wr + (size_t)hf * 512 * 32 + e; float a = 0.f;
#pragma unroll 8
    for (int d = 0; d < 512; ++d) a = fmaf(xr[d], wp[d * 32], a);
    a += __shfl_xor(a, 32);
    if (hf == 0) lg[e] = a + br[e];
    WSYNC();
    if (lane == 0) { int ei[4]; float ev[4];
      for (int k = 0; k < 4; ++k) { int bi = 0; float bv = -INFINITY; for (int j = 0; j < 32; ++j) if (lg[j] > bv) { bv = lg[j]; bi = j; } ei[k] = bi; ev[k] = bv; lg[bi] = -INFINITY; }
      float su = 0.f, ex[4]; for (int k = 0; k < 4; ++k) { ex[k] = expf(ev[k] - ev[0]); su += ex[k]; }
      for (int k = 0; k < 4; ++k) { tok_e[tok * 4 + k] = ei[k]; tok_g[tok * 4 + k] = ex[k] / su; atomicAdd(&counts[ei[k]], 1); } }
    WSYNC();
  }
}
__device__ __forceinline__ void np_moe_sort(const int* tok_e, const float* tok_g, const int* counts, int* row_tok, float* row_gate, int* slot_of, int* blk_e, int* nblk_used, char* lds) {
  if (BIDX() != 0) return;
  const int e = TIDX(); int* pstart = (int*)lds; int* stage = pstart + 64;
  if (e == 0) { int acc = 0; for (int j = 0; j < 32; ++j) { pstart[j] = acc; const int nb = (counts[j] + 255) / 256; for (int q = 0; q < nb; ++q) blk_e[acc / 256 + q] = j; acc += nb * 256; } pstart[32] = acc; *nblk_used = acc / 256; }
  __syncthreads();
  int pos = e < 32 ? pstart[e] : 0;
  for (int c0 = 0; c0 < NT * 4; c0 += 2048) {
    __syncthreads();
    for (int i = e; i < 2048; i += NTHR) stage[i] = tok_e[c0 + i];
    __syncthreads();
    if (e < 32) for (int i = 0; i < 2048; ++i) if (stage[i] == e) { const int gi = c0 + i; row_tok[pos] = gi >> 2; row_gate[pos] = tok_g[gi]; slot_of[gi] = pos; ++pos; }
  }
  __syncthreads();
}
__device__ __forceinline__ void np_moe_combine_ln(const float* x1, const float* ys, const int* slot_of, const float* tok_g, const float* g, const float* bb, float* out) {
  GW_INIT;
  for (int row = gw; row < NT; row += NGW) {
    float4 v[4]; float s = 0.f; int sl[4]; float gg[4];
#pragma unroll
    for (int k = 0; k < 4; ++k) { sl[k] = slot_of[row * 4 + k]; gg[k] = tok_g[row * 4 + k]; }
#pragma unroll
    for (int j = 0; j < 4; ++j) { const int c = lane * 4 + 256 * j; float4 f = make_float4(0.f, 0.f, 0.f, 0.f);
#pragma unroll
      for (int k = 0; k < 4; ++k) { const float4 y = *(const float4*)(ys + (size_t)sl[k] * D + c); f.x += gg[k] * y.x; f.y += gg[k] * y.y; f.z += gg[k] * y.z; f.w += gg[k] * y.w; }
      const float4 a = *(const float4*)(x1 + (size_t)row * D + c);
      v[j] = make_float4(ALPHA * a.x + f.x, ALPHA * a.y + f.y, ALPHA * a.z + f.z, ALPHA * a.w + f.w); s += (v[j].x + v[j].y) + (v[j].z + v[j].w); }
    const float mu = wave_sum(s) * (1.f / D); float q = 0.f;
#pragma unroll
    for (int j = 0; j < 4; ++j) { v[j].x -= mu; v[j].y -= mu; v[j].z -= mu; v[j].w -= mu; q += (v[j].x * v[j].x + v[j].y * v[j].y) + (v[j].z * v[j].z + v[j].w * v[j].w); }
    const float r = rsqrtf(wave_sum(q) * (1.f / D) + 1e-5f);
#pragma unroll
    for (int j = 0; j < 4; ++j) { const int c = lane * 4 + 256 * j; const float4 g4 = *(const float4*)(g + c), b4 = *(const float4*)(bb + c);
      *(float4*)(out + (size_t)row * D + c) = make_float4(v[j].x * r * g4.x + b4.x, v[j].y * r * g4.y + b4.y, v[j].z * r * g4.z + b4.z, v[j].w * r * g4.w + b4.w); }
  }
}

__device__ __forceinline__ void np_gla_gate(const float* projB, const float* w_g2, const float* gb, float* adec) {
  GW_INIT;
  for (int row = gw; row < NT; row += NGW) {
    float glr[16];
#pragma unroll
    for (int j = 0; j < 16; ++j) glr[j] = projB[(size_t)row * DINB + 2048 + j];
    for (int c = lane; c < 512; c += 64) { float a = gb[c];
#pragma unroll
      for (int j = 0; j < 16; ++j) a = fmaf(glr[j], w_g2[j * 512 + c], a);
      const float ls = fminf(a, 0.f) - log1pf(expf(-fabsf(a))); adec[(size_t)row * 512 + c] = expf(ls * (1.f / 16.f)); }
  }
}
__device__ __forceinline__ void np_gla_scan(const float* projB, const float* adec, float* og, float* lds) {
  if (BIDX() >= 8) return;
  const int b = BIDX() >> 2, h = BIDX() & 3, tid = TIDX(), dv = tid & 255, dh = tid >> 8;
  float (*qs)[128] = (float (*)[128])lds; float (*ks)[128] = (float (*)[128])(lds + 2048); float (*as)[128] = (float (*)[128])(lds + 4096);
  float (*po)[16][256] = (float (*)[16][256])(lds + 6144);
  float S[64];
#pragma unroll
  for (int d = 0; d < 64; ++d) S[d] = 0.f;
  for (int t0 = 0; t0 < L; t0 += 16) {
    __syncthreads();
    for (int i = tid; i < 16 * 128; i += NTHR) { const int tt = i >> 7, d = i & 127; const size_t r = (size_t)(b * L + t0 + tt);
      qs[tt][d] = projB[r * DINB + h * 128 + d] * 0.08838834764831845f; ks[tt][d] = projB[r * DINB + 512 + h * 128 + d]; as[tt][d] = adec[r * 512 + h * 128 + d]; }
    __syncthreads();
#pragma unroll 1
    for (int tt = 0; tt < 16; ++tt) { const size_t r = (size_t)(b * L + t0 + tt); const float v = projB[r * DINB + 1024 + h * 256 + dv]; float o = 0.f;
#pragma unroll
      for (int d = 0; d < 64; ++d) { S[d] = fmaf(as[tt][dh * 64 + d], S[d], ks[tt][dh * 64 + d] * v); o = fmaf(qs[tt][dh * 64 + d], S[d], o); }
      po[dh][tt][dv] = o; }
    __syncthreads();
    for (int i = tid; i < 16 * 256; i += NTHR) { const int tt = i >> 8, c = i & 255; og[(size_t)(b * L + t0 + tt) * 1024 + h * 256 + c] = po[0][tt][c] + po[1][tt][c]; }
  }
  __syncthreads();
}
__device__ __forceinline__ void np_gla_norm(const float* og, const float* projB, const float* ng, float* on) {
  GW_INIT;
  for (int u = gw; u < NT * 4; u += NGW) {
    const int row = u >> 2, h = u & 3; const int c = h * 256 + lane * 4;
    const float4 v = *(const float4*)(og + (size_t)row * 1024 + c);
    const float r = rsqrtf(wave_sum(v.x * v.x + v.y * v.y + v.z * v.z + v.w * v.w) * (1.f / 256.f) + 1e-6f);
    const float4 rr = *(const float4*)(projB + (size_t)row * DINB + 2064 + c), g4 = *(const float4*)(ng + c);
    *(float4*)(on + (size_t)row * 1024 + c) = make_float4(v.x * r * g4.x * (rr.x / (1.f + expf(-rr.x))), v.y * r * g4.y * (rr.y / (1.f + expf(-rr.y))), v.z * r * g4.z * (rr.z / (1.f + expf(-rr.z))), v.w * r * g4.w * (rr.w / (1.f + expf(-rr.w))));
  }
}

struct Ws { float *projA, *cn, *sc, *o2, *h, *x1, *x2, *hb, *ys, *projB, *adec, *og, *on, *tok_g, *row_gate; int *idx, *tok_e, *slot_of, *row_tok, *blk_e, *counts; };
}
constexpr size_t MiB = 1u << 20;
constexpr size_t WS_CTL = 0, CTL_ZERO_BYTES = 1 * MiB;
constexpr int CW_BAR = 4096, CW_CNT = 16384;

struct Args { In in; float* out; unsigned char* ws; };

__device__ __forceinline__ nvp::Ws carve_ws(unsigned char* ws) {
  nvp::Ws w; char* p = (char*)ws + 2 * MiB; auto take = [&](size_t bytes) { char* r = p; p += (bytes + 255) & ~(size_t)255; return r; };
  w.counts = (int*)(ws + WS_CTL) + CW_CNT;
  w.projA = (float*)take((size_t)NT * DINA * 4); w.cn = (float*)take((size_t)NT * 256 * 4); w.sc = (float*)take((size_t)NB * L * L * 4);
  w.idx = (int*)take((size_t)NT * 256 * 4); w.o2 = (float*)take((size_t)NT * D * 4); w.h = (float*)take((size_t)NT * D * 4);
  w.x1 = (float*)take((size_t)NT * D * 4); w.x2 = (float*)take((size_t)NT * D * 4);
  w.tok_e = (int*)take(NT * 4 * 4); w.tok_g = (float*)take(NT * 4 * 4); w.slot_of = (int*)take(NT * 4 * 4);
  w.row_tok = (int*)take(PMAX * 4); w.row_gate = (float*)take(PMAX * 4); w.blk_e = (int*)take(512 * 4);
  w.hb = (float*)take((size_t)PMAX * D * 4); w.ys = (float*)take((size_t)PMAX * D * 4);
  char* q = (char*)w.sc; auto take2 = [&](size_t bytes) { char* r = q; q += (bytes + 255) & ~(size_t)255; return r; };
  w.projB = (float*)take2((size_t)NT * DINB * 4); w.adec = (float*)take2((size_t)NT * 512 * 4); w.og = (float*)take2((size_t)NT * D * 4); w.on = (float*)take2((size_t)NT * D * 4);
  return w;
}
constexpr size_t WS_NEEDED = 2 * MiB + ((size_t)NT * DINA * 4 + (size_t)NT * 256 * 4 + (size_t)NB * L * L * 4 + (size_t)NT * 256 * 4 + 4 * (size_t)NT * D * 4 + 3 * NT * 16 + 2 * PMAX * 4 + 2048 + 2 * (size_t)PMAX * D * 4) + 64 * 256;

__global__ void __launch_bounds__(NTHR, 2) mk_fwd(Args args) {
  extern __shared__ __attribute__((aligned(16))) unsigned char lds[];
  const In& I = args.in;
  volatile LAS unsigned* MISC = (volatile LAS unsigned*)((LAS unsigned char*)lds + MISC_OFF);
  if (threadIdx.x < 32) MISC[threadIdx.x] = 0u;
  __syncthreads();
  XcdBarrier bar = xcd_barrier_post((unsigned*)(args.ws + WS_CTL) + CW_BAR, MISC + 8);
#define GRID_BAR() xcd_barrier(bar)
#define PH_BEGIN { unsigned char* wsb_ = args.ws; asm volatile("" : "+s"(wsb_)); const nvp::Ws w = carve_ws(wsb_); (void)w;
#define PH_END }
  float* fl = (float*)lds;
  PH_BEGIN nvp::np_sgemm<0>(nvp::mkg(I.x, D, nullptr, I.a_w_in, DINA, w.projA, DINA, NT, DINA, D, nullptr, nullptr, 0, nullptr, 0), fl); PH_END
  GRID_BAR();
  PH_BEGIN nvp::np_cnorm(w.projA, I.a_kv_norm, w.cn); PH_END
  PH_BEGIN nvp::np_iscore(w.projA, w.sc, fl); PH_END
  GRID_BAR();
  PH_BEGIN nvp::np_topk(w.sc, w.idx, (char*)lds); PH_END
  GRID_BAR();
  PH_BEGIN nvp::np_dsa_attn(w.projA, w.cn, w.idx, I.a_w_uk, I.a_w_uv, w.o2, fl); PH_END
  GRID_BAR();
  PH_BEGIN nvp::np_sgemm<0>(nvp::mkg(w.o2, D, nullptr, I.a_w_out, D, w.h, D, NT, D, D, nullptr, nullptr, 0, nullptr, 0), fl); PH_END
  GRID_BAR();
  for (int li = 0; li < 2; ++li) {
    if (li == 1) {
      PH_BEGIN nvp::np_sgemm<0>(nvp::mkg(w.x2, D, nullptr, I.b_w_in, DINB, w.projB, DINB, NT, DINB, D, nullptr, nullptr, 0, nullptr, 0), fl); PH_END
      GRID_BAR();
      PH_BEGIN nvp::np_gla_gate(w.projB, I.b_w_g2, I.b_g_bias, w.adec); PH_END
      GRID_BAR();
      PH_BEGIN nvp::np_gla_scan(w.projB, w.adec, w.og, fl); PH_END
      GRID_BAR();
      PH_BEGIN nvp::np_gla_norm(w.og, w.projB, I.b_norm, w.on); PH_END
      GRID_BAR();
      PH_BEGIN nvp::np_sgemm<0>(nvp::mkg(w.on, D, nullptr, I.b_w_out, D, w.h, D, NT, D, D, nullptr, nullptr, 0, nullptr, 0), fl); PH_END
      GRID_BAR();
    }
    PH_BEGIN nvp::np_ln_res(li == 0 ? I.x : w.x2, w.h, I.ln1_g + li * D, I.ln1_b + li * D, w.x1); PH_END
    GRID_BAR();
    PH_BEGIN nvp::np_router(w.x1, I.m_w_router + (size_t)li * D * 32, I.m_b_router + li * 32, w.tok_e, w.tok_g, w.counts, w.row_tok, (char*)lds); PH_END
    GRID_BAR();
    PH_BEGIN nvp::np_moe_sort(w.tok_e, w.tok_g, w.counts, w.row_tok, w.row_gate, w.slot_of, w.blk_e, w.counts + 32, (char*)lds); PH_END
    GRID_BAR();
    PH_BEGIN nvp::np_sgemm<1>(nvp::mkg(w.x1, D, w.row_tok, I.m_w1 + (size_t)li * 32 * D * 2048, 2048, w.hb, D, PMAX, 1024, D, w.blk_e, w.counts + 32, (size_t)D * 2048, I.m_b1 + (size_t)li * 32 * 2048, 2048), fl); PH_END
    GRID_BAR();
    PH_BEGIN nvp::np_sgemm<2>(nvp::mkg(w.hb, D, nullptr, I.m_w2 + (size_t)li * 32 * D * D, D, w.ys, D, PMAX, D, D, w.blk_e, w.counts + 32, (size_t)D * D, I.m_b2 + (size_t)li * 32 * D, (size_t)D), fl); PH_END
    GRID_BAR();
    PH_BEGIN nvp::np_moe_combine_ln(w.x1, w.ys, w.slot_of, w.tok_g, I.ln2_g + li * D, I.ln2_b + li * D, li == 0 ? w.x2 : args.out); PH_END
    if (li == 0) { PH_BEGIN if (blockIdx.x == 0 && threadIdx.x < 64) w.counts[threadIdx.x] = 0; PH_END GRID_BAR(); }
  }
}

extern "C" void kernel_launch(void* const* d_in, const int* in_sizes, int n_in, void* d_out, int out_size, void* d_ws, size_t ws_size, hipStream_t stream) {
  static int grid = 0;
  if (grid == 0) {
    if (n_in != 21 || ws_size < WS_NEEDED) { fprintf(stderr, "kernel_launch: bad inputs (n_in %d) or workspace too small (%zu needed, %zu given)\n", n_in, (size_t)WS_NEEDED, ws_size); grid = -1; return; }
    int dev = 0, cus = 0, per_cu = 0;
    if (hipGetDevice(&dev) != hipSuccess || hipDeviceGetAttribute(&cus, hipDeviceAttributeMultiprocessorCount, dev) != hipSuccess) { grid = -1; return; }
    if (hipFuncSetAttribute((const void*)mk_fwd, hipFuncAttributeMaxDynamicSharedMemorySize, LDS_BYTES) != hipSuccess) { fprintf(stderr, "kernel_launch: hipFuncSetAttribute failed\n"); grid = -1; return; }
    if (hipOccupancyMaxActiveBlocksPerMultiprocessor(&per_cu, (const void*)mk_fwd, NTHR, LDS_BYTES) != hipSuccess || per_cu < 1) fprintf(stderr, "kernel_launch: note: occupancy query reports %d\n", per_cu);
    (void)hipGetLastError();
    grid = cus;
  }
  if (grid < 0) return;
  if (hipMemsetAsync((char*)d_ws + WS_CTL, 0, CTL_ZERO_BYTES, stream) != hipSuccess) { fprintf(stderr, "kernel_launch: memset failed\n"); return; }
  Args a; memset(&a, 0, sizeof(a));
  const float** f = (const float**)&a.in;
  for (int i = 0; i < 21; ++i) f[i] = (const float*)d_in[i];
  a.out = (float*)d_out; a.ws = (unsigned char*)d_ws;
  hipLaunchKernelGGL(mk_fwd, dim3(grid), dim3(NTHR), LDS_BYTES, stream, a);
  const hipError_t le = hipPeekAtLastError();
  if (le != hipSuccess) fprintf(stderr, "kernel_launch: launch failed: %s\n", hipGetErrorName(le));
}
```

```cpp
#include <hip/hip_runtime.h>
#include <cstdio>
#include <cstdint>
#include <cstring>

#define GAS __attribute__((address_space(1)))
#define LAS __attribute__((address_space(3)))
#define NTHR 512
constexpr int LDS_BYTES = 147456;
constexpr int MISC_OFF = 131072 + 8192;

#define XB_TMO      128
#define XB_XCNT(j)  (256  + 64 * (j))
#define XB_XSUB(j)  (1280 + 64 * (j))
#define XB_XGEN(j)  (2304 + 64 * (j))
#define XB_TOP      3328
#define XB_TOPGEN   3392
#define XCD_BAR_WORDS 3456
#define XB_SPIN_CAP (1u << 25)
__device__ __forceinline__ unsigned xb_ld(unsigned* p)              { return __hip_atomic_load(p, __ATOMIC_RELAXED, __HIP_MEMORY_SCOPE_AGENT); }
__device__ __forceinline__ unsigned xb_add(unsigned* p, unsigned v) { return __hip_atomic_fetch_add(p, v, __ATOMIC_RELAXED, __HIP_MEMORY_SCOPE_AGENT); }
__device__ __forceinline__ unsigned xb_xcc_id() { return (unsigned)__builtin_amdgcn_s_getreg((3 << 11) | 20) & 0xFu; }
#define XB_SPIN(cond, bar) do { unsigned _sp = 0; while (cond) { __builtin_amdgcn_s_sleep(1); \
    if ((++_sp & 255u) == 0u) { if (xb_ld(&(bar)[XB_TMO])) break; if (_sp > XB_SPIN_CAP) { atomicAdd(&(bar)[XB_TMO], 1u); break; } } } } while (0)
struct XcdBarrier { unsigned* bar; unsigned x; volatile LAS unsigned* st; };
__device__ __forceinline__ XcdBarrier xcd_barrier_post(unsigned* bar, volatile LAS unsigned* st) {
    XcdBarrier b; b.bar = bar; b.x = xb_xcc_id(); b.st = st;
    if (threadIdx.x == 0) (void)xb_add(&bar[XB_XCNT(b.x)], 1u);
    return b;
}
__device__ __forceinline__ void xcd_barrier_complete(unsigned* bar, unsigned x, unsigned& nloc, unsigned& nx) {
    const unsigned G = gridDim.x * gridDim.y * gridDim.z;
    unsigned sum, cnt, mine, sp = 0u;
    for (;;) {
        sum = 0u; cnt = 0u; mine = 0u;
#pragma unroll
        for (unsigned j = 0; j < 16; ++j) { const unsigned c = xb_ld(&bar[XB_XCNT(j)]); sum += c; cnt += (c > 0u) ? 1u : 0u; mine = (j == x) ? c : mine; }
        if (sum == G) break;
        __builtin_amdgcn_s_sleep(1);
        if ((++sp & 255u) == 0u) { if (xb_ld(&bar[XB_TMO])) break; if (sp > XB_SPIN_CAP) { atomicAdd(&bar[XB_TMO], 1u); break; } }
    }
    nloc = mine > 0u ? mine : 1u; nx = cnt > 0u ? cnt : 1u;
}
__device__ __forceinline__ void xcd_barrier(const XcdBarrier& b) {
    asm volatile("s_waitcnt vmcnt(0)" ::: "memory");
    __syncthreads();
    if (threadIdx.x == 0) {
        unsigned* bar = b.bar;
        __builtin_amdgcn_s_waitcnt(0);
        unsigned nloc = b.st[0], nx = b.st[1];
        if (nloc == 0u) { xcd_barrier_complete(bar, b.x, nloc, nx); b.st[0] = nloc; b.st[1] = nx; }
        const unsigned old = xb_add(&bar[XB_XSUB(b.x)], 1u);
        const unsigned gen = old / nloc;
        if (old + 1u == (gen + 1u) * nloc) {
            __builtin_amdgcn_fence(__ATOMIC_RELEASE, "agent");
            asm volatile("s_waitcnt vmcnt(0)" ::: "memory");
            const unsigned og = xb_add(&bar[XB_TOP], 1u);
            const unsigned tg = og / nx;
            if (og + 1u == (tg + 1u) * nx) xb_add(&bar[XB_TOPGEN], 1u);
            else XB_SPIN(xb_ld(&bar[XB_TOPGEN]) == tg, bar);
            __builtin_amdgcn_fence(__ATOMIC_ACQUIRE, "agent");
            xb_add(&bar[XB_XGEN(b.x)], 1u);
            asm volatile("s_waitcnt vmcnt(0)" ::: "memory");
        } else {
            XB_SPIN(xb_ld(&bar[XB_XGEN(b.x)]) == gen, bar);
            __builtin_amdgcn_fence(__ATOMIC_ACQUIRE, "agent");
            asm volatile("s_waitcnt vmcnt(0)" ::: "memory");
        }
    }
    __syncthreads();
}

constexpr int NT = 16384, D = 1024, L = 8192, NB = 2;
constexpr int DINA = 1864, DINB = 3088;
constexpr int PMAX = 73728;
constexpr float ALPHA = 1.4142135623730951f;

struct In { const float *x, *a_w_in, *a_kv_norm, *a_w_uk, *a_w_uv, *a_w_out, *b_w_in, *b_w_g2, *b_g_bias, *b_norm, *b_w_out, *m_w_router, *m_b_router, *m_w1, *m_b1, *m_w2, *m_b2, *ln1_g, *ln1_b, *ln2_g, *ln2_b; };

__device__ __forceinline__ int TIDX() { int t = threadIdx.x; asm volatile("" : "+v"(t)); return t; }
__device__ __forceinline__ int BIDX() { int t = blockIdx.x; asm volatile("" : "+s"(t)); return t; }
__device__ __forceinline__ float wave_sum(float v) {
#pragma unroll
    for (int o = 1; o < 64; o <<= 1) v += __shfl_xor(v, o);
    return v;
}
namespace nvp {
#define WSYNC() asm volatile("s_waitcnt lgkmcnt(0)" ::: "memory")
struct GemmP {
  const float* A; int lda; const int* arow;
  const float* B; int ldb; float* C; int ldc; int M, N, K;
  const int* blk_e; const int* nblk_used; size_t bstride; const float* bias; size_t bias_stride;
};
__device__ __forceinline__ GemmP mkg(const float* A, int lda, const int* arow, const float* B, int ldb, float* C, int ldc, int M, int N, int K, const int* blk_e, const int* nblk_used, size_t bstride, const float* bias, size_t bias_stride) {
  GemmP p; p.A = A; p.lda = lda; p.arow = arow; p.B = B; p.ldb = ldb; p.C = C; p.ldc = ldc; p.M = M; p.N = N; p.K = K; p.blk_e = blk_e; p.nblk_used = nblk_used; p.bstride = bstride; p.bias = bias; p.bias_stride = bias_stride; return p; }

template <int MODE>
__device__ __forceinline__ void np_sgemm(const GemmP p, float* lds) {
  float (*As)[132] = (float (*)[132])lds;
  float (*Bs)[68] = (float (*)[68])(lds + 16 * 132);
  float (*Bu)[68] = (float (*)[68])(lds + 16 * 132 + 16 * 68);
  const int tid = TIDX(), tx = tid & 15, ty = tid >> 4;
  const int ntn = (p.N + 63) / 64, ntm = p.M / 128;
  const int ar = tid >> 2, ak = (tid & 3) * 4;
  const int bk = (tid & 255) >> 4, bn4 = (tid & 15) * 4;
  for (int t = BIDX(); t < ntm * ntn; t += gridDim.x) {
    const int bm = t / ntn, bn = t % ntn;
    const float* B = p.B; const float* bias = p.bias;
    if (MODE != 0) { const int blk = (bm * 128) / 256; if (blk >= *p.nblk_used) continue; const int e = p.blk_e[blk]; B += (size_t)e * p.bstride; bias += (size_t)e * p.bias_stride; }
    const int m0 = bm * 128, n0 = bn * 64;
    const int arow = p.arow ? p.arow[m0 + ar] : (m0 + ar);
    const float* Ap = p.A + (size_t)arow * p.lda + ak;
    const bool bok = (n0 + bn4) < p.N;
    float acc[4][4] = {}, accu[4][4] = {};
    for (int k0 = 0; k0 < p.K; k0 += 16) {
      const float4 av = *(const float4*)(Ap + k0);
      As[ak + 0][ar] = av.x; As[ak + 1][ar] = av.y; As[ak + 2][ar] = av.z; As[ak + 3][ar] = av.w;
      if (tid < 256) { float4 bv = make_float4(0.f, 0.f, 0.f, 0.f); if (bok) bv = *(const float4*)(B + (size_t)(k0 + bk) * p.ldb + n0 + bn4); *(float4*)&Bs[bk][bn4] = bv; }
      else if (MODE == 1) { const float4 uv = *(const float4*)(B + (size_t)(k0 + bk) * p.ldb + 1024 + n0 + bn4); *(float4*)&Bu[bk][bn4] = uv; }
      __syncthreads();
#pragma unroll
      for (int kk = 0; kk < 16; ++kk) {
        const float4 a = *(const float4*)&As[kk][ty * 4];
        const float4 b = *(const float4*)&Bs[kk][tx * 4];
        const float aa[4] = {a.x, a.y, a.z, a.w}, bb[4] = {b.x, b.y, b.z, b.w};
#pragma unroll
        for (int i = 0; i < 4; ++i)
#pragma unroll
          for (int j = 0; j < 4; ++j) acc[i][j] = fmaf(aa[i], bb[j], acc[i][j]);
        if (MODE == 1) {
          const float4 u = *(const float4*)&Bu[kk][tx * 4]; const float uu[4] = {u.x, u.y, u.z, u.w};
#pragma unroll
          for (int i = 0; i < 4; ++i)
#pragma unroll
            for (int j = 0; j < 4; ++j) accu[i][j] = fmaf(aa[i], uu[j], accu[i][j]);
        }
      }
      __syncthreads();
    }
#pragma unroll
    for (int i = 0; i < 4; ++i) {
      const int m = m0 + ty * 4 + i;
#pragma unroll
      for (int j = 0; j < 4; ++j) {
        const int n = n0 + tx * 4 + j; if (n >= p.N) continue;
        float v = acc[i][j];
        if (MODE == 1) {
          float g = v + bias[n], u = accu[i][j] + bias[1024 + n];
          g = fminf(g, 7.f); u = fminf(fmaxf(u, -7.f), 7.f);
          const float glu = g / (1.f + expf(-1.702f * g));
          v = (u + 1.f) * glu;
        } else if (MODE == 2) v += bias[n];
        p.C[(size_t)m * p.ldc + n] = v;
      }
    }
  }
}

#define GW_INIT const int lane = TIDX() & 63, wave = TIDX() >> 6, gw = BIDX() * 8 + wave, NGW = gridDim.x * 8; (void)lane; (void)wave; (void)gw; (void)NGW

__device__ __forceinline__ void np_cnorm(const float* projA, const float* g, float* cn) {
  GW_INIT;
  for (int row = gw; row < NT; row += NGW) {
    const float4 v = *(const float4*)(projA + (size_t)row * DINA + 1024 + lane * 4);
    const float ss = wave_sum(v.x * v.x + v.y * v.y + v.z * v.z + v.w * v.w);
    const float r = rsqrtf(ss * (1.f / 256.f) + 1e-6f); const float4 g4 = *(const float4*)(g + lane * 4);
    *(float4*)(cn + (size_t)row * 256 + lane * 4) = make_float4(v.x * r * g4.x, v.y * r * g4.y, v.z * r * g4.z, v.w * r * g4.w);
  }
}

__device__ __forceinline__ void np_iscore(const float* projA, float* sc, float* lds) {
  float (*As)[132] = (float (*)[132])lds;
  float (*Bs)[68] = (float (*)[68])(lds + 16 * 132);
  const int tid = TIDX(), tx = tid & 15, ty = tid >> 4;
  const int ar = tid >> 2, ak = (tid & 3) * 4;
  const int br = (tid & 255) >> 2;
  for (int u = BIDX(); u < NB * 64 * 128; u += gridDim.x) {
    const int b = u / (64 * 128), tt = (u / 128) % 64, st = u % 128;
    if (st > 2 * tt + 1) continue;
    const int t0 = tt * 128, s0 = st * 64;
    const float* Qp = projA + (size_t)(b * L + t0 + ar) * DINA + 1280 + ak;
    const float* Kp = projA + (size_t)(b * L + s0 + br) * DINA + 1792 + ak;
    float score[4][4] = {};
    for (int h = 0; h < 8; ++h) {
      float acc[4][4] = {};
      for (int k0 = 0; k0 < 64; k0 += 16) {
        const float4 av = *(const float4*)(Qp + h * 64 + k0);
        As[ak + 0][ar] = av.x; As[ak + 1][ar] = av.y; As[ak + 2][ar] = av.z; As[ak + 3][ar] = av.w;
        if (tid < 256) { const float4 bv = *(const float4*)(Kp + k0); Bs[ak + 0][br] = bv.x; Bs[ak + 1][br] = bv.y; Bs[ak + 2][br] = bv.z; Bs[ak + 3][br] = bv.w; }
        __syncthreads();
#pragma unroll
        for (int kk = 0; kk < 16; ++kk) {
          const float4 a = *(const float4*)&As[kk][ty * 4]; const float4 bq = *(const float4*)&Bs[kk][tx * 4];
          const float aa[4] = {a.x, a.y, a.z, a.w}, bb[4] = {bq.x, bq.y, bq.z, bq.w};
#pragma unroll
          for (int i = 0; i < 4; ++i)
#pragma unroll
            for (int j = 0; j < 4; ++j) acc[i][j] = fmaf(aa[i], bb[j], acc[i][j]);
        }
        __syncthreads();
      }
#pragma unroll
      for (int i = 0; i < 4; ++i) {
        const float w = projA[(size_t)(b * L + t0 + ty * 4 + i) * DINA + 1856 + h] * 0.35355339059327373f;
#pragma unroll
        for (int j = 0; j < 4; ++j) score[i][j] += w * fmaxf(acc[i][j] * 0.125f, 0.f);
      }
    }
#pragma unroll
    for (int i = 0; i < 4; ++i)
#pragma unroll
      for (int j = 0; j < 4; ++j) sc[((size_t)(b * L + t0 + ty * 4 + i)) * L + s0 + tx * 4 + j] = score[i][j];
  }
}

__device__ __forceinline__ unsigned f2key(float f) { f = f + 0.0f; const unsigned u = __float_as_uint(f); return (u & 0x80000000u) ? ~u : (u | 0x80000000u); }

__device__ __forceinline__ void np_topk(const float* sc, int* idx_out, char* lds) {
  GW_INIT;
  unsigned* hist = (unsigned*)(lds + wave * 1280); unsigned* cntw = hist + 256;
  for (int row = gw; row < NT; row += NGW) {
    const int t = row % L, n = t + 1;
    const float* s = sc + (size_t)row * L; int* out = idx_out + (size_t)row * 256;
    if (n <= 256) { for (int i = lane; i < 256; i += 64) out[i] = i < n ? i : -1; continue; }
    unsigned prefix = 0, need = 256;
    for (int pass = 3; pass >= 0; --pass) {
      const int shift = pass * 8;
      for (int i = lane; i < 256; i += 64) hist[i] = 0;
      WSYNC();
      for (int i = lane; i < n; i += 64) { const unsigned k = f2key(s[i]); const bool m = (pass == 3) || ((k >> (shift + 8)) == (prefix >> (shift + 8))); if (m) atomicAdd(&hist[(k >> shift) & 255u], 1u); }
      WSYNC();
      unsigned cum = 0; int d = 255; for (; d > 0; --d) { const unsigned hv = hist[d]; if (cum + hv >= need) break; cum += hv; }
      prefix |= ((unsigned)d << shift); need -= cum;
      WSYNC();
    }
    if (lane == 0) *cntw = 0; WSYNC();
    for (int i = lane; i < n; i += 64) { if (f2key(s[i]) > prefix) { const unsigned pos = atomicAdd(cntw, 1u); out[pos] = i; } }
    WSYNC();
    if (lane == 0) { unsigned c = *cntw; unsigned nd = need; for (int i = 0; i < n && nd > 0; ++i) if (f2key(s[i]) == prefix) { out[c++] = i; --nd; } }
    WSYNC();
  }
}

__device__ __forceinline__ void np_dsa_attn(const float* projA, const float* cn, const int* idx, const float* w_uk, const float* w_uv, float* o2, float* lds) {
  const int half = TIDX() >> 8, tid = TIDX() & 255;
  float* base = lds + half * 14336;
  float* qs = base; float (*ql)[256] = (float (*)[256])(base + 1024); float (*pr)[257] = (float (*)[257])(base + 1024 + 4096);
  float (*ol)[256] = (float (*)[256])(base + 1024 + 4096 + 4112); float* red = base + 1024 + 4096 + 4112 + 4096; int* sid = (int*)(red + 16);
  for (int r0 = BIDX() * 2; r0 < NT; r0 += gridDim.x * 2) {
    const int row = r0 + half, b = row / L;
    __syncthreads();
    for (int i = tid; i < 1024; i += 256) qs[i] = projA[(size_t)row * DINA + i];
    sid[tid] = idx[(size_t)row * 256 + tid];
    __syncthreads();
    { const int c = tid;
#pragma unroll 1
      for (int h = 0; h < 16; ++h) { float a = 0.f;
#pragma unroll 8
        for (int d = 0; d < 64; ++d) a = fmaf(qs[h * 64 + d], w_uk[((size_t)h * 64 + d) * 256 + c], a); ql[h][c] = a; } }
    __syncthreads();
    { const int k = tid, key = sid[k];
      float lg[16];
      if (key >= 0) { const float* cr = cn + (size_t)(b * L + key) * 256;
        for (int h = 0; h < 16; ++h) lg[h] = 0.f;
#pragma unroll 2
        for (int c = 0; c < 256; ++c) { const float cv = cr[c];
#pragma unroll
          for (int h = 0; h < 16; ++h) lg[h] = fmaf(ql[h][c], cv, lg[h]); }
#pragma unroll
        for (int h = 0; h < 16; ++h) pr[h][k] = lg[h] * 0.125f;
      } else {
#pragma unroll
        for (int h = 0; h < 16; ++h) pr[h][k] = -INFINITY; } }
    __syncthreads();
    if (tid < 16) { const int h = tid; float m = -INFINITY; for (int k = 0; k < 256; ++k) m = fmaxf(m, pr[h][k]); float su = 0.f; for (int k = 0; k < 256; ++k) { const float e = expf(pr[h][k] - m); pr[h][k] = e; su += e; } red[h] = 1.f / su; }
    __syncthreads();
    { const int c = tid; float a[16];
#pragma unroll
      for (int h = 0; h < 16; ++h) a[h] = 0.f;
#pragma unroll 2
      for (int k = 0; k < 256; ++k) { const int key = sid[k]; if (key < 0) continue; const float cv = cn[(size_t)(b * L + key) * 256 + c];
#pragma unroll
        for (int h = 0; h < 16; ++h) a[h] = fmaf(pr[h][k], cv, a[h]); }
#pragma unroll
      for (int h = 0; h < 16; ++h) ol[h][c] = a[h] * red[h]; }
    __syncthreads();
#pragma unroll 1
    for (int o = tid; o < 1024; o += 256) { const int h = o >> 6, v = o & 63; float a = 0.f;
#pragma unroll 8
      for (int c = 0; c < 256; ++c) a = fmaf(ol[h][c], w_uv[((size_t)h * 256 + c) * 64 + v], a); o2[(size_t)row * 1024 + o] = a; }
  }
  __syncthreads();
}

__device__ __forceinline__ void np_ln_res(const float* x, const float* h, const float* g, const float* bb, float* out) {
  GW_INIT;
  for (int row = gw; row < NT; row += NGW) {
    float4 v[4]; float s = 0.f;
#pragma unroll
    for (int j = 0; j < 4; ++j) { const float4 a = *(const float4*)(x + (size_t)row * D + lane * 4 + 256 * j), hh = *(const float4*)(h + (size_t)row * D + lane * 4 + 256 * j);
      v[j] = make_float4(ALPHA * a.x + hh.x, ALPHA * a.y + hh.y, ALPHA * a.z + hh.z, ALPHA * a.w + hh.w); s += (v[j].x + v[j].y) + (v[j].z + v[j].w); }
    const float mu = wave_sum(s) * (1.f / D); float q = 0.f;
#pragma unroll
    for (int j = 0; j < 4; ++j) { v[j].x -= mu; v[j].y -= mu; v[j].z -= mu; v[j].w -= mu; q += (v[j].x * v[j].x + v[j].y * v[j].y) + (v[j].z * v[j].z + v[j].w * v[j].w); }
    const float r = rsqrtf(wave_sum(q) * (1.f / D) + 1e-5f);
#pragma unroll
    for (int j = 0; j < 4; ++j) { const int c = lane * 4 + 256 * j; const float4 g4 = *(const float4*)(g + c), b4 = *(const float4*)(bb + c);
      *(float4*)(out + (size_t)row * D + c) = make_float4(v[j].x * r * g4.x + b4.x, v[j].y * r * g4.y + b4.y, v[j].z * r * g4.z + b4.z, v[j].w * r * g4.w + b4.w); }
  }
}

__device__ __forceinline__ void np_router(const float* x, const float* wr, const float* br, int* tok_e, float* tok_g, int* counts, int* row_tok, char* lds) {
  GW_INIT;
  for (int i = BIDX() * NTHR + TIDX(); i < PMAX; i += gridDim.x * NTHR) row_tok[i] = 0;
  float* lg = (float*)(lds + wave * 256);
  const int e = lane & 31, hf = lane >> 5;
  for (int tok = gw; tok < NT; tok += NGW) {
    const float* xr = x + (size_t)tok * D + hf * 512; const float* wp = wr + (size_t)hf * 512 * 32 + e; float a = 0.f;
#pragma unroll 8
    for (int d = 0; d < 512; ++d) a = fmaf(xr[d], wp[d * 32], a);
    a += __shfl_xor(a, 32);
    if (hf == 0) lg[e] = a + br[e];
    WSYNC();
    if (lane == 0) { int ei[4]; float ev[4];
      for (int k = 0; k < 4; ++k) { int bi = 0; float bv = -INFINITY; for (int j = 0; j < 32; ++j) if (lg[j] > bv) { bv = lg[j]; bi = j; } ei[k] = bi; ev[k] = bv; lg[bi] = -INFINITY; }
      float su = 0.f, ex[4]; for (int k = 0; k < 4; ++k) { ex[k] = expf(ev[k] - ev[0]); su += ex[k]; }
      for (int k = 0; k < 4; ++k) { tok_e[tok * 4 + k] = ei[k]; tok_g[tok * 4 + k] = ex[k] / su; atomicAdd(&counts[ei[k]], 1); } }
    WSYNC();
  }
}
__device__ __forceinline__ void np_moe_sort(const int* tok_e, const float* tok_g, const int* counts, int* row_tok, float* row_gate, int* slot_of, int* blk_e, int* nblk_used, char* lds) {
  if (BIDX() != 0) return;
  const int e = TIDX(); int* pstart = (int*)lds; int* stage = pstart + 64;
  if (e == 0) { int acc = 0; for (int j = 0; j < 32; ++j) { pstart[j] = acc; const int nb = (counts[j] + 255) / 256; for (int q = 0; q < nb; ++q) blk_e[acc / 256 + q] = j; acc += nb * 256; } pstart[32] = acc; *nblk_used = acc / 256; }
  __syncthreads();
  int pos = e < 32 ? pstart[e] : 0;
  for (int c0 = 0; c0 < NT * 4; c0 += 2048) {
    __syncthreads();
    for (int i = e; i < 2048; i += NTHR) stage[i] = tok_e[c0 + i];
    __syncthreads();
    if (e < 32) for (int i = 0; i < 2048; ++i) if (stage[i] == e) { const int gi = c0 + i; row_tok[pos] = gi >> 2; row_gate[pos] = tok_g[gi]; slot_of[gi] = pos; ++pos; }
  }
  __syncthreads();
}
__device__ __forceinline__ void np_moe_combine_ln(const float* x1, const float* ys, const int* slot_of, const float* tok_g, const float* g, const float* bb, float* out) {
  GW_INIT;
  for (int row = gw; row < NT; row += NGW) {
    float4 v[4]; float s = 0.f; int sl[4]; float gg[4];
#pragma unroll
    for (int k = 0; k < 4; ++k) { sl[k] = slot_of[row * 4 + k]; gg[k] = tok_g[row * 4 + k]; }
#pragma unroll
    for (int j = 0; j < 4; ++j) { const int c = lane * 4 + 256 * j; float4 f = make_float4(0.f, 0.f, 0.f, 0.f);
#pragma unroll
      for (int k = 0; k < 4; ++k) { const float4 y = *(const float4*)(ys + (size_t)sl[k] * D + c); f.x += gg[k] * y.x; f.y += gg[k] * y.y; f.z += gg[k] * y.z; f.w += gg[k] * y.w; }
      const float4 a = *(const float4*)(x1 + (size_t)row * D + c);
      v[j] = make_float4(ALPHA * a.x + f.x, ALPHA * a.y + f.y, ALPHA * a.z + f.z, ALPHA * a.w + f.w); s += (v[j].x + v[j].y) + (v[j].z + v[j].w); }
    const float mu = wave_sum(s) * (1.f / D); float q = 0.f;
#pragma unroll
    for (int j = 0; j < 4; ++j) { v[j].x -= mu; v[j].y -= mu; v[j].z -= mu; v[j].w -= mu; q += (v[j].x * v[j].x + v[j].y * v[j].y) + (v[j].z * v[j].z + v[j].w * v[j].w); }
    const float r = rsqrtf(wave_sum(q) * (1.f / D) + 1e-5f);
#pragma unroll
    for (int j = 0; j < 4; ++j) { const int c = lane * 4 + 256 * j; const float4 g4 = *(const float4*)(g + c), b4 = *(const float4*)(bb + c);
      *(float4*)(out + (size_t)row * D + c) = make_float4(v[j].x * r * g4.x + b4.x, v[j].y * r * g4.y + b4.y, v[j].z * r * g4.z + b4.z, v[j].w * r * g4.w + b4.w); }
  }
}

__device__ __forceinline__ void np_gla_gate(const float* projB, const float* w_g2, const float* gb, float* adec) {
  GW_INIT;
  for (int row = gw; row < NT; row += NGW) {
    float glr[16];
#pragma unroll
    for (int j = 0; j < 16; ++j) glr[j] = projB[(size_t)row * DINB + 2048 + j];
    for (int c = lane; c < 512; c += 64) { float a = gb[c];
#pragma unroll
      for (int j = 0; j < 16; ++j) a = fmaf(glr[j], w_g2[j * 512 + c], a);
      const float ls = fminf(a, 0.f) - log1pf(expf(-fabsf(a))); adec[(size_t)row * 512 + c] = expf(ls * (1.f / 16.f)); }
  }
}
__device__ __forceinline__ void np_gla_scan(const float* projB, const float* adec, float* og, float* lds) {
  if (BIDX() >= 8) return;
  const int b = BIDX() >> 2, h = BIDX() & 3, tid = TIDX(), dv = tid & 255, dh = tid >> 8;
  float (*qs)[128] = (float (*)[128])lds; float (*ks)[128] = (float (*)[128])(lds + 2048); float (*as)[128] = (float (*)[128])(lds + 4096);
  float (*po)[16][256] = (float (*)[16][256])(lds + 6144);
  float S[64];
#pragma unroll
  for (int d = 0; d < 64; ++d) S[d] = 0.f;
  for (int t0 = 0; t0 < L; t0 += 16) {
    __syncthreads();
    for (int i = tid; i < 16 * 128; i += NTHR) { const int tt = i >> 7, d = i & 127; const size_t r = (size_t)(b * L + t0 + tt);
      qs[tt][d] = projB[r * DINB + h * 128 + d] * 0.08838834764831845f; ks[tt][d] = projB[r * DINB + 512 + h * 128 + d]; as[tt][d] = adec[r * 512 + h * 128 + d]; }
    __syncthreads();
#pragma unroll 1
    for (int tt = 0; tt < 16; ++tt) { const size_t r = (size_t)(b * L + t0 + tt); const float v = projB[r * DINB + 1024 + h * 256 + dv]; float o = 0.f;
#pragma unroll
      for (int d = 0; d < 64; ++d) { S[d] = fmaf(as[tt][dh * 64 + d], S[d], ks[tt][dh * 64 + d] * v); o = fmaf(qs[tt][dh * 64 + d], S[d], o); }
      po[dh][tt][dv] = o; }
    __syncthreads();
    for (int i = tid; i < 16 * 256; i += NTHR) { const int tt = i >> 8, c = i & 255; og[(size_t)(b * L + t0 + tt) * 1024 + h * 256 + c] = po[0][tt][c] + po[1][tt][c]; }
  }
  __syncthreads();
}
__device__ __forceinline__ void np_gla_norm(const float* og, const float* projB, const float* ng, float* on) {
  GW_INIT;
  for (int u = gw; u < NT * 4; u += NGW) {
    const int row = u >> 2, h = u & 3; const int c = h * 256 + lane * 4;
    const float4 v = *(const float4*)(og + (size_t)row * 1024 + c);
    const float r = rsqrtf(wave_sum(v.x * v.x + v.y * v.y + v.z * v.z + v.w * v.w) * (1.f / 256.f) + 1e-6f);
    const float4 rr = *(const float4*)(projB + (size_t)row * DINB + 2064 + c), g4 = *(const float4*)(ng + c);
    *(float4*)(on + (size_t)row * 1024 + c) = make_float4(v.x * r * g4.x * (rr.x / (1.f + expf(-rr.x))), v.y * r * g4.y * (rr.y / (1.f + expf(-rr.y))), v.z * r * g4.z * (rr.z / (1.f + expf(-rr.z))), v.w * r * g4.w * (rr.w / (1.f + expf(-rr.w))));
  }
}

struct Ws { float *projA, *cn, *sc, *o2, *h, *x1, *x2, *hb, *ys, *projB, *adec, *og, *on, *tok_g, *row_gate; int *idx, *tok_e, *slot_of, *row_tok, *blk_e, *counts; };
}
typedef unsigned short bf16_t;
typedef unsigned v4u __attribute__((ext_vector_type(4)));
typedef unsigned v2u __attribute__((ext_vector_type(2)));
typedef float f32x4 __attribute__((ext_vector_type(4)));
typedef short bf16x8 __attribute__((ext_vector_type(8)));
__device__ __forceinline__ unsigned cvt_pk_bf16(float lo, float hi) { unsigned r; asm volatile("v_cvt_pk_bf16_f32 %0, %1, %2" : "=v"(r) : "v"(lo), "v"(hi)); return r; }
__device__ __forceinline__ float bf_lo(unsigned u) { return __uint_as_float(u << 16); }
__device__ __forceinline__ float bf_hi(unsigned u) { return __uint_as_float(u & 0xffff0000u); }
__device__ __forceinline__ float bf2f(bf16_t h) { return __uint_as_float(((unsigned)h) << 16); }

struct TJob { const float* src; int lds_; int K, N; bf16_t* dst; int ldd; int drow0, dcol0; int rowmap; int ntk, ntn; };
__device__ __forceinline__ TJob mk_tjob(const float* src, int lds_, int K, int N, bf16_t* dst, int ldd, int drow0, int dcol0, int rowmap) {
  TJob j; j.src = src; j.lds_ = lds_; j.K = K; j.N = N; j.dst = dst; j.ldd = ldd; j.drow0 = drow0; j.dcol0 = dcol0; j.rowmap = rowmap; j.ntk = K / 64; j.ntn = (N + 127) / 128; return j; }
__device__ __forceinline__ int tjob_tiles(const TJob& j) { return j.ntk * j.ntn; }
__device__ __forceinline__ void transpose_tile(const TJob& j, int tile, int lane) {
  const int kt = tile / j.ntn, nt_ = tile % j.ntn, k0 = kt * 64, n0 = nt_ * 128;
  const int q = lane & 31, par = lane >> 5;
  const bool ok = (n0 + 4 * q) < j.N;
  f32x4 v[32];
  const float* sp = j.src + (size_t)(k0 + par) * j.lds_ + n0 + 4 * q;
#pragma unroll
  for (int i = 0; i < 32; ++i) v[i] = ok ? *(const f32x4*)(sp + (size_t)(2 * i) * j.lds_) : (f32x4){0.f, 0.f, 0.f, 0.f};
  unsigned ra[32], rb[32];
#pragma unroll
  for (int i = 0; i < 32; ++i) {
    auto s0 = __builtin_amdgcn_permlane32_swap(__float_as_uint(v[i][0]), __float_as_uint(v[i][2]), false, false);
    auto s1 = __builtin_amdgcn_permlane32_swap(__float_as_uint(v[i][1]), __float_as_uint(v[i][3]), false, false);
    ra[i] = cvt_pk_bf16(__uint_as_float(s0[0]), __uint_as_float(s0[1]));
    rb[i] = cvt_pk_bf16(__uint_as_float(s1[0]), __uint_as_float(s1[1]));
  }
  if (ok) {
    const int n = n0 + 4 * q + 2 * par;
    int r0 = n, r1 = n + 1;
    if (j.rowmap == 1) { const int jj0 = r0 & 1023, jj1 = r1 & 1023; r0 = 256 * (jj0 >> 7) + ((r0 >> 10) << 7) + (jj0 & 127); r1 = 256 * (jj1 >> 7) + ((r1 >> 10) << 7) + (jj1 & 127); }
    bf16_t* d0 = j.dst + (size_t)(j.drow0 + r0) * j.ldd + j.dcol0 + k0;
    bf16_t* d1 = j.dst + (size_t)(j.drow0 + r1) * j.ldd + j.dcol0 + k0;
#pragma unroll
    for (int c = 0; c < 8; ++c) { *(v4u*)(d0 + 8 * c) = (v4u){ra[4 * c], ra[4 * c + 1], ra[4 * c + 2], ra[4 * c + 3]}; *(v4u*)(d1 + 8 * c) = (v4u){rb[4 * c], rb[4 * c + 1], rb[4 * c + 2], rb[4 * c + 3]}; }
  }
}
__device__ __forceinline__ void transpose_job(const TJob j, int& w0, int gw, int NGW, int lane) {
  const int nt_ = tjob_tiles(j);
  int first = gw - (w0 % NGW); if (first < 0) first += NGW;
#pragma unroll 1
  for (int t = first; t < nt_; t += NGW) transpose_tile(j, t, lane);
  w0 += nt_;
}
__device__ __forceinline__ void zero_rect(bf16_t* dst, int ldd, int r0, int nr, int cb0, int nbytes, int gtid, int NGT) {
  const int per = nbytes / 16;
  for (int i = gtid; i < nr * per; i += NGT) { const int r = i / per, c = i % per; *(v4u*)((char*)(dst + (size_t)(r0 + r) * ldd) + cb0 + 16 * c) = (v4u){0u, 0u, 0u, 0u}; }
}
__device__ __forceinline__ void cvt_f32_to_bf16(const float* src, int lds_, bf16_t* dst, int ldd, int rows, int ncols, int gtid, int NGT) {
  const int per = ncols / 4;
  for (size_t i = gtid; i < (size_t)rows * per; i += NGT) { const size_t r = i / per; const int c = (int)(i % per) * 4; const f32x4 v = *(const f32x4*)(src + r * lds_ + c);
    *(v2u*)(dst + r * ldd + c) = (v2u){cvt_pk_bf16(v[0], v[1]), cvt_pk_bf16(v[2], v[3])}; }
}
__device__ __forceinline__ void cvt_bf16_to_f32(const bf16_t* src, int lds_, float* dst, int ldd, int rows, int ncols, int gtid, int NGT) {
  const int per = ncols / 4;
  for (size_t i = gtid; i < (size_t)rows * per; i += NGT) { const size_t r = i / per; const int c = (int)(i % per) * 4; const v2u v = *(const v2u*)(src + r * lds_ + c);
    *(f32x4*)(dst + r * ldd + c) = (f32x4){bf_lo(v[0]), bf_hi(v[0]), bf_lo(v[1]), bf_hi(v[1])}; }
}

namespace pg8 {
#define PG8_LAS __attribute__((address_space(3)))
typedef unsigned u32x4 __attribute__((ext_vector_type(4)));
constexpr int BM = 256, BK = 64, HALF = 128, HTB = HALF * BK * 2, STAGE_BYTES = 8 * HTB, NXCD = 8, WGM = 8;
__host__ __device__ __forceinline__ int lds_byte(int r, int c) { const int st = (r >> 4) * 2 + (c >> 5), rr = r & 15, cc = c & 31, ob = rr * 64 + cc * 2; return st * 1024 + (ob ^ (((ob >> 9) & 1) << 5)); }
__host__ __device__ __forceinline__ void stage_rc(int b, int& R, int& C) { const int st = b / 1024, sb = b % 1024, swz = sb ^ (((sb >> 9) & 1) << 5); R = (st >> 1) * 16 + swz / 64; C = (st & 1) * 32 + (swz % 64) / 2; }
__host__ __device__ __forceinline__ int perm32(int rho) { const int n = rho >> 4, i = rho & 15; return 8 * (i >> 2) + 4 * n + (i & 3); }
struct Unit { const char* pa; const char* pb; int orow, ocol, e; };
struct Gemm { int lda, ldb, K; };
struct StaticOrder {
    const char* A; const char* Bt; size_t ta, tb; int nM, nN, nwg, G, c;
    __device__ void init(const void* A_, int lda, const void* Bt_, int ldb, int M, int N, int G_, int c_) { A = (const char*)A_; Bt = (const char*)Bt_; ta = (size_t)BM * lda * 2; tb = (size_t)BM * ldb * 2; nM = M / BM; nN = N / BM; nwg = nM * nN; G = G_; c = c_; }
    __device__ bool tile(int i, int& pm, int& pn) const {
        const long L = (long)i * G + c; if (L >= nwg) return false;
        int wgid = (int)L; { const int q = nwg / NXCD, r = nwg % NXCD, xcd = wgid % NXCD, off = wgid / NXCD; wgid = (xcd < r ? xcd * (q + 1) : r * (q + 1) + (xcd - r) * q) + off; }
        const int nig = WGM * nN, gid = wgid / nig, fm = gid * WGM, gsz = (nM - fm) < WGM ? (nM - fm) : WGM;
        pm = fm + ((wgid % nig) % gsz); pn = (wgid % nig) / gsz; return true;
    }
    __device__ bool next(int i, Unit& u) const { int pm, pn; if (!tile(i, pm, pn)) return false; u.pa = A + (size_t)pm * ta; u.pb = Bt + (size_t)pn * tb; u.orow = pm * BM; u.ocol = pn * BM; u.e = 0; return true; }
    __device__ __forceinline__ void a_ready(const Unit&) const {}
    __device__ __forceinline__ void done(const Unit&) const {}
};
struct EpiStore {
    static constexpr bool PERM = true, AFTER_DRAIN = false;
    bf16_t* O; int ldc;
    __device__ __forceinline__ void operator()(const f32x4 (&acc)[2][2][4][2], const Unit& u, int wr, int wc, int fr, int fq) const {
        const int row0 = u.orow + wr * 64 + fr, col0 = u.ocol + wc * 32 + 8 * fq;
#pragma unroll
        for (int ai = 0; ai < 2; ++ai)
#pragma unroll
            for (int m = 0; m < 4; ++m) { bf16_t* rowp = O + (size_t)(row0 + ai * HALF + m * 16) * ldc + col0;
#pragma unroll
                for (int bj = 0; bj < 2; ++bj) { const f32x4 v0 = acc[ai][bj][m][0], v1 = acc[ai][bj][m][1];
                    u32x4 w; w.x = cvt_pk_bf16(v0[0], v0[1]); w.y = cvt_pk_bf16(v0[2], v0[3]); w.z = cvt_pk_bf16(v1[0], v1[1]); w.w = cvt_pk_bf16(v1[2], v1[3]);
                    *(u32x4*)(rowp + bj * HALF) = w; } }
    }
};
template <class Epi, class Sched, bool ALIGN_EPI = false, bool SP2 = false>
__device__ __forceinline__ void gemm_phase(PG8_LAS unsigned char* lds, const Gemm g, const Sched& S, const Epi& E) {
    const int tid = TIDX(), wid = __builtin_amdgcn_readfirstlane(tid >> 6), lane = tid & 63, wr = wid >> 2, wc = wid & 3, fr = lane & 15, fq = lane >> 4;
    const int K = g.K, nt = K / BK;
    unsigned voffA[2], voffB[2];
#pragma unroll
    for (int i = 0; i < 2; ++i) { int R, C; stage_rc(tid * 16 + i * 8192, R, C); const int Rb = Epi::PERM ? ((R & ~31) + perm32(R & 31)) : R;
        voffA[i] = (unsigned)(R * g.lda + C) * 2u; voffB[i] = (unsigned)(Rb * g.ldb + C) * 2u; }
    const size_t kstep = (size_t)(BK * 2);
    const size_t hstepA = (size_t)HALF * g.lda * 2, hstepB = (size_t)HALF * g.ldb * 2;
    const unsigned ldsw = (unsigned)wid * 1024u;
    const int aoff = lds_byte(wr * 64 + fr, fq * 8), boff = lds_byte(wc * 32 + fr, fq * 8);
#define PG8_SA(b, h) (((b) * 2 + (h)) * HTB)
#define PG8_SB(b, h) ((4 + (b) * 2 + (h)) * HTB)
#define PG8_STAGE(bufoff, gbase, voff) do { _Pragma("unroll") for (int _i = 0; _i < 2; ++_i) \
        __builtin_amdgcn_global_load_lds((const unsigned*)((const char*)(gbase) + (voff)[_i]), (PG8_LAS unsigned*)(lds + (bufoff) + ldsw + _i * 8192), 16, 0, 0); } while (0)
#define PG8_LDA(dst, b, h) do { _Pragma("unroll") for (int m = 0; m < 4; ++m) _Pragma("unroll") for (int k = 0; k < 2; ++k) dst[m][k] = *(const PG8_LAS bf16x8*)(lds + PG8_SA(b, h) + aoff + m * 2048 + k * 1024); } while (0)
#define PG8_LDB(dst, b, h) do { _Pragma("unroll") for (int n = 0; n < 2; ++n) _Pragma("unroll") for (int k = 0; k < 2; ++k) dst[n][k] = *(const PG8_LAS bf16x8*)(lds + PG8_SB(b, h) + boff + n * 2048 + k * 1024); } while (0)
#define PG8_MMA(ai, bj, At, Bt) do { __builtin_amdgcn_s_setprio(1); _Pragma("unroll") for (int m = 0; m < 4; ++m) _Pragma("unroll") for (int n = 0; n < 2; ++n) _Pragma("unroll") for (int k = 0; k < 2; ++k) \
        acc[ai][bj][m][n] = __builtin_amdgcn_mfma_f32_16x16x32_bf16(Bt[n][k], At[m][k], acc[ai][bj][m][n], 0, 0, 0); __builtin_amdgcn_s_setprio(0); } while (0)
#define PG8_WAIT_V(n) asm volatile("s_waitcnt vmcnt(" #n ")" ::: "memory")
#define PG8_WAIT_L(n) asm volatile("s_waitcnt lgkmcnt(" #n ")" ::: "memory")
#define PG8_BAR __builtin_amdgcn_s_barrier()
#define PG8_SCHED __builtin_amdgcn_sched_barrier(0)
    Unit cur, nxt; int ui = 0;
    if (!S.next(0, cur)) return;
    f32x4 acc[2][2][4][2];
#pragma unroll
    for (int a = 0; a < 2; ++a)
#pragma unroll
        for (int b = 0; b < 2; ++b)
#pragma unroll
            for (int m = 0; m < 4; ++m)
#pragma unroll
                for (int n = 0; n < 2; ++n) acc[a][b][m][n] = (f32x4){0.f, 0.f, 0.f, 0.f};
    bf16x8 At[4][2], B0[2][2], B1[2][2];
    const char* cA = cur.pa; const char* cB = cur.pb;
    S.a_ready(cur);
    if constexpr (SP2) {
        PG8_STAGE(PG8_SB(0, 0), cB, voffB); PG8_STAGE(PG8_SB(0, 1), cB + hstepB, voffB); PG8_STAGE(PG8_SA(0, 0), cA, voffA); PG8_STAGE(PG8_SA(0, 1), cA + hstepA, voffA);
        if (wr == 1) PG8_BAR;
        PG8_WAIT_V(2); PG8_BAR;
        PG8_STAGE(PG8_SB(1, 0), cB + kstep, voffB); PG8_STAGE(PG8_SA(1, 0), cA + kstep, voffA); PG8_STAGE(PG8_SB(1, 1), cB + hstepB + kstep, voffB);
        PG8_WAIT_V(6); PG8_BAR;
    } else {
        PG8_STAGE(PG8_SB(0, 0), cB, voffB); PG8_STAGE(PG8_SA(0, 0), cA, voffA); PG8_STAGE(PG8_SB(0, 1), cB + hstepB, voffB); PG8_STAGE(PG8_SA(0, 1), cA + hstepA, voffA);
        if (wr == 1) PG8_BAR;
        PG8_WAIT_V(4); PG8_BAR;
        PG8_STAGE(PG8_SB(1, 0), cB + kstep, voffB); PG8_STAGE(PG8_SA(1, 0), cA + kstep, voffA); PG8_STAGE(PG8_SB(1, 1), cB + hstepB + kstep, voffB);
        PG8_WAIT_V(6); PG8_BAR;
    }
    for (;;) {
        const bool has_next = S.next(ui + 1, nxt);
        const char* nA = has_next ? nxt.pa : cA; const char* nB = has_next ? nxt.pb : cB;
        for (int t = 0; t < nt; t += 2) {
            const bool last = (t == nt - 2);
            const char* a1 = cA + (size_t)(t + 1) * kstep;
            const char* a2 = last ? nA : cA + (size_t)(t + 2) * kstep; const char* b2 = last ? nB : cB + (size_t)(t + 2) * kstep;
            const char* a3 = a2 + kstep; const char* b3 = b2 + kstep;
            if (last && has_next) S.a_ready(nxt);
            if constexpr (SP2) {
            PG8_LDB(B0, 0, 0); PG8_LDB(B1, 0, 1); PG8_SCHED; PG8_LDA(At, 0, 0); PG8_STAGE(PG8_SA(1, 1), a1 + hstepA, voffA);
            PG8_WAIT_V(8); PG8_WAIT_L(0); PG8_BAR; PG8_MMA(0, 0, At, B0); PG8_MMA(0, 1, At, B1); PG8_BAR; PG8_SCHED;
            PG8_LDA(At, 0, 1); PG8_STAGE(PG8_SB(0, 0), b2, voffB); PG8_STAGE(PG8_SB(0, 1), b2 + hstepB, voffB); PG8_STAGE(PG8_SA(0, 0), a2, voffA);
            PG8_WAIT_V(8); PG8_WAIT_L(0); PG8_BAR; PG8_MMA(1, 0, At, B0); PG8_MMA(1, 1, At, B1); PG8_BAR; PG8_SCHED;
            PG8_LDB(B0, 1, 0); PG8_LDB(B1, 1, 1); PG8_SCHED; PG8_LDA(At, 1, 0); PG8_STAGE(PG8_SA(0, 1), a2 + hstepA, voffA);
            PG8_WAIT_V(8); PG8_WAIT_L(0); PG8_BAR; PG8_MMA(0, 0, At, B0); PG8_MMA(0, 1, At, B1); PG8_BAR; PG8_SCHED;
            PG8_LDA(At, 1, 1); PG8_STAGE(PG8_SB(1, 0), b3, voffB); PG8_STAGE(PG8_SB(1, 1), b3 + hstepB, voffB); PG8_STAGE(PG8_SA(1, 0), a3, voffA);
            PG8_WAIT_V(8); PG8_WAIT_L(0); PG8_BAR; PG8_MMA(1, 0, At, B0); PG8_MMA(1, 1, At, B1); PG8_BAR; PG8_SCHED;
            } else {
            PG8_LDB(B0, 0, 0); PG8_SCHED; PG8_LDA(At, 0, 0); PG8_STAGE(PG8_SA(1, 1), a1 + hstepA, voffA);
            PG8_WAIT_L(8); PG8_BAR; PG8_WAIT_L(0); PG8_MMA(0, 0, At, B0); PG8_BAR; PG8_SCHED;
            PG8_LDB(B1, 0, 1); PG8_STAGE(PG8_SB(0, 0), b2, voffB);
            PG8_BAR; PG8_WAIT_L(0); PG8_MMA(0, 1, At, B1); PG8_BAR;
            PG8_LDA(At, 0, 1); PG8_STAGE(PG8_SA(0, 0), a2, voffA);
            PG8_BAR; PG8_WAIT_L(0); PG8_MMA(1, 0, At, B0); PG8_BAR; PG8_SCHED;
            PG8_STAGE(PG8_SB(0, 1), b2 + hstepB, voffB);
            PG8_WAIT_V(6); PG8_BAR; PG8_MMA(1, 1, At, B1); PG8_BAR;
            PG8_LDB(B0, 1, 0); PG8_SCHED; PG8_LDA(At, 1, 0); PG8_STAGE(PG8_SA(0, 1), a2 + hstepA, voffA);
            PG8_WAIT_L(8); PG8_BAR; PG8_WAIT_L(0); PG8_MMA(0, 0, At, B0); PG8_BAR; PG8_SCHED;
            PG8_LDB(B1, 1, 1); PG8_STAGE(PG8_SB(1, 0), b3, voffB);
            PG8_BAR; PG8_WAIT_L(0); PG8_MMA(0, 1, At, B1); PG8_BAR;
            PG8_LDA(At, 1, 1); PG8_STAGE(PG8_SA(1, 0), a3, voffA);
            PG8_BAR; PG8_WAIT_L(0); PG8_MMA(1, 0, At, B0); PG8_BAR; PG8_SCHED;
            PG8_STAGE(PG8_SB(1, 1), b3 + hstepB, voffB);
            PG8_WAIT_V(6); PG8_BAR; PG8_MMA(1, 1, At, B1); PG8_BAR;
            }
        }
        if constexpr (ALIGN_EPI) { if (wr == 0) PG8_BAR; }
        if constexpr (!Epi::AFTER_DRAIN) { E(acc, cur, wr, wc, fr, fq); S.done(cur); }
        if (!has_next) break;
#pragma unroll
        for (int a = 0; a < 2; ++a)
#pragma unroll
            for (int b = 0; b < 2; ++b)
#pragma unroll
                for (int m = 0; m < 4; ++m)
#pragma unroll
                    for (int n = 0; n < 2; ++n) acc[a][b][m][n] = (f32x4){0.f, 0.f, 0.f, 0.f};
        cur = nxt; cA = nA; cB = nB; ++ui;
        if constexpr (ALIGN_EPI) { if (wr == 1) PG8_BAR; }
    }
    PG8_WAIT_V(0);
    if constexpr (!ALIGN_EPI) { if (wr == 0) PG8_BAR; }
    PG8_BAR;
    if constexpr (Epi::AFTER_DRAIN) { E.fused(acc, cur, wr, wc, fr, fq, lds, wid, lane); S.done(cur); }
#undef PG8_SA
#undef PG8_SB
#undef PG8_STAGE
#undef PG8_LDA
#undef PG8_LDB
#undef PG8_MMA
#undef PG8_WAIT_V
#undef PG8_WAIT_L
#undef PG8_BAR
#undef PG8_SCHED
}

}
#define WSYNC2() asm volatile("s_waitcnt lgkmcnt(0)" ::: "memory")
struct MoeBufs { int* tok_e; float* tok_g; int* slot_of; float* slot_gate; int* blk_e; int* blkcnt; int* nblk; };
constexpr int WRT_LD = 1028;

__device__ __forceinline__ void ph_ln_router(const float* xin, const bf16_t* hb, const float* g, const float* bb, const float* wr, const float* br, float* x1, const MoeBufs m, float* lds) {
  const int tid = TIDX(), lane = tid & 63, wave = tid >> 6, blk = BIDX();
  float* wT = lds;
  float* lg = lds + 32 * WRT_LD + wave * 64;
  int* cnt = (int*)(lds + 32 * WRT_LD + 8 * 64);
  for (int i = tid; i < 1024 * 32; i += NTHR) { const int d = i >> 5, e = i & 31; wT[e * WRT_LD + d] = wr[i]; }
  if (tid < 32) cnt[tid] = 0;
  __syncthreads();
  for (int it = 0; it < 8; ++it) {
    const int tok = blk * 64 + wave * 8 + it; if (tok >= NT) break;
    f32x4 v[4]; float s = 0.f;
#pragma unroll
    for (int j = 0; j < 4; ++j) { const int c = lane * 4 + 256 * j; const f32x4 a = *(const f32x4*)(xin + (size_t)tok * D + c); const v2u hh = *(const v2u*)(hb + (size_t)tok * D + c);
      v[j] = (f32x4){ALPHA * a[0] + bf_lo(hh[0]), ALPHA * a[1] + bf_hi(hh[0]), ALPHA * a[2] + bf_lo(hh[1]), ALPHA * a[3] + bf_hi(hh[1])}; s += (v[j][0] + v[j][1]) + (v[j][2] + v[j][3]); }
    const float mu = wave_sum(s) * (1.f / D); float q = 0.f;
#pragma unroll
    for (int j = 0; j < 4; ++j) { v[j] = v[j] - mu; q += (v[j][0] * v[j][0] + v[j][1] * v[j][1]) + (v[j][2] * v[j][2] + v[j][3] * v[j][3]); }
    const float r = rsqrtf(wave_sum(q) * (1.f / D) + 1e-5f);
#pragma unroll
    for (int j = 0; j < 4; ++j) { const int c = lane * 4 + 256 * j; const f32x4 g4 = *(const f32x4*)(g + c), b4 = *(const f32x4*)(bb + c); v[j] = v[j] * r * g4 + b4; *(f32x4*)(x1 + (size_t)tok * D + c) = v[j]; }
    float p[32];
#pragma unroll
    for (int e = 0; e < 32; ++e) { float a = 0.f;
#pragma unroll
      for (int j = 0; j < 4; ++j) { const f32x4 w4 = *(const f32x4*)(wT + e * WRT_LD + lane * 4 + 256 * j); a = fmaf(v[j][0], w4[0], a); a = fmaf(v[j][1], w4[1], a); a = fmaf(v[j][2], w4[2], a); a = fmaf(v[j][3], w4[3], a); }
      p[e] = a; }
#pragma unroll
    for (int i = 0; i < 16; ++i) { const bool hi = (lane & 32) != 0; const float send = hi ? p[i] : p[i + 16]; const float keep = hi ? p[i + 16] : p[i]; p[i] = keep + __shfl_xor(send, 32); }
#pragma unroll
    for (int i = 0; i < 8; ++i) { const bool hi = (lane & 16) != 0; const float send = hi ? p[i] : p[i + 8]; const float keep = hi ? p[i + 8] : p[i]; p[i] = keep + __shfl_xor(send, 16); }
#pragma unroll
    for (int i = 0; i < 4; ++i) { const bool hi = (lane & 8) != 0; const float send = hi ? p[i] : p[i + 4]; const float keep = hi ? p[i + 4] : p[i]; p[i] = keep + __shfl_xor(send, 8); }
#pragma unroll
    for (int i = 0; i < 2; ++i) { const bool hi = (lane & 4) != 0; const float send = hi ? p[i] : p[i + 2]; const float keep = hi ? p[i + 2] : p[i]; p[i] = keep + __shfl_xor(send, 4); }
    { const bool hi = (lane & 2) != 0; const float send = hi ? p[0] : p[1]; const float keep = hi ? p[1] : p[0]; p[0] = keep + __shfl_xor(send, 2); }
    p[0] += __shfl_xor(p[0], 1);
    const int e_l = ((lane >> 5) & 1) * 16 + ((lane >> 4) & 1) * 8 + ((lane >> 3) & 1) * 4 + ((lane >> 2) & 1) * 2 + ((lane >> 1) & 1);
    if ((lane & 1) == 0) lg[e_l] = p[0] + br[e_l];
    WSYNC2();
    if (lane == 0) { int ei[4]; float ev[4];
#pragma unroll
      for (int k = 0; k < 4; ++k) { int bi = 0; float bv = -INFINITY; for (int j = 0; j < 32; ++j) { const float l = lg[j]; if (l > bv) { bv = l; bi = j; } } ei[k] = bi; ev[k] = bv; lg[bi] = -INFINITY; }
      float ex[4], su = 0.f;
#pragma unroll
      for (int k = 0; k < 4; ++k) { ex[k] = __expf(ev[k] - ev[0]); su += ex[k]; }
      const float inv = 1.f / su;
      *(int4*)(m.tok_e + tok * 4) = make_int4(ei[0], ei[1], ei[2], ei[3]);
      *(float4*)(m.tok_g + tok * 4) = make_float4(ex[0] * inv, ex[1] * inv, ex[2] * inv, ex[3] * inv);
#pragma unroll
      for (int k = 0; k < 4; ++k) atomicAdd(&cnt[ei[k]], 1); }
    WSYNC2();
  }
  __syncthreads();
  if (tid < 32) m.blkcnt[blk * 32 + tid] = cnt[tid];
  __syncthreads();
}

__device__ __forceinline__ void ph_moe_scatter(const float* x1, bf16_t* xs, const MoeBufs m, int* ilds) {
  const int tid = TIDX(), lane = tid & 63, wave = tid >> 6, blk = BIDX(), G = (int)gridDim.x;
  int* tot = ilds; int* bef = ilds + 32; int* pst = ilds + 64; int* es = ilds + 128; int* sl = ilds + 128 + 256;
  if (tid < 64) ilds[tid] = 0;
  __syncthreads();
  { const int bp = tid >> 1, e0 = (tid & 1) * 16;
    if (bp < G) {
#pragma unroll
      for (int q = 0; q < 4; ++q) { const int4 c = *(const int4*)(m.blkcnt + bp * 32 + e0 + 4 * q); const int cc[4] = {c.x, c.y, c.z, c.w};
#pragma unroll
        for (int z = 0; z < 4; ++z) { atomicAdd(&tot[e0 + 4 * q + z], cc[z]); if (bp < blk) atomicAdd(&bef[e0 + 4 * q + z], cc[z]); } } } }
  if (tid < 256) es[tid] = m.tok_e[blk * 256 + tid];
  __syncthreads();
  if (tid == 0) { int acc = 0; for (int e = 0; e < 32; ++e) { pst[e] = acc; acc += ((tot[e] + 255) >> 8) << 8; } pst[32] = acc;
    if (blk == 0) { *m.nblk = acc >> 8; for (int e = 0; e < 32; ++e) for (int q = pst[e] >> 8; q < (pst[e + 1] >> 8); ++q) m.blk_e[q] = e; } }
  __syncthreads();
  if (tid < 256) { const int e = es[tid]; int rank = 0; for (int j = 0; j < tid; ++j) rank += (es[j] == e) ? 1 : 0;
    const int slot = pst[e] + bef[e] + rank; sl[tid] = slot; m.slot_of[blk * 256 + tid] = slot; m.slot_gate[slot] = m.tok_g[blk * 256 + tid]; }
  __syncthreads();
  for (int it = 0; it < 8; ++it) {
    const int tl = wave * 8 + it, tok = blk * 64 + tl;
    v2u pk[4];
#pragma unroll
    for (int j = 0; j < 4; ++j) { const f32x4 a = *(const f32x4*)(x1 + (size_t)tok * D + lane * 4 + 256 * j); pk[j] = (v2u){cvt_pk_bf16(a[0], a[1]), cvt_pk_bf16(a[2], a[3])}; }
#pragma unroll
    for (int k = 0; k < 4; ++k) { bf16_t* dst = xs + (size_t)sl[tl * 4 + k] * D + lane * 4;
#pragma unroll
      for (int j = 0; j < 4; ++j) *(v2u*)(dst + 256 * j) = pk[j]; }
  }
  __syncthreads();
}

__device__ __forceinline__ void ph_combine_ln(const float* x1, const bf16_t* Ys, const int* slot_of, const float* g, const float* bb, float* out, bf16_t* outb) {
  const int tid = TIDX(), lane = tid & 63, gw = BIDX() * 8 + (tid >> 6), NGW = (int)gridDim.x * 8;
  for (int row = gw; row < NT; row += NGW) {
    const int4 s4 = *(const int4*)(slot_of + row * 4); const int sl[4] = {s4.x, s4.y, s4.z, s4.w};
    f32x4 v[4]; float s = 0.f;
#pragma unroll
    for (int j = 0; j < 4; ++j) { const int c = lane * 4 + 256 * j; f32x4 f = (f32x4){0.f, 0.f, 0.f, 0.f};
#pragma unroll
      for (int k = 0; k < 4; ++k) { const v2u y = *(const v2u*)(Ys + (size_t)sl[k] * D + c); f += (f32x4){bf_lo(y[0]), bf_hi(y[0]), bf_lo(y[1]), bf_hi(y[1])}; }
      const f32x4 a = *(const f32x4*)(x1 + (size_t)row * D + c); v[j] = a * ALPHA + f; s += (v[j][0] + v[j][1]) + (v[j][2] + v[j][3]); }
    const float mu = wave_sum(s) * (1.f / D); float q = 0.f;
#pragma unroll
    for (int j = 0; j < 4; ++j) { v[j] = v[j] - mu; q += (v[j][0] * v[j][0] + v[j][1] * v[j][1]) + (v[j][2] * v[j][2] + v[j][3] * v[j][3]); }
    const float r = rsqrtf(wave_sum(q) * (1.f / D) + 1e-5f);
#pragma unroll
    for (int j = 0; j < 4; ++j) { const int c = lane * 4 + 256 * j; const f32x4 g4 = *(const f32x4*)(g + c), b4 = *(const f32x4*)(bb + c); const f32x4 o = v[j] * r * g4 + b4;
      *(f32x4*)(out + (size_t)row * D + c) = o; if (outb) *(v2u*)(outb + (size_t)row * D + c) = (v2u){cvt_pk_bf16(o[0], o[1]), cvt_pk_bf16(o[2], o[3])}; }
  }
}

namespace pg8 {
struct MoeOrder {
    StaticOrder so; const int* blk_e; const char* W; size_t wexp; int obn;
    __device__ void init(const void* A, int lda, const void* W_, int ldb, size_t wexp_, int nM, int nN, int obn_, const int* blk_e_, int G, int c) { so.init(A, lda, W_, ldb, nM * BM, nN * BM, G, c); blk_e = blk_e_; W = (const char*)W_; wexp = wexp_; obn = obn_; }
    __device__ bool next(int i, Unit& u) const { int pm, pn; if (!so.tile(i, pm, pn)) return false; const int e = __builtin_amdgcn_readfirstlane(blk_e[pm]); u.pa = so.A + (size_t)pm * so.ta; u.pb = W + (size_t)e * wexp + (size_t)pn * so.tb; u.orow = pm * BM; u.ocol = pn * obn; u.e = e; return true; }
    __device__ __forceinline__ void a_ready(const Unit&) const {}
    __device__ __forceinline__ void done(const Unit&) const {}
};
struct EpiSwiglu {
    static constexpr bool PERM = true, AFTER_DRAIN = false;
    bf16_t* O; int ldc; const float* b1;
    __device__ __forceinline__ void operator()(const f32x4 (&acc)[2][2][4][2], const Unit& u, int wr, int wc, int fr, int fq) const {
        const int row0 = u.orow + wr * 64 + fr, cl = wc * 32 + 8 * fq, col0 = u.ocol + cl;
        const float* bg = b1 + (size_t)u.e * 2048 + col0; const float* bu = bg + 1024;
        const f32x4 bg0 = *(const f32x4*)bg, bg1 = *(const f32x4*)(bg + 4), bu0 = *(const f32x4*)bu, bu1 = *(const f32x4*)(bu + 4);
#pragma unroll
        for (int ai = 0; ai < 2; ++ai)
#pragma unroll
            for (int m = 0; m < 4; ++m) {
                f32x4 gv[2] = {acc[ai][0][m][0] + bg0, acc[ai][0][m][1] + bg1}, uv[2] = {acc[ai][1][m][0] + bu0, acc[ai][1][m][1] + bu1}; float o[8];
#pragma unroll
                for (int n = 0; n < 2; ++n)
#pragma unroll
                    for (int i = 0; i < 4; ++i) { const float gg = fminf(gv[n][i], 7.f), uu = fminf(fmaxf(uv[n][i], -7.f), 7.f);
                        const float sg = __builtin_amdgcn_rcpf(1.f + __builtin_amdgcn_exp2f(-1.702f * 1.4426950408889634f * gg)); o[4 * n + i] = (uu + 1.f) * gg * sg; }
                u32x4 w; w.x = cvt_pk_bf16(o[0], o[1]); w.y = cvt_pk_bf16(o[2], o[3]); w.z = cvt_pk_bf16(o[4], o[5]); w.w = cvt_pk_bf16(o[6], o[7]);
                *(u32x4*)(O + (size_t)(row0 + ai * HALF + m * 16) * ldc + col0) = w; asm volatile("" ::: "memory"); }
    }
};
struct EpiMoe2 {
    static constexpr bool PERM = true, AFTER_DRAIN = false;
    bf16_t* O; int ldc; const float* b2; const float* gate;
    __device__ __forceinline__ void operator()(const f32x4 (&acc)[2][2][4][2], const Unit& u, int wr, int wc, int fr, int fq) const {
        const int row0 = u.orow + wr * 64 + fr, col0 = u.ocol + wc * 32 + 8 * fq;
        const float* bp = b2 + (size_t)u.e * 1024 + col0;
#pragma unroll
        for (int bj = 0; bj < 2; ++bj) {
            const f32x4 bv0 = *(const f32x4*)(bp + bj * HALF), bv1 = *(const f32x4*)(bp + bj * HALF + 4);
#pragma unroll
            for (int ai = 0; ai < 2; ++ai)
#pragma unroll
                for (int m = 0; m < 4; ++m) { const int row = row0 + ai * HALF + m * 16; const float gt = gate[row];
                    const f32x4 v0 = (acc[ai][bj][m][0] + bv0) * gt, v1 = (acc[ai][bj][m][1] + bv1) * gt;
                    u32x4 w; w.x = cvt_pk_bf16(v0[0], v0[1]); w.y = cvt_pk_bf16(v0[2], v0[3]); w.z = cvt_pk_bf16(v1[0], v1[1]); w.w = cvt_pk_bf16(v1[2], v1[3]);
                    *(u32x4*)(O + (size_t)row * ldc + col0 + bj * HALF) = w; asm volatile("" ::: "memory"); }
        }
    }
};
}
#ifndef PROBE
#define PROBE 0
#endif
#ifndef PROBE_S
#define PROBE_S 10.0f
#endif
constexpr size_t MiB = 1u << 20;
constexpr size_t WS_CTL = 0, CTL_ZERO_BYTES = 1 * MiB;
constexpr int CW_BAR = 4096;
constexpr size_t WS_NEEDED = 2048 * MiB;

struct Args { In in; float* out; unsigned char* ws; };

struct Opt { bf16_t *xb, *WA_t, *WoutA_t, *WB_t, *WoutB_t, *W1_t, *W2_t, *projA_b, *hbf, *o2b, *xs, *act, *Ys, *projB_b; MoeBufs m; };
__device__ __forceinline__ nvp::Ws carve_ws(unsigned char* ws) {
  nvp::Ws w; auto at = [&](size_t mib) { return (char*)ws + mib * MiB; };
  w.projA = (float*)at(2); w.cn = (float*)at(119); w.sc = (float*)at(135); w.idx = (int*)at(647); w.o2 = (float*)at(663);
  w.x1 = (float*)at(727); w.x2 = (float*)at(791);
  w.projB = (float*)at(135); w.adec = (float*)at(135 + 194); w.og = (float*)at(135 + 194 + 32); w.on = (float*)at(135 + 194 + 32 + 64);
  w.counts = nullptr; w.h = nullptr; w.hb = nullptr; w.ys = nullptr; w.tok_e = nullptr; w.tok_g = nullptr; w.slot_of = nullptr; w.row_tok = nullptr; w.row_gate = nullptr; w.blk_e = nullptr;
  return w;
}
__device__ __forceinline__ Opt carve_opt(unsigned char* ws) {
  Opt o; auto at = [&](size_t mib) { return (bf16_t*)((char*)ws + mib * MiB); };
  char* sm = (char*)ws + 855 * MiB;
  o.m.tok_e = (int*)sm; o.m.tok_g = (float*)(sm + 256 * 1024); o.m.slot_of = (int*)(sm + 512 * 1024); o.m.slot_gate = (float*)(sm + 768 * 1024); o.m.blk_e = (int*)(sm + 1088 * 1024); o.m.blkcnt = (int*)(sm + 1096 * 1024); o.m.nblk = (int*)(sm + 1160 * 1024);
  o.WA_t = at(860); o.WoutA_t = at(864); o.WB_t = at(866); o.WoutB_t = at(873);
  o.W1_t = at(880); o.W2_t = at(1136);
  o.xb = at(1264); o.projA_b = at(1296); o.hbf = at(1360); o.o2b = at(1392);
  o.xs = at(1424); o.act = at(1568); o.Ys = at(1712); o.projB_b = at(1856);
  return o;
}

struct ProIn { const float *x, *a_w_in, *a_w_out, *b_w_in, *b_w_g2, *b_w_out, *m_w1, *m_w2; };
__device__ __forceinline__ void ph_prologue(const ProIn I, const Opt& o) {
  const int tid = TIDX(), lane = tid & 63, gw = BIDX() * 8 + (tid >> 6), NGW = (int)gridDim.x * 8, gtid = BIDX() * NTHR + tid, NGT = (int)gridDim.x * NTHR;
  cvt_f32_to_bf16(I.x, D, o.xb, D, NT, D, gtid, NGT);
  zero_rect(o.WA_t, D, DINA, 2048 - DINA, 0, D * 2, gtid, NGT);
  for (int i = gtid; i < 512 * 256; i += NGT) { const int n = i >> 8, k4 = (i & 255) * 4; float a[4];
#pragma unroll
    for (int z = 0; z < 4; ++z) { const float* gl = I.b_w_in + (size_t)(k4 + z) * DINB + 2048; float s = 0.f;
#pragma unroll
      for (int j = 0; j < 16; ++j) s = fmaf(gl[j], I.b_w_g2[j * 512 + n], s);
      a[z] = s; }
    *(v2u*)(o.WB_t + (size_t)(3072 + n) * D + k4) = (v2u){cvt_pk_bf16(a[0], a[1]), cvt_pk_bf16(a[2], a[3])}; }
  int w0 = 0;
  transpose_job(mk_tjob(I.a_w_in, DINA, D, DINA, o.WA_t, D, 0, 0, 0), w0, gw, NGW, lane);
  transpose_job(mk_tjob(I.a_w_out, D, D, D, o.WoutA_t, D, 0, 0, 0), w0, gw, NGW, lane);
  transpose_job(mk_tjob(I.b_w_in, DINB, D, 2048, o.WB_t, D, 0, 0, 0), w0, gw, NGW, lane);
  transpose_job(mk_tjob(I.b_w_in + 2064, DINB, D, 1024, o.WB_t, D, 2048, 0, 0), w0, gw, NGW, lane);
  transpose_job(mk_tjob(I.b_w_out, D, D, D, o.WoutB_t, D, 0, 0, 0), w0, gw, NGW, lane);
#pragma unroll 1
  for (int le = 0; le < 64; ++le) transpose_job(mk_tjob(I.m_w1 + (size_t)le * D * 2048, 2048, D, 2048, o.W1_t + (size_t)le * 2048 * D, D, 0, 0, 1), w0, gw, NGW, lane);
#pragma unroll 1
  for (int le = 0; le < 64; ++le) transpose_job(mk_tjob(I.m_w2 + (size_t)le * D * D, D, D, D, o.W2_t + (size_t)le * D * D, D, 0, 0, 0), w0, gw, NGW, lane);
}
__device__ __forceinline__ void ph_gla_shim(const bf16_t* pb, const float* gbias, float* projB, float* adec) {
  const int gtid = BIDX() * NTHR + TIDX(), NGT = (int)gridDim.x * NTHR;
  for (size_t i = gtid; i < (size_t)NT * 896; i += NGT) { const size_t r = i / 896; const int c = (int)(i % 896) * 4; const v2u v = *(const v2u*)(pb + r * 3584 + c);
    const f32x4 f = (f32x4){bf_lo(v[0]), bf_hi(v[0]), bf_lo(v[1]), bf_hi(v[1])};
    if (c < 2048) *(f32x4*)(projB + r * DINB + c) = f;
    else if (c < 3072) *(f32x4*)(projB + r * DINB + 2064 + (c - 2048)) = f;
    else { f32x4 o;
#pragma unroll
      for (int z = 0; z < 4; ++z) { const float a = f[z] + gbias[c - 3072 + z]; const float ls = fminf(a, 0.f) - log1pf(expf(-fabsf(a))); o[z] = expf(ls * (1.f / 16.f)); }
      *(f32x4*)(adec + r * 512 + (c - 3072)) = o; } }
}

#define LAYER_BODY(li) \
    if (li == 1) { \
      PH_BEGIN StaticOrder S; S.init(o.xb, D, o.WB_t, D, NT, 3584, G_, BIDX()); gemm_phase<EpiStore, StaticOrder, true, true>(ll, Gemm{D, D, D}, S, EpiStore{o.projB_b, 3584}); PH_END \
      GRID_BAR(); \
      PH_BEGIN ph_gla_shim(o.projB_b, I.b_g_bias, w.projB, w.adec); PH_END \
      GRID_BAR(); \
      PH_BEGIN nvp::np_gla_scan(w.projB, w.adec, w.og, fl); PH_END \
      GRID_BAR(); \
      PH_BEGIN nvp::np_gla_norm(w.og, w.projB, I.b_norm, w.on); PH_END \
      GRID_BAR(); \
      PH_BEGIN cvt_f32_to_bf16(w.on, D, o.o2b, D, NT, D, gtid_, NGT_); PH_END \
      GRID_BAR(); \
      PH_BEGIN StaticOrder S; S.init(o.o2b, D, o.WoutB_t, D, NT, D, G_, BIDX()); gemm_phase<EpiStore, StaticOrder, true, true>(ll, Gemm{D, D, D}, S, EpiStore{o.hbf, D}); PH_END \
      GRID_BAR(); \
    } \
    PH_BEGIN ph_ln_router(li == 0 ? I.x : w.x2, o.hbf, I.ln1_g + li * D, I.ln1_b + li * D, I.m_w_router + (size_t)li * D * 32, I.m_b_router + li * 32, w.x1, o.m, fl); PH_END \
    GRID_BAR(); \
    PH_BEGIN ph_moe_scatter(w.x1, o.xs, o.m, (int*)lds); PH_END \
    GRID_BAR(); \
    PH_BEGIN MoeOrder S; S.init(o.xs, D, o.W1_t + (size_t)li * 32 * 2048 * D, D, (size_t)2048 * D * 2, __builtin_amdgcn_readfirstlane(*o.m.nblk), 8, 128, o.m.blk_e, G_, BIDX()); \
      gemm_phase<pg8::EpiSwiglu, MoeOrder, true, true>(ll, Gemm{D, D, D}, S, pg8::EpiSwiglu{o.act, D, I.m_b1 + (size_t)li * 32 * 2048}); PH_END \
    GRID_BAR(); \
    PH_BEGIN MoeOrder S; S.init(o.act, D, o.W2_t + (size_t)li * 32 * D * D, D, (size_t)D * D * 2, __builtin_amdgcn_readfirstlane(*o.m.nblk), 4, 256, o.m.blk_e, G_, BIDX()); \
      gemm_phase<pg8::EpiMoe2, MoeOrder, true, true>(ll, Gemm{D, D, D}, S, pg8::EpiMoe2{o.Ys, D, I.m_b2 + (size_t)li * 32 * D, o.m.slot_gate}); PH_END \
    GRID_BAR(); \
    PH_BEGIN ph_combine_ln(w.x1, o.Ys, o.m.slot_of, I.ln2_g + li * D, I.ln2_b + li * D, li == 0 ? w.x2 : out_, li == 0 ? o.xb : nullptr); PH_END \
    if (li == 0) GRID_BAR();
__global__ void __launch_bounds__(NTHR, 2) mk_fwd(Args args) {
  extern __shared__ __attribute__((aligned(16))) unsigned char lds[];
  volatile LAS unsigned* MISC = (volatile LAS unsigned*)((LAS unsigned char*)lds + MISC_OFF);
  if (threadIdx.x < 32) MISC[threadIdx.x] = 0u;
  __syncthreads();
  XcdBarrier bar; { const __attribute__((address_space(4))) Args* ka0 = (const __attribute__((address_space(4))) Args*)__builtin_amdgcn_kernarg_segment_ptr(); bar = xcd_barrier_post((unsigned*)(ka0->ws + WS_CTL) + CW_BAR, MISC + 8); }
#define GRID_BAR() xcd_barrier(bar)
#define PH_BEGIN { const __attribute__((address_space(4))) Args* ka_ = (const __attribute__((address_space(4))) Args*)__builtin_amdgcn_kernarg_segment_ptr(); asm volatile("" : "+s"(ka_)); \
    float* const out_ = ka_->out; (void)out_; unsigned char* wsb_ = ka_->ws; const nvp::Ws w = carve_ws(wsb_); (void)w; const Opt o = carve_opt(wsb_); (void)o; \
    const int gtid_ = BIDX() * NTHR + TIDX(), NGT_ = (int)gridDim.x * NTHR; (void)gtid_; (void)NGT_; const int G_ = (int)gridDim.x; (void)G_;
#define PH_END }
#define I (ka_->in)
  float* fl = (float*)lds; LAS unsigned char* ll = (LAS unsigned char*)lds;
  using pg8::gemm_phase; using pg8::StaticOrder; using pg8::MoeOrder; using pg8::Gemm; using pg8::EpiStore;
  PH_BEGIN ph_prologue(ProIn{I.x, I.a_w_in, I.a_w_out, I.b_w_in, I.b_w_g2, I.b_w_out, I.m_w1, I.m_w2}, o); PH_END
  GRID_BAR();
  PH_BEGIN StaticOrder S; S.init(o.xb, D, o.WA_t, D, NT, 2048, G_, BIDX()); gemm_phase<EpiStore, StaticOrder, true, true>(ll, Gemm{D, D, D}, S, EpiStore{o.projA_b, 2048}); PH_END
  GRID_BAR();
  PH_BEGIN cvt_bf16_to_f32(o.projA_b, 2048, w.projA, DINA, NT, DINA, gtid_, NGT_); PH_END
  GRID_BAR();
  PH_BEGIN nvp::np_cnorm(w.projA, I.a_kv_norm, w.cn); PH_END
  PH_BEGIN nvp::np_iscore(w.projA, w.sc, fl); PH_END
  GRID_BAR();
  PH_BEGIN nvp::np_topk(w.sc, w.idx, (char*)lds); PH_END
  GRID_BAR();
  PH_BEGIN nvp::np_dsa_attn(w.projA, w.cn, w.idx, I.a_w_uk, I.a_w_uv, w.o2, fl); PH_END
  GRID_BAR();
  PH_BEGIN cvt_f32_to_bf16(w.o2, D, o.o2b, D, NT, D, gtid_, NGT_); PH_END
  GRID_BAR();
  PH_BEGIN StaticOrder S; S.init(o.o2b, D, o.WoutA_t, D, NT, D, G_, BIDX()); gemm_phase<EpiStore, StaticOrder, true, true>(ll, Gemm{D, D, D}, S, EpiStore{o.hbf, D}); PH_END
  GRID_BAR();
  { LAYER_BODY(0) }
  { LAYER_BODY(1) }
}

extern "C" void kernel_launch(void* const* d_in, const int* in_sizes, int n_in, void* d_out, int out_size, void* d_ws, size_t ws_size, hipStream_t stream) {
  static int grid = 0;
  if (grid == 0) {
    if (n_in != 21 || ws_size < WS_NEEDED) { fprintf(stderr, "kernel_launch: bad inputs (n_in %d) or workspace too small (%zu needed, %zu given)\n", n_in, (size_t)WS_NEEDED, ws_size); grid = -1; return; }
    int dev = 0, cus = 0, per_cu = 0;
    if (hipGetDevice(&dev) != hipSuccess || hipDeviceGetAttribute(&cus, hipDeviceAttributeMultiprocessorCount, dev) != hipSuccess) { grid = -1; return; }
    if (hipFuncSetAttribute((const void*)mk_fwd, hipFuncAttributeMaxDynamicSharedMemorySize, LDS_BYTES) != hipSuccess) { fprintf(stderr, "kernel_launch: hipFuncSetAttribute failed\n"); grid = -1; return; }
    if (hipOccupancyMaxActiveBlocksPerMultiprocessor(&per_cu, (const void*)mk_fwd, NTHR, LDS_BYTES) != hipSuccess || per_cu < 1) fprintf(stderr, "kernel_launch: note: occupancy query reports %d\n", per_cu);
    (void)hipGetLastError();
    grid = cus;
    if (grid != 256) fprintf(stderr, "kernel_launch: built for 256 CUs (token ownership per workgroup); got %d\n", grid);
  }
  if (grid < 0) return;
  if (hipMemsetAsync((char*)d_ws + WS_CTL, 0, CTL_ZERO_BYTES, stream) != hipSuccess) { fprintf(stderr, "kernel_launch: memset failed\n"); return; }
  Args a; memset(&a, 0, sizeof(a));
  const float** f = (const float**)&a.in;
  for (int i = 0; i < 21; ++i) f[i] = (const float*)d_in[i];
  a.out = (float*)d_out; a.ws = (unsigned char*)d_ws;
  hipLaunchKernelGGL(mk_fwd, dim3(grid), dim3(NTHR), LDS_BYTES, stream, a);
  const hipError_t le = hipPeekAtLastError();
  if (le != hipSuccess) fprintf(stderr, "kernel_launch: launch failed: %s\n", hipGetErrorName(le));
}
```

```cpp
#include <hip/hip_runtime.h>
#include <cstdio>
#include <cstdint>
#include <cstring>

#define GAS __attribute__((address_space(1)))
#define LAS __attribute__((address_space(3)))
#define NTHR 512
constexpr int LDS_BYTES = 147456;
constexpr int MISC_OFF = 131072 + 8192;

#define XB_TMO      128
#define XB_XCNT(j)  (256  + 64 * (j))
#define XB_XSUB(j)  (1280 + 64 * (j))
#define XB_XGEN(j)  (2304 + 64 * (j))
#define XB_TOP      3328
#define XB_TOPGEN   3392
#define XCD_BAR_WORDS 3456
#define XB_SPIN_CAP (1u << 25)
__device__ __forceinline__ unsigned xb_ld(unsigned* p)              { return __hip_atomic_load(p, __ATOMIC_RELAXED, __HIP_MEMORY_SCOPE_AGENT); }
__device__ __forceinline__ unsigned xb_add(unsigned* p, unsigned v) { return __hip_atomic_fetch_add(p, v, __ATOMIC_RELAXED, __HIP_MEMORY_SCOPE_AGENT); }
__device__ __forceinline__ unsigned xb_xcc_id() { return (unsigned)__builtin_amdgcn_s_getreg((3 << 11) | 20) & 0xFu; }
#define XB_SPIN(cond, bar) do { unsigned _sp = 0; while (cond) { __builtin_amdgcn_s_sleep(1); \
    if ((++_sp & 255u) == 0u) { if (xb_ld(&(bar)[XB_TMO])) break; if (_sp > XB_SPIN_CAP) { atomicAdd(&(bar)[XB_TMO], 1u); break; } } } } while (0)
struct XcdBarrier { unsigned* bar; unsigned x; volatile LAS unsigned* st; };
__device__ __forceinline__ XcdBarrier xcd_barrier_post(unsigned* bar, volatile LAS unsigned* st) {
    XcdBarrier b; b.bar = bar; b.x = xb_xcc_id(); b.st = st;
    if (threadIdx.x == 0) (void)xb_add(&bar[XB_XCNT(b.x)], 1u);
    return b;
}
__device__ __forceinline__ void xcd_barrier_complete(unsigned* bar, unsigned x, unsigned& nloc, unsigned& nx) {
    const unsigned G = gridDim.x * gridDim.y * gridDim.z;
    unsigned sum, cnt, mine, sp = 0u;
    for (;;) {
        sum = 0u; cnt = 0u; mine = 0u;
#pragma unroll
        for (unsigned j = 0; j < 16; ++j) { const unsigned c = xb_ld(&bar[XB_XCNT(j)]); sum += c; cnt += (c > 0u) ? 1u : 0u; mine = (j == x) ? c : mine; }
        if (sum == G) break;
        __builtin_amdgcn_s_sleep(1);
        if ((++sp & 255u) == 0u) { if (xb_ld(&bar[XB_TMO])) break; if (sp > XB_SPIN_CAP) { atomicAdd(&bar[XB_TMO], 1u); break; } }
    }
    nloc = mine > 0u ? mine : 1u; nx = cnt > 0u ? cnt : 1u;
}
__device__ __forceinline__ void xcd_barrier(const XcdBarrier& b) {
    asm volatile("s_waitcnt vmcnt(0)" ::: "memory");
    __syncthreads();
    if (threadIdx.x == 0) {
        unsigned* bar = b.bar;
        __builtin_amdgcn_s_waitcnt(0);
        unsigned nloc = b.st[0], nx = b.st[1];
        if (nloc == 0u) { xcd_barrier_complete(bar, b.x, nloc, nx); b.st[0] = nloc; b.st[1] = nx; }
        const unsigned old = xb_add(&bar[XB_XSUB(b.x)], 1u);
        const unsigned gen = old / nloc;
        if (old + 1u == (gen + 1u) * nloc) {
            __builtin_amdgcn_fence(__ATOMIC_RELEASE, "agent");
            asm volatile("s_waitcnt vmcnt(0)" ::: "memory");
            const unsigned og = xb_add(&bar[XB_TOP], 1u);
            const unsigned tg = og / nx;
            if (og + 1u == (tg + 1u) * nx) xb_add(&bar[XB_TOPGEN], 1u);
            else XB_SPIN(xb_ld(&bar[XB_TOPGEN]) == tg, bar);
            __builtin_amdgcn_fence(__ATOMIC_ACQUIRE, "agent");
            xb_add(&bar[XB_XGEN(b.x)], 1u);
            asm volatile("s_waitcnt vmcnt(0)" ::: "memory");
        } else {
            XB_SPIN(xb_ld(&bar[XB_XGEN(b.x)]) == gen, bar);
            __builtin_amdgcn_fence(__ATOMIC_ACQUIRE, "agent");
            asm volatile("s_waitcnt vmcnt(0)" ::: "memory");
        }
    }
    __syncthreads();
}

constexpr int NT = 16384, D = 1024, L = 8192, NB = 2;
constexpr int DINA = 1864, DINB = 3088;
constexpr int PMAX = 73728;
constexpr float ALPHA = 1.4142135623730951f;

struct In { const float *x, *a_w_in, *a_kv_norm, *a_w_uk, *a_w_uv, *a_w_out, *b_w_in, *b_w_g2, *b_g_bias, *b_norm, *b_w_out, *m_w_router, *m_b_router, *m_w1, *m_b1, *m_w2, *m_b2, *ln1_g, *ln1_b, *ln2_g, *ln2_b; };

__device__ __forceinline__ int TIDX() { int t = threadIdx.x; asm volatile("" : "+v"(t)); return t; }
__device__ __forceinline__ int BIDX() { int t = blockIdx.x; asm volatile("" : "+s"(t)); return t; }
__device__ __forceinline__ float wave_sum(float v) {
#pragma unroll
    for (int o = 1; o < 64; o <<= 1) v += __shfl_xor(v, o);
    return v;
}
namespace nvp {
#define WSYNC() asm volatile("s_waitcnt lgkmcnt(0)" ::: "memory")
struct GemmP {
  const float* A; int lda; const int* arow;
  const float* B; int ldb; float* C; int ldc; int M, N, K;
  const int* blk_e; const int* nblk_used; size_t bstride; const float* bias; size_t bias_stride;
};
__device__ __forceinline__ GemmP mkg(const float* A, int lda, const int* arow, const float* B, int ldb, float* C, int ldc, int M, int N, int K, const int* blk_e, const int* nblk_used, size_t bstride, const float* bias, size_t bias_stride) {
  GemmP p; p.A = A; p.lda = lda; p.arow = arow; p.B = B; p.ldb = ldb; p.C = C; p.ldc = ldc; p.M = M; p.N = N; p.K = K; p.blk_e = blk_e; p.nblk_used = nblk_used; p.bstride = bstride; p.bias = bias; p.bias_stride = bias_stride; return p; }

template <int MODE>
__device__ __forceinline__ void np_sgemm(const GemmP p, float* lds) {
  float (*As)[132] = (float (*)[132])lds;
  float (*Bs)[68] = (float (*)[68])(lds + 16 * 132);
  float (*Bu)[68] = (float (*)[68])(lds + 16 * 132 + 16 * 68);
  const int tid = TIDX(), tx = tid & 15, ty = tid >> 4;
  const int ntn = (p.N + 63) / 64, ntm = p.M / 128;
  const int ar = tid >> 2, ak = (tid & 3) * 4;
  const int bk = (tid & 255) >> 4, bn4 = (tid & 15) * 4;
  for (int t = BIDX(); t < ntm * ntn; t += gridDim.x) {
    const int bm = t / ntn, bn = t % ntn;
    const float* B = p.B; const float* bias = p.bias;
    if (MODE != 0) { const int blk = (bm * 128) / 256; if (blk >= *p.nblk_used) continue; const int e = p.blk_e[blk]; B += (size_t)e * p.bstride; bias += (size_t)e * p.bias_stride; }
    const int m0 = bm * 128, n0 = bn * 64;
    const int arow = p.arow ? p.arow[m0 + ar] : (m0 + ar);
    const float* Ap = p.A + (size_t)arow * p.lda + ak;
    const bool bok = (n0 + bn4) < p.N;
    float acc[4][4] = {}, accu[4][4] = {};
    for (int k0 = 0; k0 < p.K; k0 += 16) {
      const float4 av = *(const float4*)(Ap + k0);
      As[ak + 0][ar] = av.x; As[ak + 1][ar] = av.y; As[ak + 2][ar] = av.z; As[ak + 3][ar] = av.w;
      if (tid < 256) { float4 bv = make_float4(0.f, 0.f, 0.f, 0.f); if (bok) bv = *(const float4*)(B + (size_t)(k0 + bk) * p.ldb + n0 + bn4); *(float4*)&Bs[bk][bn4] = bv; }
      else if (MODE == 1) { const float4 uv = *(const float4*)(B + (size_t)(k0 + bk) * p.ldb + 1024 + n0 + bn4); *(float4*)&Bu[bk][bn4] = uv; }
      __syncthreads();
#pragma unroll
      for (int kk = 0; kk < 16; ++kk) {
        const float4 a = *(const float4*)&As[kk][ty * 4];
        const float4 b = *(const float4*)&Bs[kk][tx * 4];
        const float aa[4] = {a.x, a.y, a.z, a.w}, bb[4] = {b.x, b.y, b.z, b.w};
#pragma unroll
        for (int i = 0; i < 4; ++i)
#pragma unroll
          for (int j = 0; j < 4; ++j) acc[i][j] = fmaf(aa[i], bb[j], acc[i][j]);
        if (MODE == 1) {
          const float4 u = *(const float4*)&Bu[kk][tx * 4]; const float uu[4] = {u.x, u.y, u.z, u.w};
#pragma unroll
          for (int i = 0; i < 4; ++i)
#pragma unroll
            for (int j = 0; j < 4; ++j) accu[i][j] = fmaf(aa[i], uu[j], accu[i][j]);
        }
      }
      __syncthreads();
    }
#pragma unroll
    for (int i = 0; i < 4; ++i) {
      const int m = m0 + ty * 4 + i;
#pragma unroll
      for (int j = 0; j < 4; ++j) {
        const int n = n0 + tx * 4 + j; if (n >= p.N) continue;
        float v = acc[i][j];
        if (MODE == 1) {
          float g = v + bias[n], u = accu[i][j] + bias[1024 + n];
          g = fminf(g, 7.f); u = fminf(fmaxf(u, -7.f), 7.f);
          const float glu = g / (1.f + expf(-1.702f * g));
          v = (u + 1.f) * glu;
        } else if (MODE == 2) v += bias[n];
        p.C[(size_t)m * p.ldc + n] = v;
      }
    }
  }
}

#define GW_INIT const int lane = TIDX() & 63, wave = TIDX() >> 6, gw = BIDX() * 8 + wave, NGW = gridDim.x * 8; (void)lane; (void)wave; (void)gw; (void)NGW

__device__ __forceinline__ void np_cnorm(const float* projA, const float* g, float* cn) {
  GW_INIT;
  for (int row = gw; row < NT; row += NGW) {
    const float4 v = *(const float4*)(projA + (size_t)row * DINA + 1024 + lane * 4);
    const float ss = wave_sum(v.x * v.x + v.y * v.y + v.z * v.z + v.w * v.w);
    const float r = rsqrtf(ss * (1.f / 256.f) + 1e-6f); const float4 g4 = *(const float4*)(g + lane * 4);
    *(float4*)(cn + (size_t)row * 256 + lane * 4) = make_float4(v.x * r * g4.x, v.y * r * g4.y, v.z * r * g4.z, v.w * r * g4.w);
  }
}

__device__ __forceinline__ void np_iscore(const float* projA, float* sc, float* lds) {
  float (*As)[132] = (float (*)[132])lds;
  float (*Bs)[68] = (float (*)[68])(lds + 16 * 132);
  const int tid = TIDX(), tx = tid & 15, ty = tid >> 4;
  const int ar = tid >> 2, ak = (tid & 3) * 4;
  const int br = (tid & 255) >> 2;
  for (int u = BIDX(); u < NB * 64 * 128; u += gridDim.x) {
    const int b = u / (64 * 128), tt = (u / 128) % 64, st = u % 128;
    if (st > 2 * tt + 1) continue;
    const int t0 = tt * 128, s0 = st * 64;
    const float* Qp = projA + (size_t)(b * L + t0 + ar) * DINA + 1280 + ak;
    const float* Kp = projA + (size_t)(b * L + s0 + br) * DINA + 1792 + ak;
    float score[4][4] = {};
    for (int h = 0; h < 8; ++h) {
      float acc[4][4] = {};
      for (int k0 = 0; k0 < 64; k0 += 16) {
        const float4 av = *(const float4*)(Qp + h * 64 + k0);
        As[ak + 0][ar] = av.x; As[ak + 1][ar] = av.y; As[ak + 2][ar] = av.z; As[ak + 3][ar] = av.w;
        if (tid < 256) { const float4 bv = *(const float4*)(Kp + k0); Bs[ak + 0][br] = bv.x; Bs[ak + 1][br] = bv.y; Bs[ak + 2][br] = bv.z; Bs[ak + 3][br] = bv.w; }
        __syncthreads();
#pragma unroll
        for (int kk = 0; kk < 16; ++kk) {
          const float4 a = *(const float4*)&As[kk][ty * 4]; const float4 bq = *(const float4*)&Bs[kk][tx * 4];
          const float aa[4] = {a.x, a.y, a.z, a.w}, bb[4] = {bq.x, bq.y, bq.z, bq.w};
#pragma unroll
          for (int i = 0; i < 4; ++i)
#pragma unroll
            for (int j = 0; j < 4; ++j) acc[i][j] = fmaf(aa[i], bb[j], acc[i][j]);
        }
        __syncthreads();
      }
#pragma unroll
      for (int i = 0; i < 4; ++i) {
        const float w = projA[(size_t)(b * L + t0 + ty * 4 + i) * DINA + 1856 + h] * 0.35355339059327373f;
#pragma unroll
        for (int j = 0; j < 4; ++j) score[i][j] += w * fmaxf(acc[i][j] * 0.125f, 0.f);
      }
    }
#pragma unroll
    for (int i = 0; i < 4; ++i)
#pragma unroll
      for (int j = 0; j < 4; ++j) sc[((size_t)(b * L + t0 + ty * 4 + i)) * L + s0 + tx * 4 + j] = score[i][j];
  }
}

__device__ __forceinline__ unsigned f2key(float f) { f = f + 0.0f; const unsigned u = __float_as_uint(f); return (u & 0x80000000u) ? ~u : (u | 0x80000000u); }

__device__ __forceinline__ void np_topk(const float* sc, int* idx_out, char* lds) {
  GW_INIT;
  unsigned* hist = (unsigned*)(lds + wave * 1280); unsigned* cntw = hist + 256;
  for (int row = gw; row < NT; row += NGW) {
    const int t = row % L, n = t + 1;
    const float* s = sc + (size_t)row * L; int* out = idx_out + (size_t)row * 256;
    if (n <= 256) { for (int i = lane; i < 256; i += 64) out[i] = i < n ? i : -1; continue; }
    unsigned prefix = 0, need = 256;
    for (int pass = 3; pass >= 0; --pass) {
      const int shift = pass * 8;
      for (int i = lane; i < 256; i += 64) hist[i] = 0;
      WSYNC();
      for (int i = lane; i < n; i += 64) { const unsigned k = f2key(s[i]); const bool m = (pass == 3) || ((k >> (shift + 8)) == (prefix >> (shift + 8))); if (m) atomicAdd(&hist[(k >> shift) & 255u], 1u); }
      WSYNC();
      unsigned cum = 0; int d = 255; for (; d > 0; --d) { const unsigned hv = hist[d]; if (cum + hv >= need) break; cum += hv; }
      prefix |= ((unsigned)d << shift); need -= cum;
      WSYNC();
    }
    if (lane == 0) *cntw = 0; WSYNC();
    for (int i = lane; i < n; i += 64) { if (f2key(s[i]) > prefix) { const unsigned pos = atomicAdd(cntw, 1u); out[pos] = i; } }
    WSYNC();
    if (lane == 0) { unsigned c = *cntw; unsigned nd = need; for (int i = 0; i < n && nd > 0; ++i) if (f2key(s[i]) == prefix) { out[c++] = i; --nd; } }
    WSYNC();
  }
}

__device__ __forceinline__ void np_dsa_attn(const float* projA, const float* cn, const int* idx, const float* w_uk, const float* w_uv, float* o2, float* lds) {
  const int half = TIDX() >> 8, tid = TIDX() & 255;
  float* base = lds + half * 14336;
  float* qs = base; float (*ql)[256] = (float (*)[256])(base + 1024); float (*pr)[257] = (float (*)[257])(base + 1024 + 4096);
  float (*ol)[256] = (float (*)[256])(base + 1024 + 4096 + 4112); float* red = base + 1024 + 4096 + 4112 + 4096; int* sid = (int*)(red + 16);
  for (int r0 = BIDX() * 2; r0 < NT; r0 += gridDim.x * 2) {
    const int row = r0 + half, b = row / L;
    __syncthreads();
    for (int i = tid; i < 1024; i += 256) qs[i] = projA[(size_t)row * DINA + i];
    sid[tid] = idx[(size_t)row * 256 + tid];
    __syncthreads();
    { const int c = tid;
#pragma unroll 1
      for (int h = 0; h < 16; ++h) { float a = 0.f;
#pragma unroll 8
        for (int d = 0; d < 64; ++d) a = fmaf(qs[h * 64 + d], w_uk[((size_t)h * 64 + d) * 256 + c], a); ql[h][c] = a; } }
    __syncthreads();
    { const int k = tid, key = sid[k];
      float lg[16];
      if (key >= 0) { const float* cr = cn + (size_t)(b * L + key) * 256;
        for (int h = 0; h < 16; ++h) lg[h] = 0.f;
#pragma unroll 2
        for (int c = 0; c < 256; ++c) { const float cv = cr[c];
#pragma unroll
          for (int h = 0; h < 16; ++h) lg[h] = fmaf(ql[h][c], cv, lg[h]); }
#pragma unroll
        for (int h = 0; h < 16; ++h) pr[h][k] = lg[h] * 0.125f;
      } else {
#pragma unroll
        for (int h = 0; h < 16; ++h) pr[h][k] = -INFINITY; } }
    __syncthreads();
    if (tid < 16) { const int h = tid; float m = -INFINITY; for (int k = 0; k < 256; ++k) m = fmaxf(m, pr[h][k]); float su = 0.f; for (int k = 0; k < 256; ++k) { const float e = expf(pr[h][k] - m); pr[h][k] = e; su += e; } red[h] = 1.f / su; }
    __syncthreads();
    { const int c = tid; float a[16];
#pragma unroll
      for (int h = 0; h < 16; ++h) a[h] = 0.f;
#pragma unroll 2
      for (int k = 0; k < 256; ++k) { const int key = sid[k]; if (key < 0) continue; const float cv = cn[(size_t)(b * L + key) * 256 + c];
#pragma unroll
        for (int h = 0; h < 16; ++h) a[h] = fmaf(pr[h][k], cv, a[h]); }
#pragma unroll
      for (int h = 0; h < 16; ++h) ol[h][c] = a[h] * red[h]; }
    __syncthreads();
#pragma unroll 1
    for (int o = tid; o < 1024; o += 256) { const int h = o >> 6, v = o & 63; float a = 0.f;
#pragma unroll 8
      for (int c = 0; c < 256; ++c) a = fmaf(ol[h][c], w_uv[((size_t)h * 256 + c) * 64 + v], a); o2[(size_t)row * 1024 + o] = a; }
  }
  __syncthreads();
}

__device__ __forceinline__ void np_ln_res(const float* x, const float* h, const float* g, const float* bb, float* out) {
  GW_INIT;
  for (int row = gw; row < NT; row += NGW) {
    float4 v[4]; float s = 0.f;
#pragma unroll
    for (int j = 0; j < 4; ++j) { const float4 a = *(const float4*)(x + (size_t)row * D + lane * 4 + 256 * j), hh = *(const float4*)(h + (size_t)row * D + lane * 4 + 256 * j);
      v[j] = make_float4(ALPHA * a.x + hh.x, ALPHA * a.y + hh.y, ALPHA * a.z + hh.z, ALPHA * a.w + hh.w); s += (v[j].x + v[j].y) + (v[j].z + v[j].w); }
    const float mu = wave_sum(s) * (1.f / D); float q = 0.f;
#pragma unroll
    for (int j = 0; j < 4; ++j) { v[j].x -= mu; v[j].y -= mu; v[j].z -= mu; v[j].w -= mu; q += (v[j].x * v[j].x + v[j].y * v[j].y) + (v[j].z * v[j].z + v[j].w * v[j].w); }
    const float r = rsqrtf(wave_sum(q) * (1.f / D) + 1e-5f);
#pragma unroll
    for (int j = 0; j < 4; ++j) { const int c = lane * 4 + 256 * j; const float4 g4 = *(const float4*)(g + c), b4 = *(const float4*)(bb + c);
      *(float4*)(out + (size_t)row * D + c) = make_float4(v[j].x * r * g4.x + b4.x, v[j].y * r * g4.y + b4.y, v[j].z * r * g4.z + b4.z, v[j].w * r * g4.w + b4.w); }
  }
}

__device__ __forceinline__ void np_router(const float* x, const float* wr, const float* br, int* tok_e, float* tok_g, int* counts, int* row_tok, char* lds) {
  GW_INIT;
  for (int i = BIDX() * NTHR + TIDX(); i < PMAX; i += gridDim.x * NTHR) row_tok[i] = 0;
  float* lg = (float*)(lds + wave * 256);
  const int e = lane & 31, hf = lane >> 5;
  for (int tok = gw; tok < NT; tok += NGW) {
    const float* xr = x + (size_t)tok * D + hf * 512; const float* wp = wr + (size_t)hf * 512 * 32 + e; float a = 0.f;
#pragma unroll 8
    for (int d = 0; d < 512; ++d) a = fmaf(xr[d], wp[d * 32], a);
    a += __shfl_xor(a, 32);
    if (hf == 0) lg[e] = a + br[e];
    WSYNC();
    if (lane == 0) { int ei[4]; float ev[4];
      for (int k = 0; k < 4; ++k) { int bi = 0; float bv = -INFINITY; for (int j = 0; j < 32; ++j) if (lg[j] > bv) { bv = lg[j]; bi = j; } ei[k] = bi; ev[k] = bv; lg[bi] = -INFINITY; }
      float su = 0.f, ex[4]; for (int k = 0; k < 4; ++k) { ex[k] = expf(ev[k] - ev[0]); su += ex[k]; }
      for (int k = 0; k < 4; ++k) { tok_e[tok * 4 + k] = ei[k]; tok_g[tok * 4 + k] = ex[k] / su; atomicAdd(&counts[ei[k]], 1); } }
    WSYNC();
  }
}
__device__ __forceinline__ void np_moe_sort(const int* tok_e, const float* tok_g, const int* counts, int* row_tok, float* row_gate, int* slot_of, int* blk_e, int* nblk_used, char* lds) {
  if (BIDX() != 0) return;
  const int e = TIDX(); int* pstart = (int*)lds; int* stage = pstart + 64;
  if (e == 0) { int acc = 0; for (int j = 0; j < 32; ++j) { pstart[j] = acc; const int nb = (counts[j] + 255) / 256; for (int q = 0; q < nb; ++q) blk_e[acc / 256 + q] = j; acc += nb * 256; } pstart[32] = acc; *nblk_used = acc / 256; }
  __syncthreads();
  int pos = e < 32 ? pstart[e] : 0;
  for (int c0 = 0; c0 < NT * 4; c0 += 2048) {
    __syncthreads();
    for (int i = e; i < 2048; i += NTHR) stage[i] = tok_e[c0 + i];
    __syncthreads();
    if (e < 32) for (int i = 0; i < 2048; ++i) if (stage[i] == e) { const int gi = c0 + i; row_tok[pos] = gi >> 2; row_gate[pos] = tok_g[gi]; slot_of[gi] = pos; ++pos; }
  }
  __syncthreads();
}
__device__ __forceinline__ void np_moe_combine_ln(const float* x1, const float* ys, const int* slot_of, const float* tok_g, const float* g, const float* bb, float* out) {
  GW_INIT;
  for (int row = gw; row < NT; row += NGW) {
    float4 v[4]; float s = 0.f; int sl[4]; float gg[4];
#pragma unroll
    for (int k = 0; k < 4; ++k) { sl[k] = slot_of[row * 4 + k]; gg[k] = tok_g[row * 4 + k]; }
#pragma unroll
    for (int j = 0; j < 4; ++j) { const int c = lane * 4 + 256 * j; float4 f = make_float4(0.f, 0.f, 0.f, 0.f);
#pragma unroll
      for (int k = 0; k < 4; ++k) { const float4 y = *(const float4*)(ys + (size_t)sl[k] * D + c); f.x += gg[k] * y.x; f.y += gg[k] * y.y; f.z += gg[k] * y.z; f.w += gg[k] * y.w; }
      const float4 a = *(const float4*)(x1 + (size_t)row * D + c);
      v[j] = make_float4(ALPHA * a.x + f.x, ALPHA * a.y + f.y, ALPHA * a.z + f.z, ALPHA * a.w + f.w); s += (v[j].x + v[j].y) + (v[j].z + v[j].w); }
    const float mu = wave_sum(s) * (1.f / D); float q = 0.f;
#pragma unroll
    for (int j = 0; j < 4; ++j) { v[j].x -= mu; v[j].y -= mu; v[j].z -= mu; v[j].w -= mu; q += (v[j].x * v[j].x + v[j].y * v[j].y) + (v[j].z * v[j].z + v[j].w * v[j].w); }
    const float r = rsqrtf(wave_sum(q) * (1.f / D) + 1e-5f);
#pragma unroll
    for (int j = 0; j < 4; ++j) { const int c = lane * 4 + 256 * j; const float4 g4 = *(const float4*)(g + c), b4 = *(const float4*)(bb + c);
      *(float4*)(out + (size_t)row * D + c) = make_float4(v[j].x * r * g4.x + b4.x, v[j].y * r * g4.y + b4.y, v[j].z * r * g4.z + b4.z, v[j].w * r * g4.w + b4.w); }
  }
}

__device__ __forceinline__ void np_gla_gate(const float* projB, const float* w_g2, const float* gb, float* adec) {
  GW_INIT;
  for (int row = gw; row < NT; row += NGW) {
    float glr[16];
#pragma unroll
    for (int j = 0; j < 16; ++j) glr[j] = projB[(size_t)row * DINB + 2048 + j];
    for (int c = lane; c < 512; c += 64) { float a = gb[c];
#pragma unroll
      for (int j = 0; j < 16; ++j) a = fmaf(glr[j], w_g2[j * 512 + c], a);
      const float ls = fminf(a, 0.f) - log1pf(expf(-fabsf(a))); adec[(size_t)row * 512 + c] = expf(ls * (1.f / 16.f)); }
  }
}
__device__ __forceinline__ void np_gla_scan(const float* projB, const float* adec, float* og, float* lds) {
  if (BIDX() >= 8) return;
  const int b = BIDX() >> 2, h = BIDX() & 3, tid = TIDX(), dv = tid & 255, dh = tid >> 8;
  float (*qs)[128] = (float (*)[128])lds; float (*ks)[128] = (float (*)[128])(lds + 2048); float (*as)[128] = (float (*)[128])(lds + 4096);
  float (*po)[16][256] = (float (*)[16][256])(lds + 6144);
  float S[64];
#pragma unroll
  for (int d = 0; d < 64; ++d) S[d] = 0.f;
  for (int t0 = 0; t0 < L; t0 += 16) {
    __syncthreads();
    for (int i = tid; i < 16 * 128; i += NTHR) { const int tt = i >> 7, d = i & 127; const size_t r = (size_t)(b * L + t0 + tt);
      qs[tt][d] = projB[r * DINB + h * 128 + d] * 0.08838834764831845f; ks[tt][d] = projB[r * DINB + 512 + h * 128 + d]; as[tt][d] = adec[r * 512 + h * 128 + d]; }
    __syncthreads();
#pragma unroll 1
    for (int tt = 0; tt < 16; ++tt) { const size_t r = (size_t)(b * L + t0 + tt); const float v = projB[r * DINB + 1024 + h * 256 + dv]; float o = 0.f;
#pragma unroll
      for (int d = 0; d < 64; ++d) { S[d] = fmaf(as[tt][dh * 64 + d], S[d], ks[tt][dh * 64 + d] * v); o = fmaf(qs[tt][dh * 64 + d], S[d], o); }
      po[dh][tt][dv] = o; }
    __syncthreads();
    for (int i = tid; i < 16 * 256; i += NTHR) { const int tt = i >> 8, c = i & 255; og[(size_t)(b * L + t0 + tt) * 1024 + h * 256 + c] = po[0][tt][c] + po[1][tt][c]; }
  }
  __syncthreads();
}
__device__ __forceinline__ void np_gla_norm(const float* og, const float* projB, const float* ng, float* on) {
  GW_INIT;
  for (int u = gw; u < NT * 4; u += NGW) {
    const int row = u >> 2, h = u & 3; const int c = h * 256 + lane * 4;
    const float4 v = *(const float4*)(og + (size_t)row * 1024 + c);
    const float r = rsqrtf(wave_sum(v.x * v.x + v.y * v.y + v.z * v.z + v.w * v.w) * (1.f / 256.f) + 1e-6f);
    const float4 rr = *(const float4*)(projB + (size_t)row * DINB + 2064 + c), g4 = *(const float4*)(ng + c);
    *(float4*)(on + (size_t)row * 1024 + c) = make_float4(v.x * r * g4.x * (rr.x / (1.f + expf(-rr.x))), v.y * r * g4.y * (rr.y / (1.f + expf(-rr.y))), v.z * r * g4.z * (rr.z / (1.f + expf(-rr.z))), v.w * r * g4.w * (rr.w / (1.f + expf(-rr.w))));
  }
}

struct Ws { float *projA, *cn, *sc, *o2, *h, *x1, *x2, *hb, *ys, *projB, *adec, *og, *on, *tok_g, *row_gate; int *idx, *tok_e, *slot_of, *row_tok, *blk_e, *counts; };
}
typedef unsigned short bf16_t;
typedef unsigned v4u __attribute__((ext_vector_type(4)));
typedef unsigned v2u __attribute__((ext_vector_type(2)));
typedef float f32x4 __attribute__((ext_vector_type(4)));
typedef short bf16x8 __attribute__((ext_vector_type(8)));
__device__ __forceinline__ unsigned cvt_pk_bf16(float lo, float hi) { unsigned r; asm volatile("v_cvt_pk_bf16_f32 %0, %1, %2" : "=v"(r) : "v"(lo), "v"(hi)); return r; }
__device__ __forceinline__ float bf_lo(unsigned u) { return __uint_as_float(u << 16); }
__device__ __forceinline__ float bf_hi(unsigned u) { return __uint_as_float(u & 0xffff0000u); }
__device__ __forceinline__ float bf2f(bf16_t h) { return __uint_as_float(((unsigned)h) << 16); }

struct TJob { const float* src; int lds_; int K, N; bf16_t* dst; int ldd; int drow0, dcol0; int rowmap; int ntk, ntn; };
__device__ __forceinline__ TJob mk_tjob(const float* src, int lds_, int K, int N, bf16_t* dst, int ldd, int drow0, int dcol0, int rowmap) {
  TJob j; j.src = src; j.lds_ = lds_; j.K = K; j.N = N; j.dst = dst; j.ldd = ldd; j.drow0 = drow0; j.dcol0 = dcol0; j.rowmap = rowmap; j.ntk = K / 64; j.ntn = (N + 127) / 128; return j; }
__device__ __forceinline__ int tjob_tiles(const TJob& j) { return j.ntk * j.ntn; }
__device__ __forceinline__ void transpose_tile(const TJob& j, int tile, int lane) {
  const int kt = tile / j.ntn, nt_ = tile % j.ntn, k0 = kt * 64, n0 = nt_ * 128;
  const int q = lane & 31, par = lane >> 5;
  const bool ok = (n0 + 4 * q) < j.N;
  f32x4 v[32];
  const float* sp = j.src + (size_t)(k0 + par) * j.lds_ + n0 + 4 * q;
#pragma unroll
  for (int i = 0; i < 32; ++i) v[i] = ok ? *(const f32x4*)(sp + (size_t)(2 * i) * j.lds_) : (f32x4){0.f, 0.f, 0.f, 0.f};
  unsigned ra[32], rb[32];
#pragma unroll
  for (int i = 0; i < 32; ++i) {
    auto s0 = __builtin_amdgcn_permlane32_swap(__float_as_uint(v[i][0]), __float_as_uint(v[i][2]), false, false);
    auto s1 = __builtin_amdgcn_permlane32_swap(__float_as_uint(v[i][1]), __float_as_uint(v[i][3]), false, false);
    ra[i] = cvt_pk_bf16(__uint_as_float(s0[0]), __uint_as_float(s0[1]));
    rb[i] = cvt_pk_bf16(__uint_as_float(s1[0]), __uint_as_float(s1[1]));
  }
  if (ok) {
    const int n = n0 + 4 * q + 2 * par;
    int r0 = n, r1 = n + 1;
    if (j.rowmap == 1) { const int jj0 = r0 & 1023, jj1 = r1 & 1023; r0 = 256 * (jj0 >> 7) + ((r0 >> 10) << 7) + (jj0 & 127); r1 = 256 * (jj1 >> 7) + ((r1 >> 10) << 7) + (jj1 & 127); }
    bf16_t* d0 = j.dst + (size_t)(j.drow0 + r0) * j.ldd + j.dcol0 + k0;
    bf16_t* d1 = j.dst + (size_t)(j.drow0 + r1) * j.ldd + j.dcol0 + k0;
#pragma unroll
    for (int c = 0; c < 8; ++c) { *(v4u*)(d0 + 8 * c) = (v4u){ra[4 * c], ra[4 * c + 1], ra[4 * c + 2], ra[4 * c + 3]}; *(v4u*)(d1 + 8 * c) = (v4u){rb[4 * c], rb[4 * c + 1], rb[4 * c + 2], rb[4 * c + 3]}; }
  }
}
__device__ __forceinline__ void transpose_job(const TJob j, int& w0, int gw, int NGW, int lane) {
  const int nt_ = tjob_tiles(j);
  int first = gw - (w0 % NGW); if (first < 0) first += NGW;
#pragma unroll 1
  for (int t = first; t < nt_; t += NGW) transpose_tile(j, t, lane);
  w0 += nt_;
}
__device__ __forceinline__ void zero_rect(bf16_t* dst, int ldd, int r0, int nr, int cb0, int nbytes, int gtid, int NGT) {
  const int per = nbytes / 16;
  for (int i = gtid; i < nr * per; i += NGT) { const int r = i / per, c = i % per; *(v4u*)((char*)(dst + (size_t)(r0 + r) * ldd) + cb0 + 16 * c) = (v4u){0u, 0u, 0u, 0u}; }
}
__device__ __forceinline__ void cvt_f32_to_bf16(const float* src, int lds_, bf16_t* dst, int ldd, int rows, int ncols, int gtid, int NGT) {
  const int per = ncols / 4;
  for (size_t i = gtid; i < (size_t)rows * per; i += NGT) { const size_t r = i / per; const int c = (int)(i % per) * 4; const f32x4 v = *(const f32x4*)(src + r * lds_ + c);
    *(v2u*)(dst + r * ldd + c) = (v2u){cvt_pk_bf16(v[0], v[1]), cvt_pk_bf16(v[2], v[3])}; }
}
__device__ __forceinline__ void cvt_bf16_to_f32(const bf16_t* src, int lds_, float* dst, int ldd, int rows, int ncols, int gtid, int NGT) {
  const int per = ncols / 4;
  for (size_t i = gtid; i < (size_t)rows * per; i += NGT) { const size_t r = i / per; const int c = (int)(i % per) * 4; const v2u v = *(const v2u*)(src + r * lds_ + c);
    *(f32x4*)(dst + r * ldd + c) = (f32x4){bf_lo(v[0]), bf_hi(v[0]), bf_lo(v[1]), bf_hi(v[1])}; }
}

namespace pg8 {
#define PG8_LAS __attribute__((address_space(3)))
typedef unsigned u32x4 __attribute__((ext_vector_type(4)));
constexpr int BM = 256, BK = 64, HALF = 128, HTB = HALF * BK * 2, STAGE_BYTES = 8 * HTB, NXCD = 8, WGM = 8;
__host__ __device__ __forceinline__ int lds_byte(int r, int c) { const int st = (r >> 4) * 2 + (c >> 5), rr = r & 15, cc = c & 31, ob = rr * 64 + cc * 2; return st * 1024 + (ob ^ (((ob >> 9) & 1) << 5)); }
__host__ __device__ __forceinline__ void stage_rc(int b, int& R, int& C) { const int st = b / 1024, sb = b % 1024, swz = sb ^ (((sb >> 9) & 1) << 5); R = (st >> 1) * 16 + swz / 64; C = (st & 1) * 32 + (swz % 64) / 2; }
__host__ __device__ __forceinline__ int perm32(int rho) { const int n = rho >> 4, i = rho & 15; return 8 * (i >> 2) + 4 * n + (i & 3); }
struct Unit { const char* pa; const char* pb; int orow, ocol, e; };
struct Gemm { int lda, ldb, K; };
struct StaticOrder {
    const char* A; const char* Bt; size_t ta, tb; int nM, nN, nwg, G, c;
    __device__ void init(const void* A_, int lda, const void* Bt_, int ldb, int M, int N, int G_, int c_) { A = (const char*)A_; Bt = (const char*)Bt_; ta = (size_t)BM * lda * 2; tb = (size_t)BM * ldb * 2; nM = M / BM; nN = N / BM; nwg = nM * nN; G = G_; c = c_; }
    __device__ bool tile(int i, int& pm, int& pn) const {
        const long L = (long)i * G + c; if (L >= nwg) return false;
        int wgid = (int)L; { const int q = nwg / NXCD, r = nwg % NXCD, xcd = wgid % NXCD, off = wgid / NXCD; wgid = (xcd < r ? xcd * (q + 1) : r * (q + 1) + (xcd - r) * q) + off; }
        const int nig = WGM * nN, gid = wgid / nig, fm = gid * WGM, gsz = (nM - fm) < WGM ? (nM - fm) : WGM;
        pm = fm + ((wgid % nig) % gsz); pn = (wgid % nig) / gsz; return true;
    }
    __device__ bool next(int i, Unit& u) const { int pm, pn; if (!tile(i, pm, pn)) return false; u.pa = A + (size_t)pm * ta; u.pb = Bt + (size_t)pn * tb; u.orow = pm * BM; u.ocol = pn * BM; u.e = 0; return true; }
    __device__ __forceinline__ void a_ready(const Unit&) const {}
    __device__ __forceinline__ void done(const Unit&) const {}
};
struct EpiStore {
    static constexpr bool PERM = true, AFTER_DRAIN = false;
    bf16_t* O; int ldc;
    __device__ __forceinline__ void operator()(const f32x4 (&acc)[2][2][4][2], const Unit& u, int wr, int wc, int fr, int fq) const {
        const int row0 = u.orow + wr * 64 + fr, col0 = u.ocol + wc * 32 + 8 * fq;
#pragma unroll
        for (int ai = 0; ai < 2; ++ai)
#pragma unroll
            for (int m = 0; m < 4; ++m) { bf16_t* rowp = O + (size_t)(row0 + ai * HALF + m * 16) * ldc + col0;
#pragma unroll
                for (int bj = 0; bj < 2; ++bj) { const f32x4 v0 = acc[ai][bj][m][0], v1 = acc[ai][bj][m][1];
                    u32x4 w; w.x = cvt_pk_bf16(v0[0], v0[1]); w.y = cvt_pk_bf16(v0[2], v0[3]); w.z = cvt_pk_bf16(v1[0], v1[1]); w.w = cvt_pk_bf16(v1[2], v1[3]);
                    *(u32x4*)(rowp + bj * HALF) = w; } }
    }
};
template <class Epi, class Sched, bool ALIGN_EPI = false, bool SP2 = false>
__device__ __forceinline__ void gemm_phase(PG8_LAS unsigned char* lds, const Gemm g, const Sched& S, const Epi& E) {
    const int tid = TIDX(), wid = __builtin_amdgcn_readfirstlane(tid >> 6), lane = tid & 63, wr = wid >> 2, wc = wid & 3, fr = lane & 15, fq = lane >> 4;
    const int K = g.K, nt = K / BK;
    unsigned voffA[2], voffB[2];
#pragma unroll
    for (int i = 0; i < 2; ++i) { int R, C; stage_rc(tid * 16 + i * 8192, R, C); const int Rb = Epi::PERM ? ((R & ~31) + perm32(R & 31)) : R;
        voffA[i] = (unsigned)(R * g.lda + C) * 2u; voffB[i] = (unsigned)(Rb * g.ldb + C) * 2u; }
    const size_t kstep = (size_t)(BK * 2);
    const size_t hstepA = (size_t)HALF * g.lda * 2, hstepB = (size_t)HALF * g.ldb * 2;
    const unsigned ldsw = (unsigned)wid * 1024u;
    const int aoff = lds_byte(wr * 64 + fr, fq * 8), boff = lds_byte(wc * 32 + fr, fq * 8);
#define PG8_SA(b, h) (((b) * 2 + (h)) * HTB)
#define PG8_SB(b, h) ((4 + (b) * 2 + (h)) * HTB)
#define PG8_STAGE(bufoff, gbase, voff) do { _Pragma("unroll") for (int _i = 0; _i < 2; ++_i) \
        __builtin_amdgcn_global_load_lds((const unsigned*)((const char*)(gbase) + (voff)[_i]), (PG8_LAS unsigned*)(lds + (bufoff) + ldsw + _i * 8192), 16, 0, 0); } while (0)
#define PG8_LDA(dst, b, h) do { _Pragma("unroll") for (int m = 0; m < 4; ++m) _Pragma("unroll") for (int k = 0; k < 2; ++k) dst[m][k] = *(const PG8_LAS bf16x8*)(lds + PG8_SA(b, h) + aoff + m * 2048 + k * 1024); } while (0)
#define PG8_LDB(dst, b, h) do { _Pragma("unroll") for (int n = 0; n < 2; ++n) _Pragma("unroll") for (int k = 0; k < 2; ++k) dst[n][k] = *(const PG8_LAS bf16x8*)(lds + PG8_SB(b, h) + boff + n * 2048 + k * 1024); } while (0)
#define PG8_MMA(ai, bj, At, Bt) do { __builtin_amdgcn_s_setprio(1); _Pragma("unroll") for (int m = 0; m < 4; ++m) _Pragma("unroll") for (int n = 0; n < 2; ++n) _Pragma("unroll") for (int k = 0; k < 2; ++k) \
        acc[ai][bj][m][n] = __builtin_amdgcn_mfma_f32_16x16x32_bf16(Bt[n][k], At[m][k], acc[ai][bj][m][n], 0, 0, 0); __builtin_amdgcn_s_setprio(0); } while (0)
#define PG8_WAIT_V(n) asm volatile("s_waitcnt vmcnt(" #n ")" ::: "memory")
#define PG8_WAIT_L(n) asm volatile("s_waitcnt lgkmcnt(" #n ")" ::: "memory")
#define PG8_BAR __builtin_amdgcn_s_barrier()
#define PG8_SCHED __builtin_amdgcn_sched_barrier(0)
    Unit cur, nxt; int ui = 0;
    if (!S.next(0, cur)) return;
    f32x4 acc[2][2][4][2];
#pragma unroll
    for (int a = 0; a < 2; ++a)
#pragma unroll
        for (int b = 0; b < 2; ++b)
#pragma unroll
            for (int m = 0; m < 4; ++m)
#pragma unroll
                for (int n = 0; n < 2; ++n) acc[a][b][m][n] = (f32x4){0.f, 0.f, 0.f, 0.f};
    bf16x8 At[4][2], B0[2][2], B1[2][2];
    const char* cA = cur.pa; const char* cB = cur.pb;
    S.a_ready(cur);
    if constexpr (SP2) {
        PG8_STAGE(PG8_SB(0, 0), cB, voffB); PG8_STAGE(PG8_SB(0, 1), cB + hstepB, voffB); PG8_STAGE(PG8_SA(0, 0), cA, voffA); PG8_STAGE(PG8_SA(0, 1), cA + hstepA, voffA);
        if (wr == 1) PG8_BAR;
        PG8_WAIT_V(2); PG8_BAR;
        PG8_STAGE(PG8_SB(1, 0), cB + kstep, voffB); PG8_STAGE(PG8_SA(1, 0), cA + kstep, voffA); PG8_STAGE(PG8_SB(1, 1), cB + hstepB + kstep, voffB);
        PG8_WAIT_V(6); PG8_BAR;
    } else {
        PG8_STAGE(PG8_SB(0, 0), cB, voffB); PG8_STAGE(PG8_SA(0, 0), cA, voffA); PG8_STAGE(PG8_SB(0, 1), cB + hstepB, voffB); PG8_STAGE(PG8_SA(0, 1), cA + hstepA, voffA);
        if (wr == 1) PG8_BAR;
        PG8_WAIT_V(4); PG8_BAR;
        PG8_STAGE(PG8_SB(1, 0), cB + kstep, voffB); PG8_STAGE(PG8_SA(1, 0), cA + kstep, voffA); PG8_STAGE(PG8_SB(1, 1), cB + hstepB + kstep, voffB);
        PG8_WAIT_V(6); PG8_BAR;
    }
    for (;;) {
        const bool has_next = S.next(ui + 1, nxt);
        const char* nA = has_next ? nxt.pa : cA; const char* nB = has_next ? nxt.pb : cB;
        for (int t = 0; t < nt; t += 2) {
            const bool last = (t == nt - 2);
            const char* a1 = cA + (size_t)(t + 1) * kstep;
            const char* a2 = last ? nA : cA + (size_t)(t + 2) * kstep; const char* b2 = last ? nB : cB + (size_t)(t + 2) * kstep;
            const char* a3 = a2 + kstep; const char* b3 = b2 + kstep;
            if (last && has_next) S.a_ready(nxt);
            if constexpr (SP2) {
            PG8_LDB(B0, 0, 0); PG8_LDB(B1, 0, 1); PG8_SCHED; PG8_LDA(At, 0, 0); PG8_STAGE(PG8_SA(1, 1), a1 + hstepA, voffA);
            PG8_WAIT_V(8); PG8_WAIT_L(0); PG8_BAR; PG8_MMA(0, 0, At, B0); PG8_MMA(0, 1, At, B1); PG8_BAR; PG8_SCHED;
            PG8_LDA(At, 0, 1); PG8_STAGE(PG8_SB(0, 0), b2, voffB); PG8_STAGE(PG8_SB(0, 1), b2 + hstepB, voffB); PG8_STAGE(PG8_SA(0, 0), a2, voffA);
            PG8_WAIT_V(8); PG8_WAIT_L(0); PG8_BAR; PG8_MMA(1, 0, At, B0); PG8_MMA(1, 1, At, B1); PG8_BAR; PG8_SCHED;
            PG8_LDB(B0, 1, 0); PG8_LDB(B1, 1, 1); PG8_SCHED; PG8_LDA(At, 1, 0); PG8_STAGE(PG8_SA(0, 1), a2 + hstepA, voffA);
            PG8_WAIT_V(8); PG8_WAIT_L(0); PG8_BAR; PG8_MMA(0, 0, At, B0); PG8_MMA(0, 1, At, B1); PG8_BAR; PG8_SCHED;
            PG8_LDA(At, 1, 1); PG8_STAGE(PG8_SB(1, 0), b3, voffB); PG8_STAGE(PG8_SB(1, 1), b3 + hstepB, voffB); PG8_STAGE(PG8_SA(1, 0), a3, voffA);
            PG8_WAIT_V(8); PG8_WAIT_L(0); PG8_BAR; PG8_MMA(1, 0, At, B0); PG8_MMA(1, 1, At, B1); PG8_BAR; PG8_SCHED;
            } else {
            PG8_LDB(B0, 0, 0); PG8_SCHED; PG8_LDA(At, 0, 0); PG8_STAGE(PG8_SA(1, 1), a1 + hstepA, voffA);
            PG8_WAIT_L(8); PG8_BAR; PG8_WAIT_L(0); PG8_MMA(0, 0, At, B0); PG8_BAR; PG8_SCHED;
            PG8_LDB(B1, 0, 1); PG8_STAGE(PG8_SB(0, 0), b2, voffB);
            PG8_BAR; PG8_WAIT_L(0); PG8_MMA(0, 1, At, B1); PG8_BAR;
            PG8_LDA(At, 0, 1); PG8_STAGE(PG8_SA(0, 0), a2, voffA);
            PG8_BAR; PG8_WAIT_L(0); PG8_MMA(1, 0, At, B0); PG8_BAR; PG8_SCHED;
            PG8_STAGE(PG8_SB(0, 1), b2 + hstepB, voffB);
            PG8_WAIT_V(6); PG8_BAR; PG8_MMA(1, 1, At, B1); PG8_BAR;
            PG8_LDB(B0, 1, 0); PG8_SCHED; PG8_LDA(At, 1, 0); PG8_STAGE(PG8_SA(0, 1), a2 + hstepA, voffA);
            PG8_WAIT_L(8); PG8_BAR; PG8_WAIT_L(0); PG8_MMA(0, 0, At, B0); PG8_BAR; PG8_SCHED;
            PG8_LDB(B1, 1, 1); PG8_STAGE(PG8_SB(1, 0), b3, voffB);
            PG8_BAR; PG8_WAIT_L(0); PG8_MMA(0, 1, At, B1); PG8_BAR;
            PG8_LDA(At, 1, 1); PG8_STAGE(PG8_SA(1, 0), a3, voffA);
            PG8_BAR; PG8_WAIT_L(0); PG8_MMA(1, 0, At, B0); PG8_BAR; PG8_SCHED;
            PG8_STAGE(PG8_SB(1, 1), b3 + hstepB, voffB);
            PG8_WAIT_V(6); PG8_BAR; PG8_MMA(1, 1, At, B1); PG8_BAR;
            }
        }
        if constexpr (ALIGN_EPI) { if (wr == 0) PG8_BAR; }
        if constexpr (!Epi::AFTER_DRAIN) { E(acc, cur, wr, wc, fr, fq); S.done(cur); }
        if (!has_next) break;
#pragma unroll
        for (int a = 0; a < 2; ++a)
#pragma unroll
            for (int b = 0; b < 2; ++b)
#pragma unroll
                for (int m = 0; m < 4; ++m)
#pragma unroll
                    for (int n = 0; n < 2; ++n) acc[a][b][m][n] = (f32x4){0.f, 0.f, 0.f, 0.f};
        cur = nxt; cA = nA; cB = nB; ++ui;
        if constexpr (ALIGN_EPI) { if (wr == 1) PG8_BAR; }
    }
    PG8_WAIT_V(0);
    if constexpr (!ALIGN_EPI) { if (wr == 0) PG8_BAR; }
    PG8_BAR;
    if constexpr (Epi::AFTER_DRAIN) { E.fused(acc, cur, wr, wc, fr, fq, lds, wid, lane); S.done(cur); }
#undef PG8_SA
#undef PG8_SB
#undef PG8_STAGE
#undef PG8_LDA
#undef PG8_LDB
#undef PG8_MMA
#undef PG8_WAIT_V
#undef PG8_WAIT_L
#undef PG8_BAR
#undef PG8_SCHED
}

}
#define WSYNC2() asm volatile("s_waitcnt lgkmcnt(0)" ::: "memory")
struct MoeBufs { int* tok_e; float* tok_g; int* slot_of; float* slot_gate; int* blk_e; int* blkcnt; int* nblk; };
constexpr int WRT_LD = 1028;

__device__ __forceinline__ void ph_ln_router(const float* xin, const bf16_t* hb, const float* g, const float* bb, const float* wr, const float* br, float* x1, const MoeBufs m, float* lds) {
  const int tid = TIDX(), lane = tid & 63, wave = tid >> 6, blk = BIDX();
  float* wT = lds;
  float* lg = lds + 32 * WRT_LD + wave * 64;
  int* cnt = (int*)(lds + 32 * WRT_LD + 8 * 64);
  for (int i = tid; i < 1024 * 32; i += NTHR) { const int d = i >> 5, e = i & 31; wT[e * WRT_LD + d] = wr[i]; }
  if (tid < 32) cnt[tid] = 0;
  __syncthreads();
  for (int it = 0; it < 8; ++it) {
    const int tok = blk * 64 + wave * 8 + it; if (tok >= NT) break;
    f32x4 v[4]; float s = 0.f;
#pragma unroll
    for (int j = 0; j < 4; ++j) { const int c = lane * 4 + 256 * j; const f32x4 a = *(const f32x4*)(xin + (size_t)tok * D + c); const v2u hh = *(const v2u*)(hb + (size_t)tok * D + c);
      v[j] = (f32x4){ALPHA * a[0] + bf_lo(hh[0]), ALPHA * a[1] + bf_hi(hh[0]), ALPHA * a[2] + bf_lo(hh[1]), ALPHA * a[3] + bf_hi(hh[1])}; s += (v[j][0] + v[j][1]) + (v[j][2] + v[j][3]); }
    const float mu = wave_sum(s) * (1.f / D); float q = 0.f;
#pragma unroll
    for (int j = 0; j < 4; ++j) { v[j] = v[j] - mu; q += (v[j][0] * v[j][0] + v[j][1] * v[j][1]) + (v[j][2] * v[j][2] + v[j][3] * v[j][3]); }
    const float r = rsqrtf(wave_sum(q) * (1.f / D) + 1e-5f);
#pragma unroll
    for (int j = 0; j < 4; ++j) { const int c = lane * 4 + 256 * j; const f32x4 g4 = *(const f32x4*)(g + c), b4 = *(const f32x4*)(bb + c); v[j] = v[j] * r * g4 + b4; *(f32x4*)(x1 + (size_t)tok * D + c) = v[j]; }
    float p[32];
#pragma unroll
    for (int e = 0; e < 32; ++e) { float a = 0.f;
#pragma unroll
      for (int j = 0; j < 4; ++j) { const f32x4 w4 = *(const f32x4*)(wT + e * WRT_LD + lane * 4 + 256 * j); a = fmaf(v[j][0], w4[0], a); a = fmaf(v[j][1], w4[1], a); a = fmaf(v[j][2], w4[2], a); a = fmaf(v[j][3], w4[3], a); }
      p[e] = a; }
#pragma unroll
    for (int i = 0; i < 16; ++i) { const bool hi = (lane & 32) != 0; const float send = hi ? p[i] : p[i + 16]; const float keep = hi ? p[i + 16] : p[i]; p[i] = keep + __shfl_xor(send, 32); }
#pragma unroll
    for (int i = 0; i < 8; ++i) { const bool hi = (lane & 16) != 0; const float send = hi ? p[i] : p[i + 8]; const float keep = hi ? p[i + 8] : p[i]; p[i] = keep + __shfl_xor(send, 16); }
#pragma unroll
    for (int i = 0; i < 4; ++i) { const bool hi = (lane & 8) != 0; const float send = hi ? p[i] : p[i + 4]; const float keep = hi ? p[i + 4] : p[i]; p[i] = keep + __shfl_xor(send, 8); }
#pragma unroll
    for (int i = 0; i < 2; ++i) { const bool hi = (lane & 4) != 0; const float send = hi ? p[i] : p[i + 2]; const float keep = hi ? p[i + 2] : p[i]; p[i] = keep + __shfl_xor(send, 4); }
    { const bool hi = (lane & 2) != 0; const float send = hi ? p[0] : p[1]; const float keep = hi ? p[1] : p[0]; p[0] = keep + __shfl_xor(send, 2); }
    p[0] += __shfl_xor(p[0], 1);
    const int e_l = ((lane >> 5) & 1) * 16 + ((lane >> 4) & 1) * 8 + ((lane >> 3) & 1) * 4 + ((lane >> 2) & 1) * 2 + ((lane >> 1) & 1);
    if ((lane & 1) == 0) lg[e_l] = p[0] + br[e_l];
    WSYNC2();
    if (lane == 0) { int ei[4]; float ev[4];
#pragma unroll
      for (int k = 0; k < 4; ++k) { int bi = 0; float bv = -INFINITY; for (int j = 0; j < 32; ++j) { const float l = lg[j]; if (l > bv) { bv = l; bi = j; } } ei[k] = bi; ev[k] = bv; lg[bi] = -INFINITY; }
      float ex[4], su = 0.f;
#pragma unroll
      for (int k = 0; k < 4; ++k) { ex[k] = __expf(ev[k] - ev[0]); su += ex[k]; }
      const float inv = 1.f / su;
      *(int4*)(m.tok_e + tok * 4) = make_int4(ei[0], ei[1], ei[2], ei[3]);
      *(float4*)(m.tok_g + tok * 4) = make_float4(ex[0] * inv, ex[1] * inv, ex[2] * inv, ex[3] * inv);
#pragma unroll
      for (int k = 0; k < 4; ++k) atomicAdd(&cnt[ei[k]], 1); }
    WSYNC2();
  }
  __syncthreads();
  if (tid < 32) m.blkcnt[blk * 32 + tid] = cnt[tid];
  __syncthreads();
}

__device__ __forceinline__ void ph_moe_scatter(const float* x1, bf16_t* xs, const MoeBufs m, int* ilds) {
  const int tid = TIDX(), lane = tid & 63, wave = tid >> 6, blk = BIDX(), G = (int)gridDim.x;
  int* tot = ilds; int* bef = ilds + 32; int* pst = ilds + 64; int* es = ilds + 128; int* sl = ilds + 128 + 256;
  if (tid < 64) ilds[tid] = 0;
  __syncthreads();
  { const int bp = tid >> 1, e0 = (tid & 1) * 16;
    if (bp < G) {
#pragma unroll
      for (int q = 0; q < 4; ++q) { const int4 c = *(const int4*)(m.blkcnt + bp * 32 + e0 + 4 * q); const int cc[4] = {c.x, c.y, c.z, c.w};
#pragma unroll
        for (int z = 0; z < 4; ++z) { atomicAdd(&tot[e0 + 4 * q + z], cc[z]); if (bp < blk) atomicAdd(&bef[e0 + 4 * q + z], cc[z]); } } } }
  if (tid < 256) es[tid] = m.tok_e[blk * 256 + tid];
  __syncthreads();
  if (tid == 0) { int acc = 0; for (int e = 0; e < 32; ++e) { pst[e] = acc; acc += ((tot[e] + 255) >> 8) << 8; } pst[32] = acc;
    if (blk == 0) { *m.nblk = acc >> 8; for (int e = 0; e < 32; ++e) for (int q = pst[e] >> 8; q < (pst[e + 1] >> 8); ++q) m.blk_e[q] = e; } }
  __syncthreads();
  if (tid < 256) { const int e = es[tid]; int rank = 0; for (int j = 0; j < tid; ++j) rank += (es[j] == e) ? 1 : 0;
    const int slot = pst[e] + bef[e] + rank; sl[tid] = slot; m.slot_of[blk * 256 + tid] = slot; m.slot_gate[slot] = m.tok_g[blk * 256 + tid]; }
  __syncthreads();
  for (int it = 0; it < 8; ++it) {
    const int tl = wave * 8 + it, tok = blk * 64 + tl;
    v2u pk[4];
#pragma unroll
    for (int j = 0; j < 4; ++j) { const f32x4 a = *(const f32x4*)(x1 + (size_t)tok * D + lane * 4 + 256 * j); pk[j] = (v2u){cvt_pk_bf16(a[0], a[1]), cvt_pk_bf16(a[2], a[3])}; }
#pragma unroll
    for (int k = 0; k < 4; ++k) { bf16_t* dst = xs + (size_t)sl[tl * 4 + k] * D + lane * 4;
#pragma unroll
      for (int j = 0; j < 4; ++j) *(v2u*)(dst + 256 * j) = pk[j]; }
  }
  __syncthreads();
}

__device__ __forceinline__ void ph_combine_ln(const float* x1, const bf16_t* Ys, const int* slot_of, const float* g, const float* bb, float* out, bf16_t* outb) {
  const int tid = TIDX(), lane = tid & 63, gw = BIDX() * 8 + (tid >> 6), NGW = (int)gridDim.x * 8;
  for (int row = gw; row < NT; row += NGW) {
    const int4 s4 = *(const int4*)(slot_of + row * 4); const int sl[4] = {s4.x, s4.y, s4.z, s4.w};
    f32x4 v[4]; float s = 0.f;
#pragma unroll
    for (int j = 0; j < 4; ++j) { const int c = lane * 4 + 256 * j; f32x4 f = (f32x4){0.f, 0.f, 0.f, 0.f};
#pragma unroll
      for (int k = 0; k < 4; ++k) { const v2u y = *(const v2u*)(Ys + (size_t)sl[k] * D + c); f += (f32x4){bf_lo(y[0]), bf_hi(y[0]), bf_lo(y[1]), bf_hi(y[1])}; }
      const f32x4 a = *(const f32x4*)(x1 + (size_t)row * D + c); v[j] = a * ALPHA + f; s += (v[j][0] + v[j][1]) + (v[j][2] + v[j][3]); }
    const float mu = wave_sum(s) * (1.f / D); float q = 0.f;
#pragma unroll
    for (int j = 0; j < 4; ++j) { v[j] = v[j] - mu; q += (v[j][0] * v[j][0] + v[j][1] * v[j][1]) + (v[j][2] * v[j][2] + v[j][3] * v[j][3]); }
    const float r = rsqrtf(wave_sum(q) * (1.f / D) + 1e-5f);
#pragma unroll
    for (int j = 0; j < 4; ++j) { const int c = lane * 4 + 256 * j; const f32x4 g4 = *(const f32x4*)(g + c), b4 = *(const f32x4*)(bb + c); const f32x4 o = v[j] * r * g4 + b4;
      *(f32x4*)(out + (size_t)row * D + c) = o; if (outb) *(v2u*)(outb + (size_t)row * D + c) = (v2u){cvt_pk_bf16(o[0], o[1]), cvt_pk_bf16(o[2], o[3])}; }
  }
}

namespace pg8 {
struct MoeOrder {
    StaticOrder so; const int* blk_e; const char* W; size_t wexp; int obn;
    __device__ void init(const void* A, int lda, const void* W_, int ldb, size_t wexp_, int nM, int nN, int obn_, const int* blk_e_, int G, int c) { so.init(A, lda, W_, ldb, nM * BM, nN * BM, G, c); blk_e = blk_e_; W = (const char*)W_; wexp = wexp_; obn = obn_; }
    __device__ bool next(int i, Unit& u) const { int pm, pn; if (!so.tile(i, pm, pn)) return false; const int e = __builtin_amdgcn_readfirstlane(blk_e[pm]); u.pa = so.A + (size_t)pm * so.ta; u.pb = W + (size_t)e * wexp + (size_t)pn * so.tb; u.orow = pm * BM; u.ocol = pn * obn; u.e = e; return true; }
    __device__ __forceinline__ void a_ready(const Unit&) const {}
    __device__ __forceinline__ void done(const Unit&) const {}
};
struct EpiSwiglu {
    static constexpr bool PERM = true, AFTER_DRAIN = false;
    bf16_t* O; int ldc; const float* b1;
    __device__ __forceinline__ void operator()(const f32x4 (&acc)[2][2][4][2], const Unit& u, int wr, int wc, int fr, int fq) const {
        const int row0 = u.orow + wr * 64 + fr, cl = wc * 32 + 8 * fq, col0 = u.ocol + cl;
        const float* bg = b1 + (size_t)u.e * 2048 + col0; const float* bu = bg + 1024;
        const f32x4 bg0 = *(const f32x4*)bg, bg1 = *(const f32x4*)(bg + 4), bu0 = *(const f32x4*)bu, bu1 = *(const f32x4*)(bu + 4);
#pragma unroll
        for (int ai = 0; ai < 2; ++ai)
#pragma unroll
            for (int m = 0; m < 4; ++m) {
                f32x4 gv[2] = {acc[ai][0][m][0] + bg0, acc[ai][0][m][1] + bg1}, uv[2] = {acc[ai][1][m][0] + bu0, acc[ai][1][m][1] + bu1}; float o[8];
#pragma unroll
                for (int n = 0; n < 2; ++n)
#pragma unroll
                    for (int i = 0; i < 4; ++i) { const float gg = fminf(gv[n][i], 7.f), uu = fminf(fmaxf(uv[n][i], -7.f), 7.f);
                        const float sg = __builtin_amdgcn_rcpf(1.f + __builtin_amdgcn_exp2f(-1.702f * 1.4426950408889634f * gg)); o[4 * n + i] = (uu + 1.f) * gg * sg; }
                u32x4 w; w.x = cvt_pk_bf16(o[0], o[1]); w.y = cvt_pk_bf16(o[2], o[3]); w.z = cvt_pk_bf16(o[4], o[5]); w.w = cvt_pk_bf16(o[6], o[7]);
                *(u32x4*)(O + (size_t)(row0 + ai * HALF + m * 16) * ldc + col0) = w; asm volatile("" ::: "memory"); }
    }
};
struct EpiMoe2 {
    static constexpr bool PERM = true, AFTER_DRAIN = false;
    bf16_t* O; int ldc; const float* b2; const float* gate;
    __device__ __forceinline__ void operator()(const f32x4 (&acc)[2][2][4][2], const Unit& u, int wr, int wc, int fr, int fq) const {
        const int row0 = u.orow + wr * 64 + fr, col0 = u.ocol + wc * 32 + 8 * fq;
        const float* bp = b2 + (size_t)u.e * 1024 + col0;
#pragma unroll
        for (int bj = 0; bj < 2; ++bj) {
            const f32x4 bv0 = *(const f32x4*)(bp + bj * HALF), bv1 = *(const f32x4*)(bp + bj * HALF + 4);
#pragma unroll
            for (int ai = 0; ai < 2; ++ai)
#pragma unroll
                for (int m = 0; m < 4; ++m) { const int row = row0 + ai * HALF + m * 16; const float gt = gate[row];
                    const f32x4 v0 = (acc[ai][bj][m][0] + bv0) * gt, v1 = (acc[ai][bj][m][1] + bv1) * gt;
                    u32x4 w; w.x = cvt_pk_bf16(v0[0], v0[1]); w.y = cvt_pk_bf16(v0[2], v0[3]); w.z = cvt_pk_bf16(v1[0], v1[1]); w.w = cvt_pk_bf16(v1[2], v1[3]);
                    *(u32x4*)(O + (size_t)row * ldc + col0 + bj * HALF) = w; asm volatile("" ::: "memory"); }
        }
    }
};
}
typedef short v4i16_t __attribute__((ext_vector_type(4)));
__device__ __forceinline__ unsigned f2key_u(float f) { f = f + 0.0f; const unsigned u = __float_as_uint(f); return (u & 0x80000000u) ? ~u : (u | 0x80000000u); }

__device__ __forceinline__ void ph_cnorm_b(const bf16_t* pa, const float* g, bf16_t* cnb) {
  const int tid = TIDX(), lane = tid & 63, gw = BIDX() * 8 + (tid >> 6), NGW = (int)gridDim.x * 8;
  const f32x4 g4 = *(const f32x4*)(g + lane * 4);
  for (int row = gw; row < NT; row += NGW) {
    const v2u v = *(const v2u*)(pa + (size_t)row * 2048 + 1024 + lane * 4);
    const f32x4 f = (f32x4){bf_lo(v[0]), bf_hi(v[0]), bf_lo(v[1]), bf_hi(v[1])};
    const float r = rsqrtf(wave_sum((f[0] * f[0] + f[1] * f[1]) + (f[2] * f[2] + f[3] * f[3])) * (1.f / 256.f) + 1e-6f);
    const f32x4 o = f * r * g4;
    *(v2u*)(cnb + (size_t)row * 256 + lane * 4) = (v2u){cvt_pk_bf16(o[0], o[1]), cvt_pk_bf16(o[2], o[3])};
  }
}

__device__ __forceinline__ void ph_iscore(const bf16_t* pa, float* sc) {
  const int tid = TIDX(), lane = tid & 63, gw = BIDX() * 8 + (tid >> 6), NGW = (int)gridDim.x * 8;
  const int n16 = lane & 15, g = lane >> 4;
#pragma unroll 1
  for (int u = gw; u < 2 * 4352; u += NGW) {
    const int b = u / 4352, v = u % 4352;
    int a = 0; while (a < 15 && 16 * (a + 1) * (a + 2) <= v) ++a;
    const int rem = v - 16 * a * (a + 1), r = rem / (a + 1), ch = rem % (a + 1);
    const int qg = 32 * a + r, ntile = (ch < a) ? 32 : (r + 1), t0 = qg * 16, kt0 = ch * 32;
    const bf16_t* qrow = pa + (size_t)(b * L + t0 + n16) * 2048;
    bf16x8 qf[8][2]; float w[8];
#pragma unroll
    for (int h = 0; h < 8; ++h) { qf[h][0] = *(const bf16x8*)(qrow + 1280 + h * 64 + 8 * g); qf[h][1] = *(const bf16x8*)(qrow + 1280 + h * 64 + 32 + 8 * g); w[h] = bf2f(qrow[1856 + h]) * (0.35355339059327373f * 0.125f); }
    const bf16_t* kbase = pa + (size_t)(b * L + n16) * 2048 + 1792 + 8 * g;
    float* srow = sc + (size_t)(b * L + t0 + n16) * L + 4 * g;
#pragma unroll 2
    for (int kt = kt0; kt < kt0 + ntile; ++kt) {
      const bf16x8 k0 = *(const bf16x8*)(kbase + (size_t)kt * 16 * 2048), k1 = *(const bf16x8*)(kbase + (size_t)kt * 16 * 2048 + 32);
      f32x4 score = (f32x4){0.f, 0.f, 0.f, 0.f};
#pragma unroll
      for (int h = 0; h < 8; ++h) {
        f32x4 acc = __builtin_amdgcn_mfma_f32_16x16x32_bf16(k0, qf[h][0], (f32x4){0.f, 0.f, 0.f, 0.f}, 0, 0, 0);
        acc = __builtin_amdgcn_mfma_f32_16x16x32_bf16(k1, qf[h][1], acc, 0, 0, 0);
#pragma unroll
        for (int i = 0; i < 4; ++i) score[i] = fmaf(fmaxf(acc[i], 0.f), w[h], score[i]);
      }
      *(f32x4*)(srow + kt * 16) = score;
    }
  }
}

constexpr int DW_STRIDE = 17152;
__device__ __forceinline__ unsigned offb(unsigned row, unsigned ch) { return 256u * row + 16u * (ch ^ (((row & 3u) << 2) | ((row >> 2) & 3u))); }
__device__ __forceinline__ void glds16(const void* gsrc, unsigned lds_dst) { unsigned keep;
  asm volatile("s_mov_b32 %0, m0\n\ts_mov_b32 m0, %2\n\ts_nop 0\n\tglobal_load_lds_dwordx4 %1, off\n\ts_mov_b32 m0, %0" : "=&s"(keep) : "v"(gsrc), "s"(lds_dst) : "memory"); }
__device__ __forceinline__ int wave_excl_scan(int v, int lane, int& total) {
  int x = v;
#pragma unroll
  for (int o = 1; o < 64; o <<= 1) { const int y = __shfl_up(x, o); if (lane >= o) x += y; }
  total = __shfl(x, 63); return x - v;
}
#define LDSW() asm volatile("s_waitcnt lgkmcnt(0)" ::: "memory")

__device__ __forceinline__ int wave_select(const float* srow, int t, LAS unsigned char* wl, LAS unsigned short* idx16, int lane) {
  const int n = t + 1;
  if (n <= 256) { for (int i = lane; i < 256; i += 64) idx16[i] = (unsigned short)(i < n ? i : 0); LDSW(); return n; }
  LAS unsigned* hist = (LAS unsigned*)wl;
  for (int i = lane; i < 1024; i += 64) ((LAS v4u*)hist)[i] = (v4u){0u, 0u, 0u, 0u};
  unsigned bk[32][2];
#pragma unroll
  for (int i = 0; i < 32; ++i) {
    bk[i][0] = 0u; bk[i][1] = 0u;
    if (i * 256 < n) { const int e0 = (i * 64 + lane) * 4;
      if (e0 < n) { const f32x4 f = *(const f32x4*)(srow + e0); unsigned bn[4];
#pragma unroll
        for (int c = 0; c < 4; ++c) bn[c] = (e0 + c <= t) ? (f2key_u(f[c]) >> 20) : 0u;
        bk[i][0] = bn[0] | (bn[1] << 16); bk[i][1] = bn[2] | (bn[3] << 16); } }
    if ((i & 7) == 7) asm volatile("" ::: "memory");
  }
#define BIN_OF(i, c) ((bk[i][(c) >> 1] >> (((c) & 1) * 16)) & 0xFFFFu)
  LDSW();
#pragma unroll
  for (int i = 0; i < 32; ++i) if (i * 256 < n) {
#pragma unroll
    for (int c = 0; c < 4; ++c) { const unsigned bin = BIN_OF(i, c); if (bin) __hip_atomic_fetch_add(hist + bin, 1u, __ATOMIC_RELAXED, __HIP_MEMORY_SCOPE_WORKGROUP); }
    asm volatile("" ::: "memory"); }
  LDSW();
  const int bbase = 4096 - 64 * (lane + 1); int ssum = 0;
#pragma unroll 8
  for (int k = 0; k < 64; ++k) ssum += (int)hist[bbase + ((k + lane) & 63)];
  int tot; const int pre = wave_excl_scan(ssum, lane, tot);
  const unsigned long long bal = __ballot(pre < 256 && pre + ssum >= 256);
  const int Ls = (int)__builtin_ctzll(bal);
  int cum = __shfl(pre, Ls); const int sb = 4096 - 64 * (Ls + 1); int B1 = sb;
  for (int k = 63; k >= 0; --k) { const int c = (int)hist[sb + k]; if (cum + c >= 256) { B1 = sb + k; break; } cum += c; }
  const int cnt_gt = cum, need1 = 256 - cnt_gt;
  LDSW();
  int ngt = 0, neq = 0;
#pragma unroll
  for (int i = 0; i < 32; ++i) if (i * 256 < n) {
#pragma unroll
    for (int c = 0; c < 4; ++c) { const int bin = (int)BIN_OF(i, c); ngt += (bin > B1) ? 1 : 0; neq += (bin == B1) ? 1 : 0; } }
  int tg, te; int pg = wave_excl_scan(ngt, lane, tg); int pe = wave_excl_scan(neq, lane, te);
  LAS unsigned short* cand = (LAS unsigned short*)wl;
#pragma unroll
  for (int i = 0; i < 32; ++i) if (i * 256 < n) {
#pragma unroll
    for (int c = 0; c < 4; ++c) { const int bin = (int)BIN_OF(i, c); const int e = (i * 64 + lane) * 4 + c;
      if (bin > B1) { idx16[pg] = (unsigned short)e; ++pg; }
      if (bin == B1) { cand[pe] = (unsigned short)e; ++pe; } }
    asm volatile("" ::: "memory"); }
#undef BIN_OF
  LDSW();
  const int m = te;
  unsigned long long lo = 0ull;
  if (m <= 256) {
    unsigned long long cp[4];
#pragma unroll
    for (int j = 0; j < 4; ++j) { const int q = lane + 64 * j; cp[j] = 0ull; if (q < m) { const unsigned ci = cand[q]; cp[j] = ((unsigned long long)(f2key_u(srow[ci]) & 0xFFFFFu) << 13) | (unsigned long long)(8191u - ci) | (1ull << 40); } }
    for (int bit = 32; bit >= 0; --bit) { const unsigned long long trial = lo | (1ull << bit); int c = 0;
#pragma unroll
      for (int j = 0; j < 4; ++j) c += ((cp[j] >> 40) && ((cp[j] & 0x1FFFFFFFFull) >= trial)) ? 1 : 0;
      int tc; (void)wave_excl_scan(c, lane, tc); if (tc >= need1) lo = trial; }
    int c = 0;
#pragma unroll
    for (int j = 0; j < 4; ++j) c += ((cp[j] >> 40) && ((cp[j] & 0x1FFFFFFFFull) >= lo)) ? 1 : 0;
    int tc; int pos = cnt_gt + wave_excl_scan(c, lane, tc);
#pragma unroll
    for (int j = 0; j < 4; ++j) if ((cp[j] >> 40) && ((cp[j] & 0x1FFFFFFFFull) >= lo)) { idx16[pos] = (unsigned short)(8191u - (unsigned)(cp[j] & 0x1FFFull)); ++pos; }
  } else {
    for (int bit = 32; bit >= 0; --bit) { const unsigned long long trial = lo | (1ull << bit); int c = 0;
      for (int q = lane; q < m; q += 64) { const unsigned ci = cand[q]; const unsigned long long cpq = ((unsigned long long)(f2key_u(srow[ci]) & 0xFFFFFu) << 13) | (unsigned long long)(8191u - ci); c += (cpq >= trial) ? 1 : 0; }
      int tc; (void)wave_excl_scan(c, lane, tc); if (tc >= need1) lo = trial; }
    int base = cnt_gt;
    for (int q0 = 0; q0 < m; q0 += 64) { const int q = q0 + lane; bool sel = false; unsigned ci = 0;
      if (q < m) { ci = cand[q]; const unsigned long long cpq = ((unsigned long long)(f2key_u(srow[ci]) & 0xFFFFFu) << 13) | (unsigned long long)(8191u - ci); sel = cpq >= lo; }
      int tc; const int pos = base + wave_excl_scan(sel ? 1 : 0, lane, tc); if (sel) idx16[pos] = (unsigned short)ci; base += tc; }
  }
  LDSW();
  return 256;
}

__device__ __forceinline__ void wave_attend(int b, int t, int cnt, const bf16_t* qlat, const bf16_t* cnb, LAS unsigned char* wl, LAS unsigned short* idx16, bf16_t* olat, int lane) {
  const int n16 = lane & 15, g = lane >> 4, q4 = (lane & 15) >> 2, p4 = lane & 3;
  const bf16_t* qrow = qlat + (size_t)(b * L + t) * 4096 + n16 * 256 + 8 * g;
  bf16x8 qf[8];
#pragma unroll
  for (int s = 0; s < 8; ++s) qf[s] = *(const bf16x8*)(qrow + 32 * s);
  f32x4 o[16];
#pragma unroll
  for (int c = 0; c < 16; ++c) o[c] = (f32x4){0.f, 0.f, 0.f, 0.f};
  float mrun = -INFINITY, lrun = 0.f;
  const int ntile = (cnt + 31) >> 5;
  const char* cb = (const char*)(cnb + (size_t)b * L * 256);
  const unsigned wl_addr = (unsigned)__builtin_amdgcn_readfirstlane((int)(unsigned)(size_t)wl);
  const unsigned slot = lane & 15, rsub = lane >> 4;
  constexpr float SC = 0.125f * 1.4426950408889634f;
#pragma unroll 1
  for (int it = 0; it < ntile; ++it) {
#pragma unroll
    for (int rg = 0; rg < 8; ++rg) { const unsigned row = 4 * rg + rsub; const unsigned key = idx16[32 * it + row];
      const unsigned ch = slot ^ (((row & 3u) << 2) | ((row >> 2) & 3u));
      const char* src = cb + (size_t)key * 512 + ch * 16;
      glds16(src, wl_addr + rg * 1024); glds16(src + 256, wl_addr + 8192 + rg * 1024); }
    asm volatile("s_waitcnt vmcnt(0)" ::: "memory");
    f32x4 s0 = (f32x4){0.f, 0.f, 0.f, 0.f}, s1 = (f32x4){0.f, 0.f, 0.f, 0.f};
#pragma unroll
    for (int s = 0; s < 8; ++s) { const unsigned ib = (s >> 2) * 8192, chq = 4 * (s & 3) + g;
      const bf16x8 a0 = *(const LAS bf16x8*)(wl + ib + offb(n16, chq)), a1 = *(const LAS bf16x8*)(wl + ib + offb(16 + n16, chq));
      s0 = __builtin_amdgcn_mfma_f32_16x16x32_bf16(a0, qf[s], s0, 0, 0, 0); s1 = __builtin_amdgcn_mfma_f32_16x16x32_bf16(a1, qf[s], s1, 0, 0, 0); }
    const int sl0 = 32 * it + 4 * g;
    float mx = -INFINITY;
#pragma unroll
    for (int r = 0; r < 4; ++r) { s0[r] = (sl0 + r < cnt) ? s0[r] * SC : -INFINITY; s1[r] = (sl0 + 16 + r < cnt) ? s1[r] * SC : -INFINITY; mx = fmaxf(mx, fmaxf(s0[r], s1[r])); }
    mx = fmaxf(mx, __shfl_xor(mx, 16)); mx = fmaxf(mx, __shfl_xor(mx, 32));
    const float mnew = fmaxf(mrun, mx), alpha = __builtin_amdgcn_exp2f(mrun - mnew);
    float ls = 0.f; float pv[8];
#pragma unroll
    for (int r = 0; r < 4; ++r) { pv[r] = __builtin_amdgcn_exp2f(s0[r] - mnew); pv[4 + r] = __builtin_amdgcn_exp2f(s1[r] - mnew); ls += pv[r] + pv[4 + r]; }
    ls += __shfl_xor(ls, 16); ls += __shfl_xor(ls, 32);
    lrun = lrun * alpha + ls; mrun = mnew;
#pragma unroll
    for (int c = 0; c < 16; ++c) o[c] = o[c] * alpha;
    const v4u pbw = (v4u){cvt_pk_bf16(pv[0], pv[1]), cvt_pk_bf16(pv[2], pv[3]), cvt_pk_bf16(pv[4], pv[5]), cvt_pk_bf16(pv[6], pv[7])};
    const bf16x8 pb = __builtin_bit_cast(bf16x8, pbw);
#pragma unroll
    for (int c = 0; c < 16; ++c) { const unsigned ib = (c >> 3) * 8192, chc = 2 * (c & 7) + (p4 >> 1);
      const v4i16_t t0 = __builtin_amdgcn_ds_read_tr16_b64_v4i16((LAS v4i16_t*)(wl + ib + offb(4 * g + q4, chc) + 8 * (p4 & 1)));
      const v4i16_t t1 = __builtin_amdgcn_ds_read_tr16_b64_v4i16((LAS v4i16_t*)(wl + ib + offb(16 + 4 * g + q4, chc) + 8 * (p4 & 1)));
      const bf16x8 af = (bf16x8){t0[0], t0[1], t0[2], t0[3], t1[0], t1[1], t1[2], t1[3]};
      o[c] = __builtin_amdgcn_mfma_f32_16x16x32_bf16(af, pb, o[c], 0, 0, 0); }
    LDSW();
  }
  const float inv = 1.f / lrun;
  bf16_t* orow = olat + (size_t)(b * L + t) * 4096 + n16 * 256 + 4 * g;
#pragma unroll
  for (int c = 0; c < 16; ++c) { const f32x4 v = o[c] * inv; *(v2u*)(orow + 16 * c) = (v2u){cvt_pk_bf16(v[0], v[1]), cvt_pk_bf16(v[2], v[3])}; }
}

__device__ __forceinline__ void ph_select_attend(const float* sc, const bf16_t* qlat, const bf16_t* cnb, bf16_t* olat, LAS unsigned char* lds) {
  const int tid = TIDX(), lane = tid & 63, wave = __builtin_amdgcn_readfirstlane(tid >> 6), blk = BIDX();
  LAS unsigned char* wl = lds + wave * DW_STRIDE; LAS unsigned short* idx16 = (LAS unsigned short*)(wl + 16384);
  const int b = blk & 1, wb = (blk >> 1) * 8 + wave, nwb = ((int)gridDim.x >> 1) * 8;
#pragma unroll 1
  for (int t = wb; t < L; t += nwb) {
    int lane_s = lane; asm volatile("" : "+v"(lane_s));
    const int cnt = wave_select(sc + (size_t)(b * L + t) * L, t, wl, idx16, lane_s);
    int lane_a = lane; asm volatile("" : "+v"(lane_a));
    wave_attend(b, t, cnt, qlat, cnb, wl, idx16, olat, lane_a);
  }
}

namespace pg8 {
struct GroupAOrder {
    StaticOrder so; int png; size_t acol_bytes;
    __device__ void init(const void* A, int lda, const void* Bt, int ldb, int M, int N, int png_, size_t acol_bytes_, int G, int c) { so.init(A, lda, Bt, ldb, M, N, G, c); png = png_; acol_bytes = acol_bytes_; }
    __device__ bool next(int i, Unit& u) const { int pm, pn; if (!so.tile(i, pm, pn)) return false; u.pa = so.A + (size_t)pm * so.ta + (size_t)(pn / png) * acol_bytes; u.pb = so.Bt + (size_t)pn * so.tb; u.orow = pm * BM; u.ocol = pn * BM; u.e = 0; return true; }
    __device__ __forceinline__ void a_ready(const Unit&) const {}
    __device__ __forceinline__ void done(const Unit&) const {}
};
}
#ifndef PROBE
#define PROBE 0
#endif
#ifndef PROBE_S
#define PROBE_S 10.0f
#endif
constexpr size_t MiB = 1u << 20;
constexpr size_t WS_CTL = 0, CTL_ZERO_BYTES = 1 * MiB;
constexpr int CW_BAR = 4096;
constexpr size_t WS_NEEDED = 2048 * MiB;

struct Args { In in; float* out; unsigned char* ws; };

struct Opt { bf16_t *Wql_t, *Wuv_t, *cnb, *qlat, *olat; float* sc; bf16_t *xb, *WA_t, *WoutA_t, *WB_t, *WoutB_t, *W1_t, *W2_t, *projA_b, *hbf, *o2b, *xs, *act, *Ys, *projB_b; MoeBufs m; };
__device__ __forceinline__ nvp::Ws carve_ws(unsigned char* ws) {
  nvp::Ws w; auto at = [&](size_t mib) { return (char*)ws + mib * MiB; };
  w.projA = (float*)at(2); w.cn = (float*)at(119); w.sc = (float*)at(135); w.idx = (int*)at(647); w.o2 = (float*)at(663);
  w.x1 = (float*)at(727); w.x2 = (float*)at(791);
  w.projB = (float*)at(135); w.adec = (float*)at(135 + 194); w.og = (float*)at(135 + 194 + 32); w.on = (float*)at(135 + 194 + 32 + 64);
  w.counts = nullptr; w.h = nullptr; w.hb = nullptr; w.ys = nullptr; w.tok_e = nullptr; w.tok_g = nullptr; w.slot_of = nullptr; w.row_tok = nullptr; w.row_gate = nullptr; w.blk_e = nullptr;
  return w;
}
__device__ __forceinline__ Opt carve_opt(unsigned char* ws) {
  Opt o; auto at = [&](size_t mib) { return (bf16_t*)((char*)ws + mib * MiB); };
  char* sm = (char*)ws + 855 * MiB;
  o.m.tok_e = (int*)sm; o.m.tok_g = (float*)(sm + 256 * 1024); o.m.slot_of = (int*)(sm + 512 * 1024); o.m.slot_gate = (float*)(sm + 768 * 1024); o.m.blk_e = (int*)(sm + 1088 * 1024); o.m.blkcnt = (int*)(sm + 1096 * 1024); o.m.nblk = (int*)(sm + 1160 * 1024);
  o.WA_t = at(860); o.WoutA_t = at(864); o.WB_t = at(866); o.WoutB_t = at(873);
  o.Wql_t = at(875); o.Wuv_t = at(877); o.olat = at(2); o.cnb = at(647); o.qlat = at(1856); o.sc = (float*)at(135);
  o.W1_t = at(880); o.W2_t = at(1136);
  o.xb = at(1264); o.projA_b = at(1296); o.hbf = at(1360); o.o2b = at(1392);
  o.xs = at(1424); o.act = at(1568); o.Ys = at(1712); o.projB_b = at(1856);
  return o;
}

struct ProIn { const float *a_w_uk, *a_w_uv, *x, *a_w_in, *a_w_out, *b_w_in, *b_w_g2, *b_w_out, *m_w1, *m_w2; };
__device__ __forceinline__ void ph_prologue(const ProIn I, const Opt& o) {
  const int tid = TIDX(), lane = tid & 63, gw = BIDX() * 8 + (tid >> 6), NGW = (int)gridDim.x * 8, gtid = BIDX() * NTHR + tid, NGT = (int)gridDim.x * NTHR;
  cvt_f32_to_bf16(I.x, D, o.xb, D, NT, D, gtid, NGT);
  zero_rect(o.WA_t, D, DINA, 2048 - DINA, 0, D * 2, gtid, NGT);
  for (int i = gtid; i < 512 * 256; i += NGT) { const int n = i >> 8, k4 = (i & 255) * 4; float a[4];
#pragma unroll
    for (int z = 0; z < 4; ++z) { const float* gl = I.b_w_in + (size_t)(k4 + z) * DINB + 2048; float s = 0.f;
#pragma unroll
      for (int j = 0; j < 16; ++j) s = fmaf(gl[j], I.b_w_g2[j * 512 + n], s);
      a[z] = s; }
    *(v2u*)(o.WB_t + (size_t)(3072 + n) * D + k4) = (v2u){cvt_pk_bf16(a[0], a[1]), cvt_pk_bf16(a[2], a[3])}; }
  int w0 = 0;
#pragma unroll 1
  for (int h = 0; h < 16; ++h) {
    transpose_job(mk_tjob(I.a_w_uk + (size_t)h * 64 * 256, 256, 64, 256, o.Wql_t, 256, h * 256, (h & 3) * 64, 0), w0, gw, NGW, lane);
    transpose_job(mk_tjob(I.a_w_uv + (size_t)h * 256 * 64, 64, 256, 64, o.Wuv_t, 1024, h * 64, (h & 3) * 256, 0), w0, gw, NGW, lane);
    for (int hp = 0; hp < 4; ++hp) if (hp != (h & 3)) { zero_rect(o.Wql_t, 256, h * 256, 256, hp * 128, 128, gtid, NGT); zero_rect(o.Wuv_t, 1024, h * 64, 64, hp * 512, 512, gtid, NGT); }
  }
  transpose_job(mk_tjob(I.a_w_in, DINA, D, DINA, o.WA_t, D, 0, 0, 0), w0, gw, NGW, lane);
  transpose_job(mk_tjob(I.a_w_out, D, D, D, o.WoutA_t, D, 0, 0, 0), w0, gw, NGW, lane);
  transpose_job(mk_tjob(I.b_w_in, DINB, D, 2048, o.WB_t, D, 0, 0, 0), w0, gw, NGW, lane);
  transpose_job(mk_tjob(I.b_w_in + 2064, DINB, D, 1024, o.WB_t, D, 2048, 0, 0), w0, gw, NGW, lane);
  transpose_job(mk_tjob(I.b_w_out, D, D, D, o.WoutB_t, D, 0, 0, 0), w0, gw, NGW, lane);
#pragma unroll 1
  for (int le = 0; le < 64; ++le) transpose_job(mk_tjob(I.m_w1 + (size_t)le * D * 2048, 2048, D, 2048, o.W1_t + (size_t)le * 2048 * D, D, 0, 0, 1), w0, gw, NGW, lane);
#pragma unroll 1
  for (int le = 0; le < 64; ++le) transpose_job(mk_tjob(I.m_w2 + (size_t)le * D * D, D, D, D, o.W2_t + (size_t)le * D * D, D, 0, 0, 0), w0, gw, NGW, lane);
}
__device__ __forceinline__ void ph_gla_shim(const bf16_t* pb, const float* gbias, float* projB, float* adec) {
  const int gtid = BIDX() * NTHR + TIDX(), NGT = (int)gridDim.x * NTHR;
  for (size_t i = gtid; i < (size_t)NT * 896; i += NGT) { const size_t r = i / 896; const int c = (int)(i % 896) * 4; const v2u v = *(const v2u*)(pb + r * 3584 + c);
    const f32x4 f = (f32x4){bf_lo(v[0]), bf_hi(v[0]), bf_lo(v[1]), bf_hi(v[1])};
    if (c < 2048) *(f32x4*)(projB + r * DINB + c) = f;
    else if (c < 3072) *(f32x4*)(projB + r * DINB + 2064 + (c - 2048)) = f;
    else { f32x4 o;
#pragma unroll
      for (int z = 0; z < 4; ++z) { const float a = f[z] + gbias[c - 3072 + z]; const float ls = fminf(a, 0.f) - log1pf(expf(-fabsf(a))); o[z] = expf(ls * (1.f / 16.f)); }
      *(f32x4*)(adec + r * 512 + (c - 3072)) = o; } }
}

#define LAYER_BODY(li) \
    if (li == 1) { \
      PH_BEGIN StaticOrder S; S.init(o.xb, D, o.WB_t, D, NT, 3584, G_, BIDX()); gemm_phase<EpiStore, StaticOrder, true, true>(ll, Gemm{D, D, D}, S, EpiStore{o.projB_b, 3584}); PH_END \
      GRID_BAR(); \
      PH_BEGIN ph_gla_shim(o.projB_b, I.b_g_bias, w.projB, w.adec); PH_END \
      GRID_BAR(); \
      PH_BEGIN nvp::np_gla_scan(w.projB, w.adec, w.og, fl); PH_END \
      GRID_BAR(); \
      PH_BEGIN nvp::np_gla_norm(w.og, w.projB, I.b_norm, w.on); PH_END \
      GRID_BAR(); \
      PH_BEGIN cvt_f32_to_bf16(w.on, D, o.o2b, D, NT, D, gtid_, NGT_); PH_END \
      GRID_BAR(); \
      PH_BEGIN StaticOrder S; S.init(o.o2b, D, o.WoutB_t, D, NT, D, G_, BIDX()); gemm_phase<EpiStore, StaticOrder, true, true>(ll, Gemm{D, D, D}, S, EpiStore{o.hbf, D}); PH_END \
      GRID_BAR(); \
    } \
    PH_BEGIN ph_ln_router(li == 0 ? I.x : w.x2, o.hbf, I.ln1_g + li * D, I.ln1_b + li * D, I.m_w_router + (size_t)li * D * 32, I.m_b_router + li * 32, w.x1, o.m, fl); PH_END \
    GRID_BAR(); \
    PH_BEGIN ph_moe_scatter(w.x1, o.xs, o.m, (int*)lds); PH_END \
    GRID_BAR(); \
    PH_BEGIN MoeOrder S; S.init(o.xs, D, o.W1_t + (size_t)li * 32 * 2048 * D, D, (size_t)2048 * D * 2, __builtin_amdgcn_readfirstlane(*o.m.nblk), 8, 128, o.m.blk_e, G_, BIDX()); \
      gemm_phase<pg8::EpiSwiglu, MoeOrder, true, true>(ll, Gemm{D, D, D}, S, pg8::EpiSwiglu{o.act, D, I.m_b1 + (size_t)li * 32 * 2048}); PH_END \
    GRID_BAR(); \
    PH_BEGIN MoeOrder S; S.init(o.act, D, o.W2_t + (size_t)li * 32 * D * D, D, (size_t)D * D * 2, __builtin_amdgcn_readfirstlane(*o.m.nblk), 4, 256, o.m.blk_e, G_, BIDX()); \
      gemm_phase<pg8::EpiMoe2, MoeOrder, true, true>(ll, Gemm{D, D, D}, S, pg8::EpiMoe2{o.Ys, D, I.m_b2 + (size_t)li * 32 * D, o.m.slot_gate}); PH_END \
    GRID_BAR(); \
    PH_BEGIN ph_combine_ln(w.x1, o.Ys, o.m.slot_of, I.ln2_g + li * D, I.ln2_b + li * D, li == 0 ? w.x2 : out_, li == 0 ? o.xb : nullptr); PH_END \
    if (li == 0) GRID_BAR();
__global__ void __launch_bounds__(NTHR, 2) mk_fwd(Args args) {
  extern __shared__ __attribute__((aligned(16))) unsigned char lds[];
  volatile LAS unsigned* MISC = (volatile LAS unsigned*)((LAS unsigned char*)lds + MISC_OFF);
  if (threadIdx.x < 32) MISC[threadIdx.x] = 0u;
  __syncthreads();
  XcdBarrier bar; { const __attribute__((address_space(4))) Args* ka0 = (const __attribute__((address_space(4))) Args*)__builtin_amdgcn_kernarg_segment_ptr(); bar = xcd_barrier_post((unsigned*)(ka0->ws + WS_CTL) + CW_BAR, MISC + 8); }
#define GRID_BAR() xcd_barrier(bar)
#define PH_BEGIN { const __attribute__((address_space(4))) Args* ka_ = (const __attribute__((address_space(4))) Args*)__builtin_amdgcn_kernarg_segment_ptr(); asm volatile("" : "+s"(ka_)); \
    float* const out_ = ka_->out; (void)out_; unsigned char* wsb_ = ka_->ws; const nvp::Ws w = carve_ws(wsb_); (void)w; const Opt o = carve_opt(wsb_); (void)o; \
    const int gtid_ = BIDX() * NTHR + TIDX(), NGT_ = (int)gridDim.x * NTHR; (void)gtid_; (void)NGT_; const int G_ = (int)gridDim.x; (void)G_;
#define PH_END }
#define I (ka_->in)
  float* fl = (float*)lds; LAS unsigned char* ll = (LAS unsigned char*)lds;
  using pg8::gemm_phase; using pg8::StaticOrder; using pg8::MoeOrder; using pg8::Gemm; using pg8::EpiStore;
  PH_BEGIN ph_prologue(ProIn{I.a_w_uk, I.a_w_uv, I.x, I.a_w_in, I.a_w_out, I.b_w_in, I.b_w_g2, I.b_w_out, I.m_w1, I.m_w2}, o); PH_END
  GRID_BAR();
  PH_BEGIN StaticOrder S; S.init(o.xb, D, o.WA_t, D, NT, 2048, G_, BIDX()); gemm_phase<EpiStore, StaticOrder, true, true>(ll, Gemm{D, D, D}, S, EpiStore{o.projA_b, 2048}); PH_END
  GRID_BAR();
  PH_BEGIN ph_cnorm_b(o.projA_b, I.a_kv_norm, o.cnb); PH_END
  PH_BEGIN pg8::GroupAOrder S; S.init(o.projA_b, 2048, o.Wql_t, 256, NT, 4096, 4, 512, G_, BIDX()); gemm_phase<EpiStore, pg8::GroupAOrder, true, true>(ll, Gemm{2048, 256, 256}, S, EpiStore{o.qlat, 4096}); PH_END
  PH_BEGIN ph_iscore(o.projA_b, o.sc); PH_END
  GRID_BAR();
  PH_BEGIN ph_select_attend(o.sc, o.qlat, o.cnb, o.olat, ll); PH_END
  GRID_BAR();
  PH_BEGIN pg8::GroupAOrder S; S.init(o.olat, 4096, o.Wuv_t, 1024, NT, 1024, 1, 2048, G_, BIDX()); gemm_phase<EpiStore, pg8::GroupAOrder, true, true>(ll, Gemm{4096, 1024, 1024}, S, EpiStore{o.o2b, D}); PH_END
  GRID_BAR();
  PH_BEGIN StaticOrder S; S.init(o.o2b, D, o.WoutA_t, D, NT, D, G_, BIDX()); gemm_phase<EpiStore, StaticOrder, true, true>(ll, Gemm{D, D, D}, S, EpiStore{o.hbf, D}); PH_END
  GRID_BAR();
  { LAYER_BODY(0) }
  { LAYER_BODY(1) }
}

extern "C" void kernel_launch(void* const* d_in, const int* in_sizes, int n_in, void* d_out, int out_size, void* d_ws, size_t ws_size, hipStream_t stream) {
  static int grid = 0;
  if (grid == 0) {
    if (n_in != 21 || ws_size < WS_NEEDED) { fprintf(stderr, "kernel_launch: bad inputs (n_in %d) or workspace too small (%zu needed, %zu given)\n", n_in, (size_t)WS_NEEDED, ws_size); grid = -1; return; }
    int dev = 0, cus = 0, per_cu = 0;
    if (hipGetDevice(&dev) != hipSuccess || hipDeviceGetAttribute(&cus, hipDeviceAttributeMultiprocessorCount, dev) != hipSuccess) { grid = -1; return; }
    if (hipFuncSetAttribute((const void*)mk_fwd, hipFuncAttributeMaxDynamicSharedMemorySize, LDS_BYTES) != hipSuccess) { fprintf(stderr, "kernel_launch: hipFuncSetAttribute failed\n"); grid = -1; return; }
    if (hipOccupancyMaxActiveBlocksPerMultiprocessor(&per_cu, (const void*)mk_fwd, NTHR, LDS_BYTES) != hipSuccess || per_cu < 1) fprintf(stderr, "kernel_launch: note: occupancy query reports %d\n", per_cu);
    (void)hipGetLastError();
    grid = cus;
    if (grid != 256) fprintf(stderr, "kernel_launch: built for 256 CUs (token ownership per workgroup); got %d\n", grid);
  }
  if (grid < 0) return;
  if (hipMemsetAsync((char*)d_ws + WS_CTL, 0, CTL_ZERO_BYTES, stream) != hipSuccess) { fprintf(stderr, "kernel_launch: memset failed\n"); return; }
  Args a; memset(&a, 0, sizeof(a));
  const float** f = (const float**)&a.in;
  for (int i = 0; i < 21; ++i) f[i] = (const float*)d_in[i];
  a.out = (float*)d_out; a.ws = (unsigned char*)d_ws;
  hipLaunchKernelGGL(mk_fwd, dim3(grid), dim3(NTHR), LDS_BYTES, stream, a);
  const hipError_t le = hipPeekAtLastError();
  if (le != hipSuccess) fprintf(stderr, "kernel_launch: launch failed: %s\n", hipGetErrorName(le));
}
```

```cpp
#include <hip/hip_runtime.h>
#include <cstdio>
#include <cstdint>
#include <cstring>

#define GAS __attribute__((address_space(1)))
#define LAS __attribute__((address_space(3)))
#define NTHR 512
constexpr int LDS_BYTES = 147456;
constexpr int MISC_OFF = 131072 + 8192;

#define XB_TMO      128
#define XB_XCNT(j)  (256  + 64 * (j))
#define XB_XSUB(j)  (1280 + 64 * (j))
#define XB_XGEN(j)  (2304 + 64 * (j))
#define XB_TOP      3328
#define XB_TOPGEN   3392
#define XCD_BAR_WORDS 3456
#define XB_SPIN_CAP (1u << 25)
__device__ __forceinline__ unsigned xb_ld(unsigned* p)              { return __hip_atomic_load(p, __ATOMIC_RELAXED, __HIP_MEMORY_SCOPE_AGENT); }
__device__ __forceinline__ unsigned xb_add(unsigned* p, unsigned v) { return __hip_atomic_fetch_add(p, v, __ATOMIC_RELAXED, __HIP_MEMORY_SCOPE_AGENT); }
__device__ __forceinline__ unsigned xb_xcc_id() { return (unsigned)__builtin_amdgcn_s_getreg((3 << 11) | 20) & 0xFu; }
#define XB_SPIN(cond, bar) do { unsigned _sp = 0; while (cond) { __builtin_amdgcn_s_sleep(1); \
    if ((++_sp & 255u) == 0u) { if (xb_ld(&(bar)[XB_TMO])) break; if (_sp > XB_SPIN_CAP) { atomicAdd(&(bar)[XB_TMO], 1u); break; } } } } while (0)
struct XcdBarrier { unsigned* bar; unsigned x; volatile LAS unsigned* st; };
__device__ __forceinline__ XcdBarrier xcd_barrier_post(unsigned* bar, volatile LAS unsigned* st) {
    XcdBarrier b; b.bar = bar; b.x = xb_xcc_id(); b.st = st;
    if (threadIdx.x == 0) (void)xb_add(&bar[XB_XCNT(b.x)], 1u);
    return b;
}
__device__ __forceinline__ void xcd_barrier_complete(unsigned* bar, unsigned x, unsigned& nloc, unsigned& nx) {
    const unsigned G = gridDim.x * gridDim.y * gridDim.z;
    unsigned sum, cnt, mine, sp = 0u;
    for (;;) {
        sum = 0u; cnt = 0u; mine = 0u;
#pragma unroll
        for (unsigned j = 0; j < 16; ++j) { const unsigned c = xb_ld(&bar[XB_XCNT(j)]); sum += c; cnt += (c > 0u) ? 1u : 0u; mine = (j == x) ? c : mine; }
        if (sum == G) break;
        __builtin_amdgcn_s_sleep(1);
        if ((++sp & 255u) == 0u) { if (xb_ld(&bar[XB_TMO])) break; if (sp > XB_SPIN_CAP) { atomicAdd(&bar[XB_TMO], 1u); break; } }
    }
    nloc = mine > 0u ? mine : 1u; nx = cnt > 0u ? cnt : 1u;
}
__device__ __forceinline__ void xcd_barrier(const XcdBarrier& b) {
    asm volatile("s_waitcnt vmcnt(0)" ::: "memory");
    __syncthreads();
    if (threadIdx.x == 0) {
        unsigned* bar = b.bar;
        __builtin_amdgcn_s_waitcnt(0);
        unsigned nloc = b.st[0], nx = b.st[1];
        if (nloc == 0u) { xcd_barrier_complete(bar, b.x, nloc, nx); b.st[0] = nloc; b.st[1] = nx; }
        const unsigned old = xb_add(&bar[XB_XSUB(b.x)], 1u);
        const unsigned gen = old / nloc;
        if (old + 1u == (gen + 1u) * nloc) {
            __builtin_amdgcn_fence(__ATOMIC_RELEASE, "agent");
            asm volatile("s_waitcnt vmcnt(0)" ::: "memory");
            const unsigned og = xb_add(&bar[XB_TOP], 1u);
            const unsigned tg = og / nx;
            if (og + 1u == (tg + 1u) * nx) xb_add(&bar[XB_TOPGEN], 1u);
            else XB_SPIN(xb_ld(&bar[XB_TOPGEN]) == tg, bar);
            __builtin_amdgcn_fence(__ATOMIC_ACQUIRE, "agent");
            xb_add(&bar[XB_XGEN(b.x)], 1u);
            asm volatile("s_waitcnt vmcnt(0)" ::: "memory");
        } else {
            XB_SPIN(xb_ld(&bar[XB_XGEN(b.x)]) == gen, bar);
            __builtin_amdgcn_fence(__ATOMIC_ACQUIRE, "agent");
            asm volatile("s_waitcnt vmcnt(0)" ::: "memory");
        }
    }
    __syncthreads();
}

constexpr int NT = 16384, D = 1024, L = 8192, NB = 2;
constexpr int DINA = 1864, DINB = 3088;
constexpr int PMAX = 73728;
constexpr float ALPHA = 1.4142135623730951f;

struct In { const float *x, *a_w_in, *a_kv_norm, *a_w_uk, *a_w_uv, *a_w_out, *b_w_in, *b_w_g2, *b_g_bias, *b_norm, *b_w_out, *m_w_router, *m_b_router, *m_w1, *m_b1, *m_w2, *m_b2, *ln1_g, *ln1_b, *ln2_g, *ln2_b; };

__device__ __forceinline__ int TIDX() { int t = threadIdx.x; asm volatile("" : "+v"(t)); return t; }
__device__ __forceinline__ int BIDX() { int t = blockIdx.x; asm volatile("" : "+s"(t)); return t; }
__device__ __forceinline__ float wave_sum(float v) {
#pragma unroll
    for (int o = 1; o < 64; o <<= 1) v += __shfl_xor(v, o);
    return v;
}
namespace nvp {
#define WSYNC() asm volatile("s_waitcnt lgkmcnt(0)" ::: "memory")
struct GemmP {
  const float* A; int lda; const int* arow;
  const float* B; int ldb; float* C; int ldc; int M, N, K;
  const int* blk_e; const int* nblk_used; size_t bstride; const float* bias; size_t bias_stride;
};
__device__ __forceinline__ GemmP mkg(const float* A, int lda, const int* arow, const float* B, int ldb, float* C, int ldc, int M, int N, int K, const int* blk_e, const int* nblk_used, size_t bstride, const float* bias, size_t bias_stride) {
  GemmP p; p.A = A; p.lda = lda; p.arow = arow; p.B = B; p.ldb = ldb; p.C = C; p.ldc = ldc; p.M = M; p.N = N; p.K = K; p.blk_e = blk_e; p.nblk_used = nblk_used; p.bstride = bstride; p.bias = bias; p.bias_stride = bias_stride; return p; }

template <int MODE>
__device__ __forceinline__ void np_sgemm(const GemmP p, float* lds) {
  float (*As)[132] = (float (*)[132])lds;
  float (*Bs)[68] = (float (*)[68])(lds + 16 * 132);
  float (*Bu)[68] = (float (*)[68])(lds + 16 * 132 + 16 * 68);
  const int tid = TIDX(), tx = tid & 15, ty = tid >> 4;
  const int ntn = (p.N + 63) / 64, ntm = p.M / 128;
  const int ar = tid >> 2, ak = (tid & 3) * 4;
  const int bk = (tid & 255) >> 4, bn4 = (tid & 15) * 4;
  for (int t = BIDX(); t < ntm * ntn; t += gridDim.x) {
    const int bm = t / ntn, bn = t % ntn;
    const float* B = p.B; const float* bias = p.bias;
    if (MODE != 0) { const int blk = (bm * 128) / 256; if (blk >= *p.nblk_used) continue; const int e = p.blk_e[blk]; B += (size_t)e * p.bstride; bias += (size_t)e * p.bias_stride; }
    const int m0 = bm * 128, n0 = bn * 64;
    const int arow = p.arow ? p.arow[m0 + ar] : (m0 + ar);
    const float* Ap = p.A + (size_t)arow * p.lda + ak;
    const bool bok = (n0 + bn4) < p.N;
    float acc[4][4] = {}, accu[4][4] = {};
    for (int k0 = 0; k0 < p.K; k0 += 16) {
      const float4 av = *(const float4*)(Ap + k0);
      As[ak + 0][ar] = av.x; As[ak + 1][ar] = av.y; As[ak + 2][ar] = av.z; As[ak + 3][ar] = av.w;
      if (tid < 256) { float4 bv = make_float4(0.f, 0.f, 0.f, 0.f); if (bok) bv = *(const float4*)(B + (size_t)(k0 + bk) * p.ldb + n0 + bn4); *(float4*)&Bs[bk][bn4] = bv; }
      else if (MODE == 1) { const float4 uv = *(const float4*)(B + (size_t)(k0 + bk) * p.ldb + 1024 + n0 + bn4); *(float4*)&Bu[bk][bn4] = uv; }
      __syncthreads();
#pragma unroll
      for (int kk = 0; kk < 16; ++kk) {
        const float4 a = *(const float4*)&As[kk][ty * 4];
        const float4 b = *(const float4*)&Bs[kk][tx * 4];
        const float aa[4] = {a.x, a.y, a.z, a.w}, bb[4] = {b.x, b.y, b.z, b.w};
#pragma unroll
        for (int i = 0; i < 4; ++i)
#pragma unroll
          for (int j = 0; j < 4; ++j) acc[i][j] = fmaf(aa[i], bb[j], acc[i][j]);
        if (MODE == 1) {
          const float4 u = *(const float4*)&Bu[kk][tx * 4]; const float uu[4] = {u.x, u.y, u.z, u.w};
#pragma unroll
          for (int i = 0; i < 4; ++i)
#pragma unroll
            for (int j = 0; j < 4; ++j) accu[i][j] = fmaf(aa[i], uu[j], accu[i][j]);
        }
      }
      __syncthreads();
    }
#pragma unroll
    for (int i = 0; i < 4; ++i) {
      const int m = m0 + ty * 4 + i;
#pragma unroll
      for (int j = 0; j < 4; ++j) {
        const int n = n0 + tx * 4 + j; if (n >= p.N) continue;
        float v = acc[i][j];
        if (MODE == 1) {
          float g = v + bias[n], u = accu[i][j] + bias[1024 + n];
          g = fminf(g, 7.f); u = fminf(fmaxf(u, -7.f), 7.f);
          const float glu = g / (1.f + expf(-1.702f * g));
          v = (u + 1.f) * glu;
        } else if (MODE == 2) v += bias[n];
        p.C[(size_t)m * p.ldc + n] = v;
      }
    }
  }
}

#define GW_INIT const int lane = TIDX() & 63, wave = TIDX() >> 6, gw = BIDX() * 8 + wave, NGW = gridDim.x * 8; (void)lane; (void)wave; (void)gw; (void)NGW

__device__ __forceinline__ void np_cnorm(const float* projA, const float* g, float* cn) {
  GW_INIT;
  for (int row = gw; row < NT; row += NGW) {
    const float4 v = *(const float4*)(projA + (size_t)row * DINA + 1024 + lane * 4);
    const float ss = wave_sum(v.x * v.x + v.y * v.y + v.z * v.z + v.w * v.w);
    const float r = rsqrtf(ss * (1.f / 256.f) + 1e-6f); const float4 g4 = *(const float4*)(g + lane * 4);
    *(float4*)(cn + (size_t)row * 256 + lane * 4) = make_float4(v.x * r * g4.x, v.y * r * g4.y, v.z * r * g4.z, v.w * r * g4.w);
  }
}

__device__ __forceinline__ void np_iscore(const float* projA, float* sc, float* lds) {
  float (*As)[132] = (float (*)[132])lds;
  float (*Bs)[68] = (float (*)[68])(lds + 16 * 132);
  const int tid = TIDX(), tx = tid & 15, ty = tid >> 4;
  const int ar = tid >> 2, ak = (tid & 3) * 4;
  const int br = (tid & 255) >> 2;
  for (int u = BIDX(); u < NB * 64 * 128; u += gridDim.x) {
    const int b = u / (64 * 128), tt = (u / 128) % 64, st = u % 128;
    if (st > 2 * tt + 1) continue;
    const int t0 = tt * 128, s0 = st * 64;
    const float* Qp = projA + (size_t)(b * L + t0 + ar) * DINA + 1280 + ak;
    const float* Kp = projA + (size_t)(b * L + s0 + br) * DINA + 1792 + ak;
    float score[4][4] = {};
    for (int h = 0; h < 8; ++h) {
      float acc[4][4] = {};
      for (int k0 = 0; k0 < 64; k0 += 16) {
        const float4 av = *(const float4*)(Qp + h * 64 + k0);
        As[ak + 0][ar] = av.x; As[ak + 1][ar] = av.y; As[ak + 2][ar] = av.z; As[ak + 3][ar] = av.w;
        if (tid < 256) { const float4 bv = *(const float4*)(Kp + k0); Bs[ak + 0][br] = bv.x; Bs[ak + 1][br] = bv.y; Bs[ak + 2][br] = bv.z; Bs[ak + 3][br] = bv.w; }
        __syncthreads();
#pragma unroll
        for (int kk = 0; kk < 16; ++kk) {
          const float4 a = *(const float4*)&As[kk][ty * 4]; const float4 bq = *(const float4*)&Bs[kk][tx * 4];
          const float aa[4] = {a.x, a.y, a.z, a.w}, bb[4] = {bq.x, bq.y, bq.z, bq.w};
#pragma unroll
          for (int i = 0; i < 4; ++i)
#pragma unroll
            for (int j = 0; j < 4; ++j) acc[i][j] = fmaf(aa[i], bb[j], acc[i][j]);
        }
        __syncthreads();
      }
#pragma unroll
      for (int i = 0; i < 4; ++i) {
        const float w = projA[(size_t)(b * L + t0 + ty * 4 + i) * DINA + 1856 + h] * 0.35355339059327373f;
#pragma unroll
        for (int j = 0; j < 4; ++j) score[i][j] += w * fmaxf(acc[i][j] * 0.125f, 0.f);
      }
    }
#pragma unroll
    for (int i = 0; i < 4; ++i)
#pragma unroll
      for (int j = 0; j < 4; ++j) sc[((size_t)(b * L + t0 + ty * 4 + i)) * L + s0 + tx * 4 + j] = score[i][j];
  }
}

__device__ __forceinline__ unsigned f2key(float f) { f = f + 0.0f; const unsigned u = __float_as_uint(f); return (u & 0x80000000u) ? ~u : (u | 0x80000000u); }

__device__ __forceinline__ void np_topk(const float* sc, int* idx_out, char* lds) {
  GW_INIT;
  unsigned* hist = (unsigned*)(lds + wave * 1280); unsigned* cntw = hist + 256;
  for (int row = gw; row < NT; row += NGW) {
    const int t = row % L, n = t + 1;
    const float* s = sc + (size_t)row * L; int* out = idx_out + (size_t)row * 256;
    if (n <= 256) { for (int i = lane; i < 256; i += 64) out[i] = i < n ? i : -1; continue; }
    unsigned prefix = 0, need = 256;
    for (int pass = 3; pass >= 0; --pass) {
      const int shift = pass * 8;
      for (int i = lane; i < 256; i += 64) hist[i] = 0;
      WSYNC();
      for (int i = lane; i < n; i += 64) { const unsigned k = f2key(s[i]); const bool m = (pass == 3) || ((k >> (shift + 8)) == (prefix >> (shift + 8))); if (m) atomicAdd(&hist[(k >> shift) & 255u], 1u); }
      WSYNC();
      unsigned cum = 0; int d = 255; for (; d > 0; --d) { const unsigned hv = hist[d]; if (cum + hv >= need) break; cum += hv; }
      prefix |= ((unsigned)d << shift); need -= cum;
      WSYNC();
    }
    if (lane == 0) *cntw = 0; WSYNC();
    for (int i = lane; i < n; i += 64) { if (f2key(s[i]) > prefix) { const unsigned pos = atomicAdd(cntw, 1u); out[pos] = i; } }
    WSYNC();
    if (lane == 0) { unsigned c = *cntw; unsigned nd = need; for (int i = 0; i < n && nd > 0; ++i) if (f2key(s[i]) == prefix) { out[c++] = i; --nd; } }
    WSYNC();
  }
}

__device__ __forceinline__ void np_dsa_attn(const float* projA, const float* cn, const int* idx, const float* w_uk, const float* w_uv, float* o2, float* lds) {
  const int half = TIDX() >> 8, tid = TIDX() & 255;
  float* base = lds + half * 14336;
  float* qs = base; float (*ql)[256] = (float (*)[256])(base + 1024); float (*pr)[257] = (float (*)[257])(base + 1024 + 4096);
  float (*ol)[256] = (float (*)[256])(base + 1024 + 4096 + 4112); float* red = base + 1024 + 4096 + 4112 + 4096; int* sid = (int*)(red + 16);
  for (int r0 = BIDX() * 2; r0 < NT; r0 += gridDim.x * 2) {
    const int row = r0 + half, b = row / L;
    __syncthreads();
    for (int i = tid; i < 1024; i += 256) qs[i] = projA[(size_t)row * DINA + i];
    sid[tid] = idx[(size_t)row * 256 + tid];
    __syncthreads();
    { const int c = tid;
#pragma unroll 1
      for (int h = 0; h < 16; ++h) { float a = 0.f;
#pragma unroll 8
        for (int d = 0; d < 64; ++d) a = fmaf(qs[h * 64 + d], w_uk[((size_t)h * 64 + d) * 256 + c], a); ql[h][c] = a; } }
    __syncthreads();
    { const int k = tid, key = sid[k];
      float lg[16];
      if (key >= 0) { const float* cr = cn + (size_t)(b * L + key) * 256;
        for (int h = 0; h < 16; ++h) lg[h] = 0.f;
#pragma unroll 2
        for (int c = 0; c < 256; ++c) { const float cv = cr[c];
#pragma unroll
          for (int h = 0; h < 16; ++h) lg[h] = fmaf(ql[h][c], cv, lg[h]); }
#pragma unroll
        for (int h = 0; h < 16; ++h) pr[h][k] = lg[h] * 0.125f;
      } else {
#pragma unroll
        for (int h = 0; h < 16; ++h) pr[h][k] = -INFINITY; } }
    __syncthreads();
    if (tid < 16) { const int h = tid; float m = -INFINITY; for (int k = 0; k < 256; ++k) m = fmaxf(m, pr[h][k]); float su = 0.f; for (int k = 0; k < 256; ++k) { const float e = expf(pr[h][k] - m); pr[h][k] = e; su += e; } red[h] = 1.f / su; }
    __syncthreads();
    { const int c = tid; float a[16];
#pragma unroll
      for (int h = 0; h < 16; ++h) a[h] = 0.f;
#pragma unroll 2
      for (int k = 0; k < 256; ++k) { const int key = sid[k]; if (key < 0) continue; const float cv = cn[(size_t)(b * L + key) * 256 + c];
#pragma unroll
        for (int h = 0; h < 16; ++h) a[h] = fmaf(pr[h][k], cv, a[h]); }
#pragma unroll
      for (int h = 0; h < 16; ++h) ol[h][c] = a[h] * red[h]; }
    __syncthreads();
#pragma unroll 1
    for (int o = tid; o < 1024; o += 256) { const int h = o >> 6, v = o & 63; float a = 0.f;
#pragma unroll 8
      for (int c = 0; c < 256; ++c) a = fmaf(ol[h][c], w_uv[((size_t)h * 256 + c) * 64 + v], a); o2[(size_t)row * 1024 + o] = a; }
  }
  __syncthreads();
}

__device__ __forceinline__ void np_ln_res(const float* x, const float* h, const float* g, const float* bb, float* out) {
  GW_INIT;
  for (int row = gw; row < NT; row += NGW) {
    float4 v[4]; float s = 0.f;
#pragma unroll
    for (int j = 0; j < 4; ++j) { const float4 a = *(const float4*)(x + (size_t)row * D + lane * 4 + 256 * j), hh = *(const float4*)(h + (size_t)row * D + lane * 4 + 256 * j);
      v[j] = make_float4(ALPHA * a.x + hh.x, ALPHA * a.y + hh.y, ALPHA * a.z + hh.z, ALPHA * a.w + hh.w); s += (v[j].x + v[j].y) + (v[j].z + v[j].w); }
    const float mu = wave_sum(s) * (1.f / D); float q = 0.f;
#pragma unroll
    for (int j = 0; j < 4; ++j) { v[j].x -= mu; v[j].y -= mu; v[j].z -= mu; v[j].w -= mu; q += (v[j].x * v[j].x + v[j].y * v[j].y) + (v[j].z * v[j].z + v[j].w * v[j].w); }
    const float r = rsqrtf(wave_sum(q) * (1.f / D) + 1e-5f);
#pragma unroll
    for (int j = 0; j < 4; ++j) { const int c = lane * 4 + 256 * j; const float4 g4 = *(const float4*)(g + c), b4 = *(const float4*)(bb + c);
      *(float4*)(out + (size_t)row * D + c) = make_float4(v[j].x * r * g4.x + b4.x, v[j].y * r * g4.y + b4.y, v[j].z * r * g4.z + b4.z, v[j].w * r * g4.w + b4.w); }
  }
}

__device__ __forceinline__ void np_router(const float* x, const float* wr, const float* br, int* tok_e, float* tok_g, int* counts, int* row_tok, char* lds) {
  GW_INIT;
  for (int i = BIDX() * NTHR + TIDX(); i < PMAX; i += gridDim.x * NTHR) row_tok[i] = 0;
  float* lg = (float*)(lds + wave * 256);
  const int e = lane & 31, hf = lane >> 5;
  for (int tok = gw; tok < NT; tok += NGW) {
    const float* xr = x + (size_t)tok * D + hf * 512; const float* wp = wr + (size_t)hf * 512 * 32 + e; float a = 0.f;
#pragma unroll 8
    for (int d = 0; d < 512; ++d) a = fmaf(xr[d], wp[d * 32], a);
    a += __shfl_xor(a, 32);
    if (hf == 0) lg[e] = a + br[e];
    WSYNC();
    if (lane == 0) { int ei[4]; float ev[4];
      for (int k = 0; k < 4; ++k) { int bi = 0; float bv = -INFINITY; for (int j = 0; j < 32; ++j) if (lg[j] > bv) { bv = lg[j]; bi = j; } ei[k] = bi; ev[k] = bv; lg[bi] = -INFINITY; }
      float su = 0.f, ex[4]; for (int k = 0; k < 4; ++k) { ex[k] = expf(ev[k] - ev[0]); su += ex[k]; }
      for (int k = 0; k < 4; ++k) { tok_e[tok * 4 + k] = ei[k]; tok_g[tok * 4 + k] = ex[k] / su; atomicAdd(&counts[ei[k]], 1); } }
    WSYNC();
  }
}
__device__ __forceinline__ void np_moe_sort(const int* tok_e, const float* tok_g, const int* counts, int* row_tok, float* row_gate, int* slot_of, int* blk_e, int* nblk_used, char* lds) {
  if (BIDX() != 0) return;
  const int e = TIDX(); int* pstart = (int*)lds; int* stage = pstart + 64;
  if (e == 0) { int acc = 0; for (int j = 0; j < 32; ++j) { pstart[j] = acc; const int nb = (counts[j] + 255) / 256; for (int q = 0; q < nb; ++q) blk_e[acc / 256 + q] = j; acc += nb * 256; } pstart[32] = acc; *nblk_used = acc / 256; }
  __syncthreads();
  int pos = e < 32 ? pstart[e] : 0;
  for (int c0 = 0; c0 < NT * 4; c0 += 2048) {
    __syncthreads();
    for (int i = e; i < 2048; i += NTHR) stage[i] = tok_e[c0 + i];
    __syncthreads();
    if (e < 32) for (int i = 0; i < 2048; ++i) if (stage[i] == e) { const int gi = c0 + i; row_tok[pos] = gi >> 2; row_gate[pos] = tok_g[gi]; slot_of[gi] = pos; ++pos; }
  }
  __syncthreads();
}
__device__ __forceinline__ void np_moe_combine_ln(const float* x1, const float* ys, const int* slot_of, const float* tok_g, const float* g, const float* bb, float* out) {
  GW_INIT;
  for (int row = gw; row < NT; row += NGW) {
    float4 v[4]; float s = 0.f; int sl[4]; float gg[4];
#pragma unroll
    for (int k = 0; k < 4; ++k) { sl[k] = slot_of[row * 4 + k]; gg[k] = tok_g[row * 4 + k]; }
#pragma unroll
    for (int j = 0; j < 4; ++j) { const int c = lane * 4 + 256 * j; float4 f = make_float4(0.f, 0.f, 0.f, 0.f);
#pragma unroll
      for (int k = 0; k < 4; ++k) { const float4 y = *(const float4*)(ys + (size_t)sl[k] * D + c); f.x += gg[k] * y.x; f.y += gg[k] * y.y; f.z += gg[k] * y.z; f.w += gg[k] * y.w; }
      const float4 a = *(const float4*)(x1 + (size_t)row * D + c);
      v[j] = make_float4(ALPHA * a.x + f.x, ALPHA * a.y + f.y, ALPHA * a.z + f.z, ALPHA * a.w + f.w); s += (v[j].x + v[j].y) + (v[j].z + v[j].w); }
    const float mu = wave_sum(s) * (1.f / D); float q = 0.f;
#pragma unroll
    for (int j = 0; j < 4; ++j) { v[j].x -= mu; v[j].y -= mu; v[j].z -= mu; v[j].w -= mu; q += (v[j].x * v[j].x + v[j].y * v[j].y) + (v[j].z * v[j].z + v[j].w * v[j].w); }
    const float r = rsqrtf(wave_sum(q) * (1.f / D) + 1e-5f);
#pragma unroll
    for (int j = 0; j < 4; ++j) { const int c = lane * 4 + 256 * j; const float4 g4 = *(const float4*)(g + c), b4 = *(const float4*)(bb + c);
      *(float4*)(out + (size_t)row * D + c) = make_float4(v[j].x * r * g4.x + b4.x, v[j].y * r * g4.y + b4.y, v[j].z * r * g4.z + b4.z, v[j].w * r * g4.w + b4.w); }
  }
}

__device__ __forceinline__ void np_gla_gate(const float* projB, const float* w_g2, const float* gb, float* adec) {
  GW_INIT;
  for (int row = gw; row < NT; row += NGW) {
    float glr[16];
#pragma unroll
    for (int j = 0; j < 16; ++j) glr[j] = projB[(size_t)row * DINB + 2048 + j];
    for (int c = lane; c < 512; c += 64) { float a = gb[c];
#pragma unroll
      for (int j = 0; j < 16; ++j) a = fmaf(glr[j], w_g2[j * 512 + c], a);
      const float ls = fminf(a, 0.f) - log1pf(expf(-fabsf(a))); adec[(size_t)row * 512 + c] = expf(ls * (1.f / 16.f)); }
  }
}
__device__ __forceinline__ void np_gla_scan(const float* projB, const float* adec, float* og, float* lds) {
  if (BIDX() >= 8) return;
  const int b = BIDX() >> 2, h = BIDX() & 3, tid = TIDX(), dv = tid & 255, dh = tid >> 8;
  float (*qs)[128] = (float (*)[128])lds; float (*ks)[128] = (float (*)[128])(lds + 2048); float (*as)[128] = (float (*)[128])(lds + 4096);
  float (*po)[16][256] = (float (*)[16][256])(lds + 6144);
  float S[64];
#pragma unroll
  for (int d = 0; d < 64; ++d) S[d] = 0.f;
  for (int t0 = 0; t0 < L; t0 += 16) {
    __syncthreads();
    for (int i = tid; i < 16 * 128; i += NTHR) { const int tt = i >> 7, d = i & 127; const size_t r = (size_t)(b * L + t0 + tt);
      qs[tt][d] = projB[r * DINB + h * 128 + d] * 0.08838834764831845f; ks[tt][d] = projB[r * DINB + 512 + h * 128 + d]; as[tt][d] = adec[r * 512 + h * 128 + d]; }
    __syncthreads();
#pragma unroll 1
    for (int tt = 0; tt < 16; ++tt) { const size_t r = (size_t)(b * L + t0 + tt); const float v = projB[r * DINB + 1024 + h * 256 + dv]; float o = 0.f;
#pragma unroll
      for (int d = 0; d < 64; ++d) { S[d] = fmaf(as[tt][dh * 64 + d], S[d], ks[tt][dh * 64 + d] * v); o = fmaf(qs[tt][dh * 64 + d], S[d], o); }
      po[dh][tt][dv] = o; }
    __syncthreads();
    for (int i = tid; i < 16 * 256; i += NTHR) { const int tt = i >> 8, c = i & 255; og[(size_t)(b * L + t0 + tt) * 1024 + h * 256 + c] = po[0][tt][c] + po[1][tt][c]; }
  }
  __syncthreads();
}
__device__ __forceinline__ void np_gla_norm(const float* og, const float* projB, const float* ng, float* on) {
  GW_INIT;
  for (int u = gw; u < NT * 4; u += NGW) {
    const int row = u >> 2, h = u & 3; const int c = h * 256 + lane * 4;
    const float4 v = *(const float4*)(og + (size_t)row * 1024 + c);
    const float r = rsqrtf(wave_sum(v.x * v.x + v.y * v.y + v.z * v.z + v.w * v.w) * (1.f / 256.f) + 1e-6f);
    const float4 rr = *(const float4*)(projB + (size_t)row * DINB + 2064 + c), g4 = *(const float4*)(ng + c);
    *(float4*)(on + (size_t)row * 1024 + c) = make_float4(v.x * r * g4.x * (rr.x / (1.f + expf(-rr.x))), v.y * r * g4.y * (rr.y / (1.f + expf(-rr.y))), v.z * r * g4.z * (rr.z / (1.f + expf(-rr.z))), v.w * r * g4.w * (rr.w / (1.f + expf(-rr.w))));
  }
}

struct Ws { float *projA, *cn, *sc, *o2, *h, *x1, *x2, *hb, *ys, *projB, *adec, *og, *on, *tok_g, *row_gate; int *idx, *tok_e, *slot_of, *row_tok, *blk_e, *counts; };
}
typedef unsigned short bf16_t;
typedef unsigned v4u __attribute__((ext_vector_type(4)));
typedef unsigned v2u __attribute__((ext_vector_type(2)));
typedef float f32x4 __attribute__((ext_vector_type(4)));
typedef short bf16x8 __attribute__((ext_vector_type(8)));
typedef float f32x2_t __attribute__((ext_vector_type(2))); typedef __bf16 bf16x2_t __attribute__((ext_vector_type(2)));
__device__ __forceinline__ unsigned cvt_pk_bf16(float lo, float hi) { const f32x2_t v = {lo, hi}; const bf16x2_t b = __builtin_convertvector(v, bf16x2_t); return __builtin_bit_cast(unsigned, b); }
__device__ __forceinline__ float bf_lo(unsigned u) { return __uint_as_float(u << 16); }
__device__ __forceinline__ float bf_hi(unsigned u) { return __uint_as_float(u & 0xffff0000u); }
__device__ __forceinline__ float bf2f(bf16_t h) { return __uint_as_float(((unsigned)h) << 16); }

struct TJob { const float* src; int lds_; int K, N; bf16_t* dst; int ldd; int drow0, dcol0; int rowmap; int ntk, ntn; };
__device__ __forceinline__ TJob mk_tjob(const float* src, int lds_, int K, int N, bf16_t* dst, int ldd, int drow0, int dcol0, int rowmap) {
  TJob j; j.src = src; j.lds_ = lds_; j.K = K; j.N = N; j.dst = dst; j.ldd = ldd; j.drow0 = drow0; j.dcol0 = dcol0; j.rowmap = rowmap; j.ntk = K / 64; j.ntn = (N + 127) / 128; return j; }
__device__ __forceinline__ int tjob_tiles(const TJob& j) { return j.ntk * j.ntn; }
__device__ __forceinline__ void transpose_tile(const TJob& j, int tile, int lane) {
  const int kt = tile / j.ntn, nt_ = tile % j.ntn, k0 = kt * 64, n0 = nt_ * 128;
  const int q = lane & 31, par = lane >> 5;
  const bool ok = (n0 + 4 * q) < j.N;
  f32x4 v[32];
  const float* sp = j.src + (size_t)(k0 + par) * j.lds_ + n0 + 4 * q;
#pragma unroll
  for (int i = 0; i < 32; ++i) v[i] = ok ? *(const f32x4*)(sp + (size_t)(2 * i) * j.lds_) : (f32x4){0.f, 0.f, 0.f, 0.f};
  unsigned ra[32], rb[32];
#pragma unroll
  for (int i = 0; i < 32; ++i) {
    auto s0 = __builtin_amdgcn_permlane32_swap(__float_as_uint(v[i][0]), __float_as_uint(v[i][2]), false, false);
    auto s1 = __builtin_amdgcn_permlane32_swap(__float_as_uint(v[i][1]), __float_as_uint(v[i][3]), false, false);
    ra[i] = cvt_pk_bf16(__uint_as_float(s0[0]), __uint_as_float(s0[1]));
    rb[i] = cvt_pk_bf16(__uint_as_float(s1[0]), __uint_as_float(s1[1]));
  }
  if (ok) {
    const int n = n0 + 4 * q + 2 * par;
    int r0 = n, r1 = n + 1;
    if (j.rowmap == 1) { const int jj0 = r0 & 1023, jj1 = r1 & 1023; r0 = 256 * (jj0 >> 7) + ((r0 >> 10) << 7) + (jj0 & 127); r1 = 256 * (jj1 >> 7) + ((r1 >> 10) << 7) + (jj1 & 127); }
    bf16_t* d0 = j.dst + (size_t)(j.drow0 + r0) * j.ldd + j.dcol0 + k0;
    bf16_t* d1 = j.dst + (size_t)(j.drow0 + r1) * j.ldd + j.dcol0 + k0;
#pragma unroll
    for (int c = 0; c < 8; ++c) { *(v4u*)(d0 + 8 * c) = (v4u){ra[4 * c], ra[4 * c + 1], ra[4 * c + 2], ra[4 * c + 3]}; *(v4u*)(d1 + 8 * c) = (v4u){rb[4 * c], rb[4 * c + 1], rb[4 * c + 2], rb[4 * c + 3]}; }
  }
}
__device__ __forceinline__ void transpose_job(const TJob j, int& w0, int gw, int NGW, int lane) {
  const int nt_ = tjob_tiles(j);
  int first = gw - (w0 % NGW); if (first < 0) first += NGW;
#pragma unroll 1
  for (int t = first; t < nt_; t += NGW) transpose_tile(j, t, lane);
  w0 += nt_;
}
__device__ __forceinline__ void zero_rect(bf16_t* dst, int ldd, int r0, int nr, int cb0, int nbytes, int gtid, int NGT) {
  const int per = nbytes / 16;
  for (int i = gtid; i < nr * per; i += NGT) { const int r = i / per, c = i % per; *(v4u*)((char*)(dst + (size_t)(r0 + r) * ldd) + cb0 + 16 * c) = (v4u){0u, 0u, 0u, 0u}; }
}
__device__ __forceinline__ void cvt_f32_to_bf16(const float* src, int lds_, bf16_t* dst, int ldd, int rows, int ncols, int gtid, int NGT) {
  const int per = ncols / 4;
  for (size_t i = gtid; i < (size_t)rows * per; i += NGT) { const size_t r = i / per; const int c = (int)(i % per) * 4; const f32x4 v = *(const f32x4*)(src + r * lds_ + c);
    *(v2u*)(dst + r * ldd + c) = (v2u){cvt_pk_bf16(v[0], v[1]), cvt_pk_bf16(v[2], v[3])}; }
}
__device__ __forceinline__ void cvt_bf16_to_f32(const bf16_t* src, int lds_, float* dst, int ldd, int rows, int ncols, int gtid, int NGT) {
  const int per = ncols / 4;
  for (size_t i = gtid; i < (size_t)rows * per; i += NGT) { const size_t r = i / per; const int c = (int)(i % per) * 4; const v2u v = *(const v2u*)(src + r * lds_ + c);
    *(f32x4*)(dst + r * ldd + c) = (f32x4){bf_lo(v[0]), bf_hi(v[0]), bf_lo(v[1]), bf_hi(v[1])}; }
}

namespace pg8 {
#define PG8_LAS __attribute__((address_space(3)))
typedef unsigned u32x4 __attribute__((ext_vector_type(4)));
constexpr int BM = 256, BK = 64, HALF = 128, HTB = HALF * BK * 2, STAGE_BYTES = 8 * HTB, NXCD = 8, WGM = 8;
__host__ __device__ __forceinline__ int lds_byte(int r, int c) { const int st = (r >> 4) * 2 + (c >> 5), rr = r & 15, cc = c & 31, ob = rr * 64 + cc * 2; return st * 1024 + (ob ^ (((ob >> 9) & 1) << 5)); }
__host__ __device__ __forceinline__ void stage_rc(int b, int& R, int& C) { const int st = b / 1024, sb = b % 1024, swz = sb ^ (((sb >> 9) & 1) << 5); R = (st >> 1) * 16 + swz / 64; C = (st & 1) * 32 + (swz % 64) / 2; }
__host__ __device__ __forceinline__ int perm32(int rho) { const int n = rho >> 4, i = rho & 15; return 8 * (i >> 2) + 4 * n + (i & 3); }
struct Unit { const char* pa; const char* pb; int orow, ocol, e; };
struct Gemm { int lda, ldb, K; };
struct StaticOrder {
    const char* A; const char* Bt; size_t ta, tb; int nM, nN, nwg, G, c;
    __device__ void init(const void* A_, int lda, const void* Bt_, int ldb, int M, int N, int G_, int c_) { A = (const char*)A_; Bt = (const char*)Bt_; ta = (size_t)BM * lda * 2; tb = (size_t)BM * ldb * 2; nM = M / BM; nN = N / BM; nwg = nM * nN; G = G_; c = c_; }
    __device__ bool tile(int i, int& pm, int& pn) const {
        const long L = (long)i * G + c; if (L >= nwg) return false;
        int wgid = (int)L; { const int q = nwg / NXCD, r = nwg % NXCD, xcd = wgid % NXCD, off = wgid / NXCD; wgid = (xcd < r ? xcd * (q + 1) : r * (q + 1) + (xcd - r) * q) + off; }
        const int nig = WGM * nN, gid = wgid / nig, fm = gid * WGM, gsz = (nM - fm) < WGM ? (nM - fm) : WGM;
        pm = fm + ((wgid % nig) % gsz); pn = (wgid % nig) / gsz; return true;
    }
    __device__ bool next(int i, Unit& u) const { int pm, pn; if (!tile(i, pm, pn)) return false; u.pa = A + (size_t)pm * ta; u.pb = Bt + (size_t)pn * tb; u.orow = pm * BM; u.ocol = pn * BM; u.e = 0; return true; }
    __device__ __forceinline__ void a_ready(const Unit&) const {}
    __device__ __forceinline__ void done(const Unit&) const {}
};
struct EpiStore {
    static constexpr bool PERM = true, AFTER_DRAIN = false;
    bf16_t* O; int ldc;
    __device__ __forceinline__ void operator()(const f32x4 (&acc)[2][2][4][2], const Unit& u, int wr, int wc, int fr, int fq) const {
        const int row0 = u.orow + wr * 64 + fr, col0 = u.ocol + wc * 32 + 8 * fq;
#pragma unroll
        for (int ai = 0; ai < 2; ++ai)
#pragma unroll
            for (int m = 0; m < 4; ++m) { bf16_t* rowp = O + (size_t)(row0 + ai * HALF + m * 16) * ldc + col0;
#pragma unroll
                for (int bj = 0; bj < 2; ++bj) { const f32x4 v0 = acc[ai][bj][m][0], v1 = acc[ai][bj][m][1];
                    u32x4 w; w.x = cvt_pk_bf16(v0[0], v0[1]); w.y = cvt_pk_bf16(v0[2], v0[3]); w.z = cvt_pk_bf16(v1[0], v1[1]); w.w = cvt_pk_bf16(v1[2], v1[3]);
                    *(u32x4*)(rowp + bj * HALF) = w; } }
    }
};
template <class Epi, class Sched, bool ALIGN_EPI = false, bool SP2 = false>
__device__ __forceinline__ void gemm_phase(PG8_LAS unsigned char* lds, const Gemm g, const Sched& S, const Epi& E) {
    const int tid = TIDX(), wid = __builtin_amdgcn_readfirstlane(tid >> 6), lane = tid & 63, wr = wid >> 2, wc = wid & 3, fr = lane & 15, fq = lane >> 4;
    const int K = g.K, nt = K / BK;
    unsigned voffA[2], voffB[2];
#pragma unroll
    for (int i = 0; i < 2; ++i) { int R, C; stage_rc(tid * 16 + i * 8192, R, C); const int Rb = Epi::PERM ? ((R & ~31) + perm32(R & 31)) : R;
        voffA[i] = (unsigned)(R * g.lda + C) * 2u; voffB[i] = (unsigned)(Rb * g.ldb + C) * 2u; }
    const size_t kstep = (size_t)(BK * 2);
    const size_t hstepA = (size_t)HALF * g.lda * 2, hstepB = (size_t)HALF * g.ldb * 2;
    const unsigned ldsw = (unsigned)wid * 1024u;
    const int aoff = lds_byte(wr * 64 + fr, fq * 8), boff = lds_byte(wc * 32 + fr, fq * 8);
#define PG8_SA(b, h) (((b) * 2 + (h)) * HTB)
#define PG8_SB(b, h) ((4 + (b) * 2 + (h)) * HTB)
#define PG8_STAGE(bufoff, gbase, voff) do { _Pragma("unroll") for (int _i = 0; _i < 2; ++_i) \
        __builtin_amdgcn_global_load_lds((const unsigned*)((const char*)(gbase) + (voff)[_i]), (PG8_LAS unsigned*)(lds + (bufoff) + ldsw + _i * 8192), 16, 0, 0); } while (0)
#define PG8_LDA(dst, b, h) do { _Pragma("unroll") for (int m = 0; m < 4; ++m) _Pragma("unroll") for (int k = 0; k < 2; ++k) dst[m][k] = *(const PG8_LAS bf16x8*)(lds + PG8_SA(b, h) + aoff + m * 2048 + k * 1024); } while (0)
#define PG8_LDB(dst, b, h) do { _Pragma("unroll") for (int n = 0; n < 2; ++n) _Pragma("unroll") for (int k = 0; k < 2; ++k) dst[n][k] = *(const PG8_LAS bf16x8*)(lds + PG8_SB(b, h) + boff + n * 2048 + k * 1024); } while (0)
#define PG8_MMA(ai, bj, At, Bt) do { __builtin_amdgcn_s_setprio(1); _Pragma("unroll") for (int m = 0; m < 4; ++m) _Pragma("unroll") for (int n = 0; n < 2; ++n) _Pragma("unroll") for (int k = 0; k < 2; ++k) \
        acc[ai][bj][m][n] = __builtin_amdgcn_mfma_f32_16x16x32_bf16(Bt[n][k], At[m][k], acc[ai][bj][m][n], 0, 0, 0); __builtin_amdgcn_s_setprio(0); } while (0)
#define PG8_WAIT_V(n) asm volatile("s_waitcnt vmcnt(" #n ")" ::: "memory")
#define PG8_WAIT_L(n) asm volatile("s_waitcnt lgkmcnt(" #n ")" ::: "memory")
#define PG8_BAR __builtin_amdgcn_s_barrier()
#define PG8_SCHED __builtin_amdgcn_sched_barrier(0)
    Unit cur, nxt; int ui = 0;
    if (!S.next(0, cur)) return;
    f32x4 acc[2][2][4][2];
#pragma unroll
    for (int a = 0; a < 2; ++a)
#pragma unroll
        for (int b = 0; b < 2; ++b)
#pragma unroll
            for (int m = 0; m < 4; ++m)
#pragma unroll
                for (int n = 0; n < 2; ++n) acc[a][b][m][n] = (f32x4){0.f, 0.f, 0.f, 0.f};
    bf16x8 At[4][2], B0[2][2], B1[2][2];
    const char* cA = cur.pa; const char* cB = cur.pb;
    S.a_ready(cur);
    if constexpr (SP2) {
        PG8_STAGE(PG8_SB(0, 0), cB, voffB); PG8_STAGE(PG8_SB(0, 1), cB + hstepB, voffB); PG8_STAGE(PG8_SA(0, 0), cA, voffA); PG8_STAGE(PG8_SA(0, 1), cA + hstepA, voffA);
        if (wr == 1) PG8_BAR;
        PG8_WAIT_V(2); PG8_BAR;
        PG8_STAGE(PG8_SB(1, 0), cB + kstep, voffB); PG8_STAGE(PG8_SA(1, 0), cA + kstep, voffA); PG8_STAGE(PG8_SB(1, 1), cB + hstepB + kstep, voffB);
        PG8_WAIT_V(6); PG8_BAR;
    } else {
        PG8_STAGE(PG8_SB(0, 0), cB, voffB); PG8_STAGE(PG8_SA(0, 0), cA, voffA); PG8_STAGE(PG8_SB(0, 1), cB + hstepB, voffB); PG8_STAGE(PG8_SA(0, 1), cA + hstepA, voffA);
        if (wr == 1) PG8_BAR;
        PG8_WAIT_V(4); PG8_BAR;
        PG8_STAGE(PG8_SB(1, 0), cB + kstep, voffB); PG8_STAGE(PG8_SA(1, 0), cA + kstep, voffA); PG8_STAGE(PG8_SB(1, 1), cB + hstepB + kstep, voffB);
        PG8_WAIT_V(6); PG8_BAR;
    }
    for (;;) {
        const bool has_next = S.next(ui + 1, nxt);
        const char* nA = has_next ? nxt.pa : cA; const char* nB = has_next ? nxt.pb : cB;
        for (int t = 0; t < nt; t += 2) {
            const bool last = (t == nt - 2);
            const char* a1 = cA + (size_t)(t + 1) * kstep;
            const char* a2 = last ? nA : cA + (size_t)(t + 2) * kstep; const char* b2 = last ? nB : cB + (size_t)(t + 2) * kstep;
            const char* a3 = a2 + kstep; const char* b3 = b2 + kstep;
            if (last && has_next) S.a_ready(nxt);
            if constexpr (SP2) {
            PG8_LDB(B0, 0, 0); PG8_LDB(B1, 0, 1); PG8_SCHED; PG8_LDA(At, 0, 0); PG8_STAGE(PG8_SA(1, 1), a1 + hstepA, voffA);
            PG8_WAIT_V(8); PG8_WAIT_L(0); PG8_BAR; PG8_MMA(0, 0, At, B0); PG8_MMA(0, 1, At, B1); PG8_BAR; PG8_SCHED;
            PG8_LDA(At, 0, 1); PG8_STAGE(PG8_SB(0, 0), b2, voffB); PG8_STAGE(PG8_SB(0, 1), b2 + hstepB, voffB); PG8_STAGE(PG8_SA(0, 0), a2, voffA);
            PG8_WAIT_V(8); PG8_WAIT_L(0); PG8_BAR; PG8_MMA(1, 0, At, B0); PG8_MMA(1, 1, At, B1); PG8_BAR; PG8_SCHED;
            PG8_LDB(B0, 1, 0); PG8_LDB(B1, 1, 1); PG8_SCHED; PG8_LDA(At, 1, 0); PG8_STAGE(PG8_SA(0, 1), a2 + hstepA, voffA);
            PG8_WAIT_V(8); PG8_WAIT_L(0); PG8_BAR; PG8_MMA(0, 0, At, B0); PG8_MMA(0, 1, At, B1); PG8_BAR; PG8_SCHED;
            PG8_LDA(At, 1, 1); PG8_STAGE(PG8_SB(1, 0), b3, voffB); PG8_STAGE(PG8_SB(1, 1), b3 + hstepB, voffB); PG8_STAGE(PG8_SA(1, 0), a3, voffA);
            PG8_WAIT_V(8); PG8_WAIT_L(0); PG8_BAR; PG8_MMA(1, 0, At, B0); PG8_MMA(1, 1, At, B1); PG8_BAR; PG8_SCHED;
            } else {
            PG8_LDB(B0, 0, 0); PG8_SCHED; PG8_LDA(At, 0, 0); PG8_STAGE(PG8_SA(1, 1), a1 + hstepA, voffA);
            PG8_WAIT_L(8); PG8_BAR; PG8_WAIT_L(0); PG8_MMA(0, 0, At, B0); PG8_BAR; PG8_SCHED;
            PG8_LDB(B1, 0, 1); PG8_STAGE(PG8_SB(0, 0), b2, voffB);
            PG8_BAR; PG8_WAIT_L(0); PG8_MMA(0, 1, At, B1); PG8_BAR;
            PG8_LDA(At, 0, 1); PG8_STAGE(PG8_SA(0, 0), a2, voffA);
            PG8_BAR; PG8_WAIT_L(0); PG8_MMA(1, 0, At, B0); PG8_BAR; PG8_SCHED;
            PG8_STAGE(PG8_SB(0, 1), b2 + hstepB, voffB);
            PG8_WAIT_V(6); PG8_BAR; PG8_MMA(1, 1, At, B1); PG8_BAR;
            PG8_LDB(B0, 1, 0); PG8_SCHED; PG8_LDA(At, 1, 0); PG8_STAGE(PG8_SA(0, 1), a2 + hstepA, voffA);
            PG8_WAIT_L(8); PG8_BAR; PG8_WAIT_L(0); PG8_MMA(0, 0, At, B0); PG8_BAR; PG8_SCHED;
            PG8_LDB(B1, 1, 1); PG8_STAGE(PG8_SB(1, 0), b3, voffB);
            PG8_BAR; PG8_WAIT_L(0); PG8_MMA(0, 1, At, B1); PG8_BAR;
            PG8_LDA(At, 1, 1); PG8_STAGE(PG8_SA(1, 0), a3, voffA);
            PG8_BAR; PG8_WAIT_L(0); PG8_MMA(1, 0, At, B0); PG8_BAR; PG8_SCHED;
            PG8_STAGE(PG8_SB(1, 1), b3 + hstepB, voffB);
            PG8_WAIT_V(6); PG8_BAR; PG8_MMA(1, 1, At, B1); PG8_BAR;
            }
        }
        if constexpr (ALIGN_EPI) { if (wr == 0) PG8_BAR; }
        if constexpr (!Epi::AFTER_DRAIN) { E(acc, cur, wr, wc, fr, fq); S.done(cur); }
        if (!has_next) break;
#pragma unroll
        for (int a = 0; a < 2; ++a)
#pragma unroll
            for (int b = 0; b < 2; ++b)
#pragma unroll
                for (int m = 0; m < 4; ++m)
#pragma unroll
                    for (int n = 0; n < 2; ++n) acc[a][b][m][n] = (f32x4){0.f, 0.f, 0.f, 0.f};
        cur = nxt; cA = nA; cB = nB; ++ui;
        if constexpr (ALIGN_EPI) { if (wr == 1) PG8_BAR; }
    }
    PG8_WAIT_V(0);
    if constexpr (!ALIGN_EPI) { if (wr == 0) PG8_BAR; }
    PG8_BAR;
    if constexpr (Epi::AFTER_DRAIN) { E.fused(acc, cur, wr, wc, fr, fq, lds, wid, lane); S.done(cur); }
#undef PG8_SA
#undef PG8_SB
#undef PG8_STAGE
#undef PG8_LDA
#undef PG8_LDB
#undef PG8_MMA
#undef PG8_WAIT_V
#undef PG8_WAIT_L
#undef PG8_BAR
#undef PG8_SCHED
}

}
#define WSYNC2() asm volatile("s_waitcnt lgkmcnt(0)" ::: "memory")
struct MoeBufs { int* tok_e; float* tok_g; int* slot_of; float* slot_gate; int* blk_e; int* blkcnt; int* nblk; };
constexpr int WRT_LD = 1028;

__device__ __forceinline__ void ph_ln_router(const float* xin, const bf16_t* hb, const float* g, const float* bb, const float* wr, const float* br, float* x1, const MoeBufs m, float* lds) {
  const int tid = TIDX(), lane = tid & 63, wave = tid >> 6, blk = BIDX();
  float* wT = lds;
  float* lg = lds + 32 * WRT_LD + wave * 64;
  int* cnt = (int*)(lds + 32 * WRT_LD + 8 * 64);
  for (int i = tid; i < 1024 * 32; i += NTHR) { const int d = i >> 5, e = i & 31; wT[e * WRT_LD + d] = wr[i]; }
  if (tid < 32) cnt[tid] = 0;
  __syncthreads();
  for (int it = 0; it < 8; ++it) {
    const int tok = blk * 64 + wave * 8 + it; if (tok >= NT) break;
    f32x4 v[4]; float s = 0.f;
#pragma unroll
    for (int j = 0; j < 4; ++j) { const int c = lane * 4 + 256 * j; const f32x4 a = *(const f32x4*)(xin + (size_t)tok * D + c); const v2u hh = *(const v2u*)(hb + (size_t)tok * D + c);
      v[j] = (f32x4){ALPHA * a[0] + bf_lo(hh[0]), ALPHA * a[1] + bf_hi(hh[0]), ALPHA * a[2] + bf_lo(hh[1]), ALPHA * a[3] + bf_hi(hh[1])}; s += (v[j][0] + v[j][1]) + (v[j][2] + v[j][3]); }
    const float mu = wave_sum(s) * (1.f / D); float q = 0.f;
#pragma unroll
    for (int j = 0; j < 4; ++j) { v[j] = v[j] - mu; q += (v[j][0] * v[j][0] + v[j][1] * v[j][1]) + (v[j][2] * v[j][2] + v[j][3] * v[j][3]); }
    const float r = rsqrtf(wave_sum(q) * (1.f / D) + 1e-5f);
#pragma unroll
    for (int j = 0; j < 4; ++j) { const int c = lane * 4 + 256 * j; const f32x4 g4 = *(const f32x4*)(g + c), b4 = *(const f32x4*)(bb + c); v[j] = v[j] * r * g4 + b4; *(f32x4*)(x1 + (size_t)tok * D + c) = v[j]; }
    float p[32];
#pragma unroll
    for (int e = 0; e < 32; ++e) { float a = 0.f;
#pragma unroll
      for (int j = 0; j < 4; ++j) { const f32x4 w4 = *(const f32x4*)(wT + e * WRT_LD + lane * 4 + 256 * j); a = fmaf(v[j][0], w4[0], a); a = fmaf(v[j][1], w4[1], a); a = fmaf(v[j][2], w4[2], a); a = fmaf(v[j][3], w4[3], a); }
      p[e] = a; }
#pragma unroll
    for (int i = 0; i < 16; ++i) { const bool hi = (lane & 32) != 0; const float send = hi ? p[i] : p[i + 16]; const float keep = hi ? p[i + 16] : p[i]; p[i] = keep + __shfl_xor(send, 32); }
#pragma unroll
    for (int i = 0; i < 8; ++i) { const bool hi = (lane & 16) != 0; const float send = hi ? p[i] : p[i + 8]; const float keep = hi ? p[i + 8] : p[i]; p[i] = keep + __shfl_xor(send, 16); }
#pragma unroll
    for (int i = 0; i < 4; ++i) { const bool hi = (lane & 8) != 0; const float send = hi ? p[i] : p[i + 4]; const float keep = hi ? p[i + 4] : p[i]; p[i] = keep + __shfl_xor(send, 8); }
#pragma unroll
    for (int i = 0; i < 2; ++i) { const bool hi = (lane & 4) != 0; const float send = hi ? p[i] : p[i + 2]; const float keep = hi ? p[i + 2] : p[i]; p[i] = keep + __shfl_xor(send, 4); }
    { const bool hi = (lane & 2) != 0; const float send = hi ? p[0] : p[1]; const float keep = hi ? p[1] : p[0]; p[0] = keep + __shfl_xor(send, 2); }
    p[0] += __shfl_xor(p[0], 1);
    const int e_l = ((lane >> 5) & 1) * 16 + ((lane >> 4) & 1) * 8 + ((lane >> 3) & 1) * 4 + ((lane >> 2) & 1) * 2 + ((lane >> 1) & 1);
    if ((lane & 1) == 0) lg[e_l] = p[0] + br[e_l];
    WSYNC2();
    if (lane == 0) { int ei[4]; float ev[4];
#pragma unroll
      for (int k = 0; k < 4; ++k) { int bi = 0; float bv = -INFINITY; for (int j = 0; j < 32; ++j) { const float l = lg[j]; if (l > bv) { bv = l; bi = j; } } ei[k] = bi; ev[k] = bv; lg[bi] = -INFINITY; }
      float ex[4], su = 0.f;
#pragma unroll
      for (int k = 0; k < 4; ++k) { ex[k] = __expf(ev[k] - ev[0]); su += ex[k]; }
      const float inv = 1.f / su;
      *(int4*)(m.tok_e + tok * 4) = make_int4(ei[0], ei[1], ei[2], ei[3]);
      *(float4*)(m.tok_g + tok * 4) = make_float4(ex[0] * inv, ex[1] * inv, ex[2] * inv, ex[3] * inv);
#pragma unroll
      for (int k = 0; k < 4; ++k) atomicAdd(&cnt[ei[k]], 1); }
    WSYNC2();
  }
  __syncthreads();
  if (tid < 32) m.blkcnt[blk * 32 + tid] = cnt[tid];
  __syncthreads();
}

__device__ __forceinline__ void ph_moe_scatter(const float* x1, bf16_t* xs, const MoeBufs m, int* ilds) {
  const int tid = TIDX(), lane = tid & 63, wave = tid >> 6, blk = BIDX(), G = (int)gridDim.x;
  int* tot = ilds; int* bef = ilds + 32; int* pst = ilds + 64; int* es = ilds + 128; int* sl = ilds + 128 + 256;
  if (tid < 64) ilds[tid] = 0;
  __syncthreads();
  { const int bp = tid >> 1, e0 = (tid & 1) * 16;
    if (bp < G) {
#pragma unroll
      for (int q = 0; q < 4; ++q) { const int4 c = *(const int4*)(m.blkcnt + bp * 32 + e0 + 4 * q); const int cc[4] = {c.x, c.y, c.z, c.w};
#pragma unroll
        for (int z = 0; z < 4; ++z) { atomicAdd(&tot[e0 + 4 * q + z], cc[z]); if (bp < blk) atomicAdd(&bef[e0 + 4 * q + z], cc[z]); } } } }
  if (tid < 256) es[tid] = m.tok_e[blk * 256 + tid];
  __syncthreads();
  if (tid == 0) { int acc = 0; for (int e = 0; e < 32; ++e) { pst[e] = acc; acc += ((tot[e] + 255) >> 8) << 8; } pst[32] = acc;
    if (blk == 0) { *m.nblk = acc >> 8; for (int e = 0; e < 32; ++e) for (int q = pst[e] >> 8; q < (pst[e + 1] >> 8); ++q) m.blk_e[q] = e; } }
  __syncthreads();
  if (tid < 256) { const int e = es[tid]; int rank = 0; for (int j = 0; j < tid; ++j) rank += (es[j] == e) ? 1 : 0;
    const int slot = pst[e] + bef[e] + rank; sl[tid] = slot; m.slot_of[blk * 256 + tid] = slot; m.slot_gate[slot] = m.tok_g[blk * 256 + tid]; }
  __syncthreads();
  for (int it = 0; it < 8; ++it) {
    const int tl = wave * 8 + it, tok = blk * 64 + tl;
    v2u pk[4];
#pragma unroll
    for (int j = 0; j < 4; ++j) { const f32x4 a = *(const f32x4*)(x1 + (size_t)tok * D + lane * 4 + 256 * j); pk[j] = (v2u){cvt_pk_bf16(a[0], a[1]), cvt_pk_bf16(a[2], a[3])}; }
#pragma unroll
    for (int k = 0; k < 4; ++k) { bf16_t* dst = xs + (size_t)sl[tl * 4 + k] * D + lane * 4;
#pragma unroll
      for (int j = 0; j < 4; ++j) *(v2u*)(dst + 256 * j) = pk[j]; }
  }
  __syncthreads();
}

__device__ __forceinline__ void ph_combine_ln(const float* x1, const bf16_t* Ys, const int* slot_of, const float* g, const float* bb, float* out, bf16_t* outb) {
  const int tid = TIDX(), lane = tid & 63, gw = BIDX() * 8 + (tid >> 6), NGW = (int)gridDim.x * 8;
  for (int row = gw; row < NT; row += NGW) {
    const int4 s4 = *(const int4*)(slot_of + row * 4); const int sl[4] = {s4.x, s4.y, s4.z, s4.w};
    f32x4 v[4]; float s = 0.f;
#pragma unroll
    for (int j = 0; j < 4; ++j) { const int c = lane * 4 + 256 * j; f32x4 f = (f32x4){0.f, 0.f, 0.f, 0.f};
#pragma unroll
      for (int k = 0; k < 4; ++k) { const v2u y = *(const v2u*)(Ys + (size_t)sl[k] * D + c); f += (f32x4){bf_lo(y[0]), bf_hi(y[0]), bf_lo(y[1]), bf_hi(y[1])}; }
      const f32x4 a = *(const f32x4*)(x1 + (size_t)row * D + c); v[j] = a * ALPHA + f; s += (v[j][0] + v[j][1]) + (v[j][2] + v[j][3]); }
    const float mu = wave_sum(s) * (1.f / D); float q = 0.f;
#pragma unroll
    for (int j = 0; j < 4; ++j) { v[j] = v[j] - mu; q += (v[j][0] * v[j][0] + v[j][1] * v[j][1]) + (v[j][2] * v[j][2] + v[j][3] * v[j][3]); }
    const float r = rsqrtf(wave_sum(q) * (1.f / D) + 1e-5f);
#pragma unroll
    for (int j = 0; j < 4; ++j) { const int c = lane * 4 + 256 * j; const f32x4 g4 = *(const f32x4*)(g + c), b4 = *(const f32x4*)(bb + c); const f32x4 o = v[j] * r * g4 + b4;
      *(f32x4*)(out + (size_t)row * D + c) = o; if (outb) *(v2u*)(outb + (size_t)row * D + c) = (v2u){cvt_pk_bf16(o[0], o[1]), cvt_pk_bf16(o[2], o[3])}; }
  }
}

namespace pg8 {
struct MoeOrder {
    StaticOrder so; const int* blk_e; const char* W; size_t wexp; int obn;
    __device__ void init(const void* A, int lda, const void* W_, int ldb, size_t wexp_, int nM, int nN, int obn_, const int* blk_e_, int G, int c) { so.init(A, lda, W_, ldb, nM * BM, nN * BM, G, c); blk_e = blk_e_; W = (const char*)W_; wexp = wexp_; obn = obn_; }
    __device__ bool next(int i, Unit& u) const { int pm, pn; if (!so.tile(i, pm, pn)) return false; const int e = __builtin_amdgcn_readfirstlane(blk_e[pm]); u.pa = so.A + (size_t)pm * so.ta; u.pb = W + (size_t)e * wexp + (size_t)pn * so.tb; u.orow = pm * BM; u.ocol = pn * obn; u.e = e; return true; }
    __device__ __forceinline__ void a_ready(const Unit&) const {}
    __device__ __forceinline__ void done(const Unit&) const {}
};
struct EpiSwiglu {
    static constexpr bool PERM = true, AFTER_DRAIN = false;
    bf16_t* O; int ldc; const float* b1;
    __device__ __forceinline__ void operator()(const f32x4 (&acc)[2][2][4][2], const Unit& u, int wr, int wc, int fr, int fq) const {
        const int row0 = u.orow + wr * 64 + fr, cl = wc * 32 + 8 * fq, col0 = u.ocol + cl;
        const float* bg = b1 + (size_t)u.e * 2048 + col0; const float* bu = bg + 1024;
        const f32x4 bg0 = *(const f32x4*)bg, bg1 = *(const f32x4*)(bg + 4), bu0 = *(const f32x4*)bu, bu1 = *(const f32x4*)(bu + 4);
#pragma unroll
        for (int ai = 0; ai < 2; ++ai)
#pragma unroll
            for (int m = 0; m < 4; ++m) {
                f32x4 gv[2] = {acc[ai][0][m][0] + bg0, acc[ai][0][m][1] + bg1}, uv[2] = {acc[ai][1][m][0] + bu0, acc[ai][1][m][1] + bu1}; float o[8];
#pragma unroll
                for (int n = 0; n < 2; ++n)
#pragma unroll
                    for (int i = 0; i < 4; ++i) { const float gg = fminf(gv[n][i], 7.f), uu = fminf(fmaxf(uv[n][i], -7.f), 7.f);
                        const float sg = __builtin_amdgcn_rcpf(1.f + __builtin_amdgcn_exp2f(-1.702f * 1.4426950408889634f * gg)); o[4 * n + i] = (uu + 1.f) * gg * sg; }
                u32x4 w; w.x = cvt_pk_bf16(o[0], o[1]); w.y = cvt_pk_bf16(o[2], o[3]); w.z = cvt_pk_bf16(o[4], o[5]); w.w = cvt_pk_bf16(o[6], o[7]);
                *(u32x4*)(O + (size_t)(row0 + ai * HALF + m * 16) * ldc + col0) = w; asm volatile("" ::: "memory"); }
    }
};
struct EpiMoe2 {
    static constexpr bool PERM = true, AFTER_DRAIN = false;
    bf16_t* O; int ldc; const float* b2; const float* gate;
    __device__ __forceinline__ void operator()(const f32x4 (&acc)[2][2][4][2], const Unit& u, int wr, int wc, int fr, int fq) const {
        const int row0 = u.orow + wr * 64 + fr, col0 = u.ocol + wc * 32 + 8 * fq;
        const float* bp = b2 + (size_t)u.e * 1024 + col0;
#pragma unroll
        for (int bj = 0; bj < 2; ++bj) {
            const f32x4 bv0 = *(const f32x4*)(bp + bj * HALF), bv1 = *(const f32x4*)(bp + bj * HALF + 4);
#pragma unroll
            for (int ai = 0; ai < 2; ++ai)
#pragma unroll
                for (int m = 0; m < 4; ++m) { const int row = row0 + ai * HALF + m * 16; const float gt = gate[row];
                    const f32x4 v0 = (acc[ai][bj][m][0] + bv0) * gt, v1 = (acc[ai][bj][m][1] + bv1) * gt;
                    u32x4 w; w.x = cvt_pk_bf16(v0[0], v0[1]); w.y = cvt_pk_bf16(v0[2], v0[3]); w.z = cvt_pk_bf16(v1[0], v1[1]); w.w = cvt_pk_bf16(v1[2], v1[3]);
                    *(u32x4*)(O + (size_t)row * ldc + col0 + bj * HALF) = w; asm volatile("" ::: "memory"); }
        }
    }
};
}
typedef short v4i16_t __attribute__((ext_vector_type(4)));
__device__ __forceinline__ unsigned f2key_u(float f) { f = f + 0.0f; const unsigned u = __float_as_uint(f); return (u & 0x80000000u) ? ~u : (u | 0x80000000u); }

__device__ __forceinline__ void ph_cnorm_b(const bf16_t* pa, const float* g, bf16_t* cnb) {
  const int tid = TIDX(), lane = tid & 63, gw = BIDX() * 8 + (tid >> 6), NGW = (int)gridDim.x * 8;
  const f32x4 g4 = *(const f32x4*)(g + lane * 4);
  for (int row = gw; row < NT; row += NGW) {
    const v2u v = *(const v2u*)(pa + (size_t)row * 2048 + 1024 + lane * 4);
    const f32x4 f = (f32x4){bf_lo(v[0]), bf_hi(v[0]), bf_lo(v[1]), bf_hi(v[1])};
    const float r = rsqrtf(wave_sum((f[0] * f[0] + f[1] * f[1]) + (f[2] * f[2] + f[3] * f[3])) * (1.f / 256.f) + 1e-6f);
    const f32x4 o = f * r * g4;
    *(v2u*)(cnb + (size_t)row * 256 + lane * 4) = (v2u){cvt_pk_bf16(o[0], o[1]), cvt_pk_bf16(o[2], o[3])};
  }
}

__device__ __forceinline__ void ph_iscore(const bf16_t* pa, float* sc) {
  const int tid = TIDX(), lane = tid & 63, gw = BIDX() * 8 + (tid >> 6), NGW = (int)gridDim.x * 8;
  const int n16 = lane & 15, g = lane >> 4;
#pragma unroll 1
  for (int u = gw; u < 2 * 4352; u += NGW) {
    const int b = u / 4352, v = u % 4352;
    int a = 0; while (a < 15 && 16 * (a + 1) * (a + 2) <= v) ++a;
    const int rem = v - 16 * a * (a + 1), r = rem / (a + 1), ch = rem % (a + 1);
    const int qg = 32 * a + r, ntile = (ch < a) ? 32 : (r + 1), t0 = qg * 16, kt0 = ch * 32;
    const bf16_t* qrow = pa + (size_t)(b * L + t0 + n16) * 2048;
    bf16x8 qf[8][2]; float w[8];
#pragma unroll
    for (int h = 0; h < 8; ++h) { qf[h][0] = *(const bf16x8*)(qrow + 1280 + h * 64 + 8 * g); qf[h][1] = *(const bf16x8*)(qrow + 1280 + h * 64 + 32 + 8 * g); w[h] = bf2f(qrow[1856 + h]) * (0.35355339059327373f * 0.125f); }
    const bf16_t* kbase = pa + (size_t)(b * L + n16) * 2048 + 1792 + 8 * g;
    float* srow = sc + (size_t)(b * L + t0 + n16) * L + 4 * g;
#pragma unroll 2
    for (int kt = kt0; kt < kt0 + ntile; ++kt) {
      const bf16x8 k0 = *(const bf16x8*)(kbase + (size_t)kt * 16 * 2048), k1 = *(const bf16x8*)(kbase + (size_t)kt * 16 * 2048 + 32);
      f32x4 score = (f32x4){0.f, 0.f, 0.f, 0.f};
#pragma unroll
      for (int h = 0; h < 8; ++h) {
        f32x4 acc = __builtin_amdgcn_mfma_f32_16x16x32_bf16(k0, qf[h][0], (f32x4){0.f, 0.f, 0.f, 0.f}, 0, 0, 0);
        acc = __builtin_amdgcn_mfma_f32_16x16x32_bf16(k1, qf[h][1], acc, 0, 0, 0);
#pragma unroll
        for (int i = 0; i < 4; ++i) score[i] = fmaf(fmaxf(acc[i], 0.f), w[h], score[i]);
      }
      *(f32x4*)(srow + kt * 16) = score;
    }
  }
}

constexpr int DW_STRIDE = 17152;
__device__ __forceinline__ unsigned offb(unsigned row, unsigned ch) { return 256u * row + 16u * (ch ^ (((row & 3u) << 2) | ((row >> 2) & 3u))); }
__device__ __forceinline__ void glds16(const void* gsrc, unsigned lds_dst) { unsigned keep;
  asm volatile("s_mov_b32 %0, m0\n\ts_mov_b32 m0, %2\n\ts_nop 0\n\tglobal_load_lds_dwordx4 %1, off\n\ts_mov_b32 m0, %0" : "=&s"(keep) : "v"(gsrc), "s"(lds_dst) : "memory"); }
__device__ __forceinline__ int wave_excl_scan(int v, int lane, int& total) {
  int x = v;
#pragma unroll
  for (int o = 1; o < 64; o <<= 1) { const int y = __shfl_up(x, o); if (lane >= o) x += y; }
  total = __shfl(x, 63); return x - v;
}
#define LDSW() asm volatile("s_waitcnt lgkmcnt(0)" ::: "memory")

__device__ __forceinline__ int wave_select(const float* srow, int t, LAS unsigned char* wl, LAS unsigned short* idx16, int lane) {
  const int n = t + 1;
  if (n <= 256) { for (int i = lane; i < 256; i += 64) idx16[i] = (unsigned short)(i < n ? i : 0); LDSW(); return n; }
  LAS unsigned* hist = (LAS unsigned*)wl;
  for (int i = lane; i < 1024; i += 64) ((LAS v4u*)hist)[i] = (v4u){0u, 0u, 0u, 0u};
  unsigned bk[32][2];
#pragma unroll
  for (int i = 0; i < 32; ++i) {
    bk[i][0] = 0u; bk[i][1] = 0u;
    if (i * 256 < n) { const int e0 = (i * 64 + lane) * 4;
      if (e0 < n) { const f32x4 f = *(const f32x4*)(srow + e0); unsigned bn[4];
#pragma unroll
        for (int c = 0; c < 4; ++c) bn[c] = (e0 + c <= t) ? (f2key_u(f[c]) >> 20) : 0u;
        bk[i][0] = bn[0] | (bn[1] << 16); bk[i][1] = bn[2] | (bn[3] << 16); } }
    if ((i & 7) == 7) asm volatile("" ::: "memory");
  }
#define BIN_OF(i, c) ((bk[i][(c) >> 1] >> (((c) & 1) * 16)) & 0xFFFFu)
  LDSW();
#pragma unroll
  for (int i = 0; i < 32; ++i) if (i * 256 < n) {
#pragma unroll
    for (int c = 0; c < 4; ++c) { const unsigned bin = BIN_OF(i, c); if (bin) __hip_atomic_fetch_add(hist + bin, 1u, __ATOMIC_RELAXED, __HIP_MEMORY_SCOPE_WORKGROUP); }
    asm volatile("" ::: "memory"); }
  LDSW();
  const int bbase = 4096 - 64 * (lane + 1); int ssum = 0;
#pragma unroll 8
  for (int k = 0; k < 64; ++k) ssum += (int)hist[bbase + ((k + lane) & 63)];
  int tot; const int pre = wave_excl_scan(ssum, lane, tot);
  const unsigned long long bal = __ballot(pre < 256 && pre + ssum >= 256);
  const int Ls = (int)__builtin_ctzll(bal);
  int cum = __shfl(pre, Ls); const int sb = 4096 - 64 * (Ls + 1); int B1 = sb;
  for (int k = 63; k >= 0; --k) { const int c = (int)hist[sb + k]; if (cum + c >= 256) { B1 = sb + k; break; } cum += c; }
  const int cnt_gt = cum, need1 = 256 - cnt_gt;
  LDSW();
  int ngt = 0, neq = 0;
#pragma unroll
  for (int i = 0; i < 32; ++i) if (i * 256 < n) {
#pragma unroll
    for (int c = 0; c < 4; ++c) { const int bin = (int)BIN_OF(i, c); ngt += (bin > B1) ? 1 : 0; neq += (bin == B1) ? 1 : 0; } }
  int tg, te; int pg = wave_excl_scan(ngt, lane, tg); int pe = wave_excl_scan(neq, lane, te);
  LAS unsigned short* cand = (LAS unsigned short*)wl;
#pragma unroll
  for (int i = 0; i < 32; ++i) if (i * 256 < n) {
#pragma unroll
    for (int c = 0; c < 4; ++c) { const int bin = (int)BIN_OF(i, c); const int e = (i * 64 + lane) * 4 + c;
      if (bin > B1) { idx16[pg] = (unsigned short)e; ++pg; }
      if (bin == B1) { cand[pe] = (unsigned short)e; ++pe; } }
    asm volatile("" ::: "memory"); }
#undef BIN_OF
  LDSW();
  const int m = te;
  unsigned long long lo = 0ull;
  if (m <= 256) {
    unsigned long long cp[4];
#pragma unroll
    for (int j = 0; j < 4; ++j) { const int q = lane + 64 * j; cp[j] = 0ull; if (q < m) { const unsigned ci = cand[q]; cp[j] = ((unsigned long long)(f2key_u(srow[ci]) & 0xFFFFFu) << 13) | (unsigned long long)(8191u - ci) | (1ull << 40); } }
    for (int bit = 32; bit >= 0; --bit) { const unsigned long long trial = lo | (1ull << bit); int c = 0;
#pragma unroll
      for (int j = 0; j < 4; ++j) c += ((cp[j] >> 40) && ((cp[j] & 0x1FFFFFFFFull) >= trial)) ? 1 : 0;
      int tc; (void)wave_excl_scan(c, lane, tc); if (tc >= need1) lo = trial; }
    int c = 0;
#pragma unroll
    for (int j = 0; j < 4; ++j) c += ((cp[j] >> 40) && ((cp[j] & 0x1FFFFFFFFull) >= lo)) ? 1 : 0;
    int tc; int pos = cnt_gt + wave_excl_scan(c, lane, tc);
#pragma unroll
    for (int j = 0; j < 4; ++j) if ((cp[j] >> 40) && ((cp[j] & 0x1FFFFFFFFull) >= lo)) { idx16[pos] = (unsigned short)(8191u - (unsigned)(cp[j] & 0x1FFFull)); ++pos; }
  } else {
    for (int bit = 32; bit >= 0; --bit) { const unsigned long long trial = lo | (1ull << bit); int c = 0;
      for (int q = lane; q < m; q += 64) { const unsigned ci = cand[q]; const unsigned long long cpq = ((unsigned long long)(f2key_u(srow[ci]) & 0xFFFFFu) << 13) | (unsigned long long)(8191u - ci); c += (cpq >= trial) ? 1 : 0; }
      int tc; (void)wave_excl_scan(c, lane, tc); if (tc >= need1) lo = trial; }
    int base = cnt_gt;
    for (int q0 = 0; q0 < m; q0 += 64) { const int q = q0 + lane; bool sel = false; unsigned ci = 0;
      if (q < m) { ci = cand[q]; const unsigned long long cpq = ((unsigned long long)(f2key_u(srow[ci]) & 0xFFFFFu) << 13) | (unsigned long long)(8191u - ci); sel = cpq >= lo; }
      int tc; const int pos = base + wave_excl_scan(sel ? 1 : 0, lane, tc); if (sel) idx16[pos] = (unsigned short)ci; base += tc; }
  }
  LDSW();
  return 256;
}

__device__ __forceinline__ void wave_attend(int b, int t, int cnt, const bf16_t* qlat, const bf16_t* cnb, LAS unsigned char* wl, LAS unsigned short* idx16, bf16_t* olat, int lane) {
  const int n16 = lane & 15, g = lane >> 4, q4 = (lane & 15) >> 2, p4 = lane & 3;
  const bf16_t* qrow = qlat + (size_t)(b * L + t) * 4096 + n16 * 256 + 8 * g;
  bf16x8 qf[8];
#pragma unroll
  for (int s = 0; s < 8; ++s) qf[s] = *(const bf16x8*)(qrow + 32 * s);
  f32x4 o[16];
#pragma unroll
  for (int c = 0; c < 16; ++c) o[c] = (f32x4){0.f, 0.f, 0.f, 0.f};
  float mrun = -INFINITY, lrun = 0.f;
  const int ntile = (cnt + 31) >> 5;
  const char* cb = (const char*)(cnb + (size_t)b * L * 256);
  const unsigned wl_addr = (unsigned)__builtin_amdgcn_readfirstlane((int)(unsigned)(size_t)wl);
  const unsigned slot = lane & 15, rsub = lane >> 4;
  constexpr float SC = 0.125f * 1.4426950408889634f;
#pragma unroll 1
  for (int it = 0; it < ntile; ++it) {
#pragma unroll
    for (int rg = 0; rg < 8; ++rg) { const unsigned row = 4 * rg + rsub; const unsigned key = idx16[32 * it + row];
      const unsigned ch = slot ^ (((row & 3u) << 2) | ((row >> 2) & 3u));
      const char* src = cb + (size_t)key * 512 + ch * 16;
      glds16(src, wl_addr + rg * 1024); glds16(src + 256, wl_addr + 8192 + rg * 1024); }
    asm volatile("s_waitcnt vmcnt(0)" ::: "memory");
    f32x4 s0 = (f32x4){0.f, 0.f, 0.f, 0.f}, s1 = (f32x4){0.f, 0.f, 0.f, 0.f};
#pragma unroll
    for (int s = 0; s < 8; ++s) { const unsigned ib = (s >> 2) * 8192, chq = 4 * (s & 3) + g;
      const bf16x8 a0 = *(const LAS bf16x8*)(wl + ib + offb(n16, chq)), a1 = *(const LAS bf16x8*)(wl + ib + offb(16 + n16, chq));
      s0 = __builtin_amdgcn_mfma_f32_16x16x32_bf16(a0, qf[s], s0, 0, 0, 0); s1 = __builtin_amdgcn_mfma_f32_16x16x32_bf16(a1, qf[s], s1, 0, 0, 0); }
    const int sl0 = 32 * it + 4 * g;
    float mx = -INFINITY;
#pragma unroll
    for (int r = 0; r < 4; ++r) { s0[r] = (sl0 + r < cnt) ? s0[r] * SC : -INFINITY; s1[r] = (sl0 + 16 + r < cnt) ? s1[r] * SC : -INFINITY; mx = fmaxf(mx, fmaxf(s0[r], s1[r])); }
    mx = fmaxf(mx, __shfl_xor(mx, 16)); mx = fmaxf(mx, __shfl_xor(mx, 32));
    const float mnew = fmaxf(mrun, mx), alpha = __builtin_amdgcn_exp2f(mrun - mnew);
    float ls = 0.f; float pv[8];
#pragma unroll
    for (int r = 0; r < 4; ++r) { pv[r] = __builtin_amdgcn_exp2f(s0[r] - mnew); pv[4 + r] = __builtin_amdgcn_exp2f(s1[r] - mnew); ls += pv[r] + pv[4 + r]; }
    ls += __shfl_xor(ls, 16); ls += __shfl_xor(ls, 32);
    lrun = lrun * alpha + ls; mrun = mnew;
#pragma unroll
    for (int c = 0; c < 16; ++c) o[c] = o[c] * alpha;
    const v4u pbw = (v4u){cvt_pk_bf16(pv[0], pv[1]), cvt_pk_bf16(pv[2], pv[3]), cvt_pk_bf16(pv[4], pv[5]), cvt_pk_bf16(pv[6], pv[7])};
    const bf16x8 pb = __builtin_bit_cast(bf16x8, pbw);
#pragma unroll
    for (int c = 0; c < 16; ++c) { const unsigned ib = (c >> 3) * 8192, chc = 2 * (c & 7) + (p4 >> 1);
      const v4i16_t t0 = __builtin_amdgcn_ds_read_tr16_b64_v4i16((LAS v4i16_t*)(wl + ib + offb(4 * g + q4, chc) + 8 * (p4 & 1)));
      const v4i16_t t1 = __builtin_amdgcn_ds_read_tr16_b64_v4i16((LAS v4i16_t*)(wl + ib + offb(16 + 4 * g + q4, chc) + 8 * (p4 & 1)));
      const bf16x8 af = (bf16x8){t0[0], t0[1], t0[2], t0[3], t1[0], t1[1], t1[2], t1[3]};
      o[c] = __builtin_amdgcn_mfma_f32_16x16x32_bf16(af, pb, o[c], 0, 0, 0); }
    LDSW();
  }
  const float inv = 1.f / lrun;
  bf16_t* orow = olat + (size_t)(b * L + t) * 4096 + n16 * 256 + 4 * g;
#pragma unroll
  for (int c = 0; c < 16; ++c) { const f32x4 v = o[c] * inv; *(v2u*)(orow + 16 * c) = (v2u){cvt_pk_bf16(v[0], v[1]), cvt_pk_bf16(v[2], v[3])}; }
}

__device__ __forceinline__ void ph_select_attend(const float* sc, const bf16_t* qlat, const bf16_t* cnb, bf16_t* olat, LAS unsigned char* lds) {
  const int tid = TIDX(), lane = tid & 63, wave = __builtin_amdgcn_readfirstlane(tid >> 6), blk = BIDX();
  LAS unsigned char* wl = lds + wave * DW_STRIDE; LAS unsigned short* idx16 = (LAS unsigned short*)(wl + 16384);
  const int b = blk & 1, wb = (blk >> 1) * 8 + wave, nwb = ((int)gridDim.x >> 1) * 8;
#pragma unroll 1
  for (int t = wb; t < L; t += nwb) {
    int lane_s = lane; asm volatile("" : "+v"(lane_s));
    const int cnt = wave_select(sc + (size_t)(b * L + t) * L, t, wl, idx16, lane_s);
    int lane_a = lane; asm volatile("" : "+v"(lane_a));
    wave_attend(b, t, cnt, qlat, cnb, wl, idx16, olat, lane_a);
  }
}

namespace pg8 {
struct GroupAOrder {
    StaticOrder so; int png; size_t acol_bytes;
    __device__ void init(const void* A, int lda, const void* Bt, int ldb, int M, int N, int png_, size_t acol_bytes_, int G, int c) { so.init(A, lda, Bt, ldb, M, N, G, c); png = png_; acol_bytes = acol_bytes_; }
    __device__ bool next(int i, Unit& u) const { int pm, pn; if (!so.tile(i, pm, pn)) return false; u.pa = so.A + (size_t)pm * so.ta + (size_t)(pn / png) * acol_bytes; u.pb = so.Bt + (size_t)pn * so.tb; u.orow = pm * BM; u.ocol = pn * BM; u.e = 0; return true; }
    __device__ __forceinline__ void a_ready(const Unit&) const {}
    __device__ __forceinline__ void done(const Unit&) const {}
};
}
constexpr int GLA_LDSU = 65536;

__device__ __forceinline__ v4i16_t trrd(LAS unsigned char* p) { return __builtin_amdgcn_ds_read_tr16_b64_v4i16((LAS v4i16_t*)p); }
__device__ __forceinline__ bf16x8 cat44(v4i16_t a, v4i16_t b) { return (bf16x8){a[0], a[1], a[2], a[3], b[0], b[1], b[2], b[3]}; }

__device__ __forceinline__ void ph_gla_a1(const bf16_t* pb, const float* gbias, bf16_t* qt, float* og, float* kvt, float* dcy, LAS unsigned char* lds) {
  const int tid = TIDX(), lane = tid & 63, wave = __builtin_amdgcn_readfirstlane(tid >> 6), blk = BIDX();
  if ((wave & 3) != 0) return;
  const int half = wave >> 2;
  LAS unsigned char* X = lds + half * GLA_LDSU; LAS unsigned char* Y = X + 16384; LAS unsigned char* V = X + 32768;
  const unsigned v_addr = (unsigned)__builtin_amdgcn_readfirstlane((int)(unsigned)(size_t)V);
  const int n16 = lane & 15, g = lane >> 4, q4 = (lane & 15) >> 2, p4 = lane & 3;
#pragma unroll 1
  for (int uu = 0; uu < 2; ++uu) {
    const int u = blk * 4 + half * 2 + uu; if (u >= 1024) break;
    const int h = u & 3, bc = u >> 2, r0 = bc * 64;
    { const unsigned slot = lane & 15, rsub = lane >> 4;
#pragma unroll
      for (int im = 0; im < 4; ++im)
#pragma unroll
        for (int rg = 0; rg < 8; ++rg) { const unsigned row = 4 * rg + rsub; const unsigned ch = slot ^ (((row & 3u) << 2) | ((row >> 2) & 3u));
          const char* src = (const char*)(pb + (size_t)(r0 + 32 * (im >> 1) + row) * 3584 + 1024 + h * 256 + (im & 1) * 128) + ch * 16;
          glds16(src, v_addr + im * 8192 + rg * 1024); } }
    const int d0 = 2 * lane; const float gb0 = gbias[h * 128 + d0], gb1 = gbias[h * 128 + d0 + 1];
    float bc0 = 0.f, bc1 = 0.f;
    const unsigned wofs = 16u * ((unsigned)(d0 >> 3)) , wsub = (unsigned)(d0 & 7) * 2u;
#pragma unroll 1
    for (int jb = 0; jb < 4; ++jb) {
      unsigned gq[16], qq[16], kq[16];
#pragma unroll
      for (int jj = 0; jj < 16; ++jj) { const bf16_t* rp = pb + (size_t)(r0 + jb * 16 + jj) * 3584 + h * 128 + d0;
        gq[jj] = *(const unsigned*)(rp + 3072); qq[jj] = *(const unsigned*)rp; kq[jj] = *(const unsigned*)(rp + 512); }
#pragma unroll
      for (int jj = 0; jj < 16; ++jj) { const int j = jb * 16 + jj;
        const float a0 = bf_lo(gq[jj]) + gb0, a1 = bf_hi(gq[jj]) + gb1;
        bc0 += (fminf(a0, 0.f) - log1pf(__expf(-fabsf(a0)))) * (1.f / 16.f); bc1 += (fminf(a1, 0.f) - log1pf(__expf(-fabsf(a1)))) * (1.f / 16.f);
        const float e0 = __expf(bc0), e1 = __expf(bc1), i0 = __expf(fminf(-bc0, 80.f)), i1 = __expf(fminf(-bc1, 80.f));
        const unsigned qo = cvt_pk_bf16(bf_lo(qq[jj]) * 0.08838834764831845f * e0, bf_hi(qq[jj]) * 0.08838834764831845f * e1);
        const unsigned ko = cvt_pk_bf16(bf_lo(kq[jj]) * i0, bf_hi(kq[jj]) * i1);
        *(unsigned*)(qt + (size_t)(r0 + j) * 512 + h * 128 + d0) = qo;
        const unsigned row = (unsigned)(j & 31); const unsigned off = (unsigned)(j >> 5) * 8192u + 256u * row + ((wofs ^ (16u * (((row & 3u) << 2) | ((row >> 2) & 3u))))) + wsub;
        *(LAS unsigned*)(X + off) = qo; *(LAS unsigned*)(Y + off) = ko; }
    }
    *(float2*)(dcy + (size_t)u * 128 + d0) = make_float2(__expf(bc0), __expf(bc1));
    LDSW();
    bf16x8 afr[4][2];
#pragma unroll
    for (int it = 0; it < 4; ++it)
#pragma unroll
      for (int ks = 0; ks < 2; ++ks) {
        unsigned pk[4] = {0u, 0u, 0u, 0u};
#pragma unroll
        for (int jh = 0; jh < 2; ++jh) { const int jt = 2 * ks + jh;
          if (jt <= it) { f32x4 acc = (f32x4){0.f, 0.f, 0.f, 0.f};
#pragma unroll
            for (int s = 0; s < 4; ++s) { const bf16x8 ya = *(const LAS bf16x8*)(Y + (jt >> 1) * 8192 + offb(n16 + 16 * (jt & 1), 4 * s + g)), xb = *(const LAS bf16x8*)(X + (it >> 1) * 8192 + offb(n16 + 16 * (it & 1), 4 * s + g));
              acc = __builtin_amdgcn_mfma_f32_16x16x32_bf16(ya, xb, acc, 0, 0, 0); }
            const int i_ = 16 * it + n16, jbase = 16 * jt + 4 * g;
#pragma unroll
            for (int r = 0; r < 4; ++r) if (jbase + r > i_) acc[r] = 0.f;
            pk[2 * jh] = cvt_pk_bf16(acc[0], acc[1]); pk[2 * jh + 1] = cvt_pk_bf16(acc[2], acc[3]); } }
        afr[it][ks] = __builtin_bit_cast(bf16x8, (v4u){pk[0], pk[1], pk[2], pk[3]});
      }
    asm volatile("s_waitcnt vmcnt(0)" ::: "memory");
    float* ogp = og + (size_t)r0 * 1024 + h * 256 + n16; float* kvp = kvt + (size_t)u * 32768 + (size_t)n16 * 128 + 4 * g;
#pragma unroll 1
    for (int nt = 0; nt < 16; ++nt) {
      const unsigned vimg = (unsigned)(nt >> 3) * 8192u, chv = 2u * (unsigned)(nt & 7) + (unsigned)(p4 >> 1), sub = 8u * (unsigned)(p4 & 1);
      bf16x8 bi[2], bn[2];
#pragma unroll
      for (int ks = 0; ks < 2; ++ks) { LAS unsigned char* vb = V + ks * 16384 + vimg;
        bi[ks] = cat44(trrd(vb + offb(4 * g + q4, chv) + sub), trrd(vb + offb(16 + 4 * g + q4, chv) + sub));
        bn[ks] = cat44(trrd(vb + offb(8 * g + q4, chv) + sub), trrd(vb + offb(8 * g + 4 + q4, chv) + sub)); }
#pragma unroll
      for (int it = 0; it < 4; ++it) { f32x4 acc = __builtin_amdgcn_mfma_f32_16x16x32_bf16(afr[it][0], bi[0], (f32x4){0.f, 0.f, 0.f, 0.f}, 0, 0, 0);
        if (it >= 2) acc = __builtin_amdgcn_mfma_f32_16x16x32_bf16(afr[it][1], bi[1], acc, 0, 0, 0);
#pragma unroll
        for (int r = 0; r < 4; ++r) ogp[(size_t)(16 * it + 4 * g + r) * 1024 + 16 * nt] = acc[r]; }
#pragma unroll
      for (int mt = 0; mt < 8; ++mt) { const unsigned chy = 2u * (unsigned)mt + (unsigned)(p4 >> 1);
        const bf16x8 a0 = cat44(trrd(Y + offb(8 * g + q4, chy) + sub), trrd(Y + offb(8 * g + 4 + q4, chy) + sub));
        const bf16x8 a1 = cat44(trrd(Y + 8192 + offb(8 * g + q4, chy) + sub), trrd(Y + 8192 + offb(8 * g + 4 + q4, chy) + sub));
        f32x4 acc = __builtin_amdgcn_mfma_f32_16x16x32_bf16(a0, bn[0], (f32x4){0.f, 0.f, 0.f, 0.f}, 0, 0, 0);
        acc = __builtin_amdgcn_mfma_f32_16x16x32_bf16(a1, bn[1], acc, 0, 0, 0);
        *(f32x4*)(kvp + (size_t)(16 * nt) * 128 + 16 * mt) = acc; }
    }
    LDSW();
  }
}

__device__ __forceinline__ void ph_gla_a2(const float* kvt, const float* dcy, bf16_t* spt) {
  const int gtid = BIDX() * NTHR + TIDX();
  if (gtid >= 8 * 256 * 32) return;
  const int g4 = gtid & 31, dv = (gtid >> 5) & 255, bh = gtid >> 13, b = bh >> 2, h = bh & 3;
  f32x4 S = (f32x4){0.f, 0.f, 0.f, 0.f};
#pragma unroll 4
  for (int c = 0; c < 128; ++c) { const size_t u = (size_t)((b * 128 + c) * 4 + h);
    const f32x4 kv = *(const f32x4*)(kvt + u * 32768 + (size_t)dv * 128 + 4 * g4), dc = *(const f32x4*)(dcy + u * 128 + 4 * g4);
    *(v2u*)(spt + u * 32768 + (size_t)dv * 128 + 4 * g4) = (v2u){cvt_pk_bf16(S[0], S[1]), cvt_pk_bf16(S[2], S[3])};
    S = dc * (S + kv); }
}

__device__ __forceinline__ void ph_gla_a3(const bf16_t* pb, const bf16_t* qt, const float* og, const bf16_t* spt, const float* ng, bf16_t* ob) {
  const int tid = TIDX(), lane = tid & 63, gw = BIDX() * 8 + (tid >> 6), NGW = (int)gridDim.x * 8;
  const int n16 = lane & 15, g = lane >> 4;
#pragma unroll 1
  for (int u = gw; u < 1024; u += NGW) {
    const int h = u & 3, r0 = (u >> 2) * 64;
    const bf16_t* sp = spt + (size_t)u * 32768 + (size_t)n16 * 128 + 8 * g;
#pragma unroll 1
    for (int it = 0; it < 4; ++it) {
      bf16x8 qa[4];
#pragma unroll
      for (int ks = 0; ks < 4; ++ks) qa[ks] = *(const bf16x8*)(qt + (size_t)(r0 + 16 * it + n16) * 512 + h * 128 + 32 * ks + 8 * g);
      f32x4 acc[16]; const float* ogp = og + (size_t)(r0 + 16 * it + 4 * g) * 1024 + h * 256 + n16;
#pragma unroll
      for (int nt = 0; nt < 16; ++nt) {
#pragma unroll
        for (int r = 0; r < 4; ++r) acc[nt][r] = ogp[(size_t)r * 1024 + 16 * nt];
#pragma unroll
        for (int ks = 0; ks < 4; ++ks) { const bf16x8 sb = *(const bf16x8*)(sp + (size_t)(16 * nt) * 128 + 32 * ks); acc[nt] = __builtin_amdgcn_mfma_f32_16x16x32_bf16(qa[ks], sb, acc[nt], 0, 0, 0); } }
      float ss[4] = {0.f, 0.f, 0.f, 0.f};
#pragma unroll
      for (int nt = 0; nt < 16; ++nt)
#pragma unroll
        for (int r = 0; r < 4; ++r) ss[r] = fmaf(acc[nt][r], acc[nt][r], ss[r]);
#pragma unroll
      for (int r = 0; r < 4; ++r) { ss[r] += __shfl_xor(ss[r], 1); ss[r] += __shfl_xor(ss[r], 2); ss[r] += __shfl_xor(ss[r], 4); ss[r] += __shfl_xor(ss[r], 8); ss[r] = rsqrtf(ss[r] * (1.f / 256.f) + 1e-6f); }
#pragma unroll
      for (int nt = 0; nt < 16; ++nt) { const float gn = ng[h * 256 + 16 * nt + n16];
#pragma unroll
        for (int r = 0; r < 4; ++r) { const size_t row = (size_t)(r0 + 16 * it + 4 * g + r); const float rr = bf2f(pb[row * 3584 + 2048 + h * 256 + 16 * nt + n16]);
          const float o = acc[nt][r] * ss[r] * gn * (rr * __builtin_amdgcn_rcpf(1.f + __expf(-rr)));
          ob[row * 1024 + h * 256 + 16 * nt + n16] = (bf16_t)(cvt_pk_bf16(o, 0.f) & 0xffffu); } }
    }
  }
}
#ifndef PROBE
#define PROBE 0
#endif
#ifndef PROBE_S
#define PROBE_S 10.0f
#endif
constexpr size_t MiB = 1u << 20;
constexpr size_t WS_CTL = 0, CTL_ZERO_BYTES = 1 * MiB;
constexpr int CW_BAR = 4096;
constexpr size_t WS_NEEDED = 2048 * MiB;

struct Args { In in; float* out; unsigned char* ws; };

struct Opt { bf16_t *qt, *spt; float *dcy, *og, *kvt; bf16_t *Wql_t, *Wuv_t, *cnb, *qlat, *olat; float* sc; bf16_t *xb, *WA_t, *WoutA_t, *WB_t, *WoutB_t, *W1_t, *W2_t, *projA_b, *hbf, *o2b, *xs, *act, *Ys, *projB_b; MoeBufs m; };
__device__ __forceinline__ nvp::Ws carve_ws(unsigned char* ws) {
  nvp::Ws w; auto at = [&](size_t mib) { return (char*)ws + mib * MiB; };
  w.projA = (float*)at(2); w.cn = (float*)at(119); w.sc = (float*)at(135); w.idx = (int*)at(647); w.o2 = (float*)at(663);
  w.x1 = (float*)at(727); w.x2 = (float*)at(791);
  w.projB = (float*)at(135); w.adec = (float*)at(135 + 194); w.og = (float*)at(135 + 194 + 32); w.on = (float*)at(135 + 194 + 32 + 64);
  w.counts = nullptr; w.h = nullptr; w.hb = nullptr; w.ys = nullptr; w.tok_e = nullptr; w.tok_g = nullptr; w.slot_of = nullptr; w.row_tok = nullptr; w.row_gate = nullptr; w.blk_e = nullptr;
  return w;
}
__device__ __forceinline__ Opt carve_opt(unsigned char* ws) {
  Opt o; auto at = [&](size_t mib) { return (bf16_t*)((char*)ws + mib * MiB); };
  char* sm = (char*)ws + 855 * MiB;
  o.m.tok_e = (int*)sm; o.m.tok_g = (float*)(sm + 256 * 1024); o.m.slot_of = (int*)(sm + 512 * 1024); o.m.slot_gate = (float*)(sm + 768 * 1024); o.m.blk_e = (int*)(sm + 1088 * 1024); o.m.blkcnt = (int*)(sm + 1096 * 1024); o.m.nblk = (int*)(sm + 1160 * 1024);
  o.WA_t = at(860); o.WoutA_t = at(864); o.WB_t = at(866); o.WoutB_t = at(873);
  o.Wql_t = at(875); o.Wuv_t = at(877); o.olat = at(2); o.cnb = at(647); o.qlat = at(1856); o.sc = (float*)at(135);
  o.qt = at(135); o.dcy = (float*)at(151); o.og = (float*)at(152); o.kvt = (float*)at(216); o.spt = at(344);
  o.W1_t = at(880); o.W2_t = at(1136);
  o.xb = at(1264); o.projA_b = at(1296); o.hbf = at(1360); o.o2b = at(1392);
  o.xs = at(1424); o.act = at(1568); o.Ys = at(1712); o.projB_b = at(1856);
  return o;
}

struct ProIn { const float *a_w_uk, *a_w_uv, *x, *a_w_in, *a_w_out, *b_w_in, *b_w_g2, *b_w_out, *m_w1, *m_w2; };
__device__ __forceinline__ void ph_prologue(const ProIn I, const Opt& o) {
  const int tid = TIDX(), lane = tid & 63, gw = BIDX() * 8 + (tid >> 6), NGW = (int)gridDim.x * 8, gtid = BIDX() * NTHR + tid, NGT = (int)gridDim.x * NTHR;
  cvt_f32_to_bf16(I.x, D, o.xb, D, NT, D, gtid, NGT);
  zero_rect(o.WA_t, D, DINA, 2048 - DINA, 0, D * 2, gtid, NGT);
  for (int i = gtid; i < 512 * 256; i += NGT) { const int n = i >> 8, k4 = (i & 255) * 4; float a[4];
#pragma unroll
    for (int z = 0; z < 4; ++z) { const float* gl = I.b_w_in + (size_t)(k4 + z) * DINB + 2048; float s = 0.f;
#pragma unroll
      for (int j = 0; j < 16; ++j) s = fmaf(gl[j], I.b_w_g2[j * 512 + n], s);
      a[z] = s; }
    *(v2u*)(o.WB_t + (size_t)(3072 + n) * D + k4) = (v2u){cvt_pk_bf16(a[0], a[1]), cvt_pk_bf16(a[2], a[3])}; }
  int w0 = 0;
#pragma unroll 1
  for (int h = 0; h < 16; ++h) {
    transpose_job(mk_tjob(I.a_w_uk + (size_t)h * 64 * 256, 256, 64, 256, o.Wql_t, 256, h * 256, (h & 3) * 64, 0), w0, gw, NGW, lane);
    transpose_job(mk_tjob(I.a_w_uv + (size_t)h * 256 * 64, 64, 256, 64, o.Wuv_t, 1024, h * 64, (h & 3) * 256, 0), w0, gw, NGW, lane);
    for (int hp = 0; hp < 4; ++hp) if (hp != (h & 3)) { zero_rect(o.Wql_t, 256, h * 256, 256, hp * 128, 128, gtid, NGT); zero_rect(o.Wuv_t, 1024, h * 64, 64, hp * 512, 512, gtid, NGT); }
  }
  transpose_job(mk_tjob(I.a_w_in, DINA, D, DINA, o.WA_t, D, 0, 0, 0), w0, gw, NGW, lane);
  transpose_job(mk_tjob(I.a_w_out, D, D, D, o.WoutA_t, D, 0, 0, 0), w0, gw, NGW, lane);
  transpose_job(mk_tjob(I.b_w_in, DINB, D, 2048, o.WB_t, D, 0, 0, 0), w0, gw, NGW, lane);
  transpose_job(mk_tjob(I.b_w_in + 2064, DINB, D, 1024, o.WB_t, D, 2048, 0, 0), w0, gw, NGW, lane);
  transpose_job(mk_tjob(I.b_w_out, D, D, D, o.WoutB_t, D, 0, 0, 0), w0, gw, NGW, lane);
#pragma unroll 1
  for (int le = 0; le < 64; ++le) transpose_job(mk_tjob(I.m_w1 + (size_t)le * D * 2048, 2048, D, 2048, o.W1_t + (size_t)le * 2048 * D, D, 0, 0, 1), w0, gw, NGW, lane);
#pragma unroll 1
  for (int le = 0; le < 64; ++le) transpose_job(mk_tjob(I.m_w2 + (size_t)le * D * D, D, D, D, o.W2_t + (size_t)le * D * D, D, 0, 0, 0), w0, gw, NGW, lane);
}
__device__ __forceinline__ void ph_gla_shim(const bf16_t* pb, const float* gbias, float* projB, float* adec) {
  const int gtid = BIDX() * NTHR + TIDX(), NGT = (int)gridDim.x * NTHR;
  for (size_t i = gtid; i < (size_t)NT * 896; i += NGT) { const size_t r = i / 896; const int c = (int)(i % 896) * 4; const v2u v = *(const v2u*)(pb + r * 3584 + c);
    const f32x4 f = (f32x4){bf_lo(v[0]), bf_hi(v[0]), bf_lo(v[1]), bf_hi(v[1])};
    if (c < 2048) *(f32x4*)(projB + r * DINB + c) = f;
    else if (c < 3072) *(f32x4*)(projB + r * DINB + 2064 + (c - 2048)) = f;
    else { f32x4 o;
#pragma unroll
      for (int z = 0; z < 4; ++z) { const float a = f[z] + gbias[c - 3072 + z]; const float ls = fminf(a, 0.f) - log1pf(expf(-fabsf(a))); o[z] = expf(ls * (1.f / 16.f)); }
      *(f32x4*)(adec + r * 512 + (c - 3072)) = o; } }
}

#if PROBE == 3
#define GLA_PHASES \
      PH_BEGIN ph_gla_shim(o.projB_b, I.b_g_bias, w.projB, w.adec); PH_END \
      GRID_BAR(); \
      PH_BEGIN nvp::np_gla_scan(w.projB, w.adec, w.og, fl); PH_END \
      GRID_BAR(); \
      PH_BEGIN nvp::np_gla_norm(w.og, w.projB, I.b_norm, w.on); PH_END \
      GRID_BAR(); \
      PH_BEGIN cvt_f32_to_bf16(w.on, D, o.o2b, D, NT, D, gtid_, NGT_); PH_END \
      GRID_BAR(); \
      PH_BEGIN ph_gla_a1(o.projB_b, I.b_g_bias, (bf16_t*)(wsb_ + 489 * MiB), (float*)(wsb_ + 506 * MiB), (float*)(wsb_ + 880 * MiB), (float*)(wsb_ + 505 * MiB), ll); PH_END \
      GRID_BAR(); \
      PH_BEGIN ph_gla_a2((float*)(wsb_ + 880 * MiB), (float*)(wsb_ + 505 * MiB), (bf16_t*)(wsb_ + 1136 * MiB)); PH_END \
      GRID_BAR(); \
      PH_BEGIN ph_gla_a3(o.projB_b, (bf16_t*)(wsb_ + 489 * MiB), (float*)(wsb_ + 506 * MiB), (bf16_t*)(wsb_ + 1136 * MiB), I.b_norm, (bf16_t*)(wsb_ + 570 * MiB)); PH_END \
      GRID_BAR(); \
      PH_BEGIN { unsigned* fl_ = (unsigned*)(wsb_ + 512 * 1024); unsigned bits = 0u; \
        { const bf16_t* a = (const bf16_t*)(wsb_ + 489 * MiB); for (size_t i = gtid_; i < (size_t)NT * 512; i += NGT_) { const float v = bf2f(a[i]); if (!(fabsf(v) < 1e30f)) bits |= 1u; } } \
        { const float* a = (const float*)(wsb_ + 506 * MiB); for (size_t i = gtid_; i < (size_t)NT * 1024; i += NGT_) { const float v = a[i]; if (!(fabsf(v) < 1e30f)) bits |= 2u; } } \
        { const float* a = (const float*)(wsb_ + 880 * MiB); for (size_t i = gtid_; i < (size_t)1024 * 32768; i += NGT_) { const float v = a[i]; if (!(fabsf(v) < 1e30f)) bits |= 4u; } } \
        { const bf16_t* a = (const bf16_t*)(wsb_ + 1136 * MiB); for (size_t i = gtid_; i < (size_t)1024 * 32768; i += NGT_) { const float v = bf2f(a[i]); if (!(fabsf(v) < 1e30f)) bits |= 8u; } } \
        { const bf16_t* a = (const bf16_t*)(wsb_ + 570 * MiB); for (size_t i = gtid_; i < (size_t)NT * 1024; i += NGT_) { const float v = bf2f(a[i]); if (!(fabsf(v) < 1e30f)) bits |= 16u; } } \
        { const float* a = (const float*)(wsb_ + 505 * MiB); for (size_t i = gtid_; i < (size_t)1024 * 128; i += NGT_) { const float v = a[i]; if (!(fabsf(v) < 1e30f)) bits |= 32u; } } \
        if (bits) atomicOr(fl_, bits); \
        { float* pd = (float*)(wsb_ + 1968 * MiB); const bf16_t* ob = (const bf16_t*)(wsb_ + 570 * MiB); for (size_t i = gtid_; i < (size_t)NT * D; i += NGT_) pd[i] = bf2f(ob[i]) - w.on[i]; } } PH_END \
      GRID_BAR();
#else
#define GLA_PHASES \
      PH_BEGIN ph_gla_a1(o.projB_b, I.b_g_bias, o.qt, o.og, o.kvt, o.dcy, ll); PH_END \
      GRID_BAR(); \
      PH_BEGIN ph_gla_a2(o.kvt, o.dcy, o.spt); PH_END \
      GRID_BAR(); \
      PH_BEGIN ph_gla_a3(o.projB_b, o.qt, o.og, o.spt, I.b_norm, o.o2b); PH_END \
      GRID_BAR();
#endif
#define LAYER_BODY(li) \
    if (li == 1) { \
      PH_BEGIN StaticOrder S; S.init(o.xb, D, o.WB_t, D, NT, 3584, G_, BIDX()); gemm_phase<EpiStore, StaticOrder, true, true>(ll, Gemm{D, D, D}, S, EpiStore{o.projB_b, 3584}); PH_END \
      GRID_BAR(); \
      GLA_PHASES \
      PH_BEGIN StaticOrder S; S.init(o.o2b, D, o.WoutB_t, D, NT, D, G_, BIDX()); gemm_phase<EpiStore, StaticOrder, true, true>(ll, Gemm{D, D, D}, S, EpiStore{o.hbf, D}); PH_END \
      GRID_BAR(); \
    } \
    PH_BEGIN ph_ln_router(li == 0 ? I.x : w.x2, o.hbf, I.ln1_g + li * D, I.ln1_b + li * D, I.m_w_router + (size_t)li * D * 32, I.m_b_router + li * 32, w.x1, o.m, fl); PH_END \
    GRID_BAR(); \
    PH_BEGIN ph_moe_scatter(w.x1, o.xs, o.m, (int*)lds); PH_END \
    GRID_BAR(); \
    PH_BEGIN MoeOrder S; S.init(o.xs, D, o.W1_t + (size_t)li * 32 * 2048 * D, D, (size_t)2048 * D * 2, __builtin_amdgcn_readfirstlane(*o.m.nblk), 8, 128, o.m.blk_e, G_, BIDX()); \
      gemm_phase<pg8::EpiSwiglu, MoeOrder, true, true>(ll, Gemm{D, D, D}, S, pg8::EpiSwiglu{o.act, D, I.m_b1 + (size_t)li * 32 * 2048}); PH_END \
    GRID_BAR(); \
    PH_BEGIN MoeOrder S; S.init(o.act, D, o.W2_t + (size_t)li * 32 * D * D, D, (size_t)D * D * 2, __builtin_amdgcn_readfirstlane(*o.m.nblk), 4, 256, o.m.blk_e, G_, BIDX()); \
      gemm_phase<pg8::EpiMoe2, MoeOrder, true, true>(ll, Gemm{D, D, D}, S, pg8::EpiMoe2{o.Ys, D, I.m_b2 + (size_t)li * 32 * D, o.m.slot_gate}); PH_END \
    GRID_BAR(); \
    PH_BEGIN ph_combine_ln(w.x1, o.Ys, o.m.slot_of, I.ln2_g + li * D, I.ln2_b + li * D, li == 0 ? w.x2 : out_, li == 0 ? o.xb : nullptr); PH_END \
    if (li == 0) GRID_BAR();
__global__ void __launch_bounds__(NTHR, 2) mk_fwd(Args args) {
  extern __shared__ __attribute__((aligned(16))) unsigned char lds[];
  volatile LAS unsigned* MISC = (volatile LAS unsigned*)((LAS unsigned char*)lds + MISC_OFF);
  if (threadIdx.x < 32) MISC[threadIdx.x] = 0u;
  __syncthreads();
  XcdBarrier bar; { const __attribute__((address_space(4))) Args* ka0 = (const __attribute__((address_space(4))) Args*)__builtin_amdgcn_kernarg_segment_ptr(); bar = xcd_barrier_post((unsigned*)(ka0->ws + WS_CTL) + CW_BAR, MISC + 8); }
#define GRID_BAR() xcd_barrier(bar)
#define PH_BEGIN { const __attribute__((address_space(4))) Args* ka_ = (const __attribute__((address_space(4))) Args*)__builtin_amdgcn_kernarg_segment_ptr(); asm volatile("" : "+s"(ka_)); \
    float* const out_ = ka_->out; (void)out_; unsigned char* wsb_ = ka_->ws; const nvp::Ws w = carve_ws(wsb_); (void)w; const Opt o = carve_opt(wsb_); (void)o; \
    const int gtid_ = BIDX() * NTHR + TIDX(), NGT_ = (int)gridDim.x * NTHR; (void)gtid_; (void)NGT_; const int G_ = (int)gridDim.x; (void)G_;
#define PH_END }
#define I (ka_->in)
  float* fl = (float*)lds; LAS unsigned char* ll = (LAS unsigned char*)lds;
  using pg8::gemm_phase; using pg8::StaticOrder; using pg8::MoeOrder; using pg8::Gemm; using pg8::EpiStore;
  PH_BEGIN ph_prologue(ProIn{I.a_w_uk, I.a_w_uv, I.x, I.a_w_in, I.a_w_out, I.b_w_in, I.b_w_g2, I.b_w_out, I.m_w1, I.m_w2}, o); PH_END
  GRID_BAR();
  PH_BEGIN StaticOrder S; S.init(o.xb, D, o.WA_t, D, NT, 2048, G_, BIDX()); gemm_phase<EpiStore, StaticOrder, true, true>(ll, Gemm{D, D, D}, S, EpiStore{o.projA_b, 2048}); PH_END
  GRID_BAR();
  PH_BEGIN ph_cnorm_b(o.projA_b, I.a_kv_norm, o.cnb); PH_END
  PH_BEGIN pg8::GroupAOrder S; S.init(o.projA_b, 2048, o.Wql_t, 256, NT, 4096, 4, 512, G_, BIDX()); gemm_phase<EpiStore, pg8::GroupAOrder, true, true>(ll, Gemm{2048, 256, 256}, S, EpiStore{o.qlat, 4096}); PH_END
  PH_BEGIN ph_iscore(o.projA_b, o.sc); PH_END
  GRID_BAR();
  PH_BEGIN ph_select_attend(o.sc, o.qlat, o.cnb, o.olat, ll); PH_END
  GRID_BAR();
  PH_BEGIN pg8::GroupAOrder S; S.init(o.olat, 4096, o.Wuv_t, 1024, NT, 1024, 1, 2048, G_, BIDX()); gemm_phase<EpiStore, pg8::GroupAOrder, true, true>(ll, Gemm{4096, 1024, 1024}, S, EpiStore{o.o2b, D}); PH_END
  GRID_BAR();
#if PROBE == 2
  PH_BEGIN cvt_bf16_to_f32(o.projA_b, 2048, w.projA, DINA, NT, DINA, gtid_, NGT_); PH_END
  GRID_BAR();
  PH_BEGIN nvp::np_cnorm(w.projA, I.a_kv_norm, w.cn); PH_END
  PH_BEGIN nvp::np_iscore(w.projA, w.sc, fl); PH_END
  GRID_BAR();
  PH_BEGIN nvp::np_topk(w.sc, w.idx, (char*)lds); PH_END
  GRID_BAR();
  PH_BEGIN nvp::np_dsa_attn(w.projA, w.cn, w.idx, I.a_w_uk, I.a_w_uv, w.o2, fl); PH_END
  GRID_BAR();
  PH_BEGIN { float* pd = (float*)(wsb_ + 1968 * MiB); for (size_t i = gtid_; i < (size_t)NT * D; i += NGT_) pd[i] = bf2f(o.o2b[i]) - w.o2[i]; } PH_END
  GRID_BAR();
#endif
  PH_BEGIN StaticOrder S; S.init(o.o2b, D, o.WoutA_t, D, NT, D, G_, BIDX()); gemm_phase<EpiStore, StaticOrder, true, true>(ll, Gemm{D, D, D}, S, EpiStore{o.hbf, D}); PH_END
  GRID_BAR();
  { LAYER_BODY(0) }
  { LAYER_BODY(1) }
#if PROBE == 2 || PROBE == 3
  GRID_BAR();
#if PROBE == 3
  PH_BEGIN { if (gtid_ == 0) { const unsigned fb = *(const unsigned*)(wsb_ + 512 * 1024); out_[5] += (float)fb; } const float* pd = (const float*)(wsb_ + 1968 * MiB); for (size_t i = gtid_; i < (size_t)NT * D; i += NGT_) out_[i] += PROBE_S * pd[i]; } PH_END
#else
  PH_BEGIN { const float* pd = (const float*)(wsb_ + 1968 * MiB); for (size_t i = gtid_; i < (size_t)NT * D; i += NGT_) out_[i] += PROBE_S * pd[i]; } PH_END
#endif
#endif
}

extern "C" void kernel_launch(void* const* d_in, const int* in_sizes, int n_in, void* d_out, int out_size, void* d_ws, size_t ws_size, hipStream_t stream) {
  static int grid = 0;
  if (grid == 0) {
    if (n_in != 21 || ws_size < WS_NEEDED) { fprintf(stderr, "kernel_launch: bad inputs (n_in %d) or workspace too small (%zu needed, %zu given)\n", n_in, (size_t)WS_NEEDED, ws_size); grid = -1; return; }
    int dev = 0, cus = 0, per_cu = 0;
    if (hipGetDevice(&dev) != hipSuccess || hipDeviceGetAttribute(&cus, hipDeviceAttributeMultiprocessorCount, dev) != hipSuccess) { grid = -1; return; }
    if (hipFuncSetAttribute((const void*)mk_fwd, hipFuncAttributeMaxDynamicSharedMemorySize, LDS_BYTES) != hipSuccess) { fprintf(stderr, "kernel_launch: hipFuncSetAttribute failed\n"); grid = -1; return; }
    if (hipOccupancyMaxActiveBlocksPerMultiprocessor(&per_cu, (const void*)mk_fwd, NTHR, LDS_BYTES) != hipSuccess || per_cu < 1) fprintf(stderr, "kernel_launch: note: occupancy query reports %d\n", per_cu);
    (void)hipGetLastError();
    grid = cus;
    if (grid != 256) fprintf(stderr, "kernel_launch: built for 256 CUs (token ownership per workgroup); got %d\n", grid);
  }
  if (grid < 0) return;
  if (hipMemsetAsync((char*)d_ws + WS_CTL, 0, CTL_ZERO_BYTES, stream) != hipSuccess) { fprintf(stderr, "kernel_launch: memset failed\n"); return; }
  Args a; memset(&a, 0, sizeof(a));
  const float** f = (const float**)&a.in;
  for (int i = 0; i < 21; ++i) f[i] = (const float*)d_in[i];
  a.out = (float*)d_out; a.ws = (unsigned char*)d_ws;
  hipLaunchKernelGGL(mk_fwd, dim3(grid), dim3(NTHR), LDS_BYTES, stream, a);
  const hipError_t le = hipPeekAtLastError();
  if (le != hipSuccess) fprintf(stderr, "kernel_launch: launch failed: %s\n", hipGetErrorName(le));
}
```

```cpp
#include <hip/hip_runtime.h>
#include <cstdio>
#include <cstdint>
#include <cstring>

#define GAS __attribute__((address_space(1)))
#define LAS __attribute__((address_space(3)))
#define NTHR 512
constexpr int LDS_BYTES = 147456;
constexpr int MISC_OFF = 131072 + 8192;

#define XB_TMO      128
#define XB_XCNT(j)  (256  + 64 * (j))
#define XB_XSUB(j)  (1280 + 64 * (j))
#define XB_XGEN(j)  (2304 + 64 * (j))
#define XB_TOP      3328
#define XB_TOPGEN   3392
#define XCD_BAR_WORDS 3456
#define XB_SPIN_CAP (1u << 25)
__device__ __forceinline__ unsigned xb_ld(unsigned* p)              { return __hip_atomic_load(p, __ATOMIC_RELAXED, __HIP_MEMORY_SCOPE_AGENT); }
__device__ __forceinline__ unsigned xb_add(unsigned* p, unsigned v) { return __hip_atomic_fetch_add(p, v, __ATOMIC_RELAXED, __HIP_MEMORY_SCOPE_AGENT); }
__device__ __forceinline__ unsigned xb_xcc_id() { return (unsigned)__builtin_amdgcn_s_getreg((3 << 11) | 20) & 0xFu; }
#define XB_SPIN(cond, bar) do { unsigned _sp = 0; while (cond) { __builtin_amdgcn_s_sleep(1); \
    if ((++_sp & 255u) == 0u) { if (xb_ld(&(bar)[XB_TMO])) break; if (_sp > XB_SPIN_CAP) { atomicAdd(&(bar)[XB_TMO], 1u); break; } } } } while (0)
struct XcdBarrier { unsigned* bar; unsigned x; volatile LAS unsigned* st; };
__device__ __forceinline__ XcdBarrier xcd_barrier_post(unsigned* bar, volatile LAS unsigned* st) {
    XcdBarrier b; b.bar = bar; b.x = xb_xcc_id(); b.st = st;
    if (threadIdx.x == 0) (void)xb_add(&bar[XB_XCNT(b.x)], 1u);
    return b;
}
__device__ __forceinline__ void xcd_barrier_complete(unsigned* bar, unsigned x, unsigned& nloc, unsigned& nx) {
    const unsigned G = gridDim.x * gridDim.y * gridDim.z;
    unsigned sum, cnt, mine, sp = 0u;
    for (;;) {
        sum = 0u; cnt = 0u; mine = 0u;
#pragma unroll
        for (unsigned j = 0; j < 16; ++j) { const unsigned c = xb_ld(&bar[XB_XCNT(j)]); sum += c; cnt += (c > 0u) ? 1u : 0u; mine = (j == x) ? c : mine; }
        if (sum == G) break;
        __builtin_amdgcn_s_sleep(1);
        if ((++sp & 255u) == 0u) { if (xb_ld(&bar[XB_TMO])) break; if (sp > XB_SPIN_CAP) { atomicAdd(&bar[XB_TMO], 1u); break; } }
    }
    nloc = mine > 0u ? mine : 1u; nx = cnt > 0u ? cnt : 1u;
}
__device__ __forceinline__ void xcd_barrier(const XcdBarrier& b) {
    asm volatile("s_waitcnt vmcnt(0)" ::: "memory");
    __syncthreads();
    if (threadIdx.x == 0) {
        unsigned* bar = b.bar;
        __builtin_amdgcn_s_waitcnt(0);
        unsigned nloc = b.st[0], nx = b.st[1];
        if (nloc == 0u) { xcd_barrier_complete(bar, b.x, nloc, nx); b.st[0] = nloc; b.st[1] = nx; }
        const unsigned old = xb_add(&bar[XB_XSUB(b.x)], 1u);
        const unsigned gen = old / nloc;
        if (old + 1u == (gen + 1u) * nloc) {
            __builtin_amdgcn_fence(__ATOMIC_RELEASE, "agent");
            asm volatile("s_waitcnt vmcnt(0)" ::: "memory");
            const unsigned og = xb_add(&bar[XB_TOP], 1u);
            const unsigned tg = og / nx;
            if (og + 1u == (tg + 1u) * nx) xb_add(&bar[XB_TOPGEN], 1u);
            else XB_SPIN(xb_ld(&bar[XB_TOPGEN]) == tg, bar);
            __builtin_amdgcn_fence(__ATOMIC_ACQUIRE, "agent");
            xb_add(&bar[XB_XGEN(b.x)], 1u);
            asm volatile("s_waitcnt vmcnt(0)" ::: "memory");
        } else {
            XB_SPIN(xb_ld(&bar[XB_XGEN(b.x)]) == gen, bar);
            __builtin_amdgcn_fence(__ATOMIC_ACQUIRE, "agent");
            asm volatile("s_waitcnt vmcnt(0)" ::: "memory");
        }
    }
    __syncthreads();
}

constexpr int NT = 16384, D = 1024, L = 8192, NB = 2;
constexpr int DINA = 1864, DINB = 3088;
constexpr int PMAX = 73728;
constexpr float ALPHA = 1.4142135623730951f;

struct In { const float *x, *a_w_in, *a_kv_norm, *a_w_uk, *a_w_uv, *a_w_out, *b_w_in, *b_w_g2, *b_g_bias, *b_norm, *b_w_out, *m_w_router, *m_b_router, *m_w1, *m_b1, *m_w2, *m_b2, *ln1_g, *ln1_b, *ln2_g, *ln2_b; };

__device__ __forceinline__ int TIDX() { int t = threadIdx.x; asm volatile("" : "+v"(t)); return t; }
__device__ __forceinline__ int BIDX() { int t = blockIdx.x; asm volatile("" : "+s"(t)); return t; }
__device__ __forceinline__ float wave_sum(float v) {
#pragma unroll
    for (int o = 1; o < 64; o <<= 1) v += __shfl_xor(v, o);
    return v;
}
namespace nvp {
#define WSYNC() asm volatile("s_waitcnt lgkmcnt(0)" ::: "memory")
struct GemmP {
  const float* A; int lda; const int* arow;
  const float* B; int ldb; float* C; int ldc; int M, N, K;
  const int* blk_e; const int* nblk_used; size_t bstride; const float* bias; size_t bias_stride;
};
__device__ __forceinline__ GemmP mkg(const float* A, int lda, const int* arow, const float* B, int ldb, float* C, int ldc, int M, int N, int K, const int* blk_e, const int* nblk_used, size_t bstride, const float* bias, size_t bias_stride) {
  GemmP p; p.A = A; p.lda = lda; p.arow = arow; p.B = B; p.ldb = ldb; p.C = C; p.ldc = ldc; p.M = M; p.N = N; p.K = K; p.blk_e = blk_e; p.nblk_used = nblk_used; p.bstride = bstride; p.bias = bias; p.bias_stride = bias_stride; return p; }

template <int MODE>
__device__ __forceinline__ void np_sgemm(const GemmP p, float* lds) {
  float (*As)[132] = (float (*)[132])lds;
  float (*Bs)[68] = (float (*)[68])(lds + 16 * 132);
  float (*Bu)[68] = (float (*)[68])(lds + 16 * 132 + 16 * 68);
  const int tid = TIDX(), tx = tid & 15, ty = tid >> 4;
  const int ntn = (p.N + 63) / 64, ntm = p.M / 128;
  const int ar = tid >> 2, ak = (tid & 3) * 4;
  const int bk = (tid & 255) >> 4, bn4 = (tid & 15) * 4;
  for (int t = BIDX(); t < ntm * ntn; t += gridDim.x) {
    const int bm = t / ntn, bn = t % ntn;
    const float* B = p.B; const float* bias = p.bias;
    if (MODE != 0) { const int blk = (bm * 128) / 256; if (blk >= *p.nblk_used) continue; const int e = p.blk_e[blk]; B += (size_t)e * p.bstride; bias += (size_t)e * p.bias_stride; }
    const int m0 = bm * 128, n0 = bn * 64;
    const int arow = p.arow ? p.arow[m0 + ar] : (m0 + ar);
    const float* Ap = p.A + (size_t)arow * p.lda + ak;
    const bool bok = (n0 + bn4) < p.N;
    float acc[4][4] = {}, accu[4][4] = {};
    for (int k0 = 0; k0 < p.K; k0 += 16) {
      const float4 av = *(const float4*)(Ap + k0);
      As[ak + 0][ar] = av.x; As[ak + 1][ar] = av.y; As[ak + 2][ar] = av.z; As[ak + 3][ar] = av.w;
      if (tid < 256) { float4 bv = make_float4(0.f, 0.f, 0.f, 0.f); if (bok) bv = *(const float4*)(B + (size_t)(k0 + bk) * p.ldb + n0 + bn4); *(float4*)&Bs[bk][bn4] = bv; }
      else if (MODE == 1) { const float4 uv = *(const float4*)(B + (size_t)(k0 + bk) * p.ldb + 1024 + n0 + bn4); *(float4*)&Bu[bk][bn4] = uv; }
      __syncthreads();
#pragma unroll
      for (int kk = 0; kk < 16; ++kk) {
        const float4 a = *(const float4*)&As[kk][ty * 4];
        const float4 b = *(const float4*)&Bs[kk][tx * 4];
        const float aa[4] = {a.x, a.y, a.z, a.w}, bb[4] = {b.x, b.y, b.z, b.w};
#pragma unroll
        for (int i = 0; i < 4; ++i)
#pragma unroll
          for (int j = 0; j < 4; ++j) acc[i][j] = fmaf(aa[i], bb[j], acc[i][j]);
        if (MODE == 1) {
          const float4 u = *(const float4*)&Bu[kk][tx * 4]; const float uu[4] = {u.x, u.y, u.z, u.w};
#pragma unroll
          for (int i = 0; i < 4; ++i)
#pragma unroll
            for (int j = 0; j < 4; ++j) accu[i][j] = fmaf(aa[i], uu[j], accu[i][j]);
        }
      }
      __syncthreads();
    }
#pragma unroll
    for (int i = 0; i < 4; ++i) {
      const int m = m0 + ty * 4 + i;
#pragma unroll
      for (int j = 0; j < 4; ++j) {
        const int n = n0 + tx * 4 + j; if (n >= p.N) continue;
        float v = acc[i][j];
        if (MODE == 1) {
          float g = v + bias[n], u = accu[i][j] + bias[1024 + n];
          g = fminf(g, 7.f); u = fminf(fmaxf(u, -7.f), 7.f);
          const float glu = g / (1.f + expf(-1.702f * g));
          v = (u + 1.f) * glu;
        } else if (MODE == 2) v += bias[n];
        p.C[(size_t)m * p.ldc + n] = v;
      }
    }
  }
}

#define GW_INIT const int lane = TIDX() & 63, wave = TIDX() >> 6, gw = BIDX() * 8 + wave, NGW = gridDim.x * 8; (void)lane; (void)wave; (void)gw; (void)NGW

__device__ __forceinline__ void np_cnorm(const float* projA, const float* g, float* cn) {
  GW_INIT;
  for (int row = gw; row < NT; row += NGW) {
    const float4 v = *(const float4*)(projA + (size_t)row * DINA + 1024 + lane * 4);
    const float ss = wave_sum(v.x * v.x + v.y * v.y + v.z * v.z + v.w * v.w);
    const float r = rsqrtf(ss * (1.f / 256.f) + 1e-6f); const float4 g4 = *(const float4*)(g + lane * 4);
    *(float4*)(cn + (size_t)row * 256 + lane * 4) = make_float4(v.x * r * g4.x, v.y * r * g4.y, v.z * r * g4.z, v.w * r * g4.w);
  }
}

__device__ __forceinline__ void np_iscore(const float* projA, float* sc, float* lds) {
  float (*As)[132] = (float (*)[132])lds;
  float (*Bs)[68] = (float (*)[68])(lds + 16 * 132);
  const int tid = TIDX(), tx = tid & 15, ty = tid >> 4;
  const int ar = tid >> 2, ak = (tid & 3) * 4;
  const int br = (tid & 255) >> 2;
  for (int u = BIDX(); u < NB * 64 * 128; u += gridDim.x) {
    const int b = u / (64 * 128), tt = (u / 128) % 64, st = u % 128;
    if (st > 2 * tt + 1) continue;
    const int t0 = tt * 128, s0 = st * 64;
    const float* Qp = projA + (size_t)(b * L + t0 + ar) * DINA + 1280 + ak;
    const float* Kp = projA + (size_t)(b * L + s0 + br) * DINA + 1792 + ak;
    float score[4][4] = {};
    for (int h = 0; h < 8; ++h) {
      float acc[4][4] = {};
      for (int k0 = 0; k0 < 64; k0 += 16) {
        const float4 av = *(const float4*)(Qp + h * 64 + k0);
        As[ak + 0][ar] = av.x; As[ak + 1][ar] = av.y; As[ak + 2][ar] = av.z; As[ak + 3][ar] = av.w;
        if (tid < 256) { const float4 bv = *(const float4*)(Kp + k0); Bs[ak + 0][br] = bv.x; Bs[ak + 1][br] = bv.y; Bs[ak + 2][br] = bv.z; Bs[ak + 3][br] = bv.w; }
        __syncthreads();
#pragma unroll
        for (int kk = 0; kk < 16; ++kk) {
          const float4 a = *(const float4*)&As[kk][ty * 4]; const float4 bq = *(const float4*)&Bs[kk][tx * 4];
          const float aa[4] = {a.x, a.y, a.z, a.w}, bb[4] = {bq.x, bq.y, bq.z, bq.w};
#pragma unroll
          for (int i = 0; i < 4; ++i)
#pragma unroll
            for (int j = 0; j < 4; ++j) acc[i][j] = fmaf(aa[i], bb[j], acc[i][j]);
        }
        __syncthreads();
      }
#pragma unroll
      for (int i = 0; i < 4; ++i) {
        const float w = projA[(size_t)(b * L + t0 + ty * 4 + i) * DINA + 1856 + h] * 0.35355339059327373f;
#pragma unroll
        for (int j = 0; j < 4; ++j) score[i][j] += w * fmaxf(acc[i][j] * 0.125f, 0.f);
      }
    }
#pragma unroll
    for (int i = 0; i < 4; ++i)
#pragma unroll
      for (int j = 0; j < 4; ++j) sc[((size_t)(b * L + t0 + ty * 4 + i)) * L + s0 + tx * 4 + j] = score[i][j];
  }
}

__device__ __forceinline__ unsigned f2key(float f) { f = f + 0.0f; const unsigned u = __float_as_uint(f); return (u & 0x80000000u) ? ~u : (u | 0x80000000u); }

__device__ __forceinline__ void np_topk(const float* sc, int* idx_out, char* lds) {
  GW_INIT;
  unsigned* hist = (unsigned*)(lds + wave * 1280); unsigned* cntw = hist + 256;
  for (int row = gw; row < NT; row += NGW) {
    const int t = row % L, n = t + 1;
    const float* s = sc + (size_t)row * L; int* out = idx_out + (size_t)row * 256;
    if (n <= 256) { for (int i = lane; i < 256; i += 64) out[i] = i < n ? i : -1; continue; }
    unsigned prefix = 0, need = 256;
    for (int pass = 3; pass >= 0; --pass) {
      const int shift = pass * 8;
      for (int i = lane; i < 256; i += 64) hist[i] = 0;
      WSYNC();
      for (int i = lane; i < n; i += 64) { const unsigned k = f2key(s[i]); const bool m = (pass == 3) || ((k >> (shift + 8)) == (prefix >> (shift + 8))); if (m) atomicAdd(&hist[(k >> shift) & 255u], 1u); }
      WSYNC();
      unsigned cum = 0; int d = 255; for (; d > 0; --d) { const unsigned hv = hist[d]; if (cum + hv >= need) break; cum += hv; }
      prefix |= ((unsigned)d << shift); need -= cum;
      WSYNC();
    }
    if (lane == 0) *cntw = 0; WSYNC();
    for (int i = lane; i < n; i += 64) { if (f2key(s[i]) > prefix) { const unsigned pos = atomicAdd(cntw, 1u); out[pos] = i; } }
    WSYNC();
    if (lane == 0) { unsigned c = *cntw; unsigned nd = need; for (int i = 0; i < n && nd > 0; ++i) if (f2key(s[i]) == prefix) { out[c++] = i; --nd; } }
    WSYNC();
  }
}

__device__ __forceinline__ void np_dsa_attn(const float* projA, const float* cn, const int* idx, const float* w_uk, const float* w_uv, float* o2, float* lds) {
  const int half = TIDX() >> 8, tid = TIDX() & 255;
  float* base = lds + half * 14336;
  float* qs = base; float (*ql)[256] = (float (*)[256])(base + 1024); float (*pr)[257] = (float (*)[257])(base + 1024 + 4096);
  float (*ol)[256] = (float (*)[256])(base + 1024 + 4096 + 4112); float* red = base + 1024 + 4096 + 4112 + 4096; int* sid = (int*)(red + 16);
  for (int r0 = BIDX() * 2; r0 < NT; r0 += gridDim.x * 2) {
    const int row = r0 + half, b = row / L;
    __syncthreads();
    for (int i = tid; i < 1024; i += 256) qs[i] = projA[(size_t)row * DINA + i];
    sid[tid] = idx[(size_t)row * 256 + tid];
    __syncthreads();
    { const int c = tid;
#pragma unroll 1
      for (int h = 0; h < 16; ++h) { float a = 0.f;
#pragma unroll 8
        for (int d = 0; d < 64; ++d) a = fmaf(qs[h * 64 + d], w_uk[((size_t)h * 64 + d) * 256 + c], a); ql[h][c] = a; } }
    __syncthreads();
    { const int k = tid, key = sid[k];
      float lg[16];
      if (key >= 0) { const float* cr = cn + (size_t)(b * L + key) * 256;
        for (int h = 0; h < 16; ++h) lg[h] = 0.f;
#pragma unroll 2
        for (int c = 0; c < 256; ++c) { const float cv = cr[c];
#pragma unroll
          for (int h = 0; h < 16; ++h) lg[h] = fmaf(ql[h][c], cv, lg[h]); }
#pragma unroll
        for (int h = 0; h < 16; ++h) pr[h][k] = lg[h] * 0.125f;
      } else {
#pragma unroll
        for (int h = 0; h < 16; ++h) pr[h][k] = -INFINITY; } }
    __syncthreads();
    if (tid < 16) { const int h = tid; float m = -INFINITY; for (int k = 0; k < 256; ++k) m = fmaxf(m, pr[h][k]); float su = 0.f; for (int k = 0; k < 256; ++k) { const float e = expf(pr[h][k] - m); pr[h][k] = e; su += e; } red[h] = 1.f / su; }
    __syncthreads();
    { const int c = tid; float a[16];
#pragma unroll
      for (int h = 0; h < 16; ++h) a[h] = 0.f;
#pragma unroll 2
      for (int k = 0; k < 256; ++k) { const int key = sid[k]; if (key < 0) continue; const float cv = cn[(size_t)(b * L + key) * 256 + c];
#pragma unroll
        for (int h = 0; h < 16; ++h) a[h] = fmaf(pr[h][k], cv, a[h]); }
#pragma unroll
      for (int h = 0; h < 16; ++h) ol[h][c] = a[h] * red[h]; }
    __syncthreads();
#pragma unroll 1
    for (int o = tid; o < 1024; o += 256) { const int h = o >> 6, v = o & 63; float a = 0.f;
#pragma unroll 8
      for (int c = 0; c < 256; ++c) a = fmaf(ol[h][c], w_uv[((size_t)h * 256 + c) * 64 + v], a); o2[(size_t)row * 1024 + o] = a; }
  }
  __syncthreads();
}

__device__ __forceinline__ void np_ln_res(const float* x, const float* h, const float* g, const float* bb, float* out) {
  GW_INIT;
  for (int row = gw; row < NT; row += NGW) {
    float4 v[4]; float s = 0.f;
#pragma unroll
    for (int j = 0; j < 4; ++j) { const float4 a = *(const float4*)(x + (size_t)row * D + lane * 4 + 256 * j), hh = *(const float4*)(h + (size_t)row * D + lane * 4 + 256 * j);
      v[j] = make_float4(ALPHA * a.x + hh.x, ALPHA * a.y + hh.y, ALPHA * a.z + hh.z, ALPHA * a.w + hh.w); s += (v[j].x + v[j].y) + (v[j].z + v[j].w); }
    const float mu = wave_sum(s) * (1.f / D); float q = 0.f;
#pragma unroll
    for (int j = 0; j < 4; ++j) { v[j].x -= mu; v[j].y -= mu; v[j].z -= mu; v[j].w -= mu; q += (v[j].x * v[j].x + v[j].y * v[j].y) + (v[j].z * v[j].z + v[j].w * v[j].w); }
    const float r = rsqrtf(wave_sum(q) * (1.f / D) + 1e-5f);
#pragma unroll
    for (int j = 0; j < 4; ++j) { const int c = lane * 4 + 256 * j; const float4 g4 = *(const float4*)(g + c), b4 = *(const float4*)(bb + c);
      *(float4*)(out + (size_t)row * D + c) = make_float4(v[j].x * r * g4.x + b4.x, v[j].y * r * g4.y + b4.y, v[j].z * r * g4.z + b4.z, v[j].w * r * g4.w + b4.w); }
  }
}

__device__ __forceinline__ void np_router(const float* x, const float* wr, const float* br, int* tok_e, float* tok_g, int* counts, int* row_tok, char* lds) {
  GW_INIT;
  for (int i = BIDX() * NTHR + TIDX(); i < PMAX; i += gridDim.x * NTHR) row_tok[i] = 0;
  float* lg = (float*)(lds + wave * 256);
  const int e = lane & 31, hf = lane >> 5;
  for (int tok = gw; tok < NT; tok += NGW) {
    const float* xr = x + (size_t)tok * D + hf * 512; const float* wp = wr + (size_t)hf * 512 * 32 + e; float a = 0.f;
#pragma unroll 8
    for (int d = 0; d < 512; ++d) a = fmaf(xr[d], wp[d * 32], a);
    a += __shfl_xor(a, 32);
    if (hf == 0) lg[e] = a + br[e];
    WSYNC();
    if (lane == 0) { int ei[4]; float ev[4];
      for (int k = 0; k < 4; ++k) { int bi = 0; float bv = -INFINITY; for (int j = 0; j < 32; ++j) if (lg[j] > bv) { bv = lg[j]; bi = j; } ei[k] = bi; ev[k] = bv; lg[bi] = -INFINITY; }
      float su = 0.f, ex[4]; for (int k = 0; k < 4; ++k) { ex[k] = expf(ev[k] - ev[0]); su += ex[k]; }
      for (int k = 0; k < 4; ++k) { tok_e[tok * 4 + k] = ei[k]; tok_g[tok * 4 + k] = ex[k] / su; atomicAdd(&counts[ei[k]], 1); } }
    WSYNC();
  }
}
__device__ __forceinline__ void np_moe_sort(const int* tok_e, const float* tok_g, const int* counts, int* row_tok, float* row_gate, int* slot_of, int* blk_e, int* nblk_used, char* lds) {
  if (BIDX() != 0) return;
  const int e = TIDX(); int* pstart = (int*)lds; int* stage = pstart + 64;
  if (e == 0) { int acc = 0; for (int j = 0; j < 32; ++j) { pstart[j] = acc; const int nb = (counts[j] + 255) / 256; for (int q = 0; q < nb; ++q) blk_e[acc / 256 + q] = j; acc += nb * 256; } pstart[32] = acc; *nblk_used = acc / 256; }
  __syncthreads();
  int pos = e < 32 ? pstart[e] : 0;
  for (int c0 = 0; c0 < NT * 4; c0 += 2048) {
    __syncthreads();
    for (int i = e; i < 2048; i += NTHR) stage[i] = tok_e[c0 + i];
    __syncthreads();
    if (e < 32) for (int i = 0; i < 2048; ++i) if (stage[i] == e) { const int gi = c0 + i; row_tok[pos] = gi >> 2; row_gate[pos] = tok_g[gi]; slot_of[gi] = pos; ++pos; }
  }
  __syncthreads();
}
__device__ __forceinline__ void np_moe_combine_ln(const float* x1, const float* ys, const int* slot_of, const float* tok_g, const float* g, const float* bb, float* out) {
  GW_INIT;
  for (int row = gw; row < NT; row += NGW) {
    float4 v[4]; float s = 0.f; int sl[4]; float gg[4];
#pragma unroll
    for (int k = 0; k < 4; ++k) { sl[k] = slot_of[row * 4 + k]; gg[k] = tok_g[row * 4 + k]; }
#pragma unroll
    for (int j = 0; j < 4; ++j) { const int c = lane * 4 + 256 * j; float4 f = make_float4(0.f, 0.f, 0.f, 0.f);
#pragma unroll
      for (int k = 0; k < 4; ++k) { const float4 y = *(const float4*)(ys + (size_t)sl[k] * D + c); f.x += gg[k] * y.x; f.y += gg[k] * y.y; f.z += gg[k] * y.z; f.w += gg[k] * y.w; }
      const float4 a = *(const float4*)(x1 + (size_t)row * D + c);
      v[j] = make_float4(ALPHA * a.x + f.x, ALPHA * a.y + f.y, ALPHA * a.z + f.z, ALPHA * a.w + f.w); s += (v[j].x + v[j].y) + (v[j].z + v[j].w); }
    const float mu = wave_sum(s) * (1.f / D); float q = 0.f;
#pragma unroll
    for (int j = 0; j < 4; ++j) { v[j].x -= mu; v[j].y -= mu; v[j].z -= mu; v[j].w -= mu; q += (v[j].x * v[j].x + v[j].y * v[j].y) + (v[j].z * v[j].z + v[j].w * v[j].w); }
    const float r = rsqrtf(wave_sum(q) * (1.f / D) + 1e-5f);
#pragma unroll
    for (int j = 0; j < 4; ++j) { const int c = lane * 4 + 256 * j; const float4 g4 = *(const float4*)(g + c), b4 = *(const float4*)(bb + c);
      *(float4*)(out + (size_t)row * D + c) = make_float4(v[j].x * r * g4.x + b4.x, v[j].y * r * g4.y + b4.y, v[j].z * r * g4.z + b4.z, v[j].w * r * g4.w + b4.w); }
  }
}

__device__ __forceinline__ void np_gla_gate(const float* projB, const float* w_g2, const float* gb, float* adec) {
  GW_INIT;
  for (int row = gw; row < NT; row += NGW) {
    float glr[16];
#pragma unroll
    for (int j = 0; j < 16; ++j) glr[j] = projB[(size_t)row * DINB + 2048 + j];
    for (int c = lane; c < 512; c += 64) { float a = gb[c];
#pragma unroll
      for (int j = 0; j < 16; ++j) a = fmaf(glr[j], w_g2[j * 512 + c], a);
      const float ls = fminf(a, 0.f) - log1pf(expf(-fabsf(a))); adec[(size_t)row * 512 + c] = expf(ls * (1.f / 16.f)); }
  }
}
__device__ __forceinline__ void np_gla_scan(const float* projB, const float* adec, float* og, float* lds) {
  if (BIDX() >= 8) return;
  const int b = BIDX() >> 2, h = BIDX() & 3, tid = TIDX(), dv = tid & 255, dh = tid >> 8;
  float (*qs)[128] = (float (*)[128])lds; float (*ks)[128] = (float (*)[128])(lds + 2048); float (*as)[128] = (float (*)[128])(lds + 4096);
  float (*po)[16][256] = (float (*)[16][256])(lds + 6144);
  float S[64];
#pragma unroll
  for (int d = 0; d < 64; ++d) S[d] = 0.f;
  for (int t0 = 0; t0 < L; t0 += 16) {
    __syncthreads();
    for (int i = tid; i < 16 * 128; i += NTHR) { const int tt = i >> 7, d = i & 127; const size_t r = (size_t)(b * L + t0 + tt);
      qs[tt][d] = projB[r * DINB + h * 128 + d] * 0.08838834764831845f; ks[tt][d] = projB[r * DINB + 512 + h * 128 + d]; as[tt][d] = adec[r * 512 + h * 128 + d]; }
    __syncthreads();
#pragma unroll 1
    for (int tt = 0; tt < 16; ++tt) { const size_t r = (size_t)(b * L + t0 + tt); const float v = projB[r * DINB + 1024 + h * 256 + dv]; float o = 0.f;
#pragma unroll
      for (int d = 0; d < 64; ++d) { S[d] = fmaf(as[tt][dh * 64 + d], S[d], ks[tt][dh * 64 + d] * v); o = fmaf(qs[tt][dh * 64 + d], S[d], o); }
      po[dh][tt][dv] = o; }
    __syncthreads();
    for (int i = tid; i < 16 * 256; i += NTHR) { const int tt = i >> 8, c = i & 255; og[(size_t)(b * L + t0 + tt) * 1024 + h * 256 + c] = po[0][tt][c] + po[1][tt][c]; }
  }
  __syncthreads();
}
__device__ __forceinline__ void np_gla_norm(const float* og, const float* projB, const float* ng, float* on) {
  GW_INIT;
  for (int u = gw; u < NT * 4; u += NGW) {
    const int row = u >> 2, h = u & 3; const int c = h * 256 + lane * 4;
    const float4 v = *(const float4*)(og + (size_t)row * 1024 + c);
    const float r = rsqrtf(wave_sum(v.x * v.x + v.y * v.y + v.z * v.z + v.w * v.w) * (1.f / 256.f) + 1e-6f);
    const float4 rr = *(const float4*)(projB + (size_t)row * DINB + 2064 + c), g4 = *(const float4*)(ng + c);
    *(float4*)(on + (size_t)row * 1024 + c) = make_float4(v.x * r * g4.x * (rr.x / (1.f + expf(-rr.x))), v.y * r * g4.y * (rr.y / (1.f + expf(-rr.y))), v.z * r * g4.z * (rr.z / (1.f + expf(-rr.z))), v.w * r * g4.w * (rr.w / (1.f + expf(-rr.w))));
  }
}

struct Ws { float *projA, *cn, *sc, *o2, *h, *x1, *x2, *hb, *ys, *projB, *adec, *og, *on, *tok_g, *row_gate; int *idx, *tok_e, *slot_of, *row_tok, *blk_e, *counts; };
}
typedef unsigned short bf16_t;
typedef unsigned v4u __attribute__((ext_vector_type(4)));
typedef unsigned v2u __attribute__((ext_vector_type(2)));
typedef float f32x4 __attribute__((ext_vector_type(4)));
typedef short bf16x8 __attribute__((ext_vector_type(8)));
typedef float f32x2_t __attribute__((ext_vector_type(2))); typedef __bf16 bf16x2_t __attribute__((ext_vector_type(2)));
__device__ __forceinline__ unsigned cvt_pk_bf16(float lo, float hi) { const f32x2_t v = {lo, hi}; const bf16x2_t b = __builtin_convertvector(v, bf16x2_t); return __builtin_bit_cast(unsigned, b); }
__device__ __forceinline__ float bf_lo(unsigned u) { return __uint_as_float(u << 16); }
__device__ __forceinline__ float bf_hi(unsigned u) { return __uint_as_float(u & 0xffff0000u); }
__device__ __forceinline__ float bf2f(bf16_t h) { return __uint_as_float(((unsigned)h) << 16); }

struct TJob { const float* src; int lds_; int K, N; bf16_t* dst; int ldd; int drow0, dcol0; int rowmap; int ntk, ntn; };
__device__ __forceinline__ TJob mk_tjob(const float* src, int lds_, int K, int N, bf16_t* dst, int ldd, int drow0, int dcol0, int rowmap) {
  TJob j; j.src = src; j.lds_ = lds_; j.K = K; j.N = N; j.dst = dst; j.ldd = ldd; j.drow0 = drow0; j.dcol0 = dcol0; j.rowmap = rowmap; j.ntk = K / 64; j.ntn = (N + 127) / 128; return j; }
__device__ __forceinline__ int tjob_tiles(const TJob& j) { return j.ntk * j.ntn; }
__device__ __forceinline__ void transpose_tile(const TJob& j, int tile, int lane) {
  const int kt = tile / j.ntn, nt_ = tile % j.ntn, k0 = kt * 64, n0 = nt_ * 128;
  const int q = lane & 31, par = lane >> 5;
  const bool ok = (n0 + 4 * q) < j.N;
  f32x4 v[32];
  const float* sp = j.src + (size_t)(k0 + par) * j.lds_ + n0 + 4 * q;
#pragma unroll
  for (int i = 0; i < 32; ++i) v[i] = ok ? *(const f32x4*)(sp + (size_t)(2 * i) * j.lds_) : (f32x4){0.f, 0.f, 0.f, 0.f};
  unsigned ra[32], rb[32];
#pragma unroll
  for (int i = 0; i < 32; ++i) {
    auto s0 = __builtin_amdgcn_permlane32_swap(__float_as_uint(v[i][0]), __float_as_uint(v[i][2]), false, false);
    auto s1 = __builtin_amdgcn_permlane32_swap(__float_as_uint(v[i][1]), __float_as_uint(v[i][3]), false, false);
    ra[i] = cvt_pk_bf16(__uint_as_float(s0[0]), __uint_as_float(s0[1]));
    rb[i] = cvt_pk_bf16(__uint_as_float(s1[0]), __uint_as_float(s1[1]));
  }
  if (ok) {
    const int n = n0 + 4 * q + 2 * par;
    int r0 = n, r1 = n + 1;
    if (j.rowmap == 1) { const int jj0 = r0 & 1023, jj1 = r1 & 1023; r0 = 256 * (jj0 >> 7) + ((r0 >> 10) << 7) + (jj0 & 127); r1 = 256 * (jj1 >> 7) + ((r1 >> 10) << 7) + (jj1 & 127); }
    bf16_t* d0 = j.dst + (size_t)(j.drow0 + r0) * j.ldd + j.dcol0 + k0;
    bf16_t* d1 = j.dst + (size_t)(j.drow0 + r1) * j.ldd + j.dcol0 + k0;
#pragma unroll
    for (int c = 0; c < 8; ++c) { *(v4u*)(d0 + 8 * c) = (v4u){ra[4 * c], ra[4 * c + 1], ra[4 * c + 2], ra[4 * c + 3]}; *(v4u*)(d1 + 8 * c) = (v4u){rb[4 * c], rb[4 * c + 1], rb[4 * c + 2], rb[4 * c + 3]}; }
  }
}
__device__ __forceinline__ void transpose_job(const TJob j, int& w0, int gw, int NGW, int lane) {
  const int nt_ = tjob_tiles(j);
  int first = gw - (w0 % NGW); if (first < 0) first += NGW;
#pragma unroll 1
  for (int t = first; t < nt_; t += NGW) transpose_tile(j, t, lane);
  w0 += nt_;
}
__device__ __forceinline__ void zero_rect(bf16_t* dst, int ldd, int r0, int nr, int cb0, int nbytes, int gtid, int NGT) {
  const int per = nbytes / 16;
  for (int i = gtid; i < nr * per; i += NGT) { const int r = i / per, c = i % per; *(v4u*)((char*)(dst + (size_t)(r0 + r) * ldd) + cb0 + 16 * c) = (v4u){0u, 0u, 0u, 0u}; }
}
__device__ __forceinline__ void cvt_f32_to_bf16(const float* src, int lds_, bf16_t* dst, int ldd, int rows, int ncols, int gtid, int NGT) {
  const int per = ncols / 4;
  for (size_t i = gtid; i < (size_t)rows * per; i += NGT) { const size_t r = i / per; const int c = (int)(i % per) * 4; const f32x4 v = *(const f32x4*)(src + r * lds_ + c);
    *(v2u*)(dst + r * ldd + c) = (v2u){cvt_pk_bf16(v[0], v[1]), cvt_pk_bf16(v[2], v[3])}; }
}
__device__ __forceinline__ void cvt_bf16_to_f32(const bf16_t* src, int lds_, float* dst, int ldd, int rows, int ncols, int gtid, int NGT) {
  const int per = ncols / 4;
  for (size_t i = gtid; i < (size_t)rows * per; i += NGT) { const size_t r = i / per; const int c = (int)(i % per) * 4; const v2u v = *(const v2u*)(src + r * lds_ + c);
    *(f32x4*)(dst + r * ldd + c) = (f32x4){bf_lo(v[0]), bf_hi(v[0]), bf_lo(v[1]), bf_hi(v[1])}; }
}

namespace pg8 {
#define PG8_LAS __attribute__((address_space(3)))
typedef unsigned u32x4 __attribute__((ext_vector_type(4)));
constexpr int BM = 256, BK = 64, HALF = 128, HTB = HALF * BK * 2, STAGE_BYTES = 8 * HTB, NXCD = 8, WGM = 8;
__host__ __device__ __forceinline__ int lds_byte(int r, int c) { const int st = (r >> 4) * 2 + (c >> 5), rr = r & 15, cc = c & 31, ob = rr * 64 + cc * 2; return st * 1024 + (ob ^ (((ob >> 9) & 1) << 5)); }
__host__ __device__ __forceinline__ void stage_rc(int b, int& R, int& C) { const int st = b / 1024, sb = b % 1024, swz = sb ^ (((sb >> 9) & 1) << 5); R = (st >> 1) * 16 + swz / 64; C = (st & 1) * 32 + (swz % 64) / 2; }
__host__ __device__ __forceinline__ int perm32(int rho) { const int n = rho >> 4, i = rho & 15; return 8 * (i >> 2) + 4 * n + (i & 3); }
struct Unit { const char* pa; const char* pb; int orow, ocol, e; };
struct Gemm { int lda, ldb, K; };
struct StaticOrder {
    const char* A; const char* Bt; size_t ta, tb; int nM, nN, nwg, G, c;
    __device__ void init(const void* A_, int lda, const void* Bt_, int ldb, int M, int N, int G_, int c_) { A = (const char*)A_; Bt = (const char*)Bt_; ta = (size_t)BM * lda * 2; tb = (size_t)BM * ldb * 2; nM = M / BM; nN = N / BM; nwg = nM * nN; G = G_; c = c_; }
    __device__ bool tile(int i, int& pm, int& pn) const {
        const long L = (long)i * G + c; if (L >= nwg) return false;
        int wgid = (int)L; { const int q = nwg / NXCD, r = nwg % NXCD, xcd = wgid % NXCD, off = wgid / NXCD; wgid = (xcd < r ? xcd * (q + 1) : r * (q + 1) + (xcd - r) * q) + off; }
        const int nig = WGM * nN, gid = wgid / nig, fm = gid * WGM, gsz = (nM - fm) < WGM ? (nM - fm) : WGM;
        pm = fm + ((wgid % nig) % gsz); pn = (wgid % nig) / gsz; return true;
    }
    __device__ bool next(int i, Unit& u) const { int pm, pn; if (!tile(i, pm, pn)) return false; u.pa = A + (size_t)pm * ta; u.pb = Bt + (size_t)pn * tb; u.orow = pm * BM; u.ocol = pn * BM; u.e = 0; return true; }
    __device__ __forceinline__ void a_ready(const Unit&) const {}
    __device__ __forceinline__ void done(const Unit&) const {}
};
struct EpiStore {
    static constexpr bool PERM = true, AFTER_DRAIN = false;
    bf16_t* O; int ldc;
    __device__ __forceinline__ void operator()(const f32x4 (&acc)[2][2][4][2], const Unit& u, int wr, int wc, int fr, int fq) const {
        const int row0 = u.orow + wr * 64 + fr, col0 = u.ocol + wc * 32 + 8 * fq;
#pragma unroll
        for (int ai = 0; ai < 2; ++ai)
#pragma unroll
            for (int m = 0; m < 4; ++m) { bf16_t* rowp = O + (size_t)(row0 + ai * HALF + m * 16) * ldc + col0;
#pragma unroll
                for (int bj = 0; bj < 2; ++bj) { const f32x4 v0 = acc[ai][bj][m][0], v1 = acc[ai][bj][m][1];
                    u32x4 w; w.x = cvt_pk_bf16(v0[0], v0[1]); w.y = cvt_pk_bf16(v0[2], v0[3]); w.z = cvt_pk_bf16(v1[0], v1[1]); w.w = cvt_pk_bf16(v1[2], v1[3]);
                    *(u32x4*)(rowp + bj * HALF) = w; } }
    }
};
template <class Epi, class Sched, bool ALIGN_EPI = false, bool SP2 = false>
__device__ __forceinline__ void gemm_phase(PG8_LAS unsigned char* lds, const Gemm g, const Sched& S, const Epi& E) {
    const int tid = TIDX(), wid = __builtin_amdgcn_readfirstlane(tid >> 6), lane = tid & 63, wr = wid >> 2, wc = wid & 3, fr = lane & 15, fq = lane >> 4;
    const int K = g.K, nt = K / BK;
    unsigned voffA[2], voffB[2];
#pragma unroll
    for (int i = 0; i < 2; ++i) { int R, C; stage_rc(tid * 16 + i * 8192, R, C); const int Rb = Epi::PERM ? ((R & ~31) + perm32(R & 31)) : R;
        voffA[i] = (unsigned)(R * g.lda + C) * 2u; voffB[i] = (unsigned)(Rb * g.ldb + C) * 2u; }
    const size_t kstep = (size_t)(BK * 2);
    const size_t hstepA = (size_t)HALF * g.lda * 2, hstepB = (size_t)HALF * g.ldb * 2;
    const unsigned ldsw = (unsigned)wid * 1024u;
    const int aoff = lds_byte(wr * 64 + fr, fq * 8), boff = lds_byte(wc * 32 + fr, fq * 8);
#define PG8_SA(b, h) (((b) * 2 + (h)) * HTB)
#define PG8_SB(b, h) ((4 + (b) * 2 + (h)) * HTB)
#define PG8_STAGE(bufoff, gbase, voff) do { _Pragma("unroll") for (int _i = 0; _i < 2; ++_i) \
        __builtin_amdgcn_global_load_lds((const unsigned*)((const char*)(gbase) + (voff)[_i]), (PG8_LAS unsigned*)(lds + (bufoff) + ldsw + _i * 8192), 16, 0, 0); } while (0)
#define PG8_LDA(dst, b, h) do { _Pragma("unroll") for (int m = 0; m < 4; ++m) _Pragma("unroll") for (int k = 0; k < 2; ++k) dst[m][k] = *(const PG8_LAS bf16x8*)(lds + PG8_SA(b, h) + aoff + m * 2048 + k * 1024); } while (0)
#define PG8_LDB(dst, b, h) do { _Pragma("unroll") for (int n = 0; n < 2; ++n) _Pragma("unroll") for (int k = 0; k < 2; ++k) dst[n][k] = *(const PG8_LAS bf16x8*)(lds + PG8_SB(b, h) + boff + n * 2048 + k * 1024); } while (0)
#define PG8_MMA(ai, bj, At, Bt) do { __builtin_amdgcn_s_setprio(1); _Pragma("unroll") for (int m = 0; m < 4; ++m) _Pragma("unroll") for (int n = 0; n < 2; ++n) _Pragma("unroll") for (int k = 0; k < 2; ++k) \
        acc[ai][bj][m][n] = __builtin_amdgcn_mfma_f32_16x16x32_bf16(Bt[n][k], At[m][k], acc[ai][bj][m][n], 0, 0, 0); __builtin_amdgcn_s_setprio(0); } while (0)
#define PG8_WAIT_V(n) asm volatile("s_waitcnt vmcnt(" #n ")" ::: "memory")
#define PG8_WAIT_L(n) asm volatile("s_waitcnt lgkmcnt(" #n ")" ::: "memory")
#define PG8_BAR __builtin_amdgcn_s_barrier()
#define PG8_SCHED __builtin_amdgcn_sched_barrier(0)
    Unit cur, nxt; int ui = 0;
    if (!S.next(0, cur)) return;
    f32x4 acc[2][2][4][2];
#pragma unroll
    for (int a = 0; a < 2; ++a)
#pragma unroll
        for (int b = 0; b < 2; ++b)
#pragma unroll
            for (int m = 0; m < 4; ++m)
#pragma unroll
                for (int n = 0; n < 2; ++n) acc[a][b][m][n] = (f32x4){0.f, 0.f, 0.f, 0.f};
    bf16x8 At[4][2], B0[2][2], B1[2][2];
    const char* cA = cur.pa; const char* cB = cur.pb;
    S.a_ready(cur);
    if constexpr (SP2) {
        PG8_STAGE(PG8_SB(0, 0), cB, voffB); PG8_STAGE(PG8_SB(0, 1), cB + hstepB, voffB); PG8_STAGE(PG8_SA(0, 0), cA, voffA); PG8_STAGE(PG8_SA(0, 1), cA + hstepA, voffA);
        if (wr == 1) PG8_BAR;
        PG8_WAIT_V(2); PG8_BAR;
        PG8_STAGE(PG8_SB(1, 0), cB + kstep, voffB); PG8_STAGE(PG8_SA(1, 0), cA + kstep, voffA); PG8_STAGE(PG8_SB(1, 1), cB + hstepB + kstep, voffB);
        PG8_WAIT_V(6); PG8_BAR;
    } else {
        PG8_STAGE(PG8_SB(0, 0), cB, voffB); PG8_STAGE(PG8_SA(0, 0), cA, voffA); PG8_STAGE(PG8_SB(0, 1), cB + hstepB, voffB); PG8_STAGE(PG8_SA(0, 1), cA + hstepA, voffA);
        if (wr == 1) PG8_BAR;
        PG8_WAIT_V(4); PG8_BAR;
        PG8_STAGE(PG8_SB(1, 0), cB + kstep, voffB); PG8_STAGE(PG8_SA(1, 0), cA + kstep, voffA); PG8_STAGE(PG8_SB(1, 1), cB + hstepB + kstep, voffB);
        PG8_WAIT_V(6); PG8_BAR;
    }
    for (;;) {
        const bool has_next = S.next(ui + 1, nxt);
        const char* nA = has_next ? nxt.pa : cA; const char* nB = has_next ? nxt.pb : cB;
        for (int t = 0; t < nt; t += 2) {
            const bool last = (t == nt - 2);
            const char* a1 = cA + (size_t)(t + 1) * kstep;
            const char* a2 = last ? nA : cA + (size_t)(t + 2) * kstep; const char* b2 = last ? nB : cB + (size_t)(t + 2) * kstep;
            const char* a3 = a2 + kstep; const char* b3 = b2 + kstep;
            if (last && has_next) S.a_ready(nxt);
            if constexpr (SP2) {
            PG8_LDB(B0, 0, 0); PG8_LDB(B1, 0, 1); PG8_SCHED; PG8_LDA(At, 0, 0); PG8_STAGE(PG8_SA(1, 1), a1 + hstepA, voffA);
            PG8_WAIT_V(8); PG8_WAIT_L(0); PG8_BAR; PG8_MMA(0, 0, At, B0); PG8_MMA(0, 1, At, B1); PG8_BAR; PG8_SCHED;
            PG8_LDA(At, 0, 1); PG8_STAGE(PG8_SB(0, 0), b2, voffB); PG8_STAGE(PG8_SB(0, 1), b2 + hstepB, voffB); PG8_STAGE(PG8_SA(0, 0), a2, voffA);
            PG8_WAIT_V(8); PG8_WAIT_L(0); PG8_BAR; PG8_MMA(1, 0, At, B0); PG8_MMA(1, 1, At, B1); PG8_BAR; PG8_SCHED;
            PG8_LDB(B0, 1, 0); PG8_LDB(B1, 1, 1); PG8_SCHED; PG8_LDA(At, 1, 0); PG8_STAGE(PG8_SA(0, 1), a2 + hstepA, voffA);
            PG8_WAIT_V(8); PG8_WAIT_L(0); PG8_BAR; PG8_MMA(0, 0, At, B0); PG8_MMA(0, 1, At, B1); PG8_BAR; PG8_SCHED;
            PG8_LDA(At, 1, 1); PG8_STAGE(PG8_SB(1, 0), b3, voffB); PG8_STAGE(PG8_SB(1, 1), b3 + hstepB, voffB); PG8_STAGE(PG8_SA(1, 0), a3, voffA);
            PG8_WAIT_V(8); PG8_WAIT_L(0); PG8_BAR; PG8_MMA(1, 0, At, B0); PG8_MMA(1, 1, At, B1); PG8_BAR; PG8_SCHED;
            } else {
            PG8_LDB(B0, 0, 0); PG8_SCHED; PG8_LDA(At, 0, 0); PG8_STAGE(PG8_SA(1, 1), a1 + hstepA, voffA);
            PG8_WAIT_L(8); PG8_BAR; PG8_WAIT_L(0); PG8_MMA(0, 0, At, B0); PG8_BAR; PG8_SCHED;
            PG8_LDB(B1, 0, 1); PG8_STAGE(PG8_SB(0, 0), b2, voffB);
            PG8_BAR; PG8_WAIT_L(0); PG8_MMA(0, 1, At, B1); PG8_BAR;
            PG8_LDA(At, 0, 1); PG8_STAGE(PG8_SA(0, 0), a2, voffA);
            PG8_BAR; PG8_WAIT_L(0); PG8_MMA(1, 0, At, B0); PG8_BAR; PG8_SCHED;
            PG8_STAGE(PG8_SB(0, 1), b2 + hstepB, voffB);
            PG8_WAIT_V(6); PG8_BAR; PG8_MMA(1, 1, At, B1); PG8_BAR;
            PG8_LDB(B0, 1, 0); PG8_SCHED; PG8_LDA(At, 1, 0); PG8_STAGE(PG8_SA(0, 1), a2 + hstepA, voffA);
            PG8_WAIT_L(8); PG8_BAR; PG8_WAIT_L(0); PG8_MMA(0, 0, At, B0); PG8_BAR; PG8_SCHED;
            PG8_LDB(B1, 1, 1); PG8_STAGE(PG8_SB(1, 0), b3, voffB);
            PG8_BAR; PG8_WAIT_L(0); PG8_MMA(0, 1, At, B1); PG8_BAR;
            PG8_LDA(At, 1, 1); PG8_STAGE(PG8_SA(1, 0), a3, voffA);
            PG8_BAR; PG8_WAIT_L(0); PG8_MMA(1, 0, At, B0); PG8_BAR; PG8_SCHED;
            PG8_STAGE(PG8_SB(1, 1), b3 + hstepB, voffB);
            PG8_WAIT_V(6); PG8_BAR; PG8_MMA(1, 1, At, B1); PG8_BAR;
            }
        }
        if constexpr (ALIGN_EPI) { if (wr == 0) PG8_BAR; }
        if constexpr (!Epi::AFTER_DRAIN) { E(acc, cur, wr, wc, fr, fq); S.done(cur); }
        if (!has_next) break;
#pragma unroll
        for (int a = 0; a < 2; ++a)
#pragma unroll
            for (int b = 0; b < 2; ++b)
#pragma unroll
                for (int m = 0; m < 4; ++m)
#pragma unroll
                    for (int n = 0; n < 2; ++n) acc[a][b][m][n] = (f32x4){0.f, 0.f, 0.f, 0.f};
        cur = nxt; cA = nA; cB = nB; ++ui;
        if constexpr (ALIGN_EPI) { if (wr == 1) PG8_BAR; }
    }
    PG8_WAIT_V(0);
    if constexpr (!ALIGN_EPI) { if (wr == 0) PG8_BAR; }
    PG8_BAR;
    if constexpr (Epi::AFTER_DRAIN) { E.fused(acc, cur, wr, wc, fr, fq, lds, wid, lane); S.done(cur); }
#undef PG8_SA
#undef PG8_SB
#undef PG8_STAGE
#undef PG8_LDA
#undef PG8_LDB
#undef PG8_MMA
#undef PG8_WAIT_V
#undef PG8_WAIT_L
#undef PG8_BAR
#undef PG8_SCHED
}

}
#define WSYNC2() asm volatile("s_waitcnt lgkmcnt(0)" ::: "memory")
struct MoeBufs { int* tok_e; float* tok_g; int* slot_of; float* slot_gate; int* blk_e; int* blkcnt; int* nblk; };
constexpr int WRT_LD = 1028;

__device__ __forceinline__ void ph_ln_router(const float* xin, const bf16_t* hb, const float* g, const float* bb, const float* wr, const float* br, float* x1, const MoeBufs m, float* lds) {
  const int tid = TIDX(), lane = tid & 63, wave = tid >> 6, blk = BIDX();
  float* wT = lds;
  float* lg = lds + 32 * WRT_LD + wave * 64;
  int* cnt = (int*)(lds + 32 * WRT_LD + 8 * 64);
  { f32x4 wv[16];
#pragma unroll
    for (int k = 0; k < 16; ++k) wv[k] = *(const f32x4*)(wr + (size_t)(tid + NTHR * k) * 4);
#pragma unroll
    for (int k = 0; k < 16; ++k) { const int i = (tid + NTHR * k) * 4, d = i >> 5, e = i & 31;
#pragma unroll
      for (int z = 0; z < 4; ++z) wT[(e + z) * WRT_LD + d] = wv[k][z]; } }
  if (tid < 32) cnt[tid] = 0;
  __syncthreads();
  for (int it = 0; it < 8; ++it) {
    const int tok = blk * 64 + wave * 8 + it; if (tok >= NT) break;
    f32x4 v[4]; float s = 0.f;
#pragma unroll
    for (int j = 0; j < 4; ++j) { const int c = lane * 4 + 256 * j; const f32x4 a = *(const f32x4*)(xin + (size_t)tok * D + c); const v2u hh = *(const v2u*)(hb + (size_t)tok * D + c);
      v[j] = (f32x4){ALPHA * a[0] + bf_lo(hh[0]), ALPHA * a[1] + bf_hi(hh[0]), ALPHA * a[2] + bf_lo(hh[1]), ALPHA * a[3] + bf_hi(hh[1])}; s += (v[j][0] + v[j][1]) + (v[j][2] + v[j][3]); }
    const float mu = wave_sum(s) * (1.f / D); float q = 0.f;
#pragma unroll
    for (int j = 0; j < 4; ++j) { v[j] = v[j] - mu; q += (v[j][0] * v[j][0] + v[j][1] * v[j][1]) + (v[j][2] * v[j][2] + v[j][3] * v[j][3]); }
    const float r = rsqrtf(wave_sum(q) * (1.f / D) + 1e-5f);
#pragma unroll
    for (int j = 0; j < 4; ++j) { const int c = lane * 4 + 256 * j; const f32x4 g4 = *(const f32x4*)(g + c), b4 = *(const f32x4*)(bb + c); v[j] = v[j] * r * g4 + b4; *(f32x4*)(x1 + (size_t)tok * D + c) = v[j]; }
    float p[32];
#pragma unroll
    for (int e = 0; e < 32; ++e) { float a = 0.f;
#pragma unroll
      for (int j = 0; j < 4; ++j) { const f32x4 w4 = *(const f32x4*)(wT + e * WRT_LD + lane * 4 + 256 * j); a = fmaf(v[j][0], w4[0], a); a = fmaf(v[j][1], w4[1], a); a = fmaf(v[j][2], w4[2], a); a = fmaf(v[j][3], w4[3], a); }
      p[e] = a; }
#pragma unroll
    for (int i = 0; i < 16; ++i) { const bool hi = (lane & 32) != 0; const float send = hi ? p[i] : p[i + 16]; const float keep = hi ? p[i + 16] : p[i]; p[i] = keep + __shfl_xor(send, 32); }
#pragma unroll
    for (int i = 0; i < 8; ++i) { const bool hi = (lane & 16) != 0; const float send = hi ? p[i] : p[i + 8]; const float keep = hi ? p[i + 8] : p[i]; p[i] = keep + __shfl_xor(send, 16); }
#pragma unroll
    for (int i = 0; i < 4; ++i) { const bool hi = (lane & 8) != 0; const float send = hi ? p[i] : p[i + 4]; const float keep = hi ? p[i + 4] : p[i]; p[i] = keep + __shfl_xor(send, 8); }
#pragma unroll
    for (int i = 0; i < 2; ++i) { const bool hi = (lane & 4) != 0; const float send = hi ? p[i] : p[i + 2]; const float keep = hi ? p[i + 2] : p[i]; p[i] = keep + __shfl_xor(send, 4); }
    { const bool hi = (lane & 2) != 0; const float send = hi ? p[0] : p[1]; const float keep = hi ? p[1] : p[0]; p[0] = keep + __shfl_xor(send, 2); }
    p[0] += __shfl_xor(p[0], 1);
    const int e_l = ((lane >> 5) & 1) * 16 + ((lane >> 4) & 1) * 8 + ((lane >> 3) & 1) * 4 + ((lane >> 2) & 1) * 2 + ((lane >> 1) & 1);
    float lv = p[0] + br[e_l]; int ei[4]; float ev[4];
#pragma unroll
    for (int k = 0; k < 4; ++k) { float bv = lv; int bi = e_l;
#pragma unroll
      for (int o = 2; o < 64; o <<= 1) { const float ov = __shfl_xor(bv, o); const int oi = __shfl_xor(bi, o); const bool take = (ov > bv) || (ov == bv && oi < bi); bv = take ? ov : bv; bi = take ? oi : bi; }
      ei[k] = bi; ev[k] = bv; if (e_l == bi) lv = -INFINITY; }
    if (lane == 0) {
      float ex[4], su = 0.f;
#pragma unroll
      for (int k = 0; k < 4; ++k) { ex[k] = __expf(ev[k] - ev[0]); su += ex[k]; }
      const float inv = 1.f / su;
      *(int4*)(m.tok_e + tok * 4) = make_int4(ei[0], ei[1], ei[2], ei[3]);
      *(float4*)(m.tok_g + tok * 4) = make_float4(ex[0] * inv, ex[1] * inv, ex[2] * inv, ex[3] * inv);
#pragma unroll
      for (int k = 0; k < 4; ++k) atomicAdd(&cnt[ei[k]], 1); }
  }
  __syncthreads();
  if (tid < 32) m.blkcnt[blk * 32 + tid] = cnt[tid];
  __syncthreads();
}

__device__ __forceinline__ void ph_moe_scatter(const float* x1, bf16_t* xs, const MoeBufs m, int* ilds) {
  const int tid = TIDX(), lane = tid & 63, wave = tid >> 6, blk = BIDX(), G = (int)gridDim.x;
  int* tot = ilds; int* bef = ilds + 32; int* pst = ilds + 64; int* es = ilds + 128; int* sl = ilds + 128 + 256;
  if (tid < 64) ilds[tid] = 0;
  __syncthreads();
  { const int bp = tid >> 1, e0 = (tid & 1) * 16;
    if (bp < G) {
#pragma unroll
      for (int q = 0; q < 4; ++q) { const int4 c = *(const int4*)(m.blkcnt + bp * 32 + e0 + 4 * q); const int cc[4] = {c.x, c.y, c.z, c.w};
#pragma unroll
        for (int z = 0; z < 4; ++z) { atomicAdd(&tot[e0 + 4 * q + z], cc[z]); if (bp < blk) atomicAdd(&bef[e0 + 4 * q + z], cc[z]); } } } }
  if (tid < 256) es[tid] = m.tok_e[blk * 256 + tid];
  __syncthreads();
  if (tid == 0) { int acc = 0; for (int e = 0; e < 32; ++e) { pst[e] = acc; acc += ((tot[e] + 255) >> 8) << 8; } pst[32] = acc;
    if (blk == 0) { *m.nblk = acc >> 8; for (int e = 0; e < 32; ++e) for (int q = pst[e] >> 8; q < (pst[e + 1] >> 8); ++q) m.blk_e[q] = e; } }
  __syncthreads();
  if (tid < 256) { const int e = es[tid]; int rank = 0; for (int j = 0; j < tid; ++j) rank += (es[j] == e) ? 1 : 0;
    const int slot = pst[e] + bef[e] + rank; sl[tid] = slot; m.slot_of[blk * 256 + tid] = slot; m.slot_gate[slot] = m.tok_g[blk * 256 + tid]; }
  __syncthreads();
  for (int it = 0; it < 8; ++it) {
    const int tl = wave * 8 + it, tok = blk * 64 + tl;
    v2u pk[4];
#pragma unroll
    for (int j = 0; j < 4; ++j) { const f32x4 a = *(const f32x4*)(x1 + (size_t)tok * D + lane * 4 + 256 * j); pk[j] = (v2u){cvt_pk_bf16(a[0], a[1]), cvt_pk_bf16(a[2], a[3])}; }
#pragma unroll
    for (int k = 0; k < 4; ++k) { bf16_t* dst = xs + (size_t)sl[tl * 4 + k] * D + lane * 4;
#pragma unroll
      for (int j = 0; j < 4; ++j) *(v2u*)(dst + 256 * j) = pk[j]; }
  }
  __syncthreads();
}

__device__ __forceinline__ void ph_combine_ln(const float* x1, const bf16_t* Ys, const int* slot_of, const float* g, const float* bb, float* out, bf16_t* outb) {
  const int tid = TIDX(), lane = tid & 63, gw = BIDX() * 8 + (tid >> 6), NGW = (int)gridDim.x * 8;
  for (int row = gw; row < NT; row += NGW) {
    const int4 s4 = *(const int4*)(slot_of + row * 4); const int sl[4] = {s4.x, s4.y, s4.z, s4.w};
    f32x4 v[4]; float s = 0.f;
#pragma unroll
    for (int j = 0; j < 4; ++j) { const int c = lane * 4 + 256 * j; f32x4 f = (f32x4){0.f, 0.f, 0.f, 0.f};
#pragma unroll
      for (int k = 0; k < 4; ++k) { const v2u y = *(const v2u*)(Ys + (size_t)sl[k] * D + c); f += (f32x4){bf_lo(y[0]), bf_hi(y[0]), bf_lo(y[1]), bf_hi(y[1])}; }
      const f32x4 a = *(const f32x4*)(x1 + (size_t)row * D + c); v[j] = a * ALPHA + f; s += (v[j][0] + v[j][1]) + (v[j][2] + v[j][3]); }
    const float mu = wave_sum(s) * (1.f / D); float q = 0.f;
#pragma unroll
    for (int j = 0; j < 4; ++j) { v[j] = v[j] - mu; q += (v[j][0] * v[j][0] + v[j][1] * v[j][1]) + (v[j][2] * v[j][2] + v[j][3] * v[j][3]); }
    const float r = rsqrtf(wave_sum(q) * (1.f / D) + 1e-5f);
#pragma unroll
    for (int j = 0; j < 4; ++j) { const int c = lane * 4 + 256 * j; const f32x4 g4 = *(const f32x4*)(g + c), b4 = *(const f32x4*)(bb + c); const f32x4 o = v[j] * r * g4 + b4;
      *(f32x4*)(out + (size_t)row * D + c) = o; if (outb) *(v2u*)(outb + (size_t)row * D + c) = (v2u){cvt_pk_bf16(o[0], o[1]), cvt_pk_bf16(o[2], o[3])}; }
  }
}

namespace pg8 {
struct MoeOrder {
    StaticOrder so; const int* blk_e; const char* W; size_t wexp; int obn;
    __device__ void init(const void* A, int lda, const void* W_, int ldb, size_t wexp_, int nM, int nN, int obn_, const int* blk_e_, int G, int c) { so.init(A, lda, W_, ldb, nM * BM, nN * BM, G, c); blk_e = blk_e_; W = (const char*)W_; wexp = wexp_; obn = obn_; }
    __device__ bool next(int i, Unit& u) const { int pm, pn; if (!so.tile(i, pm, pn)) return false; const int e = __builtin_amdgcn_readfirstlane(blk_e[pm]); u.pa = so.A + (size_t)pm * so.ta; u.pb = W + (size_t)e * wexp + (size_t)pn * so.tb; u.orow = pm * BM; u.ocol = pn * obn; u.e = e; return true; }
    __device__ __forceinline__ void a_ready(const Unit&) const {}
    __device__ __forceinline__ void done(const Unit&) const {}
};
struct EpiSwiglu {
    static constexpr bool PERM = true, AFTER_DRAIN = false;
    bf16_t* O; int ldc; const float* b1;
    __device__ __forceinline__ void operator()(const f32x4 (&acc)[2][2][4][2], const Unit& u, int wr, int wc, int fr, int fq) const {
        const int row0 = u.orow + wr * 64 + fr, cl = wc * 32 + 8 * fq, col0 = u.ocol + cl;
        const float* bg = b1 + (size_t)u.e * 2048 + col0; const float* bu = bg + 1024;
        const f32x4 bg0 = *(const f32x4*)bg, bg1 = *(const f32x4*)(bg + 4), bu0 = *(const f32x4*)bu, bu1 = *(const f32x4*)(bu + 4);
#pragma unroll
        for (int ai = 0; ai < 2; ++ai)
#pragma unroll
            for (int m = 0; m < 4; ++m) {
                f32x4 gv[2] = {acc[ai][0][m][0] + bg0, acc[ai][0][m][1] + bg1}, uv[2] = {acc[ai][1][m][0] + bu0, acc[ai][1][m][1] + bu1}; float o[8];
#pragma unroll
                for (int n = 0; n < 2; ++n)
#pragma unroll
                    for (int i = 0; i < 4; ++i) { const float gg = fminf(gv[n][i], 7.f), uu = fminf(fmaxf(uv[n][i], -7.f), 7.f);
                        const float sg = __builtin_amdgcn_rcpf(1.f + __builtin_amdgcn_exp2f(-1.702f * 1.4426950408889634f * gg)); o[4 * n + i] = (uu + 1.f) * gg * sg; }
                u32x4 w; w.x = cvt_pk_bf16(o[0], o[1]); w.y = cvt_pk_bf16(o[2], o[3]); w.z = cvt_pk_bf16(o[4], o[5]); w.w = cvt_pk_bf16(o[6], o[7]);
                *(u32x4*)(O + (size_t)(row0 + ai * HALF + m * 16) * ldc + col0) = w; asm volatile("" ::: "memory"); }
    }
};
struct EpiMoe2 {
    static constexpr bool PERM = true, AFTER_DRAIN = false;
    bf16_t* O; int ldc; const float* b2; const float* gate;
    __device__ __forceinline__ void operator()(const f32x4 (&acc)[2][2][4][2], const Unit& u, int wr, int wc, int fr, int fq) const {
        const int row0 = u.orow + wr * 64 + fr, col0 = u.ocol + wc * 32 + 8 * fq;
        const float* bp = b2 + (size_t)u.e * 1024 + col0;
#pragma unroll
        for (int bj = 0; bj < 2; ++bj) {
            const f32x4 bv0 = *(const f32x4*)(bp + bj * HALF), bv1 = *(const f32x4*)(bp + bj * HALF + 4);
#pragma unroll
            for (int ai = 0; ai < 2; ++ai)
#pragma unroll
                for (int m = 0; m < 4; ++m) { const int row = row0 + ai * HALF + m * 16; const float gt = gate[row];
                    const f32x4 v0 = (acc[ai][bj][m][0] + bv0) * gt, v1 = (acc[ai][bj][m][1] + bv1) * gt;
                    u32x4 w; w.x = cvt_pk_bf16(v0[0], v0[1]); w.y = cvt_pk_bf16(v0[2], v0[3]); w.z = cvt_pk_bf16(v1[0], v1[1]); w.w = cvt_pk_bf16(v1[2], v1[3]);
                    *(u32x4*)(O + (size_t)row * ldc + col0 + bj * HALF) = w; asm volatile("" ::: "memory"); }
        }
    }
};
}
typedef short v4i16_t __attribute__((ext_vector_type(4)));
__device__ __forceinline__ unsigned f2key_u(float f) { f = f + 0.0f; const unsigned u = __float_as_uint(f); return (u & 0x80000000u) ? ~u : (u | 0x80000000u); }

__device__ __forceinline__ void ph_cnorm_b(const bf16_t* pa, const float* g, bf16_t* cnb) {
  const int tid = TIDX(), lane = tid & 63, gw = BIDX() * 8 + (tid >> 6), NGW = (int)gridDim.x * 8;
  const f32x4 g4 = *(const f32x4*)(g + lane * 4);
  for (int row = gw; row < NT; row += NGW) {
    const v2u v = *(const v2u*)(pa + (size_t)row * 2048 + 1024 + lane * 4);
    const f32x4 f = (f32x4){bf_lo(v[0]), bf_hi(v[0]), bf_lo(v[1]), bf_hi(v[1])};
    const float r = rsqrtf(wave_sum((f[0] * f[0] + f[1] * f[1]) + (f[2] * f[2] + f[3] * f[3])) * (1.f / 256.f) + 1e-6f);
    const f32x4 o = f * r * g4;
    *(v2u*)(cnb + (size_t)row * 256 + lane * 4) = (v2u){cvt_pk_bf16(o[0], o[1]), cvt_pk_bf16(o[2], o[3])};
  }
}

typedef _Float16 h16x2_t __attribute__((ext_vector_type(2)));
__device__ __forceinline__ unsigned cvt_pk_f16(float lo, float hi) { const f32x2_t v = {lo, hi}; const h16x2_t h = __builtin_convertvector(v, h16x2_t); return __builtin_bit_cast(unsigned, h); }
__device__ __forceinline__ void ph_iscore(const bf16_t* pa, unsigned short* sc) {
  const int tid = TIDX(), lane = tid & 63, gw = BIDX() * 8 + (tid >> 6), NGW = (int)gridDim.x * 8;
  const int n16 = lane & 15, g = lane >> 4;
#pragma unroll 1
  for (int u = gw; u < 2 * 4352; u += NGW) {
    const int b = u / 4352, v = u % 4352;
    int a = 0; while (a < 15 && 16 * (a + 1) * (a + 2) <= v) ++a;
    const int rem = v - 16 * a * (a + 1), r = rem / (a + 1), ch = rem % (a + 1);
    const int qg = 32 * a + r, ntile = (ch < a) ? 32 : (r + 1), t0 = qg * 16, kt0 = ch * 32;
    const bf16_t* qrow = pa + (size_t)(b * L + t0 + n16) * 2048;
    bf16x8 qf[8][2]; float w[8];
#pragma unroll
    for (int h = 0; h < 8; ++h) { qf[h][0] = *(const bf16x8*)(qrow + 1280 + h * 64 + 8 * g); qf[h][1] = *(const bf16x8*)(qrow + 1280 + h * 64 + 32 + 8 * g); w[h] = bf2f(qrow[1856 + h]) * (0.35355339059327373f * 0.125f); }
    const bf16_t* kbase = pa + (size_t)(b * L + n16) * 2048 + 1792 + 8 * g;
    unsigned short* srow = sc + (size_t)(b * L + t0 + n16) * L + 4 * g;
    bf16x8 kr[8][2];
    const int ktl = kt0 + ntile - 1;
#pragma unroll
    for (int p = 0; p < 8; ++p) { const int kk = min(kt0 + p, ktl); kr[p][0] = *(const bf16x8*)(kbase + (size_t)kk * 16 * 2048); kr[p][1] = *(const bf16x8*)(kbase + (size_t)kk * 16 * 2048 + 32); }
#pragma unroll 1
    for (int kt8 = kt0; kt8 < kt0 + ntile; kt8 += 8) {
#pragma unroll
      for (int p = 0; p < 8; ++p) {
        const int kt = kt8 + p;
        const bf16x8 k0 = kr[p][0], k1 = kr[p][1];
        { const int kk = min(kt + 8, ktl); kr[p][0] = *(const bf16x8*)(kbase + (size_t)kk * 16 * 2048); kr[p][1] = *(const bf16x8*)(kbase + (size_t)kk * 16 * 2048 + 32); }
        f32x4 score = (f32x4){0.f, 0.f, 0.f, 0.f};
#pragma unroll
        for (int h = 0; h < 8; ++h) {
          f32x4 acc = __builtin_amdgcn_mfma_f32_16x16x32_bf16(k0, qf[h][0], (f32x4){0.f, 0.f, 0.f, 0.f}, 0, 0, 0);
          acc = __builtin_amdgcn_mfma_f32_16x16x32_bf16(k1, qf[h][1], acc, 0, 0, 0);
#pragma unroll
          for (int i = 0; i < 4; ++i) score[i] = fmaf(fmaxf(acc[i], 0.f), w[h], score[i]);
        }
        if (kt <= ktl) *(v2u*)(srow + kt * 16) = (v2u){cvt_pk_f16(score[0], score[1]), cvt_pk_f16(score[2], score[3])};
      }
    }
  }
}

constexpr int DW_STRIDE = 17152;
__device__ __forceinline__ unsigned offb(unsigned row, unsigned ch) { return 256u * row + 16u * (ch ^ (((row & 3u) << 2) | ((row >> 2) & 3u))); }
__device__ __forceinline__ void glds16(const void* gsrc, unsigned lds_dst) { unsigned keep;
  asm volatile("s_mov_b32 %0, m0\n\ts_mov_b32 m0, %2\n\ts_nop 0\n\tglobal_load_lds_dwordx4 %1, off\n\ts_mov_b32 m0, %0" : "=&s"(keep) : "v"(gsrc), "s"(lds_dst) : "memory"); }
__device__ __forceinline__ int wave_excl_scan(int v, int lane, int& total) {
  int x = v;
#pragma unroll
  for (int o = 1; o < 64; o <<= 1) { const int y = __shfl_up(x, o); if (lane >= o) x += y; }
  total = __shfl(x, 63); return x - v;
}
#define LDSW() asm volatile("s_waitcnt lgkmcnt(0)" ::: "memory")

__device__ __forceinline__ unsigned h2key(unsigned h) { return (h & 0x8000u) ? (~h & 0xFFFFu) : (h | 0x8000u); }
__device__ __forceinline__ int wave_select(const unsigned short* srow, int t, LAS unsigned char* wl, LAS unsigned short* idx16, int lane) {
  const int n = t + 1;
  if (n <= 256) { for (int i = lane; i < 256; i += 64) idx16[i] = (unsigned short)(i < n ? i : 0); LDSW(); return n; }
  LAS unsigned* hist = (LAS unsigned*)wl;
  for (int i = lane; i < 1024; i += 64) ((LAS v4u*)hist)[i] = (v4u){0u, 0u, 0u, 0u};
  unsigned bk[16][4];
#pragma unroll
  for (int i = 0; i < 16; ++i) {
    bk[i][0] = 0u; bk[i][1] = 0u; bk[i][2] = 0u; bk[i][3] = 0u;
    if (i * 512 < n) { const int e0 = (i * 64 + lane) * 8;
      if (e0 < n) { const v4u f = *(const v4u*)(srow + e0);
#pragma unroll
        for (int c = 0; c < 4; ++c) { unsigned lo = f[c] & 0xFFFFu, hi = f[c] >> 16; lo = lo + 0u;
          const unsigned b0 = (e0 + 2 * c <= t) ? (h2key(lo == 0x8000u ? 0u : lo) >> 4) : 0u, b1 = (e0 + 2 * c + 1 <= t) ? (h2key(hi == 0x8000u ? 0u : hi) >> 4) : 0u;
          bk[i][c] = b0 | (b1 << 16); } } }
    if ((i & 3) == 3) asm volatile("" ::: "memory");
  }
#define BIN_OF(i, c) ((bk[i][(c) >> 1] >> (((c) & 1) * 16)) & 0xFFFFu)
  LDSW();
#pragma unroll
  for (int i = 0; i < 16; ++i) if (i * 512 < n) {
#pragma unroll
    for (int c = 0; c < 8; ++c) { const unsigned bin = BIN_OF(i, c); if (bin) __hip_atomic_fetch_add(hist + bin, 1u, __ATOMIC_RELAXED, __HIP_MEMORY_SCOPE_WORKGROUP); }
    asm volatile("" ::: "memory"); }
  LDSW();
  const int bbase = 4096 - 64 * (lane + 1); int ssum = 0;
#pragma unroll 8
  for (int k = 0; k < 64; ++k) ssum += (int)hist[bbase + ((k + lane) & 63)];
  int tot; const int pre = wave_excl_scan(ssum, lane, tot);
  const unsigned long long bal = __ballot(pre < 256 && pre + ssum >= 256);
  const int Ls = (int)__builtin_ctzll(bal);
  int cum = __shfl(pre, Ls); const int sb = 4096 - 64 * (Ls + 1); int B1 = sb;
  for (int k = 63; k >= 0; --k) { const int c = (int)hist[sb + k]; if (cum + c >= 256) { B1 = sb + k; break; } cum += c; }
  const int cnt_gt = cum, need1 = 256 - cnt_gt;
  LDSW();
  int ngt = 0, neq = 0;
#pragma unroll
  for (int i = 0; i < 16; ++i) if (i * 512 < n) {
#pragma unroll
    for (int c = 0; c < 8; ++c) { const int bin = (int)BIN_OF(i, c); ngt += (bin > B1) ? 1 : 0; neq += (bin == B1) ? 1 : 0; } }
  int tg, te; int pg = wave_excl_scan(ngt, lane, tg); int pe = wave_excl_scan(neq, lane, te);
  LAS unsigned short* cand = (LAS unsigned short*)wl;
#pragma unroll
  for (int i = 0; i < 16; ++i) if (i * 512 < n) {
#pragma unroll
    for (int c = 0; c < 8; ++c) { const int bin = (int)BIN_OF(i, c); const int e = (i * 64 + lane) * 8 + c;
      if (bin > B1) { idx16[pg] = (unsigned short)e; ++pg; }
      if (bin == B1) { cand[pe] = (unsigned short)e; ++pe; } }
    asm volatile("" ::: "memory"); }
#undef BIN_OF
  LDSW();
  const int m = te;
  unsigned lo = 0u;
  if (m <= 256) {
    unsigned cp[4];
#pragma unroll
    for (int j = 0; j < 4; ++j) { const int q = lane + 64 * j; cp[j] = 0u; if (q < m) { const unsigned ci = cand[q]; unsigned hv = srow[ci]; hv = (hv == 0x8000u) ? 0u : hv; cp[j] = ((h2key(hv) & 15u) << 13) | (8191u - ci) | (1u << 20); } }
    for (int bit = 16; bit >= 0; --bit) { const unsigned trial = lo | (1u << bit); int c = 0;
#pragma unroll
      for (int j = 0; j < 4; ++j) c += ((cp[j] >> 20) && ((cp[j] & 0x1FFFFu) >= trial)) ? 1 : 0;
      int tc; (void)wave_excl_scan(c, lane, tc); if (tc >= need1) lo = trial; }
    int c = 0;
#pragma unroll
    for (int j = 0; j < 4; ++j) c += ((cp[j] >> 20) && ((cp[j] & 0x1FFFFu) >= lo)) ? 1 : 0;
    int tc; int pos = cnt_gt + wave_excl_scan(c, lane, tc);
#pragma unroll
    for (int j = 0; j < 4; ++j) if ((cp[j] >> 20) && ((cp[j] & 0x1FFFFu) >= lo)) { idx16[pos] = (unsigned short)(8191u - (cp[j] & 0x1FFFu)); ++pos; }
  } else {
    for (int bit = 16; bit >= 0; --bit) { const unsigned trial = lo | (1u << bit); int c = 0;
      for (int q = lane; q < m; q += 64) { const unsigned ci = cand[q]; unsigned hv = srow[ci]; hv = (hv == 0x8000u) ? 0u : hv; const unsigned cpq = ((h2key(hv) & 15u) << 13) | (8191u - ci); c += (cpq >= trial) ? 1 : 0; }
      int tc; (void)wave_excl_scan(c, lane, tc); if (tc >= need1) lo = trial; }
    int base = cnt_gt;
    for (int q0 = 0; q0 < m; q0 += 64) { const int q = q0 + lane; bool sel = false; unsigned ci = 0;
      if (q < m) { ci = cand[q]; unsigned hv = srow[ci]; hv = (hv == 0x8000u) ? 0u : hv; const unsigned cpq = ((h2key(hv) & 15u) << 13) | (8191u - ci); sel = cpq >= lo; }
      int tc; const int pos = base + wave_excl_scan(sel ? 1 : 0, lane, tc); if (sel) idx16[pos] = (unsigned short)ci; base += tc; }
  }
  LDSW();
  return 256;
}

__device__ __forceinline__ void wave_attend(int b, int t, int cnt, const bf16_t* qlat, const bf16_t* cnb, LAS unsigned char* wl, LAS unsigned short* idx16, bf16_t* olat, int lane) {
  const int n16 = lane & 15, g = lane >> 4, q4 = (lane & 15) >> 2, p4 = lane & 3;
  const bf16_t* qrow = qlat + (size_t)(b * L + t) * 4096 + n16 * 256 + 8 * g;
  bf16x8 qf[8];
#pragma unroll
  for (int s = 0; s < 8; ++s) qf[s] = *(const bf16x8*)(qrow + 32 * s);
  f32x4 o[16];
#pragma unroll
  for (int c = 0; c < 16; ++c) o[c] = (f32x4){0.f, 0.f, 0.f, 0.f};
  float mrun = -INFINITY, lrun = 0.f;
  const int ntile = (cnt + 31) >> 5;
  const char* cb = (const char*)(cnb + (size_t)b * L * 256);
  const unsigned wl_addr = (unsigned)__builtin_amdgcn_readfirstlane((int)(unsigned)(size_t)wl);
  const unsigned slot = lane & 15, rsub = lane >> 4;
  constexpr float SC = 0.125f * 1.4426950408889634f;
#pragma unroll 1
  for (int it = 0; it < ntile; ++it) {
#pragma unroll
    for (int rg = 0; rg < 8; ++rg) { const unsigned row = 4 * rg + rsub; const unsigned key = idx16[32 * it + row];
      const unsigned ch = slot ^ (((row & 3u) << 2) | ((row >> 2) & 3u));
      const char* src = cb + (size_t)key * 512 + ch * 16;
      glds16(src, wl_addr + rg * 1024); glds16(src + 256, wl_addr + 8192 + rg * 1024); }
    asm volatile("s_waitcnt vmcnt(0)" ::: "memory");
    f32x4 s0 = (f32x4){0.f, 0.f, 0.f, 0.f}, s1 = (f32x4){0.f, 0.f, 0.f, 0.f};
#pragma unroll
    for (int s = 0; s < 8; ++s) { const unsigned ib = (s >> 2) * 8192, chq = 4 * (s & 3) + g;
      const bf16x8 a0 = *(const LAS bf16x8*)(wl + ib + offb(n16, chq)), a1 = *(const LAS bf16x8*)(wl + ib + offb(16 + n16, chq));
      s0 = __builtin_amdgcn_mfma_f32_16x16x32_bf16(a0, qf[s], s0, 0, 0, 0); s1 = __builtin_amdgcn_mfma_f32_16x16x32_bf16(a1, qf[s], s1, 0, 0, 0); }
    const int sl0 = 32 * it + 4 * g;
    float mx = -INFINITY;
#pragma unroll
    for (int r = 0; r < 4; ++r) { s0[r] = (sl0 + r < cnt) ? s0[r] * SC : -INFINITY; s1[r] = (sl0 + 16 + r < cnt) ? s1[r] * SC : -INFINITY; mx = fmaxf(mx, fmaxf(s0[r], s1[r])); }
    mx = fmaxf(mx, __shfl_xor(mx, 16)); mx = fmaxf(mx, __shfl_xor(mx, 32));
    const float mnew = fmaxf(mrun, mx), alpha = __builtin_amdgcn_exp2f(mrun - mnew);
    float ls = 0.f; float pv[8];
#pragma unroll
    for (int r = 0; r < 4; ++r) { pv[r] = __builtin_amdgcn_exp2f(s0[r] - mnew); pv[4 + r] = __builtin_amdgcn_exp2f(s1[r] - mnew); ls += pv[r] + pv[4 + r]; }
    ls += __shfl_xor(ls, 16); ls += __shfl_xor(ls, 32);
    lrun = lrun * alpha + ls; mrun = mnew;
#pragma unroll
    for (int c = 0; c < 16; ++c) o[c] = o[c] * alpha;
    const v4u pbw = (v4u){cvt_pk_bf16(pv[0], pv[1]), cvt_pk_bf16(pv[2], pv[3]), cvt_pk_bf16(pv[4], pv[5]), cvt_pk_bf16(pv[6], pv[7])};
    const bf16x8 pb = __builtin_bit_cast(bf16x8, pbw);
#pragma unroll
    for (int c = 0; c < 16; ++c) { const unsigned ib = (c >> 3) * 8192, chc = 2 * (c & 7) + (p4 >> 1);
      const v4i16_t t0 = __builtin_amdgcn_ds_read_tr16_b64_v4i16((LAS v4i16_t*)(wl + ib + offb(4 * g + q4, chc) + 8 * (p4 & 1)));
      const v4i16_t t1 = __builtin_amdgcn_ds_read_tr16_b64_v4i16((LAS v4i16_t*)(wl + ib + offb(16 + 4 * g + q4, chc) + 8 * (p4 & 1)));
      const bf16x8 af = (bf16x8){t0[0], t0[1], t0[2], t0[3], t1[0], t1[1], t1[2], t1[3]};
      o[c] = __builtin_amdgcn_mfma_f32_16x16x32_bf16(af, pb, o[c], 0, 0, 0); }
    LDSW();
  }
  const float inv = 1.f / lrun;
  bf16_t* orow = olat + (size_t)(b * L + t) * 4096 + n16 * 256 + 4 * g;
#pragma unroll
  for (int c = 0; c < 16; ++c) { const f32x4 v = o[c] * inv; *(v2u*)(orow + 16 * c) = (v2u){cvt_pk_bf16(v[0], v[1]), cvt_pk_bf16(v[2], v[3])}; }
}

__device__ __forceinline__ void ph_select_attend(const unsigned short* sc, const bf16_t* qlat, const bf16_t* cnb, bf16_t* olat, LAS unsigned char* lds) {
  const int tid = TIDX(), lane = tid & 63, wave = __builtin_amdgcn_readfirstlane(tid >> 6), blk = BIDX();
  LAS unsigned char* wl = lds + wave * DW_STRIDE; LAS unsigned short* idx16 = (LAS unsigned short*)(wl + 16384);
  const int b = blk & 1, wb = (blk >> 1) * 8 + wave, nwb = ((int)gridDim.x >> 1) * 8;
#pragma unroll 1
  for (int t = wb; t < L; t += nwb) {
    int lane_s = lane; asm volatile("" : "+v"(lane_s));
    const int cnt = wave_select(sc + (size_t)(b * L + t) * L, t, wl, idx16, lane_s);
    int lane_a = lane; asm volatile("" : "+v"(lane_a));
    wave_attend(b, t, cnt, qlat, cnb, wl, idx16, olat, lane_a);
  }
}

namespace pg8 {
struct GroupAOrder {
    StaticOrder so; int png; size_t acol_bytes;
    __device__ void init(const void* A, int lda, const void* Bt, int ldb, int M, int N, int png_, size_t acol_bytes_, int G, int c) { so.init(A, lda, Bt, ldb, M, N, G, c); png = png_; acol_bytes = acol_bytes_; }
    __device__ bool next(int i, Unit& u) const { int pm, pn; if (!so.tile(i, pm, pn)) return false; u.pa = so.A + (size_t)pm * so.ta + (size_t)(pn / png) * acol_bytes; u.pb = so.Bt + (size_t)pn * so.tb; u.orow = pm * BM; u.ocol = pn * BM; u.e = 0; return true; }
    __device__ __forceinline__ void a_ready(const Unit&) const {}
    __device__ __forceinline__ void done(const Unit&) const {}
};
}
constexpr int GLA_LDSU = 65536;

__device__ __forceinline__ v4i16_t trrd(LAS unsigned char* p) { return __builtin_amdgcn_ds_read_tr16_b64_v4i16((LAS v4i16_t*)p); }
__device__ __forceinline__ bf16x8 cat44(v4i16_t a, v4i16_t b) { return (bf16x8){a[0], a[1], a[2], a[3], b[0], b[1], b[2], b[3]}; }

__device__ __forceinline__ void ph_gla_a1(const bf16_t* pb, const float* gbias, bf16_t* qt, float* og, float* kvt, float* dcy, LAS unsigned char* lds) {
  const int tid = TIDX(), lane = tid & 63, wave = __builtin_amdgcn_readfirstlane(tid >> 6), blk = BIDX();
  if ((wave & 3) != 0) return;
  const int half = wave >> 2;
  LAS unsigned char* X = lds + half * GLA_LDSU; LAS unsigned char* Y = X + 16384; LAS unsigned char* V = X + 32768;
  const unsigned v_addr = (unsigned)__builtin_amdgcn_readfirstlane((int)(unsigned)(size_t)V);
  const int n16 = lane & 15, g = lane >> 4, q4 = (lane & 15) >> 2, p4 = lane & 3;
#pragma unroll 1
  for (int uu = 0; uu < 2; ++uu) {
    const int u = blk * 4 + half * 2 + uu; if (u >= 1024) break;
    const int h = u & 3, bc = u >> 2, r0 = bc * 64;
    { const unsigned slot = lane & 15, rsub = lane >> 4;
#pragma unroll
      for (int im = 0; im < 4; ++im)
#pragma unroll
        for (int rg = 0; rg < 8; ++rg) { const unsigned row = 4 * rg + rsub; const unsigned ch = slot ^ (((row & 3u) << 2) | ((row >> 2) & 3u));
          const char* src = (const char*)(pb + (size_t)(r0 + 32 * (im >> 1) + row) * 3584 + 1024 + h * 256 + (im & 1) * 128) + ch * 16;
          glds16(src, v_addr + im * 8192 + rg * 1024); } }
    const int d0 = 2 * lane; const float gb0 = gbias[h * 128 + d0], gb1 = gbias[h * 128 + d0 + 1];
    float bc0 = 0.f, bc1 = 0.f;
    const unsigned wofs = 16u * ((unsigned)(d0 >> 3)) , wsub = (unsigned)(d0 & 7) * 2u;
#pragma unroll 1
    for (int jb = 0; jb < 4; ++jb) {
      unsigned gq[16], qq[16], kq[16];
#pragma unroll
      for (int jj = 0; jj < 16; ++jj) { const bf16_t* rp = pb + (size_t)(r0 + jb * 16 + jj) * 3584 + h * 128 + d0;
        gq[jj] = *(const unsigned*)(rp + 3072); qq[jj] = *(const unsigned*)rp; kq[jj] = *(const unsigned*)(rp + 512); }
#pragma unroll
      for (int jj = 0; jj < 16; ++jj) { const int j = jb * 16 + jj;
        const float a0 = bf_lo(gq[jj]) + gb0, a1 = bf_hi(gq[jj]) + gb1;
        bc0 += (fminf(a0, 0.f) - log1pf(__expf(-fabsf(a0)))) * (1.f / 16.f); bc1 += (fminf(a1, 0.f) - log1pf(__expf(-fabsf(a1)))) * (1.f / 16.f);
        const float e0 = __expf(bc0), e1 = __expf(bc1), i0 = __expf(fminf(-bc0, 80.f)), i1 = __expf(fminf(-bc1, 80.f));
        const unsigned qo = cvt_pk_bf16(bf_lo(qq[jj]) * 0.08838834764831845f * e0, bf_hi(qq[jj]) * 0.08838834764831845f * e1);
        const unsigned ko = cvt_pk_bf16(bf_lo(kq[jj]) * i0, bf_hi(kq[jj]) * i1);
        *(unsigned*)(qt + (size_t)(r0 + j) * 512 + h * 128 + d0) = qo;
        const unsigned row = (unsigned)(j & 31); const unsigned off = (unsigned)(j >> 5) * 8192u + 256u * row + ((wofs ^ (16u * (((row & 3u) << 2) | ((row >> 2) & 3u))))) + wsub;
        *(LAS unsigned*)(X + off) = qo; *(LAS unsigned*)(Y + off) = ko; }
    }
    *(float2*)(dcy + (size_t)u * 128 + d0) = make_float2(__expf(bc0), __expf(bc1));
    LDSW();
    bf16x8 afr[4][2];
#pragma unroll
    for (int it = 0; it < 4; ++it)
#pragma unroll
      for (int ks = 0; ks < 2; ++ks) {
        unsigned pk[4] = {0u, 0u, 0u, 0u};
#pragma unroll
        for (int jh = 0; jh < 2; ++jh) { const int jt = 2 * ks + jh;
          if (jt <= it) { f32x4 acc = (f32x4){0.f, 0.f, 0.f, 0.f};
#pragma unroll
            for (int s = 0; s < 4; ++s) { const bf16x8 ya = *(const LAS bf16x8*)(Y + (jt >> 1) * 8192 + offb(n16 + 16 * (jt & 1), 4 * s + g)), xb = *(const LAS bf16x8*)(X + (it >> 1) * 8192 + offb(n16 + 16 * (it & 1), 4 * s + g));
              acc = __builtin_amdgcn_mfma_f32_16x16x32_bf16(ya, xb, acc, 0, 0, 0); }
            const int i_ = 16 * it + n16, jbase = 16 * jt + 4 * g;
#pragma unroll
            for (int r = 0; r < 4; ++r) if (jbase + r > i_) acc[r] = 0.f;
            pk[2 * jh] = cvt_pk_bf16(acc[0], acc[1]); pk[2 * jh + 1] = cvt_pk_bf16(acc[2], acc[3]); } }
        afr[it][ks] = __builtin_bit_cast(bf16x8, (v4u){pk[0], pk[1], pk[2], pk[3]});
      }
    asm volatile("s_waitcnt vmcnt(0)" ::: "memory");
    float* ogp = og + (size_t)u * 16384 + lane * 4; float* kvp = kvt + (size_t)u * 32768 + (size_t)n16 * 128 + 4 * g;
#pragma unroll 1
    for (int nt = 0; nt < 16; ++nt) {
      const unsigned vimg = (unsigned)(nt >> 3) * 8192u, chv = 2u * (unsigned)(nt & 7) + (unsigned)(p4 >> 1), sub = 8u * (unsigned)(p4 & 1);
      bf16x8 bi[2], bn[2];
#pragma unroll
      for (int ks = 0; ks < 2; ++ks) { LAS unsigned char* vb = V + ks * 16384 + vimg;
        bi[ks] = cat44(trrd(vb + offb(4 * g + q4, chv) + sub), trrd(vb + offb(16 + 4 * g + q4, chv) + sub));
        bn[ks] = cat44(trrd(vb + offb(8 * g + q4, chv) + sub), trrd(vb + offb(8 * g + 4 + q4, chv) + sub)); }
#pragma unroll
      for (int it = 0; it < 4; ++it) { f32x4 acc = __builtin_amdgcn_mfma_f32_16x16x32_bf16(afr[it][0], bi[0], (f32x4){0.f, 0.f, 0.f, 0.f}, 0, 0, 0);
        if (it >= 2) acc = __builtin_amdgcn_mfma_f32_16x16x32_bf16(afr[it][1], bi[1], acc, 0, 0, 0);
        *(f32x4*)(ogp + ((size_t)(it * 16 + nt) * 64) * 4) = acc; }
#pragma unroll
      for (int mt = 0; mt < 8; ++mt) { const unsigned chy = 2u * (unsigned)mt + (unsigned)(p4 >> 1);
        const bf16x8 a0 = cat44(trrd(Y + offb(8 * g + q4, chy) + sub), trrd(Y + offb(8 * g + 4 + q4, chy) + sub));
        const bf16x8 a1 = cat44(trrd(Y + 8192 + offb(8 * g + q4, chy) + sub), trrd(Y + 8192 + offb(8 * g + 4 + q4, chy) + sub));
        f32x4 acc = __builtin_amdgcn_mfma_f32_16x16x32_bf16(a0, bn[0], (f32x4){0.f, 0.f, 0.f, 0.f}, 0, 0, 0);
        acc = __builtin_amdgcn_mfma_f32_16x16x32_bf16(a1, bn[1], acc, 0, 0, 0);
        *(f32x4*)(kvp + (size_t)(16 * nt) * 128 + 16 * mt) = acc; }
    }
    LDSW();
  }
}

__device__ __forceinline__ void ph_gla_a2(const float* kvt, const float* dcy, bf16_t* spt) {
  const int gtid = BIDX() * NTHR + TIDX();
  if (gtid >= 8 * 256 * 32) return;
  const int g4 = gtid & 31, dv = (gtid >> 5) & 255, bh = gtid >> 13, b = bh >> 2, h = bh & 3;
  f32x4 S = (f32x4){0.f, 0.f, 0.f, 0.f};
#pragma unroll 4
  for (int c = 0; c < 128; ++c) { const size_t u = (size_t)((b * 128 + c) * 4 + h);
    const f32x4 kv = *(const f32x4*)(kvt + u * 32768 + (size_t)dv * 128 + 4 * g4), dc = *(const f32x4*)(dcy + u * 128 + 4 * g4);
    *(v2u*)(spt + u * 32768 + (size_t)dv * 128 + 4 * g4) = (v2u){cvt_pk_bf16(S[0], S[1]), cvt_pk_bf16(S[2], S[3])};
    S = dc * (S + kv); }
}

constexpr int A3_LD = 272;
__device__ __forceinline__ void ph_gla_a3(const bf16_t* pb, const bf16_t* qt, const float* og, const bf16_t* spt, const float* ng, bf16_t* ob, LAS unsigned char* lds) {
  const int tid = TIDX(), lane = tid & 63, wave = __builtin_amdgcn_readfirstlane(tid >> 6), gw = BIDX() * 8 + wave, NGW = (int)gridDim.x * 8;
  const int n16 = lane & 15, g = lane >> 4, row16 = lane >> 2, cq = lane & 3;
  LAS float* T = (LAS float*)(lds + wave * (16 * A3_LD * 4));
#pragma unroll 1
  for (int w = gw; w < 4096; w += NGW) {
    const int u = w >> 2, it = w & 3, h = u & 3, r0 = (u >> 2) * 64;
    const bf16_t* sp = spt + (size_t)u * 32768 + (size_t)n16 * 128 + 8 * g;
    bf16x8 qa[4];
#pragma unroll
    for (int ks = 0; ks < 4; ++ks) qa[ks] = *(const bf16x8*)(qt + (size_t)(r0 + 16 * it + n16) * 512 + h * 128 + 32 * ks + 8 * g);
    const float* ogp = og + (size_t)u * 16384 + (size_t)(it * 16) * 256 + lane * 4;
#pragma unroll
    for (int nt = 0; nt < 16; ++nt) {
      f32x4 acc = *(const f32x4*)(ogp + nt * 256);
#pragma unroll
      for (int ks = 0; ks < 4; ++ks) { const bf16x8 sb = *(const bf16x8*)(sp + (size_t)(16 * nt) * 128 + 32 * ks); acc = __builtin_amdgcn_mfma_f32_16x16x32_bf16(qa[ks], sb, acc, 0, 0, 0); }
#pragma unroll
      for (int r = 0; r < 4; ++r) T[(4 * g + r) * A3_LD + 16 * nt + n16] = acc[r];
    }
    LDSW();
    const size_t row = (size_t)(r0 + 16 * it + row16);
    f32x4 v[16]; float ss = 0.f;
#pragma unroll
    for (int k = 0; k < 16; ++k) { v[k] = *(const LAS f32x4*)(T + row16 * A3_LD + 16 * k + 4 * cq); ss += (v[k][0] * v[k][0] + v[k][1] * v[k][1]) + (v[k][2] * v[k][2] + v[k][3] * v[k][3]); }
    ss += __shfl_xor(ss, 1); ss += __shfl_xor(ss, 2);
    const float rs = rsqrtf(ss * (1.f / 256.f) + 1e-6f);
#pragma unroll
    for (int k = 0; k < 16; ++k) { const int col = h * 256 + 16 * k + 4 * cq; const v2u rg = *(const v2u*)(pb + row * 3584 + 2048 + col); const f32x4 gn = *(const f32x4*)(ng + col);
      const float rr[4] = {bf_lo(rg[0]), bf_hi(rg[0]), bf_lo(rg[1]), bf_hi(rg[1])}; float o[4];
#pragma unroll
      for (int z = 0; z < 4; ++z) o[z] = v[k][z] * rs * gn[z] * (rr[z] * __builtin_amdgcn_rcpf(1.f + __expf(-rr[z])));
      *(v2u*)(ob + row * 1024 + col) = (v2u){cvt_pk_bf16(o[0], o[1]), cvt_pk_bf16(o[2], o[3])}; }
    LDSW();
  }
}
#ifndef PROBE
#define PROBE 0
#endif
#ifndef PROBE_S
#define PROBE_S 10.0f
#endif
constexpr size_t MiB = 1u << 20;
constexpr size_t WS_CTL = 0, CTL_ZERO_BYTES = 1 * MiB;
constexpr int CW_BAR = 4096;
constexpr size_t WS_NEEDED = 2048 * MiB;

struct Args { In in; float* out; unsigned char* ws; };

struct Opt { bf16_t *qt, *spt; float *dcy, *og, *kvt; bf16_t *Wql_t, *Wuv_t, *cnb, *qlat, *olat; unsigned short* sc; bf16_t *xb, *WA_t, *WoutA_t, *WB_t, *WoutB_t, *W1_t, *W2_t, *projA_b, *hbf, *o2b, *xs, *act, *Ys, *projB_b; MoeBufs m; };
__device__ __forceinline__ nvp::Ws carve_ws(unsigned char* ws) {
  nvp::Ws w; auto at = [&](size_t mib) { return (char*)ws + mib * MiB; };
  w.projA = (float*)at(2); w.cn = (float*)at(119); w.sc = (float*)at(135); w.idx = (int*)at(647); w.o2 = (float*)at(663);
  w.x1 = (float*)at(727); w.x2 = (float*)at(791);
  w.projB = (float*)at(135); w.adec = (float*)at(135 + 194); w.og = (float*)at(135 + 194 + 32); w.on = (float*)at(135 + 194 + 32 + 64);
  w.counts = nullptr; w.h = nullptr; w.hb = nullptr; w.ys = nullptr; w.tok_e = nullptr; w.tok_g = nullptr; w.slot_of = nullptr; w.row_tok = nullptr; w.row_gate = nullptr; w.blk_e = nullptr;
  return w;
}
__device__ __forceinline__ Opt carve_opt(unsigned char* ws) {
  Opt o; auto at = [&](size_t mib) { return (bf16_t*)((char*)ws + mib * MiB); };
  char* sm = (char*)ws + 855 * MiB;
  o.m.tok_e = (int*)sm; o.m.tok_g = (float*)(sm + 256 * 1024); o.m.slot_of = (int*)(sm + 512 * 1024); o.m.slot_gate = (float*)(sm + 768 * 1024); o.m.blk_e = (int*)(sm + 1088 * 1024); o.m.blkcnt = (int*)(sm + 1096 * 1024); o.m.nblk = (int*)(sm + 1160 * 1024);
  o.WA_t = at(860); o.WoutA_t = at(864); o.WB_t = at(866); o.WoutB_t = at(873);
  o.Wql_t = at(875); o.Wuv_t = at(877); o.olat = at(2); o.cnb = at(647); o.qlat = at(1856); o.sc = (unsigned short*)at(135);
  o.qt = at(135); o.dcy = (float*)at(151); o.og = (float*)at(152); o.kvt = (float*)at(216); o.spt = at(344);
  o.W1_t = at(880); o.W2_t = at(1136);
  o.xb = at(1264); o.projA_b = at(1296); o.hbf = at(1360); o.o2b = at(1392);
  o.xs = at(1424); o.act = at(1568); o.Ys = at(1712); o.projB_b = at(1856);
  return o;
}

struct ProIn { const float *a_w_uk, *a_w_uv, *x, *a_w_in, *a_w_out, *b_w_in, *b_w_g2, *b_w_out, *m_w1, *m_w2; };
__device__ __forceinline__ void ph_prologue(const ProIn I, const Opt& o) {
  const int tid = TIDX(), lane = tid & 63, gw = BIDX() * 8 + (tid >> 6), NGW = (int)gridDim.x * 8, gtid = BIDX() * NTHR + tid, NGT = (int)gridDim.x * NTHR;
  cvt_f32_to_bf16(I.x, D, o.xb, D, NT, D, gtid, NGT);
  zero_rect(o.WA_t, D, DINA, 2048 - DINA, 0, D * 2, gtid, NGT);
  for (int i = gtid; i < 512 * 256; i += NGT) { const int n = i >> 8, k4 = (i & 255) * 4; float a[4];
#pragma unroll
    for (int z = 0; z < 4; ++z) { const float* gl = I.b_w_in + (size_t)(k4 + z) * DINB + 2048; float s = 0.f;
#pragma unroll
      for (int j = 0; j < 16; ++j) s = fmaf(gl[j], I.b_w_g2[j * 512 + n], s);
      a[z] = s; }
    *(v2u*)(o.WB_t + (size_t)(3072 + n) * D + k4) = (v2u){cvt_pk_bf16(a[0], a[1]), cvt_pk_bf16(a[2], a[3])}; }
  int w0 = 0;
#pragma unroll 1
  for (int h = 0; h < 16; ++h) {
    transpose_job(mk_tjob(I.a_w_uk + (size_t)h * 64 * 256, 256, 64, 256, o.Wql_t, 256, h * 256, (h & 3) * 64, 0), w0, gw, NGW, lane);
    transpose_job(mk_tjob(I.a_w_uv + (size_t)h * 256 * 64, 64, 256, 64, o.Wuv_t, 1024, h * 64, (h & 3) * 256, 0), w0, gw, NGW, lane);
    for (int hp = 0; hp < 4; ++hp) if (hp != (h & 3)) { zero_rect(o.Wql_t, 256, h * 256, 256, hp * 128, 128, gtid, NGT); zero_rect(o.Wuv_t, 1024, h * 64, 64, hp * 512, 512, gtid, NGT); }
  }
  transpose_job(mk_tjob(I.a_w_in, DINA, D, DINA, o.WA_t, D, 0, 0, 0), w0, gw, NGW, lane);
  transpose_job(mk_tjob(I.a_w_out, D, D, D, o.WoutA_t, D, 0, 0, 0), w0, gw, NGW, lane);
  transpose_job(mk_tjob(I.b_w_in, DINB, D, 2048, o.WB_t, D, 0, 0, 0), w0, gw, NGW, lane);
  transpose_job(mk_tjob(I.b_w_in + 2064, DINB, D, 1024, o.WB_t, D, 2048, 0, 0), w0, gw, NGW, lane);
  transpose_job(mk_tjob(I.b_w_out, D, D, D, o.WoutB_t, D, 0, 0, 0), w0, gw, NGW, lane);
#pragma unroll 1
  for (int le = 0; le < 64; ++le) transpose_job(mk_tjob(I.m_w1 + (size_t)le * D * 2048, 2048, D, 2048, o.W1_t + (size_t)le * 2048 * D, D, 0, 0, 1), w0, gw, NGW, lane);
#pragma unroll 1
  for (int le = 0; le < 64; ++le) transpose_job(mk_tjob(I.m_w2 + (size_t)le * D * D, D, D, D, o.W2_t + (size_t)le * D * D, D, 0, 0, 0), w0, gw, NGW, lane);
}
__device__ __forceinline__ void ph_gla_shim(const bf16_t* pb, const float* gbias, float* projB, float* adec) {
  const int gtid = BIDX() * NTHR + TIDX(), NGT = (int)gridDim.x * NTHR;
  for (size_t i = gtid; i < (size_t)NT * 896; i += NGT) { const size_t r = i / 896; const int c = (int)(i % 896) * 4; const v2u v = *(const v2u*)(pb + r * 3584 + c);
    const f32x4 f = (f32x4){bf_lo(v[0]), bf_hi(v[0]), bf_lo(v[1]), bf_hi(v[1])};
    if (c < 2048) *(f32x4*)(projB + r * DINB + c) = f;
    else if (c < 3072) *(f32x4*)(projB + r * DINB + 2064 + (c - 2048)) = f;
    else { f32x4 o;
#pragma unroll
      for (int z = 0; z < 4; ++z) { const float a = f[z] + gbias[c - 3072 + z]; const float ls = fminf(a, 0.f) - log1pf(expf(-fabsf(a))); o[z] = expf(ls * (1.f / 16.f)); }
      *(f32x4*)(adec + r * 512 + (c - 3072)) = o; } }
}

#if PROBE == 3
#define GLA_PHASES \
      PH_BEGIN ph_gla_shim(o.projB_b, I.b_g_bias, w.projB, w.adec); PH_END \
      GRID_BAR(); \
      PH_BEGIN nvp::np_gla_scan(w.projB, w.adec, w.og, fl); PH_END \
      GRID_BAR(); \
      PH_BEGIN nvp::np_gla_norm(w.og, w.projB, I.b_norm, w.on); PH_END \
      GRID_BAR(); \
      PH_BEGIN cvt_f32_to_bf16(w.on, D, o.o2b, D, NT, D, gtid_, NGT_); PH_END \
      GRID_BAR(); \
      PH_BEGIN ph_gla_a1(o.projB_b, I.b_g_bias, (bf16_t*)(wsb_ + 489 * MiB), (float*)(wsb_ + 506 * MiB), (float*)(wsb_ + 880 * MiB), (float*)(wsb_ + 505 * MiB), ll); PH_END \
      GRID_BAR(); \
      PH_BEGIN ph_gla_a2((float*)(wsb_ + 880 * MiB), (float*)(wsb_ + 505 * MiB), (bf16_t*)(wsb_ + 1136 * MiB)); PH_END \
      GRID_BAR(); \
      PH_BEGIN ph_gla_a3(o.projB_b, (bf16_t*)(wsb_ + 489 * MiB), (float*)(wsb_ + 506 * MiB), (bf16_t*)(wsb_ + 1136 * MiB), I.b_norm, (bf16_t*)(wsb_ + 570 * MiB), ll); PH_END \
      GRID_BAR(); \
      PH_BEGIN { unsigned* fl_ = (unsigned*)(wsb_ + 512 * 1024); unsigned bits = 0u; \
        { const bf16_t* a = (const bf16_t*)(wsb_ + 489 * MiB); for (size_t i = gtid_; i < (size_t)NT * 512; i += NGT_) { const float v = bf2f(a[i]); if (!(fabsf(v) < 1e30f)) bits |= 1u; } } \
        { const float* a = (const float*)(wsb_ + 506 * MiB); for (size_t i = gtid_; i < (size_t)NT * 1024; i += NGT_) { const float v = a[i]; if (!(fabsf(v) < 1e30f)) bits |= 2u; } } \
        { const float* a = (const float*)(wsb_ + 880 * MiB); for (size_t i = gtid_; i < (size_t)1024 * 32768; i += NGT_) { const float v = a[i]; if (!(fabsf(v) < 1e30f)) bits |= 4u; } } \
        { const bf16_t* a = (const bf16_t*)(wsb_ + 1136 * MiB); for (size_t i = gtid_; i < (size_t)1024 * 32768; i += NGT_) { const float v = bf2f(a[i]); if (!(fabsf(v) < 1e30f)) bits |= 8u; } } \
        { const bf16_t* a = (const bf16_t*)(wsb_ + 570 * MiB); for (size_t i = gtid_; i < (size_t)NT * 1024; i += NGT_) { const float v = bf2f(a[i]); if (!(fabsf(v) < 1e30f)) bits |= 16u; } } \
        { const float* a = (const float*)(wsb_ + 505 * MiB); for (size_t i = gtid_; i < (size_t)1024 * 128; i += NGT_) { const float v = a[i]; if (!(fabsf(v) < 1e30f)) bits |= 32u; } } \
        if (bits) atomicOr(fl_, bits); \
        { float* pd = (float*)(wsb_ + 1968 * MiB); const bf16_t* ob = (const bf16_t*)(wsb_ + 570 * MiB); for (size_t i = gtid_; i < (size_t)NT * D; i += NGT_) pd[i] = bf2f(ob[i]) - w.on[i]; } } PH_END \
      GRID_BAR();
#else
#define GLA_PHASES \
      PH_BEGIN ph_gla_a1(o.projB_b, I.b_g_bias, o.qt, o.og, o.kvt, o.dcy, ll); PH_END \
      GRID_BAR(); \
      PH_BEGIN ph_gla_a2(o.kvt, o.dcy, o.spt); PH_END \
      GRID_BAR(); \
      PH_BEGIN ph_gla_a3(o.projB_b, o.qt, o.og, o.spt, I.b_norm, o.o2b, ll); PH_END \
      GRID_BAR();
#endif
#define LAYER_BODY(li) \
    if (li == 1) { \
      PH_BEGIN StaticOrder S; S.init(o.xb, D, o.WB_t, D, NT, 3584, G_, BIDX()); gemm_phase<EpiStore, StaticOrder, true, true>(ll, Gemm{D, D, D}, S, EpiStore{o.projB_b, 3584}); PH_END \
      GRID_BAR(); \
      GLA_PHASES \
      PH_BEGIN StaticOrder S; S.init(o.o2b, D, o.WoutB_t, D, NT, D, G_, BIDX()); gemm_phase<EpiStore, StaticOrder, true, true>(ll, Gemm{D, D, D}, S, EpiStore{o.hbf, D}); PH_END \
      GRID_BAR(); \
    } \
    PH_BEGIN ph_ln_router(li == 0 ? I.x : w.x2, o.hbf, I.ln1_g + li * D, I.ln1_b + li * D, I.m_w_router + (size_t)li * D * 32, I.m_b_router + li * 32, w.x1, o.m, fl); PH_END \
    GRID_BAR(); \
    PH_BEGIN ph_moe_scatter(w.x1, o.xs, o.m, (int*)lds); PH_END \
    GRID_BAR(); \
    PH_BEGIN MoeOrder S; S.init(o.xs, D, o.W1_t + (size_t)li * 32 * 2048 * D, D, (size_t)2048 * D * 2, __builtin_amdgcn_readfirstlane(*o.m.nblk), 8, 128, o.m.blk_e, G_, BIDX()); \
      gemm_phase<pg8::EpiSwiglu, MoeOrder, true, true>(ll, Gemm{D, D, D}, S, pg8::EpiSwiglu{o.act, D, I.m_b1 + (size_t)li * 32 * 2048}); PH_END \
    GRID_BAR(); \
    PH_BEGIN MoeOrder S; S.init(o.act, D, o.W2_t + (size_t)li * 32 * D * D, D, (size_t)D * D * 2, __builtin_amdgcn_readfirstlane(*o.m.nblk), 4, 256, o.m.blk_e, G_, BIDX()); \
      gemm_phase<pg8::EpiMoe2, MoeOrder, true, true>(ll, Gemm{D, D, D}, S, pg8::EpiMoe2{o.Ys, D, I.m_b2 + (size_t)li * 32 * D, o.m.slot_gate}); PH_END \
    GRID_BAR(); \
    PH_BEGIN ph_combine_ln(w.x1, o.Ys, o.m.slot_of, I.ln2_g + li * D, I.ln2_b + li * D, li == 0 ? w.x2 : out_, li == 0 ? o.xb : nullptr); PH_END \
    if (li == 0) GRID_BAR();
__global__ void __launch_bounds__(NTHR, 2) mk_fwd(Args args) {
  extern __shared__ __attribute__((aligned(16))) unsigned char lds[];
  volatile LAS unsigned* MISC = (volatile LAS unsigned*)((LAS unsigned char*)lds + MISC_OFF);
  if (threadIdx.x < 32) MISC[threadIdx.x] = 0u;
  __syncthreads();
  XcdBarrier bar; { const __attribute__((address_space(4))) Args* ka0 = (const __attribute__((address_space(4))) Args*)__builtin_amdgcn_kernarg_segment_ptr(); bar = xcd_barrier_post((unsigned*)(ka0->ws + WS_CTL) + CW_BAR, MISC + 8); }
#define GRID_BAR() xcd_barrier(bar)
#define PH_BEGIN { const __attribute__((address_space(4))) Args* ka_ = (const __attribute__((address_space(4))) Args*)__builtin_amdgcn_kernarg_segment_ptr(); asm volatile("" : "+s"(ka_)); \
    float* const out_ = ka_->out; (void)out_; unsigned char* wsb_ = ka_->ws; const nvp::Ws w = carve_ws(wsb_); (void)w; const Opt o = carve_opt(wsb_); (void)o; \
    const int gtid_ = BIDX() * NTHR + TIDX(), NGT_ = (int)gridDim.x * NTHR; (void)gtid_; (void)NGT_; const int G_ = (int)gridDim.x; (void)G_;
#define PH_END }
#define I (ka_->in)
  float* fl = (float*)lds; LAS unsigned char* ll = (LAS unsigned char*)lds;
  using pg8::gemm_phase; using pg8::StaticOrder; using pg8::MoeOrder; using pg8::Gemm; using pg8::EpiStore;
  PH_BEGIN ph_prologue(ProIn{I.a_w_uk, I.a_w_uv, I.x, I.a_w_in, I.a_w_out, I.b_w_in, I.b_w_g2, I.b_w_out, I.m_w1, I.m_w2}, o); PH_END
  GRID_BAR();
  PH_BEGIN StaticOrder S; S.init(o.xb, D, o.WA_t, D, NT, 2048, G_, BIDX()); gemm_phase<EpiStore, StaticOrder, true, true>(ll, Gemm{D, D, D}, S, EpiStore{o.projA_b, 2048}); PH_END
  GRID_BAR();
  PH_BEGIN ph_cnorm_b(o.projA_b, I.a_kv_norm, o.cnb); PH_END
  PH_BEGIN pg8::GroupAOrder S; S.init(o.projA_b, 2048, o.Wql_t, 256, NT, 4096, 4, 512, G_, BIDX()); gemm_phase<EpiStore, pg8::GroupAOrder, true, true>(ll, Gemm{2048, 256, 256}, S, EpiStore{o.qlat, 4096}); PH_END
  PH_BEGIN ph_iscore(o.projA_b, o.sc); PH_END
  GRID_BAR();
  PH_BEGIN ph_select_attend(o.sc, o.qlat, o.cnb, o.olat, ll); PH_END
  GRID_BAR();
  PH_BEGIN pg8::GroupAOrder S; S.init(o.olat, 4096, o.Wuv_t, 1024, NT, 1024, 1, 2048, G_, BIDX()); gemm_phase<EpiStore, pg8::GroupAOrder, true, true>(ll, Gemm{4096, 1024, 1024}, S, EpiStore{o.o2b, D}); PH_END
  GRID_BAR();
#if PROBE == 2
  PH_BEGIN cvt_bf16_to_f32(o.projA_b, 2048, w.projA, DINA, NT, DINA, gtid_, NGT_); PH_END
  GRID_BAR();
  PH_BEGIN nvp::np_cnorm(w.projA, I.a_kv_norm, w.cn); PH_END
  PH_BEGIN nvp::np_iscore(w.projA, w.sc, fl); PH_END
  GRID_BAR();
  PH_BEGIN nvp::np_topk(w.sc, w.idx, (char*)lds); PH_END
  GRID_BAR();
  PH_BEGIN nvp::np_dsa_attn(w.projA, w.cn, w.idx, I.a_w_uk, I.a_w_uv, w.o2, fl); PH_END
  GRID_BAR();
  PH_BEGIN { float* pd = (float*)(wsb_ + 1968 * MiB); for (size_t i = gtid_; i < (size_t)NT * D; i += NGT_) pd[i] = bf2f(o.o2b[i]) - w.o2[i]; } PH_END
  GRID_BAR();
#endif
  PH_BEGIN StaticOrder S; S.init(o.o2b, D, o.WoutA_t, D, NT, D, G_, BIDX()); gemm_phase<EpiStore, StaticOrder, true, true>(ll, Gemm{D, D, D}, S, EpiStore{o.hbf, D}); PH_END
  GRID_BAR();
  { LAYER_BODY(0) }
  { LAYER_BODY(1) }
#if PROBE == 2 || PROBE == 3
  GRID_BAR();
#if PROBE == 3
  PH_BEGIN { if (gtid_ == 0) { const unsigned fb = *(const unsigned*)(wsb_ + 512 * 1024); out_[5] += (float)fb; } const float* pd = (const float*)(wsb_ + 1968 * MiB); for (size_t i = gtid_; i < (size_t)NT * D; i += NGT_) out_[i] += PROBE_S * pd[i]; } PH_END
#else
  PH_BEGIN { const float* pd = (const float*)(wsb_ + 1968 * MiB); for (size_t i = gtid_; i < (size_t)NT * D; i += NGT_) out_[i] += PROBE_S * pd[i]; } PH_END
#endif
#endif
}

extern "C" void kernel_launch(void* const* d_in, const int* in_sizes, int n_in, void* d_out, int out_size, void* d_ws, size_t ws_size, hipStream_t stream) {
  static int grid = 0;
  if (grid == 0) {
    if (n_in != 21 || ws_size < WS_NEEDED) { fprintf(stderr, "kernel_launch: bad inputs (n_in %d) or workspace too small (%zu needed, %zu given)\n", n_in, (size_t)WS_NEEDED, ws_size); grid = -1; return; }
    int dev = 0, cus = 0, per_cu = 0;
    if (hipGetDevice(&dev) != hipSuccess || hipDeviceGetAttribute(&cus, hipDeviceAttributeMultiprocessorCount, dev) != hipSuccess) { grid = -1; return; }
    if (hipFuncSetAttribute((const void*)mk_fwd, hipFuncAttributeMaxDynamicSharedMemorySize, LDS_BYTES) != hipSuccess) { fprintf(stderr, "kernel_launch: hipFuncSetAttribute failed\n"); grid = -1; return; }
    if (hipOccupancyMaxActiveBlocksPerMultiprocessor(&per_cu, (const void*)mk_fwd, NTHR, LDS_BYTES) != hipSuccess || per_cu < 1) fprintf(stderr, "kernel_launch: note: occupancy query reports %d\n", per_cu);
    (void)hipGetLastError();
    grid = cus;
    if (grid != 256) fprintf(stderr, "kernel_launch: built for 256 CUs (token ownership per workgroup); got %d\n", grid);
  }
  if (grid < 0) return;
  if (hipMemsetAsync((char*)d_ws + WS_CTL, 0, CTL_ZERO_BYTES, stream) != hipSuccess) { fprintf(stderr, "kernel_launch: memset failed\n"); return; }
  Args a; memset(&a, 0, sizeof(a));
  const float** f = (const float**)&a.in;
  for (int i = 0; i < 21; ++i) f[i] = (const float*)d_in[i];
  a.out = (float*)d_out; a.ws = (unsigned char*)d_ws;
  hipLaunchKernelGGL(mk_fwd, dim3(grid), dim3(NTHR), LDS_BYTES, stream, a);
  const hipError_t le = hipPeekAtLastError();
  if (le != hipSuccess) fprintf(stderr, "kernel_launch: launch failed: %s\n", hipGetErrorName(le));
}
```

```cpp
#include <hip/hip_runtime.h>
#include <cstdio>
#include <cstdint>
#include <cstring>

#define GAS __attribute__((address_space(1)))
#define LAS __attribute__((address_space(3)))
#define NTHR 512
constexpr int LDS_BYTES = 147456;
constexpr int MISC_OFF = 131072 + 8192;

#define XB_TMO      128
#define XB_XCNT(j)  (256  + 64 * (j))
#define XB_XSUB(j)  (1280 + 64 * (j))
#define XB_XGEN(j)  (2304 + 64 * (j))
#define XB_TOP      3328
#define XB_TOPGEN   3392
#define XCD_BAR_WORDS 3456
#define XB_SPIN_CAP (1u << 25)
__device__ __forceinline__ unsigned xb_ld(unsigned* p)              { return __hip_atomic_load(p, __ATOMIC_RELAXED, __HIP_MEMORY_SCOPE_AGENT); }
__device__ __forceinline__ unsigned xb_add(unsigned* p, unsigned v) { return __hip_atomic_fetch_add(p, v, __ATOMIC_RELAXED, __HIP_MEMORY_SCOPE_AGENT); }
__device__ __forceinline__ unsigned xb_xcc_id() { return (unsigned)__builtin_amdgcn_s_getreg((3 << 11) | 20) & 0xFu; }
#define XB_SPIN(cond, bar) do { unsigned _sp = 0; while (cond) { __builtin_amdgcn_s_sleep(1); \
    if ((++_sp & 255u) == 0u) { if (xb_ld(&(bar)[XB_TMO])) break; if (_sp > XB_SPIN_CAP) { atomicAdd(&(bar)[XB_TMO], 1u); break; } } } } while (0)
struct XcdBarrier { unsigned* bar; unsigned x; volatile LAS unsigned* st; };
__device__ __forceinline__ XcdBarrier xcd_barrier_post(unsigned* bar, volatile LAS unsigned* st) {
    XcdBarrier b; b.bar = bar; b.x = xb_xcc_id(); b.st = st;
    if (threadIdx.x == 0) (void)xb_add(&bar[XB_XCNT(b.x)], 1u);
    return b;
}
__device__ __forceinline__ void xcd_barrier_complete(unsigned* bar, unsigned x, unsigned& nloc, unsigned& nx) {
    const unsigned G = gridDim.x * gridDim.y * gridDim.z;
    unsigned sum, cnt, mine, sp = 0u;
    for (;;) {
        sum = 0u; cnt = 0u; mine = 0u;
#pragma unroll
        for (unsigned j = 0; j < 16; ++j) { const unsigned c = xb_ld(&bar[XB_XCNT(j)]); sum += c; cnt += (c > 0u) ? 1u : 0u; mine = (j == x) ? c : mine; }
        if (sum == G) break;
        __builtin_amdgcn_s_sleep(1);
        if ((++sp & 255u) == 0u) { if (xb_ld(&bar[XB_TMO])) break; if (sp > XB_SPIN_CAP) { atomicAdd(&bar[XB_TMO], 1u); break; } }
    }
    nloc = mine > 0u ? mine : 1u; nx = cnt > 0u ? cnt : 1u;
}
__device__ __forceinline__ void xcd_barrier(const XcdBarrier& b) {
    asm volatile("s_waitcnt vmcnt(0)" ::: "memory");
    __syncthreads();
    if (threadIdx.x == 0) {
        unsigned* bar = b.bar;
        __builtin_amdgcn_s_waitcnt(0);
        unsigned nloc = b.st[0], nx = b.st[1];
        if (nloc == 0u) { xcd_barrier_complete(bar, b.x, nloc, nx); b.st[0] = nloc; b.st[1] = nx; }
        const unsigned old = xb_add(&bar[XB_XSUB(b.x)], 1u);
        const unsigned gen = old / nloc;
        if (old + 1u == (gen + 1u) * nloc) {
            __builtin_amdgcn_fence(__ATOMIC_RELEASE, "agent");
            asm volatile("s_waitcnt vmcnt(0)" ::: "memory");
            const unsigned og = xb_add(&bar[XB_TOP], 1u);
            const unsigned tg = og / nx;
            if (og + 1u == (tg + 1u) * nx) xb_add(&bar[XB_TOPGEN], 1u);
            else XB_SPIN(xb_ld(&bar[XB_TOPGEN]) == tg, bar);
            __builtin_amdgcn_fence(__ATOMIC_ACQUIRE, "agent");
            xb_add(&bar[XB_XGEN(b.x)], 1u);
            asm volatile("s_waitcnt vmcnt(0)" ::: "memory");
        } else {
            XB_SPIN(xb_ld(&bar[XB_XGEN(b.x)]) == gen, bar);
            __builtin_amdgcn_fence(__ATOMIC_ACQUIRE, "agent");
            asm volatile("s_waitcnt vmcnt(0)" ::: "memory");
        }
    }
    __syncthreads();
}

constexpr int NT = 16384, D = 1024, L = 8192, NB = 2;
constexpr int DINA = 1864, DINB = 3088;
constexpr int PMAX = 73728;
constexpr float ALPHA = 1.4142135623730951f;

struct In { const float *x, *a_w_in, *a_kv_norm, *a_w_uk, *a_w_uv, *a_w_out, *b_w_in, *b_w_g2, *b_g_bias, *b_norm, *b_w_out, *m_w_router, *m_b_router, *m_w1, *m_b1, *m_w2, *m_b2, *ln1_g, *ln1_b, *ln2_g, *ln2_b; };

__device__ __forceinline__ int TIDX() { int t = threadIdx.x; asm volatile("" : "+v"(t)); return t; }
__device__ __forceinline__ int BIDX() { int t = blockIdx.x; asm volatile("" : "+s"(t)); return t; }
__device__ __forceinline__ float wave_sum(float v) {
#pragma unroll
    for (int o = 1; o < 64; o <<= 1) v += __shfl_xor(v, o);
    return v;
}
namespace nvp {
#define WSYNC() asm volatile("s_waitcnt lgkmcnt(0)" ::: "memory")
struct GemmP {
  const float* A; int lda; const int* arow;
  const float* B; int ldb; float* C; int ldc; int M, N, K;
  const int* blk_e; const int* nblk_used; size_t bstride; const float* bias; size_t bias_stride;
};
__device__ __forceinline__ GemmP mkg(const float* A, int lda, const int* arow, const float* B, int ldb, float* C, int ldc, int M, int N, int K, const int* blk_e, const int* nblk_used, size_t bstride, const float* bias, size_t bias_stride) {
  GemmP p; p.A = A; p.lda = lda; p.arow = arow; p.B = B; p.ldb = ldb; p.C = C; p.ldc = ldc; p.M = M; p.N = N; p.K = K; p.blk_e = blk_e; p.nblk_used = nblk_used; p.bstride = bstride; p.bias = bias; p.bias_stride = bias_stride; return p; }

template <int MODE>
__device__ __forceinline__ void np_sgemm(const GemmP p, float* lds) {
  float (*As)[132] = (float (*)[132])lds;
  float (*Bs)[68] = (float (*)[68])(lds + 16 * 132);
  float (*Bu)[68] = (float (*)[68])(lds + 16 * 132 + 16 * 68);
  const int tid = TIDX(), tx = tid & 15, ty = tid >> 4;
  const int ntn = (p.N + 63) / 64, ntm = p.M / 128;
  const int ar = tid >> 2, ak = (tid & 3) * 4;
  const int bk = (tid & 255) >> 4, bn4 = (tid & 15) * 4;
  for (int t = BIDX(); t < ntm * ntn; t += gridDim.x) {
    const int bm = t / ntn, bn = t % ntn;
    const float* B = p.B; const float* bias = p.bias;
    if (MODE != 0) { const int blk = (bm * 128) / 256; if (blk >= *p.nblk_used) continue; const int e = p.blk_e[blk]; B += (size_t)e * p.bstride; bias += (size_t)e * p.bias_stride; }
    const int m0 = bm * 128, n0 = bn * 64;
    const int arow = p.arow ? p.arow[m0 + ar] : (m0 + ar);
    const float* Ap = p.A + (size_t)arow * p.lda + ak;
    const bool bok = (n0 + bn4) < p.N;
    float acc[4][4] = {}, accu[4][4] = {};
    for (int k0 = 0; k0 < p.K; k0 += 16) {
      const float4 av = *(const float4*)(Ap + k0);
      As[ak + 0][ar] = av.x; As[ak + 1][ar] = av.y; As[ak + 2][ar] = av.z; As[ak + 3][ar] = av.w;
      if (tid < 256) { float4 bv = make_float4(0.f, 0.f, 0.f, 0.f); if (bok) bv = *(const float4*)(B + (size_t)(k0 + bk) * p.ldb + n0 + bn4); *(float4*)&Bs[bk][bn4] = bv; }
      else if (MODE == 1) { const float4 uv = *(const float4*)(B + (size_t)(k0 + bk) * p.ldb + 1024 + n0 + bn4); *(float4*)&Bu[bk][bn4] = uv; }
      __syncthreads();
#pragma unroll
      for (int kk = 0; kk < 16; ++kk) {
        const float4 a = *(const float4*)&As[kk][ty * 4];
        const float4 b = *(const float4*)&Bs[kk][tx * 4];
        const float aa[4] = {a.x, a.y, a.z, a.w}, bb[4] = {b.x, b.y, b.z, b.w};
#pragma unroll
        for (int i = 0; i < 4; ++i)
#pragma unroll
          for (int j = 0; j < 4; ++j) acc[i][j] = fmaf(aa[i], bb[j], acc[i][j]);
        if (MODE == 1) {
          const float4 u = *(const float4*)&Bu[kk][tx * 4]; const float uu[4] = {u.x, u.y, u.z, u.w};
#pragma unroll
          for (int i = 0; i < 4; ++i)
#pragma unroll
            for (int j = 0; j < 4; ++j) accu[i][j] = fmaf(aa[i], uu[j], accu[i][j]);
        }
      }
      __syncthreads();
    }
#pragma unroll
    for (int i = 0; i < 4; ++i) {
      const int m = m0 + ty * 4 + i;
#pragma unroll
      for (int j = 0; j < 4; ++j) {
        const int n = n0 + tx * 4 + j; if (n >= p.N) continue;
        float v = acc[i][j];
        if (MODE == 1) {
          float g = v + bias[n], u = accu[i][j] + bias[1024 + n];
          g = fminf(g, 7.f); u = fminf(fmaxf(u, -7.f), 7.f);
          const float glu = g / (1.f + expf(-1.702f * g));
          v = (u + 1.f) * glu;
        } else if (MODE == 2) v += bias[n];
        p.C[(size_t)m * p.ldc + n] = v;
      }
    }
  }
}

#define GW_INIT const int lane = TIDX() & 63, wave = TIDX() >> 6, gw = BIDX() * 8 + wave, NGW = gridDim.x * 8; (void)lane; (void)wave; (void)gw; (void)NGW

__device__ __forceinline__ void np_cnorm(const float* projA, const float* g, float* cn) {
  GW_INIT;
  for (int row = gw; row < NT; row += NGW) {
    const float4 v = *(const float4*)(projA + (size_t)row * DINA + 1024 + lane * 4);
    const float ss = wave_sum(v.x * v.x + v.y * v.y + v.z * v.z + v.w * v.w);
    const float r = rsqrtf(ss * (1.f / 256.f) + 1e-6f); const float4 g4 = *(const float4*)(g + lane * 4);
    *(float4*)(cn + (size_t)row * 256 + lane * 4) = make_float4(v.x * r * g4.x, v.y * r * g4.y, v.z * r * g4.z, v.w * r * g4.w);
  }
}

__device__ __forceinline__ void np_iscore(const float* projA, float* sc, float* lds) {
  float (*As)[132] = (float (*)[132])lds;
  float (*Bs)[68] = (float (*)[68])(lds + 16 * 132);
  const int tid = TIDX(), tx = tid & 15, ty = tid >> 4;
  const int ar = tid >> 2, ak = (tid & 3) * 4;
  const int br = (tid & 255) >> 2;
  for (int u = BIDX(); u < NB * 64 * 128; u += gridDim.x) {
    const int b = u / (64 * 128), tt = (u / 128) % 64, st = u % 128;
    if (st > 2 * tt + 1) continue;
    const int t0 = tt * 128, s0 = st * 64;
    const float* Qp = projA + (size_t)(b * L + t0 + ar) * DINA + 1280 + ak;
    const float* Kp = projA + (size_t)(b * L + s0 + br) * DINA + 1792 + ak;
    float score[4][4] = {};
    for (int h = 0; h < 8; ++h) {
      float acc[4][4] = {};
      for (int k0 = 0; k0 < 64; k0 += 16) {
        const float4 av = *(const float4*)(Qp + h * 64 + k0);
        As[ak + 0][ar] = av.x; As[ak + 1][ar] = av.y; As[ak + 2][ar] = av.z; As[ak + 3][ar] = av.w;
        if (tid < 256) { const float4 bv = *(const float4*)(Kp + k0); Bs[ak + 0][br] = bv.x; Bs[ak + 1][br] = bv.y; Bs[ak + 2][br] = bv.z; Bs[ak + 3][br] = bv.w; }
        __syncthreads();
#pragma unroll
        for (int kk = 0; kk < 16; ++kk) {
          const float4 a = *(const float4*)&As[kk][ty * 4]; const float4 bq = *(const float4*)&Bs[kk][tx * 4];
          const float aa[4] = {a.x, a.y, a.z, a.w}, bb[4] = {bq.x, bq.y, bq.z, bq.w};
#pragma unroll
          for (int i = 0; i < 4; ++i)
#pragma unroll
            for (int j = 0; j < 4; ++j) acc[i][j] = fmaf(aa[i], bb[j], acc[i][j]);
        }
        __syncthreads();
      }
#pragma unroll
      for (int i = 0; i < 4; ++i) {
        const float w = projA[(size_t)(b * L + t0 + ty * 4 + i) * DINA + 1856 + h] * 0.35355339059327373f;
#pragma unroll
        for (int j = 0; j < 4; ++j) score[i][j] += w * fmaxf(acc[i][j] * 0.125f, 0.f);
      }
    }
#pragma unroll
    for (int i = 0; i < 4; ++i)
#pragma unroll
      for (int j = 0; j < 4; ++j) sc[((size_t)(b * L + t0 + ty * 4 + i)) * L + s0 + tx * 4 + j] = score[i][j];
  }
}

__device__ __forceinline__ unsigned f2key(float f) { f = f + 0.0f; const unsigned u = __float_as_uint(f); return (u & 0x80000000u) ? ~u : (u | 0x80000000u); }

__device__ __forceinline__ void np_topk(const float* sc, int* idx_out, char* lds) {
  GW_INIT;
  unsigned* hist = (unsigned*)(lds + wave * 1280); unsigned* cntw = hist + 256;
  for (int row = gw; row < NT; row += NGW) {
    const int t = row % L, n = t + 1;
    const float* s = sc + (size_t)row * L; int* out = idx_out + (size_t)row * 256;
    if (n <= 256) { for (int i = lane; i < 256; i += 64) out[i] = i < n ? i : -1; continue; }
    unsigned prefix = 0, need = 256;
    for (int pass = 3; pass >= 0; --pass) {
      const int shift = pass * 8;
      for (int i = lane; i < 256; i += 64) hist[i] = 0;
      WSYNC();
      for (int i = lane; i < n; i += 64) { const unsigned k = f2key(s[i]); const bool m = (pass == 3) || ((k >> (shift + 8)) == (prefix >> (shift + 8))); if (m) atomicAdd(&hist[(k >> shift) & 255u], 1u); }
      WSYNC();
      unsigned cum = 0; int d = 255; for (; d > 0; --d) { const unsigned hv = hist[d]; if (cum + hv >= need) break; cum += hv; }
      prefix |= ((unsigned)d << shift); need -= cum;
      WSYNC();
    }
    if (lane == 0) *cntw = 0; WSYNC();
    for (int i = lane; i < n; i += 64) { if (f2key(s[i]) > prefix) { const unsigned pos = atomicAdd(cntw, 1u); out[pos] = i; } }
    WSYNC();
    if (lane == 0) { unsigned c = *cntw; unsigned nd = need; for (int i = 0; i < n && nd > 0; ++i) if (f2key(s[i]) == prefix) { out[c++] = i; --nd; } }
    WSYNC();
  }
}

__device__ __forceinline__ void np_dsa_attn(const float* projA, const float* cn, const int* idx, const float* w_uk, const float* w_uv, float* o2, float* lds) {
  const int half = TIDX() >> 8, tid = TIDX() & 255;
  float* base = lds + half * 14336;
  float* qs = base; float (*ql)[256] = (float (*)[256])(base + 1024); float (*pr)[257] = (float (*)[257])(base + 1024 + 4096);
  float (*ol)[256] = (float (*)[256])(base + 1024 + 4096 + 4112); float* red = base + 1024 + 4096 + 4112 + 4096; int* sid = (int*)(red + 16);
  for (int r0 = BIDX() * 2; r0 < NT; r0 += gridDim.x * 2) {
    const int row = r0 + half, b = row / L;
    __syncthreads();
    for (int i = tid; i < 1024; i += 256) qs[i] = projA[(size_t)row * DINA + i];
    sid[tid] = idx[(size_t)row * 256 + tid];
    __syncthreads();
    { const int c = tid;
#pragma unroll 1
      for (int h = 0; h < 16; ++h) { float a = 0.f;
#pragma unroll 8
        for (int d = 0; d < 64; ++d) a = fmaf(qs[h * 64 + d], w_uk[((size_t)h * 64 + d) * 256 + c], a); ql[h][c] = a; } }
    __syncthreads();
    { const int k = tid, key = sid[k];
      float lg[16];
      if (key >= 0) { const float* cr = cn + (size_t)(b * L + key) * 256;
        for (int h = 0; h < 16; ++h) lg[h] = 0.f;
#pragma unroll 2
        for (int c = 0; c < 256; ++c) { const float cv = cr[c];
#pragma unroll
          for (int h = 0; h < 16; ++h) lg[h] = fmaf(ql[h][c], cv, lg[h]); }
#pragma unroll
        for (int h = 0; h < 16; ++h) pr[h][k] = lg[h] * 0.125f;
      } else {
#pragma unroll
        for (int h = 0; h < 16; ++h) pr[h][k] = -INFINITY; } }
    __syncthreads();
    if (tid < 16) { const int h = tid; float m = -INFINITY; for (int k = 0; k < 256; ++k) m = fmaxf(m, pr[h][k]); float su = 0.f; for (int k = 0; k < 256; ++k) { const float e = expf(pr[h][k] - m); pr[h][k] = e; su += e; } red[h] = 1.f / su; }
    __syncthreads();
    { const int c = tid; float a[16];
#pragma unroll
      for (int h = 0; h < 16; ++h) a[h] = 0.f;
#pragma unroll 2
      for (int k = 0; k < 256; ++k) { const int key = sid[k]; if (key < 0) continue; const float cv = cn[(size_t)(b * L + key) * 256 + c];
#pragma unroll
        for (int h = 0; h < 16; ++h) a[h] = fmaf(pr[h][k], cv, a[h]); }
#pragma unroll
      for (int h = 0; h < 16; ++h) ol[h][c] = a[h] * red[h]; }
    __syncthreads();
#pragma unroll 1
    for (int o = tid; o < 1024; o += 256) { const int h = o >> 6, v = o & 63; float a = 0.f;
#pragma unroll 8
      for (int c = 0; c < 256; ++c) a = fmaf(ol[h][c], w_uv[((size_t)h * 256 + c) * 64 + v], a); o2[(size_t)row * 1024 + o] = a; }
  }
  __syncthreads();
}

__device__ __forceinline__ void np_ln_res(const float* x, const float* h, const float* g, const float* bb, float* out) {
  GW_INIT;
  for (int row = gw; row < NT; row += NGW) {
    float4 v[4]; float s = 0.f;
#pragma unroll
    for (int j = 0; j < 4; ++j) { const float4 a = *(const float4*)(x + (size_t)row * D + lane * 4 + 256 * j), hh = *(const float4*)(h + (size_t)row * D + lane * 4 + 256 * j);
      v[j] = make_float4(ALPHA * a.x + hh.x, ALPHA * a.y + hh.y, ALPHA * a.z + hh.z, ALPHA * a.w + hh.w); s += (v[j].x + v[j].y) + (v[j].z + v[j].w); }
    const float mu = wave_sum(s) * (1.f / D); float q = 0.f;
#pragma unroll
    for (int j = 0; j < 4; ++j) { v[j].x -= mu; v[j].y -= mu; v[j].z -= mu; v[j].w -= mu; q += (v[j].x * v[j].x + v[j].y * v[j].y) + (v[j].z * v[j].z + v[j].w * v[j].w); }
    const float r = rsqrtf(wave_sum(q) * (1.f / D) + 1e-5f);
#pragma unroll
    for (int j = 0; j < 4; ++j) { const int c = lane * 4 + 256 * j; const float4 g4 = *(const float4*)(g + c), b4 = *(const float4*)(bb + c);
      *(float4*)(out + (size_t)row * D + c) = make_float4(v[j].x * r * g4.x + b4.x, v[j].y * r * g4.y + b4.y, v[j].z * r * g4.z + b4.z, v[j].w * r * g4.w + b4.w); }
  }
}

__device__ __forceinline__ void np_router(const float* x, const float* wr, const float* br, int* tok_e, float* tok_g, int* counts, int* row_tok, char* lds) {
  GW_INIT;
  for (int i = BIDX() * NTHR + TIDX(); i < PMAX; i += gridDim.x * NTHR) row_tok[i] = 0;
  float* lg = (float*)(lds + wave * 256);
  const int e = lane & 31, hf = lane >> 5;
  for (int tok = gw; tok < NT; tok += NGW) {
    const float* xr = x + (size_t)tok * D + hf * 512; const float* wp = wr + (size_t)hf * 512 * 32 + e; float a = 0.f;
#pragma unroll 8
    for (int d = 0; d < 512; ++d) a = fmaf(xr[d], wp[d * 32], a);
    a += __shfl_xor(a, 32);
    if (hf == 0) lg[e] = a + br[e];
    WSYNC();
    if (lane == 0) { int ei[4]; float ev[4];
      for (int k = 0; k < 4; ++k) { int bi = 0; float bv = -INFINITY; for (int j = 0; j < 32; ++j) if (lg[j] > bv) { bv = lg[j]; bi = j; } ei[k] = bi; ev[k] = bv; lg[bi] = -INFINITY; }
      float su = 0.f, ex[4]; for (int k = 0; k < 4; ++k) { ex[k] = expf(ev[k] - ev[0]); su += ex[k]; }
      for (int k = 0; k < 4; ++k) { tok_e[tok * 4 + k] = ei[k]; tok_g[tok * 4 + k] = ex[k] / su; atomicAdd(&counts[ei[k]], 1); } }
    WSYNC();
  }
}
__device__ __forceinline__ void np_moe_sort(const int* tok_e, const float* tok_g, const int* counts, int* row_tok, float* row_gate, int* slot_of, int* blk_e, int* nblk_used, char* lds) {
  if (BIDX() != 0) return;
  const int e = TIDX(); int* pstart = (int*)lds; int* stage = pstart + 64;
  if (e == 0) { int acc = 0; for (int j = 0; j < 32; ++j) { pstart[j] = acc; const int nb = (counts[j] + 255) / 256; for (int q = 0; q < nb; ++q) blk_e[acc / 256 + q] = j; acc += nb * 256; } pstart[32] = acc; *nblk_used = acc / 256; }
  __syncthreads();
  int pos = e < 32 ? pstart[e] : 0;
  for (int c0 = 0; c0 < NT * 4; c0 += 2048) {
    __syncthreads();
    for (int i = e; i < 2048; i += NTHR) stage[i] = tok_e[c0 + i];
    __syncthreads();
    if (e < 32) for (int i = 0; i < 2048; ++i) if (stage[i] == e) { const int gi = c0 + i; row_tok[pos] = gi >> 2; row_gate[pos] = tok_g[gi]; slot_of[gi] = pos; ++pos; }
  }
  __syncthreads();
}
__device__ __forceinline__ void np_moe_combine_ln(const float* x1, const float* ys, const int* slot_of, const float* tok_g, const float* g, const float* bb, float* out) {
  GW_INIT;
  for (int row = gw; row < NT; row += NGW) {
    float4 v[4]; float s = 0.f; int sl[4]; float gg[4];
#pragma unroll
    for (int k = 0; k < 4; ++k) { sl[k] = slot_of[row * 4 + k]; gg[k] = tok_g[row * 4 + k]; }
#pragma unroll
    for (int j = 0; j < 4; ++j) { const int c = lane * 4 + 256 * j; float4 f = make_float4(0.f, 0.f, 0.f, 0.f);
#pragma unroll
      for (int k = 0; k < 4; ++k) { const float4 y = *(const float4*)(ys + (size_t)sl[k] * D + c); f.x += gg[k] * y.x; f.y += gg[k] * y.y; f.z += gg[k] * y.z; f.w += gg[k] * y.w; }
      const float4 a = *(const float4*)(x1 + (size_t)row * D + c);
      v[j] = make_float4(ALPHA * a.x + f.x, ALPHA * a.y + f.y, ALPHA * a.z + f.z, ALPHA * a.w + f.w); s += (v[j].x + v[j].y) + (v[j].z + v[j].w); }
    const float mu = wave_sum(s) * (1.f / D); float q = 0.f;
#pragma unroll
    for (int j = 0; j < 4; ++j) { v[j].x -= mu; v[j].y -= mu; v[j].z -= mu; v[j].w -= mu; q += (v[j].x * v[j].x + v[j].y * v[j].y) + (v[j].z * v[j].z + v[j].w * v[j].w); }
    const float r = rsqrtf(wave_sum(q) * (1.f / D) + 1e-5f);
#pragma unroll
    for (int j = 0; j < 4; ++j) { const int c = lane * 4 + 256 * j; const float4 g4 = *(const float4*)(g + c), b4 = *(const float4*)(bb + c);
      *(float4*)(out + (size_t)row * D + c) = make_float4(v[j].x * r * g4.x + b4.x, v[j].y * r * g4.y + b4.y, v[j].z * r * g4.z + b4.z, v[j].w * r * g4.w + b4.w); }
  }
}

__device__ __forceinline__ void np_gla_gate(const float* projB, const float* w_g2, const float* gb, float* adec) {
  GW_INIT;
  for (int row = gw; row < NT; row += NGW) {
    float glr[16];
#pragma unroll
    for (int j = 0; j < 16; ++j) glr[j] = projB[(size_t)row * DINB + 2048 + j];
    for (int c = lane; c < 512; c += 64) { float a = gb[c];
#pragma unroll
      for (int j = 0; j < 16; ++j) a = fmaf(glr[j], w_g2[j * 512 + c], a);
      const float ls = fminf(a, 0.f) - log1pf(expf(-fabsf(a))); adec[(size_t)row * 512 + c] = expf(ls * (1.f / 16.f)); }
  }
}
__device__ __forceinline__ void np_gla_scan(const float* projB, const float* adec, float* og, float* lds) {
  if (BIDX() >= 8) return;
  const int b = BIDX() >> 2, h = BIDX() & 3, tid = TIDX(), dv = tid & 255, dh = tid >> 8;
  float (*qs)[128] = (float (*)[128])lds; float (*ks)[128] = (float (*)[128])(lds + 2048); float (*as)[128] = (float (*)[128])(lds + 4096);
  float (*po)[16][256] = (float (*)[16][256])(lds + 6144);
  float S[64];
#pragma unroll
  for (int d = 0; d < 64; ++d) S[d] = 0.f;
  for (int t0 = 0; t0 < L; t0 += 16) {
    __syncthreads();
    for (int i = tid; i < 16 * 128; i += NTHR) { const int tt = i >> 7, d = i & 127; const size_t r = (size_t)(b * L + t0 + tt);
      qs[tt][d] = projB[r * DINB + h * 128 + d] * 0.08838834764831845f; ks[tt][d] = projB[r * DINB + 512 + h * 128 + d]; as[tt][d] = adec[r * 512 + h * 128 + d]; }
    __syncthreads();
#pragma unroll 1
    for (int tt = 0; tt < 16; ++tt) { const size_t r = (size_t)(b * L + t0 + tt); const float v = projB[r * DINB + 1024 + h * 256 + dv]; float o = 0.f;
#pragma unroll
      for (int d = 0; d < 64; ++d) { S[d] = fmaf(as[tt][dh * 64 + d], S[d], ks[tt][dh * 64 + d] * v); o = fmaf(qs[tt][dh * 64 + d], S[d], o); }
      po[dh][tt][dv] = o; }
    __syncthreads();
    for (int i = tid; i < 16 * 256; i += NTHR) { const int tt = i >> 8, c = i & 255; og[(size_t)(b * L + t0 + tt) * 1024 + h * 256 + c] = po[0][tt][c] + po[1][tt][c]; }
  }
  __syncthreads();
}
__device__ __forceinline__ void np_gla_norm(const float* og, const float* projB, const float* ng, float* on) {
  GW_INIT;
  for (int u = gw; u < NT * 4; u += NGW) {
    const int row = u >> 2, h = u & 3; const int c = h * 256 + lane * 4;
    const float4 v = *(const float4*)(og + (size_t)row * 1024 + c);
    const float r = rsqrtf(wave_sum(v.x * v.x + v.y * v.y + v.z * v.z + v.w * v.w) * (1.f / 256.f) + 1e-6f);
    const float4 rr = *(const float4*)(projB + (size_t)row * DINB + 2064 + c), g4 = *(const float4*)(ng + c);
    *(float4*)(on + (size_t)row * 1024 + c) = make_float4(v.x * r * g4.x * (rr.x / (1.f + expf(-rr.x))), v.y * r * g4.y * (rr.y / (1.f + expf(-rr.y))), v.z * r * g4.z * (rr.z / (1.f + expf(-rr.z))), v.w * r * g4.w * (rr.w / (1.f + expf(-rr.w))));
  }
}

struct Ws { float *projA, *cn, *sc, *o2, *h, *x1, *x2, *hb, *ys, *projB, *adec, *og, *on, *tok_g, *row_gate; int *idx, *tok_e, *slot_of, *row_tok, *blk_e, *counts; };
}
typedef unsigned short bf16_t;
typedef unsigned v4u __attribute__((ext_vector_type(4)));
typedef unsigned v2u __attribute__((ext_vector_type(2)));
typedef float f32x4 __attribute__((ext_vector_type(4)));
typedef short bf16x8 __attribute__((ext_vector_type(8)));
typedef float f32x2_t __attribute__((ext_vector_type(2))); typedef __bf16 bf16x2_t __attribute__((ext_vector_type(2)));
__device__ __forceinline__ unsigned cvt_pk_bf16(float lo, float hi) { const f32x2_t v = {lo, hi}; const bf16x2_t b = __builtin_convertvector(v, bf16x2_t); return __builtin_bit_cast(unsigned, b); }
__device__ __forceinline__ float bf_lo(unsigned u) { return __uint_as_float(u << 16); }
__device__ __forceinline__ float bf_hi(unsigned u) { return __uint_as_float(u & 0xffff0000u); }
__device__ __forceinline__ float bf2f(bf16_t h) { return __uint_as_float(((unsigned)h) << 16); }

struct TJob { const float* src; int lds_; int K, N; bf16_t* dst; int ldd; int drow0, dcol0; int rowmap; int ntk, ntn; };
__device__ __forceinline__ TJob mk_tjob(const float* src, int lds_, int K, int N, bf16_t* dst, int ldd, int drow0, int dcol0, int rowmap) {
  TJob j; j.src = src; j.lds_ = lds_; j.K = K; j.N = N; j.dst = dst; j.ldd = ldd; j.drow0 = drow0; j.dcol0 = dcol0; j.rowmap = rowmap; j.ntk = K / 64; j.ntn = (N + 127) / 128; return j; }
__device__ __forceinline__ int tjob_tiles(const TJob& j) { return j.ntk * j.ntn; }
__device__ __forceinline__ void transpose_tile(const TJob& j, int tile, int lane) {
  const int kt = tile / j.ntn, nt_ = tile % j.ntn, k0 = kt * 64, n0 = nt_ * 128;
  const int q = lane & 31, par = lane >> 5;
  const bool ok = (n0 + 4 * q) < j.N;
  f32x4 v[32];
  const float* sp = j.src + (size_t)(k0 + par) * j.lds_ + n0 + 4 * q;
#pragma unroll
  for (int i = 0; i < 32; ++i) v[i] = ok ? *(const f32x4*)(sp + (size_t)(2 * i) * j.lds_) : (f32x4){0.f, 0.f, 0.f, 0.f};
  unsigned ra[32], rb[32];
#pragma unroll
  for (int i = 0; i < 32; ++i) {
    auto s0 = __builtin_amdgcn_permlane32_swap(__float_as_uint(v[i][0]), __float_as_uint(v[i][2]), false, false);
    auto s1 = __builtin_amdgcn_permlane32_swap(__float_as_uint(v[i][1]), __float_as_uint(v[i][3]), false, false);
    ra[i] = cvt_pk_bf16(__uint_as_float(s0[0]), __uint_as_float(s0[1]));
    rb[i] = cvt_pk_bf16(__uint_as_float(s1[0]), __uint_as_float(s1[1]));
  }
  if (ok) {
    const int n = n0 + 4 * q + 2 * par;
    int r0 = n, r1 = n + 1;
    if (j.rowmap == 1) { const int jj0 = r0 & 1023, jj1 = r1 & 1023; r0 = 256 * (jj0 >> 7) + ((r0 >> 10) << 7) + (jj0 & 127); r1 = 256 * (jj1 >> 7) + ((r1 >> 10) << 7) + (jj1 & 127); }
    bf16_t* d0 = j.dst + (size_t)(j.drow0 + r0) * j.ldd + j.dcol0 + k0;
    bf16_t* d1 = j.dst + (size_t)(j.drow0 + r1) * j.ldd + j.dcol0 + k0;
#pragma unroll
    for (int c = 0; c < 8; ++c) { *(v4u*)(d0 + 8 * c) = (v4u){ra[4 * c], ra[4 * c + 1], ra[4 * c + 2], ra[4 * c + 3]}; *(v4u*)(d1 + 8 * c) = (v4u){rb[4 * c], rb[4 * c + 1], rb[4 * c + 2], rb[4 * c + 3]}; }
  }
}
__device__ __forceinline__ void transpose_job(const TJob j, int& w0, int gw, int NGW, int lane) {
  const int nt_ = tjob_tiles(j);
  int first = gw - (w0 % NGW); if (first < 0) first += NGW;
#pragma unroll 1
  for (int t = first; t < nt_; t += NGW) transpose_tile(j, t, lane);
  w0 += nt_;
}
__device__ __forceinline__ void zero_rect(bf16_t* dst, int ldd, int r0, int nr, int cb0, int nbytes, int gtid, int NGT) {
  const int per = nbytes / 16;
  for (int i = gtid; i < nr * per; i += NGT) { const int r = i / per, c = i % per; *(v4u*)((char*)(dst + (size_t)(r0 + r) * ldd) + cb0 + 16 * c) = (v4u){0u, 0u, 0u, 0u}; }
}
__device__ __forceinline__ void cvt_f32_to_bf16(const float* src, int lds_, bf16_t* dst, int ldd, int rows, int ncols, int gtid, int NGT) {
  const int per = ncols / 4;
  for (size_t i = gtid; i < (size_t)rows * per; i += NGT) { const size_t r = i / per; const int c = (int)(i % per) * 4; const f32x4 v = *(const f32x4*)(src + r * lds_ + c);
    *(v2u*)(dst + r * ldd + c) = (v2u){cvt_pk_bf16(v[0], v[1]), cvt_pk_bf16(v[2], v[3])}; }
}
__device__ __forceinline__ void cvt_bf16_to_f32(const bf16_t* src, int lds_, float* dst, int ldd, int rows, int ncols, int gtid, int NGT) {
  const int per = ncols / 4;
  for (size_t i = gtid; i < (size_t)rows * per; i += NGT) { const size_t r = i / per; const int c = (int)(i % per) * 4; const v2u v = *(const v2u*)(src + r * lds_ + c);
    *(f32x4*)(dst + r * ldd + c) = (f32x4){bf_lo(v[0]), bf_hi(v[0]), bf_lo(v[1]), bf_hi(v[1])}; }
}

namespace pg8 {
#define PG8_LAS __attribute__((address_space(3)))
typedef unsigned u32x4 __attribute__((ext_vector_type(4)));
constexpr int BM = 256, BK = 64, HALF = 128, HTB = HALF * BK * 2, STAGE_BYTES = 8 * HTB, NXCD = 8, WGM = 8;
__host__ __device__ __forceinline__ int lds_byte(int r, int c) { const int st = (r >> 4) * 2 + (c >> 5), rr = r & 15, cc = c & 31, ob = rr * 64 + cc * 2; return st * 1024 + (ob ^ (((ob >> 9) & 1) << 5)); }
__host__ __device__ __forceinline__ void stage_rc(int b, int& R, int& C) { const int st = b / 1024, sb = b % 1024, swz = sb ^ (((sb >> 9) & 1) << 5); R = (st >> 1) * 16 + swz / 64; C = (st & 1) * 32 + (swz % 64) / 2; }
__host__ __device__ __forceinline__ int perm32(int rho) { const int n = rho >> 4, i = rho & 15; return 8 * (i >> 2) + 4 * n + (i & 3); }
struct Unit { const char* pa; const char* pb; int orow, ocol, e; };
struct Gemm { int lda, ldb, K; };
struct StaticOrder {
    const char* A; const char* Bt; size_t ta, tb; int nM, nN, nwg, G, c;
    __device__ void init(const void* A_, int lda, const void* Bt_, int ldb, int M, int N, int G_, int c_) { A = (const char*)A_; Bt = (const char*)Bt_; ta = (size_t)BM * lda * 2; tb = (size_t)BM * ldb * 2; nM = M / BM; nN = N / BM; nwg = nM * nN; G = G_; c = c_; }
    __device__ bool tile(int i, int& pm, int& pn) const {
        const long L = (long)i * G + c; if (L >= nwg) return false;
        int wgid = (int)L; { const int q = nwg / NXCD, r = nwg % NXCD, xcd = wgid % NXCD, off = wgid / NXCD; wgid = (xcd < r ? xcd * (q + 1) : r * (q + 1) + (xcd - r) * q) + off; }
        const int nig = WGM * nN, gid = wgid / nig, fm = gid * WGM, gsz = (nM - fm) < WGM ? (nM - fm) : WGM;
        pm = fm + ((wgid % nig) % gsz); pn = (wgid % nig) / gsz; return true;
    }
    __device__ bool next(int i, Unit& u) const { int pm, pn; if (!tile(i, pm, pn)) return false; u.pa = A + (size_t)pm * ta; u.pb = Bt + (size_t)pn * tb; u.orow = pm * BM; u.ocol = pn * BM; u.e = 0; return true; }
    __device__ __forceinline__ void a_ready(const Unit&) const {}
    __device__ __forceinline__ void done(const Unit&) const {}
};
struct EpiStore {
    static constexpr bool PERM = true, AFTER_DRAIN = false;
    bf16_t* O; int ldc;
    __device__ __forceinline__ void operator()(const f32x4 (&acc)[2][2][4][2], const Unit& u, int wr, int wc, int fr, int fq) const {
        const int row0 = u.orow + wr * 64 + fr, col0 = u.ocol + wc * 32 + 8 * fq;
#pragma unroll
        for (int ai = 0; ai < 2; ++ai)
#pragma unroll
            for (int m = 0; m < 4; ++m) { bf16_t* rowp = O + (size_t)(row0 + ai * HALF + m * 16) * ldc + col0;
#pragma unroll
                for (int bj = 0; bj < 2; ++bj) { const f32x4 v0 = acc[ai][bj][m][0], v1 = acc[ai][bj][m][1];
                    u32x4 w; w.x = cvt_pk_bf16(v0[0], v0[1]); w.y = cvt_pk_bf16(v0[2], v0[3]); w.z = cvt_pk_bf16(v1[0], v1[1]); w.w = cvt_pk_bf16(v1[2], v1[3]);
                    *(u32x4*)(rowp + bj * HALF) = w; } }
    }
};
template <class Epi, class Sched, bool ALIGN_EPI = false, bool SP2 = false>
__device__ __forceinline__ void gemm_phase(PG8_LAS unsigned char* lds, const Gemm g, const Sched& S, const Epi& E) {
    const int tid = TIDX(), wid = __builtin_amdgcn_readfirstlane(tid >> 6), lane = tid & 63, wr = wid >> 2, wc = wid & 3, fr = lane & 15, fq = lane >> 4;
    const int K = g.K, nt = K / BK;
    unsigned voffA[2], voffB[2];
#pragma unroll
    for (int i = 0; i < 2; ++i) { int R, C; stage_rc(tid * 16 + i * 8192, R, C); const int Rb = Epi::PERM ? ((R & ~31) + perm32(R & 31)) : R;
        voffA[i] = (unsigned)(R * g.lda + C) * 2u; voffB[i] = (unsigned)(Rb * g.ldb + C) * 2u; }
    const size_t kstep = (size_t)(BK * 2);
    const size_t hstepA = (size_t)HALF * g.lda * 2, hstepB = (size_t)HALF * g.ldb * 2;
    const unsigned ldsw = (unsigned)wid * 1024u;
    const int aoff = lds_byte(wr * 64 + fr, fq * 8), boff = lds_byte(wc * 32 + fr, fq * 8);
#define PG8_SA(b, h) (((b) * 2 + (h)) * HTB)
#define PG8_SB(b, h) ((4 + (b) * 2 + (h)) * HTB)
#define PG8_STAGE(bufoff, gbase, voff) do { _Pragma("unroll") for (int _i = 0; _i < 2; ++_i) \
        __builtin_amdgcn_global_load_lds((const unsigned*)((const char*)(gbase) + (voff)[_i]), (PG8_LAS unsigned*)(lds + (bufoff) + ldsw + _i * 8192), 16, 0, 0); } while (0)
#define PG8_LDA(dst, b, h) do { _Pragma("unroll") for (int m = 0; m < 4; ++m) _Pragma("unroll") for (int k = 0; k < 2; ++k) dst[m][k] = *(const PG8_LAS bf16x8*)(lds + PG8_SA(b, h) + aoff + m * 2048 + k * 1024); } while (0)
#define PG8_LDB(dst, b, h) do { _Pragma("unroll") for (int n = 0; n < 2; ++n) _Pragma("unroll") for (int k = 0; k < 2; ++k) dst[n][k] = *(const PG8_LAS bf16x8*)(lds + PG8_SB(b, h) + boff + n * 2048 + k * 1024); } while (0)
#define PG8_MMA(ai, bj, At, Bt) do { __builtin_amdgcn_s_setprio(1); _Pragma("unroll") for (int m = 0; m < 4; ++m) _Pragma("unroll") for (int n = 0; n < 2; ++n) _Pragma("unroll") for (int k = 0; k < 2; ++k) \
        acc[ai][bj][m][n] = __builtin_amdgcn_mfma_f32_16x16x32_bf16(Bt[n][k], At[m][k], acc[ai][bj][m][n], 0, 0, 0); __builtin_amdgcn_s_setprio(0); } while (0)
#define PG8_WAIT_V(n) asm volatile("s_waitcnt vmcnt(" #n ")" ::: "memory")
#define PG8_WAIT_L(n) asm volatile("s_waitcnt lgkmcnt(" #n ")" ::: "memory")
#define PG8_BAR __builtin_amdgcn_s_barrier()
#define PG8_SCHED __builtin_amdgcn_sched_barrier(0)
    Unit cur, nxt; int ui = 0;
    if (!S.next(0, cur)) return;
    f32x4 acc[2][2][4][2];
#pragma unroll
    for (int a = 0; a < 2; ++a)
#pragma unroll
        for (int b = 0; b < 2; ++b)
#pragma unroll
            for (int m = 0; m < 4; ++m)
#pragma unroll
                for (int n = 0; n < 2; ++n) acc[a][b][m][n] = (f32x4){0.f, 0.f, 0.f, 0.f};
    bf16x8 At[4][2], B0[2][2], B1[2][2];
    const char* cA = cur.pa; const char* cB = cur.pb;
    S.a_ready(cur);
    if constexpr (SP2) {
        PG8_STAGE(PG8_SB(0, 0), cB, voffB); PG8_STAGE(PG8_SB(0, 1), cB + hstepB, voffB); PG8_STAGE(PG8_SA(0, 0), cA, voffA); PG8_STAGE(PG8_SA(0, 1), cA + hstepA, voffA);
        if (wr == 1) PG8_BAR;
        PG8_WAIT_V(2); PG8_BAR;
        PG8_STAGE(PG8_SB(1, 0), cB + kstep, voffB); PG8_STAGE(PG8_SA(1, 0), cA + kstep, voffA); PG8_STAGE(PG8_SB(1, 1), cB + hstepB + kstep, voffB);
        PG8_WAIT_V(6); PG8_BAR;
    } else {
        PG8_STAGE(PG8_SB(0, 0), cB, voffB); PG8_STAGE(PG8_SA(0, 0), cA, voffA); PG8_STAGE(PG8_SB(0, 1), cB + hstepB, voffB); PG8_STAGE(PG8_SA(0, 1), cA + hstepA, voffA);
        if (wr == 1) PG8_BAR;
        PG8_WAIT_V(4); PG8_BAR;
        PG8_STAGE(PG8_SB(1, 0), cB + kstep, voffB); PG8_STAGE(PG8_SA(1, 0), cA + kstep, voffA); PG8_STAGE(PG8_SB(1, 1), cB + hstepB + kstep, voffB);
        PG8_WAIT_V(6); PG8_BAR;
    }
    for (;;) {
        const bool has_next = S.next(ui + 1, nxt);
        const char* nA = has_next ? nxt.pa : cA; const char* nB = has_next ? nxt.pb : cB;
        for (int t = 0; t < nt; t += 2) {
            const bool last = (t == nt - 2);
            const char* a1 = cA + (size_t)(t + 1) * kstep;
            const char* a2 = last ? nA : cA + (size_t)(t + 2) * kstep; const char* b2 = last ? nB : cB + (size_t)(t + 2) * kstep;
            const char* a3 = a2 + kstep; const char* b3 = b2 + kstep;
            if (last && has_next) S.a_ready(nxt);
            if constexpr (SP2) {
            PG8_LDB(B0, 0, 0); PG8_LDB(B1, 0, 1); PG8_SCHED; PG8_LDA(At, 0, 0); PG8_STAGE(PG8_SA(1, 1), a1 + hstepA, voffA);
            PG8_WAIT_V(8); PG8_WAIT_L(0); PG8_BAR; PG8_MMA(0, 0, At, B0); PG8_MMA(0, 1, At, B1); PG8_BAR; PG8_SCHED;
            PG8_LDA(At, 0, 1); PG8_STAGE(PG8_SB(0, 0), b2, voffB); PG8_STAGE(PG8_SB(0, 1), b2 + hstepB, voffB); PG8_STAGE(PG8_SA(0, 0), a2, voffA);
            PG8_WAIT_V(8); PG8_WAIT_L(0); PG8_BAR; PG8_MMA(1, 0, At, B0); PG8_MMA(1, 1, At, B1); PG8_BAR; PG8_SCHED;
            PG8_LDB(B0, 1, 0); PG8_LDB(B1, 1, 1); PG8_SCHED; PG8_LDA(At, 1, 0); PG8_STAGE(PG8_SA(0, 1), a2 + hstepA, voffA);
            PG8_WAIT_V(8); PG8_WAIT_L(0); PG8_BAR; PG8_MMA(0, 0, At, B0); PG8_MMA(0, 1, At, B1); PG8_BAR; PG8_SCHED;
            PG8_LDA(At, 1, 1); PG8_STAGE(PG8_SB(1, 0), b3, voffB); PG8_STAGE(PG8_SB(1, 1), b3 + hstepB, voffB); PG8_STAGE(PG8_SA(1, 0), a3, voffA);
            PG8_WAIT_V(8); PG8_WAIT_L(0); PG8_BAR; PG8_MMA(1, 0, At, B0); PG8_MMA(1, 1, At, B1); PG8_BAR; PG8_SCHED;
            } else {
            PG8_LDB(B0, 0, 0); PG8_SCHED; PG8_LDA(At, 0, 0); PG8_STAGE(PG8_SA(1, 1), a1 + hstepA, voffA);
            PG8_WAIT_L(8); PG8_BAR; PG8_WAIT_L(0); PG8_MMA(0, 0, At, B0); PG8_BAR; PG8_SCHED;
            PG8_LDB(B1, 0, 1); PG8_STAGE(PG8_SB(0, 0), b2, voffB);
            PG8_BAR; PG8_WAIT_L(0); PG8_MMA(0, 1, At, B1); PG8_BAR;
            PG8_LDA(At, 0, 1); PG8_STAGE(PG8_SA(0, 0), a2, voffA);
            PG8_BAR; PG8_WAIT_L(0); PG8_MMA(1, 0, At, B0); PG8_BAR; PG8_SCHED;
            PG8_STAGE(PG8_SB(0, 1), b2 + hstepB, voffB);
            PG8_WAIT_V(6); PG8_BAR; PG8_MMA(1, 1, At, B1); PG8_BAR;
            PG8_LDB(B0, 1, 0); PG8_SCHED; PG8_LDA(At, 1, 0); PG8_STAGE(PG8_SA(0, 1), a2 + hstepA, voffA);
            PG8_WAIT_L(8); PG8_BAR; PG8_WAIT_L(0); PG8_MMA(0, 0, At, B0); PG8_BAR; PG8_SCHED;
            PG8_LDB(B1, 1, 1); PG8_STAGE(PG8_SB(1, 0), b3, voffB);
            PG8_BAR; PG8_WAIT_L(0); PG8_MMA(0, 1, At, B1); PG8_BAR;
            PG8_LDA(At, 1, 1); PG8_STAGE(PG8_SA(1, 0), a3, voffA);
            PG8_BAR; PG8_WAIT_L(0); PG8_MMA(1, 0, At, B0); PG8_BAR; PG8_SCHED;
            PG8_STAGE(PG8_SB(1, 1), b3 + hstepB, voffB);
            PG8_WAIT_V(6); PG8_BAR; PG8_MMA(1, 1, At, B1); PG8_BAR;
            }
        }
        if constexpr (ALIGN_EPI) { if (wr == 0) PG8_BAR; }
        if constexpr (!Epi::AFTER_DRAIN) { E(acc, cur, wr, wc, fr, fq); S.done(cur); }
        if (!has_next) break;
#pragma unroll
        for (int a = 0; a < 2; ++a)
#pragma unroll
            for (int b = 0; b < 2; ++b)
#pragma unroll
                for (int m = 0; m < 4; ++m)
#pragma unroll
                    for (int n = 0; n < 2; ++n) acc[a][b][m][n] = (f32x4){0.f, 0.f, 0.f, 0.f};
        cur = nxt; cA = nA; cB = nB; ++ui;
        if constexpr (ALIGN_EPI) { if (wr == 1) PG8_BAR; }
    }
    PG8_WAIT_V(0);
    if constexpr (!ALIGN_EPI) { if (wr == 0) PG8_BAR; }
    PG8_BAR;
    if constexpr (Epi::AFTER_DRAIN) { E.fused(acc, cur, wr, wc, fr, fq, lds, wid, lane); S.done(cur); }
#undef PG8_SA
#undef PG8_SB
#undef PG8_STAGE
#undef PG8_LDA
#undef PG8_LDB
#undef PG8_MMA
#undef PG8_WAIT_V
#undef PG8_WAIT_L
#undef PG8_BAR
#undef PG8_SCHED
}

}
#define WSYNC2() asm volatile("s_waitcnt lgkmcnt(0)" ::: "memory")
struct MoeBufs { int* tok_e; float* tok_g; int* slot_of; float* slot_gate; int* blk_e; int* blkcnt; int* nblk; };
constexpr int WRT_LD = 1028;

__device__ __forceinline__ void ph_ln_router(const float* xin, const bf16_t* hb, const float* g, const float* bb, const float* wr, const float* br, float* x1, const MoeBufs m, float* lds) {
  const int tid = TIDX(), lane = tid & 63, wave = tid >> 6, blk = BIDX();
  float* wT = lds;
  float* lg = lds + 32 * WRT_LD + wave * 64;
  int* cnt = (int*)(lds + 32 * WRT_LD + 8 * 64);
  { f32x4 wv[16];
#pragma unroll
    for (int k = 0; k < 16; ++k) wv[k] = *(const f32x4*)(wr + (size_t)(tid + NTHR * k) * 4);
#pragma unroll
    for (int k = 0; k < 16; ++k) { const int i = (tid + NTHR * k) * 4, d = i >> 5, e = i & 31;
#pragma unroll
      for (int z = 0; z < 4; ++z) wT[(e + z) * WRT_LD + d] = wv[k][z]; } }
  if (tid < 32) cnt[tid] = 0;
  __syncthreads();
#pragma unroll 1
  for (int it = 0; it < 8; it += 2) {
    const int tok0 = blk * 64 + wave * 8 + it;
    f32x4 v[2][4]; float s[2] = {0.f, 0.f};
#pragma unroll
    for (int q = 0; q < 2; ++q)
#pragma unroll
      for (int j = 0; j < 4; ++j) { const int c = lane * 4 + 256 * j; const f32x4 a = *(const f32x4*)(xin + (size_t)(tok0 + q) * D + c); const v2u hh = *(const v2u*)(hb + (size_t)(tok0 + q) * D + c);
        v[q][j] = (f32x4){ALPHA * a[0] + bf_lo(hh[0]), ALPHA * a[1] + bf_hi(hh[0]), ALPHA * a[2] + bf_lo(hh[1]), ALPHA * a[3] + bf_hi(hh[1])}; s[q] += (v[q][j][0] + v[q][j][1]) + (v[q][j][2] + v[q][j][3]); }
#pragma unroll
    for (int o = 1; o < 64; o <<= 1) { s[0] += __shfl_xor(s[0], o); s[1] += __shfl_xor(s[1], o); }
    float qq[2] = {0.f, 0.f};
#pragma unroll
    for (int q = 0; q < 2; ++q) { const float mu = s[q] * (1.f / D);
#pragma unroll
      for (int j = 0; j < 4; ++j) { v[q][j] = v[q][j] - mu; qq[q] += (v[q][j][0] * v[q][j][0] + v[q][j][1] * v[q][j][1]) + (v[q][j][2] * v[q][j][2] + v[q][j][3] * v[q][j][3]); } }
#pragma unroll
    for (int o = 1; o < 64; o <<= 1) { qq[0] += __shfl_xor(qq[0], o); qq[1] += __shfl_xor(qq[1], o); }
#pragma unroll
    for (int q = 0; q < 2; ++q) { const float r = rsqrtf(qq[q] * (1.f / D) + 1e-5f);
#pragma unroll
      for (int j = 0; j < 4; ++j) { const int c = lane * 4 + 256 * j; const f32x4 g4 = *(const f32x4*)(g + c), b4 = *(const f32x4*)(bb + c); v[q][j] = v[q][j] * r * g4 + b4; *(f32x4*)(x1 + (size_t)(tok0 + q) * D + c) = v[q][j]; } }
    float p[2][32];
#pragma unroll
    for (int e = 0; e < 32; ++e) { float a0 = 0.f, a1 = 0.f;
#pragma unroll
      for (int j = 0; j < 4; ++j) { const f32x4 w4 = *(const f32x4*)(wT + e * WRT_LD + lane * 4 + 256 * j);
        a0 = fmaf(v[0][j][0], w4[0], a0); a0 = fmaf(v[0][j][1], w4[1], a0); a0 = fmaf(v[0][j][2], w4[2], a0); a0 = fmaf(v[0][j][3], w4[3], a0);
        a1 = fmaf(v[1][j][0], w4[0], a1); a1 = fmaf(v[1][j][1], w4[1], a1); a1 = fmaf(v[1][j][2], w4[2], a1); a1 = fmaf(v[1][j][3], w4[3], a1); }
      p[0][e] = a0; p[1][e] = a1; }
#pragma unroll
    for (int i = 0; i < 16; ++i) { const bool hi = (lane & 32) != 0;
#pragma unroll
      for (int q = 0; q < 2; ++q) { const float send = hi ? p[q][i] : p[q][i + 16]; const float keep = hi ? p[q][i + 16] : p[q][i]; p[q][i] = keep + __shfl_xor(send, 32); } }
#pragma unroll
    for (int i = 0; i < 8; ++i) { const bool hi = (lane & 16) != 0;
#pragma unroll
      for (int q = 0; q < 2; ++q) { const float send = hi ? p[q][i] : p[q][i + 8]; const float keep = hi ? p[q][i + 8] : p[q][i]; p[q][i] = keep + __shfl_xor(send, 16); } }
#pragma unroll
    for (int i = 0; i < 4; ++i) { const bool hi = (lane & 8) != 0;
#pragma unroll
      for (int q = 0; q < 2; ++q) { const float send = hi ? p[q][i] : p[q][i + 4]; const float keep = hi ? p[q][i + 4] : p[q][i]; p[q][i] = keep + __shfl_xor(send, 8); } }
#pragma unroll
    for (int i = 0; i < 2; ++i) { const bool hi = (lane & 4) != 0;
#pragma unroll
      for (int q = 0; q < 2; ++q) { const float send = hi ? p[q][i] : p[q][i + 2]; const float keep = hi ? p[q][i + 2] : p[q][i]; p[q][i] = keep + __shfl_xor(send, 4); } }
#pragma unroll
    for (int q = 0; q < 2; ++q) { const bool hi = (lane & 2) != 0; const float send = hi ? p[q][0] : p[q][1]; const float keep = hi ? p[q][1] : p[q][0]; p[q][0] = keep + __shfl_xor(send, 2); }
    p[0][0] += __shfl_xor(p[0][0], 1); p[1][0] += __shfl_xor(p[1][0], 1);
    const int e_l = ((lane >> 5) & 1) * 16 + ((lane >> 4) & 1) * 8 + ((lane >> 3) & 1) * 4 + ((lane >> 2) & 1) * 2 + ((lane >> 1) & 1);
    const float brl = br[e_l];
    float lv[2] = {p[0][0] + brl, p[1][0] + brl}; int ei[2][4]; float ev[2][4];
#pragma unroll
    for (int k = 0; k < 4; ++k) { float bv[2] = {lv[0], lv[1]}; int bi[2] = {e_l, e_l};
#pragma unroll
      for (int o = 2; o < 64; o <<= 1)
#pragma unroll
        for (int q = 0; q < 2; ++q) { const float ov = __shfl_xor(bv[q], o); const int oi = __shfl_xor(bi[q], o); const bool take = (ov > bv[q]) || (ov == bv[q] && oi < bi[q]); bv[q] = take ? ov : bv[q]; bi[q] = take ? oi : bi[q]; }
#pragma unroll
      for (int q = 0; q < 2; ++q) { ei[q][k] = bi[q]; ev[q][k] = bv[q]; if (e_l == bi[q]) lv[q] = -INFINITY; } }
    if (lane < 2) { const int q = lane;
      float ex[4], su = 0.f;
#pragma unroll
      for (int k = 0; k < 4; ++k) { ex[k] = __expf((q ? ev[1][k] : ev[0][k]) - (q ? ev[1][0] : ev[0][0])); su += ex[k]; }
      const float inv = 1.f / su; const int tok = tok0 + q;
      const int e0 = q ? ei[1][0] : ei[0][0], e1 = q ? ei[1][1] : ei[0][1], e2 = q ? ei[1][2] : ei[0][2], e3 = q ? ei[1][3] : ei[0][3];
      *(int4*)(m.tok_e + tok * 4) = make_int4(e0, e1, e2, e3);
      *(float4*)(m.tok_g + tok * 4) = make_float4(ex[0] * inv, ex[1] * inv, ex[2] * inv, ex[3] * inv);
      atomicAdd(&cnt[e0], 1); atomicAdd(&cnt[e1], 1); atomicAdd(&cnt[e2], 1); atomicAdd(&cnt[e3], 1); }
  }
  __syncthreads();
  if (tid < 32) m.blkcnt[blk * 32 + tid] = cnt[tid];
  __syncthreads();
}

__device__ __forceinline__ void ph_moe_scatter(const float* x1, bf16_t* xs, const MoeBufs m, int* ilds) {
  const int tid = TIDX(), lane = tid & 63, wave = tid >> 6, blk = BIDX();
  int* tot = ilds; int* bef = ilds + 32; int* pst = ilds + 64; int* es = ilds + 128; int* rk = ilds + 384; int* sl = ilds + 640; int* part = ilds + 896; int* wcnt = ilds + 1408;
  f32x4 rw[8][4];
#pragma unroll
  for (int it = 0; it < 8; ++it)
#pragma unroll
    for (int j = 0; j < 4; ++j) rw[it][j] = *(const f32x4*)(x1 + (size_t)(blk * 64 + wave * 8 + it) * D + lane * 4 + 256 * j);
  { const int e = tid & 31, pa = tid >> 5; int sum = 0;
#pragma unroll
    for (int q = 0; q < 16; ++q) sum += m.blkcnt[(pa * 16 + q) * 32 + e];
    part[pa * 32 + e] = sum; }
  if (tid < 256) es[tid] = m.tok_e[blk * 256 + tid];
  __syncthreads();
  if (tid < 32) { const int e = tid; int t_ = 0, b_ = 0; const int pb_ = blk >> 4;
    for (int q = 0; q < 16; ++q) { const int v = part[q * 32 + e]; t_ += v; if (q < pb_) b_ += v; }
    for (int q = pb_ * 16; q < blk; ++q) b_ += m.blkcnt[q * 32 + e];
    tot[e] = t_; bef[e] = b_; }
  if (tid < 256) { const int e = es[tid]; const unsigned long long lt = (1ull << lane) - 1ull; int r = 0;
    for (int ee = 0; ee < 32; ++ee) { const unsigned long long mk = __ballot(e == ee); if (e == ee) r = __builtin_popcountll(mk & lt); if (lane == ee) wcnt[wave * 32 + ee] = __builtin_popcountll(mk); }
    rk[tid] = r; }
  __syncthreads();
  if (tid == 0) { int acc = 0; for (int e = 0; e < 32; ++e) { pst[e] = acc; acc += ((tot[e] + 255) >> 8) << 8; } pst[32] = acc;
    if (blk == 0) { *m.nblk = acc >> 8; for (int e = 0; e < 32; ++e) for (int q = pst[e] >> 8; q < (pst[e + 1] >> 8); ++q) m.blk_e[q] = e; } }
  __syncthreads();
  if (tid < 256) { const int e = es[tid]; int rank = rk[tid]; for (int w2 = 0; w2 < wave; ++w2) rank += wcnt[w2 * 32 + e];
    const int slot = pst[e] + bef[e] + rank; sl[tid] = slot; m.slot_of[blk * 256 + tid] = slot; m.slot_gate[slot] = m.tok_g[blk * 256 + tid]; }
  __syncthreads();
#pragma unroll
  for (int it = 0; it < 8; ++it) {
    const int tl = wave * 8 + it;
    v2u pk[4];
#pragma unroll
    for (int j = 0; j < 4; ++j) pk[j] = (v2u){cvt_pk_bf16(rw[it][j][0], rw[it][j][1]), cvt_pk_bf16(rw[it][j][2], rw[it][j][3])};
#pragma unroll
    for (int k = 0; k < 4; ++k) { bf16_t* dst = xs + (size_t)sl[tl * 4 + k] * D + lane * 4;
#pragma unroll
      for (int j = 0; j < 4; ++j) *(v2u*)(dst + 256 * j) = pk[j]; }
  }
  __syncthreads();
}

__device__ __forceinline__ void ph_combine_ln(const float* x1, const bf16_t* Ys, const int* slot_of, const float* g, const float* bb, float* out, bf16_t* outb) {
  const int tid = TIDX(), lane = tid & 63, gw = BIDX() * 8 + (tid >> 6), NGW = (int)gridDim.x * 8;
  for (int row = gw; row < NT; row += NGW) {
    const int4 s4 = *(const int4*)(slot_of + row * 4); const int sl[4] = {s4.x, s4.y, s4.z, s4.w};
    f32x4 v[4]; float s = 0.f;
#pragma unroll
    for (int j = 0; j < 4; ++j) { const int c = lane * 4 + 256 * j; f32x4 f = (f32x4){0.f, 0.f, 0.f, 0.f};
#pragma unroll
      for (int k = 0; k < 4; ++k) { const v2u y = *(const v2u*)(Ys + (size_t)sl[k] * D + c); f += (f32x4){bf_lo(y[0]), bf_hi(y[0]), bf_lo(y[1]), bf_hi(y[1])}; }
      const f32x4 a = *(const f32x4*)(x1 + (size_t)row * D + c); v[j] = a * ALPHA + f; s += (v[j][0] + v[j][1]) + (v[j][2] + v[j][3]); }
    const float mu = wave_sum(s) * (1.f / D); float q = 0.f;
#pragma unroll
    for (int j = 0; j < 4; ++j) { v[j] = v[j] - mu; q += (v[j][0] * v[j][0] + v[j][1] * v[j][1]) + (v[j][2] * v[j][2] + v[j][3] * v[j][3]); }
    const float r = rsqrtf(wave_sum(q) * (1.f / D) + 1e-5f);
#pragma unroll
    for (int j = 0; j < 4; ++j) { const int c = lane * 4 + 256 * j; const f32x4 g4 = *(const f32x4*)(g + c), b4 = *(const f32x4*)(bb + c); const f32x4 o = v[j] * r * g4 + b4;
      *(f32x4*)(out + (size_t)row * D + c) = o; if (outb) *(v2u*)(outb + (size_t)row * D + c) = (v2u){cvt_pk_bf16(o[0], o[1]), cvt_pk_bf16(o[2], o[3])}; }
  }
}

namespace pg8 {
struct MoeOrder {
    StaticOrder so; const int* blk_e; const char* W; size_t wexp; int obn;
    __device__ void init(const void* A, int lda, const void* W_, int ldb, size_t wexp_, int nM, int nN, int obn_, const int* blk_e_, int G, int c) { so.init(A, lda, W_, ldb, nM * BM, nN * BM, G, c); blk_e = blk_e_; W = (const char*)W_; wexp = wexp_; obn = obn_; }
    __device__ bool next(int i, Unit& u) const { int pm, pn; if (!so.tile(i, pm, pn)) return false; const int e = __builtin_amdgcn_readfirstlane(blk_e[pm]); u.pa = so.A + (size_t)pm * so.ta; u.pb = W + (size_t)e * wexp + (size_t)pn * so.tb; u.orow = pm * BM; u.ocol = pn * obn; u.e = e; return true; }
    __device__ __forceinline__ void a_ready(const Unit&) const {}
    __device__ __forceinline__ void done(const Unit&) const {}
};
struct EpiSwiglu {
    static constexpr bool PERM = true, AFTER_DRAIN = false;
    bf16_t* O; int ldc; const float* b1;
    __device__ __forceinline__ void operator()(const f32x4 (&acc)[2][2][4][2], const Unit& u, int wr, int wc, int fr, int fq) const {
        const int row0 = u.orow + wr * 64 + fr, cl = wc * 32 + 8 * fq, col0 = u.ocol + cl;
        const float* bg = b1 + (size_t)u.e * 2048 + col0; const float* bu = bg + 1024;
        const f32x4 bg0 = *(const f32x4*)bg, bg1 = *(const f32x4*)(bg + 4), bu0 = *(const f32x4*)bu, bu1 = *(const f32x4*)(bu + 4);
#pragma unroll
        for (int ai = 0; ai < 2; ++ai)
#pragma unroll
            for (int m = 0; m < 4; ++m) {
                f32x4 gv[2] = {acc[ai][0][m][0] + bg0, acc[ai][0][m][1] + bg1}, uv[2] = {acc[ai][1][m][0] + bu0, acc[ai][1][m][1] + bu1}; float o[8];
#pragma unroll
                for (int n = 0; n < 2; ++n)
#pragma unroll
                    for (int i = 0; i < 4; ++i) { const float gg = fminf(gv[n][i], 7.f), uu = fminf(fmaxf(uv[n][i], -7.f), 7.f);
                        const float sg = __builtin_amdgcn_rcpf(1.f + __builtin_amdgcn_exp2f(-1.702f * 1.4426950408889634f * gg)); o[4 * n + i] = (uu + 1.f) * gg * sg; }
                u32x4 w; w.x = cvt_pk_bf16(o[0], o[1]); w.y = cvt_pk_bf16(o[2], o[3]); w.z = cvt_pk_bf16(o[4], o[5]); w.w = cvt_pk_bf16(o[6], o[7]);
                *(u32x4*)(O + (size_t)(row0 + ai * HALF + m * 16) * ldc + col0) = w; asm volatile("" ::: "memory"); }
    }
};
struct EpiMoe2 {
    static constexpr bool PERM = true, AFTER_DRAIN = false;
    bf16_t* O; int ldc; const float* b2; const float* gate;
    __device__ __forceinline__ void operator()(const f32x4 (&acc)[2][2][4][2], const Unit& u, int wr, int wc, int fr, int fq) const {
        const int row0 = u.orow + wr * 64 + fr, col0 = u.ocol + wc * 32 + 8 * fq;
        const float* bp = b2 + (size_t)u.e * 1024 + col0;
#pragma unroll
        for (int bj = 0; bj < 2; ++bj) {
            const f32x4 bv0 = *(const f32x4*)(bp + bj * HALF), bv1 = *(const f32x4*)(bp + bj * HALF + 4);
#pragma unroll
            for (int ai = 0; ai < 2; ++ai)
#pragma unroll
                for (int m = 0; m < 4; ++m) { const int row = row0 + ai * HALF + m * 16; const float gt = gate[row];
                    const f32x4 v0 = (acc[ai][bj][m][0] + bv0) * gt, v1 = (acc[ai][bj][m][1] + bv1) * gt;
                    u32x4 w; w.x = cvt_pk_bf16(v0[0], v0[1]); w.y = cvt_pk_bf16(v0[2], v0[3]); w.z = cvt_pk_bf16(v1[0], v1[1]); w.w = cvt_pk_bf16(v1[2], v1[3]);
                    *(u32x4*)(O + (size_t)row * ldc + col0 + bj * HALF) = w; asm volatile("" ::: "memory"); }
        }
    }
};
}
typedef short v4i16_t __attribute__((ext_vector_type(4)));
__device__ __forceinline__ unsigned f2key_u(float f) { f = f + 0.0f; const unsigned u = __float_as_uint(f); return (u & 0x80000000u) ? ~u : (u | 0x80000000u); }

__device__ __forceinline__ void ph_cnorm_b(const bf16_t* pa, const float* g, bf16_t* cnb) {
  const int tid = TIDX(), lane = tid & 63, gw = BIDX() * 8 + (tid >> 6), NGW = (int)gridDim.x * 8;
  const f32x4 g4 = *(const f32x4*)(g + lane * 4);
  for (int row = gw; row < NT; row += NGW) {
    const v2u v = *(const v2u*)(pa + (size_t)row * 2048 + 1024 + lane * 4);
    const f32x4 f = (f32x4){bf_lo(v[0]), bf_hi(v[0]), bf_lo(v[1]), bf_hi(v[1])};
    const float r = rsqrtf(wave_sum((f[0] * f[0] + f[1] * f[1]) + (f[2] * f[2] + f[3] * f[3])) * (1.f / 256.f) + 1e-6f);
    const f32x4 o = f * r * g4;
    *(v2u*)(cnb + (size_t)row * 256 + lane * 4) = (v2u){cvt_pk_bf16(o[0], o[1]), cvt_pk_bf16(o[2], o[3])};
  }
}

typedef _Float16 h16x2_t __attribute__((ext_vector_type(2)));
__device__ __forceinline__ unsigned cvt_pk_f16(float lo, float hi) { const f32x2_t v = {lo, hi}; const h16x2_t h = __builtin_convertvector(v, h16x2_t); return __builtin_bit_cast(unsigned, h); }
__device__ __forceinline__ void ph_iscore(const bf16_t* pa, unsigned short* sc) {
  const int tid = TIDX(), lane = tid & 63, gw = BIDX() * 8 + (tid >> 6), NGW = (int)gridDim.x * 8;
  const int n16 = lane & 15, g = lane >> 4;
#pragma unroll 1
  for (int u = gw; u < 2 * 4352; u += NGW) {
    const int b = u / 4352, v = u % 4352;
    int a = 0; while (a < 15 && 16 * (a + 1) * (a + 2) <= v) ++a;
    const int rem = v - 16 * a * (a + 1), r = rem / (a + 1), ch = rem % (a + 1);
    const int qg = 32 * a + r, ntile = (ch < a) ? 32 : (r + 1), t0 = qg * 16, kt0 = ch * 32;
    const bf16_t* qrow = pa + (size_t)(b * L + t0 + n16) * 2048;
    bf16x8 qf[8][2]; float w[8];
#pragma unroll
    for (int h = 0; h < 8; ++h) { qf[h][0] = *(const bf16x8*)(qrow + 1280 + h * 64 + 8 * g); qf[h][1] = *(const bf16x8*)(qrow + 1280 + h * 64 + 32 + 8 * g); w[h] = bf2f(qrow[1856 + h]) * (0.35355339059327373f * 0.125f); }
    const bf16_t* kbase = pa + (size_t)(b * L + n16) * 2048 + 1792 + 8 * g;
    unsigned short* srow = sc + (size_t)(b * L + t0 + n16) * L + 4 * g;
    bf16x8 kr[8][2];
    const int ktl = kt0 + ntile - 1;
#pragma unroll
    for (int p = 0; p < 8; ++p) { const int kk = min(kt0 + p, ktl); kr[p][0] = *(const bf16x8*)(kbase + (size_t)kk * 16 * 2048); kr[p][1] = *(const bf16x8*)(kbase + (size_t)kk * 16 * 2048 + 32); }
#pragma unroll 1
    for (int kt8 = kt0; kt8 < kt0 + ntile; kt8 += 8) {
#pragma unroll
      for (int p = 0; p < 8; ++p) {
        const int kt = kt8 + p;
        const bf16x8 k0 = kr[p][0], k1 = kr[p][1];
        { const int kk = min(kt + 8, ktl); kr[p][0] = *(const bf16x8*)(kbase + (size_t)kk * 16 * 2048); kr[p][1] = *(const bf16x8*)(kbase + (size_t)kk * 16 * 2048 + 32); }
        f32x4 score = (f32x4){0.f, 0.f, 0.f, 0.f};
#pragma unroll
        for (int h = 0; h < 8; ++h) {
          f32x4 acc = __builtin_amdgcn_mfma_f32_16x16x32_bf16(k0, qf[h][0], (f32x4){0.f, 0.f, 0.f, 0.f}, 0, 0, 0);
          acc = __builtin_amdgcn_mfma_f32_16x16x32_bf16(k1, qf[h][1], acc, 0, 0, 0);
#pragma unroll
          for (int i = 0; i < 4; ++i) score[i] = fmaf(fmaxf(acc[i], 0.f), w[h], score[i]);
        }
        if (kt <= ktl) *(v2u*)(srow + kt * 16) = (v2u){cvt_pk_f16(score[0], score[1]), cvt_pk_f16(score[2], score[3])};
      }
    }
  }
}

constexpr int DW_STRIDE = 17152;
__device__ __forceinline__ unsigned offb(unsigned row, unsigned ch) { return 256u * row + 16u * (ch ^ (((row & 3u) << 2) | ((row >> 2) & 3u))); }
__device__ __forceinline__ void glds16(const void* gsrc, unsigned lds_dst) { unsigned keep;
  asm volatile("s_mov_b32 %0, m0\n\ts_mov_b32 m0, %2\n\ts_nop 0\n\tglobal_load_lds_dwordx4 %1, off\n\ts_mov_b32 m0, %0" : "=&s"(keep) : "v"(gsrc), "s"(lds_dst) : "memory"); }
__device__ __forceinline__ int wave_excl_scan(int v, int lane, int& total) {
  int x = v;
#pragma unroll
  for (int o = 1; o < 64; o <<= 1) { const int y = __shfl_up(x, o); if (lane >= o) x += y; }
  total = __shfl(x, 63); return x - v;
}
#define LDSW() asm volatile("s_waitcnt lgkmcnt(0)" ::: "memory")
__device__ __forceinline__ int wave_incl_scan_dpp(int v, int lane, int& total) {
  int x = v;
  x += __builtin_amdgcn_update_dpp(0, x, 0x111, 0xf, 0xf, true);
  x += __builtin_amdgcn_update_dpp(0, x, 0x112, 0xf, 0xf, true);
  x += __builtin_amdgcn_update_dpp(0, x, 0x114, 0xf, 0xf, true);
  x += __builtin_amdgcn_update_dpp(0, x, 0x118, 0xf, 0xf, true);
  const int t0 = __builtin_amdgcn_readlane(x, 15), t1 = __builtin_amdgcn_readlane(x, 31), t2 = __builtin_amdgcn_readlane(x, 47), t3 = __builtin_amdgcn_readlane(x, 63);
  const int row = lane >> 4;
  x += (row >= 1 ? t0 : 0) + (row >= 2 ? t1 : 0) + (row >= 3 ? t2 : 0);
  total = t0 + t1 + t2 + t3; return x;
}

__device__ __forceinline__ unsigned h2key(unsigned h) { return (h & 0x8000u) ? (~h & 0xFFFFu) : (h | 0x8000u); }
__device__ __forceinline__ int wave_select(const unsigned short* srow, int t, LAS unsigned char* wl, LAS unsigned short* idx16, int lane) {
  const int n = t + 1;
  if (n <= 256) { for (int i = lane; i < 256; i += 64) idx16[i] = (unsigned short)(i < n ? i : 0); LDSW(); return n; }
  LAS unsigned* hist = (LAS unsigned*)wl;
  for (int i = lane; i < 1024; i += 64) ((LAS v4u*)hist)[i] = (v4u){0u, 0u, 0u, 0u};
  unsigned bk[16][4];
#pragma unroll
  for (int i = 0; i < 16; ++i) {
    bk[i][0] = 0u; bk[i][1] = 0u; bk[i][2] = 0u; bk[i][3] = 0u;
    if (i * 512 < n) { const int e0 = (i * 64 + lane) * 8;
      if (e0 < n) { const v4u f = *(const v4u*)(srow + e0);
#pragma unroll
        for (int c = 0; c < 4; ++c) { unsigned lo = f[c] & 0xFFFFu, hi = f[c] >> 16; lo = lo + 0u;
          const unsigned b0 = (e0 + 2 * c <= t) ? (h2key(lo == 0x8000u ? 0u : lo) >> 4) : 0u, b1 = (e0 + 2 * c + 1 <= t) ? (h2key(hi == 0x8000u ? 0u : hi) >> 4) : 0u;
          bk[i][c] = b0 | (b1 << 16); } } }
    if ((i & 7) == 7) asm volatile("" ::: "memory");
  }
#define BIN_OF(i, c) ((bk[i][(c) >> 1] >> (((c) & 1) * 16)) & 0xFFFFu)
  LDSW();
#pragma unroll
  for (int i = 0; i < 16; ++i) if (i * 512 < n) {
#pragma unroll
    for (int c = 0; c < 8; ++c) { const unsigned bin = BIN_OF(i, c); __hip_atomic_fetch_add(hist + bin, 1u, __ATOMIC_RELAXED, __HIP_MEMORY_SCOPE_WORKGROUP); }
    asm volatile("" ::: "memory"); }
  LDSW();
  const int bbase = 4096 - 64 * (lane + 1); int ssum = 0;
#pragma unroll 16
  for (int k = 0; k < 64; ++k) ssum += (int)hist[bbase + ((k + lane) & 63)];
  int tot; const int pre = wave_incl_scan_dpp(ssum, lane, tot) - ssum;
  const unsigned long long bal = __ballot(pre < 256 && pre + ssum >= 256);
  const int Ls = (int)__builtin_ctzll(bal);
  const int cum0 = __builtin_amdgcn_readlane(pre, Ls), sb = 4096 - 64 * (Ls + 1);
  const int ck = (int)hist[sb + 63 - lane]; int t2_; const int inc = wave_incl_scan_dpp(ck, lane, t2_);
  const unsigned long long bal2 = __ballot(cum0 + inc >= 256);
  const int kk = (int)__builtin_ctzll(bal2);
  const int B1 = sb + 63 - kk, cnt_gt = cum0 + __builtin_amdgcn_readlane(inc, kk) - __builtin_amdgcn_readlane(ck, kk), need1 = 256 - cnt_gt;
  LDSW();
  int ngt = 0, neq = 0;
#pragma unroll
  for (int i = 0; i < 16; ++i) if (i * 512 < n) {
#pragma unroll
    for (int c = 0; c < 8; ++c) { const int bin = (int)BIN_OF(i, c); ngt += (bin > B1) ? 1 : 0; neq += (bin == B1) ? 1 : 0; } }
  int tg, te; int pg = wave_incl_scan_dpp(ngt, lane, tg) - ngt; int pe = wave_incl_scan_dpp(neq, lane, te) - neq;
  LAS unsigned short* cand = (LAS unsigned short*)wl;
#pragma unroll
  for (int i = 0; i < 16; ++i) if (i * 512 < n) {
#pragma unroll
    for (int c = 0; c < 8; ++c) { const int bin = (int)BIN_OF(i, c); const int e = (i * 64 + lane) * 8 + c;
      if (bin > B1) { idx16[pg] = (unsigned short)e; ++pg; }
      if (bin == B1) { cand[pe] = (unsigned short)e; ++pe; } }
    asm volatile("" ::: "memory"); }
#undef BIN_OF
  LDSW();
  const int m = te;
  unsigned lo = 0u;
  if (m <= 64) {
    unsigned cpv = 0u; if (lane < m) { const unsigned ci = cand[lane]; unsigned hv = srow[ci]; hv = (hv == 0x8000u) ? 0u : hv; cpv = ((h2key(hv) & 15u) << 13) | (8191u - ci) | (1u << 20); }
    int rank = 0;
    for (int k = 0; k < m; ++k) { const unsigned ok = (unsigned)__builtin_amdgcn_readlane((int)cpv, k); rank += (ok > cpv) ? 1 : 0; }
    const bool sel = (lane < m) && (rank < need1);
    const unsigned long long bs = __ballot(sel);
    if (sel) idx16[cnt_gt + __builtin_popcountll(bs & ((1ull << lane) - 1ull))] = (unsigned short)(8191u - (cpv & 0x1FFFu));
  } else if (m <= 256) {
    unsigned cp[4];
#pragma unroll
    for (int j = 0; j < 4; ++j) { const int q = lane + 64 * j; cp[j] = 0u; if (q < m) { const unsigned ci = cand[q]; unsigned hv = srow[ci]; hv = (hv == 0x8000u) ? 0u : hv; cp[j] = ((h2key(hv) & 15u) << 13) | (8191u - ci) | (1u << 20); } }
    for (int bit = 16; bit >= 0; --bit) { const unsigned trial = lo | (1u << bit); int tc = 0;
#pragma unroll
      for (int j = 0; j < 4; ++j) tc += __builtin_popcountll(__ballot((cp[j] >> 20) && ((cp[j] & 0x1FFFFu) >= trial)));
      if (tc >= need1) lo = trial; }
    int pos = cnt_gt;
#pragma unroll
    for (int j = 0; j < 4; ++j) { const bool sel = (cp[j] >> 20) && ((cp[j] & 0x1FFFFu) >= lo); const unsigned long long bs = __ballot(sel);
      if (sel) idx16[pos + __builtin_popcountll(bs & ((1ull << lane) - 1ull))] = (unsigned short)(8191u - (cp[j] & 0x1FFFu)); pos += __builtin_popcountll(bs); }
  } else {
    for (int bit = 16; bit >= 0; --bit) { const unsigned trial = lo | (1u << bit); int c = 0;
      for (int q = lane; q < m; q += 64) { const unsigned ci = cand[q]; unsigned hv = srow[ci]; hv = (hv == 0x8000u) ? 0u : hv; const unsigned cpq = ((h2key(hv) & 15u) << 13) | (8191u - ci); c += (cpq >= trial) ? 1 : 0; }
      int tc; (void)wave_excl_scan(c, lane, tc); if (tc >= need1) lo = trial; }
    int base = cnt_gt;
    for (int q0 = 0; q0 < m; q0 += 64) { const int q = q0 + lane; bool sel = false; unsigned ci = 0;
      if (q < m) { ci = cand[q]; unsigned hv = srow[ci]; hv = (hv == 0x8000u) ? 0u : hv; const unsigned cpq = ((h2key(hv) & 15u) << 13) | (8191u - ci); sel = cpq >= lo; }
      int tc; const int pos = base + wave_excl_scan(sel ? 1 : 0, lane, tc); if (sel) idx16[pos] = (unsigned short)ci; base += tc; }
  }
  LDSW();
  return 256;
}

__device__ __forceinline__ void wave_attend(int b, int t, int cnt, const bf16_t* qlat, const bf16_t* cnb, LAS unsigned char* wl, LAS unsigned short* idx16, bf16_t* olat, int lane) {
  const int n16 = lane & 15, g = lane >> 4, q4 = (lane & 15) >> 2, p4 = lane & 3;
  const bf16_t* qrow = qlat + (size_t)(b * L + t) * 4096 + n16 * 256 + 8 * g;
  bf16x8 qf[8];
#pragma unroll
  for (int s = 0; s < 8; ++s) qf[s] = *(const bf16x8*)(qrow + 32 * s);
  f32x4 o[16];
#pragma unroll
  for (int c = 0; c < 16; ++c) o[c] = (f32x4){0.f, 0.f, 0.f, 0.f};
  float mrun = -INFINITY, lrun = 0.f;
  const int ntile = (cnt + 31) >> 5;
  const char* cb = (const char*)(cnb + (size_t)b * L * 256);
  const unsigned slot = lane & 15, rsub = lane >> 4;
  constexpr float SC = 0.125f * 1.4426950408889634f;
  v4u stg[16];
#define GATHER_TILE(itn) do { _Pragma("unroll") for (int rg = 0; rg < 8; ++rg) { const unsigned row = 4 * rg + rsub; const unsigned key = idx16[32 * (itn) + row]; \
      const unsigned ch = slot ^ (((row & 3u) << 2) | ((row >> 2) & 3u)); const char* src = cb + (size_t)key * 512 + ch * 16; \
      stg[rg] = *(const v4u*)src; stg[8 + rg] = *(const v4u*)(src + 256); } } while (0)
  GATHER_TILE(0);
#pragma unroll 1
  for (int it = 0; it < ntile; ++it) {
#pragma unroll
    for (int rg = 0; rg < 8; ++rg) { *(LAS v4u*)(wl + rg * 1024 + lane * 16) = stg[rg]; *(LAS v4u*)(wl + 8192 + rg * 1024 + lane * 16) = stg[8 + rg]; }
    LDSW();
    if (it + 1 < ntile) GATHER_TILE(it + 1);
    f32x4 s0 = (f32x4){0.f, 0.f, 0.f, 0.f}, s1 = (f32x4){0.f, 0.f, 0.f, 0.f};
#pragma unroll
    for (int s = 0; s < 8; ++s) { const unsigned ib = (s >> 2) * 8192, chq = 4 * (s & 3) + g;
      const bf16x8 a0 = *(const LAS bf16x8*)(wl + ib + offb(n16, chq)), a1 = *(const LAS bf16x8*)(wl + ib + offb(16 + n16, chq));
      s0 = __builtin_amdgcn_mfma_f32_16x16x32_bf16(a0, qf[s], s0, 0, 0, 0); s1 = __builtin_amdgcn_mfma_f32_16x16x32_bf16(a1, qf[s], s1, 0, 0, 0); }
    const int sl0 = 32 * it + 4 * g;
    float mx = -INFINITY;
#pragma unroll
    for (int r = 0; r < 4; ++r) { s0[r] = (sl0 + r < cnt) ? s0[r] * SC : -INFINITY; s1[r] = (sl0 + 16 + r < cnt) ? s1[r] * SC : -INFINITY; mx = fmaxf(mx, fmaxf(s0[r], s1[r])); }
    mx = fmaxf(mx, __shfl_xor(mx, 16)); mx = fmaxf(mx, __shfl_xor(mx, 32));
    const float mnew = fmaxf(mrun, mx), alpha = __builtin_amdgcn_exp2f(mrun - mnew);
    float ls = 0.f; float pv[8];
#pragma unroll
    for (int r = 0; r < 4; ++r) { pv[r] = __builtin_amdgcn_exp2f(s0[r] - mnew); pv[4 + r] = __builtin_amdgcn_exp2f(s1[r] - mnew); ls += pv[r] + pv[4 + r]; }
    ls += __shfl_xor(ls, 16); ls += __shfl_xor(ls, 32);
    lrun = lrun * alpha + ls; mrun = mnew;
#pragma unroll
    for (int c = 0; c < 16; ++c) o[c] = o[c] * alpha;
    const v4u pbw = (v4u){cvt_pk_bf16(pv[0], pv[1]), cvt_pk_bf16(pv[2], pv[3]), cvt_pk_bf16(pv[4], pv[5]), cvt_pk_bf16(pv[6], pv[7])};
    const bf16x8 pb = __builtin_bit_cast(bf16x8, pbw);
#pragma unroll
    for (int c = 0; c < 16; ++c) { const unsigned ib = (c >> 3) * 8192, chc = 2 * (c & 7) + (p4 >> 1);
      const v4i16_t t0 = __builtin_amdgcn_ds_read_tr16_b64_v4i16((LAS v4i16_t*)(wl + ib + offb(4 * g + q4, chc) + 8 * (p4 & 1)));
      const v4i16_t t1 = __builtin_amdgcn_ds_read_tr16_b64_v4i16((LAS v4i16_t*)(wl + ib + offb(16 + 4 * g + q4, chc) + 8 * (p4 & 1)));
      const bf16x8 af = (bf16x8){t0[0], t0[1], t0[2], t0[3], t1[0], t1[1], t1[2], t1[3]};
      o[c] = __builtin_amdgcn_mfma_f32_16x16x32_bf16(af, pb, o[c], 0, 0, 0); }
    LDSW();
  }
  const float inv = 1.f / lrun;
  bf16_t* orow = olat + (size_t)(b * L + t) * 4096 + n16 * 256 + 4 * g;
#pragma unroll
  for (int c = 0; c < 16; ++c) { const f32x4 v = o[c] * inv; *(v2u*)(orow + 16 * c) = (v2u){cvt_pk_bf16(v[0], v[1]), cvt_pk_bf16(v[2], v[3])}; }
}

__device__ __forceinline__ int moe_layer_tile(int layer, int j) { return j < 8192 ? layer * 8192 + j : 16384 + layer * 4096 + (j - 8192); }
__device__ __forceinline__ void moe_weight_tile(int T, const float* w1, const float* w2, bf16_t* W1_t, bf16_t* W2_t, int lane) {
  if (T < 16384) { const int le = T >> 8; transpose_tile(mk_tjob(w1 + (size_t)le * D * 2048, 2048, D, 2048, W1_t + (size_t)le * 2048 * D, D, 0, 0, 1), T & 255, lane); }
  else if (T < 24576) { const int t2 = T - 16384, le = t2 >> 7; transpose_tile(mk_tjob(w2 + (size_t)le * D * D, D, D, D, W2_t + (size_t)le * D * D, D, 0, 0, 0), t2 & 127, lane); }
}
__device__ __forceinline__ void ph_select_attend(const unsigned short* sc, const bf16_t* qlat, const bf16_t* cnb, bf16_t* olat, LAS unsigned char* lds, const float* w1, const float* w2, bf16_t* W1_t, bf16_t* W2_t) {
  const int tid = TIDX(), lane = tid & 63, wave = __builtin_amdgcn_readfirstlane(tid >> 6), blk = BIDX();
  LAS unsigned char* wl = lds + wave * DW_STRIDE; LAS unsigned short* idx16 = (LAS unsigned short*)(wl + 16384);
  const int b = blk & 1, wb = (blk >> 1) * 8 + wave, nwb = ((int)gridDim.x >> 1) * 8;
  const int gw = blk * 8 + wave, NGW = (int)gridDim.x * 8; int wt = gw;
#pragma unroll 1
  for (int t = wb, qi = 0; t < L; t += nwb, ++qi) {
    int lane_s = lane; asm volatile("" : "+v"(lane_s));
    const int cnt = wave_select(sc + (size_t)(b * L + t) * L, t, wl, idx16, lane_s);
#if defined(DUPSEL)
    { int lane_s2 = lane; asm volatile("" : "+v"(lane_s2)); const int cnt2 = wave_select(sc + (size_t)(b * L + t) * L, t, wl, idx16, lane_s2); if (cnt2 != cnt) olat[0] = 0; }
#endif
    int lane_a = lane; asm volatile("" : "+v"(lane_a));
    wave_attend(b, t, cnt, qlat, cnb, wl, idx16, olat, lane_a);
#if defined(DUPATT)
    { int lane_a2 = lane; asm volatile("" : "+v"(lane_a2)); wave_attend(b, t, cnt, qlat, cnb, wl, idx16, olat, lane_a2); }
#endif
    const int ntl = (qi < 6) ? 1 : 0;
#pragma unroll 1
    for (int k = 0; k < ntl; ++k) { int lane_t = lane; asm volatile("" : "+v"(lane_t)); if (wt < 12288) moe_weight_tile(moe_layer_tile(0, wt), w1, w2, W1_t, W2_t, lane_t); wt += NGW; }
  }
#pragma unroll 1
  for (; wt < 12288; wt += NGW) { int lane_t = lane; asm volatile("" : "+v"(lane_t)); moe_weight_tile(moe_layer_tile(0, wt), w1, w2, W1_t, W2_t, lane_t); }
}

namespace pg8 {
struct GroupAOrder {
    StaticOrder so; int png; size_t acol_bytes;
    __device__ void init(const void* A, int lda, const void* Bt, int ldb, int M, int N, int png_, size_t acol_bytes_, int G, int c) { so.init(A, lda, Bt, ldb, M, N, G, c); png = png_; acol_bytes = acol_bytes_; }
    __device__ bool next(int i, Unit& u) const { int pm, pn; if (!so.tile(i, pm, pn)) return false; u.pa = so.A + (size_t)pm * so.ta + (size_t)(pn / png) * acol_bytes; u.pb = so.Bt + (size_t)pn * so.tb; u.orow = pm * BM; u.ocol = pn * BM; u.e = 0; return true; }
    __device__ __forceinline__ void a_ready(const Unit&) const {}
    __device__ __forceinline__ void done(const Unit&) const {}
};
}
constexpr int GLA_LDSU = 65536;

__device__ __forceinline__ v4i16_t trrd(LAS unsigned char* p) { return __builtin_amdgcn_ds_read_tr16_b64_v4i16((LAS v4i16_t*)p); }
__device__ __forceinline__ bf16x8 cat44(v4i16_t a, v4i16_t b) { return (bf16x8){a[0], a[1], a[2], a[3], b[0], b[1], b[2], b[3]}; }

__device__ __forceinline__ void ph_gla_a1(const bf16_t* pb, const float* gbias, bf16_t* qt, float* og, float* kvt, float* dcy, LAS unsigned char* lds, const float* w1, const float* w2, bf16_t* W1_t, bf16_t* W2_t) {
  const int tid = TIDX(), lane = tid & 63, wave = __builtin_amdgcn_readfirstlane(tid >> 6), blk = BIDX();
  if ((wave & 3) != 0) {
    const int cw = blk * 6 + (wave - 1 - (wave >> 2)), NCW = (int)gridDim.x * 6;
#pragma unroll 1
    for (int j = cw; j < 12288; j += NCW) { int lane_t = lane; asm volatile("" : "+v"(lane_t)); moe_weight_tile(moe_layer_tile(1, j), w1, w2, W1_t, W2_t, lane_t); }
    return; }
  const int half = wave >> 2;
  LAS unsigned char* X = lds + half * GLA_LDSU; LAS unsigned char* Y = X + 16384; LAS unsigned char* V = X + 32768;
  const unsigned v_addr = (unsigned)__builtin_amdgcn_readfirstlane((int)(unsigned)(size_t)V);
  const int n16 = lane & 15, g = lane >> 4, q4 = (lane & 15) >> 2, p4 = lane & 3;
#pragma unroll 1
  for (int uu = 0; uu < 2; ++uu) {
    const int u = blk * 4 + half * 2 + uu; if (u >= 1024) break;
    const int h = u & 3, bc = u >> 2, r0 = bc * 64;
    { const unsigned slot = lane & 15, rsub = lane >> 4;
#pragma unroll
      for (int im = 0; im < 4; ++im)
#pragma unroll
        for (int rg = 0; rg < 8; ++rg) { const unsigned row = 4 * rg + rsub; const unsigned ch = slot ^ (((row & 3u) << 2) | ((row >> 2) & 3u));
          const char* src = (const char*)(pb + (size_t)(r0 + 32 * (im >> 1) + row) * 3584 + 1024 + h * 256 + (im & 1) * 128) + ch * 16;
          glds16(src, v_addr + im * 8192 + rg * 1024); } }
    const int d0 = 2 * lane; const float gb0 = gbias[h * 128 + d0], gb1 = gbias[h * 128 + d0 + 1];
    float bc0 = 0.f, bc1 = 0.f;
    const unsigned wofs = 16u * ((unsigned)(d0 >> 3)) , wsub = (unsigned)(d0 & 7) * 2u;
#pragma unroll 1
    for (int jb = 0; jb < 4; ++jb) {
      unsigned gq[16], qq[16], kq[16];
#pragma unroll
      for (int jj = 0; jj < 16; ++jj) { const bf16_t* rp = pb + (size_t)(r0 + jb * 16 + jj) * 3584 + h * 128 + d0;
        gq[jj] = *(const unsigned*)(rp + 3072); qq[jj] = *(const unsigned*)rp; kq[jj] = *(const unsigned*)(rp + 512); }
#pragma unroll
      for (int jj = 0; jj < 16; ++jj) { const int j = jb * 16 + jj;
        const float a0 = bf_lo(gq[jj]) + gb0, a1 = bf_hi(gq[jj]) + gb1;
        bc0 += (fminf(a0, 0.f) - log1pf(__expf(-fabsf(a0)))) * (1.f / 16.f); bc1 += (fminf(a1, 0.f) - log1pf(__expf(-fabsf(a1)))) * (1.f / 16.f);
        const float e0 = __expf(bc0), e1 = __expf(bc1), i0 = __expf(fminf(-bc0, 80.f)), i1 = __expf(fminf(-bc1, 80.f));
        const unsigned qo = cvt_pk_bf16(bf_lo(qq[jj]) * 0.08838834764831845f * e0, bf_hi(qq[jj]) * 0.08838834764831845f * e1);
        const unsigned ko = cvt_pk_bf16(bf_lo(kq[jj]) * i0, bf_hi(kq[jj]) * i1);
        *(unsigned*)(qt + (size_t)(r0 + j) * 512 + h * 128 + d0) = qo;
        const unsigned row = (unsigned)(j & 31); const unsigned off = (unsigned)(j >> 5) * 8192u + 256u * row + ((wofs ^ (16u * (((row & 3u) << 2) | ((row >> 2) & 3u))))) + wsub;
        *(LAS unsigned*)(X + off) = qo; *(LAS unsigned*)(Y + off) = ko; }
    }
    *(float2*)(dcy + (size_t)u * 128 + d0) = make_float2(__expf(bc0), __expf(bc1));
    LDSW();
    bf16x8 afr[4][2];
#pragma unroll
    for (int it = 0; it < 4; ++it)
#pragma unroll
      for (int ks = 0; ks < 2; ++ks) {
        unsigned pk[4] = {0u, 0u, 0u, 0u};
#pragma unroll
        for (int jh = 0; jh < 2; ++jh) { const int jt = 2 * ks + jh;
          if (jt <= it) { f32x4 acc = (f32x4){0.f, 0.f, 0.f, 0.f};
#pragma unroll
            for (int s = 0; s < 4; ++s) { const bf16x8 ya = *(const LAS bf16x8*)(Y + (jt >> 1) * 8192 + offb(n16 + 16 * (jt & 1), 4 * s + g)), xb = *(const LAS bf16x8*)(X + (it >> 1) * 8192 + offb(n16 + 16 * (it & 1), 4 * s + g));
              acc = __builtin_amdgcn_mfma_f32_16x16x32_bf16(ya, xb, acc, 0, 0, 0); }
            const int i_ = 16 * it + n16, jbase = 16 * jt + 4 * g;
#pragma unroll
            for (int r = 0; r < 4; ++r) if (jbase + r > i_) acc[r] = 0.f;
            pk[2 * jh] = cvt_pk_bf16(acc[0], acc[1]); pk[2 * jh + 1] = cvt_pk_bf16(acc[2], acc[3]); } }
        afr[it][ks] = __builtin_bit_cast(bf16x8, (v4u){pk[0], pk[1], pk[2], pk[3]});
      }
    asm volatile("s_waitcnt vmcnt(0)" ::: "memory");
    float* ogp = og + (size_t)u * 16384 + lane * 4; float* kvp = kvt + (size_t)u * 32768 + (size_t)n16 * 128 + 4 * g;
#pragma unroll 1
    for (int nt = 0; nt < 16; ++nt) {
      const unsigned vimg = (unsigned)(nt >> 3) * 8192u, chv = 2u * (unsigned)(nt & 7) + (unsigned)(p4 >> 1), sub = 8u * (unsigned)(p4 & 1);
      bf16x8 bi[2], bn[2];
#pragma unroll
      for (int ks = 0; ks < 2; ++ks) { LAS unsigned char* vb = V + ks * 16384 + vimg;
        bi[ks] = cat44(trrd(vb + offb(4 * g + q4, chv) + sub), trrd(vb + offb(16 + 4 * g + q4, chv) + sub));
        bn[ks] = cat44(trrd(vb + offb(8 * g + q4, chv) + sub), trrd(vb + offb(8 * g + 4 + q4, chv) + sub)); }
#pragma unroll
      for (int it = 0; it < 4; ++it) { f32x4 acc = __builtin_amdgcn_mfma_f32_16x16x32_bf16(afr[it][0], bi[0], (f32x4){0.f, 0.f, 0.f, 0.f}, 0, 0, 0);
        if (it >= 2) acc = __builtin_amdgcn_mfma_f32_16x16x32_bf16(afr[it][1], bi[1], acc, 0, 0, 0);
        *(f32x4*)(ogp + ((size_t)(it * 16 + nt) * 64) * 4) = acc; }
#pragma unroll
      for (int mt = 0; mt < 8; ++mt) { const unsigned chy = 2u * (unsigned)mt + (unsigned)(p4 >> 1);
        const bf16x8 a0 = cat44(trrd(Y + offb(8 * g + q4, chy) + sub), trrd(Y + offb(8 * g + 4 + q4, chy) + sub));
        const bf16x8 a1 = cat44(trrd(Y + 8192 + offb(8 * g + q4, chy) + sub), trrd(Y + 8192 + offb(8 * g + 4 + q4, chy) + sub));
        f32x4 acc = __builtin_amdgcn_mfma_f32_16x16x32_bf16(a0, bn[0], (f32x4){0.f, 0.f, 0.f, 0.f}, 0, 0, 0);
        acc = __builtin_amdgcn_mfma_f32_16x16x32_bf16(a1, bn[1], acc, 0, 0, 0);
        *(f32x4*)(kvp + (size_t)(16 * nt) * 128 + 16 * mt) = acc; }
    }
    LDSW();
  }
}

__device__ __forceinline__ void ph_gla_a2(const float* kvt, const float* dcy, bf16_t* spt) {
  const int gtid = BIDX() * NTHR + TIDX();
  if (gtid >= 8 * 256 * 32) return;
  const int g4 = gtid & 31, dv = (gtid >> 5) & 255, bh = gtid >> 13, b = bh >> 2, h = bh & 3;
  f32x4 S = (f32x4){0.f, 0.f, 0.f, 0.f};
#pragma unroll 4
  for (int c = 0; c < 128; ++c) { const size_t u = (size_t)((b * 128 + c) * 4 + h);
    const f32x4 kv = *(const f32x4*)(kvt + u * 32768 + (size_t)dv * 128 + 4 * g4), dc = *(const f32x4*)(dcy + u * 128 + 4 * g4);
    *(v2u*)(spt + u * 32768 + (size_t)dv * 128 + 4 * g4) = (v2u){cvt_pk_bf16(S[0], S[1]), cvt_pk_bf16(S[2], S[3])};
    S = dc * (S + kv); }
}

constexpr int A3_LD = 272;
__device__ __forceinline__ void ph_gla_a3(const bf16_t* pb, const bf16_t* qt, const float* og, const bf16_t* spt, const float* ng, bf16_t* ob, LAS unsigned char* lds) {
  const int tid = TIDX(), lane = tid & 63, wave = __builtin_amdgcn_readfirstlane(tid >> 6), gw = BIDX() * 8 + wave, NGW = (int)gridDim.x * 8;
  const int n16 = lane & 15, g = lane >> 4, row16 = lane >> 2, cq = lane & 3;
  LAS float* T = (LAS float*)(lds + wave * (16 * A3_LD * 4));
#pragma unroll 1
  for (int w = gw; w < 4096; w += NGW) {
    const int u = w >> 2, it = w & 3, h = u & 3, r0 = (u >> 2) * 64;
    const bf16_t* sp = spt + (size_t)u * 32768 + (size_t)n16 * 128 + 8 * g;
    bf16x8 qa[4];
#pragma unroll
    for (int ks = 0; ks < 4; ++ks) qa[ks] = *(const bf16x8*)(qt + (size_t)(r0 + 16 * it + n16) * 512 + h * 128 + 32 * ks + 8 * g);
    const float* ogp = og + (size_t)u * 16384 + (size_t)(it * 16) * 256 + lane * 4;
#pragma unroll
    for (int nt = 0; nt < 16; ++nt) {
      f32x4 acc = *(const f32x4*)(ogp + nt * 256);
#pragma unroll
      for (int ks = 0; ks < 4; ++ks) { const bf16x8 sb = *(const bf16x8*)(sp + (size_t)(16 * nt) * 128 + 32 * ks); acc = __builtin_amdgcn_mfma_f32_16x16x32_bf16(qa[ks], sb, acc, 0, 0, 0); }
#pragma unroll
      for (int r = 0; r < 4; ++r) T[(4 * g + r) * A3_LD + 16 * nt + n16] = acc[r];
    }
    LDSW();
    const size_t row = (size_t)(r0 + 16 * it + row16);
    f32x4 v[16]; float ss = 0.f;
#pragma unroll
    for (int k = 0; k < 16; ++k) { v[k] = *(const LAS f32x4*)(T + row16 * A3_LD + 16 * k + 4 * cq); ss += (v[k][0] * v[k][0] + v[k][1] * v[k][1]) + (v[k][2] * v[k][2] + v[k][3] * v[k][3]); }
    ss += __shfl_xor(ss, 1); ss += __shfl_xor(ss, 2);
    const float rs = rsqrtf(ss * (1.f / 256.f) + 1e-6f);
#pragma unroll
    for (int k = 0; k < 16; ++k) { const int col = h * 256 + 16 * k + 4 * cq; const v2u rg = *(const v2u*)(pb + row * 3584 + 2048 + col); const f32x4 gn = *(const f32x4*)(ng + col);
      const float rr[4] = {bf_lo(rg[0]), bf_hi(rg[0]), bf_lo(rg[1]), bf_hi(rg[1])}; float o[4];
#pragma unroll
      for (int z = 0; z < 4; ++z) o[z] = v[k][z] * rs * gn[z] * (rr[z] * __builtin_amdgcn_rcpf(1.f + __expf(-rr[z])));
      *(v2u*)(ob + row * 1024 + col) = (v2u){cvt_pk_bf16(o[0], o[1]), cvt_pk_bf16(o[2], o[3])}; }
    LDSW();
  }
}
#ifndef PROBE
#define PROBE 0
#endif
#ifndef PROBE_S
#define PROBE_S 10.0f
#endif
constexpr size_t MiB = 1u << 20;
constexpr size_t WS_CTL = 0, CTL_ZERO_BYTES = 1 * MiB;
constexpr int CW_BAR = 4096;
constexpr size_t WS_NEEDED = 2048 * MiB;

struct Args { In in; float* out; unsigned char* ws; };

struct Opt { bf16_t *qt, *spt; float *dcy, *og, *kvt; bf16_t *Wql_t, *Wuv_t, *cnb, *qlat, *olat; unsigned short* sc; bf16_t *xb, *WA_t, *WoutA_t, *WB_t, *WoutB_t, *W1_t, *W2_t, *projA_b, *hbf, *o2b, *xs, *act, *Ys, *projB_b; MoeBufs m; };
__device__ __forceinline__ nvp::Ws carve_ws(unsigned char* ws) {
  nvp::Ws w; auto at = [&](size_t mib) { return (char*)ws + mib * MiB; };
  w.projA = (float*)at(2); w.cn = (float*)at(119); w.sc = (float*)at(135); w.idx = (int*)at(647); w.o2 = (float*)at(663);
  w.x1 = (float*)at(727); w.x2 = (float*)at(791);
  w.projB = (float*)at(135); w.adec = (float*)at(135 + 194); w.og = (float*)at(135 + 194 + 32); w.on = (float*)at(135 + 194 + 32 + 64);
  w.counts = nullptr; w.h = nullptr; w.hb = nullptr; w.ys = nullptr; w.tok_e = nullptr; w.tok_g = nullptr; w.slot_of = nullptr; w.row_tok = nullptr; w.row_gate = nullptr; w.blk_e = nullptr;
  return w;
}
__device__ __forceinline__ Opt carve_opt(unsigned char* ws) {
  Opt o; auto at = [&](size_t mib) { return (bf16_t*)((char*)ws + mib * MiB); };
  char* sm = (char*)ws + 855 * MiB;
  o.m.tok_e = (int*)sm; o.m.tok_g = (float*)(sm + 256 * 1024); o.m.slot_of = (int*)(sm + 512 * 1024); o.m.slot_gate = (float*)(sm + 768 * 1024); o.m.blk_e = (int*)(sm + 1088 * 1024); o.m.blkcnt = (int*)(sm + 1096 * 1024); o.m.nblk = (int*)(sm + 1160 * 1024);
  o.WA_t = at(860); o.WoutA_t = at(864); o.WB_t = at(866); o.WoutB_t = at(873);
  o.Wql_t = at(875); o.Wuv_t = at(877); o.olat = at(2); o.cnb = at(647); o.qlat = at(1856); o.sc = (unsigned short*)at(135);
  o.qt = at(135); o.dcy = (float*)at(151); o.og = (float*)at(152); o.kvt = (float*)at(216); o.spt = at(344);
  o.W1_t = at(880); o.W2_t = at(1136);
  o.xb = at(1264); o.projA_b = at(1296); o.hbf = at(1360); o.o2b = at(1392);
  o.xs = at(1424); o.act = at(1568); o.Ys = at(1712); o.projB_b = at(1856);
  return o;
}

struct ProIn { const float *a_w_uk, *a_w_uv, *x, *a_w_in, *a_w_out, *b_w_in, *b_w_g2, *b_w_out, *m_w1, *m_w2; };
__device__ __forceinline__ void ph_prologue(const ProIn I, const Opt& o) {
  const int tid = TIDX(), lane = tid & 63, gw = BIDX() * 8 + (tid >> 6), NGW = (int)gridDim.x * 8, gtid = BIDX() * NTHR + tid, NGT = (int)gridDim.x * NTHR;
  cvt_f32_to_bf16(I.x, D, o.xb, D, NT, D, gtid, NGT);
  zero_rect(o.WA_t, D, DINA, 2048 - DINA, 0, D * 2, gtid, NGT);
  for (int i = gtid; i < 512 * 256; i += NGT) { const int n = i >> 8, k4 = (i & 255) * 4; float a[4];
#pragma unroll
    for (int z = 0; z < 4; ++z) { const float* gl = I.b_w_in + (size_t)(k4 + z) * DINB + 2048; float s = 0.f;
#pragma unroll
      for (int j = 0; j < 16; ++j) s = fmaf(gl[j], I.b_w_g2[j * 512 + n], s);
      a[z] = s; }
    *(v2u*)(o.WB_t + (size_t)(3072 + n) * D + k4) = (v2u){cvt_pk_bf16(a[0], a[1]), cvt_pk_bf16(a[2], a[3])}; }
  int w0 = 0;
#pragma unroll 1
  for (int h = 0; h < 16; ++h) {
    transpose_job(mk_tjob(I.a_w_uk + (size_t)h * 64 * 256, 256, 64, 256, o.Wql_t, 256, h * 256, (h & 3) * 64, 0), w0, gw, NGW, lane);
    transpose_job(mk_tjob(I.a_w_uv + (size_t)h * 256 * 64, 64, 256, 64, o.Wuv_t, 1024, h * 64, (h & 3) * 256, 0), w0, gw, NGW, lane);
    for (int hp = 0; hp < 4; ++hp) if (hp != (h & 3)) { zero_rect(o.Wql_t, 256, h * 256, 256, hp * 128, 128, gtid, NGT); zero_rect(o.Wuv_t, 1024, h * 64, 64, hp * 512, 512, gtid, NGT); }
  }
  transpose_job(mk_tjob(I.a_w_in, DINA, D, DINA, o.WA_t, D, 0, 0, 0), w0, gw, NGW, lane);
  transpose_job(mk_tjob(I.a_w_out, D, D, D, o.WoutA_t, D, 0, 0, 0), w0, gw, NGW, lane);
  transpose_job(mk_tjob(I.b_w_in, DINB, D, 2048, o.WB_t, D, 0, 0, 0), w0, gw, NGW, lane);
  transpose_job(mk_tjob(I.b_w_in + 2064, DINB, D, 1024, o.WB_t, D, 2048, 0, 0), w0, gw, NGW, lane);
  transpose_job(mk_tjob(I.b_w_out, D, D, D, o.WoutB_t, D, 0, 0, 0), w0, gw, NGW, lane);
}
__device__ __forceinline__ void ph_gla_shim(const bf16_t* pb, const float* gbias, float* projB, float* adec) {
  const int gtid = BIDX() * NTHR + TIDX(), NGT = (int)gridDim.x * NTHR;
  for (size_t i = gtid; i < (size_t)NT * 896; i += NGT) { const size_t r = i / 896; const int c = (int)(i % 896) * 4; const v2u v = *(const v2u*)(pb + r * 3584 + c);
    const f32x4 f = (f32x4){bf_lo(v[0]), bf_hi(v[0]), bf_lo(v[1]), bf_hi(v[1])};
    if (c < 2048) *(f32x4*)(projB + r * DINB + c) = f;
    else if (c < 3072) *(f32x4*)(projB + r * DINB + 2064 + (c - 2048)) = f;
    else { f32x4 o;
#pragma unroll
      for (int z = 0; z < 4; ++z) { const float a = f[z] + gbias[c - 3072 + z]; const float ls = fminf(a, 0.f) - log1pf(expf(-fabsf(a))); o[z] = expf(ls * (1.f / 16.f)); }
      *(f32x4*)(adec + r * 512 + (c - 3072)) = o; } }
}

#if PROBE == 3
#define GLA_PHASES \
      PH_BEGIN ph_gla_shim(o.projB_b, I.b_g_bias, w.projB, w.adec); PH_END \
      GRID_BAR(); \
      PH_BEGIN nvp::np_gla_scan(w.projB, w.adec, w.og, fl); PH_END \
      GRID_BAR(); \
      PH_BEGIN nvp::np_gla_norm(w.og, w.projB, I.b_norm, w.on); PH_END \
      GRID_BAR(); \
      PH_BEGIN cvt_f32_to_bf16(w.on, D, o.o2b, D, NT, D, gtid_, NGT_); PH_END \
      GRID_BAR(); \
      PH_BEGIN ph_gla_a1(o.projB_b, I.b_g_bias, (bf16_t*)(wsb_ + 489 * MiB), (float*)(wsb_ + 506 * MiB), (float*)(wsb_ + 880 * MiB), (float*)(wsb_ + 505 * MiB), ll, I.m_w1, I.m_w2, o.W1_t, o.W2_t); PH_END \
      GRID_BAR(); \
      PH_BEGIN ph_gla_a2((float*)(wsb_ + 880 * MiB), (float*)(wsb_ + 505 * MiB), (bf16_t*)(wsb_ + 1136 * MiB)); PH_END \
      GRID_BAR(); \
      PH_BEGIN ph_gla_a3(o.projB_b, (bf16_t*)(wsb_ + 489 * MiB), (float*)(wsb_ + 506 * MiB), (bf16_t*)(wsb_ + 1136 * MiB), I.b_norm, (bf16_t*)(wsb_ + 570 * MiB), ll); PH_END \
      GRID_BAR(); \
      PH_BEGIN { unsigned* fl_ = (unsigned*)(wsb_ + 512 * 1024); unsigned bits = 0u; \
        { const bf16_t* a = (const bf16_t*)(wsb_ + 489 * MiB); for (size_t i = gtid_; i < (size_t)NT * 512; i += NGT_) { const float v = bf2f(a[i]); if (!(fabsf(v) < 1e30f)) bits |= 1u; } } \
        { const float* a = (const float*)(wsb_ + 506 * MiB); for (size_t i = gtid_; i < (size_t)NT * 1024; i += NGT_) { const float v = a[i]; if (!(fabsf(v) < 1e30f)) bits |= 2u; } } \
        { const float* a = (const float*)(wsb_ + 880 * MiB); for (size_t i = gtid_; i < (size_t)1024 * 32768; i += NGT_) { const float v = a[i]; if (!(fabsf(v) < 1e30f)) bits |= 4u; } } \
        { const bf16_t* a = (const bf16_t*)(wsb_ + 1136 * MiB); for (size_t i = gtid_; i < (size_t)1024 * 32768; i += NGT_) { const float v = bf2f(a[i]); if (!(fabsf(v) < 1e30f)) bits |= 8u; } } \
        { const bf16_t* a = (const bf16_t*)(wsb_ + 570 * MiB); for (size_t i = gtid_; i < (size_t)NT * 1024; i += NGT_) { const float v = bf2f(a[i]); if (!(fabsf(v) < 1e30f)) bits |= 16u; } } \
        { const float* a = (const float*)(wsb_ + 505 * MiB); for (size_t i = gtid_; i < (size_t)1024 * 128; i += NGT_) { const float v = a[i]; if (!(fabsf(v) < 1e30f)) bits |= 32u; } } \
        if (bits) atomicOr(fl_, bits); \
        { float* pd = (float*)(wsb_ + 1968 * MiB); const bf16_t* ob = (const bf16_t*)(wsb_ + 570 * MiB); for (size_t i = gtid_; i < (size_t)NT * D; i += NGT_) pd[i] = bf2f(ob[i]) - w.on[i]; } } PH_END \
      GRID_BAR();
#else
#define GLA_PHASES \
      PH_BEGIN ph_gla_a1(o.projB_b, I.b_g_bias, o.qt, o.og, o.kvt, o.dcy, ll, I.m_w1, I.m_w2, o.W1_t, o.W2_t); PH_END \
      GRID_BAR(); \
      PH_BEGIN ph_gla_a2(o.kvt, o.dcy, o.spt); PH_END \
      GRID_BAR(); \
      PH_BEGIN ph_gla_a3(o.projB_b, o.qt, o.og, o.spt, I.b_norm, o.o2b, ll); PH_END \
      GRID_BAR();
#endif
#define LAYER_BODY(li) \
    if (li == 1) { \
      PH_BEGIN StaticOrder S; S.init(o.xb, D, o.WB_t, D, NT, 3584, G_, BIDX()); gemm_phase<EpiStore, StaticOrder, true, true>(ll, Gemm{D, D, D}, S, EpiStore{o.projB_b, 3584}); PH_END \
      GRID_BAR(); \
      GLA_PHASES \
      PH_BEGIN StaticOrder S; S.init(o.o2b, D, o.WoutB_t, D, NT, D, G_, BIDX()); gemm_phase<EpiStore, StaticOrder, true, true>(ll, Gemm{D, D, D}, S, EpiStore{o.hbf, D}); PH_END \
      GRID_BAR(); \
    } \
    PH_BEGIN ph_ln_router(li == 0 ? I.x : w.x2, o.hbf, I.ln1_g + li * D, I.ln1_b + li * D, I.m_w_router + (size_t)li * D * 32, I.m_b_router + li * 32, w.x1, o.m, fl); PH_END \
    GRID_BAR(); \
    PH_BEGIN ph_moe_scatter(w.x1, o.xs, o.m, (int*)lds); PH_END \
    GRID_BAR(); \
    PH_BEGIN MoeOrder S; S.init(o.xs, D, o.W1_t + (size_t)li * 32 * 2048 * D, D, (size_t)2048 * D * 2, __builtin_amdgcn_readfirstlane(*o.m.nblk), 8, 128, o.m.blk_e, G_, BIDX()); \
      gemm_phase<pg8::EpiSwiglu, MoeOrder, true, true>(ll, Gemm{D, D, D}, S, pg8::EpiSwiglu{o.act, D, I.m_b1 + (size_t)li * 32 * 2048}); PH_END \
    GRID_BAR(); \
    PH_BEGIN MoeOrder S; S.init(o.act, D, o.W2_t + (size_t)li * 32 * D * D, D, (size_t)D * D * 2, __builtin_amdgcn_readfirstlane(*o.m.nblk), 4, 256, o.m.blk_e, G_, BIDX()); \
      gemm_phase<pg8::EpiMoe2, MoeOrder, true, true>(ll, Gemm{D, D, D}, S, pg8::EpiMoe2{o.Ys, D, I.m_b2 + (size_t)li * 32 * D, o.m.slot_gate}); PH_END \
    GRID_BAR(); \
    PH_BEGIN ph_combine_ln(w.x1, o.Ys, o.m.slot_of, I.ln2_g + li * D, I.ln2_b + li * D, li == 0 ? w.x2 : out_, li == 0 ? o.xb : nullptr); PH_END \
    if (li == 0) GRID_BAR();
__global__ void __launch_bounds__(NTHR, 2) mk_fwd(Args args) {
  extern __shared__ __attribute__((aligned(16))) unsigned char lds[];
  volatile LAS unsigned* MISC = (volatile LAS unsigned*)((LAS unsigned char*)lds + MISC_OFF);
  if (threadIdx.x < 32) MISC[threadIdx.x] = 0u;
  __syncthreads();
  XcdBarrier bar; { const __attribute__((address_space(4))) Args* ka0 = (const __attribute__((address_space(4))) Args*)__builtin_amdgcn_kernarg_segment_ptr(); bar = xcd_barrier_post((unsigned*)(ka0->ws + WS_CTL) + CW_BAR, MISC + 8); }
#define GRID_BAR() xcd_barrier(bar)
#define PH_BEGIN { const __attribute__((address_space(4))) Args* ka_ = (const __attribute__((address_space(4))) Args*)__builtin_amdgcn_kernarg_segment_ptr(); asm volatile("" : "+s"(ka_)); \
    float* const out_ = ka_->out; (void)out_; unsigned char* wsb_ = ka_->ws; const nvp::Ws w = carve_ws(wsb_); (void)w; const Opt o = carve_opt(wsb_); (void)o; \
    const int gtid_ = BIDX() * NTHR + TIDX(), NGT_ = (int)gridDim.x * NTHR; (void)gtid_; (void)NGT_; const int G_ = (int)gridDim.x; (void)G_;
#define PH_END }
#define I (ka_->in)
  float* fl = (float*)lds; LAS unsigned char* ll = (LAS unsigned char*)lds;
  using pg8::gemm_phase; using pg8::StaticOrder; using pg8::MoeOrder; using pg8::Gemm; using pg8::EpiStore;
  PH_BEGIN ph_prologue(ProIn{I.a_w_uk, I.a_w_uv, I.x, I.a_w_in, I.a_w_out, I.b_w_in, I.b_w_g2, I.b_w_out, I.m_w1, I.m_w2}, o); PH_END
  GRID_BAR();
  PH_BEGIN StaticOrder S; S.init(o.xb, D, o.WA_t, D, NT, 2048, G_, BIDX()); gemm_phase<EpiStore, StaticOrder, true, true>(ll, Gemm{D, D, D}, S, EpiStore{o.projA_b, 2048}); PH_END
  GRID_BAR();
  PH_BEGIN ph_cnorm_b(o.projA_b, I.a_kv_norm, o.cnb); PH_END
  PH_BEGIN pg8::GroupAOrder S; S.init(o.projA_b, 2048, o.Wql_t, 256, NT, 4096, 4, 512, G_, BIDX()); gemm_phase<EpiStore, pg8::GroupAOrder, true, true>(ll, Gemm{2048, 256, 256}, S, EpiStore{o.qlat, 4096}); PH_END
  PH_BEGIN ph_iscore(o.projA_b, o.sc); PH_END
  GRID_BAR();
  PH_BEGIN ph_select_attend(o.sc, o.qlat, o.cnb, o.olat, ll, I.m_w1, I.m_w2, o.W1_t, o.W2_t); PH_END
  GRID_BAR();
  PH_BEGIN pg8::GroupAOrder S; S.init(o.olat, 4096, o.Wuv_t, 1024, NT, 1024, 1, 2048, G_, BIDX()); gemm_phase<EpiStore, pg8::GroupAOrder, true, true>(ll, Gemm{4096, 1024, 1024}, S, EpiStore{o.o2b, D}); PH_END
  GRID_BAR();
#if PROBE == 2
  PH_BEGIN cvt_bf16_to_f32(o.projA_b, 2048, w.projA, DINA, NT, DINA, gtid_, NGT_); PH_END
  GRID_BAR();
  PH_BEGIN nvp::np_cnorm(w.projA, I.a_kv_norm, w.cn); PH_END
  PH_BEGIN nvp::np_iscore(w.projA, w.sc, fl); PH_END
  GRID_BAR();
  PH_BEGIN nvp::np_topk(w.sc, w.idx, (char*)lds); PH_END
  GRID_BAR();
  PH_BEGIN nvp::np_dsa_attn(w.projA, w.cn, w.idx, I.a_w_uk, I.a_w_uv, w.o2, fl); PH_END
  GRID_BAR();
  PH_BEGIN { float* pd = (float*)(wsb_ + 1968 * MiB); for (size_t i = gtid_; i < (size_t)NT * D; i += NGT_) pd[i] = bf2f(o.o2b[i]) - w.o2[i]; } PH_END
  GRID_BAR();
#endif
  PH_BEGIN StaticOrder S; S.init(o.o2b, D, o.WoutA_t, D, NT, D, G_, BIDX()); gemm_phase<EpiStore, StaticOrder, true, true>(ll, Gemm{D, D, D}, S, EpiStore{o.hbf, D}); PH_END
  GRID_BAR();
  { LAYER_BODY(0) }
  { LAYER_BODY(1) }
#if PROBE == 2 || PROBE == 3
  GRID_BAR();
#if PROBE == 3
  PH_BEGIN { if (gtid_ == 0) { const unsigned fb = *(const unsigned*)(wsb_ + 512 * 1024); out_[5] += (float)fb; } const float* pd = (const float*)(wsb_ + 1968 * MiB); for (size_t i = gtid_; i < (size_t)NT * D; i += NGT_) out_[i] += PROBE_S * pd[i]; } PH_END
#else
  PH_BEGIN { const float* pd = (const float*)(wsb_ + 1968 * MiB); for (size_t i = gtid_; i < (size_t)NT * D; i += NGT_) out_[i] += PROBE_S * pd[i]; } PH_END
#endif
#endif
}

extern "C" void kernel_launch(void* const* d_in, const int* in_sizes, int n_in, void* d_out, int out_size, void* d_ws, size_t ws_size, hipStream_t stream) {
  static int grid = 0;
  if (grid == 0) {
    if (n_in != 21 || ws_size < WS_NEEDED) { fprintf(stderr, "kernel_launch: bad inputs (n_in %d) or workspace too small (%zu needed, %zu given)\n", n_in, (size_t)WS_NEEDED, ws_size); grid = -1; return; }
    int dev = 0, cus = 0, per_cu = 0;
    if (hipGetDevice(&dev) != hipSuccess || hipDeviceGetAttribute(&cus, hipDeviceAttributeMultiprocessorCount, dev) != hipSuccess) { grid = -1; return; }
    if (hipFuncSetAttribute((const void*)mk_fwd, hipFuncAttributeMaxDynamicSharedMemorySize, LDS_BYTES) != hipSuccess) { fprintf(stderr, "kernel_launch: hipFuncSetAttribute failed\n"); grid = -1; return; }
    if (hipOccupancyMaxActiveBlocksPerMultiprocessor(&per_cu, (const void*)mk_fwd, NTHR, LDS_BYTES) != hipSuccess || per_cu < 1) fprintf(stderr, "kernel_launch: note: occupancy query reports %d\n", per_cu);
    (void)hipGetLastError();
    grid = cus;
    if (grid != 256) fprintf(stderr, "kernel_launch: built for 256 CUs (token ownership per workgroup); got %d\n", grid);
  }
  if (grid < 0) return;
  if (hipMemsetAsync((char*)d_ws + WS_CTL, 0, CTL_ZERO_BYTES, stream) != hipSuccess) { fprintf(stderr, "kernel_launch: memset failed\n"); return; }
  Args a; memset(&a, 0, sizeof(a));
  const float** f = (const float**)&a.in;
  for (int i = 0; i < 21; ++i) f[i] = (const float*)d_in[i];
  a.out = (float*)d_out; a.ws = (unsigned char*)d_ws;
  hipLaunchKernelGGL(mk_fwd, dim3(grid), dim3(NTHR), LDS_BYTES, stream, a);
  const hipError_t le = hipPeekAtLastError();
  if (le != hipSuccess) fprintf(stderr, "kernel_launch: launch failed: %s\n", hipGetErrorName(le));
}
```

```cpp
#include <hip/hip_runtime.h>
#include <cstdio>
#include <cstdint>
#include <cstring>

#define GAS __attribute__((address_space(1)))
#define LAS __attribute__((address_space(3)))
#define NTHR 512
constexpr int LDS_BYTES = 147456;
constexpr int MISC_OFF = 131072 + 8192;

#define XB_TMO      128
#define XB_XCNT(j)  (256  + 64 * (j))
#define XB_XSUB(j)  (1280 + 64 * (j))
#define XB_XGEN(j)  (2304 + 64 * (j))
#define XB_TOP      3328
#define XB_TOPGEN   3392
#define XCD_BAR_WORDS 3456
#define XB_SPIN_CAP (1u << 25)
__device__ __forceinline__ unsigned xb_ld(unsigned* p)              { return __hip_atomic_load(p, __ATOMIC_RELAXED, __HIP_MEMORY_SCOPE_AGENT); }
__device__ __forceinline__ unsigned xb_add(unsigned* p, unsigned v) { return __hip_atomic_fetch_add(p, v, __ATOMIC_RELAXED, __HIP_MEMORY_SCOPE_AGENT); }
__device__ __forceinline__ unsigned xb_xcc_id() { return (unsigned)__builtin_amdgcn_s_getreg((3 << 11) | 20) & 0xFu; }
#define XB_SPIN(cond, bar) do { unsigned _sp = 0; while (cond) { __builtin_amdgcn_s_sleep(1); \
    if ((++_sp & 255u) == 0u) { if (xb_ld(&(bar)[XB_TMO])) break; if (_sp > XB_SPIN_CAP) { atomicAdd(&(bar)[XB_TMO], 1u); break; } } } } while (0)
struct XcdBarrier { unsigned* bar; unsigned x; volatile LAS unsigned* st; };
__device__ __forceinline__ XcdBarrier xcd_barrier_post(unsigned* bar, volatile LAS unsigned* st) {
    XcdBarrier b; b.bar = bar; b.x = xb_xcc_id(); b.st = st;
    if (threadIdx.x == 0) (void)xb_add(&bar[XB_XCNT(b.x)], 1u);
    return b;
}
__device__ __forceinline__ void xcd_barrier_complete(unsigned* bar, unsigned x, unsigned& nloc, unsigned& nx) {
    const unsigned G = gridDim.x * gridDim.y * gridDim.z;
    unsigned sum, cnt, mine, sp = 0u;
    for (;;) {
        sum = 0u; cnt = 0u; mine = 0u;
#pragma unroll
        for (unsigned j = 0; j < 16; ++j) { const unsigned c = xb_ld(&bar[XB_XCNT(j)]); sum += c; cnt += (c > 0u) ? 1u : 0u; mine = (j == x) ? c : mine; }
        if (sum == G) break;
        __builtin_amdgcn_s_sleep(1);
        if ((++sp & 255u) == 0u) { if (xb_ld(&bar[XB_TMO])) break; if (sp > XB_SPIN_CAP) { atomicAdd(&bar[XB_TMO], 1u); break; } }
    }
    nloc = mine > 0u ? mine : 1u; nx = cnt > 0u ? cnt : 1u;
}
__device__ __forceinline__ void xcd_barrier(const XcdBarrier& b) {
    asm volatile("s_waitcnt vmcnt(0)" ::: "memory");
    __syncthreads();
    if (threadIdx.x == 0) {
        unsigned* bar = b.bar;
        __builtin_amdgcn_s_waitcnt(0);
        unsigned nloc = b.st[0], nx = b.st[1];
        if (nloc == 0u) { xcd_barrier_complete(bar, b.x, nloc, nx); b.st[0] = nloc; b.st[1] = nx; }
        const unsigned old = xb_add(&bar[XB_XSUB(b.x)], 1u);
        const unsigned gen = old / nloc;
        if (old + 1u == (gen + 1u) * nloc) {
            __builtin_amdgcn_fence(__ATOMIC_RELEASE, "agent");
            asm volatile("s_waitcnt vmcnt(0)" ::: "memory");
            const unsigned og = xb_add(&bar[XB_TOP], 1u);
            const unsigned tg = og / nx;
            if (og + 1u == (tg + 1u) * nx) xb_add(&bar[XB_TOPGEN], 1u);
            else XB_SPIN(xb_ld(&bar[XB_TOPGEN]) == tg, bar);
            __builtin_amdgcn_fence(__ATOMIC_ACQUIRE, "agent");
            xb_add(&bar[XB_XGEN(b.x)], 1u);
            asm volatile("s_waitcnt vmcnt(0)" ::: "memory");
        } else {
            XB_SPIN(xb_ld(&bar[XB_XGEN(b.x)]) == gen, bar);
            __builtin_amdgcn_fence(__ATOMIC_ACQUIRE, "agent");
            asm volatile("s_waitcnt vmcnt(0)" ::: "memory");
        }
    }
    __syncthreads();
}

constexpr int NT = 16384, D = 1024, L = 8192, NB = 2;
constexpr int DINA = 1864, DINB = 3088;
constexpr int PMAX = 73728;
constexpr float ALPHA = 1.4142135623730951f;

struct In { const float *x, *a_w_in, *a_kv_norm, *a_w_uk, *a_w_uv, *a_w_out, *b_w_in, *b_w_g2, *b_g_bias, *b_norm, *b_w_out, *m_w_router, *m_b_router, *m_w1, *m_b1, *m_w2, *m_b2, *ln1_g, *ln1_b, *ln2_g, *ln2_b; };

__device__ __forceinline__ int TIDX() { int t = threadIdx.x; asm volatile("" : "+v"(t)); return t; }
__device__ __forceinline__ int BIDX() { int t = blockIdx.x; asm volatile("" : "+s"(t)); return t; }
__device__ __forceinline__ float wave_sum(float v) {
#pragma unroll
    for (int o = 1; o < 64; o <<= 1) v += __shfl_xor(v, o);
    return v;
}
namespace nvp {
#define WSYNC() asm volatile("s_waitcnt lgkmcnt(0)" ::: "memory")
struct GemmP {
  const float* A; int lda; const int* arow;
  const float* B; int ldb; float* C; int ldc; int M, N, K;
  const int* blk_e; const int* nblk_used; size_t bstride; const float* bias; size_t bias_stride;
};
__device__ __forceinline__ GemmP mkg(const float* A, int lda, const int* arow, const float* B, int ldb, float* C, int ldc, int M, int N, int K, const int* blk_e, const int* nblk_used, size_t bstride, const float* bias, size_t bias_stride) {
  GemmP p; p.A = A; p.lda = lda; p.arow = arow; p.B = B; p.ldb = ldb; p.C = C; p.ldc = ldc; p.M = M; p.N = N; p.K = K; p.blk_e = blk_e; p.nblk_used = nblk_used; p.bstride = bstride; p.bias = bias; p.bias_stride = bias_stride; return p; }

template <int MODE>
__device__ __forceinline__ void np_sgemm(const GemmP p, float* lds) {
  float (*As)[132] = (float (*)[132])lds;
  float (*Bs)[68] = (float (*)[68])(lds + 16 * 132);
  float (*Bu)[68] = (float (*)[68])(lds + 16 * 132 + 16 * 68);
  const int tid = TIDX(), tx = tid & 15, ty = tid >> 4;
  const int ntn = (p.N + 63) / 64, ntm = p.M / 128;
  const int ar = tid >> 2, ak = (tid & 3) * 4;
  const int bk = (tid & 255) >> 4, bn4 = (tid & 15) * 4;
  for (int t = BIDX(); t < ntm * ntn; t += gridDim.x) {
    const int bm = t / ntn, bn = t % ntn;
    const float* B = p.B; const float* bias = p.bias;
    if (MODE != 0) { const int blk = (bm * 128) / 256; if (blk >= *p.nblk_used) continue; const int e = p.blk_e[blk]; B += (size_t)e * p.bstride; bias += (size_t)e * p.bias_stride; }
    const int m0 = bm * 128, n0 = bn * 64;
    const int arow = p.arow ? p.arow[m0 + ar] : (m0 + ar);
    const float* Ap = p.A + (size_t)arow * p.lda + ak;
    const bool bok = (n0 + bn4) < p.N;
    float acc[4][4] = {}, accu[4][4] = {};
    for (int k0 = 0; k0 < p.K; k0 += 16) {
      const float4 av = *(const float4*)(Ap + k0);
      As[ak + 0][ar] = av.x; As[ak + 1][ar] = av.y; As[ak + 2][ar] = av.z; As[ak + 3][ar] = av.w;
      if (tid < 256) { float4 bv = make_float4(0.f, 0.f, 0.f, 0.f); if (bok) bv = *(const float4*)(B + (size_t)(k0 + bk) * p.ldb + n0 + bn4); *(float4*)&Bs[bk][bn4] = bv; }
      else if (MODE == 1) { const float4 uv = *(const float4*)(B + (size_t)(k0 + bk) * p.ldb + 1024 + n0 + bn4); *(float4*)&Bu[bk][bn4] = uv; }
      __syncthreads();
#pragma unroll
      for (int kk = 0; kk < 16; ++kk) {
        const float4 a = *(const float4*)&As[kk][ty * 4];
        const float4 b = *(const float4*)&Bs[kk][tx * 4];
        const float aa[4] = {a.x, a.y, a.z, a.w}, bb[4] = {b.x, b.y, b.z, b.w};
#pragma unroll
        for (int i = 0; i < 4; ++i)
#pragma unroll
          for (int j = 0; j < 4; ++j) acc[i][j] = fmaf(aa[i], bb[j], acc[i][j]);
        if (MODE == 1) {
          const float4 u = *(const float4*)&Bu[kk][tx * 4]; const float uu[4] = {u.x, u.y, u.z, u.w};
#pragma unroll
          for (int i = 0; i < 4; ++i)
#pragma unroll
            for (int j = 0; j < 4; ++j) accu[i][j] = fmaf(aa[i], uu[j], accu[i][j]);
        }
      }
      __syncthreads();
    }
#pragma unroll
    for (int i = 0; i < 4; ++i) {
      const int m = m0 + ty * 4 + i;
#pragma unroll
      for (int j = 0; j < 4; ++j) {
        const int n = n0 + tx * 4 + j; if (n >= p.N) continue;
        float v = acc[i][j];
        if (MODE == 1) {
          float g = v + bias[n], u = accu[i][j] + bias[1024 + n];
          g = fminf(g, 7.f); u = fminf(fmaxf(u, -7.f), 7.f);
          const float glu = g / (1.f + expf(-1.702f * g));
          v = (u + 1.f) * glu;
        } else if (MODE == 2) v += bias[n];
        p.C[(size_t)m * p.ldc + n] = v;
      }
    }
  }
}

#define GW_INIT const int lane = TIDX() & 63, wave = TIDX() >> 6, gw = BIDX() * 8 + wave, NGW = gridDim.x * 8; (void)lane; (void)wave; (void)gw; (void)NGW

__device__ __forceinline__ void np_cnorm(const float* projA, const float* g, float* cn) {
  GW_INIT;
  for (int row = gw; row < NT; row += NGW) {
    const float4 v = *(const float4*)(projA + (size_t)row * DINA + 1024 + lane * 4);
    const float ss = wave_sum(v.x * v.x + v.y * v.y + v.z * v.z + v.w * v.w);
    const float r = rsqrtf(ss * (1.f / 256.f) + 1e-6f); const float4 g4 = *(const float4*)(g + lane * 4);
    *(float4*)(cn + (size_t)row * 256 + lane * 4) = make_float4(v.x * r * g4.x, v.y * r * g4.y, v.z * r * g4.z, v.w * r * g4.w);
  }
}

__device__ __forceinline__ void np_iscore(const float* projA, float* sc, float* lds) {
  float (*As)[132] = (float (*)[132])lds;
  float (*Bs)[68] = (float (*)[68])(lds + 16 * 132);
  const int tid = TIDX(), tx = tid & 15, ty = tid >> 4;
  const int ar = tid >> 2, ak = (tid & 3) * 4;
  const int br = (tid & 255) >> 2;
  for (int u = BIDX(); u < NB * 64 * 128; u += gridDim.x) {
    const int b = u / (64 * 128), tt = (u / 128) % 64, st = u % 128;
    if (st > 2 * tt + 1) continue;
    const int t0 = tt * 128, s0 = st * 64;
    const float* Qp = projA + (size_t)(b * L + t0 + ar) * DINA + 1280 + ak;
    const float* Kp = projA + (size_t)(b * L + s0 + br) * DINA + 1792 + ak;
    float score[4][4] = {};
    for (int h = 0; h < 8; ++h) {
      float acc[4][4] = {};
      for (int k0 = 0; k0 < 64; k0 += 16) {
        const float4 av = *(const float4*)(Qp + h * 64 + k0);
        As[ak + 0][ar] = av.x; As[ak + 1][ar] = av.y; As[ak + 2][ar] = av.z; As[ak + 3][ar] = av.w;
        if (tid < 256) { const float4 bv = *(const float4*)(Kp + k0); Bs[ak + 0][br] = bv.x; Bs[ak + 1][br] = bv.y; Bs[ak + 2][br] = bv.z; Bs[ak + 3][br] = bv.w; }
        __syncthreads();
#pragma unroll
        for (int kk = 0; kk < 16; ++kk) {
          const float4 a = *(const float4*)&As[kk][ty * 4]; const float4 bq = *(const float4*)&Bs[kk][tx * 4];
          const float aa[4] = {a.x, a.y, a.z, a.w}, bb[4] = {bq.x, bq.y, bq.z, bq.w};
#pragma unroll
          for (int i = 0; i < 4; ++i)
#pragma unroll
            for (int j = 0; j < 4; ++j) acc[i][j] = fmaf(aa[i], bb[j], acc[i][j]);
        }
        __syncthreads();
      }
#pragma unroll
      for (int i = 0; i < 4; ++i) {
        const float w = projA[(size_t)(b * L + t0 + ty * 4 + i) * DINA + 1856 + h] * 0.35355339059327373f;
#pragma unroll
        for (int j = 0; j < 4; ++j) score[i][j] += w * fmaxf(acc[i][j] * 0.125f, 0.f);
      }
    }
#pragma unroll
    for (int i = 0; i < 4; ++i)
#pragma unroll
      for (int j = 0; j < 4; ++j) sc[((size_t)(b * L + t0 + ty * 4 + i)) * L + s0 + tx * 4 + j] = score[i][j];
  }
}

__device__ __forceinline__ unsigned f2key(float f) { f = f + 0.0f; const unsigned u = __float_as_uint(f); return (u & 0x80000000u) ? ~u : (u | 0x80000000u); }

__device__ __forceinline__ void np_topk(const float* sc, int* idx_out, char* lds) {
  GW_INIT;
  unsigned* hist = (unsigned*)(lds + wave * 1280); unsigned* cntw = hist + 256;
  for (int row = gw; row < NT; row += NGW) {
    const int t = row % L, n = t + 1;
    const float* s = sc + (size_t)row * L; int* out = idx_out + (size_t)row * 256;
    if (n <= 256) { for (int i = lane; i < 256; i += 64) out[i] = i < n ? i : -1; continue; }
    unsigned prefix = 0, need = 256;
    for (int pass = 3; pass >= 0; --pass) {
      const int shift = pass * 8;
      for (int i = lane; i < 256; i += 64) hist[i] = 0;
      WSYNC();
      for (int i = lane; i < n; i += 64) { const unsigned k = f2key(s[i]); const bool m = (pass == 3) || ((k >> (shift + 8)) == (prefix >> (shift + 8))); if (m) atomicAdd(&hist[(k >> shift) & 255u], 1u); }
      WSYNC();
      unsigned cum = 0; int d = 255; for (; d > 0; --d) { const unsigned hv = hist[d]; if (cum + hv >= need) break; cum += hv; }
      prefix |= ((unsigned)d << shift); need -= cum;
      WSYNC();
    }
    if (lane == 0) *cntw = 0; WSYNC();
    for (int i = lane; i < n; i += 64) { if (f2key(s[i]) > prefix) { const unsigned pos = atomicAdd(cntw, 1u); out[pos] = i; } }
    WSYNC();
    if (lane == 0) { unsigned c = *cntw; unsigned nd = need; for (int i = 0; i < n && nd > 0; ++i) if (f2key(s[i]) == prefix) { out[c++] = i; --nd; } }
    WSYNC();
  }
}

__device__ __forceinline__ void np_dsa_attn(const float* projA, const float* cn, const int* idx, const float* w_uk, const float* w_uv, float* o2, float* lds) {
  const int half = TIDX() >> 8, tid = TIDX() & 255;
  float* base = lds + half * 14336;
  float* qs = base; float (*ql)[256] = (float (*)[256])(base + 1024); float (*pr)[257] = (float (*)[257])(base + 1024 + 4096);
  float (*ol)[256] = (float (*)[256])(base + 1024 + 4096 + 4112); float* red = base + 1024 + 4096 + 4112 + 4096; int* sid = (int*)(red + 16);
  for (int r0 = BIDX() * 2; r0 < NT; r0 += gridDim.x * 2) {
    const int row = r0 + half, b = row / L;
    __syncthreads();
    for (int i = tid; i < 1024; i += 256) qs[i] = projA[(size_t)row * DINA + i];
    sid[tid] = idx[(size_t)row * 256 + tid];
    __syncthreads();
    { const int c = tid;
#pragma unroll 1
      for (int h = 0; h < 16; ++h) { float a = 0.f;
#pragma unroll 8
        for (int d = 0; d < 64; ++d) a = fmaf(qs[h * 64 + d], w_uk[((size_t)h * 64 + d) * 256 + c], a); ql[h][c] = a; } }
    __syncthreads();
    { const int k = tid, key = sid[k];
      float lg[16];
      if (key >= 0) { const float* cr = cn + (size_t)(b * L + key) * 256;
        for (int h = 0; h < 16; ++h) lg[h] = 0.f;
#pragma unroll 2
        for (int c = 0; c < 256; ++c) { const float cv = cr[c];
#pragma unroll
          for (int h = 0; h < 16; ++h) lg[h] = fmaf(ql[h][c], cv, lg[h]); }
#pragma unroll
        for (int h = 0; h < 16; ++h) pr[h][k] = lg[h] * 0.125f;
      } else {
#pragma unroll
        for (int h = 0; h < 16; ++h) pr[h][k] = -INFINITY; } }
    __syncthreads();
    if (tid < 16) { const int h = tid; float m = -INFINITY; for (int k = 0; k < 256; ++k) m = fmaxf(m, pr[h][k]); float su = 0.f; for (int k = 0; k < 256; ++k) { const float e = expf(pr[h][k] - m); pr[h][k] = e; su += e; } red[h] = 1.f / su; }
    __syncthreads();
    { const int c = tid; float a[16];
#pragma unroll
      for (int h = 0; h < 16; ++h) a[h] = 0.f;
#pragma unroll 2
      for (int k = 0; k < 256; ++k) { const int key = sid[k]; if (key < 0) continue; const float cv = cn[(size_t)(b * L + key) * 256 + c];
#pragma unroll
        for (int h = 0; h < 16; ++h) a[h] = fmaf(pr[h][k], cv, a[h]); }
#pragma unroll
      for (int h = 0; h < 16; ++h) ol[h][c] = a[h] * red[h]; }
    __syncthreads();
#pragma unroll 1
    for (int o = tid; o < 1024; o += 256) { const int h = o >> 6, v = o & 63; float a = 0.f;
#pragma unroll 8
      for (int c = 0; c < 256; ++c) a = fmaf(ol[h][c], w_uv[((size_t)h * 256 + c) * 64 + v], a); o2[(size_t)row * 1024 + o] = a; }
  }
  __syncthreads();
}

__device__ __forceinline__ void np_ln_res(const float* x, const float* h, const float* g, const float* bb, float* out) {
  GW_INIT;
  for (int row = gw; row < NT; row += NGW) {
    float4 v[4]; float s = 0.f;
#pragma unroll
    for (int j = 0; j < 4; ++j) { const float4 a = *(const float4*)(x + (size_t)row * D + lane * 4 + 256 * j), hh = *(const float4*)(h + (size_t)row * D + lane * 4 + 256 * j);
      v[j] = make_float4(ALPHA * a.x + hh.x, ALPHA * a.y + hh.y, ALPHA * a.z + hh.z, ALPHA * a.w + hh.w); s += (v[j].x + v[j].y) + (v[j].z + v[j].w); }
    const float mu = wave_sum(s) * (1.f / D); float q = 0.f;
#pragma unroll
    for (int j = 0; j < 4; ++j) { v[j].x -= mu; v[j].y -= mu; v[j].z -= mu; v[j].w -= mu; q += (v[j].x * v[j].x + v[j].y * v[j].y) + (v[j].z * v[j].z + v[j].w * v[j].w); }
    const float r = rsqrtf(wave_sum(q) * (1.f / D) + 1e-5f);
#pragma unroll
    for (int j = 0; j < 4; ++j) { const int c = lane * 4 + 256 * j; const float4 g4 = *(const float4*)(g + c), b4 = *(const float4*)(bb + c);
      *(float4*)(out + (size_t)row * D + c) = make_float4(v[j].x * r * g4.x + b4.x, v[j].y * r * g4.y + b4.y, v[j].z * r * g4.z + b4.z, v[j].w * r * g4.w + b4.w); }
  }
}

__device__ __forceinline__ void np_router(const float* x, const float* wr, const float* br, int* tok_e, float* tok_g, int* counts, int* row_tok, char* lds) {
  GW_INIT;
  for (int i = BIDX() * NTHR + TIDX(); i < PMAX; i += gridDim.x * NTHR) row_tok[i] = 0;
  float* lg = (float*)(lds + wave * 256);
  const int e = lane & 31, hf = lane >> 5;
  for (int tok = gw; tok < NT; tok += NGW) {
    const float* xr = x + (size_t)tok * D + hf * 512; const float* wp = wr + (size_t)hf * 512 * 32 + e; float a = 0.f;
#pragma unroll 8
    for (int d = 0; d < 512; ++d) a = fmaf(xr[d], wp[d * 32], a);
    a += __shfl_xor(a, 32);
    if (hf == 0) lg[e] = a + br[e];
    WSYNC();
    if (lane == 0) { int ei[4]; float ev[4];
      for (int k = 0; k < 4; ++k) { int bi = 0; float bv = -INFINITY; for (int j = 0; j < 32; ++j) if (lg[j] > bv) { bv = lg[j]; bi = j; } ei[k] = bi; ev[k] = bv; lg[bi] = -INFINITY; }
      float su = 0.f, ex[4]; for (int k = 0; k < 4; ++k) { ex[k] = expf(ev[k] - ev[0]); su += ex[k]; }
      for (int k = 0; k < 4; ++k) { tok_e[tok * 4 + k] = ei[k]; tok_g[tok * 4 + k] = ex[k] / su; atomicAdd(&counts[ei[k]], 1); } }
    WSYNC();
  }
}
__device__ __forceinline__ void np_moe_sort(const int* tok_e, const float* tok_g, const int* counts, int* row_tok, float* row_gate, int* slot_of, int* blk_e, int* nblk_used, char* lds) {
  if (BIDX() != 0) return;
  const int e = TIDX(); int* pstart = (int*)lds; int* stage = pstart + 64;
  if (e == 0) { int acc = 0; for (int j = 0; j < 32; ++j) { pstart[j] = acc; const int nb = (counts[j] + 255) / 256; for (int q = 0; q < nb; ++q) blk_e[acc / 256 + q] = j; acc += nb * 256; } pstart[32] = acc; *nblk_used = acc / 256; }
  __syncthreads();
  int pos = e < 32 ? pstart[e] : 0;
  for (int c0 = 0; c0 < NT * 4; c0 += 2048) {
    __syncthreads();
    for (int i = e; i < 2048; i += NTHR) stage[i] = tok_e[c0 + i];
    __syncthreads();
    if (e < 32) for (int i = 0; i < 2048; ++i) if (stage[i] == e) { const int gi = c0 + i; row_tok[pos] = gi >> 2; row_gate[pos] = tok_g[gi]; slot_of[gi] = pos; ++pos; }
  }
  __syncthreads();
}
__device__ __forceinline__ void np_moe_combine_ln(const float* x1, const float* ys, const int* slot_of, const float* tok_g, const float* g, const float* bb, float* out) {
  GW_INIT;
  for (int row = gw; row < NT; row += NGW) {
    float4 v[4]; float s = 0.f; int sl[4]; float gg[4];
#pragma unroll
    for (int k = 0; k < 4; ++k) { sl[k] = slot_of[row * 4 + k]; gg[k] = tok_g[row * 4 + k]; }
#pragma unroll
    for (int j = 0; j < 4; ++j) { const int c = lane * 4 + 256 * j; float4 f = make_float4(0.f, 0.f, 0.f, 0.f);
#pragma unroll
      for (int k = 0; k < 4; ++k) { const float4 y = *(const float4*)(ys + (size_t)sl[k] * D + c); f.x += gg[k] * y.x; f.y += gg[k] * y.y; f.z += gg[k] * y.z; f.w += gg[k] * y.w; }
      const float4 a = *(const float4*)(x1 + (size_t)row * D + c);
      v[j] = make_float4(ALPHA * a.x + f.x, ALPHA * a.y + f.y, ALPHA * a.z + f.z, ALPHA * a.w + f.w); s += (v[j].x + v[j].y) + (v[j].z + v[j].w); }
    const float mu = wave_sum(s) * (1.f / D); float q = 0.f;
#pragma unroll
    for (int j = 0; j < 4; ++j) { v[j].x -= mu; v[j].y -= mu; v[j].z -= mu; v[j].w -= mu; q += (v[j].x * v[j].x + v[j].y * v[j].y) + (v[j].z * v[j].z + v[j].w * v[j].w); }
    const float r = rsqrtf(wave_sum(q) * (1.f / D) + 1e-5f);
#pragma unroll
    for (int j = 0; j < 4; ++j) { const int c = lane * 4 + 256 * j; const float4 g4 = *(const float4*)(g + c), b4 = *(const float4*)(bb + c);
      *(float4*)(out + (size_t)row * D + c) = make_float4(v[j].x * r * g4.x + b4.x, v[j].y * r * g4.y + b4.y, v[j].z * r * g4.z + b4.z, v[j].w * r * g4.w + b4.w); }
  }
}

__device__ __forceinline__ void np_gla_gate(const float* projB, const float* w_g2, const float* gb, float* adec) {
  GW_INIT;
  for (int row = gw; row < NT; row += NGW) {
    float glr[16];
#pragma unroll
    for (int j = 0; j < 16; ++j) glr[j] = projB[(size_t)row * DINB + 2048 + j];
    for (int c = lane; c < 512; c += 64) { float a = gb[c];
#pragma unroll
      for (int j = 0; j < 16; ++j) a = fmaf(glr[j], w_g2[j * 512 + c], a);
      const float ls = fminf(a, 0.f) - log1pf(expf(-fabsf(a))); adec[(size_t)row * 512 + c] = expf(ls * (1.f / 16.f)); }
  }
}
__device__ __forceinline__ void np_gla_scan(const float* projB, const float* adec, float* og, float* lds) {
  if (BIDX() >= 8) return;
  const int b = BIDX() >> 2, h = BIDX() & 3, tid = TIDX(), dv = tid & 255, dh = tid >> 8;
  float (*qs)[128] = (float (*)[128])lds; float (*ks)[128] = (float (*)[128])(lds + 2048); float (*as)[128] = (float (*)[128])(lds + 4096);
  float (*po)[16][256] = (float (*)[16][256])(lds + 6144);
  float S[64];
#pragma unroll
  for (int d = 0; d < 64; ++d) S[d] = 0.f;
  for (int t0 = 0; t0 < L; t0 += 16) {
    __syncthreads();
    for (int i = tid; i < 16 * 128; i += NTHR) { const int tt = i >> 7, d = i & 127; const size_t r = (size_t)(b * L + t0 + tt);
      qs[tt][d] = projB[r * DINB + h * 128 + d] * 0.08838834764831845f; ks[tt][d] = projB[r * DINB + 512 + h * 128 + d]; as[tt][d] = adec[r * 512 + h * 128 + d]; }
    __syncthreads();
#pragma unroll 1
    for (int tt = 0; tt < 16; ++tt) { const size_t r = (size_t)(b * L + t0 + tt); const float v = projB[r * DINB + 1024 + h * 256 + dv]; float o = 0.f;
#pragma unroll
      for (int d = 0; d < 64; ++d) { S[d] = fmaf(as[tt][dh * 64 + d], S[d], ks[tt][dh * 64 + d] * v); o = fmaf(qs[tt][dh * 64 + d], S[d], o); }
      po[dh][tt][dv] = o; }
    __syncthreads();
    for (int i = tid; i < 16 * 256; i += NTHR) { const int tt = i >> 8, c = i & 255; og[(size_t)(b * L + t0 + tt) * 1024 + h * 256 + c] = po[0][tt][c] + po[1][tt][c]; }
  }
  __syncthreads();
}
__device__ __forceinline__ void np_gla_norm(const float* og, const float* projB, const float* ng, float* on) {
  GW_INIT;
  for (int u = gw; u < NT * 4; u += NGW) {
    const int row = u >> 2, h = u & 3; const int c = h * 256 + lane * 4;
    const float4 v = *(const float4*)(og + (size_t)row * 1024 + c);
    const float r = rsqrtf(wave_sum(v.x * v.x + v.y * v.y + v.z * v.z + v.w * v.w) * (1.f / 256.f) + 1e-6f);
    const float4 rr = *(const float4*)(projB + (size_t)row * DINB + 2064 + c), g4 = *(const float4*)(ng + c);
    *(float4*)(on + (size_t)row * 1024 + c) = make_float4(v.x * r * g4.x * (rr.x / (1.f + expf(-rr.x))), v.y * r * g4.y * (rr.y / (1.f + expf(-rr.y))), v.z * r * g4.z * (rr.z / (1.f + expf(-rr.z))), v.w * r * g4.w * (rr.w / (1.f + expf(-rr.w))));
  }
}

struct Ws { float *projA, *cn, *sc, *o2, *h, *x1, *x2, *hb, *ys, *projB, *adec, *og, *on, *tok_g, *row_gate; int *idx, *tok_e, *slot_of, *row_tok, *blk_e, *counts; };
}
typedef unsigned short bf16_t;
typedef unsigned v4u __attribute__((ext_vector_type(4)));
typedef unsigned v2u __attribute__((ext_vector_type(2)));
typedef float f32x4 __attribute__((ext_vector_type(4)));
typedef short bf16x8 __attribute__((ext_vector_type(8)));
typedef float f32x2_t __attribute__((ext_vector_type(2))); typedef __bf16 bf16x2_t __attribute__((ext_vector_type(2)));
__device__ __forceinline__ unsigned cvt_pk_bf16(float lo, float hi) { const f32x2_t v = {lo, hi}; const bf16x2_t b = __builtin_convertvector(v, bf16x2_t); return __builtin_bit_cast(unsigned, b); }
__device__ __forceinline__ float bf_lo(unsigned u) { return __uint_as_float(u << 16); }
__device__ __forceinline__ float bf_hi(unsigned u) { return __uint_as_float(u & 0xffff0000u); }
__device__ __forceinline__ float bf2f(bf16_t h) { return __uint_as_float(((unsigned)h) << 16); }

struct TJob { const float* src; int lds_; int K, N; bf16_t* dst; int ldd; int drow0, dcol0; int rowmap; int ntk, ntn; };
__device__ __forceinline__ TJob mk_tjob(const float* src, int lds_, int K, int N, bf16_t* dst, int ldd, int drow0, int dcol0, int rowmap) {
  TJob j; j.src = src; j.lds_ = lds_; j.K = K; j.N = N; j.dst = dst; j.ldd = ldd; j.drow0 = drow0; j.dcol0 = dcol0; j.rowmap = rowmap; j.ntk = K / 64; j.ntn = (N + 127) / 128; return j; }
__device__ __forceinline__ int tjob_tiles(const TJob& j) { return j.ntk * j.ntn; }
__device__ __forceinline__ void transpose_tile(const TJob& j, int tile, int lane) {
  const int kt = tile / j.ntn, nt_ = tile % j.ntn, k0 = kt * 64, n0 = nt_ * 128;
  const int q = lane & 31, par = lane >> 5;
  const bool ok = (n0 + 4 * q) < j.N;
  f32x4 v[32];
  const float* sp = j.src + (size_t)(k0 + par) * j.lds_ + n0 + 4 * q;
#pragma unroll
  for (int i = 0; i < 32; ++i) v[i] = ok ? *(const f32x4*)(sp + (size_t)(2 * i) * j.lds_) : (f32x4){0.f, 0.f, 0.f, 0.f};
  unsigned ra[32], rb[32];
#pragma unroll
  for (int i = 0; i < 32; ++i) {
    auto s0 = __builtin_amdgcn_permlane32_swap(__float_as_uint(v[i][0]), __float_as_uint(v[i][2]), false, false);
    auto s1 = __builtin_amdgcn_permlane32_swap(__float_as_uint(v[i][1]), __float_as_uint(v[i][3]), false, false);
    ra[i] = cvt_pk_bf16(__uint_as_float(s0[0]), __uint_as_float(s0[1]));
    rb[i] = cvt_pk_bf16(__uint_as_float(s1[0]), __uint_as_float(s1[1]));
  }
  if (ok) {
    const int n = n0 + 4 * q + 2 * par;
    int r0 = n, r1 = n + 1;
    if (j.rowmap == 1) { const int jj0 = r0 & 1023, jj1 = r1 & 1023; r0 = 256 * (jj0 >> 7) + ((r0 >> 10) << 7) + (jj0 & 127); r1 = 256 * (jj1 >> 7) + ((r1 >> 10) << 7) + (jj1 & 127); }
    bf16_t* d0 = j.dst + (size_t)(j.drow0 + r0) * j.ldd + j.dcol0 + k0;
    bf16_t* d1 = j.dst + (size_t)(j.drow0 + r1) * j.ldd + j.dcol0 + k0;
#pragma unroll
    for (int c = 0; c < 8; ++c) { *(v4u*)(d0 + 8 * c) = (v4u){ra[4 * c], ra[4 * c + 1], ra[4 * c + 2], ra[4 * c + 3]}; *(v4u*)(d1 + 8 * c) = (v4u){rb[4 * c], rb[4 * c + 1], rb[4 * c + 2], rb[4 * c + 3]}; }
  }
}
__device__ __forceinline__ void transpose_job(const TJob j, int& w0, int gw, int NGW, int lane) {
  const int nt_ = tjob_tiles(j);
  int first = gw - (w0 % NGW); if (first < 0) first += NGW;
#pragma unroll 1
  for (int t = first; t < nt_; t += NGW) transpose_tile(j, t, lane);
  w0 += nt_;
}
__device__ __forceinline__ void zero_rect(bf16_t* dst, int ldd, int r0, int nr, int cb0, int nbytes, int gtid, int NGT) {
  const int per = nbytes / 16;
  for (int i = gtid; i < nr * per; i += NGT) { const int r = i / per, c = i % per; *(v4u*)((char*)(dst + (size_t)(r0 + r) * ldd) + cb0 + 16 * c) = (v4u){0u, 0u, 0u, 0u}; }
}
__device__ __forceinline__ void cvt_f32_to_bf16(const float* src, int lds_, bf16_t* dst, int ldd, int rows, int ncols, int gtid, int NGT) {
  const int per = ncols / 4;
  for (size_t i = gtid; i < (size_t)rows * per; i += NGT) { const size_t r = i / per; const int c = (int)(i % per) * 4; const f32x4 v = *(const f32x4*)(src + r * lds_ + c);
    *(v2u*)(dst + r * ldd + c) = (v2u){cvt_pk_bf16(v[0], v[1]), cvt_pk_bf16(v[2], v[3])}; }
}
__device__ __forceinline__ void cvt_bf16_to_f32(const bf16_t* src, int lds_, float* dst, int ldd, int rows, int ncols, int gtid, int NGT) {
  const int per = ncols / 4;
  for (size_t i = gtid; i < (size_t)rows * per; i += NGT) { const size_t r = i / per; const int c = (int)(i % per) * 4; const v2u v = *(const v2u*)(src + r * lds_ + c);
    *(f32x4*)(dst + r * ldd + c) = (f32x4){bf_lo(v[0]), bf_hi(v[0]), bf_lo(v[1]), bf_hi(v[1])}; }
}

namespace pg8 {
#define PG8_LAS __attribute__((address_space(3)))
typedef unsigned u32x4 __attribute__((ext_vector_type(4)));
constexpr int BM = 256, BK = 64, HALF = 128, HTB = HALF * BK * 2, STAGE_BYTES = 8 * HTB, NXCD = 8, WGM = 8;
__host__ __device__ __forceinline__ int lds_byte(int r, int c) { const int st = (r >> 4) * 2 + (c >> 5), rr = r & 15, cc = c & 31, ob = rr * 64 + cc * 2; return st * 1024 + (ob ^ (((ob >> 9) & 1) << 5)); }
__host__ __device__ __forceinline__ void stage_rc(int b, int& R, int& C) { const int st = b / 1024, sb = b % 1024, swz = sb ^ (((sb >> 9) & 1) << 5); R = (st >> 1) * 16 + swz / 64; C = (st & 1) * 32 + (swz % 64) / 2; }
__host__ __device__ __forceinline__ int perm32(int rho) { const int n = rho >> 4, i = rho & 15; return 8 * (i >> 2) + 4 * n + (i & 3); }
struct Unit { const char* pa; const char* pb; int orow, ocol, e; };
struct Gemm { int lda, ldb, K; };
struct StaticOrder {
    static constexpr bool GATHER = false; const int* rowmap;
    const char* A; const char* Bt; size_t ta, tb; int nM, nN, nwg, G, c;
    __device__ void init(const void* A_, int lda, const void* Bt_, int ldb, int M, int N, int G_, int c_) { A = (const char*)A_; Bt = (const char*)Bt_; ta = (size_t)BM * lda * 2; tb = (size_t)BM * ldb * 2; nM = M / BM; nN = N / BM; nwg = nM * nN; G = G_; c = c_; }
    __device__ bool tile(int i, int& pm, int& pn) const {
        const long L = (long)i * G + c; if (L >= nwg) return false;
        int wgid = (int)L; { const int q = nwg / NXCD, r = nwg % NXCD, xcd = wgid % NXCD, off = wgid / NXCD; wgid = (xcd < r ? xcd * (q + 1) : r * (q + 1) + (xcd - r) * q) + off; }
        const int nig = WGM * nN, gid = wgid / nig, fm = gid * WGM, gsz = (nM - fm) < WGM ? (nM - fm) : WGM;
        pm = fm + ((wgid % nig) % gsz); pn = (wgid % nig) / gsz; return true;
    }
    __device__ bool next(int i, Unit& u) const { int pm, pn; if (!tile(i, pm, pn)) return false; u.pa = A + (size_t)pm * ta; u.pb = Bt + (size_t)pn * tb; u.orow = pm * BM; u.ocol = pn * BM; u.e = 0; return true; }
    __device__ __forceinline__ void a_ready(const Unit&) const {}
    __device__ __forceinline__ void done(const Unit&) const {}
};
struct EpiStore {
    static constexpr bool PERM = true, AFTER_DRAIN = false;
    bf16_t* O; int ldc;
    __device__ __forceinline__ void operator()(const f32x4 (&acc)[2][2][4][2], const Unit& u, int wr, int wc, int fr, int fq) const {
        const int row0 = u.orow + wr * 64 + fr, col0 = u.ocol + wc * 32 + 8 * fq;
#pragma unroll
        for (int ai = 0; ai < 2; ++ai)
#pragma unroll
            for (int m = 0; m < 4; ++m) { bf16_t* rowp = O + (size_t)(row0 + ai * HALF + m * 16) * ldc + col0;
#pragma unroll
                for (int bj = 0; bj < 2; ++bj) { const f32x4 v0 = acc[ai][bj][m][0], v1 = acc[ai][bj][m][1];
                    u32x4 w; w.x = cvt_pk_bf16(v0[0], v0[1]); w.y = cvt_pk_bf16(v0[2], v0[3]); w.z = cvt_pk_bf16(v1[0], v1[1]); w.w = cvt_pk_bf16(v1[2], v1[3]);
                    *(u32x4*)(rowp + bj * HALF) = w; } }
    }
};
template <class Epi, class Sched, bool ALIGN_EPI = false, bool SP2 = false>
__device__ __forceinline__ void gemm_phase(PG8_LAS unsigned char* lds, const Gemm g, const Sched& S, const Epi& E) {
    const int tid = TIDX(), wid = __builtin_amdgcn_readfirstlane(tid >> 6), lane = tid & 63, wr = wid >> 2, wc = wid & 3, fr = lane & 15, fq = lane >> 4;
    const int K = g.K, nt = K / BK;
    unsigned voffA[2], voffB[2];
#pragma unroll
    for (int i = 0; i < 2; ++i) { int R, C; stage_rc(tid * 16 + i * 8192, R, C); const int Rb = Epi::PERM ? ((R & ~31) + perm32(R & 31)) : R;
        voffA[i] = (unsigned)(R * g.lda + C) * 2u; voffB[i] = (unsigned)(Rb * g.ldb + C) * 2u; }
    unsigned voffG[2][2][2]; int gR[2], gC[2];
#pragma unroll
    for (int i = 0; i < 2; ++i) { int R, C; stage_rc(tid * 16 + i * 8192, R, C); gR[i] = R; gC[i] = C; }
#define PG8_GOFF(dst, orow_) do { if constexpr (Sched::GATHER) { _Pragma("unroll") for (int _h = 0; _h < 2; ++_h) _Pragma("unroll") for (int _i = 0; _i < 2; ++_i) \
        dst[_h][_i] = (unsigned)S.rowmap[(orow_) + _h * HALF + gR[_i]] * (unsigned)(g.lda * 2) + (unsigned)gC[_i] * 2u; } } while (0)
#define PG8_STAGE_A(bufoff, gptr, half, vsel) do { if constexpr (Sched::GATHER) { PG8_STAGE(bufoff, gptr, vsel); } else { PG8_STAGE(bufoff, (gptr) + (half) * hstepA, voffA); } } while (0)
    const size_t kstep = (size_t)(BK * 2);
    const size_t hstepA = (size_t)HALF * g.lda * 2, hstepB = (size_t)HALF * g.ldb * 2;
    const unsigned ldsw = (unsigned)wid * 1024u;
    const int aoff = lds_byte(wr * 64 + fr, fq * 8), boff = lds_byte(wc * 32 + fr, fq * 8);
#define PG8_SA(b, h) (((b) * 2 + (h)) * HTB)
#define PG8_SB(b, h) ((4 + (b) * 2 + (h)) * HTB)
#define PG8_STAGE(bufoff, gbase, voff) do { _Pragma("unroll") for (int _i = 0; _i < 2; ++_i) \
        __builtin_amdgcn_global_load_lds((const unsigned*)((const char*)(gbase) + (voff)[_i]), (PG8_LAS unsigned*)(lds + (bufoff) + ldsw + _i * 8192), 16, 0, 0); } while (0)
#define PG8_LDA(dst, b, h) do { _Pragma("unroll") for (int m = 0; m < 4; ++m) _Pragma("unroll") for (int k = 0; k < 2; ++k) dst[m][k] = *(const PG8_LAS bf16x8*)(lds + PG8_SA(b, h) + aoff + m * 2048 + k * 1024); } while (0)
#define PG8_LDB(dst, b, h) do { _Pragma("unroll") for (int n = 0; n < 2; ++n) _Pragma("unroll") for (int k = 0; k < 2; ++k) dst[n][k] = *(const PG8_LAS bf16x8*)(lds + PG8_SB(b, h) + boff + n * 2048 + k * 1024); } while (0)
#define PG8_MMA(ai, bj, At, Bt) do { __builtin_amdgcn_s_setprio(1); _Pragma("unroll") for (int m = 0; m < 4; ++m) _Pragma("unroll") for (int n = 0; n < 2; ++n) _Pragma("unroll") for (int k = 0; k < 2; ++k) \
        acc[ai][bj][m][n] = __builtin_amdgcn_mfma_f32_16x16x32_bf16(Bt[n][k], At[m][k], acc[ai][bj][m][n], 0, 0, 0); __builtin_amdgcn_s_setprio(0); } while (0)
#define PG8_WAIT_V(n) asm volatile("s_waitcnt vmcnt(" #n ")" ::: "memory")
#define PG8_WAIT_L(n) asm volatile("s_waitcnt lgkmcnt(" #n ")" ::: "memory")
#define PG8_BAR __builtin_amdgcn_s_barrier()
#define PG8_SCHED __builtin_amdgcn_sched_barrier(0)
    Unit cur, nxt; int ui = 0;
    if (!S.next(0, cur)) return;
    f32x4 acc[2][2][4][2];
#pragma unroll
    for (int a = 0; a < 2; ++a)
#pragma unroll
        for (int b = 0; b < 2; ++b)
#pragma unroll
            for (int m = 0; m < 4; ++m)
#pragma unroll
                for (int n = 0; n < 2; ++n) acc[a][b][m][n] = (f32x4){0.f, 0.f, 0.f, 0.f};
    bf16x8 At[4][2], B0[2][2], B1[2][2];
    const char* cA = cur.pa; const char* cB = cur.pb;
    S.a_ready(cur);
    PG8_GOFF(voffG[0], cur.orow);
    if constexpr (SP2) {
        PG8_STAGE(PG8_SB(0, 0), cB, voffB); PG8_STAGE(PG8_SB(0, 1), cB + hstepB, voffB); PG8_STAGE_A(PG8_SA(0, 0), cA, 0, voffG[0][0]); PG8_STAGE_A(PG8_SA(0, 1), cA, 1, voffG[0][1]);
        if (wr == 1) PG8_BAR;
        PG8_WAIT_V(2); PG8_BAR;
        PG8_STAGE(PG8_SB(1, 0), cB + kstep, voffB); PG8_STAGE_A(PG8_SA(1, 0), cA + kstep, 0, voffG[0][0]); PG8_STAGE(PG8_SB(1, 1), cB + hstepB + kstep, voffB);
        PG8_WAIT_V(6); PG8_BAR;
    } else {
        PG8_STAGE(PG8_SB(0, 0), cB, voffB); PG8_STAGE_A(PG8_SA(0, 0), cA, 0, voffG[0][0]); PG8_STAGE(PG8_SB(0, 1), cB + hstepB, voffB); PG8_STAGE_A(PG8_SA(0, 1), cA, 1, voffG[0][1]);
        if (wr == 1) PG8_BAR;
        PG8_WAIT_V(4); PG8_BAR;
        PG8_STAGE(PG8_SB(1, 0), cB + kstep, voffB); PG8_STAGE_A(PG8_SA(1, 0), cA + kstep, 0, voffG[0][0]); PG8_STAGE(PG8_SB(1, 1), cB + hstepB + kstep, voffB);
        PG8_WAIT_V(6); PG8_BAR;
    }
    for (;;) {
        const bool has_next = S.next(ui + 1, nxt);
        if constexpr (Sched::GATHER) { if (has_next) { PG8_GOFF(voffG[1], nxt.orow); } else {
#pragma unroll
            for (int _h = 0; _h < 2; ++_h)
#pragma unroll
                for (int _i = 0; _i < 2; ++_i) voffG[1][_h][_i] = voffG[0][_h][_i]; } }
        const char* nA = has_next ? nxt.pa : cA; const char* nB = has_next ? nxt.pb : cB;
        for (int t = 0; t < nt; t += 2) {
            const bool last = (t == nt - 2);
            const char* a1 = cA + (size_t)(t + 1) * kstep;
            const char* a2 = last ? nA : cA + (size_t)(t + 2) * kstep; const char* b2 = last ? nB : cB + (size_t)(t + 2) * kstep;
            const char* a3 = a2 + kstep; const char* b3 = b2 + kstep;
            unsigned vs0[2], vs1[2];
#pragma unroll
            for (int _i = 0; _i < 2; ++_i) { vs0[_i] = last ? voffG[1][0][_i] : voffG[0][0][_i]; vs1[_i] = last ? voffG[1][1][_i] : voffG[0][1][_i]; }
            if (last && has_next) S.a_ready(nxt);
            if constexpr (SP2) {
            PG8_LDB(B0, 0, 0); PG8_LDB(B1, 0, 1); PG8_SCHED; PG8_LDA(At, 0, 0); PG8_STAGE_A(PG8_SA(1, 1), a1, 1, voffG[0][1]);
            PG8_WAIT_V(8); PG8_WAIT_L(0); PG8_BAR; PG8_MMA(0, 0, At, B0); PG8_MMA(0, 1, At, B1); PG8_BAR; PG8_SCHED;
            PG8_LDA(At, 0, 1); PG8_STAGE(PG8_SB(0, 0), b2, voffB); PG8_STAGE(PG8_SB(0, 1), b2 + hstepB, voffB); PG8_STAGE_A(PG8_SA(0, 0), a2, 0, vs0);
            PG8_WAIT_V(8); PG8_WAIT_L(0); PG8_BAR; PG8_MMA(1, 0, At, B0); PG8_MMA(1, 1, At, B1); PG8_BAR; PG8_SCHED;
            PG8_LDB(B0, 1, 0); PG8_LDB(B1, 1, 1); PG8_SCHED; PG8_LDA(At, 1, 0); PG8_STAGE_A(PG8_SA(0, 1), a2, 1, vs1);
            PG8_WAIT_V(8); PG8_WAIT_L(0); PG8_BAR; PG8_MMA(0, 0, At, B0); PG8_MMA(0, 1, At, B1); PG8_BAR; PG8_SCHED;
            PG8_LDA(At, 1, 1); PG8_STAGE(PG8_SB(1, 0), b3, voffB); PG8_STAGE(PG8_SB(1, 1), b3 + hstepB, voffB); PG8_STAGE_A(PG8_SA(1, 0), a3, 0, vs0);
            PG8_WAIT_V(8); PG8_WAIT_L(0); PG8_BAR; PG8_MMA(1, 0, At, B0); PG8_MMA(1, 1, At, B1); PG8_BAR; PG8_SCHED;
            } else {
            PG8_LDB(B0, 0, 0); PG8_SCHED; PG8_LDA(At, 0, 0); PG8_STAGE_A(PG8_SA(1, 1), a1, 1, voffG[0][1]);
            PG8_WAIT_L(8); PG8_BAR; PG8_WAIT_L(0); PG8_MMA(0, 0, At, B0); PG8_BAR; PG8_SCHED;
            PG8_LDB(B1, 0, 1); PG8_STAGE(PG8_SB(0, 0), b2, voffB);
            PG8_BAR; PG8_WAIT_L(0); PG8_MMA(0, 1, At, B1); PG8_BAR;
            PG8_LDA(At, 0, 1); PG8_STAGE_A(PG8_SA(0, 0), a2, 0, vs0);
            PG8_BAR; PG8_WAIT_L(0); PG8_MMA(1, 0, At, B0); PG8_BAR; PG8_SCHED;
            PG8_STAGE(PG8_SB(0, 1), b2 + hstepB, voffB);
            PG8_WAIT_V(6); PG8_BAR; PG8_MMA(1, 1, At, B1); PG8_BAR;
            PG8_LDB(B0, 1, 0); PG8_SCHED; PG8_LDA(At, 1, 0); PG8_STAGE_A(PG8_SA(0, 1), a2, 1, vs1);
            PG8_WAIT_L(8); PG8_BAR; PG8_WAIT_L(0); PG8_MMA(0, 0, At, B0); PG8_BAR; PG8_SCHED;
            PG8_LDB(B1, 1, 1); PG8_STAGE(PG8_SB(1, 0), b3, voffB);
            PG8_BAR; PG8_WAIT_L(0); PG8_MMA(0, 1, At, B1); PG8_BAR;
            PG8_LDA(At, 1, 1); PG8_STAGE_A(PG8_SA(1, 0), a3, 0, vs0);
            PG8_BAR; PG8_WAIT_L(0); PG8_MMA(1, 0, At, B0); PG8_BAR; PG8_SCHED;
            PG8_STAGE(PG8_SB(1, 1), b3 + hstepB, voffB);
            PG8_WAIT_V(6); PG8_BAR; PG8_MMA(1, 1, At, B1); PG8_BAR;
            }
        }
        if constexpr (ALIGN_EPI) { if (wr == 0) PG8_BAR; }
        if constexpr (!Epi::AFTER_DRAIN) { E(acc, cur, wr, wc, fr, fq); S.done(cur); }
        if (!has_next) break;
#pragma unroll
        for (int a = 0; a < 2; ++a)
#pragma unroll
            for (int b = 0; b < 2; ++b)
#pragma unroll
                for (int m = 0; m < 4; ++m)
#pragma unroll
                    for (int n = 0; n < 2; ++n) acc[a][b][m][n] = (f32x4){0.f, 0.f, 0.f, 0.f};
        cur = nxt; cA = nA; cB = nB; ++ui;
        if constexpr (Sched::GATHER) {
#pragma unroll
            for (int _h = 0; _h < 2; ++_h)
#pragma unroll
                for (int _i = 0; _i < 2; ++_i) voffG[0][_h][_i] = voffG[1][_h][_i]; }
        if constexpr (ALIGN_EPI) { if (wr == 1) PG8_BAR; }
    }
    PG8_WAIT_V(0);
    if constexpr (!ALIGN_EPI) { if (wr == 0) PG8_BAR; }
    PG8_BAR;
    if constexpr (Epi::AFTER_DRAIN) { E.fused(acc, cur, wr, wc, fr, fq, lds, wid, lane); S.done(cur); }
#undef PG8_SA
#undef PG8_SB
#undef PG8_STAGE
#undef PG8_STAGE_A
#undef PG8_GOFF
#undef PG8_LDA
#undef PG8_LDB
#undef PG8_MMA
#undef PG8_WAIT_V
#undef PG8_WAIT_L
#undef PG8_BAR
#undef PG8_SCHED
}

}
#define WSYNC2() asm volatile("s_waitcnt lgkmcnt(0)" ::: "memory")
struct MoeBufs { int* tok_e; float* tok_g; int* slot_of; float* slot_gate; int* blk_e; int* blkcnt; int* nblk; int* slot_tok; };
constexpr int WRT_LD = 1028;

template <bool XB> __device__ __forceinline__ void ph_ln_router(const void* xin_, const bf16_t* hb, const float* g, const float* bb, const float* wr, const float* br, bf16_t* x1b, const MoeBufs m, float* lds) {
  const float* xin = (const float*)xin_; const bf16_t* xinb = (const bf16_t*)xin_;
  for (int i = BIDX() * NTHR + TIDX(); i < PMAX; i += (int)gridDim.x * NTHR) m.slot_tok[i] = 0;
  const int tid = TIDX(), lane = tid & 63, wave = tid >> 6, blk = BIDX();
  float* wT = lds;
  float* lg = lds + 32 * WRT_LD + wave * 64;
  int* cnt = (int*)(lds + 32 * WRT_LD + 8 * 64);
  { f32x4 wv[16];
#pragma unroll
    for (int k = 0; k < 16; ++k) wv[k] = *(const f32x4*)(wr + (size_t)(tid + NTHR * k) * 4);
#pragma unroll
    for (int k = 0; k < 16; ++k) { const int i = (tid + NTHR * k) * 4, d = i >> 5, e = i & 31;
#pragma unroll
      for (int z = 0; z < 4; ++z) wT[(e + z) * WRT_LD + d] = wv[k][z]; } }
  if (tid < 32) cnt[tid] = 0;
  __syncthreads();
#pragma unroll 1
  for (int it = 0; it < 8; it += 2) {
    const int tok0 = blk * 64 + wave * 8 + it;
    f32x4 v[2][4]; float s[2] = {0.f, 0.f};
#pragma unroll
    for (int q = 0; q < 2; ++q)
#pragma unroll
      for (int j = 0; j < 4; ++j) { const int c = lane * 4 + 256 * j; f32x4 a;
        if (XB) { const v2u xv = *(const v2u*)(xinb + (size_t)(tok0 + q) * D + c); a = (f32x4){bf_lo(xv[0]), bf_hi(xv[0]), bf_lo(xv[1]), bf_hi(xv[1])}; } else a = *(const f32x4*)(xin + (size_t)(tok0 + q) * D + c);
        const v2u hh = *(const v2u*)(hb + (size_t)(tok0 + q) * D + c);
        v[q][j] = (f32x4){ALPHA * a[0] + bf_lo(hh[0]), ALPHA * a[1] + bf_hi(hh[0]), ALPHA * a[2] + bf_lo(hh[1]), ALPHA * a[3] + bf_hi(hh[1])}; s[q] += (v[q][j][0] + v[q][j][1]) + (v[q][j][2] + v[q][j][3]); }
#pragma unroll
    for (int o = 1; o < 64; o <<= 1) { s[0] += __shfl_xor(s[0], o); s[1] += __shfl_xor(s[1], o); }
    float qq[2] = {0.f, 0.f};
#pragma unroll
    for (int q = 0; q < 2; ++q) { const float mu = s[q] * (1.f / D);
#pragma unroll
      for (int j = 0; j < 4; ++j) { v[q][j] = v[q][j] - mu; qq[q] += (v[q][j][0] * v[q][j][0] + v[q][j][1] * v[q][j][1]) + (v[q][j][2] * v[q][j][2] + v[q][j][3] * v[q][j][3]); } }
#pragma unroll
    for (int o = 1; o < 64; o <<= 1) { qq[0] += __shfl_xor(qq[0], o); qq[1] += __shfl_xor(qq[1], o); }
#pragma unroll
    for (int q = 0; q < 2; ++q) { const float r = rsqrtf(qq[q] * (1.f / D) + 1e-5f);
#pragma unroll
      for (int j = 0; j < 4; ++j) { const int c = lane * 4 + 256 * j; const f32x4 g4 = *(const f32x4*)(g + c), b4 = *(const f32x4*)(bb + c); v[q][j] = v[q][j] * r * g4 + b4; *(v2u*)(x1b + (size_t)(tok0 + q) * D + c) = (v2u){cvt_pk_bf16(v[q][j][0], v[q][j][1]), cvt_pk_bf16(v[q][j][2], v[q][j][3])}; } }
    float p[2][32];
#pragma unroll
    for (int e = 0; e < 32; ++e) { float a0 = 0.f, a1 = 0.f;
#pragma unroll
      for (int j = 0; j < 4; ++j) { const f32x4 w4 = *(const f32x4*)(wT + e * WRT_LD + lane * 4 + 256 * j);
        a0 = fmaf(v[0][j][0], w4[0], a0); a0 = fmaf(v[0][j][1], w4[1], a0); a0 = fmaf(v[0][j][2], w4[2], a0); a0 = fmaf(v[0][j][3], w4[3], a0);
        a1 = fmaf(v[1][j][0], w4[0], a1); a1 = fmaf(v[1][j][1], w4[1], a1); a1 = fmaf(v[1][j][2], w4[2], a1); a1 = fmaf(v[1][j][3], w4[3], a1); }
      p[0][e] = a0; p[1][e] = a1; }
#pragma unroll
    for (int i = 0; i < 16; ++i) { const bool hi = (lane & 32) != 0;
#pragma unroll
      for (int q = 0; q < 2; ++q) { const float send = hi ? p[q][i] : p[q][i + 16]; const float keep = hi ? p[q][i + 16] : p[q][i]; p[q][i] = keep + __shfl_xor(send, 32); } }
#pragma unroll
    for (int i = 0; i < 8; ++i) { const bool hi = (lane & 16) != 0;
#pragma unroll
      for (int q = 0; q < 2; ++q) { const float send = hi ? p[q][i] : p[q][i + 8]; const float keep = hi ? p[q][i + 8] : p[q][i]; p[q][i] = keep + __shfl_xor(send, 16); } }
#pragma unroll
    for (int i = 0; i < 4; ++i) { const bool hi = (lane & 8) != 0;
#pragma unroll
      for (int q = 0; q < 2; ++q) { const float send = hi ? p[q][i] : p[q][i + 4]; const float keep = hi ? p[q][i + 4] : p[q][i]; p[q][i] = keep + __shfl_xor(send, 8); } }
#pragma unroll
    for (int i = 0; i < 2; ++i) { const bool hi = (lane & 4) != 0;
#pragma unroll
      for (int q = 0; q < 2; ++q) { const float send = hi ? p[q][i] : p[q][i + 2]; const float keep = hi ? p[q][i + 2] : p[q][i]; p[q][i] = keep + __shfl_xor(send, 4); } }
#pragma unroll
    for (int q = 0; q < 2; ++q) { const bool hi = (lane & 2) != 0; const float send = hi ? p[q][0] : p[q][1]; const float keep = hi ? p[q][1] : p[q][0]; p[q][0] = keep + __shfl_xor(send, 2); }
    p[0][0] += __shfl_xor(p[0][0], 1); p[1][0] += __shfl_xor(p[1][0], 1);
    const int e_l = ((lane >> 5) & 1) * 16 + ((lane >> 4) & 1) * 8 + ((lane >> 3) & 1) * 4 + ((lane >> 2) & 1) * 2 + ((lane >> 1) & 1);
    const float brl = br[e_l];
    float lv[2] = {p[0][0] + brl, p[1][0] + brl}; int ei[2][4]; float ev[2][4];
#pragma unroll
    for (int k = 0; k < 4; ++k) { float bv[2] = {lv[0], lv[1]}; int bi[2] = {e_l, e_l};
#pragma unroll
      for (int o = 2; o < 64; o <<= 1)
#pragma unroll
        for (int q = 0; q < 2; ++q) { const float ov = __shfl_xor(bv[q], o); const int oi = __shfl_xor(bi[q], o); const bool take = (ov > bv[q]) || (ov == bv[q] && oi < bi[q]); bv[q] = take ? ov : bv[q]; bi[q] = take ? oi : bi[q]; }
#pragma unroll
      for (int q = 0; q < 2; ++q) { ei[q][k] = bi[q]; ev[q][k] = bv[q]; if (e_l == bi[q]) lv[q] = -INFINITY; } }
    if (lane < 2) { const int q = lane;
      float ex[4], su = 0.f;
#pragma unroll
      for (int k = 0; k < 4; ++k) { ex[k] = __expf((q ? ev[1][k] : ev[0][k]) - (q ? ev[1][0] : ev[0][0])); su += ex[k]; }
      const float inv = 1.f / su; const int tok = tok0 + q;
      const int e0 = q ? ei[1][0] : ei[0][0], e1 = q ? ei[1][1] : ei[0][1], e2 = q ? ei[1][2] : ei[0][2], e3 = q ? ei[1][3] : ei[0][3];
      *(int4*)(m.tok_e + tok * 4) = make_int4(e0, e1, e2, e3);
      *(float4*)(m.tok_g + tok * 4) = make_float4(ex[0] * inv, ex[1] * inv, ex[2] * inv, ex[3] * inv);
      atomicAdd(&cnt[e0], 1); atomicAdd(&cnt[e1], 1); atomicAdd(&cnt[e2], 1); atomicAdd(&cnt[e3], 1); }
  }
  __syncthreads();
  if (tid < 32) m.blkcnt[blk * 32 + tid] = cnt[tid];
  __syncthreads();
}

__device__ __forceinline__ void ph_moe_scatter(const MoeBufs m, int* ilds) {
  const int tid = TIDX(), lane = tid & 63, wave = tid >> 6, blk = BIDX(); (void)lane;
  int* tot = ilds; int* bef = ilds + 32; int* pst = ilds + 64; int* es = ilds + 128; int* rk = ilds + 384; int* sl = ilds + 640; int* part = ilds + 896; int* wcnt = ilds + 1408;
  { const int e = tid & 31, pa = tid >> 5; int sum = 0;
#pragma unroll
    for (int q = 0; q < 16; ++q) sum += m.blkcnt[(pa * 16 + q) * 32 + e];
    part[pa * 32 + e] = sum; }
  if (tid < 256) es[tid] = m.tok_e[blk * 256 + tid];
  __syncthreads();
  if (tid < 32) { const int e = tid; int t_ = 0, b_ = 0; const int pb_ = blk >> 4;
    for (int q = 0; q < 16; ++q) { const int v = part[q * 32 + e]; t_ += v; if (q < pb_) b_ += v; }
    for (int q = pb_ * 16; q < blk; ++q) b_ += m.blkcnt[q * 32 + e];
    tot[e] = t_; bef[e] = b_; }
  if (tid < 256) { const int e = es[tid]; const unsigned long long lt = (1ull << lane) - 1ull; int r = 0;
    for (int ee = 0; ee < 32; ++ee) { const unsigned long long mk = __ballot(e == ee); if (e == ee) r = __builtin_popcountll(mk & lt); if (lane == ee) wcnt[wave * 32 + ee] = __builtin_popcountll(mk); }
    rk[tid] = r; }
  __syncthreads();
  if (tid == 0) { int acc = 0; for (int e = 0; e < 32; ++e) { pst[e] = acc; acc += ((tot[e] + 255) >> 8) << 8; } pst[32] = acc;
    if (blk == 0) { *m.nblk = acc >> 8; for (int e = 0; e < 32; ++e) for (int q = pst[e] >> 8; q < (pst[e + 1] >> 8); ++q) m.blk_e[q] = e; } }
  __syncthreads();
  if (tid < 256) { const int e = es[tid]; int rank = rk[tid]; for (int w2 = 0; w2 < wave; ++w2) rank += wcnt[w2 * 32 + e];
    const int slot = pst[e] + bef[e] + rank; m.slot_of[blk * 256 + tid] = slot; m.slot_gate[slot] = m.tok_g[blk * 256 + tid]; m.slot_tok[slot] = blk * 64 + (tid >> 2); }
  __syncthreads();
  __syncthreads();
}

__device__ __forceinline__ void ph_combine_ln(const bf16_t* x1b, const bf16_t* Ys, const int* slot_of, const float* g, const float* bb, float* out, bf16_t* outb) {
  const int tid = TIDX(), lane = tid & 63, gw = BIDX() * 8 + (tid >> 6), NGW = (int)gridDim.x * 8;
  for (int row = gw; row < NT; row += NGW) {
    const int4 s4 = *(const int4*)(slot_of + row * 4); const int sl[4] = {s4.x, s4.y, s4.z, s4.w};
    f32x4 v[4]; float s = 0.f;
#pragma unroll
    for (int j = 0; j < 4; ++j) { const int c = lane * 4 + 256 * j; f32x4 f = (f32x4){0.f, 0.f, 0.f, 0.f};
#pragma unroll
      for (int k = 0; k < 4; ++k) { const v2u y = *(const v2u*)(Ys + (size_t)sl[k] * D + c); f += (f32x4){bf_lo(y[0]), bf_hi(y[0]), bf_lo(y[1]), bf_hi(y[1])}; }
      const v2u xv = *(const v2u*)(x1b + (size_t)row * D + c); const f32x4 a = (f32x4){bf_lo(xv[0]), bf_hi(xv[0]), bf_lo(xv[1]), bf_hi(xv[1])}; v[j] = a * ALPHA + f; s += (v[j][0] + v[j][1]) + (v[j][2] + v[j][3]); }
    const float mu = wave_sum(s) * (1.f / D); float q = 0.f;
#pragma unroll
    for (int j = 0; j < 4; ++j) { v[j] = v[j] - mu; q += (v[j][0] * v[j][0] + v[j][1] * v[j][1]) + (v[j][2] * v[j][2] + v[j][3] * v[j][3]); }
    const float r = rsqrtf(wave_sum(q) * (1.f / D) + 1e-5f);
#pragma unroll
    for (int j = 0; j < 4; ++j) { const int c = lane * 4 + 256 * j; const f32x4 g4 = *(const f32x4*)(g + c), b4 = *(const f32x4*)(bb + c); const f32x4 o = v[j] * r * g4 + b4;
      if (out) *(f32x4*)(out + (size_t)row * D + c) = o; if (outb) *(v2u*)(outb + (size_t)row * D + c) = (v2u){cvt_pk_bf16(o[0], o[1]), cvt_pk_bf16(o[2], o[3])}; }
  }
}

namespace pg8 {
template <bool GATHER_> struct MoeOrderT {
    static constexpr bool GATHER = GATHER_; const int* rowmap;
    StaticOrder so; const int* blk_e; const char* W; size_t wexp; int obn;
    __device__ void init(const void* A, int lda, const void* W_, int ldb, size_t wexp_, int nM, int nN, int obn_, const int* blk_e_, int G, int c) { so.init(A, lda, W_, ldb, nM * BM, nN * BM, G, c); blk_e = blk_e_; W = (const char*)W_; wexp = wexp_; obn = obn_; }
    __device__ bool next(int i, Unit& u) const { int pm, pn; if (!so.tile(i, pm, pn)) return false; const int e = __builtin_amdgcn_readfirstlane(blk_e[pm]); u.pa = GATHER_ ? so.A : so.A + (size_t)pm * so.ta; u.pb = W + (size_t)e * wexp + (size_t)pn * so.tb; u.orow = pm * BM; u.ocol = pn * obn; u.e = e; return true; }
    __device__ __forceinline__ void a_ready(const Unit&) const {}
    __device__ __forceinline__ void done(const Unit&) const {}
};
typedef MoeOrderT<false> MoeOrder; typedef MoeOrderT<true> MoeOrderG;
struct EpiSwiglu {
    static constexpr bool PERM = true, AFTER_DRAIN = false;
    bf16_t* O; int ldc; const float* b1;
    __device__ __forceinline__ void operator()(const f32x4 (&acc)[2][2][4][2], const Unit& u, int wr, int wc, int fr, int fq) const {
        const int row0 = u.orow + wr * 64 + fr, cl = wc * 32 + 8 * fq, col0 = u.ocol + cl;
        const float* bg = b1 + (size_t)u.e * 2048 + col0; const float* bu = bg + 1024;
        const f32x4 bg0 = *(const f32x4*)bg, bg1 = *(const f32x4*)(bg + 4), bu0 = *(const f32x4*)bu, bu1 = *(const f32x4*)(bu + 4);
#pragma unroll
        for (int ai = 0; ai < 2; ++ai)
#pragma unroll
            for (int m = 0; m < 4; ++m) {
                f32x4 gv[2] = {acc[ai][0][m][0] + bg0, acc[ai][0][m][1] + bg1}, uv[2] = {acc[ai][1][m][0] + bu0, acc[ai][1][m][1] + bu1}; float o[8];
#pragma unroll
                for (int n = 0; n < 2; ++n)
#pragma unroll
                    for (int i = 0; i < 4; ++i) { const float gg = fminf(gv[n][i], 7.f), uu = fminf(fmaxf(uv[n][i], -7.f), 7.f);
                        const float sg = __builtin_amdgcn_rcpf(1.f + __builtin_amdgcn_exp2f(-1.702f * 1.4426950408889634f * gg)); o[4 * n + i] = (uu + 1.f) * gg * sg; }
                u32x4 w; w.x = cvt_pk_bf16(o[0], o[1]); w.y = cvt_pk_bf16(o[2], o[3]); w.z = cvt_pk_bf16(o[4], o[5]); w.w = cvt_pk_bf16(o[6], o[7]);
                *(u32x4*)(O + (size_t)(row0 + ai * HALF + m * 16) * ldc + col0) = w; asm volatile("" ::: "memory"); }
    }
};
struct EpiMoe2 {
    static constexpr bool PERM = true, AFTER_DRAIN = false;
    bf16_t* O; int ldc; const float* b2; const float* gate;
    __device__ __forceinline__ void operator()(const f32x4 (&acc)[2][2][4][2], const Unit& u, int wr, int wc, int fr, int fq) const {
        const int row0 = u.orow + wr * 64 + fr, col0 = u.ocol + wc * 32 + 8 * fq;
        const float* bp = b2 + (size_t)u.e * 1024 + col0;
#pragma unroll
        for (int bj = 0; bj < 2; ++bj) {
            const f32x4 bv0 = *(const f32x4*)(bp + bj * HALF), bv1 = *(const f32x4*)(bp + bj * HALF + 4);
#pragma unroll
            for (int ai = 0; ai < 2; ++ai)
#pragma unroll
                for (int m = 0; m < 4; ++m) { const int row = row0 + ai * HALF + m * 16; const float gt = gate[row];
                    const f32x4 v0 = (acc[ai][bj][m][0] + bv0) * gt, v1 = (acc[ai][bj][m][1] + bv1) * gt;
                    u32x4 w; w.x = cvt_pk_bf16(v0[0], v0[1]); w.y = cvt_pk_bf16(v0[2], v0[3]); w.z = cvt_pk_bf16(v1[0], v1[1]); w.w = cvt_pk_bf16(v1[2], v1[3]);
                    *(u32x4*)(O + (size_t)row * ldc + col0 + bj * HALF) = w; asm volatile("" ::: "memory"); }
        }
    }
};
}
typedef short v4i16_t __attribute__((ext_vector_type(4)));
__device__ __forceinline__ unsigned f2key_u(float f) { f = f + 0.0f; const unsigned u = __float_as_uint(f); return (u & 0x80000000u) ? ~u : (u | 0x80000000u); }

__device__ __forceinline__ void ph_cnorm_b(const bf16_t* pa, const float* g, bf16_t* cnb) {
  const int tid = TIDX(), lane = tid & 63, gw = BIDX() * 8 + (tid >> 6), NGW = (int)gridDim.x * 8;
  const f32x4 g4 = *(const f32x4*)(g + lane * 4);
  for (int row = gw; row < NT; row += NGW) {
    const v2u v = *(const v2u*)(pa + (size_t)row * 2048 + 1024 + lane * 4);
    const f32x4 f = (f32x4){bf_lo(v[0]), bf_hi(v[0]), bf_lo(v[1]), bf_hi(v[1])};
    const float r = rsqrtf(wave_sum((f[0] * f[0] + f[1] * f[1]) + (f[2] * f[2] + f[3] * f[3])) * (1.f / 256.f) + 1e-6f);
    const f32x4 o = f * r * g4;
    *(v2u*)(cnb + (size_t)row * 256 + lane * 4) = (v2u){cvt_pk_bf16(o[0], o[1]), cvt_pk_bf16(o[2], o[3])};
  }
}

__device__ __forceinline__ int moe_layer_tile(int layer, int j) { return j < 8192 ? layer * 8192 + j : 16384 + layer * 4096 + (j - 8192); }
__device__ __forceinline__ void moe_weight_tile(int T, const float* w1, const float* w2, bf16_t* W1_t, bf16_t* W2_t, int lane) {
  if (T < 16384) { const int le = T >> 8; transpose_tile(mk_tjob(w1 + (size_t)le * D * 2048, 2048, D, 2048, W1_t + (size_t)le * 2048 * D, D, 0, 0, 1), T & 255, lane); }
  else if (T < 24576) { const int t2 = T - 16384, le = t2 >> 7; transpose_tile(mk_tjob(w2 + (size_t)le * D * D, D, D, D, W2_t + (size_t)le * D * D, D, 0, 0, 0), t2 & 127, lane); }
}
typedef _Float16 h16x2_t __attribute__((ext_vector_type(2)));
__device__ __forceinline__ unsigned cvt_pk_f16(float lo, float hi) { const f32x2_t v = {lo, hi}; const h16x2_t h = __builtin_convertvector(v, h16x2_t); return __builtin_bit_cast(unsigned, h); }
__device__ __forceinline__ void ph_iscore(const bf16_t* pa, unsigned short* sc, const float* w1, const float* w2, bf16_t* W1_t, bf16_t* W2_t) {
  const int tid = TIDX(), lane = tid & 63, gw = BIDX() * 8 + (tid >> 6), NGW = (int)gridDim.x * 8;
  const int n16 = lane & 15, g = lane >> 4;
  int wt = gw;
#pragma unroll 1
  for (int u = gw; u < 2 * 4352; u += NGW) {
    const int b = u / 4352, v = u % 4352;
    int a = 0; while (a < 15 && 16 * (a + 1) * (a + 2) <= v) ++a;
    const int rem = v - 16 * a * (a + 1), r = rem / (a + 1), ch = rem % (a + 1);
    const int qg = 32 * a + r, ntile = (ch < a) ? 32 : (r + 1), t0 = qg * 16, kt0 = ch * 32;
    const bf16_t* qrow = pa + (size_t)(b * L + t0 + n16) * 2048;
    bf16x8 qf[8][2]; float w[8];
#pragma unroll
    for (int h = 0; h < 8; ++h) { qf[h][0] = *(const bf16x8*)(qrow + 1280 + h * 64 + 8 * g); qf[h][1] = *(const bf16x8*)(qrow + 1280 + h * 64 + 32 + 8 * g); w[h] = bf2f(qrow[1856 + h]) * (0.35355339059327373f * 0.125f); }
    const bf16_t* kbase = pa + (size_t)(b * L + n16) * 2048 + 1792 + 8 * g;
    unsigned short* srow = sc + (size_t)(b * L + t0 + n16) * L + 4 * g;
    bf16x8 kr[8][2];
    const int ktl = kt0 + ntile - 1;
#pragma unroll
    for (int p = 0; p < 8; ++p) { const int kk = min(kt0 + p, ktl); kr[p][0] = *(const bf16x8*)(kbase + (size_t)kk * 16 * 2048); kr[p][1] = *(const bf16x8*)(kbase + (size_t)kk * 16 * 2048 + 32); }
#pragma unroll 1
    for (int kt8 = kt0; kt8 < kt0 + ntile; kt8 += 8) {
#pragma unroll
      for (int p = 0; p < 8; ++p) {
        const int kt = kt8 + p;
        const bf16x8 k0 = kr[p][0], k1 = kr[p][1];
        { const int kk = min(kt + 8, ktl); kr[p][0] = *(const bf16x8*)(kbase + (size_t)kk * 16 * 2048); kr[p][1] = *(const bf16x8*)(kbase + (size_t)kk * 16 * 2048 + 32); }
        f32x4 score = (f32x4){0.f, 0.f, 0.f, 0.f};
#pragma unroll
        for (int h = 0; h < 8; ++h) {
          f32x4 acc = __builtin_amdgcn_mfma_f32_16x16x32_bf16(k0, qf[h][0], (f32x4){0.f, 0.f, 0.f, 0.f}, 0, 0, 0);
          acc = __builtin_amdgcn_mfma_f32_16x16x32_bf16(k1, qf[h][1], acc, 0, 0, 0);
#pragma unroll
          for (int i = 0; i < 4; ++i) score[i] = fmaf(fmaxf(acc[i], 0.f), w[h], score[i]);
        }
        if (kt <= ktl) *(v2u*)(srow + kt * 16) = (v2u){cvt_pk_f16(score[0], score[1]), cvt_pk_f16(score[2], score[3])};
      }
    }
#pragma unroll 1
    for (int k2 = 0; k2 < 2; ++k2) if (wt < 12288) { int lane_t = lane; asm volatile("" : "+v"(lane_t)); moe_weight_tile(moe_layer_tile(1, wt), w1, w2, W1_t, W2_t, lane_t); wt += NGW; }
  }
#pragma unroll 1
  for (; wt < 12288; wt += NGW) { int lane_t = lane; asm volatile("" : "+v"(lane_t)); moe_weight_tile(moe_layer_tile(1, wt), w1, w2, W1_t, W2_t, lane_t); }
}

constexpr int DW_STRIDE = 17152;
__device__ __forceinline__ unsigned offb(unsigned row, unsigned ch) { return 256u * row + 16u * (ch ^ (((row & 3u) << 2) | ((row >> 2) & 3u))); }
__device__ __forceinline__ void glds16(const void* gsrc, unsigned lds_dst) { unsigned keep;
  asm volatile("s_mov_b32 %0, m0\n\ts_mov_b32 m0, %2\n\ts_nop 0\n\tglobal_load_lds_dwordx4 %1, off\n\ts_mov_b32 m0, %0" : "=&s"(keep) : "v"(gsrc), "s"(lds_dst) : "memory"); }
__device__ __forceinline__ int wave_excl_scan(int v, int lane, int& total) {
  int x = v;
#pragma unroll
  for (int o = 1; o < 64; o <<= 1) { const int y = __shfl_up(x, o); if (lane >= o) x += y; }
  total = __shfl(x, 63); return x - v;
}
#define LDSW() asm volatile("s_waitcnt lgkmcnt(0)" ::: "memory")
__device__ __forceinline__ int wave_incl_scan_dpp(int v, int lane, int& total) {
  int x = v;
  x += __builtin_amdgcn_update_dpp(0, x, 0x111, 0xf, 0xf, true);
  x += __builtin_amdgcn_update_dpp(0, x, 0x112, 0xf, 0xf, true);
  x += __builtin_amdgcn_update_dpp(0, x, 0x114, 0xf, 0xf, true);
  x += __builtin_amdgcn_update_dpp(0, x, 0x118, 0xf, 0xf, true);
  const int t0 = __builtin_amdgcn_readlane(x, 15), t1 = __builtin_amdgcn_readlane(x, 31), t2 = __builtin_amdgcn_readlane(x, 47), t3 = __builtin_amdgcn_readlane(x, 63);
  const int row = lane >> 4;
  x += (row >= 1 ? t0 : 0) + (row >= 2 ? t1 : 0) + (row >= 3 ? t2 : 0);
  total = t0 + t1 + t2 + t3; return x;
}

__device__ __forceinline__ unsigned h2key(unsigned h) { return (h & 0x8000u) ? (~h & 0xFFFFu) : (h | 0x8000u); }
__device__ __forceinline__ int wave_select(const unsigned short* srow, int t, LAS unsigned char* wl, LAS unsigned short* idx16, int lane) {
  const int n = t + 1;
  if (n <= 256) { for (int i = lane; i < 256; i += 64) idx16[i] = (unsigned short)(i < n ? i : 0); LDSW(); return n; }
  LAS unsigned* hist = (LAS unsigned*)wl;
  for (int i = lane; i < 1024; i += 64) ((LAS v4u*)hist)[i] = (v4u){0u, 0u, 0u, 0u};
  unsigned bk[16][4];
#pragma unroll
  for (int i = 0; i < 16; ++i) {
    bk[i][0] = 0u; bk[i][1] = 0u; bk[i][2] = 0u; bk[i][3] = 0u;
    if (i * 512 < n) { const int e0 = (i * 64 + lane) * 8;
      if (e0 < n) { const v4u f = *(const v4u*)(srow + e0);
#pragma unroll
        for (int c = 0; c < 4; ++c) { unsigned lo = f[c] & 0xFFFFu, hi = f[c] >> 16; lo = lo + 0u;
          const unsigned b0 = (e0 + 2 * c <= t) ? (h2key(lo == 0x8000u ? 0u : lo) >> 4) : 0u, b1 = (e0 + 2 * c + 1 <= t) ? (h2key(hi == 0x8000u ? 0u : hi) >> 4) : 0u;
          bk[i][c] = b0 | (b1 << 16); } } }
    if ((i & 7) == 7) asm volatile("" ::: "memory");
  }
#define BIN_OF(i, c) ((bk[i][(c) >> 1] >> (((c) & 1) * 16)) & 0xFFFFu)
  LDSW();
#pragma unroll
  for (int i = 0; i < 16; ++i) if (i * 512 < n) {
#pragma unroll
    for (int c = 0; c < 8; ++c) { const unsigned bin = BIN_OF(i, c); __hip_atomic_fetch_add(hist + bin, 1u, __ATOMIC_RELAXED, __HIP_MEMORY_SCOPE_WORKGROUP); }
    asm volatile("" ::: "memory"); }
  LDSW();
  const int bbase = 4096 - 64 * (lane + 1); int ssum = 0;
#pragma unroll 16
  for (int k = 0; k < 64; ++k) ssum += (int)hist[bbase + ((k + lane) & 63)];
  int tot; const int pre = wave_incl_scan_dpp(ssum, lane, tot) - ssum;
  const unsigned long long bal = __ballot(pre < 256 && pre + ssum >= 256);
  const int Ls = (int)__builtin_ctzll(bal);
  const int cum0 = __builtin_amdgcn_readlane(pre, Ls), sb = 4096 - 64 * (Ls + 1);
  const int ck = (int)hist[sb + 63 - lane]; int t2_; const int inc = wave_incl_scan_dpp(ck, lane, t2_);
  const unsigned long long bal2 = __ballot(cum0 + inc >= 256);
  const int kk = (int)__builtin_ctzll(bal2);
  const int B1 = sb + 63 - kk, cnt_gt = cum0 + __builtin_amdgcn_readlane(inc, kk) - __builtin_amdgcn_readlane(ck, kk), need1 = 256 - cnt_gt;
  LDSW();
  int ngt = 0, neq = 0;
#pragma unroll
  for (int i = 0; i < 16; ++i) if (i * 512 < n) {
#pragma unroll
    for (int c = 0; c < 8; ++c) { const int bin = (int)BIN_OF(i, c); ngt += (bin > B1) ? 1 : 0; neq += (bin == B1) ? 1 : 0; } }
  int tg, te; int pg = wave_incl_scan_dpp(ngt, lane, tg) - ngt; int pe = wave_incl_scan_dpp(neq, lane, te) - neq;
  LAS unsigned short* cand = (LAS unsigned short*)wl;
#pragma unroll
  for (int i = 0; i < 16; ++i) if (i * 512 < n) {
#pragma unroll
    for (int c = 0; c < 8; ++c) { const int bin = (int)BIN_OF(i, c); const int e = (i * 64 + lane) * 8 + c;
      if (bin > B1) { idx16[pg] = (unsigned short)e; ++pg; }
      if (bin == B1) { cand[pe] = (unsigned short)e; ++pe; } }
    asm volatile("" ::: "memory"); }
#undef BIN_OF
  LDSW();
  const int m = te;
  unsigned lo = 0u;
  if (m <= 64) {
    unsigned cpv = 0u; if (lane < m) { const unsigned ci = cand[lane]; unsigned hv = srow[ci]; hv = (hv == 0x8000u) ? 0u : hv; cpv = ((h2key(hv) & 15u) << 13) | (8191u - ci) | (1u << 20); }
    int rank = 0;
    for (int k = 0; k < m; ++k) { const unsigned ok = (unsigned)__builtin_amdgcn_readlane((int)cpv, k); rank += (ok > cpv) ? 1 : 0; }
    const bool sel = (lane < m) && (rank < need1);
    const unsigned long long bs = __ballot(sel);
    if (sel) idx16[cnt_gt + __builtin_popcountll(bs & ((1ull << lane) - 1ull))] = (unsigned short)(8191u - (cpv & 0x1FFFu));
  } else if (m <= 256) {
    unsigned cp[4];
#pragma unroll
    for (int j = 0; j < 4; ++j) { const int q = lane + 64 * j; cp[j] = 0u; if (q < m) { const unsigned ci = cand[q]; unsigned hv = srow[ci]; hv = (hv == 0x8000u) ? 0u : hv; cp[j] = ((h2key(hv) & 15u) << 13) | (8191u - ci) | (1u << 20); } }
    for (int bit = 16; bit >= 0; --bit) { const unsigned trial = lo | (1u << bit); int tc = 0;
#pragma unroll
      for (int j = 0; j < 4; ++j) tc += __builtin_popcountll(__ballot((cp[j] >> 20) && ((cp[j] & 0x1FFFFu) >= trial)));
      if (tc >= need1) lo = trial; }
    int pos = cnt_gt;
#pragma unroll
    for (int j = 0; j < 4; ++j) { const bool sel = (cp[j] >> 20) && ((cp[j] & 0x1FFFFu) >= lo); const unsigned long long bs = __ballot(sel);
      if (sel) idx16[pos + __builtin_popcountll(bs & ((1ull << lane) - 1ull))] = (unsigned short)(8191u - (cp[j] & 0x1FFFu)); pos += __builtin_popcountll(bs); }
  } else {
    for (int bit = 16; bit >= 0; --bit) { const unsigned trial = lo | (1u << bit); int c = 0;
      for (int q = lane; q < m; q += 64) { const unsigned ci = cand[q]; unsigned hv = srow[ci]; hv = (hv == 0x8000u) ? 0u : hv; const unsigned cpq = ((h2key(hv) & 15u) << 13) | (8191u - ci); c += (cpq >= trial) ? 1 : 0; }
      int tc; (void)wave_excl_scan(c, lane, tc); if (tc >= need1) lo = trial; }
    int base = cnt_gt;
    for (int q0 = 0; q0 < m; q0 += 64) { const int q = q0 + lane; bool sel = false; unsigned ci = 0;
      if (q < m) { ci = cand[q]; unsigned hv = srow[ci]; hv = (hv == 0x8000u) ? 0u : hv; const unsigned cpq = ((h2key(hv) & 15u) << 13) | (8191u - ci); sel = cpq >= lo; }
      int tc; const int pos = base + wave_excl_scan(sel ? 1 : 0, lane, tc); if (sel) idx16[pos] = (unsigned short)ci; base += tc; }
  }
  LDSW();
  return 256;
}

__device__ __forceinline__ void wave_attend(int b, int t, int cnt, const bf16_t* qlat, const bf16_t* cnb, LAS unsigned char* wl, LAS unsigned short* idx16, bf16_t* olat, int lane) {
  const int n16 = lane & 15, g = lane >> 4, q4 = (lane & 15) >> 2, p4 = lane & 3;
  const bf16_t* qrow = qlat + (size_t)(b * L + t) * 4096 + n16 * 256 + 8 * g;
  bf16x8 qf[8];
#pragma unroll
  for (int s = 0; s < 8; ++s) qf[s] = *(const bf16x8*)(qrow + 32 * s);
  f32x4 o[16];
#pragma unroll
  for (int c = 0; c < 16; ++c) o[c] = (f32x4){0.f, 0.f, 0.f, 0.f};
  float mrun = -INFINITY, lrun = 0.f;
  const int ntile = (cnt + 31) >> 5;
  const char* cb = (const char*)(cnb + (size_t)b * L * 256);
  const unsigned slot = lane & 15, rsub = lane >> 4;
  constexpr float SC = 0.125f * 1.4426950408889634f;
  v4u stg[16];
#define GATHER_TILE(itn) do { _Pragma("unroll") for (int rg = 0; rg < 8; ++rg) { const unsigned row = 4 * rg + rsub; const unsigned key = idx16[32 * (itn) + row]; \
      const unsigned ch = slot ^ (((row & 3u) << 2) | ((row >> 2) & 3u)); const char* src = cb + (size_t)key * 512 + ch * 16; \
      stg[rg] = *(const v4u*)src; stg[8 + rg] = *(const v4u*)(src + 256); } } while (0)
  GATHER_TILE(0);
#pragma unroll 1
  for (int it = 0; it < ntile; ++it) {
#pragma unroll
    for (int rg = 0; rg < 8; ++rg) { *(LAS v4u*)(wl + rg * 1024 + lane * 16) = stg[rg]; *(LAS v4u*)(wl + 8192 + rg * 1024 + lane * 16) = stg[8 + rg]; }
    LDSW();
    if (it + 1 < ntile) GATHER_TILE(it + 1);
    f32x4 s0 = (f32x4){0.f, 0.f, 0.f, 0.f}, s1 = (f32x4){0.f, 0.f, 0.f, 0.f};
#pragma unroll
    for (int s = 0; s < 8; ++s) { const unsigned ib = (s >> 2) * 8192, chq = 4 * (s & 3) + g;
      const bf16x8 a0 = *(const LAS bf16x8*)(wl + ib + offb(n16, chq)), a1 = *(const LAS bf16x8*)(wl + ib + offb(16 + n16, chq));
      s0 = __builtin_amdgcn_mfma_f32_16x16x32_bf16(a0, qf[s], s0, 0, 0, 0); s1 = __builtin_amdgcn_mfma_f32_16x16x32_bf16(a1, qf[s], s1, 0, 0, 0); }
    const int sl0 = 32 * it + 4 * g;
    float mx = -INFINITY;
#pragma unroll
    for (int r = 0; r < 4; ++r) { s0[r] = (sl0 + r < cnt) ? s0[r] * SC : -INFINITY; s1[r] = (sl0 + 16 + r < cnt) ? s1[r] * SC : -INFINITY; mx = fmaxf(mx, fmaxf(s0[r], s1[r])); }
    mx = fmaxf(mx, __shfl_xor(mx, 16)); mx = fmaxf(mx, __shfl_xor(mx, 32));
    const float mnew = fmaxf(mrun, mx), alpha = __builtin_amdgcn_exp2f(mrun - mnew);
    float ls = 0.f; float pv[8];
#pragma unroll
    for (int r = 0; r < 4; ++r) { pv[r] = __builtin_amdgcn_exp2f(s0[r] - mnew); pv[4 + r] = __builtin_amdgcn_exp2f(s1[r] - mnew); ls += pv[r] + pv[4 + r]; }
    ls += __shfl_xor(ls, 16); ls += __shfl_xor(ls, 32);
    lrun = lrun * alpha + ls; mrun = mnew;
#pragma unroll
    for (int c = 0; c < 16; ++c) o[c] = o[c] * alpha;
    const v4u pbw = (v4u){cvt_pk_bf16(pv[0], pv[1]), cvt_pk_bf16(pv[2], pv[3]), cvt_pk_bf16(pv[4], pv[5]), cvt_pk_bf16(pv[6], pv[7])};
    const bf16x8 pb = __builtin_bit_cast(bf16x8, pbw);
#pragma unroll
    for (int c = 0; c < 16; ++c) { const unsigned ib = (c >> 3) * 8192, chc = 2 * (c & 7) + (p4 >> 1);
      const v4i16_t t0 = __builtin_amdgcn_ds_read_tr16_b64_v4i16((LAS v4i16_t*)(wl + ib + offb(4 * g + q4, chc) + 8 * (p4 & 1)));
      const v4i16_t t1 = __builtin_amdgcn_ds_read_tr16_b64_v4i16((LAS v4i16_t*)(wl + ib + offb(16 + 4 * g + q4, chc) + 8 * (p4 & 1)));
      const bf16x8 af = (bf16x8){t0[0], t0[1], t0[2], t0[3], t1[0], t1[1], t1[2], t1[3]};
      o[c] = __builtin_amdgcn_mfma_f32_16x16x32_bf16(af, pb, o[c], 0, 0, 0); }
    LDSW();
  }
  const float inv = 1.f / lrun;
  bf16_t* orow = olat + (size_t)(b * L + t) * 4096 + n16 * 256 + 4 * g;
#pragma unroll
  for (int c = 0; c < 16; ++c) { const f32x4 v = o[c] * inv; *(v2u*)(orow + 16 * c) = (v2u){cvt_pk_bf16(v[0], v[1]), cvt_pk_bf16(v[2], v[3])}; }
}

__device__ __forceinline__ void ph_select_attend(const unsigned short* sc, const bf16_t* qlat, const bf16_t* cnb, bf16_t* olat, LAS unsigned char* lds, const float* w1, const float* w2, bf16_t* W1_t, bf16_t* W2_t) {
  const int tid = TIDX(), lane = tid & 63, wave = __builtin_amdgcn_readfirstlane(tid >> 6), blk = BIDX();
  LAS unsigned char* wl = lds + wave * DW_STRIDE; LAS unsigned short* idx16 = (LAS unsigned short*)(wl + 16384);
  const int b = blk & 1, wb = (blk >> 1) * 8 + wave, nwb = ((int)gridDim.x >> 1) * 8;
  const int gw = blk * 8 + wave, NGW = (int)gridDim.x * 8; int wt = gw;
#pragma unroll 1
  for (int t = wb, qi = 0; t < L; t += nwb, ++qi) {
    int lane_s = lane; asm volatile("" : "+v"(lane_s));
    const int cnt = wave_select(sc + (size_t)(b * L + t) * L, t, wl, idx16, lane_s);
#if defined(DUPSEL)
    { int lane_s2 = lane; asm volatile("" : "+v"(lane_s2)); const int cnt2 = wave_select(sc + (size_t)(b * L + t) * L, t, wl, idx16, lane_s2); if (cnt2 != cnt) olat[0] = 0; }
#endif
    int lane_a = lane; asm volatile("" : "+v"(lane_a));
    wave_attend(b, t, cnt, qlat, cnb, wl, idx16, olat, lane_a);
#if defined(DUPATT)
    { int lane_a2 = lane; asm volatile("" : "+v"(lane_a2)); wave_attend(b, t, cnt, qlat, cnb, wl, idx16, olat, lane_a2); }
#endif
    const int ntl = (qi < 6) ? 1 : 0;
#pragma unroll 1
    for (int k = 0; k < ntl; ++k) { int lane_t = lane; asm volatile("" : "+v"(lane_t)); if (wt < 12288) moe_weight_tile(moe_layer_tile(0, wt), w1, w2, W1_t, W2_t, lane_t); wt += NGW; }
  }
#pragma unroll 1
  for (; wt < 12288; wt += NGW) { int lane_t = lane; asm volatile("" : "+v"(lane_t)); moe_weight_tile(moe_layer_tile(0, wt), w1, w2, W1_t, W2_t, lane_t); }
}

namespace pg8 {
struct GroupAOrder {
    static constexpr bool GATHER = false; const int* rowmap;
    StaticOrder so; int png; size_t acol_bytes;
    __device__ void init(const void* A, int lda, const void* Bt, int ldb, int M, int N, int png_, size_t acol_bytes_, int G, int c) { so.init(A, lda, Bt, ldb, M, N, G, c); png = png_; acol_bytes = acol_bytes_; }
    __device__ bool next(int i, Unit& u) const { int pm, pn; if (!so.tile(i, pm, pn)) return false; u.pa = so.A + (size_t)pm * so.ta + (size_t)(pn / png) * acol_bytes; u.pb = so.Bt + (size_t)pn * so.tb; u.orow = pm * BM; u.ocol = pn * BM; u.e = 0; return true; }
    __device__ __forceinline__ void a_ready(const Unit&) const {}
    __device__ __forceinline__ void done(const Unit&) const {}
};
}
constexpr int GLA_LDSU = 65536;

__device__ __forceinline__ v4i16_t trrd(LAS unsigned char* p) { return __builtin_amdgcn_ds_read_tr16_b64_v4i16((LAS v4i16_t*)p); }
__device__ __forceinline__ bf16x8 cat44(v4i16_t a, v4i16_t b) { return (bf16x8){a[0], a[1], a[2], a[3], b[0], b[1], b[2], b[3]}; }

__device__ __forceinline__ void ph_gla_a1(const bf16_t* pb, const float* gbias, bf16_t* qt, float* og, float* kvt, float* dcy, LAS unsigned char* lds, const float* w1, const float* w2, bf16_t* W1_t, bf16_t* W2_t) {
  const int tid = TIDX(), lane = tid & 63, wave = __builtin_amdgcn_readfirstlane(tid >> 6), blk = BIDX();
  const int half = wave >> 2, wq = wave & 3;
  LAS unsigned char* X = lds + half * GLA_LDSU; LAS unsigned char* Y = X + 16384; LAS unsigned char* V = X + 32768;
  LAS float* EX = (LAS float*)(lds + 131072 + half * 2048);
  const unsigned v_addr = (unsigned)__builtin_amdgcn_readfirstlane((int)(unsigned)(size_t)V);
  const int n16 = lane & 15, g = lane >> 4, q4 = (lane & 15) >> 2, p4 = lane & 3;
#pragma unroll 1
  for (int uu = 0; uu < 2; ++uu) {
    const int u = blk * 4 + half * 2 + uu;
    const int h = u & 3, bc = u >> 2, r0 = bc * 64;
    { const unsigned slot = lane & 15, rsub = lane >> 4; const int im = wq;
#pragma unroll
      for (int rg = 0; rg < 8; ++rg) { const unsigned row = 4 * rg + rsub; const unsigned ch = slot ^ (((row & 3u) << 2) | ((row >> 2) & 3u));
        const char* src = (const char*)(pb + (size_t)(r0 + 32 * (im >> 1) + row) * 3584 + 1024 + h * 256 + (im & 1) * 128) + ch * 16;
        glds16(src, v_addr + im * 8192 + rg * 1024); } }
    const int d0 = 2 * lane; const float gb0 = gbias[h * 128 + d0], gb1 = gbias[h * 128 + d0 + 1];
    const unsigned wofs = 16u * ((unsigned)(d0 >> 3)), wsub = (unsigned)(d0 & 7) * 2u;
    unsigned gq[16], qq[16], kq[16]; float bl0[16], bl1[16];
#pragma unroll
    for (int jj = 0; jj < 16; ++jj) { const bf16_t* rp = pb + (size_t)(r0 + wq * 16 + jj) * 3584 + h * 128 + d0;
      gq[jj] = *(const unsigned*)(rp + 3072); qq[jj] = *(const unsigned*)rp; kq[jj] = *(const unsigned*)(rp + 512); }
    float bc0 = 0.f, bc1 = 0.f;
#pragma unroll
    for (int jj = 0; jj < 16; ++jj) { const float a0 = bf_lo(gq[jj]) + gb0, a1 = bf_hi(gq[jj]) + gb1;
      bc0 += (fminf(a0, 0.f) - __logf(1.f + __expf(-fabsf(a0)))) * (1.f / 16.f); bc1 += (fminf(a1, 0.f) - __logf(1.f + __expf(-fabsf(a1)))) * (1.f / 16.f);
      bl0[jj] = bc0; bl1[jj] = bc1; }
    *(LAS f32x2_t*)(EX + wq * 128 + d0) = (f32x2_t){bc0, bc1};
    LDSW(); __syncthreads();
    float of0 = 0.f, of1 = 0.f, tt0 = 0.f, tt1 = 0.f;
#pragma unroll
    for (int w2_ = 0; w2_ < 4; ++w2_) { const f32x2_t e = *(const LAS f32x2_t*)(EX + w2_ * 128 + d0); tt0 += e[0]; tt1 += e[1]; if (w2_ < wq) { of0 += e[0]; of1 += e[1]; } }
#pragma unroll
    for (int jj = 0; jj < 16; ++jj) { const int j = wq * 16 + jj; const float b0 = bl0[jj] + of0, b1 = bl1[jj] + of1;
      const float e0 = __expf(b0), e1 = __expf(b1), i0 = __expf(fminf(-b0, 80.f)), i1 = __expf(fminf(-b1, 80.f));
      const unsigned qo = cvt_pk_bf16(bf_lo(qq[jj]) * 0.08838834764831845f * e0, bf_hi(qq[jj]) * 0.08838834764831845f * e1);
      const unsigned ko = cvt_pk_bf16(bf_lo(kq[jj]) * i0, bf_hi(kq[jj]) * i1);
      *(unsigned*)(qt + (size_t)(r0 + j) * 512 + h * 128 + d0) = qo;
      const unsigned row = (unsigned)(j & 31); const unsigned off = (unsigned)(j >> 5) * 8192u + 256u * row + ((wofs ^ (16u * (((row & 3u) << 2) | ((row >> 2) & 3u))))) + wsub;
      *(LAS unsigned*)(X + off) = qo; *(LAS unsigned*)(Y + off) = ko; }
    if (wq == 3) *(float2*)(dcy + (size_t)u * 128 + d0) = make_float2(__expf(tt0), __expf(tt1));
    asm volatile("s_waitcnt vmcnt(0) lgkmcnt(0)" ::: "memory");
    __syncthreads();
    const int it = wq;
    bf16x8 afr[2];
#pragma unroll
    for (int ks = 0; ks < 2; ++ks) {
      unsigned pk[4] = {0u, 0u, 0u, 0u};
#pragma unroll
      for (int jh = 0; jh < 2; ++jh) { const int jt = 2 * ks + jh;
        if (jt <= it) { f32x4 acc = (f32x4){0.f, 0.f, 0.f, 0.f};
#pragma unroll
          for (int s = 0; s < 4; ++s) { const bf16x8 ya = *(const LAS bf16x8*)(Y + (jt >> 1) * 8192 + offb(n16 + 16 * (jt & 1), 4 * s + g)), xb = *(const LAS bf16x8*)(X + (it >> 1) * 8192 + offb(n16 + 16 * (it & 1), 4 * s + g));
            acc = __builtin_amdgcn_mfma_f32_16x16x32_bf16(ya, xb, acc, 0, 0, 0); }
          const int i_ = 16 * it + n16, jbase = 16 * jt + 4 * g;
#pragma unroll
          for (int r = 0; r < 4; ++r) if (jbase + r > i_) acc[r] = 0.f;
          pk[2 * jh] = cvt_pk_bf16(acc[0], acc[1]); pk[2 * jh + 1] = cvt_pk_bf16(acc[2], acc[3]); } }
      afr[ks] = __builtin_bit_cast(bf16x8, (v4u){pk[0], pk[1], pk[2], pk[3]});
    }
    float* ogp = og + (size_t)u * 16384 + (size_t)(it * 16) * 256 + lane * 4; float* kvp = kvt + (size_t)u * 32768 + (size_t)n16 * 128 + 4 * g;
#pragma unroll 2
    for (int nt = 0; nt < 16; ++nt) {
      const unsigned vimg = (unsigned)(nt >> 3) * 8192u, chv = 2u * (unsigned)(nt & 7) + (unsigned)(p4 >> 1), sub = 8u * (unsigned)(p4 & 1);
      f32x4 acc = (f32x4){0.f, 0.f, 0.f, 0.f};
      { LAS unsigned char* vb = V + vimg; const bf16x8 bi0 = cat44(trrd(vb + offb(4 * g + q4, chv) + sub), trrd(vb + offb(16 + 4 * g + q4, chv) + sub));
        acc = __builtin_amdgcn_mfma_f32_16x16x32_bf16(afr[0], bi0, acc, 0, 0, 0); }
      if (it >= 2) { LAS unsigned char* vb = V + 16384 + vimg; const bf16x8 bi1 = cat44(trrd(vb + offb(4 * g + q4, chv) + sub), trrd(vb + offb(16 + 4 * g + q4, chv) + sub));
        acc = __builtin_amdgcn_mfma_f32_16x16x32_bf16(afr[1], bi1, acc, 0, 0, 0); }
      *(f32x4*)(ogp + (size_t)nt * 256) = acc;
    }
#pragma unroll 1
    for (int nq = 0; nq < 4; ++nq) { const int nt = 4 * wq + nq;
      const unsigned vimg = (unsigned)(nt >> 3) * 8192u, chv = 2u * (unsigned)(nt & 7) + (unsigned)(p4 >> 1), sub = 8u * (unsigned)(p4 & 1);
      bf16x8 bn[2];
#pragma unroll
      for (int ks = 0; ks < 2; ++ks) { LAS unsigned char* vb = V + ks * 16384 + vimg; bn[ks] = cat44(trrd(vb + offb(8 * g + q4, chv) + sub), trrd(vb + offb(8 * g + 4 + q4, chv) + sub)); }
#pragma unroll
      for (int mt = 0; mt < 8; ++mt) { const unsigned chy = 2u * (unsigned)mt + (unsigned)(p4 >> 1);
        const bf16x8 a0 = cat44(trrd(Y + offb(8 * g + q4, chy) + sub), trrd(Y + offb(8 * g + 4 + q4, chy) + sub));
        const bf16x8 a1 = cat44(trrd(Y + 8192 + offb(8 * g + q4, chy) + sub), trrd(Y + 8192 + offb(8 * g + 4 + q4, chy) + sub));
        f32x4 acc = __builtin_amdgcn_mfma_f32_16x16x32_bf16(a0, bn[0], (f32x4){0.f, 0.f, 0.f, 0.f}, 0, 0, 0);
        acc = __builtin_amdgcn_mfma_f32_16x16x32_bf16(a1, bn[1], acc, 0, 0, 0);
        *(f32x4*)(kvp + (size_t)(16 * nt) * 128 + 16 * mt) = acc; }
    }
    LDSW(); __syncthreads();
  }
}

__device__ __forceinline__ void ph_gla_a2(const float* kvt, const float* dcy, bf16_t* spt) {
  const int gtid = BIDX() * NTHR + TIDX();
  if (gtid >= 8 * 256 * 32) return;
  const int g4 = gtid & 31, dv = (gtid >> 5) & 255, bh = gtid >> 13, b = bh >> 2, h = bh & 3;
  f32x4 S = (f32x4){0.f, 0.f, 0.f, 0.f};
#pragma unroll 4
  for (int c = 0; c < 128; ++c) { const size_t u = (size_t)((b * 128 + c) * 4 + h);
    const f32x4 kv = *(const f32x4*)(kvt + u * 32768 + (size_t)dv * 128 + 4 * g4), dc = *(const f32x4*)(dcy + u * 128 + 4 * g4);
    *(v2u*)(spt + u * 32768 + (size_t)dv * 128 + 4 * g4) = (v2u){cvt_pk_bf16(S[0], S[1]), cvt_pk_bf16(S[2], S[3])};
    S = dc * (S + kv); }
}

constexpr int A3_LD = 272;
__device__ __forceinline__ void ph_gla_a3(const bf16_t* pb, const bf16_t* qt, const float* og, const bf16_t* spt, const float* ng, bf16_t* ob, LAS unsigned char* lds) {
  const int tid = TIDX(), lane = tid & 63, wave = __builtin_amdgcn_readfirstlane(tid >> 6), gw = BIDX() * 8 + wave, NGW = (int)gridDim.x * 8;
  const int n16 = lane & 15, g = lane >> 4, row16 = lane >> 2, cq = lane & 3;
  LAS float* T = (LAS float*)(lds + wave * (16 * A3_LD * 4));
#pragma unroll 1
  for (int w = gw; w < 4096; w += NGW) {
    const int u = w >> 2, it = w & 3, h = u & 3, r0 = (u >> 2) * 64;
    const bf16_t* sp = spt + (size_t)u * 32768 + (size_t)n16 * 128 + 8 * g;
    bf16x8 qa[4];
#pragma unroll
    for (int ks = 0; ks < 4; ++ks) qa[ks] = *(const bf16x8*)(qt + (size_t)(r0 + 16 * it + n16) * 512 + h * 128 + 32 * ks + 8 * g);
    const float* ogp = og + (size_t)u * 16384 + (size_t)(it * 16) * 256 + lane * 4;
#pragma unroll
    for (int nt = 0; nt < 16; ++nt) {
      f32x4 acc = *(const f32x4*)(ogp + nt * 256);
#pragma unroll
      for (int ks = 0; ks < 4; ++ks) { const bf16x8 sb = *(const bf16x8*)(sp + (size_t)(16 * nt) * 128 + 32 * ks); acc = __builtin_amdgcn_mfma_f32_16x16x32_bf16(qa[ks], sb, acc, 0, 0, 0); }
#pragma unroll
      for (int r = 0; r < 4; ++r) T[(4 * g + r) * A3_LD + 16 * nt + n16] = acc[r];
    }
    LDSW();
    const size_t row = (size_t)(r0 + 16 * it + row16);
    f32x4 v[16]; float ss = 0.f;
#pragma unroll
    for (int k = 0; k < 16; ++k) { v[k] = *(const LAS f32x4*)(T + row16 * A3_LD + 16 * k + 4 * cq); ss += (v[k][0] * v[k][0] + v[k][1] * v[k][1]) + (v[k][2] * v[k][2] + v[k][3] * v[k][3]); }
    ss += __shfl_xor(ss, 1); ss += __shfl_xor(ss, 2);
    const float rs = rsqrtf(ss * (1.f / 256.f) + 1e-6f);
#pragma unroll
    for (int k = 0; k < 16; ++k) { const int col = h * 256 + 16 * k + 4 * cq; const v2u rg = *(const v2u*)(pb + row * 3584 + 2048 + col); const f32x4 gn = *(const f32x4*)(ng + col);
      const float rr[4] = {bf_lo(rg[0]), bf_hi(rg[0]), bf_lo(rg[1]), bf_hi(rg[1])}; float o[4];
#pragma unroll
      for (int z = 0; z < 4; ++z) o[z] = v[k][z] * rs * gn[z] * (rr[z] * __builtin_amdgcn_rcpf(1.f + __expf(-rr[z])));
      *(v2u*)(ob + row * 1024 + col) = (v2u){cvt_pk_bf16(o[0], o[1]), cvt_pk_bf16(o[2], o[3])}; }
    LDSW();
  }
}
#ifndef PROBE
#define PROBE 0
#endif
#ifndef PROBE_S
#define PROBE_S 10.0f
#endif
constexpr size_t MiB = 1u << 20;
constexpr size_t WS_CTL = 0, CTL_ZERO_BYTES = 1 * MiB;
constexpr int CW_BAR = 4096;
constexpr size_t WS_NEEDED = 2048 * MiB;

struct Args { In in; float* out; unsigned char* ws; };

struct Opt { bf16_t *qt, *spt; float *dcy, *og, *kvt; bf16_t *Wql_t, *Wuv_t, *cnb, *qlat, *olat; unsigned short* sc; bf16_t *xb, *WA_t, *WoutA_t, *WB_t, *WoutB_t, *W1_t, *W2_t, *projA_b, *hbf, *o2b, *xs, *act, *Ys, *projB_b; MoeBufs m; };
__device__ __forceinline__ nvp::Ws carve_ws(unsigned char* ws) {
  nvp::Ws w; auto at = [&](size_t mib) { return (char*)ws + mib * MiB; };
  w.projA = (float*)at(2); w.cn = (float*)at(119); w.sc = (float*)at(135); w.idx = (int*)at(647); w.o2 = (float*)at(663);
  w.x1 = (float*)at(727); w.x2 = (float*)at(791);
  w.projB = (float*)at(135); w.adec = (float*)at(135 + 194); w.og = (float*)at(135 + 194 + 32); w.on = (float*)at(135 + 194 + 32 + 64);
  w.counts = nullptr; w.h = nullptr; w.hb = nullptr; w.ys = nullptr; w.tok_e = nullptr; w.tok_g = nullptr; w.slot_of = nullptr; w.row_tok = nullptr; w.row_gate = nullptr; w.blk_e = nullptr;
  return w;
}
__device__ __forceinline__ Opt carve_opt(unsigned char* ws) {
  Opt o; auto at = [&](size_t mib) { return (bf16_t*)((char*)ws + mib * MiB); };
  char* sm = (char*)ws + 855 * MiB;
  o.m.tok_e = (int*)sm; o.m.tok_g = (float*)(sm + 256 * 1024); o.m.slot_of = (int*)(sm + 512 * 1024); o.m.slot_gate = (float*)(sm + 768 * 1024); o.m.blk_e = (int*)(sm + 1088 * 1024); o.m.blkcnt = (int*)(sm + 1096 * 1024); o.m.nblk = (int*)(sm + 1160 * 1024); o.m.slot_tok = (int*)(sm + 1200 * 1024);
  o.WA_t = at(860); o.WoutA_t = at(864); o.WB_t = at(866); o.WoutB_t = at(873);
  o.Wql_t = at(875); o.Wuv_t = at(877); o.olat = at(2); o.cnb = at(647); o.qlat = at(1856); o.sc = (unsigned short*)at(135);
  o.qt = at(135); o.dcy = (float*)at(151); o.og = (float*)at(152); o.kvt = (float*)at(216); o.spt = at(344);
  o.W1_t = at(880); o.W2_t = at(1136);
  o.xb = at(1264); o.projA_b = at(1296); o.hbf = at(1360); o.o2b = at(1392);
  o.xs = at(1424); o.act = at(1568); o.Ys = at(1712); o.projB_b = at(1856);
  return o;
}

struct ProIn { const float *a_w_uk, *a_w_uv, *x, *a_w_in, *a_w_out, *b_w_in, *b_w_g2, *b_w_out, *m_w1, *m_w2; };
__device__ __forceinline__ void ph_prologue(const ProIn I, const Opt& o) {
  const int tid = TIDX(), lane = tid & 63, gw = BIDX() * 8 + (tid >> 6), NGW = (int)gridDim.x * 8, gtid = BIDX() * NTHR + tid, NGT = (int)gridDim.x * NTHR;
  cvt_f32_to_bf16(I.x, D, o.xb, D, NT, D, gtid, NGT);
  zero_rect(o.WA_t, D, DINA, 2048 - DINA, 0, D * 2, gtid, NGT);
  for (int i = gtid; i < 512 * 256; i += NGT) { const int n = i >> 8, k4 = (i & 255) * 4; float a[4];
#pragma unroll
    for (int z = 0; z < 4; ++z) { const float* gl = I.b_w_in + (size_t)(k4 + z) * DINB + 2048; float s = 0.f;
#pragma unroll
      for (int j = 0; j < 16; ++j) s = fmaf(gl[j], I.b_w_g2[j * 512 + n], s);
      a[z] = s; }
    *(v2u*)(o.WB_t + (size_t)(3072 + n) * D + k4) = (v2u){cvt_pk_bf16(a[0], a[1]), cvt_pk_bf16(a[2], a[3])}; }
  int w0 = 0;
#pragma unroll 1
  for (int h = 0; h < 16; ++h) {
    transpose_job(mk_tjob(I.a_w_uk + (size_t)h * 64 * 256, 256, 64, 256, o.Wql_t, 256, h * 256, (h & 3) * 64, 0), w0, gw, NGW, lane);
    transpose_job(mk_tjob(I.a_w_uv + (size_t)h * 256 * 64, 64, 256, 64, o.Wuv_t, 1024, h * 64, (h & 3) * 256, 0), w0, gw, NGW, lane);
    for (int hp = 0; hp < 4; ++hp) if (hp != (h & 3)) { zero_rect(o.Wql_t, 256, h * 256, 256, hp * 128, 128, gtid, NGT); zero_rect(o.Wuv_t, 1024, h * 64, 64, hp * 512, 512, gtid, NGT); }
  }
  transpose_job(mk_tjob(I.a_w_in, DINA, D, DINA, o.WA_t, D, 0, 0, 0), w0, gw, NGW, lane);
  transpose_job(mk_tjob(I.a_w_out, D, D, D, o.WoutA_t, D, 0, 0, 0), w0, gw, NGW, lane);
  transpose_job(mk_tjob(I.b_w_in, DINB, D, 2048, o.WB_t, D, 0, 0, 0), w0, gw, NGW, lane);
  transpose_job(mk_tjob(I.b_w_in + 2064, DINB, D, 1024, o.WB_t, D, 2048, 0, 0), w0, gw, NGW, lane);
  transpose_job(mk_tjob(I.b_w_out, D, D, D, o.WoutB_t, D, 0, 0, 0), w0, gw, NGW, lane);
}
__device__ __forceinline__ void ph_gla_shim(const bf16_t* pb, const float* gbias, float* projB, float* adec) {
  const int gtid = BIDX() * NTHR + TIDX(), NGT = (int)gridDim.x * NTHR;
  for (size_t i = gtid; i < (size_t)NT * 896; i += NGT) { const size_t r = i / 896; const int c = (int)(i % 896) * 4; const v2u v = *(const v2u*)(pb + r * 3584 + c);
    const f32x4 f = (f32x4){bf_lo(v[0]), bf_hi(v[0]), bf_lo(v[1]), bf_hi(v[1])};
    if (c < 2048) *(f32x4*)(projB + r * DINB + c) = f;
    else if (c < 3072) *(f32x4*)(projB + r * DINB + 2064 + (c - 2048)) = f;
    else { f32x4 o;
#pragma unroll
      for (int z = 0; z < 4; ++z) { const float a = f[z] + gbias[c - 3072 + z]; const float ls = fminf(a, 0.f) - log1pf(expf(-fabsf(a))); o[z] = expf(ls * (1.f / 16.f)); }
      *(f32x4*)(adec + r * 512 + (c - 3072)) = o; } }
}

#if PROBE == 3
#define GLA_PHASES \
      PH_BEGIN ph_gla_shim(o.projB_b, I.b_g_bias, w.projB, w.adec); PH_END \
      GRID_BAR(); \
      PH_BEGIN nvp::np_gla_scan(w.projB, w.adec, w.og, fl); PH_END \
      GRID_BAR(); \
      PH_BEGIN nvp::np_gla_norm(w.og, w.projB, I.b_norm, w.on); PH_END \
      GRID_BAR(); \
      PH_BEGIN cvt_f32_to_bf16(w.on, D, o.o2b, D, NT, D, gtid_, NGT_); PH_END \
      GRID_BAR(); \
      PH_BEGIN ph_gla_a1(o.projB_b, I.b_g_bias, (bf16_t*)(wsb_ + 489 * MiB), (float*)(wsb_ + 506 * MiB), (float*)(wsb_ + 880 * MiB), (float*)(wsb_ + 505 * MiB), ll, I.m_w1, I.m_w2, o.W1_t, o.W2_t); PH_END \
      GRID_BAR(); \
      PH_BEGIN ph_gla_a2((float*)(wsb_ + 880 * MiB), (float*)(wsb_ + 505 * MiB), (bf16_t*)(wsb_ + 1136 * MiB)); PH_END \
      GRID_BAR(); \
      PH_BEGIN ph_gla_a3(o.projB_b, (bf16_t*)(wsb_ + 489 * MiB), (float*)(wsb_ + 506 * MiB), (bf16_t*)(wsb_ + 1136 * MiB), I.b_norm, (bf16_t*)(wsb_ + 570 * MiB), ll); PH_END \
      GRID_BAR(); \
      PH_BEGIN { unsigned* fl_ = (unsigned*)(wsb_ + 512 * 1024); unsigned bits = 0u; \
        { const bf16_t* a = (const bf16_t*)(wsb_ + 489 * MiB); for (size_t i = gtid_; i < (size_t)NT * 512; i += NGT_) { const float v = bf2f(a[i]); if (!(fabsf(v) < 1e30f)) bits |= 1u; } } \
        { const float* a = (const float*)(wsb_ + 506 * MiB); for (size_t i = gtid_; i < (size_t)NT * 1024; i += NGT_) { const float v = a[i]; if (!(fabsf(v) < 1e30f)) bits |= 2u; } } \
        { const float* a = (const float*)(wsb_ + 880 * MiB); for (size_t i = gtid_; i < (size_t)1024 * 32768; i += NGT_) { const float v = a[i]; if (!(fabsf(v) < 1e30f)) bits |= 4u; } } \
        { const bf16_t* a = (const bf16_t*)(wsb_ + 1136 * MiB); for (size_t i = gtid_; i < (size_t)1024 * 32768; i += NGT_) { const float v = bf2f(a[i]); if (!(fabsf(v) < 1e30f)) bits |= 8u; } } \
        { const bf16_t* a = (const bf16_t*)(wsb_ + 570 * MiB); for (size_t i = gtid_; i < (size_t)NT * 1024; i += NGT_) { const float v = bf2f(a[i]); if (!(fabsf(v) < 1e30f)) bits |= 16u; } } \
        { const float* a = (const float*)(wsb_ + 505 * MiB); for (size_t i = gtid_; i < (size_t)1024 * 128; i += NGT_) { const float v = a[i]; if (!(fabsf(v) < 1e30f)) bits |= 32u; } } \
        if (bits) atomicOr(fl_, bits); \
        { float* pd = (float*)(wsb_ + 1968 * MiB); const bf16_t* ob = (const bf16_t*)(wsb_ + 570 * MiB); for (size_t i = gtid_; i < (size_t)NT * D; i += NGT_) pd[i] = bf2f(ob[i]) - w.on[i]; } } PH_END \
      GRID_BAR();
#else
#define GLA_PHASES \
      PH_BEGIN ph_gla_a1(o.projB_b, I.b_g_bias, o.qt, o.og, o.kvt, o.dcy, ll, I.m_w1, I.m_w2, o.W1_t, o.W2_t); PH_END \
      GRID_BAR(); \
      PH_BEGIN ph_gla_a2(o.kvt, o.dcy, o.spt); PH_END \
      GRID_BAR(); \
      PH_BEGIN ph_gla_a3(o.projB_b, o.qt, o.og, o.spt, I.b_norm, o.o2b, ll); PH_END \
      GRID_BAR();
#endif
#define LAYER_BODY(li) \
    if (li == 1) { \
      PH_BEGIN StaticOrder S; S.init(o.xb, D, o.WB_t, D, NT, 3584, G_, BIDX()); gemm_phase<EpiStore, StaticOrder, true, true>(ll, Gemm{D, D, D}, S, EpiStore{o.projB_b, 3584}); PH_END \
      GRID_BAR(); \
      GLA_PHASES \
      PH_BEGIN StaticOrder S; S.init(o.o2b, D, o.WoutB_t, D, NT, D, G_, BIDX()); gemm_phase<EpiStore, StaticOrder, true, true>(ll, Gemm{D, D, D}, S, EpiStore{o.hbf, D}); PH_END \
      GRID_BAR(); \
    } \
    PH_BEGIN if (li == 0) ph_ln_router<false>(I.x, o.hbf, I.ln1_g + li * D, I.ln1_b + li * D, I.m_w_router + (size_t)li * D * 32, I.m_b_router + li * 32, o.xs, o.m, fl); else ph_ln_router<true>(o.xb, o.hbf, I.ln1_g + li * D, I.ln1_b + li * D, I.m_w_router + (size_t)li * D * 32, I.m_b_router + li * 32, o.xs, o.m, fl); PH_END \
    GRID_BAR(); \
    PH_BEGIN ph_moe_scatter(o.m, (int*)lds); PH_END \
    GRID_BAR(); \
    PH_BEGIN pg8::MoeOrderG S; S.init(o.xs, D, o.W1_t + (size_t)li * 32 * 2048 * D, D, (size_t)2048 * D * 2, __builtin_amdgcn_readfirstlane(*o.m.nblk), 8, 128, o.m.blk_e, G_, BIDX()); S.rowmap = o.m.slot_tok; \
      gemm_phase<pg8::EpiSwiglu, pg8::MoeOrderG, true, true>(ll, Gemm{D, D, D}, S, pg8::EpiSwiglu{o.act, D, I.m_b1 + (size_t)li * 32 * 2048}); PH_END \
    GRID_BAR(); \
    PH_BEGIN MoeOrder S; S.init(o.act, D, o.W2_t + (size_t)li * 32 * D * D, D, (size_t)D * D * 2, __builtin_amdgcn_readfirstlane(*o.m.nblk), 4, 256, o.m.blk_e, G_, BIDX()); \
      gemm_phase<pg8::EpiMoe2, MoeOrder, true, true>(ll, Gemm{D, D, D}, S, pg8::EpiMoe2{o.Ys, D, I.m_b2 + (size_t)li * 32 * D, o.m.slot_gate}); PH_END \
    GRID_BAR(); \
    PH_BEGIN ph_combine_ln(o.xs, o.Ys, o.m.slot_of, I.ln2_g + li * D, I.ln2_b + li * D, li == 0 ? nullptr : out_, li == 0 ? o.xb : nullptr); PH_END \
    if (li == 0) GRID_BAR();
__global__ void __launch_bounds__(NTHR, 2) mk_fwd(Args args) {
  extern __shared__ __attribute__((aligned(16))) unsigned char lds[];
  volatile LAS unsigned* MISC = (volatile LAS unsigned*)((LAS unsigned char*)lds + MISC_OFF);
  if (threadIdx.x < 32) MISC[threadIdx.x] = 0u;
  __syncthreads();
  XcdBarrier bar; { const __attribute__((address_space(4))) Args* ka0 = (const __attribute__((address_space(4))) Args*)__builtin_amdgcn_kernarg_segment_ptr(); bar = xcd_barrier_post((unsigned*)(ka0->ws + WS_CTL) + CW_BAR, MISC + 8); }
#define GRID_BAR() xcd_barrier(bar)
#define PH_BEGIN { const __attribute__((address_space(4))) Args* ka_ = (const __attribute__((address_space(4))) Args*)__builtin_amdgcn_kernarg_segment_ptr(); asm volatile("" : "+s"(ka_)); \
    float* const out_ = ka_->out; (void)out_; unsigned char* wsb_ = ka_->ws; const nvp::Ws w = carve_ws(wsb_); (void)w; const Opt o = carve_opt(wsb_); (void)o; \
    const int gtid_ = BIDX() * NTHR + TIDX(), NGT_ = (int)gridDim.x * NTHR; (void)gtid_; (void)NGT_; const int G_ = (int)gridDim.x; (void)G_;
#define PH_END }
#define I (ka_->in)
  float* fl = (float*)lds; LAS unsigned char* ll = (LAS unsigned char*)lds;
  using pg8::gemm_phase; using pg8::StaticOrder; using pg8::MoeOrder; using pg8::Gemm; using pg8::EpiStore;
  PH_BEGIN ph_prologue(ProIn{I.a_w_uk, I.a_w_uv, I.x, I.a_w_in, I.a_w_out, I.b_w_in, I.b_w_g2, I.b_w_out, I.m_w1, I.m_w2}, o); PH_END
  GRID_BAR();
  PH_BEGIN StaticOrder S; S.init(o.xb, D, o.WA_t, D, NT, 2048, G_, BIDX()); gemm_phase<EpiStore, StaticOrder, true, true>(ll, Gemm{D, D, D}, S, EpiStore{o.projA_b, 2048}); PH_END
  GRID_BAR();
  PH_BEGIN ph_cnorm_b(o.projA_b, I.a_kv_norm, o.cnb); PH_END
  PH_BEGIN pg8::GroupAOrder S; S.init(o.projA_b, 2048, o.Wql_t, 256, NT, 4096, 4, 512, G_, BIDX()); gemm_phase<EpiStore, pg8::GroupAOrder, true, true>(ll, Gemm{2048, 256, 256}, S, EpiStore{o.qlat, 4096}); PH_END
  PH_BEGIN ph_iscore(o.projA_b, o.sc, I.m_w1, I.m_w2, o.W1_t, o.W2_t); PH_END
  GRID_BAR();
  PH_BEGIN ph_select_attend(o.sc, o.qlat, o.cnb, o.olat, ll, I.m_w1, I.m_w2, o.W1_t, o.W2_t); PH_END
  GRID_BAR();
  PH_BEGIN pg8::GroupAOrder S; S.init(o.olat, 4096, o.Wuv_t, 1024, NT, 1024, 1, 2048, G_, BIDX()); gemm_phase<EpiStore, pg8::GroupAOrder, true, true>(ll, Gemm{4096, 1024, 1024}, S, EpiStore{o.o2b, D}); PH_END
  GRID_BAR();
#if PROBE == 2
  PH_BEGIN cvt_bf16_to_f32(o.projA_b, 2048, w.projA, DINA, NT, DINA, gtid_, NGT_); PH_END
  GRID_BAR();
  PH_BEGIN nvp::np_cnorm(w.projA, I.a_kv_norm, w.cn); PH_END
  PH_BEGIN nvp::np_iscore(w.projA, w.sc, fl); PH_END
  GRID_BAR();
  PH_BEGIN nvp::np_topk(w.sc, w.idx, (char*)lds); PH_END
  GRID_BAR();
  PH_BEGIN nvp::np_dsa_attn(w.projA, w.cn, w.idx, I.a_w_uk, I.a_w_uv, w.o2, fl); PH_END
  GRID_BAR();
  PH_BEGIN { float* pd = (float*)(wsb_ + 1968 * MiB); for (size_t i = gtid_; i < (size_t)NT * D; i += NGT_) pd[i] = bf2f(o.o2b[i]) - w.o2[i]; } PH_END
  GRID_BAR();
#endif
  PH_BEGIN StaticOrder S; S.init(o.o2b, D, o.WoutA_t, D, NT, D, G_, BIDX()); gemm_phase<EpiStore, StaticOrder, true, true>(ll, Gemm{D, D, D}, S, EpiStore{o.hbf, D}); PH_END
  GRID_BAR();
  { LAYER_BODY(0) }
  { LAYER_BODY(1) }
#if PROBE == 2 || PROBE == 3
  GRID_BAR();
#if PROBE == 3
  PH_BEGIN { if (gtid_ == 0) { const unsigned fb = *(const unsigned*)(wsb_ + 512 * 1024); out_[5] += (float)fb; } const float* pd = (const float*)(wsb_ + 1968 * MiB); for (size_t i = gtid_; i < (size_t)NT * D; i += NGT_) out_[i] += PROBE_S * pd[i]; } PH_END
#else
  PH_BEGIN { const float* pd = (const float*)(wsb_ + 1968 * MiB); for (size_t i = gtid_; i < (size_t)NT * D; i += NGT_) out_[i] += PROBE_S * pd[i]; } PH_END
#endif
#endif
}

extern "C" void kernel_launch(void* const* d_in, const int* in_sizes, int n_in, void* d_out, int out_size, void* d_ws, size_t ws_size, hipStream_t stream) {
  static int grid = 0;
  if (grid == 0) {
    if (n_in != 21 || ws_size < WS_NEEDED) { fprintf(stderr, "kernel_launch: bad inputs (n_in %d) or workspace too small (%zu needed, %zu given)\n", n_in, (size_t)WS_NEEDED, ws_size); grid = -1; return; }
    int dev = 0, cus = 0, per_cu = 0;
    if (hipGetDevice(&dev) != hipSuccess || hipDeviceGetAttribute(&cus, hipDeviceAttributeMultiprocessorCount, dev) != hipSuccess) { grid = -1; return; }
    if (hipFuncSetAttribute((const void*)mk_fwd, hipFuncAttributeMaxDynamicSharedMemorySize, LDS_BYTES) != hipSuccess) { fprintf(stderr, "kernel_launch: hipFuncSetAttribute failed\n"); grid = -1; return; }
    if (hipOccupancyMaxActiveBlocksPerMultiprocessor(&per_cu, (const void*)mk_fwd, NTHR, LDS_BYTES) != hipSuccess || per_cu < 1) fprintf(stderr, "kernel_launch: note: occupancy query reports %d\n", per_cu);
    (void)hipGetLastError();
    grid = cus;
    if (grid != 256) fprintf(stderr, "kernel_launch: built for 256 CUs (token ownership per workgroup); got %d\n", grid);
  }
  if (grid < 0) return;
  if (hipMemsetAsync((char*)d_ws + WS_CTL, 0, CTL_ZERO_BYTES, stream) != hipSuccess) { fprintf(stderr, "kernel_launch: memset failed\n"); return; }
  Args a; memset(&a, 0, sizeof(a));
  const float** f = (const float**)&a.in;
  for (int i = 0; i < 21; ++i) f[i] = (const float*)d_in[i];
  a.out = (float*)d_out; a.ws = (unsigned char*)d_ws;
  hipLaunchKernelGGL(mk_fwd, dim3(grid), dim3(NTHR), LDS_BYTES, stream, a);
  const hipError_t le = hipPeekAtLastError();
  if (le != hipSuccess) fprintf(stderr, "kernel_launch: launch failed: %s\n", hipGetErrorName(le));
}
```

```cpp
#include <hip/hip_runtime.h>
#include <cstdio>
#include <cstdint>
#include <cstring>

#define GAS __attribute__((address_space(1)))
#define LAS __attribute__((address_space(3)))
#define NTHR 512
constexpr int LDS_BYTES = 147456;
constexpr int MISC_OFF = 131072 + 8192;

#define XB_TMO      128
#define XB_XCNT(j)  (256  + 64 * (j))
#define XB_XSUB(j)  (1280 + 64 * (j))
#define XB_XGEN(j)  (2304 + 64 * (j))
#define XB_TOP      3328
#define XB_TOPGEN   3392
#define XCD_BAR_WORDS 3456
#define XB_SPIN_CAP (1u << 25)
__device__ __forceinline__ unsigned xb_ld(unsigned* p)              { return __hip_atomic_load(p, __ATOMIC_RELAXED, __HIP_MEMORY_SCOPE_AGENT); }
__device__ __forceinline__ unsigned xb_add(unsigned* p, unsigned v) { return __hip_atomic_fetch_add(p, v, __ATOMIC_RELAXED, __HIP_MEMORY_SCOPE_AGENT); }
__device__ __forceinline__ unsigned xb_xcc_id() { return (unsigned)__builtin_amdgcn_s_getreg((3 << 11) | 20) & 0xFu; }
#define XB_SPIN(cond, bar) do { unsigned _sp = 0; while (cond) { __builtin_amdgcn_s_sleep(1); \
    if ((++_sp & 255u) == 0u) { if (xb_ld(&(bar)[XB_TMO])) break; if (_sp > XB_SPIN_CAP) { atomicAdd(&(bar)[XB_TMO], 1u); break; } } } } while (0)
struct XcdBarrier { unsigned* bar; unsigned x; volatile LAS unsigned* st; };
__device__ __forceinline__ XcdBarrier xcd_barrier_post(unsigned* bar, volatile LAS unsigned* st) {
    XcdBarrier b; b.bar = bar; b.x = xb_xcc_id(); b.st = st;
    if (threadIdx.x == 0) (void)xb_add(&bar[XB_XCNT(b.x)], 1u);
    return b;
}
__device__ __forceinline__ void xcd_barrier_complete(unsigned* bar, unsigned x, unsigned& nloc, unsigned& nx) {
    const unsigned G = gridDim.x * gridDim.y * gridDim.z;
    unsigned sum, cnt, mine, sp = 0u;
    for (;;) {
        sum = 0u; cnt = 0u; mine = 0u;
#pragma unroll
        for (unsigned j = 0; j < 16; ++j) { const unsigned c = xb_ld(&bar[XB_XCNT(j)]); sum += c; cnt += (c > 0u) ? 1u : 0u; mine = (j == x) ? c : mine; }
        if (sum == G) break;
        __builtin_amdgcn_s_sleep(1);
        if ((++sp & 255u) == 0u) { if (xb_ld(&bar[XB_TMO])) break; if (sp > XB_SPIN_CAP) { atomicAdd(&bar[XB_TMO], 1u); break; } }
    }
    nloc = mine > 0u ? mine : 1u; nx = cnt > 0u ? cnt : 1u;
}
__device__ __forceinline__ void xcd_barrier(const XcdBarrier& b) {
    asm volatile("s_waitcnt vmcnt(0)" ::: "memory");
    __syncthreads();
    if (threadIdx.x == 0) {
        unsigned* bar = b.bar;
        __builtin_amdgcn_s_waitcnt(0);
        unsigned nloc = b.st[0], nx = b.st[1];
        if (nloc == 0u) { xcd_barrier_complete(bar, b.x, nloc, nx); b.st[0] = nloc; b.st[1] = nx; }
        const unsigned old = xb_add(&bar[XB_XSUB(b.x)], 1u);
        const unsigned gen = old / nloc;
        if (old + 1u == (gen + 1u) * nloc) {
            __builtin_amdgcn_fence(__ATOMIC_RELEASE, "agent");
            asm volatile("s_waitcnt vmcnt(0)" ::: "memory");
            const unsigned og = xb_add(&bar[XB_TOP], 1u);
            const unsigned tg = og / nx;
            if (og + 1u == (tg + 1u) * nx) xb_add(&bar[XB_TOPGEN], 1u);
            else XB_SPIN(xb_ld(&bar[XB_TOPGEN]) == tg, bar);
            __builtin_amdgcn_fence(__ATOMIC_ACQUIRE, "agent");
            xb_add(&bar[XB_XGEN(b.x)], 1u);
            asm volatile("s_waitcnt vmcnt(0)" ::: "memory");
        } else {
            XB_SPIN(xb_ld(&bar[XB_XGEN(b.x)]) == gen, bar);
            __builtin_amdgcn_fence(__ATOMIC_ACQUIRE, "agent");
            asm volatile("s_waitcnt vmcnt(0)" ::: "memory");
        }
    }
    __syncthreads();
}

constexpr int NT = 16384, D = 1024, L = 8192, NB = 2;
constexpr int DINA = 1864, DINB = 3088;
constexpr int PMAX = 73728;
constexpr float ALPHA = 1.4142135623730951f;

struct In { const float *x, *a_w_in, *a_kv_norm, *a_w_uk, *a_w_uv, *a_w_out, *b_w_in, *b_w_g2, *b_g_bias, *b_norm, *b_w_out, *m_w_router, *m_b_router, *m_w1, *m_b1, *m_w2, *m_b2, *ln1_g, *ln1_b, *ln2_g, *ln2_b; };

__device__ __forceinline__ int TIDX() { int t = threadIdx.x; asm volatile("" : "+v"(t)); return t; }
__device__ __forceinline__ int BIDX() { int t = blockIdx.x; asm volatile("" : "+s"(t)); return t; }
__device__ __forceinline__ float wave_sum(float v) {
#pragma unroll
    for (int o = 1; o < 64; o <<= 1) v += __shfl_xor(v, o);
    return v;
}
namespace nvp {
#define WSYNC() asm volatile("s_waitcnt lgkmcnt(0)" ::: "memory")
struct GemmP {
  const float* A; int lda; const int* arow;
  const float* B; int ldb; float* C; int ldc; int M, N, K;
  const int* blk_e; const int* nblk_used; size_t bstride; const float* bias; size_t bias_stride;
};
__device__ __forceinline__ GemmP mkg(const float* A, int lda, const int* arow, const float* B, int ldb, float* C, int ldc, int M, int N, int K, const int* blk_e, const int* nblk_used, size_t bstride, const float* bias, size_t bias_stride) {
  GemmP p; p.A = A; p.lda = lda; p.arow = arow; p.B = B; p.ldb = ldb; p.C = C; p.ldc = ldc; p.M = M; p.N = N; p.K = K; p.blk_e = blk_e; p.nblk_used = nblk_used; p.bstride = bstride; p.bias = bias; p.bias_stride = bias_stride; return p; }

template <int MODE>
__device__ __forceinline__ void np_sgemm(const GemmP p, float* lds) {
  float (*As)[132] = (float (*)[132])lds;
  float (*Bs)[68] = (float (*)[68])(lds + 16 * 132);
  float (*Bu)[68] = (float (*)[68])(lds + 16 * 132 + 16 * 68);
  const int tid = TIDX(), tx = tid & 15, ty = tid >> 4;
  const int ntn = (p.N + 63) / 64, ntm = p.M / 128;
  const int ar = tid >> 2, ak = (tid & 3) * 4;
  const int bk = (tid & 255) >> 4, bn4 = (tid & 15) * 4;
  for (int t = BIDX(); t < ntm * ntn; t += gridDim.x) {
    const int bm = t / ntn, bn = t % ntn;
    const float* B = p.B; const float* bias = p.bias;
    if (MODE != 0) { const int blk = (bm * 128) / 256; if (blk >= *p.nblk_used) continue; const int e = p.blk_e[blk]; B += (size_t)e * p.bstride; bias += (size_t)e * p.bias_stride; }
    const int m0 = bm * 128, n0 = bn * 64;
    const int arow = p.arow ? p.arow[m0 + ar] : (m0 + ar);
    const float* Ap = p.A + (size_t)arow * p.lda + ak;
    const bool bok = (n0 + bn4) < p.N;
    float acc[4][4] = {}, accu[4][4] = {};
    for (int k0 = 0; k0 < p.K; k0 += 16) {
      const float4 av = *(const float4*)(Ap + k0);
      As[ak + 0][ar] = av.x; As[ak + 1][ar] = av.y; As[ak + 2][ar] = av.z; As[ak + 3][ar] = av.w;
      if (tid < 256) { float4 bv = make_float4(0.f, 0.f, 0.f, 0.f); if (bok) bv = *(const float4*)(B + (size_t)(k0 + bk) * p.ldb + n0 + bn4); *(float4*)&Bs[bk][bn4] = bv; }
      else if (MODE == 1) { const float4 uv = *(const float4*)(B + (size_t)(k0 + bk) * p.ldb + 1024 + n0 + bn4); *(float4*)&Bu[bk][bn4] = uv; }
      __syncthreads();
#pragma unroll
      for (int kk = 0; kk < 16; ++kk) {
        const float4 a = *(const float4*)&As[kk][ty * 4];
        const float4 b = *(const float4*)&Bs[kk][tx * 4];
        const float aa[4] = {a.x, a.y, a.z, a.w}, bb[4] = {b.x, b.y, b.z, b.w};
#pragma unroll
        for (int i = 0; i < 4; ++i)
#pragma unroll
          for (int j = 0; j < 4; ++j) acc[i][j] = fmaf(aa[i], bb[j], acc[i][j]);
        if (MODE == 1) {
          const float4 u = *(const float4*)&Bu[kk][tx * 4]; const float uu[4] = {u.x, u.y, u.z, u.w};
#pragma unroll
          for (int i = 0; i < 4; ++i)
#pragma unroll
            for (int j = 0; j < 4; ++j) accu[i][j] = fmaf(aa[i], uu[j], accu[i][j]);
        }
      }
      __syncthreads();
    }
#pragma unroll
    for (int i = 0; i < 4; ++i) {
      const int m = m0 + ty * 4 + i;
#pragma unroll
      for (int j = 0; j < 4; ++j) {
        const int n = n0 + tx * 4 + j; if (n >= p.N) continue;
        float v = acc[i][j];
        if (MODE == 1) {
          float g = v + bias[n], u = accu[i][j] + bias[1024 + n];
          g = fminf(g, 7.f); u = fminf(fmaxf(u, -7.f), 7.f);
          const float glu = g / (1.f + expf(-1.702f * g));
          v = (u + 1.f) * glu;
        } else if (MODE == 2) v += bias[n];
        p.C[(size_t)m * p.ldc + n] = v;
      }
    }
  }
}

#define GW_INIT const int lane = TIDX() & 63, wave = TIDX() >> 6, gw = BIDX() * 8 + wave, NGW = gridDim.x * 8; (void)lane; (void)wave; (void)gw; (void)NGW

__device__ __forceinline__ void np_cnorm(const float* projA, const float* g, float* cn) {
  GW_INIT;
  for (int row = gw; row < NT; row += NGW) {
    const float4 v = *(const float4*)(projA + (size_t)row * DINA + 1024 + lane * 4);
    const float ss = wave_sum(v.x * v.x + v.y * v.y + v.z * v.z + v.w * v.w);
    const float r = rsqrtf(ss * (1.f / 256.f) + 1e-6f); const float4 g4 = *(const float4*)(g + lane * 4);
    *(float4*)(cn + (size_t)row * 256 + lane * 4) = make_float4(v.x * r * g4.x, v.y * r * g4.y, v.z * r * g4.z, v.w * r * g4.w);
  }
}

__device__ __forceinline__ void np_iscore(const float* projA, float* sc, float* lds) {
  float (*As)[132] = (float (*)[132])lds;
  float (*Bs)[68] = (float (*)[68])(lds + 16 * 132);
  const int tid = TIDX(), tx = tid & 15, ty = tid >> 4;
  const int ar = tid >> 2, ak = (tid & 3) * 4;
  const int br = (tid & 255) >> 2;
  for (int u = BIDX(); u < NB * 64 * 128; u += gridDim.x) {
    const int b = u / (64 * 128), tt = (u / 128) % 64, st = u % 128;
    if (st > 2 * tt + 1) continue;
    const int t0 = tt * 128, s0 = st * 64;
    const float* Qp = projA + (size_t)(b * L + t0 + ar) * DINA + 1280 + ak;
    const float* Kp = projA + (size_t)(b * L + s0 + br) * DINA + 1792 + ak;
    float score[4][4] = {};
    for (int h = 0; h < 8; ++h) {
      float acc[4][4] = {};
      for (int k0 = 0; k0 < 64; k0 += 16) {
        const float4 av = *(const float4*)(Qp + h * 64 + k0);
        As[ak + 0][ar] = av.x; As[ak + 1][ar] = av.y; As[ak + 2][ar] = av.z; As[ak + 3][ar] = av.w;
        if (tid < 256) { const float4 bv = *(const float4*)(Kp + k0); Bs[ak + 0][br] = bv.x; Bs[ak + 1][br] = bv.y; Bs[ak + 2][br] = bv.z; Bs[ak + 3][br] = bv.w; }
        __syncthreads();
#pragma unroll
        for (int kk = 0; kk < 16; ++kk) {
          const float4 a = *(const float4*)&As[kk][ty * 4]; const float4 bq = *(const float4*)&Bs[kk][tx * 4];
          const float aa[4] = {a.x, a.y, a.z, a.w}, bb[4] = {bq.x, bq.y, bq.z, bq.w};
#pragma unroll
          for (int i = 0; i < 4; ++i)
#pragma unroll
            for (int j = 0; j < 4; ++j) acc[i][j] = fmaf(aa[i], bb[j], acc[i][j]);
        }
        __syncthreads();
      }
#pragma unroll
      for (int i = 0; i < 4; ++i) {
        const float w = projA[(size_t)(b * L + t0 + ty * 4 + i) * DINA + 1856 + h] * 0.35355339059327373f;
#pragma unroll
        for (int j = 0; j < 4; ++j) score[i][j] += w * fmaxf(acc[i][j] * 0.125f, 0.f);
      }
    }
#pragma unroll
    for (int i = 0; i < 4; ++i)
#pragma unroll
      for (int j = 0; j < 4; ++j) sc[((size_t)(b * L + t0 + ty * 4 + i)) * L + s0 + tx * 4 + j] = score[i][j];
  }
}

__device__ __forceinline__ unsigned f2key(float f) { f = f + 0.0f; const unsigned u = __float_as_uint(f); return (u & 0x80000000u) ? ~u : (u | 0x80000000u); }

__device__ __forceinline__ void np_topk(const float* sc, int* idx_out, char* lds) {
  GW_INIT;
  unsigned* hist = (unsigned*)(lds + wave * 1280); unsigned* cntw = hist + 256;
  for (int row = gw; row < NT; row += NGW) {
    const int t = row % L, n = t + 1;
    const float* s = sc + (size_t)row * L; int* out = idx_out + (size_t)row * 256;
    if (n <= 256) { for (int i = lane; i < 256; i += 64) out[i] = i < n ? i : -1; continue; }
    unsigned prefix = 0, need = 256;
    for (int pass = 3; pass >= 0; --pass) {
      const int shift = pass * 8;
      for (int i = lane; i < 256; i += 64) hist[i] = 0;
      WSYNC();
      for (int i = lane; i < n; i += 64) { const unsigned k = f2key(s[i]); const bool m = (pass == 3) || ((k >> (shift + 8)) == (prefix >> (shift + 8))); if (m) atomicAdd(&hist[(k >> shift) & 255u], 1u); }
      WSYNC();
      unsigned cum = 0; int d = 255; for (; d > 0; --d) { const unsigned hv = hist[d]; if (cum + hv >= need) break; cum += hv; }
      prefix |= ((unsigned)d << shift); need -= cum;
      WSYNC();
    }
    if (lane == 0) *cntw = 0; WSYNC();
    for (int i = lane; i < n; i += 64) { if (f2key(s[i]) > prefix) { const unsigned pos = atomicAdd(cntw, 1u); out[pos] = i; } }
    WSYNC();
    if (lane == 0) { unsigned c = *cntw; unsigned nd = need; for (int i = 0; i < n && nd > 0; ++i) if (f2key(s[i]) == prefix) { out[c++] = i; --nd; } }
    WSYNC();
  }
}

__device__ __forceinline__ void np_dsa_attn(const float* projA, const float* cn, const int* idx, const float* w_uk, const float* w_uv, float* o2, float* lds) {
  const int half = TIDX() >> 8, tid = TIDX() & 255;
  float* base = lds + half * 14336;
  float* qs = base; float (*ql)[256] = (float (*)[256])(base + 1024); float (*pr)[257] = (float (*)[257])(base + 1024 + 4096);
  float (*ol)[256] = (float (*)[256])(base + 1024 + 4096 + 4112); float* red = base + 1024 + 4096 + 4112 + 4096; int* sid = (int*)(red + 16);
  for (int r0 = BIDX() * 2; r0 < NT; r0 += gridDim.x * 2) {
    const int row = r0 + half, b = row / L;
    __syncthreads();
    for (int i = tid; i < 1024; i += 256) qs[i] = projA[(size_t)row * DINA + i];
    sid[tid] = idx[(size_t)row * 256 + tid];
    __syncthreads();
    { const int c = tid;
#pragma unroll 1
      for (int h = 0; h < 16; ++h) { float a = 0.f;
#pragma unroll 8
        for (int d = 0; d < 64; ++d) a = fmaf(qs[h * 64 + d], w_uk[((size_t)h * 64 + d) * 256 + c], a); ql[h][c] = a; } }
    __syncthreads();
    { const int k = tid, key = sid[k];
      float lg[16];
      if (key >= 0) { const float* cr = cn + (size_t)(b * L + key) * 256;
        for (int h = 0; h < 16; ++h) lg[h] = 0.f;
#pragma unroll 2
        for (int c = 0; c < 256; ++c) { const float cv = cr[c];
#pragma unroll
          for (int h = 0; h < 16; ++h) lg[h] = fmaf(ql[h][c], cv, lg[h]); }
#pragma unroll
        for (int h = 0; h < 16; ++h) pr[h][k] = lg[h] * 0.125f;
      } else {
#pragma unroll
        for (int h = 0; h < 16; ++h) pr[h][k] = -INFINITY; } }
    __syncthreads();
    if (tid < 16) { const int h = tid; float m = -INFINITY; for (int k = 0; k < 256; ++k) m = fmaxf(m, pr[h][k]); float su = 0.f; for (int k = 0; k < 256; ++k) { const float e = expf(pr[h][k] - m); pr[h][k] = e; su += e; } red[h] = 1.f / su; }
    __syncthreads();
    { const int c = tid; float a[16];
#pragma unroll
      for (int h = 0; h < 16; ++h) a[h] = 0.f;
#pragma unroll 2
      for (int k = 0; k < 256; ++k) { const int key = sid[k]; if (key < 0) continue; const float cv = cn[(size_t)(b * L + key) * 256 + c];
#pragma unroll
        for (int h = 0; h < 16; ++h) a[h] = fmaf(pr[h][k], cv, a[h]); }
#pragma unroll
      for (int h = 0; h < 16; ++h) ol[h][c] = a[h] * red[h]; }
    __syncthreads();
#pragma unroll 1
    for (int o = tid; o < 1024; o += 256) { const int h = o >> 6, v = o & 63; float a = 0.f;
#pragma unroll 8
      for (int c = 0; c < 256; ++c) a = fmaf(ol[h][c], w_uv[((size_t)h * 256 + c) * 64 + v], a); o2[(size_t)row * 1024 + o] = a; }
  }
  __syncthreads();
}

__device__ __forceinline__ void np_ln_res(const float* x, const float* h, const float* g, const float* bb, float* out) {
  GW_INIT;
  for (int row = gw; row < NT; row += NGW) {
    float4 v[4]; float s = 0.f;
#pragma unroll
    for (int j = 0; j < 4; ++j) { const float4 a = *(const float4*)(x + (size_t)row * D + lane * 4 + 256 * j), hh = *(const float4*)(h + (size_t)row * D + lane * 4 + 256 * j);
      v[j] = make_float4(ALPHA * a.x + hh.x, ALPHA * a.y + hh.y, ALPHA * a.z + hh.z, ALPHA * a.w + hh.w); s += (v[j].x + v[j].y) + (v[j].z + v[j].w); }
    const float mu = wave_sum(s) * (1.f / D); float q = 0.f;
#pragma unroll
    for (int j = 0; j < 4; ++j) { v[j].x -= mu; v[j].y -= mu; v[j].z -= mu; v[j].w -= mu; q += (v[j].x * v[j].x + v[j].y * v[j].y) + (v[j].z * v[j].z + v[j].w * v[j].w); }
    const float r = rsqrtf(wave_sum(q) * (1.f / D) + 1e-5f);
#pragma unroll
    for (int j = 0; j < 4; ++j) { const int c = lane * 4 + 256 * j; const float4 g4 = *(const float4*)(g + c), b4 = *(const float4*)(bb + c);
      *(float4*)(out + (size_t)row * D + c) = make_float4(v[j].x * r * g4.x + b4.x, v[j].y * r * g4.y + b4.y, v[j].z * r * g4.z + b4.z, v[j].w * r * g4.w + b4.w); }
  }
}

__device__ __forceinline__ void np_router(const float* x, const float* wr, const float* br, int* tok_e, float* tok_g, int* counts, int* row_tok, char* lds) {
  GW_INIT;
  for (int i = BIDX() * NTHR + TIDX(); i < PMAX; i += gridDim.x * NTHR) row_tok[i] = 0;
  float* lg = (float*)(lds + wave * 256);
  const int e = lane & 31, hf = lane >> 5;
  for (int tok = gw; tok < NT; tok += NGW) {
    const float* xr = x + (size_t)tok * D + hf * 512; const float* wp = wr + (size_t)hf * 512 * 32 + e; float a = 0.f;
#pragma unroll 8
    for (int d = 0; d < 512; ++d) a = fmaf(xr[d], wp[d * 32], a);
    a += __shfl_xor(a, 32);
    if (hf == 0) lg[e] = a + br[e];
    WSYNC();
    if (lane == 0) { int ei[4]; float ev[4];
      for (int k = 0; k < 4; ++k) { int bi = 0; float bv = -INFINITY; for (int j = 0; j < 32; ++j) if (lg[j] > bv) { bv = lg[j]; bi = j; } ei[k] = bi; ev[k] = bv; lg[bi] = -INFINITY; }
      float su = 0.f, ex[4]; for (int k = 0; k < 4; ++k) { ex[k] = expf(ev[k] - ev[0]); su += ex[k]; }
      for (int k = 0; k < 4; ++k) { tok_e[tok * 4 + k] = ei[k]; tok_g[tok * 4 + k] = ex[k] / su; atomicAdd(&counts[ei[k]], 1); } }
    WSYNC();
  }
}
__device__ __forceinline__ void np_moe_sort(const int* tok_e, const float* tok_g, const int* counts, int* row_tok, float* row_gate, int* slot_of, int* blk_e, int* nblk_used, char* lds) {
  if (BIDX() != 0) return;
  const int e = TIDX(); int* pstart = (int*)lds; int* stage = pstart + 64;
  if (e == 0) { int acc = 0; for (int j = 0; j < 32; ++j) { pstart[j] = acc; const int nb = (counts[j] + 255) / 256; for (int q = 0; q < nb; ++q) blk_e[acc / 256 + q] = j; acc += nb * 256; } pstart[32] = acc; *nblk_used = acc / 256; }
  __syncthreads();
  int pos = e < 32 ? pstart[e] : 0;
  for (int c0 = 0; c0 < NT * 4; c0 += 2048) {
    __syncthreads();
    for (int i = e; i < 2048; i += NTHR) stage[i] = tok_e[c0 + i];
    __syncthreads();
    if (e < 32) for (int i = 0; i < 2048; ++i) if (stage[i] == e) { const int gi = c0 + i; row_tok[pos] = gi >> 2; row_gate[pos] = tok_g[gi]; slot_of[gi] = pos; ++pos; }
  }
  __syncthreads();
}
__device__ __forceinline__ void np_moe_combine_ln(const float* x1, const float* ys, const int* slot_of, const float* tok_g, const float* g, const float* bb, float* out) {
  GW_INIT;
  for (int row = gw; row < NT; row += NGW) {
    float4 v[4]; float s = 0.f; int sl[4]; float gg[4];
#pragma unroll
    for (int k = 0; k < 4; ++k) { sl[k] = slot_of[row * 4 + k]; gg[k] = tok_g[row * 4 + k]; }
#pragma unroll
    for (int j = 0; j < 4; ++j) { const int c = lane * 4 + 256 * j; float4 f = make_float4(0.f, 0.f, 0.f, 0.f);
#pragma unroll
      for (int k = 0; k < 4; ++k) { const float4 y = *(const float4*)(ys + (size_t)sl[k] * D + c); f.x += gg[k] * y.x; f.y += gg[k] * y.y; f.z += gg[k] * y.z; f.w += gg[k] * y.w; }
      const float4 a = *(const float4*)(x1 + (size_t)row * D + c);
      v[j] = make_float4(ALPHA * a.x + f.x, ALPHA * a.y + f.y, ALPHA * a.z + f.z, ALPHA * a.w + f.w); s += (v[j].x + v[j].y) + (v[j].z + v[j].w); }
    const float mu = wave_sum(s) * (1.f / D); float q = 0.f;
#pragma unroll
    for (int j = 0; j < 4; ++j) { v[j].x -= mu; v[j].y -= mu; v[j].z -= mu; v[j].w -= mu; q += (v[j].x * v[j].x + v[j].y * v[j].y) + (v[j].z * v[j].z + v[j].w * v[j].w); }
    const float r = rsqrtf(wave_sum(q) * (1.f / D) + 1e-5f);
#pragma unroll
    for (int j = 0; j < 4; ++j) { const int c = lane * 4 + 256 * j; const float4 g4 = *(const float4*)(g + c), b4 = *(const float4*)(bb + c);
      *(float4*)(out + (size_t)row * D + c) = make_float4(v[j].x * r * g4.x + b4.x, v[j].y * r * g4.y + b4.y, v[j].z * r * g4.z + b4.z, v[j].w * r * g4.w + b4.w); }
  }
}

__device__ __forceinline__ void np_gla_gate(const float* projB, const float* w_g2, const float* gb, float* adec) {
  GW_INIT;
  for (int row = gw; row < NT; row += NGW) {
    float glr[16];
#pragma unroll
    for (int j = 0; j < 16; ++j) glr[j] = projB[(size_t)row * DINB + 2048 + j];
    for (int c = lane; c < 512; c += 64) { float a = gb[c];
#pragma unroll
      for (int j = 0; j < 16; ++j) a = fmaf(glr[j], w_g2[j * 512 + c], a);
      const float ls = fminf(a, 0.f) - log1pf(expf(-fabsf(a))); adec[(size_t)row * 512 + c] = expf(ls * (1.f / 16.f)); }
  }
}
__device__ __forceinline__ void np_gla_scan(const float* projB, const float* adec, float* og, float* lds) {
  if (BIDX() >= 8) return;
  const int b = BIDX() >> 2, h = BIDX() & 3, tid = TIDX(), dv = tid & 255, dh = tid >> 8;
  float (*qs)[128] = (float (*)[128])lds; float (*ks)[128] = (float (*)[128])(lds + 2048); float (*as)[128] = (float (*)[128])(lds + 4096);
  float (*po)[16][256] = (float (*)[16][256])(lds + 6144);
  float S[64];
#pragma unroll
  for (int d = 0; d < 64; ++d) S[d] = 0.f;
  for (int t0 = 0; t0 < L; t0 += 16) {
    __syncthreads();
    for (int i = tid; i < 16 * 128; i += NTHR) { const int tt = i >> 7, d = i & 127; const size_t r = (size_t)(b * L + t0 + tt);
      qs[tt][d] = projB[r * DINB + h * 128 + d] * 0.08838834764831845f; ks[tt][d] = projB[r * DINB + 512 + h * 128 + d]; as[tt][d] = adec[r * 512 + h * 128 + d]; }
    __syncthreads();
#pragma unroll 1
    for (int tt = 0; tt < 16; ++tt) { const size_t r = (size_t)(b * L + t0 + tt); const float v = projB[r * DINB + 1024 + h * 256 + dv]; float o = 0.f;
#pragma unroll
      for (int d = 0; d < 64; ++d) { S[d] = fmaf(as[tt][dh * 64 + d], S[d], ks[tt][dh * 64 + d] * v); o = fmaf(qs[tt][dh * 64 + d], S[d], o); }
      po[dh][tt][dv] = o; }
    __syncthreads();
    for (int i = tid; i < 16 * 256; i += NTHR) { const int tt = i >> 8, c = i & 255; og[(size_t)(b * L + t0 + tt) * 1024 + h * 256 + c] = po[0][tt][c] + po[1][tt][c]; }
  }
  __syncthreads();
}
__device__ __forceinline__ void np_gla_norm(const float* og, const float* projB, const float* ng, float* on) {
  GW_INIT;
  for (int u = gw; u < NT * 4; u += NGW) {
    const int row = u >> 2, h = u & 3; const int c = h * 256 + lane * 4;
    const float4 v = *(const float4*)(og + (size_t)row * 1024 + c);
    const float r = rsqrtf(wave_sum(v.x * v.x + v.y * v.y + v.z * v.z + v.w * v.w) * (1.f / 256.f) + 1e-6f);
    const float4 rr = *(const float4*)(projB + (size_t)row * DINB + 2064 + c), g4 = *(const float4*)(ng + c);
    *(float4*)(on + (size_t)row * 1024 + c) = make_float4(v.x * r * g4.x * (rr.x / (1.f + expf(-rr.x))), v.y * r * g4.y * (rr.y / (1.f + expf(-rr.y))), v.z * r * g4.z * (rr.z / (1.f + expf(-rr.z))), v.w * r * g4.w * (rr.w / (1.f + expf(-rr.w))));
  }
}

struct Ws { float *projA, *cn, *sc, *o2, *h, *x1, *x2, *hb, *ys, *projB, *adec, *og, *on, *tok_g, *row_gate; int *idx, *tok_e, *slot_of, *row_tok, *blk_e, *counts; };
}
typedef unsigned short bf16_t;
typedef unsigned v4u __attribute__((ext_vector_type(4)));
typedef unsigned v2u __attribute__((ext_vector_type(2)));
typedef float f32x4 __attribute__((ext_vector_type(4)));
typedef short bf16x8 __attribute__((ext_vector_type(8)));
typedef float f32x2_t __attribute__((ext_vector_type(2))); typedef __bf16 bf16x2_t __attribute__((ext_vector_type(2)));
__device__ __forceinline__ unsigned cvt_pk_bf16(float lo, float hi) { const f32x2_t v = {lo, hi}; const bf16x2_t b = __builtin_convertvector(v, bf16x2_t); return __builtin_bit_cast(unsigned, b); }
__device__ __forceinline__ float bf_lo(unsigned u) { return __uint_as_float(u << 16); }
__device__ __forceinline__ float bf_hi(unsigned u) { return __uint_as_float(u & 0xffff0000u); }
__device__ __forceinline__ float bf2f(bf16_t h) { return __uint_as_float(((unsigned)h) << 16); }

struct TJob { const float* src; int lds_; int K, N; bf16_t* dst; int ldd; int drow0, dcol0; int rowmap; int ntk, ntn; };
__device__ __forceinline__ TJob mk_tjob(const float* src, int lds_, int K, int N, bf16_t* dst, int ldd, int drow0, int dcol0, int rowmap) {
  TJob j; j.src = src; j.lds_ = lds_; j.K = K; j.N = N; j.dst = dst; j.ldd = ldd; j.drow0 = drow0; j.dcol0 = dcol0; j.rowmap = rowmap; j.ntk = K / 64; j.ntn = (N + 127) / 128; return j; }
__device__ __forceinline__ int tjob_tiles(const TJob& j) { return j.ntk * j.ntn; }
__device__ __forceinline__ void transpose_tile(const TJob& j, int tile, int lane) {
  const int kt = tile / j.ntn, nt_ = tile % j.ntn, k0 = kt * 64, n0 = nt_ * 128;
  const int q = lane & 31, par = lane >> 5;
  const bool ok = (n0 + 4 * q) < j.N;
  f32x4 v[32];
  const float* sp = j.src + (size_t)(k0 + par) * j.lds_ + n0 + 4 * q;
#pragma unroll
  for (int i = 0; i < 32; ++i) v[i] = ok ? *(const f32x4*)(sp + (size_t)(2 * i) * j.lds_) : (f32x4){0.f, 0.f, 0.f, 0.f};
  unsigned ra[32], rb[32];
#pragma unroll
  for (int i = 0; i < 32; ++i) {
    auto s0 = __builtin_amdgcn_permlane32_swap(__float_as_uint(v[i][0]), __float_as_uint(v[i][2]), false, false);
    auto s1 = __builtin_amdgcn_permlane32_swap(__float_as_uint(v[i][1]), __float_as_uint(v[i][3]), false, false);
    ra[i] = cvt_pk_bf16(__uint_as_float(s0[0]), __uint_as_float(s0[1]));
    rb[i] = cvt_pk_bf16(__uint_as_float(s1[0]), __uint_as_float(s1[1]));
  }
  if (ok) {
    const int n = n0 + 4 * q + 2 * par;
    int r0 = n, r1 = n + 1;
    if (j.rowmap == 1) { const int jj0 = r0 & 1023, jj1 = r1 & 1023; r0 = 256 * (jj0 >> 7) + ((r0 >> 10) << 7) + (jj0 & 127); r1 = 256 * (jj1 >> 7) + ((r1 >> 10) << 7) + (jj1 & 127); }
    bf16_t* d0 = j.dst + (size_t)(j.drow0 + r0) * j.ldd + j.dcol0 + k0;
    bf16_t* d1 = j.dst + (size_t)(j.drow0 + r1) * j.ldd + j.dcol0 + k0;
#pragma unroll
    for (int c = 0; c < 8; ++c) { *(v4u*)(d0 + 8 * c) = (v4u){ra[4 * c], ra[4 * c + 1], ra[4 * c + 2], ra[4 * c + 3]}; *(v4u*)(d1 + 8 * c) = (v4u){rb[4 * c], rb[4 * c + 1], rb[4 * c + 2], rb[4 * c + 3]}; }
  }
}
__device__ __forceinline__ void transpose_job(const TJob j, int& w0, int gw, int NGW, int lane) {
  const int nt_ = tjob_tiles(j);
  int first = gw - (w0 % NGW); if (first < 0) first += NGW;
#pragma unroll 1
  for (int t = first; t < nt_; t += NGW) transpose_tile(j, t, lane);
  w0 += nt_;
}
__device__ __forceinline__ void zero_rect(bf16_t* dst, int ldd, int r0, int nr, int cb0, int nbytes, int gtid, int NGT) {
  const int per = nbytes / 16;
  for (int i = gtid; i < nr * per; i += NGT) { const int r = i / per, c = i % per; *(v4u*)((char*)(dst + (size_t)(r0 + r) * ldd) + cb0 + 16 * c) = (v4u){0u, 0u, 0u, 0u}; }
}
__device__ __forceinline__ void cvt_f32_to_bf16(const float* src, int lds_, bf16_t* dst, int ldd, int rows, int ncols, int gtid, int NGT) {
  const int per = ncols / 4;
  for (size_t i = gtid; i < (size_t)rows * per; i += NGT) { const size_t r = i / per; const int c = (int)(i % per) * 4; const f32x4 v = *(const f32x4*)(src + r * lds_ + c);
    *(v2u*)(dst + r * ldd + c) = (v2u){cvt_pk_bf16(v[0], v[1]), cvt_pk_bf16(v[2], v[3])}; }
}
__device__ __forceinline__ void cvt_bf16_to_f32(const bf16_t* src, int lds_, float* dst, int ldd, int rows, int ncols, int gtid, int NGT) {
  const int per = ncols / 4;
  for (size_t i = gtid; i < (size_t)rows * per; i += NGT) { const size_t r = i / per; const int c = (int)(i % per) * 4; const v2u v = *(const v2u*)(src + r * lds_ + c);
    *(f32x4*)(dst + r * ldd + c) = (f32x4){bf_lo(v[0]), bf_hi(v[0]), bf_lo(v[1]), bf_hi(v[1])}; }
}

namespace pg8 {
#define PG8_LAS __attribute__((address_space(3)))
typedef unsigned u32x4 __attribute__((ext_vector_type(4)));
constexpr int BM = 256, BK = 64, HALF = 128, HTB = HALF * BK * 2, STAGE_BYTES = 8 * HTB, NXCD = 8, WGM = 8;
__host__ __device__ __forceinline__ int lds_byte(int r, int c) { const int st = (r >> 4) * 2 + (c >> 5), rr = r & 15, cc = c & 31, ob = rr * 64 + cc * 2; return st * 1024 + (ob ^ (((ob >> 9) & 1) << 5)); }
__host__ __device__ __forceinline__ void stage_rc(int b, int& R, int& C) { const int st = b / 1024, sb = b % 1024, swz = sb ^ (((sb >> 9) & 1) << 5); R = (st >> 1) * 16 + swz / 64; C = (st & 1) * 32 + (swz % 64) / 2; }
__host__ __device__ __forceinline__ int perm32(int rho) { const int n = rho >> 4, i = rho & 15; return 8 * (i >> 2) + 4 * n + (i & 3); }
struct Unit { const char* pa; const char* pb; int orow, ocol, e, kind; };
struct Gemm { int lda, ldb, K; };
struct StaticOrder {
    static constexpr bool GATHER = false; const int* rowmap;
    const char* A; const char* Bt; size_t ta, tb; int nM, nN, nwg, G, c;
    __device__ void init(const void* A_, int lda, const void* Bt_, int ldb, int M, int N, int G_, int c_) { A = (const char*)A_; Bt = (const char*)Bt_; ta = (size_t)BM * lda * 2; tb = (size_t)BM * ldb * 2; nM = M / BM; nN = N / BM; nwg = nM * nN; G = G_; c = c_; }
    __device__ bool tile(int i, int& pm, int& pn) const {
        const long L = (long)i * G + c; if (L >= nwg) return false;
        int wgid = (int)L; { const int q = nwg / NXCD, r = nwg % NXCD, xcd = wgid % NXCD, off = wgid / NXCD; wgid = (xcd < r ? xcd * (q + 1) : r * (q + 1) + (xcd - r) * q) + off; }
        const int nig = WGM * nN, gid = wgid / nig, fm = gid * WGM, gsz = (nM - fm) < WGM ? (nM - fm) : WGM;
        pm = fm + ((wgid % nig) % gsz); pn = (wgid % nig) / gsz; return true;
    }
    __device__ bool next(int i, Unit& u) const { int pm, pn; if (!tile(i, pm, pn)) return false; u.pa = A + (size_t)pm * ta; u.pb = Bt + (size_t)pn * tb; u.orow = pm * BM; u.ocol = pn * BM; u.e = 0; u.kind = 0; return true; }
    __device__ __forceinline__ int rowof(const Unit&, int r) const { return r; }
    __device__ __forceinline__ void a_ready(const Unit&) const {}
    __device__ __forceinline__ void done(const Unit&) const {}
};
struct EpiStore {
    static constexpr bool PERM = true, AFTER_DRAIN = false;
    bf16_t* O; int ldc;
    __device__ __forceinline__ void operator()(const f32x4 (&acc)[2][2][4][2], const Unit& u, int wr, int wc, int fr, int fq) const {
        const int row0 = u.orow + wr * 64 + fr, col0 = u.ocol + wc * 32 + 8 * fq;
#pragma unroll
        for (int ai = 0; ai < 2; ++ai)
#pragma unroll
            for (int m = 0; m < 4; ++m) { bf16_t* rowp = O + (size_t)(row0 + ai * HALF + m * 16) * ldc + col0;
#pragma unroll
                for (int bj = 0; bj < 2; ++bj) { const f32x4 v0 = acc[ai][bj][m][0], v1 = acc[ai][bj][m][1];
                    u32x4 w; w.x = cvt_pk_bf16(v0[0], v0[1]); w.y = cvt_pk_bf16(v0[2], v0[3]); w.z = cvt_pk_bf16(v1[0], v1[1]); w.w = cvt_pk_bf16(v1[2], v1[3]);
                    *(u32x4*)(rowp + bj * HALF) = w; } }
    }
};
template <class Epi, class Sched, bool ALIGN_EPI = false, bool SP2 = false>
__device__ __forceinline__ void gemm_phase(PG8_LAS unsigned char* lds, const Gemm g, const Sched& S, const Epi& E) {
    const int tid = TIDX(), wid = __builtin_amdgcn_readfirstlane(tid >> 6), lane = tid & 63, wr = wid >> 2, wc = wid & 3, fr = lane & 15, fq = lane >> 4;
    const int K = g.K, nt = K / BK;
    unsigned voffA[2], voffB[2];
#pragma unroll
    for (int i = 0; i < 2; ++i) { int R, C; stage_rc(tid * 16 + i * 8192, R, C); const int Rb = Epi::PERM ? ((R & ~31) + perm32(R & 31)) : R;
        voffA[i] = (unsigned)(R * g.lda + C) * 2u; voffB[i] = (unsigned)(Rb * g.ldb + C) * 2u; }
    unsigned voffG[2][2][2]; int gR[2], gC[2];
#pragma unroll
    for (int i = 0; i < 2; ++i) { int R, C; stage_rc(tid * 16 + i * 8192, R, C); gR[i] = R; gC[i] = C; }
#define PG8_GOFF(dst, unit_) do { if constexpr (Sched::GATHER) { _Pragma("unroll") for (int _h = 0; _h < 2; ++_h) _Pragma("unroll") for (int _i = 0; _i < 2; ++_i) \
        dst[_h][_i] = (unsigned)S.rowof(unit_, (unit_).orow + _h * HALF + gR[_i]) * (unsigned)(g.lda * 2) + (unsigned)gC[_i] * 2u; } } while (0)
#define PG8_STAGE_A(bufoff, gptr, half, vsel) do { if constexpr (Sched::GATHER) { PG8_STAGE(bufoff, gptr, vsel); } else { PG8_STAGE(bufoff, (gptr) + (half) * hstepA, voffA); } } while (0)
    const size_t kstep = (size_t)(BK * 2);
    const size_t hstepA = (size_t)HALF * g.lda * 2, hstepB = (size_t)HALF * g.ldb * 2;
    const unsigned ldsw = (unsigned)wid * 1024u;
    const int aoff = lds_byte(wr * 64 + fr, fq * 8), boff = lds_byte(wc * 32 + fr, fq * 8);
#define PG8_SA(b, h) (((b) * 2 + (h)) * HTB)
#define PG8_SB(b, h) ((4 + (b) * 2 + (h)) * HTB)
#define PG8_STAGE(bufoff, gbase, voff) do { _Pragma("unroll") for (int _i = 0; _i < 2; ++_i) \
        __builtin_amdgcn_global_load_lds((const unsigned*)((const char*)(gbase) + (voff)[_i]), (PG8_LAS unsigned*)(lds + (bufoff) + ldsw + _i * 8192), 16, 0, 0); } while (0)
#define PG8_LDA(dst, b, h) do { _Pragma("unroll") for (int m = 0; m < 4; ++m) _Pragma("unroll") for (int k = 0; k < 2; ++k) dst[m][k] = *(const PG8_LAS bf16x8*)(lds + PG8_SA(b, h) + aoff + m * 2048 + k * 1024); } while (0)
#define PG8_LDB(dst, b, h) do { _Pragma("unroll") for (int n = 0; n < 2; ++n) _Pragma("unroll") for (int k = 0; k < 2; ++k) dst[n][k] = *(const PG8_LAS bf16x8*)(lds + PG8_SB(b, h) + boff + n * 2048 + k * 1024); } while (0)
#define PG8_MMA(ai, bj, At, Bt) do { __builtin_amdgcn_s_setprio(1); _Pragma("unroll") for (int m = 0; m < 4; ++m) _Pragma("unroll") for (int n = 0; n < 2; ++n) _Pragma("unroll") for (int k = 0; k < 2; ++k) \
        acc[ai][bj][m][n] = __builtin_amdgcn_mfma_f32_16x16x32_bf16(Bt[n][k], At[m][k], acc[ai][bj][m][n], 0, 0, 0); __builtin_amdgcn_s_setprio(0); } while (0)
#define PG8_WAIT_V(n) asm volatile("s_waitcnt vmcnt(" #n ")" ::: "memory")
#define PG8_WAIT_L(n) asm volatile("s_waitcnt lgkmcnt(" #n ")" ::: "memory")
#define PG8_BAR __builtin_amdgcn_s_barrier()
#define PG8_SCHED __builtin_amdgcn_sched_barrier(0)
    Unit cur, nxt; int ui = 0;
    if (!S.next(0, cur)) return;
    f32x4 acc[2][2][4][2];
#pragma unroll
    for (int a = 0; a < 2; ++a)
#pragma unroll
        for (int b = 0; b < 2; ++b)
#pragma unroll
            for (int m = 0; m < 4; ++m)
#pragma unroll
                for (int n = 0; n < 2; ++n) acc[a][b][m][n] = (f32x4){0.f, 0.f, 0.f, 0.f};
    bf16x8 At[4][2], B0[2][2], B1[2][2];
    const char* cA = cur.pa; const char* cB = cur.pb;
    S.a_ready(cur);
    PG8_GOFF(voffG[0], cur);
    if constexpr (SP2) {
        PG8_STAGE(PG8_SB(0, 0), cB, voffB); PG8_STAGE(PG8_SB(0, 1), cB + hstepB, voffB); PG8_STAGE_A(PG8_SA(0, 0), cA, 0, voffG[0][0]); PG8_STAGE_A(PG8_SA(0, 1), cA, 1, voffG[0][1]);
        if (wr == 1) PG8_BAR;
        PG8_WAIT_V(2); PG8_BAR;
        PG8_STAGE(PG8_SB(1, 0), cB + kstep, voffB); PG8_STAGE_A(PG8_SA(1, 0), cA + kstep, 0, voffG[0][0]); PG8_STAGE(PG8_SB(1, 1), cB + hstepB + kstep, voffB);
        PG8_WAIT_V(6); PG8_BAR;
    } else {
        PG8_STAGE(PG8_SB(0, 0), cB, voffB); PG8_STAGE_A(PG8_SA(0, 0), cA, 0, voffG[0][0]); PG8_STAGE(PG8_SB(0, 1), cB + hstepB, voffB); PG8_STAGE_A(PG8_SA(0, 1), cA, 1, voffG[0][1]);
        if (wr == 1) PG8_BAR;
        PG8_WAIT_V(4); PG8_BAR;
        PG8_STAGE(PG8_SB(1, 0), cB + kstep, voffB); PG8_STAGE_A(PG8_SA(1, 0), cA + kstep, 0, voffG[0][0]); PG8_STAGE(PG8_SB(1, 1), cB + hstepB + kstep, voffB);
        PG8_WAIT_V(6); PG8_BAR;
    }
    for (;;) {
        const bool has_next = S.next(ui + 1, nxt);
        if constexpr (Sched::GATHER) { if (has_next) { PG8_GOFF(voffG[1], nxt); } else {
#pragma unroll
            for (int _h = 0; _h < 2; ++_h)
#pragma unroll
                for (int _i = 0; _i < 2; ++_i) voffG[1][_h][_i] = voffG[0][_h][_i]; } }
        const char* nA = has_next ? nxt.pa : cA; const char* nB = has_next ? nxt.pb : cB;
        for (int t = 0; t < nt; t += 2) {
            const bool last = (t == nt - 2);
            const char* a1 = cA + (size_t)(t + 1) * kstep;
            const char* a2 = last ? nA : cA + (size_t)(t + 2) * kstep; const char* b2 = last ? nB : cB + (size_t)(t + 2) * kstep;
            const char* a3 = a2 + kstep; const char* b3 = b2 + kstep;
            unsigned vs0[2], vs1[2];
#pragma unroll
            for (int _i = 0; _i < 2; ++_i) { vs0[_i] = last ? voffG[1][0][_i] : voffG[0][0][_i]; vs1[_i] = last ? voffG[1][1][_i] : voffG[0][1][_i]; }
            if (last && has_next) S.a_ready(nxt);
            if constexpr (SP2) {
            PG8_LDB(B0, 0, 0); PG8_LDB(B1, 0, 1); PG8_SCHED; PG8_LDA(At, 0, 0); PG8_STAGE_A(PG8_SA(1, 1), a1, 1, voffG[0][1]);
            PG8_WAIT_V(8); PG8_WAIT_L(0); PG8_BAR; PG8_MMA(0, 0, At, B0); PG8_MMA(0, 1, At, B1); PG8_BAR; PG8_SCHED;
            PG8_LDA(At, 0, 1); PG8_STAGE(PG8_SB(0, 0), b2, voffB); PG8_STAGE(PG8_SB(0, 1), b2 + hstepB, voffB); PG8_STAGE_A(PG8_SA(0, 0), a2, 0, vs0);
            PG8_WAIT_V(8); PG8_WAIT_L(0); PG8_BAR; PG8_MMA(1, 0, At, B0); PG8_MMA(1, 1, At, B1); PG8_BAR; PG8_SCHED;
            PG8_LDB(B0, 1, 0); PG8_LDB(B1, 1, 1); PG8_SCHED; PG8_LDA(At, 1, 0); PG8_STAGE_A(PG8_SA(0, 1), a2, 1, vs1);
            PG8_WAIT_V(8); PG8_WAIT_L(0); PG8_BAR; PG8_MMA(0, 0, At, B0); PG8_MMA(0, 1, At, B1); PG8_BAR; PG8_SCHED;
            PG8_LDA(At, 1, 1); PG8_STAGE(PG8_SB(1, 0), b3, voffB); PG8_STAGE(PG8_SB(1, 1), b3 + hstepB, voffB); PG8_STAGE_A(PG8_SA(1, 0), a3, 0, vs0);
            PG8_WAIT_V(8); PG8_WAIT_L(0); PG8_BAR; PG8_MMA(1, 0, At, B0); PG8_MMA(1, 1, At, B1); PG8_BAR; PG8_SCHED;
            } else {
            PG8_LDB(B0, 0, 0); PG8_SCHED; PG8_LDA(At, 0, 0); PG8_STAGE_A(PG8_SA(1, 1), a1, 1, voffG[0][1]);
            PG8_WAIT_L(8); PG8_BAR; PG8_WAIT_L(0); PG8_MMA(0, 0, At, B0); PG8_BAR; PG8_SCHED;
            PG8_LDB(B1, 0, 1); PG8_STAGE(PG8_SB(0, 0), b2, voffB);
            PG8_BAR; PG8_WAIT_L(0); PG8_MMA(0, 1, At, B1); PG8_BAR;
            PG8_LDA(At, 0, 1); PG8_STAGE_A(PG8_SA(0, 0), a2, 0, vs0);
            PG8_BAR; PG8_WAIT_L(0); PG8_MMA(1, 0, At, B0); PG8_BAR; PG8_SCHED;
            PG8_STAGE(PG8_SB(0, 1), b2 + hstepB, voffB);
            PG8_WAIT_V(6); PG8_BAR; PG8_MMA(1, 1, At, B1); PG8_BAR;
            PG8_LDB(B0, 1, 0); PG8_SCHED; PG8_LDA(At, 1, 0); PG8_STAGE_A(PG8_SA(0, 1), a2, 1, vs1);
            PG8_WAIT_L(8); PG8_BAR; PG8_WAIT_L(0); PG8_MMA(0, 0, At, B0); PG8_BAR; PG8_SCHED;
            PG8_LDB(B1, 1, 1); PG8_STAGE(PG8_SB(1, 0), b3, voffB);
            PG8_BAR; PG8_WAIT_L(0); PG8_MMA(0, 1, At, B1); PG8_BAR;
            PG8_LDA(At, 1, 1); PG8_STAGE_A(PG8_SA(1, 0), a3, 0, vs0);
            PG8_BAR; PG8_WAIT_L(0); PG8_MMA(1, 0, At, B0); PG8_BAR; PG8_SCHED;
            PG8_STAGE(PG8_SB(1, 1), b3 + hstepB, voffB);
            PG8_WAIT_V(6); PG8_BAR; PG8_MMA(1, 1, At, B1); PG8_BAR;
            }
        }
        if constexpr (ALIGN_EPI) { if (wr == 0) PG8_BAR; }
        if constexpr (!Epi::AFTER_DRAIN) { E(acc, cur, wr, wc, fr, fq); S.done(cur); }
        if (!has_next) break;
#pragma unroll
        for (int a = 0; a < 2; ++a)
#pragma unroll
            for (int b = 0; b < 2; ++b)
#pragma unroll
                for (int m = 0; m < 4; ++m)
#pragma unroll
                    for (int n = 0; n < 2; ++n) acc[a][b][m][n] = (f32x4){0.f, 0.f, 0.f, 0.f};
        cur = nxt; cA = nA; cB = nB; ++ui;
        if constexpr (Sched::GATHER) {
#pragma unroll
            for (int _h = 0; _h < 2; ++_h)
#pragma unroll
                for (int _i = 0; _i < 2; ++_i) voffG[0][_h][_i] = voffG[1][_h][_i]; }
        if constexpr (ALIGN_EPI) { if (wr == 1) PG8_BAR; }
    }
    PG8_WAIT_V(0);
    if constexpr (!ALIGN_EPI) { if (wr == 0) PG8_BAR; }
    PG8_BAR;
    if constexpr (Epi::AFTER_DRAIN) { E.fused(acc, cur, wr, wc, fr, fq, lds, wid, lane); S.done(cur); }
#undef PG8_SA
#undef PG8_SB
#undef PG8_STAGE
#undef PG8_STAGE_A
#undef PG8_GOFF
#undef PG8_LDA
#undef PG8_LDB
#undef PG8_MMA
#undef PG8_WAIT_V
#undef PG8_WAIT_L
#undef PG8_BAR
#undef PG8_SCHED
}

}
#define WSYNC2() asm volatile("s_waitcnt lgkmcnt(0)" ::: "memory")
struct MoeBufs { int* tok_e; float* tok_g; int* slot_of; float* slot_gate; int* blk_e; int* blkcnt; int* nblk; int* slot_tok; };
constexpr int WRT_LD = 1028;

template <bool XB> __device__ __forceinline__ void ph_ln_router(const void* xin_, const bf16_t* hb, const float* g, const float* bb, const float* wr, const float* br, bf16_t* x1b, const MoeBufs m, float* lds) {
  const float* xin = (const float*)xin_; const bf16_t* xinb = (const bf16_t*)xin_;
  for (int i = BIDX() * NTHR + TIDX(); i < PMAX; i += (int)gridDim.x * NTHR) m.slot_tok[i] = 0;
  const int tid = TIDX(), lane = tid & 63, wave = tid >> 6, blk = BIDX();
  float* wT = lds;
  float* lg = lds + 32 * WRT_LD + wave * 64;
  int* cnt = (int*)(lds + 32 * WRT_LD + 8 * 64);
  { f32x4 wv[16];
#pragma unroll
    for (int k = 0; k < 16; ++k) wv[k] = *(const f32x4*)(wr + (size_t)(tid + NTHR * k) * 4);
#pragma unroll
    for (int k = 0; k < 16; ++k) { const int i = (tid + NTHR * k) * 4, d = i >> 5, e = i & 31;
#pragma unroll
      for (int z = 0; z < 4; ++z) wT[(e + z) * WRT_LD + d] = wv[k][z]; } }
  if (tid < 32) cnt[tid] = 0;
  __syncthreads();
#pragma unroll 1
  for (int it = 0; it < 8; it += 2) {
    const int tok0 = blk * 64 + wave * 8 + it;
    f32x4 v[2][4]; float s[2] = {0.f, 0.f};
#pragma unroll
    for (int q = 0; q < 2; ++q)
#pragma unroll
      for (int j = 0; j < 4; ++j) { const int c = lane * 4 + 256 * j; f32x4 a;
        if (XB) { const v2u xv = *(const v2u*)(xinb + (size_t)(tok0 + q) * D + c); a = (f32x4){bf_lo(xv[0]), bf_hi(xv[0]), bf_lo(xv[1]), bf_hi(xv[1])}; } else a = *(const f32x4*)(xin + (size_t)(tok0 + q) * D + c);
        const v2u hh = *(const v2u*)(hb + (size_t)(tok0 + q) * D + c);
        v[q][j] = (f32x4){ALPHA * a[0] + bf_lo(hh[0]), ALPHA * a[1] + bf_hi(hh[0]), ALPHA * a[2] + bf_lo(hh[1]), ALPHA * a[3] + bf_hi(hh[1])}; s[q] += (v[q][j][0] + v[q][j][1]) + (v[q][j][2] + v[q][j][3]); }
#pragma unroll
    for (int o = 1; o < 64; o <<= 1) { s[0] += __shfl_xor(s[0], o); s[1] += __shfl_xor(s[1], o); }
    float qq[2] = {0.f, 0.f};
#pragma unroll
    for (int q = 0; q < 2; ++q) { const float mu = s[q] * (1.f / D);
#pragma unroll
      for (int j = 0; j < 4; ++j) { v[q][j] = v[q][j] - mu; qq[q] += (v[q][j][0] * v[q][j][0] + v[q][j][1] * v[q][j][1]) + (v[q][j][2] * v[q][j][2] + v[q][j][3] * v[q][j][3]); } }
#pragma unroll
    for (int o = 1; o < 64; o <<= 1) { qq[0] += __shfl_xor(qq[0], o); qq[1] += __shfl_xor(qq[1], o); }
#pragma unroll
    for (int q = 0; q < 2; ++q) { const float r = rsqrtf(qq[q] * (1.f / D) + 1e-5f);
#pragma unroll
      for (int j = 0; j < 4; ++j) { const int c = lane * 4 + 256 * j; const f32x4 g4 = *(const f32x4*)(g + c), b4 = *(const f32x4*)(bb + c); v[q][j] = v[q][j] * r * g4 + b4; *(v2u*)(x1b + (size_t)(tok0 + q) * D + c) = (v2u){cvt_pk_bf16(v[q][j][0], v[q][j][1]), cvt_pk_bf16(v[q][j][2], v[q][j][3])}; } }
    float p[2][32];
#pragma unroll
    for (int e = 0; e < 32; ++e) { float a0 = 0.f, a1 = 0.f;
#pragma unroll
      for (int j = 0; j < 4; ++j) { const f32x4 w4 = *(const f32x4*)(wT + e * WRT_LD + lane * 4 + 256 * j);
        a0 = fmaf(v[0][j][0], w4[0], a0); a0 = fmaf(v[0][j][1], w4[1], a0); a0 = fmaf(v[0][j][2], w4[2], a0); a0 = fmaf(v[0][j][3], w4[3], a0);
        a1 = fmaf(v[1][j][0], w4[0], a1); a1 = fmaf(v[1][j][1], w4[1], a1); a1 = fmaf(v[1][j][2], w4[2], a1); a1 = fmaf(v[1][j][3], w4[3], a1); }
      p[0][e] = a0; p[1][e] = a1; }
#pragma unroll
    for (int i = 0; i < 16; ++i) { const bool hi = (lane & 32) != 0;
#pragma unroll
      for (int q = 0; q < 2; ++q) { const float send = hi ? p[q][i] : p[q][i + 16]; const float keep = hi ? p[q][i + 16] : p[q][i]; p[q][i] = keep + __shfl_xor(send, 32); } }
#pragma unroll
    for (int i = 0; i < 8; ++i) { const bool hi = (lane & 16) != 0;
#pragma unroll
      for (int q = 0; q < 2; ++q) { const float send = hi ? p[q][i] : p[q][i + 8]; const float keep = hi ? p[q][i + 8] : p[q][i]; p[q][i] = keep + __shfl_xor(send, 16); } }
#pragma unroll
    for (int i = 0; i < 4; ++i) { const bool hi = (lane & 8) != 0;
#pragma unroll
      for (int q = 0; q < 2; ++q) { const float send = hi ? p[q][i] : p[q][i + 4]; const float keep = hi ? p[q][i + 4] : p[q][i]; p[q][i] = keep + __shfl_xor(send, 8); } }
#pragma unroll
    for (int i = 0; i < 2; ++i) { const bool hi = (lane & 4) != 0;
#pragma unroll
      for (int q = 0; q < 2; ++q) { const float send = hi ? p[q][i] : p[q][i + 2]; const float keep = hi ? p[q][i + 2] : p[q][i]; p[q][i] = keep + __shfl_xor(send, 4); } }
#pragma unroll
    for (int q = 0; q < 2; ++q) { const bool hi = (lane & 2) != 0; const float send = hi ? p[q][0] : p[q][1]; const float keep = hi ? p[q][1] : p[q][0]; p[q][0] = keep + __shfl_xor(send, 2); }
    p[0][0] += __shfl_xor(p[0][0], 1); p[1][0] += __shfl_xor(p[1][0], 1);
    const int e_l = ((lane >> 5) & 1) * 16 + ((lane >> 4) & 1) * 8 + ((lane >> 3) & 1) * 4 + ((lane >> 2) & 1) * 2 + ((lane >> 1) & 1);
    const float brl = br[e_l];
    float lv[2] = {p[0][0] + brl, p[1][0] + brl}; int ei[2][4]; float ev[2][4];
#pragma unroll
    for (int k = 0; k < 4; ++k) { float bv[2] = {lv[0], lv[1]}; int bi[2] = {e_l, e_l};
#pragma unroll
      for (int o = 2; o < 64; o <<= 1)
#pragma unroll
        for (int q = 0; q < 2; ++q) { const float ov = __shfl_xor(bv[q], o); const int oi = __shfl_xor(bi[q], o); const bool take = (ov > bv[q]) || (ov == bv[q] && oi < bi[q]); bv[q] = take ? ov : bv[q]; bi[q] = take ? oi : bi[q]; }
#pragma unroll
      for (int q = 0; q < 2; ++q) { ei[q][k] = bi[q]; ev[q][k] = bv[q]; if (e_l == bi[q]) lv[q] = -INFINITY; } }
    if (lane < 2) { const int q = lane;
      float ex[4], su = 0.f;
#pragma unroll
      for (int k = 0; k < 4; ++k) { ex[k] = __expf((q ? ev[1][k] : ev[0][k]) - (q ? ev[1][0] : ev[0][0])); su += ex[k]; }
      const float inv = 1.f / su; const int tok = tok0 + q;
      const int e0 = q ? ei[1][0] : ei[0][0], e1 = q ? ei[1][1] : ei[0][1], e2 = q ? ei[1][2] : ei[0][2], e3 = q ? ei[1][3] : ei[0][3];
      *(int4*)(m.tok_e + tok * 4) = make_int4(e0, e1, e2, e3);
      *(float4*)(m.tok_g + tok * 4) = make_float4(ex[0] * inv, ex[1] * inv, ex[2] * inv, ex[3] * inv);
      atomicAdd(&cnt[e0], 1); atomicAdd(&cnt[e1], 1); atomicAdd(&cnt[e2], 1); atomicAdd(&cnt[e3], 1); }
  }
  __syncthreads();
  if (tid < 32) m.blkcnt[blk * 32 + tid] = cnt[tid];
  __syncthreads();
}

__device__ __forceinline__ void ph_moe_scatter(const MoeBufs m, int* ilds) {
  const int tid = TIDX(), lane = tid & 63, wave = tid >> 6, blk = BIDX(); (void)lane;
  int* tot = ilds; int* bef = ilds + 32; int* pst = ilds + 64; int* es = ilds + 128; int* rk = ilds + 384; int* sl = ilds + 640; int* part = ilds + 896; int* wcnt = ilds + 1408;
  { const int e = tid & 31, pa = tid >> 5; int sum = 0;
#pragma unroll
    for (int q = 0; q < 16; ++q) sum += m.blkcnt[(pa * 16 + q) * 32 + e];
    part[pa * 32 + e] = sum; }
  if (tid < 256) es[tid] = m.tok_e[blk * 256 + tid];
  __syncthreads();
  if (tid < 32) { const int e = tid; int t_ = 0, b_ = 0; const int pb_ = blk >> 4;
    for (int q = 0; q < 16; ++q) { const int v = part[q * 32 + e]; t_ += v; if (q < pb_) b_ += v; }
    for (int q = pb_ * 16; q < blk; ++q) b_ += m.blkcnt[q * 32 + e];
    tot[e] = t_; bef[e] = b_; }
  if (tid < 256) { const int e = es[tid]; const unsigned long long lt = (1ull << lane) - 1ull; int r = 0;
    for (int ee = 0; ee < 32; ++ee) { const unsigned long long mk = __ballot(e == ee); if (e == ee) r = __builtin_popcountll(mk & lt); if (lane == ee) wcnt[wave * 32 + ee] = __builtin_popcountll(mk); }
    rk[tid] = r; }
  __syncthreads();
  if (tid == 0) { int acc = 0; for (int e = 0; e < 32; ++e) { pst[e] = acc; acc += ((tot[e] + 255) >> 8) << 8; } pst[32] = acc;
    if (blk == 0) { *m.nblk = acc >> 8; for (int e = 0; e < 32; ++e) for (int q = pst[e] >> 8; q < (pst[e + 1] >> 8); ++q) m.blk_e[q] = e; } }
  __syncthreads();
  if (tid < 256) { const int e = es[tid]; int rank = rk[tid]; for (int w2 = 0; w2 < wave; ++w2) rank += wcnt[w2 * 32 + e];
    const int slot = pst[e] + bef[e] + rank; m.slot_of[blk * 256 + tid] = slot; m.slot_gate[slot] = m.tok_g[blk * 256 + tid]; m.slot_tok[slot] = blk * 64 + (tid >> 2); }
  __syncthreads();
  __syncthreads();
}

__device__ __forceinline__ void ph_combine_ln(const bf16_t* x1b, const bf16_t* Ys, const int* slot_of, const float* g, const float* bb, float* out, bf16_t* outb) {
  const int tid = TIDX(), lane = tid & 63, gw = BIDX() * 8 + (tid >> 6), NGW = (int)gridDim.x * 8;
  for (int row = gw; row < NT; row += NGW) {
    const int4 s4 = *(const int4*)(slot_of + row * 4); const int sl[4] = {s4.x, s4.y, s4.z, s4.w};
    f32x4 v[4]; float s = 0.f;
#pragma unroll
    for (int j = 0; j < 4; ++j) { const int c = lane * 4 + 256 * j; f32x4 f = (f32x4){0.f, 0.f, 0.f, 0.f};
#pragma unroll
      for (int k = 0; k < 4; ++k) { const v2u y = *(const v2u*)(Ys + (size_t)sl[k] * D + c); f += (f32x4){bf_lo(y[0]), bf_hi(y[0]), bf_lo(y[1]), bf_hi(y[1])}; }
      const v2u xv = *(const v2u*)(x1b + (size_t)row * D + c); const f32x4 a = (f32x4){bf_lo(xv[0]), bf_hi(xv[0]), bf_lo(xv[1]), bf_hi(xv[1])}; v[j] = a * ALPHA + f; s += (v[j][0] + v[j][1]) + (v[j][2] + v[j][3]); }
    const float mu = wave_sum(s) * (1.f / D); float q = 0.f;
#pragma unroll
    for (int j = 0; j < 4; ++j) { v[j] = v[j] - mu; q += (v[j][0] * v[j][0] + v[j][1] * v[j][1]) + (v[j][2] * v[j][2] + v[j][3] * v[j][3]); }
    const float r = rsqrtf(wave_sum(q) * (1.f / D) + 1e-5f);
#pragma unroll
    for (int j = 0; j < 4; ++j) { const int c = lane * 4 + 256 * j; const f32x4 g4 = *(const f32x4*)(g + c), b4 = *(const f32x4*)(bb + c); const f32x4 o = v[j] * r * g4 + b4;
      if (out) *(f32x4*)(out + (size_t)row * D + c) = o; if (outb) *(v2u*)(outb + (size_t)row * D + c) = (v2u){cvt_pk_bf16(o[0], o[1]), cvt_pk_bf16(o[2], o[3])}; }
  }
}

namespace pg8 {
template <bool GATHER_> struct MoeOrderT {
    static constexpr bool GATHER = GATHER_; const int* rowmap;
    StaticOrder so; const int* blk_e; const char* W; size_t wexp; int obn;
    __device__ void init(const void* A, int lda, const void* W_, int ldb, size_t wexp_, int nM, int nN, int obn_, const int* blk_e_, int G, int c) { so.init(A, lda, W_, ldb, nM * BM, nN * BM, G, c); blk_e = blk_e_; W = (const char*)W_; wexp = wexp_; obn = obn_; }
    __device__ bool next(int i, Unit& u) const { int pm, pn; if (!so.tile(i, pm, pn)) return false; const int e = __builtin_amdgcn_readfirstlane(blk_e[pm]); u.pa = GATHER_ ? so.A : so.A + (size_t)pm * so.ta; u.pb = W + (size_t)e * wexp + (size_t)pn * so.tb; u.orow = pm * BM; u.ocol = pn * obn; u.e = e; u.kind = 0; return true; }
    __device__ __forceinline__ int rowof(const Unit&, int r) const { return GATHER_ ? rowmap[r] : r; }
    __device__ __forceinline__ void a_ready(const Unit&) const {}
    __device__ __forceinline__ void done(const Unit&) const {}
};
typedef MoeOrderT<false> MoeOrder; typedef MoeOrderT<true> MoeOrderG;
struct EpiSwiglu {
    static constexpr bool PERM = true, AFTER_DRAIN = false;
    bf16_t* O; int ldc; const float* b1;
    __device__ __forceinline__ void operator()(const f32x4 (&acc)[2][2][4][2], const Unit& u, int wr, int wc, int fr, int fq) const {
        const int row0 = u.orow + wr * 64 + fr, cl = wc * 32 + 8 * fq, col0 = u.ocol + cl;
        const float* bg = b1 + (size_t)u.e * 2048 + col0; const float* bu = bg + 1024;
        const f32x4 bg0 = *(const f32x4*)bg, bg1 = *(const f32x4*)(bg + 4), bu0 = *(const f32x4*)bu, bu1 = *(const f32x4*)(bu + 4);
#pragma unroll
        for (int ai = 0; ai < 2; ++ai)
#pragma unroll
            for (int m = 0; m < 4; ++m) {
                f32x4 gv[2] = {acc[ai][0][m][0] + bg0, acc[ai][0][m][1] + bg1}, uv[2] = {acc[ai][1][m][0] + bu0, acc[ai][1][m][1] + bu1}; float o[8];
#pragma unroll
                for (int n = 0; n < 2; ++n)
#pragma unroll
                    for (int i = 0; i < 4; ++i) { const float gg = fminf(gv[n][i], 7.f), uu = fminf(fmaxf(uv[n][i], -7.f), 7.f);
                        const float sg = __builtin_amdgcn_rcpf(1.f + __builtin_amdgcn_exp2f(-1.702f * 1.4426950408889634f * gg)); o[4 * n + i] = (uu + 1.f) * gg * sg; }
                u32x4 w; w.x = cvt_pk_bf16(o[0], o[1]); w.y = cvt_pk_bf16(o[2], o[3]); w.z = cvt_pk_bf16(o[4], o[5]); w.w = cvt_pk_bf16(o[6], o[7]);
                *(u32x4*)(O + (size_t)(row0 + ai * HALF + m * 16) * ldc + col0) = w; asm volatile("" ::: "memory"); }
    }
};
struct EpiMoe2 {
    static constexpr bool PERM = true, AFTER_DRAIN = false;
    bf16_t* O; int ldc; const float* b2; const float* gate;
    __device__ __forceinline__ void operator()(const f32x4 (&acc)[2][2][4][2], const Unit& u, int wr, int wc, int fr, int fq) const {
        const int row0 = u.orow + wr * 64 + fr, col0 = u.ocol + wc * 32 + 8 * fq;
        const float* bp = b2 + (size_t)u.e * 1024 + col0;
#pragma unroll
        for (int bj = 0; bj < 2; ++bj) {
            const f32x4 bv0 = *(const f32x4*)(bp + bj * HALF), bv1 = *(const f32x4*)(bp + bj * HALF + 4);
#pragma unroll
            for (int ai = 0; ai < 2; ++ai)
#pragma unroll
                for (int m = 0; m < 4; ++m) { const int row = row0 + ai * HALF + m * 16; const float gt = gate[row];
                    const f32x4 v0 = (acc[ai][bj][m][0] + bv0) * gt, v1 = (acc[ai][bj][m][1] + bv1) * gt;
                    u32x4 w; w.x = cvt_pk_bf16(v0[0], v0[1]); w.y = cvt_pk_bf16(v0[2], v0[3]); w.z = cvt_pk_bf16(v1[0], v1[1]); w.w = cvt_pk_bf16(v1[2], v1[3]);
                    *(u32x4*)(O + (size_t)row * ldc + col0 + bj * HALF) = w; asm volatile("" ::: "memory"); }
        }
    }
};

struct MoeFusedOrder {
    static constexpr bool GATHER = true;
    const int* rowmap; const int* blk_e; const char* X; const char* ACT; const char* W1; const char* W2; unsigned* ready; unsigned* tmo; int nblk, NG, G, c, total, mode;
    __device__ void init(const void* X_, const void* ACT_, const void* W1_, const void* W2_, const int* rowmap_, const int* blk_e_, unsigned* ready_, unsigned* tmo_, int nblk_, int G_, int c_) {
        X = (const char*)X_; ACT = (const char*)ACT_; W1 = (const char*)W1_; W2 = (const char*)W2_; rowmap = rowmap_; blk_e = blk_e_; ready = ready_; tmo = tmo_; nblk = nblk_; NG = (nblk_ + 31) >> 5; G = G_; c = c_; total = nblk_ * 12; }
    __device__ bool next(int i, Unit& u) const {
        int Lq = i * G + c; if (Lq >= total) return false;
#if defined(FUSE_SPLIT)
        if (c >= 0) { const int kind = mode - 1; if (Lq >= nblk * (kind ? 4 : 8)) return false; const int q = Lq; const int pm = q % nblk, pn = q / nblk, e = __builtin_amdgcn_readfirstlane(blk_e[pm]);
          u.kind = kind; u.e = e; u.orow = pm * BM;
          if (kind == 0) { u.pa = X; u.pb = W1 + ((size_t)e * 2048 + (size_t)pn * 256) * 2048; u.ocol = pn * 128; }
          else { u.pa = ACT; u.pb = W2 + ((size_t)e * 1024 + (size_t)pn * 256) * 2048; u.ocol = pn * 256; }
          return true; }
#endif
#if defined(FUSE_SERIAL)
        { const int n1 = nblk * 8; int kind = Lq < n1 ? 0 : 1; int q = kind ? Lq - n1 : Lq; const int pm = q % nblk, pn = q / nblk, e = __builtin_amdgcn_readfirstlane(blk_e[pm]);
          u.kind = kind; u.e = e; u.orow = pm * BM;
          if (kind == 0) { u.pa = X; u.pb = W1 + ((size_t)e * 2048 + (size_t)pn * 256) * 2048; u.ocol = pn * 128; }
          else { u.pa = ACT; u.pb = W2 + ((size_t)e * 1024 + (size_t)pn * 256) * 2048; u.ocol = pn * 256; }
          return true; }
#endif
        int kind = 0, g = 0;
        for (int sgm = 0; ; ++sgm) {
            if (sgm < 3) { kind = 0; g = sgm; }
            else if (sgm < 3 + 2 * (NG - 3)) { const int j = (sgm - 3) >> 1; if (((sgm - 3) & 1) == 0) { kind = 0; g = j + 3; } else { kind = 1; g = j; } }
            else { kind = 1; g = NG - 3 + (sgm - (3 + 2 * (NG - 3))); }
            const int mg = min(32, nblk - 32 * g), sz = mg * (kind ? 4 : 8);
            if (Lq < sz) { const int pm = 32 * g + Lq % mg, pn = Lq / mg, e = __builtin_amdgcn_readfirstlane(blk_e[pm]);
                u.kind = kind; u.e = e; u.orow = pm * BM;
                if (kind == 0) { u.pa = X; u.pb = W1 + ((size_t)e * 2048 + (size_t)pn * 256) * 2048; u.ocol = pn * 128; }
                else { u.pa = ACT; u.pb = W2 + ((size_t)e * 1024 + (size_t)pn * 256) * 2048; u.ocol = pn * 256; }
                return true; }
            Lq -= sz;
        }
    }
    __device__ __forceinline__ int rowof(const Unit& u, int r) const { return u.kind == 0 ? rowmap[r] : r; }
    __device__ __forceinline__ void a_ready(const Unit& u) const {
        if (u.kind == 0) return;
#if defined(FUSE_SPLIT)
        return;
#endif
        if (threadIdx.x < 64) {
#if defined(FUSE_GLOBAL_WAIT)
            const unsigned long long t0 = __builtin_amdgcn_s_memrealtime(); unsigned polls = 0; unsigned* rp = ready + 64 * 500; const unsigned want = (unsigned)nblk * 64u;
#else
            const unsigned long long t0 = __builtin_amdgcn_s_memrealtime(); unsigned polls = 0; unsigned* rp = ready + 64 * (u.orow >> 8); const unsigned want = 64u;
#endif
            while ((unsigned)__builtin_amdgcn_readfirstlane(__hip_atomic_load(rp, __ATOMIC_RELAXED, __HIP_MEMORY_SCOPE_AGENT)) < want) {
                if ((++polls & 255u) == 0u && __builtin_amdgcn_readfirstlane(__hip_atomic_load(tmo, __ATOMIC_RELAXED, __HIP_MEMORY_SCOPE_AGENT)) != 0u) break;
                if (__builtin_amdgcn_s_memrealtime() - t0 > 2000000ull) { if (threadIdx.x == 0) __hip_atomic_store(tmo, 1u, __ATOMIC_RELAXED, __HIP_MEMORY_SCOPE_AGENT); break; }
                __builtin_amdgcn_s_sleep(2); }
#if defined(FUSE_CONSUMER_WB)
            __builtin_amdgcn_fence(__ATOMIC_RELEASE, "agent"); asm volatile("s_waitcnt vmcnt(0)" ::: "memory");
#endif
#if defined(FUSE_DELAY)
            { const unsigned long long t1 = __builtin_amdgcn_s_memrealtime(); while (__builtin_amdgcn_s_memrealtime() - t1 < 2000ull) __builtin_amdgcn_s_sleep(8); }
#endif
            __builtin_amdgcn_fence(__ATOMIC_ACQUIRE, "agent");
            asm volatile("s_waitcnt vmcnt(0)" ::: "memory");
        }
        asm volatile("" ::: "memory"); __builtin_amdgcn_s_barrier(); asm volatile("" ::: "memory");
    }
    __device__ __forceinline__ void done(const Unit& u) const {
        if (u.kind != 0) return;
        asm volatile("s_waitcnt vmcnt(0)" ::: "memory");
#if defined(FUSE_HEAVY_RELEASE)
        __builtin_amdgcn_fence(__ATOMIC_RELEASE, "agent"); asm volatile("s_waitcnt vmcnt(0)" ::: "memory");
#endif
#if defined(FUSE_GLOBAL_WAIT)
        if ((threadIdx.x & 63) == 0) __hip_atomic_fetch_add(ready + 64 * 500, 1u, __ATOMIC_RELAXED, __HIP_MEMORY_SCOPE_AGENT);
#else
        if ((threadIdx.x & 63) == 0) __hip_atomic_fetch_add(ready + 64 * (u.orow >> 8), 1u, __ATOMIC_RELAXED, __HIP_MEMORY_SCOPE_AGENT);
#endif
    }
};
__device__ __forceinline__ void store16_sc1(void* p, u32x4 v) { asm volatile("global_store_dwordx4 %0, %1, off sc1\n\ts_nop 1" :: "v"(p), "v"(v) : "memory"); }
struct EpiMoeFused {
    static constexpr bool PERM = true, AFTER_DRAIN = false;
    bf16_t* ACTo; const float* b1; bf16_t* Yo; const float* b2; const float* gate;
    __device__ __forceinline__ void operator()(const f32x4 (&acc)[2][2][4][2], const Unit& u, int wr, int wc, int fr, int fq) const {
        if (u.kind == 0) {
            const int row0 = u.orow + wr * 64 + fr, cl = wc * 32 + 8 * fq, col0 = u.ocol + cl;
            const float* bg = b1 + (size_t)u.e * 2048 + col0; const float* bu = bg + 1024;
            const f32x4 bg0 = *(const f32x4*)bg, bg1 = *(const f32x4*)(bg + 4), bu0 = *(const f32x4*)bu, bu1 = *(const f32x4*)(bu + 4);
#pragma unroll
            for (int ai = 0; ai < 2; ++ai)
#pragma unroll
                for (int m = 0; m < 4; ++m) {
                    f32x4 gv[2] = {acc[ai][0][m][0] + bg0, acc[ai][0][m][1] + bg1}, uv[2] = {acc[ai][1][m][0] + bu0, acc[ai][1][m][1] + bu1}; float o[8];
#pragma unroll
                    for (int n = 0; n < 2; ++n)
#pragma unroll
                        for (int i = 0; i < 4; ++i) { const float gg = fminf(gv[n][i], 7.f), uu = fminf(fmaxf(uv[n][i], -7.f), 7.f);
                            const float sg = __builtin_amdgcn_rcpf(1.f + __builtin_amdgcn_exp2f(-1.702f * 1.4426950408889634f * gg)); o[4 * n + i] = (uu + 1.f) * gg * sg; }
                    u32x4 w; w.x = cvt_pk_bf16(o[0], o[1]); w.y = cvt_pk_bf16(o[2], o[3]); w.z = cvt_pk_bf16(o[4], o[5]); w.w = cvt_pk_bf16(o[6], o[7]);
#if defined(FUSE_PLAIN_STORE)
                    *(u32x4*)(ACTo + (size_t)(row0 + ai * HALF + m * 16) * 1024 + col0) = w; }
#else
                    store16_sc1(ACTo + (size_t)(row0 + ai * HALF + m * 16) * 1024 + col0, w); }
#endif
        } else {
            const int row0 = u.orow + wr * 64 + fr, col0 = u.ocol + wc * 32 + 8 * fq;
            const float* bp = b2 + (size_t)u.e * 1024 + col0;
#pragma unroll
            for (int bj = 0; bj < 2; ++bj) {
                const f32x4 bv0 = *(const f32x4*)(bp + bj * HALF), bv1 = *(const f32x4*)(bp + bj * HALF + 4);
#pragma unroll
                for (int ai = 0; ai < 2; ++ai)
#pragma unroll
                    for (int m = 0; m < 4; ++m) { const int row = row0 + ai * HALF + m * 16; const float gt = gate[row];
                        const f32x4 v0 = (acc[ai][bj][m][0] + bv0) * gt, v1 = (acc[ai][bj][m][1] + bv1) * gt;
                        u32x4 w; w.x = cvt_pk_bf16(v0[0], v0[1]); w.y = cvt_pk_bf16(v0[2], v0[3]); w.z = cvt_pk_bf16(v1[0], v1[1]); w.w = cvt_pk_bf16(v1[2], v1[3]);
                        *(u32x4*)(Yo + (size_t)row * 1024 + col0 + bj * HALF) = w; asm volatile("" ::: "memory"); }
            }
        }
    }
};
}
typedef short v4i16_t __attribute__((ext_vector_type(4)));
__device__ __forceinline__ unsigned f2key_u(float f) { f = f + 0.0f; const unsigned u = __float_as_uint(f); return (u & 0x80000000u) ? ~u : (u | 0x80000000u); }

__device__ __forceinline__ void ph_cnorm_b(const bf16_t* pa, const float* g, bf16_t* cnb) {
  const int tid = TIDX(), lane = tid & 63, gw = BIDX() * 8 + (tid >> 6), NGW = (int)gridDim.x * 8;
  const f32x4 g4 = *(const f32x4*)(g + lane * 4);
  for (int row = gw; row < NT; row += NGW) {
    const v2u v = *(const v2u*)(pa + (size_t)row * 2048 + 1024 + lane * 4);
    const f32x4 f = (f32x4){bf_lo(v[0]), bf_hi(v[0]), bf_lo(v[1]), bf_hi(v[1])};
    const float r = rsqrtf(wave_sum((f[0] * f[0] + f[1] * f[1]) + (f[2] * f[2] + f[3] * f[3])) * (1.f / 256.f) + 1e-6f);
    const f32x4 o = f * r * g4;
    *(v2u*)(cnb + (size_t)row * 256 + lane * 4) = (v2u){cvt_pk_bf16(o[0], o[1]), cvt_pk_bf16(o[2], o[3])};
  }
}

__device__ __forceinline__ int moe_layer_tile(int layer, int j) { return j < 8192 ? layer * 8192 + j : 16384 + layer * 4096 + (j - 8192); }
__device__ __forceinline__ void moe_weight_tile(int T, const float* w1, const float* w2, bf16_t* W1_t, bf16_t* W2_t, int lane) {
  if (T < 16384) { const int le = T >> 8; transpose_tile(mk_tjob(w1 + (size_t)le * D * 2048, 2048, D, 2048, W1_t + (size_t)le * 2048 * D, D, 0, 0, 1), T & 255, lane); }
  else if (T < 24576) { const int t2 = T - 16384, le = t2 >> 7; transpose_tile(mk_tjob(w2 + (size_t)le * D * D, D, D, D, W2_t + (size_t)le * D * D, D, 0, 0, 0), t2 & 127, lane); }
}
typedef _Float16 h16x2_t __attribute__((ext_vector_type(2)));
__device__ __forceinline__ unsigned cvt_pk_f16(float lo, float hi) { const f32x2_t v = {lo, hi}; const h16x2_t h = __builtin_convertvector(v, h16x2_t); return __builtin_bit_cast(unsigned, h); }
__device__ __forceinline__ void ph_iscore(const bf16_t* pa, unsigned short* sc, const float* w1, const float* w2, bf16_t* W1_t, bf16_t* W2_t) {
  const int tid = TIDX(), lane = tid & 63, gw = BIDX() * 8 + (tid >> 6), NGW = (int)gridDim.x * 8;
  const int n16 = lane & 15, g = lane >> 4;
  int wt = gw;
#pragma unroll 1
  for (int u = gw; u < 2 * 4352; u += NGW) {
    const int b = u / 4352, v = u % 4352;
    int a = 0; while (a < 15 && 16 * (a + 1) * (a + 2) <= v) ++a;
    const int rem = v - 16 * a * (a + 1), r = rem / (a + 1), ch = rem % (a + 1);
    const int qg = 32 * a + r, ntile = (ch < a) ? 32 : (r + 1), t0 = qg * 16, kt0 = ch * 32;
    const bf16_t* qrow = pa + (size_t)(b * L + t0 + n16) * 2048;
    bf16x8 qf[8][2]; float w[8];
#pragma unroll
    for (int h = 0; h < 8; ++h) { qf[h][0] = *(const bf16x8*)(qrow + 1280 + h * 64 + 8 * g); qf[h][1] = *(const bf16x8*)(qrow + 1280 + h * 64 + 32 + 8 * g); w[h] = bf2f(qrow[1856 + h]) * (0.35355339059327373f * 0.125f); }
    const bf16_t* kbase = pa + (size_t)(b * L + n16) * 2048 + 1792 + 8 * g;
    unsigned short* srow = sc + (size_t)(b * L + t0 + n16) * L + 4 * g;
    bf16x8 kr[8][2];
    const int ktl = kt0 + ntile - 1;
#pragma unroll
    for (int p = 0; p < 8; ++p) { const int kk = min(kt0 + p, ktl); kr[p][0] = *(const bf16x8*)(kbase + (size_t)kk * 16 * 2048); kr[p][1] = *(const bf16x8*)(kbase + (size_t)kk * 16 * 2048 + 32); }
#pragma unroll 1
    for (int kt8 = kt0; kt8 < kt0 + ntile; kt8 += 8) {
#pragma unroll
      for (int p = 0; p < 8; ++p) {
        const int kt = kt8 + p;
        const bf16x8 k0 = kr[p][0], k1 = kr[p][1];
        { const int kk = min(kt + 8, ktl); kr[p][0] = *(const bf16x8*)(kbase + (size_t)kk * 16 * 2048); kr[p][1] = *(const bf16x8*)(kbase + (size_t)kk * 16 * 2048 + 32); }
        f32x4 score = (f32x4){0.f, 0.f, 0.f, 0.f};
#pragma unroll
        for (int h = 0; h < 8; ++h) {
          f32x4 acc = __builtin_amdgcn_mfma_f32_16x16x32_bf16(k0, qf[h][0], (f32x4){0.f, 0.f, 0.f, 0.f}, 0, 0, 0);
          acc = __builtin_amdgcn_mfma_f32_16x16x32_bf16(k1, qf[h][1], acc, 0, 0, 0);
#pragma unroll
          for (int i = 0; i < 4; ++i) score[i] = fmaf(fmaxf(acc[i], 0.f), w[h], score[i]);
        }
        if (kt <= ktl) *(v2u*)(srow + kt * 16) = (v2u){cvt_pk_f16(score[0], score[1]), cvt_pk_f16(score[2], score[3])};
      }
    }
  }
  (void)wt; (void)w1; (void)w2; (void)W1_t; (void)W2_t;
}

constexpr int DW_STRIDE = 17152;
__device__ __forceinline__ unsigned offb(unsigned row, unsigned ch) { return 256u * row + 16u * (ch ^ (((row & 3u) << 2) | ((row >> 2) & 3u))); }
__device__ __forceinline__ void glds16(const void* gsrc, unsigned lds_dst) { unsigned keep;
  asm volatile("s_mov_b32 %0, m0\n\ts_mov_b32 m0, %2\n\ts_nop 0\n\tglobal_load_lds_dwordx4 %1, off\n\ts_mov_b32 m0, %0" : "=&s"(keep) : "v"(gsrc), "s"(lds_dst) : "memory"); }
__device__ __forceinline__ int wave_excl_scan(int v, int lane, int& total) {
  int x = v;
#pragma unroll
  for (int o = 1; o < 64; o <<= 1) { const int y = __shfl_up(x, o); if (lane >= o) x += y; }
  total = __shfl(x, 63); return x - v;
}
#define LDSW() asm volatile("s_waitcnt lgkmcnt(0)" ::: "memory")
__device__ __forceinline__ int wave_incl_scan_dpp(int v, int lane, int& total) {
  int x = v;
  x += __builtin_amdgcn_update_dpp(0, x, 0x111, 0xf, 0xf, true);
  x += __builtin_amdgcn_update_dpp(0, x, 0x112, 0xf, 0xf, true);
  x += __builtin_amdgcn_update_dpp(0, x, 0x114, 0xf, 0xf, true);
  x += __builtin_amdgcn_update_dpp(0, x, 0x118, 0xf, 0xf, true);
  const int t0 = __builtin_amdgcn_readlane(x, 15), t1 = __builtin_amdgcn_readlane(x, 31), t2 = __builtin_amdgcn_readlane(x, 47), t3 = __builtin_amdgcn_readlane(x, 63);
  const int row = lane >> 4;
  x += (row >= 1 ? t0 : 0) + (row >= 2 ? t1 : 0) + (row >= 3 ? t2 : 0);
  total = t0 + t1 + t2 + t3; return x;
}

__device__ __forceinline__ unsigned h2key(unsigned h) { return (h & 0x8000u) ? (~h & 0xFFFFu) : (h | 0x8000u); }
__device__ __forceinline__ int wave_select(const unsigned short* srow, int t, LAS unsigned char* wl, LAS unsigned short* idx16, int lane) {
  const int n = t + 1;
  if (n <= 256) { for (int i = lane; i < 256; i += 64) idx16[i] = (unsigned short)(i < n ? i : 0); LDSW(); return n; }
  LAS unsigned* hist = (LAS unsigned*)wl;
  for (int i = lane; i < 1024; i += 64) ((LAS v4u*)hist)[i] = (v4u){0u, 0u, 0u, 0u};
  unsigned bk[16][4];
#if defined(SEL_REP_LOAD)
#pragma unroll 1
  for (int rep_ = 0; rep_ < 2; ++rep_)
#endif
#pragma unroll
  for (int i = 0; i < 16; ++i) {
    bk[i][0] = 0u; bk[i][1] = 0u; bk[i][2] = 0u; bk[i][3] = 0u;
    if (i * 512 < n) { const int e0 = (i * 64 + lane) * 8;
      if (e0 < n) { const v4u f = *(const v4u*)(srow + e0);
#pragma unroll
        for (int c = 0; c < 4; ++c) { unsigned lo = f[c] & 0xFFFFu, hi = f[c] >> 16; lo = lo + 0u;
          const unsigned b0 = (e0 + 2 * c <= t) ? (h2key(lo == 0x8000u ? 0u : lo) >> 4) : 0u, b1 = (e0 + 2 * c + 1 <= t) ? (h2key(hi == 0x8000u ? 0u : hi) >> 4) : 0u;
          bk[i][c] = b0 | (b1 << 16); } } }
    if ((i & 7) == 7) asm volatile("" ::: "memory");
  }
#define BIN_OF(i, c) ((bk[i][(c) >> 1] >> (((c) & 1) * 16)) & 0xFFFFu)
  LDSW();
#if defined(SEL_REP_HIST)
#pragma unroll 1
  for (int rep_ = 0; rep_ < 2; ++rep_) {
  for (int i = lane; i < 1024; i += 64) ((LAS v4u*)hist)[i] = (v4u){0u, 0u, 0u, 0u};
  LDSW();
#endif
#pragma unroll
  for (int i = 0; i < 16; ++i) if (i * 512 < n) {
#pragma unroll
    for (int c = 0; c < 8; ++c) { const unsigned bin = BIN_OF(i, c); __hip_atomic_fetch_add(hist + bin, 1u, __ATOMIC_RELAXED, __HIP_MEMORY_SCOPE_WORKGROUP); }
    asm volatile("" ::: "memory"); }
  LDSW();
#if defined(SEL_REP_HIST)
  }
#endif
  const int bbase = 4096 - 64 * (lane + 1); int ssum = 0;
#pragma unroll 16
  for (int k = 0; k < 64; ++k) ssum += (int)hist[bbase + ((k + lane) & 63)];
  int tot; const int pre = wave_incl_scan_dpp(ssum, lane, tot) - ssum;
  const unsigned long long bal = __ballot(pre < 256 && pre + ssum >= 256);
  const int Ls = (int)__builtin_ctzll(bal);
  const int cum0 = __builtin_amdgcn_readlane(pre, Ls), sb = 4096 - 64 * (Ls + 1);
  const int ck = (int)hist[sb + 63 - lane]; int t2_; const int inc = wave_incl_scan_dpp(ck, lane, t2_);
  const unsigned long long bal2 = __ballot(cum0 + inc >= 256);
  const int kk = (int)__builtin_ctzll(bal2);
  const int B1 = sb + 63 - kk, cnt_gt = cum0 + __builtin_amdgcn_readlane(inc, kk) - __builtin_amdgcn_readlane(ck, kk), need1 = 256 - cnt_gt;
  LDSW();
  const unsigned kg = (0x7FFFu - (unsigned)B1) * 0x00010001u, kge = kg + 0x00010001u;
  int ngt = 0, neq = 0;
#pragma unroll
  for (int i = 0; i < 16; ++i) if (i * 512 < n) {
#pragma unroll
    for (int c2 = 0; c2 < 4; ++c2) { const unsigned x = bk[i][c2], fg = (x + kg) & 0x80008000u, fe = ((x + kge) & 0x80008000u) & ~fg; ngt += __builtin_popcount(fg); neq += __builtin_popcount(fe); } }
  int tg, te; int pg = wave_incl_scan_dpp(ngt, lane, tg) - ngt; int pe = wave_incl_scan_dpp(neq, lane, te) - neq;
  LAS unsigned short* cand = (LAS unsigned short*)wl;
#pragma unroll
  for (int i = 0; i < 16; ++i) if (i * 512 < n) {
#pragma unroll
    for (int c2 = 0; c2 < 4; ++c2) { const unsigned x = bk[i][c2], fg = (x + kg) & 0x80008000u, fe = ((x + kge) & 0x80008000u) & ~fg; const int e = (i * 64 + lane) * 8 + 2 * c2;
      if (fg & 0x8000u) { idx16[pg] = (unsigned short)e; ++pg; }
      if (fg & 0x80000000u) { idx16[pg] = (unsigned short)(e + 1); ++pg; }
      if (fe & 0x8000u) { cand[pe] = (unsigned short)e; ++pe; }
      if (fe & 0x80000000u) { cand[pe] = (unsigned short)(e + 1); ++pe; } }
    asm volatile("" ::: "memory"); }
#undef BIN_OF
  LDSW();
  const int m = te;
  unsigned lo = 0u;
  if (m <= 64) {
    unsigned cpv = 0u; if (lane < m) { const unsigned ci = cand[lane]; unsigned hv = srow[ci]; hv = (hv == 0x8000u) ? 0u : hv; cpv = ((h2key(hv) & 15u) << 13) | (8191u - ci) | (1u << 20); }
    int rank = 0;
    for (int k = 0; k < m; ++k) { const unsigned ok = (unsigned)__builtin_amdgcn_readlane((int)cpv, k); rank += (ok > cpv) ? 1 : 0; }
    const bool sel = (lane < m) && (rank < need1);
    const unsigned long long bs = __ballot(sel);
    if (sel) idx16[cnt_gt + __builtin_popcountll(bs & ((1ull << lane) - 1ull))] = (unsigned short)(8191u - (cpv & 0x1FFFu));
  } else if (m <= 256) {
    unsigned cp[4];
#pragma unroll
    for (int j = 0; j < 4; ++j) { const int q = lane + 64 * j; cp[j] = 0u; if (q < m) { const unsigned ci = cand[q]; unsigned hv = srow[ci]; hv = (hv == 0x8000u) ? 0u : hv; cp[j] = ((h2key(hv) & 15u) << 13) | (8191u - ci) | (1u << 20); } }
    for (int bit = 16; bit >= 0; --bit) { const unsigned trial = lo | (1u << bit); int tc = 0;
#pragma unroll
      for (int j = 0; j < 4; ++j) tc += __builtin_popcountll(__ballot((cp[j] >> 20) && ((cp[j] & 0x1FFFFu) >= trial)));
      if (tc >= need1) lo = trial; }
    int pos = cnt_gt;
#pragma unroll
    for (int j = 0; j < 4; ++j) { const bool sel = (cp[j] >> 20) && ((cp[j] & 0x1FFFFu) >= lo); const unsigned long long bs = __ballot(sel);
      if (sel) idx16[pos + __builtin_popcountll(bs & ((1ull << lane) - 1ull))] = (unsigned short)(8191u - (cp[j] & 0x1FFFu)); pos += __builtin_popcountll(bs); }
  } else {
    for (int bit = 16; bit >= 0; --bit) { const unsigned trial = lo | (1u << bit); int c = 0;
      for (int q = lane; q < m; q += 64) { const unsigned ci = cand[q]; unsigned hv = srow[ci]; hv = (hv == 0x8000u) ? 0u : hv; const unsigned cpq = ((h2key(hv) & 15u) << 13) | (8191u - ci); c += (cpq >= trial) ? 1 : 0; }
      int tc; (void)wave_excl_scan(c, lane, tc); if (tc >= need1) lo = trial; }
    int base = cnt_gt;
    for (int q0 = 0; q0 < m; q0 += 64) { const int q = q0 + lane; bool sel = false; unsigned ci = 0;
      if (q < m) { ci = cand[q]; unsigned hv = srow[ci]; hv = (hv == 0x8000u) ? 0u : hv; const unsigned cpq = ((h2key(hv) & 15u) << 13) | (8191u - ci); sel = cpq >= lo; }
      int tc; const int pos = base + wave_excl_scan(sel ? 1 : 0, lane, tc); if (sel) idx16[pos] = (unsigned short)ci; base += tc; }
  }
  LDSW();
  return 256;
}

__device__ __forceinline__ void wave_attend(int b, int t, int cnt, const bf16_t* qlat, const bf16_t* cnb, LAS unsigned char* wl, LAS unsigned short* idx16, bf16_t* olat, int lane) {
  const int n16 = lane & 15, g = lane >> 4, q4 = (lane & 15) >> 2, p4 = lane & 3;
  const bf16_t* qrow = qlat + (size_t)(b * L + t) * 4096 + n16 * 256 + 8 * g;
  bf16x8 qf[8];
#pragma unroll
  for (int s = 0; s < 8; ++s) qf[s] = *(const bf16x8*)(qrow + 32 * s);
  f32x4 o[16];
#pragma unroll
  for (int c = 0; c < 16; ++c) o[c] = (f32x4){0.f, 0.f, 0.f, 0.f};
  float mrun = -INFINITY, lrun = 0.f;
  const int ntile = (cnt + 31) >> 5;
  const char* cb = (const char*)(cnb + (size_t)b * L * 256);
  const unsigned slot = lane & 15, rsub = lane >> 4;
  constexpr float SC = 0.125f * 1.4426950408889634f;
  v4u stg[16];
#define GATHER_TILE(itn) do { _Pragma("unroll") for (int rg = 0; rg < 8; ++rg) { const unsigned row = 4 * rg + rsub; const unsigned key = idx16[32 * (itn) + row]; \
      const unsigned ch = slot ^ (((row & 3u) << 2) | ((row >> 2) & 3u)); const char* src = cb + (size_t)key * 512 + ch * 16; \
      stg[rg] = *(const v4u*)src; stg[8 + rg] = *(const v4u*)(src + 256); } } while (0)
  GATHER_TILE(0);
#pragma unroll 1
  for (int it = 0; it < ntile; ++it) {
#pragma unroll
    for (int rg = 0; rg < 8; ++rg) { *(LAS v4u*)(wl + rg * 1024 + lane * 16) = stg[rg]; *(LAS v4u*)(wl + 8192 + rg * 1024 + lane * 16) = stg[8 + rg]; }
    LDSW();
    if (it + 1 < ntile) GATHER_TILE(it + 1);
    f32x4 s0 = (f32x4){0.f, 0.f, 0.f, 0.f}, s1 = (f32x4){0.f, 0.f, 0.f, 0.f};
#pragma unroll
    for (int s = 0; s < 8; ++s) { const unsigned ib = (s >> 2) * 8192, chq = 4 * (s & 3) + g;
      const bf16x8 a0 = *(const LAS bf16x8*)(wl + ib + offb(n16, chq)), a1 = *(const LAS bf16x8*)(wl + ib + offb(16 + n16, chq));
      s0 = __builtin_amdgcn_mfma_f32_16x16x32_bf16(a0, qf[s], s0, 0, 0, 0); s1 = __builtin_amdgcn_mfma_f32_16x16x32_bf16(a1, qf[s], s1, 0, 0, 0); }
    const int sl0 = 32 * it + 4 * g;
    float mx = -INFINITY;
#pragma unroll
    for (int r = 0; r < 4; ++r) { s0[r] = (sl0 + r < cnt) ? s0[r] * SC : -INFINITY; s1[r] = (sl0 + 16 + r < cnt) ? s1[r] * SC : -INFINITY; mx = fmaxf(mx, fmaxf(s0[r], s1[r])); }
    mx = fmaxf(mx, __shfl_xor(mx, 16)); mx = fmaxf(mx, __shfl_xor(mx, 32));
    const float mnew = fmaxf(mrun, mx), alpha = __builtin_amdgcn_exp2f(mrun - mnew);
    float ls = 0.f; float pv[8];
#pragma unroll
    for (int r = 0; r < 4; ++r) { pv[r] = __builtin_amdgcn_exp2f(s0[r] - mnew); pv[4 + r] = __builtin_amdgcn_exp2f(s1[r] - mnew); ls += pv[r] + pv[4 + r]; }
    ls += __shfl_xor(ls, 16); ls += __shfl_xor(ls, 32);
    lrun = lrun * alpha + ls; mrun = mnew;
#pragma unroll
    for (int c = 0; c < 16; ++c) o[c] = o[c] * alpha;
    const v4u pbw = (v4u){cvt_pk_bf16(pv[0], pv[1]), cvt_pk_bf16(pv[2], pv[3]), cvt_pk_bf16(pv[4], pv[5]), cvt_pk_bf16(pv[6], pv[7])};
    const bf16x8 pb = __builtin_bit_cast(bf16x8, pbw);
#pragma unroll
    for (int c = 0; c < 16; ++c) { const unsigned ib = (c >> 3) * 8192, chc = 2 * (c & 7) + (p4 >> 1);
      const v4i16_t t0 = __builtin_amdgcn_ds_read_tr16_b64_v4i16((LAS v4i16_t*)(wl + ib + offb(4 * g + q4, chc) + 8 * (p4 & 1)));
      const v4i16_t t1 = __builtin_amdgcn_ds_read_tr16_b64_v4i16((LAS v4i16_t*)(wl + ib + offb(16 + 4 * g + q4, chc) + 8 * (p4 & 1)));
      const bf16x8 af = (bf16x8){t0[0], t0[1], t0[2], t0[3], t1[0], t1[1], t1[2], t1[3]};
      o[c] = __builtin_amdgcn_mfma_f32_16x16x32_bf16(af, pb, o[c], 0, 0, 0); }
    LDSW();
  }
  const float inv = 1.f / lrun;
  bf16_t* orow = olat + (size_t)(b * L + t) * 4096 + n16 * 256 + 4 * g;
#pragma unroll
  for (int c = 0; c < 16; ++c) { const f32x4 v = o[c] * inv; *(v2u*)(orow + 16 * c) = (v2u){cvt_pk_bf16(v[0], v[1]), cvt_pk_bf16(v[2], v[3])}; }
}

__device__ __forceinline__ void ph_select_attend(const unsigned short* sc, const bf16_t* qlat, const bf16_t* cnb, bf16_t* olat, LAS unsigned char* lds, const float* w1, const float* w2, bf16_t* W1_t, bf16_t* W2_t) {
  const int tid = TIDX(), lane = tid & 63, wave = __builtin_amdgcn_readfirstlane(tid >> 6), blk = BIDX();
  LAS unsigned char* wl = lds + wave * DW_STRIDE; LAS unsigned short* idx16 = (LAS unsigned short*)(wl + 16384);
  const int b = blk & 1, wb = (blk >> 1) * 8 + wave, nwb = ((int)gridDim.x >> 1) * 8;
  const int gw = blk * 8 + wave, NGW = (int)gridDim.x * 8; int wt = gw;
#pragma unroll 1
  for (int t = wb, qi = 0; t < L; t += nwb, ++qi) {
    int lane_s = lane; asm volatile("" : "+v"(lane_s));
    const int cnt = wave_select(sc + (size_t)(b * L + t) * L, t, wl, idx16, lane_s);
#if defined(DUPSEL)
    { int lane_s2 = lane; asm volatile("" : "+v"(lane_s2)); const int cnt2 = wave_select(sc + (size_t)(b * L + t) * L, t, wl, idx16, lane_s2); if (cnt2 != cnt) olat[0] = 0; }
#endif
    int lane_a = lane; asm volatile("" : "+v"(lane_a));
    wave_attend(b, t, cnt, qlat, cnb, wl, idx16, olat, lane_a);
#if defined(DUPATT)
    { int lane_a2 = lane; asm volatile("" : "+v"(lane_a2)); wave_attend(b, t, cnt, qlat, cnb, wl, idx16, olat, lane_a2); }
#endif
    const int ntl = (qi < 4) ? 2 : 1;
#pragma unroll 1
    for (int k = 0; k < ntl; ++k) { int lane_t = lane; asm volatile("" : "+v"(lane_t)); if (wt < 24576) moe_weight_tile(wt < 12288 ? moe_layer_tile(0, wt) : moe_layer_tile(1, wt - 12288), w1, w2, W1_t, W2_t, lane_t); wt += NGW; }
  }
#pragma unroll 1
  for (; wt < 24576; wt += NGW) { int lane_t = lane; asm volatile("" : "+v"(lane_t)); moe_weight_tile(wt < 12288 ? moe_layer_tile(0, wt) : moe_layer_tile(1, wt - 12288), w1, w2, W1_t, W2_t, lane_t); }
}

__device__ __forceinline__ void ph_qlat(const bf16_t* pa, const bf16_t* WqT, bf16_t* qlat) {
  const int tid = TIDX(), lane = tid & 63, gw = BIDX() * 8 + (tid >> 6), NGW = (int)gridDim.x * 8;
  const int n16 = lane & 15, g = lane >> 4;
#pragma unroll 1
  for (int it = gw; it < 16 * 512; it += NGW) {
    const int h = it & 15, rt = it >> 4;
    bf16x8 qb[2][2];
#pragma unroll
    for (int mt = 0; mt < 2; ++mt)
#pragma unroll
      for (int ks = 0; ks < 2; ++ks) qb[mt][ks] = *(const bf16x8*)(pa + (size_t)(rt * 32 + mt * 16 + n16) * 2048 + h * 64 + 32 * ks + 8 * g);
    const bf16_t* wp = WqT + (size_t)h * 256 * 64 + (size_t)n16 * 64 + 8 * g;
    bf16_t* op = qlat + (size_t)(rt * 32 + n16) * 4096 + h * 256 + 4 * g;
#pragma unroll 4
    for (int ct = 0; ct < 16; ++ct) {
      const bf16x8 a0 = *(const bf16x8*)(wp + (size_t)(16 * ct) * 64), a1 = *(const bf16x8*)(wp + (size_t)(16 * ct) * 64 + 32);
#pragma unroll
      for (int mt = 0; mt < 2; ++mt) { f32x4 acc = __builtin_amdgcn_mfma_f32_16x16x32_bf16(a0, qb[mt][0], (f32x4){0.f, 0.f, 0.f, 0.f}, 0, 0, 0);
        acc = __builtin_amdgcn_mfma_f32_16x16x32_bf16(a1, qb[mt][1], acc, 0, 0, 0);
        *(v2u*)(op + (size_t)(mt * 16) * 4096 + 16 * ct) = (v2u){cvt_pk_bf16(acc[0], acc[1]), cvt_pk_bf16(acc[2], acc[3])}; }
    }
  }
}
__device__ __forceinline__ void ph_o2(const bf16_t* olat, const bf16_t* WuvT, bf16_t* o2b) {
  const int tid = TIDX(), lane = tid & 63, gw = BIDX() * 8 + (tid >> 6), NGW = (int)gridDim.x * 8;
  const int n16 = lane & 15, g = lane >> 4;
#pragma unroll 1
  for (int it = gw; it < 16 * 512; it += NGW) {
    const int h = it & 15, rt = it >> 4;
    f32x4 acc[4][2];
#pragma unroll
    for (int vt = 0; vt < 4; ++vt) { acc[vt][0] = (f32x4){0.f, 0.f, 0.f, 0.f}; acc[vt][1] = (f32x4){0.f, 0.f, 0.f, 0.f}; }
    const bf16_t* ap = olat + (size_t)(rt * 32 + n16) * 4096 + h * 256 + 8 * g;
    const bf16_t* wp = WuvT + (size_t)h * 64 * 256 + (size_t)n16 * 256 + 8 * g;
#pragma unroll
    for (int ks = 0; ks < 8; ++ks) {
      const bf16x8 b0 = *(const bf16x8*)(ap + 32 * ks), b1 = *(const bf16x8*)(ap + (size_t)16 * 4096 + 32 * ks);
#pragma unroll
      for (int vt = 0; vt < 4; ++vt) { const bf16x8 a = *(const bf16x8*)(wp + (size_t)(16 * vt) * 256 + 32 * ks);
        acc[vt][0] = __builtin_amdgcn_mfma_f32_16x16x32_bf16(a, b0, acc[vt][0], 0, 0, 0); acc[vt][1] = __builtin_amdgcn_mfma_f32_16x16x32_bf16(a, b1, acc[vt][1], 0, 0, 0); }
    }
    bf16_t* op = o2b + (size_t)(rt * 32 + n16) * 1024 + h * 64 + 4 * g;
#pragma unroll
    for (int vt = 0; vt < 4; ++vt)
#pragma unroll
      for (int mt = 0; mt < 2; ++mt) *(v2u*)(op + (size_t)(mt * 16) * 1024 + 16 * vt) = (v2u){cvt_pk_bf16(acc[vt][mt][0], acc[vt][mt][1]), cvt_pk_bf16(acc[vt][mt][2], acc[vt][mt][3])};
  }
}

namespace pg8 {
struct GroupAOrder {
    static constexpr bool GATHER = false; const int* rowmap;
    StaticOrder so; int png; size_t acol_bytes;
    __device__ void init(const void* A, int lda, const void* Bt, int ldb, int M, int N, int png_, size_t acol_bytes_, int G, int c) { so.init(A, lda, Bt, ldb, M, N, G, c); png = png_; acol_bytes = acol_bytes_; }
    __device__ bool next(int i, Unit& u) const { int pm, pn; if (!so.tile(i, pm, pn)) return false; u.pa = so.A + (size_t)pm * so.ta + (size_t)(pn / png) * acol_bytes; u.pb = so.Bt + (size_t)pn * so.tb; u.orow = pm * BM; u.ocol = pn * BM; u.e = 0; u.kind = 0; return true; }
    __device__ __forceinline__ int rowof(const Unit&, int r) const { return r; }
    __device__ __forceinline__ void a_ready(const Unit&) const {}
    __device__ __forceinline__ void done(const Unit&) const {}
};
}
constexpr int GLA_LDSU = 65536;

__device__ __forceinline__ v4i16_t trrd(LAS unsigned char* p) { return __builtin_amdgcn_ds_read_tr16_b64_v4i16((LAS v4i16_t*)p); }
__device__ __forceinline__ bf16x8 cat44(v4i16_t a, v4i16_t b) { return (bf16x8){a[0], a[1], a[2], a[3], b[0], b[1], b[2], b[3]}; }

__device__ __forceinline__ void ph_gla_a1(const bf16_t* pb, const float* gbias, bf16_t* qt, bf16_t* og, bf16_t* kvt, float* dcy, LAS unsigned char* lds, const float* w1, const float* w2, bf16_t* W1_t, bf16_t* W2_t) {
  const int tid = TIDX(), lane = tid & 63, wave = __builtin_amdgcn_readfirstlane(tid >> 6), blk = BIDX();
  const int half = wave >> 2, wq = wave & 3;
  LAS unsigned char* X = lds + half * GLA_LDSU; LAS unsigned char* Y = X + 16384; LAS unsigned char* V = X + 32768;
  LAS float* EX = (LAS float*)(lds + 131072 + half * 2048);
  const unsigned v_addr = (unsigned)__builtin_amdgcn_readfirstlane((int)(unsigned)(size_t)V);
  const int n16 = lane & 15, g = lane >> 4, q4 = (lane & 15) >> 2, p4 = lane & 3;
#pragma unroll 1
  for (int uu = 0; uu < 2; ++uu) {
    const int u = blk * 4 + half * 2 + uu;
    const int h = u & 3, bc = u >> 2, r0 = bc * 64;
    { const unsigned slot = lane & 15, rsub = lane >> 4; const int im = wq;
#pragma unroll
      for (int rg = 0; rg < 8; ++rg) { const unsigned row = 4 * rg + rsub; const unsigned ch = slot ^ (((row & 3u) << 2) | ((row >> 2) & 3u));
        const char* src = (const char*)(pb + (size_t)(r0 + 32 * (im >> 1) + row) * 3584 + 1024 + h * 256 + (im & 1) * 128) + ch * 16;
        glds16(src, v_addr + im * 8192 + rg * 1024); } }
    const int d0 = 2 * lane; const float gb0 = gbias[h * 128 + d0], gb1 = gbias[h * 128 + d0 + 1];
    const unsigned wofs = 16u * ((unsigned)(d0 >> 3)), wsub = (unsigned)(d0 & 7) * 2u;
    unsigned gq[16], qq[16], kq[16]; float bl0[16], bl1[16];
#pragma unroll
    for (int jj = 0; jj < 16; ++jj) { const bf16_t* rp = pb + (size_t)(r0 + wq * 16 + jj) * 3584 + h * 128 + d0;
      gq[jj] = *(const unsigned*)(rp + 3072); qq[jj] = *(const unsigned*)rp; kq[jj] = *(const unsigned*)(rp + 512); }
    float bc0 = 0.f, bc1 = 0.f;
#pragma unroll
    for (int jj = 0; jj < 16; ++jj) { const float a0 = bf_lo(gq[jj]) + gb0, a1 = bf_hi(gq[jj]) + gb1;
      bc0 += (fminf(a0, 0.f) - __logf(1.f + __expf(-fabsf(a0)))) * (1.f / 16.f); bc1 += (fminf(a1, 0.f) - __logf(1.f + __expf(-fabsf(a1)))) * (1.f / 16.f);
      bl0[jj] = bc0; bl1[jj] = bc1; }
    *(LAS f32x2_t*)(EX + wq * 128 + d0) = (f32x2_t){bc0, bc1};
    LDSW(); __syncthreads();
    float of0 = 0.f, of1 = 0.f, tt0 = 0.f, tt1 = 0.f;
#pragma unroll
    for (int w2_ = 0; w2_ < 4; ++w2_) { const f32x2_t e = *(const LAS f32x2_t*)(EX + w2_ * 128 + d0); tt0 += e[0]; tt1 += e[1]; if (w2_ < wq) { of0 += e[0]; of1 += e[1]; } }
#pragma unroll
    for (int jj = 0; jj < 16; ++jj) { const int j = wq * 16 + jj; const float b0 = bl0[jj] + of0, b1 = bl1[jj] + of1;
      const float e0 = __expf(b0), e1 = __expf(b1), i0 = __expf(fminf(-b0, 80.f)), i1 = __expf(fminf(-b1, 80.f));
      const unsigned qo = cvt_pk_bf16(bf_lo(qq[jj]) * 0.08838834764831845f * e0, bf_hi(qq[jj]) * 0.08838834764831845f * e1);
      const unsigned ko = cvt_pk_bf16(bf_lo(kq[jj]) * i0, bf_hi(kq[jj]) * i1);
      *(unsigned*)(qt + (size_t)(r0 + j) * 512 + h * 128 + d0) = qo;
      const unsigned row = (unsigned)(j & 31); const unsigned off = (unsigned)(j >> 5) * 8192u + 256u * row + ((wofs ^ (16u * (((row & 3u) << 2) | ((row >> 2) & 3u))))) + wsub;
      *(LAS unsigned*)(X + off) = qo; *(LAS unsigned*)(Y + off) = ko; }
    if (wq == 3) *(float2*)(dcy + (size_t)u * 128 + d0) = make_float2(__expf(tt0), __expf(tt1));
    asm volatile("s_waitcnt vmcnt(0) lgkmcnt(0)" ::: "memory");
    __syncthreads();
    const int it = wq;
    bf16x8 afr[2];
#pragma unroll
    for (int ks = 0; ks < 2; ++ks) {
      unsigned pk[4] = {0u, 0u, 0u, 0u};
#pragma unroll
      for (int jh = 0; jh < 2; ++jh) { const int jt = 2 * ks + jh;
        if (jt <= it) { f32x4 acc = (f32x4){0.f, 0.f, 0.f, 0.f};
#pragma unroll
          for (int s = 0; s < 4; ++s) { const bf16x8 ya = *(const LAS bf16x8*)(Y + (jt >> 1) * 8192 + offb(n16 + 16 * (jt & 1), 4 * s + g)), xb = *(const LAS bf16x8*)(X + (it >> 1) * 8192 + offb(n16 + 16 * (it & 1), 4 * s + g));
            acc = __builtin_amdgcn_mfma_f32_16x16x32_bf16(ya, xb, acc, 0, 0, 0); }
          const int i_ = 16 * it + n16, jbase = 16 * jt + 4 * g;
#pragma unroll
          for (int r = 0; r < 4; ++r) if (jbase + r > i_) acc[r] = 0.f;
          pk[2 * jh] = cvt_pk_bf16(acc[0], acc[1]); pk[2 * jh + 1] = cvt_pk_bf16(acc[2], acc[3]); } }
      afr[ks] = __builtin_bit_cast(bf16x8, (v4u){pk[0], pk[1], pk[2], pk[3]});
    }
    bf16_t* ogp = og + (size_t)u * 16384 + (size_t)(it * 16) * 256 + lane * 4; bf16_t* kvp = kvt + (size_t)u * 32768 + (size_t)n16 * 128 + 4 * g;
#pragma unroll 2
    for (int nt = 0; nt < 16; ++nt) {
      const unsigned vimg = (unsigned)(nt >> 3) * 8192u, chv = 2u * (unsigned)(nt & 7) + (unsigned)(p4 >> 1), sub = 8u * (unsigned)(p4 & 1);
      f32x4 acc = (f32x4){0.f, 0.f, 0.f, 0.f};
      { LAS unsigned char* vb = V + vimg; const bf16x8 bi0 = cat44(trrd(vb + offb(4 * g + q4, chv) + sub), trrd(vb + offb(16 + 4 * g + q4, chv) + sub));
        acc = __builtin_amdgcn_mfma_f32_16x16x32_bf16(afr[0], bi0, acc, 0, 0, 0); }
      if (it >= 2) { LAS unsigned char* vb = V + 16384 + vimg; const bf16x8 bi1 = cat44(trrd(vb + offb(4 * g + q4, chv) + sub), trrd(vb + offb(16 + 4 * g + q4, chv) + sub));
        acc = __builtin_amdgcn_mfma_f32_16x16x32_bf16(afr[1], bi1, acc, 0, 0, 0); }
      *(v2u*)(ogp + (size_t)nt * 256) = (v2u){cvt_pk_bf16(acc[0], acc[1]), cvt_pk_bf16(acc[2], acc[3])};
    }
#pragma unroll 1
    for (int nq = 0; nq < 4; ++nq) { const int nt = 4 * wq + nq;
      const unsigned vimg = (unsigned)(nt >> 3) * 8192u, chv = 2u * (unsigned)(nt & 7) + (unsigned)(p4 >> 1), sub = 8u * (unsigned)(p4 & 1);
      bf16x8 bn[2];
#pragma unroll
      for (int ks = 0; ks < 2; ++ks) { LAS unsigned char* vb = V + ks * 16384 + vimg; bn[ks] = cat44(trrd(vb + offb(8 * g + q4, chv) + sub), trrd(vb + offb(8 * g + 4 + q4, chv) + sub)); }
#pragma unroll
      for (int mt = 0; mt < 8; ++mt) { const unsigned chy = 2u * (unsigned)mt + (unsigned)(p4 >> 1);
        const bf16x8 a0 = cat44(trrd(Y + offb(8 * g + q4, chy) + sub), trrd(Y + offb(8 * g + 4 + q4, chy) + sub));
        const bf16x8 a1 = cat44(trrd(Y + 8192 + offb(8 * g + q4, chy) + sub), trrd(Y + 8192 + offb(8 * g + 4 + q4, chy) + sub));
        f32x4 acc = __builtin_amdgcn_mfma_f32_16x16x32_bf16(a0, bn[0], (f32x4){0.f, 0.f, 0.f, 0.f}, 0, 0, 0);
        acc = __builtin_amdgcn_mfma_f32_16x16x32_bf16(a1, bn[1], acc, 0, 0, 0);
        *(v2u*)(kvp + (size_t)(16 * nt) * 128 + 16 * mt) = (v2u){cvt_pk_bf16(acc[0], acc[1]), cvt_pk_bf16(acc[2], acc[3])}; }
    }
    LDSW(); __syncthreads();
  }
}

__device__ __forceinline__ void ph_gla_a2(const bf16_t* kvt, const float* dcy, bf16_t* spt) {
  const int gtid = BIDX() * NTHR + TIDX();
  if (gtid >= 8 * 256 * 32) return;
  const int g4 = gtid & 31, dv = (gtid >> 5) & 255, bh = gtid >> 13, b = bh >> 2, h = bh & 3;
  f32x4 S = (f32x4){0.f, 0.f, 0.f, 0.f};
#pragma unroll 4
  for (int c = 0; c < 128; ++c) { const size_t u = (size_t)((b * 128 + c) * 4 + h);
    const v2u kvb = *(const v2u*)(kvt + u * 32768 + (size_t)dv * 128 + 4 * g4); const f32x4 kv = (f32x4){bf_lo(kvb[0]), bf_hi(kvb[0]), bf_lo(kvb[1]), bf_hi(kvb[1])}, dc = *(const f32x4*)(dcy + u * 128 + 4 * g4);
    *(v2u*)(spt + u * 32768 + (size_t)dv * 128 + 4 * g4) = (v2u){cvt_pk_bf16(S[0], S[1]), cvt_pk_bf16(S[2], S[3])};
    S = dc * (S + kv); }
}

constexpr int A3_LD = 272;
__device__ __forceinline__ void ph_gla_a3(const bf16_t* pb, const bf16_t* qt, const bf16_t* og, const bf16_t* spt, const float* ng, bf16_t* ob, LAS unsigned char* lds) {
  const int tid = TIDX(), lane = tid & 63, wave = __builtin_amdgcn_readfirstlane(tid >> 6), gw = BIDX() * 8 + wave, NGW = (int)gridDim.x * 8;
  const int n16 = lane & 15, g = lane >> 4, row16 = lane >> 2, cq = lane & 3;
  LAS float* T = (LAS float*)(lds + wave * (16 * A3_LD * 4));
#pragma unroll 1
  for (int w = gw; w < 4096; w += NGW) {
    const int u = w >> 2, it = w & 3, h = u & 3, r0 = (u >> 2) * 64;
    const bf16_t* sp = spt + (size_t)u * 32768 + (size_t)n16 * 128 + 8 * g;
    bf16x8 qa[4];
#pragma unroll
    for (int ks = 0; ks < 4; ++ks) qa[ks] = *(const bf16x8*)(qt + (size_t)(r0 + 16 * it + n16) * 512 + h * 128 + 32 * ks + 8 * g);
    const bf16_t* ogp = og + (size_t)u * 16384 + (size_t)(it * 16) * 256 + lane * 4;
#pragma unroll
    for (int nt = 0; nt < 16; ++nt) {
      const v2u ogb = *(const v2u*)(ogp + nt * 256); f32x4 acc = (f32x4){bf_lo(ogb[0]), bf_hi(ogb[0]), bf_lo(ogb[1]), bf_hi(ogb[1])};
#pragma unroll
      for (int ks = 0; ks < 4; ++ks) { const bf16x8 sb = *(const bf16x8*)(sp + (size_t)(16 * nt) * 128 + 32 * ks); acc = __builtin_amdgcn_mfma_f32_16x16x32_bf16(qa[ks], sb, acc, 0, 0, 0); }
#pragma unroll
      for (int r = 0; r < 4; ++r) T[(4 * g + r) * A3_LD + 16 * nt + n16] = acc[r];
    }
    LDSW();
    const size_t row = (size_t)(r0 + 16 * it + row16);
    f32x4 v[16]; float ss = 0.f;
#pragma unroll
    for (int k = 0; k < 16; ++k) { v[k] = *(const LAS f32x4*)(T + row16 * A3_LD + 16 * k + 4 * cq); ss += (v[k][0] * v[k][0] + v[k][1] * v[k][1]) + (v[k][2] * v[k][2] + v[k][3] * v[k][3]); }
    ss += __shfl_xor(ss, 1); ss += __shfl_xor(ss, 2);
    const float rs = rsqrtf(ss * (1.f / 256.f) + 1e-6f);
#pragma unroll
    for (int k = 0; k < 16; ++k) { const int col = h * 256 + 16 * k + 4 * cq; const v2u rg = *(const v2u*)(pb + row * 3584 + 2048 + col); const f32x4 gn = *(const f32x4*)(ng + col);
      const float rr[4] = {bf_lo(rg[0]), bf_hi(rg[0]), bf_lo(rg[1]), bf_hi(rg[1])}; float o[4];
#pragma unroll
      for (int z = 0; z < 4; ++z) o[z] = v[k][z] * rs * gn[z] * (rr[z] * __builtin_amdgcn_rcpf(1.f + __expf(-rr[z])));
      *(v2u*)(ob + row * 1024 + col) = (v2u){cvt_pk_bf16(o[0], o[1]), cvt_pk_bf16(o[2], o[3])}; }
    LDSW();
  }
}
#ifndef PROBE
#define PROBE 0
#endif
#ifndef PROBE_S
#define PROBE_S 10.0f
#endif
constexpr size_t MiB = 1u << 20;
constexpr size_t WS_CTL = 0, CTL_ZERO_BYTES = 1 * MiB;
constexpr int CW_BAR = 4096, CW_TMO = 64, CW_RDY = 65536;
constexpr size_t WS_NEEDED = 2048 * MiB;

struct Args { In in; float* out; unsigned char* ws; };

struct Opt { bf16_t *qt, *spt, *og, *kvt; float *dcy; bf16_t *Wql_t, *Wuv_t, *cnb, *qlat, *olat; unsigned short* sc; bf16_t *xb, *WA_t, *WoutA_t, *WB_t, *WoutB_t, *W1_t, *W2_t, *projA_b, *hbf, *o2b, *xs, *act, *Ys, *projB_b; MoeBufs m; };
__device__ __forceinline__ nvp::Ws carve_ws(unsigned char* ws) {
  nvp::Ws w; auto at = [&](size_t mib) { return (char*)ws + mib * MiB; };
  w.projA = (float*)at(2); w.cn = (float*)at(119); w.sc = (float*)at(135); w.idx = (int*)at(647); w.o2 = (float*)at(663);
  w.x1 = (float*)at(727); w.x2 = (float*)at(791);
  w.projB = (float*)at(135); w.adec = (float*)at(135 + 194); w.og = (float*)at(135 + 194 + 32); w.on = (float*)at(135 + 194 + 32 + 64);
  w.counts = nullptr; w.h = nullptr; w.hb = nullptr; w.ys = nullptr; w.tok_e = nullptr; w.tok_g = nullptr; w.slot_of = nullptr; w.row_tok = nullptr; w.row_gate = nullptr; w.blk_e = nullptr;
  return w;
}
__device__ __forceinline__ Opt carve_opt(unsigned char* ws) {
  Opt o; auto at = [&](size_t mib) { return (bf16_t*)((char*)ws + mib * MiB); };
  char* sm = (char*)ws + 855 * MiB;
  o.m.tok_e = (int*)sm; o.m.tok_g = (float*)(sm + 256 * 1024); o.m.slot_of = (int*)(sm + 512 * 1024); o.m.slot_gate = (float*)(sm + 768 * 1024); o.m.blk_e = (int*)(sm + 1088 * 1024); o.m.blkcnt = (int*)(sm + 1096 * 1024); o.m.nblk = (int*)(sm + 1160 * 1024); o.m.slot_tok = (int*)(sm + 1200 * 1024);
  o.WA_t = at(860); o.WoutA_t = at(864); o.WB_t = at(866); o.WoutB_t = at(873);
  o.Wql_t = at(875); o.Wuv_t = at(877); o.olat = at(2); o.cnb = at(647); o.qlat = at(1856); o.sc = (unsigned short*)at(135);
  o.qt = at(135); o.dcy = (float*)at(151); o.og = at(152); o.kvt = at(216); o.spt = at(344);
  o.W1_t = at(880); o.W2_t = at(1136);
  o.xb = at(1264); o.projA_b = at(1296); o.hbf = at(1360); o.o2b = at(1392);
  o.xs = at(1424); o.act = at(1568); o.Ys = at(1712); o.projB_b = at(1856);
  return o;
}

struct ProIn { const float *a_w_uk, *a_w_uv, *x, *a_w_in, *a_w_out, *b_w_in, *b_w_g2, *b_w_out, *m_w1, *m_w2; };
__device__ __forceinline__ void ph_prologue(const ProIn I, const Opt& o) {
  const int tid = TIDX(), lane = tid & 63, gw = BIDX() * 8 + (tid >> 6), NGW = (int)gridDim.x * 8, gtid = BIDX() * NTHR + tid, NGT = (int)gridDim.x * NTHR;
  cvt_f32_to_bf16(I.x, D, o.xb, D, NT, D, gtid, NGT);
  zero_rect(o.WA_t, D, DINA, 2048 - DINA, 0, D * 2, gtid, NGT);
  for (int i = gtid; i < 512 * 256; i += NGT) { const int n = i >> 8, k4 = (i & 255) * 4; float a[4];
#pragma unroll
    for (int z = 0; z < 4; ++z) { const float* gl = I.b_w_in + (size_t)(k4 + z) * DINB + 2048; float s = 0.f;
#pragma unroll
      for (int j = 0; j < 16; ++j) s = fmaf(gl[j], I.b_w_g2[j * 512 + n], s);
      a[z] = s; }
    *(v2u*)(o.WB_t + (size_t)(3072 + n) * D + k4) = (v2u){cvt_pk_bf16(a[0], a[1]), cvt_pk_bf16(a[2], a[3])}; }
  int w0 = 0;
#pragma unroll 1
  for (int h = 0; h < 16; ++h) {
    transpose_job(mk_tjob(I.a_w_uk + (size_t)h * 64 * 256, 256, 64, 256, o.Wql_t, 256, h * 256, (h & 3) * 64, 0), w0, gw, NGW, lane);
    transpose_job(mk_tjob(I.a_w_uv + (size_t)h * 256 * 64, 64, 256, 64, o.Wuv_t, 1024, h * 64, (h & 3) * 256, 0), w0, gw, NGW, lane);
    for (int hp = 0; hp < 4; ++hp) if (hp != (h & 3)) { zero_rect(o.Wql_t, 256, h * 256, 256, hp * 128, 128, gtid, NGT); zero_rect(o.Wuv_t, 1024, h * 64, 64, hp * 512, 512, gtid, NGT); }
  }
  transpose_job(mk_tjob(I.a_w_in, DINA, D, DINA, o.WA_t, D, 0, 0, 0), w0, gw, NGW, lane);
  transpose_job(mk_tjob(I.a_w_out, D, D, D, o.WoutA_t, D, 0, 0, 0), w0, gw, NGW, lane);
  transpose_job(mk_tjob(I.b_w_in, DINB, D, 2048, o.WB_t, D, 0, 0, 0), w0, gw, NGW, lane);
  transpose_job(mk_tjob(I.b_w_in + 2064, DINB, D, 1024, o.WB_t, D, 2048, 0, 0), w0, gw, NGW, lane);
  transpose_job(mk_tjob(I.b_w_out, D, D, D, o.WoutB_t, D, 0, 0, 0), w0, gw, NGW, lane);
}
__device__ __forceinline__ void ph_gla_shim(const bf16_t* pb, const float* gbias, float* projB, float* adec) {
  const int gtid = BIDX() * NTHR + TIDX(), NGT = (int)gridDim.x * NTHR;
  for (size_t i = gtid; i < (size_t)NT * 896; i += NGT) { const size_t r = i / 896; const int c = (int)(i % 896) * 4; const v2u v = *(const v2u*)(pb + r * 3584 + c);
    const f32x4 f = (f32x4){bf_lo(v[0]), bf_hi(v[0]), bf_lo(v[1]), bf_hi(v[1])};
    if (c < 2048) *(f32x4*)(projB + r * DINB + c) = f;
    else if (c < 3072) *(f32x4*)(projB + r * DINB + 2064 + (c - 2048)) = f;
    else { f32x4 o;
#pragma unroll
      for (int z = 0; z < 4; ++z) { const float a = f[z] + gbias[c - 3072 + z]; const float ls = fminf(a, 0.f) - log1pf(expf(-fabsf(a))); o[z] = expf(ls * (1.f / 16.f)); }
      *(f32x4*)(adec + r * 512 + (c - 3072)) = o; } }
}

#if PROBE == 3
#define GLA_PHASES \
      PH_BEGIN ph_gla_shim(o.projB_b, I.b_g_bias, w.projB, w.adec); PH_END \
      GRID_BAR(); \
      PH_BEGIN nvp::np_gla_scan(w.projB, w.adec, w.og, fl); PH_END \
      GRID_BAR(); \
      PH_BEGIN nvp::np_gla_norm(w.og, w.projB, I.b_norm, w.on); PH_END \
      GRID_BAR(); \
      PH_BEGIN cvt_f32_to_bf16(w.on, D, o.o2b, D, NT, D, gtid_, NGT_); PH_END \
      GRID_BAR(); \
      PH_BEGIN ph_gla_a1(o.projB_b, I.b_g_bias, (bf16_t*)(wsb_ + 489 * MiB), (bf16_t*)(wsb_ + 506 * MiB), (bf16_t*)(wsb_ + 880 * MiB), (float*)(wsb_ + 505 * MiB), ll, I.m_w1, I.m_w2, o.W1_t, o.W2_t); PH_END \
      GRID_BAR(); \
      PH_BEGIN ph_gla_a2((bf16_t*)(wsb_ + 880 * MiB), (float*)(wsb_ + 505 * MiB), (bf16_t*)(wsb_ + 1136 * MiB)); PH_END \
      GRID_BAR(); \
      PH_BEGIN ph_gla_a3(o.projB_b, (bf16_t*)(wsb_ + 489 * MiB), (bf16_t*)(wsb_ + 506 * MiB), (bf16_t*)(wsb_ + 1136 * MiB), I.b_norm, (bf16_t*)(wsb_ + 570 * MiB), ll); PH_END \
      GRID_BAR(); \
      PH_BEGIN { unsigned* fl_ = (unsigned*)(wsb_ + 512 * 1024); unsigned bits = 0u; \
        { const bf16_t* a = (const bf16_t*)(wsb_ + 489 * MiB); for (size_t i = gtid_; i < (size_t)NT * 512; i += NGT_) { const float v = bf2f(a[i]); if (!(fabsf(v) < 1e30f)) bits |= 1u; } } \
        { const float* a = (const float*)(wsb_ + 506 * MiB); for (size_t i = gtid_; i < (size_t)NT * 1024; i += NGT_) { const float v = a[i]; if (!(fabsf(v) < 1e30f)) bits |= 2u; } } \
        { const float* a = (const float*)(wsb_ + 880 * MiB); for (size_t i = gtid_; i < (size_t)1024 * 32768; i += NGT_) { const float v = a[i]; if (!(fabsf(v) < 1e30f)) bits |= 4u; } } \
        { const bf16_t* a = (const bf16_t*)(wsb_ + 1136 * MiB); for (size_t i = gtid_; i < (size_t)1024 * 32768; i += NGT_) { const float v = bf2f(a[i]); if (!(fabsf(v) < 1e30f)) bits |= 8u; } } \
        { const bf16_t* a = (const bf16_t*)(wsb_ + 570 * MiB); for (size_t i = gtid_; i < (size_t)NT * 1024; i += NGT_) { const float v = bf2f(a[i]); if (!(fabsf(v) < 1e30f)) bits |= 16u; } } \
        { const float* a = (const float*)(wsb_ + 505 * MiB); for (size_t i = gtid_; i < (size_t)1024 * 128; i += NGT_) { const float v = a[i]; if (!(fabsf(v) < 1e30f)) bits |= 32u; } } \
        if (bits) atomicOr(fl_, bits); \
        { float* pd = (float*)(wsb_ + 1968 * MiB); const bf16_t* ob = (const bf16_t*)(wsb_ + 570 * MiB); for (size_t i = gtid_; i < (size_t)NT * D; i += NGT_) pd[i] = bf2f(ob[i]) - w.on[i]; } } PH_END \
      GRID_BAR();
#else
#define GLA_PHASES \
      PH_BEGIN ph_gla_a1(o.projB_b, I.b_g_bias, o.qt, o.og, o.kvt, o.dcy, ll, I.m_w1, I.m_w2, o.W1_t, o.W2_t); PH_END \
      GRID_BAR(); \
      PH_BEGIN ph_gla_a2(o.kvt, o.dcy, o.spt); PH_END \
      GRID_BAR(); \
      PH_BEGIN ph_gla_a3(o.projB_b, o.qt, o.og, o.spt, I.b_norm, o.o2b, ll); PH_END \
      GRID_BAR();
#endif
#if defined(FUSE_ON)
#define MOE_GEMM_PHASES(li) \
    PH_BEGIN pg8::MoeFusedOrder S; S.init(o.xs, o.act, o.W1_t + (size_t)li * 32 * 2048 * D, o.W2_t + (size_t)li * 32 * D * D, o.m.slot_tok, o.m.blk_e, (unsigned*)(wsb_ + WS_CTL) + CW_RDY + li * 32768, (unsigned*)(wsb_ + WS_CTL) + CW_TMO, __builtin_amdgcn_readfirstlane(*o.m.nblk), G_, BIDX()); S.mode = 0; \
      gemm_phase<pg8::EpiMoeFused, pg8::MoeFusedOrder, true, true>(ll, Gemm{D, D, D}, S, pg8::EpiMoeFused{o.act, I.m_b1 + (size_t)li * 32 * 2048, o.Ys, I.m_b2 + (size_t)li * 32 * D, o.m.slot_gate}); PH_END \
    GRID_BAR();
#else
#define MOE_GEMM_PHASES(li) \
    PH_BEGIN pg8::MoeOrderG S; S.init(o.xs, D, o.W1_t + (size_t)li * 32 * 2048 * D, D, (size_t)2048 * D * 2, __builtin_amdgcn_readfirstlane(*o.m.nblk), 8, 128, o.m.blk_e, G_, BIDX()); S.rowmap = o.m.slot_tok; \
      gemm_phase<pg8::EpiSwiglu, pg8::MoeOrderG, true, true>(ll, Gemm{D, D, D}, S, pg8::EpiSwiglu{o.act, D, I.m_b1 + (size_t)li * 32 * 2048}); PH_END \
    GRID_BAR(); \
    PH_BEGIN MoeOrder S; S.init(o.act, D, o.W2_t + (size_t)li * 32 * D * D, D, (size_t)D * D * 2, __builtin_amdgcn_readfirstlane(*o.m.nblk), 4, 256, o.m.blk_e, G_, BIDX()); \
      gemm_phase<pg8::EpiMoe2, MoeOrder, true, true>(ll, Gemm{D, D, D}, S, pg8::EpiMoe2{o.Ys, D, I.m_b2 + (size_t)li * 32 * D, o.m.slot_gate}); PH_END \
    GRID_BAR();
#endif
#define LAYER_BODY(li) \
    if (li == 1) { \
      PH_BEGIN StaticOrder S; S.init(o.xb, D, o.WB_t, D, NT, 3584, G_, BIDX()); gemm_phase<EpiStore, StaticOrder, true, true>(ll, Gemm{D, D, D}, S, EpiStore{o.projB_b, 3584}); PH_END \
      GRID_BAR(); \
      GLA_PHASES \
      PH_BEGIN StaticOrder S; S.init(o.o2b, D, o.WoutB_t, D, NT, D, G_, BIDX()); gemm_phase<EpiStore, StaticOrder, true, true>(ll, Gemm{D, D, D}, S, EpiStore{o.hbf, D}); PH_END \
      GRID_BAR(); \
    } \
    PH_BEGIN if (li == 0) ph_ln_router<false>(I.x, o.hbf, I.ln1_g + li * D, I.ln1_b + li * D, I.m_w_router + (size_t)li * D * 32, I.m_b_router + li * 32, o.xs, o.m, fl); else ph_ln_router<true>(o.xb, o.hbf, I.ln1_g + li * D, I.ln1_b + li * D, I.m_w_router + (size_t)li * D * 32, I.m_b_router + li * 32, o.xs, o.m, fl); PH_END \
    GRID_BAR(); \
    PH_BEGIN ph_moe_scatter(o.m, (int*)lds); PH_END \
    GRID_BAR(); \
MOE_GEMM_PHASES(li) \
    PH_BEGIN ph_combine_ln(o.xs, o.Ys, o.m.slot_of, I.ln2_g + li * D, I.ln2_b + li * D, li == 0 ? nullptr : out_, li == 0 ? o.xb : nullptr); PH_END \
    if (li == 0) GRID_BAR();
__global__ void __launch_bounds__(NTHR, 2) mk_fwd(Args args) {
  extern __shared__ __attribute__((aligned(16))) unsigned char lds[];
  volatile LAS unsigned* MISC = (volatile LAS unsigned*)((LAS unsigned char*)lds + MISC_OFF);
  if (threadIdx.x < 32) MISC[threadIdx.x] = 0u;
  __syncthreads();
  XcdBarrier bar; { const __attribute__((address_space(4))) Args* ka0 = (const __attribute__((address_space(4))) Args*)__builtin_amdgcn_kernarg_segment_ptr(); bar = xcd_barrier_post((unsigned*)(ka0->ws + WS_CTL) + CW_BAR, MISC + 8); }
#define GRID_BAR() xcd_barrier(bar)
#define PH_BEGIN { const __attribute__((address_space(4))) Args* ka_ = (const __attribute__((address_space(4))) Args*)__builtin_amdgcn_kernarg_segment_ptr(); asm volatile("" : "+s"(ka_)); \
    float* const out_ = ka_->out; (void)out_; unsigned char* wsb_ = ka_->ws; const nvp::Ws w = carve_ws(wsb_); (void)w; const Opt o = carve_opt(wsb_); (void)o; \
    const int gtid_ = BIDX() * NTHR + TIDX(), NGT_ = (int)gridDim.x * NTHR; (void)gtid_; (void)NGT_; const int G_ = (int)gridDim.x; (void)G_;
#define PH_END }
#define I (ka_->in)
  float* fl = (float*)lds; LAS unsigned char* ll = (LAS unsigned char*)lds;
  using pg8::gemm_phase; using pg8::StaticOrder; using pg8::MoeOrder; using pg8::Gemm; using pg8::EpiStore;
  PH_BEGIN ph_prologue(ProIn{I.a_w_uk, I.a_w_uv, I.x, I.a_w_in, I.a_w_out, I.b_w_in, I.b_w_g2, I.b_w_out, I.m_w1, I.m_w2}, o); PH_END
  GRID_BAR();
  PH_BEGIN StaticOrder S; S.init(o.xb, D, o.WA_t, D, NT, 2048, G_, BIDX()); gemm_phase<EpiStore, StaticOrder, true, true>(ll, Gemm{D, D, D}, S, EpiStore{o.projA_b, 2048}); PH_END
  GRID_BAR();
  PH_BEGIN ph_cnorm_b(o.projA_b, I.a_kv_norm, o.cnb); PH_END
  PH_BEGIN pg8::GroupAOrder S; S.init(o.projA_b, 2048, o.Wql_t, 256, NT, 4096, 4, 512, G_, BIDX()); gemm_phase<EpiStore, pg8::GroupAOrder, true, true>(ll, Gemm{2048, 256, 256}, S, EpiStore{o.qlat, 4096}); PH_END
  PH_BEGIN ph_iscore(o.projA_b, o.sc, I.m_w1, I.m_w2, o.W1_t, o.W2_t); PH_END
  GRID_BAR();
  PH_BEGIN ph_select_attend(o.sc, o.qlat, o.cnb, o.olat, ll, I.m_w1, I.m_w2, o.W1_t, o.W2_t); PH_END
  GRID_BAR();
  PH_BEGIN pg8::GroupAOrder S; S.init(o.olat, 4096, o.Wuv_t, 1024, NT, 1024, 1, 2048, G_, BIDX()); gemm_phase<EpiStore, pg8::GroupAOrder, true, true>(ll, Gemm{4096, 1024, 1024}, S, EpiStore{o.o2b, D}); PH_END
  GRID_BAR();
#if PROBE == 2
  PH_BEGIN cvt_bf16_to_f32(o.projA_b, 2048, w.projA, DINA, NT, DINA, gtid_, NGT_); PH_END
  GRID_BAR();
  PH_BEGIN nvp::np_cnorm(w.projA, I.a_kv_norm, w.cn); PH_END
  PH_BEGIN nvp::np_iscore(w.projA, w.sc, fl); PH_END
  GRID_BAR();
  PH_BEGIN nvp::np_topk(w.sc, w.idx, (char*)lds); PH_END
  GRID_BAR();
  PH_BEGIN nvp::np_dsa_attn(w.projA, w.cn, w.idx, I.a_w_uk, I.a_w_uv, w.o2, fl); PH_END
  GRID_BAR();
  PH_BEGIN { float* pd = (float*)(wsb_ + 1968 * MiB); for (size_t i = gtid_; i < (size_t)NT * D; i += NGT_) pd[i] = bf2f(o.o2b[i]) - w.o2[i]; } PH_END
  GRID_BAR();
#endif
  PH_BEGIN StaticOrder S; S.init(o.o2b, D, o.WoutA_t, D, NT, D, G_, BIDX()); gemm_phase<EpiStore, StaticOrder, true, true>(ll, Gemm{D, D, D}, S, EpiStore{o.hbf, D}); PH_END
  GRID_BAR();
  { LAYER_BODY(0) }
  { LAYER_BODY(1) }
#if PROBE == 2 || PROBE == 3
  GRID_BAR();
#if PROBE == 3
  PH_BEGIN { if (gtid_ == 0) { const unsigned fb = *(const unsigned*)(wsb_ + 512 * 1024); out_[5] += (float)fb; } const float* pd = (const float*)(wsb_ + 1968 * MiB); for (size_t i = gtid_; i < (size_t)NT * D; i += NGT_) out_[i] += PROBE_S * pd[i]; } PH_END
#else
  PH_BEGIN { const float* pd = (const float*)(wsb_ + 1968 * MiB); for (size_t i = gtid_; i < (size_t)NT * D; i += NGT_) out_[i] += PROBE_S * pd[i]; } PH_END
#endif
#endif
}

extern "C" void kernel_launch(void* const* d_in, const int* in_sizes, int n_in, void* d_out, int out_size, void* d_ws, size_t ws_size, hipStream_t stream) {
  static int grid = 0;
  if (grid == 0) {
    if (n_in != 21 || ws_size < WS_NEEDED) { fprintf(stderr, "kernel_launch: bad inputs (n_in %d) or workspace too small (%zu needed, %zu given)\n", n_in, (size_t)WS_NEEDED, ws_size); grid = -1; return; }
    int dev = 0, cus = 0, per_cu = 0;
    if (hipGetDevice(&dev) != hipSuccess || hipDeviceGetAttribute(&cus, hipDeviceAttributeMultiprocessorCount, dev) != hipSuccess) { grid = -1; return; }
    if (hipFuncSetAttribute((const void*)mk_fwd, hipFuncAttributeMaxDynamicSharedMemorySize, LDS_BYTES) != hipSuccess) { fprintf(stderr, "kernel_launch: hipFuncSetAttribute failed\n"); grid = -1; return; }
    if (hipOccupancyMaxActiveBlocksPerMultiprocessor(&per_cu, (const void*)mk_fwd, NTHR, LDS_BYTES) != hipSuccess || per_cu < 1) fprintf(stderr, "kernel_launch: note: occupancy query reports %d\n", per_cu);
    (void)hipGetLastError();
    grid = cus;
    if (grid != 256) fprintf(stderr, "kernel_launch: built for 256 CUs (token ownership per workgroup); got %d\n", grid);
  }
  if (grid < 0) return;
  if (hipMemsetAsync((char*)d_ws + WS_CTL, 0, CTL_ZERO_BYTES, stream) != hipSuccess) { fprintf(stderr, "kernel_launch: memset failed\n"); return; }
  Args a; memset(&a, 0, sizeof(a));
  const float** f = (const float**)&a.in;
  for (int i = 0; i < 21; ++i) f[i] = (const float*)d_in[i];
  a.out = (float*)d_out; a.ws = (unsigned char*)d_ws;
  hipLaunchKernelGGL(mk_fwd, dim3(grid), dim3(NTHR), LDS_BYTES, stream, a);
  const hipError_t le = hipPeekAtLastError();
  if (le != hipSuccess) fprintf(stderr, "kernel_launch: launch failed: %s\n", hipGetErrorName(le));
}
```

```cpp
#include <hip/hip_runtime.h>
#include <cstdio>
#include <cstdint>
#include <cstring>

#define GAS __attribute__((address_space(1)))
#define LAS __attribute__((address_space(3)))
#define NTHR 512
constexpr int LDS_BYTES = 147456;
constexpr int MISC_OFF = 131072 + 8192;

#define XB_TMO      128
#define XB_XCNT(j)  (256  + 64 * (j))
#define XB_XSUB(j)  (1280 + 64 * (j))
#define XB_XGEN(j)  (2304 + 64 * (j))
#define XB_TOP      3328
#define XB_TOPGEN   3392
#define XCD_BAR_WORDS 3456
#define XB_SPIN_CAP (1u << 25)
__device__ __forceinline__ unsigned xb_ld(unsigned* p)              { return __hip_atomic_load(p, __ATOMIC_RELAXED, __HIP_MEMORY_SCOPE_AGENT); }
__device__ __forceinline__ unsigned xb_add(unsigned* p, unsigned v) { return __hip_atomic_fetch_add(p, v, __ATOMIC_RELAXED, __HIP_MEMORY_SCOPE_AGENT); }
__device__ __forceinline__ unsigned xb_xcc_id() { return (unsigned)__builtin_amdgcn_s_getreg((3 << 11) | 20) & 0xFu; }
#define XB_SPIN(cond, bar) do { unsigned _sp = 0; while (cond) { __builtin_amdgcn_s_sleep(1); \
    if ((++_sp & 255u) == 0u) { if (xb_ld(&(bar)[XB_TMO])) break; if (_sp > XB_SPIN_CAP) { atomicAdd(&(bar)[XB_TMO], 1u); break; } } } } while (0)
struct XcdBarrier { unsigned* bar; unsigned x; volatile LAS unsigned* st; };
__device__ __forceinline__ XcdBarrier xcd_barrier_post(unsigned* bar, volatile LAS unsigned* st) {
    XcdBarrier b; b.bar = bar; b.x = xb_xcc_id(); b.st = st;
    if (threadIdx.x == 0) (void)xb_add(&bar[XB_XCNT(b.x)], 1u);
    return b;
}
__device__ __forceinline__ void xcd_barrier_complete(unsigned* bar, unsigned x, unsigned& nloc, unsigned& nx) {
    const unsigned G = gridDim.x * gridDim.y * gridDim.z;
    unsigned sum, cnt, mine, sp = 0u;
    for (;;) {
        sum = 0u; cnt = 0u; mine = 0u;
#pragma unroll
        for (unsigned j = 0; j < 16; ++j) { const unsigned c = xb_ld(&bar[XB_XCNT(j)]); sum += c; cnt += (c > 0u) ? 1u : 0u; mine = (j == x) ? c : mine; }
        if (sum == G) break;
        __builtin_amdgcn_s_sleep(1);
        if ((++sp & 255u) == 0u) { if (xb_ld(&bar[XB_TMO])) break; if (sp > XB_SPIN_CAP) { atomicAdd(&bar[XB_TMO], 1u); break; } }
    }
    nloc = mine > 0u ? mine : 1u; nx = cnt > 0u ? cnt : 1u;
}
__device__ __forceinline__ void xcd_barrier(const XcdBarrier& b) {
    asm volatile("s_waitcnt vmcnt(0)" ::: "memory");
    __syncthreads();
    if (threadIdx.x == 0) {
        unsigned* bar = b.bar;
        __builtin_amdgcn_s_waitcnt(0);
        unsigned nloc = b.st[0], nx = b.st[1];
        if (nloc == 0u) { xcd_barrier_complete(bar, b.x, nloc, nx); b.st[0] = nloc; b.st[1] = nx; }
        const unsigned old = xb_add(&bar[XB_XSUB(b.x)], 1u);
        const unsigned gen = old / nloc;
        if (old + 1u == (gen + 1u) * nloc) {
            __builtin_amdgcn_fence(__ATOMIC_RELEASE, "agent");
            asm volatile("s_waitcnt vmcnt(0)" ::: "memory");
            const unsigned og = xb_add(&bar[XB_TOP], 1u);
            const unsigned tg = og / nx;
            if (og + 1u == (tg + 1u) * nx) xb_add(&bar[XB_TOPGEN], 1u);
            else XB_SPIN(xb_ld(&bar[XB_TOPGEN]) == tg, bar);
            __builtin_amdgcn_fence(__ATOMIC_ACQUIRE, "agent");
            xb_add(&bar[XB_XGEN(b.x)], 1u);
            asm volatile("s_waitcnt vmcnt(0)" ::: "memory");
        } else {
            XB_SPIN(xb_ld(&bar[XB_XGEN(b.x)]) == gen, bar);
            __builtin_amdgcn_fence(__ATOMIC_ACQUIRE, "agent");
            asm volatile("s_waitcnt vmcnt(0)" ::: "memory");
        }
    }
    __syncthreads();
}

constexpr int NT = 16384, D = 1024, L = 8192, NB = 2;
constexpr int DINA = 1864, DINB = 3088;
constexpr int PMAX = 73728;
constexpr float ALPHA = 1.4142135623730951f;

struct In { const float *x, *a_w_in, *a_kv_norm, *a_w_uk, *a_w_uv, *a_w_out, *b_w_in, *b_w_g2, *b_g_bias, *b_norm, *b_w_out, *m_w_router, *m_b_router, *m_w1, *m_b1, *m_w2, *m_b2, *ln1_g, *ln1_b, *ln2_g, *ln2_b; };

__device__ __forceinline__ int TIDX() { int t = threadIdx.x; asm volatile("" : "+v"(t)); return t; }
__device__ __forceinline__ int BIDX() { int t = blockIdx.x; asm volatile("" : "+s"(t)); return t; }
__device__ __forceinline__ float wave_sum(float v) {
#pragma unroll
    for (int o = 1; o < 64; o <<= 1) v += __shfl_xor(v, o);
    return v;
}
namespace nvp {
#define WSYNC() asm volatile("s_waitcnt lgkmcnt(0)" ::: "memory")
struct GemmP {
  const float* A; int lda; const int* arow;
  const float* B; int ldb; float* C; int ldc; int M, N, K;
  const int* blk_e; const int* nblk_used; size_t bstride; const float* bias; size_t bias_stride;
};
__device__ __forceinline__ GemmP mkg(const float* A, int lda, const int* arow, const float* B, int ldb, float* C, int ldc, int M, int N, int K, const int* blk_e, const int* nblk_used, size_t bstride, const float* bias, size_t bias_stride) {
  GemmP p; p.A = A; p.lda = lda; p.arow = arow; p.B = B; p.ldb = ldb; p.C = C; p.ldc = ldc; p.M = M; p.N = N; p.K = K; p.blk_e = blk_e; p.nblk_used = nblk_used; p.bstride = bstride; p.bias = bias; p.bias_stride = bias_stride; return p; }

template <int MODE>
__device__ __forceinline__ void np_sgemm(const GemmP p, float* lds) {
  float (*As)[132] = (float (*)[132])lds;
  float (*Bs)[68] = (float (*)[68])(lds + 16 * 132);
  float (*Bu)[68] = (float (*)[68])(lds + 16 * 132 + 16 * 68);
  const int tid = TIDX(), tx = tid & 15, ty = tid >> 4;
  const int ntn = (p.N + 63) / 64, ntm = p.M / 128;
  const int ar = tid >> 2, ak = (tid & 3) * 4;
  const int bk = (tid & 255) >> 4, bn4 = (tid & 15) * 4;
  for (int t = BIDX(); t < ntm * ntn; t += gridDim.x) {
    const int bm = t / ntn, bn = t % ntn;
    const float* B = p.B; const float* bias = p.bias;
    if (MODE != 0) { const int blk = (bm * 128) / 256; if (blk >= *p.nblk_used) continue; const int e = p.blk_e[blk]; B += (size_t)e * p.bstride; bias += (size_t)e * p.bias_stride; }
    const int m0 = bm * 128, n0 = bn * 64;
    const int arow = p.arow ? p.arow[m0 + ar] : (m0 + ar);
    const float* Ap = p.A + (size_t)arow * p.lda + ak;
    const bool bok = (n0 + bn4) < p.N;
    float acc[4][4] = {}, accu[4][4] = {};
    for (int k0 = 0; k0 < p.K; k0 += 16) {
      const float4 av = *(const float4*)(Ap + k0);
      As[ak + 0][ar] = av.x; As[ak + 1][ar] = av.y; As[ak + 2][ar] = av.z; As[ak + 3][ar] = av.w;
      if (tid < 256) { float4 bv = make_float4(0.f, 0.f, 0.f, 0.f); if (bok) bv = *(const float4*)(B + (size_t)(k0 + bk) * p.ldb + n0 + bn4); *(float4*)&Bs[bk][bn4] = bv; }
      else if (MODE == 1) { const float4 uv = *(const float4*)(B + (size_t)(k0 + bk) * p.ldb + 1024 + n0 + bn4); *(float4*)&Bu[bk][bn4] = uv; }
      __syncthreads();
#pragma unroll
      for (int kk = 0; kk < 16; ++kk) {
        const float4 a = *(const float4*)&As[kk][ty * 4];
        const float4 b = *(const float4*)&Bs[kk][tx * 4];
        const float aa[4] = {a.x, a.y, a.z, a.w}, bb[4] = {b.x, b.y, b.z, b.w};
#pragma unroll
        for (int i = 0; i < 4; ++i)
#pragma unroll
          for (int j = 0; j < 4; ++j) acc[i][j] = fmaf(aa[i], bb[j], acc[i][j]);
        if (MODE == 1) {
          const float4 u = *(const float4*)&Bu[kk][tx * 4]; const float uu[4] = {u.x, u.y, u.z, u.w};
#pragma unroll
          for (int i = 0; i < 4; ++i)
#pragma unroll
            for (int j = 0; j < 4; ++j) accu[i][j] = fmaf(aa[i], uu[j], accu[i][j]);
        }
      }
      __syncthreads();
    }
#pragma unroll
    for (int i = 0; i < 4; ++i) {
      const int m = m0 + ty * 4 + i;
#pragma unroll
      for (int j = 0; j < 4; ++j) {
        const int n = n0 + tx * 4 + j; if (n >= p.N) continue;
        float v = acc[i][j];
        if (MODE == 1) {
          float g = v + bias[n], u = accu[i][j] + bias[1024 + n];
          g = fminf(g, 7.f); u = fminf(fmaxf(u, -7.f), 7.f);
          const float glu = g / (1.f + expf(-1.702f * g));
          v = (u + 1.f) * glu;
        } else if (MODE == 2) v += bias[n];
        p.C[(size_t)m * p.ldc + n] = v;
      }
    }
  }
}

#define GW_INIT const int lane = TIDX() & 63, wave = TIDX() >> 6, gw = BIDX() * 8 + wave, NGW = gridDim.x * 8; (void)lane; (void)wave; (void)gw; (void)NGW

__device__ __forceinline__ void np_cnorm(const float* projA, const float* g, float* cn) {
  GW_INIT;
  for (int row = gw; row < NT; row += NGW) {
    const float4 v = *(const float4*)(projA + (size_t)row * DINA + 1024 + lane * 4);
    const float ss = wave_sum(v.x * v.x + v.y * v.y + v.z * v.z + v.w * v.w);
    const float r = rsqrtf(ss * (1.f / 256.f) + 1e-6f); const float4 g4 = *(const float4*)(g + lane * 4);
    *(float4*)(cn + (size_t)row * 256 + lane * 4) = make_float4(v.x * r * g4.x, v.y * r * g4.y, v.z * r * g4.z, v.w * r * g4.w);
  }
}

__device__ __forceinline__ void np_iscore(const float* projA, float* sc, float* lds) {
  float (*As)[132] = (float (*)[132])lds;
  float (*Bs)[68] = (float (*)[68])(lds + 16 * 132);
  const int tid = TIDX(), tx = tid & 15, ty = tid >> 4;
  const int ar = tid >> 2, ak = (tid & 3) * 4;
  const int br = (tid & 255) >> 2;
  for (int u = BIDX(); u < NB * 64 * 128; u += gridDim.x) {
    const int b = u / (64 * 128), tt = (u / 128) % 64, st = u % 128;
    if (st > 2 * tt + 1) continue;
    const int t0 = tt * 128, s0 = st * 64;
    const float* Qp = projA + (size_t)(b * L + t0 + ar) * DINA + 1280 + ak;
    const float* Kp = projA + (size_t)(b * L + s0 + br) * DINA + 1792 + ak;
    float score[4][4] = {};
    for (int h = 0; h < 8; ++h) {
      float acc[4][4] = {};
      for (int k0 = 0; k0 < 64; k0 += 16) {
        const float4 av = *(const float4*)(Qp + h * 64 + k0);
        As[ak + 0][ar] = av.x; As[ak + 1][ar] = av.y; As[ak + 2][ar] = av.z; As[ak + 3][ar] = av.w;
        if (tid < 256) { const float4 bv = *(const float4*)(Kp + k0); Bs[ak + 0][br] = bv.x; Bs[ak + 1][br] = bv.y; Bs[ak + 2][br] = bv.z; Bs[ak + 3][br] = bv.w; }
        __syncthreads();
#pragma unroll
        for (int kk = 0; kk < 16; ++kk) {
          const float4 a = *(const float4*)&As[kk][ty * 4]; const float4 bq = *(const float4*)&Bs[kk][tx * 4];
          const float aa[4] = {a.x, a.y, a.z, a.w}, bb[4] = {bq.x, bq.y, bq.z, bq.w};
#pragma unroll
          for (int i = 0; i < 4; ++i)
#pragma unroll
            for (int j = 0; j < 4; ++j) acc[i][j] = fmaf(aa[i], bb[j], acc[i][j]);
        }
        __syncthreads();
      }
#pragma unroll
      for (int i = 0; i < 4; ++i) {
        const float w = projA[(size_t)(b * L + t0 + ty * 4 + i) * DINA + 1856 + h] * 0.35355339059327373f;
#pragma unroll
        for (int j = 0; j < 4; ++j) score[i][j] += w * fmaxf(acc[i][j] * 0.125f, 0.f);
      }
    }
#pragma unroll
    for (int i = 0; i < 4; ++i)
#pragma unroll
      for (int j = 0; j < 4; ++j) sc[((size_t)(b * L + t0 + ty * 4 + i)) * L + s0 + tx * 4 + j] = score[i][j];
  }
}

__device__ __forceinline__ unsigned f2key(float f) { f = f + 0.0f; const unsigned u = __float_as_uint(f); return (u & 0x80000000u) ? ~u : (u | 0x80000000u); }

__device__ __forceinline__ void np_topk(const float* sc, int* idx_out, char* lds) {
  GW_INIT;
  unsigned* hist = (unsigned*)(lds + wave * 1280); unsigned* cntw = hist + 256;
  for (int row = gw; row < NT; row += NGW) {
    const int t = row % L, n = t + 1;
    const float* s = sc + (size_t)row * L; int* out = idx_out + (size_t)row * 256;
    if (n <= 256) { for (int i = lane; i < 256; i += 64) out[i] = i < n ? i : -1; continue; }
    unsigned prefix = 0, need = 256;
    for (int pass = 3; pass >= 0; --pass) {
      const int shift = pass * 8;
      for (int i = lane; i < 256; i += 64) hist[i] = 0;
      WSYNC();
      for (int i = lane; i < n; i += 64) { const unsigned k = f2key(s[i]); const bool m = (pass == 3) || ((k >> (shift + 8)) == (prefix >> (shift + 8))); if (m) atomicAdd(&hist[(k >> shift) & 255u], 1u); }
      WSYNC();
      unsigned cum = 0; int d = 255; for (; d > 0; --d) { const unsigned hv = hist[d]; if (cum + hv >= need) break; cum += hv; }
      prefix |= ((unsigned)d << shift); need -= cum;
      WSYNC();
    }
    if (lane == 0) *cntw = 0; WSYNC();
    for (int i = lane; i < n; i += 64) { if (f2key(s[i]) > prefix) { const unsigned pos = atomicAdd(cntw, 1u); out[pos] = i; } }
    WSYNC();
    if (lane == 0) { unsigned c = *cntw; unsigned nd = need; for (int i = 0; i < n && nd > 0; ++i) if (f2key(s[i]) == prefix) { out[c++] = i; --nd; } }
    WSYNC();
  }
}

__device__ __forceinline__ void np_dsa_attn(const float* projA, const float* cn, const int* idx, const float* w_uk, const float* w_uv, float* o2, float* lds) {
  const int half = TIDX() >> 8, tid = TIDX() & 255;
  float* base = lds + half * 14336;
  float* qs = base; float (*ql)[256] = (float (*)[256])(base + 1024); float (*pr)[257] = (float (*)[257])(base + 1024 + 4096);
  float (*ol)[256] = (float (*)[256])(base + 1024 + 4096 + 4112); float* red = base + 1024 + 4096 + 4112 + 4096; int* sid = (int*)(red + 16);
  for (int r0 = BIDX() * 2; r0 < NT; r0 += gridDim.x * 2) {
    const int row = r0 + half, b = row / L;
    __syncthreads();
    for (int i = tid; i < 1024; i += 256) qs[i] = projA[(size_t)row * DINA + i];
    sid[tid] = idx[(size_t)row * 256 + tid];
    __syncthreads();
    { const int c = tid;
#pragma unroll 1
      for (int h = 0; h < 16; ++h) { float a = 0.f;
#pragma unroll 8
        for (int d = 0; d < 64; ++d) a = fmaf(qs[h * 64 + d], w_uk[((size_t)h * 64 + d) * 256 + c], a); ql[h][c] = a; } }
    __syncthreads();
    { const int k = tid, key = sid[k];
      float lg[16];
      if (key >= 0) { const float* cr = cn + (size_t)(b * L + key) * 256;
        for (int h = 0; h < 16; ++h) lg[h] = 0.f;
#pragma unroll 2
        for (int c = 0; c < 256; ++c) { const float cv = cr[c];
#pragma unroll
          for (int h = 0; h < 16; ++h) lg[h] = fmaf(ql[h][c], cv, lg[h]); }
#pragma unroll
        for (int h = 0; h < 16; ++h) pr[h][k] = lg[h] * 0.125f;
      } else {
#pragma unroll
        for (int h = 0; h < 16; ++h) pr[h][k] = -INFINITY; } }
    __syncthreads();
    if (tid < 16) { const int h = tid; float m = -INFINITY; for (int k = 0; k < 256; ++k) m = fmaxf(m, pr[h][k]); float su = 0.f; for (int k = 0; k < 256; ++k) { const float e = expf(pr[h][k] - m); pr[h][k] = e; su += e; } red[h] = 1.f / su; }
    __syncthreads();
    { const int c = tid; float a[16];
#pragma unroll
      for (int h = 0; h < 16; ++h) a[h] = 0.f;
#pragma unroll 2
      for (int k = 0; k < 256; ++k) { const int key = sid[k]; if (key < 0) continue; const float cv = cn[(size_t)(b * L + key) * 256 + c];
#pragma unroll
        for (int h = 0; h < 16; ++h) a[h] = fmaf(pr[h][k], cv, a[h]); }
#pragma unroll
      for (int h = 0; h < 16; ++h) ol[h][c] = a[h] * red[h]; }
    __syncthreads();
#pragma unroll 1
    for (int o = tid; o < 1024; o += 256) { const int h = o >> 6, v = o & 63; float a = 0.f;
#pragma unroll 8
      for (int c = 0; c < 256; ++c) a = fmaf(ol[h][c], w_uv[((size_t)h * 256 + c) * 64 + v], a); o2[(size_t)row * 1024 + o] = a; }
  }
  __syncthreads();
}

__device__ __forceinline__ void np_ln_res(const float* x, const float* h, const float* g, const float* bb, float* out) {
  GW_INIT;
  for (int row = gw; row < NT; row += NGW) {
    float4 v[4]; float s = 0.f;
#pragma unroll
    for (int j = 0; j < 4; ++j) { const float4 a = *(const float4*)(x + (size_t)row * D + lane * 4 + 256 * j), hh = *(const float4*)(h + (size_t)row * D + lane * 4 + 256 * j);
      v[j] = make_float4(ALPHA * a.x + hh.x, ALPHA * a.y + hh.y, ALPHA * a.z + hh.z, ALPHA * a.w + hh.w); s += (v[j].x + v[j].y) + (v[j].z + v[j].w); }
    const float mu = wave_sum(s) * (1.f / D); float q = 0.f;
#pragma unroll
    for (int j = 0; j < 4; ++j) { v[j].x -= mu; v[j].y -= mu; v[j].z -= mu; v[j].w -= mu; q += (v[j].x * v[j].x + v[j].y * v[j].y) + (v[j].z * v[j].z + v[j].w * v[j].w); }
    const float r = rsqrtf(wave_sum(q) * (1.f / D) + 1e-5f);
#pragma unroll
    for (int j = 0; j < 4; ++j) { const int c = lane * 4 + 256 * j; const float4 g4 = *(const float4*)(g + c), b4 = *(const float4*)(bb + c);
      *(float4*)(out + (size_t)row * D + c) = make_float4(v[j].x * r * g4.x + b4.x, v[j].y * r * g4.y + b4.y, v[j].z * r * g4.z + b4.z, v[j].w * r * g4.w + b4.w); }
  }
}

__device__ __forceinline__ void np_router(const float* x, const float* wr, const float* br, int* tok_e, float* tok_g, int* counts, int* row_tok, char* lds) {
  GW_INIT;
  for (int i = BIDX() * NTHR + TIDX(); i < PMAX; i += gridDim.x * NTHR) row_tok[i] = 0;
  float* lg = (float*)(lds + wave * 256);
  const int e = lane & 31, hf = lane >> 5;
  for (int tok = gw; tok < NT; tok += NGW) {
    const float* xr = x + (size_t)tok * D + hf * 512; const float* wp = wr + (size_t)hf * 512 * 32 + e; float a = 0.f;
#pragma unroll 8
    for (int d = 0; d < 512; ++d) a = fmaf(xr[d], wp[d * 32], a);
    a += __shfl_xor(a, 32);
    if (hf == 0) lg[e] = a + br[e];
    WSYNC();
    if (lane == 0) { int ei[4]; float ev[4];
      for (int k = 0; k < 4; ++k) { int bi = 0; float bv = -INFINITY; for (int j = 0; j < 32; ++j) if (lg[j] > bv) { bv = lg[j]; bi = j; } ei[k] = bi; ev[k] = bv; lg[bi] = -INFINITY; }
      float su = 0.f, ex[4]; for (int k = 0; k < 4; ++k) { ex[k] = expf(ev[k] - ev[0]); su += ex[k]; }
      for (int k = 0; k < 4; ++k) { tok_e[tok * 4 + k] = ei[k]; tok_g[tok * 4 + k] = ex[k] / su; atomicAdd(&counts[ei[k]], 1); } }
    WSYNC();
  }
}
__device__ __forceinline__ void np_moe_sort(const int* tok_e, const float* tok_g, const int* counts, int* row_tok, float* row_gate, int* slot_of, int* blk_e, int* nblk_used, char* lds) {
  if (BIDX() != 0) return;
  const int e = TIDX(); int* pstart = (int*)lds; int* stage = pstart + 64;
  if (e == 0) { int acc = 0; for (int j = 0; j < 32; ++j) { pstart[j] = acc; const int nb = (counts[j] + 255) / 256; for (int q = 0; q < nb; ++q) blk_e[acc / 256 + q] = j; acc += nb * 256; } pstart[32] = acc; *nblk_used = acc / 256; }
  __syncthreads();
  int pos = e < 32 ? pstart[e] : 0;
  for (int c0 = 0; c0 < NT * 4; c0 += 2048) {
    __syncthreads();
    for (int i = e; i < 2048; i += NTHR) stage[i] = tok_e[c0 + i];
    __syncthreads();
    if (e < 32) for (int i = 0; i < 2048; ++i) if (stage[i] == e) { const int gi = c0 + i; row_tok[pos] = gi >> 2; row_gate[pos] = tok_g[gi]; slot_of[gi] = pos; ++pos; }
  }
  __syncthreads();
}
__device__ __forceinline__ void np_moe_combine_ln(const float* x1, const float* ys, const int* slot_of, const float* tok_g, const float* g, const float* bb, float* out) {
  GW_INIT;
  for (int row = gw; row < NT; row += NGW) {
    float4 v[4]; float s = 0.f; int sl[4]; float gg[4];
#pragma unroll
    for (int k = 0; k < 4; ++k) { sl[k] = slot_of[row * 4 + k]; gg[k] = tok_g[row * 4 + k]; }
#pragma unroll
    for (int j = 0; j < 4; ++j) { const int c = lane * 4 + 256 * j; float4 f = make_float4(0.f, 0.f, 0.f, 0.f);
#pragma unroll
      for (int k = 0; k < 4; ++k) { const float4 y = *(const float4*)(ys + (size_t)sl[k] * D + c); f.x += gg[k] * y.x; f.y += gg[k] * y.y; f.z += gg[k] * y.z; f.w += gg[k] * y.w; }
      const float4 a = *(const float4*)(x1 + (size_t)row * D + c);
      v[j] = make_float4(ALPHA * a.x + f.x, ALPHA * a.y + f.y, ALPHA * a.z + f.z, ALPHA * a.w + f.w); s += (v[j].x + v[j].y) + (v[j].z + v[j].w); }
    const float mu = wave_sum(s) * (1.f / D); float q = 0.f;
#pragma unroll
    for (int j = 0; j < 4; ++j) { v[j].x -= mu; v[j].y -= mu; v[j].z -= mu; v[j].w -= mu; q += (v[j].x * v[j].x + v[j].y * v[j].y) + (v[j].z * v[j].z + v[j].w * v[j].w); }
    const float r = rsqrtf(wave_sum(q) * (1.f / D) + 1e-5f);
#pragma unroll
    for (int j = 0; j < 4; ++j) { const int c = lane * 4 + 256 * j; const float4 g4 = *(const float4*)(g + c), b4 = *(const float4*)(bb + c);
      *(float4*)(out + (size_t)row * D + c) = make_float4(v[j].x * r * g4.x + b4.x, v[j].y * r * g4.y + b4.y, v[j].z * r * g4.z + b4.z, v[j].w * r * g4.w + b4.w); }
  }
}

__device__ __forceinline__ void np_gla_gate(const float* projB, const float* w_g2, const float* gb, float* adec) {
  GW_INIT;
  for (int row = gw; row < NT; row += NGW) {
    float glr[16];
#pragma unroll
    for (int j = 0; j < 16; ++j) glr[j] = projB[(size_t)row * DINB + 2048 + j];
    for (int c = lane; c < 512; c += 64) { float a = gb[c];
#pragma unroll
      for (int j = 0; j < 16; ++j) a = fmaf(glr[j], w_g2[j * 512 + c], a);
      const float ls = fminf(a, 0.f) - log1pf(expf(-fabsf(a))); adec[(size_t)row * 512 + c] = expf(ls * (1.f / 16.f)); }
  }
}
__device__ __forceinline__ void np_gla_scan(const float* projB, const float* adec, float* og, float* lds) {
  if (BIDX() >= 8) return;
  const int b = BIDX() >> 2, h = BIDX() & 3, tid = TIDX(), dv = tid & 255, dh = tid >> 8;
  float (*qs)[128] = (float (*)[128])lds; float (*ks)[128] = (float (*)[128])(lds + 2048); float (*as)[128] = (float (*)[128])(lds + 4096);
  float (*po)[16][256] = (float (*)[16][256])(lds + 6144);
  float S[64];
#pragma unroll
  for (int d = 0; d < 64; ++d) S[d] = 0.f;
  for (int t0 = 0; t0 < L; t0 += 16) {
    __syncthreads();
    for (int i = tid; i < 16 * 128; i += NTHR) { const int tt = i >> 7, d = i & 127; const size_t r = (size_t)(b * L + t0 + tt);
      qs[tt][d] = projB[r * DINB + h * 128 + d] * 0.08838834764831845f; ks[tt][d] = projB[r * DINB + 512 + h * 128 + d]; as[tt][d] = adec[r * 512 + h * 128 + d]; }
    __syncthreads();
#pragma unroll 1
    for (int tt = 0; tt < 16; ++tt) { const size_t r = (size_t)(b * L + t0 + tt); const float v = projB[r * DINB + 1024 + h * 256 + dv]; float o = 0.f;
#pragma unroll
      for (int d = 0; d < 64; ++d) { S[d] = fmaf(as[tt][dh * 64 + d], S[d], ks[tt][dh * 64 + d] * v); o = fmaf(qs[tt][dh * 64 + d], S[d], o); }
      po[dh][tt][dv] = o; }
    __syncthreads();
    for (int i = tid; i < 16 * 256; i += NTHR) { const int tt = i >> 8, c = i & 255; og[(size_t)(b * L + t0 + tt) * 1024 + h * 256 + c] = po[0][tt][c] + po[1][tt][c]; }
  }
  __syncthreads();
}
__device__ __forceinline__ void np_gla_norm(const float* og, const float* projB, const float* ng, float* on) {
  GW_INIT;
  for (int u = gw; u < NT * 4; u += NGW) {
    const int row = u >> 2, h = u & 3; const int c = h * 256 + lane * 4;
    const float4 v = *(const float4*)(og + (size_t)row * 1024 + c);
    const float r = rsqrtf(wave_sum(v.x * v.x + v.y * v.y + v.z * v.z + v.w * v.w) * (1.f / 256.f) + 1e-6f);
    const float4 rr = *(const float4*)(projB + (size_t)row * DINB + 2064 + c), g4 = *(const float4*)(ng + c);
    *(float4*)(on + (size_t)row * 1024 + c) = make_float4(v.x * r * g4.x * (rr.x / (1.f + expf(-rr.x))), v.y * r * g4.y * (rr.y / (1.f + expf(-rr.y))), v.z * r * g4.z * (rr.z / (1.f + expf(-rr.z))), v.w * r * g4.w * (rr.w / (1.f + expf(-rr.w))));
  }
}

struct Ws { float *projA, *cn, *sc, *o2, *h, *x1, *x2, *hb, *ys, *projB, *adec, *og, *on, *tok_g, *row_gate; int *idx, *tok_e, *slot_of, *row_tok, *blk_e, *counts; };
}
typedef unsigned short bf16_t;
typedef unsigned v4u __attribute__((ext_vector_type(4)));
typedef unsigned v2u __attribute__((ext_vector_type(2)));
typedef float f32x4 __attribute__((ext_vector_type(4)));
typedef short bf16x8 __attribute__((ext_vector_type(8)));
typedef float f32x2_t __attribute__((ext_vector_type(2))); typedef __bf16 bf16x2_t __attribute__((ext_vector_type(2)));
__device__ __forceinline__ unsigned cvt_pk_bf16(float lo, float hi) { const f32x2_t v = {lo, hi}; const bf16x2_t b = __builtin_convertvector(v, bf16x2_t); return __builtin_bit_cast(unsigned, b); }
__device__ __forceinline__ float bf_lo(unsigned u) { return __uint_as_float(u << 16); }
__device__ __forceinline__ float bf_hi(unsigned u) { return __uint_as_float(u & 0xffff0000u); }
__device__ __forceinline__ float bf2f(bf16_t h) { return __uint_as_float(((unsigned)h) << 16); }

struct TJob { const float* src; int lds_; int K, N; bf16_t* dst; int ldd; int drow0, dcol0; int rowmap; int ntk, ntn; };
__device__ __forceinline__ TJob mk_tjob(const float* src, int lds_, int K, int N, bf16_t* dst, int ldd, int drow0, int dcol0, int rowmap) {
  TJob j; j.src = src; j.lds_ = lds_; j.K = K; j.N = N; j.dst = dst; j.ldd = ldd; j.drow0 = drow0; j.dcol0 = dcol0; j.rowmap = rowmap; j.ntk = K / 64; j.ntn = (N + 127) / 128; return j; }
__device__ __forceinline__ int tjob_tiles(const TJob& j) { return j.ntk * j.ntn; }
__device__ __forceinline__ void transpose_tile(const TJob& j, int tile, int lane) {
  const int kt = tile / j.ntn, nt_ = tile % j.ntn, k0 = kt * 64, n0 = nt_ * 128;
  const int q = lane & 31, par = lane >> 5;
  const bool ok = (n0 + 4 * q) < j.N;
  f32x4 v[32];
  const float* sp = j.src + (size_t)(k0 + par) * j.lds_ + n0 + 4 * q;
#pragma unroll
  for (int i = 0; i < 32; ++i) v[i] = ok ? *(const f32x4*)(sp + (size_t)(2 * i) * j.lds_) : (f32x4){0.f, 0.f, 0.f, 0.f};
  unsigned ra[32], rb[32];
#pragma unroll
  for (int i = 0; i < 32; ++i) {
    auto s0 = __builtin_amdgcn_permlane32_swap(__float_as_uint(v[i][0]), __float_as_uint(v[i][2]), false, false);
    auto s1 = __builtin_amdgcn_permlane32_swap(__float_as_uint(v[i][1]), __float_as_uint(v[i][3]), false, false);
    ra[i] = cvt_pk_bf16(__uint_as_float(s0[0]), __uint_as_float(s0[1]));
    rb[i] = cvt_pk_bf16(__uint_as_float(s1[0]), __uint_as_float(s1[1]));
  }
  if (ok) {
    const int n = n0 + 4 * q + 2 * par;
    int r0 = n, r1 = n + 1;
    if (j.rowmap == 1) { const int jj0 = r0 & 1023, jj1 = r1 & 1023; r0 = 256 * (jj0 >> 7) + ((r0 >> 10) << 7) + (jj0 & 127); r1 = 256 * (jj1 >> 7) + ((r1 >> 10) << 7) + (jj1 & 127); }
    bf16_t* d0 = j.dst + (size_t)(j.drow0 + r0) * j.ldd + j.dcol0 + k0;
    bf16_t* d1 = j.dst + (size_t)(j.drow0 + r1) * j.ldd + j.dcol0 + k0;
#pragma unroll
    for (int c = 0; c < 8; ++c) { *(v4u*)(d0 + 8 * c) = (v4u){ra[4 * c], ra[4 * c + 1], ra[4 * c + 2], ra[4 * c + 3]}; *(v4u*)(d1 + 8 * c) = (v4u){rb[4 * c], rb[4 * c + 1], rb[4 * c + 2], rb[4 * c + 3]}; }
  }
}
__device__ __forceinline__ void transpose_job(const TJob j, int& w0, int gw, int NGW, int lane) {
  const int nt_ = tjob_tiles(j);
  int first = gw - (w0 % NGW); if (first < 0) first += NGW;
#pragma unroll 1
  for (int t = first; t < nt_; t += NGW) transpose_tile(j, t, lane);
  w0 += nt_;
}
__device__ __forceinline__ void zero_rect(bf16_t* dst, int ldd, int r0, int nr, int cb0, int nbytes, int gtid, int NGT) {
  const int per = nbytes / 16;
  for (int i = gtid; i < nr * per; i += NGT) { const int r = i / per, c = i % per; *(v4u*)((char*)(dst + (size_t)(r0 + r) * ldd) + cb0 + 16 * c) = (v4u){0u, 0u, 0u, 0u}; }
}
__device__ __forceinline__ void cvt_f32_to_bf16(const float* src, int lds_, bf16_t* dst, int ldd, int rows, int ncols, int gtid, int NGT) {
  const int per = ncols / 4;
  for (size_t i = gtid; i < (size_t)rows * per; i += NGT) { const size_t r = i / per; const int c = (int)(i % per) * 4; const f32x4 v = *(const f32x4*)(src + r * lds_ + c);
    *(v2u*)(dst + r * ldd + c) = (v2u){cvt_pk_bf16(v[0], v[1]), cvt_pk_bf16(v[2], v[3])}; }
}
__device__ __forceinline__ void cvt_bf16_to_f32(const bf16_t* src, int lds_, float* dst, int ldd, int rows, int ncols, int gtid, int NGT) {
  const int per = ncols / 4;
  for (size_t i = gtid; i < (size_t)rows * per; i += NGT) { const size_t r = i / per; const int c = (int)(i % per) * 4; const v2u v = *(const v2u*)(src + r * lds_ + c);
    *(f32x4*)(dst + r * ldd + c) = (f32x4){bf_lo(v[0]), bf_hi(v[0]), bf_lo(v[1]), bf_hi(v[1])}; }
}

namespace pg8 {
#define PG8_LAS __attribute__((address_space(3)))
typedef unsigned u32x4 __attribute__((ext_vector_type(4)));
constexpr int BM = 256, BK = 64, HALF = 128, HTB = HALF * BK * 2, STAGE_BYTES = 8 * HTB, NXCD = 8, WGM = 8;
__host__ __device__ __forceinline__ int lds_byte(int r, int c) { const int st = (r >> 4) * 2 + (c >> 5), rr = r & 15, cc = c & 31, ob = rr * 64 + cc * 2; return st * 1024 + (ob ^ (((ob >> 9) & 1) << 5)); }
__host__ __device__ __forceinline__ void stage_rc(int b, int& R, int& C) { const int st = b / 1024, sb = b % 1024, swz = sb ^ (((sb >> 9) & 1) << 5); R = (st >> 1) * 16 + swz / 64; C = (st & 1) * 32 + (swz % 64) / 2; }
__host__ __device__ __forceinline__ int perm32(int rho) { const int n = rho >> 4, i = rho & 15; return 8 * (i >> 2) + 4 * n + (i & 3); }
struct Unit { const char* pa; const char* pb; int orow, ocol, e, kind; };
struct Gemm { int lda, ldb, K; };
struct StaticOrder {
    static constexpr bool GATHER = false; const int* rowmap;
    const char* A; const char* Bt; size_t ta, tb; int nM, nN, nwg, G, c;
    __device__ void init(const void* A_, int lda, const void* Bt_, int ldb, int M, int N, int G_, int c_) { A = (const char*)A_; Bt = (const char*)Bt_; ta = (size_t)BM * lda * 2; tb = (size_t)BM * ldb * 2; nM = M / BM; nN = N / BM; nwg = nM * nN; G = G_; c = c_; }
    __device__ bool tile(int i, int& pm, int& pn) const {
        const long L = (long)i * G + c; if (L >= nwg) return false;
        int wgid = (int)L; { const int q = nwg / NXCD, r = nwg % NXCD, xcd = wgid % NXCD, off = wgid / NXCD; wgid = (xcd < r ? xcd * (q + 1) : r * (q + 1) + (xcd - r) * q) + off; }
        const int nig = WGM * nN, gid = wgid / nig, fm = gid * WGM, gsz = (nM - fm) < WGM ? (nM - fm) : WGM;
        pm = fm + ((wgid % nig) % gsz); pn = (wgid % nig) / gsz; return true;
    }
    __device__ bool next(int i, Unit& u) const { int pm, pn; if (!tile(i, pm, pn)) return false; u.pa = A + (size_t)pm * ta; u.pb = Bt + (size_t)pn * tb; u.orow = pm * BM; u.ocol = pn * BM; u.e = 0; u.kind = 0; return true; }
    __device__ __forceinline__ int rowof(const Unit&, int r) const { return r; }
    __device__ __forceinline__ void a_ready(const Unit&) const {}
    __device__ __forceinline__ void done(const Unit&) const {}
};
struct EpiStore {
    static constexpr bool PERM = true, AFTER_DRAIN = false;
    bf16_t* O; int ldc;
    __device__ __forceinline__ void operator()(const f32x4 (&acc)[2][2][4][2], const Unit& u, int wr, int wc, int fr, int fq) const {
        const int row0 = u.orow + wr * 64 + fr, col0 = u.ocol + wc * 32 + 8 * fq;
#pragma unroll
        for (int ai = 0; ai < 2; ++ai)
#pragma unroll
            for (int m = 0; m < 4; ++m) { bf16_t* rowp = O + (size_t)(row0 + ai * HALF + m * 16) * ldc + col0;
#pragma unroll
                for (int bj = 0; bj < 2; ++bj) { const f32x4 v0 = acc[ai][bj][m][0], v1 = acc[ai][bj][m][1];
                    u32x4 w; w.x = cvt_pk_bf16(v0[0], v0[1]); w.y = cvt_pk_bf16(v0[2], v0[3]); w.z = cvt_pk_bf16(v1[0], v1[1]); w.w = cvt_pk_bf16(v1[2], v1[3]);
                    *(u32x4*)(rowp + bj * HALF) = w; } }
    }
};
template <class Epi, class Sched, bool ALIGN_EPI = false, bool SP2 = false>
__device__ __forceinline__ void gemm_phase(PG8_LAS unsigned char* lds, const Gemm g, const Sched& S, const Epi& E) {
    const int tid = TIDX(), wid = __builtin_amdgcn_readfirstlane(tid >> 6), lane = tid & 63, wr = wid >> 2, wc = wid & 3, fr = lane & 15, fq = lane >> 4;
    const int K = g.K, nt = K / BK;
    unsigned voffA[2], voffB[2];
#pragma unroll
    for (int i = 0; i < 2; ++i) { int R, C; stage_rc(tid * 16 + i * 8192, R, C); const int Rb = Epi::PERM ? ((R & ~31) + perm32(R & 31)) : R;
        voffA[i] = (unsigned)(R * g.lda + C) * 2u; voffB[i] = (unsigned)(Rb * g.ldb + C) * 2u; }
    unsigned voffG[2][2][2]; int gR[2], gC[2];
#pragma unroll
    for (int i = 0; i < 2; ++i) { int R, C; stage_rc(tid * 16 + i * 8192, R, C); gR[i] = R; gC[i] = C; }
#define PG8_GOFF(dst, unit_) do { if constexpr (Sched::GATHER) { _Pragma("unroll") for (int _h = 0; _h < 2; ++_h) _Pragma("unroll") for (int _i = 0; _i < 2; ++_i) \
        dst[_h][_i] = (unsigned)S.rowof(unit_, (unit_).orow + _h * HALF + gR[_i]) * (unsigned)(g.lda * 2) + (unsigned)gC[_i] * 2u; } } while (0)
#define PG8_STAGE_A(bufoff, gptr, half, vsel) do { if constexpr (Sched::GATHER) { PG8_STAGE(bufoff, gptr, vsel); } else { PG8_STAGE(bufoff, (gptr) + (half) * hstepA, voffA); } } while (0)
    const size_t kstep = (size_t)(BK * 2);
    const size_t hstepA = (size_t)HALF * g.lda * 2, hstepB = (size_t)HALF * g.ldb * 2;
    const unsigned ldsw = (unsigned)wid * 1024u;
    const int aoff = lds_byte(wr * 64 + fr, fq * 8), boff = lds_byte(wc * 32 + fr, fq * 8);
#define PG8_SA(b, h) (((b) * 2 + (h)) * HTB)
#define PG8_SB(b, h) ((4 + (b) * 2 + (h)) * HTB)
#define PG8_STAGE(bufoff, gbase, voff) do { _Pragma("unroll") for (int _i = 0; _i < 2; ++_i) \
        __builtin_amdgcn_global_load_lds((const unsigned*)((const char*)(gbase) + (voff)[_i]), (PG8_LAS unsigned*)(lds + (bufoff) + ldsw + _i * 8192), 16, 0, 0); } while (0)
#define PG8_LDA(dst, b, h) do { _Pragma("unroll") for (int m = 0; m < 4; ++m) _Pragma("unroll") for (int k = 0; k < 2; ++k) dst[m][k] = *(const PG8_LAS bf16x8*)(lds + PG8_SA(b, h) + aoff + m * 2048 + k * 1024); } while (0)
#define PG8_LDB(dst, b, h) do { _Pragma("unroll") for (int n = 0; n < 2; ++n) _Pragma("unroll") for (int k = 0; k < 2; ++k) dst[n][k] = *(const PG8_LAS bf16x8*)(lds + PG8_SB(b, h) + boff + n * 2048 + k * 1024); } while (0)
#define PG8_MMA(ai, bj, At, Bt) do { __builtin_amdgcn_s_setprio(1); _Pragma("unroll") for (int m = 0; m < 4; ++m) _Pragma("unroll") for (int n = 0; n < 2; ++n) _Pragma("unroll") for (int k = 0; k < 2; ++k) \
        acc[ai][bj][m][n] = __builtin_amdgcn_mfma_f32_16x16x32_bf16(Bt[n][k], At[m][k], acc[ai][bj][m][n], 0, 0, 0); __builtin_amdgcn_s_setprio(0); } while (0)
#define PG8_WAIT_V(n) asm volatile("s_waitcnt vmcnt(" #n ")" ::: "memory")
#define PG8_WAIT_L(n) asm volatile("s_waitcnt lgkmcnt(" #n ")" ::: "memory")
#define PG8_BAR __builtin_amdgcn_s_barrier()
#define PG8_SCHED __builtin_amdgcn_sched_barrier(0)
    Unit cur, nxt; int ui = 0;
    if (!S.next(0, cur)) return;
    f32x4 acc[2][2][4][2];
#pragma unroll
    for (int a = 0; a < 2; ++a)
#pragma unroll
        for (int b = 0; b < 2; ++b)
#pragma unroll
            for (int m = 0; m < 4; ++m)
#pragma unroll
                for (int n = 0; n < 2; ++n) acc[a][b][m][n] = (f32x4){0.f, 0.f, 0.f, 0.f};
    bf16x8 At[4][2], B0[2][2], B1[2][2];
    const char* cA = cur.pa; const char* cB = cur.pb;
    S.a_ready(cur);
    PG8_GOFF(voffG[0], cur);
    if constexpr (SP2) {
        PG8_STAGE(PG8_SB(0, 0), cB, voffB); PG8_STAGE(PG8_SB(0, 1), cB + hstepB, voffB); PG8_STAGE_A(PG8_SA(0, 0), cA, 0, voffG[0][0]); PG8_STAGE_A(PG8_SA(0, 1), cA, 1, voffG[0][1]);
        if (wr == 1) PG8_BAR;
        PG8_WAIT_V(2); PG8_BAR;
        PG8_STAGE(PG8_SB(1, 0), cB + kstep, voffB); PG8_STAGE_A(PG8_SA(1, 0), cA + kstep, 0, voffG[0][0]); PG8_STAGE(PG8_SB(1, 1), cB + hstepB + kstep, voffB);
        PG8_WAIT_V(6); PG8_BAR;
    } else {
        PG8_STAGE(PG8_SB(0, 0), cB, voffB); PG8_STAGE_A(PG8_SA(0, 0), cA, 0, voffG[0][0]); PG8_STAGE(PG8_SB(0, 1), cB + hstepB, voffB); PG8_STAGE_A(PG8_SA(0, 1), cA, 1, voffG[0][1]);
        if (wr == 1) PG8_BAR;
        PG8_WAIT_V(4); PG8_BAR;
        PG8_STAGE(PG8_SB(1, 0), cB + kstep, voffB); PG8_STAGE_A(PG8_SA(1, 0), cA + kstep, 0, voffG[0][0]); PG8_STAGE(PG8_SB(1, 1), cB + hstepB + kstep, voffB);
        PG8_WAIT_V(6); PG8_BAR;
    }
    for (;;) {
        const bool has_next = S.next(ui + 1, nxt);
        if constexpr (Sched::GATHER) { if (has_next) { PG8_GOFF(voffG[1], nxt); } else {
#pragma unroll
            for (int _h = 0; _h < 2; ++_h)
#pragma unroll
                for (int _i = 0; _i < 2; ++_i) voffG[1][_h][_i] = voffG[0][_h][_i]; } }
        const char* nA = has_next ? nxt.pa : cA; const char* nB = has_next ? nxt.pb : cB;
        for (int t = 0; t < nt; t += 2) {
            const bool last = (t == nt - 2);
            const char* a1 = cA + (size_t)(t + 1) * kstep;
            const char* a2 = last ? nA : cA + (size_t)(t + 2) * kstep; const char* b2 = last ? nB : cB + (size_t)(t + 2) * kstep;
            const char* a3 = a2 + kstep; const char* b3 = b2 + kstep;
            unsigned vs0[2], vs1[2];
#pragma unroll
            for (int _i = 0; _i < 2; ++_i) { vs0[_i] = last ? voffG[1][0][_i] : voffG[0][0][_i]; vs1[_i] = last ? voffG[1][1][_i] : voffG[0][1][_i]; }
            if (last && has_next) S.a_ready(nxt);
            if constexpr (SP2) {
            PG8_LDB(B0, 0, 0); PG8_LDB(B1, 0, 1); PG8_SCHED; PG8_LDA(At, 0, 0); PG8_STAGE_A(PG8_SA(1, 1), a1, 1, voffG[0][1]);
            PG8_WAIT_V(8); PG8_WAIT_L(0); PG8_BAR; PG8_MMA(0, 0, At, B0); PG8_MMA(0, 1, At, B1); PG8_BAR; PG8_SCHED;
            PG8_LDA(At, 0, 1); PG8_STAGE(PG8_SB(0, 0), b2, voffB); PG8_STAGE(PG8_SB(0, 1), b2 + hstepB, voffB); PG8_STAGE_A(PG8_SA(0, 0), a2, 0, vs0);
            PG8_WAIT_V(8); PG8_WAIT_L(0); PG8_BAR; PG8_MMA(1, 0, At, B0); PG8_MMA(1, 1, At, B1); PG8_BAR; PG8_SCHED;
            PG8_LDB(B0, 1, 0); PG8_LDB(B1, 1, 1); PG8_SCHED; PG8_LDA(At, 1, 0); PG8_STAGE_A(PG8_SA(0, 1), a2, 1, vs1);
            PG8_WAIT_V(8); PG8_WAIT_L(0); PG8_BAR; PG8_MMA(0, 0, At, B0); PG8_MMA(0, 1, At, B1); PG8_BAR; PG8_SCHED;
            PG8_LDA(At, 1, 1); PG8_STAGE(PG8_SB(1, 0), b3, voffB); PG8_STAGE(PG8_SB(1, 1), b3 + hstepB, voffB); PG8_STAGE_A(PG8_SA(1, 0), a3, 0, vs0);
            PG8_WAIT_V(8); PG8_WAIT_L(0); PG8_BAR; PG8_MMA(1, 0, At, B0); PG8_MMA(1, 1, At, B1); PG8_BAR; PG8_SCHED;
            } else {
            PG8_LDB(B0, 0, 0); PG8_SCHED; PG8_LDA(At, 0, 0); PG8_STAGE_A(PG8_SA(1, 1), a1, 1, voffG[0][1]);
            PG8_WAIT_L(8); PG8_BAR; PG8_WAIT_L(0); PG8_MMA(0, 0, At, B0); PG8_BAR; PG8_SCHED;
            PG8_LDB(B1, 0, 1); PG8_STAGE(PG8_SB(0, 0), b2, voffB);
            PG8_BAR; PG8_WAIT_L(0); PG8_MMA(0, 1, At, B1); PG8_BAR;
            PG8_LDA(At, 0, 1); PG8_STAGE_A(PG8_SA(0, 0), a2, 0, vs0);
            PG8_BAR; PG8_WAIT_L(0); PG8_MMA(1, 0, At, B0); PG8_BAR; PG8_SCHED;
            PG8_STAGE(PG8_SB(0, 1), b2 + hstepB, voffB);
            PG8_WAIT_V(6); PG8_BAR; PG8_MMA(1, 1, At, B1); PG8_BAR;
            PG8_LDB(B0, 1, 0); PG8_SCHED; PG8_LDA(At, 1, 0); PG8_STAGE_A(PG8_SA(0, 1), a2, 1, vs1);
            PG8_WAIT_L(8); PG8_BAR; PG8_WAIT_L(0); PG8_MMA(0, 0, At, B0); PG8_BAR; PG8_SCHED;
            PG8_LDB(B1, 1, 1); PG8_STAGE(PG8_SB(1, 0), b3, voffB);
            PG8_BAR; PG8_WAIT_L(0); PG8_MMA(0, 1, At, B1); PG8_BAR;
            PG8_LDA(At, 1, 1); PG8_STAGE_A(PG8_SA(1, 0), a3, 0, vs0);
            PG8_BAR; PG8_WAIT_L(0); PG8_MMA(1, 0, At, B0); PG8_BAR; PG8_SCHED;
            PG8_STAGE(PG8_SB(1, 1), b3 + hstepB, voffB);
            PG8_WAIT_V(6); PG8_BAR; PG8_MMA(1, 1, At, B1); PG8_BAR;
            }
        }
        if constexpr (ALIGN_EPI) { if (wr == 0) PG8_BAR; }
        if constexpr (!Epi::AFTER_DRAIN) { E(acc, cur, wr, wc, fr, fq); S.done(cur); }
        if (!has_next) break;
#pragma unroll
        for (int a = 0; a < 2; ++a)
#pragma unroll
            for (int b = 0; b < 2; ++b)
#pragma unroll
                for (int m = 0; m < 4; ++m)
#pragma unroll
                    for (int n = 0; n < 2; ++n) acc[a][b][m][n] = (f32x4){0.f, 0.f, 0.f, 0.f};
        cur = nxt; cA = nA; cB = nB; ++ui;
        if constexpr (Sched::GATHER) {
#pragma unroll
            for (int _h = 0; _h < 2; ++_h)
#pragma unroll
                for (int _i = 0; _i < 2; ++_i) voffG[0][_h][_i] = voffG[1][_h][_i]; }
        if constexpr (ALIGN_EPI) { if (wr == 1) PG8_BAR; }
    }
    PG8_WAIT_V(0);
    if constexpr (!ALIGN_EPI) { if (wr == 0) PG8_BAR; }
    PG8_BAR;
    if constexpr (Epi::AFTER_DRAIN) { E.fused(acc, cur, wr, wc, fr, fq, lds, wid, lane); S.done(cur); }
#undef PG8_SA
#undef PG8_SB
#undef PG8_STAGE
#undef PG8_STAGE_A
#undef PG8_GOFF
#undef PG8_LDA
#undef PG8_LDB
#undef PG8_MMA
#undef PG8_WAIT_V
#undef PG8_WAIT_L
#undef PG8_BAR
#undef PG8_SCHED
}

}
#define WSYNC2() asm volatile("s_waitcnt lgkmcnt(0)" ::: "memory")
struct MoeBufs { int* tok_e; float* tok_g; int* slot_of; float* slot_gate; int* blk_e; int* blkcnt; int* nblk; int* slot_tok; };
constexpr int WRT_LD = 1028;

template <bool XB> __device__ __forceinline__ void ph_ln_router(const void* xin_, const bf16_t* hb, const float* g, const float* bb, const float* wr, const float* br, bf16_t* x1b, const MoeBufs m, float* lds) {
  const float* xin = (const float*)xin_; const bf16_t* xinb = (const bf16_t*)xin_;
  for (int i = BIDX() * NTHR + TIDX(); i < PMAX; i += (int)gridDim.x * NTHR) m.slot_tok[i] = 0;
  const int tid = TIDX(), lane = tid & 63, wave = tid >> 6, blk = BIDX();
  float* wT = lds;
  float* lg = lds + 32 * WRT_LD + wave * 64;
  int* cnt = (int*)(lds + 32 * WRT_LD + 8 * 64);
  { f32x4 wv[16];
#pragma unroll
    for (int k = 0; k < 16; ++k) wv[k] = *(const f32x4*)(wr + (size_t)(tid + NTHR * k) * 4);
#pragma unroll
    for (int k = 0; k < 16; ++k) { const int i = (tid + NTHR * k) * 4, d = i >> 5, e = i & 31;
#pragma unroll
      for (int z = 0; z < 4; ++z) wT[(e + z) * WRT_LD + d] = wv[k][z]; } }
  if (tid < 32) cnt[tid] = 0;
  __syncthreads();
#pragma unroll 1
  for (int it = 0; it < 8; it += 2) {
    const int tok0 = blk * 64 + wave * 8 + it;
    f32x4 v[2][4]; float s[2] = {0.f, 0.f};
#pragma unroll
    for (int q = 0; q < 2; ++q)
#pragma unroll
      for (int j = 0; j < 4; ++j) { const int c = lane * 4 + 256 * j; f32x4 a;
        if (XB) { const v2u xv = *(const v2u*)(xinb + (size_t)(tok0 + q) * D + c); a = (f32x4){bf_lo(xv[0]), bf_hi(xv[0]), bf_lo(xv[1]), bf_hi(xv[1])}; } else a = *(const f32x4*)(xin + (size_t)(tok0 + q) * D + c);
        const v2u hh = *(const v2u*)(hb + (size_t)(tok0 + q) * D + c);
        v[q][j] = (f32x4){ALPHA * a[0] + bf_lo(hh[0]), ALPHA * a[1] + bf_hi(hh[0]), ALPHA * a[2] + bf_lo(hh[1]), ALPHA * a[3] + bf_hi(hh[1])}; s[q] += (v[q][j][0] + v[q][j][1]) + (v[q][j][2] + v[q][j][3]); }
#pragma unroll
    for (int o = 1; o < 64; o <<= 1) { s[0] += __shfl_xor(s[0], o); s[1] += __shfl_xor(s[1], o); }
    float qq[2] = {0.f, 0.f};
#pragma unroll
    for (int q = 0; q < 2; ++q) { const float mu = s[q] * (1.f / D);
#pragma unroll
      for (int j = 0; j < 4; ++j) { v[q][j] = v[q][j] - mu; qq[q] += (v[q][j][0] * v[q][j][0] + v[q][j][1] * v[q][j][1]) + (v[q][j][2] * v[q][j][2] + v[q][j][3] * v[q][j][3]); } }
#pragma unroll
    for (int o = 1; o < 64; o <<= 1) { qq[0] += __shfl_xor(qq[0], o); qq[1] += __shfl_xor(qq[1], o); }
#pragma unroll
    for (int q = 0; q < 2; ++q) { const float r = rsqrtf(qq[q] * (1.f / D) + 1e-5f);
#pragma unroll
      for (int j = 0; j < 4; ++j) { const int c = lane * 4 + 256 * j; const f32x4 g4 = *(const f32x4*)(g + c), b4 = *(const f32x4*)(bb + c); v[q][j] = v[q][j] * r * g4 + b4; *(v2u*)(x1b + (size_t)(tok0 + q) * D + c) = (v2u){cvt_pk_bf16(v[q][j][0], v[q][j][1]), cvt_pk_bf16(v[q][j][2], v[q][j][3])}; } }
    float p[2][32];
#pragma unroll
    for (int e = 0; e < 32; ++e) { float a0 = 0.f, a1 = 0.f;
#pragma unroll
      for (int j = 0; j < 4; ++j) { const f32x4 w4 = *(const f32x4*)(wT + e * WRT_LD + lane * 4 + 256 * j);
        a0 = fmaf(v[0][j][0], w4[0], a0); a0 = fmaf(v[0][j][1], w4[1], a0); a0 = fmaf(v[0][j][2], w4[2], a0); a0 = fmaf(v[0][j][3], w4[3], a0);
        a1 = fmaf(v[1][j][0], w4[0], a1); a1 = fmaf(v[1][j][1], w4[1], a1); a1 = fmaf(v[1][j][2], w4[2], a1); a1 = fmaf(v[1][j][3], w4[3], a1); }
      p[0][e] = a0; p[1][e] = a1; }
#pragma unroll
    for (int i = 0; i < 16; ++i) { const bool hi = (lane & 32) != 0;
#pragma unroll
      for (int q = 0; q < 2; ++q) { const float send = hi ? p[q][i] : p[q][i + 16]; const float keep = hi ? p[q][i + 16] : p[q][i]; p[q][i] = keep + __shfl_xor(send, 32); } }
#pragma unroll
    for (int i = 0; i < 8; ++i) { const bool hi = (lane & 16) != 0;
#pragma unroll
      for (int q = 0; q < 2; ++q) { const float send = hi ? p[q][i] : p[q][i + 8]; const float keep = hi ? p[q][i + 8] : p[q][i]; p[q][i] = keep + __shfl_xor(send, 16); } }
#pragma unroll
    for (int i = 0; i < 4; ++i) { const bool hi = (lane & 8) != 0;
#pragma unroll
      for (int q = 0; q < 2; ++q) { const float send = hi ? p[q][i] : p[q][i + 4]; const float keep = hi ? p[q][i + 4] : p[q][i]; p[q][i] = keep + __shfl_xor(send, 8); } }
#pragma unroll
    for (int i = 0; i < 2; ++i) { const bool hi = (lane & 4) != 0;
#pragma unroll
      for (int q = 0; q < 2; ++q) { const float send = hi ? p[q][i] : p[q][i + 2]; const float keep = hi ? p[q][i + 2] : p[q][i]; p[q][i] = keep + __shfl_xor(send, 4); } }
#pragma unroll
    for (int q = 0; q < 2; ++q) { const bool hi = (lane & 2) != 0; const float send = hi ? p[q][0] : p[q][1]; const float keep = hi ? p[q][1] : p[q][0]; p[q][0] = keep + __shfl_xor(send, 2); }
    p[0][0] += __shfl_xor(p[0][0], 1); p[1][0] += __shfl_xor(p[1][0], 1);
    const int e_l = ((lane >> 5) & 1) * 16 + ((lane >> 4) & 1) * 8 + ((lane >> 3) & 1) * 4 + ((lane >> 2) & 1) * 2 + ((lane >> 1) & 1);
    const float brl = br[e_l];
    float lv[2] = {p[0][0] + brl, p[1][0] + brl}; int ei[2][4]; float ev[2][4];
#pragma unroll
    for (int k = 0; k < 4; ++k) { float bv[2] = {lv[0], lv[1]}; int bi[2] = {e_l, e_l};
#pragma unroll
      for (int o = 2; o < 64; o <<= 1)
#pragma unroll
        for (int q = 0; q < 2; ++q) { const float ov = __shfl_xor(bv[q], o); const int oi = __shfl_xor(bi[q], o); const bool take = (ov > bv[q]) || (ov == bv[q] && oi < bi[q]); bv[q] = take ? ov : bv[q]; bi[q] = take ? oi : bi[q]; }
#pragma unroll
      for (int q = 0; q < 2; ++q) { ei[q][k] = bi[q]; ev[q][k] = bv[q]; if (e_l == bi[q]) lv[q] = -INFINITY; } }
    if (lane < 2) { const int q = lane;
      float ex[4], su = 0.f;
#pragma unroll
      for (int k = 0; k < 4; ++k) { ex[k] = __expf((q ? ev[1][k] : ev[0][k]) - (q ? ev[1][0] : ev[0][0])); su += ex[k]; }
      const float inv = 1.f / su; const int tok = tok0 + q;
      const int e0 = q ? ei[1][0] : ei[0][0], e1 = q ? ei[1][1] : ei[0][1], e2 = q ? ei[1][2] : ei[0][2], e3 = q ? ei[1][3] : ei[0][3];
      *(int4*)(m.tok_e + tok * 4) = make_int4(e0, e1, e2, e3);
      *(float4*)(m.tok_g + tok * 4) = make_float4(ex[0] * inv, ex[1] * inv, ex[2] * inv, ex[3] * inv);
      atomicAdd(&cnt[e0], 1); atomicAdd(&cnt[e1], 1); atomicAdd(&cnt[e2], 1); atomicAdd(&cnt[e3], 1); }
  }
  __syncthreads();
  if (tid < 32) m.blkcnt[blk * 32 + tid] = cnt[tid];
  __syncthreads();
}

__device__ __forceinline__ void ph_moe_scatter(const MoeBufs m, int* ilds) {
  const int tid = TIDX(), lane = tid & 63, wave = tid >> 6, blk = BIDX(); (void)lane;
  int* tot = ilds; int* bef = ilds + 32; int* pst = ilds + 64; int* es = ilds + 128; int* rk = ilds + 384; int* sl = ilds + 640; int* part = ilds + 896; int* wcnt = ilds + 1408;
  { const int e = tid & 31, pa = tid >> 5; int sum = 0;
#pragma unroll
    for (int q = 0; q < 16; ++q) sum += m.blkcnt[(pa * 16 + q) * 32 + e];
    part[pa * 32 + e] = sum; }
  if (tid < 256) es[tid] = m.tok_e[blk * 256 + tid];
  __syncthreads();
  if (tid < 32) { const int e = tid; int t_ = 0, b_ = 0; const int pb_ = blk >> 4;
    for (int q = 0; q < 16; ++q) { const int v = part[q * 32 + e]; t_ += v; if (q < pb_) b_ += v; }
    for (int q = pb_ * 16; q < blk; ++q) b_ += m.blkcnt[q * 32 + e];
    tot[e] = t_; bef[e] = b_; }
  if (tid < 256) { const int e = es[tid]; const unsigned long long lt = (1ull << lane) - 1ull; int r = 0;
    for (int ee = 0; ee < 32; ++ee) { const unsigned long long mk = __ballot(e == ee); if (e == ee) r = __builtin_popcountll(mk & lt); if (lane == ee) wcnt[wave * 32 + ee] = __builtin_popcountll(mk); }
    rk[tid] = r; }
  __syncthreads();
  if (tid == 0) { int acc = 0; for (int e = 0; e < 32; ++e) { pst[e] = acc; acc += ((tot[e] + 255) >> 8) << 8; } pst[32] = acc;
    if (blk == 0) { *m.nblk = acc >> 8; for (int e = 0; e < 32; ++e) for (int q = pst[e] >> 8; q < (pst[e + 1] >> 8); ++q) m.blk_e[q] = e; } }
  __syncthreads();
  if (tid < 256) { const int e = es[tid]; int rank = rk[tid]; for (int w2 = 0; w2 < wave; ++w2) rank += wcnt[w2 * 32 + e];
    const int slot = pst[e] + bef[e] + rank; m.slot_of[blk * 256 + tid] = slot; m.slot_gate[slot] = m.tok_g[blk * 256 + tid]; m.slot_tok[slot] = blk * 64 + (tid >> 2); }
  __syncthreads();
  __syncthreads();
}

__device__ __forceinline__ void ph_combine_ln(const bf16_t* x1b, const bf16_t* Ys, const int* slot_of, const float* g, const float* bb, float* out, bf16_t* outb) {
  const int tid = TIDX(), lane = tid & 63, gw = BIDX() * 8 + (tid >> 6), NGW = (int)gridDim.x * 8;
  for (int row = gw; row < NT; row += NGW) {
    const int4 s4 = *(const int4*)(slot_of + row * 4); const int sl[4] = {s4.x, s4.y, s4.z, s4.w};
    f32x4 v[4]; float s = 0.f;
#pragma unroll
    for (int j = 0; j < 4; ++j) { const int c = lane * 4 + 256 * j; f32x4 f = (f32x4){0.f, 0.f, 0.f, 0.f};
#pragma unroll
      for (int k = 0; k < 4; ++k) { const v2u y = *(const v2u*)(Ys + (size_t)sl[k] * D + c); f += (f32x4){bf_lo(y[0]), bf_hi(y[0]), bf_lo(y[1]), bf_hi(y[1])}; }
      const v2u xv = *(const v2u*)(x1b + (size_t)row * D + c); const f32x4 a = (f32x4){bf_lo(xv[0]), bf_hi(xv[0]), bf_lo(xv[1]), bf_hi(xv[1])}; v[j] = a * ALPHA + f; s += (v[j][0] + v[j][1]) + (v[j][2] + v[j][3]); }
    const float mu = wave_sum(s) * (1.f / D); float q = 0.f;
#pragma unroll
    for (int j = 0; j < 4; ++j) { v[j] = v[j] - mu; q += (v[j][0] * v[j][0] + v[j][1] * v[j][1]) + (v[j][2] * v[j][2] + v[j][3] * v[j][3]); }
    const float r = rsqrtf(wave_sum(q) * (1.f / D) + 1e-5f);
#pragma unroll
    for (int j = 0; j < 4; ++j) { const int c = lane * 4 + 256 * j; const f32x4 g4 = *(const f32x4*)(g + c), b4 = *(const f32x4*)(bb + c); const f32x4 o = v[j] * r * g4 + b4;
      if (out) *(f32x4*)(out + (size_t)row * D + c) = o; if (outb) *(v2u*)(outb + (size_t)row * D + c) = (v2u){cvt_pk_bf16(o[0], o[1]), cvt_pk_bf16(o[2], o[3])}; }
  }
}

namespace pg8 {
template <bool GATHER_> struct MoeOrderT {
    static constexpr bool GATHER = GATHER_; const int* rowmap;
    StaticOrder so; const int* blk_e; const char* W; size_t wexp; int obn;
    __device__ void init(const void* A, int lda, const void* W_, int ldb, size_t wexp_, int nM, int nN, int obn_, const int* blk_e_, int G, int c) { so.init(A, lda, W_, ldb, nM * BM, nN * BM, G, c); blk_e = blk_e_; W = (const char*)W_; wexp = wexp_; obn = obn_; }
    __device__ bool next(int i, Unit& u) const { int pm, pn; if (!so.tile(i, pm, pn)) return false; const int e = __builtin_amdgcn_readfirstlane(blk_e[pm]); u.pa = GATHER_ ? so.A : so.A + (size_t)pm * so.ta; u.pb = W + (size_t)e * wexp + (size_t)pn * so.tb; u.orow = pm * BM; u.ocol = pn * obn; u.e = e; u.kind = 0; return true; }
    __device__ __forceinline__ int rowof(const Unit&, int r) const { return GATHER_ ? rowmap[r] : r; }
    __device__ __forceinline__ void a_ready(const Unit&) const {}
    __device__ __forceinline__ void done(const Unit&) const {}
};
typedef MoeOrderT<false> MoeOrder; typedef MoeOrderT<true> MoeOrderG;
struct EpiSwiglu {
    static constexpr bool PERM = true, AFTER_DRAIN = false;
    bf16_t* O; int ldc; const float* b1;
    __device__ __forceinline__ void operator()(const f32x4 (&acc)[2][2][4][2], const Unit& u, int wr, int wc, int fr, int fq) const {
        const int row0 = u.orow + wr * 64 + fr, cl = wc * 32 + 8 * fq, col0 = u.ocol + cl;
        const float* bg = b1 + (size_t)u.e * 2048 + col0; const float* bu = bg + 1024;
        const f32x4 bg0 = *(const f32x4*)bg, bg1 = *(const f32x4*)(bg + 4), bu0 = *(const f32x4*)bu, bu1 = *(const f32x4*)(bu + 4);
#pragma unroll
        for (int ai = 0; ai < 2; ++ai)
#pragma unroll
            for (int m = 0; m < 4; ++m) {
                f32x4 gv[2] = {acc[ai][0][m][0] + bg0, acc[ai][0][m][1] + bg1}, uv[2] = {acc[ai][1][m][0] + bu0, acc[ai][1][m][1] + bu1}; float o[8];
#pragma unroll
                for (int n = 0; n < 2; ++n)
#pragma unroll
                    for (int i = 0; i < 4; ++i) { const float gg = fminf(gv[n][i], 7.f), uu = fminf(fmaxf(uv[n][i], -7.f), 7.f);
                        const float sg = __builtin_amdgcn_rcpf(1.f + __builtin_amdgcn_exp2f(-1.702f * 1.4426950408889634f * gg)); o[4 * n + i] = (uu + 1.f) * gg * sg; }
                u32x4 w; w.x = cvt_pk_bf16(o[0], o[1]); w.y = cvt_pk_bf16(o[2], o[3]); w.z = cvt_pk_bf16(o[4], o[5]); w.w = cvt_pk_bf16(o[6], o[7]);
                *(u32x4*)(O + (size_t)(row0 + ai * HALF + m * 16) * ldc + col0) = w; asm volatile("" ::: "memory"); }
    }
};
struct EpiMoe2 {
    static constexpr bool PERM = true, AFTER_DRAIN = false;
    bf16_t* O; int ldc; const float* b2; const float* gate;
    __device__ __forceinline__ void operator()(const f32x4 (&acc)[2][2][4][2], const Unit& u, int wr, int wc, int fr, int fq) const {
        const int row0 = u.orow + wr * 64 + fr, col0 = u.ocol + wc * 32 + 8 * fq;
        const float* bp = b2 + (size_t)u.e * 1024 + col0;
#pragma unroll
        for (int bj = 0; bj < 2; ++bj) {
            const f32x4 bv0 = *(const f32x4*)(bp + bj * HALF), bv1 = *(const f32x4*)(bp + bj * HALF + 4);
#pragma unroll
            for (int ai = 0; ai < 2; ++ai)
#pragma unroll
                for (int m = 0; m < 4; ++m) { const int row = row0 + ai * HALF + m * 16; const float gt = gate[row];
                    const f32x4 v0 = (acc[ai][bj][m][0] + bv0) * gt, v1 = (acc[ai][bj][m][1] + bv1) * gt;
                    u32x4 w; w.x = cvt_pk_bf16(v0[0], v0[1]); w.y = cvt_pk_bf16(v0[2], v0[3]); w.z = cvt_pk_bf16(v1[0], v1[1]); w.w = cvt_pk_bf16(v1[2], v1[3]);
                    *(u32x4*)(O + (size_t)row * ldc + col0 + bj * HALF) = w; asm volatile("" ::: "memory"); }
        }
    }
};

struct MoeFusedOrder {
    static constexpr bool GATHER = true;
    const int* rowmap; const int* blk_e; const char* X; const char* ACT; const char* W1; const char* W2; unsigned* ready; unsigned* tmo; int nblk, NG, G, c, total, mode;
    __device__ void init(const void* X_, const void* ACT_, const void* W1_, const void* W2_, const int* rowmap_, const int* blk_e_, unsigned* ready_, unsigned* tmo_, int nblk_, int G_, int c_) {
        X = (const char*)X_; ACT = (const char*)ACT_; W1 = (const char*)W1_; W2 = (const char*)W2_; rowmap = rowmap_; blk_e = blk_e_; ready = ready_; tmo = tmo_; nblk = nblk_; NG = (nblk_ + 31) >> 5; G = G_; c = c_; total = nblk_ * 12; }
    __device__ bool next(int i, Unit& u) const {
        int Lq = i * G + c; if (Lq >= total) return false;
#if defined(FUSE_SPLIT)
        if (c >= 0) { const int kind = mode - 1; if (Lq >= nblk * (kind ? 4 : 8)) return false; const int q = Lq; const int pm = q % nblk, pn = q / nblk, e = __builtin_amdgcn_readfirstlane(blk_e[pm]);
          u.kind = kind; u.e = e; u.orow = pm * BM;
          if (kind == 0) { u.pa = X; u.pb = W1 + ((size_t)e * 2048 + (size_t)pn * 256) * 2048; u.ocol = pn * 128; }
          else { u.pa = ACT; u.pb = W2 + ((size_t)e * 1024 + (size_t)pn * 256) * 2048; u.ocol = pn * 256; }
          return true; }
#endif
#if defined(FUSE_SERIAL)
        { const int n1 = nblk * 8; int kind = Lq < n1 ? 0 : 1; int q = kind ? Lq - n1 : Lq; const int pm = q % nblk, pn = q / nblk, e = __builtin_amdgcn_readfirstlane(blk_e[pm]);
          u.kind = kind; u.e = e; u.orow = pm * BM;
          if (kind == 0) { u.pa = X; u.pb = W1 + ((size_t)e * 2048 + (size_t)pn * 256) * 2048; u.ocol = pn * 128; }
          else { u.pa = ACT; u.pb = W2 + ((size_t)e * 1024 + (size_t)pn * 256) * 2048; u.ocol = pn * 256; }
          return true; }
#endif
        int kind = 0, g = 0;
        for (int sgm = 0; ; ++sgm) {
            if (sgm < 3) { kind = 0; g = sgm; }
            else if (sgm < 3 + 2 * (NG - 3)) { const int j = (sgm - 3) >> 1; if (((sgm - 3) & 1) == 0) { kind = 0; g = j + 3; } else { kind = 1; g = j; } }
            else { kind = 1; g = NG - 3 + (sgm - (3 + 2 * (NG - 3))); }
            const int mg = min(32, nblk - 32 * g), sz = mg * (kind ? 4 : 8);
            if (Lq < sz) { const int pm = 32 * g + Lq % mg, pn = Lq / mg, e = __builtin_amdgcn_readfirstlane(blk_e[pm]);
                u.kind = kind; u.e = e; u.orow = pm * BM;
                if (kind == 0) { u.pa = X; u.pb = W1 + ((size_t)e * 2048 + (size_t)pn * 256) * 2048; u.ocol = pn * 128; }
                else { u.pa = ACT; u.pb = W2 + ((size_t)e * 1024 + (size_t)pn * 256) * 2048; u.ocol = pn * 256; }
                return true; }
            Lq -= sz;
        }
    }
    __device__ __forceinline__ int rowof(const Unit& u, int r) const { return u.kind == 0 ? rowmap[r] : r; }
    __device__ __forceinline__ void a_ready(const Unit& u) const {
        if (u.kind == 0) return;
#if defined(FUSE_SPLIT)
        return;
#endif
        if (threadIdx.x < 64) {
#if defined(FUSE_GLOBAL_WAIT)
            const unsigned long long t0 = __builtin_amdgcn_s_memrealtime(); unsigned polls = 0; unsigned* rp = ready + 64 * 500; const unsigned want = (unsigned)nblk * 64u;
#else
            const unsigned long long t0 = __builtin_amdgcn_s_memrealtime(); unsigned polls = 0; unsigned* rp = ready + 64 * (u.orow >> 8); const unsigned want = 64u;
#endif
            while ((unsigned)__builtin_amdgcn_readfirstlane(__hip_atomic_load(rp, __ATOMIC_RELAXED, __HIP_MEMORY_SCOPE_AGENT)) < want) {
                if ((++polls & 255u) == 0u && __builtin_amdgcn_readfirstlane(__hip_atomic_load(tmo, __ATOMIC_RELAXED, __HIP_MEMORY_SCOPE_AGENT)) != 0u) break;
                if (__builtin_amdgcn_s_memrealtime() - t0 > 2000000ull) { if (threadIdx.x == 0) __hip_atomic_store(tmo, 1u, __ATOMIC_RELAXED, __HIP_MEMORY_SCOPE_AGENT); break; }
                __builtin_amdgcn_s_sleep(2); }
#if defined(FUSE_CONSUMER_WB)
            __builtin_amdgcn_fence(__ATOMIC_RELEASE, "agent"); asm volatile("s_waitcnt vmcnt(0)" ::: "memory");
#endif
#if defined(FUSE_DELAY)
            { const unsigned long long t1 = __builtin_amdgcn_s_memrealtime(); while (__builtin_amdgcn_s_memrealtime() - t1 < 2000ull) __builtin_amdgcn_s_sleep(8); }
#endif
            __builtin_amdgcn_fence(__ATOMIC_ACQUIRE, "agent");
            asm volatile("s_waitcnt vmcnt(0)" ::: "memory");
        }
        asm volatile("" ::: "memory"); __builtin_amdgcn_s_barrier(); asm volatile("" ::: "memory");
    }
    __device__ __forceinline__ void done(const Unit& u) const {
        if (u.kind != 0) return;
        asm volatile("s_waitcnt vmcnt(0)" ::: "memory");
#if defined(FUSE_HEAVY_RELEASE)
        __builtin_amdgcn_fence(__ATOMIC_RELEASE, "agent"); asm volatile("s_waitcnt vmcnt(0)" ::: "memory");
#endif
#if defined(FUSE_GLOBAL_WAIT)
        if ((threadIdx.x & 63) == 0) __hip_atomic_fetch_add(ready + 64 * 500, 1u, __ATOMIC_RELAXED, __HIP_MEMORY_SCOPE_AGENT);
#else
        if ((threadIdx.x & 63) == 0) __hip_atomic_fetch_add(ready + 64 * (u.orow >> 8), 1u, __ATOMIC_RELAXED, __HIP_MEMORY_SCOPE_AGENT);
#endif
    }
};
__device__ __forceinline__ void store16_sc1(void* p, u32x4 v) { asm volatile("global_store_dwordx4 %0, %1, off sc1\n\ts_nop 1" :: "v"(p), "v"(v) : "memory"); }
struct EpiMoeFused {
    static constexpr bool PERM = true, AFTER_DRAIN = false;
    bf16_t* ACTo; const float* b1; bf16_t* Yo; const float* b2; const float* gate;
    __device__ __forceinline__ void operator()(const f32x4 (&acc)[2][2][4][2], const Unit& u, int wr, int wc, int fr, int fq) const {
        if (u.kind == 0) {
            const int row0 = u.orow + wr * 64 + fr, cl = wc * 32 + 8 * fq, col0 = u.ocol + cl;
            const float* bg = b1 + (size_t)u.e * 2048 + col0; const float* bu = bg + 1024;
            const f32x4 bg0 = *(const f32x4*)bg, bg1 = *(const f32x4*)(bg + 4), bu0 = *(const f32x4*)bu, bu1 = *(const f32x4*)(bu + 4);
#pragma unroll
            for (int ai = 0; ai < 2; ++ai)
#pragma unroll
                for (int m = 0; m < 4; ++m) {
                    f32x4 gv[2] = {acc[ai][0][m][0] + bg0, acc[ai][0][m][1] + bg1}, uv[2] = {acc[ai][1][m][0] + bu0, acc[ai][1][m][1] + bu1}; float o[8];
#pragma unroll
                    for (int n = 0; n < 2; ++n)
#pragma unroll
                        for (int i = 0; i < 4; ++i) { const float gg = fminf(gv[n][i], 7.f), uu = fminf(fmaxf(uv[n][i], -7.f), 7.f);
                            const float sg = __builtin_amdgcn_rcpf(1.f + __builtin_amdgcn_exp2f(-1.702f * 1.4426950408889634f * gg)); o[4 * n + i] = (uu + 1.f) * gg * sg; }
                    u32x4 w; w.x = cvt_pk_bf16(o[0], o[1]); w.y = cvt_pk_bf16(o[2], o[3]); w.z = cvt_pk_bf16(o[4], o[5]); w.w = cvt_pk_bf16(o[6], o[7]);
#if defined(FUSE_PLAIN_STORE)
                    *(u32x4*)(ACTo + (size_t)(row0 + ai * HALF + m * 16) * 1024 + col0) = w; }
#else
                    store16_sc1(ACTo + (size_t)(row0 + ai * HALF + m * 16) * 1024 + col0, w); }
#endif
        } else {
            const int row0 = u.orow + wr * 64 + fr, col0 = u.ocol + wc * 32 + 8 * fq;
            const float* bp = b2 + (size_t)u.e * 1024 + col0;
#pragma unroll
            for (int bj = 0; bj < 2; ++bj) {
                const f32x4 bv0 = *(const f32x4*)(bp + bj * HALF), bv1 = *(const f32x4*)(bp + bj * HALF + 4);
#pragma unroll
                for (int ai = 0; ai < 2; ++ai)
#pragma unroll
                    for (int m = 0; m < 4; ++m) { const int row = row0 + ai * HALF + m * 16; const float gt = gate[row];
                        const f32x4 v0 = (acc[ai][bj][m][0] + bv0) * gt, v1 = (acc[ai][bj][m][1] + bv1) * gt;
                        u32x4 w; w.x = cvt_pk_bf16(v0[0], v0[1]); w.y = cvt_pk_bf16(v0[2], v0[3]); w.z = cvt_pk_bf16(v1[0], v1[1]); w.w = cvt_pk_bf16(v1[2], v1[3]);
                        *(u32x4*)(Yo + (size_t)row * 1024 + col0 + bj * HALF) = w; asm volatile("" ::: "memory"); }
            }
        }
    }
};
}
typedef short v4i16_t __attribute__((ext_vector_type(4)));
__device__ __forceinline__ unsigned f2key_u(float f) { f = f + 0.0f; const unsigned u = __float_as_uint(f); return (u & 0x80000000u) ? ~u : (u | 0x80000000u); }

__device__ __forceinline__ void ph_cnorm_b(const bf16_t* pa, const float* g, bf16_t* cnb) {
  const int tid = TIDX(), lane = tid & 63, gw = BIDX() * 8 + (tid >> 6), NGW = (int)gridDim.x * 8;
  const f32x4 g4 = *(const f32x4*)(g + lane * 4);
  for (int row = gw; row < NT; row += NGW) {
    const v2u v = *(const v2u*)(pa + (size_t)row * 2048 + 1024 + lane * 4);
    const f32x4 f = (f32x4){bf_lo(v[0]), bf_hi(v[0]), bf_lo(v[1]), bf_hi(v[1])};
    const float r = rsqrtf(wave_sum((f[0] * f[0] + f[1] * f[1]) + (f[2] * f[2] + f[3] * f[3])) * (1.f / 256.f) + 1e-6f);
    const f32x4 o = f * r * g4;
    *(v2u*)(cnb + (size_t)row * 256 + lane * 4) = (v2u){cvt_pk_bf16(o[0], o[1]), cvt_pk_bf16(o[2], o[3])};
  }
}

__device__ __forceinline__ int moe_layer_tile(int layer, int j) { return j < 8192 ? layer * 8192 + j : 16384 + layer * 4096 + (j - 8192); }
__device__ __forceinline__ void moe_weight_tile(int T, const float* w1, const float* w2, bf16_t* W1_t, bf16_t* W2_t, int lane) {
  if (T < 16384) { const int le = T >> 8; transpose_tile(mk_tjob(w1 + (size_t)le * D * 2048, 2048, D, 2048, W1_t + (size_t)le * 2048 * D, D, 0, 0, 1), T & 255, lane); }
  else if (T < 24576) { const int t2 = T - 16384, le = t2 >> 7; transpose_tile(mk_tjob(w2 + (size_t)le * D * D, D, D, D, W2_t + (size_t)le * D * D, D, 0, 0, 0), t2 & 127, lane); }
}
typedef _Float16 h16x2_t __attribute__((ext_vector_type(2)));
typedef int i32x4_t __attribute__((ext_vector_type(4)));
__device__ __forceinline__ unsigned cvt_pk_f16(float lo, float hi) { const f32x2_t v = {lo, hi}; const h16x2_t h = __builtin_convertvector(v, h16x2_t); return __builtin_bit_cast(unsigned, h); }
__device__ __forceinline__ void ph_iscore(const bf16_t* pa, unsigned short* sc, const float* w1, const float* w2, bf16_t* W1_t, bf16_t* W2_t) {
  const int tid = TIDX(), lane = tid & 63, gw = BIDX() * 8 + (tid >> 6), NGW = (int)gridDim.x * 8;
  const int n16 = lane & 15, g = lane >> 4;
  int wt = gw;
#pragma unroll 1
  for (int u = gw; u < 2 * 4352; u += NGW) {
    const int b = u / 4352, v = u % 4352;
    int a = 0; while (a < 15 && 16 * (a + 1) * (a + 2) <= v) ++a;
    const int rem = v - 16 * a * (a + 1), r = rem / (a + 1), ch = rem % (a + 1);
    const int qg = 32 * a + r, ntile = (ch < a) ? 32 : (r + 1), t0 = qg * 16, kt0 = ch * 32;
    const bf16_t* qrow = pa + (size_t)(b * L + t0 + n16) * 2048;
    bf16x8 qf[8][2]; float w[8];
#pragma unroll
    for (int h = 0; h < 8; ++h) { qf[h][0] = *(const bf16x8*)(qrow + 1280 + h * 64 + 8 * g); qf[h][1] = *(const bf16x8*)(qrow + 1280 + h * 64 + 32 + 8 * g); w[h] = bf2f(qrow[1856 + h]) * (0.35355339059327373f * 0.125f); }
    const bf16_t* kbase = pa + (size_t)(b * L + n16) * 2048 + 1792 + 8 * g;
    unsigned short* srow = sc + (size_t)(b * L + t0 + n16) * L + 4 * g;
    bf16x8 kr[8][2];
    const int ktl = kt0 + ntile - 1;
#pragma unroll
    for (int p = 0; p < 8; ++p) { const int kk = min(kt0 + p, ktl); kr[p][0] = *(const bf16x8*)(kbase + (size_t)kk * 16 * 2048); kr[p][1] = *(const bf16x8*)(kbase + (size_t)kk * 16 * 2048 + 32); }
#pragma unroll 1
    for (int kt8 = kt0; kt8 < kt0 + ntile; kt8 += 8) {
#pragma unroll
      for (int p = 0; p < 8; ++p) {
        const int kt = kt8 + p;
        const bf16x8 k0 = kr[p][0], k1 = kr[p][1];
        { const int kk = min(kt + 8, ktl); kr[p][0] = *(const bf16x8*)(kbase + (size_t)kk * 16 * 2048); kr[p][1] = *(const bf16x8*)(kbase + (size_t)kk * 16 * 2048 + 32); }
        f32x4 score = (f32x4){0.f, 0.f, 0.f, 0.f};
#pragma unroll
        for (int h = 0; h < 8; ++h) {
          f32x4 acc = __builtin_amdgcn_mfma_f32_16x16x32_bf16(k0, qf[h][0], (f32x4){0.f, 0.f, 0.f, 0.f}, 0, 0, 0);
          acc = __builtin_amdgcn_mfma_f32_16x16x32_bf16(k1, qf[h][1], acc, 0, 0, 0);
          const f32x4 relu = __builtin_bit_cast(f32x4, __builtin_elementwise_max(__builtin_bit_cast(i32x4_t, acc), (i32x4_t){0, 0, 0, 0}));
#pragma unroll
          for (int i = 0; i < 4; ++i) score[i] = fmaf(relu[i], w[h], score[i]);
        }
        if (kt <= ktl) *(v2u*)(srow + kt * 16) = (v2u){cvt_pk_f16(score[0], score[1]), cvt_pk_f16(score[2], score[3])};
      }
    }
  }
  (void)wt; (void)w1; (void)w2; (void)W1_t; (void)W2_t;
}

constexpr int DW_STRIDE = 17152;
__device__ __forceinline__ unsigned offb(unsigned row, unsigned ch) { return 256u * row + 16u * (ch ^ (((row & 3u) << 2) | ((row >> 2) & 3u))); }
__device__ __forceinline__ void glds16(const void* gsrc, unsigned lds_dst) { unsigned keep;
  asm volatile("s_mov_b32 %0, m0\n\ts_mov_b32 m0, %2\n\ts_nop 0\n\tglobal_load_lds_dwordx4 %1, off\n\ts_mov_b32 m0, %0" : "=&s"(keep) : "v"(gsrc), "s"(lds_dst) : "memory"); }
__device__ __forceinline__ int wave_excl_scan(int v, int lane, int& total) {
  int x = v;
#pragma unroll
  for (int o = 1; o < 64; o <<= 1) { const int y = __shfl_up(x, o); if (lane >= o) x += y; }
  total = __shfl(x, 63); return x - v;
}
#define LDSW() asm volatile("s_waitcnt lgkmcnt(0)" ::: "memory")
__device__ __forceinline__ int wave_incl_scan_dpp(int v, int lane, int& total) {
  int x = v;
  x += __builtin_amdgcn_update_dpp(0, x, 0x111, 0xf, 0xf, true);
  x += __builtin_amdgcn_update_dpp(0, x, 0x112, 0xf, 0xf, true);
  x += __builtin_amdgcn_update_dpp(0, x, 0x114, 0xf, 0xf, true);
  x += __builtin_amdgcn_update_dpp(0, x, 0x118, 0xf, 0xf, true);
  const int t0 = __builtin_amdgcn_readlane(x, 15), t1 = __builtin_amdgcn_readlane(x, 31), t2 = __builtin_amdgcn_readlane(x, 47), t3 = __builtin_amdgcn_readlane(x, 63);
  const int row = lane >> 4;
  x += (row >= 1 ? t0 : 0) + (row >= 2 ? t1 : 0) + (row >= 3 ? t2 : 0);
  total = t0 + t1 + t2 + t3; return x;
}

__device__ __forceinline__ unsigned h2key(unsigned h) { return (h & 0x8000u) ? (~h & 0xFFFFu) : (h | 0x8000u); }
__device__ __forceinline__ int wave_select(const unsigned short* srow, int t, LAS unsigned char* wl, LAS unsigned short* idx16, int lane) {
  const int n = t + 1;
  if (n <= 256) { for (int i = lane; i < 256; i += 64) idx16[i] = (unsigned short)(i < n ? i : 0); LDSW(); return n; }
  LAS unsigned* hist = (LAS unsigned*)wl;
  for (int i = lane; i < 1024; i += 64) ((LAS v4u*)hist)[i] = (v4u){0u, 0u, 0u, 0u};
  unsigned bk[16][4];
#if defined(SEL_REP_LOAD)
#pragma unroll 1
  for (int rep_ = 0; rep_ < 2; ++rep_)
#endif
#pragma unroll
  for (int i = 0; i < 16; ++i) {
    bk[i][0] = 0u; bk[i][1] = 0u; bk[i][2] = 0u; bk[i][3] = 0u;
    if (i * 512 < n) { const int e0 = (i * 64 + lane) * 8;
      if (e0 < n) { const v4u f = *(const v4u*)(srow + e0);
#pragma unroll
        for (int c = 0; c < 4; ++c) { unsigned lo = f[c] & 0xFFFFu, hi = f[c] >> 16; lo = lo + 0u;
          const unsigned b0 = (e0 + 2 * c <= t) ? (h2key(lo == 0x8000u ? 0u : lo) >> 4) : 0u, b1 = (e0 + 2 * c + 1 <= t) ? (h2key(hi == 0x8000u ? 0u : hi) >> 4) : 0u;
          bk[i][c] = b0 | (b1 << 16); } } }
    if ((i & 7) == 7) asm volatile("" ::: "memory");
  }
#define BIN_OF(i, c) ((bk[i][(c) >> 1] >> (((c) & 1) * 16)) & 0xFFFFu)
  LDSW();
#if defined(SEL_REP_HIST)
#pragma unroll 1
  for (int rep_ = 0; rep_ < 2; ++rep_) {
  for (int i = lane; i < 1024; i += 64) ((LAS v4u*)hist)[i] = (v4u){0u, 0u, 0u, 0u};
  LDSW();
#endif
#pragma unroll
  for (int i = 0; i < 16; ++i) if (i * 512 < n) {
#pragma unroll
    for (int c = 0; c < 8; ++c) { const unsigned bin = BIN_OF(i, c); __hip_atomic_fetch_add(hist + bin, 1u, __ATOMIC_RELAXED, __HIP_MEMORY_SCOPE_WORKGROUP); }
    asm volatile("" ::: "memory"); }
  LDSW();
#if defined(SEL_REP_HIST)
  }
#endif
  const int bbase = 4096 - 64 * (lane + 1); int ssum = 0;
#pragma unroll 16
  for (int k = 0; k < 64; ++k) ssum += (int)hist[bbase + ((k + lane) & 63)];
  int tot; const int pre = wave_incl_scan_dpp(ssum, lane, tot) - ssum;
  const unsigned long long bal = __ballot(pre < 256 && pre + ssum >= 256);
  const int Ls = (int)__builtin_ctzll(bal);
  const int cum0 = __builtin_amdgcn_readlane(pre, Ls), sb = 4096 - 64 * (Ls + 1);
  const int ck = (int)hist[sb + 63 - lane]; int t2_; const int inc = wave_incl_scan_dpp(ck, lane, t2_);
  const unsigned long long bal2 = __ballot(cum0 + inc >= 256);
  const int kk = (int)__builtin_ctzll(bal2);
  const int B1 = sb + 63 - kk, cnt_gt = cum0 + __builtin_amdgcn_readlane(inc, kk) - __builtin_amdgcn_readlane(ck, kk), need1 = 256 - cnt_gt;
  LDSW();
  const unsigned kg = (0x7FFFu - (unsigned)B1) * 0x00010001u, kge = kg + 0x00010001u;
  int ngt = 0, neq = 0;
#pragma unroll
  for (int i = 0; i < 16; ++i) if (i * 512 < n) {
#pragma unroll
    for (int c2 = 0; c2 < 4; ++c2) { const unsigned x = bk[i][c2], fg = (x + kg) & 0x80008000u, fe = ((x + kge) & 0x80008000u) & ~fg; ngt += __builtin_popcount(fg); neq += __builtin_popcount(fe); } }
  int tg, te; int pg = wave_incl_scan_dpp(ngt, lane, tg) - ngt; int pe = wave_incl_scan_dpp(neq, lane, te) - neq;
  LAS unsigned short* cand = (LAS unsigned short*)wl;
#pragma unroll
  for (int i = 0; i < 16; ++i) if (i * 512 < n) {
#pragma unroll
    for (int c2 = 0; c2 < 4; ++c2) { const unsigned x = bk[i][c2], fg = (x + kg) & 0x80008000u, fe = ((x + kge) & 0x80008000u) & ~fg; const int e = (i * 64 + lane) * 8 + 2 * c2;
      if (fg & 0x8000u) { idx16[pg] = (unsigned short)e; ++pg; }
      if (fg & 0x80000000u) { idx16[pg] = (unsigned short)(e + 1); ++pg; }
      if (fe & 0x8000u) { cand[pe] = (unsigned short)e; ++pe; }
      if (fe & 0x80000000u) { cand[pe] = (unsigned short)(e + 1); ++pe; } }
    asm volatile("" ::: "memory"); }
#undef BIN_OF
  LDSW();
  const int m = te;
  unsigned lo = 0u;
  if (m <= 64) {
    unsigned cpv = 0u; if (lane < m) { const unsigned ci = cand[lane]; unsigned hv = srow[ci]; hv = (hv == 0x8000u) ? 0u : hv; cpv = ((h2key(hv) & 15u) << 13) | (8191u - ci) | (1u << 20); }
    int rank = 0;
    for (int k = 0; k < m; ++k) { const unsigned ok = (unsigned)__builtin_amdgcn_readlane((int)cpv, k); rank += (ok > cpv) ? 1 : 0; }
    const bool sel = (lane < m) && (rank < need1);
    const unsigned long long bs = __ballot(sel);
    if (sel) idx16[cnt_gt + __builtin_popcountll(bs & ((1ull << lane) - 1ull))] = (unsigned short)(8191u - (cpv & 0x1FFFu));
  } else if (m <= 256) {
    unsigned cp[4];
#pragma unroll
    for (int j = 0; j < 4; ++j) { const int q = lane + 64 * j; cp[j] = 0u; if (q < m) { const unsigned ci = cand[q]; unsigned hv = srow[ci]; hv = (hv == 0x8000u) ? 0u : hv; cp[j] = ((h2key(hv) & 15u) << 13) | (8191u - ci) | (1u << 20); } }
    for (int bit = 16; bit >= 0; --bit) { const unsigned trial = lo | (1u << bit); int tc = 0;
#pragma unroll
      for (int j = 0; j < 4; ++j) tc += __builtin_popcountll(__ballot((cp[j] >> 20) && ((cp[j] & 0x1FFFFu) >= trial)));
      if (tc >= need1) lo = trial; }
    int pos = cnt_gt;
#pragma unroll
    for (int j = 0; j < 4; ++j) { const bool sel = (cp[j] >> 20) && ((cp[j] & 0x1FFFFu) >= lo); const unsigned long long bs = __ballot(sel);
      if (sel) idx16[pos + __builtin_popcountll(bs & ((1ull << lane) - 1ull))] = (unsigned short)(8191u - (cp[j] & 0x1FFFu)); pos += __builtin_popcountll(bs); }
  } else {
    for (int bit = 16; bit >= 0; --bit) { const unsigned trial = lo | (1u << bit); int c = 0;
      for (int q = lane; q < m; q += 64) { const unsigned ci = cand[q]; unsigned hv = srow[ci]; hv = (hv == 0x8000u) ? 0u : hv; const unsigned cpq = ((h2key(hv) & 15u) << 13) | (8191u - ci); c += (cpq >= trial) ? 1 : 0; }
      int tc; (void)wave_excl_scan(c, lane, tc); if (tc >= need1) lo = trial; }
    int base = cnt_gt;
    for (int q0 = 0; q0 < m; q0 += 64) { const int q = q0 + lane; bool sel = false; unsigned ci = 0;
      if (q < m) { ci = cand[q]; unsigned hv = srow[ci]; hv = (hv == 0x8000u) ? 0u : hv; const unsigned cpq = ((h2key(hv) & 15u) << 13) | (8191u - ci); sel = cpq >= lo; }
      int tc; const int pos = base + wave_excl_scan(sel ? 1 : 0, lane, tc); if (sel) idx16[pos] = (unsigned short)ci; base += tc; }
  }
  LDSW();
  return 256;
}

__device__ __forceinline__ void wave_attend(int b, int t, int cnt, const bf16_t* qlat, const bf16_t* cnb, LAS unsigned char* wl, LAS unsigned short* idx16, bf16_t* olat, int lane) {
  const int n16 = lane & 15, g = lane >> 4, q4 = (lane & 15) >> 2, p4 = lane & 3;
  const bf16_t* qrow = qlat + (size_t)(b * L + t) * 4096 + n16 * 256 + 8 * g;
  bf16x8 qf[8];
#pragma unroll
  for (int s = 0; s < 8; ++s) qf[s] = *(const bf16x8*)(qrow + 32 * s);
  f32x4 o[16];
#pragma unroll
  for (int c = 0; c < 16; ++c) o[c] = (f32x4){0.f, 0.f, 0.f, 0.f};
  float mrun = -INFINITY, lrun = 0.f;
  const int ntile = (cnt + 31) >> 5;
  const char* cb = (const char*)(cnb + (size_t)b * L * 256);
  const unsigned slot = lane & 15, rsub = lane >> 4;
  constexpr float SC = 0.125f * 1.4426950408889634f;
  v4u stg[16];
#define GATHER_TILE(itn) do { _Pragma("unroll") for (int rg = 0; rg < 8; ++rg) { const unsigned row = 4 * rg + rsub; const unsigned key = idx16[32 * (itn) + row]; \
      const unsigned ch = slot ^ (((row & 3u) << 2) | ((row >> 2) & 3u)); const char* src = cb + (size_t)key * 512 + ch * 16; \
      stg[rg] = *(const v4u*)src; stg[8 + rg] = *(const v4u*)(src + 256); } } while (0)
  GATHER_TILE(0);
#pragma unroll 1
  for (int it = 0; it < ntile; ++it) {
#pragma unroll
    for (int rg = 0; rg < 8; ++rg) { *(LAS v4u*)(wl + rg * 1024 + lane * 16) = stg[rg]; *(LAS v4u*)(wl + 8192 + rg * 1024 + lane * 16) = stg[8 + rg]; }
    LDSW();
    if (it + 1 < ntile) GATHER_TILE(it + 1);
    f32x4 s0 = (f32x4){0.f, 0.f, 0.f, 0.f}, s1 = (f32x4){0.f, 0.f, 0.f, 0.f};
#pragma unroll
    for (int s = 0; s < 8; ++s) { const unsigned ib = (s >> 2) * 8192, chq = 4 * (s & 3) + g;
      const bf16x8 a0 = *(const LAS bf16x8*)(wl + ib + offb(n16, chq)), a1 = *(const LAS bf16x8*)(wl + ib + offb(16 + n16, chq));
      s0 = __builtin_amdgcn_mfma_f32_16x16x32_bf16(a0, qf[s], s0, 0, 0, 0); s1 = __builtin_amdgcn_mfma_f32_16x16x32_bf16(a1, qf[s], s1, 0, 0, 0); }
    const int sl0 = 32 * it + 4 * g;
    float mx = -INFINITY;
#pragma unroll
    for (int r = 0; r < 4; ++r) { s0[r] = (sl0 + r < cnt) ? s0[r] * SC : -INFINITY; s1[r] = (sl0 + 16 + r < cnt) ? s1[r] * SC : -INFINITY; mx = fmaxf(mx, fmaxf(s0[r], s1[r])); }
    mx = fmaxf(mx, __shfl_xor(mx, 16)); mx = fmaxf(mx, __shfl_xor(mx, 32));
    const float mnew = fmaxf(mrun, mx), alpha = __builtin_amdgcn_exp2f(mrun - mnew);
    float ls = 0.f; float pv[8];
#pragma unroll
    for (int r = 0; r < 4; ++r) { pv[r] = __builtin_amdgcn_exp2f(s0[r] - mnew); pv[4 + r] = __builtin_amdgcn_exp2f(s1[r] - mnew); ls += pv[r] + pv[4 + r]; }
    ls += __shfl_xor(ls, 16); ls += __shfl_xor(ls, 32);
    lrun = lrun * alpha + ls; mrun = mnew;
#pragma unroll
    for (int c = 0; c < 16; ++c) o[c] = o[c] * alpha;
    const v4u pbw = (v4u){cvt_pk_bf16(pv[0], pv[1]), cvt_pk_bf16(pv[2], pv[3]), cvt_pk_bf16(pv[4], pv[5]), cvt_pk_bf16(pv[6], pv[7])};
    const bf16x8 pb = __builtin_bit_cast(bf16x8, pbw);
#pragma unroll
    for (int c = 0; c < 16; ++c) { const unsigned ib = (c >> 3) * 8192, chc = 2 * (c & 7) + (p4 >> 1);
      const v4i16_t t0 = __builtin_amdgcn_ds_read_tr16_b64_v4i16((LAS v4i16_t*)(wl + ib + offb(4 * g + q4, chc) + 8 * (p4 & 1)));
      const v4i16_t t1 = __builtin_amdgcn_ds_read_tr16_b64_v4i16((LAS v4i16_t*)(wl + ib + offb(16 + 4 * g + q4, chc) + 8 * (p4 & 1)));
      const bf16x8 af = (bf16x8){t0[0], t0[1], t0[2], t0[3], t1[0], t1[1], t1[2], t1[3]};
      o[c] = __builtin_amdgcn_mfma_f32_16x16x32_bf16(af, pb, o[c], 0, 0, 0); }
    LDSW();
  }
  const float inv = 1.f / lrun;
  bf16_t* orow = olat + (size_t)(b * L + t) * 4096 + n16 * 256 + 4 * g;
#pragma unroll
  for (int c = 0; c < 16; ++c) { const f32x4 v = o[c] * inv; *(v2u*)(orow + 16 * c) = (v2u){cvt_pk_bf16(v[0], v[1]), cvt_pk_bf16(v[2], v[3])}; }
}

__device__ __forceinline__ void ph_select_attend(const unsigned short* sc, const bf16_t* qlat, const bf16_t* cnb, bf16_t* olat, LAS unsigned char* lds, const float* w1, const float* w2, bf16_t* W1_t, bf16_t* W2_t) {
  const int tid = TIDX(), lane = tid & 63, wave = __builtin_amdgcn_readfirstlane(tid >> 6), blk = BIDX();
  LAS unsigned char* wl = lds + wave * DW_STRIDE; LAS unsigned short* idx16 = (LAS unsigned short*)(wl + 16384);
  const int b = blk & 1, wb = (blk >> 1) * 8 + wave, nwb = ((int)gridDim.x >> 1) * 8;
  const int gw = blk * 8 + wave, NGW = (int)gridDim.x * 8; int wt = gw;
#pragma unroll 1
  for (int t = wb, qi = 0; t < L; t += nwb, ++qi) {
    int lane_s = lane; asm volatile("" : "+v"(lane_s));
    const int cnt = wave_select(sc + (size_t)(b * L + t) * L, t, wl, idx16, lane_s);
#if defined(DUPSEL)
    { int lane_s2 = lane; asm volatile("" : "+v"(lane_s2)); const int cnt2 = wave_select(sc + (size_t)(b * L + t) * L, t, wl, idx16, lane_s2); if (cnt2 != cnt) olat[0] = 0; }
#endif
    int lane_a = lane; asm volatile("" : "+v"(lane_a));
    wave_attend(b, t, cnt, qlat, cnb, wl, idx16, olat, lane_a);
#if defined(DUPATT)
    { int lane_a2 = lane; asm volatile("" : "+v"(lane_a2)); wave_attend(b, t, cnt, qlat, cnb, wl, idx16, olat, lane_a2); }
#endif
    const int ntl = (qi < 4) ? 2 : 1;
#pragma unroll 1
    for (int k = 0; k < ntl; ++k) { int lane_t = lane; asm volatile("" : "+v"(lane_t)); if (wt < 24576) moe_weight_tile(wt < 12288 ? moe_layer_tile(0, wt) : moe_layer_tile(1, wt - 12288), w1, w2, W1_t, W2_t, lane_t); wt += NGW; }
  }
#pragma unroll 1
  for (; wt < 24576; wt += NGW) { int lane_t = lane; asm volatile("" : "+v"(lane_t)); moe_weight_tile(wt < 12288 ? moe_layer_tile(0, wt) : moe_layer_tile(1, wt - 12288), w1, w2, W1_t, W2_t, lane_t); }
}

__device__ __forceinline__ void ph_qlat(const bf16_t* pa, const bf16_t* WqT, bf16_t* qlat) {
  const int tid = TIDX(), lane = tid & 63, gw = BIDX() * 8 + (tid >> 6), NGW = (int)gridDim.x * 8;
  const int n16 = lane & 15, g = lane >> 4;
#pragma unroll 1
  for (int it = gw; it < 16 * 512; it += NGW) {
    const int h = it & 15, rt = it >> 4;
    bf16x8 qb[2][2];
#pragma unroll
    for (int mt = 0; mt < 2; ++mt)
#pragma unroll
      for (int ks = 0; ks < 2; ++ks) qb[mt][ks] = *(const bf16x8*)(pa + (size_t)(rt * 32 + mt * 16 + n16) * 2048 + h * 64 + 32 * ks + 8 * g);
    const bf16_t* wp = WqT + (size_t)h * 256 * 64 + (size_t)n16 * 64 + 8 * g;
    bf16_t* op = qlat + (size_t)(rt * 32 + n16) * 4096 + h * 256 + 4 * g;
#pragma unroll 4
    for (int ct = 0; ct < 16; ++ct) {
      const bf16x8 a0 = *(const bf16x8*)(wp + (size_t)(16 * ct) * 64), a1 = *(const bf16x8*)(wp + (size_t)(16 * ct) * 64 + 32);
#pragma unroll
      for (int mt = 0; mt < 2; ++mt) { f32x4 acc = __builtin_amdgcn_mfma_f32_16x16x32_bf16(a0, qb[mt][0], (f32x4){0.f, 0.f, 0.f, 0.f}, 0, 0, 0);
        acc = __builtin_amdgcn_mfma_f32_16x16x32_bf16(a1, qb[mt][1], acc, 0, 0, 0);
        *(v2u*)(op + (size_t)(mt * 16) * 4096 + 16 * ct) = (v2u){cvt_pk_bf16(acc[0], acc[1]), cvt_pk_bf16(acc[2], acc[3])}; }
    }
  }
}
__device__ __forceinline__ void ph_o2(const bf16_t* olat, const bf16_t* WuvT, bf16_t* o2b) {
  const int tid = TIDX(), lane = tid & 63, gw = BIDX() * 8 + (tid >> 6), NGW = (int)gridDim.x * 8;
  const int n16 = lane & 15, g = lane >> 4;
#pragma unroll 1
  for (int it = gw; it < 16 * 512; it += NGW) {
    const int h = it & 15, rt = it >> 4;
    f32x4 acc[4][2];
#pragma unroll
    for (int vt = 0; vt < 4; ++vt) { acc[vt][0] = (f32x4){0.f, 0.f, 0.f, 0.f}; acc[vt][1] = (f32x4){0.f, 0.f, 0.f, 0.f}; }
    const bf16_t* ap = olat + (size_t)(rt * 32 + n16) * 4096 + h * 256 + 8 * g;
    const bf16_t* wp = WuvT + (size_t)h * 64 * 256 + (size_t)n16 * 256 + 8 * g;
#pragma unroll
    for (int ks = 0; ks < 8; ++ks) {
      const bf16x8 b0 = *(const bf16x8*)(ap + 32 * ks), b1 = *(const bf16x8*)(ap + (size_t)16 * 4096 + 32 * ks);
#pragma unroll
      for (int vt = 0; vt < 4; ++vt) { const bf16x8 a = *(const bf16x8*)(wp + (size_t)(16 * vt) * 256 + 32 * ks);
        acc[vt][0] = __builtin_amdgcn_mfma_f32_16x16x32_bf16(a, b0, acc[vt][0], 0, 0, 0); acc[vt][1] = __builtin_amdgcn_mfma_f32_16x16x32_bf16(a, b1, acc[vt][1], 0, 0, 0); }
    }
    bf16_t* op = o2b + (size_t)(rt * 32 + n16) * 1024 + h * 64 + 4 * g;
#pragma unroll
    for (int vt = 0; vt < 4; ++vt)
#pragma unroll
      for (int mt = 0; mt < 2; ++mt) *(v2u*)(op + (size_t)(mt * 16) * 1024 + 16 * vt) = (v2u){cvt_pk_bf16(acc[vt][mt][0], acc[vt][mt][1]), cvt_pk_bf16(acc[vt][mt][2], acc[vt][mt][3])};
  }
}

namespace pg8 {
struct GroupAOrder {
    static constexpr bool GATHER = false; const int* rowmap;
    StaticOrder so; int png; size_t acol_bytes;
    __device__ void init(const void* A, int lda, const void* Bt, int ldb, int M, int N, int png_, size_t acol_bytes_, int G, int c) { so.init(A, lda, Bt, ldb, M, N, G, c); png = png_; acol_bytes = acol_bytes_; }
    __device__ bool next(int i, Unit& u) const { int pm, pn; if (!so.tile(i, pm, pn)) return false; u.pa = so.A + (size_t)pm * so.ta + (size_t)(pn / png) * acol_bytes; u.pb = so.Bt + (size_t)pn * so.tb; u.orow = pm * BM; u.ocol = pn * BM; u.e = 0; u.kind = 0; return true; }
    __device__ __forceinline__ int rowof(const Unit&, int r) const { return r; }
    __device__ __forceinline__ void a_ready(const Unit&) const {}
    __device__ __forceinline__ void done(const Unit&) const {}
};
}
constexpr int GLA_LDSU = 65536;

__device__ __forceinline__ v4i16_t trrd(LAS unsigned char* p) { return __builtin_amdgcn_ds_read_tr16_b64_v4i16((LAS v4i16_t*)p); }
__device__ __forceinline__ bf16x8 cat44(v4i16_t a, v4i16_t b) { return (bf16x8){a[0], a[1], a[2], a[3], b[0], b[1], b[2], b[3]}; }

__device__ __forceinline__ void ph_gla_a1(const bf16_t* pb, const float* gbias, bf16_t* qt, bf16_t* og, bf16_t* kvt, float* dcy, LAS unsigned char* lds, const float* w1, const float* w2, bf16_t* W1_t, bf16_t* W2_t) {
  const int tid = TIDX(), lane = tid & 63, wave = __builtin_amdgcn_readfirstlane(tid >> 6), blk = BIDX();
  const int half = wave >> 2, wq = wave & 3;
  LAS unsigned char* X = lds + half * GLA_LDSU; LAS unsigned char* Y = X + 16384; LAS unsigned char* V = X + 32768;
  LAS float* EX = (LAS float*)(lds + 131072 + half * 2048);
  const unsigned v_addr = (unsigned)__builtin_amdgcn_readfirstlane((int)(unsigned)(size_t)V);
  const int n16 = lane & 15, g = lane >> 4, q4 = (lane & 15) >> 2, p4 = lane & 3;
#pragma unroll 1
  for (int uu = 0; uu < 2; ++uu) {
    const int u = blk * 4 + half * 2 + uu;
    const int h = u & 3, bc = u >> 2, r0 = bc * 64;
    { const unsigned slot = lane & 15, rsub = lane >> 4; const int im = wq;
#pragma unroll
      for (int rg = 0; rg < 8; ++rg) { const unsigned row = 4 * rg + rsub; const unsigned ch = slot ^ (((row & 3u) << 2) | ((row >> 2) & 3u));
        const char* src = (const char*)(pb + (size_t)(r0 + 32 * (im >> 1) + row) * 3584 + 1024 + h * 256 + (im & 1) * 128) + ch * 16;
        glds16(src, v_addr + im * 8192 + rg * 1024); } }
    const int d0 = 2 * lane; const float gb0 = gbias[h * 128 + d0], gb1 = gbias[h * 128 + d0 + 1];
    const unsigned wofs = 16u * ((unsigned)(d0 >> 3)), wsub = (unsigned)(d0 & 7) * 2u;
    unsigned gq[16], qq[16], kq[16]; float bl0[16], bl1[16];
#pragma unroll
    for (int jj = 0; jj < 16; ++jj) { const bf16_t* rp = pb + (size_t)(r0 + wq * 16 + jj) * 3584 + h * 128 + d0;
      gq[jj] = *(const unsigned*)(rp + 3072); qq[jj] = *(const unsigned*)rp; kq[jj] = *(const unsigned*)(rp + 512); }
    float bc0 = 0.f, bc1 = 0.f;
#pragma unroll
    for (int jj = 0; jj < 16; ++jj) { const float a0 = bf_lo(gq[jj]) + gb0, a1 = bf_hi(gq[jj]) + gb1;
      bc0 += (fminf(a0, 0.f) - __logf(1.f + __expf(-fabsf(a0)))) * (1.f / 16.f); bc1 += (fminf(a1, 0.f) - __logf(1.f + __expf(-fabsf(a1)))) * (1.f / 16.f);
      bl0[jj] = bc0; bl1[jj] = bc1; }
    *(LAS f32x2_t*)(EX + wq * 128 + d0) = (f32x2_t){bc0, bc1};
    LDSW(); __syncthreads();
    float of0 = 0.f, of1 = 0.f, tt0 = 0.f, tt1 = 0.f;
#pragma unroll
    for (int w2_ = 0; w2_ < 4; ++w2_) { const f32x2_t e = *(const LAS f32x2_t*)(EX + w2_ * 128 + d0); tt0 += e[0]; tt1 += e[1]; if (w2_ < wq) { of0 += e[0]; of1 += e[1]; } }
#pragma unroll
    for (int jj = 0; jj < 16; ++jj) { const int j = wq * 16 + jj; const float b0 = bl0[jj] + of0, b1 = bl1[jj] + of1;
      const float e0 = __expf(b0), e1 = __expf(b1), i0 = __expf(fminf(-b0, 80.f)), i1 = __expf(fminf(-b1, 80.f));
      const unsigned qo = cvt_pk_bf16(bf_lo(qq[jj]) * 0.08838834764831845f * e0, bf_hi(qq[jj]) * 0.08838834764831845f * e1);
      const unsigned ko = cvt_pk_bf16(bf_lo(kq[jj]) * i0, bf_hi(kq[jj]) * i1);
      *(unsigned*)(qt + (size_t)(r0 + j) * 512 + h * 128 + d0) = qo;
      const unsigned row = (unsigned)(j & 31); const unsigned off = (unsigned)(j >> 5) * 8192u + 256u * row + ((wofs ^ (16u * (((row & 3u) << 2) | ((row >> 2) & 3u))))) + wsub;
      *(LAS unsigned*)(X + off) = qo; *(LAS unsigned*)(Y + off) = ko; }
    if (wq == 3) *(float2*)(dcy + (size_t)u * 128 + d0) = make_float2(__expf(tt0), __expf(tt1));
    asm volatile("s_waitcnt vmcnt(0) lgkmcnt(0)" ::: "memory");
    __syncthreads();
    const int it = wq;
    bf16x8 afr[2];
#pragma unroll
    for (int ks = 0; ks < 2; ++ks) {
      unsigned pk[4] = {0u, 0u, 0u, 0u};
#pragma unroll
      for (int jh = 0; jh < 2; ++jh) { const int jt = 2 * ks + jh;
        if (jt <= it) { f32x4 acc = (f32x4){0.f, 0.f, 0.f, 0.f};
#pragma unroll
          for (int s = 0; s < 4; ++s) { const bf16x8 ya = *(const LAS bf16x8*)(Y + (jt >> 1) * 8192 + offb(n16 + 16 * (jt & 1), 4 * s + g)), xb = *(const LAS bf16x8*)(X + (it >> 1) * 8192 + offb(n16 + 16 * (it & 1), 4 * s + g));
            acc = __builtin_amdgcn_mfma_f32_16x16x32_bf16(ya, xb, acc, 0, 0, 0); }
          const int i_ = 16 * it + n16, jbase = 16 * jt + 4 * g;
#pragma unroll
          for (int r = 0; r < 4; ++r) if (jbase + r > i_) acc[r] = 0.f;
          pk[2 * jh] = cvt_pk_bf16(acc[0], acc[1]); pk[2 * jh + 1] = cvt_pk_bf16(acc[2], acc[3]); } }
      afr[ks] = __builtin_bit_cast(bf16x8, (v4u){pk[0], pk[1], pk[2], pk[3]});
    }
    bf16_t* ogp = og + (size_t)u * 16384 + (size_t)(it * 16) * 256 + lane * 4; bf16_t* kvp = kvt + (size_t)u * 32768 + (size_t)n16 * 128 + 4 * g;
#pragma unroll 2
    for (int nt = 0; nt < 16; ++nt) {
      const unsigned vimg = (unsigned)(nt >> 3) * 8192u, chv = 2u * (unsigned)(nt & 7) + (unsigned)(p4 >> 1), sub = 8u * (unsigned)(p4 & 1);
      f32x4 acc = (f32x4){0.f, 0.f, 0.f, 0.f};
      { LAS unsigned char* vb = V + vimg; const bf16x8 bi0 = cat44(trrd(vb + offb(4 * g + q4, chv) + sub), trrd(vb + offb(16 + 4 * g + q4, chv) + sub));
        acc = __builtin_amdgcn_mfma_f32_16x16x32_bf16(afr[0], bi0, acc, 0, 0, 0); }
      if (it >= 2) { LAS unsigned char* vb = V + 16384 + vimg; const bf16x8 bi1 = cat44(trrd(vb + offb(4 * g + q4, chv) + sub), trrd(vb + offb(16 + 4 * g + q4, chv) + sub));
        acc = __builtin_amdgcn_mfma_f32_16x16x32_bf16(afr[1], bi1, acc, 0, 0, 0); }
      *(v2u*)(ogp + (size_t)nt * 256) = (v2u){cvt_pk_bf16(acc[0], acc[1]), cvt_pk_bf16(acc[2], acc[3])};
    }
#pragma unroll 1
    for (int nq = 0; nq < 4; ++nq) { const int nt = 4 * wq + nq;
      const unsigned vimg = (unsigned)(nt >> 3) * 8192u, chv = 2u * (unsigned)(nt & 7) + (unsigned)(p4 >> 1), sub = 8u * (unsigned)(p4 & 1);
      bf16x8 bn[2];
#pragma unroll
      for (int ks = 0; ks < 2; ++ks) { LAS unsigned char* vb = V + ks * 16384 + vimg; bn[ks] = cat44(trrd(vb + offb(8 * g + q4, chv) + sub), trrd(vb + offb(8 * g + 4 + q4, chv) + sub)); }
#pragma unroll
      for (int mt = 0; mt < 8; ++mt) { const unsigned chy = 2u * (unsigned)mt + (unsigned)(p4 >> 1);
        const bf16x8 a0 = cat44(trrd(Y + offb(8 * g + q4, chy) + sub), trrd(Y + offb(8 * g + 4 + q4, chy) + sub));
        const bf16x8 a1 = cat44(trrd(Y + 8192 + offb(8 * g + q4, chy) + sub), trrd(Y + 8192 + offb(8 * g + 4 + q4, chy) + sub));
        f32x4 acc = __builtin_amdgcn_mfma_f32_16x16x32_bf16(a0, bn[0], (f32x4){0.f, 0.f, 0.f, 0.f}, 0, 0, 0);
        acc = __builtin_amdgcn_mfma_f32_16x16x32_bf16(a1, bn[1], acc, 0, 0, 0);
        *(v2u*)(kvp + (size_t)(16 * nt) * 128 + 16 * mt) = (v2u){cvt_pk_bf16(acc[0], acc[1]), cvt_pk_bf16(acc[2], acc[3])}; }
    }
    LDSW(); __syncthreads();
  }
}

__device__ __forceinline__ void ph_gla_a2(const bf16_t* kvt, const float* dcy, bf16_t* spt) {
  const int gtid = BIDX() * NTHR + TIDX();
  if (gtid >= 8 * 256 * 32) return;
  const int g4 = gtid & 31, dv = (gtid >> 5) & 255, bh = gtid >> 13, b = bh >> 2, h = bh & 3;
  f32x4 S = (f32x4){0.f, 0.f, 0.f, 0.f};
#pragma unroll 4
  for (int c = 0; c < 128; ++c) { const size_t u = (size_t)((b * 128 + c) * 4 + h);
    const v2u kvb = *(const v2u*)(kvt + u * 32768 + (size_t)dv * 128 + 4 * g4); const f32x4 kv = (f32x4){bf_lo(kvb[0]), bf_hi(kvb[0]), bf_lo(kvb[1]), bf_hi(kvb[1])}, dc = *(const f32x4*)(dcy + u * 128 + 4 * g4);
    *(v2u*)(spt + u * 32768 + (size_t)dv * 128 + 4 * g4) = (v2u){cvt_pk_bf16(S[0], S[1]), cvt_pk_bf16(S[2], S[3])};
    S = dc * (S + kv); }
}

constexpr int A3_LD = 272;
__device__ __forceinline__ void ph_gla_a3(const bf16_t* pb, const bf16_t* qt, const bf16_t* og, const bf16_t* spt, const float* ng, bf16_t* ob, LAS unsigned char* lds) {
  const int tid = TIDX(), lane = tid & 63, wave = __builtin_amdgcn_readfirstlane(tid >> 6), gw = BIDX() * 8 + wave, NGW = (int)gridDim.x * 8;
  const int n16 = lane & 15, g = lane >> 4, row16 = lane >> 2, cq = lane & 3;
  LAS float* T = (LAS float*)(lds + wave * (16 * A3_LD * 4));
#pragma unroll 1
  for (int w = gw; w < 4096; w += NGW) {
    const int u = w >> 2, it = w & 3, h = u & 3, r0 = (u >> 2) * 64;
    const bf16_t* sp = spt + (size_t)u * 32768 + (size_t)n16 * 128 + 8 * g;
    bf16x8 qa[4];
#pragma unroll
    for (int ks = 0; ks < 4; ++ks) qa[ks] = *(const bf16x8*)(qt + (size_t)(r0 + 16 * it + n16) * 512 + h * 128 + 32 * ks + 8 * g);
    const bf16_t* ogp = og + (size_t)u * 16384 + (size_t)(it * 16) * 256 + lane * 4;
#pragma unroll
    for (int nt = 0; nt < 16; ++nt) {
      const v2u ogb = *(const v2u*)(ogp + nt * 256); f32x4 acc = (f32x4){bf_lo(ogb[0]), bf_hi(ogb[0]), bf_lo(ogb[1]), bf_hi(ogb[1])};
#pragma unroll
      for (int ks = 0; ks < 4; ++ks) { const bf16x8 sb = *(const bf16x8*)(sp + (size_t)(16 * nt) * 128 + 32 * ks); acc = __builtin_amdgcn_mfma_f32_16x16x32_bf16(qa[ks], sb, acc, 0, 0, 0); }
#pragma unroll
      for (int r = 0; r < 4; ++r) T[(4 * g + r) * A3_LD + 16 * nt + n16] = acc[r];
    }
    LDSW();
    const size_t row = (size_t)(r0 + 16 * it + row16);
    f32x4 v[16]; float ss = 0.f;
#pragma unroll
    for (int k = 0; k < 16; ++k) { v[k] = *(const LAS f32x4*)(T + row16 * A3_LD + 16 * k + 4 * cq); ss += (v[k][0] * v[k][0] + v[k][1] * v[k][1]) + (v[k][2] * v[k][2] + v[k][3] * v[k][3]); }
    ss += __shfl_xor(ss, 1); ss += __shfl_xor(ss, 2);
    const float rs = rsqrtf(ss * (1.f / 256.f) + 1e-6f);
#pragma unroll
    for (int k = 0; k < 16; ++k) { const int col = h * 256 + 16 * k + 4 * cq; const v2u rg = *(const v2u*)(pb + row * 3584 + 2048 + col); const f32x4 gn = *(const f32x4*)(ng + col);
      const float rr[4] = {bf_lo(rg[0]), bf_hi(rg[0]), bf_lo(rg[1]), bf_hi(rg[1])}; float o[4];
#pragma unroll
      for (int z = 0; z < 4; ++z) o[z] = v[k][z] * rs * gn[z] * (rr[z] * __builtin_amdgcn_rcpf(1.f + __expf(-rr[z])));
      *(v2u*)(ob + row * 1024 + col) = (v2u){cvt_pk_bf16(o[0], o[1]), cvt_pk_bf16(o[2], o[3])}; }
    LDSW();
  }
}
#ifndef PROBE
#define PROBE 0
#endif
#ifndef PROBE_S
#define PROBE_S 10.0f
#endif
constexpr size_t MiB = 1u << 20;
constexpr size_t WS_CTL = 0, CTL_ZERO_BYTES = 1 * MiB;
constexpr int CW_BAR = 4096, CW_TMO = 64, CW_RDY = 65536;
constexpr size_t WS_NEEDED = 2048 * MiB;

struct Args { In in; float* out; unsigned char* ws; };

struct Opt { bf16_t *qt, *spt, *og, *kvt; float *dcy; bf16_t *Wql_t, *Wuv_t, *cnb, *qlat, *olat; unsigned short* sc; bf16_t *xb, *WA_t, *WoutA_t, *WB_t, *WoutB_t, *W1_t, *W2_t, *projA_b, *hbf, *o2b, *xs, *act, *Ys, *projB_b; MoeBufs m; };
__device__ __forceinline__ nvp::Ws carve_ws(unsigned char* ws) {
  nvp::Ws w; auto at = [&](size_t mib) { return (char*)ws + mib * MiB; };
  w.projA = (float*)at(2); w.cn = (float*)at(119); w.sc = (float*)at(135); w.idx = (int*)at(647); w.o2 = (float*)at(663);
  w.x1 = (float*)at(727); w.x2 = (float*)at(791);
  w.projB = (float*)at(135); w.adec = (float*)at(135 + 194); w.og = (float*)at(135 + 194 + 32); w.on = (float*)at(135 + 194 + 32 + 64);
  w.counts = nullptr; w.h = nullptr; w.hb = nullptr; w.ys = nullptr; w.tok_e = nullptr; w.tok_g = nullptr; w.slot_of = nullptr; w.row_tok = nullptr; w.row_gate = nullptr; w.blk_e = nullptr;
  return w;
}
__device__ __forceinline__ Opt carve_opt(unsigned char* ws) {
  Opt o; auto at = [&](size_t mib) { return (bf16_t*)((char*)ws + mib * MiB); };
  char* sm = (char*)ws + 855 * MiB;
  o.m.tok_e = (int*)sm; o.m.tok_g = (float*)(sm + 256 * 1024); o.m.slot_of = (int*)(sm + 512 * 1024); o.m.slot_gate = (float*)(sm + 768 * 1024); o.m.blk_e = (int*)(sm + 1088 * 1024); o.m.blkcnt = (int*)(sm + 1096 * 1024); o.m.nblk = (int*)(sm + 1160 * 1024); o.m.slot_tok = (int*)(sm + 1200 * 1024);
  o.WA_t = at(860); o.WoutA_t = at(864); o.WB_t = at(866); o.WoutB_t = at(873);
  o.Wql_t = at(875); o.Wuv_t = at(877); o.olat = at(2); o.cnb = at(647); o.qlat = at(1856); o.sc = (unsigned short*)at(135);
  o.qt = at(135); o.dcy = (float*)at(151); o.og = at(152); o.kvt = at(216); o.spt = at(344);
  o.W1_t = at(880); o.W2_t = at(1136);
  o.xb = at(1264); o.projA_b = at(1296); o.hbf = at(1360); o.o2b = at(1392);
  o.xs = at(1424); o.act = at(1568); o.Ys = at(1712); o.projB_b = at(1856);
  return o;
}

struct ProIn { const float *a_w_uk, *a_w_uv, *x, *a_w_in, *a_w_out, *b_w_in, *b_w_g2, *b_w_out, *m_w1, *m_w2; };
__device__ __forceinline__ void ph_prologue(const ProIn I, const Opt& o) {
  const int tid = TIDX(), lane = tid & 63, gw = BIDX() * 8 + (tid >> 6), NGW = (int)gridDim.x * 8, gtid = BIDX() * NTHR + tid, NGT = (int)gridDim.x * NTHR;
  cvt_f32_to_bf16(I.x, D, o.xb, D, NT, D, gtid, NGT);
  zero_rect(o.WA_t, D, DINA, 2048 - DINA, 0, D * 2, gtid, NGT);
  for (int i = gtid; i < 512 * 256; i += NGT) { const int n = i >> 8, k4 = (i & 255) * 4; float a[4];
#pragma unroll
    for (int z = 0; z < 4; ++z) { const float* gl = I.b_w_in + (size_t)(k4 + z) * DINB + 2048; float s = 0.f;
#pragma unroll
      for (int j = 0; j < 16; ++j) s = fmaf(gl[j], I.b_w_g2[j * 512 + n], s);
      a[z] = s; }
    *(v2u*)(o.WB_t + (size_t)(3072 + n) * D + k4) = (v2u){cvt_pk_bf16(a[0], a[1]), cvt_pk_bf16(a[2], a[3])}; }
  int w0 = 0;
#pragma unroll 1
  for (int h = 0; h < 16; ++h) {
    transpose_job(mk_tjob(I.a_w_uk + (size_t)h * 64 * 256, 256, 64, 256, o.Wql_t, 256, h * 256, (h & 3) * 64, 0), w0, gw, NGW, lane);
    transpose_job(mk_tjob(I.a_w_uv + (size_t)h * 256 * 64, 64, 256, 64, o.Wuv_t, 1024, h * 64, (h & 3) * 256, 0), w0, gw, NGW, lane);
    for (int hp = 0; hp < 4; ++hp) if (hp != (h & 3)) { zero_rect(o.Wql_t, 256, h * 256, 256, hp * 128, 128, gtid, NGT); zero_rect(o.Wuv_t, 1024, h * 64, 64, hp * 512, 512, gtid, NGT); }
  }
  transpose_job(mk_tjob(I.a_w_in, DINA, D, DINA, o.WA_t, D, 0, 0, 0), w0, gw, NGW, lane);
  transpose_job(mk_tjob(I.a_w_out, D, D, D, o.WoutA_t, D, 0, 0, 0), w0, gw, NGW, lane);
  transpose_job(mk_tjob(I.b_w_in, DINB, D, 2048, o.WB_t, D, 0, 0, 0), w0, gw, NGW, lane);
  transpose_job(mk_tjob(I.b_w_in + 2064, DINB, D, 1024, o.WB_t, D, 2048, 0, 0), w0, gw, NGW, lane);
  transpose_job(mk_tjob(I.b_w_out, D, D, D, o.WoutB_t, D, 0, 0, 0), w0, gw, NGW, lane);
}
__device__ __forceinline__ void ph_gla_shim(const bf16_t* pb, const float* gbias, float* projB, float* adec) {
  const int gtid = BIDX() * NTHR + TIDX(), NGT = (int)gridDim.x * NTHR;
  for (size_t i = gtid; i < (size_t)NT * 896; i += NGT) { const size_t r = i / 896; const int c = (int)(i % 896) * 4; const v2u v = *(const v2u*)(pb + r * 3584 + c);
    const f32x4 f = (f32x4){bf_lo(v[0]), bf_hi(v[0]), bf_lo(v[1]), bf_hi(v[1])};
    if (c < 2048) *(f32x4*)(projB + r * DINB + c) = f;
    else if (c < 3072) *(f32x4*)(projB + r * DINB + 2064 + (c - 2048)) = f;
    else { f32x4 o;
#pragma unroll
      for (int z = 0; z < 4; ++z) { const float a = f[z] + gbias[c - 3072 + z]; const float ls = fminf(a, 0.f) - log1pf(expf(-fabsf(a))); o[z] = expf(ls * (1.f / 16.f)); }
      *(f32x4*)(adec + r * 512 + (c - 3072)) = o; } }
}

#if PROBE == 3
#define GLA_PHASES \
      PH_BEGIN ph_gla_shim(o.projB_b, I.b_g_bias, w.projB, w.adec); PH_END \
      GRID_BAR(); \
      PH_BEGIN nvp::np_gla_scan(w.projB, w.adec, w.og, fl); PH_END \
      GRID_BAR(); \
      PH_BEGIN nvp::np_gla_norm(w.og, w.projB, I.b_norm, w.on); PH_END \
      GRID_BAR(); \
      PH_BEGIN cvt_f32_to_bf16(w.on, D, o.o2b, D, NT, D, gtid_, NGT_); PH_END \
      GRID_BAR(); \
      PH_BEGIN ph_gla_a1(o.projB_b, I.b_g_bias, (bf16_t*)(wsb_ + 489 * MiB), (bf16_t*)(wsb_ + 506 * MiB), (bf16_t*)(wsb_ + 880 * MiB), (float*)(wsb_ + 505 * MiB), ll, I.m_w1, I.m_w2, o.W1_t, o.W2_t); PH_END \
      GRID_BAR(); \
      PH_BEGIN ph_gla_a2((bf16_t*)(wsb_ + 880 * MiB), (float*)(wsb_ + 505 * MiB), (bf16_t*)(wsb_ + 1136 * MiB)); PH_END \
      GRID_BAR(); \
      PH_BEGIN ph_gla_a3(o.projB_b, (bf16_t*)(wsb_ + 489 * MiB), (bf16_t*)(wsb_ + 506 * MiB), (bf16_t*)(wsb_ + 1136 * MiB), I.b_norm, (bf16_t*)(wsb_ + 570 * MiB), ll); PH_END \
      GRID_BAR(); \
      PH_BEGIN { unsigned* fl_ = (unsigned*)(wsb_ + 512 * 1024); unsigned bits = 0u; \
        { const bf16_t* a = (const bf16_t*)(wsb_ + 489 * MiB); for (size_t i = gtid_; i < (size_t)NT * 512; i += NGT_) { const float v = bf2f(a[i]); if (!(fabsf(v) < 1e30f)) bits |= 1u; } } \
        { const float* a = (const float*)(wsb_ + 506 * MiB); for (size_t i = gtid_; i < (size_t)NT * 1024; i += NGT_) { const float v = a[i]; if (!(fabsf(v) < 1e30f)) bits |= 2u; } } \
        { const float* a = (const float*)(wsb_ + 880 * MiB); for (size_t i = gtid_; i < (size_t)1024 * 32768; i += NGT_) { const float v = a[i]; if (!(fabsf(v) < 1e30f)) bits |= 4u; } } \
        { const bf16_t* a = (const bf16_t*)(wsb_ + 1136 * MiB); for (size_t i = gtid_; i < (size_t)1024 * 32768; i += NGT_) { const float v = bf2f(a[i]); if (!(fabsf(v) < 1e30f)) bits |= 8u; } } \
        { const bf16_t* a = (const bf16_t*)(wsb_ + 570 * MiB); for (size_t i = gtid_; i < (size_t)NT * 1024; i += NGT_) { const float v = bf2f(a[i]); if (!(fabsf(v) < 1e30f)) bits |= 16u; } } \
        { const float* a = (const float*)(wsb_ + 505 * MiB); for (size_t i = gtid_; i < (size_t)1024 * 128; i += NGT_) { const float v = a[i]; if (!(fabsf(v) < 1e30f)) bits |= 32u; } } \
        if (bits) atomicOr(fl_, bits); \
        { float* pd = (float*)(wsb_ + 1968 * MiB); const bf16_t* ob = (const bf16_t*)(wsb_ + 570 * MiB); for (size_t i = gtid_; i < (size_t)NT * D; i += NGT_) pd[i] = bf2f(ob[i]) - w.on[i]; } } PH_END \
      GRID_BAR();
#else
#define GLA_PHASES \
      PH_BEGIN ph_gla_a1(o.projB_b, I.b_g_bias, o.qt, o.og, o.kvt, o.dcy, ll, I.m_w1, I.m_w2, o.W1_t, o.W2_t); PH_END \
      GRID_BAR(); \
      PH_BEGIN ph_gla_a2(o.kvt, o.dcy, o.spt); PH_END \
      GRID_BAR(); \
      PH_BEGIN ph_gla_a3(o.projB_b, o.qt, o.og, o.spt, I.b_norm, o.o2b, ll); PH_END \
      GRID_BAR();
#endif
#if defined(FUSE_ON)
#define MOE_GEMM_PHASES(li) \
    PH_BEGIN pg8::MoeFusedOrder S; S.init(o.xs, o.act, o.W1_t + (size_t)li * 32 * 2048 * D, o.W2_t + (size_t)li * 32 * D * D, o.m.slot_tok, o.m.blk_e, (unsigned*)(wsb_ + WS_CTL) + CW_RDY + li * 32768, (unsigned*)(wsb_ + WS_CTL) + CW_TMO, __builtin_amdgcn_readfirstlane(*o.m.nblk), G_, BIDX()); S.mode = 0; \
      gemm_phase<pg8::EpiMoeFused, pg8::MoeFusedOrder, true, true>(ll, Gemm{D, D, D}, S, pg8::EpiMoeFused{o.act, I.m_b1 + (size_t)li * 32 * 2048, o.Ys, I.m_b2 + (size_t)li * 32 * D, o.m.slot_gate}); PH_END \
    GRID_BAR();
#else
#define MOE_GEMM_PHASES(li) \
    PH_BEGIN pg8::MoeOrderG S; S.init(o.xs, D, o.W1_t + (size_t)li * 32 * 2048 * D, D, (size_t)2048 * D * 2, __builtin_amdgcn_readfirstlane(*o.m.nblk), 8, 128, o.m.blk_e, G_, BIDX()); S.rowmap = o.m.slot_tok; \
      gemm_phase<pg8::EpiSwiglu, pg8::MoeOrderG, true, true>(ll, Gemm{D, D, D}, S, pg8::EpiSwiglu{o.act, D, I.m_b1 + (size_t)li * 32 * 2048}); PH_END \
    GRID_BAR(); \
    PH_BEGIN MoeOrder S; S.init(o.act, D, o.W2_t + (size_t)li * 32 * D * D, D, (size_t)D * D * 2, __builtin_amdgcn_readfirstlane(*o.m.nblk), 4, 256, o.m.blk_e, G_, BIDX()); \
      gemm_phase<pg8::EpiMoe2, MoeOrder, true, true>(ll, Gemm{D, D, D}, S, pg8::EpiMoe2{o.Ys, D, I.m_b2 + (size_t)li * 32 * D, o.m.slot_gate}); PH_END \
    GRID_BAR();
#endif
#define LAYER_BODY(li) \
    if (li == 1) { \
      PH_BEGIN StaticOrder S; S.init(o.xb, D, o.WB_t, D, NT, 3584, G_, BIDX()); gemm_phase<EpiStore, StaticOrder, true, true>(ll, Gemm{D, D, D}, S, EpiStore{o.projB_b, 3584}); PH_END \
      GRID_BAR(); \
      GLA_PHASES \
      PH_BEGIN StaticOrder S; S.init(o.o2b, D, o.WoutB_t, D, NT, D, G_, BIDX()); gemm_phase<EpiStore, StaticOrder, true, true>(ll, Gemm{D, D, D}, S, EpiStore{o.hbf, D}); PH_END \
      GRID_BAR(); \
    } \
    PH_BEGIN if (li == 0) ph_ln_router<false>(I.x, o.hbf, I.ln1_g + li * D, I.ln1_b + li * D, I.m_w_router + (size_t)li * D * 32, I.m_b_router + li * 32, o.xs, o.m, fl); else ph_ln_router<true>(o.xb, o.hbf, I.ln1_g + li * D, I.ln1_b + li * D, I.m_w_router + (size_t)li * D * 32, I.m_b_router + li * 32, o.xs, o.m, fl); PH_END \
    GRID_BAR(); \
    PH_BEGIN ph_moe_scatter(o.m, (int*)lds); PH_END \
    GRID_BAR(); \
MOE_GEMM_PHASES(li) \
    PH_BEGIN ph_combine_ln(o.xs, o.Ys, o.m.slot_of, I.ln2_g + li * D, I.ln2_b + li * D, li == 0 ? nullptr : out_, li == 0 ? o.xb : nullptr); PH_END \
    if (li == 0) GRID_BAR();
__global__ void __launch_bounds__(NTHR, 2) mk_fwd(Args args) {
  extern __shared__ __attribute__((aligned(16))) unsigned char lds[];
  volatile LAS unsigned* MISC = (volatile LAS unsigned*)((LAS unsigned char*)lds + MISC_OFF);
  if (threadIdx.x < 32) MISC[threadIdx.x] = 0u;
  __syncthreads();
  XcdBarrier bar; { const __attribute__((address_space(4))) Args* ka0 = (const __attribute__((address_space(4))) Args*)__builtin_amdgcn_kernarg_segment_ptr(); bar = xcd_barrier_post((unsigned*)(ka0->ws + WS_CTL) + CW_BAR, MISC + 8); }
#define GRID_BAR() xcd_barrier(bar)
#define PH_BEGIN { const __attribute__((address_space(4))) Args* ka_ = (const __attribute__((address_space(4))) Args*)__builtin_amdgcn_kernarg_segment_ptr(); asm volatile("" : "+s"(ka_)); \
    float* const out_ = ka_->out; (void)out_; unsigned char* wsb_ = ka_->ws; const nvp::Ws w = carve_ws(wsb_); (void)w; const Opt o = carve_opt(wsb_); (void)o; \
    const int gtid_ = BIDX() * NTHR + TIDX(), NGT_ = (int)gridDim.x * NTHR; (void)gtid_; (void)NGT_; const int G_ = (int)gridDim.x; (void)G_;
#define PH_END }
#define I (ka_->in)
  float* fl = (float*)lds; LAS unsigned char* ll = (LAS unsigned char*)lds;
  using pg8::gemm_phase; using pg8::StaticOrder; using pg8::MoeOrder; using pg8::Gemm; using pg8::EpiStore;
  PH_BEGIN ph_prologue(ProIn{I.a_w_uk, I.a_w_uv, I.x, I.a_w_in, I.a_w_out, I.b_w_in, I.b_w_g2, I.b_w_out, I.m_w1, I.m_w2}, o); PH_END
  GRID_BAR();
  PH_BEGIN StaticOrder S; S.init(o.xb, D, o.WA_t, D, NT, 2048, G_, BIDX()); gemm_phase<EpiStore, StaticOrder, true, true>(ll, Gemm{D, D, D}, S, EpiStore{o.projA_b, 2048}); PH_END
  GRID_BAR();
  PH_BEGIN ph_cnorm_b(o.projA_b, I.a_kv_norm, o.cnb); PH_END
  PH_BEGIN pg8::GroupAOrder S; S.init(o.projA_b, 2048, o.Wql_t, 256, NT, 4096, 4, 512, G_, BIDX()); gemm_phase<EpiStore, pg8::GroupAOrder, true, true>(ll, Gemm{2048, 256, 256}, S, EpiStore{o.qlat, 4096}); PH_END
  PH_BEGIN ph_iscore(o.projA_b, o.sc, I.m_w1, I.m_w2, o.W1_t, o.W2_t); PH_END
  GRID_BAR();
  PH_BEGIN ph_select_attend(o.sc, o.qlat, o.cnb, o.olat, ll, I.m_w1, I.m_w2, o.W1_t, o.W2_t); PH_END
  GRID_BAR();
  PH_BEGIN pg8::GroupAOrder S; S.init(o.olat, 4096, o.Wuv_t, 1024, NT, 1024, 1, 2048, G_, BIDX()); gemm_phase<EpiStore, pg8::GroupAOrder, true, true>(ll, Gemm{4096, 1024, 1024}, S, EpiStore{o.o2b, D}); PH_END
  GRID_BAR();
#if PROBE == 2
  PH_BEGIN cvt_bf16_to_f32(o.projA_b, 2048, w.projA, DINA, NT, DINA, gtid_, NGT_); PH_END
  GRID_BAR();
  PH_BEGIN nvp::np_cnorm(w.projA, I.a_kv_norm, w.cn); PH_END
  PH_BEGIN nvp::np_iscore(w.projA, w.sc, fl); PH_END
  GRID_BAR();
  PH_BEGIN nvp::np_topk(w.sc, w.idx, (char*)lds); PH_END
  GRID_BAR();
  PH_BEGIN nvp::np_dsa_attn(w.projA, w.cn, w.idx, I.a_w_uk, I.a_w_uv, w.o2, fl); PH_END
  GRID_BAR();
  PH_BEGIN { float* pd = (float*)(wsb_ + 1968 * MiB); for (size_t i = gtid_; i < (size_t)NT * D; i += NGT_) pd[i] = bf2f(o.o2b[i]) - w.o2[i]; } PH_END
  GRID_BAR();
#endif
  PH_BEGIN StaticOrder S; S.init(o.o2b, D, o.WoutA_t, D, NT, D, G_, BIDX()); gemm_phase<EpiStore, StaticOrder, true, true>(ll, Gemm{D, D, D}, S, EpiStore{o.hbf, D}); PH_END
  GRID_BAR();
  { LAYER_BODY(0) }
  { LAYER_BODY(1) }
#if PROBE == 2 || PROBE == 3
  GRID_BAR();
#if PROBE == 3
  PH_BEGIN { if (gtid_ == 0) { const unsigned fb = *(const unsigned*)(wsb_ + 512 * 1024); out_[5] += (float)fb; } const float* pd = (const float*)(wsb_ + 1968 * MiB); for (size_t i = gtid_; i < (size_t)NT * D; i += NGT_) out_[i] += PROBE_S * pd[i]; } PH_END
#else
  PH_BEGIN { const float* pd = (const float*)(wsb_ + 1968 * MiB); for (size_t i = gtid_; i < (size_t)NT * D; i += NGT_) out_[i] += PROBE_S * pd[i]; } PH_END
#endif
#endif
}

extern "C" void kernel_launch(void* const* d_in, const int* in_sizes, int n_in, void* d_out, int out_size, void* d_ws, size_t ws_size, hipStream_t stream) {
  static int grid = 0;
  if (grid == 0) {
    if (n_in != 21 || ws_size < WS_NEEDED) { fprintf(stderr, "kernel_launch: bad inputs (n_in %d) or workspace too small (%zu needed, %zu given)\n", n_in, (size_t)WS_NEEDED, ws_size); grid = -1; return; }
    int dev = 0, cus = 0, per_cu = 0;
    if (hipGetDevice(&dev) != hipSuccess || hipDeviceGetAttribute(&cus, hipDeviceAttributeMultiprocessorCount, dev) != hipSuccess) { grid = -1; return; }
    if (hipFuncSetAttribute((const void*)mk_fwd, hipFuncAttributeMaxDynamicSharedMemorySize, LDS_BYTES) != hipSuccess) { fprintf(stderr, "kernel_launch: hipFuncSetAttribute failed\n"); grid = -1; return; }
    if (hipOccupancyMaxActiveBlocksPerMultiprocessor(&per_cu, (const void*)mk_fwd, NTHR, LDS_BYTES) != hipSuccess || per_cu < 1) fprintf(stderr, "kernel_launch: note: occupancy query reports %d\n", per_cu);
    (void)hipGetLastError();
    grid = cus;
    if (grid != 256) fprintf(stderr, "kernel_launch: built for 256 CUs (token ownership per workgroup); got %d\n", grid);
  }
  if (grid < 0) return;
  if (hipMemsetAsync((char*)d_ws + WS_CTL, 0, CTL_ZERO_BYTES, stream) != hipSuccess) { fprintf(stderr, "kernel_launch: memset failed\n"); return; }
  Args a; memset(&a, 0, sizeof(a));
  const float** f = (const float**)&a.in;
  for (int i = 0; i < 21; ++i) f[i] = (const float*)d_in[i];
  a.out = (float*)d_out; a.ws = (unsigned char*)d_ws;
  hipLaunchKernelGGL(mk_fwd, dim3(grid), dim3(NTHR), LDS_BYTES, stream, a);
  const hipError_t le = hipPeekAtLastError();
  if (le != hipSuccess) fprintf(stderr, "kernel_launch: launch failed: %s\n", hipGetErrorName(le));
}
```

```cpp
#include <hip/hip_runtime.h>
#include <cstdio>
#include <cstdint>
#include <cstring>

#define GAS __attribute__((address_space(1)))
#define LAS __attribute__((address_space(3)))
#define NTHR 512
constexpr int LDS_BYTES = 147456;
constexpr int MISC_OFF = 131072 + 8192;

#define XB_TMO      128
#define XB_XCNT(j)  (256  + 64 * (j))
#define XB_XSUB(j)  (1280 + 64 * (j))
#define XB_XGEN(j)  (2304 + 64 * (j))
#define XB_TOP      3328
#define XB_TOPGEN   3392
#define XCD_BAR_WORDS 3456
#define XB_SPIN_CAP (1u << 25)
__device__ __forceinline__ unsigned xb_ld(unsigned* p)              { return __hip_atomic_load(p, __ATOMIC_RELAXED, __HIP_MEMORY_SCOPE_AGENT); }
__device__ __forceinline__ unsigned xb_add(unsigned* p, unsigned v) { return __hip_atomic_fetch_add(p, v, __ATOMIC_RELAXED, __HIP_MEMORY_SCOPE_AGENT); }
__device__ __forceinline__ unsigned xb_xcc_id() { return (unsigned)__builtin_amdgcn_s_getreg((3 << 11) | 20) & 0xFu; }
#define XB_SPIN(cond, bar) do { unsigned _sp = 0; while (cond) { __builtin_amdgcn_s_sleep(1); \
    if ((++_sp & 255u) == 0u) { if (xb_ld(&(bar)[XB_TMO])) break; if (_sp > XB_SPIN_CAP) { atomicAdd(&(bar)[XB_TMO], 1u); break; } } } } while (0)
struct XcdBarrier { unsigned* bar; unsigned x; volatile LAS unsigned* st; };
__device__ __forceinline__ XcdBarrier xcd_barrier_post(unsigned* bar, volatile LAS unsigned* st) {
    XcdBarrier b; b.bar = bar; b.x = xb_xcc_id(); b.st = st;
    if (threadIdx.x == 0) (void)xb_add(&bar[XB_XCNT(b.x)], 1u);
    return b;
}
__device__ __forceinline__ void xcd_barrier_complete(unsigned* bar, unsigned x, unsigned& nloc, unsigned& nx) {
    const unsigned G = gridDim.x * gridDim.y * gridDim.z;
    unsigned sum, cnt, mine, sp = 0u;
    for (;;) {
        sum = 0u; cnt = 0u; mine = 0u;
#pragma unroll
        for (unsigned j = 0; j < 16; ++j) { const unsigned c = xb_ld(&bar[XB_XCNT(j)]); sum += c; cnt += (c > 0u) ? 1u : 0u; mine = (j == x) ? c : mine; }
        if (sum == G) break;
        __builtin_amdgcn_s_sleep(1);
        if ((++sp & 255u) == 0u) { if (xb_ld(&bar[XB_TMO])) break; if (sp > XB_SPIN_CAP) { atomicAdd(&bar[XB_TMO], 1u); break; } }
    }
    nloc = mine > 0u ? mine : 1u; nx = cnt > 0u ? cnt : 1u;
}
__device__ __forceinline__ void xcd_barrier(const XcdBarrier& b) {
    asm volatile("s_waitcnt vmcnt(0)" ::: "memory");
    __syncthreads();
    if (threadIdx.x == 0) {
        unsigned* bar = b.bar;
        __builtin_amdgcn_s_waitcnt(0);
        unsigned nloc = b.st[0], nx = b.st[1];
        if (nloc == 0u) { xcd_barrier_complete(bar, b.x, nloc, nx); b.st[0] = nloc; b.st[1] = nx; }
        const unsigned old = xb_add(&bar[XB_XSUB(b.x)], 1u);
        const unsigned gen = old / nloc;
        if (old + 1u == (gen + 1u) * nloc) {
            __builtin_amdgcn_fence(__ATOMIC_RELEASE, "agent");
            asm volatile("s_waitcnt vmcnt(0)" ::: "memory");
            const unsigned og = xb_add(&bar[XB_TOP], 1u);
            const unsigned tg = og / nx;
            if (og + 1u == (tg + 1u) * nx) xb_add(&bar[XB_TOPGEN], 1u);
            else XB_SPIN(xb_ld(&bar[XB_TOPGEN]) == tg, bar);
            __builtin_amdgcn_fence(__ATOMIC_ACQUIRE, "agent");
            xb_add(&bar[XB_XGEN(b.x)], 1u);
            asm volatile("s_waitcnt vmcnt(0)" ::: "memory");
        } else {
            XB_SPIN(xb_ld(&bar[XB_XGEN(b.x)]) == gen, bar);
            __builtin_amdgcn_fence(__ATOMIC_ACQUIRE, "agent");
            asm volatile("s_waitcnt vmcnt(0)" ::: "memory");
        }
    }
    __syncthreads();
}

constexpr int NT = 16384, D = 1024, L = 8192, NB = 2;
constexpr int DINA = 1864, DINB = 3088;
constexpr int PMAX = 73728;
constexpr float ALPHA = 1.4142135623730951f;

struct In { const float *x, *a_w_in, *a_kv_norm, *a_w_uk, *a_w_uv, *a_w_out, *b_w_in, *b_w_g2, *b_g_bias, *b_norm, *b_w_out, *m_w_router, *m_b_router, *m_w1, *m_b1, *m_w2, *m_b2, *ln1_g, *ln1_b, *ln2_g, *ln2_b; };

__device__ __forceinline__ int TIDX() { int t = threadIdx.x; asm volatile("" : "+v"(t)); return t; }
__device__ __forceinline__ int BIDX() { int t = blockIdx.x; asm volatile("" : "+s"(t)); return t; }
__device__ __forceinline__ float wave_sum(float v) {
#pragma unroll
    for (int o = 1; o < 64; o <<= 1) v += __shfl_xor(v, o);
    return v;
}
namespace nvp {
#define WSYNC() asm volatile("s_waitcnt lgkmcnt(0)" ::: "memory")
struct GemmP {
  const float* A; int lda; const int* arow;
  const float* B; int ldb; float* C; int ldc; int M, N, K;
  const int* blk_e; const int* nblk_used; size_t bstride; const float* bias; size_t bias_stride;
};
__device__ __forceinline__ GemmP mkg(const float* A, int lda, const int* arow, const float* B, int ldb, float* C, int ldc, int M, int N, int K, const int* blk_e, const int* nblk_used, size_t bstride, const float* bias, size_t bias_stride) {
  GemmP p; p.A = A; p.lda = lda; p.arow = arow; p.B = B; p.ldb = ldb; p.C = C; p.ldc = ldc; p.M = M; p.N = N; p.K = K; p.blk_e = blk_e; p.nblk_used = nblk_used; p.bstride = bstride; p.bias = bias; p.bias_stride = bias_stride; return p; }

template <int MODE>
__device__ __forceinline__ void np_sgemm(const GemmP p, float* lds) {
  float (*As)[132] = (float (*)[132])lds;
  float (*Bs)[68] = (float (*)[68])(lds + 16 * 132);
  float (*Bu)[68] = (float (*)[68])(lds + 16 * 132 + 16 * 68);
  const int tid = TIDX(), tx = tid & 15, ty = tid >> 4;
  const int ntn = (p.N + 63) / 64, ntm = p.M / 128;
  const int ar = tid >> 2, ak = (tid & 3) * 4;
  const int bk = (tid & 255) >> 4, bn4 = (tid & 15) * 4;
  for (int t = BIDX(); t < ntm * ntn; t += gridDim.x) {
    const int bm = t / ntn, bn = t % ntn;
    const float* B = p.B; const float* bias = p.bias;
    if (MODE != 0) { const int blk = (bm * 128) / 256; if (blk >= *p.nblk_used) continue; const int e = p.blk_e[blk]; B += (size_t)e * p.bstride; bias += (size_t)e * p.bias_stride; }
    const int m0 = bm * 128, n0 = bn * 64;
    const int arow = p.arow ? p.arow[m0 + ar] : (m0 + ar);
    const float* Ap = p.A + (size_t)arow * p.lda + ak;
    const bool bok = (n0 + bn4) < p.N;
    float acc[4][4] = {}, accu[4][4] = {};
    for (int k0 = 0; k0 < p.K; k0 += 16) {
      const float4 av = *(const float4*)(Ap + k0);
      As[ak + 0][ar] = av.x; As[ak + 1][ar] = av.y; As[ak + 2][ar] = av.z; As[ak + 3][ar] = av.w;
      if (tid < 256) { float4 bv = make_float4(0.f, 0.f, 0.f, 0.f); if (bok) bv = *(const float4*)(B + (size_t)(k0 + bk) * p.ldb + n0 + bn4); *(float4*)&Bs[bk][bn4] = bv; }
      else if (MODE == 1) { const float4 uv = *(const float4*)(B + (size_t)(k0 + bk) * p.ldb + 1024 + n0 + bn4); *(float4*)&Bu[bk][bn4] = uv; }
      __syncthreads();
#pragma unroll
      for (int kk = 0; kk < 16; ++kk) {
        const float4 a = *(const float4*)&As[kk][ty * 4];
        const float4 b = *(const float4*)&Bs[kk][tx * 4];
        const float aa[4] = {a.x, a.y, a.z, a.w}, bb[4] = {b.x, b.y, b.z, b.w};
#pragma unroll
        for (int i = 0; i < 4; ++i)
#pragma unroll
          for (int j = 0; j < 4; ++j) acc[i][j] = fmaf(aa[i], bb[j], acc[i][j]);
        if (MODE == 1) {
          const float4 u = *(const float4*)&Bu[kk][tx * 4]; const float uu[4] = {u.x, u.y, u.z, u.w};
#pragma unroll
          for (int i = 0; i < 4; ++i)
#pragma unroll
            for (int j = 0; j < 4; ++j) accu[i][j] = fmaf(aa[i], uu[j], accu[i][j]);
        }
      }
      __syncthreads();
    }
#pragma unroll
    for (int i = 0; i < 4; ++i) {
      const int m = m0 + ty * 4 + i;
#pragma unroll
      for (int j = 0; j < 4; ++j) {
        const int n = n0 + tx * 4 + j; if (n >= p.N) continue;
        float v = acc[i][j];
        if (MODE == 1) {
          float g = v + bias[n], u = accu[i][j] + bias[1024 + n];
          g = fminf(g, 7.f); u = fminf(fmaxf(u, -7.f), 7.f);
          const float glu = g / (1.f + expf(-1.702f * g));
          v = (u + 1.f) * glu;
        } else if (MODE == 2) v += bias[n];
        p.C[(size_t)m * p.ldc + n] = v;
      }
    }
  }
}

#define GW_INIT const int lane = TIDX() & 63, wave = TIDX() >> 6, gw = BIDX() * 8 + wave, NGW = gridDim.x * 8; (void)lane; (void)wave; (void)gw; (void)NGW

__device__ __forceinline__ void np_cnorm(const float* projA, const float* g, float* cn) {
  GW_INIT;
  for (int row = gw; row < NT; row += NGW) {
    const float4 v = *(const float4*)(projA + (size_t)row * DINA + 1024 + lane * 4);
    const float ss = wave_sum(v.x * v.x + v.y * v.y + v.z * v.z + v.w * v.w);
    const float r = rsqrtf(ss * (1.f / 256.f) + 1e-6f); const float4 g4 = *(const float4*)(g + lane * 4);
    *(float4*)(cn + (size_t)row * 256 + lane * 4) = make_float4(v.x * r * g4.x, v.y * r * g4.y, v.z * r * g4.z, v.w * r * g4.w);
  }
}

__device__ __forceinline__ void np_iscore(const float* projA, float* sc, float* lds) {
  float (*As)[132] = (float (*)[132])lds;
  float (*Bs)[68] = (float (*)[68])(lds + 16 * 132);
  const int tid = TIDX(), tx = tid & 15, ty = tid >> 4;
  const int ar = tid >> 2, ak = (tid & 3) * 4;
  const int br = (tid & 255) >> 2;
  for (int u = BIDX(); u < NB * 64 * 128; u += gridDim.x) {
    const int b = u / (64 * 128), tt = (u / 128) % 64, st = u % 128;
    if (st > 2 * tt + 1) continue;
    const int t0 = tt * 128, s0 = st * 64;
    const float* Qp = projA + (size_t)(b * L + t0 + ar) * DINA + 1280 + ak;
    const float* Kp = projA + (size_t)(b * L + s0 + br) * DINA + 1792 + ak;
    float score[4][4] = {};
    for (int h = 0; h < 8; ++h) {
      float acc[4][4] = {};
      for (int k0 = 0; k0 < 64; k0 += 16) {
        const float4 av = *(const float4*)(Qp + h * 64 + k0);
        As[ak + 0][ar] = av.x; As[ak + 1][ar] = av.y; As[ak + 2][ar] = av.z; As[ak + 3][ar] = av.w;
        if (tid < 256) { const float4 bv = *(const float4*)(Kp + k0); Bs[ak + 0][br] = bv.x; Bs[ak + 1][br] = bv.y; Bs[ak + 2][br] = bv.z; Bs[ak + 3][br] = bv.w; }
        __syncthreads();
#pragma unroll
        for (int kk = 0; kk < 16; ++kk) {
          const float4 a = *(const float4*)&As[kk][ty * 4]; const float4 bq = *(const float4*)&Bs[kk][tx * 4];
          const float aa[4] = {a.x, a.y, a.z, a.w}, bb[4] = {bq.x, bq.y, bq.z, bq.w};
#pragma unroll
          for (int i = 0; i < 4; ++i)
#pragma unroll
            for (int j = 0; j < 4; ++j) acc[i][j] = fmaf(aa[i], bb[j], acc[i][j]);
        }
        __syncthreads();
      }
#pragma unroll
      for (int i = 0; i < 4; ++i) {
        const float w = projA[(size_t)(b * L + t0 + ty * 4 + i) * DINA + 1856 + h] * 0.35355339059327373f;
#pragma unroll
        for (int j = 0; j < 4; ++j) score[i][j] += w * fmaxf(acc[i][j] * 0.125f, 0.f);
      }
    }
#pragma unroll
    for (int i = 0; i < 4; ++i)
#pragma unroll
      for (int j = 0; j < 4; ++j) sc[((size_t)(b * L + t0 + ty * 4 + i)) * L + s0 + tx * 4 + j] = score[i][j];
  }
}

__device__ __forceinline__ unsigned f2key(float f) { f = f + 0.0f; const unsigned u = __float_as_uint(f); return (u & 0x80000000u) ? ~u : (u | 0x80000000u); }

__device__ __forceinline__ void np_topk(const float* sc, int* idx_out, char* lds) {
  GW_INIT;
  unsigned* hist = (unsigned*)(lds + wave * 1280); unsigned* cntw = hist + 256;
  for (int row = gw; row < NT; row += NGW) {
    const int t = row % L, n = t + 1;
    const float* s = sc + (size_t)row * L; int* out = idx_out + (size_t)row * 256;
    if (n <= 256) { for (int i = lane; i < 256; i += 64) out[i] = i < n ? i : -1; continue; }
    unsigned prefix = 0, need = 256;
    for (int pass = 3; pass >= 0; --pass) {
      const int shift = pass * 8;
      for (int i = lane; i < 256; i += 64) hist[i] = 0;
      WSYNC();
      for (int i = lane; i < n; i += 64) { const unsigned k = f2key(s[i]); const bool m = (pass == 3) || ((k >> (shift + 8)) == (prefix >> (shift + 8))); if (m) atomicAdd(&hist[(k >> shift) & 255u], 1u); }
      WSYNC();
      unsigned cum = 0; int d = 255; for (; d > 0; --d) { const unsigned hv = hist[d]; if (cum + hv >= need) break; cum += hv; }
      prefix |= ((unsigned)d << shift); need -= cum;
      WSYNC();
    }
    if (lane == 0) *cntw = 0; WSYNC();
    for (int i = lane; i < n; i += 64) { if (f2key(s[i]) > prefix) { const unsigned pos = atomicAdd(cntw, 1u); out[pos] = i; } }
    WSYNC();
    if (lane == 0) { unsigned c = *cntw; unsigned nd = need; for (int i = 0; i < n && nd > 0; ++i) if (f2key(s[i]) == prefix) { out[c++] = i; --nd; } }
    WSYNC();
  }
}

__device__ __forceinline__ void np_dsa_attn(const float* projA, const float* cn, const int* idx, const float* w_uk, const float* w_uv, float* o2, float* lds) {
  const int half = TIDX() >> 8, tid = TIDX() & 255;
  float* base = lds + half * 14336;
  float* qs = base; float (*ql)[256] = (float (*)[256])(base + 1024); float (*pr)[257] = (float (*)[257])(base + 1024 + 4096);
  float (*ol)[256] = (float (*)[256])(base + 1024 + 4096 + 4112); float* red = base + 1024 + 4096 + 4112 + 4096; int* sid = (int*)(red + 16);
  for (int r0 = BIDX() * 2; r0 < NT; r0 += gridDim.x * 2) {
    const int row = r0 + half, b = row / L;
    __syncthreads();
    for (int i = tid; i < 1024; i += 256) qs[i] = projA[(size_t)row * DINA + i];
    sid[tid] = idx[(size_t)row * 256 + tid];
    __syncthreads();
    { const int c = tid;
#pragma unroll 1
      for (int h = 0; h < 16; ++h) { float a = 0.f;
#pragma unroll 8
        for (int d = 0; d < 64; ++d) a = fmaf(qs[h * 64 + d], w_uk[((size_t)h * 64 + d) * 256 + c], a); ql[h][c] = a; } }
    __syncthreads();
    { const int k = tid, key = sid[k];
      float lg[16];
      if (key >= 0) { const float* cr = cn + (size_t)(b * L + key) * 256;
        for (int h = 0; h < 16; ++h) lg[h] = 0.f;
#pragma unroll 2
        for (int c = 0; c < 256; ++c) { const float cv = cr[c];
#pragma unroll
          for (int h = 0; h < 16; ++h) lg[h] = fmaf(ql[h][c], cv, lg[h]); }
#pragma unroll
        for (int h = 0; h < 16; ++h) pr[h][k] = lg[h] * 0.125f;
      } else {
#pragma unroll
        for (int h = 0; h < 16; ++h) pr[h][k] = -INFINITY; } }
    __syncthreads();
    if (tid < 16) { const int h = tid; float m = -INFINITY; for (int k = 0; k < 256; ++k) m = fmaxf(m, pr[h][k]); float su = 0.f; for (int k = 0; k < 256; ++k) { const float e = expf(pr[h][k] - m); pr[h][k] = e; su += e; } red[h] = 1.f / su; }
    __syncthreads();
    { const int c = tid; float a[16];
#pragma unroll
      for (int h = 0; h < 16; ++h) a[h] = 0.f;
#pragma unroll 2
      for (int k = 0; k < 256; ++k) { const int key = sid[k]; if (key < 0) continue; const float cv = cn[(size_t)(b * L + key) * 256 + c];
#pragma unroll
        for (int h = 0; h < 16; ++h) a[h] = fmaf(pr[h][k], cv, a[h]); }
#pragma unroll
      for (int h = 0; h < 16; ++h) ol[h][c] = a[h] * red[h]; }
    __syncthreads();
#pragma unroll 1
    for (int o = tid; o < 1024; o += 256) { const int h = o >> 6, v = o & 63; float a = 0.f;
#pragma unroll 8
      for (int c = 0; c < 256; ++c) a = fmaf(ol[h][c], w_uv[((size_t)h * 256 + c) * 64 + v], a); o2[(size_t)row * 1024 + o] = a; }
  }
  __syncthreads();
}

__device__ __forceinline__ void np_ln_res(const float* x, const float* h, const float* g, const float* bb, float* out) {
  GW_INIT;
  for (int row = gw; row < NT; row += NGW) {
    float4 v[4]; float s = 0.f;
#pragma unroll
    for (int j = 0; j < 4; ++j) { const float4 a = *(const float4*)(x + (size_t)row * D + lane * 4 + 256 * j), hh = *(const float4*)(h + (size_t)row * D + lane * 4 + 256 * j);
      v[j] = make_float4(ALPHA * a.x + hh.x, ALPHA * a.y + hh.y, ALPHA * a.z + hh.z, ALPHA * a.w + hh.w); s += (v[j].x + v[j].y) + (v[j].z + v[j].w); }
    const float mu = wave_sum(s) * (1.f / D); float q = 0.f;
#pragma unroll
    for (int j = 0; j < 4; ++j) { v[j].x -= mu; v[j].y -= mu; v[j].z -= mu; v[j].w -= mu; q += (v[j].x * v[j].x + v[j].y * v[j].y) + (v[j].z * v[j].z + v[j].w * v[j].w); }
    const float r = rsqrtf(wave_sum(q) * (1.f / D) + 1e-5f);
#pragma unroll
    for (int j = 0; j < 4; ++j) { const int c = lane * 4 + 256 * j; const float4 g4 = *(const float4*)(g + c), b4 = *(const float4*)(bb + c);
      *(float4*)(out + (size_t)row * D + c) = make_float4(v[j].x * r * g4.x + b4.x, v[j].y * r * g4.y + b4.y, v[j].z * r * g4.z + b4.z, v[j].w * r * g4.w + b4.w); }
  }
}

__device__ __forceinline__ void np_router(const float* x, const float* wr, const float* br, int* tok_e, float* tok_g, int* counts, int* row_tok, char* lds) {
  GW_INIT;
  for (int i = BIDX() * NTHR + TIDX(); i < PMAX; i += gridDim.x * NTHR) row_tok[i] = 0;
  float* lg = (float*)(lds + wave * 256);
  const int e = lane & 31, hf = lane >> 5;
  for (int tok = gw; tok < NT; tok += NGW) {
    const float* xr = x + (size_t)tok * D + hf * 512; const float* wp = wr + (size_t)hf * 512 * 32 + e; float a = 0.f;
#pragma unroll 8
    for (int d = 0; d < 512; ++d) a = fmaf(xr[d], wp[d * 32], a);
    a += __shfl_xor(a, 32);
    if (hf == 0) lg[e] = a + br[e];
    WSYNC();
    if (lane == 0) { int ei[4]; float ev[4];
      for (int k = 0; k < 4; ++k) { int bi = 0; float bv = -INFINITY; for (int j = 0; j < 32; ++j) if (lg[j] > bv) { bv = lg[j]; bi = j; } ei[k] = bi; ev[k] = bv; lg[bi] = -INFINITY; }
      float su = 0.f, ex[4]; for (int k = 0; k < 4; ++k) { ex[k] = expf(ev[k] - ev[0]); su += ex[k]; }
      for (int k = 0; k < 4; ++k) { tok_e[tok * 4 + k] = ei[k]; tok_g[tok * 4 + k] = ex[k] / su; atomicAdd(&counts[ei[k]], 1); } }
    WSYNC();
  }
}
__device__ __forceinline__ void np_moe_sort(const int* tok_e, const float* tok_g, const int* counts, int* row_tok, float* row_gate, int* slot_of, int* blk_e, int* nblk_used, char* lds) {
  if (BIDX() != 0) return;
  const int e = TIDX(); int* pstart = (int*)lds; int* stage = pstart + 64;
  if (e == 0) { int acc = 0; for (int j = 0; j < 32; ++j) { pstart[j] = acc; const int nb = (counts[j] + 255) / 256; for (int q = 0; q < nb; ++q) blk_e[acc / 256 + q] = j; acc += nb * 256; } pstart[32] = acc; *nblk_used = acc / 256; }
  __syncthreads();
  int pos = e < 32 ? pstart[e] : 0;
  for (int c0 = 0; c0 < NT * 4; c0 += 2048) {
    __syncthreads();
    for (int i = e; i < 2048; i += NTHR) stage[i] = tok_e[c0 + i];
    __syncthreads();
    if (e < 32) for (int i = 0; i < 2048; ++i) if (stage[i] == e) { const int gi = c0 + i; row_tok[pos] = gi >> 2; row_gate[pos] = tok_g[gi]; slot_of[gi] = pos; ++pos; }
  }
  __syncthreads();
}
__device__ __forceinline__ void np_moe_combine_ln(const float* x1, const float* ys, const int* slot_of, const float* tok_g, const float* g, const float* bb, float* out) {
  GW_INIT;
  for (int row = gw; row < NT; row += NGW) {
    float4 v[4]; float s = 0.f; int sl[4]; float gg[4];
#pragma unroll
    for (int k = 0; k < 4; ++k) { sl[k] = slot_of[row * 4 + k]; gg[k] = tok_g[row * 4 + k]; }
#pragma unroll
    for (int j = 0; j < 4; ++j) { const int c = lane * 4 + 256 * j; float4 f = make_float4(0.f, 0.f, 0.f, 0.f);
#pragma unroll
      for (int k = 0; k < 4; ++k) { const float4 y = *(const float4*)(ys + (size_t)sl[k] * D + c); f.x += gg[k] * y.x; f.y += gg[k] * y.y; f.z += gg[k] * y.z; f.w += gg[k] * y.w; }
      const float4 a = *(const float4*)(x1 + (size_t)row * D + c);
      v[j] = make_float4(ALPHA * a.x + f.x, ALPHA * a.y + f.y, ALPHA * a.z + f.z, ALPHA * a.w + f.w); s += (v[j].x + v[j].y) + (v[j].z + v[j].w); }
    const float mu = wave_sum(s) * (1.f / D); float q = 0.f;
#pragma unroll
    for (int j = 0; j < 4; ++j) { v[j].x -= mu; v[j].y -= mu; v[j].z -= mu; v[j].w -= mu; q += (v[j].x * v[j].x + v[j].y * v[j].y) + (v[j].z * v[j].z + v[j].w * v[j].w); }
    const float r = rsqrtf(wave_sum(q) * (1.f / D) + 1e-5f);
#pragma unroll
    for (int j = 0; j < 4; ++j) { const int c = lane * 4 + 256 * j; const float4 g4 = *(const float4*)(g + c), b4 = *(const float4*)(bb + c);
      *(float4*)(out + (size_t)row * D + c) = make_float4(v[j].x * r * g4.x + b4.x, v[j].y * r * g4.y + b4.y, v[j].z * r * g4.z + b4.z, v[j].w * r * g4.w + b4.w); }
  }
}

__device__ __forceinline__ void np_gla_gate(const float* projB, const float* w_g2, const float* gb, float* adec) {
  GW_INIT;
  for (int row = gw; row < NT; row += NGW) {
    float glr[16];
#pragma unroll
    for (int j = 0; j < 16; ++j) glr[j] = projB[(size_t)row * DINB + 2048 + j];
    for (int c = lane; c < 512; c += 64) { float a = gb[c];
#pragma unroll
      for (int j = 0; j < 16; ++j) a = fmaf(glr[j], w_g2[j * 512 + c], a);
      const float ls = fminf(a, 0.f) - log1pf(expf(-fabsf(a))); adec[(size_t)row * 512 + c] = expf(ls * (1.f / 16.f)); }
  }
}
__device__ __forceinline__ void np_gla_scan(const float* projB, const float* adec, float* og, float* lds) {
  if (BIDX() >= 8) return;
  const int b = BIDX() >> 2, h = BIDX() & 3, tid = TIDX(), dv = tid & 255, dh = tid >> 8;
  float (*qs)[128] = (float (*)[128])lds; float (*ks)[128] = (float (*)[128])(lds + 2048); float (*as)[128] = (float (*)[128])(lds + 4096);
  float (*po)[16][256] = (float (*)[16][256])(lds + 6144);
  float S[64];
#pragma unroll
  for (int d = 0; d < 64; ++d) S[d] = 0.f;
  for (int t0 = 0; t0 < L; t0 += 16) {
    __syncthreads();
    for (int i = tid; i < 16 * 128; i += NTHR) { const int tt = i >> 7, d = i & 127; const size_t r = (size_t)(b * L + t0 + tt);
      qs[tt][d] = projB[r * DINB + h * 128 + d] * 0.08838834764831845f; ks[tt][d] = projB[r * DINB + 512 + h * 128 + d]; as[tt][d] = adec[r * 512 + h * 128 + d]; }
    __syncthreads();
#pragma unroll 1
    for (int tt = 0; tt < 16; ++tt) { const size_t r = (size_t)(b * L + t0 + tt); const float v = projB[r * DINB + 1024 + h * 256 + dv]; float o = 0.f;
#pragma unroll
      for (int d = 0; d < 64; ++d) { S[d] = fmaf(as[tt][dh * 64 + d], S[d], ks[tt][dh * 64 + d] * v); o = fmaf(qs[tt][dh * 64 + d], S[d], o); }
      po[dh][tt][dv] = o; }
    __syncthreads();
    for (int i = tid; i < 16 * 256; i += NTHR) { const int tt = i >> 8, c = i & 255; og[(size_t)(b * L + t0 + tt) * 1024 + h * 256 + c] = po[0][tt][c] + po[1][tt][c]; }
  }
  __syncthreads();
}
__device__ __forceinline__ void np_gla_norm(const float* og, const float* projB, const float* ng, float* on) {
  GW_INIT;
  for (int u = gw; u < NT * 4; u += NGW) {
    const int row = u >> 2, h = u & 3; const int c = h * 256 + lane * 4;
    const float4 v = *(const float4*)(og + (size_t)row * 1024 + c);
    const float r = rsqrtf(wave_sum(v.x * v.x + v.y * v.y + v.z * v.z + v.w * v.w) * (1.f / 256.f) + 1e-6f);
    const float4 rr = *(const float4*)(projB + (size_t)row * DINB + 2064 + c), g4 = *(const float4*)(ng + c);
    *(float4*)(on + (size_t)row * 1024 + c) = make_float4(v.x * r * g4.x * (rr.x / (1.f + expf(-rr.x))), v.y * r * g4.y * (rr.y / (1.f + expf(-rr.y))), v.z * r * g4.z * (rr.z / (1.f + expf(-rr.z))), v.w * r * g4.w * (rr.w / (1.f + expf(-rr.w))));
  }
}

struct Ws { float *projA, *cn, *sc, *o2, *h, *x1, *x2, *hb, *ys, *projB, *adec, *og, *on, *tok_g, *row_gate; int *idx, *tok_e, *slot_of, *row_tok, *blk_e, *counts; };
}
typedef unsigned short bf16_t;
typedef unsigned v4u __attribute__((ext_vector_type(4)));
typedef unsigned v2u __attribute__((ext_vector_type(2)));
typedef float f32x4 __attribute__((ext_vector_type(4)));
typedef short bf16x8 __attribute__((ext_vector_type(8)));
typedef float f32x2_t __attribute__((ext_vector_type(2))); typedef __bf16 bf16x2_t __attribute__((ext_vector_type(2)));
__device__ __forceinline__ unsigned cvt_pk_bf16(float lo, float hi) { const f32x2_t v = {lo, hi}; const bf16x2_t b = __builtin_convertvector(v, bf16x2_t); return __builtin_bit_cast(unsigned, b); }
__device__ __forceinline__ float bf_lo(unsigned u) { return __uint_as_float(u << 16); }
__device__ __forceinline__ float bf_hi(unsigned u) { return __uint_as_float(u & 0xffff0000u); }
__device__ __forceinline__ float bf2f(bf16_t h) { return __uint_as_float(((unsigned)h) << 16); }

struct TJob { const float* src; int lds_; int K, N; bf16_t* dst; int ldd; int drow0, dcol0; int rowmap; int ntk, ntn; };
__device__ __forceinline__ TJob mk_tjob(const float* src, int lds_, int K, int N, bf16_t* dst, int ldd, int drow0, int dcol0, int rowmap) {
  TJob j; j.src = src; j.lds_ = lds_; j.K = K; j.N = N; j.dst = dst; j.ldd = ldd; j.drow0 = drow0; j.dcol0 = dcol0; j.rowmap = rowmap; j.ntk = K / 64; j.ntn = (N + 127) / 128; return j; }
__device__ __forceinline__ int tjob_tiles(const TJob& j) { return j.ntk * j.ntn; }
__device__ __forceinline__ void transpose_tile(const TJob& j, int tile, int lane) {
  const int kt = tile / j.ntn, nt_ = tile % j.ntn, k0 = kt * 64, n0 = nt_ * 128;
  const int q = lane & 31, par = lane >> 5;
  const bool ok = (n0 + 4 * q) < j.N;
  f32x4 v[32];
  const float* sp = j.src + (size_t)(k0 + par) * j.lds_ + n0 + 4 * q;
#pragma unroll
  for (int i = 0; i < 32; ++i) v[i] = ok ? *(const f32x4*)(sp + (size_t)(2 * i) * j.lds_) : (f32x4){0.f, 0.f, 0.f, 0.f};
  unsigned ra[32], rb[32];
#pragma unroll
  for (int i = 0; i < 32; ++i) {
    auto s0 = __builtin_amdgcn_permlane32_swap(__float_as_uint(v[i][0]), __float_as_uint(v[i][2]), false, false);
    auto s1 = __builtin_amdgcn_permlane32_swap(__float_as_uint(v[i][1]), __float_as_uint(v[i][3]), false, false);
    ra[i] = cvt_pk_bf16(__uint_as_float(s0[0]), __uint_as_float(s0[1]));
    rb[i] = cvt_pk_bf16(__uint_as_float(s1[0]), __uint_as_float(s1[1]));
  }
  if (ok) {
    const int n = n0 + 4 * q + 2 * par;
    int r0 = n, r1 = n + 1;
    if (j.rowmap == 1) { const int jj0 = r0 & 1023, jj1 = r1 & 1023; r0 = 256 * (jj0 >> 7) + ((r0 >> 10) << 7) + (jj0 & 127); r1 = 256 * (jj1 >> 7) + ((r1 >> 10) << 7) + (jj1 & 127); }
    bf16_t* d0 = j.dst + (size_t)(j.drow0 + r0) * j.ldd + j.dcol0 + k0;
    bf16_t* d1 = j.dst + (size_t)(j.drow0 + r1) * j.ldd + j.dcol0 + k0;
#pragma unroll
    for (int c = 0; c < 8; ++c) { *(v4u*)(d0 + 8 * c) = (v4u){ra[4 * c], ra[4 * c + 1], ra[4 * c + 2], ra[4 * c + 3]}; *(v4u*)(d1 + 8 * c) = (v4u){rb[4 * c], rb[4 * c + 1], rb[4 * c + 2], rb[4 * c + 3]}; }
  }
}
__device__ __forceinline__ void transpose_job(const TJob j, int& w0, int gw, int NGW, int lane) {
  const int nt_ = tjob_tiles(j);
  int first = gw - (w0 % NGW); if (first < 0) first += NGW;
#pragma unroll 1
  for (int t = first; t < nt_; t += NGW) transpose_tile(j, t, lane);
  w0 += nt_;
}
__device__ __forceinline__ void zero_rect(bf16_t* dst, int ldd, int r0, int nr, int cb0, int nbytes, int gtid, int NGT) {
  const int per = nbytes / 16;
  for (int i = gtid; i < nr * per; i += NGT) { const int r = i / per, c = i % per; *(v4u*)((char*)(dst + (size_t)(r0 + r) * ldd) + cb0 + 16 * c) = (v4u){0u, 0u, 0u, 0u}; }
}
__device__ __forceinline__ void cvt_f32_to_bf16(const float* src, int lds_, bf16_t* dst, int ldd, int rows, int ncols, int gtid, int NGT) {
  const int per = ncols / 4;
  for (size_t i = gtid; i < (size_t)rows * per; i += NGT) { const size_t r = i / per; const int c = (int)(i % per) * 4; const f32x4 v = *(const f32x4*)(src + r * lds_ + c);
    *(v2u*)(dst + r * ldd + c) = (v2u){cvt_pk_bf16(v[0], v[1]), cvt_pk_bf16(v[2], v[3])}; }
}
__device__ __forceinline__ void cvt_bf16_to_f32(const bf16_t* src, int lds_, float* dst, int ldd, int rows, int ncols, int gtid, int NGT) {
  const int per = ncols / 4;
  for (size_t i = gtid; i < (size_t)rows * per; i += NGT) { const size_t r = i / per; const int c = (int)(i % per) * 4; const v2u v = *(const v2u*)(src + r * lds_ + c);
    *(f32x4*)(dst + r * ldd + c) = (f32x4){bf_lo(v[0]), bf_hi(v[0]), bf_lo(v[1]), bf_hi(v[1])}; }
}

namespace pg8 {
#define PG8_LAS __attribute__((address_space(3)))
typedef unsigned u32x4 __attribute__((ext_vector_type(4)));
constexpr int BM = 256, BK = 64, HALF = 128, HTB = HALF * BK * 2, STAGE_BYTES = 8 * HTB, NXCD = 8, WGM = 8;
__host__ __device__ __forceinline__ int lds_byte(int r, int c) { const int st = (r >> 4) * 2 + (c >> 5), rr = r & 15, cc = c & 31, ob = rr * 64 + cc * 2; return st * 1024 + (ob ^ (((ob >> 9) & 1) << 5)); }
__host__ __device__ __forceinline__ void stage_rc(int b, int& R, int& C) { const int st = b / 1024, sb = b % 1024, swz = sb ^ (((sb >> 9) & 1) << 5); R = (st >> 1) * 16 + swz / 64; C = (st & 1) * 32 + (swz % 64) / 2; }
__host__ __device__ __forceinline__ int perm32(int rho) { const int n = rho >> 4, i = rho & 15; return 8 * (i >> 2) + 4 * n + (i & 3); }
struct Unit { const char* pa; const char* pb; int orow, ocol, e, kind; };
struct Gemm { int lda, ldb, K; };
struct StaticOrder {
    static constexpr bool GATHER = false; const int* rowmap;
    const char* A; const char* Bt; size_t ta, tb; int nM, nN, nwg, G, c;
    __device__ void init(const void* A_, int lda, const void* Bt_, int ldb, int M, int N, int G_, int c_) { A = (const char*)A_; Bt = (const char*)Bt_; ta = (size_t)BM * lda * 2; tb = (size_t)BM * ldb * 2; nM = M / BM; nN = N / BM; nwg = nM * nN; G = G_; c = c_; }
    __device__ bool tile(int i, int& pm, int& pn) const {
        const long L = (long)i * G + c; if (L >= nwg) return false;
        int wgid = (int)L; { const int q = nwg / NXCD, r = nwg % NXCD, xcd = wgid % NXCD, off = wgid / NXCD; wgid = (xcd < r ? xcd * (q + 1) : r * (q + 1) + (xcd - r) * q) + off; }
        const int nig = WGM * nN, gid = wgid / nig, fm = gid * WGM, gsz = (nM - fm) < WGM ? (nM - fm) : WGM;
        pm = fm + ((wgid % nig) % gsz); pn = (wgid % nig) / gsz; return true;
    }
    __device__ bool next(int i, Unit& u) const { int pm, pn; if (!tile(i, pm, pn)) return false; u.pa = A + (size_t)pm * ta; u.pb = Bt + (size_t)pn * tb; u.orow = pm * BM; u.ocol = pn * BM; u.e = 0; u.kind = 0; return true; }
    __device__ __forceinline__ int rowof(const Unit&, int r) const { return r; }
    __device__ __forceinline__ void a_ready(const Unit&) const {}
    __device__ __forceinline__ void done(const Unit&) const {}
};
struct EpiStore {
    static constexpr bool PERM = true, AFTER_DRAIN = false;
    bf16_t* O; int ldc;
    __device__ __forceinline__ void operator()(const f32x4 (&acc)[2][2][4][2], const Unit& u, int wr, int wc, int fr, int fq) const {
        const int row0 = u.orow + wr * 64 + fr, col0 = u.ocol + wc * 32 + 8 * fq;
#pragma unroll
        for (int ai = 0; ai < 2; ++ai)
#pragma unroll
            for (int m = 0; m < 4; ++m) { bf16_t* rowp = O + (size_t)(row0 + ai * HALF + m * 16) * ldc + col0;
#pragma unroll
                for (int bj = 0; bj < 2; ++bj) { const f32x4 v0 = acc[ai][bj][m][0], v1 = acc[ai][bj][m][1];
                    u32x4 w; w.x = cvt_pk_bf16(v0[0], v0[1]); w.y = cvt_pk_bf16(v0[2], v0[3]); w.z = cvt_pk_bf16(v1[0], v1[1]); w.w = cvt_pk_bf16(v1[2], v1[3]);
                    *(u32x4*)(rowp + bj * HALF) = w; } }
    }
};
template <class Epi, class Sched, bool ALIGN_EPI = false, bool SP2 = false>
__device__ __forceinline__ void gemm_phase(PG8_LAS unsigned char* lds, const Gemm g, const Sched& S, const Epi& E) {
    const int tid = TIDX(), wid = __builtin_amdgcn_readfirstlane(tid >> 6), lane = tid & 63, wr = wid >> 2, wc = wid & 3, fr = lane & 15, fq = lane >> 4;
    const int K = g.K, nt = K / BK;
    unsigned voffA[2], voffB[2];
#pragma unroll
    for (int i = 0; i < 2; ++i) { int R, C; stage_rc(tid * 16 + i * 8192, R, C); const int Rb = Epi::PERM ? ((R & ~31) + perm32(R & 31)) : R;
        voffA[i] = (unsigned)(R * g.lda + C) * 2u; voffB[i] = (unsigned)(Rb * g.ldb + C) * 2u; }
    unsigned voffG[2][2][2]; int gR[2], gC[2];
#pragma unroll
    for (int i = 0; i < 2; ++i) { int R, C; stage_rc(tid * 16 + i * 8192, R, C); gR[i] = R; gC[i] = C; }
#define PG8_GOFF(dst, unit_) do { if constexpr (Sched::GATHER) { _Pragma("unroll") for (int _h = 0; _h < 2; ++_h) _Pragma("unroll") for (int _i = 0; _i < 2; ++_i) \
        dst[_h][_i] = (unsigned)S.rowof(unit_, (unit_).orow + _h * HALF + gR[_i]) * (unsigned)(g.lda * 2) + (unsigned)gC[_i] * 2u; } } while (0)
#define PG8_STAGE_A(bufoff, gptr, half, vsel) do { if constexpr (Sched::GATHER) { PG8_STAGE(bufoff, gptr, vsel); } else { PG8_STAGE(bufoff, (gptr) + (half) * hstepA, voffA); } } while (0)
    const size_t kstep = (size_t)(BK * 2);
    const size_t hstepA = (size_t)HALF * g.lda * 2, hstepB = (size_t)HALF * g.ldb * 2;
    const unsigned ldsw = (unsigned)wid * 1024u;
    const int aoff = lds_byte(wr * 64 + fr, fq * 8), boff = lds_byte(wc * 32 + fr, fq * 8);
#define PG8_SA(b, h) (((b) * 2 + (h)) * HTB)
#define PG8_SB(b, h) ((4 + (b) * 2 + (h)) * HTB)
#define PG8_STAGE(bufoff, gbase, voff) do { _Pragma("unroll") for (int _i = 0; _i < 2; ++_i) \
        __builtin_amdgcn_global_load_lds((const unsigned*)((const char*)(gbase) + (voff)[_i]), (PG8_LAS unsigned*)(lds + (bufoff) + ldsw + _i * 8192), 16, 0, 0); } while (0)
#define PG8_LDA(dst, b, h) do { _Pragma("unroll") for (int m = 0; m < 4; ++m) _Pragma("unroll") for (int k = 0; k < 2; ++k) dst[m][k] = *(const PG8_LAS bf16x8*)(lds + PG8_SA(b, h) + aoff + m * 2048 + k * 1024); } while (0)
#define PG8_LDB(dst, b, h) do { _Pragma("unroll") for (int n = 0; n < 2; ++n) _Pragma("unroll") for (int k = 0; k < 2; ++k) dst[n][k] = *(const PG8_LAS bf16x8*)(lds + PG8_SB(b, h) + boff + n * 2048 + k * 1024); } while (0)
#define PG8_MMA(ai, bj, At, Bt) do { __builtin_amdgcn_s_setprio(1); _Pragma("unroll") for (int m = 0; m < 4; ++m) _Pragma("unroll") for (int n = 0; n < 2; ++n) _Pragma("unroll") for (int k = 0; k < 2; ++k) \
        acc[ai][bj][m][n] = __builtin_amdgcn_mfma_f32_16x16x32_bf16(Bt[n][k], At[m][k], acc[ai][bj][m][n], 0, 0, 0); __builtin_amdgcn_s_setprio(0); } while (0)
#define PG8_WAIT_V(n) asm volatile("s_waitcnt vmcnt(" #n ")" ::: "memory")
#define PG8_WAIT_L(n) asm volatile("s_waitcnt lgkmcnt(" #n ")" ::: "memory")
#define PG8_BAR __builtin_amdgcn_s_barrier()
#define PG8_SCHED __builtin_amdgcn_sched_barrier(0)
    Unit cur, nxt; int ui = 0;
    if (!S.next(0, cur)) return;
    f32x4 acc[2][2][4][2];
#pragma unroll
    for (int a = 0; a < 2; ++a)
#pragma unroll
        for (int b = 0; b < 2; ++b)
#pragma unroll
            for (int m = 0; m < 4; ++m)
#pragma unroll
                for (int n = 0; n < 2; ++n) acc[a][b][m][n] = (f32x4){0.f, 0.f, 0.f, 0.f};
    bf16x8 At[4][2], B0[2][2], B1[2][2];
    const char* cA = cur.pa; const char* cB = cur.pb;
    S.a_ready(cur);
    PG8_GOFF(voffG[0], cur);
    if constexpr (SP2) {
        PG8_STAGE(PG8_SB(0, 0), cB, voffB); PG8_STAGE(PG8_SB(0, 1), cB + hstepB, voffB); PG8_STAGE_A(PG8_SA(0, 0), cA, 0, voffG[0][0]); PG8_STAGE_A(PG8_SA(0, 1), cA, 1, voffG[0][1]);
        if (wr == 1) PG8_BAR;
        PG8_WAIT_V(2); PG8_BAR;
        PG8_STAGE(PG8_SB(1, 0), cB + kstep, voffB); PG8_STAGE_A(PG8_SA(1, 0), cA + kstep, 0, voffG[0][0]); PG8_STAGE(PG8_SB(1, 1), cB + hstepB + kstep, voffB);
        PG8_WAIT_V(6); PG8_BAR;
    } else {
        PG8_STAGE(PG8_SB(0, 0), cB, voffB); PG8_STAGE_A(PG8_SA(0, 0), cA, 0, voffG[0][0]); PG8_STAGE(PG8_SB(0, 1), cB + hstepB, voffB); PG8_STAGE_A(PG8_SA(0, 1), cA, 1, voffG[0][1]);
        if (wr == 1) PG8_BAR;
        PG8_WAIT_V(4); PG8_BAR;
        PG8_STAGE(PG8_SB(1, 0), cB + kstep, voffB); PG8_STAGE_A(PG8_SA(1, 0), cA + kstep, 0, voffG[0][0]); PG8_STAGE(PG8_SB(1, 1), cB + hstepB + kstep, voffB);
        PG8_WAIT_V(6); PG8_BAR;
    }
    for (;;) {
        const bool has_next = S.next(ui + 1, nxt);
        if constexpr (Sched::GATHER) { if (has_next) { PG8_GOFF(voffG[1], nxt); } else {
#pragma unroll
            for (int _h = 0; _h < 2; ++_h)
#pragma unroll
                for (int _i = 0; _i < 2; ++_i) voffG[1][_h][_i] = voffG[0][_h][_i]; } }
        const char* nA = has_next ? nxt.pa : cA; const char* nB = has_next ? nxt.pb : cB;
        for (int t = 0; t < nt; t += 2) {
            const bool last = (t == nt - 2);
            const char* a1 = cA + (size_t)(t + 1) * kstep;
            const char* a2 = last ? nA : cA + (size_t)(t + 2) * kstep; const char* b2 = last ? nB : cB + (size_t)(t + 2) * kstep;
            const char* a3 = a2 + kstep; const char* b3 = b2 + kstep;
            unsigned vs0[2], vs1[2];
#pragma unroll
            for (int _i = 0; _i < 2; ++_i) { vs0[_i] = last ? voffG[1][0][_i] : voffG[0][0][_i]; vs1[_i] = last ? voffG[1][1][_i] : voffG[0][1][_i]; }
            if (last && has_next) S.a_ready(nxt);
            if constexpr (SP2) {
            PG8_LDB(B0, 0, 0); PG8_LDB(B1, 0, 1); PG8_SCHED; PG8_LDA(At, 0, 0); PG8_STAGE_A(PG8_SA(1, 1), a1, 1, voffG[0][1]);
            PG8_WAIT_V(8); PG8_WAIT_L(0); PG8_BAR; PG8_MMA(0, 0, At, B0); PG8_MMA(0, 1, At, B1); PG8_BAR; PG8_SCHED;
            PG8_LDA(At, 0, 1); PG8_STAGE(PG8_SB(0, 0), b2, voffB); PG8_STAGE(PG8_SB(0, 1), b2 + hstepB, voffB); PG8_STAGE_A(PG8_SA(0, 0), a2, 0, vs0);
            PG8_WAIT_V(8); PG8_WAIT_L(0); PG8_BAR; PG8_MMA(1, 0, At, B0); PG8_MMA(1, 1, At, B1); PG8_BAR; PG8_SCHED;
            PG8_LDB(B0, 1, 0); PG8_LDB(B1, 1, 1); PG8_SCHED; PG8_LDA(At, 1, 0); PG8_STAGE_A(PG8_SA(0, 1), a2, 1, vs1);
            PG8_WAIT_V(8); PG8_WAIT_L(0); PG8_BAR; PG8_MMA(0, 0, At, B0); PG8_MMA(0, 1, At, B1); PG8_BAR; PG8_SCHED;
            PG8_LDA(At, 1, 1); PG8_STAGE(PG8_SB(1, 0), b3, voffB); PG8_STAGE(PG8_SB(1, 1), b3 + hstepB, voffB); PG8_STAGE_A(PG8_SA(1, 0), a3, 0, vs0);
            PG8_WAIT_V(8); PG8_WAIT_L(0); PG8_BAR; PG8_MMA(1, 0, At, B0); PG8_MMA(1, 1, At, B1); PG8_BAR; PG8_SCHED;
            } else {
            PG8_LDB(B0, 0, 0); PG8_SCHED; PG8_LDA(At, 0, 0); PG8_STAGE_A(PG8_SA(1, 1), a1, 1, voffG[0][1]);
            PG8_WAIT_L(8); PG8_BAR; PG8_WAIT_L(0); PG8_MMA(0, 0, At, B0); PG8_BAR; PG8_SCHED;
            PG8_LDB(B1, 0, 1); PG8_STAGE(PG8_SB(0, 0), b2, voffB);
            PG8_BAR; PG8_WAIT_L(0); PG8_MMA(0, 1, At, B1); PG8_BAR;
            PG8_LDA(At, 0, 1); PG8_STAGE_A(PG8_SA(0, 0), a2, 0, vs0);
            PG8_BAR; PG8_WAIT_L(0); PG8_MMA(1, 0, At, B0); PG8_BAR; PG8_SCHED;
            PG8_STAGE(PG8_SB(0, 1), b2 + hstepB, voffB);
            PG8_WAIT_V(6); PG8_BAR; PG8_MMA(1, 1, At, B1); PG8_BAR;
            PG8_LDB(B0, 1, 0); PG8_SCHED; PG8_LDA(At, 1, 0); PG8_STAGE_A(PG8_SA(0, 1), a2, 1, vs1);
            PG8_WAIT_L(8); PG8_BAR; PG8_WAIT_L(0); PG8_MMA(0, 0, At, B0); PG8_BAR; PG8_SCHED;
            PG8_LDB(B1, 1, 1); PG8_STAGE(PG8_SB(1, 0), b3, voffB);
            PG8_BAR; PG8_WAIT_L(0); PG8_MMA(0, 1, At, B1); PG8_BAR;
            PG8_LDA(At, 1, 1); PG8_STAGE_A(PG8_SA(1, 0), a3, 0, vs0);
            PG8_BAR; PG8_WAIT_L(0); PG8_MMA(1, 0, At, B0); PG8_BAR; PG8_SCHED;
            PG8_STAGE(PG8_SB(1, 1), b3 + hstepB, voffB);
            PG8_WAIT_V(6); PG8_BAR; PG8_MMA(1, 1, At, B1); PG8_BAR;
            }
        }
        if constexpr (ALIGN_EPI) { if (wr == 0) PG8_BAR; }
        if constexpr (!Epi::AFTER_DRAIN) { E(acc, cur, wr, wc, fr, fq); S.done(cur); }
        if (!has_next) break;
#pragma unroll
        for (int a = 0; a < 2; ++a)
#pragma unroll
            for (int b = 0; b < 2; ++b)
#pragma unroll
                for (int m = 0; m < 4; ++m)
#pragma unroll
                    for (int n = 0; n < 2; ++n) acc[a][b][m][n] = (f32x4){0.f, 0.f, 0.f, 0.f};
        cur = nxt; cA = nA; cB = nB; ++ui;
        if constexpr (Sched::GATHER) {
#pragma unroll
            for (int _h = 0; _h < 2; ++_h)
#pragma unroll
                for (int _i = 0; _i < 2; ++_i) voffG[0][_h][_i] = voffG[1][_h][_i]; }
        if constexpr (ALIGN_EPI) { if (wr == 1) PG8_BAR; }
    }
    PG8_WAIT_V(0);
    if constexpr (!ALIGN_EPI) { if (wr == 0) PG8_BAR; }
    PG8_BAR;
    if constexpr (Epi::AFTER_DRAIN) { E.fused(acc, cur, wr, wc, fr, fq, lds, wid, lane); S.done(cur); }
#undef PG8_SA
#undef PG8_SB
#undef PG8_STAGE
#undef PG8_STAGE_A
#undef PG8_GOFF
#undef PG8_LDA
#undef PG8_LDB
#undef PG8_MMA
#undef PG8_WAIT_V
#undef PG8_WAIT_L
#undef PG8_BAR
#undef PG8_SCHED
}

}
#define WSYNC2() asm volatile("s_waitcnt lgkmcnt(0)" ::: "memory")
struct MoeBufs { int* tok_e; float* tok_g; int* slot_of; float* slot_gate; int* blk_e; int* blkcnt; int* nblk; int* slot_tok; };
constexpr int WRT_LD = 1028;

template <bool XB, int MODE = 0> __device__ __forceinline__ void ph_ln_router(const void* xin_, const bf16_t* hb, const float* g, const float* bb, const float* wr, const float* br, bf16_t* x1b, const MoeBufs m, float* lds) {
  const float* xin = (const float*)xin_; const bf16_t* xinb = (const bf16_t*)xin_;
  for (int i = BIDX() * NTHR + TIDX(); i < PMAX; i += (int)gridDim.x * NTHR) m.slot_tok[i] = 0;
  const int tid = TIDX(), lane = tid & 63, wave = tid >> 6, blk = BIDX();
  float* wT = lds;
  float* lg = lds + 32 * WRT_LD + wave * 64;
  int* cnt = (int*)(lds + 32 * WRT_LD + 8 * 64);
  { f32x4 wv[16];
#pragma unroll
    for (int k = 0; k < 16; ++k) wv[k] = *(const f32x4*)(wr + (size_t)(tid + NTHR * k) * 4);
#pragma unroll
    for (int k = 0; k < 16; ++k) { const int i = (tid + NTHR * k) * 4, d = i >> 5, e = i & 31;
#pragma unroll
      for (int z = 0; z < 4; ++z) wT[(e + z) * WRT_LD + d] = wv[k][z]; } }
  if (tid < 32) cnt[tid] = 0;
  __syncthreads();
#pragma unroll 1
  for (int it = 0; it < 8; it += 2) {
    const int tok0 = blk * 64 + wave * 8 + it;
    f32x4 v[2][4]; float s[2] = {0.f, 0.f};
#pragma unroll
    for (int q = 0; q < 2; ++q)
#pragma unroll
      for (int j = 0; j < 4; ++j) { const int c = lane * 4 + 256 * j; f32x4 a;
        if (XB) { const v2u xv = *(const v2u*)(xinb + (size_t)(tok0 + q) * D + c); a = (f32x4){bf_lo(xv[0]), bf_hi(xv[0]), bf_lo(xv[1]), bf_hi(xv[1])}; } else a = *(const f32x4*)(xin + (size_t)(tok0 + q) * D + c);
        const v2u hh = *(const v2u*)(hb + (size_t)(tok0 + q) * D + c);
        v[q][j] = (f32x4){ALPHA * a[0] + bf_lo(hh[0]), ALPHA * a[1] + bf_hi(hh[0]), ALPHA * a[2] + bf_lo(hh[1]), ALPHA * a[3] + bf_hi(hh[1])}; s[q] += (v[q][j][0] + v[q][j][1]) + (v[q][j][2] + v[q][j][3]); }
#pragma unroll
    for (int o = 1; o < 64; o <<= 1) { s[0] += __shfl_xor(s[0], o); s[1] += __shfl_xor(s[1], o); }
    float qq[2] = {0.f, 0.f};
#pragma unroll
    for (int q = 0; q < 2; ++q) { const float mu = s[q] * (1.f / D);
#pragma unroll
      for (int j = 0; j < 4; ++j) { v[q][j] = v[q][j] - mu; qq[q] += (v[q][j][0] * v[q][j][0] + v[q][j][1] * v[q][j][1]) + (v[q][j][2] * v[q][j][2] + v[q][j][3] * v[q][j][3]); } }
#pragma unroll
    for (int o = 1; o < 64; o <<= 1) { qq[0] += __shfl_xor(qq[0], o); qq[1] += __shfl_xor(qq[1], o); }
#pragma unroll
    for (int q = 0; q < 2; ++q) { const float r = rsqrtf(qq[q] * (1.f / D) + 1e-5f);
#pragma unroll
      for (int j = 0; j < 4; ++j) { const int c = lane * 4 + 256 * j; const f32x4 g4 = *(const f32x4*)(g + c), b4 = *(const f32x4*)(bb + c); v[q][j] = v[q][j] * r * g4 + b4; *(v2u*)(x1b + (size_t)(tok0 + q) * D + c) = (v2u){cvt_pk_bf16(v[q][j][0], v[q][j][1]), cvt_pk_bf16(v[q][j][2], v[q][j][3])}; } }
    if (MODE == 1) continue;
    float p[2][32];
    { const float* wl = wT + lane * 4; f32x4 wb[2][4];
#pragma unroll
      for (int j = 0; j < 4; ++j) wb[0][j] = *(const f32x4*)(wl + 256 * j);
#pragma unroll
      for (int e = 0; e < 32; ++e) {
        if (e < 31) {
#pragma unroll
          for (int j = 0; j < 4; ++j) wb[(e + 1) & 1][j] = *(const f32x4*)(wl + (e + 1) * WRT_LD + 256 * j); }
        __builtin_amdgcn_sched_barrier(0);
        f32x2_t a0 = {0.f, 0.f}, a1 = {0.f, 0.f};
#pragma unroll
        for (int j = 0; j < 4; ++j) { const f32x4 w4 = wb[e & 1][j]; const f32x2_t wlo = {w4[0], w4[1]}, whi = {w4[2], w4[3]};
          a0 = __builtin_elementwise_fma((f32x2_t){v[0][j][0], v[0][j][1]}, wlo, a0); a0 = __builtin_elementwise_fma((f32x2_t){v[0][j][2], v[0][j][3]}, whi, a0);
          a1 = __builtin_elementwise_fma((f32x2_t){v[1][j][0], v[1][j][1]}, wlo, a1); a1 = __builtin_elementwise_fma((f32x2_t){v[1][j][2], v[1][j][3]}, whi, a1); }
        p[0][e] = a0[0] + a0[1]; p[1][e] = a1[0] + a1[1];
        __builtin_amdgcn_sched_barrier(0);
      } }
#pragma unroll
    for (int i = 0; i < 16; ++i) { const bool hi = (lane & 32) != 0;
#pragma unroll
      for (int q = 0; q < 2; ++q) { const float send = hi ? p[q][i] : p[q][i + 16]; const float keep = hi ? p[q][i + 16] : p[q][i]; p[q][i] = keep + __shfl_xor(send, 32); } }
#pragma unroll
    for (int i = 0; i < 8; ++i) { const bool hi = (lane & 16) != 0;
#pragma unroll
      for (int q = 0; q < 2; ++q) { const float send = hi ? p[q][i] : p[q][i + 8]; const float keep = hi ? p[q][i + 8] : p[q][i]; p[q][i] = keep + __shfl_xor(send, 16); } }
#pragma unroll
    for (int i = 0; i < 4; ++i) { const bool hi = (lane & 8) != 0;
#pragma unroll
      for (int q = 0; q < 2; ++q) { const float send = hi ? p[q][i] : p[q][i + 4]; const float keep = hi ? p[q][i + 4] : p[q][i]; p[q][i] = keep + __shfl_xor(send, 8); } }
#pragma unroll
    for (int i = 0; i < 2; ++i) { const bool hi = (lane & 4) != 0;
#pragma unroll
      for (int q = 0; q < 2; ++q) { const float send = hi ? p[q][i] : p[q][i + 2]; const float keep = hi ? p[q][i + 2] : p[q][i]; p[q][i] = keep + __shfl_xor(send, 4); } }
#pragma unroll
    for (int q = 0; q < 2; ++q) { const bool hi = (lane & 2) != 0; const float send = hi ? p[q][0] : p[q][1]; const float keep = hi ? p[q][1] : p[q][0]; p[q][0] = keep + __shfl_xor(send, 2); }
    p[0][0] += __shfl_xor(p[0][0], 1); p[1][0] += __shfl_xor(p[1][0], 1);
    const int e_l = ((lane >> 5) & 1) * 16 + ((lane >> 4) & 1) * 8 + ((lane >> 3) & 1) * 4 + ((lane >> 2) & 1) * 2 + ((lane >> 1) & 1);
    const float brl = br[e_l];
    float lv[2] = {p[0][0] + brl, p[1][0] + brl}; int ei[2][4]; float ev[2][4];
    if (MODE == 2) for (int k = 1; k < 4; ++k) { ei[0][k] = ei[1][k] = k; ev[0][k] = ev[1][k] = 0.f; }
#pragma unroll
    for (int k = 0; k < (MODE == 2 ? 1 : 4); ++k) { float bv[2] = {lv[0], lv[1]}; int bi[2] = {e_l, e_l};
#pragma unroll
      for (int o = 2; o < 64; o <<= 1)
#pragma unroll
        for (int q = 0; q < 2; ++q) { const float ov = __shfl_xor(bv[q], o); const int oi = __shfl_xor(bi[q], o); const bool take = (ov > bv[q]) || (ov == bv[q] && oi < bi[q]); bv[q] = take ? ov : bv[q]; bi[q] = take ? oi : bi[q]; }
#pragma unroll
      for (int q = 0; q < 2; ++q) { ei[q][k] = bi[q]; ev[q][k] = bv[q]; if (e_l == bi[q]) lv[q] = -INFINITY; } }
    if (lane < 2) { const int q = lane;
      float ex[4], su = 0.f;
#pragma unroll
      for (int k = 0; k < 4; ++k) { ex[k] = __expf((q ? ev[1][k] : ev[0][k]) - (q ? ev[1][0] : ev[0][0])); su += ex[k]; }
      const float inv = 1.f / su; const int tok = tok0 + q;
      const int e0 = q ? ei[1][0] : ei[0][0], e1 = q ? ei[1][1] : ei[0][1], e2 = q ? ei[1][2] : ei[0][2], e3 = q ? ei[1][3] : ei[0][3];
      *(int4*)(m.tok_e + tok * 4) = make_int4(e0, e1, e2, e3);
      *(float4*)(m.tok_g + tok * 4) = make_float4(ex[0] * inv, ex[1] * inv, ex[2] * inv, ex[3] * inv);
      atomicAdd(&cnt[e0], 1); atomicAdd(&cnt[e1], 1); atomicAdd(&cnt[e2], 1); atomicAdd(&cnt[e3], 1); }
  }
  __syncthreads();
  if (tid < 32) m.blkcnt[blk * 32 + tid] = cnt[tid];
  __syncthreads();
}

__device__ __forceinline__ void ph_moe_scatter(const MoeBufs m, int* ilds) {
  const int tid = TIDX(), lane = tid & 63, wave = tid >> 6, blk = BIDX(); (void)lane;
  int* tot = ilds; int* bef = ilds + 32; int* pst = ilds + 64; int* es = ilds + 128; int* rk = ilds + 384; int* sl = ilds + 640; int* part = ilds + 896; int* wcnt = ilds + 1408;
  { const int e = tid & 31, pa = tid >> 5; int sum = 0;
#pragma unroll
    for (int q = 0; q < 16; ++q) sum += m.blkcnt[(pa * 16 + q) * 32 + e];
    part[pa * 32 + e] = sum; }
  if (tid < 256) es[tid] = m.tok_e[blk * 256 + tid];
  __syncthreads();
  if (tid < 32) { const int e = tid; int t_ = 0, b_ = 0; const int pb_ = blk >> 4;
    for (int q = 0; q < 16; ++q) { const int v = part[q * 32 + e]; t_ += v; if (q < pb_) b_ += v; }
    for (int q = pb_ * 16; q < blk; ++q) b_ += m.blkcnt[q * 32 + e];
    tot[e] = t_; bef[e] = b_; }
  if (tid < 256) { const int e = es[tid]; const unsigned long long lt = (1ull << lane) - 1ull; int r = 0;
    for (int ee = 0; ee < 32; ++ee) { const unsigned long long mk = __ballot(e == ee); if (e == ee) r = __builtin_popcountll(mk & lt); if (lane == ee) wcnt[wave * 32 + ee] = __builtin_popcountll(mk); }
    rk[tid] = r; }
  __syncthreads();
  if (tid == 0) { int acc = 0; for (int e = 0; e < 32; ++e) { pst[e] = acc; acc += ((tot[e] + 255) >> 8) << 8; } pst[32] = acc;
    if (blk == 0) { *m.nblk = acc >> 8; for (int e = 0; e < 32; ++e) for (int q = pst[e] >> 8; q < (pst[e + 1] >> 8); ++q) m.blk_e[q] = e; } }
  __syncthreads();
  if (tid < 256) { const int e = es[tid]; int rank = rk[tid]; for (int w2 = 0; w2 < wave; ++w2) rank += wcnt[w2 * 32 + e];
    const int slot = pst[e] + bef[e] + rank; m.slot_of[blk * 256 + tid] = slot; m.slot_gate[slot] = m.tok_g[blk * 256 + tid]; m.slot_tok[slot] = blk * 64 + (tid >> 2); }
  __syncthreads();
  __syncthreads();
}

__device__ __forceinline__ void ph_combine_ln(const bf16_t* x1b, const bf16_t* Ys, const int* slot_of, const float* g, const float* bb, float* out, bf16_t* outb) {
  const int tid = TIDX(), lane = tid & 63, gw = BIDX() * 8 + (tid >> 6), NGW = (int)gridDim.x * 8;
  for (int row = gw; row < NT; row += NGW) {
    const int4 s4 = *(const int4*)(slot_of + row * 4); const int sl[4] = {s4.x, s4.y, s4.z, s4.w};
    f32x4 v[4]; float s = 0.f;
#pragma unroll
    for (int j = 0; j < 4; ++j) { const int c = lane * 4 + 256 * j; f32x4 f = (f32x4){0.f, 0.f, 0.f, 0.f};
#pragma unroll
      for (int k = 0; k < 4; ++k) { const v2u y = *(const v2u*)(Ys + (size_t)sl[k] * D + c); f += (f32x4){bf_lo(y[0]), bf_hi(y[0]), bf_lo(y[1]), bf_hi(y[1])}; }
      const v2u xv = *(const v2u*)(x1b + (size_t)row * D + c); const f32x4 a = (f32x4){bf_lo(xv[0]), bf_hi(xv[0]), bf_lo(xv[1]), bf_hi(xv[1])}; v[j] = a * ALPHA + f; s += (v[j][0] + v[j][1]) + (v[j][2] + v[j][3]); }
    const float mu = wave_sum(s) * (1.f / D); float q = 0.f;
#pragma unroll
    for (int j = 0; j < 4; ++j) { v[j] = v[j] - mu; q += (v[j][0] * v[j][0] + v[j][1] * v[j][1]) + (v[j][2] * v[j][2] + v[j][3] * v[j][3]); }
    const float r = rsqrtf(wave_sum(q) * (1.f / D) + 1e-5f);
#pragma unroll
    for (int j = 0; j < 4; ++j) { const int c = lane * 4 + 256 * j; const f32x4 g4 = *(const f32x4*)(g + c), b4 = *(const f32x4*)(bb + c); const f32x4 o = v[j] * r * g4 + b4;
      if (out) *(f32x4*)(out + (size_t)row * D + c) = o; if (outb) *(v2u*)(outb + (size_t)row * D + c) = (v2u){cvt_pk_bf16(o[0], o[1]), cvt_pk_bf16(o[2], o[3])}; }
  }
}

namespace pg8 {
template <bool GATHER_> struct MoeOrderT {
    static constexpr bool GATHER = GATHER_; const int* rowmap;
    StaticOrder so; const int* blk_e; const char* W; size_t wexp; int obn;
    __device__ void init(const void* A, int lda, const void* W_, int ldb, size_t wexp_, int nM, int nN, int obn_, const int* blk_e_, int G, int c) { so.init(A, lda, W_, ldb, nM * BM, nN * BM, G, c); blk_e = blk_e_; W = (const char*)W_; wexp = wexp_; obn = obn_; }
    __device__ bool next(int i, Unit& u) const { int pm, pn; if (!so.tile(i, pm, pn)) return false; const int e = __builtin_amdgcn_readfirstlane(blk_e[pm]); u.pa = GATHER_ ? so.A : so.A + (size_t)pm * so.ta; u.pb = W + (size_t)e * wexp + (size_t)pn * so.tb; u.orow = pm * BM; u.ocol = pn * obn; u.e = e; u.kind = 0; return true; }
    __device__ __forceinline__ int rowof(const Unit&, int r) const { return GATHER_ ? rowmap[r] : r; }
    __device__ __forceinline__ void a_ready(const Unit&) const {}
    __device__ __forceinline__ void done(const Unit&) const {}
};
typedef MoeOrderT<false> MoeOrder; typedef MoeOrderT<true> MoeOrderG;
struct EpiSwiglu {
    static constexpr bool PERM = true, AFTER_DRAIN = false;
    bf16_t* O; int ldc; const float* b1;
    __device__ __forceinline__ void operator()(const f32x4 (&acc)[2][2][4][2], const Unit& u, int wr, int wc, int fr, int fq) const {
        const int row0 = u.orow + wr * 64 + fr, cl = wc * 32 + 8 * fq, col0 = u.ocol + cl;
        const float* bg = b1 + (size_t)u.e * 2048 + col0; const float* bu = bg + 1024;
        const f32x4 bg0 = *(const f32x4*)bg, bg1 = *(const f32x4*)(bg + 4), bu0 = *(const f32x4*)bu, bu1 = *(const f32x4*)(bu + 4);
#pragma unroll
        for (int ai = 0; ai < 2; ++ai)
#pragma unroll
            for (int m = 0; m < 4; ++m) {
                f32x4 gv[2] = {acc[ai][0][m][0] + bg0, acc[ai][0][m][1] + bg1}, uv[2] = {acc[ai][1][m][0] + bu0, acc[ai][1][m][1] + bu1}; float o[8];
#pragma unroll
                for (int n = 0; n < 2; ++n)
#pragma unroll
                    for (int i = 0; i < 4; ++i) { const float gg = fminf(gv[n][i], 7.f), uu = fminf(fmaxf(uv[n][i], -7.f), 7.f);
                        const float sg = __builtin_amdgcn_rcpf(1.f + __builtin_amdgcn_exp2f(-1.702f * 1.4426950408889634f * gg)); o[4 * n + i] = (uu + 1.f) * gg * sg; }
                u32x4 w; w.x = cvt_pk_bf16(o[0], o[1]); w.y = cvt_pk_bf16(o[2], o[3]); w.z = cvt_pk_bf16(o[4], o[5]); w.w = cvt_pk_bf16(o[6], o[7]);
                *(u32x4*)(O + (size_t)(row0 + ai * HALF + m * 16) * ldc + col0) = w; asm volatile("" ::: "memory"); }
    }
};
struct EpiMoe2 {
    static constexpr bool PERM = true, AFTER_DRAIN = false;
    bf16_t* O; int ldc; const float* b2; const float* gate;
    __device__ __forceinline__ void operator()(const f32x4 (&acc)[2][2][4][2], const Unit& u, int wr, int wc, int fr, int fq) const {
        const int row0 = u.orow + wr * 64 + fr, col0 = u.ocol + wc * 32 + 8 * fq;
        const float* bp = b2 + (size_t)u.e * 1024 + col0;
#pragma unroll
        for (int bj = 0; bj < 2; ++bj) {
            const f32x4 bv0 = *(const f32x4*)(bp + bj * HALF), bv1 = *(const f32x4*)(bp + bj * HALF + 4);
#pragma unroll
            for (int ai = 0; ai < 2; ++ai)
#pragma unroll
                for (int m = 0; m < 4; ++m) { const int row = row0 + ai * HALF + m * 16; const float gt = gate[row];
                    const f32x4 v0 = (acc[ai][bj][m][0] + bv0) * gt, v1 = (acc[ai][bj][m][1] + bv1) * gt;
                    u32x4 w; w.x = cvt_pk_bf16(v0[0], v0[1]); w.y = cvt_pk_bf16(v0[2], v0[3]); w.z = cvt_pk_bf16(v1[0], v1[1]); w.w = cvt_pk_bf16(v1[2], v1[3]);
                    *(u32x4*)(O + (size_t)row * ldc + col0 + bj * HALF) = w; asm volatile("" ::: "memory"); }
        }
    }
};

struct MoeFusedOrder {
    static constexpr bool GATHER = true;
    const int* rowmap; const int* blk_e; const char* X; const char* ACT; const char* W1; const char* W2; unsigned* ready; unsigned* tmo; int nblk, NG, G, c, total, mode;
    __device__ void init(const void* X_, const void* ACT_, const void* W1_, const void* W2_, const int* rowmap_, const int* blk_e_, unsigned* ready_, unsigned* tmo_, int nblk_, int G_, int c_) {
        X = (const char*)X_; ACT = (const char*)ACT_; W1 = (const char*)W1_; W2 = (const char*)W2_; rowmap = rowmap_; blk_e = blk_e_; ready = ready_; tmo = tmo_; nblk = nblk_; NG = (nblk_ + 31) >> 5; G = G_; c = c_; total = nblk_ * 12; }
    __device__ bool next(int i, Unit& u) const {
        int Lq = i * G + c; if (Lq >= total) return false;
#if defined(FUSE_SPLIT)
        if (c >= 0) { const int kind = mode - 1; if (Lq >= nblk * (kind ? 4 : 8)) return false; const int q = Lq; const int pm = q % nblk, pn = q / nblk, e = __builtin_amdgcn_readfirstlane(blk_e[pm]);
          u.kind = kind; u.e = e; u.orow = pm * BM;
          if (kind == 0) { u.pa = X; u.pb = W1 + ((size_t)e * 2048 + (size_t)pn * 256) * 2048; u.ocol = pn * 128; }
          else { u.pa = ACT; u.pb = W2 + ((size_t)e * 1024 + (size_t)pn * 256) * 2048; u.ocol = pn * 256; }
          return true; }
#endif
#if defined(FUSE_SERIAL)
        { const int n1 = nblk * 8; int kind = Lq < n1 ? 0 : 1; int q = kind ? Lq - n1 : Lq; const int pm = q % nblk, pn = q / nblk, e = __builtin_amdgcn_readfirstlane(blk_e[pm]);
          u.kind = kind; u.e = e; u.orow = pm * BM;
          if (kind == 0) { u.pa = X; u.pb = W1 + ((size_t)e * 2048 + (size_t)pn * 256) * 2048; u.ocol = pn * 128; }
          else { u.pa = ACT; u.pb = W2 + ((size_t)e * 1024 + (size_t)pn * 256) * 2048; u.ocol = pn * 256; }
          return true; }
#endif
        int kind = 0, g = 0;
        for (int sgm = 0; ; ++sgm) {
            if (sgm < 3) { kind = 0; g = sgm; }
            else if (sgm < 3 + 2 * (NG - 3)) { const int j = (sgm - 3) >> 1; if (((sgm - 3) & 1) == 0) { kind = 0; g = j + 3; } else { kind = 1; g = j; } }
            else { kind = 1; g = NG - 3 + (sgm - (3 + 2 * (NG - 3))); }
            const int mg = min(32, nblk - 32 * g), sz = mg * (kind ? 4 : 8);
            if (Lq < sz) { const int pm = 32 * g + Lq % mg, pn = Lq / mg, e = __builtin_amdgcn_readfirstlane(blk_e[pm]);
                u.kind = kind; u.e = e; u.orow = pm * BM;
                if (kind == 0) { u.pa = X; u.pb = W1 + ((size_t)e * 2048 + (size_t)pn * 256) * 2048; u.ocol = pn * 128; }
                else { u.pa = ACT; u.pb = W2 + ((size_t)e * 1024 + (size_t)pn * 256) * 2048; u.ocol = pn * 256; }
                return true; }
            Lq -= sz;
        }
    }
    __device__ __forceinline__ int rowof(const Unit& u, int r) const { return u.kind == 0 ? rowmap[r] : r; }
    __device__ __forceinline__ void a_ready(const Unit& u) const {
        if (u.kind == 0) return;
#if defined(FUSE_SPLIT)
        return;
#endif
        if (threadIdx.x < 64) {
#if defined(FUSE_GLOBAL_WAIT)
            const unsigned long long t0 = __builtin_amdgcn_s_memrealtime(); unsigned polls = 0; unsigned* rp = ready + 64 * 500; const unsigned want = (unsigned)nblk * 64u;
#else
            const unsigned long long t0 = __builtin_amdgcn_s_memrealtime(); unsigned polls = 0; unsigned* rp = ready + 64 * (u.orow >> 8); const unsigned want = 64u;
#endif
            while ((unsigned)__builtin_amdgcn_readfirstlane(__hip_atomic_load(rp, __ATOMIC_RELAXED, __HIP_MEMORY_SCOPE_AGENT)) < want) {
                if ((++polls & 255u) == 0u && __builtin_amdgcn_readfirstlane(__hip_atomic_load(tmo, __ATOMIC_RELAXED, __HIP_MEMORY_SCOPE_AGENT)) != 0u) break;
                if (__builtin_amdgcn_s_memrealtime() - t0 > 2000000ull) { if (threadIdx.x == 0) __hip_atomic_store(tmo, 1u, __ATOMIC_RELAXED, __HIP_MEMORY_SCOPE_AGENT); break; }
                __builtin_amdgcn_s_sleep(2); }
#if defined(FUSE_CONSUMER_WB)
            __builtin_amdgcn_fence(__ATOMIC_RELEASE, "agent"); asm volatile("s_waitcnt vmcnt(0)" ::: "memory");
#endif
#if defined(FUSE_DELAY)
            { const unsigned long long t1 = __builtin_amdgcn_s_memrealtime(); while (__builtin_amdgcn_s_memrealtime() - t1 < 2000ull) __builtin_amdgcn_s_sleep(8); }
#endif
            __builtin_amdgcn_fence(__ATOMIC_ACQUIRE, "agent");
            asm volatile("s_waitcnt vmcnt(0)" ::: "memory");
        }
        asm volatile("" ::: "memory"); __builtin_amdgcn_s_barrier(); asm volatile("" ::: "memory");
    }
    __device__ __forceinline__ void done(const Unit& u) const {
        if (u.kind != 0) return;
        asm volatile("s_waitcnt vmcnt(0)" ::: "memory");
#if defined(FUSE_HEAVY_RELEASE)
        __builtin_amdgcn_fence(__ATOMIC_RELEASE, "agent"); asm volatile("s_waitcnt vmcnt(0)" ::: "memory");
#endif
#if defined(FUSE_GLOBAL_WAIT)
        if ((threadIdx.x & 63) == 0) __hip_atomic_fetch_add(ready + 64 * 500, 1u, __ATOMIC_RELAXED, __HIP_MEMORY_SCOPE_AGENT);
#else
        if ((threadIdx.x & 63) == 0) __hip_atomic_fetch_add(ready + 64 * (u.orow >> 8), 1u, __ATOMIC_RELAXED, __HIP_MEMORY_SCOPE_AGENT);
#endif
    }
};
__device__ __forceinline__ void store16_sc1(void* p, u32x4 v) { asm volatile("global_store_dwordx4 %0, %1, off sc1\n\ts_nop 1" :: "v"(p), "v"(v) : "memory"); }
struct EpiMoeFused {
    static constexpr bool PERM = true, AFTER_DRAIN = false;
    bf16_t* ACTo; const float* b1; bf16_t* Yo; const float* b2; const float* gate;
    __device__ __forceinline__ void operator()(const f32x4 (&acc)[2][2][4][2], const Unit& u, int wr, int wc, int fr, int fq) const {
        if (u.kind == 0) {
            const int row0 = u.orow + wr * 64 + fr, cl = wc * 32 + 8 * fq, col0 = u.ocol + cl;
            const float* bg = b1 + (size_t)u.e * 2048 + col0; const float* bu = bg + 1024;
            const f32x4 bg0 = *(const f32x4*)bg, bg1 = *(const f32x4*)(bg + 4), bu0 = *(const f32x4*)bu, bu1 = *(const f32x4*)(bu + 4);
#pragma unroll
            for (int ai = 0; ai < 2; ++ai)
#pragma unroll
                for (int m = 0; m < 4; ++m) {
                    f32x4 gv[2] = {acc[ai][0][m][0] + bg0, acc[ai][0][m][1] + bg1}, uv[2] = {acc[ai][1][m][0] + bu0, acc[ai][1][m][1] + bu1}; float o[8];
#pragma unroll
                    for (int n = 0; n < 2; ++n)
#pragma unroll
                        for (int i = 0; i < 4; ++i) { const float gg = fminf(gv[n][i], 7.f), uu = fminf(fmaxf(uv[n][i], -7.f), 7.f);
                            const float sg = __builtin_amdgcn_rcpf(1.f + __builtin_amdgcn_exp2f(-1.702f * 1.4426950408889634f * gg)); o[4 * n + i] = (uu + 1.f) * gg * sg; }
                    u32x4 w; w.x = cvt_pk_bf16(o[0], o[1]); w.y = cvt_pk_bf16(o[2], o[3]); w.z = cvt_pk_bf16(o[4], o[5]); w.w = cvt_pk_bf16(o[6], o[7]);
#if defined(FUSE_PLAIN_STORE)
                    *(u32x4*)(ACTo + (size_t)(row0 + ai * HALF + m * 16) * 1024 + col0) = w; }
#else
                    store16_sc1(ACTo + (size_t)(row0 + ai * HALF + m * 16) * 1024 + col0, w); }
#endif
        } else {
            const int row0 = u.orow + wr * 64 + fr, col0 = u.ocol + wc * 32 + 8 * fq;
            const float* bp = b2 + (size_t)u.e * 1024 + col0;
#pragma unroll
            for (int bj = 0; bj < 2; ++bj) {
                const f32x4 bv0 = *(const f32x4*)(bp + bj * HALF), bv1 = *(const f32x4*)(bp + bj * HALF + 4);
#pragma unroll
                for (int ai = 0; ai < 2; ++ai)
#pragma unroll
                    for (int m = 0; m < 4; ++m) { const int row = row0 + ai * HALF + m * 16; const float gt = gate[row];
                        const f32x4 v0 = (acc[ai][bj][m][0] + bv0) * gt, v1 = (acc[ai][bj][m][1] + bv1) * gt;
                        u32x4 w; w.x = cvt_pk_bf16(v0[0], v0[1]); w.y = cvt_pk_bf16(v0[2], v0[3]); w.z = cvt_pk_bf16(v1[0], v1[1]); w.w = cvt_pk_bf16(v1[2], v1[3]);
                        *(u32x4*)(Yo + (size_t)row * 1024 + col0 + bj * HALF) = w; asm volatile("" ::: "memory"); }
            }
        }
    }
};
}
typedef short v4i16_t __attribute__((ext_vector_type(4)));
__device__ __forceinline__ unsigned f2key_u(float f) { f = f + 0.0f; const unsigned u = __float_as_uint(f); return (u & 0x80000000u) ? ~u : (u | 0x80000000u); }

__device__ __forceinline__ void ph_cnorm_b(const bf16_t* pa, const float* g, bf16_t* cnb) {
  const int tid = TIDX(), lane = tid & 63, gw = BIDX() * 8 + (tid >> 6), NGW = (int)gridDim.x * 8;
  const f32x4 g4 = *(const f32x4*)(g + lane * 4);
  for (int row = gw; row < NT; row += NGW) {
    const v2u v = *(const v2u*)(pa + (size_t)row * 2048 + 1024 + lane * 4);
    const f32x4 f = (f32x4){bf_lo(v[0]), bf_hi(v[0]), bf_lo(v[1]), bf_hi(v[1])};
    const float r = rsqrtf(wave_sum((f[0] * f[0] + f[1] * f[1]) + (f[2] * f[2] + f[3] * f[3])) * (1.f / 256.f) + 1e-6f);
    const f32x4 o = f * r * g4;
    *(v2u*)(cnb + (size_t)row * 256 + lane * 4) = (v2u){cvt_pk_bf16(o[0], o[1]), cvt_pk_bf16(o[2], o[3])};
  }
}

__device__ __forceinline__ int moe_layer_tile(int layer, int j) { return j < 8192 ? layer * 8192 + j : 16384 + layer * 4096 + (j - 8192); }
__device__ __forceinline__ void moe_weight_tile(int T, const float* w1, const float* w2, bf16_t* W1_t, bf16_t* W2_t, int lane) {
  if (T < 16384) { const int le = T >> 8; transpose_tile(mk_tjob(w1 + (size_t)le * D * 2048, 2048, D, 2048, W1_t + (size_t)le * 2048 * D, D, 0, 0, 1), T & 255, lane); }
  else if (T < 24576) { const int t2 = T - 16384, le = t2 >> 7; transpose_tile(mk_tjob(w2 + (size_t)le * D * D, D, D, D, W2_t + (size_t)le * D * D, D, 0, 0, 0), t2 & 127, lane); }
}
typedef _Float16 h16x2_t __attribute__((ext_vector_type(2)));
typedef int i32x4_t __attribute__((ext_vector_type(4)));
__device__ __forceinline__ unsigned cvt_pk_f16(float lo, float hi) { const f32x2_t v = {lo, hi}; const h16x2_t h = __builtin_convertvector(v, h16x2_t); return __builtin_bit_cast(unsigned, h); }
__device__ __forceinline__ void ph_iscore(const bf16_t* pa, unsigned short* sc, const float* w1, const float* w2, bf16_t* W1_t, bf16_t* W2_t) {
  const int tid = TIDX(), lane = tid & 63, gw = BIDX() * 8 + (tid >> 6), NGW = (int)gridDim.x * 8;
  const int n16 = lane & 15, g = lane >> 4;
  int wt = gw;
#pragma unroll 1
  for (int u = gw; u < 2 * 4352; u += NGW) {
    const int b = u / 4352, v = u % 4352;
    int a = 0; while (a < 15 && 16 * (a + 1) * (a + 2) <= v) ++a;
    const int rem = v - 16 * a * (a + 1), r = rem / (a + 1), ch = rem % (a + 1);
    const int qg = 32 * a + r, ntile = (ch < a) ? 32 : (r + 1), t0 = qg * 16, kt0 = ch * 32;
    const bf16_t* qrow = pa + (size_t)(b * L + t0 + n16) * 2048;
    bf16x8 qf[8][2]; float w[8];
#pragma unroll
    for (int h = 0; h < 8; ++h) { qf[h][0] = *(const bf16x8*)(qrow + 1280 + h * 64 + 8 * g); qf[h][1] = *(const bf16x8*)(qrow + 1280 + h * 64 + 32 + 8 * g); w[h] = bf2f(qrow[1856 + h]) * (0.35355339059327373f * 0.125f); }
    const bf16_t* kbase = pa + (size_t)(b * L + n16) * 2048 + 1792 + 8 * g;
    unsigned short* srow = sc + (size_t)(b * L + t0 + n16) * L + 4 * g;
    bf16x8 kr[8][2];
    const int ktl = kt0 + ntile - 1;
#pragma unroll
    for (int p = 0; p < 8; ++p) { const int kk = min(kt0 + p, ktl); kr[p][0] = *(const bf16x8*)(kbase + (size_t)kk * 16 * 2048); kr[p][1] = *(const bf16x8*)(kbase + (size_t)kk * 16 * 2048 + 32); }
#pragma unroll 1
    for (int kt8 = kt0; kt8 < kt0 + ntile; kt8 += 8) {
#pragma unroll
      for (int p = 0; p < 8; ++p) {
        const int kt = kt8 + p;
        const bf16x8 k0 = kr[p][0], k1 = kr[p][1];
        { const int kk = min(kt + 8, ktl); kr[p][0] = *(const bf16x8*)(kbase + (size_t)kk * 16 * 2048); kr[p][1] = *(const bf16x8*)(kbase + (size_t)kk * 16 * 2048 + 32); }
        f32x4 score = (f32x4){0.f, 0.f, 0.f, 0.f};
#pragma unroll
        for (int h = 0; h < 8; ++h) {
          f32x4 acc = __builtin_amdgcn_mfma_f32_16x16x32_bf16(k0, qf[h][0], (f32x4){0.f, 0.f, 0.f, 0.f}, 0, 0, 0);
          acc = __builtin_amdgcn_mfma_f32_16x16x32_bf16(k1, qf[h][1], acc, 0, 0, 0);
          const f32x4 relu = __builtin_bit_cast(f32x4, __builtin_elementwise_max(__builtin_bit_cast(i32x4_t, acc), (i32x4_t){0, 0, 0, 0}));
#pragma unroll
          for (int i = 0; i < 4; ++i) score[i] = fmaf(relu[i], w[h], score[i]);
        }
        if (kt <= ktl) *(v2u*)(srow + kt * 16) = (v2u){cvt_pk_f16(score[0], score[1]), cvt_pk_f16(score[2], score[3])};
      }
    }
  }
  (void)wt; (void)w1; (void)w2; (void)W1_t; (void)W2_t;
}

constexpr int DW_STRIDE = 17152;
__device__ __forceinline__ unsigned offb(unsigned row, unsigned ch) { return 256u * row + 16u * (ch ^ (((row & 3u) << 2) | ((row >> 2) & 3u))); }
__device__ __forceinline__ void glds16(const void* gsrc, unsigned lds_dst) { unsigned keep;
  asm volatile("s_mov_b32 %0, m0\n\ts_mov_b32 m0, %2\n\ts_nop 0\n\tglobal_load_lds_dwordx4 %1, off\n\ts_mov_b32 m0, %0" : "=&s"(keep) : "v"(gsrc), "s"(lds_dst) : "memory"); }
__device__ __forceinline__ int wave_excl_scan(int v, int lane, int& total) {
  int x = v;
#pragma unroll
  for (int o = 1; o < 64; o <<= 1) { const int y = __shfl_up(x, o); if (lane >= o) x += y; }
  total = __shfl(x, 63); return x - v;
}
#define LDSW() asm volatile("s_waitcnt lgkmcnt(0)" ::: "memory")
__device__ __forceinline__ int wave_incl_scan_dpp(int v, int lane, int& total) {
  int x = v;
  x += __builtin_amdgcn_update_dpp(0, x, 0x111, 0xf, 0xf, true);
  x += __builtin_amdgcn_update_dpp(0, x, 0x112, 0xf, 0xf, true);
  x += __builtin_amdgcn_update_dpp(0, x, 0x114, 0xf, 0xf, true);
  x += __builtin_amdgcn_update_dpp(0, x, 0x118, 0xf, 0xf, true);
  const int t0 = __builtin_amdgcn_readlane(x, 15), t1 = __builtin_amdgcn_readlane(x, 31), t2 = __builtin_amdgcn_readlane(x, 47), t3 = __builtin_amdgcn_readlane(x, 63);
  const int row = lane >> 4;
  x += (row >= 1 ? t0 : 0) + (row >= 2 ? t1 : 0) + (row >= 3 ? t2 : 0);
  total = t0 + t1 + t2 + t3; return x;
}

__device__ __forceinline__ unsigned h2key(unsigned h) { return (h & 0x8000u) ? (~h & 0xFFFFu) : (h | 0x8000u); }
__device__ __forceinline__ int wave_select(const unsigned short* srow, int t, LAS unsigned char* wl, LAS unsigned short* idx16, int lane) {
  const int n = t + 1;
  if (n <= 256) { for (int i = lane; i < 256; i += 64) idx16[i] = (unsigned short)(i < n ? i : 0); LDSW(); return n; }
  LAS unsigned* hist = (LAS unsigned*)wl;
  for (int i = lane; i < 1024; i += 64) ((LAS v4u*)hist)[i] = (v4u){0u, 0u, 0u, 0u};
  unsigned bk[16][4];
#if defined(SEL_REP_LOAD)
#pragma unroll 1
  for (int rep_ = 0; rep_ < 2; ++rep_)
#endif
#pragma unroll
  for (int i = 0; i < 16; ++i) {
    bk[i][0] = 0u; bk[i][1] = 0u; bk[i][2] = 0u; bk[i][3] = 0u;
    if (i * 512 < n) { const int e0 = (i * 64 + lane) * 8;
      if (e0 < n) { const v4u f = *(const v4u*)(srow + e0);
#pragma unroll
        for (int c = 0; c < 4; ++c) { unsigned lo = f[c] & 0xFFFFu, hi = f[c] >> 16; lo = lo + 0u;
          const unsigned b0 = (e0 + 2 * c <= t) ? (h2key(lo == 0x8000u ? 0u : lo) >> 4) : 0u, b1 = (e0 + 2 * c + 1 <= t) ? (h2key(hi == 0x8000u ? 0u : hi) >> 4) : 0u;
          bk[i][c] = b0 | (b1 << 16); } } }
    if ((i & 7) == 7) asm volatile("" ::: "memory");
  }
#define BIN_OF(i, c) ((bk[i][(c) >> 1] >> (((c) & 1) * 16)) & 0xFFFFu)
  LDSW();
#if defined(SEL_REP_HIST)
#pragma unroll 1
  for (int rep_ = 0; rep_ < 2; ++rep_) {
  for (int i = lane; i < 1024; i += 64) ((LAS v4u*)hist)[i] = (v4u){0u, 0u, 0u, 0u};
  LDSW();
#endif
#pragma unroll
  for (int i = 0; i < 16; ++i) if (i * 512 < n) {
#pragma unroll
    for (int c = 0; c < 8; ++c) { const unsigned bin = BIN_OF(i, c); __hip_atomic_fetch_add(hist + bin, 1u, __ATOMIC_RELAXED, __HIP_MEMORY_SCOPE_WORKGROUP); }
    asm volatile("" ::: "memory"); }
  LDSW();
#if defined(SEL_REP_HIST)
  }
#endif
  const int bbase = 4096 - 64 * (lane + 1); int ssum = 0;
#pragma unroll 16
  for (int k = 0; k < 64; ++k) ssum += (int)hist[bbase + ((k + lane) & 63)];
  int tot; const int pre = wave_incl_scan_dpp(ssum, lane, tot) - ssum;
  const unsigned long long bal = __ballot(pre < 256 && pre + ssum >= 256);
  const int Ls = (int)__builtin_ctzll(bal);
  const int cum0 = __builtin_amdgcn_readlane(pre, Ls), sb = 4096 - 64 * (Ls + 1);
  const int ck = (int)hist[sb + 63 - lane]; int t2_; const int inc = wave_incl_scan_dpp(ck, lane, t2_);
  const unsigned long long bal2 = __ballot(cum0 + inc >= 256);
  const int kk = (int)__builtin_ctzll(bal2);
  const int B1 = sb + 63 - kk, cnt_gt = cum0 + __builtin_amdgcn_readlane(inc, kk) - __builtin_amdgcn_readlane(ck, kk), need1 = 256 - cnt_gt;
  LDSW();
  const unsigned kg = (0x7FFFu - (unsigned)B1) * 0x00010001u, kge = kg + 0x00010001u;
  int ngt = 0, neq = 0;
#pragma unroll
  for (int i = 0; i < 16; ++i) if (i * 512 < n) {
#pragma unroll
    for (int c2 = 0; c2 < 4; ++c2) { const unsigned x = bk[i][c2], fg = (x + kg) & 0x80008000u, fe = ((x + kge) & 0x80008000u) & ~fg; ngt += __builtin_popcount(fg); neq += __builtin_popcount(fe); } }
  int tg, te; int pg = wave_incl_scan_dpp(ngt, lane, tg) - ngt; int pe = wave_incl_scan_dpp(neq, lane, te) - neq;
  LAS unsigned short* cand = (LAS unsigned short*)wl;
#pragma unroll
  for (int i = 0; i < 16; ++i) if (i * 512 < n) {
#pragma unroll
    for (int c2 = 0; c2 < 4; ++c2) { const unsigned x = bk[i][c2], fg = (x + kg) & 0x80008000u, fe = ((x + kge) & 0x80008000u) & ~fg; const int e = (i * 64 + lane) * 8 + 2 * c2;
      if (fg & 0x8000u) { idx16[pg] = (unsigned short)e; ++pg; }
      if (fg & 0x80000000u) { idx16[pg] = (unsigned short)(e + 1); ++pg; }
      if (fe & 0x8000u) { cand[pe] = (unsigned short)e; ++pe; }
      if (fe & 0x80000000u) { cand[pe] = (unsigned short)(e + 1); ++pe; } }
    asm volatile("" ::: "memory"); }
#undef BIN_OF
  LDSW();
  const int m = te;
  unsigned lo = 0u;
  if (m <= 64) {
    unsigned cpv = 0u; if (lane < m) { const unsigned ci = cand[lane]; unsigned hv = srow[ci]; hv = (hv == 0x8000u) ? 0u : hv; cpv = ((h2key(hv) & 15u) << 13) | (8191u - ci) | (1u << 20); }
    int rank = 0;
    for (int k = 0; k < m; ++k) { const unsigned ok = (unsigned)__builtin_amdgcn_readlane((int)cpv, k); rank += (ok > cpv) ? 1 : 0; }
    const bool sel = (lane < m) && (rank < need1);
    const unsigned long long bs = __ballot(sel);
    if (sel) idx16[cnt_gt + __builtin_popcountll(bs & ((1ull << lane) - 1ull))] = (unsigned short)(8191u - (cpv & 0x1FFFu));
  } else if (m <= 256) {
    unsigned cp[4];
#pragma unroll
    for (int j = 0; j < 4; ++j) { const int q = lane + 64 * j; cp[j] = 0u; if (q < m) { const unsigned ci = cand[q]; unsigned hv = srow[ci]; hv = (hv == 0x8000u) ? 0u : hv; cp[j] = ((h2key(hv) & 15u) << 13) | (8191u - ci) | (1u << 20); } }
    for (int bit = 16; bit >= 0; --bit) { const unsigned trial = lo | (1u << bit); int tc = 0;
#pragma unroll
      for (int j = 0; j < 4; ++j) tc += __builtin_popcountll(__ballot((cp[j] >> 20) && ((cp[j] & 0x1FFFFu) >= trial)));
      if (tc >= need1) lo = trial; }
    int pos = cnt_gt;
#pragma unroll
    for (int j = 0; j < 4; ++j) { const bool sel = (cp[j] >> 20) && ((cp[j] & 0x1FFFFu) >= lo); const unsigned long long bs = __ballot(sel);
      if (sel) idx16[pos + __builtin_popcountll(bs & ((1ull << lane) - 1ull))] = (unsigned short)(8191u - (cp[j] & 0x1FFFu)); pos += __builtin_popcountll(bs); }
  } else {
    for (int bit = 16; bit >= 0; --bit) { const unsigned trial = lo | (1u << bit); int c = 0;
      for (int q = lane; q < m; q += 64) { const unsigned ci = cand[q]; unsigned hv = srow[ci]; hv = (hv == 0x8000u) ? 0u : hv; const unsigned cpq = ((h2key(hv) & 15u) << 13) | (8191u - ci); c += (cpq >= trial) ? 1 : 0; }
      int tc; (void)wave_excl_scan(c, lane, tc); if (tc >= need1) lo = trial; }
    int base = cnt_gt;
    for (int q0 = 0; q0 < m; q0 += 64) { const int q = q0 + lane; bool sel = false; unsigned ci = 0;
      if (q < m) { ci = cand[q]; unsigned hv = srow[ci]; hv = (hv == 0x8000u) ? 0u : hv; const unsigned cpq = ((h2key(hv) & 15u) << 13) | (8191u - ci); sel = cpq >= lo; }
      int tc; const int pos = base + wave_excl_scan(sel ? 1 : 0, lane, tc); if (sel) idx16[pos] = (unsigned short)ci; base += tc; }
  }
  LDSW();
  return 256;
}

__device__ __forceinline__ void wave_attend(int b, int t, int cnt, const bf16_t* qlat, const bf16_t* cnb, LAS unsigned char* wl, LAS unsigned short* idx16, bf16_t* olat, int lane) {
  const int n16 = lane & 15, g = lane >> 4, q4 = (lane & 15) >> 2, p4 = lane & 3;
  const bf16_t* qrow = qlat + (size_t)(b * L + t) * 4096 + n16 * 256 + 8 * g;
  bf16x8 qf[8];
#pragma unroll
  for (int s = 0; s < 8; ++s) qf[s] = *(const bf16x8*)(qrow + 32 * s);
  f32x4 o[16];
#pragma unroll
  for (int c = 0; c < 16; ++c) o[c] = (f32x4){0.f, 0.f, 0.f, 0.f};
  float mrun = -INFINITY, lrun = 0.f;
  const int ntile = (cnt + 31) >> 5;
  const char* cb = (const char*)(cnb + (size_t)b * L * 256);
  const unsigned slot = lane & 15, rsub = lane >> 4;
  constexpr float SC = 0.125f * 1.4426950408889634f;
  v4u stg[16];
#define GATHER_TILE(itn) do { _Pragma("unroll") for (int rg = 0; rg < 8; ++rg) { const unsigned row = 4 * rg + rsub; const unsigned key = idx16[32 * (itn) + row]; \
      const unsigned ch = slot ^ (((row & 3u) << 2) | ((row >> 2) & 3u)); const char* src = cb + (size_t)key * 512 + ch * 16; \
      stg[rg] = *(const v4u*)src; stg[8 + rg] = *(const v4u*)(src + 256); } } while (0)
  GATHER_TILE(0);
#pragma unroll 1
  for (int it = 0; it < ntile; ++it) {
#pragma unroll
    for (int rg = 0; rg < 8; ++rg) { *(LAS v4u*)(wl + rg * 1024 + lane * 16) = stg[rg]; *(LAS v4u*)(wl + 8192 + rg * 1024 + lane * 16) = stg[8 + rg]; }
    LDSW();
    if (it + 1 < ntile) GATHER_TILE(it + 1);
    f32x4 s0 = (f32x4){0.f, 0.f, 0.f, 0.f}, s1 = (f32x4){0.f, 0.f, 0.f, 0.f};
#pragma unroll
    for (int s = 0; s < 8; ++s) { const unsigned ib = (s >> 2) * 8192, chq = 4 * (s & 3) + g;
      const bf16x8 a0 = *(const LAS bf16x8*)(wl + ib + offb(n16, chq)), a1 = *(const LAS bf16x8*)(wl + ib + offb(16 + n16, chq));
      s0 = __builtin_amdgcn_mfma_f32_16x16x32_bf16(a0, qf[s], s0, 0, 0, 0); s1 = __builtin_amdgcn_mfma_f32_16x16x32_bf16(a1, qf[s], s1, 0, 0, 0); }
    const int sl0 = 32 * it + 4 * g;
    float mx = -INFINITY;
#pragma unroll
    for (int r = 0; r < 4; ++r) { s0[r] = (sl0 + r < cnt) ? s0[r] * SC : -INFINITY; s1[r] = (sl0 + 16 + r < cnt) ? s1[r] * SC : -INFINITY; mx = fmaxf(mx, fmaxf(s0[r], s1[r])); }
    mx = fmaxf(mx, __shfl_xor(mx, 16)); mx = fmaxf(mx, __shfl_xor(mx, 32));
    const float mnew = fmaxf(mrun, mx), alpha = __builtin_amdgcn_exp2f(mrun - mnew);
    float ls = 0.f; float pv[8];
#pragma unroll
    for (int r = 0; r < 4; ++r) { pv[r] = __builtin_amdgcn_exp2f(s0[r] - mnew); pv[4 + r] = __builtin_amdgcn_exp2f(s1[r] - mnew); ls += pv[r] + pv[4 + r]; }
    ls += __shfl_xor(ls, 16); ls += __shfl_xor(ls, 32);
    lrun = lrun * alpha + ls; mrun = mnew;
#pragma unroll
    for (int c = 0; c < 16; ++c) o[c] = o[c] * alpha;
    const v4u pbw = (v4u){cvt_pk_bf16(pv[0], pv[1]), cvt_pk_bf16(pv[2], pv[3]), cvt_pk_bf16(pv[4], pv[5]), cvt_pk_bf16(pv[6], pv[7])};
    const bf16x8 pb = __builtin_bit_cast(bf16x8, pbw);
#pragma unroll
    for (int c = 0; c < 16; ++c) { const unsigned ib = (c >> 3) * 8192, chc = 2 * (c & 7) + (p4 >> 1);
      const v4i16_t t0 = __builtin_amdgcn_ds_read_tr16_b64_v4i16((LAS v4i16_t*)(wl + ib + offb(4 * g + q4, chc) + 8 * (p4 & 1)));
      const v4i16_t t1 = __builtin_amdgcn_ds_read_tr16_b64_v4i16((LAS v4i16_t*)(wl + ib + offb(16 + 4 * g + q4, chc) + 8 * (p4 & 1)));
      const bf16x8 af = (bf16x8){t0[0], t0[1], t0[2], t0[3], t1[0], t1[1], t1[2], t1[3]};
      o[c] = __builtin_amdgcn_mfma_f32_16x16x32_bf16(af, pb, o[c], 0, 0, 0); }
    LDSW();
  }
  const float inv = 1.f / lrun;
  bf16_t* orow = olat + (size_t)(b * L + t) * 4096 + n16 * 256 + 4 * g;
#pragma unroll
  for (int c = 0; c < 16; ++c) { const f32x4 v = o[c] * inv; *(v2u*)(orow + 16 * c) = (v2u){cvt_pk_bf16(v[0], v[1]), cvt_pk_bf16(v[2], v[3])}; }
}

__device__ __forceinline__ void ph_select_attend(const unsigned short* sc, const bf16_t* qlat, const bf16_t* cnb, bf16_t* olat, LAS unsigned char* lds, const float* w1, const float* w2, bf16_t* W1_t, bf16_t* W2_t) {
  const int tid = TIDX(), lane = tid & 63, wave = __builtin_amdgcn_readfirstlane(tid >> 6), blk = BIDX();
  LAS unsigned char* wl = lds + wave * DW_STRIDE; LAS unsigned short* idx16 = (LAS unsigned short*)(wl + 16384);
  const int b = blk & 1, wb = (blk >> 1) * 8 + wave, nwb = ((int)gridDim.x >> 1) * 8;
  const int gw = blk * 8 + wave, NGW = (int)gridDim.x * 8; int wt = gw;
#pragma unroll 1
  for (int t = wb, qi = 0; t < L; t += nwb, ++qi) {
    int lane_s = lane; asm volatile("" : "+v"(lane_s));
    const int cnt = wave_select(sc + (size_t)(b * L + t) * L, t, wl, idx16, lane_s);
#if defined(DUPSEL)
    { int lane_s2 = lane; asm volatile("" : "+v"(lane_s2)); const int cnt2 = wave_select(sc + (size_t)(b * L + t) * L, t, wl, idx16, lane_s2); if (cnt2 != cnt) olat[0] = 0; }
#endif
    int lane_a = lane; asm volatile("" : "+v"(lane_a));
    wave_attend(b, t, cnt, qlat, cnb, wl, idx16, olat, lane_a);
#if defined(DUPATT)
    { int lane_a2 = lane; asm volatile("" : "+v"(lane_a2)); wave_attend(b, t, cnt, qlat, cnb, wl, idx16, olat, lane_a2); }
#endif
    const int ntl = (qi < 4) ? 2 : 1;
#pragma unroll 1
    for (int k = 0; k < ntl; ++k) { int lane_t = lane; asm volatile("" : "+v"(lane_t)); if (wt < 24576) moe_weight_tile(wt < 12288 ? moe_layer_tile(0, wt) : moe_layer_tile(1, wt - 12288), w1, w2, W1_t, W2_t, lane_t); wt += NGW; }
  }
#pragma unroll 1
  for (; wt < 24576; wt += NGW) { int lane_t = lane; asm volatile("" : "+v"(lane_t)); moe_weight_tile(wt < 12288 ? moe_layer_tile(0, wt) : moe_layer_tile(1, wt - 12288), w1, w2, W1_t, W2_t, lane_t); }
}

__device__ __forceinline__ void ph_qlat(const bf16_t* pa, const bf16_t* WqT, bf16_t* qlat) {
  const int tid = TIDX(), lane = tid & 63, gw = BIDX() * 8 + (tid >> 6), NGW = (int)gridDim.x * 8;
  const int n16 = lane & 15, g = lane >> 4;
#pragma unroll 1
  for (int it = gw; it < 16 * 512; it += NGW) {
    const int h = it & 15, rt = it >> 4;
    bf16x8 qb[2][2];
#pragma unroll
    for (int mt = 0; mt < 2; ++mt)
#pragma unroll
      for (int ks = 0; ks < 2; ++ks) qb[mt][ks] = *(const bf16x8*)(pa + (size_t)(rt * 32 + mt * 16 + n16) * 2048 + h * 64 + 32 * ks + 8 * g);
    const bf16_t* wp = WqT + (size_t)h * 256 * 64 + (size_t)n16 * 64 + 8 * g;
    bf16_t* op = qlat + (size_t)(rt * 32 + n16) * 4096 + h * 256 + 4 * g;
#pragma unroll 4
    for (int ct = 0; ct < 16; ++ct) {
      const bf16x8 a0 = *(const bf16x8*)(wp + (size_t)(16 * ct) * 64), a1 = *(const bf16x8*)(wp + (size_t)(16 * ct) * 64 + 32);
#pragma unroll
      for (int mt = 0; mt < 2; ++mt) { f32x4 acc = __builtin_amdgcn_mfma_f32_16x16x32_bf16(a0, qb[mt][0], (f32x4){0.f, 0.f, 0.f, 0.f}, 0, 0, 0);
        acc = __builtin_amdgcn_mfma_f32_16x16x32_bf16(a1, qb[mt][1], acc, 0, 0, 0);
        *(v2u*)(op + (size_t)(mt * 16) * 4096 + 16 * ct) = (v2u){cvt_pk_bf16(acc[0], acc[1]), cvt_pk_bf16(acc[2], acc[3])}; }
    }
  }
}
__device__ __forceinline__ void ph_o2(const bf16_t* olat, const bf16_t* WuvT, bf16_t* o2b) {
  const int tid = TIDX(), lane = tid & 63, gw = BIDX() * 8 + (tid >> 6), NGW = (int)gridDim.x * 8;
  const int n16 = lane & 15, g = lane >> 4;
#pragma unroll 1
  for (int it = gw; it < 16 * 512; it += NGW) {
    const int h = it & 15, rt = it >> 4;
    f32x4 acc[4][2];
#pragma unroll
    for (int vt = 0; vt < 4; ++vt) { acc[vt][0] = (f32x4){0.f, 0.f, 0.f, 0.f}; acc[vt][1] = (f32x4){0.f, 0.f, 0.f, 0.f}; }
    const bf16_t* ap = olat + (size_t)(rt * 32 + n16) * 4096 + h * 256 + 8 * g;
    const bf16_t* wp = WuvT + (size_t)h * 64 * 256 + (size_t)n16 * 256 + 8 * g;
#pragma unroll
    for (int ks = 0; ks < 8; ++ks) {
      const bf16x8 b0 = *(const bf16x8*)(ap + 32 * ks), b1 = *(const bf16x8*)(ap + (size_t)16 * 4096 + 32 * ks);
#pragma unroll
      for (int vt = 0; vt < 4; ++vt) { const bf16x8 a = *(const bf16x8*)(wp + (size_t)(16 * vt) * 256 + 32 * ks);
        acc[vt][0] = __builtin_amdgcn_mfma_f32_16x16x32_bf16(a, b0, acc[vt][0], 0, 0, 0); acc[vt][1] = __builtin_amdgcn_mfma_f32_16x16x32_bf16(a, b1, acc[vt][1], 0, 0, 0); }
    }
    bf16_t* op = o2b + (size_t)(rt * 32 + n16) * 1024 + h * 64 + 4 * g;
#pragma unroll
    for (int vt = 0; vt < 4; ++vt)
#pragma unroll
      for (int mt = 0; mt < 2; ++mt) *(v2u*)(op + (size_t)(mt * 16) * 1024 + 16 * vt) = (v2u){cvt_pk_bf16(acc[vt][mt][0], acc[vt][mt][1]), cvt_pk_bf16(acc[vt][mt][2], acc[vt][mt][3])};
  }
}

namespace pg8 {
struct GroupAOrder {
    static constexpr bool GATHER = false; const int* rowmap;
    StaticOrder so; int png; size_t acol_bytes;
    __device__ void init(const void* A, int lda, const void* Bt, int ldb, int M, int N, int png_, size_t acol_bytes_, int G, int c) { so.init(A, lda, Bt, ldb, M, N, G, c); png = png_; acol_bytes = acol_bytes_; }
    __device__ bool next(int i, Unit& u) const { int pm, pn; if (!so.tile(i, pm, pn)) return false; u.pa = so.A + (size_t)pm * so.ta + (size_t)(pn / png) * acol_bytes; u.pb = so.Bt + (size_t)pn * so.tb; u.orow = pm * BM; u.ocol = pn * BM; u.e = 0; u.kind = 0; return true; }
    __device__ __forceinline__ int rowof(const Unit&, int r) const { return r; }
    __device__ __forceinline__ void a_ready(const Unit&) const {}
    __device__ __forceinline__ void done(const Unit&) const {}
};
}
constexpr int GLA_LDSU = 65536;

__device__ __forceinline__ v4i16_t trrd(LAS unsigned char* p) { return __builtin_amdgcn_ds_read_tr16_b64_v4i16((LAS v4i16_t*)p); }
__device__ __forceinline__ bf16x8 cat44(v4i16_t a, v4i16_t b) { return (bf16x8){a[0], a[1], a[2], a[3], b[0], b[1], b[2], b[3]}; }

__device__ __forceinline__ void ph_gla_a1(const bf16_t* pb, const float* gbias, bf16_t* qt, bf16_t* og, bf16_t* kvt, float* dcy, LAS unsigned char* lds, const float* w1, const float* w2, bf16_t* W1_t, bf16_t* W2_t) {
  const int tid = TIDX(), lane = tid & 63, wave = __builtin_amdgcn_readfirstlane(tid >> 6), blk = BIDX();
  const int half = wave >> 2, wq = wave & 3;
  LAS unsigned char* X = lds + half * GLA_LDSU; LAS unsigned char* Y = X + 16384; LAS unsigned char* V = X + 32768;
  LAS float* EX = (LAS float*)(lds + 131072 + half * 2048);
  const unsigned v_addr = (unsigned)__builtin_amdgcn_readfirstlane((int)(unsigned)(size_t)V);
  const int n16 = lane & 15, g = lane >> 4, q4 = (lane & 15) >> 2, p4 = lane & 3;
#pragma unroll 1
  for (int uu = 0; uu < 2; ++uu) {
    const int u = blk * 4 + half * 2 + uu;
    const int h = u & 3, bc = u >> 2, r0 = bc * 64;
    { const unsigned slot = lane & 15, rsub = lane >> 4; const int im = wq;
#pragma unroll
      for (int rg = 0; rg < 8; ++rg) { const unsigned row = 4 * rg + rsub; const unsigned ch = slot ^ (((row & 3u) << 2) | ((row >> 2) & 3u));
        const char* src = (const char*)(pb + (size_t)(r0 + 32 * (im >> 1) + row) * 3584 + 1024 + h * 256 + (im & 1) * 128) + ch * 16;
        glds16(src, v_addr + im * 8192 + rg * 1024); } }
    const int d0 = 2 * lane; const float gb0 = gbias[h * 128 + d0], gb1 = gbias[h * 128 + d0 + 1];
    const unsigned wofs = 16u * ((unsigned)(d0 >> 3)), wsub = (unsigned)(d0 & 7) * 2u;
    unsigned gq[16], qq[16], kq[16]; float bl0[16], bl1[16];
#pragma unroll
    for (int jj = 0; jj < 16; ++jj) { const bf16_t* rp = pb + (size_t)(r0 + wq * 16 + jj) * 3584 + h * 128 + d0;
      gq[jj] = *(const unsigned*)(rp + 3072); qq[jj] = *(const unsigned*)rp; kq[jj] = *(const unsigned*)(rp + 512); }
    float bc0 = 0.f, bc1 = 0.f;
#pragma unroll
    for (int jj = 0; jj < 16; ++jj) { const float a0 = bf_lo(gq[jj]) + gb0, a1 = bf_hi(gq[jj]) + gb1;
      bc0 += (fminf(a0, 0.f) - __logf(1.f + __expf(-fabsf(a0)))) * (1.f / 16.f); bc1 += (fminf(a1, 0.f) - __logf(1.f + __expf(-fabsf(a1)))) * (1.f / 16.f);
      bl0[jj] = bc0; bl1[jj] = bc1; }
    *(LAS f32x2_t*)(EX + wq * 128 + d0) = (f32x2_t){bc0, bc1};
    LDSW(); __syncthreads();
    float of0 = 0.f, of1 = 0.f, tt0 = 0.f, tt1 = 0.f;
#pragma unroll
    for (int w2_ = 0; w2_ < 4; ++w2_) { const f32x2_t e = *(const LAS f32x2_t*)(EX + w2_ * 128 + d0); tt0 += e[0]; tt1 += e[1]; if (w2_ < wq) { of0 += e[0]; of1 += e[1]; } }
#pragma unroll
    for (int jj = 0; jj < 16; ++jj) { const int j = wq * 16 + jj; const float b0 = bl0[jj] + of0, b1 = bl1[jj] + of1;
      const float e0 = __expf(b0), e1 = __expf(b1), i0 = __expf(fminf(-b0, 80.f)), i1 = __expf(fminf(-b1, 80.f));
      const unsigned qo = cvt_pk_bf16(bf_lo(qq[jj]) * 0.08838834764831845f * e0, bf_hi(qq[jj]) * 0.08838834764831845f * e1);
      const unsigned ko = cvt_pk_bf16(bf_lo(kq[jj]) * i0, bf_hi(kq[jj]) * i1);
      *(unsigned*)(qt + (size_t)(r0 + j) * 512 + h * 128 + d0) = qo;
      const unsigned row = (unsigned)(j & 31); const unsigned off = (unsigned)(j >> 5) * 8192u + 256u * row + ((wofs ^ (16u * (((row & 3u) << 2) | ((row >> 2) & 3u))))) + wsub;
      *(LAS unsigned*)(X + off) = qo; *(LAS unsigned*)(Y + off) = ko; }
    if (wq == 3) *(float2*)(dcy + (size_t)u * 128 + d0) = make_float2(__expf(tt0), __expf(tt1));
    asm volatile("s_waitcnt vmcnt(0) lgkmcnt(0)" ::: "memory");
    __syncthreads();
    const int it = wq;
    bf16x8 afr[2];
#pragma unroll
    for (int ks = 0; ks < 2; ++ks) {
      unsigned pk[4] = {0u, 0u, 0u, 0u};
#pragma unroll
      for (int jh = 0; jh < 2; ++jh) { const int jt = 2 * ks + jh;
        if (jt <= it) { f32x4 acc = (f32x4){0.f, 0.f, 0.f, 0.f};
#pragma unroll
          for (int s = 0; s < 4; ++s) { const bf16x8 ya = *(const LAS bf16x8*)(Y + (jt >> 1) * 8192 + offb(n16 + 16 * (jt & 1), 4 * s + g)), xb = *(const LAS bf16x8*)(X + (it >> 1) * 8192 + offb(n16 + 16 * (it & 1), 4 * s + g));
            acc = __builtin_amdgcn_mfma_f32_16x16x32_bf16(ya, xb, acc, 0, 0, 0); }
          const int i_ = 16 * it + n16, jbase = 16 * jt + 4 * g;
#pragma unroll
          for (int r = 0; r < 4; ++r) if (jbase + r > i_) acc[r] = 0.f;
          pk[2 * jh] = cvt_pk_bf16(acc[0], acc[1]); pk[2 * jh + 1] = cvt_pk_bf16(acc[2], acc[3]); } }
      afr[ks] = __builtin_bit_cast(bf16x8, (v4u){pk[0], pk[1], pk[2], pk[3]});
    }
    bf16_t* ogp = og + (size_t)u * 16384 + (size_t)(it * 16) * 256 + lane * 4; bf16_t* kvp = kvt + (size_t)u * 32768 + (size_t)n16 * 128 + 4 * g;
#pragma unroll 2
    for (int nt = 0; nt < 16; ++nt) {
      const unsigned vimg = (unsigned)(nt >> 3) * 8192u, chv = 2u * (unsigned)(nt & 7) + (unsigned)(p4 >> 1), sub = 8u * (unsigned)(p4 & 1);
      f32x4 acc = (f32x4){0.f, 0.f, 0.f, 0.f};
      { LAS unsigned char* vb = V + vimg; const bf16x8 bi0 = cat44(trrd(vb + offb(4 * g + q4, chv) + sub), trrd(vb + offb(16 + 4 * g + q4, chv) + sub));
        acc = __builtin_amdgcn_mfma_f32_16x16x32_bf16(afr[0], bi0, acc, 0, 0, 0); }
      if (it >= 2) { LAS unsigned char* vb = V + 16384 + vimg; const bf16x8 bi1 = cat44(trrd(vb + offb(4 * g + q4, chv) + sub), trrd(vb + offb(16 + 4 * g + q4, chv) + sub));
        acc = __builtin_amdgcn_mfma_f32_16x16x32_bf16(afr[1], bi1, acc, 0, 0, 0); }
      *(v2u*)(ogp + (size_t)nt * 256) = (v2u){cvt_pk_bf16(acc[0], acc[1]), cvt_pk_bf16(acc[2], acc[3])};
    }
#pragma unroll 1
    for (int nq = 0; nq < 4; ++nq) { const int nt = 4 * wq + nq;
      const unsigned vimg = (unsigned)(nt >> 3) * 8192u, chv = 2u * (unsigned)(nt & 7) + (unsigned)(p4 >> 1), sub = 8u * (unsigned)(p4 & 1);
      bf16x8 bn[2];
#pragma unroll
      for (int ks = 0; ks < 2; ++ks) { LAS unsigned char* vb = V + ks * 16384 + vimg; bn[ks] = cat44(trrd(vb + offb(8 * g + q4, chv) + sub), trrd(vb + offb(8 * g + 4 + q4, chv) + sub)); }
#pragma unroll
      for (int mt = 0; mt < 8; ++mt) { const unsigned chy = 2u * (unsigned)mt + (unsigned)(p4 >> 1);
        const bf16x8 a0 = cat44(trrd(Y + offb(8 * g + q4, chy) + sub), trrd(Y + offb(8 * g + 4 + q4, chy) + sub));
        const bf16x8 a1 = cat44(trrd(Y + 8192 + offb(8 * g + q4, chy) + sub), trrd(Y + 8192 + offb(8 * g + 4 + q4, chy) + sub));
        f32x4 acc = __builtin_amdgcn_mfma_f32_16x16x32_bf16(a0, bn[0], (f32x4){0.f, 0.f, 0.f, 0.f}, 0, 0, 0);
        acc = __builtin_amdgcn_mfma_f32_16x16x32_bf16(a1, bn[1], acc, 0, 0, 0);
        *(v2u*)(kvp + (size_t)(16 * nt) * 128 + 16 * mt) = (v2u){cvt_pk_bf16(acc[0], acc[1]), cvt_pk_bf16(acc[2], acc[3])}; }
    }
    LDSW(); __syncthreads();
  }
}

__device__ __forceinline__ void ph_gla_a2(const bf16_t* kvt, const float* dcy, bf16_t* spt) {
  const int gtid = BIDX() * NTHR + TIDX();
  if (gtid >= 8 * 256 * 32) return;
  const int g4 = gtid & 31, dv = (gtid >> 5) & 255, bh = gtid >> 13, b = bh >> 2, h = bh & 3;
  f32x4 S = (f32x4){0.f, 0.f, 0.f, 0.f};
#pragma unroll 4
  for (int c = 0; c < 128; ++c) { const size_t u = (size_t)((b * 128 + c) * 4 + h);
    const v2u kvb = *(const v2u*)(kvt + u * 32768 + (size_t)dv * 128 + 4 * g4); const f32x4 kv = (f32x4){bf_lo(kvb[0]), bf_hi(kvb[0]), bf_lo(kvb[1]), bf_hi(kvb[1])}, dc = *(const f32x4*)(dcy + u * 128 + 4 * g4);
    *(v2u*)(spt + u * 32768 + (size_t)dv * 128 + 4 * g4) = (v2u){cvt_pk_bf16(S[0], S[1]), cvt_pk_bf16(S[2], S[3])};
    S = dc * (S + kv); }
}

constexpr int A3_LD = 272;
__device__ __forceinline__ void ph_gla_a3(const bf16_t* pb, const bf16_t* qt, const bf16_t* og, const bf16_t* spt, const float* ng, bf16_t* ob, LAS unsigned char* lds) {
  const int tid = TIDX(), lane = tid & 63, wave = __builtin_amdgcn_readfirstlane(tid >> 6), gw = BIDX() * 8 + wave, NGW = (int)gridDim.x * 8;
  const int n16 = lane & 15, g = lane >> 4, row16 = lane >> 2, cq = lane & 3;
  LAS float* T = (LAS float*)(lds + wave * (16 * A3_LD * 4));
#pragma unroll 1
  for (int w = gw; w < 4096; w += NGW) {
    const int u = w >> 2, it = w & 3, h = u & 3, r0 = (u >> 2) * 64;
    const bf16_t* sp = spt + (size_t)u * 32768 + (size_t)n16 * 128 + 8 * g;
    bf16x8 qa[4];
#pragma unroll
    for (int ks = 0; ks < 4; ++ks) qa[ks] = *(const bf16x8*)(qt + (size_t)(r0 + 16 * it + n16) * 512 + h * 128 + 32 * ks + 8 * g);
    const bf16_t* ogp = og + (size_t)u * 16384 + (size_t)(it * 16) * 256 + lane * 4;
#pragma unroll
    for (int nt = 0; nt < 16; ++nt) {
      const v2u ogb = *(const v2u*)(ogp + nt * 256); f32x4 acc = (f32x4){bf_lo(ogb[0]), bf_hi(ogb[0]), bf_lo(ogb[1]), bf_hi(ogb[1])};
#pragma unroll
      for (int ks = 0; ks < 4; ++ks) { const bf16x8 sb = *(const bf16x8*)(sp + (size_t)(16 * nt) * 128 + 32 * ks); acc = __builtin_amdgcn_mfma_f32_16x16x32_bf16(qa[ks], sb, acc, 0, 0, 0); }
#pragma unroll
      for (int r = 0; r < 4; ++r) T[(4 * g + r) * A3_LD + 16 * nt + n16] = acc[r];
    }
    LDSW();
    const size_t row = (size_t)(r0 + 16 * it + row16);
    f32x4 v[16]; float ss = 0.f;
#pragma unroll
    for (int k = 0; k < 16; ++k) { v[k] = *(const LAS f32x4*)(T + row16 * A3_LD + 16 * k + 4 * cq); ss += (v[k][0] * v[k][0] + v[k][1] * v[k][1]) + (v[k][2] * v[k][2] + v[k][3] * v[k][3]); }
    ss += __shfl_xor(ss, 1); ss += __shfl_xor(ss, 2);
    const float rs = rsqrtf(ss * (1.f / 256.f) + 1e-6f);
#pragma unroll
    for (int k = 0; k < 16; ++k) { const int col = h * 256 + 16 * k + 4 * cq; const v2u rg = *(const v2u*)(pb + row * 3584 + 2048 + col); const f32x4 gn = *(const f32x4*)(ng + col);
      const float rr[4] = {bf_lo(rg[0]), bf_hi(rg[0]), bf_lo(rg[1]), bf_hi(rg[1])}; float o[4];
#pragma unroll
      for (int z = 0; z < 4; ++z) o[z] = v[k][z] * rs * gn[z] * (rr[z] * __builtin_amdgcn_rcpf(1.f + __expf(-rr[z])));
      *(v2u*)(ob + row * 1024 + col) = (v2u){cvt_pk_bf16(o[0], o[1]), cvt_pk_bf16(o[2], o[3])}; }
    LDSW();
  }
}
#ifndef PROBE
#define PROBE 0
#endif
#ifndef PROBE_S
#define PROBE_S 10.0f
#endif
constexpr size_t MiB = 1u << 20;
constexpr size_t WS_CTL = 0, CTL_ZERO_BYTES = 1 * MiB;
constexpr int CW_BAR = 4096, CW_TMO = 64, CW_RDY = 65536;
constexpr size_t WS_NEEDED = 2048 * MiB;

struct Args { In in; float* out; unsigned char* ws; };

struct Opt { bf16_t *qt, *spt, *og, *kvt; float *dcy; bf16_t *Wql_t, *Wuv_t, *cnb, *qlat, *olat; unsigned short* sc; bf16_t *xb, *WA_t, *WoutA_t, *WB_t, *WoutB_t, *W1_t, *W2_t, *projA_b, *hbf, *o2b, *xs, *act, *Ys, *projB_b; MoeBufs m; };
__device__ __forceinline__ nvp::Ws carve_ws(unsigned char* ws) {
  nvp::Ws w; auto at = [&](size_t mib) { return (char*)ws + mib * MiB; };
  w.projA = (float*)at(2); w.cn = (float*)at(119); w.sc = (float*)at(135); w.idx = (int*)at(647); w.o2 = (float*)at(663);
  w.x1 = (float*)at(727); w.x2 = (float*)at(791);
  w.projB = (float*)at(135); w.adec = (float*)at(135 + 194); w.og = (float*)at(135 + 194 + 32); w.on = (float*)at(135 + 194 + 32 + 64);
  w.counts = nullptr; w.h = nullptr; w.hb = nullptr; w.ys = nullptr; w.tok_e = nullptr; w.tok_g = nullptr; w.slot_of = nullptr; w.row_tok = nullptr; w.row_gate = nullptr; w.blk_e = nullptr;
  return w;
}
__device__ __forceinline__ Opt carve_opt(unsigned char* ws) {
  Opt o; auto at = [&](size_t mib) { return (bf16_t*)((char*)ws + mib * MiB); };
  char* sm = (char*)ws + 855 * MiB;
  o.m.tok_e = (int*)sm; o.m.tok_g = (float*)(sm + 256 * 1024); o.m.slot_of = (int*)(sm + 512 * 1024); o.m.slot_gate = (float*)(sm + 768 * 1024); o.m.blk_e = (int*)(sm + 1088 * 1024); o.m.blkcnt = (int*)(sm + 1096 * 1024); o.m.nblk = (int*)(sm + 1160 * 1024); o.m.slot_tok = (int*)(sm + 1200 * 1024);
  o.WA_t = at(860); o.WoutA_t = at(864); o.WB_t = at(866); o.WoutB_t = at(873);
  o.Wql_t = at(875); o.Wuv_t = at(877); o.olat = at(2); o.cnb = at(647); o.qlat = at(1856); o.sc = (unsigned short*)at(135);
  o.qt = at(135); o.dcy = (float*)at(151); o.og = at(152); o.kvt = at(216); o.spt = at(344);
  o.W1_t = at(880); o.W2_t = at(1136);
  o.xb = at(1264); o.projA_b = at(1296); o.hbf = at(1360); o.o2b = at(1392);
  o.xs = at(1424); o.act = at(1568); o.Ys = at(1712); o.projB_b = at(1856);
  return o;
}

struct ProIn { const float *a_w_uk, *a_w_uv, *x, *a_w_in, *a_w_out, *b_w_in, *b_w_g2, *b_w_out, *m_w1, *m_w2; };
__device__ __forceinline__ void ph_prologue(const ProIn I, const Opt& o) {
  const int tid = TIDX(), lane = tid & 63, gw = BIDX() * 8 + (tid >> 6), NGW = (int)gridDim.x * 8, gtid = BIDX() * NTHR + tid, NGT = (int)gridDim.x * NTHR;
  cvt_f32_to_bf16(I.x, D, o.xb, D, NT, D, gtid, NGT);
  zero_rect(o.WA_t, D, DINA, 2048 - DINA, 0, D * 2, gtid, NGT);
  for (int i = gtid; i < 512 * 256; i += NGT) { const int n = i >> 8, k4 = (i & 255) * 4; float a[4];
#pragma unroll
    for (int z = 0; z < 4; ++z) { const float* gl = I.b_w_in + (size_t)(k4 + z) * DINB + 2048; float s = 0.f;
#pragma unroll
      for (int j = 0; j < 16; ++j) s = fmaf(gl[j], I.b_w_g2[j * 512 + n], s);
      a[z] = s; }
    *(v2u*)(o.WB_t + (size_t)(3072 + n) * D + k4) = (v2u){cvt_pk_bf16(a[0], a[1]), cvt_pk_bf16(a[2], a[3])}; }
  int w0 = 0;
#pragma unroll 1
  for (int h = 0; h < 16; ++h) {
    transpose_job(mk_tjob(I.a_w_uk + (size_t)h * 64 * 256, 256, 64, 256, o.Wql_t, 256, h * 256, (h & 3) * 64, 0), w0, gw, NGW, lane);
    transpose_job(mk_tjob(I.a_w_uv + (size_t)h * 256 * 64, 64, 256, 64, o.Wuv_t, 1024, h * 64, (h & 3) * 256, 0), w0, gw, NGW, lane);
    for (int hp = 0; hp < 4; ++hp) if (hp != (h & 3)) { zero_rect(o.Wql_t, 256, h * 256, 256, hp * 128, 128, gtid, NGT); zero_rect(o.Wuv_t, 1024, h * 64, 64, hp * 512, 512, gtid, NGT); }
  }
  transpose_job(mk_tjob(I.a_w_in, DINA, D, DINA, o.WA_t, D, 0, 0, 0), w0, gw, NGW, lane);
  transpose_job(mk_tjob(I.a_w_out, D, D, D, o.WoutA_t, D, 0, 0, 0), w0, gw, NGW, lane);
  transpose_job(mk_tjob(I.b_w_in, DINB, D, 2048, o.WB_t, D, 0, 0, 0), w0, gw, NGW, lane);
  transpose_job(mk_tjob(I.b_w_in + 2064, DINB, D, 1024, o.WB_t, D, 2048, 0, 0), w0, gw, NGW, lane);
  transpose_job(mk_tjob(I.b_w_out, D, D, D, o.WoutB_t, D, 0, 0, 0), w0, gw, NGW, lane);
}
__device__ __forceinline__ void ph_gla_shim(const bf16_t* pb, const float* gbias, float* projB, float* adec) {
  const int gtid = BIDX() * NTHR + TIDX(), NGT = (int)gridDim.x * NTHR;
  for (size_t i = gtid; i < (size_t)NT * 896; i += NGT) { const size_t r = i / 896; const int c = (int)(i % 896) * 4; const v2u v = *(const v2u*)(pb + r * 3584 + c);
    const f32x4 f = (f32x4){bf_lo(v[0]), bf_hi(v[0]), bf_lo(v[1]), bf_hi(v[1])};
    if (c < 2048) *(f32x4*)(projB + r * DINB + c) = f;
    else if (c < 3072) *(f32x4*)(projB + r * DINB + 2064 + (c - 2048)) = f;
    else { f32x4 o;
#pragma unroll
      for (int z = 0; z < 4; ++z) { const float a = f[z] + gbias[c - 3072 + z]; const float ls = fminf(a, 0.f) - log1pf(expf(-fabsf(a))); o[z] = expf(ls * (1.f / 16.f)); }
      *(f32x4*)(adec + r * 512 + (c - 3072)) = o; } }
}

#if PROBE == 3
#define GLA_PHASES \
      PH_BEGIN ph_gla_shim(o.projB_b, I.b_g_bias, w.projB, w.adec); PH_END \
      GRID_BAR(); \
      PH_BEGIN nvp::np_gla_scan(w.projB, w.adec, w.og, fl); PH_END \
      GRID_BAR(); \
      PH_BEGIN nvp::np_gla_norm(w.og, w.projB, I.b_norm, w.on); PH_END \
      GRID_BAR(); \
      PH_BEGIN cvt_f32_to_bf16(w.on, D, o.o2b, D, NT, D, gtid_, NGT_); PH_END \
      GRID_BAR(); \
      PH_BEGIN ph_gla_a1(o.projB_b, I.b_g_bias, (bf16_t*)(wsb_ + 489 * MiB), (bf16_t*)(wsb_ + 506 * MiB), (bf16_t*)(wsb_ + 880 * MiB), (float*)(wsb_ + 505 * MiB), ll, I.m_w1, I.m_w2, o.W1_t, o.W2_t); PH_END \
      GRID_BAR(); \
      PH_BEGIN ph_gla_a2((bf16_t*)(wsb_ + 880 * MiB), (float*)(wsb_ + 505 * MiB), (bf16_t*)(wsb_ + 1136 * MiB)); PH_END \
      GRID_BAR(); \
      PH_BEGIN ph_gla_a3(o.projB_b, (bf16_t*)(wsb_ + 489 * MiB), (bf16_t*)(wsb_ + 506 * MiB), (bf16_t*)(wsb_ + 1136 * MiB), I.b_norm, (bf16_t*)(wsb_ + 570 * MiB), ll); PH_END \
      GRID_BAR(); \
      PH_BEGIN { unsigned* fl_ = (unsigned*)(wsb_ + 512 * 1024); unsigned bits = 0u; \
        { const bf16_t* a = (const bf16_t*)(wsb_ + 489 * MiB); for (size_t i = gtid_; i < (size_t)NT * 512; i += NGT_) { const float v = bf2f(a[i]); if (!(fabsf(v) < 1e30f)) bits |= 1u; } } \
        { const float* a = (const float*)(wsb_ + 506 * MiB); for (size_t i = gtid_; i < (size_t)NT * 1024; i += NGT_) { const float v = a[i]; if (!(fabsf(v) < 1e30f)) bits |= 2u; } } \
        { const float* a = (const float*)(wsb_ + 880 * MiB); for (size_t i = gtid_; i < (size_t)1024 * 32768; i += NGT_) { const float v = a[i]; if (!(fabsf(v) < 1e30f)) bits |= 4u; } } \
        { const bf16_t* a = (const bf16_t*)(wsb_ + 1136 * MiB); for (size_t i = gtid_; i < (size_t)1024 * 32768; i += NGT_) { const float v = bf2f(a[i]); if (!(fabsf(v) < 1e30f)) bits |= 8u; } } \
        { const bf16_t* a = (const bf16_t*)(wsb_ + 570 * MiB); for (size_t i = gtid_; i < (size_t)NT * 1024; i += NGT_) { const float v = bf2f(a[i]); if (!(fabsf(v) < 1e30f)) bits |= 16u; } } \
        { const float* a = (const float*)(wsb_ + 505 * MiB); for (size_t i = gtid_; i < (size_t)1024 * 128; i += NGT_) { const float v = a[i]; if (!(fabsf(v) < 1e30f)) bits |= 32u; } } \
        if (bits) atomicOr(fl_, bits); \
        { float* pd = (float*)(wsb_ + 1968 * MiB); const bf16_t* ob = (const bf16_t*)(wsb_ + 570 * MiB); for (size_t i = gtid_; i < (size_t)NT * D; i += NGT_) pd[i] = bf2f(ob[i]) - w.on[i]; } } PH_END \
      GRID_BAR();
#else
#define GLA_PHASES \
      PH_BEGIN ph_gla_a1(o.projB_b, I.b_g_bias, o.qt, o.og, o.kvt, o.dcy, ll, I.m_w1, I.m_w2, o.W1_t, o.W2_t); PH_END \
      GRID_BAR(); \
      PH_BEGIN ph_gla_a2(o.kvt, o.dcy, o.spt); PH_END \
      GRID_BAR(); \
      PH_BEGIN ph_gla_a3(o.projB_b, o.qt, o.og, o.spt, I.b_norm, o.o2b, ll); PH_END \
      GRID_BAR();
#endif
#if defined(FUSE_ON)
#define MOE_GEMM_PHASES(li) \
    PH_BEGIN pg8::MoeFusedOrder S; S.init(o.xs, o.act, o.W1_t + (size_t)li * 32 * 2048 * D, o.W2_t + (size_t)li * 32 * D * D, o.m.slot_tok, o.m.blk_e, (unsigned*)(wsb_ + WS_CTL) + CW_RDY + li * 32768, (unsigned*)(wsb_ + WS_CTL) + CW_TMO, __builtin_amdgcn_readfirstlane(*o.m.nblk), G_, BIDX()); S.mode = 0; \
      gemm_phase<pg8::EpiMoeFused, pg8::MoeFusedOrder, true, true>(ll, Gemm{D, D, D}, S, pg8::EpiMoeFused{o.act, I.m_b1 + (size_t)li * 32 * 2048, o.Ys, I.m_b2 + (size_t)li * 32 * D, o.m.slot_gate}); PH_END \
    GRID_BAR();
#else
#define MOE_GEMM_PHASES(li) \
    PH_BEGIN pg8::MoeOrderG S; S.init(o.xs, D, o.W1_t + (size_t)li * 32 * 2048 * D, D, (size_t)2048 * D * 2, __builtin_amdgcn_readfirstlane(*o.m.nblk), 8, 128, o.m.blk_e, G_, BIDX()); S.rowmap = o.m.slot_tok; \
      gemm_phase<pg8::EpiSwiglu, pg8::MoeOrderG, true, true>(ll, Gemm{D, D, D}, S, pg8::EpiSwiglu{o.act, D, I.m_b1 + (size_t)li * 32 * 2048}); PH_END \
    GRID_BAR(); \
    PH_BEGIN MoeOrder S; S.init(o.act, D, o.W2_t + (size_t)li * 32 * D * D, D, (size_t)D * D * 2, __builtin_amdgcn_readfirstlane(*o.m.nblk), 4, 256, o.m.blk_e, G_, BIDX()); \
      gemm_phase<pg8::EpiMoe2, MoeOrder, true, true>(ll, Gemm{D, D, D}, S, pg8::EpiMoe2{o.Ys, D, I.m_b2 + (size_t)li * 32 * D, o.m.slot_gate}); PH_END \
    GRID_BAR();
#endif
#ifdef LNR_MODE
#define LNR_EXTRA(li) PH_BEGIN if (li == 0) ph_ln_router<false, LNR_MODE>(I.x, o.hbf, I.ln1_g + li * D, I.ln1_b + li * D, I.m_w_router + (size_t)li * D * 32, I.m_b_router + li * 32, o.xs, o.m, fl); else ph_ln_router<true, LNR_MODE>(o.xb, o.hbf, I.ln1_g + li * D, I.ln1_b + li * D, I.m_w_router + (size_t)li * D * 32, I.m_b_router + li * 32, o.xs, o.m, fl); PH_END GRID_BAR();
#else
#define LNR_EXTRA(li)
#endif
#define LAYER_BODY(li) \
    if (li == 1) { \
      PH_BEGIN StaticOrder S; S.init(o.xb, D, o.WB_t, D, NT, 3584, G_, BIDX()); gemm_phase<EpiStore, StaticOrder, true, true>(ll, Gemm{D, D, D}, S, EpiStore{o.projB_b, 3584}); PH_END \
      GRID_BAR(); \
      GLA_PHASES \
      PH_BEGIN StaticOrder S; S.init(o.o2b, D, o.WoutB_t, D, NT, D, G_, BIDX()); gemm_phase<EpiStore, StaticOrder, true, true>(ll, Gemm{D, D, D}, S, EpiStore{o.hbf, D}); PH_END \
      GRID_BAR(); \
    } \
LNR_EXTRA(li) \
    PH_BEGIN if (li == 0) ph_ln_router<false>(I.x, o.hbf, I.ln1_g + li * D, I.ln1_b + li * D, I.m_w_router + (size_t)li * D * 32, I.m_b_router + li * 32, o.xs, o.m, fl); else ph_ln_router<true>(o.xb, o.hbf, I.ln1_g + li * D, I.ln1_b + li * D, I.m_w_router + (size_t)li * D * 32, I.m_b_router + li * 32, o.xs, o.m, fl); PH_END \
    GRID_BAR(); \
    PH_BEGIN ph_moe_scatter(o.m, (int*)lds); PH_END \
    GRID_BAR(); \
MOE_GEMM_PHASES(li) \
    PH_BEGIN ph_combine_ln(o.xs, o.Ys, o.m.slot_of, I.ln2_g + li * D, I.ln2_b + li * D, li == 0 ? nullptr : out_, li == 0 ? o.xb : nullptr); PH_END \
    if (li == 0) GRID_BAR();
__global__ void __launch_bounds__(NTHR, 2) mk_fwd(Args args) {
  extern __shared__ __attribute__((aligned(16))) unsigned char lds[];
  volatile LAS unsigned* MISC = (volatile LAS unsigned*)((LAS unsigned char*)lds + MISC_OFF);
  if (threadIdx.x < 32) MISC[threadIdx.x] = 0u;
  __syncthreads();
  XcdBarrier bar; { const __attribute__((address_space(4))) Args* ka0 = (const __attribute__((address_space(4))) Args*)__builtin_amdgcn_kernarg_segment_ptr(); bar = xcd_barrier_post((unsigned*)(ka0->ws + WS_CTL) + CW_BAR, MISC + 8); }
#define GRID_BAR() xcd_barrier(bar)
#define PH_BEGIN { const __attribute__((address_space(4))) Args* ka_ = (const __attribute__((address_space(4))) Args*)__builtin_amdgcn_kernarg_segment_ptr(); asm volatile("" : "+s"(ka_)); \
    float* const out_ = ka_->out; (void)out_; unsigned char* wsb_ = ka_->ws; const nvp::Ws w = carve_ws(wsb_); (void)w; const Opt o = carve_opt(wsb_); (void)o; \
    const int gtid_ = BIDX() * NTHR + TIDX(), NGT_ = (int)gridDim.x * NTHR; (void)gtid_; (void)NGT_; const int G_ = (int)gridDim.x; (void)G_;
#define PH_END }
#define I (ka_->in)
  float* fl = (float*)lds; LAS unsigned char* ll = (LAS unsigned char*)lds;
  using pg8::gemm_phase; using pg8::StaticOrder; using pg8::MoeOrder; using pg8::Gemm; using pg8::EpiStore;
  PH_BEGIN ph_prologue(ProIn{I.a_w_uk, I.a_w_uv, I.x, I.a_w_in, I.a_w_out, I.b_w_in, I.b_w_g2, I.b_w_out, I.m_w1, I.m_w2}, o); PH_END
  GRID_BAR();
  PH_BEGIN StaticOrder S; S.init(o.xb, D, o.WA_t, D, NT, 2048, G_, BIDX()); gemm_phase<EpiStore, StaticOrder, true, true>(ll, Gemm{D, D, D}, S, EpiStore{o.projA_b, 2048}); PH_END
  GRID_BAR();
  PH_BEGIN ph_cnorm_b(o.projA_b, I.a_kv_norm, o.cnb); PH_END
  PH_BEGIN pg8::GroupAOrder S; S.init(o.projA_b, 2048, o.Wql_t, 256, NT, 4096, 4, 512, G_, BIDX()); gemm_phase<EpiStore, pg8::GroupAOrder, true, true>(ll, Gemm{2048, 256, 256}, S, EpiStore{o.qlat, 4096}); PH_END
  PH_BEGIN ph_iscore(o.projA_b, o.sc, I.m_w1, I.m_w2, o.W1_t, o.W2_t); PH_END
  GRID_BAR();
  PH_BEGIN ph_select_attend(o.sc, o.qlat, o.cnb, o.olat, ll, I.m_w1, I.m_w2, o.W1_t, o.W2_t); PH_END
  GRID_BAR();
  PH_BEGIN pg8::GroupAOrder S; S.init(o.olat, 4096, o.Wuv_t, 1024, NT, 1024, 1, 2048, G_, BIDX()); gemm_phase<EpiStore, pg8::GroupAOrder, true, true>(ll, Gemm{4096, 1024, 1024}, S, EpiStore{o.o2b, D}); PH_END
  GRID_BAR();
#if PROBE == 2
  PH_BEGIN cvt_bf16_to_f32(o.projA_b, 2048, w.projA, DINA, NT, DINA, gtid_, NGT_); PH_END
  GRID_BAR();
  PH_BEGIN nvp::np_cnorm(w.projA, I.a_kv_norm, w.cn); PH_END
  PH_BEGIN nvp::np_iscore(w.projA, w.sc, fl); PH_END
  GRID_BAR();
  PH_BEGIN nvp::np_topk(w.sc, w.idx, (char*)lds); PH_END
  GRID_BAR();
  PH_BEGIN nvp::np_dsa_attn(w.projA, w.cn, w.idx, I.a_w_uk, I.a_w_uv, w.o2, fl); PH_END
  GRID_BAR();
  PH_BEGIN { float* pd = (float*)(wsb_ + 1968 * MiB); for (size_t i = gtid_; i < (size_t)NT * D; i += NGT_) pd[i] = bf2f(o.o2b[i]) - w.o2[i]; } PH_END
  GRID_BAR();
#endif
  PH_BEGIN StaticOrder S; S.init(o.o2b, D, o.WoutA_t, D, NT, D, G_, BIDX()); gemm_phase<EpiStore, StaticOrder, true, true>(ll, Gemm{D, D, D}, S, EpiStore{o.hbf, D}); PH_END
  GRID_BAR();
  { LAYER_BODY(0) }
  { LAYER_BODY(1) }
#if PROBE == 2 || PROBE == 3
  GRID_BAR();
#if PROBE == 3
  PH_BEGIN { if (gtid_ == 0) { const unsigned fb = *(const unsigned*)(wsb_ + 512 * 1024); out_[5] += (float)fb; } const float* pd = (const float*)(wsb_ + 1968 * MiB); for (size_t i = gtid_; i < (size_t)NT * D; i += NGT_) out_[i] += PROBE_S * pd[i]; } PH_END
#else
  PH_BEGIN { const float* pd = (const float*)(wsb_ + 1968 * MiB); for (size_t i = gtid_; i < (size_t)NT * D; i += NGT_) out_[i] += PROBE_S * pd[i]; } PH_END
#endif
#endif
}

extern "C" void kernel_launch(void* const* d_in, const int* in_sizes, int n_in, void* d_out, int out_size, void* d_ws, size_t ws_size, hipStream_t stream) {
  static int grid = 0;
  if (grid == 0) {
    if (n_in != 21 || ws_size < WS_NEEDED) { fprintf(stderr, "kernel_launch: bad inputs (n_in %d) or workspace too small (%zu needed, %zu given)\n", n_in, (size_t)WS_NEEDED, ws_size); grid = -1; return; }
    int dev = 0, cus = 0, per_cu = 0;
    if (hipGetDevice(&dev) != hipSuccess || hipDeviceGetAttribute(&cus, hipDeviceAttributeMultiprocessorCount, dev) != hipSuccess) { grid = -1; return; }
    if (hipFuncSetAttribute((const void*)mk_fwd, hipFuncAttributeMaxDynamicSharedMemorySize, LDS_BYTES) != hipSuccess) { fprintf(stderr, "kernel_launch: hipFuncSetAttribute failed\n"); grid = -1; return; }
    if (hipOccupancyMaxActiveBlocksPerMultiprocessor(&per_cu, (const void*)mk_fwd, NTHR, LDS_BYTES) != hipSuccess || per_cu < 1) fprintf(stderr, "kernel_launch: note: occupancy query reports %d\n", per_cu);
    (void)hipGetLastError();
    grid = cus;
    if (grid != 256) fprintf(stderr, "kernel_launch: built for 256 CUs (token ownership per workgroup); got %d\n", grid);
  }
  if (grid < 0) return;
  if (hipMemsetAsync((char*)d_ws + WS_CTL, 0, CTL_ZERO_BYTES, stream) != hipSuccess) { fprintf(stderr, "kernel_launch: memset failed\n"); return; }
  Args a; memset(&a, 0, sizeof(a));
  const float** f = (const float**)&a.in;
  for (int i = 0; i < 21; ++i) f[i] = (const float*)d_in[i];
  a.out = (float*)d_out; a.ws = (unsigned char*)d_ws;
  hipLaunchKernelGGL(mk_fwd, dim3(grid), dim3(NTHR), LDS_BYTES, stream, a);
  const hipError_t le = hipPeekAtLastError();
  if (le != hipSuccess) fprintf(stderr, "kernel_launch: launch failed: %s\n", hipGetErrorName(le));
}
```

```cpp
#include <hip/hip_runtime.h>
#include <cstdio>
#include <cstdint>
#include <cstring>

#define GAS __attribute__((address_space(1)))
#define LAS __attribute__((address_space(3)))
#define NTHR 512
constexpr int LDS_BYTES = 147456;
constexpr int MISC_OFF = 131072 + 8192;

#define XB_TMO      128
#define XB_XCNT(j)  (256  + 64 * (j))
#define XB_XSUB(j)  (1280 + 64 * (j))
#define XB_XGEN(j)  (2304 + 64 * (j))
#define XB_TOP      3328
#define XB_TOPGEN   3392
#define XCD_BAR_WORDS 3456
#define XB_SPIN_CAP (1u << 25)
__device__ __forceinline__ unsigned xb_ld(unsigned* p)              { return __hip_atomic_load(p, __ATOMIC_RELAXED, __HIP_MEMORY_SCOPE_AGENT); }
__device__ __forceinline__ unsigned xb_add(unsigned* p, unsigned v) { return __hip_atomic_fetch_add(p, v, __ATOMIC_RELAXED, __HIP_MEMORY_SCOPE_AGENT); }
__device__ __forceinline__ unsigned xb_xcc_id() { return (unsigned)__builtin_amdgcn_s_getreg((3 << 11) | 20) & 0xFu; }
#define XB_SPIN(cond, bar) do { unsigned _sp = 0; while (cond) { __builtin_amdgcn_s_sleep(1); \
    if ((++_sp & 255u) == 0u) { if (xb_ld(&(bar)[XB_TMO])) break; if (_sp > XB_SPIN_CAP) { atomicAdd(&(bar)[XB_TMO], 1u); break; } } } } while (0)
struct XcdBarrier { unsigned* bar; unsigned x; volatile LAS unsigned* st; };
__device__ __forceinline__ XcdBarrier xcd_barrier_post(unsigned* bar, volatile LAS unsigned* st) {
    XcdBarrier b; b.bar = bar; b.x = xb_xcc_id(); b.st = st;
    if (threadIdx.x == 0) (void)xb_add(&bar[XB_XCNT(b.x)], 1u);
    return b;
}
__device__ __forceinline__ void xcd_barrier_complete(unsigned* bar, unsigned x, unsigned& nloc, unsigned& nx) {
    const unsigned G = gridDim.x * gridDim.y * gridDim.z;
    unsigned sum, cnt, mine, sp = 0u;
    for (;;) {
        sum = 0u; cnt = 0u; mine = 0u;
#pragma unroll
        for (unsigned j = 0; j < 16; ++j) { const unsigned c = xb_ld(&bar[XB_XCNT(j)]); sum += c; cnt += (c > 0u) ? 1u : 0u; mine = (j == x) ? c : mine; }
        if (sum == G) break;
        __builtin_amdgcn_s_sleep(1);
        if ((++sp & 255u) == 0u) { if (xb_ld(&bar[XB_TMO])) break; if (sp > XB_SPIN_CAP) { atomicAdd(&bar[XB_TMO], 1u); break; } }
    }
    nloc = mine > 0u ? mine : 1u; nx = cnt > 0u ? cnt : 1u;
}
__device__ __forceinline__ void xcd_barrier(const XcdBarrier& b) {
    asm volatile("s_waitcnt vmcnt(0)" ::: "memory");
    __syncthreads();
    if (threadIdx.x == 0) {
        unsigned* bar = b.bar;
        __builtin_amdgcn_s_waitcnt(0);
        unsigned nloc = b.st[0], nx = b.st[1];
        if (nloc == 0u) { xcd_barrier_complete(bar, b.x, nloc, nx); b.st[0] = nloc; b.st[1] = nx; }
        const unsigned old = xb_add(&bar[XB_XSUB(b.x)], 1u);
        const unsigned gen = old / nloc;
        if (old + 1u == (gen + 1u) * nloc) {
            __builtin_amdgcn_fence(__ATOMIC_RELEASE, "agent");
            asm volatile("s_waitcnt vmcnt(0)" ::: "memory");
            const unsigned og = xb_add(&bar[XB_TOP], 1u);
            const unsigned tg = og / nx;
            if (og + 1u == (tg + 1u) * nx) xb_add(&bar[XB_TOPGEN], 1u);
            else XB_SPIN(xb_ld(&bar[XB_TOPGEN]) == tg, bar);
            __builtin_amdgcn_fence(__ATOMIC_ACQUIRE, "agent");
            xb_add(&bar[XB_XGEN(b.x)], 1u);
            asm volatile("s_waitcnt vmcnt(0)" ::: "memory");
        } else {
            XB_SPIN(xb_ld(&bar[XB_XGEN(b.x)]) == gen, bar);
            __builtin_amdgcn_fence(__ATOMIC_ACQUIRE, "agent");
            asm volatile("s_waitcnt vmcnt(0)" ::: "memory");
        }
    }
    __syncthreads();
}

constexpr int NT = 16384, D = 1024, L = 8192, NB = 2;
constexpr int DINA = 1864, DINB = 3088;
constexpr int PMAX = 73728;
constexpr float ALPHA = 1.4142135623730951f;

struct In { const float *x, *a_w_in, *a_kv_norm, *a_w_uk, *a_w_uv, *a_w_out, *b_w_in, *b_w_g2, *b_g_bias, *b_norm, *b_w_out, *m_w_router, *m_b_router, *m_w1, *m_b1, *m_w2, *m_b2, *ln1_g, *ln1_b, *ln2_g, *ln2_b; };

__device__ __forceinline__ int TIDX() { int t = threadIdx.x; asm volatile("" : "+v"(t)); return t; }
__device__ __forceinline__ int BIDX() { int t = blockIdx.x; asm volatile("" : "+s"(t)); return t; }
__device__ __forceinline__ float wave_sum(float v) {
#pragma unroll
    for (int o = 1; o < 64; o <<= 1) v += __shfl_xor(v, o);
    return v;
}
namespace nvp {
#define WSYNC() asm volatile("s_waitcnt lgkmcnt(0)" ::: "memory")
struct GemmP {
  const float* A; int lda; const int* arow;
  const float* B; int ldb; float* C; int ldc; int M, N, K;
  const int* blk_e; const int* nblk_used; size_t bstride; const float* bias; size_t bias_stride;
};
__device__ __forceinline__ GemmP mkg(const float* A, int lda, const int* arow, const float* B, int ldb, float* C, int ldc, int M, int N, int K, const int* blk_e, const int* nblk_used, size_t bstride, const float* bias, size_t bias_stride) {
  GemmP p; p.A = A; p.lda = lda; p.arow = arow; p.B = B; p.ldb = ldb; p.C = C; p.ldc = ldc; p.M = M; p.N = N; p.K = K; p.blk_e = blk_e; p.nblk_used = nblk_used; p.bstride = bstride; p.bias = bias; p.bias_stride = bias_stride; return p; }

template <int MODE>
__device__ __forceinline__ void np_sgemm(const GemmP p, float* lds) {
  float (*As)[132] = (float (*)[132])lds;
  float (*Bs)[68] = (float (*)[68])(lds + 16 * 132);
  float (*Bu)[68] = (float (*)[68])(lds + 16 * 132 + 16 * 68);
  const int tid = TIDX(), tx = tid & 15, ty = tid >> 4;
  const int ntn = (p.N + 63) / 64, ntm = p.M / 128;
  const int ar = tid >> 2, ak = (tid & 3) * 4;
  const int bk = (tid & 255) >> 4, bn4 = (tid & 15) * 4;
  for (int t = BIDX(); t < ntm * ntn; t += gridDim.x) {
    const int bm = t / ntn, bn = t % ntn;
    const float* B = p.B; const float* bias = p.bias;
    if (MODE != 0) { const int blk = (bm * 128) / 256; if (blk >= *p.nblk_used) continue; const int e = p.blk_e[blk]; B += (size_t)e * p.bstride; bias += (size_t)e * p.bias_stride; }
    const int m0 = bm * 128, n0 = bn * 64;
    const int arow = p.arow ? p.arow[m0 + ar] : (m0 + ar);
    const float* Ap = p.A + (size_t)arow * p.lda + ak;
    const bool bok = (n0 + bn4) < p.N;
    float acc[4][4] = {}, accu[4][4] = {};
    for (int k0 = 0; k0 < p.K; k0 += 16) {
      const float4 av = *(const float4*)(Ap + k0);
      As[ak + 0][ar] = av.x; As[ak + 1][ar] = av.y; As[ak + 2][ar] = av.z; As[ak + 3][ar] = av.w;
      if (tid < 256) { float4 bv = make_float4(0.f, 0.f, 0.f, 0.f); if (bok) bv = *(const float4*)(B + (size_t)(k0 + bk) * p.ldb + n0 + bn4); *(float4*)&Bs[bk][bn4] = bv; }
      else if (MODE == 1) { const float4 uv = *(const float4*)(B + (size_t)(k0 + bk) * p.ldb + 1024 + n0 + bn4); *(float4*)&Bu[bk][bn4] = uv; }
      __syncthreads();
#pragma unroll
      for (int kk = 0; kk < 16; ++kk) {
        const float4 a = *(const float4*)&As[kk][ty * 4];
        const float4 b = *(const float4*)&Bs[kk][tx * 4];
        const float aa[4] = {a.x, a.y, a.z, a.w}, bb[4] = {b.x, b.y, b.z, b.w};
#pragma unroll
        for (int i = 0; i < 4; ++i)
#pragma unroll
          for (int j = 0; j < 4; ++j) acc[i][j] = fmaf(aa[i], bb[j], acc[i][j]);
        if (MODE == 1) {
          const float4 u = *(const float4*)&Bu[kk][tx * 4]; const float uu[4] = {u.x, u.y, u.z, u.w};
#pragma unroll
          for (int i = 0; i < 4; ++i)
#pragma unroll
            for (int j = 0; j < 4; ++j) accu[i][j] = fmaf(aa[i], uu[j], accu[i][j]);
        }
      }
      __syncthreads();
    }
#pragma unroll
    for (int i = 0; i < 4; ++i) {
      const int m = m0 + ty * 4 + i;
#pragma unroll
      for (int j = 0; j < 4; ++j) {
        const int n = n0 + tx * 4 + j; if (n >= p.N) continue;
        float v = acc[i][j];
        if (MODE == 1) {
          float g = v + bias[n], u = accu[i][j] + bias[1024 + n];
          g = fminf(g, 7.f); u = fminf(fmaxf(u, -7.f), 7.f);
          const float glu = g / (1.f + expf(-1.702f * g));
          v = (u + 1.f) * glu;
        } else if (MODE == 2) v += bias[n];
        p.C[(size_t)m * p.ldc + n] = v;
      }
    }
  }
}

#define GW_INIT const int lane = TIDX() & 63, wave = TIDX() >> 6, gw = BIDX() * 8 + wave, NGW = gridDim.x * 8; (void)lane; (void)wave; (void)gw; (void)NGW

__device__ __forceinline__ void np_cnorm(const float* projA, const float* g, float* cn) {
  GW_INIT;
  for (int row = gw; row < NT; row += NGW) {
    const float4 v = *(const float4*)(projA + (size_t)row * DINA + 1024 + lane * 4);
    const float ss = wave_sum(v.x * v.x + v.y * v.y + v.z * v.z + v.w * v.w);
    const float r = rsqrtf(ss * (1.f / 256.f) + 1e-6f); const float4 g4 = *(const float4*)(g + lane * 4);
    *(float4*)(cn + (size_t)row * 256 + lane * 4) = make_float4(v.x * r * g4.x, v.y * r * g4.y, v.z * r * g4.z, v.w * r * g4.w);
  }
}

__device__ __forceinline__ void np_iscore(const float* projA, float* sc, float* lds) {
  float (*As)[132] = (float (*)[132])lds;
  float (*Bs)[68] = (float (*)[68])(lds + 16 * 132);
  const int tid = TIDX(), tx = tid & 15, ty = tid >> 4;
  const int ar = tid >> 2, ak = (tid & 3) * 4;
  const int br = (tid & 255) >> 2;
  for (int u = BIDX(); u < NB * 64 * 128; u += gridDim.x) {
    const int b = u / (64 * 128), tt = (u / 128) % 64, st = u % 128;
    if (st > 2 * tt + 1) continue;
    const int t0 = tt * 128, s0 = st * 64;
    const float* Qp = projA + (size_t)(b * L + t0 + ar) * DINA + 1280 + ak;
    const float* Kp = projA + (size_t)(b * L + s0 + br) * DINA + 1792 + ak;
    float score[4][4] = {};
    for (int h = 0; h < 8; ++h) {
      float acc[4][4] = {};
      for (int k0 = 0; k0 < 64; k0 += 16) {
        const float4 av = *(const float4*)(Qp + h * 64 + k0);
        As[ak + 0][ar] = av.x; As[ak + 1][ar] = av.y; As[ak + 2][ar] = av.z; As[ak + 3][ar] = av.w;
        if (tid < 256) { const float4 bv = *(const float4*)(Kp + k0); Bs[ak + 0][br] = bv.x; Bs[ak + 1][br] = bv.y; Bs[ak + 2][br] = bv.z; Bs[ak + 3][br] = bv.w; }
        __syncthreads();
#pragma unroll
        for (int kk = 0; kk < 16; ++kk) {
          const float4 a = *(const float4*)&As[kk][ty * 4]; const float4 bq = *(const float4*)&Bs[kk][tx * 4];
          const float aa[4] = {a.x, a.y, a.z, a.w}, bb[4] = {bq.x, bq.y, bq.z, bq.w};
#pragma unroll
          for (int i = 0; i < 4; ++i)
#pragma unroll
            for (int j = 0; j < 4; ++j) acc[i][j] = fmaf(aa[i], bb[j], acc[i][j]);
        }
        __syncthreads();
      }
#pragma unroll
      for (int i = 0; i < 4; ++i) {
        const float w = projA[(size_t)(b * L + t0 + ty * 4 + i) * DINA + 1856 + h] * 0.35355339059327373f;
#pragma unroll
        for (int j = 0; j < 4; ++j) score[i][j] += w * fmaxf(acc[i][j] * 0.125f, 0.f);
      }
    }
#pragma unroll
    for (int i = 0; i < 4; ++i)
#pragma unroll
      for (int j = 0; j < 4; ++j) sc[((size_t)(b * L + t0 + ty * 4 + i)) * L + s0 + tx * 4 + j] = score[i][j];
  }
}

__device__ __forceinline__ unsigned f2key(float f) { f = f + 0.0f; const unsigned u = __float_as_uint(f); return (u & 0x80000000u) ? ~u : (u | 0x80000000u); }

__device__ __forceinline__ void np_topk(const float* sc, int* idx_out, char* lds) {
  GW_INIT;
  unsigned* hist = (unsigned*)(lds + wave * 1280); unsigned* cntw = hist + 256;
  for (int row = gw; row < NT; row += NGW) {
    const int t = row % L, n = t + 1;
    const float* s = sc + (size_t)row * L; int* out = idx_out + (size_t)row * 256;
    if (n <= 256) { for (int i = lane; i < 256; i += 64) out[i] = i < n ? i : -1; continue; }
    unsigned prefix = 0, need = 256;
    for (int pass = 3; pass >= 0; --pass) {
      const int shift = pass * 8;
      for (int i = lane; i < 256; i += 64) hist[i] = 0;
      WSYNC();
      for (int i = lane; i < n; i += 64) { const unsigned k = f2key(s[i]); const bool m = (pass == 3) || ((k >> (shift + 8)) == (prefix >> (shift + 8))); if (m) atomicAdd(&hist[(k >> shift) & 255u], 1u); }
      WSYNC();
      unsigned cum = 0; int d = 255; for (; d > 0; --d) { const unsigned hv = hist[d]; if (cum + hv >= need) break; cum += hv; }
      prefix |= ((unsigned)d << shift); need -= cum;
      WSYNC();
    }
    if (lane == 0) *cntw = 0; WSYNC();
    for (int i = lane; i < n; i += 64) { if (f2key(s[i]) > prefix) { const unsigned pos = atomicAdd(cntw, 1u); out[pos] = i; } }
    WSYNC();
    if (lane == 0) { unsigned c = *cntw; unsigned nd = need; for (int i = 0; i < n && nd > 0; ++i) if (f2key(s[i]) == prefix) { out[c++] = i; --nd; } }
    WSYNC();
  }
}

__device__ __forceinline__ void np_dsa_attn(const float* projA, const float* cn, const int* idx, const float* w_uk, const float* w_uv, float* o2, float* lds) {
  const int half = TIDX() >> 8, tid = TIDX() & 255;
  float* base = lds + half * 14336;
  float* qs = base; float (*ql)[256] = (float (*)[256])(base + 1024); float (*pr)[257] = (float (*)[257])(base + 1024 + 4096);
  float (*ol)[256] = (float (*)[256])(base + 1024 + 4096 + 4112); float* red = base + 1024 + 4096 + 4112 + 4096; int* sid = (int*)(red + 16);
  for (int r0 = BIDX() * 2; r0 < NT; r0 += gridDim.x * 2) {
    const int row = r0 + half, b = row / L;
    __syncthreads();
    for (int i = tid; i < 1024; i += 256) qs[i] = projA[(size_t)row * DINA + i];
    sid[tid] = idx[(size_t)row * 256 + tid];
    __syncthreads();
    { const int c = tid;
#pragma unroll 1
      for (int h = 0; h < 16; ++h) { float a = 0.f;
#pragma unroll 8
        for (int d = 0; d < 64; ++d) a = fmaf(qs[h * 64 + d], w_uk[((size_t)h * 64 + d) * 256 + c], a); ql[h][c] = a; } }
    __syncthreads();
    { const int k = tid, key = sid[k];
      float lg[16];
      if (key >= 0) { const float* cr = cn + (size_t)(b * L + key) * 256;
        for (int h = 0; h < 16; ++h) lg[h] = 0.f;
#pragma unroll 2
        for (int c = 0; c < 256; ++c) { const float cv = cr[c];
#pragma unroll
          for (int h = 0; h < 16; ++h) lg[h] = fmaf(ql[h][c], cv, lg[h]); }
#pragma unroll
        for (int h = 0; h < 16; ++h) pr[h][k] = lg[h] * 0.125f;
      } else {
#pragma unroll
        for (int h = 0; h < 16; ++h) pr[h][k] = -INFINITY; } }
    __syncthreads();
    if (tid < 16) { const int h = tid; float m = -INFINITY; for (int k = 0; k < 256; ++k) m = fmaxf(m, pr[h][k]); float su = 0.f; for (int k = 0; k < 256; ++k) { const float e = expf(pr[h][k] - m); pr[h][k] = e; su += e; } red[h] = 1.f / su; }
    __syncthreads();
    { const int c = tid; float a[16];
#pragma unroll
      for (int h = 0; h < 16; ++h) a[h] = 0.f;
#pragma unroll 2
      for (int k = 0; k < 256; ++k) { const int key = sid[k]; if (key < 0) continue; const float cv = cn[(size_t)(b * L + key) * 256 + c];
#pragma unroll
        for (int h = 0; h < 16; ++h) a[h] = fmaf(pr[h][k], cv, a[h]); }
#pragma unroll
      for (int h = 0; h < 16; ++h) ol[h][c] = a[h] * red[h]; }
    __syncthreads();
#pragma unroll 1
    for (int o = tid; o < 1024; o += 256) { const int h = o >> 6, v = o & 63; float a = 0.f;
#pragma unroll 8
      for (int c = 0; c < 256; ++c) a = fmaf(ol[h][c], w_uv[((size_t)h * 256 + c) * 64 + v], a); o2[(size_t)row * 1024 + o] = a; }
  }
  __syncthreads();
}

__device__ __forceinline__ void np_ln_res(const float* x, const float* h, const float* g, const float* bb, float* out) {
  GW_INIT;
  for (int row = gw; row < NT; row += NGW) {
    float4 v[4]; float s = 0.f;
#pragma unroll
    for (int j = 0; j < 4; ++j) { const float4 a = *(const float4*)(x + (size_t)row * D + lane * 4 + 256 * j), hh = *(const float4*)(h + (size_t)row * D + lane * 4 + 256 * j);
      v[j] = make_float4(ALPHA * a.x + hh.x, ALPHA * a.y + hh.y, ALPHA * a.z + hh.z, ALPHA * a.w + hh.w); s += (v[j].x + v[j].y) + (v[j].z + v[j].w); }
    const float mu = wave_sum(s) * (1.f / D); float q = 0.f;
#pragma unroll
    for (int j = 0; j < 4; ++j) { v[j].x -= mu; v[j].y -= mu; v[j].z -= mu; v[j].w -= mu; q += (v[j].x * v[j].x + v[j].y * v[j].y) + (v[j].z * v[j].z + v[j].w * v[j].w); }
    const float r = rsqrtf(wave_sum(q) * (1.f / D) + 1e-5f);
#pragma unroll
    for (int j = 0; j < 4; ++j) { const int c = lane * 4 + 256 * j; const float4 g4 = *(const float4*)(g + c), b4 = *(const float4*)(bb + c);
      *(float4*)(out + (size_t)row * D + c) = make_float4(v[j].x * r * g4.x + b4.x, v[j].y * r * g4.y + b4.y, v[j].z * r * g4.z + b4.z, v[j].w * r * g4.w + b4.w); }
  }
}

__device__ __forceinline__ void np_router(const float* x, const float* wr, const float* br, int* tok_e, float* tok_g, int* counts, int* row_tok, char* lds) {
  GW_INIT;
  for (int i = BIDX() * NTHR + TIDX(); i < PMAX; i += gridDim.x * NTHR) row_tok[i] = 0;
  float* lg = (float*)(lds + wave * 256);
  const int e = lane & 31, hf = lane >> 5;
  for (int tok = gw; tok < NT; tok += NGW) {
    const float* xr = x + (size_t)tok * D + hf * 512; const float* wp = wr + (size_t)hf * 512 * 32 + e; float a = 0.f;
#pragma unroll 8
    for (int d = 0; d < 512; ++d) a = fmaf(xr[d], wp[d * 32], a);
    a += __shfl_xor(a, 32);
    if (hf == 0) lg[e] = a + br[e];
    WSYNC();
    if (lane == 0) { int ei[4]; float ev[4];
      for (int k = 0; k < 4; ++k) { int bi = 0; float bv = -INFINITY; for (int j = 0; j < 32; ++j) if (lg[j] > bv) { bv = lg[j]; bi = j; } ei[k] = bi; ev[k] = bv; lg[bi] = -INFINITY; }
      float su = 0.f, ex[4]; for (int k = 0; k < 4; ++k) { ex[k] = expf(ev[k] - ev[0]); su += ex[k]; }
      for (int k = 0; k < 4; ++k) { tok_e[tok * 4 + k] = ei[k]; tok_g[tok * 4 + k] = ex[k] / su; atomicAdd(&counts[ei[k]], 1); } }
    WSYNC();
  }
}
__device__ __forceinline__ void np_moe_sort(const int* tok_e, const float* tok_g, const int* counts, int* row_tok, float* row_gate, int* slot_of, int* blk_e, int* nblk_used, char* lds) {
  if (BIDX() != 0) return;
  const int e = TIDX(); int* pstart = (int*)lds; int* stage = pstart + 64;
  if (e == 0) { int acc = 0; for (int j = 0; j < 32; ++j) { pstart[j] = acc; const int nb = (counts[j] + 255) / 256; for (int q = 0; q < nb; ++q) blk_e[acc / 256 + q] = j; acc += nb * 256; } pstart[32] = acc; *nblk_used = acc / 256; }
  __syncthreads();
  int pos = e < 32 ? pstart[e] : 0;
  for (int c0 = 0; c0 < NT * 4; c0 += 2048) {
    __syncthreads();
    for (int i = e; i < 2048; i += NTHR) stage[i] = tok_e[c0 + i];
    __syncthreads();
    if (e < 32) for (int i = 0; i < 2048; ++i) if (stage[i] == e) { const int gi = c0 + i; row_tok[pos] = gi >> 2; row_gate[pos] = tok_g[gi]; slot_of[gi] = pos; ++pos; }
  }
  __syncthreads();
}
__device__ __forceinline__ void np_moe_combine_ln(const float* x1, const float* ys, const int* slot_of, const float* tok_g, const float* g, const float* bb, float* out) {
  GW_INIT;
  for (int row = gw; row < NT; row += NGW) {
    float4 v[4]; float s = 0.f; int sl[4]; float gg[4];
#pragma unroll
    for (int k = 0; k < 4; ++k) { sl[k] = slot_of[row * 4 + k]; gg[k] = tok_g[row * 4 + k]; }
#pragma unroll
    for (int j = 0; j < 4; ++j) { const int c = lane * 4 + 256 * j; float4 f = make_float4(0.f, 0.f, 0.f, 0.f);
#pragma unroll
      for (int k = 0; k < 4; ++k) { const float4 y = *(const float4*)(ys + (size_t)sl[k] * D + c); f.x += gg[k] * y.x; f.y += gg[k] * y.y; f.z += gg[k] * y.z; f.w += gg[k] * y.w; }
      const float4 a = *(const float4*)(x1 + (size_t)row * D + c);
      v[j] = make_float4(ALPHA * a.x + f.x, ALPHA * a.y + f.y, ALPHA * a.z + f.z, ALPHA * a.w + f.w); s += (v[j].x + v[j].y) + (v[j].z + v[j].w); }
    const float mu = wave_sum(s) * (1.f / D); float q = 0.f;
#pragma unroll
    for (int j = 0; j < 4; ++j) { v[j].x -= mu; v[j].y -= mu; v[j].z -= mu; v[j].w -= mu; q += (v[j].x * v[j].x + v[j].y * v[j].y) + (v[j].z * v[j].z + v[j].w * v[j].w); }
    const float r = rsqrtf(wave_sum(q) * (1.f / D) + 1e-5f);
#pragma unroll
    for (int j = 0; j < 4; ++j) { const int c = lane * 4 + 256 * j; const float4 g4 = *(const float4*)(g + c), b4 = *(const float4*)(bb + c);
      *(float4*)(out + (size_t)row * D + c) = make_float4(v[j].x * r * g4.x + b4.x, v[j].y * r * g4.y + b4.y, v[j].z * r * g4.z + b4.z, v[j].w * r * g4.w + b4.w); }
  }
}

__device__ __forceinline__ void np_gla_gate(const float* projB, const float* w_g2, const float* gb, float* adec) {
  GW_INIT;
  for (int row = gw; row < NT; row += NGW) {
    float glr[16];
#pragma unroll
    for (int j = 0; j < 16; ++j) glr[j] = projB[(size_t)row * DINB + 2048 + j];
    for (int c = lane; c < 512; c += 64) { float a = gb[c];
#pragma unroll
      for (int j = 0; j < 16; ++j) a = fmaf(glr[j], w_g2[j * 512 + c], a);
      const float ls = fminf(a, 0.f) - log1pf(expf(-fabsf(a))); adec[(size_t)row * 512 + c] = expf(ls * (1.f / 16.f)); }
  }
}
__device__ __forceinline__ void np_gla_scan(const float* projB, const float* adec, float* og, float* lds) {
  if (BIDX() >= 8) return;
  const int b = BIDX() >> 2, h = BIDX() & 3, tid = TIDX(), dv = tid & 255, dh = tid >> 8;
  float (*qs)[128] = (float (*)[128])lds; float (*ks)[128] = (float (*)[128])(lds + 2048); float (*as)[128] = (float (*)[128])(lds + 4096);
  float (*po)[16][256] = (float (*)[16][256])(lds + 6144);
  float S[64];
#pragma unroll
  for (int d = 0; d < 64; ++d) S[d] = 0.f;
  for (int t0 = 0; t0 < L; t0 += 16) {
    __syncthreads();
    for (int i = tid; i < 16 * 128; i += NTHR) { const int tt = i >> 7, d = i & 127; const size_t r = (size_t)(b * L + t0 + tt);
      qs[tt][d] = projB[r * DINB + h * 128 + d] * 0.08838834764831845f; ks[tt][d] = projB[r * DINB + 512 + h * 128 + d]; as[tt][d] = adec[r * 512 + h * 128 + d]; }
    __syncthreads();
#pragma unroll 1
    for (int tt = 0; tt < 16; ++tt) { const size_t r = (size_t)(b * L + t0 + tt); const float v = projB[r * DINB + 1024 + h * 256 + dv]; float o = 0.f;
#pragma unroll
      for (int d = 0; d < 64; ++d) { S[d] = fmaf(as[tt][dh * 64 + d], S[d], ks[tt][dh * 64 + d] * v); o = fmaf(qs[tt][dh * 64 + d], S[d], o); }
      po[dh][tt][dv] = o; }
    __syncthreads();
    for (int i = tid; i < 16 * 256; i += NTHR) { const int tt = i >> 8, c = i & 255; og[(size_t)(b * L + t0 + tt) * 1024 + h * 256 + c] = po[0][tt][c] + po[1][tt][c]; }
  }
  __syncthreads();
}
__device__ __forceinline__ void np_gla_norm(const float* og, const float* projB, const float* ng, float* on) {
  GW_INIT;
  for (int u = gw; u < NT * 4; u += NGW) {
    const int row = u >> 2, h = u & 3; const int c = h * 256 + lane * 4;
    const float4 v = *(const float4*)(og + (size_t)row * 1024 + c);
    const float r = rsqrtf(wave_sum(v.x * v.x + v.y * v.y + v.z * v.z + v.w * v.w) * (1.f / 256.f) + 1e-6f);
    const float4 rr = *(const float4*)(projB + (size_t)row * DINB + 2064 + c), g4 = *(const float4*)(ng + c);
    *(float4*)(on + (size_t)row * 1024 + c) = make_float4(v.x * r * g4.x * (rr.x / (1.f + expf(-rr.x))), v.y * r * g4.y * (rr.y / (1.f + expf(-rr.y))), v.z * r * g4.z * (rr.z / (1.f + expf(-rr.z))), v.w * r * g4.w * (rr.w / (1.f + expf(-rr.w))));
  }
}

struct Ws { float *projA, *cn, *sc, *o2, *h, *x1, *x2, *hb, *ys, *projB, *adec, *og, *on, *tok_g, *row_gate; int *idx, *tok_e, *slot_of, *row_tok, *blk_e, *counts; };
}
typedef unsigned short bf16_t;
typedef unsigned v4u __attribute__((ext_vector_type(4)));
typedef unsigned v2u __attribute__((ext_vector_type(2)));
typedef float f32x4 __attribute__((ext_vector_type(4)));
typedef short bf16x8 __attribute__((ext_vector_type(8)));
typedef float f32x2_t __attribute__((ext_vector_type(2))); typedef __bf16 bf16x2_t __attribute__((ext_vector_type(2)));
__device__ __forceinline__ unsigned cvt_pk_bf16(float lo, float hi) { const f32x2_t v = {lo, hi}; const bf16x2_t b = __builtin_convertvector(v, bf16x2_t); return __builtin_bit_cast(unsigned, b); }
__device__ __forceinline__ float bf_lo(unsigned u) { return __uint_as_float(u << 16); }
__device__ __forceinline__ float bf_hi(unsigned u) { return __uint_as_float(u & 0xffff0000u); }
__device__ __forceinline__ float bf2f(bf16_t h) { return __uint_as_float(((unsigned)h) << 16); }

struct TJob { const float* src; int lds_; int K, N; bf16_t* dst; int ldd; int drow0, dcol0; int rowmap; int ntk, ntn; };
__device__ __forceinline__ TJob mk_tjob(const float* src, int lds_, int K, int N, bf16_t* dst, int ldd, int drow0, int dcol0, int rowmap) {
  TJob j; j.src = src; j.lds_ = lds_; j.K = K; j.N = N; j.dst = dst; j.ldd = ldd; j.drow0 = drow0; j.dcol0 = dcol0; j.rowmap = rowmap; j.ntk = K / 64; j.ntn = (N + 127) / 128; return j; }
__device__ __forceinline__ int tjob_tiles(const TJob& j) { return j.ntk * j.ntn; }
__device__ __forceinline__ void transpose_tile(const TJob& j, int tile, int lane) {
  const int kt = tile / j.ntn, nt_ = tile % j.ntn, k0 = kt * 64, n0 = nt_ * 128;
  const int q = lane & 31, par = lane >> 5;
  const bool ok = (n0 + 4 * q) < j.N;
  f32x4 v[32];
  const float* sp = j.src + (size_t)(k0 + par) * j.lds_ + n0 + 4 * q;
#pragma unroll
  for (int i = 0; i < 32; ++i) v[i] = ok ? *(const f32x4*)(sp + (size_t)(2 * i) * j.lds_) : (f32x4){0.f, 0.f, 0.f, 0.f};
  unsigned ra[32], rb[32];
#pragma unroll
  for (int i = 0; i < 32; ++i) {
    auto s0 = __builtin_amdgcn_permlane32_swap(__float_as_uint(v[i][0]), __float_as_uint(v[i][2]), false, false);
    auto s1 = __builtin_amdgcn_permlane32_swap(__float_as_uint(v[i][1]), __float_as_uint(v[i][3]), false, false);
    ra[i] = cvt_pk_bf16(__uint_as_float(s0[0]), __uint_as_float(s0[1]));
    rb[i] = cvt_pk_bf16(__uint_as_float(s1[0]), __uint_as_float(s1[1]));
  }
  if (ok) {
    const int n = n0 + 4 * q + 2 * par;
    int r0 = n, r1 = n + 1;
    if (j.rowmap == 1) { const int jj0 = r0 & 1023, jj1 = r1 & 1023; r0 = 256 * (jj0 >> 7) + ((r0 >> 10) << 7) + (jj0 & 127); r1 = 256 * (jj1 >> 7) + ((r1 >> 10) << 7) + (jj1 & 127); }
    bf16_t* d0 = j.dst + (size_t)(j.drow0 + r0) * j.ldd + j.dcol0 + k0;
    bf16_t* d1 = j.dst + (size_t)(j.drow0 + r1) * j.ldd + j.dcol0 + k0;
#pragma unroll
    for (int c = 0; c < 8; ++c) { *(v4u*)(d0 + 8 * c) = (v4u){ra[4 * c], ra[4 * c + 1], ra[4 * c + 2], ra[4 * c + 3]}; *(v4u*)(d1 + 8 * c) = (v4u){rb[4 * c], rb[4 * c + 1], rb[4 * c + 2], rb[4 * c + 3]}; }
  }
}
__device__ __forceinline__ void transpose_job(const TJob j, int& w0, int gw, int NGW, int lane) {
  const int nt_ = tjob_tiles(j);
  int first = gw - (w0 % NGW); if (first < 0) first += NGW;
#pragma unroll 1
  for (int t = first; t < nt_; t += NGW) transpose_tile(j, t, lane);
  w0 += nt_;
}
__device__ __forceinline__ void zero_rect(bf16_t* dst, int ldd, int r0, int nr, int cb0, int nbytes, int gtid, int NGT) {
  const int per = nbytes / 16;
  for (int i = gtid; i < nr * per; i += NGT) { const int r = i / per, c = i % per; *(v4u*)((char*)(dst + (size_t)(r0 + r) * ldd) + cb0 + 16 * c) = (v4u){0u, 0u, 0u, 0u}; }
}
__device__ __forceinline__ void cvt_f32_to_bf16(const float* src, int lds_, bf16_t* dst, int ldd, int rows, int ncols, int gtid, int NGT) {
  const int per = ncols / 4;
  for (size_t i = gtid; i < (size_t)rows * per; i += NGT) { const size_t r = i / per; const int c = (int)(i % per) * 4; const f32x4 v = *(const f32x4*)(src + r * lds_ + c);
    *(v2u*)(dst + r * ldd + c) = (v2u){cvt_pk_bf16(v[0], v[1]), cvt_pk_bf16(v[2], v[3])}; }
}
__device__ __forceinline__ void cvt_bf16_to_f32(const bf16_t* src, int lds_, float* dst, int ldd, int rows, int ncols, int gtid, int NGT) {
  const int per = ncols / 4;
  for (size_t i = gtid; i < (size_t)rows * per; i += NGT) { const size_t r = i / per; const int c = (int)(i % per) * 4; const v2u v = *(const v2u*)(src + r * lds_ + c);
    *(f32x4*)(dst + r * ldd + c) = (f32x4){bf_lo(v[0]), bf_hi(v[0]), bf_lo(v[1]), bf_hi(v[1])}; }
}

namespace pg8 {
#define PG8_LAS __attribute__((address_space(3)))
typedef unsigned u32x4 __attribute__((ext_vector_type(4)));
constexpr int BM = 256, BK = 64, HALF = 128, HTB = HALF * BK * 2, STAGE_BYTES = 8 * HTB, NXCD = 8, WGM = 8;
__host__ __device__ __forceinline__ int lds_byte(int r, int c) { const int st = (r >> 4) * 2 + (c >> 5), rr = r & 15, cc = c & 31, ob = rr * 64 + cc * 2; return st * 1024 + (ob ^ (((ob >> 9) & 1) << 5)); }
__host__ __device__ __forceinline__ void stage_rc(int b, int& R, int& C) { const int st = b / 1024, sb = b % 1024, swz = sb ^ (((sb >> 9) & 1) << 5); R = (st >> 1) * 16 + swz / 64; C = (st & 1) * 32 + (swz % 64) / 2; }
__host__ __device__ __forceinline__ int perm32(int rho) { const int n = rho >> 4, i = rho & 15; return 8 * (i >> 2) + 4 * n + (i & 3); }
struct Unit { const char* pa; const char* pb; int orow, ocol, e, kind; };
struct Gemm { int lda, ldb, K; };
struct StaticOrder {
    static constexpr bool GATHER = false; const int* rowmap;
    const char* A; const char* Bt; size_t ta, tb; int nM, nN, nwg, G, c;
    __device__ void init(const void* A_, int lda, const void* Bt_, int ldb, int M, int N, int G_, int c_) { A = (const char*)A_; Bt = (const char*)Bt_; ta = (size_t)BM * lda * 2; tb = (size_t)BM * ldb * 2; nM = M / BM; nN = N / BM; nwg = nM * nN; G = G_; c = c_; }
    __device__ bool tile(int i, int& pm, int& pn) const {
        const long L = (long)i * G + c; if (L >= nwg) return false;
        int wgid = (int)L; { const int q = nwg / NXCD, r = nwg % NXCD, xcd = wgid % NXCD, off = wgid / NXCD; wgid = (xcd < r ? xcd * (q + 1) : r * (q + 1) + (xcd - r) * q) + off; }
        const int nig = WGM * nN, gid = wgid / nig, fm = gid * WGM, gsz = (nM - fm) < WGM ? (nM - fm) : WGM;
        pm = fm + ((wgid % nig) % gsz); pn = (wgid % nig) / gsz; return true;
    }
    __device__ bool next(int i, Unit& u) const { int pm, pn; if (!tile(i, pm, pn)) return false; u.pa = A + (size_t)pm * ta; u.pb = Bt + (size_t)pn * tb; u.orow = pm * BM; u.ocol = pn * BM; u.e = 0; u.kind = 0; return true; }
    __device__ __forceinline__ int rowof(const Unit&, int r) const { return r; }
    __device__ __forceinline__ void a_ready(const Unit&) const {}
    __device__ __forceinline__ void done(const Unit&) const {}
};
struct EpiStore {
    static constexpr bool PERM = true, AFTER_DRAIN = false;
    bf16_t* O; int ldc;
    __device__ __forceinline__ void operator()(const f32x4 (&acc)[2][2][4][2], const Unit& u, int wr, int wc, int fr, int fq) const {
        const int row0 = u.orow + wr * 64 + fr, col0 = u.ocol + wc * 32 + 8 * fq;
#pragma unroll
        for (int ai = 0; ai < 2; ++ai)
#pragma unroll
            for (int m = 0; m < 4; ++m) { bf16_t* rowp = O + (size_t)(row0 + ai * HALF + m * 16) * ldc + col0;
#pragma unroll
                for (int bj = 0; bj < 2; ++bj) { const f32x4 v0 = acc[ai][bj][m][0], v1 = acc[ai][bj][m][1];
                    u32x4 w; w.x = cvt_pk_bf16(v0[0], v0[1]); w.y = cvt_pk_bf16(v0[2], v0[3]); w.z = cvt_pk_bf16(v1[0], v1[1]); w.w = cvt_pk_bf16(v1[2], v1[3]);
                    *(u32x4*)(rowp + bj * HALF) = w; } }
    }
};
template <class Epi, class Sched, bool ALIGN_EPI = false, bool SP2 = false>
__device__ __forceinline__ void gemm_phase(PG8_LAS unsigned char* lds, const Gemm g, const Sched& S, const Epi& E) {
    const int tid = TIDX(), wid = __builtin_amdgcn_readfirstlane(tid >> 6), lane = tid & 63, wr = wid >> 2, wc = wid & 3, fr = lane & 15, fq = lane >> 4;
    const int K = g.K, nt = K / BK;
    unsigned voffA[2], voffB[2];
#pragma unroll
    for (int i = 0; i < 2; ++i) { int R, C; stage_rc(tid * 16 + i * 8192, R, C); const int Rb = Epi::PERM ? ((R & ~31) + perm32(R & 31)) : R;
        voffA[i] = (unsigned)(R * g.lda + C) * 2u; voffB[i] = (unsigned)(Rb * g.ldb + C) * 2u; }
    unsigned voffG[2][2][2]; int gR[2], gC[2];
#pragma unroll
    for (int i = 0; i < 2; ++i) { int R, C; stage_rc(tid * 16 + i * 8192, R, C); gR[i] = R; gC[i] = C; }
#define PG8_GOFF(dst, unit_) do { if constexpr (Sched::GATHER) { _Pragma("unroll") for (int _h = 0; _h < 2; ++_h) _Pragma("unroll") for (int _i = 0; _i < 2; ++_i) \
        dst[_h][_i] = (unsigned)S.rowof(unit_, (unit_).orow + _h * HALF + gR[_i]) * (unsigned)(g.lda * 2) + (unsigned)gC[_i] * 2u; } } while (0)
#define PG8_STAGE_A(bufoff, gptr, half, vsel) do { if constexpr (Sched::GATHER) { PG8_STAGE(bufoff, gptr, vsel); } else { PG8_STAGE(bufoff, (gptr) + (half) * hstepA, voffA); } } while (0)
    const size_t kstep = (size_t)(BK * 2);
    const size_t hstepA = (size_t)HALF * g.lda * 2, hstepB = (size_t)HALF * g.ldb * 2;
    const unsigned ldsw = (unsigned)wid * 1024u;
    const int aoff = lds_byte(wr * 64 + fr, fq * 8), boff = lds_byte(wc * 32 + fr, fq * 8);
#define PG8_SA(b, h) (((b) * 2 + (h)) * HTB)
#define PG8_SB(b, h) ((4 + (b) * 2 + (h)) * HTB)
#define PG8_STAGE(bufoff, gbase, voff) do { _Pragma("unroll") for (int _i = 0; _i < 2; ++_i) \
        __builtin_amdgcn_global_load_lds((const unsigned*)((const char*)(gbase) + (voff)[_i]), (PG8_LAS unsigned*)(lds + (bufoff) + ldsw + _i * 8192), 16, 0, 0); } while (0)
#define PG8_LDA(dst, b, h) do { _Pragma("unroll") for (int m = 0; m < 4; ++m) _Pragma("unroll") for (int k = 0; k < 2; ++k) dst[m][k] = *(const PG8_LAS bf16x8*)(lds + PG8_SA(b, h) + aoff + m * 2048 + k * 1024); } while (0)
#define PG8_LDB(dst, b, h) do { _Pragma("unroll") for (int n = 0; n < 2; ++n) _Pragma("unroll") for (int k = 0; k < 2; ++k) dst[n][k] = *(const PG8_LAS bf16x8*)(lds + PG8_SB(b, h) + boff + n * 2048 + k * 1024); } while (0)
#define PG8_MMA(ai, bj, At, Bt) do { __builtin_amdgcn_s_setprio(1); _Pragma("unroll") for (int m = 0; m < 4; ++m) _Pragma("unroll") for (int n = 0; n < 2; ++n) _Pragma("unroll") for (int k = 0; k < 2; ++k) \
        acc[ai][bj][m][n] = __builtin_amdgcn_mfma_f32_16x16x32_bf16(Bt[n][k], At[m][k], acc[ai][bj][m][n], 0, 0, 0); __builtin_amdgcn_s_setprio(0); } while (0)
#define PG8_WAIT_V(n) asm volatile("s_waitcnt vmcnt(" #n ")" ::: "memory")
#define PG8_WAIT_L(n) asm volatile("s_waitcnt lgkmcnt(" #n ")" ::: "memory")
#define PG8_BAR __builtin_amdgcn_s_barrier()
#define PG8_SCHED __builtin_amdgcn_sched_barrier(0)
    Unit cur, nxt; int ui = 0;
    if (!S.next(0, cur)) return;
    f32x4 acc[2][2][4][2];
#pragma unroll
    for (int a = 0; a < 2; ++a)
#pragma unroll
        for (int b = 0; b < 2; ++b)
#pragma unroll
            for (int m = 0; m < 4; ++m)
#pragma unroll
                for (int n = 0; n < 2; ++n) acc[a][b][m][n] = (f32x4){0.f, 0.f, 0.f, 0.f};
    bf16x8 At[4][2], B0[2][2], B1[2][2];
    const char* cA = cur.pa; const char* cB = cur.pb;
    S.a_ready(cur);
    PG8_GOFF(voffG[0], cur);
    if constexpr (SP2) {
        PG8_STAGE(PG8_SB(0, 0), cB, voffB); PG8_STAGE(PG8_SB(0, 1), cB + hstepB, voffB); PG8_STAGE_A(PG8_SA(0, 0), cA, 0, voffG[0][0]); PG8_STAGE_A(PG8_SA(0, 1), cA, 1, voffG[0][1]);
        if (wr == 1) PG8_BAR;
        PG8_WAIT_V(2); PG8_BAR;
        PG8_STAGE(PG8_SB(1, 0), cB + kstep, voffB); PG8_STAGE_A(PG8_SA(1, 0), cA + kstep, 0, voffG[0][0]); PG8_STAGE(PG8_SB(1, 1), cB + hstepB + kstep, voffB);
        PG8_WAIT_V(6); PG8_BAR;
    } else {
        PG8_STAGE(PG8_SB(0, 0), cB, voffB); PG8_STAGE_A(PG8_SA(0, 0), cA, 0, voffG[0][0]); PG8_STAGE(PG8_SB(0, 1), cB + hstepB, voffB); PG8_STAGE_A(PG8_SA(0, 1), cA, 1, voffG[0][1]);
        if (wr == 1) PG8_BAR;
        PG8_WAIT_V(4); PG8_BAR;
        PG8_STAGE(PG8_SB(1, 0), cB + kstep, voffB); PG8_STAGE_A(PG8_SA(1, 0), cA + kstep, 0, voffG[0][0]); PG8_STAGE(PG8_SB(1, 1), cB + hstepB + kstep, voffB);
        PG8_WAIT_V(6); PG8_BAR;
    }
    for (;;) {
        const bool has_next = S.next(ui + 1, nxt);
        if constexpr (Sched::GATHER) { if (has_next) { PG8_GOFF(voffG[1], nxt); } else {
#pragma unroll
            for (int _h = 0; _h < 2; ++_h)
#pragma unroll
                for (int _i = 0; _i < 2; ++_i) voffG[1][_h][_i] = voffG[0][_h][_i]; } }
        const char* nA = has_next ? nxt.pa : cA; const char* nB = has_next ? nxt.pb : cB;
        for (int t = 0; t < nt; t += 2) {
            const bool last = (t == nt - 2);
            const char* a1 = cA + (size_t)(t + 1) * kstep;
            const char* a2 = last ? nA : cA + (size_t)(t + 2) * kstep; const char* b2 = last ? nB : cB + (size_t)(t + 2) * kstep;
            const char* a3 = a2 + kstep; const char* b3 = b2 + kstep;
            unsigned vs0[2], vs1[2];
#pragma unroll
            for (int _i = 0; _i < 2; ++_i) { vs0[_i] = last ? voffG[1][0][_i] : voffG[0][0][_i]; vs1[_i] = last ? voffG[1][1][_i] : voffG[0][1][_i]; }
            if (last && has_next) S.a_ready(nxt);
            if constexpr (SP2) {
            PG8_LDB(B0, 0, 0); PG8_LDB(B1, 0, 1); PG8_SCHED; PG8_LDA(At, 0, 0); PG8_STAGE_A(PG8_SA(1, 1), a1, 1, voffG[0][1]);
            PG8_WAIT_V(8); PG8_WAIT_L(0); PG8_BAR; PG8_MMA(0, 0, At, B0); PG8_MMA(0, 1, At, B1); PG8_BAR; PG8_SCHED;
            PG8_LDA(At, 0, 1); PG8_STAGE(PG8_SB(0, 0), b2, voffB); PG8_STAGE(PG8_SB(0, 1), b2 + hstepB, voffB); PG8_STAGE_A(PG8_SA(0, 0), a2, 0, vs0);
            PG8_WAIT_V(8); PG8_WAIT_L(0); PG8_BAR; PG8_MMA(1, 0, At, B0); PG8_MMA(1, 1, At, B1); PG8_BAR; PG8_SCHED;
            PG8_LDB(B0, 1, 0); PG8_LDB(B1, 1, 1); PG8_SCHED; PG8_LDA(At, 1, 0); PG8_STAGE_A(PG8_SA(0, 1), a2, 1, vs1);
            PG8_WAIT_V(8); PG8_WAIT_L(0); PG8_BAR; PG8_MMA(0, 0, At, B0); PG8_MMA(0, 1, At, B1); PG8_BAR; PG8_SCHED;
            PG8_LDA(At, 1, 1); PG8_STAGE(PG8_SB(1, 0), b3, voffB); PG8_STAGE(PG8_SB(1, 1), b3 + hstepB, voffB); PG8_STAGE_A(PG8_SA(1, 0), a3, 0, vs0);
            PG8_WAIT_V(8); PG8_WAIT_L(0); PG8_BAR; PG8_MMA(1, 0, At, B0); PG8_MMA(1, 1, At, B1); PG8_BAR; PG8_SCHED;
            } else {
            PG8_LDB(B0, 0, 0); PG8_SCHED; PG8_LDA(At, 0, 0); PG8_STAGE_A(PG8_SA(1, 1), a1, 1, voffG[0][1]);
            PG8_WAIT_L(8); PG8_BAR; PG8_WAIT_L(0); PG8_MMA(0, 0, At, B0); PG8_BAR; PG8_SCHED;
            PG8_LDB(B1, 0, 1); PG8_STAGE(PG8_SB(0, 0), b2, voffB);
            PG8_BAR; PG8_WAIT_L(0); PG8_MMA(0, 1, At, B1); PG8_BAR;
            PG8_LDA(At, 0, 1); PG8_STAGE_A(PG8_SA(0, 0), a2, 0, vs0);
            PG8_BAR; PG8_WAIT_L(0); PG8_MMA(1, 0, At, B0); PG8_BAR; PG8_SCHED;
            PG8_STAGE(PG8_SB(0, 1), b2 + hstepB, voffB);
            PG8_WAIT_V(6); PG8_BAR; PG8_MMA(1, 1, At, B1); PG8_BAR;
            PG8_LDB(B0, 1, 0); PG8_SCHED; PG8_LDA(At, 1, 0); PG8_STAGE_A(PG8_SA(0, 1), a2, 1, vs1);
            PG8_WAIT_L(8); PG8_BAR; PG8_WAIT_L(0); PG8_MMA(0, 0, At, B0); PG8_BAR; PG8_SCHED;
            PG8_LDB(B1, 1, 1); PG8_STAGE(PG8_SB(1, 0), b3, voffB);
            PG8_BAR; PG8_WAIT_L(0); PG8_MMA(0, 1, At, B1); PG8_BAR;
            PG8_LDA(At, 1, 1); PG8_STAGE_A(PG8_SA(1, 0), a3, 0, vs0);
            PG8_BAR; PG8_WAIT_L(0); PG8_MMA(1, 0, At, B0); PG8_BAR; PG8_SCHED;
            PG8_STAGE(PG8_SB(1, 1), b3 + hstepB, voffB);
            PG8_WAIT_V(6); PG8_BAR; PG8_MMA(1, 1, At, B1); PG8_BAR;
            }
        }
        if constexpr (ALIGN_EPI) { if (wr == 0) PG8_BAR; }
        if constexpr (!Epi::AFTER_DRAIN) { E(acc, cur, wr, wc, fr, fq); S.done(cur); }
        if (!has_next) break;
#pragma unroll
        for (int a = 0; a < 2; ++a)
#pragma unroll
            for (int b = 0; b < 2; ++b)
#pragma unroll
                for (int m = 0; m < 4; ++m)
#pragma unroll
                    for (int n = 0; n < 2; ++n) acc[a][b][m][n] = (f32x4){0.f, 0.f, 0.f, 0.f};
        cur = nxt; cA = nA; cB = nB; ++ui;
        if constexpr (Sched::GATHER) {
#pragma unroll
            for (int _h = 0; _h < 2; ++_h)
#pragma unroll
                for (int _i = 0; _i < 2; ++_i) voffG[0][_h][_i] = voffG[1][_h][_i]; }
        if constexpr (ALIGN_EPI) { if (wr == 1) PG8_BAR; }
    }
    PG8_WAIT_V(0);
    if constexpr (!ALIGN_EPI) { if (wr == 0) PG8_BAR; }
    PG8_BAR;
    if constexpr (Epi::AFTER_DRAIN) { E.fused(acc, cur, wr, wc, fr, fq, lds, wid, lane); S.done(cur); }
#undef PG8_SA
#undef PG8_SB
#undef PG8_STAGE
#undef PG8_STAGE_A
#undef PG8_GOFF
#undef PG8_LDA
#undef PG8_LDB
#undef PG8_MMA
#undef PG8_WAIT_V
#undef PG8_WAIT_L
#undef PG8_BAR
#undef PG8_SCHED
}

}
#define WSYNC2() asm volatile("s_waitcnt lgkmcnt(0)" ::: "memory")
struct MoeBufs { int* tok_e; float* tok_g; int* slot_of; float* slot_gate; int* blk_e; int* blkcnt; int* nblk; int* slot_tok; };
constexpr int WRT_LD = 1028;

template <bool XB, int MODE = 0> __device__ __forceinline__ void ph_ln_router(const void* xin_, const bf16_t* hb, const float* g, const float* bb, const float* wr, const float* br, bf16_t* x1b, const MoeBufs m, float* lds) {
  const float* xin = (const float*)xin_; const bf16_t* xinb = (const bf16_t*)xin_;
  for (int i = BIDX() * NTHR + TIDX(); i < PMAX; i += (int)gridDim.x * NTHR) m.slot_tok[i] = 0;
  const int tid = TIDX(), lane = tid & 63, wave = tid >> 6, blk = BIDX();
  float* wT = lds;
  float* lg = lds + 32 * WRT_LD + wave * 64;
  int* cnt = (int*)(lds + 32 * WRT_LD + 8 * 64);
  f32x4 raf[2][4]; v2u rab[2][4], rh[2][4];
#define LNR_LOAD(tk) { _Pragma("unroll") for (int q = 0; q < 2; ++q) _Pragma("unroll") for (int j = 0; j < 4; ++j) { const int c = lane * 4 + 256 * j; \
      if (XB) rab[q][j] = *(const v2u*)(xinb + (size_t)((tk) + q) * D + c); else raf[q][j] = *(const f32x4*)(xin + (size_t)((tk) + q) * D + c); \
      rh[q][j] = *(const v2u*)(hb + (size_t)((tk) + q) * D + c); } }
  LNR_LOAD(blk * 64 + wave * 8)
  { f32x4 wv[16];
#pragma unroll
    for (int k = 0; k < 16; ++k) wv[k] = *(const f32x4*)(wr + (size_t)(tid + NTHR * k) * 4);
#pragma unroll
    for (int k = 0; k < 16; ++k) { const int i = (tid + NTHR * k) * 4, d = i >> 5, e = i & 31;
#pragma unroll
      for (int z = 0; z < 4; ++z) wT[(e + z) * WRT_LD + d] = wv[k][z]; } }
  if (tid < 32) cnt[tid] = 0;
  __syncthreads();
#pragma unroll 1
  for (int it = 0; it < 8; it += 2) {
    const int tok0 = blk * 64 + wave * 8 + it;
    f32x4 v[2][4]; float s[2] = {0.f, 0.f};
#pragma unroll
    for (int q = 0; q < 2; ++q)
#pragma unroll
      for (int j = 0; j < 4; ++j) { f32x4 a;
        if (XB) { const v2u xv = rab[q][j]; a = (f32x4){bf_lo(xv[0]), bf_hi(xv[0]), bf_lo(xv[1]), bf_hi(xv[1])}; } else a = raf[q][j];
        const v2u hh = rh[q][j];
        v[q][j] = (f32x4){ALPHA * a[0] + bf_lo(hh[0]), ALPHA * a[1] + bf_hi(hh[0]), ALPHA * a[2] + bf_lo(hh[1]), ALPHA * a[3] + bf_hi(hh[1])}; s[q] += (v[q][j][0] + v[q][j][1]) + (v[q][j][2] + v[q][j][3]); }
    if (it + 2 < 8) LNR_LOAD(tok0 + 2)
#pragma unroll
    for (int o = 1; o < 64; o <<= 1) { s[0] += __shfl_xor(s[0], o); s[1] += __shfl_xor(s[1], o); }
    float qq[2] = {0.f, 0.f};
#pragma unroll
    for (int q = 0; q < 2; ++q) { const float mu = s[q] * (1.f / D);
#pragma unroll
      for (int j = 0; j < 4; ++j) { v[q][j] = v[q][j] - mu; qq[q] += (v[q][j][0] * v[q][j][0] + v[q][j][1] * v[q][j][1]) + (v[q][j][2] * v[q][j][2] + v[q][j][3] * v[q][j][3]); } }
#pragma unroll
    for (int o = 1; o < 64; o <<= 1) { qq[0] += __shfl_xor(qq[0], o); qq[1] += __shfl_xor(qq[1], o); }
#pragma unroll
    for (int q = 0; q < 2; ++q) { const float r = rsqrtf(qq[q] * (1.f / D) + 1e-5f);
#pragma unroll
      for (int j = 0; j < 4; ++j) { const int c = lane * 4 + 256 * j; const f32x4 g4 = *(const f32x4*)(g + c), b4 = *(const f32x4*)(bb + c); v[q][j] = v[q][j] * r * g4 + b4; *(v2u*)(x1b + (size_t)(tok0 + q) * D + c) = (v2u){cvt_pk_bf16(v[q][j][0], v[q][j][1]), cvt_pk_bf16(v[q][j][2], v[q][j][3])}; } }
    if (MODE == 1) continue;
    float p[2][32];
    { const float* wl = wT + lane * 4; f32x4 wb[2][4];
#pragma unroll
      for (int j = 0; j < 4; ++j) wb[0][j] = *(const f32x4*)(wl + 256 * j);
#pragma unroll
      for (int e = 0; e < 32; ++e) {
        if (e < 31) {
#pragma unroll
          for (int j = 0; j < 4; ++j) wb[(e + 1) & 1][j] = *(const f32x4*)(wl + (e + 1) * WRT_LD + 256 * j); }
        __builtin_amdgcn_sched_barrier(0);
        f32x2_t a0 = {0.f, 0.f}, a1 = {0.f, 0.f};
#pragma unroll
        for (int j = 0; j < 4; ++j) { const f32x4 w4 = wb[e & 1][j]; const f32x2_t wlo = {w4[0], w4[1]}, whi = {w4[2], w4[3]};
          a0 = __builtin_elementwise_fma((f32x2_t){v[0][j][0], v[0][j][1]}, wlo, a0); a0 = __builtin_elementwise_fma((f32x2_t){v[0][j][2], v[0][j][3]}, whi, a0);
          a1 = __builtin_elementwise_fma((f32x2_t){v[1][j][0], v[1][j][1]}, wlo, a1); a1 = __builtin_elementwise_fma((f32x2_t){v[1][j][2], v[1][j][3]}, whi, a1); }
        p[0][e] = a0[0] + a0[1]; p[1][e] = a1[0] + a1[1];
        __builtin_amdgcn_sched_barrier(0);
      } }
#pragma unroll
    for (int i = 0; i < 16; ++i) { const bool hi = (lane & 32) != 0;
#pragma unroll
      for (int q = 0; q < 2; ++q) { const float send = hi ? p[q][i] : p[q][i + 16]; const float keep = hi ? p[q][i + 16] : p[q][i]; p[q][i] = keep + __shfl_xor(send, 32); } }
#pragma unroll
    for (int i = 0; i < 8; ++i) { const bool hi = (lane & 16) != 0;
#pragma unroll
      for (int q = 0; q < 2; ++q) { const float send = hi ? p[q][i] : p[q][i + 8]; const float keep = hi ? p[q][i + 8] : p[q][i]; p[q][i] = keep + __shfl_xor(send, 16); } }
#pragma unroll
    for (int i = 0; i < 4; ++i) { const bool hi = (lane & 8) != 0;
#pragma unroll
      for (int q = 0; q < 2; ++q) { const float send = hi ? p[q][i] : p[q][i + 4]; const float keep = hi ? p[q][i + 4] : p[q][i]; p[q][i] = keep + __shfl_xor(send, 8); } }
#pragma unroll
    for (int i = 0; i < 2; ++i) { const bool hi = (lane & 4) != 0;
#pragma unroll
      for (int q = 0; q < 2; ++q) { const float send = hi ? p[q][i] : p[q][i + 2]; const float keep = hi ? p[q][i + 2] : p[q][i]; p[q][i] = keep + __shfl_xor(send, 4); } }
#pragma unroll
    for (int q = 0; q < 2; ++q) { const bool hi = (lane & 2) != 0; const float send = hi ? p[q][0] : p[q][1]; const float keep = hi ? p[q][1] : p[q][0]; p[q][0] = keep + __shfl_xor(send, 2); }
    p[0][0] += __shfl_xor(p[0][0], 1); p[1][0] += __shfl_xor(p[1][0], 1);
    const int e_l = ((lane >> 5) & 1) * 16 + ((lane >> 4) & 1) * 8 + ((lane >> 3) & 1) * 4 + ((lane >> 2) & 1) * 2 + ((lane >> 1) & 1);
    const float brl = br[e_l];
    float lv[2] = {p[0][0] + brl, p[1][0] + brl}; int ei[2][4]; float ev[2][4];
    if (MODE == 2) for (int k = 1; k < 4; ++k) { ei[0][k] = ei[1][k] = k; ev[0][k] = ev[1][k] = 0.f; }
#pragma unroll
    for (int k = 0; k < (MODE == 2 ? 1 : 4); ++k) { float bv[2] = {lv[0], lv[1]}; int bi[2] = {e_l, e_l};
#pragma unroll
      for (int o = 2; o < 64; o <<= 1)
#pragma unroll
        for (int q = 0; q < 2; ++q) { const float ov = __shfl_xor(bv[q], o); const int oi = __shfl_xor(bi[q], o); const bool take = (ov > bv[q]) || (ov == bv[q] && oi < bi[q]); bv[q] = take ? ov : bv[q]; bi[q] = take ? oi : bi[q]; }
#pragma unroll
      for (int q = 0; q < 2; ++q) { ei[q][k] = bi[q]; ev[q][k] = bv[q]; if (e_l == bi[q]) lv[q] = -INFINITY; } }
    if (lane < 2) { const int q = lane;
      float ex[4], su = 0.f;
#pragma unroll
      for (int k = 0; k < 4; ++k) { ex[k] = __expf((q ? ev[1][k] : ev[0][k]) - (q ? ev[1][0] : ev[0][0])); su += ex[k]; }
      const float inv = 1.f / su; const int tok = tok0 + q;
      const int e0 = q ? ei[1][0] : ei[0][0], e1 = q ? ei[1][1] : ei[0][1], e2 = q ? ei[1][2] : ei[0][2], e3 = q ? ei[1][3] : ei[0][3];
      *(int4*)(m.tok_e + tok * 4) = make_int4(e0, e1, e2, e3);
      *(float4*)(m.tok_g + tok * 4) = make_float4(ex[0] * inv, ex[1] * inv, ex[2] * inv, ex[3] * inv);
      atomicAdd(&cnt[e0], 1); atomicAdd(&cnt[e1], 1); atomicAdd(&cnt[e2], 1); atomicAdd(&cnt[e3], 1); }
  }
  __syncthreads();
  if (tid < 32) m.blkcnt[blk * 32 + tid] = cnt[tid];
  __syncthreads();
}

__device__ __forceinline__ void ph_moe_scatter(const MoeBufs m, int* ilds) {
  const int tid = TIDX(), lane = tid & 63, wave = tid >> 6, blk = BIDX(); (void)lane;
  int* tot = ilds; int* bef = ilds + 32; int* pst = ilds + 64; int* es = ilds + 128; int* rk = ilds + 384; int* sl = ilds + 640; int* part = ilds + 896; int* wcnt = ilds + 1408;
  { const int e = tid & 31, pa = tid >> 5; int sum = 0;
#pragma unroll
    for (int q = 0; q < 16; ++q) sum += m.blkcnt[(pa * 16 + q) * 32 + e];
    part[pa * 32 + e] = sum; }
  if (tid < 256) es[tid] = m.tok_e[blk * 256 + tid];
  __syncthreads();
  if (tid < 32) { const int e = tid; int t_ = 0, b_ = 0; const int pb_ = blk >> 4;
    for (int q = 0; q < 16; ++q) { const int v = part[q * 32 + e]; t_ += v; if (q < pb_) b_ += v; }
    for (int q = pb_ * 16; q < blk; ++q) b_ += m.blkcnt[q * 32 + e];
    tot[e] = t_; bef[e] = b_; }
  if (tid < 256) { const int e = es[tid]; const unsigned long long lt = (1ull << lane) - 1ull; int r = 0;
    for (int ee = 0; ee < 32; ++ee) { const unsigned long long mk = __ballot(e == ee); if (e == ee) r = __builtin_popcountll(mk & lt); if (lane == ee) wcnt[wave * 32 + ee] = __builtin_popcountll(mk); }
    rk[tid] = r; }
  __syncthreads();
  if (tid == 0) { int acc = 0; for (int e = 0; e < 32; ++e) { pst[e] = acc; acc += ((tot[e] + 255) >> 8) << 8; } pst[32] = acc;
    if (blk == 0) { *m.nblk = acc >> 8; for (int e = 0; e < 32; ++e) for (int q = pst[e] >> 8; q < (pst[e + 1] >> 8); ++q) m.blk_e[q] = e; } }
  __syncthreads();
  if (tid < 256) { const int e = es[tid]; int rank = rk[tid]; for (int w2 = 0; w2 < wave; ++w2) rank += wcnt[w2 * 32 + e];
    const int slot = pst[e] + bef[e] + rank; m.slot_of[blk * 256 + tid] = slot; m.slot_gate[slot] = m.tok_g[blk * 256 + tid]; m.slot_tok[slot] = blk * 64 + (tid >> 2); }
  __syncthreads();
  __syncthreads();
}

__device__ __forceinline__ void ph_combine_ln(const bf16_t* x1b, const bf16_t* Ys, const int* slot_of, const float* g, const float* bb, float* out, bf16_t* outb) {
  const int tid = TIDX(), lane = tid & 63, gw = BIDX() * 8 + (tid >> 6), NGW = (int)gridDim.x * 8;
  for (int row = gw; row < NT; row += NGW) {
    const int4 s4 = *(const int4*)(slot_of + row * 4); const int sl[4] = {s4.x, s4.y, s4.z, s4.w};
    f32x4 v[4]; float s = 0.f;
#pragma unroll
    for (int j = 0; j < 4; ++j) { const int c = lane * 4 + 256 * j; f32x4 f = (f32x4){0.f, 0.f, 0.f, 0.f};
#pragma unroll
      for (int k = 0; k < 4; ++k) { const v2u y = *(const v2u*)(Ys + (size_t)sl[k] * D + c); f += (f32x4){bf_lo(y[0]), bf_hi(y[0]), bf_lo(y[1]), bf_hi(y[1])}; }
      const v2u xv = *(const v2u*)(x1b + (size_t)row * D + c); const f32x4 a = (f32x4){bf_lo(xv[0]), bf_hi(xv[0]), bf_lo(xv[1]), bf_hi(xv[1])}; v[j] = a * ALPHA + f; s += (v[j][0] + v[j][1]) + (v[j][2] + v[j][3]); }
    const float mu = wave_sum(s) * (1.f / D); float q = 0.f;
#pragma unroll
    for (int j = 0; j < 4; ++j) { v[j] = v[j] - mu; q += (v[j][0] * v[j][0] + v[j][1] * v[j][1]) + (v[j][2] * v[j][2] + v[j][3] * v[j][3]); }
    const float r = rsqrtf(wave_sum(q) * (1.f / D) + 1e-5f);
#pragma unroll
    for (int j = 0; j < 4; ++j) { const int c = lane * 4 + 256 * j; const f32x4 g4 = *(const f32x4*)(g + c), b4 = *(const f32x4*)(bb + c); const f32x4 o = v[j] * r * g4 + b4;
      if (out) *(f32x4*)(out + (size_t)row * D + c) = o; if (outb) *(v2u*)(outb + (size_t)row * D + c) = (v2u){cvt_pk_bf16(o[0], o[1]), cvt_pk_bf16(o[2], o[3])}; }
  }
}

namespace pg8 {
template <bool GATHER_> struct MoeOrderT {
    static constexpr bool GATHER = GATHER_; const int* rowmap;
    StaticOrder so; const int* blk_e; const char* W; size_t wexp; int obn;
    __device__ void init(const void* A, int lda, const void* W_, int ldb, size_t wexp_, int nM, int nN, int obn_, const int* blk_e_, int G, int c) { so.init(A, lda, W_, ldb, nM * BM, nN * BM, G, c); blk_e = blk_e_; W = (const char*)W_; wexp = wexp_; obn = obn_; }
    __device__ bool next(int i, Unit& u) const { int pm, pn; if (!so.tile(i, pm, pn)) return false; const int e = __builtin_amdgcn_readfirstlane(blk_e[pm]); u.pa = GATHER_ ? so.A : so.A + (size_t)pm * so.ta; u.pb = W + (size_t)e * wexp + (size_t)pn * so.tb; u.orow = pm * BM; u.ocol = pn * obn; u.e = e; u.kind = 0; return true; }
    __device__ __forceinline__ int rowof(const Unit&, int r) const { return GATHER_ ? rowmap[r] : r; }
    __device__ __forceinline__ void a_ready(const Unit&) const {}
    __device__ __forceinline__ void done(const Unit&) const {}
};
typedef MoeOrderT<false> MoeOrder; typedef MoeOrderT<true> MoeOrderG;
struct EpiSwiglu {
    static constexpr bool PERM = true, AFTER_DRAIN = false;
    bf16_t* O; int ldc; const float* b1;
    __device__ __forceinline__ void operator()(const f32x4 (&acc)[2][2][4][2], const Unit& u, int wr, int wc, int fr, int fq) const {
        const int row0 = u.orow + wr * 64 + fr, cl = wc * 32 + 8 * fq, col0 = u.ocol + cl;
        const float* bg = b1 + (size_t)u.e * 2048 + col0; const float* bu = bg + 1024;
        const f32x4 bg0 = *(const f32x4*)bg, bg1 = *(const f32x4*)(bg + 4), bu0 = *(const f32x4*)bu, bu1 = *(const f32x4*)(bu + 4);
#pragma unroll
        for (int ai = 0; ai < 2; ++ai)
#pragma unroll
            for (int m = 0; m < 4; ++m) {
                f32x4 gv[2] = {acc[ai][0][m][0] + bg0, acc[ai][0][m][1] + bg1}, uv[2] = {acc[ai][1][m][0] + bu0, acc[ai][1][m][1] + bu1}; float o[8];
#pragma unroll
                for (int n = 0; n < 2; ++n)
#pragma unroll
                    for (int i = 0; i < 4; ++i) { const float gg = fminf(gv[n][i], 7.f), uu = fminf(fmaxf(uv[n][i], -7.f), 7.f);
                        const float sg = __builtin_amdgcn_rcpf(1.f + __builtin_amdgcn_exp2f(-1.702f * 1.4426950408889634f * gg)); o[4 * n + i] = (uu + 1.f) * gg * sg; }
                u32x4 w; w.x = cvt_pk_bf16(o[0], o[1]); w.y = cvt_pk_bf16(o[2], o[3]); w.z = cvt_pk_bf16(o[4], o[5]); w.w = cvt_pk_bf16(o[6], o[7]);
                *(u32x4*)(O + (size_t)(row0 + ai * HALF + m * 16) * ldc + col0) = w; asm volatile("" ::: "memory"); }
    }
};
struct EpiMoe2 {
    static constexpr bool PERM = true, AFTER_DRAIN = false;
    bf16_t* O; int ldc; const float* b2; const float* gate;
    __device__ __forceinline__ void operator()(const f32x4 (&acc)[2][2][4][2], const Unit& u, int wr, int wc, int fr, int fq) const {
        const int row0 = u.orow + wr * 64 + fr, col0 = u.ocol + wc * 32 + 8 * fq;
        const float* bp = b2 + (size_t)u.e * 1024 + col0;
#pragma unroll
        for (int bj = 0; bj < 2; ++bj) {
            const f32x4 bv0 = *(const f32x4*)(bp + bj * HALF), bv1 = *(const f32x4*)(bp + bj * HALF + 4);
#pragma unroll
            for (int ai = 0; ai < 2; ++ai)
#pragma unroll
                for (int m = 0; m < 4; ++m) { const int row = row0 + ai * HALF + m * 16; const float gt = gate[row];
                    const f32x4 v0 = (acc[ai][bj][m][0] + bv0) * gt, v1 = (acc[ai][bj][m][1] + bv1) * gt;
                    u32x4 w; w.x = cvt_pk_bf16(v0[0], v0[1]); w.y = cvt_pk_bf16(v0[2], v0[3]); w.z = cvt_pk_bf16(v1[0], v1[1]); w.w = cvt_pk_bf16(v1[2], v1[3]);
                    *(u32x4*)(O + (size_t)row * ldc + col0 + bj * HALF) = w; asm volatile("" ::: "memory"); }
        }
    }
};

struct MoeFusedOrder {
    static constexpr bool GATHER = true;
    const int* rowmap; const int* blk_e; const char* X; const char* ACT; const char* W1; const char* W2; unsigned* ready; unsigned* tmo; int nblk, NG, G, c, total, mode;
    __device__ void init(const void* X_, const void* ACT_, const void* W1_, const void* W2_, const int* rowmap_, const int* blk_e_, unsigned* ready_, unsigned* tmo_, int nblk_, int G_, int c_) {
        X = (const char*)X_; ACT = (const char*)ACT_; W1 = (const char*)W1_; W2 = (const char*)W2_; rowmap = rowmap_; blk_e = blk_e_; ready = ready_; tmo = tmo_; nblk = nblk_; NG = (nblk_ + 31) >> 5; G = G_; c = c_; total = nblk_ * 12; }
    __device__ bool next(int i, Unit& u) const {
        int Lq = i * G + c; if (Lq >= total) return false;
#if defined(FUSE_SPLIT)
        if (c >= 0) { const int kind = mode - 1; if (Lq >= nblk * (kind ? 4 : 8)) return false; const int q = Lq; const int pm = q % nblk, pn = q / nblk, e = __builtin_amdgcn_readfirstlane(blk_e[pm]);
          u.kind = kind; u.e = e; u.orow = pm * BM;
          if (kind == 0) { u.pa = X; u.pb = W1 + ((size_t)e * 2048 + (size_t)pn * 256) * 2048; u.ocol = pn * 128; }
          else { u.pa = ACT; u.pb = W2 + ((size_t)e * 1024 + (size_t)pn * 256) * 2048; u.ocol = pn * 256; }
          return true; }
#endif
#if defined(FUSE_SERIAL)
        { const int n1 = nblk * 8; int kind = Lq < n1 ? 0 : 1; int q = kind ? Lq - n1 : Lq; const int pm = q % nblk, pn = q / nblk, e = __builtin_amdgcn_readfirstlane(blk_e[pm]);
          u.kind = kind; u.e = e; u.orow = pm * BM;
          if (kind == 0) { u.pa = X; u.pb = W1 + ((size_t)e * 2048 + (size_t)pn * 256) * 2048; u.ocol = pn * 128; }
          else { u.pa = ACT; u.pb = W2 + ((size_t)e * 1024 + (size_t)pn * 256) * 2048; u.ocol = pn * 256; }
          return true; }
#endif
        int kind = 0, g = 0;
        for (int sgm = 0; ; ++sgm) {
            if (sgm < 3) { kind = 0; g = sgm; }
            else if (sgm < 3 + 2 * (NG - 3)) { const int j = (sgm - 3) >> 1; if (((sgm - 3) & 1) == 0) { kind = 0; g = j + 3; } else { kind = 1; g = j; } }
            else { kind = 1; g = NG - 3 + (sgm - (3 + 2 * (NG - 3))); }
            const int mg = min(32, nblk - 32 * g), sz = mg * (kind ? 4 : 8);
            if (Lq < sz) { const int pm = 32 * g + Lq % mg, pn = Lq / mg, e = __builtin_amdgcn_readfirstlane(blk_e[pm]);
                u.kind = kind; u.e = e; u.orow = pm * BM;
                if (kind == 0) { u.pa = X; u.pb = W1 + ((size_t)e * 2048 + (size_t)pn * 256) * 2048; u.ocol = pn * 128; }
                else { u.pa = ACT; u.pb = W2 + ((size_t)e * 1024 + (size_t)pn * 256) * 2048; u.ocol = pn * 256; }
                return true; }
            Lq -= sz;
        }
    }
    __device__ __forceinline__ int rowof(const Unit& u, int r) const { return u.kind == 0 ? rowmap[r] : r; }
    __device__ __forceinline__ void a_ready(const Unit& u) const {
        if (u.kind == 0) return;
#if defined(FUSE_SPLIT)
        return;
#endif
        if (threadIdx.x < 64) {
#if defined(FUSE_GLOBAL_WAIT)
            const unsigned long long t0 = __builtin_amdgcn_s_memrealtime(); unsigned polls = 0; unsigned* rp = ready + 64 * 500; const unsigned want = (unsigned)nblk * 64u;
#else
            const unsigned long long t0 = __builtin_amdgcn_s_memrealtime(); unsigned polls = 0; unsigned* rp = ready + 64 * (u.orow >> 8); const unsigned want = 64u;
#endif
            while ((unsigned)__builtin_amdgcn_readfirstlane(__hip_atomic_load(rp, __ATOMIC_RELAXED, __HIP_MEMORY_SCOPE_AGENT)) < want) {
                if ((++polls & 255u) == 0u && __builtin_amdgcn_readfirstlane(__hip_atomic_load(tmo, __ATOMIC_RELAXED, __HIP_MEMORY_SCOPE_AGENT)) != 0u) break;
                if (__builtin_amdgcn_s_memrealtime() - t0 > 2000000ull) { if (threadIdx.x == 0) __hip_atomic_store(tmo, 1u, __ATOMIC_RELAXED, __HIP_MEMORY_SCOPE_AGENT); break; }
                __builtin_amdgcn_s_sleep(2); }
#if defined(FUSE_CONSUMER_WB)
            __builtin_amdgcn_fence(__ATOMIC_RELEASE, "agent"); asm volatile("s_waitcnt vmcnt(0)" ::: "memory");
#endif
#if defined(FUSE_DELAY)
            { const unsigned long long t1 = __builtin_amdgcn_s_memrealtime(); while (__builtin_amdgcn_s_memrealtime() - t1 < 2000ull) __builtin_amdgcn_s_sleep(8); }
#endif
            __builtin_amdgcn_fence(__ATOMIC_ACQUIRE, "agent");
            asm volatile("s_waitcnt vmcnt(0)" ::: "memory");
        }
        asm volatile("" ::: "memory"); __builtin_amdgcn_s_barrier(); asm volatile("" ::: "memory");
    }
    __device__ __forceinline__ void done(const Unit& u) const {
        if (u.kind != 0) return;
        asm volatile("s_waitcnt vmcnt(0)" ::: "memory");
#if defined(FUSE_HEAVY_RELEASE)
        __builtin_amdgcn_fence(__ATOMIC_RELEASE, "agent"); asm volatile("s_waitcnt vmcnt(0)" ::: "memory");
#endif
#if defined(FUSE_GLOBAL_WAIT)
        if ((threadIdx.x & 63) == 0) __hip_atomic_fetch_add(ready + 64 * 500, 1u, __ATOMIC_RELAXED, __HIP_MEMORY_SCOPE_AGENT);
#else
        if ((threadIdx.x & 63) == 0) __hip_atomic_fetch_add(ready + 64 * (u.orow >> 8), 1u, __ATOMIC_RELAXED, __HIP_MEMORY_SCOPE_AGENT);
#endif
    }
};
__device__ __forceinline__ void store16_sc1(void* p, u32x4 v) { asm volatile("global_store_dwordx4 %0, %1, off sc1\n\ts_nop 1" :: "v"(p), "v"(v) : "memory"); }
struct EpiMoeFused {
    static constexpr bool PERM = true, AFTER_DRAIN = false;
    bf16_t* ACTo; const float* b1; bf16_t* Yo; const float* b2; const float* gate;
    __device__ __forceinline__ void operator()(const f32x4 (&acc)[2][2][4][2], const Unit& u, int wr, int wc, int fr, int fq) const {
        if (u.kind == 0) {
            const int row0 = u.orow + wr * 64 + fr, cl = wc * 32 + 8 * fq, col0 = u.ocol + cl;
            const float* bg = b1 + (size_t)u.e * 2048 + col0; const float* bu = bg + 1024;
            const f32x4 bg0 = *(const f32x4*)bg, bg1 = *(const f32x4*)(bg + 4), bu0 = *(const f32x4*)bu, bu1 = *(const f32x4*)(bu + 4);
#pragma unroll
            for (int ai = 0; ai < 2; ++ai)
#pragma unroll
                for (int m = 0; m < 4; ++m) {
                    f32x4 gv[2] = {acc[ai][0][m][0] + bg0, acc[ai][0][m][1] + bg1}, uv[2] = {acc[ai][1][m][0] + bu0, acc[ai][1][m][1] + bu1}; float o[8];
#pragma unroll
                    for (int n = 0; n < 2; ++n)
#pragma unroll
                        for (int i = 0; i < 4; ++i) { const float gg = fminf(gv[n][i], 7.f), uu = fminf(fmaxf(uv[n][i], -7.f), 7.f);
                            const float sg = __builtin_amdgcn_rcpf(1.f + __builtin_amdgcn_exp2f(-1.702f * 1.4426950408889634f * gg)); o[4 * n + i] = (uu + 1.f) * gg * sg; }
                    u32x4 w; w.x = cvt_pk_bf16(o[0], o[1]); w.y = cvt_pk_bf16(o[2], o[3]); w.z = cvt_pk_bf16(o[4], o[5]); w.w = cvt_pk_bf16(o[6], o[7]);
#if defined(FUSE_PLAIN_STORE)
                    *(u32x4*)(ACTo + (size_t)(row0 + ai * HALF + m * 16) * 1024 + col0) = w; }
#else
                    store16_sc1(ACTo + (size_t)(row0 + ai * HALF + m * 16) * 1024 + col0, w); }
#endif
        } else {
            const int row0 = u.orow + wr * 64 + fr, col0 = u.ocol + wc * 32 + 8 * fq;
            const float* bp = b2 + (size_t)u.e * 1024 + col0;
#pragma unroll
            for (int bj = 0; bj < 2; ++bj) {
                const f32x4 bv0 = *(const f32x4*)(bp + bj * HALF), bv1 = *(const f32x4*)(bp + bj * HALF + 4);
#pragma unroll
                for (int ai = 0; ai < 2; ++ai)
#pragma unroll
                    for (int m = 0; m < 4; ++m) { const int row = row0 + ai * HALF + m * 16; const float gt = gate[row];
                        const f32x4 v0 = (acc[ai][bj][m][0] + bv0) * gt, v1 = (acc[ai][bj][m][1] + bv1) * gt;
                        u32x4 w; w.x = cvt_pk_bf16(v0[0], v0[1]); w.y = cvt_pk_bf16(v0[2], v0[3]); w.z = cvt_pk_bf16(v1[0], v1[1]); w.w = cvt_pk_bf16(v1[2], v1[3]);
                        *(u32x4*)(Yo + (size_t)row * 1024 + col0 + bj * HALF) = w; asm volatile("" ::: "memory"); }
            }
        }
    }
};
}
typedef short v4i16_t __attribute__((ext_vector_type(4)));
__device__ __forceinline__ unsigned f2key_u(float f) { f = f + 0.0f; const unsigned u = __float_as_uint(f); return (u & 0x80000000u) ? ~u : (u | 0x80000000u); }

__device__ __forceinline__ void ph_cnorm_b(const bf16_t* pa, const float* g, bf16_t* cnb) {
  const int tid = TIDX(), lane = tid & 63, gw = BIDX() * 8 + (tid >> 6), NGW = (int)gridDim.x * 8;
  const f32x4 g4 = *(const f32x4*)(g + lane * 4);
  for (int row = gw; row < NT; row += NGW) {
    const v2u v = *(const v2u*)(pa + (size_t)row * 2048 + 1024 + lane * 4);
    const f32x4 f = (f32x4){bf_lo(v[0]), bf_hi(v[0]), bf_lo(v[1]), bf_hi(v[1])};
    const float r = rsqrtf(wave_sum((f[0] * f[0] + f[1] * f[1]) + (f[2] * f[2] + f[3] * f[3])) * (1.f / 256.f) + 1e-6f);
    const f32x4 o = f * r * g4;
    *(v2u*)(cnb + (size_t)row * 256 + lane * 4) = (v2u){cvt_pk_bf16(o[0], o[1]), cvt_pk_bf16(o[2], o[3])};
  }
}

__device__ __forceinline__ int moe_layer_tile(int layer, int j) { return j < 8192 ? layer * 8192 + j : 16384 + layer * 4096 + (j - 8192); }
__device__ __forceinline__ void moe_weight_tile(int T, const float* w1, const float* w2, bf16_t* W1_t, bf16_t* W2_t, int lane) {
  if (T < 16384) { const int le = T >> 8; transpose_tile(mk_tjob(w1 + (size_t)le * D * 2048, 2048, D, 2048, W1_t + (size_t)le * 2048 * D, D, 0, 0, 1), T & 255, lane); }
  else if (T < 24576) { const int t2 = T - 16384, le = t2 >> 7; transpose_tile(mk_tjob(w2 + (size_t)le * D * D, D, D, D, W2_t + (size_t)le * D * D, D, 0, 0, 0), t2 & 127, lane); }
}
typedef _Float16 h16x2_t __attribute__((ext_vector_type(2)));
typedef int i32x4_t __attribute__((ext_vector_type(4)));
__device__ __forceinline__ unsigned cvt_pk_f16(float lo, float hi) { const f32x2_t v = {lo, hi}; const h16x2_t h = __builtin_convertvector(v, h16x2_t); return __builtin_bit_cast(unsigned, h); }
__device__ __forceinline__ void ph_iscore(const bf16_t* pa, unsigned short* sc, const float* w1, const float* w2, bf16_t* W1_t, bf16_t* W2_t) {
  const int tid = TIDX(), lane = tid & 63, gw = BIDX() * 8 + (tid >> 6), NGW = (int)gridDim.x * 8;
  const int n16 = lane & 15, g = lane >> 4;
  int wt = gw;
#pragma unroll 1
  for (int u = gw; u < 2 * 4352; u += NGW) {
    const int b = u / 4352, v = u % 4352;
    int a = 0; while (a < 15 && 16 * (a + 1) * (a + 2) <= v) ++a;
    const int rem = v - 16 * a * (a + 1), r = rem / (a + 1), ch = rem % (a + 1);
    const int qg = 32 * a + r, ntile = (ch < a) ? 32 : (r + 1), t0 = qg * 16, kt0 = ch * 32;
    const bf16_t* qrow = pa + (size_t)(b * L + t0 + n16) * 2048;
    bf16x8 qf[8][2]; float w[8];
#pragma unroll
    for (int h = 0; h < 8; ++h) { qf[h][0] = *(const bf16x8*)(qrow + 1280 + h * 64 + 8 * g); qf[h][1] = *(const bf16x8*)(qrow + 1280 + h * 64 + 32 + 8 * g); w[h] = bf2f(qrow[1856 + h]) * (0.35355339059327373f * 0.125f); }
    const bf16_t* kbase = pa + (size_t)(b * L + n16) * 2048 + 1792 + 8 * g;
    unsigned short* srow = sc + (size_t)(b * L + t0 + n16) * L + 4 * g;
    bf16x8 kr[8][2];
    const int ktl = kt0 + ntile - 1;
#pragma unroll
    for (int p = 0; p < 8; ++p) { const int kk = min(kt0 + p, ktl); kr[p][0] = *(const bf16x8*)(kbase + (size_t)kk * 16 * 2048); kr[p][1] = *(const bf16x8*)(kbase + (size_t)kk * 16 * 2048 + 32); }
#pragma unroll 1
    for (int kt8 = kt0; kt8 < kt0 + ntile; kt8 += 8) {
#pragma unroll
      for (int p = 0; p < 8; ++p) {
        const int kt = kt8 + p;
        const bf16x8 k0 = kr[p][0], k1 = kr[p][1];
        { const int kk = min(kt + 8, ktl); kr[p][0] = *(const bf16x8*)(kbase + (size_t)kk * 16 * 2048); kr[p][1] = *(const bf16x8*)(kbase + (size_t)kk * 16 * 2048 + 32); }
        f32x4 score = (f32x4){0.f, 0.f, 0.f, 0.f};
#pragma unroll
        for (int h = 0; h < 8; ++h) {
          f32x4 acc = __builtin_amdgcn_mfma_f32_16x16x32_bf16(k0, qf[h][0], (f32x4){0.f, 0.f, 0.f, 0.f}, 0, 0, 0);
          acc = __builtin_amdgcn_mfma_f32_16x16x32_bf16(k1, qf[h][1], acc, 0, 0, 0);
          const f32x4 relu = __builtin_bit_cast(f32x4, __builtin_elementwise_max(__builtin_bit_cast(i32x4_t, acc), (i32x4_t){0, 0, 0, 0}));
#pragma unroll
          for (int i = 0; i < 4; ++i) score[i] = fmaf(relu[i], w[h], score[i]);
        }
        if (kt <= ktl) *(v2u*)(srow + kt * 16) = (v2u){cvt_pk_f16(score[0], score[1]), cvt_pk_f16(score[2], score[3])};
      }
    }
  }
  (void)wt; (void)w1; (void)w2; (void)W1_t; (void)W2_t;
}

constexpr int DW_STRIDE = 17152;
__device__ __forceinline__ unsigned offb(unsigned row, unsigned ch) { return 256u * row + 16u * (ch ^ (((row & 3u) << 2) | ((row >> 2) & 3u))); }
__device__ __forceinline__ void glds16(const void* gsrc, unsigned lds_dst) { unsigned keep;
  asm volatile("s_mov_b32 %0, m0\n\ts_mov_b32 m0, %2\n\ts_nop 0\n\tglobal_load_lds_dwordx4 %1, off\n\ts_mov_b32 m0, %0" : "=&s"(keep) : "v"(gsrc), "s"(lds_dst) : "memory"); }
__device__ __forceinline__ int wave_excl_scan(int v, int lane, int& total) {
  int x = v;
#pragma unroll
  for (int o = 1; o < 64; o <<= 1) { const int y = __shfl_up(x, o); if (lane >= o) x += y; }
  total = __shfl(x, 63); return x - v;
}
#define LDSW() asm volatile("s_waitcnt lgkmcnt(0)" ::: "memory")
__device__ __forceinline__ int wave_incl_scan_dpp(int v, int lane, int& total) {
  int x = v;
  x += __builtin_amdgcn_update_dpp(0, x, 0x111, 0xf, 0xf, true);
  x += __builtin_amdgcn_update_dpp(0, x, 0x112, 0xf, 0xf, true);
  x += __builtin_amdgcn_update_dpp(0, x, 0x114, 0xf, 0xf, true);
  x += __builtin_amdgcn_update_dpp(0, x, 0x118, 0xf, 0xf, true);
  const int t0 = __builtin_amdgcn_readlane(x, 15), t1 = __builtin_amdgcn_readlane(x, 31), t2 = __builtin_amdgcn_readlane(x, 47), t3 = __builtin_amdgcn_readlane(x, 63);
  const int row = lane >> 4;
  x += (row >= 1 ? t0 : 0) + (row >= 2 ? t1 : 0) + (row >= 3 ? t2 : 0);
  total = t0 + t1 + t2 + t3; return x;
}

__device__ __forceinline__ unsigned h2key(unsigned h) { return (h & 0x8000u) ? (~h & 0xFFFFu) : (h | 0x8000u); }
__device__ __forceinline__ int wave_select(const unsigned short* srow, int t, LAS unsigned char* wl, LAS unsigned short* idx16, int lane) {
  const int n = t + 1;
  if (n <= 256) { for (int i = lane; i < 256; i += 64) idx16[i] = (unsigned short)(i < n ? i : 0); LDSW(); return n; }
  LAS unsigned* hist = (LAS unsigned*)wl;
  for (int i = lane; i < 1024; i += 64) ((LAS v4u*)hist)[i] = (v4u){0u, 0u, 0u, 0u};
  unsigned bk[16][4];
#if defined(SEL_REP_LOAD)
#pragma unroll 1
  for (int rep_ = 0; rep_ < 2; ++rep_)
#endif
#pragma unroll
  for (int i = 0; i < 16; ++i) {
    bk[i][0] = 0u; bk[i][1] = 0u; bk[i][2] = 0u; bk[i][3] = 0u;
    if (i * 512 < n) { const int e0 = (i * 64 + lane) * 8;
      if (e0 < n) { const v4u f = *(const v4u*)(srow + e0);
#pragma unroll
        for (int c = 0; c < 4; ++c) { unsigned lo = f[c] & 0xFFFFu, hi = f[c] >> 16; lo = lo + 0u;
          const unsigned b0 = (e0 + 2 * c <= t) ? (h2key(lo == 0x8000u ? 0u : lo) >> 4) : 0u, b1 = (e0 + 2 * c + 1 <= t) ? (h2key(hi == 0x8000u ? 0u : hi) >> 4) : 0u;
          bk[i][c] = b0 | (b1 << 16); } } }
    if ((i & 7) == 7) asm volatile("" ::: "memory");
  }
#define BIN_OF(i, c) ((bk[i][(c) >> 1] >> (((c) & 1) * 16)) & 0xFFFFu)
  LDSW();
#if defined(SEL_REP_HIST)
#pragma unroll 1
  for (int rep_ = 0; rep_ < 2; ++rep_) {
  for (int i = lane; i < 1024; i += 64) ((LAS v4u*)hist)[i] = (v4u){0u, 0u, 0u, 0u};
  LDSW();
#endif
#pragma unroll
  for (int i = 0; i < 16; ++i) if (i * 512 < n) {
#pragma unroll
    for (int c = 0; c < 8; ++c) { const unsigned bin = BIN_OF(i, c); __hip_atomic_fetch_add(hist + bin, 1u, __ATOMIC_RELAXED, __HIP_MEMORY_SCOPE_WORKGROUP); }
    asm volatile("" ::: "memory"); }
  LDSW();
#if defined(SEL_REP_HIST)
  }
#endif
  const int bbase = 4096 - 64 * (lane + 1); int ssum = 0;
#pragma unroll 16
  for (int k = 0; k < 64; ++k) ssum += (int)hist[bbase + ((k + lane) & 63)];
  int tot; const int pre = wave_incl_scan_dpp(ssum, lane, tot) - ssum;
  const unsigned long long bal = __ballot(pre < 256 && pre + ssum >= 256);
  const int Ls = (int)__builtin_ctzll(bal);
  const int cum0 = __builtin_amdgcn_readlane(pre, Ls), sb = 4096 - 64 * (Ls + 1);
  const int ck = (int)hist[sb + 63 - lane]; int t2_; const int inc = wave_incl_scan_dpp(ck, lane, t2_);
  const unsigned long long bal2 = __ballot(cum0 + inc >= 256);
  const int kk = (int)__builtin_ctzll(bal2);
  const int B1 = sb + 63 - kk, cnt_gt = cum0 + __builtin_amdgcn_readlane(inc, kk) - __builtin_amdgcn_readlane(ck, kk), need1 = 256 - cnt_gt;
  LDSW();
  const unsigned kg = (0x7FFFu - (unsigned)B1) * 0x00010001u, kge = kg + 0x00010001u;
  int ngt = 0, neq = 0;
#pragma unroll
  for (int i = 0; i < 16; ++i) if (i * 512 < n) {
#pragma unroll
    for (int c2 = 0; c2 < 4; ++c2) { const unsigned x = bk[i][c2], fg = (x + kg) & 0x80008000u, fe = ((x + kge) & 0x80008000u) & ~fg; ngt += __builtin_popcount(fg); neq += __builtin_popcount(fe); } }
  int tg, te; int pg = wave_incl_scan_dpp(ngt, lane, tg) - ngt; int pe = wave_incl_scan_dpp(neq, lane, te) - neq;
  LAS unsigned short* cand = (LAS unsigned short*)wl;
#pragma unroll
  for (int i = 0; i < 16; ++i) if (i * 512 < n) {
#pragma unroll
    for (int c2 = 0; c2 < 4; ++c2) { const unsigned x = bk[i][c2], fg = (x + kg) & 0x80008000u, fe = ((x + kge) & 0x80008000u) & ~fg; const int e = (i * 64 + lane) * 8 + 2 * c2;
      if (fg & 0x8000u) { idx16[pg] = (unsigned short)e; ++pg; }
      if (fg & 0x80000000u) { idx16[pg] = (unsigned short)(e + 1); ++pg; }
      if (fe & 0x8000u) { cand[pe] = (unsigned short)e; ++pe; }
      if (fe & 0x80000000u) { cand[pe] = (unsigned short)(e + 1); ++pe; } }
    asm volatile("" ::: "memory"); }
#undef BIN_OF
  LDSW();
  const int m = te;
  unsigned lo = 0u;
  if (m <= 64) {
    unsigned cpv = 0u; if (lane < m) { const unsigned ci = cand[lane]; unsigned hv = srow[ci]; hv = (hv == 0x8000u) ? 0u : hv; cpv = ((h2key(hv) & 15u) << 13) | (8191u - ci) | (1u << 20); }
    int rank = 0;
    for (int k = 0; k < m; ++k) { const unsigned ok = (unsigned)__builtin_amdgcn_readlane((int)cpv, k); rank += (ok > cpv) ? 1 : 0; }
    const bool sel = (lane < m) && (rank < need1);
    const unsigned long long bs = __ballot(sel);
    if (sel) idx16[cnt_gt + __builtin_popcountll(bs & ((1ull << lane) - 1ull))] = (unsigned short)(8191u - (cpv & 0x1FFFu));
  } else if (m <= 256) {
    unsigned cp[4];
#pragma unroll
    for (int j = 0; j < 4; ++j) { const int q = lane + 64 * j; cp[j] = 0u; if (q < m) { const unsigned ci = cand[q]; unsigned hv = srow[ci]; hv = (hv == 0x8000u) ? 0u : hv; cp[j] = ((h2key(hv) & 15u) << 13) | (8191u - ci) | (1u << 20); } }
    for (int bit = 16; bit >= 0; --bit) { const unsigned trial = lo | (1u << bit); int tc = 0;
#pragma unroll
      for (int j = 0; j < 4; ++j) tc += __builtin_popcountll(__ballot((cp[j] >> 20) && ((cp[j] & 0x1FFFFu) >= trial)));
      if (tc >= need1) lo = trial; }
    int pos = cnt_gt;
#pragma unroll
    for (int j = 0; j < 4; ++j) { const bool sel = (cp[j] >> 20) && ((cp[j] & 0x1FFFFu) >= lo); const unsigned long long bs = __ballot(sel);
      if (sel) idx16[pos + __builtin_popcountll(bs & ((1ull << lane) - 1ull))] = (unsigned short)(8191u - (cp[j] & 0x1FFFu)); pos += __builtin_popcountll(bs); }
  } else {
    for (int bit = 16; bit >= 0; --bit) { const unsigned trial = lo | (1u << bit); int c = 0;
      for (int q = lane; q < m; q += 64) { const unsigned ci = cand[q]; unsigned hv = srow[ci]; hv = (hv == 0x8000u) ? 0u : hv; const unsigned cpq = ((h2key(hv) & 15u) << 13) | (8191u - ci); c += (cpq >= trial) ? 1 : 0; }
      int tc; (void)wave_excl_scan(c, lane, tc); if (tc >= need1) lo = trial; }
    int base = cnt_gt;
    for (int q0 = 0; q0 < m; q0 += 64) { const int q = q0 + lane; bool sel = false; unsigned ci = 0;
      if (q < m) { ci = cand[q]; unsigned hv = srow[ci]; hv = (hv == 0x8000u) ? 0u : hv; const unsigned cpq = ((h2key(hv) & 15u) << 13) | (8191u - ci); sel = cpq >= lo; }
      int tc; const int pos = base + wave_excl_scan(sel ? 1 : 0, lane, tc); if (sel) idx16[pos] = (unsigned short)ci; base += tc; }
  }
  LDSW();
  return 256;
}

template <int HOT = 0> __device__ __forceinline__ void wave_attend(int b, int t, int cnt, const bf16_t* qlat, const bf16_t* cnb, LAS unsigned char* wl, LAS unsigned short* idx16, bf16_t* olat, int lane) {
  const int n16 = lane & 15, g = lane >> 4, q4 = (lane & 15) >> 2, p4 = lane & 3;
  const bf16_t* qrow = qlat + (size_t)(b * L + t) * 4096 + n16 * 256 + 8 * g;
  bf16x8 qf[8];
#pragma unroll
  for (int s = 0; s < 8; ++s) qf[s] = *(const bf16x8*)(qrow + 32 * s);
  f32x4 o[16];
#pragma unroll
  for (int c = 0; c < 16; ++c) o[c] = (f32x4){0.f, 0.f, 0.f, 0.f};
  float mrun = -INFINITY, lrun = 0.f;
  const int ntile = (cnt + 31) >> 5;
  const char* cb = (const char*)(cnb + (size_t)b * L * 256);
  const unsigned slot = lane & 15, rsub = lane >> 4;
  constexpr float SC = 0.125f * 1.4426950408889634f;
  v4u stg[16];
#define GATHER_TILE(itn) do { _Pragma("unroll") for (int rg = 0; rg < 8; ++rg) { const unsigned row = 4 * rg + rsub; const unsigned key = HOT ? (idx16[32 * (itn) + row] & 255u) : idx16[32 * (itn) + row]; \
      const unsigned ch = slot ^ (((row & 3u) << 2) | ((row >> 2) & 3u)); const unsigned off = key * 512u + ch * 16u;     \
      stg[rg] = *(const v4u*)(cb + off); stg[8 + rg] = *(const v4u*)(cb + off + 256u); } } while (0)
  GATHER_TILE(0);
#pragma unroll 1
  for (int it = 0; it < ntile; ++it) {
#pragma unroll
    for (int rg = 0; rg < 8; ++rg) { *(LAS v4u*)(wl + rg * 1024 + lane * 16) = stg[rg]; *(LAS v4u*)(wl + 8192 + rg * 1024 + lane * 16) = stg[8 + rg]; }
    LDSW();
    if (it + 1 < ntile) GATHER_TILE(it + 1);
    f32x4 s0 = (f32x4){0.f, 0.f, 0.f, 0.f}, s1 = (f32x4){0.f, 0.f, 0.f, 0.f};
    { bf16x8 fa[4];
#define QK_RD(s_, d0, d1) { const unsigned ib = ((s_) >> 2) * 8192, chq = 4 * ((s_) & 3) + g; d0 = *(const LAS bf16x8*)(wl + ib + offb(n16, chq)); d1 = *(const LAS bf16x8*)(wl + ib + offb(16 + n16, chq)); }
#pragma unroll
      for (int s = 0; s < 2; ++s) QK_RD(s, fa[2 * s], fa[2 * s + 1])
      __builtin_amdgcn_sched_barrier(0);
#pragma unroll
      for (int s = 0; s < 8; ++s) {
        s0 = __builtin_amdgcn_mfma_f32_16x16x32_bf16(fa[2 * (s & 1)], qf[s], s0, 0, 0, 0); s1 = __builtin_amdgcn_mfma_f32_16x16x32_bf16(fa[2 * (s & 1) + 1], qf[s], s1, 0, 0, 0);
        if (s < 6) QK_RD(s + 2, fa[2 * (s & 1)], fa[2 * (s & 1) + 1])
        __builtin_amdgcn_sched_barrier(0);
      } }
    const int sl0 = 32 * it + 4 * g;
    float mx = -INFINITY;
#pragma unroll
    for (int r = 0; r < 4; ++r) { s0[r] = (sl0 + r < cnt) ? s0[r] * SC : -INFINITY; s1[r] = (sl0 + 16 + r < cnt) ? s1[r] * SC : -INFINITY; mx = fmaxf(mx, fmaxf(s0[r], s1[r])); }
    { const auto r16 = __builtin_amdgcn_permlane16_swap(__float_as_uint(mx), __float_as_uint(mx), false, false); mx = fmaxf(__uint_as_float(r16[0]), __uint_as_float(r16[1]));
      const auto r32 = __builtin_amdgcn_permlane32_swap(__float_as_uint(mx), __float_as_uint(mx), false, false); mx = fmaxf(__uint_as_float(r32[0]), __uint_as_float(r32[1])); }
    const float mnew = fmaxf(mrun, mx), alpha = __builtin_amdgcn_exp2f(mrun - mnew);
    float ls = 0.f; float pv[8];
#pragma unroll
    for (int r = 0; r < 4; ++r) { pv[r] = __builtin_amdgcn_exp2f(s0[r] - mnew); pv[4 + r] = __builtin_amdgcn_exp2f(s1[r] - mnew); ls += pv[r] + pv[4 + r]; }
    lrun = lrun * alpha + ls; mrun = mnew;
#pragma unroll
    for (int c = 0; c < 16; ++c) o[c] = o[c] * alpha;
    const v4u pbw = (v4u){cvt_pk_bf16(pv[0], pv[1]), cvt_pk_bf16(pv[2], pv[3]), cvt_pk_bf16(pv[4], pv[5]), cvt_pk_bf16(pv[6], pv[7])};
    const bf16x8 pb = __builtin_bit_cast(bf16x8, pbw);
    { v4i16_t ft[4][2];
#define PV_RD(c_, d) { const unsigned ib = ((c_) >> 3) * 8192, chc = 2 * ((c_) & 7) + (p4 >> 1); \
        d[0] = __builtin_amdgcn_ds_read_tr16_b64_v4i16((LAS v4i16_t*)(wl + ib + offb(4 * g + q4, chc) + 8 * (p4 & 1))); \
        d[1] = __builtin_amdgcn_ds_read_tr16_b64_v4i16((LAS v4i16_t*)(wl + ib + offb(16 + 4 * g + q4, chc) + 8 * (p4 & 1))); }
#pragma unroll
      for (int c = 0; c < 4; ++c) PV_RD(c, ft[c])
      __builtin_amdgcn_sched_barrier(0);
#pragma unroll
      for (int c = 0; c < 16; ++c) { const v4i16_t t0 = ft[c & 3][0], t1 = ft[c & 3][1];
        const bf16x8 af = (bf16x8){t0[0], t0[1], t0[2], t0[3], t1[0], t1[1], t1[2], t1[3]};
        o[c] = __builtin_amdgcn_mfma_f32_16x16x32_bf16(af, pb, o[c], 0, 0, 0);
        if (c < 12) PV_RD(c + 4, ft[c & 3])
        __builtin_amdgcn_sched_barrier(0);
      } }
    LDSW();
  }
  lrun += __shfl_xor(lrun, 16); lrun += __shfl_xor(lrun, 32);
  const float inv = 1.f / lrun;
  bf16_t* orow = olat + (size_t)(b * L + t) * 4096 + n16 * 256 + 4 * g;
#pragma unroll
  for (int c = 0; c < 16; ++c) { const f32x4 v = o[c] * inv; *(v2u*)(orow + 16 * c) = (v2u){cvt_pk_bf16(v[0], v[1]), cvt_pk_bf16(v[2], v[3])}; }
}

__device__ __forceinline__ void ph_select_attend(const unsigned short* sc, const bf16_t* qlat, const bf16_t* cnb, bf16_t* olat, LAS unsigned char* lds, const float* w1, const float* w2, bf16_t* W1_t, bf16_t* W2_t, void* scratch_olat = nullptr) {
  const int tid = TIDX(), lane = tid & 63, wave = __builtin_amdgcn_readfirstlane(tid >> 6), blk = BIDX();
  LAS unsigned char* wl = lds + wave * DW_STRIDE; LAS unsigned short* idx16 = (LAS unsigned short*)(wl + 16384);
  LAS unsigned* qctr = (LAS unsigned*)(lds + MISC_OFF + 64);
  if (tid == 0) *qctr = 0u;
  __syncthreads();
  const int b = blk & 1, NGW = (int)gridDim.x * 8; (void)scratch_olat;
#pragma unroll 1
  for (;;) {
    unsigned item = 0u; if (lane == 0) item = __hip_atomic_fetch_add(qctr, 1u, __ATOMIC_RELAXED, __HIP_MEMORY_SCOPE_WORKGROUP);
    item = (unsigned)__builtin_amdgcn_readfirstlane((int)item);
    if (item >= 160u) break;
    const unsigned grp = item / 5u, r = item - grp * 5u;
    if (r == 0u || r == 3u) {
      const unsigned qn = grp * 2u + (r == 3u ? 1u : 0u);
      const int t = (blk >> 1) * 8 + (int)(qn & 7u) + 1024 * (7 - (int)(qn >> 3));
      int lane_s = lane; asm volatile("" : "+v"(lane_s));
      const int cnt = wave_select(sc + (size_t)(b * L + t) * L, t, wl, idx16, lane_s);
      int lane_a = lane; asm volatile("" : "+v"(lane_a));
      wave_attend(b, t, cnt, qlat, cnb, wl, idx16, olat, lane_a);
    } else {
      const unsigned cn = grp * 3u + (r == 1u ? 0u : (r == 2u ? 1u : 2u));
      const int wt = blk * 8 + (int)(cn & 7u) + (int)(cn >> 3) * NGW;
      int lane_t = lane; asm volatile("" : "+v"(lane_t));
      moe_weight_tile(wt < 12288 ? moe_layer_tile(0, wt) : moe_layer_tile(1, wt - 12288), w1, w2, W1_t, W2_t, lane_t);
    }
  }
}

__device__ __forceinline__ void ph_qlat(const bf16_t* pa, const bf16_t* WqT, bf16_t* qlat) {
  const int tid = TIDX(), lane = tid & 63, gw = BIDX() * 8 + (tid >> 6), NGW = (int)gridDim.x * 8;
  const int n16 = lane & 15, g = lane >> 4;
#pragma unroll 1
  for (int it = gw; it < 16 * 512; it += NGW) {
    const int h = it & 15, rt = it >> 4;
    bf16x8 qb[2][2];
#pragma unroll
    for (int mt = 0; mt < 2; ++mt)
#pragma unroll
      for (int ks = 0; ks < 2; ++ks) qb[mt][ks] = *(const bf16x8*)(pa + (size_t)(rt * 32 + mt * 16 + n16) * 2048 + h * 64 + 32 * ks + 8 * g);
    const bf16_t* wp = WqT + (size_t)h * 256 * 64 + (size_t)n16 * 64 + 8 * g;
    bf16_t* op = qlat + (size_t)(rt * 32 + n16) * 4096 + h * 256 + 4 * g;
#pragma unroll 4
    for (int ct = 0; ct < 16; ++ct) {
      const bf16x8 a0 = *(const bf16x8*)(wp + (size_t)(16 * ct) * 64), a1 = *(const bf16x8*)(wp + (size_t)(16 * ct) * 64 + 32);
#pragma unroll
      for (int mt = 0; mt < 2; ++mt) { f32x4 acc = __builtin_amdgcn_mfma_f32_16x16x32_bf16(a0, qb[mt][0], (f32x4){0.f, 0.f, 0.f, 0.f}, 0, 0, 0);
        acc = __builtin_amdgcn_mfma_f32_16x16x32_bf16(a1, qb[mt][1], acc, 0, 0, 0);
        *(v2u*)(op + (size_t)(mt * 16) * 4096 + 16 * ct) = (v2u){cvt_pk_bf16(acc[0], acc[1]), cvt_pk_bf16(acc[2], acc[3])}; }
    }
  }
}
__device__ __forceinline__ void ph_o2(const bf16_t* olat, const bf16_t* WuvT, bf16_t* o2b) {
  const int tid = TIDX(), lane = tid & 63, gw = BIDX() * 8 + (tid >> 6), NGW = (int)gridDim.x * 8;
  const int n16 = lane & 15, g = lane >> 4;
#pragma unroll 1
  for (int it = gw; it < 16 * 512; it += NGW) {
    const int h = it & 15, rt = it >> 4;
    f32x4 acc[4][2];
#pragma unroll
    for (int vt = 0; vt < 4; ++vt) { acc[vt][0] = (f32x4){0.f, 0.f, 0.f, 0.f}; acc[vt][1] = (f32x4){0.f, 0.f, 0.f, 0.f}; }
    const bf16_t* ap = olat + (size_t)(rt * 32 + n16) * 4096 + h * 256 + 8 * g;
    const bf16_t* wp = WuvT + (size_t)h * 64 * 256 + (size_t)n16 * 256 + 8 * g;
#pragma unroll
    for (int ks = 0; ks < 8; ++ks) {
      const bf16x8 b0 = *(const bf16x8*)(ap + 32 * ks), b1 = *(const bf16x8*)(ap + (size_t)16 * 4096 + 32 * ks);
#pragma unroll
      for (int vt = 0; vt < 4; ++vt) { const bf16x8 a = *(const bf16x8*)(wp + (size_t)(16 * vt) * 256 + 32 * ks);
        acc[vt][0] = __builtin_amdgcn_mfma_f32_16x16x32_bf16(a, b0, acc[vt][0], 0, 0, 0); acc[vt][1] = __builtin_amdgcn_mfma_f32_16x16x32_bf16(a, b1, acc[vt][1], 0, 0, 0); }
    }
    bf16_t* op = o2b + (size_t)(rt * 32 + n16) * 1024 + h * 64 + 4 * g;
#pragma unroll
    for (int vt = 0; vt < 4; ++vt)
#pragma unroll
      for (int mt = 0; mt < 2; ++mt) *(v2u*)(op + (size_t)(mt * 16) * 1024 + 16 * vt) = (v2u){cvt_pk_bf16(acc[vt][mt][0], acc[vt][mt][1]), cvt_pk_bf16(acc[vt][mt][2], acc[vt][mt][3])};
  }
}

namespace pg8 {
struct GroupAOrder {
    static constexpr bool GATHER = false; const int* rowmap;
    StaticOrder so; int png; size_t acol_bytes;
    __device__ void init(const void* A, int lda, const void* Bt, int ldb, int M, int N, int png_, size_t acol_bytes_, int G, int c) { so.init(A, lda, Bt, ldb, M, N, G, c); png = png_; acol_bytes = acol_bytes_; }
    __device__ bool next(int i, Unit& u) const { int pm, pn; if (!so.tile(i, pm, pn)) return false; u.pa = so.A + (size_t)pm * so.ta + (size_t)(pn / png) * acol_bytes; u.pb = so.Bt + (size_t)pn * so.tb; u.orow = pm * BM; u.ocol = pn * BM; u.e = 0; u.kind = 0; return true; }
    __device__ __forceinline__ int rowof(const Unit&, int r) const { return r; }
    __device__ __forceinline__ void a_ready(const Unit&) const {}
    __device__ __forceinline__ void done(const Unit&) const {}
};
}
constexpr int GLA_LDSU = 65536;

__device__ __forceinline__ v4i16_t trrd(LAS unsigned char* p) { return __builtin_amdgcn_ds_read_tr16_b64_v4i16((LAS v4i16_t*)p); }
__device__ __forceinline__ bf16x8 cat44(v4i16_t a, v4i16_t b) { return (bf16x8){a[0], a[1], a[2], a[3], b[0], b[1], b[2], b[3]}; }

__device__ __forceinline__ void ph_gla_a1(const bf16_t* pb, const float* gbias, bf16_t* qt, bf16_t* og, bf16_t* kvt, float* dcy, LAS unsigned char* lds, const float* w1, const float* w2, bf16_t* W1_t, bf16_t* W2_t) {
  const int tid = TIDX(), lane = tid & 63, wave = __builtin_amdgcn_readfirstlane(tid >> 6), blk = BIDX();
  const int half = wave >> 2, wq = wave & 3;
  LAS unsigned char* X = lds + half * GLA_LDSU; LAS unsigned char* Y = X + 16384; LAS unsigned char* V = X + 32768;
  LAS float* EX = (LAS float*)(lds + 131072 + half * 2048);
  const unsigned v_addr = (unsigned)__builtin_amdgcn_readfirstlane((int)(unsigned)(size_t)V);
  const int n16 = lane & 15, g = lane >> 4, q4 = (lane & 15) >> 2, p4 = lane & 3;
#pragma unroll 1
  for (int uu = 0; uu < 2; ++uu) {
    const int u = blk * 4 + half * 2 + uu;
    const int h = u & 3, bc = u >> 2, r0 = bc * 64;
    { const unsigned slot = lane & 15, rsub = lane >> 4; const int im = wq;
#pragma unroll
      for (int rg = 0; rg < 8; ++rg) { const unsigned row = 4 * rg + rsub; const unsigned ch = slot ^ (((row & 3u) << 2) | ((row >> 2) & 3u));
        const char* src = (const char*)(pb + (size_t)(r0 + 32 * (im >> 1) + row) * 3584 + 1024 + h * 256 + (im & 1) * 128) + ch * 16;
        glds16(src, v_addr + im * 8192 + rg * 1024); } }
    const int d0 = 2 * lane; const float gb0 = gbias[h * 128 + d0], gb1 = gbias[h * 128 + d0 + 1];
    const unsigned wofs = 16u * ((unsigned)(d0 >> 3)), wsub = (unsigned)(d0 & 7) * 2u;
    unsigned gq[16], qq[16], kq[16]; float bl0[16], bl1[16];
#pragma unroll
    for (int jj = 0; jj < 16; ++jj) { const bf16_t* rp = pb + (size_t)(r0 + wq * 16 + jj) * 3584 + h * 128 + d0;
      gq[jj] = *(const unsigned*)(rp + 3072); qq[jj] = *(const unsigned*)rp; kq[jj] = *(const unsigned*)(rp + 512); }
    float bc0 = 0.f, bc1 = 0.f;
#pragma unroll
    for (int jj = 0; jj < 16; ++jj) { const float a0 = bf_lo(gq[jj]) + gb0, a1 = bf_hi(gq[jj]) + gb1;
      bc0 += (fminf(a0, 0.f) - __logf(1.f + __expf(-fabsf(a0)))) * (1.f / 16.f); bc1 += (fminf(a1, 0.f) - __logf(1.f + __expf(-fabsf(a1)))) * (1.f / 16.f);
      bl0[jj] = bc0; bl1[jj] = bc1; }
    *(LAS f32x2_t*)(EX + wq * 128 + d0) = (f32x2_t){bc0, bc1};
    LDSW(); __syncthreads();
    float of0 = 0.f, of1 = 0.f, tt0 = 0.f, tt1 = 0.f;
#pragma unroll
    for (int w2_ = 0; w2_ < 4; ++w2_) { const f32x2_t e = *(const LAS f32x2_t*)(EX + w2_ * 128 + d0); tt0 += e[0]; tt1 += e[1]; if (w2_ < wq) { of0 += e[0]; of1 += e[1]; } }
#pragma unroll
    for (int jj = 0; jj < 16; ++jj) { const int j = wq * 16 + jj; const float b0 = bl0[jj] + of0, b1 = bl1[jj] + of1;
      const float e0 = __expf(b0), e1 = __expf(b1), i0 = __expf(fminf(-b0, 80.f)), i1 = __expf(fminf(-b1, 80.f));
      const unsigned qo = cvt_pk_bf16(bf_lo(qq[jj]) * 0.08838834764831845f * e0, bf_hi(qq[jj]) * 0.08838834764831845f * e1);
      const unsigned ko = cvt_pk_bf16(bf_lo(kq[jj]) * i0, bf_hi(kq[jj]) * i1);
      *(unsigned*)(qt + (size_t)(r0 + j) * 512 + h * 128 + d0) = qo;
      const unsigned row = (unsigned)(j & 31); const unsigned off = (unsigned)(j >> 5) * 8192u + 256u * row + ((wofs ^ (16u * (((row & 3u) << 2) | ((row >> 2) & 3u))))) + wsub;
      *(LAS unsigned*)(X + off) = qo; *(LAS unsigned*)(Y + off) = ko; }
    if (wq == 3) *(float2*)(dcy + (size_t)u * 128 + d0) = make_float2(__expf(tt0), __expf(tt1));
    asm volatile("s_waitcnt vmcnt(0) lgkmcnt(0)" ::: "memory");
    __syncthreads();
    const int it = wq;
    bf16x8 afr[2];
#pragma unroll
    for (int ks = 0; ks < 2; ++ks) {
      unsigned pk[4] = {0u, 0u, 0u, 0u};
#pragma unroll
      for (int jh = 0; jh < 2; ++jh) { const int jt = 2 * ks + jh;
        if (jt <= it) { f32x4 acc = (f32x4){0.f, 0.f, 0.f, 0.f};
#pragma unroll
          for (int s = 0; s < 4; ++s) { const bf16x8 ya = *(const LAS bf16x8*)(Y + (jt >> 1) * 8192 + offb(n16 + 16 * (jt & 1), 4 * s + g)), xb = *(const LAS bf16x8*)(X + (it >> 1) * 8192 + offb(n16 + 16 * (it & 1), 4 * s + g));
            acc = __builtin_amdgcn_mfma_f32_16x16x32_bf16(ya, xb, acc, 0, 0, 0); }
          const int i_ = 16 * it + n16, jbase = 16 * jt + 4 * g;
#pragma unroll
          for (int r = 0; r < 4; ++r) if (jbase + r > i_) acc[r] = 0.f;
          pk[2 * jh] = cvt_pk_bf16(acc[0], acc[1]); pk[2 * jh + 1] = cvt_pk_bf16(acc[2], acc[3]); } }
      afr[ks] = __builtin_bit_cast(bf16x8, (v4u){pk[0], pk[1], pk[2], pk[3]});
    }
    bf16_t* ogp = og + (size_t)u * 16384 + (size_t)(it * 16) * 256 + lane * 4; bf16_t* kvp = kvt + (size_t)u * 32768 + (size_t)n16 * 128 + 4 * g;
#pragma unroll 2
    for (int nt = 0; nt < 16; ++nt) {
      const unsigned vimg = (unsigned)(nt >> 3) * 8192u, chv = 2u * (unsigned)(nt & 7) + (unsigned)(p4 >> 1), sub = 8u * (unsigned)(p4 & 1);
      f32x4 acc = (f32x4){0.f, 0.f, 0.f, 0.f};
      { LAS unsigned char* vb = V + vimg; const bf16x8 bi0 = cat44(trrd(vb + offb(4 * g + q4, chv) + sub), trrd(vb + offb(16 + 4 * g + q4, chv) + sub));
        acc = __builtin_amdgcn_mfma_f32_16x16x32_bf16(afr[0], bi0, acc, 0, 0, 0); }
      if (it >= 2) { LAS unsigned char* vb = V + 16384 + vimg; const bf16x8 bi1 = cat44(trrd(vb + offb(4 * g + q4, chv) + sub), trrd(vb + offb(16 + 4 * g + q4, chv) + sub));
        acc = __builtin_amdgcn_mfma_f32_16x16x32_bf16(afr[1], bi1, acc, 0, 0, 0); }
      *(v2u*)(ogp + (size_t)nt * 256) = (v2u){cvt_pk_bf16(acc[0], acc[1]), cvt_pk_bf16(acc[2], acc[3])};
    }
#pragma unroll 1
    for (int nq = 0; nq < 4; ++nq) { const int nt = 4 * wq + nq;
      const unsigned vimg = (unsigned)(nt >> 3) * 8192u, chv = 2u * (unsigned)(nt & 7) + (unsigned)(p4 >> 1), sub = 8u * (unsigned)(p4 & 1);
      bf16x8 bn[2];
#pragma unroll
      for (int ks = 0; ks < 2; ++ks) { LAS unsigned char* vb = V + ks * 16384 + vimg; bn[ks] = cat44(trrd(vb + offb(8 * g + q4, chv) + sub), trrd(vb + offb(8 * g + 4 + q4, chv) + sub)); }
#pragma unroll
      for (int mt = 0; mt < 8; ++mt) { const unsigned chy = 2u * (unsigned)mt + (unsigned)(p4 >> 1);
        const bf16x8 a0 = cat44(trrd(Y + offb(8 * g + q4, chy) + sub), trrd(Y + offb(8 * g + 4 + q4, chy) + sub));
        const bf16x8 a1 = cat44(trrd(Y + 8192 + offb(8 * g + q4, chy) + sub), trrd(Y + 8192 + offb(8 * g + 4 + q4, chy) + sub));
        f32x4 acc = __builtin_amdgcn_mfma_f32_16x16x32_bf16(a0, bn[0], (f32x4){0.f, 0.f, 0.f, 0.f}, 0, 0, 0);
        acc = __builtin_amdgcn_mfma_f32_16x16x32_bf16(a1, bn[1], acc, 0, 0, 0);
        *(v2u*)(kvp + (size_t)(16 * nt) * 128 + 16 * mt) = (v2u){cvt_pk_bf16(acc[0], acc[1]), cvt_pk_bf16(acc[2], acc[3])}; }
    }
    LDSW(); __syncthreads();
  }
}

__device__ __forceinline__ void ph_gla_a2(const bf16_t* kvt, const float* dcy, bf16_t* spt) {
  const int gtid = BIDX() * NTHR + TIDX();
  if (gtid >= 8 * 256 * 32) return;
  const int g4 = gtid & 31, dv = (gtid >> 5) & 255, bh = gtid >> 13, b = bh >> 2, h = bh & 3;
  f32x4 S = (f32x4){0.f, 0.f, 0.f, 0.f};
#pragma unroll 4
  for (int c = 0; c < 128; ++c) { const size_t u = (size_t)((b * 128 + c) * 4 + h);
    const v2u kvb = *(const v2u*)(kvt + u * 32768 + (size_t)dv * 128 + 4 * g4); const f32x4 kv = (f32x4){bf_lo(kvb[0]), bf_hi(kvb[0]), bf_lo(kvb[1]), bf_hi(kvb[1])}, dc = *(const f32x4*)(dcy + u * 128 + 4 * g4);
    *(v2u*)(spt + u * 32768 + (size_t)dv * 128 + 4 * g4) = (v2u){cvt_pk_bf16(S[0], S[1]), cvt_pk_bf16(S[2], S[3])};
    S = dc * (S + kv); }
}

constexpr int A3_LD = 272;
__device__ __forceinline__ void ph_gla_a3(const bf16_t* pb, const bf16_t* qt, const bf16_t* og, const bf16_t* spt, const float* ng, bf16_t* ob, LAS unsigned char* lds) {
  const int tid = TIDX(), lane = tid & 63, wave = __builtin_amdgcn_readfirstlane(tid >> 6), gw = BIDX() * 8 + wave, NGW = (int)gridDim.x * 8;
  const int n16 = lane & 15, g = lane >> 4, row16 = lane >> 2, cq = lane & 3;
  LAS float* T = (LAS float*)(lds + wave * (16 * A3_LD * 4));
#pragma unroll 1
  for (int w = gw; w < 4096; w += NGW) {
    const int u = w >> 2, it = w & 3, h = u & 3, r0 = (u >> 2) * 64;
    const bf16_t* sp = spt + (size_t)u * 32768 + (size_t)n16 * 128 + 8 * g;
    bf16x8 qa[4];
#pragma unroll
    for (int ks = 0; ks < 4; ++ks) qa[ks] = *(const bf16x8*)(qt + (size_t)(r0 + 16 * it + n16) * 512 + h * 128 + 32 * ks + 8 * g);
    const bf16_t* ogp = og + (size_t)u * 16384 + (size_t)(it * 16) * 256 + lane * 4;
#pragma unroll
    for (int nt = 0; nt < 16; ++nt) {
      const v2u ogb = *(const v2u*)(ogp + nt * 256); f32x4 acc = (f32x4){bf_lo(ogb[0]), bf_hi(ogb[0]), bf_lo(ogb[1]), bf_hi(ogb[1])};
#pragma unroll
      for (int ks = 0; ks < 4; ++ks) { const bf16x8 sb = *(const bf16x8*)(sp + (size_t)(16 * nt) * 128 + 32 * ks); acc = __builtin_amdgcn_mfma_f32_16x16x32_bf16(qa[ks], sb, acc, 0, 0, 0); }
#pragma unroll
      for (int r = 0; r < 4; ++r) T[(4 * g + r) * A3_LD + 16 * nt + n16] = acc[r];
    }
    LDSW();
    const size_t row = (size_t)(r0 + 16 * it + row16);
    f32x4 v[16]; float ss = 0.f;
#pragma unroll
    for (int k = 0; k < 16; ++k) { v[k] = *(const LAS f32x4*)(T + row16 * A3_LD + 16 * k + 4 * cq); ss += (v[k][0] * v[k][0] + v[k][1] * v[k][1]) + (v[k][2] * v[k][2] + v[k][3] * v[k][3]); }
    ss += __shfl_xor(ss, 1); ss += __shfl_xor(ss, 2);
    const float rs = rsqrtf(ss * (1.f / 256.f) + 1e-6f);
#pragma unroll
    for (int k = 0; k < 16; ++k) { const int col = h * 256 + 16 * k + 4 * cq; const v2u rg = *(const v2u*)(pb + row * 3584 + 2048 + col); const f32x4 gn = *(const f32x4*)(ng + col);
      const float rr[4] = {bf_lo(rg[0]), bf_hi(rg[0]), bf_lo(rg[1]), bf_hi(rg[1])}; float o[4];
#pragma unroll
      for (int z = 0; z < 4; ++z) o[z] = v[k][z] * rs * gn[z] * (rr[z] * __builtin_amdgcn_rcpf(1.f + __expf(-rr[z])));
      *(v2u*)(ob + row * 1024 + col) = (v2u){cvt_pk_bf16(o[0], o[1]), cvt_pk_bf16(o[2], o[3])}; }
    LDSW();
  }
}
#ifndef PROBE
#define PROBE 0
#endif
#ifndef PROBE_S
#define PROBE_S 10.0f
#endif
constexpr size_t MiB = 1u << 20;
constexpr size_t WS_CTL = 0, CTL_ZERO_BYTES = 1 * MiB;
constexpr int CW_BAR = 4096, CW_TMO = 64, CW_RDY = 65536;
constexpr size_t WS_NEEDED = 2048 * MiB;

struct Args { In in; float* out; unsigned char* ws; };

struct Opt { bf16_t *qt, *spt, *og, *kvt; float *dcy; bf16_t *Wql_t, *Wuv_t, *cnb, *qlat, *olat; unsigned short* sc; bf16_t *xb, *WA_t, *WoutA_t, *WB_t, *WoutB_t, *W1_t, *W2_t, *projA_b, *hbf, *o2b, *xs, *act, *Ys, *projB_b; MoeBufs m; };
__device__ __forceinline__ nvp::Ws carve_ws(unsigned char* ws) {
  nvp::Ws w; auto at = [&](size_t mib) { return (char*)ws + mib * MiB; };
  w.projA = (float*)at(2); w.cn = (float*)at(119); w.sc = (float*)at(135); w.idx = (int*)at(647); w.o2 = (float*)at(663);
  w.x1 = (float*)at(727); w.x2 = (float*)at(791);
  w.projB = (float*)at(135); w.adec = (float*)at(135 + 194); w.og = (float*)at(135 + 194 + 32); w.on = (float*)at(135 + 194 + 32 + 64);
  w.counts = nullptr; w.h = nullptr; w.hb = nullptr; w.ys = nullptr; w.tok_e = nullptr; w.tok_g = nullptr; w.slot_of = nullptr; w.row_tok = nullptr; w.row_gate = nullptr; w.blk_e = nullptr;
  return w;
}
__device__ __forceinline__ Opt carve_opt(unsigned char* ws) {
  Opt o; auto at = [&](size_t mib) { return (bf16_t*)((char*)ws + mib * MiB); };
  char* sm = (char*)ws + 855 * MiB;
  o.m.tok_e = (int*)sm; o.m.tok_g = (float*)(sm + 256 * 1024); o.m.slot_of = (int*)(sm + 512 * 1024); o.m.slot_gate = (float*)(sm + 768 * 1024); o.m.blk_e = (int*)(sm + 1088 * 1024); o.m.blkcnt = (int*)(sm + 1096 * 1024); o.m.nblk = (int*)(sm + 1160 * 1024); o.m.slot_tok = (int*)(sm + 1200 * 1024);
  o.WA_t = at(860); o.WoutA_t = at(864); o.WB_t = at(866); o.WoutB_t = at(873);
  o.Wql_t = at(875); o.Wuv_t = at(877); o.olat = at(2); o.cnb = at(647); o.qlat = at(1856); o.sc = (unsigned short*)at(135);
  o.qt = at(135); o.dcy = (float*)at(151); o.og = at(152); o.kvt = at(216); o.spt = at(344);
  o.W1_t = at(880); o.W2_t = at(1136);
  o.xb = at(1264); o.projA_b = at(1296); o.hbf = at(1360); o.o2b = at(1392);
  o.xs = at(1424); o.act = at(1568); o.Ys = at(1712); o.projB_b = at(1856);
  return o;
}

struct ProIn { const float *a_w_uk, *a_w_uv, *x, *a_w_in, *a_w_out, *b_w_in, *b_w_g2, *b_w_out, *m_w1, *m_w2; };
__device__ __forceinline__ void ph_prologue(const ProIn I, const Opt& o) {
  const int tid = TIDX(), lane = tid & 63, gw = BIDX() * 8 + (tid >> 6), NGW = (int)gridDim.x * 8, gtid = BIDX() * NTHR + tid, NGT = (int)gridDim.x * NTHR;
  cvt_f32_to_bf16(I.x, D, o.xb, D, NT, D, gtid, NGT);
  zero_rect(o.WA_t, D, DINA, 2048 - DINA, 0, D * 2, gtid, NGT);
  for (int i = gtid; i < 512 * 256; i += NGT) { const int n = i >> 8, k4 = (i & 255) * 4; float a[4];
#pragma unroll
    for (int z = 0; z < 4; ++z) { const float* gl = I.b_w_in + (size_t)(k4 + z) * DINB + 2048; float s = 0.f;
#pragma unroll
      for (int j = 0; j < 16; ++j) s = fmaf(gl[j], I.b_w_g2[j * 512 + n], s);
      a[z] = s; }
    *(v2u*)(o.WB_t + (size_t)(3072 + n) * D + k4) = (v2u){cvt_pk_bf16(a[0], a[1]), cvt_pk_bf16(a[2], a[3])}; }
  int w0 = 0;
#pragma unroll 1
  for (int h = 0; h < 16; ++h) {
    transpose_job(mk_tjob(I.a_w_uk + (size_t)h * 64 * 256, 256, 64, 256, o.Wql_t, 256, h * 256, (h & 3) * 64, 0), w0, gw, NGW, lane);
    transpose_job(mk_tjob(I.a_w_uv + (size_t)h * 256 * 64, 64, 256, 64, o.Wuv_t, 1024, h * 64, (h & 3) * 256, 0), w0, gw, NGW, lane);
    for (int hp = 0; hp < 4; ++hp) if (hp != (h & 3)) { zero_rect(o.Wql_t, 256, h * 256, 256, hp * 128, 128, gtid, NGT); zero_rect(o.Wuv_t, 1024, h * 64, 64, hp * 512, 512, gtid, NGT); }
  }
  transpose_job(mk_tjob(I.a_w_in, DINA, D, DINA, o.WA_t, D, 0, 0, 0), w0, gw, NGW, lane);
  transpose_job(mk_tjob(I.a_w_out, D, D, D, o.WoutA_t, D, 0, 0, 0), w0, gw, NGW, lane);
  transpose_job(mk_tjob(I.b_w_in, DINB, D, 2048, o.WB_t, D, 0, 0, 0), w0, gw, NGW, lane);
  transpose_job(mk_tjob(I.b_w_in + 2064, DINB, D, 1024, o.WB_t, D, 2048, 0, 0), w0, gw, NGW, lane);
  transpose_job(mk_tjob(I.b_w_out, D, D, D, o.WoutB_t, D, 0, 0, 0), w0, gw, NGW, lane);
}
__device__ __forceinline__ void ph_gla_shim(const bf16_t* pb, const float* gbias, float* projB, float* adec) {
  const int gtid = BIDX() * NTHR + TIDX(), NGT = (int)gridDim.x * NTHR;
  for (size_t i = gtid; i < (size_t)NT * 896; i += NGT) { const size_t r = i / 896; const int c = (int)(i % 896) * 4; const v2u v = *(const v2u*)(pb + r * 3584 + c);
    const f32x4 f = (f32x4){bf_lo(v[0]), bf_hi(v[0]), bf_lo(v[1]), bf_hi(v[1])};
    if (c < 2048) *(f32x4*)(projB + r * DINB + c) = f;
    else if (c < 3072) *(f32x4*)(projB + r * DINB + 2064 + (c - 2048)) = f;
    else { f32x4 o;
#pragma unroll
      for (int z = 0; z < 4; ++z) { const float a = f[z] + gbias[c - 3072 + z]; const float ls = fminf(a, 0.f) - log1pf(expf(-fabsf(a))); o[z] = expf(ls * (1.f / 16.f)); }
      *(f32x4*)(adec + r * 512 + (c - 3072)) = o; } }
}

#if PROBE == 3
#define GLA_PHASES \
      PH_BEGIN ph_gla_shim(o.projB_b, I.b_g_bias, w.projB, w.adec); PH_END \
      GRID_BAR(); \
      PH_BEGIN nvp::np_gla_scan(w.projB, w.adec, w.og, fl); PH_END \
      GRID_BAR(); \
      PH_BEGIN nvp::np_gla_norm(w.og, w.projB, I.b_norm, w.on); PH_END \
      GRID_BAR(); \
      PH_BEGIN cvt_f32_to_bf16(w.on, D, o.o2b, D, NT, D, gtid_, NGT_); PH_END \
      GRID_BAR(); \
      PH_BEGIN ph_gla_a1(o.projB_b, I.b_g_bias, (bf16_t*)(wsb_ + 489 * MiB), (bf16_t*)(wsb_ + 506 * MiB), (bf16_t*)(wsb_ + 880 * MiB), (float*)(wsb_ + 505 * MiB), ll, I.m_w1, I.m_w2, o.W1_t, o.W2_t); PH_END \
      GRID_BAR(); \
      PH_BEGIN ph_gla_a2((bf16_t*)(wsb_ + 880 * MiB), (float*)(wsb_ + 505 * MiB), (bf16_t*)(wsb_ + 1136 * MiB)); PH_END \
      GRID_BAR(); \
      PH_BEGIN ph_gla_a3(o.projB_b, (bf16_t*)(wsb_ + 489 * MiB), (bf16_t*)(wsb_ + 506 * MiB), (bf16_t*)(wsb_ + 1136 * MiB), I.b_norm, (bf16_t*)(wsb_ + 570 * MiB), ll); PH_END \
      GRID_BAR(); \
      PH_BEGIN { unsigned* fl_ = (unsigned*)(wsb_ + 512 * 1024); unsigned bits = 0u; \
        { const bf16_t* a = (const bf16_t*)(wsb_ + 489 * MiB); for (size_t i = gtid_; i < (size_t)NT * 512; i += NGT_) { const float v = bf2f(a[i]); if (!(fabsf(v) < 1e30f)) bits |= 1u; } } \
        { const float* a = (const float*)(wsb_ + 506 * MiB); for (size_t i = gtid_; i < (size_t)NT * 1024; i += NGT_) { const float v = a[i]; if (!(fabsf(v) < 1e30f)) bits |= 2u; } } \
        { const float* a = (const float*)(wsb_ + 880 * MiB); for (size_t i = gtid_; i < (size_t)1024 * 32768; i += NGT_) { const float v = a[i]; if (!(fabsf(v) < 1e30f)) bits |= 4u; } } \
        { const bf16_t* a = (const bf16_t*)(wsb_ + 1136 * MiB); for (size_t i = gtid_; i < (size_t)1024 * 32768; i += NGT_) { const float v = bf2f(a[i]); if (!(fabsf(v) < 1e30f)) bits |= 8u; } } \
        { const bf16_t* a = (const bf16_t*)(wsb_ + 570 * MiB); for (size_t i = gtid_; i < (size_t)NT * 1024; i += NGT_) { const float v = bf2f(a[i]); if (!(fabsf(v) < 1e30f)) bits |= 16u; } } \
        { const float* a = (const float*)(wsb_ + 505 * MiB); for (size_t i = gtid_; i < (size_t)1024 * 128; i += NGT_) { const float v = a[i]; if (!(fabsf(v) < 1e30f)) bits |= 32u; } } \
        if (bits) atomicOr(fl_, bits); \
        { float* pd = (float*)(wsb_ + 1968 * MiB); const bf16_t* ob = (const bf16_t*)(wsb_ + 570 * MiB); for (size_t i = gtid_; i < (size_t)NT * D; i += NGT_) pd[i] = bf2f(ob[i]) - w.on[i]; } } PH_END \
      GRID_BAR();
#else
#define GLA_PHASES \
      PH_BEGIN ph_gla_a1(o.projB_b, I.b_g_bias, o.qt, o.og, o.kvt, o.dcy, ll, I.m_w1, I.m_w2, o.W1_t, o.W2_t); PH_END \
      GRID_BAR(); \
      PH_BEGIN ph_gla_a2(o.kvt, o.dcy, o.spt); PH_END \
      GRID_BAR(); \
      PH_BEGIN ph_gla_a3(o.projB_b, o.qt, o.og, o.spt, I.b_norm, o.o2b, ll); PH_END \
      GRID_BAR();
#endif
#if defined(FUSE_ON)
#define MOE_GEMM_PHASES(li) \
    PH_BEGIN pg8::MoeFusedOrder S; S.init(o.xs, o.act, o.W1_t + (size_t)li * 32 * 2048 * D, o.W2_t + (size_t)li * 32 * D * D, o.m.slot_tok, o.m.blk_e, (unsigned*)(wsb_ + WS_CTL) + CW_RDY + li * 32768, (unsigned*)(wsb_ + WS_CTL) + CW_TMO, __builtin_amdgcn_readfirstlane(*o.m.nblk), G_, BIDX()); S.mode = 0; \
      gemm_phase<pg8::EpiMoeFused, pg8::MoeFusedOrder, true, true>(ll, Gemm{D, D, D}, S, pg8::EpiMoeFused{o.act, I.m_b1 + (size_t)li * 32 * 2048, o.Ys, I.m_b2 + (size_t)li * 32 * D, o.m.slot_gate}); PH_END \
    GRID_BAR();
#else
#define MOE_GEMM_PHASES(li) \
    PH_BEGIN pg8::MoeOrderG S; S.init(o.xs, D, o.W1_t + (size_t)li * 32 * 2048 * D, D, (size_t)2048 * D * 2, __builtin_amdgcn_readfirstlane(*o.m.nblk), 8, 128, o.m.blk_e, G_, BIDX()); S.rowmap = o.m.slot_tok; \
      gemm_phase<pg8::EpiSwiglu, pg8::MoeOrderG, true, true>(ll, Gemm{D, D, D}, S, pg8::EpiSwiglu{o.act, D, I.m_b1 + (size_t)li * 32 * 2048}); PH_END \
    GRID_BAR(); \
    PH_BEGIN MoeOrder S; S.init(o.act, D, o.W2_t + (size_t)li * 32 * D * D, D, (size_t)D * D * 2, __builtin_amdgcn_readfirstlane(*o.m.nblk), 4, 256, o.m.blk_e, G_, BIDX()); \
      gemm_phase<pg8::EpiMoe2, MoeOrder, true, true>(ll, Gemm{D, D, D}, S, pg8::EpiMoe2{o.Ys, D, I.m_b2 + (size_t)li * 32 * D, o.m.slot_gate}); PH_END \
    GRID_BAR();
#endif
#ifdef LNR_MODE
#define LNR_EXTRA(li) PH_BEGIN if (li == 0) ph_ln_router<false, LNR_MODE>(I.x, o.hbf, I.ln1_g + li * D, I.ln1_b + li * D, I.m_w_router + (size_t)li * D * 32, I.m_b_router + li * 32, o.xs, o.m, fl); else ph_ln_router<true, LNR_MODE>(o.xb, o.hbf, I.ln1_g + li * D, I.ln1_b + li * D, I.m_w_router + (size_t)li * D * 32, I.m_b_router + li * 32, o.xs, o.m, fl); PH_END GRID_BAR();
#else
#define LNR_EXTRA(li)
#endif
#define LAYER_BODY(li) \
    if (li == 1) { \
      PH_BEGIN StaticOrder S; S.init(o.xb, D, o.WB_t, D, NT, 3584, G_, BIDX()); gemm_phase<EpiStore, StaticOrder, true, true>(ll, Gemm{D, D, D}, S, EpiStore{o.projB_b, 3584}); PH_END \
      GRID_BAR(); \
      GLA_PHASES \
      PH_BEGIN StaticOrder S; S.init(o.o2b, D, o.WoutB_t, D, NT, D, G_, BIDX()); gemm_phase<EpiStore, StaticOrder, true, true>(ll, Gemm{D, D, D}, S, EpiStore{o.hbf, D}); PH_END \
      GRID_BAR(); \
    } \
LNR_EXTRA(li) \
    PH_BEGIN if (li == 0) ph_ln_router<false>(I.x, o.hbf, I.ln1_g + li * D, I.ln1_b + li * D, I.m_w_router + (size_t)li * D * 32, I.m_b_router + li * 32, o.xs, o.m, fl); else ph_ln_router<true>(o.xb, o.hbf, I.ln1_g + li * D, I.ln1_b + li * D, I.m_w_router + (size_t)li * D * 32, I.m_b_router + li * 32, o.xs, o.m, fl); PH_END \
    GRID_BAR(); \
    PH_BEGIN ph_moe_scatter(o.m, (int*)lds); PH_END \
    GRID_BAR(); \
MOE_GEMM_PHASES(li) \
    PH_BEGIN ph_combine_ln(o.xs, o.Ys, o.m.slot_of, I.ln2_g + li * D, I.ln2_b + li * D, li == 0 ? nullptr : out_, li == 0 ? o.xb : nullptr); PH_END \
    if (li == 0) GRID_BAR();
__global__ void __launch_bounds__(NTHR, 2) mk_fwd(Args args) {
  extern __shared__ __attribute__((aligned(16))) unsigned char lds[];
  volatile LAS unsigned* MISC = (volatile LAS unsigned*)((LAS unsigned char*)lds + MISC_OFF);
  if (threadIdx.x < 32) MISC[threadIdx.x] = 0u;
  __syncthreads();
  XcdBarrier bar; { const __attribute__((address_space(4))) Args* ka0 = (const __attribute__((address_space(4))) Args*)__builtin_amdgcn_kernarg_segment_ptr(); bar = xcd_barrier_post((unsigned*)(ka0->ws + WS_CTL) + CW_BAR, MISC + 8); }
#define GRID_BAR() xcd_barrier(bar)
#define PH_BEGIN { const __attribute__((address_space(4))) Args* ka_ = (const __attribute__((address_space(4))) Args*)__builtin_amdgcn_kernarg_segment_ptr(); asm volatile("" : "+s"(ka_)); \
    float* const out_ = ka_->out; (void)out_; unsigned char* wsb_ = ka_->ws; const nvp::Ws w = carve_ws(wsb_); (void)w; const Opt o = carve_opt(wsb_); (void)o; \
    const int gtid_ = BIDX() * NTHR + TIDX(), NGT_ = (int)gridDim.x * NTHR; (void)gtid_; (void)NGT_; const int G_ = (int)gridDim.x; (void)G_;
#define PH_END }
#define I (ka_->in)
  float* fl = (float*)lds; LAS unsigned char* ll = (LAS unsigned char*)lds;
  using pg8::gemm_phase; using pg8::StaticOrder; using pg8::MoeOrder; using pg8::Gemm; using pg8::EpiStore;
  PH_BEGIN ph_prologue(ProIn{I.a_w_uk, I.a_w_uv, I.x, I.a_w_in, I.a_w_out, I.b_w_in, I.b_w_g2, I.b_w_out, I.m_w1, I.m_w2}, o); PH_END
  GRID_BAR();
  PH_BEGIN StaticOrder S; S.init(o.xb, D, o.WA_t, D, NT, 2048, G_, BIDX()); gemm_phase<EpiStore, StaticOrder, true, true>(ll, Gemm{D, D, D}, S, EpiStore{o.projA_b, 2048}); PH_END
  GRID_BAR();
  PH_BEGIN ph_cnorm_b(o.projA_b, I.a_kv_norm, o.cnb); PH_END
  PH_BEGIN pg8::GroupAOrder S; S.init(o.projA_b, 2048, o.Wql_t, 256, NT, 4096, 4, 512, G_, BIDX()); gemm_phase<EpiStore, pg8::GroupAOrder, true, true>(ll, Gemm{2048, 256, 256}, S, EpiStore{o.qlat, 4096}); PH_END
  PH_BEGIN ph_iscore(o.projA_b, o.sc, I.m_w1, I.m_w2, o.W1_t, o.W2_t); PH_END
  GRID_BAR();
  PH_BEGIN ph_select_attend(o.sc, o.qlat, o.cnb, o.olat, ll, I.m_w1, I.m_w2, o.W1_t, o.W2_t, o.act); PH_END
  GRID_BAR();
  PH_BEGIN pg8::GroupAOrder S; S.init(o.olat, 4096, o.Wuv_t, 1024, NT, 1024, 1, 2048, G_, BIDX()); gemm_phase<EpiStore, pg8::GroupAOrder, true, true>(ll, Gemm{4096, 1024, 1024}, S, EpiStore{o.o2b, D}); PH_END
  GRID_BAR();
#if PROBE == 2
  PH_BEGIN cvt_bf16_to_f32(o.projA_b, 2048, w.projA, DINA, NT, DINA, gtid_, NGT_); PH_END
  GRID_BAR();
  PH_BEGIN nvp::np_cnorm(w.projA, I.a_kv_norm, w.cn); PH_END
  PH_BEGIN nvp::np_iscore(w.projA, w.sc, fl); PH_END
  GRID_BAR();
  PH_BEGIN nvp::np_topk(w.sc, w.idx, (char*)lds); PH_END
  GRID_BAR();
  PH_BEGIN nvp::np_dsa_attn(w.projA, w.cn, w.idx, I.a_w_uk, I.a_w_uv, w.o2, fl); PH_END
  GRID_BAR();
  PH_BEGIN { float* pd = (float*)(wsb_ + 1968 * MiB); for (size_t i = gtid_; i < (size_t)NT * D; i += NGT_) pd[i] = bf2f(o.o2b[i]) - w.o2[i]; } PH_END
  GRID_BAR();
#endif
  PH_BEGIN StaticOrder S; S.init(o.o2b, D, o.WoutA_t, D, NT, D, G_, BIDX()); gemm_phase<EpiStore, StaticOrder, true, true>(ll, Gemm{D, D, D}, S, EpiStore{o.hbf, D}); PH_END
  GRID_BAR();
  { LAYER_BODY(0) }
  { LAYER_BODY(1) }
#if PROBE == 2 || PROBE == 3
  GRID_BAR();
#if PROBE == 3
  PH_BEGIN { if (gtid_ == 0) { const unsigned fb = *(const unsigned*)(wsb_ + 512 * 1024); out_[5] += (float)fb; } const float* pd = (const float*)(wsb_ + 1968 * MiB); for (size_t i = gtid_; i < (size_t)NT * D; i += NGT_) out_[i] += PROBE_S * pd[i]; } PH_END
#else
  PH_BEGIN { const float* pd = (const float*)(wsb_ + 1968 * MiB); for (size_t i = gtid_; i < (size_t)NT * D; i += NGT_) out_[i] += PROBE_S * pd[i]; } PH_END
#endif
#endif
}

extern "C" void kernel_launch(void* const* d_in, const int* in_sizes, int n_in, void* d_out, int out_size, void* d_ws, size_t ws_size, hipStream_t stream) {
  static int grid = 0;
  if (grid == 0) {
    if (n_in != 21 || ws_size < WS_NEEDED) { fprintf(stderr, "kernel_launch: bad inputs (n_in %d) or workspace too small (%zu needed, %zu given)\n", n_in, (size_t)WS_NEEDED, ws_size); grid = -1; return; }
    int dev = 0, cus = 0, per_cu = 0;
    if (hipGetDevice(&dev) != hipSuccess || hipDeviceGetAttribute(&cus, hipDeviceAttributeMultiprocessorCount, dev) != hipSuccess) { grid = -1; return; }
    if (hipFuncSetAttribute((const void*)mk_fwd, hipFuncAttributeMaxDynamicSharedMemorySize, LDS_BYTES) != hipSuccess) { fprintf(stderr, "kernel_launch: hipFuncSetAttribute failed\n"); grid = -1; return; }
    if (hipOccupancyMaxActiveBlocksPerMultiprocessor(&per_cu, (const void*)mk_fwd, NTHR, LDS_BYTES) != hipSuccess || per_cu < 1) fprintf(stderr, "kernel_launch: note: occupancy query reports %d\n", per_cu);
    (void)hipGetLastError();
    grid = cus;
    if (grid != 256) fprintf(stderr, "kernel_launch: built for 256 CUs (token ownership per workgroup); got %d\n", grid);
  }
  if (grid < 0) return;
  if (hipMemsetAsync((char*)d_ws + WS_CTL, 0, CTL_ZERO_BYTES, stream) != hipSuccess) { fprintf(stderr, "kernel_launch: memset failed\n"); return; }
  Args a; memset(&a, 0, sizeof(a));
  const float** f = (const float**)&a.in;
  for (int i = 0; i < 21; ++i) f[i] = (const float*)d_in[i];
  a.out = (float*)d_out; a.ws = (unsigned char*)d_ws;
  hipLaunchKernelGGL(mk_fwd, dim3(grid), dim3(NTHR), LDS_BYTES, stream, a);
  const hipError_t le = hipPeekAtLastError();
  if (le != hipSuccess) fprintf(stderr, "kernel_launch: launch failed: %s\n", hipGetErrorName(le));
}
```

```cpp
#include <hip/hip_runtime.h>
#include <cstdio>
#include <cstdint>
#include <cstring>

#define GAS __attribute__((address_space(1)))
#define LAS __attribute__((address_space(3)))
#define NTHR 512
constexpr int LDS_BYTES = 147456;
constexpr int MISC_OFF = 131072 + 8192;

#define XB_TMO      128
#define XB_XCNT(j)  (256  + 64 * (j))
#define XB_XSUB(j)  (1280 + 64 * (j))
#define XB_XGEN(j)  (2304 + 64 * (j))
#define XB_TOP      3328
#define XB_TOPGEN   3392
#define XCD_BAR_WORDS 3456
#define XB_SPIN_CAP (1u << 25)
__device__ __forceinline__ unsigned xb_ld(unsigned* p)              { return __hip_atomic_load(p, __ATOMIC_RELAXED, __HIP_MEMORY_SCOPE_AGENT); }
__device__ __forceinline__ unsigned xb_add(unsigned* p, unsigned v) { return __hip_atomic_fetch_add(p, v, __ATOMIC_RELAXED, __HIP_MEMORY_SCOPE_AGENT); }
__device__ __forceinline__ unsigned xb_xcc_id() { return (unsigned)__builtin_amdgcn_s_getreg((3 << 11) | 20) & 0xFu; }
#define XB_SPIN(cond, bar) do { unsigned _sp = 0; while (cond) { __builtin_amdgcn_s_sleep(1); \
    if ((++_sp & 255u) == 0u) { if (xb_ld(&(bar)[XB_TMO])) break; if (_sp > XB_SPIN_CAP) { atomicAdd(&(bar)[XB_TMO], 1u); break; } } } } while (0)
struct XcdBarrier { unsigned* bar; unsigned x; volatile LAS unsigned* st; };
__device__ __forceinline__ XcdBarrier xcd_barrier_post(unsigned* bar, volatile LAS unsigned* st) {
    XcdBarrier b; b.bar = bar; b.x = xb_xcc_id(); b.st = st;
    if (threadIdx.x == 0) (void)xb_add(&bar[XB_XCNT(b.x)], 1u);
    return b;
}
__device__ __forceinline__ void xcd_barrier_complete(unsigned* bar, unsigned x, unsigned& nloc, unsigned& nx) {
    const unsigned G = gridDim.x * gridDim.y * gridDim.z;
    unsigned sum, cnt, mine, sp = 0u;
    for (;;) {
        sum = 0u; cnt = 0u; mine = 0u;
#pragma unroll
        for (unsigned j = 0; j < 16; ++j) { const unsigned c = xb_ld(&bar[XB_XCNT(j)]); sum += c; cnt += (c > 0u) ? 1u : 0u; mine = (j == x) ? c : mine; }
        if (sum == G) break;
        __builtin_amdgcn_s_sleep(1);
        if ((++sp & 255u) == 0u) { if (xb_ld(&bar[XB_TMO])) break; if (sp > XB_SPIN_CAP) { atomicAdd(&bar[XB_TMO], 1u); break; } }
    }
    nloc = mine > 0u ? mine : 1u; nx = cnt > 0u ? cnt : 1u;
}
__device__ __forceinline__ void xcd_barrier(const XcdBarrier& b) {
    asm volatile("s_waitcnt vmcnt(0)" ::: "memory");
    __syncthreads();
    if (threadIdx.x == 0) {
        unsigned* bar = b.bar;
        __builtin_amdgcn_s_waitcnt(0);
        unsigned nloc = b.st[0], nx = b.st[1];
        if (nloc == 0u) { xcd_barrier_complete(bar, b.x, nloc, nx); b.st[0] = nloc; b.st[1] = nx; }
        const unsigned old = xb_add(&bar[XB_XSUB(b.x)], 1u);
        const unsigned gen = old / nloc;
        if (old + 1u == (gen + 1u) * nloc) {
            __builtin_amdgcn_fence(__ATOMIC_RELEASE, "agent");
            asm volatile("s_waitcnt vmcnt(0)" ::: "memory");
            const unsigned og = xb_add(&bar[XB_TOP], 1u);
            const unsigned tg = og / nx;
            if (og + 1u == (tg + 1u) * nx) xb_add(&bar[XB_TOPGEN], 1u);
            else XB_SPIN(xb_ld(&bar[XB_TOPGEN]) == tg, bar);
            __builtin_amdgcn_fence(__ATOMIC_ACQUIRE, "agent");
            xb_add(&bar[XB_XGEN(b.x)], 1u);
            asm volatile("s_waitcnt vmcnt(0)" ::: "memory");
        } else {
            XB_SPIN(xb_ld(&bar[XB_XGEN(b.x)]) == gen, bar);
            __builtin_amdgcn_fence(__ATOMIC_ACQUIRE, "agent");
            asm volatile("s_waitcnt vmcnt(0)" ::: "memory");
        }
    }
    __syncthreads();
}

constexpr int NT = 16384, D = 1024, L = 8192, NB = 2;
constexpr int DINA = 1864, DINB = 3088;
constexpr int PMAX = 73728;
constexpr float ALPHA = 1.4142135623730951f;

struct In { const float *x, *a_w_in, *a_kv_norm, *a_w_uk, *a_w_uv, *a_w_out, *b_w_in, *b_w_g2, *b_g_bias, *b_norm, *b_w_out, *m_w_router, *m_b_router, *m_w1, *m_b1, *m_w2, *m_b2, *ln1_g, *ln1_b, *ln2_g, *ln2_b; };

__device__ __forceinline__ int TIDX() { int t = threadIdx.x; asm volatile("" : "+v"(t)); return t; }
__device__ __forceinline__ int BIDX() { int t = blockIdx.x; asm volatile("" : "+s"(t)); return t; }
__device__ __forceinline__ float wave_sum(float v) {
#pragma unroll
    for (int o = 1; o < 64; o <<= 1) v += __shfl_xor(v, o);
    return v;
}
namespace nvp {
#define WSYNC() asm volatile("s_waitcnt lgkmcnt(0)" ::: "memory")
struct GemmP {
  const float* A; int lda; const int* arow;
  const float* B; int ldb; float* C; int ldc; int M, N, K;
  const int* blk_e; const int* nblk_used; size_t bstride; const float* bias; size_t bias_stride;
};
__device__ __forceinline__ GemmP mkg(const float* A, int lda, const int* arow, const float* B, int ldb, float* C, int ldc, int M, int N, int K, const int* blk_e, const int* nblk_used, size_t bstride, const float* bias, size_t bias_stride) {
  GemmP p; p.A = A; p.lda = lda; p.arow = arow; p.B = B; p.ldb = ldb; p.C = C; p.ldc = ldc; p.M = M; p.N = N; p.K = K; p.blk_e = blk_e; p.nblk_used = nblk_used; p.bstride = bstride; p.bias = bias; p.bias_stride = bias_stride; return p; }

template <int MODE>
__device__ __forceinline__ void np_sgemm(const GemmP p, float* lds) {
  float (*As)[132] = (float (*)[132])lds;
  float (*Bs)[68] = (float (*)[68])(lds + 16 * 132);
  float (*Bu)[68] = (float (*)[68])(lds + 16 * 132 + 16 * 68);
  const int tid = TIDX(), tx = tid & 15, ty = tid >> 4;
  const int ntn = (p.N + 63) / 64, ntm = p.M / 128;
  const int ar = tid >> 2, ak = (tid & 3) * 4;
  const int bk = (tid & 255) >> 4, bn4 = (tid & 15) * 4;
  for (int t = BIDX(); t < ntm * ntn; t += gridDim.x) {
    const int bm = t / ntn, bn = t % ntn;
    const float* B = p.B; const float* bias = p.bias;
    if (MODE != 0) { const int blk = (bm * 128) / 256; if (blk >= *p.nblk_used) continue; const int e = p.blk_e[blk]; B += (size_t)e * p.bstride; bias += (size_t)e * p.bias_stride; }
    const int m0 = bm * 128, n0 = bn * 64;
    const int arow = p.arow ? p.arow[m0 + ar] : (m0 + ar);
    const float* Ap = p.A + (size_t)arow * p.lda + ak;
    const bool bok = (n0 + bn4) < p.N;
    float acc[4][4] = {}, accu[4][4] = {};
    for (int k0 = 0; k0 < p.K; k0 += 16) {
      const float4 av = *(const float4*)(Ap + k0);
      As[ak + 0][ar] = av.x; As[ak + 1][ar] = av.y; As[ak + 2][ar] = av.z; As[ak + 3][ar] = av.w;
      if (tid < 256) { float4 bv = make_float4(0.f, 0.f, 0.f, 0.f); if (bok) bv = *(const float4*)(B + (size_t)(k0 + bk) * p.ldb + n0 + bn4); *(float4*)&Bs[bk][bn4] = bv; }
      else if (MODE == 1) { const float4 uv = *(const float4*)(B + (size_t)(k0 + bk) * p.ldb + 1024 + n0 + bn4); *(float4*)&Bu[bk][bn4] = uv; }
      __syncthreads();
#pragma unroll
      for (int kk = 0; kk < 16; ++kk) {
        const float4 a = *(const float4*)&As[kk][ty * 4];
        const float4 b = *(const float4*)&Bs[kk][tx * 4];
        const float aa[4] = {a.x, a.y, a.z, a.w}, bb[4] = {b.x, b.y, b.z, b.w};
#pragma unroll
        for (int i = 0; i < 4; ++i)
#pragma unroll
          for (int j = 0; j < 4; ++j) acc[i][j] = fmaf(aa[i], bb[j], acc[i][j]);
        if (MODE == 1) {
          const float4 u = *(const float4*)&Bu[kk][tx * 4]; const float uu[4] = {u.x, u.y, u.z, u.w};
#pragma unroll
          for (int i = 0; i < 4; ++i)
#pragma unroll
            for (int j = 0; j < 4; ++j) accu[i][j] = fmaf(aa[i], uu[j], accu[i][j]);
        }
      }
      __syncthreads();
    }
#pragma unroll
    for (int i = 0; i < 4; ++i) {
      const int m = m0 + ty * 4 + i;
#pragma unroll
      for (int j = 0; j < 4; ++j) {
        const int n = n0 + tx * 4 + j; if (n >= p.N) continue;
        float v = acc[i][j];
        if (MODE == 1) {
          float g = v + bias[n], u = accu[i][j] + bias[1024 + n];
          g = fminf(g, 7.f); u = fminf(fmaxf(u, -7.f), 7.f);
          const float glu = g / (1.f + expf(-1.702f * g));
          v = (u + 1.f) * glu;
        } else if (MODE == 2) v += bias[n];
        p.C[(size_t)m * p.ldc + n] = v;
      }
    }
  }
}

#define GW_INIT const int lane = TIDX() & 63, wave = TIDX() >> 6, gw = BIDX() * 8 + wave, NGW = gridDim.x * 8; (void)lane; (void)wave; (void)gw; (void)NGW

__device__ __forceinline__ void np_cnorm(const float* projA, const float* g, float* cn) {
  GW_INIT;
  for (int row = gw; row < NT; row += NGW) {
    const float4 v = *(const float4*)(projA + (size_t)row * DINA + 1024 + lane * 4);
    const float ss = wave_sum(v.x * v.x + v.y * v.y + v.z * v.z + v.w * v.w);
    const float r = rsqrtf(ss * (1.f / 256.f) + 1e-6f); const float4 g4 = *(const float4*)(g + lane * 4);
    *(float4*)(cn + (size_t)row * 256 + lane * 4) = make_float4(v.x * r * g4.x, v.y * r * g4.y, v.z * r * g4.z, v.w * r * g4.w);
  }
}

__device__ __forceinline__ void np_iscore(const float* projA, float* sc, float* lds) {
  float (*As)[132] = (float (*)[132])lds;
  float (*Bs)[68] = (float (*)[68])(lds + 16 * 132);
  const int tid = TIDX(), tx = tid & 15, ty = tid >> 4;
  const int ar = tid >> 2, ak = (tid & 3) * 4;
  const int br = (tid & 255) >> 2;
  for (int u = BIDX(); u < NB * 64 * 128; u += gridDim.x) {
    const int b = u / (64 * 128), tt = (u / 128) % 64, st = u % 128;
    if (st > 2 * tt + 1) continue;
    const int t0 = tt * 128, s0 = st * 64;
    const float* Qp = projA + (size_t)(b * L + t0 + ar) * DINA + 1280 + ak;
    const float* Kp = projA + (size_t)(b * L + s0 + br) * DINA + 1792 + ak;
    float score[4][4] = {};
    for (int h = 0; h < 8; ++h) {
      float acc[4][4] = {};
      for (int k0 = 0; k0 < 64; k0 += 16) {
        const float4 av = *(const float4*)(Qp + h * 64 + k0);
        As[ak + 0][ar] = av.x; As[ak + 1][ar] = av.y; As[ak + 2][ar] = av.z; As[ak + 3][ar] = av.w;
        if (tid < 256) { const float4 bv = *(const float4*)(Kp + k0); Bs[ak + 0][br] = bv.x; Bs[ak + 1][br] = bv.y; Bs[ak + 2][br] = bv.z; Bs[ak + 3][br] = bv.w; }
        __syncthreads();
#pragma unroll
        for (int kk = 0; kk < 16; ++kk) {
          const float4 a = *(const float4*)&As[kk][ty * 4]; const float4 bq = *(const float4*)&Bs[kk][tx * 4];
          const float aa[4] = {a.x, a.y, a.z, a.w}, bb[4] = {bq.x, bq.y, bq.z, bq.w};
#pragma unroll
          for (int i = 0; i < 4; ++i)
#pragma unroll
            for (int j = 0; j < 4; ++j) acc[i][j] = fmaf(aa[i], bb[j], acc[i][j]);
        }
        __syncthreads();
      }
#pragma unroll
      for (int i = 0; i < 4; ++i) {
        const float w = projA[(size_t)(b * L + t0 + ty * 4 + i) * DINA + 1856 + h] * 0.35355339059327373f;
#pragma unroll
        for (int j = 0; j < 4; ++j) score[i][j] += w * fmaxf(acc[i][j] * 0.125f, 0.f);
      }
    }
#pragma unroll
    for (int i = 0; i < 4; ++i)
#pragma unroll
      for (int j = 0; j < 4; ++j) sc[((size_t)(b * L + t0 + ty * 4 + i)) * L + s0 + tx * 4 + j] = score[i][j];
  }
}

__device__ __forceinline__ unsigned f2key(float f) { f = f + 0.0f; const unsigned u = __float_as_uint(f); return (u & 0x80000000u) ? ~u : (u | 0x80000000u); }

__device__ __forceinline__ void np_topk(const float* sc, int* idx_out, char* lds) {
  GW_INIT;
  unsigned* hist = (unsigned*)(lds + wave * 1280); unsigned* cntw = hist + 256;
  for (int row = gw; row < NT; row += NGW) {
    const int t = row % L, n = t + 1;
    const float* s = sc + (size_t)row * L; int* out = idx_out + (size_t)row * 256;
    if (n <= 256) { for (int i = lane; i < 256; i += 64) out[i] = i < n ? i : -1; continue; }
    unsigned prefix = 0, need = 256;
    for (int pass = 3; pass >= 0; --pass) {
      const int shift = pass * 8;
      for (int i = lane; i < 256; i += 64) hist[i] = 0;
      WSYNC();
      for (int i = lane; i < n; i += 64) { const unsigned k = f2key(s[i]); const bool m = (pass == 3) || ((k >> (shift + 8)) == (prefix >> (shift + 8))); if (m) atomicAdd(&hist[(k >> shift) & 255u], 1u); }
      WSYNC();
      unsigned cum = 0; int d = 255; for (; d > 0; --d) { const unsigned hv = hist[d]; if (cum + hv >= need) break; cum += hv; }
      prefix |= ((unsigned)d << shift); need -= cum;
      WSYNC();
    }
    if (lane == 0) *cntw = 0; WSYNC();
    for (int i = lane; i < n; i += 64) { if (f2key(s[i]) > prefix) { const unsigned pos = atomicAdd(cntw, 1u); out[pos] = i; } }
    WSYNC();
    if (lane == 0) { unsigned c = *cntw; unsigned nd = need; for (int i = 0; i < n && nd > 0; ++i) if (f2key(s[i]) == prefix) { out[c++] = i; --nd; } }
    WSYNC();
  }
}

__device__ __forceinline__ void np_dsa_attn(const float* projA, const float* cn, const int* idx, const float* w_uk, const float* w_uv, float* o2, float* lds) {
  const int half = TIDX() >> 8, tid = TIDX() & 255;
  float* base = lds + half * 14336;
  float* qs = base; float (*ql)[256] = (float (*)[256])(base + 1024); float (*pr)[257] = (float (*)[257])(base + 1024 + 4096);
  float (*ol)[256] = (float (*)[256])(base + 1024 + 4096 + 4112); float* red = base + 1024 + 4096 + 4112 + 4096; int* sid = (int*)(red + 16);
  for (int r0 = BIDX() * 2; r0 < NT; r0 += gridDim.x * 2) {
    const int row = r0 + half, b = row / L;
    __syncthreads();
    for (int i = tid; i < 1024; i += 256) qs[i] = projA[(size_t)row * DINA + i];
    sid[tid] = idx[(size_t)row * 256 + tid];
    __syncthreads();
    { const int c = tid;
#pragma unroll 1
      for (int h = 0; h < 16; ++h) { float a = 0.f;
#pragma unroll 8
        for (int d = 0; d < 64; ++d) a = fmaf(qs[h * 64 + d], w_uk[((size_t)h * 64 + d) * 256 + c], a); ql[h][c] = a; } }
    __syncthreads();
    { const int k = tid, key = sid[k];
      float lg[16];
      if (key >= 0) { const float* cr = cn + (size_t)(b * L + key) * 256;
        for (int h = 0; h < 16; ++h) lg[h] = 0.f;
#pragma unroll 2
        for (int c = 0; c < 256; ++c) { const float cv = cr[c];
#pragma unroll
          for (int h = 0; h < 16; ++h) lg[h] = fmaf(ql[h][c], cv, lg[h]); }
#pragma unroll
        for (int h = 0; h < 16; ++h) pr[h][k] = lg[h] * 0.125f;
      } else {
#pragma unroll
        for (int h = 0; h < 16; ++h) pr[h][k] = -INFINITY; } }
    __syncthreads();
    if (tid < 16) { const int h = tid; float m = -INFINITY; for (int k = 0; k < 256; ++k) m = fmaxf(m, pr[h][k]); float su = 0.f; for (int k = 0; k < 256; ++k) { const float e = expf(pr[h][k] - m); pr[h][k] = e; su += e; } red[h] = 1.f / su; }
    __syncthreads();
    { const int c = tid; float a[16];
#pragma unroll
      for (int h = 0; h < 16; ++h) a[h] = 0.f;
#pragma unroll 2
      for (int k = 0; k < 256; ++k) { const int key = sid[k]; if (key < 0) continue; const float cv = cn[(size_t)(b * L + key) * 256 + c];
#pragma unroll
        for (int h = 0; h < 16; ++h) a[h] = fmaf(pr[h][k], cv, a[h]); }
#pragma unroll
      for (int h = 0; h < 16; ++h) ol[h][c] = a[h] * red[h]; }
    __syncthreads();
#pragma unroll 1
    for (int o = tid; o < 1024; o += 256) { const int h = o >> 6, v = o & 63; float a = 0.f;
#pragma unroll 8
      for (int c = 0; c < 256; ++c) a = fmaf(ol[h][c], w_uv[((size_t)h * 256 + c) * 64 + v], a); o2[(size_t)row * 1024 + o] = a; }
  }
  __syncthreads();
}

__device__ __forceinline__ void np_ln_res(const float* x, const float* h, const float* g, const float* bb, float* out) {
  GW_INIT;
  for (int row = gw; row < NT; row += NGW) {
    float4 v[4]; float s = 0.f;
#pragma unroll
    for (int j = 0; j < 4; ++j) { const float4 a = *(const float4*)(x + (size_t)row * D + lane * 4 + 256 * j), hh = *(const float4*)(h + (size_t)row * D + lane * 4 + 256 * j);
      v[j] = make_float4(ALPHA * a.x + hh.x, ALPHA * a.y + hh.y, ALPHA * a.z + hh.z, ALPHA * a.w + hh.w); s += (v[j].x + v[j].y) + (v[j].z + v[j].w); }
    const float mu = wave_sum(s) * (1.f / D); float q = 0.f;
#pragma unroll
    for (int j = 0; j < 4; ++j) { v[j].x -= mu; v[j].y -= mu; v[j].z -= mu; v[j].w -= mu; q += (v[j].x * v[j].x + v[j].y * v[j].y) + (v[j].z * v[j].z + v[j].w * v[j].w); }
    const float r = rsqrtf(wave_sum(q) * (1.f / D) + 1e-5f);
#pragma unroll
    for (int j = 0; j < 4; ++j) { const int c = lane * 4 + 256 * j; const float4 g4 = *(const float4*)(g + c), b4 = *(const float4*)(bb + c);
      *(float4*)(out + (size_t)row * D + c) = make_float4(v[j].x * r * g4.x + b4.x, v[j].y * r * g4.y + b4.y, v[j].z * r * g4.z + b4.z, v[j].w * r * g4.w + b4.w); }
  }
}

__device__ __forceinline__ void np_router(const float* x, const float* wr, const float* br, int* tok_e, float* tok_g, int* counts, int* row_tok, char* lds) {
  GW_INIT;
  for (int i = BIDX() * NTHR + TIDX(); i < PMAX; i += gridDim.x * NTHR) row_tok[i] = 0;
  float* lg = (float*)(lds + wave * 256);
  const int e = lane & 31, hf = lane >> 5;
  for (int tok = gw; tok < NT; tok += NGW) {
    const float* xr = x + (size_t)tok * D + hf * 512; const float* wp = wr + (size_t)hf * 512 * 32 + e; float a = 0.f;
#pragma unroll 8
    for (int d = 0; d < 512; ++d) a = fmaf(xr[d], wp[d * 32], a);
    a += __shfl_xor(a, 32);
    if (hf == 0) lg[e] = a + br[e];
    WSYNC();
    if (lane == 0) { int ei[4]; float ev[4];
      for (int k = 0; k < 4; ++k) { int bi = 0; float bv = -INFINITY; for (int j = 0; j < 32; ++j) if (lg[j] > bv) { bv = lg[j]; bi = j; } ei[k] = bi; ev[k] = bv; lg[bi] = -INFINITY; }
      float su = 0.f, ex[4]; for (int k = 0; k < 4; ++k) { ex[k] = expf(ev[k] - ev[0]); su += ex[k]; }
      for (int k = 0; k < 4; ++k) { tok_e[tok * 4 + k] = ei[k]; tok_g[tok * 4 + k] = ex[k] / su; atomicAdd(&counts[ei[k]], 1); } }
    WSYNC();
  }
}
__device__ __forceinline__ void np_moe_sort(const int* tok_e, const float* tok_g, const int* counts, int* row_tok, float* row_gate, int* slot_of, int* blk_e, int* nblk_used, char* lds) {
  if (BIDX() != 0) return;
  const int e = TIDX(); int* pstart = (int*)lds; int* stage = pstart + 64;
  if (e == 0) { int acc = 0; for (int j = 0; j < 32; ++j) { pstart[j] = acc; const int nb = (counts[j] + 255) / 256; for (int q = 0; q < nb; ++q) blk_e[acc / 256 + q] = j; acc += nb * 256; } pstart[32] = acc; *nblk_used = acc / 256; }
  __syncthreads();
  int pos = e < 32 ? pstart[e] : 0;
  for (int c0 = 0; c0 < NT * 4; c0 += 2048) {
    __syncthreads();
    for (int i = e; i < 2048; i += NTHR) stage[i] = tok_e[c0 + i];
    __syncthreads();
    if (e < 32) for (int i = 0; i < 2048; ++i) if (stage[i] == e) { const int gi = c0 + i; row_tok[pos] = gi >> 2; row_gate[pos] = tok_g[gi]; slot_of[gi] = pos; ++pos; }
  }
  __syncthreads();
}
__device__ __forceinline__ void np_moe_combine_ln(const float* x1, const float* ys, const int* slot_of, const float* tok_g, const float* g, const float* bb, float* out) {
  GW_INIT;
  for (int row = gw; row < NT; row += NGW) {
    float4 v[4]; float s = 0.f; int sl[4]; float gg[4];
#pragma unroll
    for (int k = 0; k < 4; ++k) { sl[k] = slot_of[row * 4 + k]; gg[k] = tok_g[row * 4 + k]; }
#pragma unroll
    for (int j = 0; j < 4; ++j) { const int c = lane * 4 + 256 * j; float4 f = make_float4(0.f, 0.f, 0.f, 0.f);
#pragma unroll
      for (int k = 0; k < 4; ++k) { const float4 y = *(const float4*)(ys + (size_t)sl[k] * D + c); f.x += gg[k] * y.x; f.y += gg[k] * y.y; f.z += gg[k] * y.z; f.w += gg[k] * y.w; }
      const float4 a = *(const float4*)(x1 + (size_t)row * D + c);
      v[j] = make_float4(ALPHA * a.x + f.x, ALPHA * a.y + f.y, ALPHA * a.z + f.z, ALPHA * a.w + f.w); s += (v[j].x + v[j].y) + (v[j].z + v[j].w); }
    const float mu = wave_sum(s) * (1.f / D); float q = 0.f;
#pragma unroll
    for (int j = 0; j < 4; ++j) { v[j].x -= mu; v[j].y -= mu; v[j].z -= mu; v[j].w -= mu; q += (v[j].x * v[j].x + v[j].y * v[j].y) + (v[j].z * v[j].z + v[j].w * v[j].w); }
    const float r = rsqrtf(wave_sum(q) * (1.f / D) + 1e-5f);
#pragma unroll
    for (int j = 0; j < 4; ++j) { const int c = lane * 4 + 256 * j; const float4 g4 = *(const float4*)(g + c), b4 = *(const float4*)(bb + c);
      *(float4*)(out + (size_t)row * D + c) = make_float4(v[j].x * r * g4.x + b4.x, v[j].y * r * g4.y + b4.y, v[j].z * r * g4.z + b4.z, v[j].w * r * g4.w + b4.w); }
  }
}

__device__ __forceinline__ void np_gla_gate(const float* projB, const float* w_g2, const float* gb, float* adec) {
  GW_INIT;
  for (int row = gw; row < NT; row += NGW) {
    float glr[16];
#pragma unroll
    for (int j = 0; j < 16; ++j) glr[j] = projB[(size_t)row * DINB + 2048 + j];
    for (int c = lane; c < 512; c += 64) { float a = gb[c];
#pragma unroll
      for (int j = 0; j < 16; ++j) a = fmaf(glr[j], w_g2[j * 512 + c], a);
      const float ls = fminf(a, 0.f) - log1pf(expf(-fabsf(a))); adec[(size_t)row * 512 + c] = expf(ls * (1.f / 16.f)); }
  }
}
__device__ __forceinline__ void np_gla_scan(const float* projB, const float* adec, float* og, float* lds) {
  if (BIDX() >= 8) return;
  const int b = BIDX() >> 2, h = BIDX() & 3, tid = TIDX(), dv = tid & 255, dh = tid >> 8;
  float (*qs)[128] = (float (*)[128])lds; float (*ks)[128] = (float (*)[128])(lds + 2048); float (*as)[128] = (float (*)[128])(lds + 4096);
  float (*po)[16][256] = (float (*)[16][256])(lds + 6144);
  float S[64];
#pragma unroll
  for (int d = 0; d < 64; ++d) S[d] = 0.f;
  for (int t0 = 0; t0 < L; t0 += 16) {
    __syncthreads();
    for (int i = tid; i < 16 * 128; i += NTHR) { const int tt = i >> 7, d = i & 127; const size_t r = (size_t)(b * L + t0 + tt);
      qs[tt][d] = projB[r * DINB + h * 128 + d] * 0.08838834764831845f; ks[tt][d] = projB[r * DINB + 512 + h * 128 + d]; as[tt][d] = adec[r * 512 + h * 128 + d]; }
    __syncthreads();
#pragma unroll 1
    for (int tt = 0; tt < 16; ++tt) { const size_t r = (size_t)(b * L + t0 + tt); const float v = projB[r * DINB + 1024 + h * 256 + dv]; float o = 0.f;
#pragma unroll
      for (int d = 0; d < 64; ++d) { S[d] = fmaf(as[tt][dh * 64 + d], S[d], ks[tt][dh * 64 + d] * v); o = fmaf(qs[tt][dh * 64 + d], S[d], o); }
      po[dh][tt][dv] = o; }
    __syncthreads();
    for (int i = tid; i < 16 * 256; i += NTHR) { const int tt = i >> 8, c = i & 255; og[(size_t)(b * L + t0 + tt) * 1024 + h * 256 + c] = po[0][tt][c] + po[1][tt][c]; }
  }
  __syncthreads();
}
__device__ __forceinline__ void np_gla_norm(const float* og, const float* projB, const float* ng, float* on) {
  GW_INIT;
  for (int u = gw; u < NT * 4; u += NGW) {
    const int row = u >> 2, h = u & 3; const int c = h * 256 + lane * 4;
    const float4 v = *(const float4*)(og + (size_t)row * 1024 + c);
    const float r = rsqrtf(wave_sum(v.x * v.x + v.y * v.y + v.z * v.z + v.w * v.w) * (1.f / 256.f) + 1e-6f);
    const float4 rr = *(const float4*)(projB + (size_t)row * DINB + 2064 + c), g4 = *(const float4*)(ng + c);
    *(float4*)(on + (size_t)row * 1024 + c) = make_float4(v.x * r * g4.x * (rr.x / (1.f + expf(-rr.x))), v.y * r * g4.y * (rr.y / (1.f + expf(-rr.y))), v.z * r * g4.z * (rr.z / (1.f + expf(-rr.z))), v.w * r * g4.w * (rr.w / (1.f + expf(-rr.w))));
  }
}

struct Ws { float *projA, *cn, *sc, *o2, *h, *x1, *x2, *hb, *ys, *projB, *adec, *og, *on, *tok_g, *row_gate; int *idx, *tok_e, *slot_of, *row_tok, *blk_e, *counts; };
}
typedef unsigned short bf16_t;
typedef unsigned v4u __attribute__((ext_vector_type(4)));
typedef unsigned v2u __attribute__((ext_vector_type(2)));
typedef float f32x4 __attribute__((ext_vector_type(4)));
typedef short bf16x8 __attribute__((ext_vector_type(8)));
typedef float f32x2_t __attribute__((ext_vector_type(2))); typedef __bf16 bf16x2_t __attribute__((ext_vector_type(2)));
__device__ __forceinline__ unsigned cvt_pk_bf16(float lo, float hi) { const f32x2_t v = {lo, hi}; const bf16x2_t b = __builtin_convertvector(v, bf16x2_t); return __builtin_bit_cast(unsigned, b); }
__device__ __forceinline__ float bf_lo(unsigned u) { return __uint_as_float(u << 16); }
__device__ __forceinline__ float bf_hi(unsigned u) { return __uint_as_float(u & 0xffff0000u); }
__device__ __forceinline__ float bf2f(bf16_t h) { return __uint_as_float(((unsigned)h) << 16); }

struct TJob { const float* src; int lds_; int K, N; bf16_t* dst; int ldd; int drow0, dcol0; int rowmap; int ntk, ntn; };
__device__ __forceinline__ TJob mk_tjob(const float* src, int lds_, int K, int N, bf16_t* dst, int ldd, int drow0, int dcol0, int rowmap) {
  TJob j; j.src = src; j.lds_ = lds_; j.K = K; j.N = N; j.dst = dst; j.ldd = ldd; j.drow0 = drow0; j.dcol0 = dcol0; j.rowmap = rowmap; j.ntk = K / 64; j.ntn = (N + 127) / 128; return j; }
__device__ __forceinline__ int tjob_tiles(const TJob& j) { return j.ntk * j.ntn; }
__device__ __forceinline__ void transpose_tile(const TJob& j, int tile, int lane) {
  const int kt = tile / j.ntn, nt_ = tile % j.ntn, k0 = kt * 64, n0 = nt_ * 128;
  const int q = lane & 31, par = lane >> 5;
  const bool ok = (n0 + 4 * q) < j.N;
  f32x4 v[32];
  const float* sp = j.src + (size_t)(k0 + par) * j.lds_ + n0 + 4 * q;
#pragma unroll
  for (int i = 0; i < 32; ++i) v[i] = ok ? *(const f32x4*)(sp + (size_t)(2 * i) * j.lds_) : (f32x4){0.f, 0.f, 0.f, 0.f};
  unsigned ra[32], rb[32];
#pragma unroll
  for (int i = 0; i < 32; ++i) {
    auto s0 = __builtin_amdgcn_permlane32_swap(__float_as_uint(v[i][0]), __float_as_uint(v[i][2]), false, false);
    auto s1 = __builtin_amdgcn_permlane32_swap(__float_as_uint(v[i][1]), __float_as_uint(v[i][3]), false, false);
    ra[i] = cvt_pk_bf16(__uint_as_float(s0[0]), __uint_as_float(s0[1]));
    rb[i] = cvt_pk_bf16(__uint_as_float(s1[0]), __uint_as_float(s1[1]));
  }
  if (ok) {
    const int n = n0 + 4 * q + 2 * par;
    int r0 = n, r1 = n + 1;
    if (j.rowmap == 1) { const int jj0 = r0 & 1023, jj1 = r1 & 1023; r0 = 256 * (jj0 >> 7) + ((r0 >> 10) << 7) + (jj0 & 127); r1 = 256 * (jj1 >> 7) + ((r1 >> 10) << 7) + (jj1 & 127); }
    bf16_t* d0 = j.dst + (size_t)(j.drow0 + r0) * j.ldd + j.dcol0 + k0;
    bf16_t* d1 = j.dst + (size_t)(j.drow0 + r1) * j.ldd + j.dcol0 + k0;
#pragma unroll
    for (int c = 0; c < 8; ++c) { *(v4u*)(d0 + 8 * c) = (v4u){ra[4 * c], ra[4 * c + 1], ra[4 * c + 2], ra[4 * c + 3]}; *(v4u*)(d1 + 8 * c) = (v4u){rb[4 * c], rb[4 * c + 1], rb[4 * c + 2], rb[4 * c + 3]}; }
  }
}
__device__ __forceinline__ void transpose_job(const TJob j, int& w0, int gw, int NGW, int lane) {
  const int nt_ = tjob_tiles(j);
  int first = gw - (w0 % NGW); if (first < 0) first += NGW;
#pragma unroll 1
  for (int t = first; t < nt_; t += NGW) transpose_tile(j, t, lane);
  w0 += nt_;
}
__device__ __forceinline__ void zero_rect(bf16_t* dst, int ldd, int r0, int nr, int cb0, int nbytes, int gtid, int NGT) {
  const int per = nbytes / 16;
  for (int i = gtid; i < nr * per; i += NGT) { const int r = i / per, c = i % per; *(v4u*)((char*)(dst + (size_t)(r0 + r) * ldd) + cb0 + 16 * c) = (v4u){0u, 0u, 0u, 0u}; }
}
__device__ __forceinline__ void cvt_f32_to_bf16(const float* src, int lds_, bf16_t* dst, int ldd, int rows, int ncols, int gtid, int NGT) {
  const int per = ncols / 4;
  for (size_t i = gtid; i < (size_t)rows * per; i += NGT) { const size_t r = i / per; const int c = (int)(i % per) * 4; const f32x4 v = *(const f32x4*)(src + r * lds_ + c);
    *(v2u*)(dst + r * ldd + c) = (v2u){cvt_pk_bf16(v[0], v[1]), cvt_pk_bf16(v[2], v[3])}; }
}
__device__ __forceinline__ void cvt_bf16_to_f32(const bf16_t* src, int lds_, float* dst, int ldd, int rows, int ncols, int gtid, int NGT) {
  const int per = ncols / 4;
  for (size_t i = gtid; i < (size_t)rows * per; i += NGT) { const size_t r = i / per; const int c = (int)(i % per) * 4; const v2u v = *(const v2u*)(src + r * lds_ + c);
    *(f32x4*)(dst + r * ldd + c) = (f32x4){bf_lo(v[0]), bf_hi(v[0]), bf_lo(v[1]), bf_hi(v[1])}; }
}

namespace pg8 {
#define PG8_LAS __attribute__((address_space(3)))
typedef unsigned u32x4 __attribute__((ext_vector_type(4)));
constexpr int BM = 256, BK = 64, HALF = 128, HTB = HALF * BK * 2, STAGE_BYTES = 8 * HTB, NXCD = 8, WGM = 8;
__host__ __device__ __forceinline__ int lds_byte(int r, int c) { const int st = (r >> 4) * 2 + (c >> 5), rr = r & 15, cc = c & 31, ob = rr * 64 + cc * 2; return st * 1024 + (ob ^ (((ob >> 9) & 1) << 5)); }
__host__ __device__ __forceinline__ void stage_rc(int b, int& R, int& C) { const int st = b / 1024, sb = b % 1024, swz = sb ^ (((sb >> 9) & 1) << 5); R = (st >> 1) * 16 + swz / 64; C = (st & 1) * 32 + (swz % 64) / 2; }
__host__ __device__ __forceinline__ int perm32(int rho) { const int n = rho >> 4, i = rho & 15; return 8 * (i >> 2) + 4 * n + (i & 3); }
struct Unit { const char* pa; const char* pb; int orow, ocol, e, kind; };
struct Gemm { int lda, ldb, K; };
struct StaticOrder {
    static constexpr bool GATHER = false; const int* rowmap;
    const char* A; const char* Bt; size_t ta, tb; int nM, nN, nwg, G, c;
    __device__ void init(const void* A_, int lda, const void* Bt_, int ldb, int M, int N, int G_, int c_) { A = (const char*)A_; Bt = (const char*)Bt_; ta = (size_t)BM * lda * 2; tb = (size_t)BM * ldb * 2; nM = M / BM; nN = N / BM; nwg = nM * nN; G = G_; c = c_; }
    __device__ bool tile(int i, int& pm, int& pn) const {
        const long L = (long)i * G + c; if (L >= nwg) return false;
        int wgid = (int)L; { const int q = nwg / NXCD, r = nwg % NXCD, xcd = wgid % NXCD, off = wgid / NXCD; wgid = (xcd < r ? xcd * (q + 1) : r * (q + 1) + (xcd - r) * q) + off; }
        const int nig = WGM * nN, gid = wgid / nig, fm = gid * WGM, gsz = (nM - fm) < WGM ? (nM - fm) : WGM;
        pm = fm + ((wgid % nig) % gsz); pn = (wgid % nig) / gsz; return true;
    }
    __device__ bool next(int i, Unit& u) const { int pm, pn; if (!tile(i, pm, pn)) return false; u.pa = A + (size_t)pm * ta; u.pb = Bt + (size_t)pn * tb; u.orow = pm * BM; u.ocol = pn * BM; u.e = 0; u.kind = 0; return true; }
    __device__ __forceinline__ int rowof(const Unit&, int r) const { return r; }
    __device__ __forceinline__ void a_ready(const Unit&) const {}
    __device__ __forceinline__ void done(const Unit&) const {}
};
struct EpiStore {
    static constexpr bool PERM = true, AFTER_DRAIN = false;
    bf16_t* O; int ldc;
    __device__ __forceinline__ void operator()(const f32x4 (&acc)[2][2][4][2], const Unit& u, int wr, int wc, int fr, int fq) const {
        const int row0 = u.orow + wr * 64 + fr, col0 = u.ocol + wc * 32 + 8 * fq;
#pragma unroll
        for (int ai = 0; ai < 2; ++ai)
#pragma unroll
            for (int m = 0; m < 4; ++m) { bf16_t* rowp = O + (size_t)(row0 + ai * HALF + m * 16) * ldc + col0;
#pragma unroll
                for (int bj = 0; bj < 2; ++bj) { const f32x4 v0 = acc[ai][bj][m][0], v1 = acc[ai][bj][m][1];
                    u32x4 w; w.x = cvt_pk_bf16(v0[0], v0[1]); w.y = cvt_pk_bf16(v0[2], v0[3]); w.z = cvt_pk_bf16(v1[0], v1[1]); w.w = cvt_pk_bf16(v1[2], v1[3]);
                    *(u32x4*)(rowp + bj * HALF) = w; } }
    }
};
struct EpiStoreKi {
    static constexpr bool PERM = true, AFTER_DRAIN = false;
    bf16_t* O; int ldc; bf16_t* Ki; int kcol;
    __device__ __forceinline__ void operator()(const f32x4 (&acc)[2][2][4][2], const Unit& u, int wr, int wc, int fr, int fq) const {
        const int row0 = u.orow + wr * 64 + fr, col0 = u.ocol + wc * 32 + 8 * fq;
        const bool kt = (u.ocol == kcol) && (wc < 2);
#pragma unroll
        for (int ai = 0; ai < 2; ++ai)
#pragma unroll
            for (int m = 0; m < 4; ++m) { bf16_t* rowp = O + (size_t)(row0 + ai * HALF + m * 16) * ldc + col0;
#pragma unroll
                for (int bj = 0; bj < 2; ++bj) { const f32x4 v0 = acc[ai][bj][m][0], v1 = acc[ai][bj][m][1];
                    u32x4 w; w.x = cvt_pk_bf16(v0[0], v0[1]); w.y = cvt_pk_bf16(v0[2], v0[3]); w.z = cvt_pk_bf16(v1[0], v1[1]); w.w = cvt_pk_bf16(v1[2], v1[3]);
                    *(u32x4*)(rowp + bj * HALF) = w;
                    if (bj == 0 && kt) *(u32x4*)(Ki + (size_t)(row0 + ai * HALF + m * 16) * 64 + wc * 32 + 8 * fq) = w; } }
    }
};
template <class Epi, class Sched, bool ALIGN_EPI = false, bool SP2 = false>
__device__ __forceinline__ void gemm_phase(PG8_LAS unsigned char* lds, const Gemm g, const Sched& S, const Epi& E) {
    const int tid = TIDX(), wid = __builtin_amdgcn_readfirstlane(tid >> 6), lane = tid & 63, wr = wid >> 2, wc = wid & 3, fr = lane & 15, fq = lane >> 4;
    const int K = g.K, nt = K / BK;
    unsigned voffA[2], voffB[2];
#pragma unroll
    for (int i = 0; i < 2; ++i) { int R, C; stage_rc(tid * 16 + i * 8192, R, C); const int Rb = Epi::PERM ? ((R & ~31) + perm32(R & 31)) : R;
        voffA[i] = (unsigned)(R * g.lda + C) * 2u; voffB[i] = (unsigned)(Rb * g.ldb + C) * 2u; }
    unsigned voffG[2][2][2]; int gR[2], gC[2];
#pragma unroll
    for (int i = 0; i < 2; ++i) { int R, C; stage_rc(tid * 16 + i * 8192, R, C); gR[i] = R; gC[i] = C; }
#define PG8_GOFF(dst, unit_) do { if constexpr (Sched::GATHER) { _Pragma("unroll") for (int _h = 0; _h < 2; ++_h) _Pragma("unroll") for (int _i = 0; _i < 2; ++_i) \
        dst[_h][_i] = (unsigned)S.rowof(unit_, (unit_).orow + _h * HALF + gR[_i]) * (unsigned)(g.lda * 2) + (unsigned)gC[_i] * 2u; } } while (0)
#define PG8_STAGE_A(bufoff, gptr, half, vsel) do { if constexpr (Sched::GATHER) { PG8_STAGE(bufoff, gptr, vsel); } else { PG8_STAGE(bufoff, (gptr) + (half) * hstepA, voffA); } } while (0)
    const size_t kstep = (size_t)(BK * 2);
    const size_t hstepA = (size_t)HALF * g.lda * 2, hstepB = (size_t)HALF * g.ldb * 2;
    const unsigned ldsw = (unsigned)wid * 1024u;
    const int aoff = lds_byte(wr * 64 + fr, fq * 8), boff = lds_byte(wc * 32 + fr, fq * 8);
#define PG8_SA(b, h) (((b) * 2 + (h)) * HTB)
#define PG8_SB(b, h) ((4 + (b) * 2 + (h)) * HTB)
#define PG8_STAGE(bufoff, gbase, voff) do { _Pragma("unroll") for (int _i = 0; _i < 2; ++_i) \
        __builtin_amdgcn_global_load_lds((const unsigned*)((const char*)(gbase) + (voff)[_i]), (PG8_LAS unsigned*)(lds + (bufoff) + ldsw + _i * 8192), 16, 0, 0); } while (0)
#define PG8_LDA(dst, b, h) do { _Pragma("unroll") for (int m = 0; m < 4; ++m) _Pragma("unroll") for (int k = 0; k < 2; ++k) dst[m][k] = *(const PG8_LAS bf16x8*)(lds + PG8_SA(b, h) + aoff + m * 2048 + k * 1024); } while (0)
#define PG8_LDB(dst, b, h) do { _Pragma("unroll") for (int n = 0; n < 2; ++n) _Pragma("unroll") for (int k = 0; k < 2; ++k) dst[n][k] = *(const PG8_LAS bf16x8*)(lds + PG8_SB(b, h) + boff + n * 2048 + k * 1024); } while (0)
#define PG8_MMA(ai, bj, At, Bt) do { __builtin_amdgcn_s_setprio(1); _Pragma("unroll") for (int m = 0; m < 4; ++m) _Pragma("unroll") for (int n = 0; n < 2; ++n) _Pragma("unroll") for (int k = 0; k < 2; ++k) \
        acc[ai][bj][m][n] = __builtin_amdgcn_mfma_f32_16x16x32_bf16(Bt[n][k], At[m][k], acc[ai][bj][m][n], 0, 0, 0); __builtin_amdgcn_s_setprio(0); } while (0)
#define PG8_WAIT_V(n) asm volatile("s_waitcnt vmcnt(" #n ")" ::: "memory")
#define PG8_WAIT_L(n) asm volatile("s_waitcnt lgkmcnt(" #n ")" ::: "memory")
#define PG8_BAR __builtin_amdgcn_s_barrier()
#define PG8_SCHED __builtin_amdgcn_sched_barrier(0)
    Unit cur, nxt; int ui = 0;
    if (!S.next(0, cur)) return;
    f32x4 acc[2][2][4][2];
#pragma unroll
    for (int a = 0; a < 2; ++a)
#pragma unroll
        for (int b = 0; b < 2; ++b)
#pragma unroll
            for (int m = 0; m < 4; ++m)
#pragma unroll
                for (int n = 0; n < 2; ++n) acc[a][b][m][n] = (f32x4){0.f, 0.f, 0.f, 0.f};
    bf16x8 At[4][2], B0[2][2], B1[2][2];
    const char* cA = cur.pa; const char* cB = cur.pb;
    S.a_ready(cur);
    PG8_GOFF(voffG[0], cur);
    if constexpr (SP2) {
        PG8_STAGE(PG8_SB(0, 0), cB, voffB); PG8_STAGE(PG8_SB(0, 1), cB + hstepB, voffB); PG8_STAGE_A(PG8_SA(0, 0), cA, 0, voffG[0][0]); PG8_STAGE_A(PG8_SA(0, 1), cA, 1, voffG[0][1]);
        if (wr == 1) PG8_BAR;
        PG8_WAIT_V(2); PG8_BAR;
        PG8_STAGE(PG8_SB(1, 0), cB + kstep, voffB); PG8_STAGE_A(PG8_SA(1, 0), cA + kstep, 0, voffG[0][0]); PG8_STAGE(PG8_SB(1, 1), cB + hstepB + kstep, voffB);
        PG8_WAIT_V(6); PG8_BAR;
    } else {
        PG8_STAGE(PG8_SB(0, 0), cB, voffB); PG8_STAGE_A(PG8_SA(0, 0), cA, 0, voffG[0][0]); PG8_STAGE(PG8_SB(0, 1), cB + hstepB, voffB); PG8_STAGE_A(PG8_SA(0, 1), cA, 1, voffG[0][1]);
        if (wr == 1) PG8_BAR;
        PG8_WAIT_V(4); PG8_BAR;
        PG8_STAGE(PG8_SB(1, 0), cB + kstep, voffB); PG8_STAGE_A(PG8_SA(1, 0), cA + kstep, 0, voffG[0][0]); PG8_STAGE(PG8_SB(1, 1), cB + hstepB + kstep, voffB);
        PG8_WAIT_V(6); PG8_BAR;
    }
    for (;;) {
        const bool has_next = S.next(ui + 1, nxt);
        if constexpr (Sched::GATHER) { if (has_next) { PG8_GOFF(voffG[1], nxt); } else {
#pragma unroll
            for (int _h = 0; _h < 2; ++_h)
#pragma unroll
                for (int _i = 0; _i < 2; ++_i) voffG[1][_h][_i] = voffG[0][_h][_i]; } }
        const char* nA = has_next ? nxt.pa : cA; const char* nB = has_next ? nxt.pb : cB;
        for (int t = 0; t < nt; t += 2) {
            const bool last = (t == nt - 2);
            const char* a1 = cA + (size_t)(t + 1) * kstep;
            const char* a2 = last ? nA : cA + (size_t)(t + 2) * kstep; const char* b2 = last ? nB : cB + (size_t)(t + 2) * kstep;
            const char* a3 = a2 + kstep; const char* b3 = b2 + kstep;
            unsigned vs0[2], vs1[2];
#pragma unroll
            for (int _i = 0; _i < 2; ++_i) { vs0[_i] = last ? voffG[1][0][_i] : voffG[0][0][_i]; vs1[_i] = last ? voffG[1][1][_i] : voffG[0][1][_i]; }
            if (last && has_next) S.a_ready(nxt);
            if constexpr (SP2) {
            PG8_LDB(B0, 0, 0); PG8_LDB(B1, 0, 1); PG8_SCHED; PG8_LDA(At, 0, 0); PG8_STAGE_A(PG8_SA(1, 1), a1, 1, voffG[0][1]);
            PG8_WAIT_V(8); PG8_WAIT_L(0); PG8_BAR; PG8_MMA(0, 0, At, B0); PG8_MMA(0, 1, At, B1); PG8_BAR; PG8_SCHED;
            PG8_LDA(At, 0, 1); PG8_STAGE(PG8_SB(0, 0), b2, voffB); PG8_STAGE(PG8_SB(0, 1), b2 + hstepB, voffB); PG8_STAGE_A(PG8_SA(0, 0), a2, 0, vs0);
            PG8_WAIT_V(8); PG8_WAIT_L(0); PG8_BAR; PG8_MMA(1, 0, At, B0); PG8_MMA(1, 1, At, B1); PG8_BAR; PG8_SCHED;
            PG8_LDB(B0, 1, 0); PG8_LDB(B1, 1, 1); PG8_SCHED; PG8_LDA(At, 1, 0); PG8_STAGE_A(PG8_SA(0, 1), a2, 1, vs1);
            PG8_WAIT_V(8); PG8_WAIT_L(0); PG8_BAR; PG8_MMA(0, 0, At, B0); PG8_MMA(0, 1, At, B1); PG8_BAR; PG8_SCHED;
            PG8_LDA(At, 1, 1); PG8_STAGE(PG8_SB(1, 0), b3, voffB); PG8_STAGE(PG8_SB(1, 1), b3 + hstepB, voffB); PG8_STAGE_A(PG8_SA(1, 0), a3, 0, vs0);
            PG8_WAIT_V(8); PG8_WAIT_L(0); PG8_BAR; PG8_MMA(1, 0, At, B0); PG8_MMA(1, 1, At, B1); PG8_BAR; PG8_SCHED;
            } else {
            PG8_LDB(B0, 0, 0); PG8_SCHED; PG8_LDA(At, 0, 0); PG8_STAGE_A(PG8_SA(1, 1), a1, 1, voffG[0][1]);
            PG8_WAIT_L(8); PG8_BAR; PG8_WAIT_L(0); PG8_MMA(0, 0, At, B0); PG8_BAR; PG8_SCHED;
            PG8_LDB(B1, 0, 1); PG8_STAGE(PG8_SB(0, 0), b2, voffB);
            PG8_BAR; PG8_WAIT_L(0); PG8_MMA(0, 1, At, B1); PG8_BAR;
            PG8_LDA(At, 0, 1); PG8_STAGE_A(PG8_SA(0, 0), a2, 0, vs0);
            PG8_BAR; PG8_WAIT_L(0); PG8_MMA(1, 0, At, B0); PG8_BAR; PG8_SCHED;
            PG8_STAGE(PG8_SB(0, 1), b2 + hstepB, voffB);
            PG8_WAIT_V(6); PG8_BAR; PG8_MMA(1, 1, At, B1); PG8_BAR;
            PG8_LDB(B0, 1, 0); PG8_SCHED; PG8_LDA(At, 1, 0); PG8_STAGE_A(PG8_SA(0, 1), a2, 1, vs1);
            PG8_WAIT_L(8); PG8_BAR; PG8_WAIT_L(0); PG8_MMA(0, 0, At, B0); PG8_BAR; PG8_SCHED;
            PG8_LDB(B1, 1, 1); PG8_STAGE(PG8_SB(1, 0), b3, voffB);
            PG8_BAR; PG8_WAIT_L(0); PG8_MMA(0, 1, At, B1); PG8_BAR;
            PG8_LDA(At, 1, 1); PG8_STAGE_A(PG8_SA(1, 0), a3, 0, vs0);
            PG8_BAR; PG8_WAIT_L(0); PG8_MMA(1, 0, At, B0); PG8_BAR; PG8_SCHED;
            PG8_STAGE(PG8_SB(1, 1), b3 + hstepB, voffB);
            PG8_WAIT_V(6); PG8_BAR; PG8_MMA(1, 1, At, B1); PG8_BAR;
            }
        }
        if constexpr (ALIGN_EPI) { if (wr == 0) PG8_BAR; }
        if constexpr (!Epi::AFTER_DRAIN) { E(acc, cur, wr, wc, fr, fq); S.done(cur); }
        if (!has_next) break;
#pragma unroll
        for (int a = 0; a < 2; ++a)
#pragma unroll
            for (int b = 0; b < 2; ++b)
#pragma unroll
                for (int m = 0; m < 4; ++m)
#pragma unroll
                    for (int n = 0; n < 2; ++n) acc[a][b][m][n] = (f32x4){0.f, 0.f, 0.f, 0.f};
        cur = nxt; cA = nA; cB = nB; ++ui;
        if constexpr (Sched::GATHER) {
#pragma unroll
            for (int _h = 0; _h < 2; ++_h)
#pragma unroll
                for (int _i = 0; _i < 2; ++_i) voffG[0][_h][_i] = voffG[1][_h][_i]; }
        if constexpr (ALIGN_EPI) { if (wr == 1) PG8_BAR; }
    }
    PG8_WAIT_V(0);
    if constexpr (!ALIGN_EPI) { if (wr == 0) PG8_BAR; }
    PG8_BAR;
    if constexpr (Epi::AFTER_DRAIN) { E.fused(acc, cur, wr, wc, fr, fq, lds, wid, lane); S.done(cur); }
#undef PG8_SA
#undef PG8_SB
#undef PG8_STAGE
#undef PG8_STAGE_A
#undef PG8_GOFF
#undef PG8_LDA
#undef PG8_LDB
#undef PG8_MMA
#undef PG8_WAIT_V
#undef PG8_WAIT_L
#undef PG8_BAR
#undef PG8_SCHED
}

}
#define WSYNC2() asm volatile("s_waitcnt lgkmcnt(0)" ::: "memory")
struct MoeBufs { int* tok_e; float* tok_g; int* slot_of; float* slot_gate; int* blk_e; int* blkcnt; int* nblk; int* slot_tok; };
constexpr int WRT_LD = 1028;

template <bool XB, int MODE = 0> __device__ __forceinline__ void ph_ln_router(const void* xin_, const bf16_t* hb, const float* g, const float* bb, const float* wr, const float* br, bf16_t* x1b, const MoeBufs m, float* lds) {
  const float* xin = (const float*)xin_; const bf16_t* xinb = (const bf16_t*)xin_;
  for (int i = BIDX() * NTHR + TIDX(); i < PMAX; i += (int)gridDim.x * NTHR) m.slot_tok[i] = 0;
  const int tid = TIDX(), lane = tid & 63, wave = tid >> 6, blk = BIDX();
  float* wT = lds;
  float* lg = lds + 32 * WRT_LD + wave * 64;
  int* cnt = (int*)(lds + 32 * WRT_LD + 8 * 64);
  f32x4 raf[2][4]; v2u rab[2][4], rh[2][4];
#define LNR_LOAD(tk) { _Pragma("unroll") for (int q = 0; q < 2; ++q) _Pragma("unroll") for (int j = 0; j < 4; ++j) { const int c = lane * 4 + 256 * j; \
      if (XB) rab[q][j] = *(const v2u*)(xinb + (size_t)((tk) + q) * D + c); else raf[q][j] = *(const f32x4*)(xin + (size_t)((tk) + q) * D + c); \
      rh[q][j] = *(const v2u*)(hb + (size_t)((tk) + q) * D + c); } }
  LNR_LOAD(blk * 64 + wave * 8)
  { f32x4 wv[16];
#pragma unroll
    for (int k = 0; k < 16; ++k) wv[k] = *(const f32x4*)(wr + (size_t)(tid + NTHR * k) * 4);
#pragma unroll
    for (int k = 0; k < 16; ++k) { const int i = (tid + NTHR * k) * 4, d = i >> 5, e = i & 31;
#pragma unroll
      for (int z = 0; z < 4; ++z) wT[(e + z) * WRT_LD + d] = wv[k][z]; } }
  if (tid < 32) cnt[tid] = 0;
  __syncthreads();
#pragma unroll 1
  for (int it = 0; it < 8; it += 2) {
    const int tok0 = blk * 64 + wave * 8 + it;
    f32x4 v[2][4]; float s[2] = {0.f, 0.f};
#pragma unroll
    for (int q = 0; q < 2; ++q)
#pragma unroll
      for (int j = 0; j < 4; ++j) { f32x4 a;
        if (XB) { const v2u xv = rab[q][j]; a = (f32x4){bf_lo(xv[0]), bf_hi(xv[0]), bf_lo(xv[1]), bf_hi(xv[1])}; } else a = raf[q][j];
        const v2u hh = rh[q][j];
        v[q][j] = (f32x4){ALPHA * a[0] + bf_lo(hh[0]), ALPHA * a[1] + bf_hi(hh[0]), ALPHA * a[2] + bf_lo(hh[1]), ALPHA * a[3] + bf_hi(hh[1])}; s[q] += (v[q][j][0] + v[q][j][1]) + (v[q][j][2] + v[q][j][3]); }
    if (it + 2 < 8) LNR_LOAD(tok0 + 2)
#pragma unroll
    for (int o = 1; o < 64; o <<= 1) { s[0] += __shfl_xor(s[0], o); s[1] += __shfl_xor(s[1], o); }
    float qq[2] = {0.f, 0.f};
#pragma unroll
    for (int q = 0; q < 2; ++q) { const float mu = s[q] * (1.f / D);
#pragma unroll
      for (int j = 0; j < 4; ++j) { v[q][j] = v[q][j] - mu; qq[q] += (v[q][j][0] * v[q][j][0] + v[q][j][1] * v[q][j][1]) + (v[q][j][2] * v[q][j][2] + v[q][j][3] * v[q][j][3]); } }
#pragma unroll
    for (int o = 1; o < 64; o <<= 1) { qq[0] += __shfl_xor(qq[0], o); qq[1] += __shfl_xor(qq[1], o); }
#pragma unroll
    for (int q = 0; q < 2; ++q) { const float r = rsqrtf(qq[q] * (1.f / D) + 1e-5f);
#pragma unroll
      for (int j = 0; j < 4; ++j) { const int c = lane * 4 + 256 * j; const f32x4 g4 = *(const f32x4*)(g + c), b4 = *(const f32x4*)(bb + c); v[q][j] = v[q][j] * r * g4 + b4; *(v2u*)(x1b + (size_t)(tok0 + q) * D + c) = (v2u){cvt_pk_bf16(v[q][j][0], v[q][j][1]), cvt_pk_bf16(v[q][j][2], v[q][j][3])}; } }
    if (MODE == 1) continue;
    float p[2][32];
    { const float* wl = wT + lane * 4; f32x4 wb[2][4];
#pragma unroll
      for (int j = 0; j < 4; ++j) wb[0][j] = *(const f32x4*)(wl + 256 * j);
#pragma unroll
      for (int e = 0; e < 32; ++e) {
        if (e < 31) {
#pragma unroll
          for (int j = 0; j < 4; ++j) wb[(e + 1) & 1][j] = *(const f32x4*)(wl + (e + 1) * WRT_LD + 256 * j); }
        __builtin_amdgcn_sched_barrier(0);
        f32x2_t a0 = {0.f, 0.f}, a1 = {0.f, 0.f};
#pragma unroll
        for (int j = 0; j < 4; ++j) { const f32x4 w4 = wb[e & 1][j]; const f32x2_t wlo = {w4[0], w4[1]}, whi = {w4[2], w4[3]};
          a0 = __builtin_elementwise_fma((f32x2_t){v[0][j][0], v[0][j][1]}, wlo, a0); a0 = __builtin_elementwise_fma((f32x2_t){v[0][j][2], v[0][j][3]}, whi, a0);
          a1 = __builtin_elementwise_fma((f32x2_t){v[1][j][0], v[1][j][1]}, wlo, a1); a1 = __builtin_elementwise_fma((f32x2_t){v[1][j][2], v[1][j][3]}, whi, a1); }
        p[0][e] = a0[0] + a0[1]; p[1][e] = a1[0] + a1[1];
        __builtin_amdgcn_sched_barrier(0);
      } }
#pragma unroll
    for (int i = 0; i < 16; ++i) { const bool hi = (lane & 32) != 0;
#pragma unroll
      for (int q = 0; q < 2; ++q) { const float send = hi ? p[q][i] : p[q][i + 16]; const float keep = hi ? p[q][i + 16] : p[q][i]; p[q][i] = keep + __shfl_xor(send, 32); } }
#pragma unroll
    for (int i = 0; i < 8; ++i) { const bool hi = (lane & 16) != 0;
#pragma unroll
      for (int q = 0; q < 2; ++q) { const float send = hi ? p[q][i] : p[q][i + 8]; const float keep = hi ? p[q][i + 8] : p[q][i]; p[q][i] = keep + __shfl_xor(send, 16); } }
#pragma unroll
    for (int i = 0; i < 4; ++i) { const bool hi = (lane & 8) != 0;
#pragma unroll
      for (int q = 0; q < 2; ++q) { const float send = hi ? p[q][i] : p[q][i + 4]; const float keep = hi ? p[q][i + 4] : p[q][i]; p[q][i] = keep + __shfl_xor(send, 8); } }
#pragma unroll
    for (int i = 0; i < 2; ++i) { const bool hi = (lane & 4) != 0;
#pragma unroll
      for (int q = 0; q < 2; ++q) { const float send = hi ? p[q][i] : p[q][i + 2]; const float keep = hi ? p[q][i + 2] : p[q][i]; p[q][i] = keep + __shfl_xor(send, 4); } }
#pragma unroll
    for (int q = 0; q < 2; ++q) { const bool hi = (lane & 2) != 0; const float send = hi ? p[q][0] : p[q][1]; const float keep = hi ? p[q][1] : p[q][0]; p[q][0] = keep + __shfl_xor(send, 2); }
    p[0][0] += __shfl_xor(p[0][0], 1); p[1][0] += __shfl_xor(p[1][0], 1);
    const int e_l = ((lane >> 5) & 1) * 16 + ((lane >> 4) & 1) * 8 + ((lane >> 3) & 1) * 4 + ((lane >> 2) & 1) * 2 + ((lane >> 1) & 1);
    const float brl = br[e_l];
    float lv[2] = {p[0][0] + brl, p[1][0] + brl}; int ei[2][4]; float ev[2][4];
    if (MODE == 2) for (int k = 1; k < 4; ++k) { ei[0][k] = ei[1][k] = k; ev[0][k] = ev[1][k] = 0.f; }
#pragma unroll
    for (int k = 0; k < (MODE == 2 ? 1 : 4); ++k) { float bv[2] = {lv[0], lv[1]}; int bi[2] = {e_l, e_l};
#pragma unroll
      for (int o = 2; o < 64; o <<= 1)
#pragma unroll
        for (int q = 0; q < 2; ++q) { const float ov = __shfl_xor(bv[q], o); const int oi = __shfl_xor(bi[q], o); const bool take = (ov > bv[q]) || (ov == bv[q] && oi < bi[q]); bv[q] = take ? ov : bv[q]; bi[q] = take ? oi : bi[q]; }
#pragma unroll
      for (int q = 0; q < 2; ++q) { ei[q][k] = bi[q]; ev[q][k] = bv[q]; if (e_l == bi[q]) lv[q] = -INFINITY; } }
    if (lane < 2) { const int q = lane;
      float ex[4], su = 0.f;
#pragma unroll
      for (int k = 0; k < 4; ++k) { ex[k] = __expf((q ? ev[1][k] : ev[0][k]) - (q ? ev[1][0] : ev[0][0])); su += ex[k]; }
      const float inv = 1.f / su; const int tok = tok0 + q;
      const int e0 = q ? ei[1][0] : ei[0][0], e1 = q ? ei[1][1] : ei[0][1], e2 = q ? ei[1][2] : ei[0][2], e3 = q ? ei[1][3] : ei[0][3];
      *(int4*)(m.tok_e + tok * 4) = make_int4(e0, e1, e2, e3);
      *(float4*)(m.tok_g + tok * 4) = make_float4(ex[0] * inv, ex[1] * inv, ex[2] * inv, ex[3] * inv);
      atomicAdd(&cnt[e0], 1); atomicAdd(&cnt[e1], 1); atomicAdd(&cnt[e2], 1); atomicAdd(&cnt[e3], 1); }
  }
  __syncthreads();
  if (tid < 32) m.blkcnt[blk * 32 + tid] = cnt[tid];
  __syncthreads();
}

__device__ __forceinline__ void ph_moe_scatter(const MoeBufs m, int* ilds) {
  const int tid = TIDX(), lane = tid & 63, wave = tid >> 6, blk = BIDX(); (void)lane;
  int* tot = ilds; int* bef = ilds + 32; int* pst = ilds + 64; int* es = ilds + 128; int* rk = ilds + 384; int* sl = ilds + 640; int* part = ilds + 896; int* wcnt = ilds + 1408;
  { const int e = tid & 31, pa = tid >> 5; int sum = 0;
#pragma unroll
    for (int q = 0; q < 16; ++q) sum += m.blkcnt[(pa * 16 + q) * 32 + e];
    part[pa * 32 + e] = sum; }
  if (tid < 256) es[tid] = m.tok_e[blk * 256 + tid];
  __syncthreads();
  if (tid < 32) { const int e = tid; int t_ = 0, b_ = 0; const int pb_ = blk >> 4;
    for (int q = 0; q < 16; ++q) { const int v = part[q * 32 + e]; t_ += v; if (q < pb_) b_ += v; }
    for (int q = pb_ * 16; q < blk; ++q) b_ += m.blkcnt[q * 32 + e];
    tot[e] = t_; bef[e] = b_; }
  if (tid < 256) { const int e = es[tid]; const unsigned long long lt = (1ull << lane) - 1ull; int r = 0;
    for (int ee = 0; ee < 32; ++ee) { const unsigned long long mk = __ballot(e == ee); if (e == ee) r = __builtin_popcountll(mk & lt); if (lane == ee) wcnt[wave * 32 + ee] = __builtin_popcountll(mk); }
    rk[tid] = r; }
  __syncthreads();
  if (tid == 0) { int acc = 0; for (int e = 0; e < 32; ++e) { pst[e] = acc; acc += ((tot[e] + 255) >> 8) << 8; } pst[32] = acc;
    if (blk == 0) { *m.nblk = acc >> 8; for (int e = 0; e < 32; ++e) for (int q = pst[e] >> 8; q < (pst[e + 1] >> 8); ++q) m.blk_e[q] = e; } }
  __syncthreads();
  if (tid < 256) { const int e = es[tid]; int rank = rk[tid]; for (int w2 = 0; w2 < wave; ++w2) rank += wcnt[w2 * 32 + e];
    const int slot = pst[e] + bef[e] + rank; m.slot_of[blk * 256 + tid] = slot; m.slot_gate[slot] = m.tok_g[blk * 256 + tid]; m.slot_tok[slot] = blk * 64 + (tid >> 2); }
  __syncthreads();
  __syncthreads();
}

__device__ __forceinline__ void ph_combine_ln(const bf16_t* x1b, const bf16_t* Ys, const int* slot_of, const float* g, const float* bb, float* out, bf16_t* outb) {
  const int tid = TIDX(), lane = tid & 63, gw = BIDX() * 8 + (tid >> 6), NGW = (int)gridDim.x * 8;
  for (int row = gw; row < NT; row += NGW) {
    const int4 s4 = *(const int4*)(slot_of + row * 4); const int sl[4] = {s4.x, s4.y, s4.z, s4.w};
    f32x4 v[4]; float s = 0.f;
#pragma unroll
    for (int j = 0; j < 4; ++j) { const int c = lane * 4 + 256 * j; f32x4 f = (f32x4){0.f, 0.f, 0.f, 0.f};
#pragma unroll
      for (int k = 0; k < 4; ++k) { const v2u y = *(const v2u*)(Ys + (size_t)sl[k] * D + c); f += (f32x4){bf_lo(y[0]), bf_hi(y[0]), bf_lo(y[1]), bf_hi(y[1])}; }
      const v2u xv = *(const v2u*)(x1b + (size_t)row * D + c); const f32x4 a = (f32x4){bf_lo(xv[0]), bf_hi(xv[0]), bf_lo(xv[1]), bf_hi(xv[1])}; v[j] = a * ALPHA + f; s += (v[j][0] + v[j][1]) + (v[j][2] + v[j][3]); }
    const float mu = wave_sum(s) * (1.f / D); float q = 0.f;
#pragma unroll
    for (int j = 0; j < 4; ++j) { v[j] = v[j] - mu; q += (v[j][0] * v[j][0] + v[j][1] * v[j][1]) + (v[j][2] * v[j][2] + v[j][3] * v[j][3]); }
    const float r = rsqrtf(wave_sum(q) * (1.f / D) + 1e-5f);
#pragma unroll
    for (int j = 0; j < 4; ++j) { const int c = lane * 4 + 256 * j; const f32x4 g4 = *(const f32x4*)(g + c), b4 = *(const f32x4*)(bb + c); const f32x4 o = v[j] * r * g4 + b4;
      if (out) *(f32x4*)(out + (size_t)row * D + c) = o; if (outb) *(v2u*)(outb + (size_t)row * D + c) = (v2u){cvt_pk_bf16(o[0], o[1]), cvt_pk_bf16(o[2], o[3])}; }
  }
}

namespace pg8 {
template <bool GATHER_> struct MoeOrderT {
    static constexpr bool GATHER = GATHER_; const int* rowmap;
    StaticOrder so; const int* blk_e; const char* W; size_t wexp; int obn;
    __device__ void init(const void* A, int lda, const void* W_, int ldb, size_t wexp_, int nM, int nN, int obn_, const int* blk_e_, int G, int c) { so.init(A, lda, W_, ldb, nM * BM, nN * BM, G, c); blk_e = blk_e_; W = (const char*)W_; wexp = wexp_; obn = obn_; }
    __device__ bool next(int i, Unit& u) const { int pm, pn; if (!so.tile(i, pm, pn)) return false; const int e = __builtin_amdgcn_readfirstlane(blk_e[pm]); u.pa = GATHER_ ? so.A : so.A + (size_t)pm * so.ta; u.pb = W + (size_t)e * wexp + (size_t)pn * so.tb; u.orow = pm * BM; u.ocol = pn * obn; u.e = e; u.kind = 0; return true; }
    __device__ __forceinline__ int rowof(const Unit&, int r) const { return GATHER_ ? rowmap[r] : r; }
    __device__ __forceinline__ void a_ready(const Unit&) const {}
    __device__ __forceinline__ void done(const Unit&) const {}
};
typedef MoeOrderT<false> MoeOrder; typedef MoeOrderT<true> MoeOrderG;
struct EpiSwiglu {
    static constexpr bool PERM = true, AFTER_DRAIN = false;
    bf16_t* O; int ldc; const float* b1;
    __device__ __forceinline__ void operator()(const f32x4 (&acc)[2][2][4][2], const Unit& u, int wr, int wc, int fr, int fq) const {
        const int row0 = u.orow + wr * 64 + fr, cl = wc * 32 + 8 * fq, col0 = u.ocol + cl;
        const float* bg = b1 + (size_t)u.e * 2048 + col0; const float* bu = bg + 1024;
        const f32x4 bg0 = *(const f32x4*)bg, bg1 = *(const f32x4*)(bg + 4), bu0 = *(const f32x4*)bu, bu1 = *(const f32x4*)(bu + 4);
#pragma unroll
        for (int ai = 0; ai < 2; ++ai)
#pragma unroll
            for (int m = 0; m < 4; ++m) {
                f32x4 gv[2] = {acc[ai][0][m][0] + bg0, acc[ai][0][m][1] + bg1}, uv[2] = {acc[ai][1][m][0] + bu0, acc[ai][1][m][1] + bu1}; float o[8];
#pragma unroll
                for (int n = 0; n < 2; ++n)
#pragma unroll
                    for (int i = 0; i < 4; ++i) { const float gg = fminf(gv[n][i], 7.f), uu = fminf(fmaxf(uv[n][i], -7.f), 7.f);
                        const float sg = __builtin_amdgcn_rcpf(1.f + __builtin_amdgcn_exp2f(-1.702f * 1.4426950408889634f * gg)); o[4 * n + i] = (uu + 1.f) * gg * sg; }
                u32x4 w; w.x = cvt_pk_bf16(o[0], o[1]); w.y = cvt_pk_bf16(o[2], o[3]); w.z = cvt_pk_bf16(o[4], o[5]); w.w = cvt_pk_bf16(o[6], o[7]);
                *(u32x4*)(O + (size_t)(row0 + ai * HALF + m * 16) * ldc + col0) = w; asm volatile("" ::: "memory"); }
    }
};
struct EpiMoe2 {
    static constexpr bool PERM = true, AFTER_DRAIN = false;
    bf16_t* O; int ldc; const float* b2; const float* gate;
    __device__ __forceinline__ void operator()(const f32x4 (&acc)[2][2][4][2], const Unit& u, int wr, int wc, int fr, int fq) const {
        const int row0 = u.orow + wr * 64 + fr, col0 = u.ocol + wc * 32 + 8 * fq;
        const float* bp = b2 + (size_t)u.e * 1024 + col0;
#pragma unroll
        for (int bj = 0; bj < 2; ++bj) {
            const f32x4 bv0 = *(const f32x4*)(bp + bj * HALF), bv1 = *(const f32x4*)(bp + bj * HALF + 4);
#pragma unroll
            for (int ai = 0; ai < 2; ++ai)
#pragma unroll
                for (int m = 0; m < 4; ++m) { const int row = row0 + ai * HALF + m * 16; const float gt = gate[row];
                    const f32x4 v0 = (acc[ai][bj][m][0] + bv0) * gt, v1 = (acc[ai][bj][m][1] + bv1) * gt;
                    u32x4 w; w.x = cvt_pk_bf16(v0[0], v0[1]); w.y = cvt_pk_bf16(v0[2], v0[3]); w.z = cvt_pk_bf16(v1[0], v1[1]); w.w = cvt_pk_bf16(v1[2], v1[3]);
                    *(u32x4*)(O + (size_t)row * ldc + col0 + bj * HALF) = w; asm volatile("" ::: "memory"); }
        }
    }
};

struct MoeFusedOrder {
    static constexpr bool GATHER = true;
    const int* rowmap; const int* blk_e; const char* X; const char* ACT; const char* W1; const char* W2; unsigned* ready; unsigned* tmo; int nblk, NG, G, c, total, mode;
    __device__ void init(const void* X_, const void* ACT_, const void* W1_, const void* W2_, const int* rowmap_, const int* blk_e_, unsigned* ready_, unsigned* tmo_, int nblk_, int G_, int c_) {
        X = (const char*)X_; ACT = (const char*)ACT_; W1 = (const char*)W1_; W2 = (const char*)W2_; rowmap = rowmap_; blk_e = blk_e_; ready = ready_; tmo = tmo_; nblk = nblk_; NG = (nblk_ + 31) >> 5; G = G_; c = c_; total = nblk_ * 12; }
    __device__ bool next(int i, Unit& u) const {
        int Lq = i * G + c; if (Lq >= total) return false;
#if defined(FUSE_SPLIT)
        if (c >= 0) { const int kind = mode - 1; if (Lq >= nblk * (kind ? 4 : 8)) return false; const int q = Lq; const int pm = q % nblk, pn = q / nblk, e = __builtin_amdgcn_readfirstlane(blk_e[pm]);
          u.kind = kind; u.e = e; u.orow = pm * BM;
          if (kind == 0) { u.pa = X; u.pb = W1 + ((size_t)e * 2048 + (size_t)pn * 256) * 2048; u.ocol = pn * 128; }
          else { u.pa = ACT; u.pb = W2 + ((size_t)e * 1024 + (size_t)pn * 256) * 2048; u.ocol = pn * 256; }
          return true; }
#endif
#if defined(FUSE_SERIAL)
        { const int n1 = nblk * 8; int kind = Lq < n1 ? 0 : 1; int q = kind ? Lq - n1 : Lq; const int pm = q % nblk, pn = q / nblk, e = __builtin_amdgcn_readfirstlane(blk_e[pm]);
          u.kind = kind; u.e = e; u.orow = pm * BM;
          if (kind == 0) { u.pa = X; u.pb = W1 + ((size_t)e * 2048 + (size_t)pn * 256) * 2048; u.ocol = pn * 128; }
          else { u.pa = ACT; u.pb = W2 + ((size_t)e * 1024 + (size_t)pn * 256) * 2048; u.ocol = pn * 256; }
          return true; }
#endif
        int kind = 0, g = 0;
        for (int sgm = 0; ; ++sgm) {
            if (sgm < 3) { kind = 0; g = sgm; }
            else if (sgm < 3 + 2 * (NG - 3)) { const int j = (sgm - 3) >> 1; if (((sgm - 3) & 1) == 0) { kind = 0; g = j + 3; } else { kind = 1; g = j; } }
            else { kind = 1; g = NG - 3 + (sgm - (3 + 2 * (NG - 3))); }
            const int mg = min(32, nblk - 32 * g), sz = mg * (kind ? 4 : 8);
            if (Lq < sz) { const int pm = 32 * g + Lq % mg, pn = Lq / mg, e = __builtin_amdgcn_readfirstlane(blk_e[pm]);
                u.kind = kind; u.e = e; u.orow = pm * BM;
                if (kind == 0) { u.pa = X; u.pb = W1 + ((size_t)e * 2048 + (size_t)pn * 256) * 2048; u.ocol = pn * 128; }
                else { u.pa = ACT; u.pb = W2 + ((size_t)e * 1024 + (size_t)pn * 256) * 2048; u.ocol = pn * 256; }
                return true; }
            Lq -= sz;
        }
    }
    __device__ __forceinline__ int rowof(const Unit& u, int r) const { return u.kind == 0 ? rowmap[r] : r; }
    __device__ __forceinline__ void a_ready(const Unit& u) const {
        if (u.kind == 0) return;
#if defined(FUSE_SPLIT)
        return;
#endif
        if (threadIdx.x < 64) {
#if defined(FUSE_GLOBAL_WAIT)
            const unsigned long long t0 = __builtin_amdgcn_s_memrealtime(); unsigned polls = 0; unsigned* rp = ready + 64 * 500; const unsigned want = (unsigned)nblk * 64u;
#else
            const unsigned long long t0 = __builtin_amdgcn_s_memrealtime(); unsigned polls = 0; unsigned* rp = ready + 64 * (u.orow >> 8); const unsigned want = 64u;
#endif
            while ((unsigned)__builtin_amdgcn_readfirstlane(__hip_atomic_load(rp, __ATOMIC_RELAXED, __HIP_MEMORY_SCOPE_AGENT)) < want) {
                if ((++polls & 255u) == 0u && __builtin_amdgcn_readfirstlane(__hip_atomic_load(tmo, __ATOMIC_RELAXED, __HIP_MEMORY_SCOPE_AGENT)) != 0u) break;
                if (__builtin_amdgcn_s_memrealtime() - t0 > 2000000ull) { if (threadIdx.x == 0) __hip_atomic_store(tmo, 1u, __ATOMIC_RELAXED, __HIP_MEMORY_SCOPE_AGENT); break; }
                __builtin_amdgcn_s_sleep(2); }
#if defined(FUSE_CONSUMER_WB)
            __builtin_amdgcn_fence(__ATOMIC_RELEASE, "agent"); asm volatile("s_waitcnt vmcnt(0)" ::: "memory");
#endif
#if defined(FUSE_DELAY)
            { const unsigned long long t1 = __builtin_amdgcn_s_memrealtime(); while (__builtin_amdgcn_s_memrealtime() - t1 < 2000ull) __builtin_amdgcn_s_sleep(8); }
#endif
            __builtin_amdgcn_fence(__ATOMIC_ACQUIRE, "agent");
            asm volatile("s_waitcnt vmcnt(0)" ::: "memory");
        }
        asm volatile("" ::: "memory"); __builtin_amdgcn_s_barrier(); asm volatile("" ::: "memory");
    }
    __device__ __forceinline__ void done(const Unit& u) const {
        if (u.kind != 0) return;
        asm volatile("s_waitcnt vmcnt(0)" ::: "memory");
#if defined(FUSE_HEAVY_RELEASE)
        __builtin_amdgcn_fence(__ATOMIC_RELEASE, "agent"); asm volatile("s_waitcnt vmcnt(0)" ::: "memory");
#endif
#if defined(FUSE_GLOBAL_WAIT)
        if ((threadIdx.x & 63) == 0) __hip_atomic_fetch_add(ready + 64 * 500, 1u, __ATOMIC_RELAXED, __HIP_MEMORY_SCOPE_AGENT);
#else
        if ((threadIdx.x & 63) == 0) __hip_atomic_fetch_add(ready + 64 * (u.orow >> 8), 1u, __ATOMIC_RELAXED, __HIP_MEMORY_SCOPE_AGENT);
#endif
    }
};
__device__ __forceinline__ void store16_sc1(void* p, u32x4 v) { asm volatile("global_store_dwordx4 %0, %1, off sc1\n\ts_nop 1" :: "v"(p), "v"(v) : "memory"); }
struct EpiMoeFused {
    static constexpr bool PERM = true, AFTER_DRAIN = false;
    bf16_t* ACTo; const float* b1; bf16_t* Yo; const float* b2; const float* gate;
    __device__ __forceinline__ void operator()(const f32x4 (&acc)[2][2][4][2], const Unit& u, int wr, int wc, int fr, int fq) const {
        if (u.kind == 0) {
            const int row0 = u.orow + wr * 64 + fr, cl = wc * 32 + 8 * fq, col0 = u.ocol + cl;
            const float* bg = b1 + (size_t)u.e * 2048 + col0; const float* bu = bg + 1024;
            const f32x4 bg0 = *(const f32x4*)bg, bg1 = *(const f32x4*)(bg + 4), bu0 = *(const f32x4*)bu, bu1 = *(const f32x4*)(bu + 4);
#pragma unroll
            for (int ai = 0; ai < 2; ++ai)
#pragma unroll
                for (int m = 0; m < 4; ++m) {
                    f32x4 gv[2] = {acc[ai][0][m][0] + bg0, acc[ai][0][m][1] + bg1}, uv[2] = {acc[ai][1][m][0] + bu0, acc[ai][1][m][1] + bu1}; float o[8];
#pragma unroll
                    for (int n = 0; n < 2; ++n)
#pragma unroll
                        for (int i = 0; i < 4; ++i) { const float gg = fminf(gv[n][i], 7.f), uu = fminf(fmaxf(uv[n][i], -7.f), 7.f);
                            const float sg = __builtin_amdgcn_rcpf(1.f + __builtin_amdgcn_exp2f(-1.702f * 1.4426950408889634f * gg)); o[4 * n + i] = (uu + 1.f) * gg * sg; }
                    u32x4 w; w.x = cvt_pk_bf16(o[0], o[1]); w.y = cvt_pk_bf16(o[2], o[3]); w.z = cvt_pk_bf16(o[4], o[5]); w.w = cvt_pk_bf16(o[6], o[7]);
#if defined(FUSE_PLAIN_STORE)
                    *(u32x4*)(ACTo + (size_t)(row0 + ai * HALF + m * 16) * 1024 + col0) = w; }
#else
                    store16_sc1(ACTo + (size_t)(row0 + ai * HALF + m * 16) * 1024 + col0, w); }
#endif
        } else {
            const int row0 = u.orow + wr * 64 + fr, col0 = u.ocol + wc * 32 + 8 * fq;
            const float* bp = b2 + (size_t)u.e * 1024 + col0;
#pragma unroll
            for (int bj = 0; bj < 2; ++bj) {
                const f32x4 bv0 = *(const f32x4*)(bp + bj * HALF), bv1 = *(const f32x4*)(bp + bj * HALF + 4);
#pragma unroll
                for (int ai = 0; ai < 2; ++ai)
#pragma unroll
                    for (int m = 0; m < 4; ++m) { const int row = row0 + ai * HALF + m * 16; const float gt = gate[row];
                        const f32x4 v0 = (acc[ai][bj][m][0] + bv0) * gt, v1 = (acc[ai][bj][m][1] + bv1) * gt;
                        u32x4 w; w.x = cvt_pk_bf16(v0[0], v0[1]); w.y = cvt_pk_bf16(v0[2], v0[3]); w.z = cvt_pk_bf16(v1[0], v1[1]); w.w = cvt_pk_bf16(v1[2], v1[3]);
                        *(u32x4*)(Yo + (size_t)row * 1024 + col0 + bj * HALF) = w; asm volatile("" ::: "memory"); }
            }
        }
    }
};
}
typedef short v4i16_t __attribute__((ext_vector_type(4)));
__device__ __forceinline__ unsigned f2key_u(float f) { f = f + 0.0f; const unsigned u = __float_as_uint(f); return (u & 0x80000000u) ? ~u : (u | 0x80000000u); }

__device__ __forceinline__ void ph_cnorm_b(const bf16_t* pa, const float* g, bf16_t* cnb) {
  const int tid = TIDX(), lane = tid & 63, gw = BIDX() * 8 + (tid >> 6), NGW = (int)gridDim.x * 8;
  const f32x4 g4 = *(const f32x4*)(g + lane * 4);
  for (int row = gw; row < NT; row += NGW) {
    const v2u v = *(const v2u*)(pa + (size_t)row * 2048 + 1024 + lane * 4);
    const f32x4 f = (f32x4){bf_lo(v[0]), bf_hi(v[0]), bf_lo(v[1]), bf_hi(v[1])};
    const float r = rsqrtf(wave_sum((f[0] * f[0] + f[1] * f[1]) + (f[2] * f[2] + f[3] * f[3])) * (1.f / 256.f) + 1e-6f);
    const f32x4 o = f * r * g4;
    *(v2u*)(cnb + (size_t)row * 256 + lane * 4) = (v2u){cvt_pk_bf16(o[0], o[1]), cvt_pk_bf16(o[2], o[3])};
  }
}

__device__ __forceinline__ int moe_layer_tile(int layer, int j) { return j < 8192 ? layer * 8192 + j : 16384 + layer * 4096 + (j - 8192); }
__device__ __forceinline__ void moe_weight_tile(int T, const float* w1, const float* w2, bf16_t* W1_t, bf16_t* W2_t, int lane) {
  if (T < 16384) { const int le = T >> 8; transpose_tile(mk_tjob(w1 + (size_t)le * D * 2048, 2048, D, 2048, W1_t + (size_t)le * 2048 * D, D, 0, 0, 1), T & 255, lane); }
  else if (T < 24576) { const int t2 = T - 16384, le = t2 >> 7; transpose_tile(mk_tjob(w2 + (size_t)le * D * D, D, D, D, W2_t + (size_t)le * D * D, D, 0, 0, 0), t2 & 127, lane); }
}
typedef _Float16 h16x2_t __attribute__((ext_vector_type(2)));
typedef int i32x4_t __attribute__((ext_vector_type(4)));
__device__ __forceinline__ unsigned cvt_pk_f16(float lo, float hi) { const f32x2_t v = {lo, hi}; const h16x2_t h = __builtin_convertvector(v, h16x2_t); return __builtin_bit_cast(unsigned, h); }
constexpr int ISC_NU = 1088;
__device__ __forceinline__ void isc_decode(unsigned u, int& b, int& j, int& c) { b = (int)(u / 544u); int v = (int)u - b * 544; j = 63; while (v >= ((j + 4) >> 2)) { v -= (j + 4) >> 2; --j; } c = v; }
template <int HOT = 0> __device__ __forceinline__ void ph_iscore(const bf16_t* pa, const bf16_t* kib, unsigned short* sc, unsigned* ctr, LAS unsigned char* lds) {
  const int tid = TIDX(), lane = tid & 63, wave = __builtin_amdgcn_readfirstlane(tid >> 6);
  const int n16 = lane & 15, g = lane >> 4;
  volatile LAS unsigned* slot = (volatile LAS unsigned*)(lds + MISC_OFF + 80);
  __syncthreads();
  if (tid == 0) { slot[0] = __hip_atomic_fetch_add(ctr, 1u, __ATOMIC_RELAXED, __HIP_MEMORY_SCOPE_AGENT); slot[1] = __hip_atomic_fetch_add(ctr, 1u, __ATOMIC_RELAXED, __HIP_MEMORY_SCOPE_AGENT); }
  __syncthreads();
  unsigned cur = slot[0], nxt = slot[1];
  __syncthreads();
  const unsigned lofs = (unsigned)(n16 * 128 + 16 * (g ^ (n16 >> 1))), lofs1 = (unsigned)(n16 * 128 + 16 * ((4 + g) ^ (n16 >> 1)));
#define ISC_DMA(u_, pb_) { int b_, j_, c_; isc_decode((u_), b_, j_, c_); const bf16_t* src0 = kib + (size_t)(b_ * L + 512 * c_) * 64; \
    _Pragma("unroll") for (int i = 0; i < 8; ++i) { const int rl = 8 * (8 * wave + i) + (lane >> 3), ch = (lane & 7) ^ ((rl >> 1) & 7); \
      __builtin_amdgcn_global_load_lds((const unsigned*)(src0 + (size_t)rl * 64 + ch * 8), (LAS unsigned*)(lds + (pb_) * 65536 + (8 * wave + i) * 1024), 16, 0, 0); } }
  int pb = 0;
  bf16x8 qn[8][2], wvn;
#define ISC_QLOAD(u_) { int b_, j_, c_; isc_decode((u_), b_, j_, c_); const bf16_t* qr_ = pa + (size_t)(b_ * L + (8 * j_ + wave) * 16 + n16) * 2048; wvn = *(const bf16x8*)(qr_ + 1856); \
    _Pragma("unroll") for (int h = 0; h < 8; ++h) { qn[h][0] = *(const bf16x8*)(qr_ + 1280 + h * 64 + 8 * g); qn[h][1] = *(const bf16x8*)(qr_ + 1280 + h * 64 + 32 + 8 * g); } }
  if (cur < (unsigned)ISC_NU) { ISC_DMA(cur, 0) ISC_QLOAD(cur) }
  asm volatile("s_waitcnt vmcnt(0)" ::: "memory");
  __syncthreads();
  int itp = 0;
#pragma unroll 1
  while (cur < (unsigned)ISC_NU) {
    bf16x8 qf[8][2]; float w[8];
#pragma unroll
    for (int h = 0; h < 8; ++h) { qf[h][0] = qn[h][0]; qf[h][1] = qn[h][1]; w[h] = bf2f((bf16_t)wvn[h]) * (0.35355339059327373f * 0.125f); }
    if (nxt < (unsigned)ISC_NU) { ISC_DMA(nxt, pb ^ 1) ISC_QLOAD(nxt) }
    unsigned grabbed = 0u; if (tid == 0) grabbed = __hip_atomic_fetch_add(ctr, 1u, __ATOMIC_RELAXED, __HIP_MEMORY_SCOPE_AGENT);
    int b, j, c; isc_decode(cur, b, j, c);
    const int qg = 8 * j + wave, t0 = qg * 16, ntl = min(32, qg + 1 - 32 * c);
    unsigned short* srow = sc + (size_t)(HOT ? ((t0 + n16) & 63) : (b * L + t0 + n16)) * L + 4 * g + 32 * c * 16;
    const LAS unsigned char* kb0 = lds + pb * 65536 + lofs; const LAS unsigned char* kb1 = lds + pb * 65536 + lofs1;
#pragma unroll 1
    for (int tl = 0; tl < ntl; tl += 4) {
      bf16x8 k0[4], k1[4];
#pragma unroll
      for (int p = 0; p < 4; ++p) { k0[p] = *(const LAS bf16x8*)(kb0 + (tl + p) * 2048); k1[p] = *(const LAS bf16x8*)(kb1 + (tl + p) * 2048); }
#pragma unroll
      for (int p = 0; p < 4; ++p) {
        f32x4 score = (f32x4){0.f, 0.f, 0.f, 0.f};
#pragma unroll
        for (int h = 0; h < 8; h += 2) {
          f32x4 acc0 = __builtin_amdgcn_mfma_f32_16x16x32_bf16(k0[p], qf[h][0], (f32x4){0.f, 0.f, 0.f, 0.f}, 0, 0, 0);
          f32x4 acc1 = __builtin_amdgcn_mfma_f32_16x16x32_bf16(k0[p], qf[h + 1][0], (f32x4){0.f, 0.f, 0.f, 0.f}, 0, 0, 0);
          acc0 = __builtin_amdgcn_mfma_f32_16x16x32_bf16(k1[p], qf[h][1], acc0, 0, 0, 0);
          acc1 = __builtin_amdgcn_mfma_f32_16x16x32_bf16(k1[p], qf[h + 1][1], acc1, 0, 0, 0);
          const f32x4 r0 = __builtin_bit_cast(f32x4, __builtin_elementwise_max(__builtin_bit_cast(i32x4_t, acc0), (i32x4_t){0, 0, 0, 0}));
          const f32x4 r1 = __builtin_bit_cast(f32x4, __builtin_elementwise_max(__builtin_bit_cast(i32x4_t, acc1), (i32x4_t){0, 0, 0, 0}));
#pragma unroll
          for (int i = 0; i < 4; ++i) score[i] = fmaf(r1[i], w[h + 1], fmaf(r0[i], w[h], score[i]));
        }
        if (tl + p < ntl) *(v2u*)(srow + (tl + p) * 16) = (v2u){cvt_pk_f16(score[0], score[1]), cvt_pk_f16(score[2], score[3])};
      }
    }
    if (tid == 0) slot[itp] = grabbed;
    asm volatile("s_waitcnt vmcnt(0)" ::: "memory");
    __syncthreads();
    cur = nxt; nxt = slot[itp]; itp ^= 1; pb ^= 1;
  }
#undef ISC_DMA
#undef ISC_QLOAD
  __syncthreads();
}

constexpr int DW_STRIDE = 17152;
__device__ __forceinline__ unsigned offb(unsigned row, unsigned ch) { return 256u * row + 16u * (ch ^ (((row & 3u) << 2) | ((row >> 2) & 3u))); }
__device__ __forceinline__ void glds16(const void* gsrc, unsigned lds_dst) { unsigned keep;
  asm volatile("s_mov_b32 %0, m0\n\ts_mov_b32 m0, %2\n\ts_nop 0\n\tglobal_load_lds_dwordx4 %1, off\n\ts_mov_b32 m0, %0" : "=&s"(keep) : "v"(gsrc), "s"(lds_dst) : "memory"); }
__device__ __forceinline__ int wave_excl_scan(int v, int lane, int& total) {
  int x = v;
#pragma unroll
  for (int o = 1; o < 64; o <<= 1) { const int y = __shfl_up(x, o); if (lane >= o) x += y; }
  total = __shfl(x, 63); return x - v;
}
#define LDSW() asm volatile("s_waitcnt lgkmcnt(0)" ::: "memory")
__device__ __forceinline__ int wave_incl_scan_dpp(int v, int lane, int& total) {
  int x = v;
  x += __builtin_amdgcn_update_dpp(0, x, 0x111, 0xf, 0xf, true);
  x += __builtin_amdgcn_update_dpp(0, x, 0x112, 0xf, 0xf, true);
  x += __builtin_amdgcn_update_dpp(0, x, 0x114, 0xf, 0xf, true);
  x += __builtin_amdgcn_update_dpp(0, x, 0x118, 0xf, 0xf, true);
  const int t0 = __builtin_amdgcn_readlane(x, 15), t1 = __builtin_amdgcn_readlane(x, 31), t2 = __builtin_amdgcn_readlane(x, 47), t3 = __builtin_amdgcn_readlane(x, 63);
  const int row = lane >> 4;
  x += (row >= 1 ? t0 : 0) + (row >= 2 ? t1 : 0) + (row >= 3 ? t2 : 0);
  total = t0 + t1 + t2 + t3; return x;
}

__device__ __forceinline__ unsigned h2key(unsigned h) { return (h & 0x8000u) ? (~h & 0xFFFFu) : (h | 0x8000u); }
template <int MODE = 0> __device__ __forceinline__ int wave_select(const unsigned short* srow, int t, LAS unsigned char* wl, LAS unsigned short* idx16, int lane) {
  const int n = t + 1;
  if (n <= 256) { for (int i = lane; i < 256; i += 64) idx16[i] = (unsigned short)(i < n ? i : 0); LDSW(); return n; }
  LAS unsigned* hist = (LAS unsigned*)wl;
  for (int i = lane; i < 1024; i += 64) ((LAS v4u*)hist)[i] = (v4u){0u, 0u, 0u, 0u};
  unsigned bk[16][4];
#if defined(SEL_REP_LOAD)
#pragma unroll 1
  for (int rep_ = 0; rep_ < 2; ++rep_)
#endif
#pragma unroll
  for (int i = 0; i < 16; ++i) {
    bk[i][0] = 0u; bk[i][1] = 0u; bk[i][2] = 0u; bk[i][3] = 0u;
    if (i * 512 < n) { const int e0 = (i * 64 + lane) * 8;
      if (e0 < n) { const v4u f = *(const v4u*)(srow + e0);
#pragma unroll
        for (int c = 0; c < 4; ++c) { unsigned lo = f[c] & 0xFFFFu, hi = f[c] >> 16; lo = lo + 0u;
          const unsigned b0 = (e0 + 2 * c <= t) ? (h2key(lo == 0x8000u ? 0u : lo) >> 4) : 0u, b1 = (e0 + 2 * c + 1 <= t) ? (h2key(hi == 0x8000u ? 0u : hi) >> 4) : 0u;
          bk[i][c] = b0 | (b1 << 16); } } }
    if ((i & 7) == 7) asm volatile("" ::: "memory");
  }
#define BIN_OF(i, c) ((bk[i][(c) >> 1] >> (((c) & 1) * 16)) & 0xFFFFu)
  LDSW();
#if defined(SEL_REP_HIST)
#pragma unroll 1
  for (int rep_ = 0; rep_ < 2; ++rep_) {
  for (int i = lane; i < 1024; i += 64) ((LAS v4u*)hist)[i] = (v4u){0u, 0u, 0u, 0u};
  LDSW();
#endif
#pragma unroll
  for (int i = 0; i < 16; ++i) if (i * 512 < n) {
#pragma unroll
    for (int c = 0; c < 8; ++c) { const unsigned bin = BIN_OF(i, c); __hip_atomic_fetch_add(hist + bin, 1u, __ATOMIC_RELAXED, __HIP_MEMORY_SCOPE_WORKGROUP); }
    asm volatile("" ::: "memory"); }
  LDSW();
#if defined(SEL_REP_HIST)
  }
#endif
  if (MODE == 1) return 0;
  const int bbase = 4096 - 64 * (lane + 1); int ssum = 0;
#pragma unroll 16
  for (int k = 0; k < 64; ++k) ssum += (int)hist[bbase + ((k + lane) & 63)];
  int tot; const int pre = wave_incl_scan_dpp(ssum, lane, tot) - ssum;
  const unsigned long long bal = __ballot(pre < 256 && pre + ssum >= 256);
  const int Ls = (int)__builtin_ctzll(bal);
  const int cum0 = __builtin_amdgcn_readlane(pre, Ls), sb = 4096 - 64 * (Ls + 1);
  const int ck = (int)hist[sb + 63 - lane]; int t2_; const int inc = wave_incl_scan_dpp(ck, lane, t2_);
  const unsigned long long bal2 = __ballot(cum0 + inc >= 256);
  const int kk = (int)__builtin_ctzll(bal2);
  const int B1 = sb + 63 - kk, cnt_gt = cum0 + __builtin_amdgcn_readlane(inc, kk) - __builtin_amdgcn_readlane(ck, kk), need1 = 256 - cnt_gt;
  LDSW();
  if (MODE == 2) { idx16[lane] = (unsigned short)(B1 + need1); return 0; }
  const unsigned kg = (0x7FFFu - (unsigned)B1) * 0x00010001u, kge = kg + 0x00010001u;
  int ngt = 0, neq = 0;
#pragma unroll
  for (int i = 0; i < 16; ++i) if (i * 512 < n) {
#pragma unroll
    for (int c2 = 0; c2 < 4; ++c2) { const unsigned x = bk[i][c2], fg = (x + kg) & 0x80008000u, fe = ((x + kge) & 0x80008000u) & ~fg; ngt += __builtin_popcount(fg); neq += __builtin_popcount(fe); } }
  int tg, te; int pg = wave_incl_scan_dpp(ngt, lane, tg) - ngt; int pe = wave_incl_scan_dpp(neq, lane, te) - neq;
  LAS unsigned short* cand = (LAS unsigned short*)wl;
#pragma unroll
  for (int i = 0; i < 16; ++i) if (i * 512 < n) {
#pragma unroll
    for (int c2 = 0; c2 < 4; ++c2) { const unsigned x = bk[i][c2], fg = (x + kg) & 0x80008000u, fe = ((x + kge) & 0x80008000u) & ~fg; const int e = (i * 64 + lane) * 8 + 2 * c2;
      if (fg & 0x8000u) { idx16[pg] = (unsigned short)e; ++pg; }
      if (fg & 0x80000000u) { idx16[pg] = (unsigned short)(e + 1); ++pg; }
      if (fe & 0x8000u) { cand[pe] = (unsigned short)e; ++pe; }
      if (fe & 0x80000000u) { cand[pe] = (unsigned short)(e + 1); ++pe; } }
    asm volatile("" ::: "memory"); }
#undef BIN_OF
  LDSW();
  const int m = te;
  if (MODE == 3) return m;
  unsigned lo = 0u;
  if (m <= 64) {
    unsigned cpv = 0u; if (lane < m) { const unsigned ci = cand[lane]; unsigned hv = srow[ci]; hv = (hv == 0x8000u) ? 0u : hv; cpv = ((h2key(hv) & 15u) << 13) | (8191u - ci) | (1u << 20); }
    int rank = 0;
    for (int k = 0; k < m; ++k) { const unsigned ok = (unsigned)__builtin_amdgcn_readlane((int)cpv, k); rank += (ok > cpv) ? 1 : 0; }
    const bool sel = (lane < m) && (rank < need1);
    const unsigned long long bs = __ballot(sel);
    if (sel) idx16[cnt_gt + __builtin_popcountll(bs & ((1ull << lane) - 1ull))] = (unsigned short)(8191u - (cpv & 0x1FFFu));
  } else if (m <= 256) {
    unsigned cp[4];
#pragma unroll
    for (int j = 0; j < 4; ++j) { const int q = lane + 64 * j; cp[j] = 0u; if (q < m) { const unsigned ci = cand[q]; unsigned hv = srow[ci]; hv = (hv == 0x8000u) ? 0u : hv; cp[j] = ((h2key(hv) & 15u) << 13) | (8191u - ci) | (1u << 20); } }
    for (int bit = 16; bit >= 0; --bit) { const unsigned trial = lo | (1u << bit); int tc = 0;
#pragma unroll
      for (int j = 0; j < 4; ++j) tc += __builtin_popcountll(__ballot((cp[j] >> 20) && ((cp[j] & 0x1FFFFu) >= trial)));
      if (tc >= need1) lo = trial; }
    int pos = cnt_gt;
#pragma unroll
    for (int j = 0; j < 4; ++j) { const bool sel = (cp[j] >> 20) && ((cp[j] & 0x1FFFFu) >= lo); const unsigned long long bs = __ballot(sel);
      if (sel) idx16[pos + __builtin_popcountll(bs & ((1ull << lane) - 1ull))] = (unsigned short)(8191u - (cp[j] & 0x1FFFu)); pos += __builtin_popcountll(bs); }
  } else {
    for (int bit = 16; bit >= 0; --bit) { const unsigned trial = lo | (1u << bit); int c = 0;
      for (int q = lane; q < m; q += 64) { const unsigned ci = cand[q]; unsigned hv = srow[ci]; hv = (hv == 0x8000u) ? 0u : hv; const unsigned cpq = ((h2key(hv) & 15u) << 13) | (8191u - ci); c += (cpq >= trial) ? 1 : 0; }
      int tc; (void)wave_excl_scan(c, lane, tc); if (tc >= need1) lo = trial; }
    int base = cnt_gt;
    for (int q0 = 0; q0 < m; q0 += 64) { const int q = q0 + lane; bool sel = false; unsigned ci = 0;
      if (q < m) { ci = cand[q]; unsigned hv = srow[ci]; hv = (hv == 0x8000u) ? 0u : hv; const unsigned cpq = ((h2key(hv) & 15u) << 13) | (8191u - ci); sel = cpq >= lo; }
      int tc; const int pos = base + wave_excl_scan(sel ? 1 : 0, lane, tc); if (sel) idx16[pos] = (unsigned short)ci; base += tc; }
  }
  LDSW();
  return 256;
}

template <int HOT = 0> __device__ __forceinline__ void wave_attend(int b, int t, int cnt, const bf16_t* qlat, const bf16_t* cnb, LAS unsigned char* wl, LAS unsigned short* idx16, bf16_t* olat, int lane) {
  const int n16 = lane & 15, g = lane >> 4, q4 = (lane & 15) >> 2, p4 = lane & 3;
  const bf16_t* qrow = qlat + (size_t)(b * L + t) * 4096 + n16 * 256 + 8 * g;
  bf16x8 qf[8];
#pragma unroll
  for (int s = 0; s < 8; ++s) qf[s] = *(const bf16x8*)(qrow + 32 * s);
  f32x4 o[16];
#pragma unroll
  for (int c = 0; c < 16; ++c) o[c] = (f32x4){0.f, 0.f, 0.f, 0.f};
  float mrun = -INFINITY, lrun = 0.f;
  const int ntile = (cnt + 31) >> 5;
  const char* cb = (const char*)(cnb + (size_t)b * L * 256);
  const unsigned slot = lane & 15, rsub = lane >> 4;
  constexpr float SC = 0.125f * 1.4426950408889634f;
  v4u stg[16];
#define GATHER_TILE(itn) do { _Pragma("unroll") for (int rg = 0; rg < 8; ++rg) { const unsigned row = 4 * rg + rsub; const unsigned key = HOT ? (idx16[32 * (itn) + row] & 255u) : idx16[32 * (itn) + row]; \
      const unsigned ch = slot ^ (((row & 3u) << 2) | ((row >> 2) & 3u)); const unsigned off = key * 512u + ch * 16u;     \
      stg[rg] = *(const v4u*)(cb + off); stg[8 + rg] = *(const v4u*)(cb + off + 256u); } } while (0)
  GATHER_TILE(0);
#pragma unroll 1
  for (int it = 0; it < ntile; ++it) {
#pragma unroll
    for (int rg = 0; rg < 8; ++rg) { *(LAS v4u*)(wl + rg * 1024 + lane * 16) = stg[rg]; *(LAS v4u*)(wl + 8192 + rg * 1024 + lane * 16) = stg[8 + rg]; }
    LDSW();
    if (it + 1 < ntile) GATHER_TILE(it + 1);
    f32x4 s0 = (f32x4){0.f, 0.f, 0.f, 0.f}, s1 = (f32x4){0.f, 0.f, 0.f, 0.f};
    { bf16x8 fa[4];
#define QK_RD(s_, d0, d1) { const unsigned ib = ((s_) >> 2) * 8192, chq = 4 * ((s_) & 3) + g; d0 = *(const LAS bf16x8*)(wl + ib + offb(n16, chq)); d1 = *(const LAS bf16x8*)(wl + ib + offb(16 + n16, chq)); }
#pragma unroll
      for (int s = 0; s < 2; ++s) QK_RD(s, fa[2 * s], fa[2 * s + 1])
      __builtin_amdgcn_sched_barrier(0);
#pragma unroll
      for (int s = 0; s < 8; ++s) {
        s0 = __builtin_amdgcn_mfma_f32_16x16x32_bf16(fa[2 * (s & 1)], qf[s], s0, 0, 0, 0); s1 = __builtin_amdgcn_mfma_f32_16x16x32_bf16(fa[2 * (s & 1) + 1], qf[s], s1, 0, 0, 0);
        if (s < 6) QK_RD(s + 2, fa[2 * (s & 1)], fa[2 * (s & 1) + 1])
        __builtin_amdgcn_sched_barrier(0);
      } }
    const int sl0 = 32 * it + 4 * g;
    float mx = -INFINITY;
#pragma unroll
    for (int r = 0; r < 4; ++r) { s0[r] = (sl0 + r < cnt) ? s0[r] * SC : -INFINITY; s1[r] = (sl0 + 16 + r < cnt) ? s1[r] * SC : -INFINITY; mx = fmaxf(mx, fmaxf(s0[r], s1[r])); }
    { const auto r16 = __builtin_amdgcn_permlane16_swap(__float_as_uint(mx), __float_as_uint(mx), false, false); mx = fmaxf(__uint_as_float(r16[0]), __uint_as_float(r16[1]));
      const auto r32 = __builtin_amdgcn_permlane32_swap(__float_as_uint(mx), __float_as_uint(mx), false, false); mx = fmaxf(__uint_as_float(r32[0]), __uint_as_float(r32[1])); }
    const float mnew = fmaxf(mrun, mx), alpha = __builtin_amdgcn_exp2f(mrun - mnew);
    float ls = 0.f; float pv[8];
#pragma unroll
    for (int r = 0; r < 4; ++r) { pv[r] = __builtin_amdgcn_exp2f(s0[r] - mnew); pv[4 + r] = __builtin_amdgcn_exp2f(s1[r] - mnew); ls += pv[r] + pv[4 + r]; }
    lrun = lrun * alpha + ls; mrun = mnew;
#pragma unroll
    for (int c = 0; c < 16; ++c) o[c] = o[c] * alpha;
    const v4u pbw = (v4u){cvt_pk_bf16(pv[0], pv[1]), cvt_pk_bf16(pv[2], pv[3]), cvt_pk_bf16(pv[4], pv[5]), cvt_pk_bf16(pv[6], pv[7])};
    const bf16x8 pb = __builtin_bit_cast(bf16x8, pbw);
    { v4i16_t ft[4][2];
#define PV_RD(c_, d) { const unsigned ib = ((c_) >> 3) * 8192, chc = 2 * ((c_) & 7) + (p4 >> 1); \
        d[0] = __builtin_amdgcn_ds_read_tr16_b64_v4i16((LAS v4i16_t*)(wl + ib + offb(4 * g + q4, chc) + 8 * (p4 & 1))); \
        d[1] = __builtin_amdgcn_ds_read_tr16_b64_v4i16((LAS v4i16_t*)(wl + ib + offb(16 + 4 * g + q4, chc) + 8 * (p4 & 1))); }
#pragma unroll
      for (int c = 0; c < 4; ++c) PV_RD(c, ft[c])
      __builtin_amdgcn_sched_barrier(0);
#pragma unroll
      for (int c = 0; c < 16; ++c) { const v4i16_t t0 = ft[c & 3][0], t1 = ft[c & 3][1];
        const bf16x8 af = (bf16x8){t0[0], t0[1], t0[2], t0[3], t1[0], t1[1], t1[2], t1[3]};
        o[c] = __builtin_amdgcn_mfma_f32_16x16x32_bf16(af, pb, o[c], 0, 0, 0);
        if (c < 12) PV_RD(c + 4, ft[c & 3])
        __builtin_amdgcn_sched_barrier(0);
      } }
    LDSW();
  }
  lrun += __shfl_xor(lrun, 16); lrun += __shfl_xor(lrun, 32);
  const float inv = 1.f / lrun;
  bf16_t* orow = olat + (size_t)(b * L + t) * 4096 + n16 * 256 + 4 * g;
#pragma unroll
  for (int c = 0; c < 16; ++c) { const f32x4 v = o[c] * inv; *(v2u*)(orow + 16 * c) = (v2u){cvt_pk_bf16(v[0], v[1]), cvt_pk_bf16(v[2], v[3])}; }
}

__device__ __forceinline__ void ph_select_attend(const unsigned short* sc, const bf16_t* qlat, const bf16_t* cnb, bf16_t* olat, LAS unsigned char* lds, const float* w1, const float* w2, bf16_t* W1_t, bf16_t* W2_t, void* scratch_olat = nullptr) {
  const int tid = TIDX(), lane = tid & 63, wave = __builtin_amdgcn_readfirstlane(tid >> 6), blk = BIDX();
  LAS unsigned char* wl = lds + wave * DW_STRIDE; LAS unsigned short* idx16 = (LAS unsigned short*)(wl + 16384);
  LAS unsigned* qctr = (LAS unsigned*)(lds + MISC_OFF + 64);
  if (tid == 0) *qctr = 0u;
  __syncthreads();
  const int b = blk & 1, NGW = (int)gridDim.x * 8; (void)scratch_olat;
#pragma unroll 1
  for (;;) {
    unsigned item = 0u; if (lane == 0) item = __hip_atomic_fetch_add(qctr, 1u, __ATOMIC_RELAXED, __HIP_MEMORY_SCOPE_WORKGROUP);
    item = (unsigned)__builtin_amdgcn_readfirstlane((int)item);
    if (item >= 160u) break;
    const unsigned grp = item / 5u, r = item - grp * 5u;
    if (r == 0u || r == 3u) {
      const unsigned qn = grp * 2u + (r == 3u ? 1u : 0u);
      const int t = (blk >> 1) * 8 + (int)(qn & 7u) + 1024 * (7 - (int)(qn >> 3));
      int lane_s = lane; asm volatile("" : "+v"(lane_s));
#ifdef SELMODE
      { int lane_x = lane; asm volatile("" : "+v"(lane_x)); const int cx = wave_select<SELMODE>(sc + (size_t)(b * L + t) * L, t, wl, idx16, lane_x); if (cx == 12345) olat[0] = 0; }
#endif
      const int cnt = wave_select(sc + (size_t)(b * L + t) * L, t, wl, idx16, lane_s);
      int lane_a = lane; asm volatile("" : "+v"(lane_a));
      wave_attend(b, t, cnt, qlat, cnb, wl, idx16, olat, lane_a);
    } else {
      const unsigned cn = grp * 3u + (r == 1u ? 0u : (r == 2u ? 1u : 2u));
      const int wt = blk * 8 + (int)(cn & 7u) + (int)(cn >> 3) * NGW;
      int lane_t = lane; asm volatile("" : "+v"(lane_t));
      moe_weight_tile(wt < 12288 ? moe_layer_tile(0, wt) : moe_layer_tile(1, wt - 12288), w1, w2, W1_t, W2_t, lane_t);
    }
  }
}

__device__ __forceinline__ void ph_qlat(const bf16_t* pa, const bf16_t* WqT, bf16_t* qlat) {
  const int tid = TIDX(), lane = tid & 63, gw = BIDX() * 8 + (tid >> 6), NGW = (int)gridDim.x * 8;
  const int n16 = lane & 15, g = lane >> 4;
#pragma unroll 1
  for (int it = gw; it < 16 * 512; it += NGW) {
    const int h = it & 15, rt = it >> 4;
    bf16x8 qb[2][2];
#pragma unroll
    for (int mt = 0; mt < 2; ++mt)
#pragma unroll
      for (int ks = 0; ks < 2; ++ks) qb[mt][ks] = *(const bf16x8*)(pa + (size_t)(rt * 32 + mt * 16 + n16) * 2048 + h * 64 + 32 * ks + 8 * g);
    const bf16_t* wp = WqT + (size_t)h * 256 * 64 + (size_t)n16 * 64 + 8 * g;
    bf16_t* op = qlat + (size_t)(rt * 32 + n16) * 4096 + h * 256 + 4 * g;
#pragma unroll 4
    for (int ct = 0; ct < 16; ++ct) {
      const bf16x8 a0 = *(const bf16x8*)(wp + (size_t)(16 * ct) * 64), a1 = *(const bf16x8*)(wp + (size_t)(16 * ct) * 64 + 32);
#pragma unroll
      for (int mt = 0; mt < 2; ++mt) { f32x4 acc = __builtin_amdgcn_mfma_f32_16x16x32_bf16(a0, qb[mt][0], (f32x4){0.f, 0.f, 0.f, 0.f}, 0, 0, 0);
        acc = __builtin_amdgcn_mfma_f32_16x16x32_bf16(a1, qb[mt][1], acc, 0, 0, 0);
        *(v2u*)(op + (size_t)(mt * 16) * 4096 + 16 * ct) = (v2u){cvt_pk_bf16(acc[0], acc[1]), cvt_pk_bf16(acc[2], acc[3])}; }
    }
  }
}
__device__ __forceinline__ void ph_o2(const bf16_t* olat, const bf16_t* WuvT, bf16_t* o2b) {
  const int tid = TIDX(), lane = tid & 63, gw = BIDX() * 8 + (tid >> 6), NGW = (int)gridDim.x * 8;
  const int n16 = lane & 15, g = lane >> 4;
#pragma unroll 1
  for (int it = gw; it < 16 * 512; it += NGW) {
    const int h = it & 15, rt = it >> 4;
    f32x4 acc[4][2];
#pragma unroll
    for (int vt = 0; vt < 4; ++vt) { acc[vt][0] = (f32x4){0.f, 0.f, 0.f, 0.f}; acc[vt][1] = (f32x4){0.f, 0.f, 0.f, 0.f}; }
    const bf16_t* ap = olat + (size_t)(rt * 32 + n16) * 4096 + h * 256 + 8 * g;
    const bf16_t* wp = WuvT + (size_t)h * 64 * 256 + (size_t)n16 * 256 + 8 * g;
#pragma unroll
    for (int ks = 0; ks < 8; ++ks) {
      const bf16x8 b0 = *(const bf16x8*)(ap + 32 * ks), b1 = *(const bf16x8*)(ap + (size_t)16 * 4096 + 32 * ks);
#pragma unroll
      for (int vt = 0; vt < 4; ++vt) { const bf16x8 a = *(const bf16x8*)(wp + (size_t)(16 * vt) * 256 + 32 * ks);
        acc[vt][0] = __builtin_amdgcn_mfma_f32_16x16x32_bf16(a, b0, acc[vt][0], 0, 0, 0); acc[vt][1] = __builtin_amdgcn_mfma_f32_16x16x32_bf16(a, b1, acc[vt][1], 0, 0, 0); }
    }
    bf16_t* op = o2b + (size_t)(rt * 32 + n16) * 1024 + h * 64 + 4 * g;
#pragma unroll
    for (int vt = 0; vt < 4; ++vt)
#pragma unroll
      for (int mt = 0; mt < 2; ++mt) *(v2u*)(op + (size_t)(mt * 16) * 1024 + 16 * vt) = (v2u){cvt_pk_bf16(acc[vt][mt][0], acc[vt][mt][1]), cvt_pk_bf16(acc[vt][mt][2], acc[vt][mt][3])};
  }
}

namespace pg8 {
struct GroupAOrder {
    static constexpr bool GATHER = false; const int* rowmap;
    StaticOrder so; int png; size_t acol_bytes;
    __device__ void init(const void* A, int lda, const void* Bt, int ldb, int M, int N, int png_, size_t acol_bytes_, int G, int c) { so.init(A, lda, Bt, ldb, M, N, G, c); png = png_; acol_bytes = acol_bytes_; }
    __device__ bool next(int i, Unit& u) const { int pm, pn; if (!so.tile(i, pm, pn)) return false; u.pa = so.A + (size_t)pm * so.ta + (size_t)(pn / png) * acol_bytes; u.pb = so.Bt + (size_t)pn * so.tb; u.orow = pm * BM; u.ocol = pn * BM; u.e = 0; u.kind = 0; return true; }
    __device__ __forceinline__ int rowof(const Unit&, int r) const { return r; }
    __device__ __forceinline__ void a_ready(const Unit&) const {}
    __device__ __forceinline__ void done(const Unit&) const {}
};
}
constexpr int GLA_LDSU = 65536;

__device__ __forceinline__ v4i16_t trrd(LAS unsigned char* p) { return __builtin_amdgcn_ds_read_tr16_b64_v4i16((LAS v4i16_t*)p); }
__device__ __forceinline__ bf16x8 cat44(v4i16_t a, v4i16_t b) { return (bf16x8){a[0], a[1], a[2], a[3], b[0], b[1], b[2], b[3]}; }

__device__ __forceinline__ void ph_gla_a1(const bf16_t* pb, const float* gbias, bf16_t* qt, bf16_t* og, bf16_t* kvt, float* dcy, LAS unsigned char* lds, const float* w1, const float* w2, bf16_t* W1_t, bf16_t* W2_t) {
  const int tid = TIDX(), lane = tid & 63, wave = __builtin_amdgcn_readfirstlane(tid >> 6), blk = BIDX();
  const int half = wave >> 2, wq = wave & 3;
  LAS unsigned char* X = lds + half * GLA_LDSU; LAS unsigned char* Y = X + 16384; LAS unsigned char* V = X + 32768;
  LAS float* EX = (LAS float*)(lds + 131072 + half * 2048);
  const unsigned v_addr = (unsigned)__builtin_amdgcn_readfirstlane((int)(unsigned)(size_t)V);
  const int n16 = lane & 15, g = lane >> 4, q4 = (lane & 15) >> 2, p4 = lane & 3;
#pragma unroll 1
  for (int uu = 0; uu < 2; ++uu) {
    const int u = blk * 4 + half * 2 + uu;
    const int h = u & 3, bc = u >> 2, r0 = bc * 64;
    { const unsigned slot = lane & 15, rsub = lane >> 4; const int im = wq;
#pragma unroll
      for (int rg = 0; rg < 8; ++rg) { const unsigned row = 4 * rg + rsub; const unsigned ch = slot ^ (((row & 3u) << 2) | ((row >> 2) & 3u));
        const char* src = (const char*)(pb + (size_t)(r0 + 32 * (im >> 1) + row) * 3584 + 1024 + h * 256 + (im & 1) * 128) + ch * 16;
        glds16(src, v_addr + im * 8192 + rg * 1024); } }
    const int d0 = 2 * lane; const float gb0 = gbias[h * 128 + d0], gb1 = gbias[h * 128 + d0 + 1];
    const unsigned wofs = 16u * ((unsigned)(d0 >> 3)), wsub = (unsigned)(d0 & 7) * 2u;
    unsigned gq[16], qq[16], kq[16]; float bl0[16], bl1[16];
#pragma unroll
    for (int jj = 0; jj < 16; ++jj) { const bf16_t* rp = pb + (size_t)(r0 + wq * 16 + jj) * 3584 + h * 128 + d0;
      gq[jj] = *(const unsigned*)(rp + 3072); qq[jj] = *(const unsigned*)rp; kq[jj] = *(const unsigned*)(rp + 512); }
    float bc0 = 0.f, bc1 = 0.f;
#pragma unroll
    for (int jj = 0; jj < 16; ++jj) { const float a0 = bf_lo(gq[jj]) + gb0, a1 = bf_hi(gq[jj]) + gb1;
      bc0 += (fminf(a0, 0.f) - __logf(1.f + __expf(-fabsf(a0)))) * (1.f / 16.f); bc1 += (fminf(a1, 0.f) - __logf(1.f + __expf(-fabsf(a1)))) * (1.f / 16.f);
      bl0[jj] = bc0; bl1[jj] = bc1; }
    *(LAS f32x2_t*)(EX + wq * 128 + d0) = (f32x2_t){bc0, bc1};
    LDSW(); __syncthreads();
    float of0 = 0.f, of1 = 0.f, tt0 = 0.f, tt1 = 0.f;
#pragma unroll
    for (int w2_ = 0; w2_ < 4; ++w2_) { const f32x2_t e = *(const LAS f32x2_t*)(EX + w2_ * 128 + d0); tt0 += e[0]; tt1 += e[1]; if (w2_ < wq) { of0 += e[0]; of1 += e[1]; } }
#pragma unroll
    for (int jj = 0; jj < 16; ++jj) { const int j = wq * 16 + jj; const float b0 = bl0[jj] + of0, b1 = bl1[jj] + of1;
      const float e0 = __expf(b0), e1 = __expf(b1), i0 = __expf(fminf(-b0, 80.f)), i1 = __expf(fminf(-b1, 80.f));
      const unsigned qo = cvt_pk_bf16(bf_lo(qq[jj]) * 0.08838834764831845f * e0, bf_hi(qq[jj]) * 0.08838834764831845f * e1);
      const unsigned ko = cvt_pk_bf16(bf_lo(kq[jj]) * i0, bf_hi(kq[jj]) * i1);
      *(unsigned*)(qt + (size_t)(r0 + j) * 512 + h * 128 + d0) = qo;
      const unsigned row = (unsigned)(j & 31); const unsigned off = (unsigned)(j >> 5) * 8192u + 256u * row + ((wofs ^ (16u * (((row & 3u) << 2) | ((row >> 2) & 3u))))) + wsub;
      *(LAS unsigned*)(X + off) = qo; *(LAS unsigned*)(Y + off) = ko; }
    if (wq == 3) *(float2*)(dcy + (size_t)u * 128 + d0) = make_float2(__expf(tt0), __expf(tt1));
    asm volatile("s_waitcnt vmcnt(0) lgkmcnt(0)" ::: "memory");
    __syncthreads();
    const int it = wq;
    bf16x8 afr[2];
#pragma unroll
    for (int ks = 0; ks < 2; ++ks) {
      unsigned pk[4] = {0u, 0u, 0u, 0u};
#pragma unroll
      for (int jh = 0; jh < 2; ++jh) { const int jt = 2 * ks + jh;
        if (jt <= it) { f32x4 acc = (f32x4){0.f, 0.f, 0.f, 0.f};
#pragma unroll
          for (int s = 0; s < 4; ++s) { const bf16x8 ya = *(const LAS bf16x8*)(Y + (jt >> 1) * 8192 + offb(n16 + 16 * (jt & 1), 4 * s + g)), xb = *(const LAS bf16x8*)(X + (it >> 1) * 8192 + offb(n16 + 16 * (it & 1), 4 * s + g));
            acc = __builtin_amdgcn_mfma_f32_16x16x32_bf16(ya, xb, acc, 0, 0, 0); }
          const int i_ = 16 * it + n16, jbase = 16 * jt + 4 * g;
#pragma unroll
          for (int r = 0; r < 4; ++r) if (jbase + r > i_) acc[r] = 0.f;
          pk[2 * jh] = cvt_pk_bf16(acc[0], acc[1]); pk[2 * jh + 1] = cvt_pk_bf16(acc[2], acc[3]); } }
      afr[ks] = __builtin_bit_cast(bf16x8, (v4u){pk[0], pk[1], pk[2], pk[3]});
    }
    bf16_t* ogp = og + (size_t)u * 16384 + (size_t)(it * 16) * 256 + lane * 4; bf16_t* kvp = kvt + (size_t)u * 32768 + (size_t)n16 * 128 + 4 * g;
#pragma unroll 2
    for (int nt = 0; nt < 16; ++nt) {
      const unsigned vimg = (unsigned)(nt >> 3) * 8192u, chv = 2u * (unsigned)(nt & 7) + (unsigned)(p4 >> 1), sub = 8u * (unsigned)(p4 & 1);
      f32x4 acc = (f32x4){0.f, 0.f, 0.f, 0.f};
      { LAS unsigned char* vb = V + vimg; const bf16x8 bi0 = cat44(trrd(vb + offb(4 * g + q4, chv) + sub), trrd(vb + offb(16 + 4 * g + q4, chv) + sub));
        acc = __builtin_amdgcn_mfma_f32_16x16x32_bf16(afr[0], bi0, acc, 0, 0, 0); }
      if (it >= 2) { LAS unsigned char* vb = V + 16384 + vimg; const bf16x8 bi1 = cat44(trrd(vb + offb(4 * g + q4, chv) + sub), trrd(vb + offb(16 + 4 * g + q4, chv) + sub));
        acc = __builtin_amdgcn_mfma_f32_16x16x32_bf16(afr[1], bi1, acc, 0, 0, 0); }
      *(v2u*)(ogp + (size_t)nt * 256) = (v2u){cvt_pk_bf16(acc[0], acc[1]), cvt_pk_bf16(acc[2], acc[3])};
    }
#pragma unroll 1
    for (int nq = 0; nq < 4; ++nq) { const int nt = 4 * wq + nq;
      const unsigned vimg = (unsigned)(nt >> 3) * 8192u, chv = 2u * (unsigned)(nt & 7) + (unsigned)(p4 >> 1), sub = 8u * (unsigned)(p4 & 1);
      bf16x8 bn[2];
#pragma unroll
      for (int ks = 0; ks < 2; ++ks) { LAS unsigned char* vb = V + ks * 16384 + vimg; bn[ks] = cat44(trrd(vb + offb(8 * g + q4, chv) + sub), trrd(vb + offb(8 * g + 4 + q4, chv) + sub)); }
#pragma unroll
      for (int mt = 0; mt < 8; ++mt) { const unsigned chy = 2u * (unsigned)mt + (unsigned)(p4 >> 1);
        const bf16x8 a0 = cat44(trrd(Y + offb(8 * g + q4, chy) + sub), trrd(Y + offb(8 * g + 4 + q4, chy) + sub));
        const bf16x8 a1 = cat44(trrd(Y + 8192 + offb(8 * g + q4, chy) + sub), trrd(Y + 8192 + offb(8 * g + 4 + q4, chy) + sub));
        f32x4 acc = __builtin_amdgcn_mfma_f32_16x16x32_bf16(a0, bn[0], (f32x4){0.f, 0.f, 0.f, 0.f}, 0, 0, 0);
        acc = __builtin_amdgcn_mfma_f32_16x16x32_bf16(a1, bn[1], acc, 0, 0, 0);
        *(v2u*)(kvp + (size_t)(16 * nt) * 128 + 16 * mt) = (v2u){cvt_pk_bf16(acc[0], acc[1]), cvt_pk_bf16(acc[2], acc[3])}; }
    }
    LDSW(); __syncthreads();
  }
}

__device__ __forceinline__ void ph_gla_a2(const bf16_t* kvt, const float* dcy, bf16_t* spt) {
  const int gtid = BIDX() * NTHR + TIDX();
  if (gtid >= 8 * 256 * 32) return;
  const int g4 = gtid & 31, dv = (gtid >> 5) & 255, bh = gtid >> 13, b = bh >> 2, h = bh & 3;
  f32x4 S = (f32x4){0.f, 0.f, 0.f, 0.f};
#pragma unroll 4
  for (int c = 0; c < 128; ++c) { const size_t u = (size_t)((b * 128 + c) * 4 + h);
    const v2u kvb = *(const v2u*)(kvt + u * 32768 + (size_t)dv * 128 + 4 * g4); const f32x4 kv = (f32x4){bf_lo(kvb[0]), bf_hi(kvb[0]), bf_lo(kvb[1]), bf_hi(kvb[1])}, dc = *(const f32x4*)(dcy + u * 128 + 4 * g4);
    *(v2u*)(spt + u * 32768 + (size_t)dv * 128 + 4 * g4) = (v2u){cvt_pk_bf16(S[0], S[1]), cvt_pk_bf16(S[2], S[3])};
    S = dc * (S + kv); }
}

constexpr int A3_LD = 272;
__device__ __forceinline__ void ph_gla_a3(const bf16_t* pb, const bf16_t* qt, const bf16_t* og, const bf16_t* spt, const float* ng, bf16_t* ob, LAS unsigned char* lds) {
  const int tid = TIDX(), lane = tid & 63, wave = __builtin_amdgcn_readfirstlane(tid >> 6), gw = BIDX() * 8 + wave, NGW = (int)gridDim.x * 8;
  const int n16 = lane & 15, g = lane >> 4, row16 = lane >> 2, cq = lane & 3;
  LAS float* T = (LAS float*)(lds + wave * (16 * A3_LD * 4));
#pragma unroll 1
  for (int w = gw; w < 4096; w += NGW) {
    const int u = w >> 2, it = w & 3, h = u & 3, r0 = (u >> 2) * 64;
    const bf16_t* sp = spt + (size_t)u * 32768 + (size_t)n16 * 128 + 8 * g;
    bf16x8 qa[4];
#pragma unroll
    for (int ks = 0; ks < 4; ++ks) qa[ks] = *(const bf16x8*)(qt + (size_t)(r0 + 16 * it + n16) * 512 + h * 128 + 32 * ks + 8 * g);
    const bf16_t* ogp = og + (size_t)u * 16384 + (size_t)(it * 16) * 256 + lane * 4;
#pragma unroll
    for (int nt = 0; nt < 16; ++nt) {
      const v2u ogb = *(const v2u*)(ogp + nt * 256); f32x4 acc = (f32x4){bf_lo(ogb[0]), bf_hi(ogb[0]), bf_lo(ogb[1]), bf_hi(ogb[1])};
#pragma unroll
      for (int ks = 0; ks < 4; ++ks) { const bf16x8 sb = *(const bf16x8*)(sp + (size_t)(16 * nt) * 128 + 32 * ks); acc = __builtin_amdgcn_mfma_f32_16x16x32_bf16(qa[ks], sb, acc, 0, 0, 0); }
#pragma unroll
      for (int r = 0; r < 4; ++r) T[(4 * g + r) * A3_LD + 16 * nt + n16] = acc[r];
    }
    LDSW();
    const size_t row = (size_t)(r0 + 16 * it + row16);
    f32x4 v[16]; float ss = 0.f;
#pragma unroll
    for (int k = 0; k < 16; ++k) { v[k] = *(const LAS f32x4*)(T + row16 * A3_LD + 16 * k + 4 * cq); ss += (v[k][0] * v[k][0] + v[k][1] * v[k][1]) + (v[k][2] * v[k][2] + v[k][3] * v[k][3]); }
    ss += __shfl_xor(ss, 1); ss += __shfl_xor(ss, 2);
    const float rs = rsqrtf(ss * (1.f / 256.f) + 1e-6f);
#pragma unroll
    for (int k = 0; k < 16; ++k) { const int col = h * 256 + 16 * k + 4 * cq; const v2u rg = *(const v2u*)(pb + row * 3584 + 2048 + col); const f32x4 gn = *(const f32x4*)(ng + col);
      const float rr[4] = {bf_lo(rg[0]), bf_hi(rg[0]), bf_lo(rg[1]), bf_hi(rg[1])}; float o[4];
#pragma unroll
      for (int z = 0; z < 4; ++z) o[z] = v[k][z] * rs * gn[z] * (rr[z] * __builtin_amdgcn_rcpf(1.f + __expf(-rr[z])));
      *(v2u*)(ob + row * 1024 + col) = (v2u){cvt_pk_bf16(o[0], o[1]), cvt_pk_bf16(o[2], o[3])}; }
    LDSW();
  }
}
#ifndef PROBE
#define PROBE 0
#endif
#ifndef PROBE_S
#define PROBE_S 10.0f
#endif
constexpr size_t MiB = 1u << 20;
constexpr size_t WS_CTL = 0, CTL_ZERO_BYTES = 1 * MiB;
constexpr int CW_BAR = 4096, CW_TMO = 64, CW_RDY = 65536, CW_ISC = 1024;
constexpr size_t WS_NEEDED = 2048 * MiB;

struct Args { In in; float* out; unsigned char* ws; };

struct Opt { bf16_t *qt, *spt, *og, *kvt; float *dcy; bf16_t *Wql_t, *Wuv_t, *cnb, *kib, *qlat, *olat; unsigned short* sc; bf16_t *xb, *WA_t, *WoutA_t, *WB_t, *WoutB_t, *W1_t, *W2_t, *projA_b, *hbf, *o2b, *xs, *act, *Ys, *projB_b; MoeBufs m; };
__device__ __forceinline__ nvp::Ws carve_ws(unsigned char* ws) {
  nvp::Ws w; auto at = [&](size_t mib) { return (char*)ws + mib * MiB; };
  w.projA = (float*)at(2); w.cn = (float*)at(119); w.sc = (float*)at(135); w.idx = (int*)at(647); w.o2 = (float*)at(663);
  w.x1 = (float*)at(727); w.x2 = (float*)at(791);
  w.projB = (float*)at(135); w.adec = (float*)at(135 + 194); w.og = (float*)at(135 + 194 + 32); w.on = (float*)at(135 + 194 + 32 + 64);
  w.counts = nullptr; w.h = nullptr; w.hb = nullptr; w.ys = nullptr; w.tok_e = nullptr; w.tok_g = nullptr; w.slot_of = nullptr; w.row_tok = nullptr; w.row_gate = nullptr; w.blk_e = nullptr;
  return w;
}
__device__ __forceinline__ Opt carve_opt(unsigned char* ws) {
  Opt o; auto at = [&](size_t mib) { return (bf16_t*)((char*)ws + mib * MiB); };
  char* sm = (char*)ws + 855 * MiB;
  o.m.tok_e = (int*)sm; o.m.tok_g = (float*)(sm + 256 * 1024); o.m.slot_of = (int*)(sm + 512 * 1024); o.m.slot_gate = (float*)(sm + 768 * 1024); o.m.blk_e = (int*)(sm + 1088 * 1024); o.m.blkcnt = (int*)(sm + 1096 * 1024); o.m.nblk = (int*)(sm + 1160 * 1024); o.m.slot_tok = (int*)(sm + 1200 * 1024);
  o.WA_t = at(860); o.WoutA_t = at(864); o.WB_t = at(866); o.WoutB_t = at(873);
  o.Wql_t = at(875); o.Wuv_t = at(877); o.olat = at(2); o.cnb = at(647); o.kib = at(656); o.qlat = at(1856); o.sc = (unsigned short*)at(135);
  o.qt = at(135); o.dcy = (float*)at(151); o.og = at(152); o.kvt = at(216); o.spt = at(344);
  o.W1_t = at(880); o.W2_t = at(1136);
  o.xb = at(1264); o.projA_b = at(1296); o.hbf = at(1360); o.o2b = at(1392);
  o.xs = at(1424); o.act = at(1568); o.Ys = at(1712); o.projB_b = at(1856);
  return o;
}

struct ProIn { const float *a_w_uk, *a_w_uv, *x, *a_w_in, *a_w_out, *b_w_in, *b_w_g2, *b_w_out, *m_w1, *m_w2; };
__device__ __forceinline__ void ph_prologue(const ProIn I, const Opt& o) {
  const int tid = TIDX(), lane = tid & 63, gw = BIDX() * 8 + (tid >> 6), NGW = (int)gridDim.x * 8, gtid = BIDX() * NTHR + tid, NGT = (int)gridDim.x * NTHR;
  cvt_f32_to_bf16(I.x, D, o.xb, D, NT, D, gtid, NGT);
  zero_rect(o.WA_t, D, DINA, 2048 - DINA, 0, D * 2, gtid, NGT);
  for (int i = gtid; i < 512 * 256; i += NGT) { const int n = i >> 8, k4 = (i & 255) * 4; float a[4];
#pragma unroll
    for (int z = 0; z < 4; ++z) { const float* gl = I.b_w_in + (size_t)(k4 + z) * DINB + 2048; float s = 0.f;
#pragma unroll
      for (int j = 0; j < 16; ++j) s = fmaf(gl[j], I.b_w_g2[j * 512 + n], s);
      a[z] = s; }
    *(v2u*)(o.WB_t + (size_t)(3072 + n) * D + k4) = (v2u){cvt_pk_bf16(a[0], a[1]), cvt_pk_bf16(a[2], a[3])}; }
  int w0 = 0;
#pragma unroll 1
  for (int h = 0; h < 16; ++h) {
    transpose_job(mk_tjob(I.a_w_uk + (size_t)h * 64 * 256, 256, 64, 256, o.Wql_t, 256, h * 256, (h & 3) * 64, 0), w0, gw, NGW, lane);
    transpose_job(mk_tjob(I.a_w_uv + (size_t)h * 256 * 64, 64, 256, 64, o.Wuv_t, 1024, h * 64, (h & 3) * 256, 0), w0, gw, NGW, lane);
    for (int hp = 0; hp < 4; ++hp) if (hp != (h & 3)) { zero_rect(o.Wql_t, 256, h * 256, 256, hp * 128, 128, gtid, NGT); zero_rect(o.Wuv_t, 1024, h * 64, 64, hp * 512, 512, gtid, NGT); }
  }
  transpose_job(mk_tjob(I.a_w_in, DINA, D, DINA, o.WA_t, D, 0, 0, 0), w0, gw, NGW, lane);
  transpose_job(mk_tjob(I.a_w_out, D, D, D, o.WoutA_t, D, 0, 0, 0), w0, gw, NGW, lane);
  transpose_job(mk_tjob(I.b_w_in, DINB, D, 2048, o.WB_t, D, 0, 0, 0), w0, gw, NGW, lane);
  transpose_job(mk_tjob(I.b_w_in + 2064, DINB, D, 1024, o.WB_t, D, 2048, 0, 0), w0, gw, NGW, lane);
  transpose_job(mk_tjob(I.b_w_out, D, D, D, o.WoutB_t, D, 0, 0, 0), w0, gw, NGW, lane);
}
__device__ __forceinline__ void ph_gla_shim(const bf16_t* pb, const float* gbias, float* projB, float* adec) {
  const int gtid = BIDX() * NTHR + TIDX(), NGT = (int)gridDim.x * NTHR;
  for (size_t i = gtid; i < (size_t)NT * 896; i += NGT) { const size_t r = i / 896; const int c = (int)(i % 896) * 4; const v2u v = *(const v2u*)(pb + r * 3584 + c);
    const f32x4 f = (f32x4){bf_lo(v[0]), bf_hi(v[0]), bf_lo(v[1]), bf_hi(v[1])};
    if (c < 2048) *(f32x4*)(projB + r * DINB + c) = f;
    else if (c < 3072) *(f32x4*)(projB + r * DINB + 2064 + (c - 2048)) = f;
    else { f32x4 o;
#pragma unroll
      for (int z = 0; z < 4; ++z) { const float a = f[z] + gbias[c - 3072 + z]; const float ls = fminf(a, 0.f) - log1pf(expf(-fabsf(a))); o[z] = expf(ls * (1.f / 16.f)); }
      *(f32x4*)(adec + r * 512 + (c - 3072)) = o; } }
}

#if PROBE == 3
#define GLA_PHASES \
      PH_BEGIN ph_gla_shim(o.projB_b, I.b_g_bias, w.projB, w.adec); PH_END \
      GRID_BAR(); \
      PH_BEGIN nvp::np_gla_scan(w.projB, w.adec, w.og, fl); PH_END \
      GRID_BAR(); \
      PH_BEGIN nvp::np_gla_norm(w.og, w.projB, I.b_norm, w.on); PH_END \
      GRID_BAR(); \
      PH_BEGIN cvt_f32_to_bf16(w.on, D, o.o2b, D, NT, D, gtid_, NGT_); PH_END \
      GRID_BAR(); \
      PH_BEGIN ph_gla_a1(o.projB_b, I.b_g_bias, (bf16_t*)(wsb_ + 489 * MiB), (bf16_t*)(wsb_ + 506 * MiB), (bf16_t*)(wsb_ + 880 * MiB), (float*)(wsb_ + 505 * MiB), ll, I.m_w1, I.m_w2, o.W1_t, o.W2_t); PH_END \
      GRID_BAR(); \
      PH_BEGIN ph_gla_a2((bf16_t*)(wsb_ + 880 * MiB), (float*)(wsb_ + 505 * MiB), (bf16_t*)(wsb_ + 1136 * MiB)); PH_END \
      GRID_BAR(); \
      PH_BEGIN ph_gla_a3(o.projB_b, (bf16_t*)(wsb_ + 489 * MiB), (bf16_t*)(wsb_ + 506 * MiB), (bf16_t*)(wsb_ + 1136 * MiB), I.b_norm, (bf16_t*)(wsb_ + 570 * MiB), ll); PH_END \
      GRID_BAR(); \
      PH_BEGIN { unsigned* fl_ = (unsigned*)(wsb_ + 512 * 1024); unsigned bits = 0u; \
        { const bf16_t* a = (const bf16_t*)(wsb_ + 489 * MiB); for (size_t i = gtid_; i < (size_t)NT * 512; i += NGT_) { const float v = bf2f(a[i]); if (!(fabsf(v) < 1e30f)) bits |= 1u; } } \
        { const float* a = (const float*)(wsb_ + 506 * MiB); for (size_t i = gtid_; i < (size_t)NT * 1024; i += NGT_) { const float v = a[i]; if (!(fabsf(v) < 1e30f)) bits |= 2u; } } \
        { const float* a = (const float*)(wsb_ + 880 * MiB); for (size_t i = gtid_; i < (size_t)1024 * 32768; i += NGT_) { const float v = a[i]; if (!(fabsf(v) < 1e30f)) bits |= 4u; } } \
        { const bf16_t* a = (const bf16_t*)(wsb_ + 1136 * MiB); for (size_t i = gtid_; i < (size_t)1024 * 32768; i += NGT_) { const float v = bf2f(a[i]); if (!(fabsf(v) < 1e30f)) bits |= 8u; } } \
        { const bf16_t* a = (const bf16_t*)(wsb_ + 570 * MiB); for (size_t i = gtid_; i < (size_t)NT * 1024; i += NGT_) { const float v = bf2f(a[i]); if (!(fabsf(v) < 1e30f)) bits |= 16u; } } \
        { const float* a = (const float*)(wsb_ + 505 * MiB); for (size_t i = gtid_; i < (size_t)1024 * 128; i += NGT_) { const float v = a[i]; if (!(fabsf(v) < 1e30f)) bits |= 32u; } } \
        if (bits) atomicOr(fl_, bits); \
        { float* pd = (float*)(wsb_ + 1968 * MiB); const bf16_t* ob = (const bf16_t*)(wsb_ + 570 * MiB); for (size_t i = gtid_; i < (size_t)NT * D; i += NGT_) pd[i] = bf2f(ob[i]) - w.on[i]; } } PH_END \
      GRID_BAR();
#else
#define GLA_PHASES \
      PH_BEGIN ph_gla_a1(o.projB_b, I.b_g_bias, o.qt, o.og, o.kvt, o.dcy, ll, I.m_w1, I.m_w2, o.W1_t, o.W2_t); PH_END \
      GRID_BAR(); \
      PH_BEGIN ph_gla_a2(o.kvt, o.dcy, o.spt); PH_END \
      GRID_BAR(); \
      PH_BEGIN ph_gla_a3(o.projB_b, o.qt, o.og, o.spt, I.b_norm, o.o2b, ll); PH_END \
      GRID_BAR();
#endif
#if defined(FUSE_ON)
#define MOE_GEMM_PHASES(li) \
    PH_BEGIN pg8::MoeFusedOrder S; S.init(o.xs, o.act, o.W1_t + (size_t)li * 32 * 2048 * D, o.W2_t + (size_t)li * 32 * D * D, o.m.slot_tok, o.m.blk_e, (unsigned*)(wsb_ + WS_CTL) + CW_RDY + li * 32768, (unsigned*)(wsb_ + WS_CTL) + CW_TMO, __builtin_amdgcn_readfirstlane(*o.m.nblk), G_, BIDX()); S.mode = 0; \
      gemm_phase<pg8::EpiMoeFused, pg8::MoeFusedOrder, true, true>(ll, Gemm{D, D, D}, S, pg8::EpiMoeFused{o.act, I.m_b1 + (size_t)li * 32 * 2048, o.Ys, I.m_b2 + (size_t)li * 32 * D, o.m.slot_gate}); PH_END \
    GRID_BAR();
#else
#define MOE_GEMM_PHASES(li) \
    PH_BEGIN pg8::MoeOrderG S; S.init(o.xs, D, o.W1_t + (size_t)li * 32 * 2048 * D, D, (size_t)2048 * D * 2, __builtin_amdgcn_readfirstlane(*o.m.nblk), 8, 128, o.m.blk_e, G_, BIDX()); S.rowmap = o.m.slot_tok; \
      gemm_phase<pg8::EpiSwiglu, pg8::MoeOrderG, true, true>(ll, Gemm{D, D, D}, S, pg8::EpiSwiglu{o.act, D, I.m_b1 + (size_t)li * 32 * 2048}); PH_END \
    GRID_BAR(); \
    PH_BEGIN MoeOrder S; S.init(o.act, D, o.W2_t + (size_t)li * 32 * D * D, D, (size_t)D * D * 2, __builtin_amdgcn_readfirstlane(*o.m.nblk), 4, 256, o.m.blk_e, G_, BIDX()); \
      gemm_phase<pg8::EpiMoe2, MoeOrder, true, true>(ll, Gemm{D, D, D}, S, pg8::EpiMoe2{o.Ys, D, I.m_b2 + (size_t)li * 32 * D, o.m.slot_gate}); PH_END \
    GRID_BAR();
#endif
#ifdef LNR_MODE
#define LNR_EXTRA(li) PH_BEGIN if (li == 0) ph_ln_router<false, LNR_MODE>(I.x, o.hbf, I.ln1_g + li * D, I.ln1_b + li * D, I.m_w_router + (size_t)li * D * 32, I.m_b_router + li * 32, o.xs, o.m, fl); else ph_ln_router<true, LNR_MODE>(o.xb, o.hbf, I.ln1_g + li * D, I.ln1_b + li * D, I.m_w_router + (size_t)li * D * 32, I.m_b_router + li * 32, o.xs, o.m, fl); PH_END GRID_BAR();
#else
#define LNR_EXTRA(li)
#endif
#define LAYER_BODY(li) \
    if (li == 1) { \
      PH_BEGIN StaticOrder S; S.init(o.xb, D, o.WB_t, D, NT, 3584, G_, BIDX()); gemm_phase<EpiStore, StaticOrder, true, true>(ll, Gemm{D, D, D}, S, EpiStore{o.projB_b, 3584}); PH_END \
      GRID_BAR(); \
      GLA_PHASES \
      PH_BEGIN StaticOrder S; S.init(o.o2b, D, o.WoutB_t, D, NT, D, G_, BIDX()); gemm_phase<EpiStore, StaticOrder, true, true>(ll, Gemm{D, D, D}, S, EpiStore{o.hbf, D}); PH_END \
      GRID_BAR(); \
    } \
LNR_EXTRA(li) \
    PH_BEGIN if (li == 0) ph_ln_router<false>(I.x, o.hbf, I.ln1_g + li * D, I.ln1_b + li * D, I.m_w_router + (size_t)li * D * 32, I.m_b_router + li * 32, o.xs, o.m, fl); else ph_ln_router<true>(o.xb, o.hbf, I.ln1_g + li * D, I.ln1_b + li * D, I.m_w_router + (size_t)li * D * 32, I.m_b_router + li * 32, o.xs, o.m, fl); PH_END \
    GRID_BAR(); \
    PH_BEGIN ph_moe_scatter(o.m, (int*)lds); PH_END \
    GRID_BAR(); \
MOE_GEMM_PHASES(li) \
    PH_BEGIN ph_combine_ln(o.xs, o.Ys, o.m.slot_of, I.ln2_g + li * D, I.ln2_b + li * D, li == 0 ? nullptr : out_, li == 0 ? o.xb : nullptr); PH_END \
    if (li == 0) GRID_BAR();
__global__ void __launch_bounds__(NTHR, 2) mk_fwd(Args args) {
  extern __shared__ __attribute__((aligned(16))) unsigned char lds[];
  volatile LAS unsigned* MISC = (volatile LAS unsigned*)((LAS unsigned char*)lds + MISC_OFF);
  if (threadIdx.x < 32) MISC[threadIdx.x] = 0u;
  __syncthreads();
  XcdBarrier bar; { const __attribute__((address_space(4))) Args* ka0 = (const __attribute__((address_space(4))) Args*)__builtin_amdgcn_kernarg_segment_ptr(); bar = xcd_barrier_post((unsigned*)(ka0->ws + WS_CTL) + CW_BAR, MISC + 8); }
#define GRID_BAR() xcd_barrier(bar)
#define PH_BEGIN { const __attribute__((address_space(4))) Args* ka_ = (const __attribute__((address_space(4))) Args*)__builtin_amdgcn_kernarg_segment_ptr(); asm volatile("" : "+s"(ka_)); \
    float* const out_ = ka_->out; (void)out_; unsigned char* wsb_ = ka_->ws; const nvp::Ws w = carve_ws(wsb_); (void)w; const Opt o = carve_opt(wsb_); (void)o; \
    const int gtid_ = BIDX() * NTHR + TIDX(), NGT_ = (int)gridDim.x * NTHR; (void)gtid_; (void)NGT_; const int G_ = (int)gridDim.x; (void)G_;
#define PH_END }
#define I (ka_->in)
  float* fl = (float*)lds; LAS unsigned char* ll = (LAS unsigned char*)lds;
  using pg8::gemm_phase; using pg8::StaticOrder; using pg8::MoeOrder; using pg8::Gemm; using pg8::EpiStore;
  PH_BEGIN ph_prologue(ProIn{I.a_w_uk, I.a_w_uv, I.x, I.a_w_in, I.a_w_out, I.b_w_in, I.b_w_g2, I.b_w_out, I.m_w1, I.m_w2}, o); PH_END
  GRID_BAR();
  PH_BEGIN StaticOrder S; S.init(o.xb, D, o.WA_t, D, NT, 2048, G_, BIDX()); gemm_phase<pg8::EpiStoreKi, StaticOrder, true, true>(ll, Gemm{D, D, D}, S, pg8::EpiStoreKi{o.projA_b, 2048, o.kib, 1792}); PH_END
  GRID_BAR();
  PH_BEGIN ph_cnorm_b(o.projA_b, I.a_kv_norm, o.cnb); PH_END
  PH_BEGIN pg8::GroupAOrder S; S.init(o.projA_b, 2048, o.Wql_t, 256, NT, 4096, 4, 512, G_, BIDX()); gemm_phase<EpiStore, pg8::GroupAOrder, true, true>(ll, Gemm{2048, 256, 256}, S, EpiStore{o.qlat, 4096}); PH_END
#ifdef ISC_HOT
  PH_BEGIN ph_iscore<ISC_HOT>(o.projA_b, o.kib, (unsigned short*)o.act, (unsigned*)(wsb_ + WS_CTL) + CW_ISC + 64, ll); PH_END
  GRID_BAR();
#endif
  PH_BEGIN ph_iscore(o.projA_b, o.kib, o.sc, (unsigned*)(wsb_ + WS_CTL) + CW_ISC, ll); PH_END
  GRID_BAR();
  PH_BEGIN ph_select_attend(o.sc, o.qlat, o.cnb, o.olat, ll, I.m_w1, I.m_w2, o.W1_t, o.W2_t, o.act); PH_END
  GRID_BAR();
  PH_BEGIN pg8::GroupAOrder S; S.init(o.olat, 4096, o.Wuv_t, 1024, NT, 1024, 1, 2048, G_, BIDX()); gemm_phase<EpiStore, pg8::GroupAOrder, true, true>(ll, Gemm{4096, 1024, 1024}, S, EpiStore{o.o2b, D}); PH_END
  GRID_BAR();
#if PROBE == 2
  PH_BEGIN cvt_bf16_to_f32(o.projA_b, 2048, w.projA, DINA, NT, DINA, gtid_, NGT_); PH_END
  GRID_BAR();
  PH_BEGIN nvp::np_cnorm(w.projA, I.a_kv_norm, w.cn); PH_END
  PH_BEGIN nvp::np_iscore(w.projA, w.sc, fl); PH_END
  GRID_BAR();
  PH_BEGIN nvp::np_topk(w.sc, w.idx, (char*)lds); PH_END
  GRID_BAR();
  PH_BEGIN nvp::np_dsa_attn(w.projA, w.cn, w.idx, I.a_w_uk, I.a_w_uv, w.o2, fl); PH_END
  GRID_BAR();
  PH_BEGIN { float* pd = (float*)(wsb_ + 1968 * MiB); for (size_t i = gtid_; i < (size_t)NT * D; i += NGT_) pd[i] = bf2f(o.o2b[i]) - w.o2[i]; } PH_END
  GRID_BAR();
#endif
  PH_BEGIN StaticOrder S; S.init(o.o2b, D, o.WoutA_t, D, NT, D, G_, BIDX()); gemm_phase<EpiStore, StaticOrder, true, true>(ll, Gemm{D, D, D}, S, EpiStore{o.hbf, D}); PH_END
  GRID_BAR();
  { LAYER_BODY(0) }
  { LAYER_BODY(1) }
#if PROBE == 2 || PROBE == 3
  GRID_BAR();
#if PROBE == 3
  PH_BEGIN { if (gtid_ == 0) { const unsigned fb = *(const unsigned*)(wsb_ + 512 * 1024); out_[5] += (float)fb; } const float* pd = (const float*)(wsb_ + 1968 * MiB); for (size_t i = gtid_; i < (size_t)NT * D; i += NGT_) out_[i] += PROBE_S * pd[i]; } PH_END
#else
  PH_BEGIN { const float* pd = (const float*)(wsb_ + 1968 * MiB); for (size_t i = gtid_; i < (size_t)NT * D; i += NGT_) out_[i] += PROBE_S * pd[i]; } PH_END
#endif
#endif
}

extern "C" void kernel_launch(void* const* d_in, const int* in_sizes, int n_in, void* d_out, int out_size, void* d_ws, size_t ws_size, hipStream_t stream) {
  static int grid = 0;
  if (grid == 0) {
    if (n_in != 21 || ws_size < WS_NEEDED) { fprintf(stderr, "kernel_launch: bad inputs (n_in %d) or workspace too small (%zu needed, %zu given)\n", n_in, (size_t)WS_NEEDED, ws_size); grid = -1; return; }
    int dev = 0, cus = 0, per_cu = 0;
    if (hipGetDevice(&dev) != hipSuccess || hipDeviceGetAttribute(&cus, hipDeviceAttributeMultiprocessorCount, dev) != hipSuccess) { grid = -1; return; }
    if (hipFuncSetAttribute((const void*)mk_fwd, hipFuncAttributeMaxDynamicSharedMemorySize, LDS_BYTES) != hipSuccess) { fprintf(stderr, "kernel_launch: hipFuncSetAttribute failed\n"); grid = -1; return; }
    if (hipOccupancyMaxActiveBlocksPerMultiprocessor(&per_cu, (const void*)mk_fwd, NTHR, LDS_BYTES) != hipSuccess || per_cu < 1) fprintf(stderr, "kernel_launch: note: occupancy query reports %d\n", per_cu);
    (void)hipGetLastError();
    grid = cus;
    if (grid != 256) fprintf(stderr, "kernel_launch: built for 256 CUs (token ownership per workgroup); got %d\n", grid);
  }
  if (grid < 0) return;
  if (hipMemsetAsync((char*)d_ws + WS_CTL, 0, CTL_ZERO_BYTES, stream) != hipSuccess) { fprintf(stderr, "kernel_launch: memset failed\n"); return; }
  Args a; memset(&a, 0, sizeof(a));
  const float** f = (const float**)&a.in;
  for (int i = 0; i < 21; ++i) f[i] = (const float*)d_in[i];
  a.out = (float*)d_out; a.ws = (unsigned char*)d_ws;
  hipLaunchKernelGGL(mk_fwd, dim3(grid), dim3(NTHR), LDS_BYTES, stream, a);
  const hipError_t le = hipPeekAtLastError();
  if (le != hipSuccess) fprintf(stderr, "kernel_launch: launch failed: %s\n", hipGetErrorName(le));
}
```

```cpp
#include <hip/hip_runtime.h>
#include <cstdio>
#include <cstdint>
#include <cstring>

#define GAS __attribute__((address_space(1)))
#define LAS __attribute__((address_space(3)))
#define NTHR 512
constexpr int LDS_BYTES = 147456;
constexpr int MISC_OFF = 131072 + 8192;

#define XB_TMO      128
#define XB_XCNT(j)  (256  + 64 * (j))
#define XB_XSUB(j)  (1280 + 64 * (j))
#define XB_XGEN(j)  (2304 + 64 * (j))
#define XB_TOP      3328
#define XB_TOPGEN   3392
#define XCD_BAR_WORDS 3456
#define XB_SPIN_CAP (1u << 25)
__device__ __forceinline__ unsigned xb_ld(unsigned* p)              { return __hip_atomic_load(p, __ATOMIC_RELAXED, __HIP_MEMORY_SCOPE_AGENT); }
__device__ __forceinline__ unsigned xb_add(unsigned* p, unsigned v) { return __hip_atomic_fetch_add(p, v, __ATOMIC_RELAXED, __HIP_MEMORY_SCOPE_AGENT); }
__device__ __forceinline__ unsigned xb_xcc_id() { return (unsigned)__builtin_amdgcn_s_getreg((3 << 11) | 20) & 0xFu; }
#define XB_SPIN(cond, bar) do { unsigned _sp = 0; while (cond) { __builtin_amdgcn_s_sleep(1); \
    if ((++_sp & 255u) == 0u) { if (xb_ld(&(bar)[XB_TMO])) break; if (_sp > XB_SPIN_CAP) { atomicAdd(&(bar)[XB_TMO], 1u); break; } } } } while (0)
struct XcdBarrier { unsigned* bar; unsigned x; volatile LAS unsigned* st; };
__device__ __forceinline__ XcdBarrier xcd_barrier_post(unsigned* bar, volatile LAS unsigned* st) {
    XcdBarrier b; b.bar = bar; b.x = xb_xcc_id(); b.st = st;
    if (threadIdx.x == 0) (void)xb_add(&bar[XB_XCNT(b.x)], 1u);
    return b;
}
__device__ __forceinline__ void xcd_barrier_complete(unsigned* bar, unsigned x, unsigned& nloc, unsigned& nx) {
    const unsigned G = gridDim.x * gridDim.y * gridDim.z;
    unsigned sum, cnt, mine, sp = 0u;
    for (;;) {
        sum = 0u; cnt = 0u; mine = 0u;
#pragma unroll
        for (unsigned j = 0; j < 16; ++j) { const unsigned c = xb_ld(&bar[XB_XCNT(j)]); sum += c; cnt += (c > 0u) ? 1u : 0u; mine = (j == x) ? c : mine; }
        if (sum == G) break;
        __builtin_amdgcn_s_sleep(1);
        if ((++sp & 255u) == 0u) { if (xb_ld(&bar[XB_TMO])) break; if (sp > XB_SPIN_CAP) { atomicAdd(&bar[XB_TMO], 1u); break; } }
    }
    nloc = mine > 0u ? mine : 1u; nx = cnt > 0u ? cnt : 1u;
}
__device__ __forceinline__ void xcd_barrier(const XcdBarrier& b) {
    asm volatile("s_waitcnt vmcnt(0)" ::: "memory");
    __syncthreads();
    if (threadIdx.x == 0) {
        unsigned* bar = b.bar;
        __builtin_amdgcn_s_waitcnt(0);
        unsigned nloc = b.st[0], nx = b.st[1];
        if (nloc == 0u) { xcd_barrier_complete(bar, b.x, nloc, nx); b.st[0] = nloc; b.st[1] = nx; }
        const unsigned old = xb_add(&bar[XB_XSUB(b.x)], 1u);
        const unsigned gen = old / nloc;
        if (old + 1u == (gen + 1u) * nloc) {
            __builtin_amdgcn_fence(__ATOMIC_RELEASE, "agent");
            asm volatile("s_waitcnt vmcnt(0)" ::: "memory");
            const unsigned og = xb_add(&bar[XB_TOP], 1u);
            const unsigned tg = og / nx;
            if (og + 1u == (tg + 1u) * nx) xb_add(&bar[XB_TOPGEN], 1u);
            else XB_SPIN(xb_ld(&bar[XB_TOPGEN]) == tg, bar);
            __builtin_amdgcn_fence(__ATOMIC_ACQUIRE, "agent");
            xb_add(&bar[XB_XGEN(b.x)], 1u);
            asm volatile("s_waitcnt vmcnt(0)" ::: "memory");
        } else {
            XB_SPIN(xb_ld(&bar[XB_XGEN(b.x)]) == gen, bar);
            __builtin_amdgcn_fence(__ATOMIC_ACQUIRE, "agent");
            asm volatile("s_waitcnt vmcnt(0)" ::: "memory");
        }
    }
    __syncthreads();
}

constexpr int NT = 16384, D = 1024, L = 8192, NB = 2;
constexpr int DINA = 1864, DINB = 3088;
constexpr int PMAX = 73728;
constexpr float ALPHA = 1.4142135623730951f;

struct In { const float *x, *a_w_in, *a_kv_norm, *a_w_uk, *a_w_uv, *a_w_out, *b_w_in, *b_w_g2, *b_g_bias, *b_norm, *b_w_out, *m_w_router, *m_b_router, *m_w1, *m_b1, *m_w2, *m_b2, *ln1_g, *ln1_b, *ln2_g, *ln2_b; };

__device__ __forceinline__ int TIDX() { int t = threadIdx.x; asm volatile("" : "+v"(t)); return t; }
__device__ __forceinline__ int BIDX() { int t = blockIdx.x; asm volatile("" : "+s"(t)); return t; }
__device__ __forceinline__ float wave_sum(float v) {
#pragma unroll
    for (int o = 1; o < 64; o <<= 1) v += __shfl_xor(v, o);
    return v;
}
namespace nvp {
#define WSYNC() asm volatile("s_waitcnt lgkmcnt(0)" ::: "memory")
struct GemmP {
  const float* A; int lda; const int* arow;
  const float* B; int ldb; float* C; int ldc; int M, N, K;
  const int* blk_e; const int* nblk_used; size_t bstride; const float* bias; size_t bias_stride;
};
__device__ __forceinline__ GemmP mkg(const float* A, int lda, const int* arow, const float* B, int ldb, float* C, int ldc, int M, int N, int K, const int* blk_e, const int* nblk_used, size_t bstride, const float* bias, size_t bias_stride) {
  GemmP p; p.A = A; p.lda = lda; p.arow = arow; p.B = B; p.ldb = ldb; p.C = C; p.ldc = ldc; p.M = M; p.N = N; p.K = K; p.blk_e = blk_e; p.nblk_used = nblk_used; p.bstride = bstride; p.bias = bias; p.bias_stride = bias_stride; return p; }

template <int MODE>
__device__ __forceinline__ void np_sgemm(const GemmP p, float* lds) {
  float (*As)[132] = (float (*)[132])lds;
  float (*Bs)[68] = (float (*)[68])(lds + 16 * 132);
  float (*Bu)[68] = (float (*)[68])(lds + 16 * 132 + 16 * 68);
  const int tid = TIDX(), tx = tid & 15, ty = tid >> 4;
  const int ntn = (p.N + 63) / 64, ntm = p.M / 128;
  const int ar = tid >> 2, ak = (tid & 3) * 4;
  const int bk = (tid & 255) >> 4, bn4 = (tid & 15) * 4;
  for (int t = BIDX(); t < ntm * ntn; t += gridDim.x) {
    const int bm = t / ntn, bn = t % ntn;
    const float* B = p.B; const float* bias = p.bias;
    if (MODE != 0) { const int blk = (bm * 128) / 256; if (blk >= *p.nblk_used) continue; const int e = p.blk_e[blk]; B += (size_t)e * p.bstride; bias += (size_t)e * p.bias_stride; }
    const int m0 = bm * 128, n0 = bn * 64;
    const int arow = p.arow ? p.arow[m0 + ar] : (m0 + ar);
    const float* Ap = p.A + (size_t)arow * p.lda + ak;
    const bool bok = (n0 + bn4) < p.N;
    float acc[4][4] = {}, accu[4][4] = {};
    for (int k0 = 0; k0 < p.K; k0 += 16) {
      const float4 av = *(const float4*)(Ap + k0);
      As[ak + 0][ar] = av.x; As[ak + 1][ar] = av.y; As[ak + 2][ar] = av.z; As[ak + 3][ar] = av.w;
      if (tid < 256) { float4 bv = make_float4(0.f, 0.f, 0.f, 0.f); if (bok) bv = *(const float4*)(B + (size_t)(k0 + bk) * p.ldb + n0 + bn4); *(float4*)&Bs[bk][bn4] = bv; }
      else if (MODE == 1) { const float4 uv = *(const float4*)(B + (size_t)(k0 + bk) * p.ldb + 1024 + n0 + bn4); *(float4*)&Bu[bk][bn4] = uv; }
      __syncthreads();
#pragma unroll
      for (int kk = 0; kk < 16; ++kk) {
        const float4 a = *(const float4*)&As[kk][ty * 4];
        const float4 b = *(const float4*)&Bs[kk][tx * 4];
        const float aa[4] = {a.x, a.y, a.z, a.w}, bb[4] = {b.x, b.y, b.z, b.w};
#pragma unroll
        for (int i = 0; i < 4; ++i)
#pragma unroll
          for (int j = 0; j < 4; ++j) acc[i][j] = fmaf(aa[i], bb[j], acc[i][j]);
        if (MODE == 1) {
          const float4 u = *(const float4*)&Bu[kk][tx * 4]; const float uu[4] = {u.x, u.y, u.z, u.w};
#pragma unroll
          for (int i = 0; i < 4; ++i)
#pragma unroll
            for (int j = 0; j < 4; ++j) accu[i][j] = fmaf(aa[i], uu[j], accu[i][j]);
        }
      }
      __syncthreads();
    }
#pragma unroll
    for (int i = 0; i < 4; ++i) {
      const int m = m0 + ty * 4 + i;
#pragma unroll
      for (int j = 0; j < 4; ++j) {
        const int n = n0 + tx * 4 + j; if (n >= p.N) continue;
        float v = acc[i][j];
        if (MODE == 1) {
          float g = v + bias[n], u = accu[i][j] + bias[1024 + n];
          g = fminf(g, 7.f); u = fminf(fmaxf(u, -7.f), 7.f);
          const float glu = g / (1.f + expf(-1.702f * g));
          v = (u + 1.f) * glu;
        } else if (MODE == 2) v += bias[n];
        p.C[(size_t)m * p.ldc + n] = v;
      }
    }
  }
}

#define GW_INIT const int lane = TIDX() & 63, wave = TIDX() >> 6, gw = BIDX() * 8 + wave, NGW = gridDim.x * 8; (void)lane; (void)wave; (void)gw; (void)NGW

__device__ __forceinline__ void np_cnorm(const float* projA, const float* g, float* cn) {
  GW_INIT;
  for (int row = gw; row < NT; row += NGW) {
    const float4 v = *(const float4*)(projA + (size_t)row * DINA + 1024 + lane * 4);
    const float ss = wave_sum(v.x * v.x + v.y * v.y + v.z * v.z + v.w * v.w);
    const float r = rsqrtf(ss * (1.f / 256.f) + 1e-6f); const float4 g4 = *(const float4*)(g + lane * 4);
    *(float4*)(cn + (size_t)row * 256 + lane * 4) = make_float4(v.x * r * g4.x, v.y * r * g4.y, v.z * r * g4.z, v.w * r * g4.w);
  }
}

__device__ __forceinline__ void np_iscore(const float* projA, float* sc, float* lds) {
  float (*As)[132] = (float (*)[132])lds;
  float (*Bs)[68] = (float (*)[68])(lds + 16 * 132);
  const int tid = TIDX(), tx = tid & 15, ty = tid >> 4;
  const int ar = tid >> 2, ak = (tid & 3) * 4;
  const int br = (tid & 255) >> 2;
  for (int u = BIDX(); u < NB * 64 * 128; u += gridDim.x) {
    const int b = u / (64 * 128), tt = (u / 128) % 64, st = u % 128;
    if (st > 2 * tt + 1) continue;
    const int t0 = tt * 128, s0 = st * 64;
    const float* Qp = projA + (size_t)(b * L + t0 + ar) * DINA + 1280 + ak;
    const float* Kp = projA + (size_t)(b * L + s0 + br) * DINA + 1792 + ak;
    float score[4][4] = {};
    for (int h = 0; h < 8; ++h) {
      float acc[4][4] = {};
      for (int k0 = 0; k0 < 64; k0 += 16) {
        const float4 av = *(const float4*)(Qp + h * 64 + k0);
        As[ak + 0][ar] = av.x; As[ak + 1][ar] = av.y; As[ak + 2][ar] = av.z; As[ak + 3][ar] = av.w;
        if (tid < 256) { const float4 bv = *(const float4*)(Kp + k0); Bs[ak + 0][br] = bv.x; Bs[ak + 1][br] = bv.y; Bs[ak + 2][br] = bv.z; Bs[ak + 3][br] = bv.w; }
        __syncthreads();
#pragma unroll
        for (int kk = 0; kk < 16; ++kk) {
          const float4 a = *(const float4*)&As[kk][ty * 4]; const float4 bq = *(const float4*)&Bs[kk][tx * 4];
          const float aa[4] = {a.x, a.y, a.z, a.w}, bb[4] = {bq.x, bq.y, bq.z, bq.w};
#pragma unroll
          for (int i = 0; i < 4; ++i)
#pragma unroll
            for (int j = 0; j < 4; ++j) acc[i][j] = fmaf(aa[i], bb[j], acc[i][j]);
        }
        __syncthreads();
      }
#pragma unroll
      for (int i = 0; i < 4; ++i) {
        const float w = projA[(size_t)(b * L + t0 + ty * 4 + i) * DINA + 1856 + h] * 0.35355339059327373f;
#pragma unroll
        for (int j = 0; j < 4; ++j) score[i][j] += w * fmaxf(acc[i][j] * 0.125f, 0.f);
      }
    }
#pragma unroll
    for (int i = 0; i < 4; ++i)
#pragma unroll
      for (int j = 0; j < 4; ++j) sc[((size_t)(b * L + t0 + ty * 4 + i)) * L + s0 + tx * 4 + j] = score[i][j];
  }
}

__device__ __forceinline__ unsigned f2key(float f) { f = f + 0.0f; const unsigned u = __float_as_uint(f); return (u & 0x80000000u) ? ~u : (u | 0x80000000u); }

__device__ __forceinline__ void np_topk(const float* sc, int* idx_out, char* lds) {
  GW_INIT;
  unsigned* hist = (unsigned*)(lds + wave * 1280); unsigned* cntw = hist + 256;
  for (int row = gw; row < NT; row += NGW) {
    const int t = row % L, n = t + 1;
    const float* s = sc + (size_t)row * L; int* out = idx_out + (size_t)row * 256;
    if (n <= 256) { for (int i = lane; i < 256; i += 64) out[i] = i < n ? i : -1; continue; }
    unsigned prefix = 0, need = 256;
    for (int pass = 3; pass >= 0; --pass) {
      const int shift = pass * 8;
      for (int i = lane; i < 256; i += 64) hist[i] = 0;
      WSYNC();
      for (int i = lane; i < n; i += 64) { const unsigned k = f2key(s[i]); const bool m = (pass == 3) || ((k >> (shift + 8)) == (prefix >> (shift + 8))); if (m) atomicAdd(&hist[(k >> shift) & 255u], 1u); }
      WSYNC();
      unsigned cum = 0; int d = 255; for (; d > 0; --d) { const unsigned hv = hist[d]; if (cum + hv >= need) break; cum += hv; }
      prefix |= ((unsigned)d << shift); need -= cum;
      WSYNC();
    }
    if (lane == 0) *cntw = 0; WSYNC();
    for (int i = lane; i < n; i += 64) { if (f2key(s[i]) > prefix) { const unsigned pos = atomicAdd(cntw, 1u); out[pos] = i; } }
    WSYNC();
    if (lane == 0) { unsigned c = *cntw; unsigned nd = need; for (int i = 0; i < n && nd > 0; ++i) if (f2key(s[i]) == prefix) { out[c++] = i; --nd; } }
    WSYNC();
  }
}

__device__ __forceinline__ void np_dsa_attn(const float* projA, const float* cn, const int* idx, const float* w_uk, const float* w_uv, float* o2, float* lds) {
  const int half = TIDX() >> 8, tid = TIDX() & 255;
  float* base = lds + half * 14336;
  float* qs = base; float (*ql)[256] = (float (*)[256])(base + 1024); float (*pr)[257] = (float (*)[257])(base + 1024 + 4096);
  float (*ol)[256] = (float (*)[256])(base + 1024 + 4096 + 4112); float* red = base + 1024 + 4096 + 4112 + 4096; int* sid = (int*)(red + 16);
  for (int r0 = BIDX() * 2; r0 < NT; r0 += gridDim.x * 2) {
    const int row = r0 + half, b = row / L;
    __syncthreads();
    for (int i = tid; i < 1024; i += 256) qs[i] = projA[(size_t)row * DINA + i];
    sid[tid] = idx[(size_t)row * 256 + tid];
    __syncthreads();
    { const int c = tid;
#pragma unroll 1
      for (int h = 0; h < 16; ++h) { float a = 0.f;
#pragma unroll 8
        for (int d = 0; d < 64; ++d) a = fmaf(qs[h * 64 + d], w_uk[((size_t)h * 64 + d) * 256 + c], a); ql[h][c] = a; } }
    __syncthreads();
    { const int k = tid, key = sid[k];
      float lg[16];
      if (key >= 0) { const float* cr = cn + (size_t)(b * L + key) * 256;
        for (int h = 0; h < 16; ++h) lg[h] = 0.f;
#pragma unroll 2
        for (int c = 0; c < 256; ++c) { const float cv = cr[c];
#pragma unroll
          for (int h = 0; h < 16; ++h) lg[h] = fmaf(ql[h][c], cv, lg[h]); }
#pragma unroll
        for (int h = 0; h < 16; ++h) pr[h][k] = lg[h] * 0.125f;
      } else {
#pragma unroll
        for (int h = 0; h < 16; ++h) pr[h][k] = -INFINITY; } }
    __syncthreads();
    if (tid < 16) { const int h = tid; float m = -INFINITY; for (int k = 0; k < 256; ++k) m = fmaxf(m, pr[h][k]); float su = 0.f; for (int k = 0; k < 256; ++k) { const float e = expf(pr[h][k] - m); pr[h][k] = e; su += e; } red[h] = 1.f / su; }
    __syncthreads();
    { const int c = tid; float a[16];
#pragma unroll
      for (int h = 0; h < 16; ++h) a[h] = 0.f;
#pragma unroll 2
      for (int k = 0; k < 256; ++k) { const int key = sid[k]; if (key < 0) continue; const float cv = cn[(size_t)(b * L + key) * 256 + c];
#pragma unroll
        for (int h = 0; h < 16; ++h) a[h] = fmaf(pr[h][k], cv, a[h]); }
#pragma unroll
      for (int h = 0; h < 16; ++h) ol[h][c] = a[h] * red[h]; }
    __syncthreads();
#pragma unroll 1
    for (int o = tid; o < 1024; o += 256) { const int h = o >> 6, v = o & 63; float a = 0.f;
#pragma unroll 8
      for (int c = 0; c < 256; ++c) a = fmaf(ol[h][c], w_uv[((size_t)h * 256 + c) * 64 + v], a); o2[(size_t)row * 1024 + o] = a; }
  }
  __syncthreads();
}

__device__ __forceinline__ void np_ln_res(const float* x, const float* h, const float* g, const float* bb, float* out) {
  GW_INIT;
  for (int row = gw; row < NT; row += NGW) {
    float4 v[4]; float s = 0.f;
#pragma unroll
    for (int j = 0; j < 4; ++j) { const float4 a = *(const float4*)(x + (size_t)row * D + lane * 4 + 256 * j), hh = *(const float4*)(h + (size_t)row * D + lane * 4 + 256 * j);
      v[j] = make_float4(ALPHA * a.x + hh.x, ALPHA * a.y + hh.y, ALPHA * a.z + hh.z, ALPHA * a.w + hh.w); s += (v[j].x + v[j].y) + (v[j].z + v[j].w); }
    const float mu = wave_sum(s) * (1.f / D); float q = 0.f;
#pragma unroll
    for (int j = 0; j < 4; ++j) { v[j].x -= mu; v[j].y -= mu; v[j].z -= mu; v[j].w -= mu; q += (v[j].x * v[j].x + v[j].y * v[j].y) + (v[j].z * v[j].z + v[j].w * v[j].w); }
    const float r = rsqrtf(wave_sum(q) * (1.f / D) + 1e-5f);
#pragma unroll
    for (int j = 0; j < 4; ++j) { const int c = lane * 4 + 256 * j; const float4 g4 = *(const float4*)(g + c), b4 = *(const float4*)(bb + c);
      *(float4*)(out + (size_t)row * D + c) = make_float4(v[j].x * r * g4.x + b4.x, v[j].y * r * g4.y + b4.y, v[j].z * r * g4.z + b4.z, v[j].w * r * g4.w + b4.w); }
  }
}

__device__ __forceinline__ void np_router(const float* x, const float* wr, const float* br, int* tok_e, float* tok_g, int* counts, int* row_tok, char* lds) {
  GW_INIT;
  for (int i = BIDX() * NTHR + TIDX(); i < PMAX; i += gridDim.x * NTHR) row_tok[i] = 0;
  float* lg = (float*)(lds + wave * 256);
  const int e = lane & 31, hf = lane >> 5;
  for (int tok = gw; tok < NT; tok += NGW) {
    const float* xr = x + (size_t)tok * D + hf * 512; const float* wp = wr + (size_t)hf * 512 * 32 + e; float a = 0.f;
#pragma unroll 8
    for (int d = 0; d < 512; ++d) a = fmaf(xr[d], wp[d * 32], a);
    a += __shfl_xor(a, 32);
    if (hf == 0) lg[e] = a + br[e];
    WSYNC();
    if (lane == 0) { int ei[4]; float ev[4];
      for (int k = 0; k < 4; ++k) { int bi = 0; float bv = -INFINITY; for (int j = 0; j < 32; ++j) if (lg[j] > bv) { bv = lg[j]; bi = j; } ei[k] = bi; ev[k] = bv; lg[bi] = -INFINITY; }
      float su = 0.f, ex[4]; for (int k = 0; k < 4; ++k) { ex[k] = expf(ev[k] - ev[0]); su += ex[k]; }
      for (int k = 0; k < 4; ++k) { tok_e[tok * 4 + k] = ei[k]; tok_g[tok * 4 + k] = ex[k] / su; atomicAdd(&counts[ei[k]], 1); } }
    WSYNC();
  }
}
__device__ __forceinline__ void np_moe_sort(const int* tok_e, const float* tok_g, const int* counts, int* row_tok, float* row_gate, int* slot_of, int* blk_e, int* nblk_used, char* lds) {
  if (BIDX() != 0) return;
  const int e = TIDX(); int* pstart = (int*)lds; int* stage = pstart + 64;
  if (e == 0) { int acc = 0; for (int j = 0; j < 32; ++j) { pstart[j] = acc; const int nb = (counts[j] + 255) / 256; for (int q = 0; q < nb; ++q) blk_e[acc / 256 + q] = j; acc += nb * 256; } pstart[32] = acc; *nblk_used = acc / 256; }
  __syncthreads();
  int pos = e < 32 ? pstart[e] : 0;
  for (int c0 = 0; c0 < NT * 4; c0 += 2048) {
    __syncthreads();
    for (int i = e; i < 2048; i += NTHR) stage[i] = tok_e[c0 + i];
    __syncthreads();
    if (e < 32) for (int i = 0; i < 2048; ++i) if (stage[i] == e) { const int gi = c0 + i; row_tok[pos] = gi >> 2; row_gate[pos] = tok_g[gi]; slot_of[gi] = pos; ++pos; }
  }
  __syncthreads();
}
__device__ __forceinline__ void np_moe_combine_ln(const float* x1, const float* ys, const int* slot_of, const float* tok_g, const float* g, const float* bb, float* out) {
  GW_INIT;
  for (int row = gw; row < NT; row += NGW) {
    float4 v[4]; float s = 0.f; int sl[4]; float gg[4];
#pragma unroll
    for (int k = 0; k < 4; ++k) { sl[k] = slot_of[row * 4 + k]; gg[k] = tok_g[row * 4 + k]; }
#pragma unroll
    for (int j = 0; j < 4; ++j) { const int c = lane * 4 + 256 * j; float4 f = make_float4(0.f, 0.f, 0.f, 0.f);
#pragma unroll
      for (int k = 0; k < 4; ++k) { const float4 y = *(const float4*)(ys + (size_t)sl[k] * D + c); f.x += gg[k] * y.x; f.y += gg[k] * y.y; f.z += gg[k] * y.z; f.w += gg[k] * y.w; }
      const float4 a = *(const float4*)(x1 + (size_t)row * D + c);
      v[j] = make_float4(ALPHA * a.x + f.x, ALPHA * a.y + f.y, ALPHA * a.z + f.z, ALPHA * a.w + f.w); s += (v[j].x + v[j].y) + (v[j].z + v[j].w); }
    const float mu = wave_sum(s) * (1.f / D); float q = 0.f;
#pragma unroll
    for (int j = 0; j < 4; ++j) { v[j].x -= mu; v[j].y -= mu; v[j].z -= mu; v[j].w -= mu; q += (v[j].x * v[j].x + v[j].y * v[j].y) + (v[j].z * v[j].z + v[j].w * v[j].w); }
    const float r = rsqrtf(wave_sum(q) * (1.f / D) + 1e-5f);
#pragma unroll
    for (int j = 0; j < 4; ++j) { const int c = lane * 4 + 256 * j; const float4 g4 = *(const float4*)(g + c), b4 = *(const float4*)(bb + c);
      *(float4*)(out + (size_t)row * D + c) = make_float4(v[j].x * r * g4.x + b4.x, v[j].y * r * g4.y + b4.y, v[j].z * r * g4.z + b4.z, v[j].w * r * g4.w + b4.w); }
  }
}

__device__ __forceinline__ void np_gla_gate(const float* projB, const float* w_g2, const float* gb, float* adec) {
  GW_INIT;
  for (int row = gw; row < NT; row += NGW) {
    float glr[16];
#pragma unroll
    for (int j = 0; j < 16; ++j) glr[j] = projB[(size_t)row * DINB + 2048 + j];
    for (int c = lane; c < 512; c += 64) { float a = gb[c];
#pragma unroll
      for (int j = 0; j < 16; ++j) a = fmaf(glr[j], w_g2[j * 512 + c], a);
      const float ls = fminf(a, 0.f) - log1pf(expf(-fabsf(a))); adec[(size_t)row * 512 + c] = expf(ls * (1.f / 16.f)); }
  }
}
__device__ __forceinline__ void np_gla_scan(const float* projB, const float* adec, float* og, float* lds) {
  if (BIDX() >= 8) return;
  const int b = BIDX() >> 2, h = BIDX() & 3, tid = TIDX(), dv = tid & 255, dh = tid >> 8;
  float (*qs)[128] = (float (*)[128])lds; float (*ks)[128] = (float (*)[128])(lds + 2048); float (*as)[128] = (float (*)[128])(lds + 4096);
  float (*po)[16][256] = (float (*)[16][256])(lds + 6144);
  float S[64];
#pragma unroll
  for (int d = 0; d < 64; ++d) S[d] = 0.f;
  for (int t0 = 0; t0 < L; t0 += 16) {
    __syncthreads();
    for (int i = tid; i < 16 * 128; i += NTHR) { const int tt = i >> 7, d = i & 127; const size_t r = (size_t)(b * L + t0 + tt);
      qs[tt][d] = projB[r * DINB + h * 128 + d] * 0.08838834764831845f; ks[tt][d] = projB[r * DINB + 512 + h * 128 + d]; as[tt][d] = adec[r * 512 + h * 128 + d]; }
    __syncthreads();
#pragma unroll 1
    for (int tt = 0; tt < 16; ++tt) { const size_t r = (size_t)(b * L + t0 + tt); const float v = projB[r * DINB + 1024 + h * 256 + dv]; float o = 0.f;
#pragma unroll
      for (int d = 0; d < 64; ++d) { S[d] = fmaf(as[tt][dh * 64 + d], S[d], ks[tt][dh * 64 + d] * v); o = fmaf(qs[tt][dh * 64 + d], S[d], o); }
      po[dh][tt][dv] = o; }
    __syncthreads();
    for (int i = tid; i < 16 * 256; i += NTHR) { const int tt = i >> 8, c = i & 255; og[(size_t)(b * L + t0 + tt) * 1024 + h * 256 + c] = po[0][tt][c] + po[1][tt][c]; }
  }
  __syncthreads();
}
__device__ __forceinline__ void np_gla_norm(const float* og, const float* projB, const float* ng, float* on) {
  GW_INIT;
  for (int u = gw; u < NT * 4; u += NGW) {
    const int row = u >> 2, h = u & 3; const int c = h * 256 + lane * 4;
    const float4 v = *(const float4*)(og + (size_t)row * 1024 + c);
    const float r = rsqrtf(wave_sum(v.x * v.x + v.y * v.y + v.z * v.z + v.w * v.w) * (1.f / 256.f) + 1e-6f);
    const float4 rr = *(const float4*)(projB + (size_t)row * DINB + 2064 + c), g4 = *(const float4*)(ng + c);
    *(float4*)(on + (size_t)row * 1024 + c) = make_float4(v.x * r * g4.x * (rr.x / (1.f + expf(-rr.x))), v.y * r * g4.y * (rr.y / (1.f + expf(-rr.y))), v.z * r * g4.z * (rr.z / (1.f + expf(-rr.z))), v.w * r * g4.w * (rr.w / (1.f + expf(-rr.w))));
  }
}

struct Ws { float *projA, *cn, *sc, *o2, *h, *x1, *x2, *hb, *ys, *projB, *adec, *og, *on, *tok_g, *row_gate; int *idx, *tok_e, *slot_of, *row_tok, *blk_e, *counts; };
}
typedef unsigned short bf16_t;
typedef unsigned v4u __attribute__((ext_vector_type(4)));
typedef unsigned v2u __attribute__((ext_vector_type(2)));
typedef float f32x4 __attribute__((ext_vector_type(4)));
typedef short bf16x8 __attribute__((ext_vector_type(8)));
typedef float f32x2_t __attribute__((ext_vector_type(2))); typedef __bf16 bf16x2_t __attribute__((ext_vector_type(2)));
__device__ __forceinline__ unsigned cvt_pk_bf16(float lo, float hi) { const f32x2_t v = {lo, hi}; const bf16x2_t b = __builtin_convertvector(v, bf16x2_t); return __builtin_bit_cast(unsigned, b); }
__device__ __forceinline__ float bf_lo(unsigned u) { return __uint_as_float(u << 16); }
__device__ __forceinline__ float bf_hi(unsigned u) { return __uint_as_float(u & 0xffff0000u); }
__device__ __forceinline__ float bf2f(bf16_t h) { return __uint_as_float(((unsigned)h) << 16); }

struct TJob { const float* src; int lds_; int K, N; bf16_t* dst; int ldd; int drow0, dcol0; int rowmap; int ntk, ntn; };
__device__ __forceinline__ TJob mk_tjob(const float* src, int lds_, int K, int N, bf16_t* dst, int ldd, int drow0, int dcol0, int rowmap) {
  TJob j; j.src = src; j.lds_ = lds_; j.K = K; j.N = N; j.dst = dst; j.ldd = ldd; j.drow0 = drow0; j.dcol0 = dcol0; j.rowmap = rowmap; j.ntk = K / 64; j.ntn = (N + 127) / 128; return j; }
__device__ __forceinline__ int tjob_tiles(const TJob& j) { return j.ntk * j.ntn; }
__device__ __forceinline__ void transpose_tile(const TJob& j, int tile, int lane) {
  const int kt = tile / j.ntn, nt_ = tile % j.ntn, k0 = kt * 64, n0 = nt_ * 128;
  const int q = lane & 31, par = lane >> 5;
  const bool ok = (n0 + 4 * q) < j.N;
  f32x4 v[32];
  const float* sp = j.src + (size_t)(k0 + par) * j.lds_ + n0 + 4 * q;
#pragma unroll
  for (int i = 0; i < 32; ++i) v[i] = ok ? *(const f32x4*)(sp + (size_t)(2 * i) * j.lds_) : (f32x4){0.f, 0.f, 0.f, 0.f};
  unsigned ra[32], rb[32];
#pragma unroll
  for (int i = 0; i < 32; ++i) {
    auto s0 = __builtin_amdgcn_permlane32_swap(__float_as_uint(v[i][0]), __float_as_uint(v[i][2]), false, false);
    auto s1 = __builtin_amdgcn_permlane32_swap(__float_as_uint(v[i][1]), __float_as_uint(v[i][3]), false, false);
    ra[i] = cvt_pk_bf16(__uint_as_float(s0[0]), __uint_as_float(s0[1]));
    rb[i] = cvt_pk_bf16(__uint_as_float(s1[0]), __uint_as_float(s1[1]));
  }
  if (ok) {
    const int n = n0 + 4 * q + 2 * par;
    int r0 = n, r1 = n + 1;
    if (j.rowmap == 1) { const int jj0 = r0 & 1023, jj1 = r1 & 1023; r0 = 256 * (jj0 >> 7) + ((r0 >> 10) << 7) + (jj0 & 127); r1 = 256 * (jj1 >> 7) + ((r1 >> 10) << 7) + (jj1 & 127); }
    bf16_t* d0 = j.dst + (size_t)(j.drow0 + r0) * j.ldd + j.dcol0 + k0;
    bf16_t* d1 = j.dst + (size_t)(j.drow0 + r1) * j.ldd + j.dcol0 + k0;
#pragma unroll
    for (int c = 0; c < 8; ++c) { *(v4u*)(d0 + 8 * c) = (v4u){ra[4 * c], ra[4 * c + 1], ra[4 * c + 2], ra[4 * c + 3]}; *(v4u*)(d1 + 8 * c) = (v4u){rb[4 * c], rb[4 * c + 1], rb[4 * c + 2], rb[4 * c + 3]}; }
  }
}
__device__ __forceinline__ void transpose_job(const TJob j, int& w0, int gw, int NGW, int lane) {
  const int nt_ = tjob_tiles(j);
  int first = gw - (w0 % NGW); if (first < 0) first += NGW;
#pragma unroll 1
  for (int t = first; t < nt_; t += NGW) transpose_tile(j, t, lane);
  w0 += nt_;
}
__device__ __forceinline__ void zero_rect(bf16_t* dst, int ldd, int r0, int nr, int cb0, int nbytes, int gtid, int NGT) {
  const int per = nbytes / 16;
  for (int i = gtid; i < nr * per; i += NGT) { const int r = i / per, c = i % per; *(v4u*)((char*)(dst + (size_t)(r0 + r) * ldd) + cb0 + 16 * c) = (v4u){0u, 0u, 0u, 0u}; }
}
__device__ __forceinline__ void cvt_f32_to_bf16(const float* src, int lds_, bf16_t* dst, int ldd, int rows, int ncols, int gtid, int NGT) {
  const int per = ncols / 4;
  for (size_t i = gtid; i < (size_t)rows * per; i += NGT) { const size_t r = i / per; const int c = (int)(i % per) * 4; const f32x4 v = *(const f32x4*)(src + r * lds_ + c);
    *(v2u*)(dst + r * ldd + c) = (v2u){cvt_pk_bf16(v[0], v[1]), cvt_pk_bf16(v[2], v[3])}; }
}
__device__ __forceinline__ void cvt_bf16_to_f32(const bf16_t* src, int lds_, float* dst, int ldd, int rows, int ncols, int gtid, int NGT) {
  const int per = ncols / 4;
  for (size_t i = gtid; i < (size_t)rows * per; i += NGT) { const size_t r = i / per; const int c = (int)(i % per) * 4; const v2u v = *(const v2u*)(src + r * lds_ + c);
    *(f32x4*)(dst + r * ldd + c) = (f32x4){bf_lo(v[0]), bf_hi(v[0]), bf_lo(v[1]), bf_hi(v[1])}; }
}

namespace pg8 {
#define PG8_LAS __attribute__((address_space(3)))
typedef unsigned u32x4 __attribute__((ext_vector_type(4)));
constexpr int BM = 256, BK = 64, HALF = 128, HTB = HALF * BK * 2, STAGE_BYTES = 8 * HTB, NXCD = 8, WGM = 8;
__host__ __device__ __forceinline__ int lds_byte(int r, int c) { const int st = (r >> 4) * 2 + (c >> 5), rr = r & 15, cc = c & 31, ob = rr * 64 + cc * 2; return st * 1024 + (ob ^ (((ob >> 9) & 1) << 5)); }
__host__ __device__ __forceinline__ void stage_rc(int b, int& R, int& C) { const int st = b / 1024, sb = b % 1024, swz = sb ^ (((sb >> 9) & 1) << 5); R = (st >> 1) * 16 + swz / 64; C = (st & 1) * 32 + (swz % 64) / 2; }
__host__ __device__ __forceinline__ int perm32(int rho) { const int n = rho >> 4, i = rho & 15; return 8 * (i >> 2) + 4 * n + (i & 3); }
struct Unit { const char* pa; const char* pb; int orow, ocol, e, kind; };
struct Gemm { int lda, ldb, K; };
struct StaticOrder {
    static constexpr bool GATHER = false; const int* rowmap;
    const char* A; const char* Bt; size_t ta, tb; int nM, nN, nwg, G, c;
    __device__ void init(const void* A_, int lda, const void* Bt_, int ldb, int M, int N, int G_, int c_) { A = (const char*)A_; Bt = (const char*)Bt_; ta = (size_t)BM * lda * 2; tb = (size_t)BM * ldb * 2; nM = M / BM; nN = N / BM; nwg = nM * nN; G = G_; c = c_; }
    __device__ bool tile(int i, int& pm, int& pn) const {
        const long L = (long)i * G + c; if (L >= nwg) return false;
        int wgid = (int)L; { const int q = nwg / NXCD, r = nwg % NXCD, xcd = wgid % NXCD, off = wgid / NXCD; wgid = (xcd < r ? xcd * (q + 1) : r * (q + 1) + (xcd - r) * q) + off; }
        const int nig = WGM * nN, gid = wgid / nig, fm = gid * WGM, gsz = (nM - fm) < WGM ? (nM - fm) : WGM;
        pm = fm + ((wgid % nig) % gsz); pn = (wgid % nig) / gsz; return true;
    }
    __device__ bool next(int i, Unit& u) const { int pm, pn; if (!tile(i, pm, pn)) return false; u.pa = A + (size_t)pm * ta; u.pb = Bt + (size_t)pn * tb; u.orow = pm * BM; u.ocol = pn * BM; u.e = 0; u.kind = 0; return true; }
    __device__ __forceinline__ int rowof(const Unit&, int r) const { return r; }
    __device__ __forceinline__ void a_ready(const Unit&) const {}
    __device__ __forceinline__ void done(const Unit&) const {}
};
struct EpiStore {
    static constexpr bool PERM = true, AFTER_DRAIN = false;
    bf16_t* O; int ldc;
    __device__ __forceinline__ void operator()(const f32x4 (&acc)[2][2][4][2], const Unit& u, int wr, int wc, int fr, int fq) const {
        const int row0 = u.orow + wr * 64 + fr, col0 = u.ocol + wc * 32 + 8 * fq;
#pragma unroll
        for (int ai = 0; ai < 2; ++ai)
#pragma unroll
            for (int m = 0; m < 4; ++m) { bf16_t* rowp = O + (size_t)(row0 + ai * HALF + m * 16) * ldc + col0;
#pragma unroll
                for (int bj = 0; bj < 2; ++bj) { const f32x4 v0 = acc[ai][bj][m][0], v1 = acc[ai][bj][m][1];
                    u32x4 w; w.x = cvt_pk_bf16(v0[0], v0[1]); w.y = cvt_pk_bf16(v0[2], v0[3]); w.z = cvt_pk_bf16(v1[0], v1[1]); w.w = cvt_pk_bf16(v1[2], v1[3]);
                    *(u32x4*)(rowp + bj * HALF) = w; } }
    }
};
struct EpiStoreKi {
    static constexpr bool PERM = true, AFTER_DRAIN = false;
    bf16_t* O; int ldc; bf16_t* Ki; int kcol;
    __device__ __forceinline__ void operator()(const f32x4 (&acc)[2][2][4][2], const Unit& u, int wr, int wc, int fr, int fq) const {
        const int row0 = u.orow + wr * 64 + fr, col0 = u.ocol + wc * 32 + 8 * fq;
        const bool kt = (u.ocol == kcol) && (wc < 2);
#pragma unroll
        for (int ai = 0; ai < 2; ++ai)
#pragma unroll
            for (int m = 0; m < 4; ++m) { bf16_t* rowp = O + (size_t)(row0 + ai * HALF + m * 16) * ldc + col0;
#pragma unroll
                for (int bj = 0; bj < 2; ++bj) { const f32x4 v0 = acc[ai][bj][m][0], v1 = acc[ai][bj][m][1];
                    u32x4 w; w.x = cvt_pk_bf16(v0[0], v0[1]); w.y = cvt_pk_bf16(v0[2], v0[3]); w.z = cvt_pk_bf16(v1[0], v1[1]); w.w = cvt_pk_bf16(v1[2], v1[3]);
                    *(u32x4*)(rowp + bj * HALF) = w;
                    if (bj == 0 && kt) *(u32x4*)(Ki + (size_t)(row0 + ai * HALF + m * 16) * 64 + wc * 32 + 8 * fq) = w; } }
    }
};
template <class Epi, class Sched, bool ALIGN_EPI = false, bool SP2 = false>
__device__ __forceinline__ void gemm_phase(PG8_LAS unsigned char* lds, const Gemm g, const Sched& S, const Epi& E) {
    const int tid = TIDX(), wid = __builtin_amdgcn_readfirstlane(tid >> 6), lane = tid & 63, wr = wid >> 2, wc = wid & 3, fr = lane & 15, fq = lane >> 4;
    const int K = g.K, nt = K / BK;
    unsigned voffA[2], voffB[2];
#pragma unroll
    for (int i = 0; i < 2; ++i) { int R, C; stage_rc(tid * 16 + i * 8192, R, C); const int Rb = Epi::PERM ? ((R & ~31) + perm32(R & 31)) : R;
        voffA[i] = (unsigned)(R * g.lda + C) * 2u; voffB[i] = (unsigned)(Rb * g.ldb + C) * 2u; }
    unsigned voffG[2][2][2]; int gR[2], gC[2];
#pragma unroll
    for (int i = 0; i < 2; ++i) { int R, C; stage_rc(tid * 16 + i * 8192, R, C); gR[i] = R; gC[i] = C; }
#define PG8_GOFF(dst, unit_) do { if constexpr (Sched::GATHER) { _Pragma("unroll") for (int _h = 0; _h < 2; ++_h) _Pragma("unroll") for (int _i = 0; _i < 2; ++_i) \
        dst[_h][_i] = (unsigned)S.rowof(unit_, (unit_).orow + _h * HALF + gR[_i]) * (unsigned)(g.lda * 2) + (unsigned)gC[_i] * 2u; } } while (0)
#define PG8_STAGE_A(bufoff, gptr, half, vsel) do { if constexpr (Sched::GATHER) { PG8_STAGE(bufoff, gptr, vsel); } else { PG8_STAGE(bufoff, (gptr) + (half) * hstepA, voffA); } } while (0)
    const size_t kstep = (size_t)(BK * 2);
    const size_t hstepA = (size_t)HALF * g.lda * 2, hstepB = (size_t)HALF * g.ldb * 2;
    const unsigned ldsw = (unsigned)wid * 1024u;
    const int aoff = lds_byte(wr * 64 + fr, fq * 8), boff = lds_byte(wc * 32 + fr, fq * 8);
#define PG8_SA(b, h) (((b) * 2 + (h)) * HTB)
#define PG8_SB(b, h) ((4 + (b) * 2 + (h)) * HTB)
#define PG8_STAGE(bufoff, gbase, voff) do { _Pragma("unroll") for (int _i = 0; _i < 2; ++_i) \
        __builtin_amdgcn_global_load_lds((const unsigned*)((const char*)(gbase) + (voff)[_i]), (PG8_LAS unsigned*)(lds + (bufoff) + ldsw + _i * 8192), 16, 0, 0); } while (0)
#define PG8_LDA(dst, b, h) do { _Pragma("unroll") for (int m = 0; m < 4; ++m) _Pragma("unroll") for (int k = 0; k < 2; ++k) dst[m][k] = *(const PG8_LAS bf16x8*)(lds + PG8_SA(b, h) + aoff + m * 2048 + k * 1024); } while (0)
#define PG8_LDB(dst, b, h) do { _Pragma("unroll") for (int n = 0; n < 2; ++n) _Pragma("unroll") for (int k = 0; k < 2; ++k) dst[n][k] = *(const PG8_LAS bf16x8*)(lds + PG8_SB(b, h) + boff + n * 2048 + k * 1024); } while (0)
#define PG8_MMA(ai, bj, At, Bt) do { __builtin_amdgcn_s_setprio(1); _Pragma("unroll") for (int m = 0; m < 4; ++m) _Pragma("unroll") for (int n = 0; n < 2; ++n) _Pragma("unroll") for (int k = 0; k < 2; ++k) \
        acc[ai][bj][m][n] = __builtin_amdgcn_mfma_f32_16x16x32_bf16(Bt[n][k], At[m][k], acc[ai][bj][m][n], 0, 0, 0); __builtin_amdgcn_s_setprio(0); } while (0)
#define PG8_WAIT_V(n) asm volatile("s_waitcnt vmcnt(" #n ")" ::: "memory")
#define PG8_WAIT_L(n) asm volatile("s_waitcnt lgkmcnt(" #n ")" ::: "memory")
#define PG8_BAR __builtin_amdgcn_s_barrier()
#define PG8_SCHED __builtin_amdgcn_sched_barrier(0)
    Unit cur, nxt; int ui = 0;
    if (!S.next(0, cur)) return;
    f32x4 acc[2][2][4][2];
#pragma unroll
    for (int a = 0; a < 2; ++a)
#pragma unroll
        for (int b = 0; b < 2; ++b)
#pragma unroll
            for (int m = 0; m < 4; ++m)
#pragma unroll
                for (int n = 0; n < 2; ++n) acc[a][b][m][n] = (f32x4){0.f, 0.f, 0.f, 0.f};
    bf16x8 At[4][2], B0[2][2], B1[2][2];
    const char* cA = cur.pa; const char* cB = cur.pb;
    S.a_ready(cur);
    PG8_GOFF(voffG[0], cur);
    if constexpr (SP2) {
        PG8_STAGE(PG8_SB(0, 0), cB, voffB); PG8_STAGE(PG8_SB(0, 1), cB + hstepB, voffB); PG8_STAGE_A(PG8_SA(0, 0), cA, 0, voffG[0][0]); PG8_STAGE_A(PG8_SA(0, 1), cA, 1, voffG[0][1]);
        if (wr == 1) PG8_BAR;
        PG8_WAIT_V(2); PG8_BAR;
        PG8_STAGE(PG8_SB(1, 0), cB + kstep, voffB); PG8_STAGE_A(PG8_SA(1, 0), cA + kstep, 0, voffG[0][0]); PG8_STAGE(PG8_SB(1, 1), cB + hstepB + kstep, voffB);
        PG8_WAIT_V(6); PG8_BAR;
    } else {
        PG8_STAGE(PG8_SB(0, 0), cB, voffB); PG8_STAGE_A(PG8_SA(0, 0), cA, 0, voffG[0][0]); PG8_STAGE(PG8_SB(0, 1), cB + hstepB, voffB); PG8_STAGE_A(PG8_SA(0, 1), cA, 1, voffG[0][1]);
        if (wr == 1) PG8_BAR;
        PG8_WAIT_V(4); PG8_BAR;
        PG8_STAGE(PG8_SB(1, 0), cB + kstep, voffB); PG8_STAGE_A(PG8_SA(1, 0), cA + kstep, 0, voffG[0][0]); PG8_STAGE(PG8_SB(1, 1), cB + hstepB + kstep, voffB);
        PG8_WAIT_V(6); PG8_BAR;
    }
    for (;;) {
        const bool has_next = S.next(ui + 1, nxt);
        if constexpr (Sched::GATHER) { if (has_next) { PG8_GOFF(voffG[1], nxt); } else {
#pragma unroll
            for (int _h = 0; _h < 2; ++_h)
#pragma unroll
                for (int _i = 0; _i < 2; ++_i) voffG[1][_h][_i] = voffG[0][_h][_i]; } }
        const char* nA = has_next ? nxt.pa : cA; const char* nB = has_next ? nxt.pb : cB;
        for (int t = 0; t < nt; t += 2) {
            const bool last = (t == nt - 2);
            const char* a1 = cA + (size_t)(t + 1) * kstep;
            const char* a2 = last ? nA : cA + (size_t)(t + 2) * kstep; const char* b2 = last ? nB : cB + (size_t)(t + 2) * kstep;
            const char* a3 = a2 + kstep; const char* b3 = b2 + kstep;
            unsigned vs0[2], vs1[2];
#pragma unroll
            for (int _i = 0; _i < 2; ++_i) { vs0[_i] = last ? voffG[1][0][_i] : voffG[0][0][_i]; vs1[_i] = last ? voffG[1][1][_i] : voffG[0][1][_i]; }
            if (last && has_next) S.a_ready(nxt);
            if constexpr (SP2) {
            PG8_LDB(B0, 0, 0); PG8_LDB(B1, 0, 1); PG8_SCHED; PG8_LDA(At, 0, 0); PG8_STAGE_A(PG8_SA(1, 1), a1, 1, voffG[0][1]);
            PG8_WAIT_V(8); PG8_WAIT_L(0); PG8_BAR; PG8_MMA(0, 0, At, B0); PG8_MMA(0, 1, At, B1); PG8_BAR; PG8_SCHED;
            PG8_LDA(At, 0, 1); PG8_STAGE(PG8_SB(0, 0), b2, voffB); PG8_STAGE(PG8_SB(0, 1), b2 + hstepB, voffB); PG8_STAGE_A(PG8_SA(0, 0), a2, 0, vs0);
            PG8_WAIT_V(8); PG8_WAIT_L(0); PG8_BAR; PG8_MMA(1, 0, At, B0); PG8_MMA(1, 1, At, B1); PG8_BAR; PG8_SCHED;
            PG8_LDB(B0, 1, 0); PG8_LDB(B1, 1, 1); PG8_SCHED; PG8_LDA(At, 1, 0); PG8_STAGE_A(PG8_SA(0, 1), a2, 1, vs1);
            PG8_WAIT_V(8); PG8_WAIT_L(0); PG8_BAR; PG8_MMA(0, 0, At, B0); PG8_MMA(0, 1, At, B1); PG8_BAR; PG8_SCHED;
            PG8_LDA(At, 1, 1); PG8_STAGE(PG8_SB(1, 0), b3, voffB); PG8_STAGE(PG8_SB(1, 1), b3 + hstepB, voffB); PG8_STAGE_A(PG8_SA(1, 0), a3, 0, vs0);
            PG8_WAIT_V(8); PG8_WAIT_L(0); PG8_BAR; PG8_MMA(1, 0, At, B0); PG8_MMA(1, 1, At, B1); PG8_BAR; PG8_SCHED;
            } else {
            PG8_LDB(B0, 0, 0); PG8_SCHED; PG8_LDA(At, 0, 0); PG8_STAGE_A(PG8_SA(1, 1), a1, 1, voffG[0][1]);
            PG8_WAIT_L(8); PG8_BAR; PG8_WAIT_L(0); PG8_MMA(0, 0, At, B0); PG8_BAR; PG8_SCHED;
            PG8_LDB(B1, 0, 1); PG8_STAGE(PG8_SB(0, 0), b2, voffB);
            PG8_BAR; PG8_WAIT_L(0); PG8_MMA(0, 1, At, B1); PG8_BAR;
            PG8_LDA(At, 0, 1); PG8_STAGE_A(PG8_SA(0, 0), a2, 0, vs0);
            PG8_BAR; PG8_WAIT_L(0); PG8_MMA(1, 0, At, B0); PG8_BAR; PG8_SCHED;
            PG8_STAGE(PG8_SB(0, 1), b2 + hstepB, voffB);
            PG8_WAIT_V(6); PG8_BAR; PG8_MMA(1, 1, At, B1); PG8_BAR;
            PG8_LDB(B0, 1, 0); PG8_SCHED; PG8_LDA(At, 1, 0); PG8_STAGE_A(PG8_SA(0, 1), a2, 1, vs1);
            PG8_WAIT_L(8); PG8_BAR; PG8_WAIT_L(0); PG8_MMA(0, 0, At, B0); PG8_BAR; PG8_SCHED;
            PG8_LDB(B1, 1, 1); PG8_STAGE(PG8_SB(1, 0), b3, voffB);
            PG8_BAR; PG8_WAIT_L(0); PG8_MMA(0, 1, At, B1); PG8_BAR;
            PG8_LDA(At, 1, 1); PG8_STAGE_A(PG8_SA(1, 0), a3, 0, vs0);
            PG8_BAR; PG8_WAIT_L(0); PG8_MMA(1, 0, At, B0); PG8_BAR; PG8_SCHED;
            PG8_STAGE(PG8_SB(1, 1), b3 + hstepB, voffB);
            PG8_WAIT_V(6); PG8_BAR; PG8_MMA(1, 1, At, B1); PG8_BAR;
            }
        }
        if constexpr (ALIGN_EPI) { if (wr == 0) PG8_BAR; }
        if constexpr (!Epi::AFTER_DRAIN) { E(acc, cur, wr, wc, fr, fq); S.done(cur); }
        if (!has_next) break;
#pragma unroll
        for (int a = 0; a < 2; ++a)
#pragma unroll
            for (int b = 0; b < 2; ++b)
#pragma unroll
                for (int m = 0; m < 4; ++m)
#pragma unroll
                    for (int n = 0; n < 2; ++n) acc[a][b][m][n] = (f32x4){0.f, 0.f, 0.f, 0.f};
        cur = nxt; cA = nA; cB = nB; ++ui;
        if constexpr (Sched::GATHER) {
#pragma unroll
            for (int _h = 0; _h < 2; ++_h)
#pragma unroll
                for (int _i = 0; _i < 2; ++_i) voffG[0][_h][_i] = voffG[1][_h][_i]; }
        if constexpr (ALIGN_EPI) { if (wr == 1) PG8_BAR; }
    }
    PG8_WAIT_V(0);
    if constexpr (!ALIGN_EPI) { if (wr == 0) PG8_BAR; }
    PG8_BAR;
    if constexpr (Epi::AFTER_DRAIN) { E.fused(acc, cur, wr, wc, fr, fq, lds, wid, lane); S.done(cur); }
#undef PG8_SA
#undef PG8_SB
#undef PG8_STAGE
#undef PG8_STAGE_A
#undef PG8_GOFF
#undef PG8_LDA
#undef PG8_LDB
#undef PG8_MMA
#undef PG8_WAIT_V
#undef PG8_WAIT_L
#undef PG8_BAR
#undef PG8_SCHED
}

}
#define WSYNC2() asm volatile("s_waitcnt lgkmcnt(0)" ::: "memory")
struct MoeBufs { int* tok_e; float* tok_g; int* slot_of; float* slot_gate; int* blk_e; int* blkcnt; int* nblk; int* slot_tok; };
constexpr int WRT_LD = 1028;

template <bool XB, int MODE = 0> __device__ __forceinline__ void ph_ln_router(const void* xin_, const bf16_t* hb, const float* g, const float* bb, const float* wr, const float* br, bf16_t* x1b, const MoeBufs m, float* lds) {
  const float* xin = (const float*)xin_; const bf16_t* xinb = (const bf16_t*)xin_;
  for (int i = BIDX() * NTHR + TIDX(); i < PMAX; i += (int)gridDim.x * NTHR) m.slot_tok[i] = 0;
  const int tid = TIDX(), lane = tid & 63, wave = tid >> 6, blk = BIDX();
  float* wT = lds;
  float* lg = lds + 32 * WRT_LD + wave * 64;
  int* cnt = (int*)(lds + 32 * WRT_LD + 8 * 64);
  f32x4 raf[2][4]; v2u rab[2][4], rh[2][4];
#define LNR_LOAD(tk) { _Pragma("unroll") for (int q = 0; q < 2; ++q) _Pragma("unroll") for (int j = 0; j < 4; ++j) { const int c = lane * 4 + 256 * j; \
      if (XB) rab[q][j] = *(const v2u*)(xinb + (size_t)((tk) + q) * D + c); else raf[q][j] = *(const f32x4*)(xin + (size_t)((tk) + q) * D + c); \
      rh[q][j] = *(const v2u*)(hb + (size_t)((tk) + q) * D + c); } }
  LNR_LOAD(blk * 64 + wave * 8)
  { f32x4 wv[16];
#pragma unroll
    for (int k = 0; k < 16; ++k) wv[k] = *(const f32x4*)(wr + (size_t)(tid + NTHR * k) * 4);
#pragma unroll
    for (int k = 0; k < 16; ++k) { const int i = (tid + NTHR * k) * 4, d = i >> 5, e = i & 31;
#pragma unroll
      for (int z = 0; z < 4; ++z) wT[(e + z) * WRT_LD + d] = wv[k][z]; } }
  if (tid < 32) cnt[tid] = 0;
  __syncthreads();
#pragma unroll 1
  for (int it = 0; it < 8; it += 2) {
    const int tok0 = blk * 64 + wave * 8 + it;
    f32x4 v[2][4]; float s[2] = {0.f, 0.f};
#pragma unroll
    for (int q = 0; q < 2; ++q)
#pragma unroll
      for (int j = 0; j < 4; ++j) { f32x4 a;
        if (XB) { const v2u xv = rab[q][j]; a = (f32x4){bf_lo(xv[0]), bf_hi(xv[0]), bf_lo(xv[1]), bf_hi(xv[1])}; } else a = raf[q][j];
        const v2u hh = rh[q][j];
        v[q][j] = (f32x4){ALPHA * a[0] + bf_lo(hh[0]), ALPHA * a[1] + bf_hi(hh[0]), ALPHA * a[2] + bf_lo(hh[1]), ALPHA * a[3] + bf_hi(hh[1])}; s[q] += (v[q][j][0] + v[q][j][1]) + (v[q][j][2] + v[q][j][3]); }
    if (it + 2 < 8) LNR_LOAD(tok0 + 2)
#pragma unroll
    for (int o = 1; o < 64; o <<= 1) { s[0] += __shfl_xor(s[0], o); s[1] += __shfl_xor(s[1], o); }
    float qq[2] = {0.f, 0.f};
#pragma unroll
    for (int q = 0; q < 2; ++q) { const float mu = s[q] * (1.f / D);
#pragma unroll
      for (int j = 0; j < 4; ++j) { v[q][j] = v[q][j] - mu; qq[q] += (v[q][j][0] * v[q][j][0] + v[q][j][1] * v[q][j][1]) + (v[q][j][2] * v[q][j][2] + v[q][j][3] * v[q][j][3]); } }
#pragma unroll
    for (int o = 1; o < 64; o <<= 1) { qq[0] += __shfl_xor(qq[0], o); qq[1] += __shfl_xor(qq[1], o); }
#pragma unroll
    for (int q = 0; q < 2; ++q) { const float r = rsqrtf(qq[q] * (1.f / D) + 1e-5f);
#pragma unroll
      for (int j = 0; j < 4; ++j) { const int c = lane * 4 + 256 * j; const f32x4 g4 = *(const f32x4*)(g + c), b4 = *(const f32x4*)(bb + c); v[q][j] = v[q][j] * r * g4 + b4; *(v2u*)(x1b + (size_t)(tok0 + q) * D + c) = (v2u){cvt_pk_bf16(v[q][j][0], v[q][j][1]), cvt_pk_bf16(v[q][j][2], v[q][j][3])}; } }
    if (MODE == 1) continue;
    float p[2][32];
    { const float* wl = wT + lane * 4; f32x4 wb[2][4];
#pragma unroll
      for (int j = 0; j < 4; ++j) wb[0][j] = *(const f32x4*)(wl + 256 * j);
#pragma unroll
      for (int e = 0; e < 32; ++e) {
        if (e < 31) {
#pragma unroll
          for (int j = 0; j < 4; ++j) wb[(e + 1) & 1][j] = *(const f32x4*)(wl + (e + 1) * WRT_LD + 256 * j); }
        __builtin_amdgcn_sched_barrier(0);
        f32x2_t a0 = {0.f, 0.f}, a1 = {0.f, 0.f};
#pragma unroll
        for (int j = 0; j < 4; ++j) { const f32x4 w4 = wb[e & 1][j]; const f32x2_t wlo = {w4[0], w4[1]}, whi = {w4[2], w4[3]};
          a0 = __builtin_elementwise_fma((f32x2_t){v[0][j][0], v[0][j][1]}, wlo, a0); a0 = __builtin_elementwise_fma((f32x2_t){v[0][j][2], v[0][j][3]}, whi, a0);
          a1 = __builtin_elementwise_fma((f32x2_t){v[1][j][0], v[1][j][1]}, wlo, a1); a1 = __builtin_elementwise_fma((f32x2_t){v[1][j][2], v[1][j][3]}, whi, a1); }
        p[0][e] = a0[0] + a0[1]; p[1][e] = a1[0] + a1[1];
        __builtin_amdgcn_sched_barrier(0);
      } }
#pragma unroll
    for (int i = 0; i < 16; ++i) { const bool hi = (lane & 32) != 0;
#pragma unroll
      for (int q = 0; q < 2; ++q) { const float send = hi ? p[q][i] : p[q][i + 16]; const float keep = hi ? p[q][i + 16] : p[q][i]; p[q][i] = keep + __shfl_xor(send, 32); } }
#pragma unroll
    for (int i = 0; i < 8; ++i) { const bool hi = (lane & 16) != 0;
#pragma unroll
      for (int q = 0; q < 2; ++q) { const float send = hi ? p[q][i] : p[q][i + 8]; const float keep = hi ? p[q][i + 8] : p[q][i]; p[q][i] = keep + __shfl_xor(send, 16); } }
#pragma unroll
    for (int i = 0; i < 4; ++i) { const bool hi = (lane & 8) != 0;
#pragma unroll
      for (int q = 0; q < 2; ++q) { const float send = hi ? p[q][i] : p[q][i + 4]; const float keep = hi ? p[q][i + 4] : p[q][i]; p[q][i] = keep + __shfl_xor(send, 8); } }
#pragma unroll
    for (int i = 0; i < 2; ++i) { const bool hi = (lane & 4) != 0;
#pragma unroll
      for (int q = 0; q < 2; ++q) { const float send = hi ? p[q][i] : p[q][i + 2]; const float keep = hi ? p[q][i + 2] : p[q][i]; p[q][i] = keep + __shfl_xor(send, 4); } }
#pragma unroll
    for (int q = 0; q < 2; ++q) { const bool hi = (lane & 2) != 0; const float send = hi ? p[q][0] : p[q][1]; const float keep = hi ? p[q][1] : p[q][0]; p[q][0] = keep + __shfl_xor(send, 2); }
    p[0][0] += __shfl_xor(p[0][0], 1); p[1][0] += __shfl_xor(p[1][0], 1);
    const int e_l = ((lane >> 5) & 1) * 16 + ((lane >> 4) & 1) * 8 + ((lane >> 3) & 1) * 4 + ((lane >> 2) & 1) * 2 + ((lane >> 1) & 1);
    const float brl = br[e_l];
    float lv[2] = {p[0][0] + brl, p[1][0] + brl}; int ei[2][4]; float ev[2][4];
    if (MODE == 2) for (int k = 1; k < 4; ++k) { ei[0][k] = ei[1][k] = k; ev[0][k] = ev[1][k] = 0.f; }
#pragma unroll
    for (int k = 0; k < (MODE == 2 ? 1 : 4); ++k) { float bv[2] = {lv[0], lv[1]}; int bi[2] = {e_l, e_l};
#pragma unroll
      for (int o = 2; o < 64; o <<= 1)
#pragma unroll
        for (int q = 0; q < 2; ++q) { const float ov = __shfl_xor(bv[q], o); const int oi = __shfl_xor(bi[q], o); const bool take = (ov > bv[q]) || (ov == bv[q] && oi < bi[q]); bv[q] = take ? ov : bv[q]; bi[q] = take ? oi : bi[q]; }
#pragma unroll
      for (int q = 0; q < 2; ++q) { ei[q][k] = bi[q]; ev[q][k] = bv[q]; if (e_l == bi[q]) lv[q] = -INFINITY; } }
    if (lane < 2) { const int q = lane;
      float ex[4], su = 0.f;
#pragma unroll
      for (int k = 0; k < 4; ++k) { ex[k] = __expf((q ? ev[1][k] : ev[0][k]) - (q ? ev[1][0] : ev[0][0])); su += ex[k]; }
      const float inv = 1.f / su; const int tok = tok0 + q;
      const int e0 = q ? ei[1][0] : ei[0][0], e1 = q ? ei[1][1] : ei[0][1], e2 = q ? ei[1][2] : ei[0][2], e3 = q ? ei[1][3] : ei[0][3];
      *(int4*)(m.tok_e + tok * 4) = make_int4(e0, e1, e2, e3);
      *(float4*)(m.tok_g + tok * 4) = make_float4(ex[0] * inv, ex[1] * inv, ex[2] * inv, ex[3] * inv);
      atomicAdd(&cnt[e0], 1); atomicAdd(&cnt[e1], 1); atomicAdd(&cnt[e2], 1); atomicAdd(&cnt[e3], 1); }
  }
  __syncthreads();
  if (tid < 32) m.blkcnt[blk * 32 + tid] = cnt[tid];
  __syncthreads();
}

__device__ __forceinline__ void ph_moe_scatter(const MoeBufs m, int* ilds) {
  const int tid = TIDX(), lane = tid & 63, wave = tid >> 6, blk = BIDX(); (void)lane;
  int* tot = ilds; int* bef = ilds + 32; int* pst = ilds + 64; int* es = ilds + 128; int* rk = ilds + 384; int* sl = ilds + 640; int* part = ilds + 896; int* wcnt = ilds + 1408;
  { const int e = tid & 31, pa = tid >> 5; int sum = 0;
#pragma unroll
    for (int q = 0; q < 16; ++q) sum += m.blkcnt[(pa * 16 + q) * 32 + e];
    part[pa * 32 + e] = sum; }
  if (tid < 256) es[tid] = m.tok_e[blk * 256 + tid];
  __syncthreads();
  if (tid < 32) { const int e = tid; int t_ = 0, b_ = 0; const int pb_ = blk >> 4;
    for (int q = 0; q < 16; ++q) { const int v = part[q * 32 + e]; t_ += v; if (q < pb_) b_ += v; }
    for (int q = pb_ * 16; q < blk; ++q) b_ += m.blkcnt[q * 32 + e];
    tot[e] = t_; bef[e] = b_; }
  if (tid < 256) { const int e = es[tid]; const unsigned long long lt = (1ull << lane) - 1ull; int r = 0;
    for (int ee = 0; ee < 32; ++ee) { const unsigned long long mk = __ballot(e == ee); if (e == ee) r = __builtin_popcountll(mk & lt); if (lane == ee) wcnt[wave * 32 + ee] = __builtin_popcountll(mk); }
    rk[tid] = r; }
  __syncthreads();
  if (tid == 0) { int acc = 0; for (int e = 0; e < 32; ++e) { pst[e] = acc; acc += ((tot[e] + 255) >> 8) << 8; } pst[32] = acc;
    if (blk == 0) { *m.nblk = acc >> 8; for (int e = 0; e < 32; ++e) for (int q = pst[e] >> 8; q < (pst[e + 1] >> 8); ++q) m.blk_e[q] = e; } }
  __syncthreads();
  if (tid < 256) { const int e = es[tid]; int rank = rk[tid]; for (int w2 = 0; w2 < wave; ++w2) rank += wcnt[w2 * 32 + e];
    const int slot = pst[e] + bef[e] + rank; m.slot_of[blk * 256 + tid] = slot; m.slot_gate[slot] = m.tok_g[blk * 256 + tid]; m.slot_tok[slot] = blk * 64 + (tid >> 2); }
  __syncthreads();
  __syncthreads();
}

__device__ __forceinline__ void ph_combine_ln(const bf16_t* x1b, const bf16_t* Ys, const int* slot_of, const float* g, const float* bb, float* out, bf16_t* outb) {
  const int tid = TIDX(), lane = tid & 63, gw = BIDX() * 8 + (tid >> 6), NGW = (int)gridDim.x * 8;
  for (int row = gw; row < NT; row += NGW) {
    const int4 s4 = *(const int4*)(slot_of + row * 4); const int sl[4] = {s4.x, s4.y, s4.z, s4.w};
    f32x4 v[4]; float s = 0.f;
#pragma unroll
    for (int j = 0; j < 4; ++j) { const int c = lane * 4 + 256 * j; f32x4 f = (f32x4){0.f, 0.f, 0.f, 0.f};
#pragma unroll
      for (int k = 0; k < 4; ++k) { const v2u y = *(const v2u*)(Ys + (size_t)sl[k] * D + c); f += (f32x4){bf_lo(y[0]), bf_hi(y[0]), bf_lo(y[1]), bf_hi(y[1])}; }
      const v2u xv = *(const v2u*)(x1b + (size_t)row * D + c); const f32x4 a = (f32x4){bf_lo(xv[0]), bf_hi(xv[0]), bf_lo(xv[1]), bf_hi(xv[1])}; v[j] = a * ALPHA + f; s += (v[j][0] + v[j][1]) + (v[j][2] + v[j][3]); }
    const float mu = wave_sum(s) * (1.f / D); float q = 0.f;
#pragma unroll
    for (int j = 0; j < 4; ++j) { v[j] = v[j] - mu; q += (v[j][0] * v[j][0] + v[j][1] * v[j][1]) + (v[j][2] * v[j][2] + v[j][3] * v[j][3]); }
    const float r = rsqrtf(wave_sum(q) * (1.f / D) + 1e-5f);
#pragma unroll
    for (int j = 0; j < 4; ++j) { const int c = lane * 4 + 256 * j; const f32x4 g4 = *(const f32x4*)(g + c), b4 = *(const f32x4*)(bb + c); const f32x4 o = v[j] * r * g4 + b4;
      if (out) *(f32x4*)(out + (size_t)row * D + c) = o; if (outb) *(v2u*)(outb + (size_t)row * D + c) = (v2u){cvt_pk_bf16(o[0], o[1]), cvt_pk_bf16(o[2], o[3])}; }
  }
}

namespace pg8 {
template <bool GATHER_> struct MoeOrderT {
    static constexpr bool GATHER = GATHER_; const int* rowmap;
    StaticOrder so; const int* blk_e; const char* W; size_t wexp; int obn;
    __device__ void init(const void* A, int lda, const void* W_, int ldb, size_t wexp_, int nM, int nN, int obn_, const int* blk_e_, int G, int c) { so.init(A, lda, W_, ldb, nM * BM, nN * BM, G, c); blk_e = blk_e_; W = (const char*)W_; wexp = wexp_; obn = obn_; }
    __device__ bool next(int i, Unit& u) const { int pm, pn; if (!so.tile(i, pm, pn)) return false; const int e = __builtin_amdgcn_readfirstlane(blk_e[pm]); u.pa = GATHER_ ? so.A : so.A + (size_t)pm * so.ta; u.pb = W + (size_t)e * wexp + (size_t)pn * so.tb; u.orow = pm * BM; u.ocol = pn * obn; u.e = e; u.kind = 0; return true; }
    __device__ __forceinline__ int rowof(const Unit&, int r) const { return GATHER_ ? rowmap[r] : r; }
    __device__ __forceinline__ void a_ready(const Unit&) const {}
    __device__ __forceinline__ void done(const Unit&) const {}
};
typedef MoeOrderT<false> MoeOrder; typedef MoeOrderT<true> MoeOrderG;
struct EpiSwiglu {
    static constexpr bool PERM = true, AFTER_DRAIN = false;
    bf16_t* O; int ldc; const float* b1;
    __device__ __forceinline__ void operator()(const f32x4 (&acc)[2][2][4][2], const Unit& u, int wr, int wc, int fr, int fq) const {
        const int row0 = u.orow + wr * 64 + fr, cl = wc * 32 + 8 * fq, col0 = u.ocol + cl;
        const float* bg = b1 + (size_t)u.e * 2048 + col0; const float* bu = bg + 1024;
        const f32x4 bg0 = *(const f32x4*)bg, bg1 = *(const f32x4*)(bg + 4), bu0 = *(const f32x4*)bu, bu1 = *(const f32x4*)(bu + 4);
#pragma unroll
        for (int ai = 0; ai < 2; ++ai)
#pragma unroll
            for (int m = 0; m < 4; ++m) {
                f32x4 gv[2] = {acc[ai][0][m][0] + bg0, acc[ai][0][m][1] + bg1}, uv[2] = {acc[ai][1][m][0] + bu0, acc[ai][1][m][1] + bu1}; float o[8];
#pragma unroll
                for (int n = 0; n < 2; ++n)
#pragma unroll
                    for (int i = 0; i < 4; ++i) { const float gg = fminf(gv[n][i], 7.f), uu = fminf(fmaxf(uv[n][i], -7.f), 7.f);
                        const float sg = __builtin_amdgcn_rcpf(1.f + __builtin_amdgcn_exp2f(-1.702f * 1.4426950408889634f * gg)); o[4 * n + i] = (uu + 1.f) * gg * sg; }
                u32x4 w; w.x = cvt_pk_bf16(o[0], o[1]); w.y = cvt_pk_bf16(o[2], o[3]); w.z = cvt_pk_bf16(o[4], o[5]); w.w = cvt_pk_bf16(o[6], o[7]);
                *(u32x4*)(O + (size_t)(row0 + ai * HALF + m * 16) * ldc + col0) = w; asm volatile("" ::: "memory"); }
    }
};
struct EpiMoe2 {
    static constexpr bool PERM = true, AFTER_DRAIN = false;
    bf16_t* O; int ldc; const float* b2; const float* gate;
    __device__ __forceinline__ void operator()(const f32x4 (&acc)[2][2][4][2], const Unit& u, int wr, int wc, int fr, int fq) const {
        const int row0 = u.orow + wr * 64 + fr, col0 = u.ocol + wc * 32 + 8 * fq;
        const float* bp = b2 + (size_t)u.e * 1024 + col0;
#pragma unroll
        for (int bj = 0; bj < 2; ++bj) {
            const f32x4 bv0 = *(const f32x4*)(bp + bj * HALF), bv1 = *(const f32x4*)(bp + bj * HALF + 4);
#pragma unroll
            for (int ai = 0; ai < 2; ++ai)
#pragma unroll
                for (int m = 0; m < 4; ++m) { const int row = row0 + ai * HALF + m * 16; const float gt = gate[row];
                    const f32x4 v0 = (acc[ai][bj][m][0] + bv0) * gt, v1 = (acc[ai][bj][m][1] + bv1) * gt;
                    u32x4 w; w.x = cvt_pk_bf16(v0[0], v0[1]); w.y = cvt_pk_bf16(v0[2], v0[3]); w.z = cvt_pk_bf16(v1[0], v1[1]); w.w = cvt_pk_bf16(v1[2], v1[3]);
                    *(u32x4*)(O + (size_t)row * ldc + col0 + bj * HALF) = w; asm volatile("" ::: "memory"); }
        }
    }
};

struct MoeFusedOrder {
    static constexpr bool GATHER = true;
    const int* rowmap; const int* blk_e; const char* X; const char* ACT; const char* W1; const char* W2; unsigned* ready; unsigned* tmo; int nblk, NG, G, c, total, mode;
    __device__ void init(const void* X_, const void* ACT_, const void* W1_, const void* W2_, const int* rowmap_, const int* blk_e_, unsigned* ready_, unsigned* tmo_, int nblk_, int G_, int c_) {
        X = (const char*)X_; ACT = (const char*)ACT_; W1 = (const char*)W1_; W2 = (const char*)W2_; rowmap = rowmap_; blk_e = blk_e_; ready = ready_; tmo = tmo_; nblk = nblk_; NG = (nblk_ + 31) >> 5; G = G_; c = c_; total = nblk_ * 12; }
    __device__ bool next(int i, Unit& u) const {
        int Lq = i * G + c; if (Lq >= total) return false;
#if defined(FUSE_SPLIT)
        if (c >= 0) { const int kind = mode - 1; if (Lq >= nblk * (kind ? 4 : 8)) return false; const int q = Lq; const int pm = q % nblk, pn = q / nblk, e = __builtin_amdgcn_readfirstlane(blk_e[pm]);
          u.kind = kind; u.e = e; u.orow = pm * BM;
          if (kind == 0) { u.pa = X; u.pb = W1 + ((size_t)e * 2048 + (size_t)pn * 256) * 2048; u.ocol = pn * 128; }
          else { u.pa = ACT; u.pb = W2 + ((size_t)e * 1024 + (size_t)pn * 256) * 2048; u.ocol = pn * 256; }
          return true; }
#endif
#if defined(FUSE_SERIAL)
        { const int n1 = nblk * 8; int kind = Lq < n1 ? 0 : 1; int q = kind ? Lq - n1 : Lq; const int pm = q % nblk, pn = q / nblk, e = __builtin_amdgcn_readfirstlane(blk_e[pm]);
          u.kind = kind; u.e = e; u.orow = pm * BM;
          if (kind == 0) { u.pa = X; u.pb = W1 + ((size_t)e * 2048 + (size_t)pn * 256) * 2048; u.ocol = pn * 128; }
          else { u.pa = ACT; u.pb = W2 + ((size_t)e * 1024 + (size_t)pn * 256) * 2048; u.ocol = pn * 256; }
          return true; }
#endif
        int kind = 0, g = 0;
        for (int sgm = 0; ; ++sgm) {
            if (sgm < 3) { kind = 0; g = sgm; }
            else if (sgm < 3 + 2 * (NG - 3)) { const int j = (sgm - 3) >> 1; if (((sgm - 3) & 1) == 0) { kind = 0; g = j + 3; } else { kind = 1; g = j; } }
            else { kind = 1; g = NG - 3 + (sgm - (3 + 2 * (NG - 3))); }
            const int mg = min(32, nblk - 32 * g), sz = mg * (kind ? 4 : 8);
            if (Lq < sz) { const int pm = 32 * g + Lq % mg, pn = Lq / mg, e = __builtin_amdgcn_readfirstlane(blk_e[pm]);
                u.kind = kind; u.e = e; u.orow = pm * BM;
                if (kind == 0) { u.pa = X; u.pb = W1 + ((size_t)e * 2048 + (size_t)pn * 256) * 2048; u.ocol = pn * 128; }
                else { u.pa = ACT; u.pb = W2 + ((size_t)e * 1024 + (size_t)pn * 256) * 2048; u.ocol = pn * 256; }
                return true; }
            Lq -= sz;
        }
    }
    __device__ __forceinline__ int rowof(const Unit& u, int r) const { return u.kind == 0 ? rowmap[r] : r; }
    __device__ __forceinline__ void a_ready(const Unit& u) const {
        if (u.kind == 0) return;
#if defined(FUSE_SPLIT)
        return;
#endif
        if (threadIdx.x < 64) {
#if defined(FUSE_GLOBAL_WAIT)
            const unsigned long long t0 = __builtin_amdgcn_s_memrealtime(); unsigned polls = 0; unsigned* rp = ready + 64 * 500; const unsigned want = (unsigned)nblk * 64u;
#else
            const unsigned long long t0 = __builtin_amdgcn_s_memrealtime(); unsigned polls = 0; unsigned* rp = ready + 64 * (u.orow >> 8); const unsigned want = 64u;
#endif
            while ((unsigned)__builtin_amdgcn_readfirstlane(__hip_atomic_load(rp, __ATOMIC_RELAXED, __HIP_MEMORY_SCOPE_AGENT)) < want) {
                if ((++polls & 255u) == 0u && __builtin_amdgcn_readfirstlane(__hip_atomic_load(tmo, __ATOMIC_RELAXED, __HIP_MEMORY_SCOPE_AGENT)) != 0u) break;
                if (__builtin_amdgcn_s_memrealtime() - t0 > 2000000ull) { if (threadIdx.x == 0) __hip_atomic_store(tmo, 1u, __ATOMIC_RELAXED, __HIP_MEMORY_SCOPE_AGENT); break; }
                __builtin_amdgcn_s_sleep(2); }
#if defined(FUSE_CONSUMER_WB)
            __builtin_amdgcn_fence(__ATOMIC_RELEASE, "agent"); asm volatile("s_waitcnt vmcnt(0)" ::: "memory");
#endif
#if defined(FUSE_DELAY)
            { const unsigned long long t1 = __builtin_amdgcn_s_memrealtime(); while (__builtin_amdgcn_s_memrealtime() - t1 < 2000ull) __builtin_amdgcn_s_sleep(8); }
#endif
            __builtin_amdgcn_fence(__ATOMIC_ACQUIRE, "agent");
            asm volatile("s_waitcnt vmcnt(0)" ::: "memory");
        }
        asm volatile("" ::: "memory"); __builtin_amdgcn_s_barrier(); asm volatile("" ::: "memory");
    }
    __device__ __forceinline__ void done(const Unit& u) const {
        if (u.kind != 0) return;
        asm volatile("s_waitcnt vmcnt(0)" ::: "memory");
#if defined(FUSE_HEAVY_RELEASE)
        __builtin_amdgcn_fence(__ATOMIC_RELEASE, "agent"); asm volatile("s_waitcnt vmcnt(0)" ::: "memory");
#endif
#if defined(FUSE_GLOBAL_WAIT)
        if ((threadIdx.x & 63) == 0) __hip_atomic_fetch_add(ready + 64 * 500, 1u, __ATOMIC_RELAXED, __HIP_MEMORY_SCOPE_AGENT);
#else
        if ((threadIdx.x & 63) == 0) __hip_atomic_fetch_add(ready + 64 * (u.orow >> 8), 1u, __ATOMIC_RELAXED, __HIP_MEMORY_SCOPE_AGENT);
#endif
    }
};
__device__ __forceinline__ void store16_sc1(void* p, u32x4 v) { asm volatile("global_store_dwordx4 %0, %1, off sc1\n\ts_nop 1" :: "v"(p), "v"(v) : "memory"); }
struct EpiMoeFused {
    static constexpr bool PERM = true, AFTER_DRAIN = false;
    bf16_t* ACTo; const float* b1; bf16_t* Yo; const float* b2; const float* gate;
    __device__ __forceinline__ void operator()(const f32x4 (&acc)[2][2][4][2], const Unit& u, int wr, int wc, int fr, int fq) const {
        if (u.kind == 0) {
            const int row0 = u.orow + wr * 64 + fr, cl = wc * 32 + 8 * fq, col0 = u.ocol + cl;
            const float* bg = b1 + (size_t)u.e * 2048 + col0; const float* bu = bg + 1024;
            const f32x4 bg0 = *(const f32x4*)bg, bg1 = *(const f32x4*)(bg + 4), bu0 = *(const f32x4*)bu, bu1 = *(const f32x4*)(bu + 4);
#pragma unroll
            for (int ai = 0; ai < 2; ++ai)
#pragma unroll
                for (int m = 0; m < 4; ++m) {
                    f32x4 gv[2] = {acc[ai][0][m][0] + bg0, acc[ai][0][m][1] + bg1}, uv[2] = {acc[ai][1][m][0] + bu0, acc[ai][1][m][1] + bu1}; float o[8];
#pragma unroll
                    for (int n = 0; n < 2; ++n)
#pragma unroll
                        for (int i = 0; i < 4; ++i) { const float gg = fminf(gv[n][i], 7.f), uu = fminf(fmaxf(uv[n][i], -7.f), 7.f);
                            const float sg = __builtin_amdgcn_rcpf(1.f + __builtin_amdgcn_exp2f(-1.702f * 1.4426950408889634f * gg)); o[4 * n + i] = (uu + 1.f) * gg * sg; }
                    u32x4 w; w.x = cvt_pk_bf16(o[0], o[1]); w.y = cvt_pk_bf16(o[2], o[3]); w.z = cvt_pk_bf16(o[4], o[5]); w.w = cvt_pk_bf16(o[6], o[7]);
#if defined(FUSE_PLAIN_STORE)
                    *(u32x4*)(ACTo + (size_t)(row0 + ai * HALF + m * 16) * 1024 + col0) = w; }
#else
                    store16_sc1(ACTo + (size_t)(row0 + ai * HALF + m * 16) * 1024 + col0, w); }
#endif
        } else {
            const int row0 = u.orow + wr * 64 + fr, col0 = u.ocol + wc * 32 + 8 * fq;
            const float* bp = b2 + (size_t)u.e * 1024 + col0;
#pragma unroll
            for (int bj = 0; bj < 2; ++bj) {
                const f32x4 bv0 = *(const f32x4*)(bp + bj * HALF), bv1 = *(const f32x4*)(bp + bj * HALF + 4);
#pragma unroll
                for (int ai = 0; ai < 2; ++ai)
#pragma unroll
                    for (int m = 0; m < 4; ++m) { const int row = row0 + ai * HALF + m * 16; const float gt = gate[row];
                        const f32x4 v0 = (acc[ai][bj][m][0] + bv0) * gt, v1 = (acc[ai][bj][m][1] + bv1) * gt;
                        u32x4 w; w.x = cvt_pk_bf16(v0[0], v0[1]); w.y = cvt_pk_bf16(v0[2], v0[3]); w.z = cvt_pk_bf16(v1[0], v1[1]); w.w = cvt_pk_bf16(v1[2], v1[3]);
                        *(u32x4*)(Yo + (size_t)row * 1024 + col0 + bj * HALF) = w; asm volatile("" ::: "memory"); }
            }
        }
    }
};
}
typedef short v4i16_t __attribute__((ext_vector_type(4)));
__device__ __forceinline__ unsigned f2key_u(float f) { f = f + 0.0f; const unsigned u = __float_as_uint(f); return (u & 0x80000000u) ? ~u : (u | 0x80000000u); }

__device__ __forceinline__ void ph_cnorm_b(const bf16_t* pa, const float* g, bf16_t* cnb) {
  const int tid = TIDX(), lane = tid & 63, gw = BIDX() * 8 + (tid >> 6), NGW = (int)gridDim.x * 8;
  const f32x4 g4 = *(const f32x4*)(g + lane * 4);
  for (int row = gw; row < NT; row += NGW) {
    const v2u v = *(const v2u*)(pa + (size_t)row * 2048 + 1024 + lane * 4);
    const f32x4 f = (f32x4){bf_lo(v[0]), bf_hi(v[0]), bf_lo(v[1]), bf_hi(v[1])};
    const float r = rsqrtf(wave_sum((f[0] * f[0] + f[1] * f[1]) + (f[2] * f[2] + f[3] * f[3])) * (1.f / 256.f) + 1e-6f);
    const f32x4 o = f * r * g4;
    *(v2u*)(cnb + (size_t)row * 256 + lane * 4) = (v2u){cvt_pk_bf16(o[0], o[1]), cvt_pk_bf16(o[2], o[3])};
  }
}

__device__ __forceinline__ int moe_layer_tile(int layer, int j) { return j < 8192 ? layer * 8192 + j : 16384 + layer * 4096 + (j - 8192); }
__device__ __forceinline__ void moe_weight_tile(int T, const float* w1, const float* w2, bf16_t* W1_t, bf16_t* W2_t, int lane) {
  if (T < 16384) { const int le = T >> 8; transpose_tile(mk_tjob(w1 + (size_t)le * D * 2048, 2048, D, 2048, W1_t + (size_t)le * 2048 * D, D, 0, 0, 1), T & 255, lane); }
  else if (T < 24576) { const int t2 = T - 16384, le = t2 >> 7; transpose_tile(mk_tjob(w2 + (size_t)le * D * D, D, D, D, W2_t + (size_t)le * D * D, D, 0, 0, 0), t2 & 127, lane); }
}
typedef _Float16 h16x2_t __attribute__((ext_vector_type(2)));
typedef int i32x4_t __attribute__((ext_vector_type(4)));
__device__ __forceinline__ unsigned cvt_pk_f16(float lo, float hi) { const f32x2_t v = {lo, hi}; const h16x2_t h = __builtin_convertvector(v, h16x2_t); return __builtin_bit_cast(unsigned, h); }
constexpr int ISC_NU = 1088;
__device__ __forceinline__ void isc_decode(unsigned u, int& b, int& j, int& c) { b = (int)(u / 544u); int v = (int)u - b * 544; j = 63; while (v >= ((j + 4) >> 2)) { v -= (j + 4) >> 2; --j; } c = v; }
template <int HOT = 0> __device__ __forceinline__ void ph_iscore(const bf16_t* pa, const bf16_t* kib, unsigned short* sc, unsigned* ctr, LAS unsigned char* lds) {
  const int tid = TIDX(), lane = tid & 63, wave = __builtin_amdgcn_readfirstlane(tid >> 6);
  const int n16 = lane & 15, g = lane >> 4;
  volatile LAS unsigned* slot = (volatile LAS unsigned*)(lds + MISC_OFF + 80);
  __syncthreads();
  if (tid == 0) { slot[0] = __hip_atomic_fetch_add(ctr, 1u, __ATOMIC_RELAXED, __HIP_MEMORY_SCOPE_AGENT); slot[1] = __hip_atomic_fetch_add(ctr, 1u, __ATOMIC_RELAXED, __HIP_MEMORY_SCOPE_AGENT); }
  __syncthreads();
  unsigned cur = slot[0], nxt = slot[1];
  __syncthreads();
  const unsigned lofs = (unsigned)(n16 * 128 + 16 * (g ^ (n16 >> 1))), lofs1 = (unsigned)(n16 * 128 + 16 * ((4 + g) ^ (n16 >> 1)));
#define ISC_DMA(u_, pb_) { int b_, j_, c_; isc_decode((u_), b_, j_, c_); const bf16_t* src0 = kib + (size_t)(b_ * L + 512 * c_) * 64; \
    _Pragma("unroll") for (int i = 0; i < 8; ++i) { const int rl = 8 * (8 * wave + i) + (lane >> 3), ch = (lane & 7) ^ ((rl >> 1) & 7); \
      __builtin_amdgcn_global_load_lds((const unsigned*)(src0 + (size_t)rl * 64 + ch * 8), (LAS unsigned*)(lds + (pb_) * 65536 + (8 * wave + i) * 1024), 16, 0, 0); } }
  int pb = 0;
  bf16x8 qn[8][2], wvn;
#define ISC_QLOAD(u_) { int b_, j_, c_; isc_decode((u_), b_, j_, c_); const bf16_t* qr_ = pa + (size_t)(b_ * L + (8 * j_ + wave) * 16 + n16) * 2048; wvn = *(const bf16x8*)(qr_ + 1856); \
    _Pragma("unroll") for (int h = 0; h < 8; ++h) { qn[h][0] = *(const bf16x8*)(qr_ + 1280 + h * 64 + 8 * g); qn[h][1] = *(const bf16x8*)(qr_ + 1280 + h * 64 + 32 + 8 * g); } }
  if (cur < (unsigned)ISC_NU) { ISC_DMA(cur, 0) ISC_QLOAD(cur) }
  asm volatile("s_waitcnt vmcnt(0)" ::: "memory");
  __syncthreads();
  int itp = 0;
#pragma unroll 1
  while (cur < (unsigned)ISC_NU) {
    bf16x8 qf[8][2]; float w[8];
#pragma unroll
    for (int h = 0; h < 8; ++h) { qf[h][0] = qn[h][0]; qf[h][1] = qn[h][1]; w[h] = bf2f((bf16_t)wvn[h]) * (0.35355339059327373f * 0.125f); }
    if (nxt < (unsigned)ISC_NU) { ISC_DMA(nxt, pb ^ 1) ISC_QLOAD(nxt) }
    unsigned grabbed = 0u; if (tid == 0) grabbed = __hip_atomic_fetch_add(ctr, 1u, __ATOMIC_RELAXED, __HIP_MEMORY_SCOPE_AGENT);
    int b, j, c; isc_decode(cur, b, j, c);
    const int qg = 8 * j + wave, t0 = qg * 16, ntl = min(32, qg + 1 - 32 * c);
    unsigned short* srow = sc + (size_t)(HOT ? ((t0 + n16) & 63) : (b * L + t0 + n16)) * L + 4 * g + 32 * c * 16;
    const LAS unsigned char* kb0 = lds + pb * 65536 + lofs; const LAS unsigned char* kb1 = lds + pb * 65536 + lofs1;
#pragma unroll 1
    for (int tl = 0; tl < ntl; tl += 4) {
      bf16x8 k0[4], k1[4];
#pragma unroll
      for (int p = 0; p < 4; ++p) { k0[p] = *(const LAS bf16x8*)(kb0 + (tl + p) * 2048); k1[p] = *(const LAS bf16x8*)(kb1 + (tl + p) * 2048); }
#pragma unroll
      for (int p = 0; p < 4; ++p) {
        f32x4 score = (f32x4){0.f, 0.f, 0.f, 0.f};
#pragma unroll
        for (int h = 0; h < 8; h += 2) {
          f32x4 acc0 = __builtin_amdgcn_mfma_f32_16x16x32_bf16(k0[p], qf[h][0], (f32x4){0.f, 0.f, 0.f, 0.f}, 0, 0, 0);
          f32x4 acc1 = __builtin_amdgcn_mfma_f32_16x16x32_bf16(k0[p], qf[h + 1][0], (f32x4){0.f, 0.f, 0.f, 0.f}, 0, 0, 0);
          acc0 = __builtin_amdgcn_mfma_f32_16x16x32_bf16(k1[p], qf[h][1], acc0, 0, 0, 0);
          acc1 = __builtin_amdgcn_mfma_f32_16x16x32_bf16(k1[p], qf[h + 1][1], acc1, 0, 0, 0);
          const f32x4 r0 = __builtin_bit_cast(f32x4, __builtin_elementwise_max(__builtin_bit_cast(i32x4_t, acc0), (i32x4_t){0, 0, 0, 0}));
          const f32x4 r1 = __builtin_bit_cast(f32x4, __builtin_elementwise_max(__builtin_bit_cast(i32x4_t, acc1), (i32x4_t){0, 0, 0, 0}));
#pragma unroll
          for (int i = 0; i < 4; ++i) score[i] = fmaf(r1[i], w[h + 1], fmaf(r0[i], w[h], score[i]));
        }
        if (tl + p < ntl) *(v2u*)(srow + (tl + p) * 16) = (v2u){cvt_pk_f16(score[0], score[1]), cvt_pk_f16(score[2], score[3])};
      }
    }
    if (tid == 0) slot[itp] = grabbed;
    asm volatile("s_waitcnt vmcnt(0)" ::: "memory");
    __syncthreads();
    cur = nxt; nxt = slot[itp]; itp ^= 1; pb ^= 1;
  }
#undef ISC_DMA
#undef ISC_QLOAD
  __syncthreads();
}

constexpr int DW_STRIDE = 17152;
__device__ __forceinline__ unsigned offb(unsigned row, unsigned ch) { return 256u * row + 16u * (ch ^ (((row & 3u) << 2) | ((row >> 2) & 3u))); }
__device__ __forceinline__ void glds16(const void* gsrc, unsigned lds_dst) { unsigned keep;
  asm volatile("s_mov_b32 %0, m0\n\ts_mov_b32 m0, %2\n\ts_nop 0\n\tglobal_load_lds_dwordx4 %1, off\n\ts_mov_b32 m0, %0" : "=&s"(keep) : "v"(gsrc), "s"(lds_dst) : "memory"); }
__device__ __forceinline__ int wave_excl_scan(int v, int lane, int& total) {
  int x = v;
#pragma unroll
  for (int o = 1; o < 64; o <<= 1) { const int y = __shfl_up(x, o); if (lane >= o) x += y; }
  total = __shfl(x, 63); return x - v;
}
#define LDSW() asm volatile("s_waitcnt lgkmcnt(0)" ::: "memory")
__device__ __forceinline__ int wave_incl_scan_dpp(int v, int lane, int& total) {
  int x = v;
  x += __builtin_amdgcn_update_dpp(0, x, 0x111, 0xf, 0xf, true);
  x += __builtin_amdgcn_update_dpp(0, x, 0x112, 0xf, 0xf, true);
  x += __builtin_amdgcn_update_dpp(0, x, 0x114, 0xf, 0xf, true);
  x += __builtin_amdgcn_update_dpp(0, x, 0x118, 0xf, 0xf, true);
  const int t0 = __builtin_amdgcn_readlane(x, 15), t1 = __builtin_amdgcn_readlane(x, 31), t2 = __builtin_amdgcn_readlane(x, 47), t3 = __builtin_amdgcn_readlane(x, 63);
  const int row = lane >> 4;
  x += (row >= 1 ? t0 : 0) + (row >= 2 ? t1 : 0) + (row >= 3 ? t2 : 0);
  total = t0 + t1 + t2 + t3; return x;
}

__device__ __forceinline__ unsigned h2key(unsigned h) { return (h & 0x8000u) ? (~h & 0xFFFFu) : (h | 0x8000u); }
template <int MODE = 0> __device__ __forceinline__ int wave_select(const unsigned short* srow, int t, LAS unsigned char* wl, LAS unsigned short* idx16, int lane) {
  const int n = t + 1;
  if (n <= 256) { for (int i = lane; i < 256; i += 64) idx16[i] = (unsigned short)(i < n ? i : 0); LDSW(); return n; }
  LAS unsigned* hist = (LAS unsigned*)wl;
  for (int i = lane; i < 1024; i += 64) ((LAS v4u*)hist)[i] = (v4u){0u, 0u, 0u, 0u};
  unsigned bk[16][4];
#pragma unroll
  for (int hb = 0; hb < 2; ++hb) { v4u f[8]; int lane_l = lane; asm volatile("" : "+v"(lane_l));
#pragma unroll
    for (int grp = 0; grp < 2; ++grp) if ((2 * hb + grp) * 2048 < n) {
#pragma unroll
      for (int k = 0; k < 4; ++k) f[4 * grp + k] = *(const v4u*)(srow + ((8 * hb + 4 * grp + k) * 64 + lane_l) * 8); }
#pragma unroll
    for (int ii = 0; ii < 8; ++ii) { const int i = 8 * hb + ii;
      bk[i][0] = 0u; bk[i][1] = 0u; bk[i][2] = 0u; bk[i][3] = 0u;
      if (i * 512 < n) { const int e0 = (i * 64 + lane_l) * 8;
#pragma unroll
        for (int c = 0; c < 4; ++c) { const unsigned lo = f[ii][c] & 0xFFFFu, hi = f[ii][c] >> 16;
          const unsigned m0 = (e0 + 2 * c <= t) ? 0xFFFFu : 0u, m1 = (e0 + 2 * c + 1 <= t) ? 0xFFFFu : 0u;
          const unsigned b0 = (h2key(lo == 0x8000u ? 0u : lo) >> 4) & m0, b1 = (h2key(hi == 0x8000u ? 0u : hi) >> 4) & m1;
          bk[i][c] = b0 | (b1 << 16); } }
    }
    asm volatile("" ::: "memory"); }
#define BIN_OF(i, c) ((bk[i][(c) >> 1] >> (((c) & 1) * 16)) & 0xFFFFu)
  LDSW();
#if defined(SEL_REP_HIST)
#pragma unroll 1
  for (int rep_ = 0; rep_ < 2; ++rep_) {
  for (int i = lane; i < 1024; i += 64) ((LAS v4u*)hist)[i] = (v4u){0u, 0u, 0u, 0u};
  LDSW();
#endif
#pragma unroll
  for (int i = 0; i < 16; ++i) if (i * 512 < n) {
#pragma unroll
    for (int c = 0; c < 8; ++c) { const unsigned bin = BIN_OF(i, c); __hip_atomic_fetch_add(hist + bin, 1u, __ATOMIC_RELAXED, __HIP_MEMORY_SCOPE_WORKGROUP); }
    asm volatile("" ::: "memory"); }
  LDSW();
#if defined(SEL_REP_HIST)
  }
#endif
  if (MODE == 1) return 0;
  const int bbase = 4096 - 64 * (lane + 1); int ssum = 0;
#pragma unroll 16
  for (int k = 0; k < 64; ++k) ssum += (int)hist[bbase + ((k + lane) & 63)];
  int tot; const int pre = wave_incl_scan_dpp(ssum, lane, tot) - ssum;
  const unsigned long long bal = __ballot(pre < 256 && pre + ssum >= 256);
  const int Ls = (int)__builtin_ctzll(bal);
  const int cum0 = __builtin_amdgcn_readlane(pre, Ls), sb = 4096 - 64 * (Ls + 1);
  const int ck = (int)hist[sb + 63 - lane]; int t2_; const int inc = wave_incl_scan_dpp(ck, lane, t2_);
  const unsigned long long bal2 = __ballot(cum0 + inc >= 256);
  const int kk = (int)__builtin_ctzll(bal2);
  const int B1 = sb + 63 - kk, cnt_gt = cum0 + __builtin_amdgcn_readlane(inc, kk) - __builtin_amdgcn_readlane(ck, kk), need1 = 256 - cnt_gt;
  LDSW();
  if (MODE == 2) { idx16[lane] = (unsigned short)(B1 + need1); return 0; }
  const unsigned kg = (0x7FFFu - (unsigned)B1) * 0x00010001u, kge = kg + 0x00010001u;
  int ngt = 0, neq = 0;
#pragma unroll
  for (int i = 0; i < 16; ++i) if (i * 512 < n) {
#pragma unroll
    for (int c2 = 0; c2 < 4; ++c2) { const unsigned x = bk[i][c2], fg = (x + kg) & 0x80008000u, fe = ((x + kge) & 0x80008000u) & ~fg; ngt += __builtin_popcount(fg); neq += __builtin_popcount(fe); } }
  int tg, te; int pg = wave_incl_scan_dpp(ngt, lane, tg) - ngt; int pe = wave_incl_scan_dpp(neq, lane, te) - neq;
  LAS unsigned short* cand = (LAS unsigned short*)wl;
#pragma unroll
  for (int i = 0; i < 16; ++i) if (i * 512 < n) {
#pragma unroll
    for (int c2 = 0; c2 < 4; ++c2) { const unsigned x = bk[i][c2], fg = (x + kg) & 0x80008000u, fe = ((x + kge) & 0x80008000u) & ~fg; const int e = (i * 64 + lane) * 8 + 2 * c2;
      if (fg & 0x8000u) { idx16[pg] = (unsigned short)e; ++pg; }
      if (fg & 0x80000000u) { idx16[pg] = (unsigned short)(e + 1); ++pg; }
      if (fe & 0x8000u) { cand[pe] = (unsigned short)e; ++pe; }
      if (fe & 0x80000000u) { cand[pe] = (unsigned short)(e + 1); ++pe; } }
    asm volatile("" ::: "memory"); }
#undef BIN_OF
  LDSW();
  const int m = te;
  if (MODE == 3) return m;
  unsigned lo = 0u;
  if (m <= 64) {
    unsigned cpv = 0u; if (lane < m) { const unsigned ci = cand[lane]; unsigned hv = srow[ci]; hv = (hv == 0x8000u) ? 0u : hv; cpv = ((h2key(hv) & 15u) << 13) | (8191u - ci) | (1u << 20); }
    int rank = 0;
    for (int k = 0; k < m; ++k) { const unsigned ok = (unsigned)__builtin_amdgcn_readlane((int)cpv, k); rank += (ok > cpv) ? 1 : 0; }
    const bool sel = (lane < m) && (rank < need1);
    const unsigned long long bs = __ballot(sel);
    if (sel) idx16[cnt_gt + __builtin_popcountll(bs & ((1ull << lane) - 1ull))] = (unsigned short)(8191u - (cpv & 0x1FFFu));
  } else if (m <= 256) {
    unsigned cp[4];
#pragma unroll
    for (int j = 0; j < 4; ++j) { const int q = lane + 64 * j; cp[j] = 0u; if (q < m) { const unsigned ci = cand[q]; unsigned hv = srow[ci]; hv = (hv == 0x8000u) ? 0u : hv; cp[j] = ((h2key(hv) & 15u) << 13) | (8191u - ci) | (1u << 20); } }
    for (int bit = 16; bit >= 0; --bit) { const unsigned trial = lo | (1u << bit); int tc = 0;
#pragma unroll
      for (int j = 0; j < 4; ++j) tc += __builtin_popcountll(__ballot((cp[j] >> 20) && ((cp[j] & 0x1FFFFu) >= trial)));
      if (tc >= need1) lo = trial; }
    int pos = cnt_gt;
#pragma unroll
    for (int j = 0; j < 4; ++j) { const bool sel = (cp[j] >> 20) && ((cp[j] & 0x1FFFFu) >= lo); const unsigned long long bs = __ballot(sel);
      if (sel) idx16[pos + __builtin_popcountll(bs & ((1ull << lane) - 1ull))] = (unsigned short)(8191u - (cp[j] & 0x1FFFu)); pos += __builtin_popcountll(bs); }
  } else {
    for (int bit = 16; bit >= 0; --bit) { const unsigned trial = lo | (1u << bit); int c = 0;
      for (int q = lane; q < m; q += 64) { const unsigned ci = cand[q]; unsigned hv = srow[ci]; hv = (hv == 0x8000u) ? 0u : hv; const unsigned cpq = ((h2key(hv) & 15u) << 13) | (8191u - ci); c += (cpq >= trial) ? 1 : 0; }
      int tc; (void)wave_excl_scan(c, lane, tc); if (tc >= need1) lo = trial; }
    int base = cnt_gt;
    for (int q0 = 0; q0 < m; q0 += 64) { const int q = q0 + lane; bool sel = false; unsigned ci = 0;
      if (q < m) { ci = cand[q]; unsigned hv = srow[ci]; hv = (hv == 0x8000u) ? 0u : hv; const unsigned cpq = ((h2key(hv) & 15u) << 13) | (8191u - ci); sel = cpq >= lo; }
      int tc; const int pos = base + wave_excl_scan(sel ? 1 : 0, lane, tc); if (sel) idx16[pos] = (unsigned short)ci; base += tc; }
  }
  LDSW();
  return 256;
}

template <int HOT = 0> __device__ __forceinline__ void wave_attend(int b, int t, int cnt, const bf16_t* qlat, const bf16_t* cnb, LAS unsigned char* wl, LAS unsigned short* idx16, bf16_t* olat, int lane) {
  const int n16 = lane & 15, g = lane >> 4, q4 = (lane & 15) >> 2, p4 = lane & 3;
  const bf16_t* qrow = qlat + (size_t)(b * L + t) * 4096 + n16 * 256 + 8 * g;
  bf16x8 qf[8];
#pragma unroll
  for (int s = 0; s < 8; ++s) qf[s] = *(const bf16x8*)(qrow + 32 * s);
  f32x4 o[16];
#pragma unroll
  for (int c = 0; c < 16; ++c) o[c] = (f32x4){0.f, 0.f, 0.f, 0.f};
  float mrun = -INFINITY, lrun = 0.f;
  const int ntile = (cnt + 31) >> 5;
  const char* cb = (const char*)(cnb + (size_t)b * L * 256);
  const unsigned slot = lane & 15, rsub = lane >> 4;
  constexpr float SC = 0.125f * 1.4426950408889634f;
  v4u stg[16];
#define GATHER_TILE(itn) do { _Pragma("unroll") for (int rg = 0; rg < 8; ++rg) { const unsigned row = 4 * rg + rsub; const unsigned key = HOT ? (idx16[32 * (itn) + row] & 255u) : idx16[32 * (itn) + row]; \
      const unsigned ch = slot ^ (((row & 3u) << 2) | ((row >> 2) & 3u)); const unsigned off = key * 512u + ch * 16u;     \
      stg[rg] = *(const v4u*)(cb + off); stg[8 + rg] = *(const v4u*)(cb + off + 256u); } } while (0)
  GATHER_TILE(0);
#pragma unroll 1
  for (int it = 0; it < ntile; ++it) {
#pragma unroll
    for (int rg = 0; rg < 8; ++rg) { *(LAS v4u*)(wl + rg * 1024 + lane * 16) = stg[rg]; *(LAS v4u*)(wl + 8192 + rg * 1024 + lane * 16) = stg[8 + rg]; }
    LDSW();
    if (it + 1 < ntile) GATHER_TILE(it + 1);
    f32x4 s0 = (f32x4){0.f, 0.f, 0.f, 0.f}, s1 = (f32x4){0.f, 0.f, 0.f, 0.f};
    { bf16x8 fa[4];
#define QK_RD(s_, d0, d1) { const unsigned ib = ((s_) >> 2) * 8192, chq = 4 * ((s_) & 3) + g; d0 = *(const LAS bf16x8*)(wl + ib + offb(n16, chq)); d1 = *(const LAS bf16x8*)(wl + ib + offb(16 + n16, chq)); }
#pragma unroll
      for (int s = 0; s < 2; ++s) QK_RD(s, fa[2 * s], fa[2 * s + 1])
      __builtin_amdgcn_sched_barrier(0);
#pragma unroll
      for (int s = 0; s < 8; ++s) {
        s0 = __builtin_amdgcn_mfma_f32_16x16x32_bf16(fa[2 * (s & 1)], qf[s], s0, 0, 0, 0); s1 = __builtin_amdgcn_mfma_f32_16x16x32_bf16(fa[2 * (s & 1) + 1], qf[s], s1, 0, 0, 0);
        if (s < 6) QK_RD(s + 2, fa[2 * (s & 1)], fa[2 * (s & 1) + 1])
        __builtin_amdgcn_sched_barrier(0);
      } }
    const int sl0 = 32 * it + 4 * g;
    float mx = -INFINITY;
#pragma unroll
    for (int r = 0; r < 4; ++r) { s0[r] = (sl0 + r < cnt) ? s0[r] * SC : -INFINITY; s1[r] = (sl0 + 16 + r < cnt) ? s1[r] * SC : -INFINITY; mx = fmaxf(mx, fmaxf(s0[r], s1[r])); }
    { const auto r16 = __builtin_amdgcn_permlane16_swap(__float_as_uint(mx), __float_as_uint(mx), false, false); mx = fmaxf(__uint_as_float(r16[0]), __uint_as_float(r16[1]));
      const auto r32 = __builtin_amdgcn_permlane32_swap(__float_as_uint(mx), __float_as_uint(mx), false, false); mx = fmaxf(__uint_as_float(r32[0]), __uint_as_float(r32[1])); }
    const float mnew = fmaxf(mrun, mx), alpha = __builtin_amdgcn_exp2f(mrun - mnew);
    float ls = 0.f; float pv[8];
#pragma unroll
    for (int r = 0; r < 4; ++r) { pv[r] = __builtin_amdgcn_exp2f(s0[r] - mnew); pv[4 + r] = __builtin_amdgcn_exp2f(s1[r] - mnew); ls += pv[r] + pv[4 + r]; }
    lrun = lrun * alpha + ls; mrun = mnew;
#pragma unroll
    for (int c = 0; c < 16; ++c) o[c] = o[c] * alpha;
    const v4u pbw = (v4u){cvt_pk_bf16(pv[0], pv[1]), cvt_pk_bf16(pv[2], pv[3]), cvt_pk_bf16(pv[4], pv[5]), cvt_pk_bf16(pv[6], pv[7])};
    const bf16x8 pb = __builtin_bit_cast(bf16x8, pbw);
    { v4i16_t ft[4][2];
#define PV_RD(c_, d) { const unsigned ib = ((c_) >> 3) * 8192, chc = 2 * ((c_) & 7) + (p4 >> 1); \
        d[0] = __builtin_amdgcn_ds_read_tr16_b64_v4i16((LAS v4i16_t*)(wl + ib + offb(4 * g + q4, chc) + 8 * (p4 & 1))); \
        d[1] = __builtin_amdgcn_ds_read_tr16_b64_v4i16((LAS v4i16_t*)(wl + ib + offb(16 + 4 * g + q4, chc) + 8 * (p4 & 1))); }
#pragma unroll
      for (int c = 0; c < 4; ++c) PV_RD(c, ft[c])
      __builtin_amdgcn_sched_barrier(0);
#pragma unroll
      for (int c = 0; c < 16; ++c) { const v4i16_t t0 = ft[c & 3][0], t1 = ft[c & 3][1];
        const bf16x8 af = (bf16x8){t0[0], t0[1], t0[2], t0[3], t1[0], t1[1], t1[2], t1[3]};
        o[c] = __builtin_amdgcn_mfma_f32_16x16x32_bf16(af, pb, o[c], 0, 0, 0);
        if (c < 12) PV_RD(c + 4, ft[c & 3])
        __builtin_amdgcn_sched_barrier(0);
      } }
    LDSW();
  }
  lrun += __shfl_xor(lrun, 16); lrun += __shfl_xor(lrun, 32);
  const float inv = 1.f / lrun;
  bf16_t* orow = olat + (size_t)(b * L + t) * 4096 + n16 * 256 + 4 * g;
#pragma unroll
  for (int c = 0; c < 16; ++c) { const f32x4 v = o[c] * inv; *(v2u*)(orow + 16 * c) = (v2u){cvt_pk_bf16(v[0], v[1]), cvt_pk_bf16(v[2], v[3])}; }
}

__device__ __forceinline__ void ph_select_attend(const unsigned short* sc, const bf16_t* qlat, const bf16_t* cnb, bf16_t* olat, LAS unsigned char* lds, const float* w1, const float* w2, bf16_t* W1_t, bf16_t* W2_t, void* scratch_olat = nullptr) {
  const int tid = TIDX(), lane = tid & 63, wave = __builtin_amdgcn_readfirstlane(tid >> 6), blk = BIDX();
  LAS unsigned char* wl = lds + wave * DW_STRIDE; LAS unsigned short* idx16 = (LAS unsigned short*)(wl + 16384);
  LAS unsigned* qctr = (LAS unsigned*)(lds + MISC_OFF + 64);
  if (tid == 0) *qctr = 0u;
  __syncthreads();
  const int b = blk & 1, NGW = (int)gridDim.x * 8; (void)scratch_olat;
#pragma unroll 1
  for (;;) {
    unsigned item = 0u; if (lane == 0) item = __hip_atomic_fetch_add(qctr, 1u, __ATOMIC_RELAXED, __HIP_MEMORY_SCOPE_WORKGROUP);
    item = (unsigned)__builtin_amdgcn_readfirstlane((int)item);
    if (item >= 160u) break;
    const unsigned grp = item / 5u, r = item - grp * 5u;
    if (r == 0u || r == 3u) {
      const unsigned qn = grp * 2u + (r == 3u ? 1u : 0u);
      const int t = (blk >> 1) * 8 + (int)(qn & 7u) + 1024 * (7 - (int)(qn >> 3));
      int lane_s = lane; asm volatile("" : "+v"(lane_s));
#ifdef SELMODE
      { int lane_x = lane; asm volatile("" : "+v"(lane_x)); const int cx = wave_select<SELMODE>(sc + (size_t)(b * L + t) * L, t, wl, idx16, lane_x); if (cx == 12345) olat[0] = 0; }
#endif
      const int cnt = wave_select(sc + (size_t)(b * L + t) * L, t, wl, idx16, lane_s);
      int lane_a = lane; asm volatile("" : "+v"(lane_a));
      wave_attend(b, t, cnt, qlat, cnb, wl, idx16, olat, lane_a);
    } else {
      const unsigned cn = grp * 3u + (r == 1u ? 0u : (r == 2u ? 1u : 2u));
      const int wt = blk * 8 + (int)(cn & 7u) + (int)(cn >> 3) * NGW;
      int lane_t = lane; asm volatile("" : "+v"(lane_t));
      moe_weight_tile(wt < 12288 ? moe_layer_tile(0, wt) : moe_layer_tile(1, wt - 12288), w1, w2, W1_t, W2_t, lane_t);
    }
  }
}

__device__ __forceinline__ void ph_qlat(const bf16_t* pa, const bf16_t* WqT, bf16_t* qlat) {
  const int tid = TIDX(), lane = tid & 63, gw = BIDX() * 8 + (tid >> 6), NGW = (int)gridDim.x * 8;
  const int n16 = lane & 15, g = lane >> 4;
#pragma unroll 1
  for (int it = gw; it < 16 * 512; it += NGW) {
    const int h = it & 15, rt = it >> 4;
    bf16x8 qb[2][2];
#pragma unroll
    for (int mt = 0; mt < 2; ++mt)
#pragma unroll
      for (int ks = 0; ks < 2; ++ks) qb[mt][ks] = *(const bf16x8*)(pa + (size_t)(rt * 32 + mt * 16 + n16) * 2048 + h * 64 + 32 * ks + 8 * g);
    const bf16_t* wp = WqT + (size_t)h * 256 * 64 + (size_t)n16 * 64 + 8 * g;
    bf16_t* op = qlat + (size_t)(rt * 32 + n16) * 4096 + h * 256 + 4 * g;
#pragma unroll 4
    for (int ct = 0; ct < 16; ++ct) {
      const bf16x8 a0 = *(const bf16x8*)(wp + (size_t)(16 * ct) * 64), a1 = *(const bf16x8*)(wp + (size_t)(16 * ct) * 64 + 32);
#pragma unroll
      for (int mt = 0; mt < 2; ++mt) { f32x4 acc = __builtin_amdgcn_mfma_f32_16x16x32_bf16(a0, qb[mt][0], (f32x4){0.f, 0.f, 0.f, 0.f}, 0, 0, 0);
        acc = __builtin_amdgcn_mfma_f32_16x16x32_bf16(a1, qb[mt][1], acc, 0, 0, 0);
        *(v2u*)(op + (size_t)(mt * 16) * 4096 + 16 * ct) = (v2u){cvt_pk_bf16(acc[0], acc[1]), cvt_pk_bf16(acc[2], acc[3])}; }
    }
  }
}
__device__ __forceinline__ void ph_o2(const bf16_t* olat, const bf16_t* WuvT, bf16_t* o2b) {
  const int tid = TIDX(), lane = tid & 63, gw = BIDX() * 8 + (tid >> 6), NGW = (int)gridDim.x * 8;
  const int n16 = lane & 15, g = lane >> 4;
#pragma unroll 1
  for (int it = gw; it < 16 * 512; it += NGW) {
    const int h = it & 15, rt = it >> 4;
    f32x4 acc[4][2];
#pragma unroll
    for (int vt = 0; vt < 4; ++vt) { acc[vt][0] = (f32x4){0.f, 0.f, 0.f, 0.f}; acc[vt][1] = (f32x4){0.f, 0.f, 0.f, 0.f}; }
    const bf16_t* ap = olat + (size_t)(rt * 32 + n16) * 4096 + h * 256 + 8 * g;
    const bf16_t* wp = WuvT + (size_t)h * 64 * 256 + (size_t)n16 * 256 + 8 * g;
#pragma unroll
    for (int ks = 0; ks < 8; ++ks) {
      const bf16x8 b0 = *(const bf16x8*)(ap + 32 * ks), b1 = *(const bf16x8*)(ap + (size_t)16 * 4096 + 32 * ks);
#pragma unroll
      for (int vt = 0; vt < 4; ++vt) { const bf16x8 a = *(const bf16x8*)(wp + (size_t)(16 * vt) * 256 + 32 * ks);
        acc[vt][0] = __builtin_amdgcn_mfma_f32_16x16x32_bf16(a, b0, acc[vt][0], 0, 0, 0); acc[vt][1] = __builtin_amdgcn_mfma_f32_16x16x32_bf16(a, b1, acc[vt][1], 0, 0, 0); }
    }
    bf16_t* op = o2b + (size_t)(rt * 32 + n16) * 1024 + h * 64 + 4 * g;
#pragma unroll
    for (int vt = 0; vt < 4; ++vt)
#pragma unroll
      for (int mt = 0; mt < 2; ++mt) *(v2u*)(op + (size_t)(mt * 16) * 1024 + 16 * vt) = (v2u){cvt_pk_bf16(acc[vt][mt][0], acc[vt][mt][1]), cvt_pk_bf16(acc[vt][mt][2], acc[vt][mt][3])};
  }
}

namespace pg8 {
struct GroupAOrder {
    static constexpr bool GATHER = false; const int* rowmap;
    StaticOrder so; int png; size_t acol_bytes;
    __device__ void init(const void* A, int lda, const void* Bt, int ldb, int M, int N, int png_, size_t acol_bytes_, int G, int c) { so.init(A, lda, Bt, ldb, M, N, G, c); png = png_; acol_bytes = acol_bytes_; }
    __device__ bool next(int i, Unit& u) const { int pm, pn; if (!so.tile(i, pm, pn)) return false; u.pa = so.A + (size_t)pm * so.ta + (size_t)(pn / png) * acol_bytes; u.pb = so.Bt + (size_t)pn * so.tb; u.orow = pm * BM; u.ocol = pn * BM; u.e = 0; u.kind = 0; return true; }
    __device__ __forceinline__ int rowof(const Unit&, int r) const { return r; }
    __device__ __forceinline__ void a_ready(const Unit&) const {}
    __device__ __forceinline__ void done(const Unit&) const {}
};
}
constexpr int GLA_LDSU = 65536;

__device__ __forceinline__ v4i16_t trrd(LAS unsigned char* p) { return __builtin_amdgcn_ds_read_tr16_b64_v4i16((LAS v4i16_t*)p); }
__device__ __forceinline__ bf16x8 cat44(v4i16_t a, v4i16_t b) { return (bf16x8){a[0], a[1], a[2], a[3], b[0], b[1], b[2], b[3]}; }

__device__ __forceinline__ void ph_gla_a1(const bf16_t* pb, const float* gbias, bf16_t* qt, bf16_t* og, bf16_t* kvt, float* dcy, LAS unsigned char* lds, const float* w1, const float* w2, bf16_t* W1_t, bf16_t* W2_t) {
  const int tid = TIDX(), lane = tid & 63, wave = __builtin_amdgcn_readfirstlane(tid >> 6), blk = BIDX();
  const int half = wave >> 2, wq = wave & 3;
  LAS unsigned char* X = lds + half * GLA_LDSU; LAS unsigned char* Y = X + 16384; LAS unsigned char* V = X + 32768;
  LAS float* EX = (LAS float*)(lds + 131072 + half * 2048);
  const unsigned v_addr = (unsigned)__builtin_amdgcn_readfirstlane((int)(unsigned)(size_t)V);
  const int n16 = lane & 15, g = lane >> 4, q4 = (lane & 15) >> 2, p4 = lane & 3;
#pragma unroll 1
  for (int uu = 0; uu < 2; ++uu) {
    const int u = blk * 4 + half * 2 + uu;
    const int h = u & 3, bc = u >> 2, r0 = bc * 64;
    { const unsigned slot = lane & 15, rsub = lane >> 4; const int im = wq;
#pragma unroll
      for (int rg = 0; rg < 8; ++rg) { const unsigned row = 4 * rg + rsub; const unsigned ch = slot ^ (((row & 3u) << 2) | ((row >> 2) & 3u));
        const char* src = (const char*)(pb + (size_t)(r0 + 32 * (im >> 1) + row) * 3584 + 1024 + h * 256 + (im & 1) * 128) + ch * 16;
        glds16(src, v_addr + im * 8192 + rg * 1024); } }
    const int d0 = 2 * lane; const float gb0 = gbias[h * 128 + d0], gb1 = gbias[h * 128 + d0 + 1];
    const unsigned wofs = 16u * ((unsigned)(d0 >> 3)), wsub = (unsigned)(d0 & 7) * 2u;
    unsigned gq[16], qq[16], kq[16]; float bl0[16], bl1[16];
#pragma unroll
    for (int jj = 0; jj < 16; ++jj) { const bf16_t* rp = pb + (size_t)(r0 + wq * 16 + jj) * 3584 + h * 128 + d0;
      gq[jj] = *(const unsigned*)(rp + 3072); qq[jj] = *(const unsigned*)rp; kq[jj] = *(const unsigned*)(rp + 512); }
    float bc0 = 0.f, bc1 = 0.f;
#pragma unroll
    for (int jj = 0; jj < 16; ++jj) { const float a0 = bf_lo(gq[jj]) + gb0, a1 = bf_hi(gq[jj]) + gb1;
      bc0 += (fminf(a0, 0.f) - __logf(1.f + __expf(-fabsf(a0)))) * (1.f / 16.f); bc1 += (fminf(a1, 0.f) - __logf(1.f + __expf(-fabsf(a1)))) * (1.f / 16.f);
      bl0[jj] = bc0; bl1[jj] = bc1; }
    *(LAS f32x2_t*)(EX + wq * 128 + d0) = (f32x2_t){bc0, bc1};
    LDSW(); __syncthreads();
    float of0 = 0.f, of1 = 0.f, tt0 = 0.f, tt1 = 0.f;
#pragma unroll
    for (int w2_ = 0; w2_ < 4; ++w2_) { const f32x2_t e = *(const LAS f32x2_t*)(EX + w2_ * 128 + d0); tt0 += e[0]; tt1 += e[1]; if (w2_ < wq) { of0 += e[0]; of1 += e[1]; } }
#pragma unroll
    for (int jj = 0; jj < 16; ++jj) { const int j = wq * 16 + jj; const float b0 = bl0[jj] + of0, b1 = bl1[jj] + of1;
      const float e0 = __expf(b0), e1 = __expf(b1), i0 = __expf(fminf(-b0, 80.f)), i1 = __expf(fminf(-b1, 80.f));
      const unsigned qo = cvt_pk_bf16(bf_lo(qq[jj]) * 0.08838834764831845f * e0, bf_hi(qq[jj]) * 0.08838834764831845f * e1);
      const unsigned ko = cvt_pk_bf16(bf_lo(kq[jj]) * i0, bf_hi(kq[jj]) * i1);
      *(unsigned*)(qt + (size_t)(r0 + j) * 512 + h * 128 + d0) = qo;
      const unsigned row = (unsigned)(j & 31); const unsigned off = (unsigned)(j >> 5) * 8192u + 256u * row + ((wofs ^ (16u * (((row & 3u) << 2) | ((row >> 2) & 3u))))) + wsub;
      *(LAS unsigned*)(X + off) = qo; *(LAS unsigned*)(Y + off) = ko; }
    if (wq == 3) *(float2*)(dcy + (size_t)u * 128 + d0) = make_float2(__expf(tt0), __expf(tt1));
    asm volatile("s_waitcnt vmcnt(0) lgkmcnt(0)" ::: "memory");
    __syncthreads();
    const int it = wq;
    bf16x8 afr[2];
#pragma unroll
    for (int ks = 0; ks < 2; ++ks) {
      unsigned pk[4] = {0u, 0u, 0u, 0u};
#pragma unroll
      for (int jh = 0; jh < 2; ++jh) { const int jt = 2 * ks + jh;
        if (jt <= it) { f32x4 acc = (f32x4){0.f, 0.f, 0.f, 0.f};
#pragma unroll
          for (int s = 0; s < 4; ++s) { const bf16x8 ya = *(const LAS bf16x8*)(Y + (jt >> 1) * 8192 + offb(n16 + 16 * (jt & 1), 4 * s + g)), xb = *(const LAS bf16x8*)(X + (it >> 1) * 8192 + offb(n16 + 16 * (it & 1), 4 * s + g));
            acc = __builtin_amdgcn_mfma_f32_16x16x32_bf16(ya, xb, acc, 0, 0, 0); }
          const int i_ = 16 * it + n16, jbase = 16 * jt + 4 * g;
#pragma unroll
          for (int r = 0; r < 4; ++r) if (jbase + r > i_) acc[r] = 0.f;
          pk[2 * jh] = cvt_pk_bf16(acc[0], acc[1]); pk[2 * jh + 1] = cvt_pk_bf16(acc[2], acc[3]); } }
      afr[ks] = __builtin_bit_cast(bf16x8, (v4u){pk[0], pk[1], pk[2], pk[3]});
    }
    bf16_t* ogp = og + (size_t)u * 16384 + (size_t)(it * 16) * 256 + lane * 4; bf16_t* kvp = kvt + (size_t)u * 32768 + (size_t)n16 * 128 + 4 * g;
#pragma unroll 2
    for (int nt = 0; nt < 16; ++nt) {
      const unsigned vimg = (unsigned)(nt >> 3) * 8192u, chv = 2u * (unsigned)(nt & 7) + (unsigned)(p4 >> 1), sub = 8u * (unsigned)(p4 & 1);
      f32x4 acc = (f32x4){0.f, 0.f, 0.f, 0.f};
      { LAS unsigned char* vb = V + vimg; const bf16x8 bi0 = cat44(trrd(vb + offb(4 * g + q4, chv) + sub), trrd(vb + offb(16 + 4 * g + q4, chv) + sub));
        acc = __builtin_amdgcn_mfma_f32_16x16x32_bf16(afr[0], bi0, acc, 0, 0, 0); }
      if (it >= 2) { LAS unsigned char* vb = V + 16384 + vimg; const bf16x8 bi1 = cat44(trrd(vb + offb(4 * g + q4, chv) + sub), trrd(vb + offb(16 + 4 * g + q4, chv) + sub));
        acc = __builtin_amdgcn_mfma_f32_16x16x32_bf16(afr[1], bi1, acc, 0, 0, 0); }
      *(v2u*)(ogp + (size_t)nt * 256) = (v2u){cvt_pk_bf16(acc[0], acc[1]), cvt_pk_bf16(acc[2], acc[3])};
    }
#pragma unroll 1
    for (int nq = 0; nq < 4; ++nq) { const int nt = 4 * wq + nq;
      const unsigned vimg = (unsigned)(nt >> 3) * 8192u, chv = 2u * (unsigned)(nt & 7) + (unsigned)(p4 >> 1), sub = 8u * (unsigned)(p4 & 1);
      bf16x8 bn[2];
#pragma unroll
      for (int ks = 0; ks < 2; ++ks) { LAS unsigned char* vb = V + ks * 16384 + vimg; bn[ks] = cat44(trrd(vb + offb(8 * g + q4, chv) + sub), trrd(vb + offb(8 * g + 4 + q4, chv) + sub)); }
#pragma unroll
      for (int mt = 0; mt < 8; ++mt) { const unsigned chy = 2u * (unsigned)mt + (unsigned)(p4 >> 1);
        const bf16x8 a0 = cat44(trrd(Y + offb(8 * g + q4, chy) + sub), trrd(Y + offb(8 * g + 4 + q4, chy) + sub));
        const bf16x8 a1 = cat44(trrd(Y + 8192 + offb(8 * g + q4, chy) + sub), trrd(Y + 8192 + offb(8 * g + 4 + q4, chy) + sub));
        f32x4 acc = __builtin_amdgcn_mfma_f32_16x16x32_bf16(a0, bn[0], (f32x4){0.f, 0.f, 0.f, 0.f}, 0, 0, 0);
        acc = __builtin_amdgcn_mfma_f32_16x16x32_bf16(a1, bn[1], acc, 0, 0, 0);
        *(v2u*)(kvp + (size_t)(16 * nt) * 128 + 16 * mt) = (v2u){cvt_pk_bf16(acc[0], acc[1]), cvt_pk_bf16(acc[2], acc[3])}; }
    }
    LDSW(); __syncthreads();
  }
}

__device__ __forceinline__ void ph_gla_a2(const bf16_t* kvt, const float* dcy, bf16_t* spt) {
  const int gtid = BIDX() * NTHR + TIDX();
  if (gtid >= 8 * 256 * 32) return;
  const int g4 = gtid & 31, dv = (gtid >> 5) & 255, bh = gtid >> 13, b = bh >> 2, h = bh & 3;
  f32x4 S = (f32x4){0.f, 0.f, 0.f, 0.f};
#pragma unroll 4
  for (int c = 0; c < 128; ++c) { const size_t u = (size_t)((b * 128 + c) * 4 + h);
    const v2u kvb = *(const v2u*)(kvt + u * 32768 + (size_t)dv * 128 + 4 * g4); const f32x4 kv = (f32x4){bf_lo(kvb[0]), bf_hi(kvb[0]), bf_lo(kvb[1]), bf_hi(kvb[1])}, dc = *(const f32x4*)(dcy + u * 128 + 4 * g4);
    *(v2u*)(spt + u * 32768 + (size_t)dv * 128 + 4 * g4) = (v2u){cvt_pk_bf16(S[0], S[1]), cvt_pk_bf16(S[2], S[3])};
    S = dc * (S + kv); }
}

constexpr int A3_LD = 272;
__device__ __forceinline__ void ph_gla_a3(const bf16_t* pb, const bf16_t* qt, const bf16_t* og, const bf16_t* spt, const float* ng, bf16_t* ob, LAS unsigned char* lds) {
  const int tid = TIDX(), lane = tid & 63, wave = __builtin_amdgcn_readfirstlane(tid >> 6), gw = BIDX() * 8 + wave, NGW = (int)gridDim.x * 8;
  const int n16 = lane & 15, g = lane >> 4, row16 = lane >> 2, cq = lane & 3;
  LAS float* T = (LAS float*)(lds + wave * (16 * A3_LD * 4));
#pragma unroll 1
  for (int w = gw; w < 4096; w += NGW) {
    const int u = w >> 2, it = w & 3, h = u & 3, r0 = (u >> 2) * 64;
    const bf16_t* sp = spt + (size_t)u * 32768 + (size_t)n16 * 128 + 8 * g;
    bf16x8 qa[4];
#pragma unroll
    for (int ks = 0; ks < 4; ++ks) qa[ks] = *(const bf16x8*)(qt + (size_t)(r0 + 16 * it + n16) * 512 + h * 128 + 32 * ks + 8 * g);
    const bf16_t* ogp = og + (size_t)u * 16384 + (size_t)(it * 16) * 256 + lane * 4;
#pragma unroll
    for (int nt = 0; nt < 16; ++nt) {
      const v2u ogb = *(const v2u*)(ogp + nt * 256); f32x4 acc = (f32x4){bf_lo(ogb[0]), bf_hi(ogb[0]), bf_lo(ogb[1]), bf_hi(ogb[1])};
#pragma unroll
      for (int ks = 0; ks < 4; ++ks) { const bf16x8 sb = *(const bf16x8*)(sp + (size_t)(16 * nt) * 128 + 32 * ks); acc = __builtin_amdgcn_mfma_f32_16x16x32_bf16(qa[ks], sb, acc, 0, 0, 0); }
#pragma unroll
      for (int r = 0; r < 4; ++r) T[(4 * g + r) * A3_LD + 16 * nt + n16] = acc[r];
    }
    LDSW();
    const size_t row = (size_t)(r0 + 16 * it + row16);
    f32x4 v[16]; float ss = 0.f;
#pragma unroll
    for (int k = 0; k < 16; ++k) { v[k] = *(const LAS f32x4*)(T + row16 * A3_LD + 16 * k + 4 * cq); ss += (v[k][0] * v[k][0] + v[k][1] * v[k][1]) + (v[k][2] * v[k][2] + v[k][3] * v[k][3]); }
    ss += __shfl_xor(ss, 1); ss += __shfl_xor(ss, 2);
    const float rs = rsqrtf(ss * (1.f / 256.f) + 1e-6f);
#pragma unroll
    for (int k = 0; k < 16; ++k) { const int col = h * 256 + 16 * k + 4 * cq; const v2u rg = *(const v2u*)(pb + row * 3584 + 2048 + col); const f32x4 gn = *(const f32x4*)(ng + col);
      const float rr[4] = {bf_lo(rg[0]), bf_hi(rg[0]), bf_lo(rg[1]), bf_hi(rg[1])}; float o[4];
#pragma unroll
      for (int z = 0; z < 4; ++z) o[z] = v[k][z] * rs * gn[z] * (rr[z] * __builtin_amdgcn_rcpf(1.f + __expf(-rr[z])));
      *(v2u*)(ob + row * 1024 + col) = (v2u){cvt_pk_bf16(o[0], o[1]), cvt_pk_bf16(o[2], o[3])}; }
    LDSW();
  }
}
#ifndef PROBE
#define PROBE 0
#endif
#ifndef PROBE_S
#define PROBE_S 10.0f
#endif
constexpr size_t MiB = 1u << 20;
constexpr size_t WS_CTL = 0, CTL_ZERO_BYTES = 1 * MiB;
constexpr int CW_BAR = 4096, CW_TMO = 64, CW_RDY = 65536, CW_ISC = 1024;
constexpr size_t WS_NEEDED = 2048 * MiB;

struct Args { In in; float* out; unsigned char* ws; };

struct Opt { bf16_t *qt, *spt, *og, *kvt; float *dcy; bf16_t *Wql_t, *Wuv_t, *cnb, *kib, *qlat, *olat; unsigned short* sc; bf16_t *xb, *WA_t, *WoutA_t, *WB_t, *WoutB_t, *W1_t, *W2_t, *projA_b, *hbf, *o2b, *xs, *act, *Ys, *projB_b; MoeBufs m; };
__device__ __forceinline__ nvp::Ws carve_ws(unsigned char* ws) {
  nvp::Ws w; auto at = [&](size_t mib) { return (char*)ws + mib * MiB; };
  w.projA = (float*)at(2); w.cn = (float*)at(119); w.sc = (float*)at(135); w.idx = (int*)at(647); w.o2 = (float*)at(663);
  w.x1 = (float*)at(727); w.x2 = (float*)at(791);
  w.projB = (float*)at(135); w.adec = (float*)at(135 + 194); w.og = (float*)at(135 + 194 + 32); w.on = (float*)at(135 + 194 + 32 + 64);
  w.counts = nullptr; w.h = nullptr; w.hb = nullptr; w.ys = nullptr; w.tok_e = nullptr; w.tok_g = nullptr; w.slot_of = nullptr; w.row_tok = nullptr; w.row_gate = nullptr; w.blk_e = nullptr;
  return w;
}
__device__ __forceinline__ Opt carve_opt(unsigned char* ws) {
  Opt o; auto at = [&](size_t mib) { return (bf16_t*)((char*)ws + mib * MiB); };
  char* sm = (char*)ws + 855 * MiB;
  o.m.tok_e = (int*)sm; o.m.tok_g = (float*)(sm + 256 * 1024); o.m.slot_of = (int*)(sm + 512 * 1024); o.m.slot_gate = (float*)(sm + 768 * 1024); o.m.blk_e = (int*)(sm + 1088 * 1024); o.m.blkcnt = (int*)(sm + 1096 * 1024); o.m.nblk = (int*)(sm + 1160 * 1024); o.m.slot_tok = (int*)(sm + 1200 * 1024);
  o.WA_t = at(860); o.WoutA_t = at(864); o.WB_t = at(866); o.WoutB_t = at(873);
  o.Wql_t = at(875); o.Wuv_t = at(877); o.olat = at(2); o.cnb = at(647); o.kib = at(656); o.qlat = at(1856); o.sc = (unsigned short*)at(135);
  o.qt = at(135); o.dcy = (float*)at(151); o.og = at(152); o.kvt = at(216); o.spt = at(344);
  o.W1_t = at(880); o.W2_t = at(1136);
  o.xb = at(1264); o.projA_b = at(1296); o.hbf = at(1360); o.o2b = at(1392);
  o.xs = at(1424); o.act = at(1568); o.Ys = at(1712); o.projB_b = at(1856);
  return o;
}

struct ProIn { const float *a_w_uk, *a_w_uv, *x, *a_w_in, *a_w_out, *b_w_in, *b_w_g2, *b_w_out, *m_w1, *m_w2; };
__device__ __forceinline__ void ph_prologue(const ProIn I, const Opt& o) {
  const int tid = TIDX(), lane = tid & 63, gw = BIDX() * 8 + (tid >> 6), NGW = (int)gridDim.x * 8, gtid = BIDX() * NTHR + tid, NGT = (int)gridDim.x * NTHR;
  cvt_f32_to_bf16(I.x, D, o.xb, D, NT, D, gtid, NGT);
  zero_rect(o.WA_t, D, DINA, 2048 - DINA, 0, D * 2, gtid, NGT);
  for (int i = gtid; i < 512 * 256; i += NGT) { const int n = i >> 8, k4 = (i & 255) * 4; float a[4];
#pragma unroll
    for (int z = 0; z < 4; ++z) { const float* gl = I.b_w_in + (size_t)(k4 + z) * DINB + 2048; float s = 0.f;
#pragma unroll
      for (int j = 0; j < 16; ++j) s = fmaf(gl[j], I.b_w_g2[j * 512 + n], s);
      a[z] = s; }
    *(v2u*)(o.WB_t + (size_t)(3072 + n) * D + k4) = (v2u){cvt_pk_bf16(a[0], a[1]), cvt_pk_bf16(a[2], a[3])}; }
  int w0 = 0;
#pragma unroll 1
  for (int h = 0; h < 16; ++h) {
    transpose_job(mk_tjob(I.a_w_uk + (size_t)h * 64 * 256, 256, 64, 256, o.Wql_t, 256, h * 256, (h & 3) * 64, 0), w0, gw, NGW, lane);
    transpose_job(mk_tjob(I.a_w_uv + (size_t)h * 256 * 64, 64, 256, 64, o.Wuv_t, 1024, h * 64, (h & 3) * 256, 0), w0, gw, NGW, lane);
    for (int hp = 0; hp < 4; ++hp) if (hp != (h & 3)) { zero_rect(o.Wql_t, 256, h * 256, 256, hp * 128, 128, gtid, NGT); zero_rect(o.Wuv_t, 1024, h * 64, 64, hp * 512, 512, gtid, NGT); }
  }
  transpose_job(mk_tjob(I.a_w_in, DINA, D, DINA, o.WA_t, D, 0, 0, 0), w0, gw, NGW, lane);
  transpose_job(mk_tjob(I.a_w_out, D, D, D, o.WoutA_t, D, 0, 0, 0), w0, gw, NGW, lane);
  transpose_job(mk_tjob(I.b_w_in, DINB, D, 2048, o.WB_t, D, 0, 0, 0), w0, gw, NGW, lane);
  transpose_job(mk_tjob(I.b_w_in + 2064, DINB, D, 1024, o.WB_t, D, 2048, 0, 0), w0, gw, NGW, lane);
  transpose_job(mk_tjob(I.b_w_out, D, D, D, o.WoutB_t, D, 0, 0, 0), w0, gw, NGW, lane);
}
__device__ __forceinline__ void ph_gla_shim(const bf16_t* pb, const float* gbias, float* projB, float* adec) {
  const int gtid = BIDX() * NTHR + TIDX(), NGT = (int)gridDim.x * NTHR;
  for (size_t i = gtid; i < (size_t)NT * 896; i += NGT) { const size_t r = i / 896; const int c = (int)(i % 896) * 4; const v2u v = *(const v2u*)(pb + r * 3584 + c);
    const f32x4 f = (f32x4){bf_lo(v[0]), bf_hi(v[0]), bf_lo(v[1]), bf_hi(v[1])};
    if (c < 2048) *(f32x4*)(projB + r * DINB + c) = f;
    else if (c < 3072) *(f32x4*)(projB + r * DINB + 2064 + (c - 2048)) = f;
    else { f32x4 o;
#pragma unroll
      for (int z = 0; z < 4; ++z) { const float a = f[z] + gbias[c - 3072 + z]; const float ls = fminf(a, 0.f) - log1pf(expf(-fabsf(a))); o[z] = expf(ls * (1.f / 16.f)); }
      *(f32x4*)(adec + r * 512 + (c - 3072)) = o; } }
}

#if PROBE == 3
#define GLA_PHASES \
      PH_BEGIN ph_gla_shim(o.projB_b, I.b_g_bias, w.projB, w.adec); PH_END \
      GRID_BAR(); \
      PH_BEGIN nvp::np_gla_scan(w.projB, w.adec, w.og, fl); PH_END \
      GRID_BAR(); \
      PH_BEGIN nvp::np_gla_norm(w.og, w.projB, I.b_norm, w.on); PH_END \
      GRID_BAR(); \
      PH_BEGIN cvt_f32_to_bf16(w.on, D, o.o2b, D, NT, D, gtid_, NGT_); PH_END \
      GRID_BAR(); \
      PH_BEGIN ph_gla_a1(o.projB_b, I.b_g_bias, (bf16_t*)(wsb_ + 489 * MiB), (bf16_t*)(wsb_ + 506 * MiB), (bf16_t*)(wsb_ + 880 * MiB), (float*)(wsb_ + 505 * MiB), ll, I.m_w1, I.m_w2, o.W1_t, o.W2_t); PH_END \
      GRID_BAR(); \
      PH_BEGIN ph_gla_a2((bf16_t*)(wsb_ + 880 * MiB), (float*)(wsb_ + 505 * MiB), (bf16_t*)(wsb_ + 1136 * MiB)); PH_END \
      GRID_BAR(); \
      PH_BEGIN ph_gla_a3(o.projB_b, (bf16_t*)(wsb_ + 489 * MiB), (bf16_t*)(wsb_ + 506 * MiB), (bf16_t*)(wsb_ + 1136 * MiB), I.b_norm, (bf16_t*)(wsb_ + 570 * MiB), ll); PH_END \
      GRID_BAR(); \
      PH_BEGIN { unsigned* fl_ = (unsigned*)(wsb_ + 512 * 1024); unsigned bits = 0u; \
        { const bf16_t* a = (const bf16_t*)(wsb_ + 489 * MiB); for (size_t i = gtid_; i < (size_t)NT * 512; i += NGT_) { const float v = bf2f(a[i]); if (!(fabsf(v) < 1e30f)) bits |= 1u; } } \
        { const float* a = (const float*)(wsb_ + 506 * MiB); for (size_t i = gtid_; i < (size_t)NT * 1024; i += NGT_) { const float v = a[i]; if (!(fabsf(v) < 1e30f)) bits |= 2u; } } \
        { const float* a = (const float*)(wsb_ + 880 * MiB); for (size_t i = gtid_; i < (size_t)1024 * 32768; i += NGT_) { const float v = a[i]; if (!(fabsf(v) < 1e30f)) bits |= 4u; } } \
        { const bf16_t* a = (const bf16_t*)(wsb_ + 1136 * MiB); for (size_t i = gtid_; i < (size_t)1024 * 32768; i += NGT_) { const float v = bf2f(a[i]); if (!(fabsf(v) < 1e30f)) bits |= 8u; } } \
        { const bf16_t* a = (const bf16_t*)(wsb_ + 570 * MiB); for (size_t i = gtid_; i < (size_t)NT * 1024; i += NGT_) { const float v = bf2f(a[i]); if (!(fabsf(v) < 1e30f)) bits |= 16u; } } \
        { const float* a = (const float*)(wsb_ + 505 * MiB); for (size_t i = gtid_; i < (size_t)1024 * 128; i += NGT_) { const float v = a[i]; if (!(fabsf(v) < 1e30f)) bits |= 32u; } } \
        if (bits) atomicOr(fl_, bits); \
        { float* pd = (float*)(wsb_ + 1968 * MiB); const bf16_t* ob = (const bf16_t*)(wsb_ + 570 * MiB); for (size_t i = gtid_; i < (size_t)NT * D; i += NGT_) pd[i] = bf2f(ob[i]) - w.on[i]; } } PH_END \
      GRID_BAR();
#else
#define GLA_PHASES \
      PH_BEGIN ph_gla_a1(o.projB_b, I.b_g_bias, o.qt, o.og, o.kvt, o.dcy, ll, I.m_w1, I.m_w2, o.W1_t, o.W2_t); PH_END \
      GRID_BAR(); \
      PH_BEGIN ph_gla_a2(o.kvt, o.dcy, o.spt); PH_END \
      GRID_BAR(); \
      PH_BEGIN ph_gla_a3(o.projB_b, o.qt, o.og, o.spt, I.b_norm, o.o2b, ll); PH_END \
      GRID_BAR();
#endif
#if defined(FUSE_ON)
#define MOE_GEMM_PHASES(li) \
    PH_BEGIN pg8::MoeFusedOrder S; S.init(o.xs, o.act, o.W1_t + (size_t)li * 32 * 2048 * D, o.W2_t + (size_t)li * 32 * D * D, o.m.slot_tok, o.m.blk_e, (unsigned*)(wsb_ + WS_CTL) + CW_RDY + li * 32768, (unsigned*)(wsb_ + WS_CTL) + CW_TMO, __builtin_amdgcn_readfirstlane(*o.m.nblk), G_, BIDX()); S.mode = 0; \
      gemm_phase<pg8::EpiMoeFused, pg8::MoeFusedOrder, true, true>(ll, Gemm{D, D, D}, S, pg8::EpiMoeFused{o.act, I.m_b1 + (size_t)li * 32 * 2048, o.Ys, I.m_b2 + (size_t)li * 32 * D, o.m.slot_gate}); PH_END \
    GRID_BAR();
#else
#define MOE_GEMM_PHASES(li) \
    PH_BEGIN pg8::MoeOrderG S; S.init(o.xs, D, o.W1_t + (size_t)li * 32 * 2048 * D, D, (size_t)2048 * D * 2, __builtin_amdgcn_readfirstlane(*o.m.nblk), 8, 128, o.m.blk_e, G_, BIDX()); S.rowmap = o.m.slot_tok; \
      gemm_phase<pg8::EpiSwiglu, pg8::MoeOrderG, true, true>(ll, Gemm{D, D, D}, S, pg8::EpiSwiglu{o.act, D, I.m_b1 + (size_t)li * 32 * 2048}); PH_END \
    GRID_BAR(); \
    PH_BEGIN MoeOrder S; S.init(o.act, D, o.W2_t + (size_t)li * 32 * D * D, D, (size_t)D * D * 2, __builtin_amdgcn_readfirstlane(*o.m.nblk), 4, 256, o.m.blk_e, G_, BIDX()); \
      gemm_phase<pg8::EpiMoe2, MoeOrder, true, true>(ll, Gemm{D, D, D}, S, pg8::EpiMoe2{o.Ys, D, I.m_b2 + (size_t)li * 32 * D, o.m.slot_gate}); PH_END \
    GRID_BAR();
#endif
#ifdef LNR_MODE
#define LNR_EXTRA(li) PH_BEGIN if (li == 0) ph_ln_router<false, LNR_MODE>(I.x, o.hbf, I.ln1_g + li * D, I.ln1_b + li * D, I.m_w_router + (size_t)li * D * 32, I.m_b_router + li * 32, o.xs, o.m, fl); else ph_ln_router<true, LNR_MODE>(o.xb, o.hbf, I.ln1_g + li * D, I.ln1_b + li * D, I.m_w_router + (size_t)li * D * 32, I.m_b_router + li * 32, o.xs, o.m, fl); PH_END GRID_BAR();
#else
#define LNR_EXTRA(li)
#endif
#define LAYER_BODY(li) \
    if (li == 1) { \
      PH_BEGIN StaticOrder S; S.init(o.xb, D, o.WB_t, D, NT, 3584, G_, BIDX()); gemm_phase<EpiStore, StaticOrder, true, true>(ll, Gemm{D, D, D}, S, EpiStore{o.projB_b, 3584}); PH_END \
      GRID_BAR(); \
      GLA_PHASES \
      PH_BEGIN StaticOrder S; S.init(o.o2b, D, o.WoutB_t, D, NT, D, G_, BIDX()); gemm_phase<EpiStore, StaticOrder, true, true>(ll, Gemm{D, D, D}, S, EpiStore{o.hbf, D}); PH_END \
      GRID_BAR(); \
    } \
LNR_EXTRA(li) \
    PH_BEGIN if (li == 0) ph_ln_router<false>(I.x, o.hbf, I.ln1_g + li * D, I.ln1_b + li * D, I.m_w_router + (size_t)li * D * 32, I.m_b_router + li * 32, o.xs, o.m, fl); else ph_ln_router<true>(o.xb, o.hbf, I.ln1_g + li * D, I.ln1_b + li * D, I.m_w_router + (size_t)li * D * 32, I.m_b_router + li * 32, o.xs, o.m, fl); PH_END \
    GRID_BAR(); \
    PH_BEGIN ph_moe_scatter(o.m, (int*)lds); PH_END \
    GRID_BAR(); \
MOE_GEMM_PHASES(li) \
    PH_BEGIN ph_combine_ln(o.xs, o.Ys, o.m.slot_of, I.ln2_g + li * D, I.ln2_b + li * D, li == 0 ? nullptr : out_, li == 0 ? o.xb : nullptr); PH_END \
    if (li == 0) GRID_BAR();
__global__ void __launch_bounds__(NTHR, 2) mk_fwd(Args args) {
  extern __shared__ __attribute__((aligned(16))) unsigned char lds[];
  volatile LAS unsigned* MISC = (volatile LAS unsigned*)((LAS unsigned char*)lds + MISC_OFF);
  if (threadIdx.x < 32) MISC[threadIdx.x] = 0u;
  __syncthreads();
  XcdBarrier bar; { const __attribute__((address_space(4))) Args* ka0 = (const __attribute__((address_space(4))) Args*)__builtin_amdgcn_kernarg_segment_ptr(); bar = xcd_barrier_post((unsigned*)(ka0->ws + WS_CTL) + CW_BAR, MISC + 8); }
#define GRID_BAR() xcd_barrier(bar)
#define PH_BEGIN { const __attribute__((address_space(4))) Args* ka_ = (const __attribute__((address_space(4))) Args*)__builtin_amdgcn_kernarg_segment_ptr(); asm volatile("" : "+s"(ka_)); \
    float* const out_ = ka_->out; (void)out_; unsigned char* wsb_ = ka_->ws; const nvp::Ws w = carve_ws(wsb_); (void)w; const Opt o = carve_opt(wsb_); (void)o; \
    const int gtid_ = BIDX() * NTHR + TIDX(), NGT_ = (int)gridDim.x * NTHR; (void)gtid_; (void)NGT_; const int G_ = (int)gridDim.x; (void)G_;
#define PH_END }
#define I (ka_->in)
  float* fl = (float*)lds; LAS unsigned char* ll = (LAS unsigned char*)lds;
  using pg8::gemm_phase; using pg8::StaticOrder; using pg8::MoeOrder; using pg8::Gemm; using pg8::EpiStore;
  PH_BEGIN ph_prologue(ProIn{I.a_w_uk, I.a_w_uv, I.x, I.a_w_in, I.a_w_out, I.b_w_in, I.b_w_g2, I.b_w_out, I.m_w1, I.m_w2}, o); PH_END
  GRID_BAR();
  PH_BEGIN StaticOrder S; S.init(o.xb, D, o.WA_t, D, NT, 2048, G_, BIDX()); gemm_phase<pg8::EpiStoreKi, StaticOrder, true, true>(ll, Gemm{D, D, D}, S, pg8::EpiStoreKi{o.projA_b, 2048, o.kib, 1792}); PH_END
  GRID_BAR();
  PH_BEGIN ph_cnorm_b(o.projA_b, I.a_kv_norm, o.cnb); PH_END
  PH_BEGIN pg8::GroupAOrder S; S.init(o.projA_b, 2048, o.Wql_t, 256, NT, 4096, 4, 512, G_, BIDX()); gemm_phase<EpiStore, pg8::GroupAOrder, true, true>(ll, Gemm{2048, 256, 256}, S, EpiStore{o.qlat, 4096}); PH_END
#ifdef ISC_HOT
  PH_BEGIN ph_iscore<ISC_HOT>(o.projA_b, o.kib, (unsigned short*)o.act, (unsigned*)(wsb_ + WS_CTL) + CW_ISC + 64, ll); PH_END
  GRID_BAR();
#endif
  PH_BEGIN ph_iscore(o.projA_b, o.kib, o.sc, (unsigned*)(wsb_ + WS_CTL) + CW_ISC, ll); PH_END
  GRID_BAR();
  PH_BEGIN ph_select_attend(o.sc, o.qlat, o.cnb, o.olat, ll, I.m_w1, I.m_w2, o.W1_t, o.W2_t, o.act); PH_END
  GRID_BAR();
  PH_BEGIN pg8::GroupAOrder S; S.init(o.olat, 4096, o.Wuv_t, 1024, NT, 1024, 1, 2048, G_, BIDX()); gemm_phase<EpiStore, pg8::GroupAOrder, true, true>(ll, Gemm{4096, 1024, 1024}, S, EpiStore{o.o2b, D}); PH_END
  GRID_BAR();
#if PROBE == 2
  PH_BEGIN cvt_bf16_to_f32(o.projA_b, 2048, w.projA, DINA, NT, DINA, gtid_, NGT_); PH_END
  GRID_BAR();
  PH_BEGIN nvp::np_cnorm(w.projA, I.a_kv_norm, w.cn); PH_END
  PH_BEGIN nvp::np_iscore(w.projA, w.sc, fl); PH_END
  GRID_BAR();
  PH_BEGIN nvp::np_topk(w.sc, w.idx, (char*)lds); PH_END
  GRID_BAR();
  PH_BEGIN nvp::np_dsa_attn(w.projA, w.cn, w.idx, I.a_w_uk, I.a_w_uv, w.o2, fl); PH_END
  GRID_BAR();
  PH_BEGIN { float* pd = (float*)(wsb_ + 1968 * MiB); for (size_t i = gtid_; i < (size_t)NT * D; i += NGT_) pd[i] = bf2f(o.o2b[i]) - w.o2[i]; } PH_END
  GRID_BAR();
#endif
  PH_BEGIN StaticOrder S; S.init(o.o2b, D, o.WoutA_t, D, NT, D, G_, BIDX()); gemm_phase<EpiStore, StaticOrder, true, true>(ll, Gemm{D, D, D}, S, EpiStore{o.hbf, D}); PH_END
  GRID_BAR();
  { LAYER_BODY(0) }
  { LAYER_BODY(1) }
#if PROBE == 2 || PROBE == 3
  GRID_BAR();
#if PROBE == 3
  PH_BEGIN { if (gtid_ == 0) { const unsigned fb = *(const unsigned*)(wsb_ + 512 * 1024); out_[5] += (float)fb; } const float* pd = (const float*)(wsb_ + 1968 * MiB); for (size_t i = gtid_; i < (size_t)NT * D; i += NGT_) out_[i] += PROBE_S * pd[i]; } PH_END
#else
  PH_BEGIN { const float* pd = (const float*)(wsb_ + 1968 * MiB); for (size_t i = gtid_; i < (size_t)NT * D; i += NGT_) out_[i] += PROBE_S * pd[i]; } PH_END
#endif
#endif
}

extern "C" void kernel_launch(void* const* d_in, const int* in_sizes, int n_in, void* d_out, int out_size, void* d_ws, size_t ws_size, hipStream_t stream) {
  static int grid = 0;
  if (grid == 0) {
    if (n_in != 21 || ws_size < WS_NEEDED) { fprintf(stderr, "kernel_launch: bad inputs (n_in %d) or workspace too small (%zu needed, %zu given)\n", n_in, (size_t)WS_NEEDED, ws_size); grid = -1; return; }
    int dev = 0, cus = 0, per_cu = 0;
    if (hipGetDevice(&dev) != hipSuccess || hipDeviceGetAttribute(&cus, hipDeviceAttributeMultiprocessorCount, dev) != hipSuccess) { grid = -1; return; }
    if (hipFuncSetAttribute((const void*)mk_fwd, hipFuncAttributeMaxDynamicSharedMemorySize, LDS_BYTES) != hipSuccess) { fprintf(stderr, "kernel_launch: hipFuncSetAttribute failed\n"); grid = -1; return; }
    if (hipOccupancyMaxActiveBlocksPerMultiprocessor(&per_cu, (const void*)mk_fwd, NTHR, LDS_BYTES) != hipSuccess || per_cu < 1) fprintf(stderr, "kernel_launch: note: occupancy query reports %d\n", per_cu);
    (void)hipGetLastError();
    grid = cus;
    if (grid != 256) fprintf(stderr, "kernel_launch: built for 256 CUs (token ownership per workgroup); got %d\n", grid);
  }
  if (grid < 0) return;
  if (hipMemsetAsync((char*)d_ws + WS_CTL, 0, CTL_ZERO_BYTES, stream) != hipSuccess) { fprintf(stderr, "kernel_launch: memset failed\n"); return; }
  Args a; memset(&a, 0, sizeof(a));
  const float** f = (const float**)&a.in;
  for (int i = 0; i < 21; ++i) f[i] = (const float*)d_in[i];
  a.out = (float*)d_out; a.ws = (unsigned char*)d_ws;
  hipLaunchKernelGGL(mk_fwd, dim3(grid), dim3(NTHR), LDS_BYTES, stream, a);
  const hipError_t le = hipPeekAtLastError();
  if (le != hipSuccess) fprintf(stderr, "kernel_launch: launch failed: %s\n", hipGetErrorName(le));
}
```

```cpp
#include <hip/hip_runtime.h>
#include <cstdio>
#include <cstdint>
#include <cstring>

#define GAS __attribute__((address_space(1)))
#define LAS __attribute__((address_space(3)))
#define NTHR 512
constexpr int LDS_BYTES = 147456;
constexpr int MISC_OFF = 131072 + 8192;

#define XB_TMO      128
#define XB_XCNT(j)  (256  + 64 * (j))
#define XB_XSUB(j)  (1280 + 64 * (j))
#define XB_XGEN(j)  (2304 + 64 * (j))
#define XB_TOP      3328
#define XB_TOPGEN   3392
#define XCD_BAR_WORDS 3456
#define XB_SPIN_CAP (1u << 25)
__device__ __forceinline__ unsigned xb_ld(unsigned* p)              { return __hip_atomic_load(p, __ATOMIC_RELAXED, __HIP_MEMORY_SCOPE_AGENT); }
__device__ __forceinline__ unsigned xb_add(unsigned* p, unsigned v) { return __hip_atomic_fetch_add(p, v, __ATOMIC_RELAXED, __HIP_MEMORY_SCOPE_AGENT); }
__device__ __forceinline__ unsigned xb_xcc_id() { return (unsigned)__builtin_amdgcn_s_getreg((3 << 11) | 20) & 0xFu; }
#define XB_SPIN(cond, bar) do { unsigned _sp = 0; while (cond) { __builtin_amdgcn_s_sleep(1); \
    if ((++_sp & 255u) == 0u) { if (xb_ld(&(bar)[XB_TMO])) break; if (_sp > XB_SPIN_CAP) { atomicAdd(&(bar)[XB_TMO], 1u); break; } } } } while (0)
struct XcdBarrier { unsigned* bar; unsigned x; volatile LAS unsigned* st; };
__device__ __forceinline__ XcdBarrier xcd_barrier_post(unsigned* bar, volatile LAS unsigned* st) {
    XcdBarrier b; b.bar = bar; b.x = xb_xcc_id(); b.st = st;
    if (threadIdx.x == 0) (void)xb_add(&bar[XB_XCNT(b.x)], 1u);
    return b;
}
__device__ __forceinline__ void xcd_barrier_complete(unsigned* bar, unsigned x, unsigned& nloc, unsigned& nx) {
    const unsigned G = gridDim.x * gridDim.y * gridDim.z;
    unsigned sum, cnt, mine, sp = 0u;
    for (;;) {
        sum = 0u; cnt = 0u; mine = 0u;
#pragma unroll
        for (unsigned j = 0; j < 16; ++j) { const unsigned c = xb_ld(&bar[XB_XCNT(j)]); sum += c; cnt += (c > 0u) ? 1u : 0u; mine = (j == x) ? c : mine; }
        if (sum == G) break;
        __builtin_amdgcn_s_sleep(1);
        if ((++sp & 255u) == 0u) { if (xb_ld(&bar[XB_TMO])) break; if (sp > XB_SPIN_CAP) { atomicAdd(&bar[XB_TMO], 1u); break; } }
    }
    nloc = mine > 0u ? mine : 1u; nx = cnt > 0u ? cnt : 1u;
}
__device__ __forceinline__ void xcd_barrier(const XcdBarrier& b) {
    asm volatile("s_waitcnt vmcnt(0)" ::: "memory");
    __syncthreads();
    if (threadIdx.x == 0) {
        unsigned* bar = b.bar;
        __builtin_amdgcn_s_waitcnt(0);
        unsigned nloc = b.st[0], nx = b.st[1];
        if (nloc == 0u) { xcd_barrier_complete(bar, b.x, nloc, nx); b.st[0] = nloc; b.st[1] = nx; }
        const unsigned old = xb_add(&bar[XB_XSUB(b.x)], 1u);
        const unsigned gen = old / nloc;
        if (old + 1u == (gen + 1u) * nloc) {
            __builtin_amdgcn_fence(__ATOMIC_RELEASE, "agent");
            asm volatile("s_waitcnt vmcnt(0)" ::: "memory");
            const unsigned og = xb_add(&bar[XB_TOP], 1u);
            const unsigned tg = og / nx;
            if (og + 1u == (tg + 1u) * nx) xb_add(&bar[XB_TOPGEN], 1u);
            else XB_SPIN(xb_ld(&bar[XB_TOPGEN]) == tg, bar);
            __builtin_amdgcn_fence(__ATOMIC_ACQUIRE, "agent");
            xb_add(&bar[XB_XGEN(b.x)], 1u);
            asm volatile("s_waitcnt vmcnt(0)" ::: "memory");
        } else {
            XB_SPIN(xb_ld(&bar[XB_XGEN(b.x)]) == gen, bar);
            __builtin_amdgcn_fence(__ATOMIC_ACQUIRE, "agent");
            asm volatile("s_waitcnt vmcnt(0)" ::: "memory");
        }
    }
    __syncthreads();
}

constexpr int NT = 16384, D = 1024, L = 8192, NB = 2;
constexpr int DINA = 1864, DINB = 3088;
constexpr int PMAX = 73728;
constexpr float ALPHA = 1.4142135623730951f;

struct In { const float *x, *a_w_in, *a_kv_norm, *a_w_uk, *a_w_uv, *a_w_out, *b_w_in, *b_w_g2, *b_g_bias, *b_norm, *b_w_out, *m_w_router, *m_b_router, *m_w1, *m_b1, *m_w2, *m_b2, *ln1_g, *ln1_b, *ln2_g, *ln2_b; };

__device__ __forceinline__ int TIDX() { int t = threadIdx.x; asm volatile("" : "+v"(t)); return t; }
__device__ __forceinline__ int BIDX() { int t = blockIdx.x; asm volatile("" : "+s"(t)); return t; }
__device__ __forceinline__ float wave_sum(float v) {
#pragma unroll
    for (int o = 1; o < 64; o <<= 1) v += __shfl_xor(v, o);
    return v;
}
namespace nvp {
#define WSYNC() asm volatile("s_waitcnt lgkmcnt(0)" ::: "memory")
struct GemmP {
  const float* A; int lda; const int* arow;
  const float* B; int ldb; float* C; int ldc; int M, N, K;
  const int* blk_e; const int* nblk_used; size_t bstride; const float* bias; size_t bias_stride;
};
__device__ __forceinline__ GemmP mkg(const float* A, int lda, const int* arow, const float* B, int ldb, float* C, int ldc, int M, int N, int K, const int* blk_e, const int* nblk_used, size_t bstride, const float* bias, size_t bias_stride) {
  GemmP p; p.A = A; p.lda = lda; p.arow = arow; p.B = B; p.ldb = ldb; p.C = C; p.ldc = ldc; p.M = M; p.N = N; p.K = K; p.blk_e = blk_e; p.nblk_used = nblk_used; p.bstride = bstride; p.bias = bias; p.bias_stride = bias_stride; return p; }

template <int MODE>
__device__ __forceinline__ void np_sgemm(const GemmP p, float* lds) {
  float (*As)[132] = (float (*)[132])lds;
  float (*Bs)[68] = (float (*)[68])(lds + 16 * 132);
  float (*Bu)[68] = (float (*)[68])(lds + 16 * 132 + 16 * 68);
  const int tid = TIDX(), tx = tid & 15, ty = tid >> 4;
  const int ntn = (p.N + 63) / 64, ntm = p.M / 128;
  const int ar = tid >> 2, ak = (tid & 3) * 4;
  const int bk = (tid & 255) >> 4, bn4 = (tid & 15) * 4;
  for (int t = BIDX(); t < ntm * ntn; t += gridDim.x) {
    const int bm = t / ntn, bn = t % ntn;
    const float* B = p.B; const float* bias = p.bias;
    if (MODE != 0) { const int blk = (bm * 128) / 256; if (blk >= *p.nblk_used) continue; const int e = p.blk_e[blk]; B += (size_t)e * p.bstride; bias += (size_t)e * p.bias_stride; }
    const int m0 = bm * 128, n0 = bn * 64;
    const int arow = p.arow ? p.arow[m0 + ar] : (m0 + ar);
    const float* Ap = p.A + (size_t)arow * p.lda + ak;
    const bool bok = (n0 + bn4) < p.N;
    float acc[4][4] = {}, accu[4][4] = {};
    for (int k0 = 0; k0 < p.K; k0 += 16) {
      const float4 av = *(const float4*)(Ap + k0);
      As[ak + 0][ar] = av.x; As[ak + 1][ar] = av.y; As[ak + 2][ar] = av.z; As[ak + 3][ar] = av.w;
      if (tid < 256) { float4 bv = make_float4(0.f, 0.f, 0.f, 0.f); if (bok) bv = *(const float4*)(B + (size_t)(k0 + bk) * p.ldb + n0 + bn4); *(float4*)&Bs[bk][bn4] = bv; }
      else if (MODE == 1) { const float4 uv = *(const float4*)(B + (size_t)(k0 + bk) * p.ldb + 1024 + n0 + bn4); *(float4*)&Bu[bk][bn4] = uv; }
      __syncthreads();
#pragma unroll
      for (int kk = 0; kk < 16; ++kk) {
        const float4 a = *(const float4*)&As[kk][ty * 4];
        const float4 b = *(const float4*)&Bs[kk][tx * 4];
        const float aa[4] = {a.x, a.y, a.z, a.w}, bb[4] = {b.x, b.y, b.z, b.w};
#pragma unroll
        for (int i = 0; i < 4; ++i)
#pragma unroll
          for (int j = 0; j < 4; ++j) acc[i][j] = fmaf(aa[i], bb[j], acc[i][j]);
        if (MODE == 1) {
          const float4 u = *(const float4*)&Bu[kk][tx * 4]; const float uu[4] = {u.x, u.y, u.z, u.w};
#pragma unroll
          for (int i = 0; i < 4; ++i)
#pragma unroll
            for (int j = 0; j < 4; ++j) accu[i][j] = fmaf(aa[i], uu[j], accu[i][j]);
        }
      }
      __syncthreads();
    }
#pragma unroll
    for (int i = 0; i < 4; ++i) {
      const int m = m0 + ty * 4 + i;
#pragma unroll
      for (int j = 0; j < 4; ++j) {
        const int n = n0 + tx * 4 + j; if (n >= p.N) continue;
        float v = acc[i][j];
        if (MODE == 1) {
          float g = v + bias[n], u = accu[i][j] + bias[1024 + n];
          g = fminf(g, 7.f); u = fminf(fmaxf(u, -7.f), 7.f);
          const float glu = g / (1.f + expf(-1.702f * g));
          v = (u + 1.f) * glu;
        } else if (MODE == 2) v += bias[n];
        p.C[(size_t)m * p.ldc + n] = v;
      }
    }
  }
}

#define GW_INIT const int lane = TIDX() & 63, wave = TIDX() >> 6, gw = BIDX() * 8 + wave, NGW = gridDim.x * 8; (void)lane; (void)wave; (void)gw; (void)NGW

__device__ __forceinline__ void np_cnorm(const float* projA, const float* g, float* cn) {
  GW_INIT;
  for (int row = gw; row < NT; row += NGW) {
    const float4 v = *(const float4*)(projA + (size_t)row * DINA + 1024 + lane * 4);
    const float ss = wave_sum(v.x * v.x + v.y * v.y + v.z * v.z + v.w * v.w);
    const float r = rsqrtf(ss * (1.f / 256.f) + 1e-6f); const float4 g4 = *(const float4*)(g + lane * 4);
    *(float4*)(cn + (size_t)row * 256 + lane * 4) = make_float4(v.x * r * g4.x, v.y * r * g4.y, v.z * r * g4.z, v.w * r * g4.w);
  }
}

__device__ __forceinline__ void np_iscore(const float* projA, float* sc, float* lds) {
  float (*As)[132] = (float (*)[132])lds;
  float (*Bs)[68] = (float (*)[68])(lds + 16 * 132);
  const int tid = TIDX(), tx = tid & 15, ty = tid >> 4;
  const int ar = tid >> 2, ak = (tid & 3) * 4;
  const int br = (tid & 255) >> 2;
  for (int u = BIDX(); u < NB * 64 * 128; u += gridDim.x) {
    const int b = u / (64 * 128), tt = (u / 128) % 64, st = u % 128;
    if (st > 2 * tt + 1) continue;
    const int t0 = tt * 128, s0 = st * 64;
    const float* Qp = projA + (size_t)(b * L + t0 + ar) * DINA + 1280 + ak;
    const float* Kp = projA + (size_t)(b * L + s0 + br) * DINA + 1792 + ak;
    float score[4][4] = {};
    for (int h = 0; h < 8; ++h) {
      float acc[4][4] = {};
      for (int k0 = 0; k0 < 64; k0 += 16) {
        const float4 av = *(const float4*)(Qp + h * 64 + k0);
        As[ak + 0][ar] = av.x; As[ak + 1][ar] = av.y; As[ak + 2][ar] = av.z; As[ak + 3][ar] = av.w;
        if (tid < 256) { const float4 bv = *(const float4*)(Kp + k0); Bs[ak + 0][br] = bv.x; Bs[ak + 1][br] = bv.y; Bs[ak + 2][br] = bv.z; Bs[ak + 3][br] = bv.w; }
        __syncthreads();
#pragma unroll
        for (int kk = 0; kk < 16; ++kk) {
          const float4 a = *(const float4*)&As[kk][ty * 4]; const float4 bq = *(const float4*)&Bs[kk][tx * 4];
          const float aa[4] = {a.x, a.y, a.z, a.w}, bb[4] = {bq.x, bq.y, bq.z, bq.w};
#pragma unroll
          for (int i = 0; i < 4; ++i)
#pragma unroll
            for (int j = 0; j < 4; ++j) acc[i][j] = fmaf(aa[i], bb[j], acc[i][j]);
        }
        __syncthreads();
      }
#pragma unroll
      for (int i = 0; i < 4; ++i) {
        const float w = projA[(size_t)(b * L + t0 + ty * 4 + i) * DINA + 1856 + h] * 0.35355339059327373f;
#pragma unroll
        for (int j = 0; j < 4; ++j) score[i][j] += w * fmaxf(acc[i][j] * 0.125f, 0.f);
      }
    }
#pragma unroll
    for (int i = 0; i < 4; ++i)
#pragma unroll
      for (int j = 0; j < 4; ++j) sc[((size_t)(b * L + t0 + ty * 4 + i)) * L + s0 + tx * 4 + j] = score[i][j];
  }
}

__device__ __forceinline__ unsigned f2key(float f) { f = f + 0.0f; const unsigned u = __float_as_uint(f); return (u & 0x80000000u) ? ~u : (u | 0x80000000u); }

__device__ __forceinline__ void np_topk(const float* sc, int* idx_out, char* lds) {
  GW_INIT;
  unsigned* hist = (unsigned*)(lds + wave * 1280); unsigned* cntw = hist + 256;
  for (int row = gw; row < NT; row += NGW) {
    const int t = row % L, n = t + 1;
    const float* s = sc + (size_t)row * L; int* out = idx_out + (size_t)row * 256;
    if (n <= 256) { for (int i = lane; i < 256; i += 64) out[i] = i < n ? i : -1; continue; }
    unsigned prefix = 0, need = 256;
    for (int pass = 3; pass >= 0; --pass) {
      const int shift = pass * 8;
      for (int i = lane; i < 256; i += 64) hist[i] = 0;
      WSYNC();
      for (int i = lane; i < n; i += 64) { const unsigned k = f2key(s[i]); const bool m = (pass == 3) || ((k >> (shift + 8)) == (prefix >> (shift + 8))); if (m) atomicAdd(&hist[(k >> shift) & 255u], 1u); }
      WSYNC();
      unsigned cum = 0; int d = 255; for (; d > 0; --d) { const unsigned hv = hist[d]; if (cum + hv >= need) break; cum += hv; }
      prefix |= ((unsigned)d << shift); need -= cum;
      WSYNC();
    }
    if (lane == 0) *cntw = 0; WSYNC();
    for (int i = lane; i < n; i += 64) { if (f2key(s[i]) > prefix) { const unsigned pos = atomicAdd(cntw, 1u); out[pos] = i; } }
    WSYNC();
    if (lane == 0) { unsigned c = *cntw; unsigned nd = need; for (int i = 0; i < n && nd > 0; ++i) if (f2key(s[i]) == prefix) { out[c++] = i; --nd; } }
    WSYNC();
  }
}

__device__ __forceinline__ void np_dsa_attn(const float* projA, const float* cn, const int* idx, const float* w_uk, const float* w_uv, float* o2, float* lds) {
  const int half = TIDX() >> 8, tid = TIDX() & 255;
  float* base = lds + half * 14336;
  float* qs = base; float (*ql)[256] = (float (*)[256])(base + 1024); float (*pr)[257] = (float (*)[257])(base + 1024 + 4096);
  float (*ol)[256] = (float (*)[256])(base + 1024 + 4096 + 4112); float* red = base + 1024 + 4096 + 4112 + 4096; int* sid = (int*)(red + 16);
  for (int r0 = BIDX() * 2; r0 < NT; r0 += gridDim.x * 2) {
    const int row = r0 + half, b = row / L;
    __syncthreads();
    for (int i = tid; i < 1024; i += 256) qs[i] = projA[(size_t)row * DINA + i];
    sid[tid] = idx[(size_t)row * 256 + tid];
    __syncthreads();
    { const int c = tid;
#pragma unroll 1
      for (int h = 0; h < 16; ++h) { float a = 0.f;
#pragma unroll 8
        for (int d = 0; d < 64; ++d) a = fmaf(qs[h * 64 + d], w_uk[((size_t)h * 64 + d) * 256 + c], a); ql[h][c] = a; } }
    __syncthreads();
    { const int k = tid, key = sid[k];
      float lg[16];
      if (key >= 0) { const float* cr = cn + (size_t)(b * L + key) * 256;
        for (int h = 0; h < 16; ++h) lg[h] = 0.f;
#pragma unroll 2
        for (int c = 0; c < 256; ++c) { const float cv = cr[c];
#pragma unroll
          for (int h = 0; h < 16; ++h) lg[h] = fmaf(ql[h][c], cv, lg[h]); }
#pragma unroll
        for (int h = 0; h < 16; ++h) pr[h][k] = lg[h] * 0.125f;
      } else {
#pragma unroll
        for (int h = 0; h < 16; ++h) pr[h][k] = -INFINITY; } }
    __syncthreads();
    if (tid < 16) { const int h = tid; float m = -INFINITY; for (int k = 0; k < 256; ++k) m = fmaxf(m, pr[h][k]); float su = 0.f; for (int k = 0; k < 256; ++k) { const float e = expf(pr[h][k] - m); pr[h][k] = e; su += e; } red[h] = 1.f / su; }
    __syncthreads();
    { const int c = tid; float a[16];
#pragma unroll
      for (int h = 0; h < 16; ++h) a[h] = 0.f;
#pragma unroll 2
      for (int k = 0; k < 256; ++k) { const int key = sid[k]; if (key < 0) continue; const float cv = cn[(size_t)(b * L + key) * 256 + c];
#pragma unroll
        for (int h = 0; h < 16; ++h) a[h] = fmaf(pr[h][k], cv, a[h]); }
#pragma unroll
      for (int h = 0; h < 16; ++h) ol[h][c] = a[h] * red[h]; }
    __syncthreads();
#pragma unroll 1
    for (int o = tid; o < 1024; o += 256) { const int h = o >> 6, v = o & 63; float a = 0.f;
#pragma unroll 8
      for (int c = 0; c < 256; ++c) a = fmaf(ol[h][c], w_uv[((size_t)h * 256 + c) * 64 + v], a); o2[(size_t)row * 1024 + o] = a; }
  }
  __syncthreads();
}

__device__ __forceinline__ void np_ln_res(const float* x, const float* h, const float* g, const float* bb, float* out) {
  GW_INIT;
  for (int row = gw; row < NT; row += NGW) {
    float4 v[4]; float s = 0.f;
#pragma unroll
    for (int j = 0; j < 4; ++j) { const float4 a = *(const float4*)(x + (size_t)row * D + lane * 4 + 256 * j), hh = *(const float4*)(h + (size_t)row * D + lane * 4 + 256 * j);
      v[j] = make_float4(ALPHA * a.x + hh.x, ALPHA * a.y + hh.y, ALPHA * a.z + hh.z, ALPHA * a.w + hh.w); s += (v[j].x + v[j].y) + (v[j].z + v[j].w); }
    const float mu = wave_sum(s) * (1.f / D); float q = 0.f;
#pragma unroll
    for (int j = 0; j < 4; ++j) { v[j].x -= mu; v[j].y -= mu; v[j].z -= mu; v[j].w -= mu; q += (v[j].x * v[j].x + v[j].y * v[j].y) + (v[j].z * v[j].z + v[j].w * v[j].w); }
    const float r = rsqrtf(wave_sum(q) * (1.f / D) + 1e-5f);
#pragma unroll
    for (int j = 0; j < 4; ++j) { const int c = lane * 4 + 256 * j; const float4 g4 = *(const float4*)(g + c), b4 = *(const float4*)(bb + c);
      *(float4*)(out + (size_t)row * D + c) = make_float4(v[j].x * r * g4.x + b4.x, v[j].y * r * g4.y + b4.y, v[j].z * r * g4.z + b4.z, v[j].w * r * g4.w + b4.w); }
  }
}

__device__ __forceinline__ void np_router(const float* x, const float* wr, const float* br, int* tok_e, float* tok_g, int* counts, int* row_tok, char* lds) {
  GW_INIT;
  for (int i = BIDX() * NTHR + TIDX(); i < PMAX; i += gridDim.x * NTHR) row_tok[i] = 0;
  float* lg = (float*)(lds + wave * 256);
  const int e = lane & 31, hf = lane >> 5;
  for (int tok = gw; tok < NT; tok += NGW) {
    const float* xr = x + (size_t)tok * D + hf * 512; const float* wp = wr + (size_t)hf * 512 * 32 + e; float a = 0.f;
#pragma unroll 8
    for (int d = 0; d < 512; ++d) a = fmaf(xr[d], wp[d * 32], a);
    a += __shfl_xor(a, 32);
    if (hf == 0) lg[e] = a + br[e];
    WSYNC();
    if (lane == 0) { int ei[4]; float ev[4];
      for (int k = 0; k < 4; ++k) { int bi = 0; float bv = -INFINITY; for (int j = 0; j < 32; ++j) if (lg[j] > bv) { bv = lg[j]; bi = j; } ei[k] = bi; ev[k] = bv; lg[bi] = -INFINITY; }
      float su = 0.f, ex[4]; for (int k = 0; k < 4; ++k) { ex[k] = expf(ev[k] - ev[0]); su += ex[k]; }
      for (int k = 0; k < 4; ++k) { tok_e[tok * 4 + k] = ei[k]; tok_g[tok * 4 + k] = ex[k] / su; atomicAdd(&counts[ei[k]], 1); } }
    WSYNC();
  }
}
__device__ __forceinline__ void np_moe_sort(const int* tok_e, const float* tok_g, const int* counts, int* row_tok, float* row_gate, int* slot_of, int* blk_e, int* nblk_used, char* lds) {
  if (BIDX() != 0) return;
  const int e = TIDX(); int* pstart = (int*)lds; int* stage = pstart + 64;
  if (e == 0) { int acc = 0; for (int j = 0; j < 32; ++j) { pstart[j] = acc; const int nb = (counts[j] + 255) / 256; for (int q = 0; q < nb; ++q) blk_e[acc / 256 + q] = j; acc += nb * 256; } pstart[32] = acc; *nblk_used = acc / 256; }
  __syncthreads();
  int pos = e < 32 ? pstart[e] : 0;
  for (int c0 = 0; c0 < NT * 4; c0 += 2048) {
    __syncthreads();
    for (int i = e; i < 2048; i += NTHR) stage[i] = tok_e[c0 + i];
    __syncthreads();
    if (e < 32) for (int i = 0; i < 2048; ++i) if (stage[i] == e) { const int gi = c0 + i; row_tok[pos] = gi >> 2; row_gate[pos] = tok_g[gi]; slot_of[gi] = pos; ++pos; }
  }
  __syncthreads();
}
__device__ __forceinline__ void np_moe_combine_ln(const float* x1, const float* ys, const int* slot_of, const float* tok_g, const float* g, const float* bb, float* out) {
  GW_INIT;
  for (int row = gw; row < NT; row += NGW) {
    float4 v[4]; float s = 0.f; int sl[4]; float gg[4];
#pragma unroll
    for (int k = 0; k < 4; ++k) { sl[k] = slot_of[row * 4 + k]; gg[k] = tok_g[row * 4 + k]; }
#pragma unroll
    for (int j = 0; j < 4; ++j) { const int c = lane * 4 + 256 * j; float4 f = make_float4(0.f, 0.f, 0.f, 0.f);
#pragma unroll
      for (int k = 0; k < 4; ++k) { const float4 y = *(const float4*)(ys + (size_t)sl[k] * D + c); f.x += gg[k] * y.x; f.y += gg[k] * y.y; f.z += gg[k] * y.z; f.w += gg[k] * y.w; }
      const float4 a = *(const float4*)(x1 + (size_t)row * D + c);
      v[j] = make_float4(ALPHA * a.x + f.x, ALPHA * a.y + f.y, ALPHA * a.z + f.z, ALPHA * a.w + f.w); s += (v[j].x + v[j].y) + (v[j].z + v[j].w); }
    const float mu = wave_sum(s) * (1.f / D); float q = 0.f;
#pragma unroll
    for (int j = 0; j < 4; ++j) { v[j].x -= mu; v[j].y -= mu; v[j].z -= mu; v[j].w -= mu; q += (v[j].x * v[j].x + v[j].y * v[j].y) + (v[j].z * v[j].z + v[j].w * v[j].w); }
    const float r = rsqrtf(wave_sum(q) * (1.f / D) + 1e-5f);
#pragma unroll
    for (int j = 0; j < 4; ++j) { const int c = lane * 4 + 256 * j; const float4 g4 = *(const float4*)(g + c), b4 = *(const float4*)(bb + c);
      *(float4*)(out + (size_t)row * D + c) = make_float4(v[j].x * r * g4.x + b4.x, v[j].y * r * g4.y + b4.y, v[j].z * r * g4.z + b4.z, v[j].w * r * g4.w + b4.w); }
  }
}

__device__ __forceinline__ void np_gla_gate(const float* projB, const float* w_g2, const float* gb, float* adec) {
  GW_INIT;
  for (int row = gw; row < NT; row += NGW) {
    float glr[16];
#pragma unroll
    for (int j = 0; j < 16; ++j) glr[j] = projB[(size_t)row * DINB + 2048 + j];
    for (int c = lane; c < 512; c += 64) { float a = gb[c];
#pragma unroll
      for (int j = 0; j < 16; ++j) a = fmaf(glr[j], w_g2[j * 512 + c], a);
      const float ls = fminf(a, 0.f) - log1pf(expf(-fabsf(a))); adec[(size_t)row * 512 + c] = expf(ls * (1.f / 16.f)); }
  }
}
__device__ __forceinline__ void np_gla_scan(const float* projB, const float* adec, float* og, float* lds) {
  if (BIDX() >= 8) return;
  const int b = BIDX() >> 2, h = BIDX() & 3, tid = TIDX(), dv = tid & 255, dh = tid >> 8;
  float (*qs)[128] = (float (*)[128])lds; float (*ks)[128] = (float (*)[128])(lds + 2048); float (*as)[128] = (float (*)[128])(lds + 4096);
  float (*po)[16][256] = (float (*)[16][256])(lds + 6144);
  float S[64];
#pragma unroll
  for (int d = 0; d < 64; ++d) S[d] = 0.f;
  for (int t0 = 0; t0 < L; t0 += 16) {
    __syncthreads();
    for (int i = tid; i < 16 * 128; i += NTHR) { const int tt = i >> 7, d = i & 127; const size_t r = (size_t)(b * L + t0 + tt);
      qs[tt][d] = projB[r * DINB + h * 128 + d] * 0.08838834764831845f; ks[tt][d] = projB[r * DINB + 512 + h * 128 + d]; as[tt][d] = adec[r * 512 + h * 128 + d]; }
    __syncthreads();
#pragma unroll 1
    for (int tt = 0; tt < 16; ++tt) { const size_t r = (size_t)(b * L + t0 + tt); const float v = projB[r * DINB + 1024 + h * 256 + dv]; float o = 0.f;
#pragma unroll
      for (int d = 0; d < 64; ++d) { S[d] = fmaf(as[tt][dh * 64 + d], S[d], ks[tt][dh * 64 + d] * v); o = fmaf(qs[tt][dh * 64 + d], S[d], o); }
      po[dh][tt][dv] = o; }
    __syncthreads();
    for (int i = tid; i < 16 * 256; i += NTHR) { const int tt = i >> 8, c = i & 255; og[(size_t)(b * L + t0 + tt) * 1024 + h * 256 + c] = po[0][tt][c] + po[1][tt][c]; }
  }
  __syncthreads();
}
__device__ __forceinline__ void np_gla_norm(const float* og, const float* projB, const float* ng, float* on) {
  GW_INIT;
  for (int u = gw; u < NT * 4; u += NGW) {
    const int row = u >> 2, h = u & 3; const int c = h * 256 + lane * 4;
    const float4 v = *(const float4*)(og + (size_t)row * 1024 + c);
    const float r = rsqrtf(wave_sum(v.x * v.x + v.y * v.y + v.z * v.z + v.w * v.w) * (1.f / 256.f) + 1e-6f);
    const float4 rr = *(const float4*)(projB + (size_t)row * DINB + 2064 + c), g4 = *(const float4*)(ng + c);
    *(float4*)(on + (size_t)row * 1024 + c) = make_float4(v.x * r * g4.x * (rr.x / (1.f + expf(-rr.x))), v.y * r * g4.y * (rr.y / (1.f + expf(-rr.y))), v.z * r * g4.z * (rr.z / (1.f + expf(-rr.z))), v.w * r * g4.w * (rr.w / (1.f + expf(-rr.w))));
  }
}

struct Ws { float *projA, *cn, *sc, *o2, *h, *x1, *x2, *hb, *ys, *projB, *adec, *og, *on, *tok_g, *row_gate; int *idx, *tok_e, *slot_of, *row_tok, *blk_e, *counts; };
}
typedef unsigned short bf16_t;
typedef unsigned v4u __attribute__((ext_vector_type(4)));
typedef unsigned v2u __attribute__((ext_vector_type(2)));
typedef float f32x4 __attribute__((ext_vector_type(4)));
typedef short bf16x8 __attribute__((ext_vector_type(8)));
typedef float f32x2_t __attribute__((ext_vector_type(2))); typedef __bf16 bf16x2_t __attribute__((ext_vector_type(2)));
__device__ __forceinline__ unsigned cvt_pk_bf16(float lo, float hi) { const f32x2_t v = {lo, hi}; const bf16x2_t b = __builtin_convertvector(v, bf16x2_t); return __builtin_bit_cast(unsigned, b); }
__device__ __forceinline__ float bf_lo(unsigned u) { return __uint_as_float(u << 16); }
__device__ __forceinline__ float bf_hi(unsigned u) { return __uint_as_float(u & 0xffff0000u); }
__device__ __forceinline__ float bf2f(bf16_t h) { return __uint_as_float(((unsigned)h) << 16); }

struct TJob { const float* src; int lds_; int K, N; bf16_t* dst; int ldd; int drow0, dcol0; int rowmap; int ntk, ntn; };
__device__ __forceinline__ TJob mk_tjob(const float* src, int lds_, int K, int N, bf16_t* dst, int ldd, int drow0, int dcol0, int rowmap) {
  TJob j; j.src = src; j.lds_ = lds_; j.K = K; j.N = N; j.dst = dst; j.ldd = ldd; j.drow0 = drow0; j.dcol0 = dcol0; j.rowmap = rowmap; j.ntk = K / 64; j.ntn = (N + 127) / 128; return j; }
__device__ __forceinline__ int tjob_tiles(const TJob& j) { return j.ntk * j.ntn; }
__device__ __forceinline__ void transpose_tile(const TJob& j, int tile, int lane) {
  const int kt = tile / j.ntn, nt_ = tile % j.ntn, k0 = kt * 64, n0 = nt_ * 128;
  const int q = lane & 31, par = lane >> 5;
  const bool ok = (n0 + 4 * q) < j.N;
  f32x4 v[32];
  const float* sp = j.src + (size_t)(k0 + par) * j.lds_ + (ok ? n0 + 4 * q : 0);
#pragma unroll
  for (int i = 0; i < 32; ++i) v[i] = *(const f32x4*)(sp + (size_t)(2 * i) * j.lds_);
  __builtin_amdgcn_sched_barrier(0);
  unsigned ra[32], rb[32];
#pragma unroll
  for (int i = 0; i < 32; ++i) {
    auto s0 = __builtin_amdgcn_permlane32_swap(__float_as_uint(v[i][0]), __float_as_uint(v[i][2]), false, false);
    auto s1 = __builtin_amdgcn_permlane32_swap(__float_as_uint(v[i][1]), __float_as_uint(v[i][3]), false, false);
    ra[i] = cvt_pk_bf16(__uint_as_float(s0[0]), __uint_as_float(s0[1]));
    rb[i] = cvt_pk_bf16(__uint_as_float(s1[0]), __uint_as_float(s1[1]));
  }
  if (ok) {
    const int n = n0 + 4 * q + 2 * par;
    int r0 = n, r1 = n + 1;
    if (j.rowmap == 1) { const int jj0 = r0 & 1023, jj1 = r1 & 1023; r0 = 256 * (jj0 >> 7) + ((r0 >> 10) << 7) + (jj0 & 127); r1 = 256 * (jj1 >> 7) + ((r1 >> 10) << 7) + (jj1 & 127); }
    bf16_t* d0 = j.dst + (size_t)(j.drow0 + r0) * j.ldd + j.dcol0 + k0;
    bf16_t* d1 = j.dst + (size_t)(j.drow0 + r1) * j.ldd + j.dcol0 + k0;
#pragma unroll
    for (int c = 0; c < 8; ++c) { *(v4u*)(d0 + 8 * c) = (v4u){ra[4 * c], ra[4 * c + 1], ra[4 * c + 2], ra[4 * c + 3]}; *(v4u*)(d1 + 8 * c) = (v4u){rb[4 * c], rb[4 * c + 1], rb[4 * c + 2], rb[4 * c + 3]}; }
  }
}
__device__ __forceinline__ void transpose_job(const TJob j, int& w0, int gw, int NGW, int lane) {
  const int nt_ = tjob_tiles(j);
  int first = gw - (w0 % NGW); if (first < 0) first += NGW;
#pragma unroll 1
  for (int t = first; t < nt_; t += NGW) transpose_tile(j, t, lane);
  w0 += nt_;
}
__device__ __forceinline__ void zero_rect(bf16_t* dst, int ldd, int r0, int nr, int cb0, int nbytes, int gtid, int NGT) {
  const int per = nbytes / 16;
  for (int i = gtid; i < nr * per; i += NGT) { const int r = i / per, c = i % per; *(v4u*)((char*)(dst + (size_t)(r0 + r) * ldd) + cb0 + 16 * c) = (v4u){0u, 0u, 0u, 0u}; }
}
__device__ __forceinline__ void cvt_f32_to_bf16(const float* src, int lds_, bf16_t* dst, int ldd, int rows, int ncols, int gtid, int NGT) {
  const int per = ncols / 4;
  for (size_t i = gtid; i < (size_t)rows * per; i += NGT) { const size_t r = i / per; const int c = (int)(i % per) * 4; const f32x4 v = *(const f32x4*)(src + r * lds_ + c);
    *(v2u*)(dst + r * ldd + c) = (v2u){cvt_pk_bf16(v[0], v[1]), cvt_pk_bf16(v[2], v[3])}; }
}
__device__ __forceinline__ void cvt_bf16_to_f32(const bf16_t* src, int lds_, float* dst, int ldd, int rows, int ncols, int gtid, int NGT) {
  const int per = ncols / 4;
  for (size_t i = gtid; i < (size_t)rows * per; i += NGT) { const size_t r = i / per; const int c = (int)(i % per) * 4; const v2u v = *(const v2u*)(src + r * lds_ + c);
    *(f32x4*)(dst + r * ldd + c) = (f32x4){bf_lo(v[0]), bf_hi(v[0]), bf_lo(v[1]), bf_hi(v[1])}; }
}

namespace pg8 {
#define PG8_LAS __attribute__((address_space(3)))
typedef unsigned u32x4 __attribute__((ext_vector_type(4)));
constexpr int BM = 256, BK = 64, HALF = 128, HTB = HALF * BK * 2, STAGE_BYTES = 8 * HTB, NXCD = 8, WGM = 8;
__host__ __device__ __forceinline__ int lds_byte(int r, int c) { const int st = (r >> 4) * 2 + (c >> 5), rr = r & 15, cc = c & 31, ob = rr * 64 + cc * 2; return st * 1024 + (ob ^ (((ob >> 9) & 1) << 5)); }
__host__ __device__ __forceinline__ void stage_rc(int b, int& R, int& C) { const int st = b / 1024, sb = b % 1024, swz = sb ^ (((sb >> 9) & 1) << 5); R = (st >> 1) * 16 + swz / 64; C = (st & 1) * 32 + (swz % 64) / 2; }
__host__ __device__ __forceinline__ int perm32(int rho) { const int n = rho >> 4, i = rho & 15; return 8 * (i >> 2) + 4 * n + (i & 3); }
struct Unit { const char* pa; const char* pb; int orow, ocol, e, kind; };
struct Gemm { int lda, ldb, K; };
struct StaticOrder {
    static constexpr bool GATHER = false; const int* rowmap;
    const char* A; const char* Bt; size_t ta, tb; int nM, nN, nwg, G, c;
    __device__ void init(const void* A_, int lda, const void* Bt_, int ldb, int M, int N, int G_, int c_) { A = (const char*)A_; Bt = (const char*)Bt_; ta = (size_t)BM * lda * 2; tb = (size_t)BM * ldb * 2; nM = M / BM; nN = N / BM; nwg = nM * nN; G = G_; c = c_; }
    __device__ bool tile(int i, int& pm, int& pn) const {
        const long L = (long)i * G + c; if (L >= nwg) return false;
        int wgid = (int)L; { const int q = nwg / NXCD, r = nwg % NXCD, xcd = wgid % NXCD, off = wgid / NXCD; wgid = (xcd < r ? xcd * (q + 1) : r * (q + 1) + (xcd - r) * q) + off; }
        const int nig = WGM * nN, gid = wgid / nig, fm = gid * WGM, gsz = (nM - fm) < WGM ? (nM - fm) : WGM;
        pm = fm + ((wgid % nig) % gsz); pn = (wgid % nig) / gsz; return true;
    }
    __device__ bool next(int i, Unit& u) const { int pm, pn; if (!tile(i, pm, pn)) return false; u.pa = A + (size_t)pm * ta; u.pb = Bt + (size_t)pn * tb; u.orow = pm * BM; u.ocol = pn * BM; u.e = 0; u.kind = 0; return true; }
    __device__ __forceinline__ int rowof(const Unit&, int r) const { return r; }
    __device__ __forceinline__ void a_ready(const Unit&) const {}
    __device__ __forceinline__ void done(const Unit&) const {}
};
struct EpiStore {
    static constexpr bool PERM = true, AFTER_DRAIN = false;
    bf16_t* O; int ldc;
    __device__ __forceinline__ void operator()(const f32x4 (&acc)[2][2][4][2], const Unit& u, int wr, int wc, int fr, int fq) const {
        const int row0 = u.orow + wr * 64 + fr, col0 = u.ocol + wc * 32 + 8 * fq;
#pragma unroll
        for (int ai = 0; ai < 2; ++ai)
#pragma unroll
            for (int m = 0; m < 4; ++m) { bf16_t* rowp = O + (size_t)(row0 + ai * HALF + m * 16) * ldc + col0;
#pragma unroll
                for (int bj = 0; bj < 2; ++bj) { const f32x4 v0 = acc[ai][bj][m][0], v1 = acc[ai][bj][m][1];
                    u32x4 w; w.x = cvt_pk_bf16(v0[0], v0[1]); w.y = cvt_pk_bf16(v0[2], v0[3]); w.z = cvt_pk_bf16(v1[0], v1[1]); w.w = cvt_pk_bf16(v1[2], v1[3]);
                    *(u32x4*)(rowp + bj * HALF) = w; } }
    }
};
struct EpiStoreKi {
    static constexpr bool PERM = true, AFTER_DRAIN = false;
    bf16_t* O; int ldc; bf16_t* Ki; int kcol;
    __device__ __forceinline__ void operator()(const f32x4 (&acc)[2][2][4][2], const Unit& u, int wr, int wc, int fr, int fq) const {
        const int row0 = u.orow + wr * 64 + fr, col0 = u.ocol + wc * 32 + 8 * fq;
        const bool kt = (u.ocol == kcol) && (wc < 2);
#pragma unroll
        for (int ai = 0; ai < 2; ++ai)
#pragma unroll
            for (int m = 0; m < 4; ++m) { bf16_t* rowp = O + (size_t)(row0 + ai * HALF + m * 16) * ldc + col0;
#pragma unroll
                for (int bj = 0; bj < 2; ++bj) { const f32x4 v0 = acc[ai][bj][m][0], v1 = acc[ai][bj][m][1];
                    u32x4 w; w.x = cvt_pk_bf16(v0[0], v0[1]); w.y = cvt_pk_bf16(v0[2], v0[3]); w.z = cvt_pk_bf16(v1[0], v1[1]); w.w = cvt_pk_bf16(v1[2], v1[3]);
                    *(u32x4*)(rowp + bj * HALF) = w;
                    if (bj == 0 && kt) *(u32x4*)(Ki + (size_t)(row0 + ai * HALF + m * 16) * 64 + wc * 32 + 8 * fq) = w; } }
    }
};
template <class Epi, class Sched, bool ALIGN_EPI = false, bool SP2 = false>
__device__ __forceinline__ void gemm_phase(PG8_LAS unsigned char* lds, const Gemm g, const Sched& S, const Epi& E) {
    const int tid = TIDX(), wid = __builtin_amdgcn_readfirstlane(tid >> 6), lane = tid & 63, wr = wid >> 2, wc = wid & 3, fr = lane & 15, fq = lane >> 4;
    const int K = g.K, nt = K / BK;
    unsigned voffA[2], voffB[2];
#pragma unroll
    for (int i = 0; i < 2; ++i) { int R, C; stage_rc(tid * 16 + i * 8192, R, C); const int Rb = Epi::PERM ? ((R & ~31) + perm32(R & 31)) : R;
        voffA[i] = (unsigned)(R * g.lda + C) * 2u; voffB[i] = (unsigned)(Rb * g.ldb + C) * 2u; }
    unsigned voffG[2][2][2]; int gR[2], gC[2];
#pragma unroll
    for (int i = 0; i < 2; ++i) { int R, C; stage_rc(tid * 16 + i * 8192, R, C); gR[i] = R; gC[i] = C; }
#define PG8_GOFF(dst, unit_) do { if constexpr (Sched::GATHER) { _Pragma("unroll") for (int _h = 0; _h < 2; ++_h) _Pragma("unroll") for (int _i = 0; _i < 2; ++_i) \
        dst[_h][_i] = (unsigned)S.rowof(unit_, (unit_).orow + _h * HALF + gR[_i]) * (unsigned)(g.lda * 2) + (unsigned)gC[_i] * 2u; } } while (0)
#define PG8_STAGE_A(bufoff, gptr, half, vsel) do { if constexpr (Sched::GATHER) { PG8_STAGE(bufoff, gptr, vsel); } else { PG8_STAGE(bufoff, (gptr) + (half) * hstepA, voffA); } } while (0)
    const size_t kstep = (size_t)(BK * 2);
    const size_t hstepA = (size_t)HALF * g.lda * 2, hstepB = (size_t)HALF * g.ldb * 2;
    const unsigned ldsw = (unsigned)wid * 1024u;
    const int aoff = lds_byte(wr * 64 + fr, fq * 8), boff = lds_byte(wc * 32 + fr, fq * 8);
#define PG8_SA(b, h) (((b) * 2 + (h)) * HTB)
#define PG8_SB(b, h) ((4 + (b) * 2 + (h)) * HTB)
#define PG8_STAGE(bufoff, gbase, voff) do { _Pragma("unroll") for (int _i = 0; _i < 2; ++_i) \
        __builtin_amdgcn_global_load_lds((const unsigned*)((const char*)(gbase) + (voff)[_i]), (PG8_LAS unsigned*)(lds + (bufoff) + ldsw + _i * 8192), 16, 0, 0); } while (0)
#define PG8_LDA(dst, b, h) do { _Pragma("unroll") for (int m = 0; m < 4; ++m) _Pragma("unroll") for (int k = 0; k < 2; ++k) dst[m][k] = *(const PG8_LAS bf16x8*)(lds + PG8_SA(b, h) + aoff + m * 2048 + k * 1024); } while (0)
#define PG8_LDB(dst, b, h) do { _Pragma("unroll") for (int n = 0; n < 2; ++n) _Pragma("unroll") for (int k = 0; k < 2; ++k) dst[n][k] = *(const PG8_LAS bf16x8*)(lds + PG8_SB(b, h) + boff + n * 2048 + k * 1024); } while (0)
#define PG8_MMA(ai, bj, At, Bt) do { __builtin_amdgcn_s_setprio(1); _Pragma("unroll") for (int m = 0; m < 4; ++m) _Pragma("unroll") for (int n = 0; n < 2; ++n) _Pragma("unroll") for (int k = 0; k < 2; ++k) \
        acc[ai][bj][m][n] = __builtin_amdgcn_mfma_f32_16x16x32_bf16(Bt[n][k], At[m][k], acc[ai][bj][m][n], 0, 0, 0); __builtin_amdgcn_s_setprio(0); } while (0)
#define PG8_WAIT_V(n) asm volatile("s_waitcnt vmcnt(" #n ")" ::: "memory")
#define PG8_WAIT_L(n) asm volatile("s_waitcnt lgkmcnt(" #n ")" ::: "memory")
#define PG8_BAR __builtin_amdgcn_s_barrier()
#define PG8_SCHED __builtin_amdgcn_sched_barrier(0)
    Unit cur, nxt; int ui = 0;
    if (!S.next(0, cur)) return;
    f32x4 acc[2][2][4][2];
#pragma unroll
    for (int a = 0; a < 2; ++a)
#pragma unroll
        for (int b = 0; b < 2; ++b)
#pragma unroll
            for (int m = 0; m < 4; ++m)
#pragma unroll
                for (int n = 0; n < 2; ++n) acc[a][b][m][n] = (f32x4){0.f, 0.f, 0.f, 0.f};
    bf16x8 At[4][2], B0[2][2], B1[2][2];
    const char* cA = cur.pa; const char* cB = cur.pb;
    S.a_ready(cur);
    PG8_GOFF(voffG[0], cur);
    if constexpr (SP2) {
        PG8_STAGE(PG8_SB(0, 0), cB, voffB); PG8_STAGE(PG8_SB(0, 1), cB + hstepB, voffB); PG8_STAGE_A(PG8_SA(0, 0), cA, 0, voffG[0][0]); PG8_STAGE_A(PG8_SA(0, 1), cA, 1, voffG[0][1]);
        if (wr == 1) PG8_BAR;
        PG8_WAIT_V(2); PG8_BAR;
        PG8_STAGE(PG8_SB(1, 0), cB + kstep, voffB); PG8_STAGE_A(PG8_SA(1, 0), cA + kstep, 0, voffG[0][0]); PG8_STAGE(PG8_SB(1, 1), cB + hstepB + kstep, voffB);
        PG8_WAIT_V(6); PG8_BAR;
    } else {
        PG8_STAGE(PG8_SB(0, 0), cB, voffB); PG8_STAGE_A(PG8_SA(0, 0), cA, 0, voffG[0][0]); PG8_STAGE(PG8_SB(0, 1), cB + hstepB, voffB); PG8_STAGE_A(PG8_SA(0, 1), cA, 1, voffG[0][1]);
        if (wr == 1) PG8_BAR;
        PG8_WAIT_V(4); PG8_BAR;
        PG8_STAGE(PG8_SB(1, 0), cB + kstep, voffB); PG8_STAGE_A(PG8_SA(1, 0), cA + kstep, 0, voffG[0][0]); PG8_STAGE(PG8_SB(1, 1), cB + hstepB + kstep, voffB);
        PG8_WAIT_V(6); PG8_BAR;
    }
    for (;;) {
        const bool has_next = S.next(ui + 1, nxt);
        if constexpr (Sched::GATHER) { if (has_next) { PG8_GOFF(voffG[1], nxt); } else {
#pragma unroll
            for (int _h = 0; _h < 2; ++_h)
#pragma unroll
                for (int _i = 0; _i < 2; ++_i) voffG[1][_h][_i] = voffG[0][_h][_i]; } }
        const char* nA = has_next ? nxt.pa : cA; const char* nB = has_next ? nxt.pb : cB;
        for (int t = 0; t < nt; t += 2) {
            const bool last = (t == nt - 2);
            const char* a1 = cA + (size_t)(t + 1) * kstep;
            const char* a2 = last ? nA : cA + (size_t)(t + 2) * kstep; const char* b2 = last ? nB : cB + (size_t)(t + 2) * kstep;
            const char* a3 = a2 + kstep; const char* b3 = b2 + kstep;
            unsigned vs0[2], vs1[2];
#pragma unroll
            for (int _i = 0; _i < 2; ++_i) { vs0[_i] = last ? voffG[1][0][_i] : voffG[0][0][_i]; vs1[_i] = last ? voffG[1][1][_i] : voffG[0][1][_i]; }
            if (last && has_next) S.a_ready(nxt);
            if constexpr (SP2) {
            PG8_LDB(B0, 0, 0); PG8_LDB(B1, 0, 1); PG8_SCHED; PG8_LDA(At, 0, 0); PG8_STAGE_A(PG8_SA(1, 1), a1, 1, voffG[0][1]);
            PG8_WAIT_V(8); PG8_WAIT_L(0); PG8_BAR; PG8_MMA(0, 0, At, B0); PG8_MMA(0, 1, At, B1); PG8_BAR; PG8_SCHED;
            PG8_LDA(At, 0, 1); PG8_STAGE(PG8_SB(0, 0), b2, voffB); PG8_STAGE(PG8_SB(0, 1), b2 + hstepB, voffB); PG8_STAGE_A(PG8_SA(0, 0), a2, 0, vs0);
            PG8_WAIT_V(8); PG8_WAIT_L(0); PG8_BAR; PG8_MMA(1, 0, At, B0); PG8_MMA(1, 1, At, B1); PG8_BAR; PG8_SCHED;
            PG8_LDB(B0, 1, 0); PG8_LDB(B1, 1, 1); PG8_SCHED; PG8_LDA(At, 1, 0); PG8_STAGE_A(PG8_SA(0, 1), a2, 1, vs1);
            PG8_WAIT_V(8); PG8_WAIT_L(0); PG8_BAR; PG8_MMA(0, 0, At, B0); PG8_MMA(0, 1, At, B1); PG8_BAR; PG8_SCHED;
            PG8_LDA(At, 1, 1); PG8_STAGE(PG8_SB(1, 0), b3, voffB); PG8_STAGE(PG8_SB(1, 1), b3 + hstepB, voffB); PG8_STAGE_A(PG8_SA(1, 0), a3, 0, vs0);
            PG8_WAIT_V(8); PG8_WAIT_L(0); PG8_BAR; PG8_MMA(1, 0, At, B0); PG8_MMA(1, 1, At, B1); PG8_BAR; PG8_SCHED;
            } else {
            PG8_LDB(B0, 0, 0); PG8_SCHED; PG8_LDA(At, 0, 0); PG8_STAGE_A(PG8_SA(1, 1), a1, 1, voffG[0][1]);
            PG8_WAIT_L(8); PG8_BAR; PG8_WAIT_L(0); PG8_MMA(0, 0, At, B0); PG8_BAR; PG8_SCHED;
            PG8_LDB(B1, 0, 1); PG8_STAGE(PG8_SB(0, 0), b2, voffB);
            PG8_BAR; PG8_WAIT_L(0); PG8_MMA(0, 1, At, B1); PG8_BAR;
            PG8_LDA(At, 0, 1); PG8_STAGE_A(PG8_SA(0, 0), a2, 0, vs0);
            PG8_BAR; PG8_WAIT_L(0); PG8_MMA(1, 0, At, B0); PG8_BAR; PG8_SCHED;
            PG8_STAGE(PG8_SB(0, 1), b2 + hstepB, voffB);
            PG8_WAIT_V(6); PG8_BAR; PG8_MMA(1, 1, At, B1); PG8_BAR;
            PG8_LDB(B0, 1, 0); PG8_SCHED; PG8_LDA(At, 1, 0); PG8_STAGE_A(PG8_SA(0, 1), a2, 1, vs1);
            PG8_WAIT_L(8); PG8_BAR; PG8_WAIT_L(0); PG8_MMA(0, 0, At, B0); PG8_BAR; PG8_SCHED;
            PG8_LDB(B1, 1, 1); PG8_STAGE(PG8_SB(1, 0), b3, voffB);
            PG8_BAR; PG8_WAIT_L(0); PG8_MMA(0, 1, At, B1); PG8_BAR;
            PG8_LDA(At, 1, 1); PG8_STAGE_A(PG8_SA(1, 0), a3, 0, vs0);
            PG8_BAR; PG8_WAIT_L(0); PG8_MMA(1, 0, At, B0); PG8_BAR; PG8_SCHED;
            PG8_STAGE(PG8_SB(1, 1), b3 + hstepB, voffB);
            PG8_WAIT_V(6); PG8_BAR; PG8_MMA(1, 1, At, B1); PG8_BAR;
            }
        }
        if constexpr (ALIGN_EPI) { if (wr == 0) PG8_BAR; }
        if constexpr (!Epi::AFTER_DRAIN) { E(acc, cur, wr, wc, fr, fq); S.done(cur); }
        if (!has_next) break;
#pragma unroll
        for (int a = 0; a < 2; ++a)
#pragma unroll
            for (int b = 0; b < 2; ++b)
#pragma unroll
                for (int m = 0; m < 4; ++m)
#pragma unroll
                    for (int n = 0; n < 2; ++n) acc[a][b][m][n] = (f32x4){0.f, 0.f, 0.f, 0.f};
        cur = nxt; cA = nA; cB = nB; ++ui;
        if constexpr (Sched::GATHER) {
#pragma unroll
            for (int _h = 0; _h < 2; ++_h)
#pragma unroll
                for (int _i = 0; _i < 2; ++_i) voffG[0][_h][_i] = voffG[1][_h][_i]; }
        if constexpr (ALIGN_EPI) { if (wr == 1) PG8_BAR; }
    }
    PG8_WAIT_V(0);
    if constexpr (!ALIGN_EPI) { if (wr == 0) PG8_BAR; }
    PG8_BAR;
    if constexpr (Epi::AFTER_DRAIN) { E.fused(acc, cur, wr, wc, fr, fq, lds, wid, lane); S.done(cur); }
#undef PG8_SA
#undef PG8_SB
#undef PG8_STAGE
#undef PG8_STAGE_A
#undef PG8_GOFF
#undef PG8_LDA
#undef PG8_LDB
#undef PG8_MMA
#undef PG8_WAIT_V
#undef PG8_WAIT_L
#undef PG8_BAR
#undef PG8_SCHED
}

}
#define WSYNC2() asm volatile("s_waitcnt lgkmcnt(0)" ::: "memory")
struct MoeBufs { int* tok_e; float* tok_g; int* slot_of; float* slot_gate; int* blk_e; int* blkcnt; int* nblk; int* slot_tok; };
constexpr int WRT_LD = 1028;

template <bool XB, int MODE = 0> __device__ __forceinline__ void ph_ln_router(const void* xin_, const bf16_t* hb, const float* g, const float* bb, const float* wr, const float* br, bf16_t* x1b, const MoeBufs m, float* lds) {
  const float* xin = (const float*)xin_; const bf16_t* xinb = (const bf16_t*)xin_;
  for (int i = BIDX() * NTHR + TIDX(); i < PMAX; i += (int)gridDim.x * NTHR) m.slot_tok[i] = 0;
  const int tid = TIDX(), lane = tid & 63, wave = tid >> 6, blk = BIDX();
  float* wT = lds;
  float* lg = lds + 32 * WRT_LD + wave * 64;
  int* cnt = (int*)(lds + 32 * WRT_LD + 8 * 64);
  f32x4 raf[2][4]; v2u rab[2][4], rh[2][4];
#define LNR_LOAD(tk) { _Pragma("unroll") for (int q = 0; q < 2; ++q) _Pragma("unroll") for (int j = 0; j < 4; ++j) { const int c = lane * 4 + 256 * j; \
      if (XB) rab[q][j] = *(const v2u*)(xinb + (size_t)((tk) + q) * D + c); else raf[q][j] = *(const f32x4*)(xin + (size_t)((tk) + q) * D + c); \
      rh[q][j] = *(const v2u*)(hb + (size_t)((tk) + q) * D + c); } }
  LNR_LOAD(blk * 64 + wave * 8)
  { f32x4 wv[16];
#pragma unroll
    for (int k = 0; k < 16; ++k) wv[k] = *(const f32x4*)(wr + (size_t)(tid + NTHR * k) * 4);
#pragma unroll
    for (int k = 0; k < 16; ++k) { const int i = (tid + NTHR * k) * 4, d = i >> 5, e = i & 31;
#pragma unroll
      for (int z = 0; z < 4; ++z) wT[(e + z) * WRT_LD + d] = wv[k][z]; } }
  if (tid < 32) cnt[tid] = 0;
  __syncthreads();
#pragma unroll 1
  for (int it = 0; it < 8; it += 2) {
    const int tok0 = blk * 64 + wave * 8 + it;
    f32x4 v[2][4]; float s[2] = {0.f, 0.f};
#pragma unroll
    for (int q = 0; q < 2; ++q)
#pragma unroll
      for (int j = 0; j < 4; ++j) { f32x4 a;
        if (XB) { const v2u xv = rab[q][j]; a = (f32x4){bf_lo(xv[0]), bf_hi(xv[0]), bf_lo(xv[1]), bf_hi(xv[1])}; } else a = raf[q][j];
        const v2u hh = rh[q][j];
        v[q][j] = (f32x4){ALPHA * a[0] + bf_lo(hh[0]), ALPHA * a[1] + bf_hi(hh[0]), ALPHA * a[2] + bf_lo(hh[1]), ALPHA * a[3] + bf_hi(hh[1])}; s[q] += (v[q][j][0] + v[q][j][1]) + (v[q][j][2] + v[q][j][3]); }
    if (it + 2 < 8) LNR_LOAD(tok0 + 2)
#pragma unroll
    for (int o = 1; o < 64; o <<= 1) { s[0] += __shfl_xor(s[0], o); s[1] += __shfl_xor(s[1], o); }
    float qq[2] = {0.f, 0.f};
#pragma unroll
    for (int q = 0; q < 2; ++q) { const float mu = s[q] * (1.f / D);
#pragma unroll
      for (int j = 0; j < 4; ++j) { v[q][j] = v[q][j] - mu; qq[q] += (v[q][j][0] * v[q][j][0] + v[q][j][1] * v[q][j][1]) + (v[q][j][2] * v[q][j][2] + v[q][j][3] * v[q][j][3]); } }
#pragma unroll
    for (int o = 1; o < 64; o <<= 1) { qq[0] += __shfl_xor(qq[0], o); qq[1] += __shfl_xor(qq[1], o); }
#pragma unroll
    for (int q = 0; q < 2; ++q) { const float r = rsqrtf(qq[q] * (1.f / D) + 1e-5f);
#pragma unroll
      for (int j = 0; j < 4; ++j) { const int c = lane * 4 + 256 * j; const f32x4 g4 = *(const f32x4*)(g + c), b4 = *(const f32x4*)(bb + c); v[q][j] = v[q][j] * r * g4 + b4; *(v2u*)(x1b + (size_t)(tok0 + q) * D + c) = (v2u){cvt_pk_bf16(v[q][j][0], v[q][j][1]), cvt_pk_bf16(v[q][j][2], v[q][j][3])}; } }
    if (MODE == 1) continue;
    float p[2][32];
    { const float* wl = wT + lane * 4; f32x4 wb[2][4];
#pragma unroll
      for (int j = 0; j < 4; ++j) wb[0][j] = *(const f32x4*)(wl + 256 * j);
#pragma unroll
      for (int e = 0; e < 32; ++e) {
        if (e < 31) {
#pragma unroll
          for (int j = 0; j < 4; ++j) wb[(e + 1) & 1][j] = *(const f32x4*)(wl + (e + 1) * WRT_LD + 256 * j); }
        __builtin_amdgcn_sched_barrier(0);
        f32x2_t a0 = {0.f, 0.f}, a1 = {0.f, 0.f};
#pragma unroll
        for (int j = 0; j < 4; ++j) { const f32x4 w4 = wb[e & 1][j]; const f32x2_t wlo = {w4[0], w4[1]}, whi = {w4[2], w4[3]};
          a0 = __builtin_elementwise_fma((f32x2_t){v[0][j][0], v[0][j][1]}, wlo, a0); a0 = __builtin_elementwise_fma((f32x2_t){v[0][j][2], v[0][j][3]}, whi, a0);
          a1 = __builtin_elementwise_fma((f32x2_t){v[1][j][0], v[1][j][1]}, wlo, a1); a1 = __builtin_elementwise_fma((f32x2_t){v[1][j][2], v[1][j][3]}, whi, a1); }
        p[0][e] = a0[0] + a0[1]; p[1][e] = a1[0] + a1[1];
        __builtin_amdgcn_sched_barrier(0);
      } }
#pragma unroll
    for (int i = 0; i < 16; ++i) { const bool hi = (lane & 32) != 0;
#pragma unroll
      for (int q = 0; q < 2; ++q) { const float send = hi ? p[q][i] : p[q][i + 16]; const float keep = hi ? p[q][i + 16] : p[q][i]; p[q][i] = keep + __shfl_xor(send, 32); } }
#pragma unroll
    for (int i = 0; i < 8; ++i) { const bool hi = (lane & 16) != 0;
#pragma unroll
      for (int q = 0; q < 2; ++q) { const float send = hi ? p[q][i] : p[q][i + 8]; const float keep = hi ? p[q][i + 8] : p[q][i]; p[q][i] = keep + __shfl_xor(send, 16); } }
#pragma unroll
    for (int i = 0; i < 4; ++i) { const bool hi = (lane & 8) != 0;
#pragma unroll
      for (int q = 0; q < 2; ++q) { const float send = hi ? p[q][i] : p[q][i + 4]; const float keep = hi ? p[q][i + 4] : p[q][i]; p[q][i] = keep + __shfl_xor(send, 8); } }
#pragma unroll
    for (int i = 0; i < 2; ++i) { const bool hi = (lane & 4) != 0;
#pragma unroll
      for (int q = 0; q < 2; ++q) { const float send = hi ? p[q][i] : p[q][i + 2]; const float keep = hi ? p[q][i + 2] : p[q][i]; p[q][i] = keep + __shfl_xor(send, 4); } }
#pragma unroll
    for (int q = 0; q < 2; ++q) { const bool hi = (lane & 2) != 0; const float send = hi ? p[q][0] : p[q][1]; const float keep = hi ? p[q][1] : p[q][0]; p[q][0] = keep + __shfl_xor(send, 2); }
    p[0][0] += __shfl_xor(p[0][0], 1); p[1][0] += __shfl_xor(p[1][0], 1);
    const int e_l = ((lane >> 5) & 1) * 16 + ((lane >> 4) & 1) * 8 + ((lane >> 3) & 1) * 4 + ((lane >> 2) & 1) * 2 + ((lane >> 1) & 1);
    const float brl = br[e_l];
    float lv[2] = {p[0][0] + brl, p[1][0] + brl}; int ei[2][4]; float ev[2][4];
    if (MODE == 2) for (int k = 1; k < 4; ++k) { ei[0][k] = ei[1][k] = k; ev[0][k] = ev[1][k] = 0.f; }
#pragma unroll
    for (int k = 0; k < (MODE == 2 ? 1 : 4); ++k) { float bv[2] = {lv[0], lv[1]}; int bi[2] = {e_l, e_l};
#pragma unroll
      for (int o = 2; o < 64; o <<= 1)
#pragma unroll
        for (int q = 0; q < 2; ++q) { const float ov = __shfl_xor(bv[q], o); const int oi = __shfl_xor(bi[q], o); const bool take = (ov > bv[q]) || (ov == bv[q] && oi < bi[q]); bv[q] = take ? ov : bv[q]; bi[q] = take ? oi : bi[q]; }
#pragma unroll
      for (int q = 0; q < 2; ++q) { ei[q][k] = bi[q]; ev[q][k] = bv[q]; if (e_l == bi[q]) lv[q] = -INFINITY; } }
    if (lane < 2) { const int q = lane;
      float ex[4], su = 0.f;
#pragma unroll
      for (int k = 0; k < 4; ++k) { ex[k] = __expf((q ? ev[1][k] : ev[0][k]) - (q ? ev[1][0] : ev[0][0])); su += ex[k]; }
      const float inv = 1.f / su; const int tok = tok0 + q;
      const int e0 = q ? ei[1][0] : ei[0][0], e1 = q ? ei[1][1] : ei[0][1], e2 = q ? ei[1][2] : ei[0][2], e3 = q ? ei[1][3] : ei[0][3];
      *(int4*)(m.tok_e + tok * 4) = make_int4(e0, e1, e2, e3);
      *(float4*)(m.tok_g + tok * 4) = make_float4(ex[0] * inv, ex[1] * inv, ex[2] * inv, ex[3] * inv);
      atomicAdd(&cnt[e0], 1); atomicAdd(&cnt[e1], 1); atomicAdd(&cnt[e2], 1); atomicAdd(&cnt[e3], 1); }
  }
  __syncthreads();
  if (tid < 32) m.blkcnt[blk * 32 + tid] = cnt[tid];
  __syncthreads();
}

__device__ __forceinline__ void ph_moe_scatter(const MoeBufs m, int* ilds) {
  const int tid = TIDX(), lane = tid & 63, wave = tid >> 6, blk = BIDX(); (void)lane;
  int* tot = ilds; int* bef = ilds + 32; int* pst = ilds + 64; int* es = ilds + 128; int* rk = ilds + 384; int* sl = ilds + 640; int* part = ilds + 896; int* wcnt = ilds + 1408;
  { const int e = tid & 31, pa = tid >> 5; int sum = 0;
#pragma unroll
    for (int q = 0; q < 16; ++q) sum += m.blkcnt[(pa * 16 + q) * 32 + e];
    part[pa * 32 + e] = sum; }
  if (tid < 256) es[tid] = m.tok_e[blk * 256 + tid];
  __syncthreads();
  if (tid < 32) { const int e = tid; int t_ = 0, b_ = 0; const int pb_ = blk >> 4;
    for (int q = 0; q < 16; ++q) { const int v = part[q * 32 + e]; t_ += v; if (q < pb_) b_ += v; }
    for (int q = pb_ * 16; q < blk; ++q) b_ += m.blkcnt[q * 32 + e];
    tot[e] = t_; bef[e] = b_; }
  if (tid < 256) { const int e = es[tid]; const unsigned long long lt = (1ull << lane) - 1ull; int r = 0;
    for (int ee = 0; ee < 32; ++ee) { const unsigned long long mk = __ballot(e == ee); if (e == ee) r = __builtin_popcountll(mk & lt); if (lane == ee) wcnt[wave * 32 + ee] = __builtin_popcountll(mk); }
    rk[tid] = r; }
  __syncthreads();
  if (tid == 0) { int acc = 0; for (int e = 0; e < 32; ++e) { pst[e] = acc; acc += ((tot[e] + 255) >> 8) << 8; } pst[32] = acc;
    if (blk == 0) { *m.nblk = acc >> 8; for (int e = 0; e < 32; ++e) for (int q = pst[e] >> 8; q < (pst[e + 1] >> 8); ++q) m.blk_e[q] = e; } }
  __syncthreads();
  if (tid < 256) { const int e = es[tid]; int rank = rk[tid]; for (int w2 = 0; w2 < wave; ++w2) rank += wcnt[w2 * 32 + e];
    const int slot = pst[e] + bef[e] + rank; m.slot_of[blk * 256 + tid] = slot; m.slot_gate[slot] = m.tok_g[blk * 256 + tid]; m.slot_tok[slot] = blk * 64 + (tid >> 2); }
  __syncthreads();
  __syncthreads();
}

__device__ __forceinline__ void ph_combine_ln(const bf16_t* x1b, const bf16_t* Ys, const int* slot_of, const float* g, const float* bb, float* out, bf16_t* outb) {
  const int tid = TIDX(), lane = tid & 63, gw = BIDX() * 8 + (tid >> 6), NGW = (int)gridDim.x * 8;
  f32x4 g4[4], b4[4];
#pragma unroll
  for (int j = 0; j < 4; ++j) { const int c = lane * 4 + 256 * j; g4[j] = *(const f32x4*)(g + c); b4[j] = *(const f32x4*)(bb + c); }
  v2u ys[4][4], xs[4];
#define CLN_RAW(r_, s_) { const int sl_[4] = {(s_).x, (s_).y, (s_).z, (s_).w}; _Pragma("unroll") for (int j = 0; j < 4; ++j) { const int c = lane * 4 + 256 * j; \
    _Pragma("unroll") for (int k = 0; k < 4; ++k) ys[j][k] = *(const v2u*)(Ys + (size_t)sl_[k] * D + c); xs[j] = *(const v2u*)(x1b + (size_t)(r_) * D + c); } }
  int row = gw;
  if (row >= NT) return;
  int4 s4n;
  { const int4 s4 = *(const int4*)(slot_of + row * 4); CLN_RAW(row, s4) s4n = *(const int4*)(slot_of + (row + NGW < NT ? row + NGW : row) * 4); }
#pragma unroll 1
  for (; row < NT; row += NGW) {
    f32x4 v[4]; float s = 0.f;
#pragma unroll
    for (int j = 0; j < 4; ++j) { f32x4 f = (f32x4){0.f, 0.f, 0.f, 0.f};
#pragma unroll
      for (int k = 0; k < 4; ++k) { const v2u y = ys[j][k]; f += (f32x4){bf_lo(y[0]), bf_hi(y[0]), bf_lo(y[1]), bf_hi(y[1])}; }
      const v2u xv = xs[j]; const f32x4 a = (f32x4){bf_lo(xv[0]), bf_hi(xv[0]), bf_lo(xv[1]), bf_hi(xv[1])}; v[j] = a * ALPHA + f; s += (v[j][0] + v[j][1]) + (v[j][2] + v[j][3]); }
    if (row + NGW < NT) { const int4 s4 = s4n; CLN_RAW(row + NGW, s4) s4n = *(const int4*)(slot_of + (row + 2 * NGW < NT ? row + 2 * NGW : row) * 4); }
    const float mu = wave_sum(s) * (1.f / D); float q = 0.f;
#pragma unroll
    for (int j = 0; j < 4; ++j) { v[j] = v[j] - mu; q += (v[j][0] * v[j][0] + v[j][1] * v[j][1]) + (v[j][2] * v[j][2] + v[j][3] * v[j][3]); }
    const float r = rsqrtf(wave_sum(q) * (1.f / D) + 1e-5f);
#pragma unroll
    for (int j = 0; j < 4; ++j) { const int c = lane * 4 + 256 * j; const f32x4 o = v[j] * r * g4[j] + b4[j];
      if (out) *(f32x4*)(out + (size_t)row * D + c) = o; if (outb) *(v2u*)(outb + (size_t)row * D + c) = (v2u){cvt_pk_bf16(o[0], o[1]), cvt_pk_bf16(o[2], o[3])}; }
  }
#undef CLN_RAW
}

namespace pg8 {
template <bool GATHER_> struct MoeOrderT {
    static constexpr bool GATHER = GATHER_; const int* rowmap;
    StaticOrder so; const int* blk_e; const char* W; size_t wexp; int obn;
    __device__ void init(const void* A, int lda, const void* W_, int ldb, size_t wexp_, int nM, int nN, int obn_, const int* blk_e_, int G, int c) { so.init(A, lda, W_, ldb, nM * BM, nN * BM, G, c); blk_e = blk_e_; W = (const char*)W_; wexp = wexp_; obn = obn_; }
    __device__ bool next(int i, Unit& u) const { int pm, pn; if (!so.tile(i, pm, pn)) return false; const int e = __builtin_amdgcn_readfirstlane(blk_e[pm]); u.pa = GATHER_ ? so.A : so.A + (size_t)pm * so.ta; u.pb = W + (size_t)e * wexp + (size_t)pn * so.tb; u.orow = pm * BM; u.ocol = pn * obn; u.e = e; u.kind = 0; return true; }
    __device__ __forceinline__ int rowof(const Unit&, int r) const { return GATHER_ ? rowmap[r] : r; }
    __device__ __forceinline__ void a_ready(const Unit&) const {}
    __device__ __forceinline__ void done(const Unit&) const {}
};
typedef MoeOrderT<false> MoeOrder; typedef MoeOrderT<true> MoeOrderG;
struct EpiSwiglu {
    static constexpr bool PERM = true, AFTER_DRAIN = false;
    bf16_t* O; int ldc; const float* b1;
    __device__ __forceinline__ void operator()(const f32x4 (&acc)[2][2][4][2], const Unit& u, int wr, int wc, int fr, int fq) const {
        const int row0 = u.orow + wr * 64 + fr, cl = wc * 32 + 8 * fq, col0 = u.ocol + cl;
        const float* bg = b1 + (size_t)u.e * 2048 + col0; const float* bu = bg + 1024;
        const f32x4 bg0 = *(const f32x4*)bg, bg1 = *(const f32x4*)(bg + 4), bu0 = *(const f32x4*)bu, bu1 = *(const f32x4*)(bu + 4);
#pragma unroll
        for (int ai = 0; ai < 2; ++ai)
#pragma unroll
            for (int m = 0; m < 4; ++m) {
                f32x4 gv[2] = {acc[ai][0][m][0] + bg0, acc[ai][0][m][1] + bg1}, uv[2] = {acc[ai][1][m][0] + bu0, acc[ai][1][m][1] + bu1}; float o[8];
#pragma unroll
                for (int n = 0; n < 2; ++n)
#pragma unroll
                    for (int i = 0; i < 4; ++i) { const float gg = fminf(gv[n][i], 7.f), uu = fminf(fmaxf(uv[n][i], -7.f), 7.f);
                        const float sg = __builtin_amdgcn_rcpf(1.f + __builtin_amdgcn_exp2f(-1.702f * 1.4426950408889634f * gg)); o[4 * n + i] = (uu + 1.f) * gg * sg; }
                u32x4 w; w.x = cvt_pk_bf16(o[0], o[1]); w.y = cvt_pk_bf16(o[2], o[3]); w.z = cvt_pk_bf16(o[4], o[5]); w.w = cvt_pk_bf16(o[6], o[7]);
                *(u32x4*)(O + (size_t)(row0 + ai * HALF + m * 16) * ldc + col0) = w; asm volatile("" ::: "memory"); }
    }
};
struct EpiMoe2 {
    static constexpr bool PERM = true, AFTER_DRAIN = false;
    bf16_t* O; int ldc; const float* b2; const float* gate;
    __device__ __forceinline__ void operator()(const f32x4 (&acc)[2][2][4][2], const Unit& u, int wr, int wc, int fr, int fq) const {
        const int row0 = u.orow + wr * 64 + fr, col0 = u.ocol + wc * 32 + 8 * fq;
        const float* bp = b2 + (size_t)u.e * 1024 + col0;
        f32x4 bv[2][2]; float gts[2][4];
#pragma unroll
        for (int bj = 0; bj < 2; ++bj) { bv[bj][0] = *(const f32x4*)(bp + bj * HALF); bv[bj][1] = *(const f32x4*)(bp + bj * HALF + 4); }
#pragma unroll
        for (int ai = 0; ai < 2; ++ai)
#pragma unroll
            for (int m = 0; m < 4; ++m) gts[ai][m] = gate[row0 + ai * HALF + m * 16];
#pragma unroll
        for (int bj = 0; bj < 2; ++bj) {
            const f32x4 bv0 = bv[bj][0], bv1 = bv[bj][1];
#pragma unroll
            for (int ai = 0; ai < 2; ++ai)
#pragma unroll
                for (int m = 0; m < 4; ++m) { const int row = row0 + ai * HALF + m * 16; const float gt = gts[ai][m];
                    const f32x4 v0 = (acc[ai][bj][m][0] + bv0) * gt, v1 = (acc[ai][bj][m][1] + bv1) * gt;
                    u32x4 w; w.x = cvt_pk_bf16(v0[0], v0[1]); w.y = cvt_pk_bf16(v0[2], v0[3]); w.z = cvt_pk_bf16(v1[0], v1[1]); w.w = cvt_pk_bf16(v1[2], v1[3]);
                    *(u32x4*)(O + (size_t)row * ldc + col0 + bj * HALF) = w; asm volatile("" ::: "memory"); }
        }
    }
};

struct MoeFusedOrder {
    static constexpr bool GATHER = true;
    const int* rowmap; const int* blk_e; const char* X; const char* ACT; const char* W1; const char* W2; unsigned* ready; unsigned* tmo; int nblk, NG, G, c, total, mode;
    __device__ void init(const void* X_, const void* ACT_, const void* W1_, const void* W2_, const int* rowmap_, const int* blk_e_, unsigned* ready_, unsigned* tmo_, int nblk_, int G_, int c_) {
        X = (const char*)X_; ACT = (const char*)ACT_; W1 = (const char*)W1_; W2 = (const char*)W2_; rowmap = rowmap_; blk_e = blk_e_; ready = ready_; tmo = tmo_; nblk = nblk_; NG = (nblk_ + 31) >> 5; G = G_; c = c_; total = nblk_ * 12; }
    __device__ bool next(int i, Unit& u) const {
        int Lq = i * G + c; if (Lq >= total) return false;
#if defined(FUSE_SPLIT)
        if (c >= 0) { const int kind = mode - 1; if (Lq >= nblk * (kind ? 4 : 8)) return false; const int q = Lq; const int pm = q % nblk, pn = q / nblk, e = __builtin_amdgcn_readfirstlane(blk_e[pm]);
          u.kind = kind; u.e = e; u.orow = pm * BM;
          if (kind == 0) { u.pa = X; u.pb = W1 + ((size_t)e * 2048 + (size_t)pn * 256) * 2048; u.ocol = pn * 128; }
          else { u.pa = ACT; u.pb = W2 + ((size_t)e * 1024 + (size_t)pn * 256) * 2048; u.ocol = pn * 256; }
          return true; }
#endif
#if defined(FUSE_SERIAL)
        { const int n1 = nblk * 8; int kind = Lq < n1 ? 0 : 1; int q = kind ? Lq - n1 : Lq; const int pm = q % nblk, pn = q / nblk, e = __builtin_amdgcn_readfirstlane(blk_e[pm]);
          u.kind = kind; u.e = e; u.orow = pm * BM;
          if (kind == 0) { u.pa = X; u.pb = W1 + ((size_t)e * 2048 + (size_t)pn * 256) * 2048; u.ocol = pn * 128; }
          else { u.pa = ACT; u.pb = W2 + ((size_t)e * 1024 + (size_t)pn * 256) * 2048; u.ocol = pn * 256; }
          return true; }
#endif
        int kind = 0, g = 0;
        for (int sgm = 0; ; ++sgm) {
            if (sgm < 3) { kind = 0; g = sgm; }
            else if (sgm < 3 + 2 * (NG - 3)) { const int j = (sgm - 3) >> 1; if (((sgm - 3) & 1) == 0) { kind = 0; g = j + 3; } else { kind = 1; g = j; } }
            else { kind = 1; g = NG - 3 + (sgm - (3 + 2 * (NG - 3))); }
            const int mg = min(32, nblk - 32 * g), sz = mg * (kind ? 4 : 8);
            if (Lq < sz) { const int pm = 32 * g + Lq % mg, pn = Lq / mg, e = __builtin_amdgcn_readfirstlane(blk_e[pm]);
                u.kind = kind; u.e = e; u.orow = pm * BM;
                if (kind == 0) { u.pa = X; u.pb = W1 + ((size_t)e * 2048 + (size_t)pn * 256) * 2048; u.ocol = pn * 128; }
                else { u.pa = ACT; u.pb = W2 + ((size_t)e * 1024 + (size_t)pn * 256) * 2048; u.ocol = pn * 256; }
                return true; }
            Lq -= sz;
        }
    }
    __device__ __forceinline__ int rowof(const Unit& u, int r) const { return u.kind == 0 ? rowmap[r] : r; }
    __device__ __forceinline__ void a_ready(const Unit& u) const {
        if (u.kind == 0) return;
#if defined(FUSE_SPLIT)
        return;
#endif
        if (threadIdx.x < 64) {
#if defined(FUSE_GLOBAL_WAIT)
            const unsigned long long t0 = __builtin_amdgcn_s_memrealtime(); unsigned polls = 0; unsigned* rp = ready + 64 * 500; const unsigned want = (unsigned)nblk * 64u;
#else
            const unsigned long long t0 = __builtin_amdgcn_s_memrealtime(); unsigned polls = 0; unsigned* rp = ready + 64 * (u.orow >> 8); const unsigned want = 64u;
#endif
            while ((unsigned)__builtin_amdgcn_readfirstlane(__hip_atomic_load(rp, __ATOMIC_RELAXED, __HIP_MEMORY_SCOPE_AGENT)) < want) {
                if ((++polls & 255u) == 0u && __builtin_amdgcn_readfirstlane(__hip_atomic_load(tmo, __ATOMIC_RELAXED, __HIP_MEMORY_SCOPE_AGENT)) != 0u) break;
                if (__builtin_amdgcn_s_memrealtime() - t0 > 2000000ull) { if (threadIdx.x == 0) __hip_atomic_store(tmo, 1u, __ATOMIC_RELAXED, __HIP_MEMORY_SCOPE_AGENT); break; }
                __builtin_amdgcn_s_sleep(2); }
#if defined(FUSE_CONSUMER_WB)
            __builtin_amdgcn_fence(__ATOMIC_RELEASE, "agent"); asm volatile("s_waitcnt vmcnt(0)" ::: "memory");
#endif
#if defined(FUSE_DELAY)
            { const unsigned long long t1 = __builtin_amdgcn_s_memrealtime(); while (__builtin_amdgcn_s_memrealtime() - t1 < 2000ull) __builtin_amdgcn_s_sleep(8); }
#endif
            __builtin_amdgcn_fence(__ATOMIC_ACQUIRE, "agent");
            asm volatile("s_waitcnt vmcnt(0)" ::: "memory");
        }
        asm volatile("" ::: "memory"); __builtin_amdgcn_s_barrier(); asm volatile("" ::: "memory");
    }
    __device__ __forceinline__ void done(const Unit& u) const {
        if (u.kind != 0) return;
        asm volatile("s_waitcnt vmcnt(0)" ::: "memory");
#if defined(FUSE_HEAVY_RELEASE)
        __builtin_amdgcn_fence(__ATOMIC_RELEASE, "agent"); asm volatile("s_waitcnt vmcnt(0)" ::: "memory");
#endif
#if defined(FUSE_GLOBAL_WAIT)
        if ((threadIdx.x & 63) == 0) __hip_atomic_fetch_add(ready + 64 * 500, 1u, __ATOMIC_RELAXED, __HIP_MEMORY_SCOPE_AGENT);
#else
        if ((threadIdx.x & 63) == 0) __hip_atomic_fetch_add(ready + 64 * (u.orow >> 8), 1u, __ATOMIC_RELAXED, __HIP_MEMORY_SCOPE_AGENT);
#endif
    }
};
__device__ __forceinline__ void store16_sc1(void* p, u32x4 v) { asm volatile("global_store_dwordx4 %0, %1, off sc1\n\ts_nop 1" :: "v"(p), "v"(v) : "memory"); }
struct EpiMoeFused {
    static constexpr bool PERM = true, AFTER_DRAIN = false;
    bf16_t* ACTo; const float* b1; bf16_t* Yo; const float* b2; const float* gate;
    __device__ __forceinline__ void operator()(const f32x4 (&acc)[2][2][4][2], const Unit& u, int wr, int wc, int fr, int fq) const {
        if (u.kind == 0) {
            const int row0 = u.orow + wr * 64 + fr, cl = wc * 32 + 8 * fq, col0 = u.ocol + cl;
            const float* bg = b1 + (size_t)u.e * 2048 + col0; const float* bu = bg + 1024;
            const f32x4 bg0 = *(const f32x4*)bg, bg1 = *(const f32x4*)(bg + 4), bu0 = *(const f32x4*)bu, bu1 = *(const f32x4*)(bu + 4);
#pragma unroll
            for (int ai = 0; ai < 2; ++ai)
#pragma unroll
                for (int m = 0; m < 4; ++m) {
                    f32x4 gv[2] = {acc[ai][0][m][0] + bg0, acc[ai][0][m][1] + bg1}, uv[2] = {acc[ai][1][m][0] + bu0, acc[ai][1][m][1] + bu1}; float o[8];
#pragma unroll
                    for (int n = 0; n < 2; ++n)
#pragma unroll
                        for (int i = 0; i < 4; ++i) { const float gg = fminf(gv[n][i], 7.f), uu = fminf(fmaxf(uv[n][i], -7.f), 7.f);
                            const float sg = __builtin_amdgcn_rcpf(1.f + __builtin_amdgcn_exp2f(-1.702f * 1.4426950408889634f * gg)); o[4 * n + i] = (uu + 1.f) * gg * sg; }
                    u32x4 w; w.x = cvt_pk_bf16(o[0], o[1]); w.y = cvt_pk_bf16(o[2], o[3]); w.z = cvt_pk_bf16(o[4], o[5]); w.w = cvt_pk_bf16(o[6], o[7]);
#if defined(FUSE_PLAIN_STORE)
                    *(u32x4*)(ACTo + (size_t)(row0 + ai * HALF + m * 16) * 1024 + col0) = w; }
#else
                    store16_sc1(ACTo + (size_t)(row0 + ai * HALF + m * 16) * 1024 + col0, w); }
#endif
        } else {
            const int row0 = u.orow + wr * 64 + fr, col0 = u.ocol + wc * 32 + 8 * fq;
            const float* bp = b2 + (size_t)u.e * 1024 + col0;
#pragma unroll
            for (int bj = 0; bj < 2; ++bj) {
                const f32x4 bv0 = *(const f32x4*)(bp + bj * HALF), bv1 = *(const f32x4*)(bp + bj * HALF + 4);
#pragma unroll
                for (int ai = 0; ai < 2; ++ai)
#pragma unroll
                    for (int m = 0; m < 4; ++m) { const int row = row0 + ai * HALF + m * 16; const float gt = gate[row];
                        const f32x4 v0 = (acc[ai][bj][m][0] + bv0) * gt, v1 = (acc[ai][bj][m][1] + bv1) * gt;
                        u32x4 w; w.x = cvt_pk_bf16(v0[0], v0[1]); w.y = cvt_pk_bf16(v0[2], v0[3]); w.z = cvt_pk_bf16(v1[0], v1[1]); w.w = cvt_pk_bf16(v1[2], v1[3]);
                        *(u32x4*)(Yo + (size_t)row * 1024 + col0 + bj * HALF) = w; asm volatile("" ::: "memory"); }
            }
        }
    }
};
}
typedef short v4i16_t __attribute__((ext_vector_type(4)));
__device__ __forceinline__ unsigned f2key_u(float f) { f = f + 0.0f; const unsigned u = __float_as_uint(f); return (u & 0x80000000u) ? ~u : (u | 0x80000000u); }

__device__ __forceinline__ void ph_cnorm_b(const bf16_t* pa, const float* g, bf16_t* cnb) {
  const int tid = TIDX(), lane = tid & 63, gw = BIDX() * 8 + (tid >> 6), NGW = (int)gridDim.x * 8;
  const f32x4 g4 = *(const f32x4*)(g + lane * 4);
  for (int row = gw; row < NT; row += NGW) {
    const v2u v = *(const v2u*)(pa + (size_t)row * 2048 + 1024 + lane * 4);
    const f32x4 f = (f32x4){bf_lo(v[0]), bf_hi(v[0]), bf_lo(v[1]), bf_hi(v[1])};
    const float r = rsqrtf(wave_sum((f[0] * f[0] + f[1] * f[1]) + (f[2] * f[2] + f[3] * f[3])) * (1.f / 256.f) + 1e-6f);
    const f32x4 o = f * r * g4;
    *(v2u*)(cnb + (size_t)row * 256 + lane * 4) = (v2u){cvt_pk_bf16(o[0], o[1]), cvt_pk_bf16(o[2], o[3])};
  }
}

__device__ __forceinline__ int moe_layer_tile(int layer, int j) { return j < 8192 ? layer * 8192 + j : 16384 + layer * 4096 + (j - 8192); }
__device__ __forceinline__ void moe_weight_tile(int T, const float* w1, const float* w2, bf16_t* W1_t, bf16_t* W2_t, int lane) {
  if (T < 16384) { const int le = T >> 8; transpose_tile(mk_tjob(w1 + (size_t)le * D * 2048, 2048, D, 2048, W1_t + (size_t)le * 2048 * D, D, 0, 0, 1), T & 255, lane); }
  else if (T < 24576) { const int t2 = T - 16384, le = t2 >> 7; transpose_tile(mk_tjob(w2 + (size_t)le * D * D, D, D, D, W2_t + (size_t)le * D * D, D, 0, 0, 0), t2 & 127, lane); }
}
typedef _Float16 h16x2_t __attribute__((ext_vector_type(2)));
typedef int i32x4_t __attribute__((ext_vector_type(4)));
__device__ __forceinline__ unsigned cvt_pk_f16(float lo, float hi) { const f32x2_t v = {lo, hi}; const h16x2_t h = __builtin_convertvector(v, h16x2_t); return __builtin_bit_cast(unsigned, h); }
constexpr int ISC_NU = 1088;
__device__ __forceinline__ void isc_decode(unsigned u, int& b, int& j, int& c) { b = (int)(u / 544u); int v = (int)u - b * 544; j = 63; while (v >= ((j + 4) >> 2)) { v -= (j + 4) >> 2; --j; } c = v; }
template <int HOT = 0> __device__ __forceinline__ void ph_iscore(const bf16_t* pa, const bf16_t* kib, unsigned short* sc, unsigned* ctr, LAS unsigned char* lds) {
  const int tid = TIDX(), lane = tid & 63, wave = __builtin_amdgcn_readfirstlane(tid >> 6);
  const int n16 = lane & 15, g = lane >> 4;
  volatile LAS unsigned* slot = (volatile LAS unsigned*)(lds + MISC_OFF + 80);
  __syncthreads();
  if (tid == 0) { slot[0] = __hip_atomic_fetch_add(ctr, 1u, __ATOMIC_RELAXED, __HIP_MEMORY_SCOPE_AGENT); slot[1] = __hip_atomic_fetch_add(ctr, 1u, __ATOMIC_RELAXED, __HIP_MEMORY_SCOPE_AGENT); }
  __syncthreads();
  unsigned cur = slot[0], nxt = slot[1];
  __syncthreads();
  const unsigned lofs = (unsigned)(n16 * 128 + 16 * (g ^ (n16 >> 1))), lofs1 = (unsigned)(n16 * 128 + 16 * ((4 + g) ^ (n16 >> 1)));
#define ISC_DMA(u_, pb_) { int b_, j_, c_; isc_decode((u_), b_, j_, c_); const bf16_t* src0 = kib + (size_t)(b_ * L + 512 * c_) * 64; \
    _Pragma("unroll") for (int i = 0; i < 8; ++i) { const int rl = 8 * (8 * wave + i) + (lane >> 3), ch = (lane & 7) ^ ((rl >> 1) & 7); \
      __builtin_amdgcn_global_load_lds((const unsigned*)(src0 + (size_t)rl * 64 + ch * 8), (LAS unsigned*)(lds + (pb_) * 65536 + (8 * wave + i) * 1024), 16, 0, 0); } }
  int pb = 0;
  bf16x8 qn[8][2], wvn;
#define ISC_QLOAD(u_) { int b_, j_, c_; isc_decode((u_), b_, j_, c_); const bf16_t* qr_ = pa + (size_t)(b_ * L + (8 * j_ + wave) * 16 + n16) * 2048; wvn = *(const bf16x8*)(qr_ + 1856); \
    _Pragma("unroll") for (int h = 0; h < 8; ++h) { qn[h][0] = *(const bf16x8*)(qr_ + 1280 + h * 64 + 8 * g); qn[h][1] = *(const bf16x8*)(qr_ + 1280 + h * 64 + 32 + 8 * g); } }
  if (cur < (unsigned)ISC_NU) { ISC_DMA(cur, 0) ISC_QLOAD(cur) }
  asm volatile("s_waitcnt vmcnt(0)" ::: "memory");
  __syncthreads();
  int itp = 0;
#pragma unroll 1
  while (cur < (unsigned)ISC_NU) {
    bf16x8 qf[8][2]; float w[8];
#pragma unroll
    for (int h = 0; h < 8; ++h) { qf[h][0] = qn[h][0]; qf[h][1] = qn[h][1]; w[h] = bf2f((bf16_t)wvn[h]) * (0.35355339059327373f * 0.125f); }
    if (nxt < (unsigned)ISC_NU) { ISC_DMA(nxt, pb ^ 1) ISC_QLOAD(nxt) }
    unsigned grabbed = 0u; if (tid == 0) grabbed = __hip_atomic_fetch_add(ctr, 1u, __ATOMIC_RELAXED, __HIP_MEMORY_SCOPE_AGENT);
    int b, j, c; isc_decode(cur, b, j, c);
    const int qg = 8 * j + wave, t0 = qg * 16, ntl = min(32, qg + 1 - 32 * c);
    unsigned short* srow = sc + (size_t)(HOT ? ((t0 + n16) & 63) : (b * L + t0 + n16)) * L + 4 * g + 32 * c * 16;
    const LAS unsigned char* kb0 = lds + pb * 65536 + lofs; const LAS unsigned char* kb1 = lds + pb * 65536 + lofs1;
#pragma unroll 1
    for (int tl = 0; tl < ntl; tl += 4) {
      bf16x8 k0[4], k1[4];
#pragma unroll
      for (int p = 0; p < 4; ++p) { k0[p] = *(const LAS bf16x8*)(kb0 + (tl + p) * 2048); k1[p] = *(const LAS bf16x8*)(kb1 + (tl + p) * 2048); }
#pragma unroll
      for (int p = 0; p < 4; ++p) {
        f32x4 score = (f32x4){0.f, 0.f, 0.f, 0.f};
#pragma unroll
        for (int h = 0; h < 8; h += 2) {
          f32x4 acc0 = __builtin_amdgcn_mfma_f32_16x16x32_bf16(k0[p], qf[h][0], (f32x4){0.f, 0.f, 0.f, 0.f}, 0, 0, 0);
          f32x4 acc1 = __builtin_amdgcn_mfma_f32_16x16x32_bf16(k0[p], qf[h + 1][0], (f32x4){0.f, 0.f, 0.f, 0.f}, 0, 0, 0);
          acc0 = __builtin_amdgcn_mfma_f32_16x16x32_bf16(k1[p], qf[h][1], acc0, 0, 0, 0);
          acc1 = __builtin_amdgcn_mfma_f32_16x16x32_bf16(k1[p], qf[h + 1][1], acc1, 0, 0, 0);
          const f32x4 r0 = __builtin_bit_cast(f32x4, __builtin_elementwise_max(__builtin_bit_cast(i32x4_t, acc0), (i32x4_t){0, 0, 0, 0}));
          const f32x4 r1 = __builtin_bit_cast(f32x4, __builtin_elementwise_max(__builtin_bit_cast(i32x4_t, acc1), (i32x4_t){0, 0, 0, 0}));
#pragma unroll
          for (int i = 0; i < 4; ++i) score[i] = fmaf(r1[i], w[h + 1], fmaf(r0[i], w[h], score[i]));
        }
        if (tl + p < ntl) *(v2u*)(srow + (tl + p) * 16) = (v2u){cvt_pk_f16(score[0], score[1]), cvt_pk_f16(score[2], score[3])};
      }
    }
    if (tid == 0) slot[itp] = grabbed;
    asm volatile("s_waitcnt vmcnt(0)" ::: "memory");
    __syncthreads();
    cur = nxt; nxt = slot[itp]; itp ^= 1; pb ^= 1;
  }
#undef ISC_DMA
#undef ISC_QLOAD
  __syncthreads();
}

constexpr int DW_STRIDE = 17152;
__device__ __forceinline__ unsigned offb(unsigned row, unsigned ch) { return 256u * row + 16u * (ch ^ (((row & 3u) << 2) | ((row >> 2) & 3u))); }
__device__ __forceinline__ void glds16(const void* gsrc, unsigned lds_dst) { unsigned keep;
  asm volatile("s_mov_b32 %0, m0\n\ts_mov_b32 m0, %2\n\ts_nop 0\n\tglobal_load_lds_dwordx4 %1, off\n\ts_mov_b32 m0, %0" : "=&s"(keep) : "v"(gsrc), "s"(lds_dst) : "memory"); }
__device__ __forceinline__ int wave_excl_scan(int v, int lane, int& total) {
  int x = v;
#pragma unroll
  for (int o = 1; o < 64; o <<= 1) { const int y = __shfl_up(x, o); if (lane >= o) x += y; }
  total = __shfl(x, 63); return x - v;
}
#define LDSW() asm volatile("s_waitcnt lgkmcnt(0)" ::: "memory")
__device__ __forceinline__ int wave_incl_scan_dpp(int v, int lane, int& total) {
  int x = v;
  x += __builtin_amdgcn_update_dpp(0, x, 0x111, 0xf, 0xf, true);
  x += __builtin_amdgcn_update_dpp(0, x, 0x112, 0xf, 0xf, true);
  x += __builtin_amdgcn_update_dpp(0, x, 0x114, 0xf, 0xf, true);
  x += __builtin_amdgcn_update_dpp(0, x, 0x118, 0xf, 0xf, true);
  const int t0 = __builtin_amdgcn_readlane(x, 15), t1 = __builtin_amdgcn_readlane(x, 31), t2 = __builtin_amdgcn_readlane(x, 47), t3 = __builtin_amdgcn_readlane(x, 63);
  const int row = lane >> 4;
  x += (row >= 1 ? t0 : 0) + (row >= 2 ? t1 : 0) + (row >= 3 ? t2 : 0);
  total = t0 + t1 + t2 + t3; return x;
}

__device__ __forceinline__ unsigned h2key(unsigned h) { return (h & 0x8000u) ? (~h & 0xFFFFu) : (h | 0x8000u); }
template <int MODE = 0> __device__ __forceinline__ int wave_select(const unsigned short* srow, int t, LAS unsigned char* wl, LAS unsigned short* idx16, int lane) {
  const int n = t + 1;
  if (n <= 256) { for (int i = lane; i < 256; i += 64) idx16[i] = (unsigned short)(i < n ? i : 0); LDSW(); return n; }
  LAS unsigned* hist = (LAS unsigned*)wl;
  for (int i = lane; i < 1024; i += 64) ((LAS v4u*)hist)[i] = (v4u){0u, 0u, 0u, 0u};
  unsigned bk[16][4];
#pragma unroll
  for (int hb = 0; hb < 2; ++hb) { v4u f[8]; int lane_l = lane; asm volatile("" : "+v"(lane_l));
#pragma unroll
    for (int grp = 0; grp < 2; ++grp) if ((2 * hb + grp) * 2048 < n) {
#pragma unroll
      for (int k = 0; k < 4; ++k) f[4 * grp + k] = *(const v4u*)(srow + ((8 * hb + 4 * grp + k) * 64 + lane_l) * 8); }
#pragma unroll
    for (int ii = 0; ii < 8; ++ii) { const int i = 8 * hb + ii;
      bk[i][0] = 0u; bk[i][1] = 0u; bk[i][2] = 0u; bk[i][3] = 0u;
      if (i * 512 < n) { const int e0 = (i * 64 + lane_l) * 8;
#pragma unroll
        for (int c = 0; c < 4; ++c) { const unsigned lo = f[ii][c] & 0xFFFFu, hi = f[ii][c] >> 16;
          const unsigned m0 = (e0 + 2 * c <= t) ? 0xFFFFu : 0u, m1 = (e0 + 2 * c + 1 <= t) ? 0xFFFFu : 0u;
          const unsigned b0 = (h2key(lo == 0x8000u ? 0u : lo) >> 4) & m0, b1 = (h2key(hi == 0x8000u ? 0u : hi) >> 4) & m1;
          bk[i][c] = b0 | (b1 << 16); } }
    }
    asm volatile("" ::: "memory"); }
#define BIN_OF(i, c) ((bk[i][(c) >> 1] >> (((c) & 1) * 16)) & 0xFFFFu)
  LDSW();
#if defined(SEL_REP_HIST)
#pragma unroll 1
  for (int rep_ = 0; rep_ < 2; ++rep_) {
  for (int i = lane; i < 1024; i += 64) ((LAS v4u*)hist)[i] = (v4u){0u, 0u, 0u, 0u};
  LDSW();
#endif
#pragma unroll
  for (int i = 0; i < 16; ++i) if (i * 512 < n) {
#pragma unroll
    for (int c = 0; c < 8; ++c) { const unsigned bin = BIN_OF(i, c); __hip_atomic_fetch_add(hist + bin, 1u, __ATOMIC_RELAXED, __HIP_MEMORY_SCOPE_WORKGROUP); }
    asm volatile("" ::: "memory"); }
  LDSW();
#if defined(SEL_REP_HIST)
  }
#endif
  if (MODE == 1) return 0;
  const int bbase = 4096 - 64 * (lane + 1); int ssum = 0;
#pragma unroll 16
  for (int k = 0; k < 64; ++k) ssum += (int)hist[bbase + ((k + lane) & 63)];
  int tot; const int pre = wave_incl_scan_dpp(ssum, lane, tot) - ssum;
  const unsigned long long bal = __ballot(pre < 256 && pre + ssum >= 256);
  const int Ls = (int)__builtin_ctzll(bal);
  const int cum0 = __builtin_amdgcn_readlane(pre, Ls), sb = 4096 - 64 * (Ls + 1);
  const int ck = (int)hist[sb + 63 - lane]; int t2_; const int inc = wave_incl_scan_dpp(ck, lane, t2_);
  const unsigned long long bal2 = __ballot(cum0 + inc >= 256);
  const int kk = (int)__builtin_ctzll(bal2);
  const int B1 = sb + 63 - kk, cnt_gt = cum0 + __builtin_amdgcn_readlane(inc, kk) - __builtin_amdgcn_readlane(ck, kk), need1 = 256 - cnt_gt;
  LDSW();
  if (MODE == 2) { idx16[lane] = (unsigned short)(B1 + need1); return 0; }
  const unsigned kg = (0x7FFFu - (unsigned)B1) * 0x00010001u, kge = kg + 0x00010001u;
  int ngt = 0, neq = 0;
#pragma unroll
  for (int i = 0; i < 16; ++i) if (i * 512 < n) {
#pragma unroll
    for (int c2 = 0; c2 < 4; ++c2) { const unsigned x = bk[i][c2], fg = (x + kg) & 0x80008000u, fe = ((x + kge) & 0x80008000u) & ~fg; ngt += __builtin_popcount(fg); neq += __builtin_popcount(fe); } }
  int tg, te; int pg = wave_incl_scan_dpp(ngt, lane, tg) - ngt; int pe = wave_incl_scan_dpp(neq, lane, te) - neq;
  LAS unsigned short* cand = (LAS unsigned short*)wl;
#pragma unroll
  for (int i = 0; i < 16; ++i) if (i * 512 < n) {
#pragma unroll
    for (int c2 = 0; c2 < 4; ++c2) { const unsigned x = bk[i][c2], fg = (x + kg) & 0x80008000u, fe = ((x + kge) & 0x80008000u) & ~fg; const int e = (i * 64 + lane) * 8 + 2 * c2;
      if (fg & 0x8000u) { idx16[pg] = (unsigned short)e; ++pg; }
      if (fg & 0x80000000u) { idx16[pg] = (unsigned short)(e + 1); ++pg; }
      if (fe & 0x8000u) { cand[pe] = (unsigned short)e; ++pe; }
      if (fe & 0x80000000u) { cand[pe] = (unsigned short)(e + 1); ++pe; } }
    asm volatile("" ::: "memory"); }
#undef BIN_OF
  LDSW();
  const int m = te;
  if (MODE == 3) return m;
  unsigned lo = 0u;
  if (m <= 64) {
    unsigned cpv = 0u; if (lane < m) { const unsigned ci = cand[lane]; unsigned hv = srow[ci]; hv = (hv == 0x8000u) ? 0u : hv; cpv = ((h2key(hv) & 15u) << 13) | (8191u - ci) | (1u << 20); }
    int rank = 0;
    for (int k = 0; k < m; ++k) { const unsigned ok = (unsigned)__builtin_amdgcn_readlane((int)cpv, k); rank += (ok > cpv) ? 1 : 0; }
    const bool sel = (lane < m) && (rank < need1);
    const unsigned long long bs = __ballot(sel);
    if (sel) idx16[cnt_gt + __builtin_popcountll(bs & ((1ull << lane) - 1ull))] = (unsigned short)(8191u - (cpv & 0x1FFFu));
  } else if (m <= 256) {
    unsigned cp[4];
#pragma unroll
    for (int j = 0; j < 4; ++j) { const int q = lane + 64 * j; cp[j] = 0u; if (q < m) { const unsigned ci = cand[q]; unsigned hv = srow[ci]; hv = (hv == 0x8000u) ? 0u : hv; cp[j] = ((h2key(hv) & 15u) << 13) | (8191u - ci) | (1u << 20); } }
    for (int bit = 16; bit >= 0; --bit) { const unsigned trial = lo | (1u << bit); int tc = 0;
#pragma unroll
      for (int j = 0; j < 4; ++j) tc += __builtin_popcountll(__ballot((cp[j] >> 20) && ((cp[j] & 0x1FFFFu) >= trial)));
      if (tc >= need1) lo = trial; }
    int pos = cnt_gt;
#pragma unroll
    for (int j = 0; j < 4; ++j) { const bool sel = (cp[j] >> 20) && ((cp[j] & 0x1FFFFu) >= lo); const unsigned long long bs = __ballot(sel);
      if (sel) idx16[pos + __builtin_popcountll(bs & ((1ull << lane) - 1ull))] = (unsigned short)(8191u - (cp[j] & 0x1FFFu)); pos += __builtin_popcountll(bs); }
  } else {
    for (int bit = 16; bit >= 0; --bit) { const unsigned trial = lo | (1u << bit); int c = 0;
      for (int q = lane; q < m; q += 64) { const unsigned ci = cand[q]; unsigned hv = srow[ci]; hv = (hv == 0x8000u) ? 0u : hv; const unsigned cpq = ((h2key(hv) & 15u) << 13) | (8191u - ci); c += (cpq >= trial) ? 1 : 0; }
      int tc; (void)wave_excl_scan(c, lane, tc); if (tc >= need1) lo = trial; }
    int base = cnt_gt;
    for (int q0 = 0; q0 < m; q0 += 64) { const int q = q0 + lane; bool sel = false; unsigned ci = 0;
      if (q < m) { ci = cand[q]; unsigned hv = srow[ci]; hv = (hv == 0x8000u) ? 0u : hv; const unsigned cpq = ((h2key(hv) & 15u) << 13) | (8191u - ci); sel = cpq >= lo; }
      int tc; const int pos = base + wave_excl_scan(sel ? 1 : 0, lane, tc); if (sel) idx16[pos] = (unsigned short)ci; base += tc; }
  }
  LDSW();
  return 256;
}

template <int HOT = 0> __device__ __forceinline__ void wave_attend(int b, int t, int cnt, const bf16_t* qlat, const bf16_t* cnb, LAS unsigned char* wl, LAS unsigned short* idx16, bf16_t* olat, int lane) {
  const int n16 = lane & 15, g = lane >> 4, q4 = (lane & 15) >> 2, p4 = lane & 3;
  const bf16_t* qrow = qlat + (size_t)(b * L + t) * 4096 + n16 * 256 + 8 * g;
  bf16x8 qf[8];
#pragma unroll
  for (int s = 0; s < 8; ++s) qf[s] = *(const bf16x8*)(qrow + 32 * s);
  f32x4 o[16];
#pragma unroll
  for (int c = 0; c < 16; ++c) o[c] = (f32x4){0.f, 0.f, 0.f, 0.f};
  float mrun = -INFINITY, lrun = 0.f;
  const int ntile = (cnt + 31) >> 5;
  const char* cb = (const char*)(cnb + (size_t)b * L * 256);
  const unsigned slot = lane & 15, rsub = lane >> 4;
  constexpr float SC = 0.125f * 1.4426950408889634f;
  v4u stg[16];
#define GATHER_TILE(itn) do { _Pragma("unroll") for (int rg = 0; rg < 8; ++rg) { const unsigned row = 4 * rg + rsub; const unsigned key = HOT ? (idx16[32 * (itn) + row] & 255u) : idx16[32 * (itn) + row]; \
      const unsigned ch = slot ^ (((row & 3u) << 2) | ((row >> 2) & 3u)); const unsigned off = key * 512u + ch * 16u;     \
      stg[rg] = *(const v4u*)(cb + off); stg[8 + rg] = *(const v4u*)(cb + off + 256u); } } while (0)
  GATHER_TILE(0);
#pragma unroll 1
  for (int it = 0; it < ntile; ++it) {
#pragma unroll
    for (int rg = 0; rg < 8; ++rg) { *(LAS v4u*)(wl + rg * 1024 + lane * 16) = stg[rg]; *(LAS v4u*)(wl + 8192 + rg * 1024 + lane * 16) = stg[8 + rg]; }
    LDSW();
    if (it + 1 < ntile) GATHER_TILE(it + 1);
    f32x4 s0 = (f32x4){0.f, 0.f, 0.f, 0.f}, s1 = (f32x4){0.f, 0.f, 0.f, 0.f};
    { bf16x8 fa[4];
#define QK_RD(s_, d0, d1) { const unsigned ib = ((s_) >> 2) * 8192, chq = 4 * ((s_) & 3) + g; d0 = *(const LAS bf16x8*)(wl + ib + offb(n16, chq)); d1 = *(const LAS bf16x8*)(wl + ib + offb(16 + n16, chq)); }
#pragma unroll
      for (int s = 0; s < 2; ++s) QK_RD(s, fa[2 * s], fa[2 * s + 1])
      __builtin_amdgcn_sched_barrier(0);
#pragma unroll
      for (int s = 0; s < 8; ++s) {
        s0 = __builtin_amdgcn_mfma_f32_16x16x32_bf16(fa[2 * (s & 1)], qf[s], s0, 0, 0, 0); s1 = __builtin_amdgcn_mfma_f32_16x16x32_bf16(fa[2 * (s & 1) + 1], qf[s], s1, 0, 0, 0);
        if (s < 6) QK_RD(s + 2, fa[2 * (s & 1)], fa[2 * (s & 1) + 1])
        __builtin_amdgcn_sched_barrier(0);
      } }
    const int sl0 = 32 * it + 4 * g;
    float mx = -INFINITY;
#pragma unroll
    for (int r = 0; r < 4; ++r) { s0[r] = (sl0 + r < cnt) ? s0[r] * SC : -INFINITY; s1[r] = (sl0 + 16 + r < cnt) ? s1[r] * SC : -INFINITY; mx = fmaxf(mx, fmaxf(s0[r], s1[r])); }
    { const auto r16 = __builtin_amdgcn_permlane16_swap(__float_as_uint(mx), __float_as_uint(mx), false, false); mx = fmaxf(__uint_as_float(r16[0]), __uint_as_float(r16[1]));
      const auto r32 = __builtin_amdgcn_permlane32_swap(__float_as_uint(mx), __float_as_uint(mx), false, false); mx = fmaxf(__uint_as_float(r32[0]), __uint_as_float(r32[1])); }
    const float mnew = fmaxf(mrun, mx), alpha = __builtin_amdgcn_exp2f(mrun - mnew);
    float ls = 0.f; float pv[8];
#pragma unroll
    for (int r = 0; r < 4; ++r) { pv[r] = __builtin_amdgcn_exp2f(s0[r] - mnew); pv[4 + r] = __builtin_amdgcn_exp2f(s1[r] - mnew); ls += pv[r] + pv[4 + r]; }
    lrun = lrun * alpha + ls; mrun = mnew;
#pragma unroll
    for (int c = 0; c < 16; ++c) o[c] = o[c] * alpha;
    const v4u pbw = (v4u){cvt_pk_bf16(pv[0], pv[1]), cvt_pk_bf16(pv[2], pv[3]), cvt_pk_bf16(pv[4], pv[5]), cvt_pk_bf16(pv[6], pv[7])};
    const bf16x8 pb = __builtin_bit_cast(bf16x8, pbw);
    { v4i16_t ft[4][2];
#define PV_RD(c_, d) { const unsigned ib = ((c_) >> 3) * 8192, chc = 2 * ((c_) & 7) + (p4 >> 1); \
        d[0] = __builtin_amdgcn_ds_read_tr16_b64_v4i16((LAS v4i16_t*)(wl + ib + offb(4 * g + q4, chc) + 8 * (p4 & 1))); \
        d[1] = __builtin_amdgcn_ds_read_tr16_b64_v4i16((LAS v4i16_t*)(wl + ib + offb(16 + 4 * g + q4, chc) + 8 * (p4 & 1))); }
#pragma unroll
      for (int c = 0; c < 4; ++c) PV_RD(c, ft[c])
      __builtin_amdgcn_sched_barrier(0);
#pragma unroll
      for (int c = 0; c < 16; ++c) { const v4i16_t t0 = ft[c & 3][0], t1 = ft[c & 3][1];
        const bf16x8 af = (bf16x8){t0[0], t0[1], t0[2], t0[3], t1[0], t1[1], t1[2], t1[3]};
        o[c] = __builtin_amdgcn_mfma_f32_16x16x32_bf16(af, pb, o[c], 0, 0, 0);
        if (c < 12) PV_RD(c + 4, ft[c & 3])
        __builtin_amdgcn_sched_barrier(0);
      } }
    LDSW();
  }
  lrun += __shfl_xor(lrun, 16); lrun += __shfl_xor(lrun, 32);
  const float inv = 1.f / lrun;
  bf16_t* orow = olat + (size_t)(b * L + t) * 4096 + n16 * 256 + 4 * g;
#pragma unroll
  for (int c = 0; c < 16; ++c) { const f32x4 v = o[c] * inv; *(v2u*)(orow + 16 * c) = (v2u){cvt_pk_bf16(v[0], v[1]), cvt_pk_bf16(v[2], v[3])}; }
}

__device__ __forceinline__ void ph_select_attend(const unsigned short* sc, const bf16_t* qlat, const bf16_t* cnb, bf16_t* olat, LAS unsigned char* lds, const float* w1, const float* w2, bf16_t* W1_t, bf16_t* W2_t, void* scratch_olat = nullptr) {
  const int tid = TIDX(), lane = tid & 63, wave = __builtin_amdgcn_readfirstlane(tid >> 6), blk = BIDX();
  LAS unsigned char* wl = lds + wave * DW_STRIDE; LAS unsigned short* idx16 = (LAS unsigned short*)(wl + 16384);
  LAS unsigned* qctr = (LAS unsigned*)(lds + MISC_OFF + 64);
  if (tid == 0) *qctr = 0u;
  __syncthreads();
  const int b = blk & 1, NGW = (int)gridDim.x * 8; (void)scratch_olat;
#pragma unroll 1
  for (;;) {
    unsigned item = 0u; if (lane == 0) item = __hip_atomic_fetch_add(qctr, 1u, __ATOMIC_RELAXED, __HIP_MEMORY_SCOPE_WORKGROUP);
    item = (unsigned)__builtin_amdgcn_readfirstlane((int)item);
    if (item >= 160u) break;
    const unsigned grp = item / 5u, r = item - grp * 5u;
    if (r == 0u || r == 3u) {
      const unsigned qn = grp * 2u + (r == 3u ? 1u : 0u);
      const int t = (blk >> 1) * 8 + (int)(qn & 7u) + 1024 * (7 - (int)(qn >> 3));
      int lane_s = lane; asm volatile("" : "+v"(lane_s));
#ifdef SELMODE
      { int lane_x = lane; asm volatile("" : "+v"(lane_x)); const int cx = wave_select<SELMODE>(sc + (size_t)(b * L + t) * L, t, wl, idx16, lane_x); if (cx == 12345) olat[0] = 0; }
#endif
      const int cnt = wave_select(sc + (size_t)(b * L + t) * L, t, wl, idx16, lane_s);
      int lane_a = lane; asm volatile("" : "+v"(lane_a));
      wave_attend(b, t, cnt, qlat, cnb, wl, idx16, olat, lane_a);
    } else {
      const unsigned cn = grp * 3u + (r == 1u ? 0u : (r == 2u ? 1u : 2u));
      const int wt = blk * 8 + (int)(cn & 7u) + (int)(cn >> 3) * NGW;
      int lane_t = lane; asm volatile("" : "+v"(lane_t));
      moe_weight_tile(wt < 12288 ? moe_layer_tile(0, wt) : moe_layer_tile(1, wt - 12288), w1, w2, W1_t, W2_t, lane_t);
    }
  }
}

__device__ __forceinline__ void ph_qlat(const bf16_t* pa, const bf16_t* WqT, bf16_t* qlat) {
  const int tid = TIDX(), lane = tid & 63, gw = BIDX() * 8 + (tid >> 6), NGW = (int)gridDim.x * 8;
  const int n16 = lane & 15, g = lane >> 4;
#pragma unroll 1
  for (int it = gw; it < 16 * 512; it += NGW) {
    const int h = it & 15, rt = it >> 4;
    bf16x8 qb[2][2];
#pragma unroll
    for (int mt = 0; mt < 2; ++mt)
#pragma unroll
      for (int ks = 0; ks < 2; ++ks) qb[mt][ks] = *(const bf16x8*)(pa + (size_t)(rt * 32 + mt * 16 + n16) * 2048 + h * 64 + 32 * ks + 8 * g);
    const bf16_t* wp = WqT + (size_t)h * 256 * 64 + (size_t)n16 * 64 + 8 * g;
    bf16_t* op = qlat + (size_t)(rt * 32 + n16) * 4096 + h * 256 + 4 * g;
#pragma unroll 4
    for (int ct = 0; ct < 16; ++ct) {
      const bf16x8 a0 = *(const bf16x8*)(wp + (size_t)(16 * ct) * 64), a1 = *(const bf16x8*)(wp + (size_t)(16 * ct) * 64 + 32);
#pragma unroll
      for (int mt = 0; mt < 2; ++mt) { f32x4 acc = __builtin_amdgcn_mfma_f32_16x16x32_bf16(a0, qb[mt][0], (f32x4){0.f, 0.f, 0.f, 0.f}, 0, 0, 0);
        acc = __builtin_amdgcn_mfma_f32_16x16x32_bf16(a1, qb[mt][1], acc, 0, 0, 0);
        *(v2u*)(op + (size_t)(mt * 16) * 4096 + 16 * ct) = (v2u){cvt_pk_bf16(acc[0], acc[1]), cvt_pk_bf16(acc[2], acc[3])}; }
    }
  }
}
__device__ __forceinline__ void ph_o2(const bf16_t* olat, const bf16_t* WuvT, bf16_t* o2b) {
  const int tid = TIDX(), lane = tid & 63, gw = BIDX() * 8 + (tid >> 6), NGW = (int)gridDim.x * 8;
  const int n16 = lane & 15, g = lane >> 4;
#pragma unroll 1
  for (int it = gw; it < 16 * 512; it += NGW) {
    const int h = it & 15, rt = it >> 4;
    f32x4 acc[4][2];
#pragma unroll
    for (int vt = 0; vt < 4; ++vt) { acc[vt][0] = (f32x4){0.f, 0.f, 0.f, 0.f}; acc[vt][1] = (f32x4){0.f, 0.f, 0.f, 0.f}; }
    const bf16_t* ap = olat + (size_t)(rt * 32 + n16) * 4096 + h * 256 + 8 * g;
    const bf16_t* wp = WuvT + (size_t)h * 64 * 256 + (size_t)n16 * 256 + 8 * g;
#pragma unroll
    for (int ks = 0; ks < 8; ++ks) {
      const bf16x8 b0 = *(const bf16x8*)(ap + 32 * ks), b1 = *(const bf16x8*)(ap + (size_t)16 * 4096 + 32 * ks);
#pragma unroll
      for (int vt = 0; vt < 4; ++vt) { const bf16x8 a = *(const bf16x8*)(wp + (size_t)(16 * vt) * 256 + 32 * ks);
        acc[vt][0] = __builtin_amdgcn_mfma_f32_16x16x32_bf16(a, b0, acc[vt][0], 0, 0, 0); acc[vt][1] = __builtin_amdgcn_mfma_f32_16x16x32_bf16(a, b1, acc[vt][1], 0, 0, 0); }
    }
    bf16_t* op = o2b + (size_t)(rt * 32 + n16) * 1024 + h * 64 + 4 * g;
#pragma unroll
    for (int vt = 0; vt < 4; ++vt)
#pragma unroll
      for (int mt = 0; mt < 2; ++mt) *(v2u*)(op + (size_t)(mt * 16) * 1024 + 16 * vt) = (v2u){cvt_pk_bf16(acc[vt][mt][0], acc[vt][mt][1]), cvt_pk_bf16(acc[vt][mt][2], acc[vt][mt][3])};
  }
}

namespace pg8 {
struct GroupAOrder {
    static constexpr bool GATHER = false; const int* rowmap;
    StaticOrder so; int png; size_t acol_bytes;
    __device__ void init(const void* A, int lda, const void* Bt, int ldb, int M, int N, int png_, size_t acol_bytes_, int G, int c) { so.init(A, lda, Bt, ldb, M, N, G, c); png = png_; acol_bytes = acol_bytes_; }
    __device__ bool next(int i, Unit& u) const { int pm, pn; if (!so.tile(i, pm, pn)) return false; u.pa = so.A + (size_t)pm * so.ta + (size_t)(pn / png) * acol_bytes; u.pb = so.Bt + (size_t)pn * so.tb; u.orow = pm * BM; u.ocol = pn * BM; u.e = 0; u.kind = 0; return true; }
    __device__ __forceinline__ int rowof(const Unit&, int r) const { return r; }
    __device__ __forceinline__ void a_ready(const Unit&) const {}
    __device__ __forceinline__ void done(const Unit&) const {}
};
}
constexpr int GLA_LDSU = 65536;

__device__ __forceinline__ v4i16_t trrd(LAS unsigned char* p) { return __builtin_amdgcn_ds_read_tr16_b64_v4i16((LAS v4i16_t*)p); }
__device__ __forceinline__ bf16x8 cat44(v4i16_t a, v4i16_t b) { return (bf16x8){a[0], a[1], a[2], a[3], b[0], b[1], b[2], b[3]}; }

__device__ __forceinline__ void ph_gla_a1(const bf16_t* pb, const float* gbias, bf16_t* qt, bf16_t* og, bf16_t* kvt, float* dcy, LAS unsigned char* lds, const float* w1, const float* w2, bf16_t* W1_t, bf16_t* W2_t) {
  const int tid = TIDX(), lane = tid & 63, wave = __builtin_amdgcn_readfirstlane(tid >> 6), blk = BIDX();
  const int half = wave >> 2, wq = wave & 3;
  LAS unsigned char* X = lds + half * GLA_LDSU; LAS unsigned char* Y = X + 16384; LAS unsigned char* V = X + 32768;
  LAS float* EX = (LAS float*)(lds + 131072 + half * 2048);
  const unsigned v_addr = (unsigned)__builtin_amdgcn_readfirstlane((int)(unsigned)(size_t)V);
  const int n16 = lane & 15, g = lane >> 4, q4 = (lane & 15) >> 2, p4 = lane & 3;
#pragma unroll 1
  for (int uu = 0; uu < 2; ++uu) {
    const int u = blk * 4 + half * 2 + uu;
    const int h = u & 3, bc = u >> 2, r0 = bc * 64;
    { const unsigned slot = lane & 15, rsub = lane >> 4; const int im = wq;
#pragma unroll
      for (int rg = 0; rg < 8; ++rg) { const unsigned row = 4 * rg + rsub; const unsigned ch = slot ^ (((row & 3u) << 2) | ((row >> 2) & 3u));
        const char* src = (const char*)(pb + (size_t)(r0 + 32 * (im >> 1) + row) * 3584 + 1024 + h * 256 + (im & 1) * 128) + ch * 16;
        glds16(src, v_addr + im * 8192 + rg * 1024); } }
    const int d0 = 2 * lane; const float gb0 = gbias[h * 128 + d0], gb1 = gbias[h * 128 + d0 + 1];
    const unsigned wofs = 16u * ((unsigned)(d0 >> 3)), wsub = (unsigned)(d0 & 7) * 2u;
    unsigned gq[16], qq[16], kq[16]; float bl0[16], bl1[16];
#pragma unroll
    for (int jj = 0; jj < 16; ++jj) { const bf16_t* rp = pb + (size_t)(r0 + wq * 16 + jj) * 3584 + h * 128 + d0;
      gq[jj] = *(const unsigned*)(rp + 3072); qq[jj] = *(const unsigned*)rp; kq[jj] = *(const unsigned*)(rp + 512); }
    float bc0 = 0.f, bc1 = 0.f;
#pragma unroll
    for (int jj = 0; jj < 16; ++jj) { const float a0 = bf_lo(gq[jj]) + gb0, a1 = bf_hi(gq[jj]) + gb1;
      bc0 += (fminf(a0, 0.f) - __logf(1.f + __expf(-fabsf(a0)))) * (1.f / 16.f); bc1 += (fminf(a1, 0.f) - __logf(1.f + __expf(-fabsf(a1)))) * (1.f / 16.f);
      bl0[jj] = bc0; bl1[jj] = bc1; }
    *(LAS f32x2_t*)(EX + wq * 128 + d0) = (f32x2_t){bc0, bc1};
    LDSW(); __syncthreads();
    float of0 = 0.f, of1 = 0.f, tt0 = 0.f, tt1 = 0.f;
#pragma unroll
    for (int w2_ = 0; w2_ < 4; ++w2_) { const f32x2_t e = *(const LAS f32x2_t*)(EX + w2_ * 128 + d0); tt0 += e[0]; tt1 += e[1]; if (w2_ < wq) { of0 += e[0]; of1 += e[1]; } }
#pragma unroll
    for (int jj = 0; jj < 16; ++jj) { const int j = wq * 16 + jj; const float b0 = bl0[jj] + of0, b1 = bl1[jj] + of1;
      const float e0 = __expf(b0), e1 = __expf(b1), i0 = __expf(fminf(-b0, 80.f)), i1 = __expf(fminf(-b1, 80.f));
      const unsigned qo = cvt_pk_bf16(bf_lo(qq[jj]) * 0.08838834764831845f * e0, bf_hi(qq[jj]) * 0.08838834764831845f * e1);
      const unsigned ko = cvt_pk_bf16(bf_lo(kq[jj]) * i0, bf_hi(kq[jj]) * i1);
      *(unsigned*)(qt + (size_t)(r0 + j) * 512 + h * 128 + d0) = qo;
      const unsigned row = (unsigned)(j & 31); const unsigned off = (unsigned)(j >> 5) * 8192u + 256u * row + ((wofs ^ (16u * (((row & 3u) << 2) | ((row >> 2) & 3u))))) + wsub;
      *(LAS unsigned*)(X + off) = qo; *(LAS unsigned*)(Y + off) = ko; }
    if (wq == 3) *(float2*)(dcy + (size_t)u * 128 + d0) = make_float2(__expf(tt0), __expf(tt1));
    asm volatile("s_waitcnt vmcnt(0) lgkmcnt(0)" ::: "memory");
    __syncthreads();
    const int it = wq;
    bf16x8 afr[2];
#pragma unroll
    for (int ks = 0; ks < 2; ++ks) {
      unsigned pk[4] = {0u, 0u, 0u, 0u};
#pragma unroll
      for (int jh = 0; jh < 2; ++jh) { const int jt = 2 * ks + jh;
        if (jt <= it) { f32x4 acc = (f32x4){0.f, 0.f, 0.f, 0.f};
#pragma unroll
          for (int s = 0; s < 4; ++s) { const bf16x8 ya = *(const LAS bf16x8*)(Y + (jt >> 1) * 8192 + offb(n16 + 16 * (jt & 1), 4 * s + g)), xb = *(const LAS bf16x8*)(X + (it >> 1) * 8192 + offb(n16 + 16 * (it & 1), 4 * s + g));
            acc = __builtin_amdgcn_mfma_f32_16x16x32_bf16(ya, xb, acc, 0, 0, 0); }
          const int i_ = 16 * it + n16, jbase = 16 * jt + 4 * g;
#pragma unroll
          for (int r = 0; r < 4; ++r) if (jbase + r > i_) acc[r] = 0.f;
          pk[2 * jh] = cvt_pk_bf16(acc[0], acc[1]); pk[2 * jh + 1] = cvt_pk_bf16(acc[2], acc[3]); } }
      afr[ks] = __builtin_bit_cast(bf16x8, (v4u){pk[0], pk[1], pk[2], pk[3]});
    }
    bf16_t* ogp = og + (size_t)u * 16384 + (size_t)(it * 16) * 256 + lane * 4; bf16_t* kvp = kvt + (size_t)u * 32768 + (size_t)n16 * 128 + 4 * g;
#pragma unroll 2
    for (int nt = 0; nt < 16; ++nt) {
      const unsigned vimg = (unsigned)(nt >> 3) * 8192u, chv = 2u * (unsigned)(nt & 7) + (unsigned)(p4 >> 1), sub = 8u * (unsigned)(p4 & 1);
      f32x4 acc = (f32x4){0.f, 0.f, 0.f, 0.f};
      { LAS unsigned char* vb = V + vimg; const bf16x8 bi0 = cat44(trrd(vb + offb(4 * g + q4, chv) + sub), trrd(vb + offb(16 + 4 * g + q4, chv) + sub));
        acc = __builtin_amdgcn_mfma_f32_16x16x32_bf16(afr[0], bi0, acc, 0, 0, 0); }
      if (it >= 2) { LAS unsigned char* vb = V + 16384 + vimg; const bf16x8 bi1 = cat44(trrd(vb + offb(4 * g + q4, chv) + sub), trrd(vb + offb(16 + 4 * g + q4, chv) + sub));
        acc = __builtin_amdgcn_mfma_f32_16x16x32_bf16(afr[1], bi1, acc, 0, 0, 0); }
      *(v2u*)(ogp + (size_t)nt * 256) = (v2u){cvt_pk_bf16(acc[0], acc[1]), cvt_pk_bf16(acc[2], acc[3])};
    }
#pragma unroll 1
    for (int nq = 0; nq < 4; ++nq) { const int nt = 4 * wq + nq;
      const unsigned vimg = (unsigned)(nt >> 3) * 8192u, chv = 2u * (unsigned)(nt & 7) + (unsigned)(p4 >> 1), sub = 8u * (unsigned)(p4 & 1);
      bf16x8 bn[2];
#pragma unroll
      for (int ks = 0; ks < 2; ++ks) { LAS unsigned char* vb = V + ks * 16384 + vimg; bn[ks] = cat44(trrd(vb + offb(8 * g + q4, chv) + sub), trrd(vb + offb(8 * g + 4 + q4, chv) + sub)); }
#pragma unroll
      for (int mt = 0; mt < 8; ++mt) { const unsigned chy = 2u * (unsigned)mt + (unsigned)(p4 >> 1);
        const bf16x8 a0 = cat44(trrd(Y + offb(8 * g + q4, chy) + sub), trrd(Y + offb(8 * g + 4 + q4, chy) + sub));
        const bf16x8 a1 = cat44(trrd(Y + 8192 + offb(8 * g + q4, chy) + sub), trrd(Y + 8192 + offb(8 * g + 4 + q4, chy) + sub));
        f32x4 acc = __builtin_amdgcn_mfma_f32_16x16x32_bf16(a0, bn[0], (f32x4){0.f, 0.f, 0.f, 0.f}, 0, 0, 0);
        acc = __builtin_amdgcn_mfma_f32_16x16x32_bf16(a1, bn[1], acc, 0, 0, 0);
        *(v2u*)(kvp + (size_t)(16 * nt) * 128 + 16 * mt) = (v2u){cvt_pk_bf16(acc[0], acc[1]), cvt_pk_bf16(acc[2], acc[3])}; }
    }
    LDSW(); __syncthreads();
  }
}

__device__ __forceinline__ void ph_gla_a2(const bf16_t* kvt, const float* dcy, bf16_t* spt) {
  const int gtid = BIDX() * NTHR + TIDX();
  if (gtid >= 8 * 256 * 32) return;
  const int g4 = gtid & 31, dv = (gtid >> 5) & 255, bh = gtid >> 13, b = bh >> 2, h = bh & 3;
  f32x4 S = (f32x4){0.f, 0.f, 0.f, 0.f};
#pragma unroll 16
  for (int c = 0; c < 128; ++c) { const size_t u = (size_t)((b * 128 + c) * 4 + h);
    const v2u kvb = *(const v2u*)(kvt + u * 32768 + (size_t)dv * 128 + 4 * g4); const f32x4 kv = (f32x4){bf_lo(kvb[0]), bf_hi(kvb[0]), bf_lo(kvb[1]), bf_hi(kvb[1])}, dc = *(const f32x4*)(dcy + u * 128 + 4 * g4);
    *(v2u*)(spt + u * 32768 + (size_t)dv * 128 + 4 * g4) = (v2u){cvt_pk_bf16(S[0], S[1]), cvt_pk_bf16(S[2], S[3])};
    S = dc * (S + kv); }
}

constexpr int A3_LD = 272;
__device__ __forceinline__ void ph_gla_a3(const bf16_t* pb, const bf16_t* qt, const bf16_t* og, const bf16_t* spt, const float* ng, bf16_t* ob, LAS unsigned char* lds) {
  const int tid = TIDX(), lane = tid & 63, wave = __builtin_amdgcn_readfirstlane(tid >> 6), gw = BIDX() * 8 + wave, NGW = (int)gridDim.x * 8;
  const int n16 = lane & 15, g = lane >> 4, row16 = lane >> 2, cq = lane & 3;
  LAS float* T = (LAS float*)(lds + wave * (16 * A3_LD * 4));
#pragma unroll 1
  for (int w = gw; w < 4096; w += NGW) {
    const int u = w >> 2, it = w & 3, h = u & 3, r0 = (u >> 2) * 64;
    const bf16_t* sp = spt + (size_t)u * 32768 + (size_t)n16 * 128 + 8 * g;
    bf16x8 qa[4];
#pragma unroll
    for (int ks = 0; ks < 4; ++ks) qa[ks] = *(const bf16x8*)(qt + (size_t)(r0 + 16 * it + n16) * 512 + h * 128 + 32 * ks + 8 * g);
    const bf16_t* ogp = og + (size_t)u * 16384 + (size_t)(it * 16) * 256 + lane * 4;
#pragma unroll
    for (int nt = 0; nt < 16; ++nt) {
      const v2u ogb = *(const v2u*)(ogp + nt * 256); f32x4 acc = (f32x4){bf_lo(ogb[0]), bf_hi(ogb[0]), bf_lo(ogb[1]), bf_hi(ogb[1])};
#pragma unroll
      for (int ks = 0; ks < 4; ++ks) { const bf16x8 sb = *(const bf16x8*)(sp + (size_t)(16 * nt) * 128 + 32 * ks); acc = __builtin_amdgcn_mfma_f32_16x16x32_bf16(qa[ks], sb, acc, 0, 0, 0); }
#pragma unroll
      for (int r = 0; r < 4; ++r) T[(4 * g + r) * A3_LD + 16 * nt + n16] = acc[r];
    }
    LDSW();
    const size_t row = (size_t)(r0 + 16 * it + row16);
    f32x4 v[16]; float ss = 0.f;
#pragma unroll
    for (int k = 0; k < 16; ++k) { v[k] = *(const LAS f32x4*)(T + row16 * A3_LD + 16 * k + 4 * cq); ss += (v[k][0] * v[k][0] + v[k][1] * v[k][1]) + (v[k][2] * v[k][2] + v[k][3] * v[k][3]); }
    ss += __shfl_xor(ss, 1); ss += __shfl_xor(ss, 2);
    const float rs = rsqrtf(ss * (1.f / 256.f) + 1e-6f);
#pragma unroll
    for (int k = 0; k < 16; ++k) { const int col = h * 256 + 16 * k + 4 * cq; const v2u rg = *(const v2u*)(pb + row * 3584 + 2048 + col); const f32x4 gn = *(const f32x4*)(ng + col);
      const float rr[4] = {bf_lo(rg[0]), bf_hi(rg[0]), bf_lo(rg[1]), bf_hi(rg[1])}; float o[4];
#pragma unroll
      for (int z = 0; z < 4; ++z) o[z] = v[k][z] * rs * gn[z] * (rr[z] * __builtin_amdgcn_rcpf(1.f + __expf(-rr[z])));
      *(v2u*)(ob + row * 1024 + col) = (v2u){cvt_pk_bf16(o[0], o[1]), cvt_pk_bf16(o[2], o[3])}; }
    LDSW();
  }
}
#ifndef PROBE
#define PROBE 0
#endif
#ifndef PROBE_S
#define PROBE_S 10.0f
#endif
constexpr size_t MiB = 1u << 20;
constexpr size_t WS_CTL = 0, CTL_ZERO_BYTES = 1 * MiB;
constexpr int CW_BAR = 4096, CW_TMO = 64, CW_RDY = 65536, CW_ISC = 1024;
constexpr size_t WS_NEEDED = 2048 * MiB;

struct Args { In in; float* out; unsigned char* ws; };

struct Opt { bf16_t *qt, *spt, *og, *kvt; float *dcy; bf16_t *Wql_t, *Wuv_t, *cnb, *kib, *qlat, *olat; unsigned short* sc; bf16_t *xb, *WA_t, *WoutA_t, *WB_t, *WoutB_t, *W1_t, *W2_t, *projA_b, *hbf, *o2b, *xs, *act, *Ys, *projB_b; MoeBufs m; };
__device__ __forceinline__ nvp::Ws carve_ws(unsigned char* ws) {
  nvp::Ws w; auto at = [&](size_t mib) { return (char*)ws + mib * MiB; };
  w.projA = (float*)at(2); w.cn = (float*)at(119); w.sc = (float*)at(135); w.idx = (int*)at(647); w.o2 = (float*)at(663);
  w.x1 = (float*)at(727); w.x2 = (float*)at(791);
  w.projB = (float*)at(135); w.adec = (float*)at(135 + 194); w.og = (float*)at(135 + 194 + 32); w.on = (float*)at(135 + 194 + 32 + 64);
  w.counts = nullptr; w.h = nullptr; w.hb = nullptr; w.ys = nullptr; w.tok_e = nullptr; w.tok_g = nullptr; w.slot_of = nullptr; w.row_tok = nullptr; w.row_gate = nullptr; w.blk_e = nullptr;
  return w;
}
__device__ __forceinline__ Opt carve_opt(unsigned char* ws) {
  Opt o; auto at = [&](size_t mib) { return (bf16_t*)((char*)ws + mib * MiB); };
  char* sm = (char*)ws + 855 * MiB;
  o.m.tok_e = (int*)sm; o.m.tok_g = (float*)(sm + 256 * 1024); o.m.slot_of = (int*)(sm + 512 * 1024); o.m.slot_gate = (float*)(sm + 768 * 1024); o.m.blk_e = (int*)(sm + 1088 * 1024); o.m.blkcnt = (int*)(sm + 1096 * 1024); o.m.nblk = (int*)(sm + 1160 * 1024); o.m.slot_tok = (int*)(sm + 1200 * 1024);
  o.WA_t = at(860); o.WoutA_t = at(864); o.WB_t = at(866); o.WoutB_t = at(873);
  o.Wql_t = at(875); o.Wuv_t = at(877); o.olat = at(2); o.cnb = at(647); o.kib = at(656); o.qlat = at(1856); o.sc = (unsigned short*)at(135);
  o.qt = at(135); o.dcy = (float*)at(151); o.og = at(152); o.kvt = at(216); o.spt = at(344);
  o.W1_t = at(880); o.W2_t = at(1136);
  o.xb = at(1264); o.projA_b = at(1296); o.hbf = at(1360); o.o2b = at(1392);
  o.xs = at(1424); o.act = at(1568); o.Ys = at(1712); o.projB_b = at(1856);
  return o;
}

struct ProIn { const float *a_w_uk, *a_w_uv, *x, *a_w_in, *a_w_out, *b_w_in, *b_w_g2, *b_w_out, *m_w1, *m_w2; };
__device__ __forceinline__ void ph_prologue(const ProIn I, const Opt& o) {
  const int tid = TIDX(), lane = tid & 63, gw = BIDX() * 8 + (tid >> 6), NGW = (int)gridDim.x * 8, gtid = BIDX() * NTHR + tid, NGT = (int)gridDim.x * NTHR;
  cvt_f32_to_bf16(I.x, D, o.xb, D, NT, D, gtid, NGT);
  zero_rect(o.WA_t, D, DINA, 2048 - DINA, 0, D * 2, gtid, NGT);
  for (int i = gtid; i < 512 * 256; i += NGT) { const int n = i >> 8, k4 = (i & 255) * 4; float a[4];
#pragma unroll
    for (int z = 0; z < 4; ++z) { const float* gl = I.b_w_in + (size_t)(k4 + z) * DINB + 2048; float s = 0.f;
#pragma unroll
      for (int j = 0; j < 16; ++j) s = fmaf(gl[j], I.b_w_g2[j * 512 + n], s);
      a[z] = s; }
    *(v2u*)(o.WB_t + (size_t)(3072 + n) * D + k4) = (v2u){cvt_pk_bf16(a[0], a[1]), cvt_pk_bf16(a[2], a[3])}; }
  int w0 = 0;
#pragma unroll 1
  for (int h = 0; h < 16; ++h) {
    transpose_job(mk_tjob(I.a_w_uk + (size_t)h * 64 * 256, 256, 64, 256, o.Wql_t, 256, h * 256, (h & 3) * 64, 0), w0, gw, NGW, lane);
    transpose_job(mk_tjob(I.a_w_uv + (size_t)h * 256 * 64, 64, 256, 64, o.Wuv_t, 1024, h * 64, (h & 3) * 256, 0), w0, gw, NGW, lane);
    for (int hp = 0; hp < 4; ++hp) if (hp != (h & 3)) { zero_rect(o.Wql_t, 256, h * 256, 256, hp * 128, 128, gtid, NGT); zero_rect(o.Wuv_t, 1024, h * 64, 64, hp * 512, 512, gtid, NGT); }
  }
  transpose_job(mk_tjob(I.a_w_in, DINA, D, DINA, o.WA_t, D, 0, 0, 0), w0, gw, NGW, lane);
  transpose_job(mk_tjob(I.a_w_out, D, D, D, o.WoutA_t, D, 0, 0, 0), w0, gw, NGW, lane);
  transpose_job(mk_tjob(I.b_w_in, DINB, D, 2048, o.WB_t, D, 0, 0, 0), w0, gw, NGW, lane);
  transpose_job(mk_tjob(I.b_w_in + 2064, DINB, D, 1024, o.WB_t, D, 2048, 0, 0), w0, gw, NGW, lane);
  transpose_job(mk_tjob(I.b_w_out, D, D, D, o.WoutB_t, D, 0, 0, 0), w0, gw, NGW, lane);
}
__device__ __forceinline__ void ph_gla_shim(const bf16_t* pb, const float* gbias, float* projB, float* adec) {
  const int gtid = BIDX() * NTHR + TIDX(), NGT = (int)gridDim.x * NTHR;
  for (size_t i = gtid; i < (size_t)NT * 896; i += NGT) { const size_t r = i / 896; const int c = (int)(i % 896) * 4; const v2u v = *(const v2u*)(pb + r * 3584 + c);
    const f32x4 f = (f32x4){bf_lo(v[0]), bf_hi(v[0]), bf_lo(v[1]), bf_hi(v[1])};
    if (c < 2048) *(f32x4*)(projB + r * DINB + c) = f;
    else if (c < 3072) *(f32x4*)(projB + r * DINB + 2064 + (c - 2048)) = f;
    else { f32x4 o;
#pragma unroll
      for (int z = 0; z < 4; ++z) { const float a = f[z] + gbias[c - 3072 + z]; const float ls = fminf(a, 0.f) - log1pf(expf(-fabsf(a))); o[z] = expf(ls * (1.f / 16.f)); }
      *(f32x4*)(adec + r * 512 + (c - 3072)) = o; } }
}

#if PROBE == 3
#define GLA_PHASES \
      PH_BEGIN ph_gla_shim(o.projB_b, I.b_g_bias, w.projB, w.adec); PH_END \
      GRID_BAR(); \
      PH_BEGIN nvp::np_gla_scan(w.projB, w.adec, w.og, fl); PH_END \
      GRID_BAR(); \
      PH_BEGIN nvp::np_gla_norm(w.og, w.projB, I.b_norm, w.on); PH_END \
      GRID_BAR(); \
      PH_BEGIN cvt_f32_to_bf16(w.on, D, o.o2b, D, NT, D, gtid_, NGT_); PH_END \
      GRID_BAR(); \
      PH_BEGIN ph_gla_a1(o.projB_b, I.b_g_bias, (bf16_t*)(wsb_ + 489 * MiB), (bf16_t*)(wsb_ + 506 * MiB), (bf16_t*)(wsb_ + 880 * MiB), (float*)(wsb_ + 505 * MiB), ll, I.m_w1, I.m_w2, o.W1_t, o.W2_t); PH_END \
      GRID_BAR(); \
      PH_BEGIN ph_gla_a2((bf16_t*)(wsb_ + 880 * MiB), (float*)(wsb_ + 505 * MiB), (bf16_t*)(wsb_ + 1136 * MiB)); PH_END \
      GRID_BAR(); \
      PH_BEGIN ph_gla_a3(o.projB_b, (bf16_t*)(wsb_ + 489 * MiB), (bf16_t*)(wsb_ + 506 * MiB), (bf16_t*)(wsb_ + 1136 * MiB), I.b_norm, (bf16_t*)(wsb_ + 570 * MiB), ll); PH_END \
      GRID_BAR(); \
      PH_BEGIN { unsigned* fl_ = (unsigned*)(wsb_ + 512 * 1024); unsigned bits = 0u; \
        { const bf16_t* a = (const bf16_t*)(wsb_ + 489 * MiB); for (size_t i = gtid_; i < (size_t)NT * 512; i += NGT_) { const float v = bf2f(a[i]); if (!(fabsf(v) < 1e30f)) bits |= 1u; } } \
        { const float* a = (const float*)(wsb_ + 506 * MiB); for (size_t i = gtid_; i < (size_t)NT * 1024; i += NGT_) { const float v = a[i]; if (!(fabsf(v) < 1e30f)) bits |= 2u; } } \
        { const float* a = (const float*)(wsb_ + 880 * MiB); for (size_t i = gtid_; i < (size_t)1024 * 32768; i += NGT_) { const float v = a[i]; if (!(fabsf(v) < 1e30f)) bits |= 4u; } } \
        { const bf16_t* a = (const bf16_t*)(wsb_ + 1136 * MiB); for (size_t i = gtid_; i < (size_t)1024 * 32768; i += NGT_) { const float v = bf2f(a[i]); if (!(fabsf(v) < 1e30f)) bits |= 8u; } } \
        { const bf16_t* a = (const bf16_t*)(wsb_ + 570 * MiB); for (size_t i = gtid_; i < (size_t)NT * 1024; i += NGT_) { const float v = bf2f(a[i]); if (!(fabsf(v) < 1e30f)) bits |= 16u; } } \
        { const float* a = (const float*)(wsb_ + 505 * MiB); for (size_t i = gtid_; i < (size_t)1024 * 128; i += NGT_) { const float v = a[i]; if (!(fabsf(v) < 1e30f)) bits |= 32u; } } \
        if (bits) atomicOr(fl_, bits); \
        { float* pd = (float*)(wsb_ + 1968 * MiB); const bf16_t* ob = (const bf16_t*)(wsb_ + 570 * MiB); for (size_t i = gtid_; i < (size_t)NT * D; i += NGT_) pd[i] = bf2f(ob[i]) - w.on[i]; } } PH_END \
      GRID_BAR();
#else
#define GLA_PHASES \
      PH_BEGIN ph_gla_a1(o.projB_b, I.b_g_bias, o.qt, o.og, o.kvt, o.dcy, ll, I.m_w1, I.m_w2, o.W1_t, o.W2_t); PH_END \
      GRID_BAR(); \
      PH_BEGIN ph_gla_a2(o.kvt, o.dcy, o.spt); PH_END \
      GRID_BAR(); \
      PH_BEGIN ph_gla_a3(o.projB_b, o.qt, o.og, o.spt, I.b_norm, o.o2b, ll); PH_END \
      GRID_BAR();
#endif
#if defined(FUSE_ON)
#define MOE_GEMM_PHASES(li) \
    PH_BEGIN pg8::MoeFusedOrder S; S.init(o.xs, o.act, o.W1_t + (size_t)li * 32 * 2048 * D, o.W2_t + (size_t)li * 32 * D * D, o.m.slot_tok, o.m.blk_e, (unsigned*)(wsb_ + WS_CTL) + CW_RDY + li * 32768, (unsigned*)(wsb_ + WS_CTL) + CW_TMO, __builtin_amdgcn_readfirstlane(*o.m.nblk), G_, BIDX()); S.mode = 0; \
      gemm_phase<pg8::EpiMoeFused, pg8::MoeFusedOrder, true, true>(ll, Gemm{D, D, D}, S, pg8::EpiMoeFused{o.act, I.m_b1 + (size_t)li * 32 * 2048, o.Ys, I.m_b2 + (size_t)li * 32 * D, o.m.slot_gate}); PH_END \
    GRID_BAR();
#else
#define MOE_GEMM_PHASES(li) \
    PH_BEGIN pg8::MoeOrderG S; S.init(o.xs, D, o.W1_t + (size_t)li * 32 * 2048 * D, D, (size_t)2048 * D * 2, __builtin_amdgcn_readfirstlane(*o.m.nblk), 8, 128, o.m.blk_e, G_, BIDX()); S.rowmap = o.m.slot_tok; \
      gemm_phase<pg8::EpiSwiglu, pg8::MoeOrderG, true, true>(ll, Gemm{D, D, D}, S, pg8::EpiSwiglu{o.act, D, I.m_b1 + (size_t)li * 32 * 2048}); PH_END \
    GRID_BAR(); \
    PH_BEGIN MoeOrder S; S.init(o.act, D, o.W2_t + (size_t)li * 32 * D * D, D, (size_t)D * D * 2, __builtin_amdgcn_readfirstlane(*o.m.nblk), 4, 256, o.m.blk_e, G_, BIDX()); \
      gemm_phase<pg8::EpiMoe2, MoeOrder, true, true>(ll, Gemm{D, D, D}, S, pg8::EpiMoe2{o.Ys, D, I.m_b2 + (size_t)li * 32 * D, o.m.slot_gate}); PH_END \
    GRID_BAR();
#endif
#ifdef LNR_MODE
#define LNR_EXTRA(li) PH_BEGIN if (li == 0) ph_ln_router<false, LNR_MODE>(I.x, o.hbf, I.ln1_g + li * D, I.ln1_b + li * D, I.m_w_router + (size_t)li * D * 32, I.m_b_router + li * 32, o.xs, o.m, fl); else ph_ln_router<true, LNR_MODE>(o.xb, o.hbf, I.ln1_g + li * D, I.ln1_b + li * D, I.m_w_router + (size_t)li * D * 32, I.m_b_router + li * 32, o.xs, o.m, fl); PH_END GRID_BAR();
#else
#define LNR_EXTRA(li)
#endif
#define LAYER_BODY(li) \
    if (li == 1) { \
      PH_BEGIN StaticOrder S; S.init(o.xb, D, o.WB_t, D, NT, 3584, G_, BIDX()); gemm_phase<EpiStore, StaticOrder, true, true>(ll, Gemm{D, D, D}, S, EpiStore{o.projB_b, 3584}); PH_END \
      GRID_BAR(); \
      GLA_PHASES \
      PH_BEGIN StaticOrder S; S.init(o.o2b, D, o.WoutB_t, D, NT, D, G_, BIDX()); gemm_phase<EpiStore, StaticOrder, true, true>(ll, Gemm{D, D, D}, S, EpiStore{o.hbf, D}); PH_END \
      GRID_BAR(); \
    } \
LNR_EXTRA(li) \
    PH_BEGIN if (li == 0) ph_ln_router<false>(I.x, o.hbf, I.ln1_g + li * D, I.ln1_b + li * D, I.m_w_router + (size_t)li * D * 32, I.m_b_router + li * 32, o.xs, o.m, fl); else ph_ln_router<true>(o.xb, o.hbf, I.ln1_g + li * D, I.ln1_b + li * D, I.m_w_router + (size_t)li * D * 32, I.m_b_router + li * 32, o.xs, o.m, fl); PH_END \
    GRID_BAR(); \
    PH_BEGIN ph_moe_scatter(o.m, (int*)lds); PH_END \
    GRID_BAR(); \
MOE_GEMM_PHASES(li) \
    PH_BEGIN ph_combine_ln(o.xs, o.Ys, o.m.slot_of, I.ln2_g + li * D, I.ln2_b + li * D, li == 0 ? nullptr : out_, li == 0 ? o.xb : nullptr); PH_END \
    if (li == 0) GRID_BAR();
__global__ void __launch_bounds__(NTHR, 2) mk_fwd(Args args) {
  extern __shared__ __attribute__((aligned(16))) unsigned char lds[];
  volatile LAS unsigned* MISC = (volatile LAS unsigned*)((LAS unsigned char*)lds + MISC_OFF);
  if (threadIdx.x < 32) MISC[threadIdx.x] = 0u;
  __syncthreads();
  XcdBarrier bar; { const __attribute__((address_space(4))) Args* ka0 = (const __attribute__((address_space(4))) Args*)__builtin_amdgcn_kernarg_segment_ptr(); bar = xcd_barrier_post((unsigned*)(ka0->ws + WS_CTL) + CW_BAR, MISC + 8); }
#define GRID_BAR() xcd_barrier(bar)
#define PH_BEGIN { const __attribute__((address_space(4))) Args* ka_ = (const __attribute__((address_space(4))) Args*)__builtin_amdgcn_kernarg_segment_ptr(); asm volatile("" : "+s"(ka_)); \
    float* const out_ = ka_->out; (void)out_; unsigned char* wsb_ = ka_->ws; const nvp::Ws w = carve_ws(wsb_); (void)w; const Opt o = carve_opt(wsb_); (void)o; \
    const int gtid_ = BIDX() * NTHR + TIDX(), NGT_ = (int)gridDim.x * NTHR; (void)gtid_; (void)NGT_; const int G_ = (int)gridDim.x; (void)G_;
#define PH_END }
#define I (ka_->in)
  float* fl = (float*)lds; LAS unsigned char* ll = (LAS unsigned char*)lds;
  using pg8::gemm_phase; using pg8::StaticOrder; using pg8::MoeOrder; using pg8::Gemm; using pg8::EpiStore;
  PH_BEGIN ph_prologue(ProIn{I.a_w_uk, I.a_w_uv, I.x, I.a_w_in, I.a_w_out, I.b_w_in, I.b_w_g2, I.b_w_out, I.m_w1, I.m_w2}, o); PH_END
  GRID_BAR();
  PH_BEGIN StaticOrder S; S.init(o.xb, D, o.WA_t, D, NT, 2048, G_, BIDX()); gemm_phase<pg8::EpiStoreKi, StaticOrder, true, true>(ll, Gemm{D, D, D}, S, pg8::EpiStoreKi{o.projA_b, 2048, o.kib, 1792}); PH_END
  GRID_BAR();
  PH_BEGIN ph_cnorm_b(o.projA_b, I.a_kv_norm, o.cnb); PH_END
  PH_BEGIN pg8::GroupAOrder S; S.init(o.projA_b, 2048, o.Wql_t, 256, NT, 4096, 4, 512, G_, BIDX()); gemm_phase<EpiStore, pg8::GroupAOrder, true, true>(ll, Gemm{2048, 256, 256}, S, EpiStore{o.qlat, 4096}); PH_END
#ifdef ISC_HOT
  PH_BEGIN ph_iscore<ISC_HOT>(o.projA_b, o.kib, (unsigned short*)o.act, (unsigned*)(wsb_ + WS_CTL) + CW_ISC + 64, ll); PH_END
  GRID_BAR();
#endif
  PH_BEGIN ph_iscore(o.projA_b, o.kib, o.sc, (unsigned*)(wsb_ + WS_CTL) + CW_ISC, ll); PH_END
  GRID_BAR();
  PH_BEGIN ph_select_attend(o.sc, o.qlat, o.cnb, o.olat, ll, I.m_w1, I.m_w2, o.W1_t, o.W2_t, o.act); PH_END
  GRID_BAR();
  PH_BEGIN pg8::GroupAOrder S; S.init(o.olat, 4096, o.Wuv_t, 1024, NT, 1024, 1, 2048, G_, BIDX()); gemm_phase<EpiStore, pg8::GroupAOrder, true, true>(ll, Gemm{4096, 1024, 1024}, S, EpiStore{o.o2b, D}); PH_END
  GRID_BAR();
#if PROBE == 2
  PH_BEGIN cvt_bf16_to_f32(o.projA_b, 2048, w.projA, DINA, NT, DINA, gtid_, NGT_); PH_END
  GRID_BAR();
  PH_BEGIN nvp::np_cnorm(w.projA, I.a_kv_norm, w.cn); PH_END
  PH_BEGIN nvp::np_iscore(w.projA, w.sc, fl); PH_END
  GRID_BAR();
  PH_BEGIN nvp::np_topk(w.sc, w.idx, (char*)lds); PH_END
  GRID_BAR();
  PH_BEGIN nvp::np_dsa_attn(w.projA, w.cn, w.idx, I.a_w_uk, I.a_w_uv, w.o2, fl); PH_END
  GRID_BAR();
  PH_BEGIN { float* pd = (float*)(wsb_ + 1968 * MiB); for (size_t i = gtid_; i < (size_t)NT * D; i += NGT_) pd[i] = bf2f(o.o2b[i]) - w.o2[i]; } PH_END
  GRID_BAR();
#endif
  PH_BEGIN StaticOrder S; S.init(o.o2b, D, o.WoutA_t, D, NT, D, G_, BIDX()); gemm_phase<EpiStore, StaticOrder, true, true>(ll, Gemm{D, D, D}, S, EpiStore{o.hbf, D}); PH_END
  GRID_BAR();
  { LAYER_BODY(0) }
  { LAYER_BODY(1) }
#if PROBE == 2 || PROBE == 3
  GRID_BAR();
#if PROBE == 3
  PH_BEGIN { if (gtid_ == 0) { const unsigned fb = *(const unsigned*)(wsb_ + 512 * 1024); out_[5] += (float)fb; } const float* pd = (const float*)(wsb_ + 1968 * MiB); for (size_t i = gtid_; i < (size_t)NT * D; i += NGT_) out_[i] += PROBE_S * pd[i]; } PH_END
#else
  PH_BEGIN { const float* pd = (const float*)(wsb_ + 1968 * MiB); for (size_t i = gtid_; i < (size_t)NT * D; i += NGT_) out_[i] += PROBE_S * pd[i]; } PH_END
#endif
#endif
}

extern "C" void kernel_launch(void* const* d_in, const int* in_sizes, int n_in, void* d_out, int out_size, void* d_ws, size_t ws_size, hipStream_t stream) {
  static int grid = 0;
  if (grid == 0) {
    if (n_in != 21 || ws_size < WS_NEEDED) { fprintf(stderr, "kernel_launch: bad inputs (n_in %d) or workspace too small (%zu needed, %zu given)\n", n_in, (size_t)WS_NEEDED, ws_size); grid = -1; return; }
    int dev = 0, cus = 0, per_cu = 0;
    if (hipGetDevice(&dev) != hipSuccess || hipDeviceGetAttribute(&cus, hipDeviceAttributeMultiprocessorCount, dev) != hipSuccess) { grid = -1; return; }
    if (hipFuncSetAttribute((const void*)mk_fwd, hipFuncAttributeMaxDynamicSharedMemorySize, LDS_BYTES) != hipSuccess) { fprintf(stderr, "kernel_launch: hipFuncSetAttribute failed\n"); grid = -1; return; }
    if (hipOccupancyMaxActiveBlocksPerMultiprocessor(&per_cu, (const void*)mk_fwd, NTHR, LDS_BYTES) != hipSuccess || per_cu < 1) fprintf(stderr, "kernel_launch: note: occupancy query reports %d\n", per_cu);
    (void)hipGetLastError();
    grid = cus;
    if (grid != 256) fprintf(stderr, "kernel_launch: built for 256 CUs (token ownership per workgroup); got %d\n", grid);
  }
  if (grid < 0) return;
  if (hipMemsetAsync((char*)d_ws + WS_CTL, 0, CTL_ZERO_BYTES, stream) != hipSuccess) { fprintf(stderr, "kernel_launch: memset failed\n"); return; }
  Args a; memset(&a, 0, sizeof(a));
  const float** f = (const float**)&a.in;
  for (int i = 0; i < 21; ++i) f[i] = (const float*)d_in[i];
  a.out = (float*)d_out; a.ws = (unsigned char*)d_ws;
  hipLaunchKernelGGL(mk_fwd, dim3(grid), dim3(NTHR), LDS_BYTES, stream, a);
  const hipError_t le = hipPeekAtLastError();
  if (le != hipSuccess) fprintf(stderr, "kernel_launch: launch failed: %s\n", hipGetErrorName(le));
}
```

```cpp
#include <hip/hip_runtime.h>
#include <cstdio>
#include <cstdint>
#include <cstring>

#define GAS __attribute__((address_space(1)))
#define LAS __attribute__((address_space(3)))
#define NTHR 512
constexpr int LDS_BYTES = 147456;
constexpr int MISC_OFF = 131072 + 8192;

#define XB_TMO      128
#define XB_XCNT(j)  (256  + 64 * (j))
#define XB_XSUB(j)  (1280 + 64 * (j))
#define XB_XGEN(j)  (2304 + 64 * (j))
#define XB_TOP      3328
#define XB_TOPGEN   3392
#define XCD_BAR_WORDS 3456
#define XB_SPIN_CAP (1u << 25)
__device__ __forceinline__ unsigned xb_ld(unsigned* p)              { return __hip_atomic_load(p, __ATOMIC_RELAXED, __HIP_MEMORY_SCOPE_AGENT); }
__device__ __forceinline__ unsigned xb_add(unsigned* p, unsigned v) { return __hip_atomic_fetch_add(p, v, __ATOMIC_RELAXED, __HIP_MEMORY_SCOPE_AGENT); }
__device__ __forceinline__ unsigned xb_xcc_id() { return (unsigned)__builtin_amdgcn_s_getreg((3 << 11) | 20) & 0xFu; }
#define XB_SPIN(cond, bar) do { unsigned _sp = 0; while (cond) { __builtin_amdgcn_s_sleep(1); \
    if ((++_sp & 255u) == 0u) { if (xb_ld(&(bar)[XB_TMO])) break; if (_sp > XB_SPIN_CAP) { atomicAdd(&(bar)[XB_TMO], 1u); break; } } } } while (0)
struct XcdBarrier { unsigned* bar; unsigned x; volatile LAS unsigned* st; };
__device__ __forceinline__ XcdBarrier xcd_barrier_post(unsigned* bar, volatile LAS unsigned* st) {
    XcdBarrier b; b.bar = bar; b.x = xb_xcc_id(); b.st = st;
    if (threadIdx.x == 0) (void)xb_add(&bar[XB_XCNT(b.x)], 1u);
    return b;
}
__device__ __forceinline__ void xcd_barrier_complete(unsigned* bar, unsigned x, unsigned& nloc, unsigned& nx) {
    const unsigned G = gridDim.x * gridDim.y * gridDim.z;
    unsigned sum, cnt, mine, sp = 0u;
    for (;;) {
        sum = 0u; cnt = 0u; mine = 0u;
#pragma unroll
        for (unsigned j = 0; j < 16; ++j) { const unsigned c = xb_ld(&bar[XB_XCNT(j)]); sum += c; cnt += (c > 0u) ? 1u : 0u; mine = (j == x) ? c : mine; }
        if (sum == G) break;
        __builtin_amdgcn_s_sleep(1);
        if ((++sp & 255u) == 0u) { if (xb_ld(&bar[XB_TMO])) break; if (sp > XB_SPIN_CAP) { atomicAdd(&bar[XB_TMO], 1u); break; } }
    }
    nloc = mine > 0u ? mine : 1u; nx = cnt > 0u ? cnt : 1u;
}
__device__ __forceinline__ void xcd_barrier(const XcdBarrier& b) {
    asm volatile("s_waitcnt vmcnt(0)" ::: "memory");
    __syncthreads();
    if (threadIdx.x == 0) {
        unsigned* bar = b.bar;
        __builtin_amdgcn_s_waitcnt(0);
        unsigned nloc = b.st[0], nx = b.st[1];
        if (nloc == 0u) { xcd_barrier_complete(bar, b.x, nloc, nx); b.st[0] = nloc; b.st[1] = nx; }
        const unsigned old = xb_add(&bar[XB_XSUB(b.x)], 1u);
        const unsigned gen = old / nloc;
        if (old + 1u == (gen + 1u) * nloc) {
            __builtin_amdgcn_fence(__ATOMIC_RELEASE, "agent");
            asm volatile("s_waitcnt vmcnt(0)" ::: "memory");
            const unsigned og = xb_add(&bar[XB_TOP], 1u);
            const unsigned tg = og / nx;
            if (og + 1u == (tg + 1u) * nx) xb_add(&bar[XB_TOPGEN], 1u);
            else XB_SPIN(xb_ld(&bar[XB_TOPGEN]) == tg, bar);
            __builtin_amdgcn_fence(__ATOMIC_ACQUIRE, "agent");
            xb_add(&bar[XB_XGEN(b.x)], 1u);
            asm volatile("s_waitcnt vmcnt(0)" ::: "memory");
        } else {
            XB_SPIN(xb_ld(&bar[XB_XGEN(b.x)]) == gen, bar);
            __builtin_amdgcn_fence(__ATOMIC_ACQUIRE, "agent");
            asm volatile("s_waitcnt vmcnt(0)" ::: "memory");
        }
    }
    __syncthreads();
}

constexpr int NT = 16384, D = 1024, L = 8192, NB = 2;
constexpr int DINA = 1864, DINB = 3088;
constexpr int PMAX = 73728;
constexpr float ALPHA = 1.4142135623730951f;

struct In { const float *x, *a_w_in, *a_kv_norm, *a_w_uk, *a_w_uv, *a_w_out, *b_w_in, *b_w_g2, *b_g_bias, *b_norm, *b_w_out, *m_w_router, *m_b_router, *m_w1, *m_b1, *m_w2, *m_b2, *ln1_g, *ln1_b, *ln2_g, *ln2_b; };

__device__ __forceinline__ int TIDX() { int t = threadIdx.x; asm volatile("" : "+v"(t)); return t; }
__device__ __forceinline__ int BIDX() { int t = blockIdx.x; asm volatile("" : "+s"(t)); return t; }
__device__ __forceinline__ float wave_sum(float v) {
#pragma unroll
    for (int o = 1; o < 64; o <<= 1) v += __shfl_xor(v, o);
    return v;
}
namespace nvp {
#define WSYNC() asm volatile("s_waitcnt lgkmcnt(0)" ::: "memory")
struct GemmP {
  const float* A; int lda; const int* arow;
  const float* B; int ldb; float* C; int ldc; int M, N, K;
  const int* blk_e; const int* nblk_used; size_t bstride; const float* bias; size_t bias_stride;
};
__device__ __forceinline__ GemmP mkg(const float* A, int lda, const int* arow, const float* B, int ldb, float* C, int ldc, int M, int N, int K, const int* blk_e, const int* nblk_used, size_t bstride, const float* bias, size_t bias_stride) {
  GemmP p; p.A = A; p.lda = lda; p.arow = arow; p.B = B; p.ldb = ldb; p.C = C; p.ldc = ldc; p.M = M; p.N = N; p.K = K; p.blk_e = blk_e; p.nblk_used = nblk_used; p.bstride = bstride; p.bias = bias; p.bias_stride = bias_stride; return p; }

template <int MODE>
__device__ __forceinline__ void np_sgemm(const GemmP p, float* lds) {
  float (*As)[132] = (float (*)[132])lds;
  float (*Bs)[68] = (float (*)[68])(lds + 16 * 132);
  float (*Bu)[68] = (float (*)[68])(lds + 16 * 132 + 16 * 68);
  const int tid = TIDX(), tx = tid & 15, ty = tid >> 4;
  const int ntn = (p.N + 63) / 64, ntm = p.M / 128;
  const int ar = tid >> 2, ak = (tid & 3) * 4;
  const int bk = (tid & 255) >> 4, bn4 = (tid & 15) * 4;
  for (int t = BIDX(); t < ntm * ntn; t += gridDim.x) {
    const int bm = t / ntn, bn = t % ntn;
    const float* B = p.B; const float* bias = p.bias;
    if (MODE != 0) { const int blk = (bm * 128) / 256; if (blk >= *p.nblk_used) continue; const int e = p.blk_e[blk]; B += (size_t)e * p.bstride; bias += (size_t)e * p.bias_stride; }
    const int m0 = bm * 128, n0 = bn * 64;
    const int arow = p.arow ? p.arow[m0 + ar] : (m0 + ar);
    const float* Ap = p.A + (size_t)arow * p.lda + ak;
    const bool bok = (n0 + bn4) < p.N;
    float acc[4][4] = {}, accu[4][4] = {};
    for (int k0 = 0; k0 < p.K; k0 += 16) {
      const float4 av = *(const float4*)(Ap + k0);
      As[ak + 0][ar] = av.x; As[ak + 1][ar] = av.y; As[ak + 2][ar] = av.z; As[ak + 3][ar] = av.w;
      if (tid < 256) { float4 bv = make_float4(0.f, 0.f, 0.f, 0.f); if (bok) bv = *(const float4*)(B + (size_t)(k0 + bk) * p.ldb + n0 + bn4); *(float4*)&Bs[bk][bn4] = bv; }
      else if (MODE == 1) { const float4 uv = *(const float4*)(B + (size_t)(k0 + bk) * p.ldb + 1024 + n0 + bn4); *(float4*)&Bu[bk][bn4] = uv; }
      __syncthreads();
#pragma unroll
      for (int kk = 0; kk < 16; ++kk) {
        const float4 a = *(const float4*)&As[kk][ty * 4];
        const float4 b = *(const float4*)&Bs[kk][tx * 4];
        const float aa[4] = {a.x, a.y, a.z, a.w}, bb[4] = {b.x, b.y, b.z, b.w};
#pragma unroll
        for (int i = 0; i < 4; ++i)
#pragma unroll
          for (int j = 0; j < 4; ++j) acc[i][j] = fmaf(aa[i], bb[j], acc[i][j]);
        if (MODE == 1) {
          const float4 u = *(const float4*)&Bu[kk][tx * 4]; const float uu[4] = {u.x, u.y, u.z, u.w};
#pragma unroll
          for (int i = 0; i < 4; ++i)
#pragma unroll
            for (int j = 0; j < 4; ++j) accu[i][j] = fmaf(aa[i], uu[j], accu[i][j]);
        }
      }
      __syncthreads();
    }
#pragma unroll
    for (int i = 0; i < 4; ++i) {
      const int m = m0 + ty * 4 + i;
#pragma unroll
      for (int j = 0; j < 4; ++j) {
        const int n = n0 + tx * 4 + j; if (n >= p.N) continue;
        float v = acc[i][j];
        if (MODE == 1) {
          float g = v + bias[n], u = accu[i][j] + bias[1024 + n];
          g = fminf(g, 7.f); u = fminf(fmaxf(u, -7.f), 7.f);
          const float glu = g / (1.f + expf(-1.702f * g));
          v = (u + 1.f) * glu;
        } else if (MODE == 2) v += bias[n];
        p.C[(size_t)m * p.ldc + n] = v;
      }
    }
  }
}

#define GW_INIT const int lane = TIDX() & 63, wave = TIDX() >> 6, gw = BIDX() * 8 + wave, NGW = gridDim.x * 8; (void)lane; (void)wave; (void)gw; (void)NGW

__device__ __forceinline__ void np_cnorm(const float* projA, const float* g, float* cn) {
  GW_INIT;
  for (int row = gw; row < NT; row += NGW) {
    const float4 v = *(const float4*)(projA + (size_t)row * DINA + 1024 + lane * 4);
    const float ss = wave_sum(v.x * v.x + v.y * v.y + v.z * v.z + v.w * v.w);
    const float r = rsqrtf(ss * (1.f / 256.f) + 1e-6f); const float4 g4 = *(const float4*)(g + lane * 4);
    *(float4*)(cn + (size_t)row * 256 + lane * 4) = make_float4(v.x * r * g4.x, v.y * r * g4.y, v.z * r * g4.z, v.w * r * g4.w);
  }
}

__device__ __forceinline__ void np_iscore(const float* projA, float* sc, float* lds) {
  float (*As)[132] = (float (*)[132])lds;
  float (*Bs)[68] = (float (*)[68])(lds + 16 * 132);
  const int tid = TIDX(), tx = tid & 15, ty = tid >> 4;
  const int ar = tid >> 2, ak = (tid & 3) * 4;
  const int br = (tid & 255) >> 2;
  for (int u = BIDX(); u < NB * 64 * 128; u += gridDim.x) {
    const int b = u / (64 * 128), tt = (u / 128) % 64, st = u % 128;
    if (st > 2 * tt + 1) continue;
    const int t0 = tt * 128, s0 = st * 64;
    const float* Qp = projA + (size_t)(b * L + t0 + ar) * DINA + 1280 + ak;
    const float* Kp = projA + (size_t)(b * L + s0 + br) * DINA + 1792 + ak;
    float score[4][4] = {};
    for (int h = 0; h < 8; ++h) {
      float acc[4][4] = {};
      for (int k0 = 0; k0 < 64; k0 += 16) {
        const float4 av = *(const float4*)(Qp + h * 64 + k0);
        As[ak + 0][ar] = av.x; As[ak + 1][ar] = av.y; As[ak + 2][ar] = av.z; As[ak + 3][ar] = av.w;
        if (tid < 256) { const float4 bv = *(const float4*)(Kp + k0); Bs[ak + 0][br] = bv.x; Bs[ak + 1][br] = bv.y; Bs[ak + 2][br] = bv.z; Bs[ak + 3][br] = bv.w; }
        __syncthreads();
#pragma unroll
        for (int kk = 0; kk < 16; ++kk) {
          const float4 a = *(const float4*)&As[kk][ty * 4]; const float4 bq = *(const float4*)&Bs[kk][tx * 4];
          const float aa[4] = {a.x, a.y, a.z, a.w}, bb[4] = {bq.x, bq.y, bq.z, bq.w};
#pragma unroll
          for (int i = 0; i < 4; ++i)
#pragma unroll
            for (int j = 0; j < 4; ++j) acc[i][j] = fmaf(aa[i], bb[j], acc[i][j]);
        }
        __syncthreads();
      }
#pragma unroll
      for (int i = 0; i < 4; ++i) {
        const float w = projA[(size_t)(b * L + t0 + ty * 4 + i) * DINA + 1856 + h] * 0.35355339059327373f;
#pragma unroll
        for (int j = 0; j < 4; ++j) score[i][j] += w * fmaxf(acc[i][j] * 0.125f, 0.f);
      }
    }
#pragma unroll
    for (int i = 0; i < 4; ++i)
#pragma unroll
      for (int j = 0; j < 4; ++j) sc[((size_t)(b * L + t0 + ty * 4 + i)) * L + s0 + tx * 4 + j] = score[i][j];
  }
}

__device__ __forceinline__ unsigned f2key(float f) { f = f + 0.0f; const unsigned u = __float_as_uint(f); return (u & 0x80000000u) ? ~u : (u | 0x80000000u); }

__device__ __forceinline__ void np_topk(const float* sc, int* idx_out, char* lds) {
  GW_INIT;
  unsigned* hist = (unsigned*)(lds + wave * 1280); unsigned* cntw = hist + 256;
  for (int row = gw; row < NT; row += NGW) {
    const int t = row % L, n = t + 1;
    const float* s = sc + (size_t)row * L; int* out = idx_out + (size_t)row * 256;
    if (n <= 256) { for (int i = lane; i < 256; i += 64) out[i] = i < n ? i : -1; continue; }
    unsigned prefix = 0, need = 256;
    for (int pass = 3; pass >= 0; --pass) {
      const int shift = pass * 8;
      for (int i = lane; i < 256; i += 64) hist[i] = 0;
      WSYNC();
      for (int i = lane; i < n; i += 64) { const unsigned k = f2key(s[i]); const bool m = (pass == 3) || ((k >> (shift + 8)) == (prefix >> (shift + 8))); if (m) atomicAdd(&hist[(k >> shift) & 255u], 1u); }
      WSYNC();
      unsigned cum = 0; int d = 255; for (; d > 0; --d) { const unsigned hv = hist[d]; if (cum + hv >= need) break; cum += hv; }
      prefix |= ((unsigned)d << shift); need -= cum;
      WSYNC();
    }
    if (lane == 0) *cntw = 0; WSYNC();
    for (int i = lane; i < n; i += 64) { if (f2key(s[i]) > prefix) { const unsigned pos = atomicAdd(cntw, 1u); out[pos] = i; } }
    WSYNC();
    if (lane == 0) { unsigned c = *cntw; unsigned nd = need; for (int i = 0; i < n && nd > 0; ++i) if (f2key(s[i]) == prefix) { out[c++] = i; --nd; } }
    WSYNC();
  }
}

__device__ __forceinline__ void np_dsa_attn(const float* projA, const float* cn, const int* idx, const float* w_uk, const float* w_uv, float* o2, float* lds) {
  const int half = TIDX() >> 8, tid = TIDX() & 255;
  float* base = lds + half * 14336;
  float* qs = base; float (*ql)[256] = (float (*)[256])(base + 1024); float (*pr)[257] = (float (*)[257])(base + 1024 + 4096);
  float (*ol)[256] = (float (*)[256])(base + 1024 + 4096 + 4112); float* red = base + 1024 + 4096 + 4112 + 4096; int* sid = (int*)(red + 16);
  for (int r0 = BIDX() * 2; r0 < NT; r0 += gridDim.x * 2) {
    const int row = r0 + half, b = row / L;
    __syncthreads();
    for (int i = tid; i < 1024; i += 256) qs[i] = projA[(size_t)row * DINA + i];
    sid[tid] = idx[(size_t)row * 256 + tid];
    __syncthreads();
    { const int c = tid;
#pragma unroll 1
      for (int h = 0; h < 16; ++h) { float a = 0.f;
#pragma unroll 8
        for (int d = 0; d < 64; ++d) a = fmaf(qs[h * 64 + d], w_uk[((size_t)h * 64 + d) * 256 + c], a); ql[h][c] = a; } }
    __syncthreads();
    { const int k = tid, key = sid[k];
      float lg[16];
      if (key >= 0) { const float* cr = cn + (size_t)(b * L + key) * 256;
        for (int h = 0; h < 16; ++h) lg[h] = 0.f;
#pragma unroll 2
        for (int c = 0; c < 256; ++c) { const float cv = cr[c];
#pragma unroll
          for (int h = 0; h < 16; ++h) lg[h] = fmaf(ql[h][c], cv, lg[h]); }
#pragma unroll
        for (int h = 0; h < 16; ++h) pr[h][k] = lg[h] * 0.125f;
      } else {
#pragma unroll
        for (int h = 0; h < 16; ++h) pr[h][k] = -INFINITY; } }
    __syncthreads();
    if (tid < 16) { const int h = tid; float m = -INFINITY; for (int k = 0; k < 256; ++k) m = fmaxf(m, pr[h][k]); float su = 0.f; for (int k = 0; k < 256; ++k) { const float e = expf(pr[h][k] - m); pr[h][k] = e; su += e; } red[h] = 1.f / su; }
    __syncthreads();
    { const int c = tid; float a[16];
#pragma unroll
      for (int h = 0; h < 16; ++h) a[h] = 0.f;
#pragma unroll 2
      for (int k = 0; k < 256; ++k) { const int key = sid[k]; if (key < 0) continue; const float cv = cn[(size_t)(b * L + key) * 256 + c];
#pragma unroll
        for (int h = 0; h < 16; ++h) a[h] = fmaf(pr[h][k], cv, a[h]); }
#pragma unroll
      for (int h = 0; h < 16; ++h) ol[h][c] = a[h] * red[h]; }
    __syncthreads();
#pragma unroll 1
    for (int o = tid; o < 1024; o += 256) { const int h = o >> 6, v = o & 63; float a = 0.f;
#pragma unroll 8
      for (int c = 0; c < 256; ++c) a = fmaf(ol[h][c], w_uv[((size_t)h * 256 + c) * 64 + v], a); o2[(size_t)row * 1024 + o] = a; }
  }
  __syncthreads();
}

__device__ __forceinline__ void np_ln_res(const float* x, const float* h, const float* g, const float* bb, float* out) {
  GW_INIT;
  for (int row = gw; row < NT; row += NGW) {
    float4 v[4]; float s = 0.f;
#pragma unroll
    for (int j = 0; j < 4; ++j) { const float4 a = *(const float4*)(x + (size_t)row * D + lane * 4 + 256 * j), hh = *(const float4*)(h + (size_t)row * D + lane * 4 + 256 * j);
      v[j] = make_float4(ALPHA * a.x + hh.x, ALPHA * a.y + hh.y, ALPHA * a.z + hh.z, ALPHA * a.w + hh.w); s += (v[j].x + v[j].y) + (v[j].z + v[j].w); }
    const float mu = wave_sum(s) * (1.f / D); float q = 0.f;
#pragma unroll
    for (int j = 0; j < 4; ++j) { v[j].x -= mu; v[j].y -= mu; v[j].z -= mu; v[j].w -= mu; q += (v[j].x * v[j].x + v[j].y * v[j].y) + (v[j].z * v[j].z + v[j].w * v[j].w); }
    const float r = rsqrtf(wave_sum(q) * (1.f / D) + 1e-5f);
#pragma unroll
    for (int j = 0; j < 4; ++j) { const int c = lane * 4 + 256 * j; const float4 g4 = *(const float4*)(g + c), b4 = *(const float4*)(bb + c);
      *(float4*)(out + (size_t)row * D + c) = make_float4(v[j].x * r * g4.x + b4.x, v[j].y * r * g4.y + b4.y, v[j].z * r * g4.z + b4.z, v[j].w * r * g4.w + b4.w); }
  }
}

__device__ __forceinline__ void np_router(const float* x, const float* wr, const float* br, int* tok_e, float* tok_g, int* counts, int* row_tok, char* lds) {
  GW_INIT;
  for (int i = BIDX() * NTHR + TIDX(); i < PMAX; i += gridDim.x * NTHR) row_tok[i] = 0;
  float* lg = (float*)(lds + wave * 256);
  const int e = lane & 31, hf = lane >> 5;
  for (int tok = gw; tok < NT; tok += NGW) {
    const float* xr = x + (size_t)tok * D + hf * 512; const float* wp = wr + (size_t)hf * 512 * 32 + e; float a = 0.f;
#pragma unroll 8
    for (int d = 0; d < 512; ++d) a = fmaf(xr[d], wp[d * 32], a);
    a += __shfl_xor(a, 32);
    if (hf == 0) lg[e] = a + br[e];
    WSYNC();
    if (lane == 0) { int ei[4]; float ev[4];
      for (int k = 0; k < 4; ++k) { int bi = 0; float bv = -INFINITY; for (int j = 0; j < 32; ++j) if (lg[j] > bv) { bv = lg[j]; bi = j; } ei[k] = bi; ev[k] = bv; lg[bi] = -INFINITY; }
      float su = 0.f, ex[4]; for (int k = 0; k < 4; ++k) { ex[k] = expf(ev[k] - ev[0]); su += ex[k]; }
      for (int k = 0; k < 4; ++k) { tok_e[tok * 4 + k] = ei[k]; tok_g[tok * 4 + k] = ex[k] / su; atomicAdd(&counts[ei[k]], 1); } }
    WSYNC();
  }
}
__device__ __forceinline__ void np_moe_sort(const int* tok_e, const float* tok_g, const int* counts, int* row_tok, float* row_gate, int* slot_of, int* blk_e, int* nblk_used, char* lds) {
  if (BIDX() != 0) return;
  const int e = TIDX(); int* pstart = (int*)lds; int* stage = pstart + 64;
  if (e == 0) { int acc = 0; for (int j = 0; j < 32; ++j) { pstart[j] = acc; const int nb = (counts[j] + 255) / 256; for (int q = 0; q < nb; ++q) blk_e[acc / 256 + q] = j; acc += nb * 256; } pstart[32] = acc; *nblk_used = acc / 256; }
  __syncthreads();
  int pos = e < 32 ? pstart[e] : 0;
  for (int c0 = 0; c0 < NT * 4; c0 += 2048) {
    __syncthreads();
    for (int i = e; i < 2048; i += NTHR) stage[i] = tok_e[c0 + i];
    __syncthreads();
    if (e < 32) for (int i = 0; i < 2048; ++i) if (stage[i] == e) { const int gi = c0 + i; row_tok[pos] = gi >> 2; row_gate[pos] = tok_g[gi]; slot_of[gi] = pos; ++pos; }
  }
  __syncthreads();
}
__device__ __forceinline__ void np_moe_combine_ln(const float* x1, const float* ys, const int* slot_of, const float* tok_g, const float* g, const float* bb, float* out) {
  GW_INIT;
  for (int row = gw; row < NT; row += NGW) {
    float4 v[4]; float s = 0.f; int sl[4]; float gg[4];
#pragma unroll
    for (int k = 0; k < 4; ++k) { sl[k] = slot_of[row * 4 + k]; gg[k] = tok_g[row * 4 + k]; }
#pragma unroll
    for (int j = 0; j < 4; ++j) { const int c = lane * 4 + 256 * j; float4 f = make_float4(0.f, 0.f, 0.f, 0.f);
#pragma unroll
      for (int k = 0; k < 4; ++k) { const float4 y = *(const float4*)(ys + (size_t)sl[k] * D + c); f.x += gg[k] * y.x; f.y += gg[k] * y.y; f.z += gg[k] * y.z; f.w += gg[k] * y.w; }
      const float4 a = *(const float4*)(x1 + (size_t)row * D + c);
      v[j] = make_float4(ALPHA * a.x + f.x, ALPHA * a.y + f.y, ALPHA * a.z + f.z, ALPHA * a.w + f.w); s += (v[j].x + v[j].y) + (v[j].z + v[j].w); }
    const float mu = wave_sum(s) * (1.f / D); float q = 0.f;
#pragma unroll
    for (int j = 0; j < 4; ++j) { v[j].x -= mu; v[j].y -= mu; v[j].z -= mu; v[j].w -= mu; q += (v[j].x * v[j].x + v[j].y * v[j].y) + (v[j].z * v[j].z + v[j].w * v[j].w); }
    const float r = rsqrtf(wave_sum(q) * (1.f / D) + 1e-5f);
#pragma unroll
    for (int j = 0; j < 4; ++j) { const int c = lane * 4 + 256 * j; const float4 g4 = *(const float4*)(g + c), b4 = *(const float4*)(bb + c);
      *(float4*)(out + (size_t)row * D + c) = make_float4(v[j].x * r * g4.x + b4.x, v[j].y * r * g4.y + b4.y, v[j].z * r * g4.z + b4.z, v[j].w * r * g4.w + b4.w); }
  }
}

__device__ __forceinline__ void np_gla_gate(const float* projB, const float* w_g2, const float* gb, float* adec) {
  GW_INIT;
  for (int row = gw; row < NT; row += NGW) {
    float glr[16];
#pragma unroll
    for (int j = 0; j < 16; ++j) glr[j] = projB[(size_t)row * DINB + 2048 + j];
    for (int c = lane; c < 512; c += 64) { float a = gb[c];
#pragma unroll
      for (int j = 0; j < 16; ++j) a = fmaf(glr[j], w_g2[j * 512 + c], a);
      const float ls = fminf(a, 0.f) - log1pf(expf(-fabsf(a))); adec[(size_t)row * 512 + c] = expf(ls * (1.f / 16.f)); }
  }
}
__device__ __forceinline__ void np_gla_scan(const float* projB, const float* adec, float* og, float* lds) {
  if (BIDX() >= 8) return;
  const int b = BIDX() >> 2, h = BIDX() & 3, tid = TIDX(), dv = tid & 255, dh = tid >> 8;
  float (*qs)[128] = (float (*)[128])lds; float (*ks)[128] = (float (*)[128])(lds + 2048); float (*as)[128] = (float (*)[128])(lds + 4096);
  float (*po)[16][256] = (float (*)[16][256])(lds + 6144);
  float S[64];
#pragma unroll
  for (int d = 0; d < 64; ++d) S[d] = 0.f;
  for (int t0 = 0; t0 < L; t0 += 16) {
    __syncthreads();
    for (int i = tid; i < 16 * 128; i += NTHR) { const int tt = i >> 7, d = i & 127; const size_t r = (size_t)(b * L + t0 + tt);
      qs[tt][d] = projB[r * DINB + h * 128 + d] * 0.08838834764831845f; ks[tt][d] = projB[r * DINB + 512 + h * 128 + d]; as[tt][d] = adec[r * 512 + h * 128 + d]; }
    __syncthreads();
#pragma unroll 1
    for (int tt = 0; tt < 16; ++tt) { const size_t r = (size_t)(b * L + t0 + tt); const float v = projB[r * DINB + 1024 + h * 256 + dv]; float o = 0.f;
#pragma unroll
      for (int d = 0; d < 64; ++d) { S[d] = fmaf(as[tt][dh * 64 + d], S[d], ks[tt][dh * 64 + d] * v); o = fmaf(qs[tt][dh * 64 + d], S[d], o); }
      po[dh][tt][dv] = o; }
    __syncthreads();
    for (int i = tid; i < 16 * 256; i += NTHR) { const int tt = i >> 8, c = i & 255; og[(size_t)(b * L + t0 + tt) * 1024 + h * 256 + c] = po[0][tt][c] + po[1][tt][c]; }
  }
  __syncthreads();
}
__device__ __forceinline__ void np_gla_norm(const float* og, const float* projB, const float* ng, float* on) {
  GW_INIT;
  for (int u = gw; u < NT * 4; u += NGW) {
    const int row = u >> 2, h = u & 3; const int c = h * 256 + lane * 4;
    const float4 v = *(const float4*)(og + (size_t)row * 1024 + c);
    const float r = rsqrtf(wave_sum(v.x * v.x + v.y * v.y + v.z * v.z + v.w * v.w) * (1.f / 256.f) + 1e-6f);
    const float4 rr = *(const float4*)(projB + (size_t)row * DINB + 2064 + c), g4 = *(const float4*)(ng + c);
    *(float4*)(on + (size_t)row * 1024 + c) = make_float4(v.x * r * g4.x * (rr.x / (1.f + expf(-rr.x))), v.y * r * g4.y * (rr.y / (1.f + expf(-rr.y))), v.z * r * g4.z * (rr.z / (1.f + expf(-rr.z))), v.w * r * g4.w * (rr.w / (1.f + expf(-rr.w))));
  }
}

struct Ws { float *projA, *cn, *sc, *o2, *h, *x1, *x2, *hb, *ys, *projB, *adec, *og, *on, *tok_g, *row_gate; int *idx, *tok_e, *slot_of, *row_tok, *blk_e, *counts; };
}
typedef unsigned short bf16_t;
typedef unsigned v4u __attribute__((ext_vector_type(4)));
typedef unsigned v2u __attribute__((ext_vector_type(2)));
typedef float f32x4 __attribute__((ext_vector_type(4)));
typedef short bf16x8 __attribute__((ext_vector_type(8)));
typedef float f32x2_t __attribute__((ext_vector_type(2))); typedef __bf16 bf16x2_t __attribute__((ext_vector_type(2)));
__device__ __forceinline__ unsigned cvt_pk_bf16(float lo, float hi) { const f32x2_t v = {lo, hi}; const bf16x2_t b = __builtin_convertvector(v, bf16x2_t); return __builtin_bit_cast(unsigned, b); }
__device__ __forceinline__ float bf_lo(unsigned u) { return __uint_as_float(u << 16); }
__device__ __forceinline__ float bf_hi(unsigned u) { return __uint_as_float(u & 0xffff0000u); }
__device__ __forceinline__ float bf2f(bf16_t h) { return __uint_as_float(((unsigned)h) << 16); }

struct TJob { const float* src; int lds_; int K, N; bf16_t* dst; int ldd; int drow0, dcol0; int rowmap; int ntk, ntn; };
__device__ __forceinline__ TJob mk_tjob(const float* src, int lds_, int K, int N, bf16_t* dst, int ldd, int drow0, int dcol0, int rowmap) {
  TJob j; j.src = src; j.lds_ = lds_; j.K = K; j.N = N; j.dst = dst; j.ldd = ldd; j.drow0 = drow0; j.dcol0 = dcol0; j.rowmap = rowmap; j.ntk = K / 64; j.ntn = (N + 127) / 128; return j; }
__device__ __forceinline__ int tjob_tiles(const TJob& j) { return j.ntk * j.ntn; }
template <int NOST = 0> __device__ __forceinline__ void transpose_tile(const TJob& j, int tile, int lane, LAS unsigned char* stage, unsigned* sink = nullptr) {
  const int kt = tile / j.ntn, nt_ = tile % j.ntn, k0 = kt * 64, n0 = nt_ * 128;
  const int q = lane & 31, par = lane >> 5;
  const bool ok = (n0 + 4 * q) < j.N;
  f32x4 v[32];
  const float* sp = j.src + (size_t)(k0 + par) * j.lds_ + (ok ? n0 + 4 * q : 0);
#pragma unroll
  for (int i = 0; i < 32; ++i) v[i] = *(const f32x4*)(sp + (size_t)(2 * i) * j.lds_);
  __builtin_amdgcn_sched_barrier(0);
  unsigned ra[32], rb[32];
#pragma unroll
  for (int i = 0; i < 32; ++i) {
    auto s0 = __builtin_amdgcn_permlane32_swap(__float_as_uint(v[i][0]), __float_as_uint(v[i][2]), false, false);
    auto s1 = __builtin_amdgcn_permlane32_swap(__float_as_uint(v[i][1]), __float_as_uint(v[i][3]), false, false);
    ra[i] = cvt_pk_bf16(__uint_as_float(s0[0]), __uint_as_float(s0[1]));
    rb[i] = cvt_pk_bf16(__uint_as_float(s1[0]), __uint_as_float(s1[1]));
  }
  if (NOST) { unsigned x = 0u;
#pragma unroll
    for (int i = 0; i < 32; ++i) x ^= ra[i] ^ rb[i];
    if (x == 0x12345678u) sink[lane] = x; return; }
  { const unsigned sw = (unsigned)(q & 7); LAS unsigned char* wp = stage + (4 * q + 2 * par) * 128;
#pragma unroll
    for (int c = 0; c < 8; ++c) { *(LAS v4u*)(wp + 16 * ((unsigned)c ^ sw)) = (v4u){ra[4 * c], ra[4 * c + 1], ra[4 * c + 2], ra[4 * c + 3]}; *(LAS v4u*)(wp + 128 + 16 * ((unsigned)c ^ sw)) = (v4u){rb[4 * c], rb[4 * c + 1], rb[4 * c + 2], rb[4 * c + 3]}; } }
  const int jj = lane & 7, rl = lane >> 3;
  v4u d[16];
#pragma unroll
  for (int c2 = 0; c2 < 16; ++c2) { const int r = 8 * c2 + rl; d[c2] = *(const LAS v4u*)(stage + r * 128 + 16 * (jj ^ ((r >> 2) & 7))); }
#pragma unroll
  for (int c2 = 0; c2 < 16; ++c2) { const int n = n0 + 8 * c2 + rl;
    if (n < j.N) { int rr = n; if (j.rowmap == 1) { const int j0 = rr & 1023; rr = 256 * (j0 >> 7) + ((rr >> 10) << 7) + (j0 & 127); }
      *(v4u*)(j.dst + (size_t)(j.drow0 + rr) * j.ldd + j.dcol0 + k0 + 8 * jj) = d[c2]; } }
  asm volatile("s_waitcnt lgkmcnt(0)" ::: "memory");
}
__device__ __forceinline__ void transpose_job(const TJob j, int& w0, int gw, int NGW, int lane, LAS unsigned char* stage) {
  const int nt_ = tjob_tiles(j);
  int first = gw - (w0 % NGW); if (first < 0) first += NGW;
#pragma unroll 1
  for (int t = first; t < nt_; t += NGW) transpose_tile(j, t, lane, stage);
  w0 += nt_;
}
__device__ __forceinline__ void zero_rect(bf16_t* dst, int ldd, int r0, int nr, int cb0, int nbytes, int gtid, int NGT) {
  const int per = nbytes / 16;
  for (int i = gtid; i < nr * per; i += NGT) { const int r = i / per, c = i % per; *(v4u*)((char*)(dst + (size_t)(r0 + r) * ldd) + cb0 + 16 * c) = (v4u){0u, 0u, 0u, 0u}; }
}
__device__ __forceinline__ void cvt_f32_to_bf16(const float* src, int lds_, bf16_t* dst, int ldd, int rows, int ncols, int gtid, int NGT) {
  const int per = ncols / 4;
  for (size_t i = gtid; i < (size_t)rows * per; i += NGT) { const size_t r = i / per; const int c = (int)(i % per) * 4; const f32x4 v = *(const f32x4*)(src + r * lds_ + c);
    *(v2u*)(dst + r * ldd + c) = (v2u){cvt_pk_bf16(v[0], v[1]), cvt_pk_bf16(v[2], v[3])}; }
}
__device__ __forceinline__ void cvt_bf16_to_f32(const bf16_t* src, int lds_, float* dst, int ldd, int rows, int ncols, int gtid, int NGT) {
  const int per = ncols / 4;
  for (size_t i = gtid; i < (size_t)rows * per; i += NGT) { const size_t r = i / per; const int c = (int)(i % per) * 4; const v2u v = *(const v2u*)(src + r * lds_ + c);
    *(f32x4*)(dst + r * ldd + c) = (f32x4){bf_lo(v[0]), bf_hi(v[0]), bf_lo(v[1]), bf_hi(v[1])}; }
}

namespace pg8 {
#define PG8_LAS __attribute__((address_space(3)))
typedef unsigned u32x4 __attribute__((ext_vector_type(4)));
constexpr int BM = 256, BK = 64, HALF = 128, HTB = HALF * BK * 2, STAGE_BYTES = 8 * HTB, NXCD = 8, WGM = 8;
__host__ __device__ __forceinline__ int lds_byte(int r, int c) { const int st = (r >> 4) * 2 + (c >> 5), rr = r & 15, cc = c & 31, ob = rr * 64 + cc * 2; return st * 1024 + (ob ^ (((ob >> 9) & 1) << 5)); }
__host__ __device__ __forceinline__ void stage_rc(int b, int& R, int& C) { const int st = b / 1024, sb = b % 1024, swz = sb ^ (((sb >> 9) & 1) << 5); R = (st >> 1) * 16 + swz / 64; C = (st & 1) * 32 + (swz % 64) / 2; }
__host__ __device__ __forceinline__ int perm32(int rho) { const int n = rho >> 4, i = rho & 15; return 8 * (i >> 2) + 4 * n + (i & 3); }
struct Unit { const char* pa; const char* pb; int orow, ocol, e, kind; };
struct Gemm { int lda, ldb, K; };
struct StaticOrder {
    static constexpr bool GATHER = false; const int* rowmap;
    const char* A; const char* Bt; size_t ta, tb; int nM, nN, nwg, G, c;
    __device__ void init(const void* A_, int lda, const void* Bt_, int ldb, int M, int N, int G_, int c_) { A = (const char*)A_; Bt = (const char*)Bt_; ta = (size_t)BM * lda * 2; tb = (size_t)BM * ldb * 2; nM = M / BM; nN = N / BM; nwg = nM * nN; G = G_; c = c_; }
    __device__ bool tile(int i, int& pm, int& pn) const {
        const long L = (long)i * G + c; if (L >= nwg) return false;
        int wgid = (int)L; { const int q = nwg / NXCD, r = nwg % NXCD, xcd = wgid % NXCD, off = wgid / NXCD; wgid = (xcd < r ? xcd * (q + 1) : r * (q + 1) + (xcd - r) * q) + off; }
        const int nig = WGM * nN, gid = wgid / nig, fm = gid * WGM, gsz = (nM - fm) < WGM ? (nM - fm) : WGM;
        pm = fm + ((wgid % nig) % gsz); pn = (wgid % nig) / gsz; return true;
    }
    __device__ bool next(int i, Unit& u) const { int pm, pn; if (!tile(i, pm, pn)) return false; u.pa = A + (size_t)pm * ta; u.pb = Bt + (size_t)pn * tb; u.orow = pm * BM; u.ocol = pn * BM; u.e = 0; u.kind = 0; return true; }
    __device__ __forceinline__ int rowof(const Unit&, int r) const { return r; }
    __device__ __forceinline__ void a_ready(const Unit&) const {}
    __device__ __forceinline__ void done(const Unit&) const {}
};
struct EpiStore {
    static constexpr bool PERM = true, AFTER_DRAIN = false;
    bf16_t* O; int ldc;
    __device__ __forceinline__ void operator()(const f32x4 (&acc)[2][2][4][2], const Unit& u, int wr, int wc, int fr, int fq) const {
        const int row0 = u.orow + wr * 64 + fr, col0 = u.ocol + wc * 32 + 8 * fq;
#pragma unroll
        for (int ai = 0; ai < 2; ++ai)
#pragma unroll
            for (int m = 0; m < 4; ++m) { bf16_t* rowp = O + (size_t)(row0 + ai * HALF + m * 16) * ldc + col0;
#pragma unroll
                for (int bj = 0; bj < 2; ++bj) { const f32x4 v0 = acc[ai][bj][m][0], v1 = acc[ai][bj][m][1];
                    u32x4 w; w.x = cvt_pk_bf16(v0[0], v0[1]); w.y = cvt_pk_bf16(v0[2], v0[3]); w.z = cvt_pk_bf16(v1[0], v1[1]); w.w = cvt_pk_bf16(v1[2], v1[3]);
                    *(u32x4*)(rowp + bj * HALF) = w; } }
    }
};
struct EpiStoreKi {
    static constexpr bool PERM = true, AFTER_DRAIN = false;
    bf16_t* O; int ldc; bf16_t* Ki; int kcol;
    __device__ __forceinline__ void operator()(const f32x4 (&acc)[2][2][4][2], const Unit& u, int wr, int wc, int fr, int fq) const {
        const int row0 = u.orow + wr * 64 + fr, col0 = u.ocol + wc * 32 + 8 * fq;
        const bool kt = (u.ocol == kcol) && (wc < 2);
#pragma unroll
        for (int ai = 0; ai < 2; ++ai)
#pragma unroll
            for (int m = 0; m < 4; ++m) { bf16_t* rowp = O + (size_t)(row0 + ai * HALF + m * 16) * ldc + col0;
#pragma unroll
                for (int bj = 0; bj < 2; ++bj) { const f32x4 v0 = acc[ai][bj][m][0], v1 = acc[ai][bj][m][1];
                    u32x4 w; w.x = cvt_pk_bf16(v0[0], v0[1]); w.y = cvt_pk_bf16(v0[2], v0[3]); w.z = cvt_pk_bf16(v1[0], v1[1]); w.w = cvt_pk_bf16(v1[2], v1[3]);
                    *(u32x4*)(rowp + bj * HALF) = w;
                    if (bj == 0 && kt) *(u32x4*)(Ki + (size_t)(row0 + ai * HALF + m * 16) * 64 + wc * 32 + 8 * fq) = w; } }
    }
};
template <class Epi, class Sched, bool ALIGN_EPI = false, bool SP2 = false>
__device__ __forceinline__ void gemm_phase(PG8_LAS unsigned char* lds, const Gemm g, const Sched& S, const Epi& E) {
    const int tid = TIDX(), wid = __builtin_amdgcn_readfirstlane(tid >> 6), lane = tid & 63, wr = wid >> 2, wc = wid & 3, fr = lane & 15, fq = lane >> 4;
    const int K = g.K, nt = K / BK;
    unsigned voffA[2], voffB[2];
#pragma unroll
    for (int i = 0; i < 2; ++i) { int R, C; stage_rc(tid * 16 + i * 8192, R, C); const int Rb = Epi::PERM ? ((R & ~31) + perm32(R & 31)) : R;
        voffA[i] = (unsigned)(R * g.lda + C) * 2u; voffB[i] = (unsigned)(Rb * g.ldb + C) * 2u; }
    unsigned voffG[2][2][2]; int gR[2], gC[2];
#pragma unroll
    for (int i = 0; i < 2; ++i) { int R, C; stage_rc(tid * 16 + i * 8192, R, C); gR[i] = R; gC[i] = C; }
#define PG8_GOFF(dst, unit_) do { if constexpr (Sched::GATHER) { _Pragma("unroll") for (int _h = 0; _h < 2; ++_h) _Pragma("unroll") for (int _i = 0; _i < 2; ++_i) \
        dst[_h][_i] = (unsigned)S.rowof(unit_, (unit_).orow + _h * HALF + gR[_i]) * (unsigned)(g.lda * 2) + (unsigned)gC[_i] * 2u; } } while (0)
#define PG8_STAGE_A(bufoff, gptr, half, vsel) do { if constexpr (Sched::GATHER) { PG8_STAGE(bufoff, gptr, vsel); } else { PG8_STAGE(bufoff, (gptr) + (half) * hstepA, voffA); } } while (0)
    const size_t kstep = (size_t)(BK * 2);
    const size_t hstepA = (size_t)HALF * g.lda * 2, hstepB = (size_t)HALF * g.ldb * 2;
    const unsigned ldsw = (unsigned)wid * 1024u;
    const int aoff = lds_byte(wr * 64 + fr, fq * 8), boff = lds_byte(wc * 32 + fr, fq * 8);
#define PG8_SA(b, h) (((b) * 2 + (h)) * HTB)
#define PG8_SB(b, h) ((4 + (b) * 2 + (h)) * HTB)
#define PG8_STAGE(bufoff, gbase, voff) do { _Pragma("unroll") for (int _i = 0; _i < 2; ++_i) \
        __builtin_amdgcn_global_load_lds((const unsigned*)((const char*)(gbase) + (voff)[_i]), (PG8_LAS unsigned*)(lds + (bufoff) + ldsw + _i * 8192), 16, 0, 0); } while (0)
#define PG8_LDA(dst, b, h) do { _Pragma("unroll") for (int m = 0; m < 4; ++m) _Pragma("unroll") for (int k = 0; k < 2; ++k) dst[m][k] = *(const PG8_LAS bf16x8*)(lds + PG8_SA(b, h) + aoff + m * 2048 + k * 1024); } while (0)
#define PG8_LDB(dst, b, h) do { _Pragma("unroll") for (int n = 0; n < 2; ++n) _Pragma("unroll") for (int k = 0; k < 2; ++k) dst[n][k] = *(const PG8_LAS bf16x8*)(lds + PG8_SB(b, h) + boff + n * 2048 + k * 1024); } while (0)
#define PG8_MMA(ai, bj, At, Bt) do { __builtin_amdgcn_s_setprio(1); _Pragma("unroll") for (int m = 0; m < 4; ++m) _Pragma("unroll") for (int n = 0; n < 2; ++n) _Pragma("unroll") for (int k = 0; k < 2; ++k) \
        acc[ai][bj][m][n] = __builtin_amdgcn_mfma_f32_16x16x32_bf16(Bt[n][k], At[m][k], acc[ai][bj][m][n], 0, 0, 0); __builtin_amdgcn_s_setprio(0); } while (0)
#define PG8_WAIT_V(n) asm volatile("s_waitcnt vmcnt(" #n ")" ::: "memory")
#define PG8_WAIT_L(n) asm volatile("s_waitcnt lgkmcnt(" #n ")" ::: "memory")
#define PG8_BAR __builtin_amdgcn_s_barrier()
#define PG8_SCHED __builtin_amdgcn_sched_barrier(0)
    Unit cur, nxt; int ui = 0;
    if (!S.next(0, cur)) return;
    f32x4 acc[2][2][4][2];
#pragma unroll
    for (int a = 0; a < 2; ++a)
#pragma unroll
        for (int b = 0; b < 2; ++b)
#pragma unroll
            for (int m = 0; m < 4; ++m)
#pragma unroll
                for (int n = 0; n < 2; ++n) acc[a][b][m][n] = (f32x4){0.f, 0.f, 0.f, 0.f};
    bf16x8 At[4][2], B0[2][2], B1[2][2];
    const char* cA = cur.pa; const char* cB = cur.pb;
    S.a_ready(cur);
    PG8_GOFF(voffG[0], cur);
    if constexpr (SP2) {
        PG8_STAGE(PG8_SB(0, 0), cB, voffB); PG8_STAGE(PG8_SB(0, 1), cB + hstepB, voffB); PG8_STAGE_A(PG8_SA(0, 0), cA, 0, voffG[0][0]); PG8_STAGE_A(PG8_SA(0, 1), cA, 1, voffG[0][1]);
        if (wr == 1) PG8_BAR;
        PG8_WAIT_V(2); PG8_BAR;
        PG8_STAGE(PG8_SB(1, 0), cB + kstep, voffB); PG8_STAGE_A(PG8_SA(1, 0), cA + kstep, 0, voffG[0][0]); PG8_STAGE(PG8_SB(1, 1), cB + hstepB + kstep, voffB);
        PG8_WAIT_V(6); PG8_BAR;
    } else {
        PG8_STAGE(PG8_SB(0, 0), cB, voffB); PG8_STAGE_A(PG8_SA(0, 0), cA, 0, voffG[0][0]); PG8_STAGE(PG8_SB(0, 1), cB + hstepB, voffB); PG8_STAGE_A(PG8_SA(0, 1), cA, 1, voffG[0][1]);
        if (wr == 1) PG8_BAR;
        PG8_WAIT_V(4); PG8_BAR;
        PG8_STAGE(PG8_SB(1, 0), cB + kstep, voffB); PG8_STAGE_A(PG8_SA(1, 0), cA + kstep, 0, voffG[0][0]); PG8_STAGE(PG8_SB(1, 1), cB + hstepB + kstep, voffB);
        PG8_WAIT_V(6); PG8_BAR;
    }
    for (;;) {
        const bool has_next = S.next(ui + 1, nxt);
        if constexpr (Sched::GATHER) { if (has_next) { PG8_GOFF(voffG[1], nxt); } else {
#pragma unroll
            for (int _h = 0; _h < 2; ++_h)
#pragma unroll
                for (int _i = 0; _i < 2; ++_i) voffG[1][_h][_i] = voffG[0][_h][_i]; } }
        const char* nA = has_next ? nxt.pa : cA; const char* nB = has_next ? nxt.pb : cB;
        for (int t = 0; t < nt; t += 2) {
            const bool last = (t == nt - 2);
            const char* a1 = cA + (size_t)(t + 1) * kstep;
            const char* a2 = last ? nA : cA + (size_t)(t + 2) * kstep; const char* b2 = last ? nB : cB + (size_t)(t + 2) * kstep;
            const char* a3 = a2 + kstep; const char* b3 = b2 + kstep;
            unsigned vs0[2], vs1[2];
#pragma unroll
            for (int _i = 0; _i < 2; ++_i) { vs0[_i] = last ? voffG[1][0][_i] : voffG[0][0][_i]; vs1[_i] = last ? voffG[1][1][_i] : voffG[0][1][_i]; }
            if (last && has_next) S.a_ready(nxt);
            if constexpr (SP2) {
            PG8_LDB(B0, 0, 0); PG8_LDB(B1, 0, 1); PG8_SCHED; PG8_LDA(At, 0, 0); PG8_STAGE_A(PG8_SA(1, 1), a1, 1, voffG[0][1]);
            PG8_WAIT_V(8); PG8_WAIT_L(0); PG8_BAR; PG8_MMA(0, 0, At, B0); PG8_MMA(0, 1, At, B1); PG8_BAR; PG8_SCHED;
            PG8_LDA(At, 0, 1); PG8_STAGE(PG8_SB(0, 0), b2, voffB); PG8_STAGE(PG8_SB(0, 1), b2 + hstepB, voffB); PG8_STAGE_A(PG8_SA(0, 0), a2, 0, vs0);
            PG8_WAIT_V(8); PG8_WAIT_L(0); PG8_BAR; PG8_MMA(1, 0, At, B0); PG8_MMA(1, 1, At, B1); PG8_BAR; PG8_SCHED;
            PG8_LDB(B0, 1, 0); PG8_LDB(B1, 1, 1); PG8_SCHED; PG8_LDA(At, 1, 0); PG8_STAGE_A(PG8_SA(0, 1), a2, 1, vs1);
            PG8_WAIT_V(8); PG8_WAIT_L(0); PG8_BAR; PG8_MMA(0, 0, At, B0); PG8_MMA(0, 1, At, B1); PG8_BAR; PG8_SCHED;
            PG8_LDA(At, 1, 1); PG8_STAGE(PG8_SB(1, 0), b3, voffB); PG8_STAGE(PG8_SB(1, 1), b3 + hstepB, voffB); PG8_STAGE_A(PG8_SA(1, 0), a3, 0, vs0);
            PG8_WAIT_V(8); PG8_WAIT_L(0); PG8_BAR; PG8_MMA(1, 0, At, B0); PG8_MMA(1, 1, At, B1); PG8_BAR; PG8_SCHED;
            } else {
            PG8_LDB(B0, 0, 0); PG8_SCHED; PG8_LDA(At, 0, 0); PG8_STAGE_A(PG8_SA(1, 1), a1, 1, voffG[0][1]);
            PG8_WAIT_L(8); PG8_BAR; PG8_WAIT_L(0); PG8_MMA(0, 0, At, B0); PG8_BAR; PG8_SCHED;
            PG8_LDB(B1, 0, 1); PG8_STAGE(PG8_SB(0, 0), b2, voffB);
            PG8_BAR; PG8_WAIT_L(0); PG8_MMA(0, 1, At, B1); PG8_BAR;
            PG8_LDA(At, 0, 1); PG8_STAGE_A(PG8_SA(0, 0), a2, 0, vs0);
            PG8_BAR; PG8_WAIT_L(0); PG8_MMA(1, 0, At, B0); PG8_BAR; PG8_SCHED;
            PG8_STAGE(PG8_SB(0, 1), b2 + hstepB, voffB);
            PG8_WAIT_V(6); PG8_BAR; PG8_MMA(1, 1, At, B1); PG8_BAR;
            PG8_LDB(B0, 1, 0); PG8_SCHED; PG8_LDA(At, 1, 0); PG8_STAGE_A(PG8_SA(0, 1), a2, 1, vs1);
            PG8_WAIT_L(8); PG8_BAR; PG8_WAIT_L(0); PG8_MMA(0, 0, At, B0); PG8_BAR; PG8_SCHED;
            PG8_LDB(B1, 1, 1); PG8_STAGE(PG8_SB(1, 0), b3, voffB);
            PG8_BAR; PG8_WAIT_L(0); PG8_MMA(0, 1, At, B1); PG8_BAR;
            PG8_LDA(At, 1, 1); PG8_STAGE_A(PG8_SA(1, 0), a3, 0, vs0);
            PG8_BAR; PG8_WAIT_L(0); PG8_MMA(1, 0, At, B0); PG8_BAR; PG8_SCHED;
            PG8_STAGE(PG8_SB(1, 1), b3 + hstepB, voffB);
            PG8_WAIT_V(6); PG8_BAR; PG8_MMA(1, 1, At, B1); PG8_BAR;
            }
        }
        if constexpr (ALIGN_EPI) { if (wr == 0) PG8_BAR; }
        if constexpr (!Epi::AFTER_DRAIN) { E(acc, cur, wr, wc, fr, fq); S.done(cur); }
        if (!has_next) break;
#pragma unroll
        for (int a = 0; a < 2; ++a)
#pragma unroll
            for (int b = 0; b < 2; ++b)
#pragma unroll
                for (int m = 0; m < 4; ++m)
#pragma unroll
                    for (int n = 0; n < 2; ++n) acc[a][b][m][n] = (f32x4){0.f, 0.f, 0.f, 0.f};
        cur = nxt; cA = nA; cB = nB; ++ui;
        if constexpr (Sched::GATHER) {
#pragma unroll
            for (int _h = 0; _h < 2; ++_h)
#pragma unroll
                for (int _i = 0; _i < 2; ++_i) voffG[0][_h][_i] = voffG[1][_h][_i]; }
        if constexpr (ALIGN_EPI) { if (wr == 1) PG8_BAR; }
    }
    PG8_WAIT_V(0);
    if constexpr (!ALIGN_EPI) { if (wr == 0) PG8_BAR; }
    PG8_BAR;
    if constexpr (Epi::AFTER_DRAIN) { E.fused(acc, cur, wr, wc, fr, fq, lds, wid, lane); S.done(cur); }
#undef PG8_SA
#undef PG8_SB
#undef PG8_STAGE
#undef PG8_STAGE_A
#undef PG8_GOFF
#undef PG8_LDA
#undef PG8_LDB
#undef PG8_MMA
#undef PG8_WAIT_V
#undef PG8_WAIT_L
#undef PG8_BAR
#undef PG8_SCHED
}

}
#define WSYNC2() asm volatile("s_waitcnt lgkmcnt(0)" ::: "memory")
struct MoeBufs { int* tok_e; float* tok_g; int* slot_of; float* slot_gate; int* blk_e; int* blkcnt; int* nblk; int* slot_tok; };
constexpr int WRT_LD = 1028;

template <bool XB, int MODE = 0> __device__ __forceinline__ void ph_ln_router(const void* xin_, const bf16_t* hb, const float* g, const float* bb, const float* wr, const float* br, bf16_t* x1b, const MoeBufs m, float* lds) {
  const float* xin = (const float*)xin_; const bf16_t* xinb = (const bf16_t*)xin_;
  for (int i = BIDX() * NTHR + TIDX(); i < PMAX; i += (int)gridDim.x * NTHR) m.slot_tok[i] = 0;
  const int tid = TIDX(), lane = tid & 63, wave = tid >> 6, blk = BIDX();
  float* wT = lds;
  float* lg = lds + 32 * WRT_LD + wave * 64;
  int* cnt = (int*)(lds + 32 * WRT_LD + 8 * 64);
  f32x4 raf[2][4]; v2u rab[2][4], rh[2][4];
#define LNR_LOAD(tk) { _Pragma("unroll") for (int q = 0; q < 2; ++q) _Pragma("unroll") for (int j = 0; j < 4; ++j) { const int c = lane * 4 + 256 * j; \
      if (XB) rab[q][j] = *(const v2u*)(xinb + (size_t)((tk) + q) * D + c); else raf[q][j] = *(const f32x4*)(xin + (size_t)((tk) + q) * D + c); \
      rh[q][j] = *(const v2u*)(hb + (size_t)((tk) + q) * D + c); } }
  LNR_LOAD(blk * 64 + wave * 8)
  { f32x4 wv[16];
#pragma unroll
    for (int k = 0; k < 16; ++k) wv[k] = *(const f32x4*)(wr + (size_t)(tid + NTHR * k) * 4);
#pragma unroll
    for (int k = 0; k < 16; ++k) { const int i = (tid + NTHR * k) * 4, d = i >> 5, e = i & 31;
#pragma unroll
      for (int z = 0; z < 4; ++z) wT[(e + z) * WRT_LD + d] = wv[k][z]; } }
  if (tid < 32) cnt[tid] = 0;
  __syncthreads();
#pragma unroll 1
  for (int it = 0; it < 8; it += 2) {
    const int tok0 = blk * 64 + wave * 8 + it;
    f32x4 v[2][4]; float s[2] = {0.f, 0.f};
#pragma unroll
    for (int q = 0; q < 2; ++q)
#pragma unroll
      for (int j = 0; j < 4; ++j) { f32x4 a;
        if (XB) { const v2u xv = rab[q][j]; a = (f32x4){bf_lo(xv[0]), bf_hi(xv[0]), bf_lo(xv[1]), bf_hi(xv[1])}; } else a = raf[q][j];
        const v2u hh = rh[q][j];
        v[q][j] = (f32x4){ALPHA * a[0] + bf_lo(hh[0]), ALPHA * a[1] + bf_hi(hh[0]), ALPHA * a[2] + bf_lo(hh[1]), ALPHA * a[3] + bf_hi(hh[1])}; s[q] += (v[q][j][0] + v[q][j][1]) + (v[q][j][2] + v[q][j][3]); }
    if (it + 2 < 8) LNR_LOAD(tok0 + 2)
#pragma unroll
    for (int o = 1; o < 64; o <<= 1) { s[0] += __shfl_xor(s[0], o); s[1] += __shfl_xor(s[1], o); }
    float qq[2] = {0.f, 0.f};
#pragma unroll
    for (int q = 0; q < 2; ++q) { const float mu = s[q] * (1.f / D);
#pragma unroll
      for (int j = 0; j < 4; ++j) { v[q][j] = v[q][j] - mu; qq[q] += (v[q][j][0] * v[q][j][0] + v[q][j][1] * v[q][j][1]) + (v[q][j][2] * v[q][j][2] + v[q][j][3] * v[q][j][3]); } }
#pragma unroll
    for (int o = 1; o < 64; o <<= 1) { qq[0] += __shfl_xor(qq[0], o); qq[1] += __shfl_xor(qq[1], o); }
#pragma unroll
    for (int q = 0; q < 2; ++q) { const float r = rsqrtf(qq[q] * (1.f / D) + 1e-5f);
#pragma unroll
      for (int j = 0; j < 4; ++j) { const int c = lane * 4 + 256 * j; const f32x4 g4 = *(const f32x4*)(g + c), b4 = *(const f32x4*)(bb + c); v[q][j] = v[q][j] * r * g4 + b4; *(v2u*)(x1b + (size_t)(tok0 + q) * D + c) = (v2u){cvt_pk_bf16(v[q][j][0], v[q][j][1]), cvt_pk_bf16(v[q][j][2], v[q][j][3])}; } }
    if (MODE == 1) continue;
    float p[2][32];
    { const float* wl = wT + lane * 4; f32x4 wb[2][4];
#pragma unroll
      for (int j = 0; j < 4; ++j) wb[0][j] = *(const f32x4*)(wl + 256 * j);
#pragma unroll
      for (int e = 0; e < 32; ++e) {
        if (e < 31) {
#pragma unroll
          for (int j = 0; j < 4; ++j) wb[(e + 1) & 1][j] = *(const f32x4*)(wl + (e + 1) * WRT_LD + 256 * j); }
        __builtin_amdgcn_sched_barrier(0);
        f32x2_t a0 = {0.f, 0.f}, a1 = {0.f, 0.f};
#pragma unroll
        for (int j = 0; j < 4; ++j) { const f32x4 w4 = wb[e & 1][j]; const f32x2_t wlo = {w4[0], w4[1]}, whi = {w4[2], w4[3]};
          a0 = __builtin_elementwise_fma((f32x2_t){v[0][j][0], v[0][j][1]}, wlo, a0); a0 = __builtin_elementwise_fma((f32x2_t){v[0][j][2], v[0][j][3]}, whi, a0);
          a1 = __builtin_elementwise_fma((f32x2_t){v[1][j][0], v[1][j][1]}, wlo, a1); a1 = __builtin_elementwise_fma((f32x2_t){v[1][j][2], v[1][j][3]}, whi, a1); }
        p[0][e] = a0[0] + a0[1]; p[1][e] = a1[0] + a1[1];
        __builtin_amdgcn_sched_barrier(0);
      } }
#pragma unroll
    for (int i = 0; i < 16; ++i) { const bool hi = (lane & 32) != 0;
#pragma unroll
      for (int q = 0; q < 2; ++q) { const float send = hi ? p[q][i] : p[q][i + 16]; const float keep = hi ? p[q][i + 16] : p[q][i]; p[q][i] = keep + __shfl_xor(send, 32); } }
#pragma unroll
    for (int i = 0; i < 8; ++i) { const bool hi = (lane & 16) != 0;
#pragma unroll
      for (int q = 0; q < 2; ++q) { const float send = hi ? p[q][i] : p[q][i + 8]; const float keep = hi ? p[q][i + 8] : p[q][i]; p[q][i] = keep + __shfl_xor(send, 16); } }
#pragma unroll
    for (int i = 0; i < 4; ++i) { const bool hi = (lane & 8) != 0;
#pragma unroll
      for (int q = 0; q < 2; ++q) { const float send = hi ? p[q][i] : p[q][i + 4]; const float keep = hi ? p[q][i + 4] : p[q][i]; p[q][i] = keep + __shfl_xor(send, 8); } }
#pragma unroll
    for (int i = 0; i < 2; ++i) { const bool hi = (lane & 4) != 0;
#pragma unroll
      for (int q = 0; q < 2; ++q) { const float send = hi ? p[q][i] : p[q][i + 2]; const float keep = hi ? p[q][i + 2] : p[q][i]; p[q][i] = keep + __shfl_xor(send, 4); } }
#pragma unroll
    for (int q = 0; q < 2; ++q) { const bool hi = (lane & 2) != 0; const float send = hi ? p[q][0] : p[q][1]; const float keep = hi ? p[q][1] : p[q][0]; p[q][0] = keep + __shfl_xor(send, 2); }
    p[0][0] += __shfl_xor(p[0][0], 1); p[1][0] += __shfl_xor(p[1][0], 1);
    const int e_l = ((lane >> 5) & 1) * 16 + ((lane >> 4) & 1) * 8 + ((lane >> 3) & 1) * 4 + ((lane >> 2) & 1) * 2 + ((lane >> 1) & 1);
    const float brl = br[e_l];
    float lv[2] = {p[0][0] + brl, p[1][0] + brl}; int ei[2][4]; float ev[2][4];
    if (MODE == 2) for (int k = 1; k < 4; ++k) { ei[0][k] = ei[1][k] = k; ev[0][k] = ev[1][k] = 0.f; }
#pragma unroll
    for (int k = 0; k < (MODE == 2 ? 1 : 4); ++k) { float bv[2] = {lv[0], lv[1]}; int bi[2] = {e_l, e_l};
#pragma unroll
      for (int o = 2; o < 64; o <<= 1)
#pragma unroll
        for (int q = 0; q < 2; ++q) { const float ov = __shfl_xor(bv[q], o); const int oi = __shfl_xor(bi[q], o); const bool take = (ov > bv[q]) || (ov == bv[q] && oi < bi[q]); bv[q] = take ? ov : bv[q]; bi[q] = take ? oi : bi[q]; }
#pragma unroll
      for (int q = 0; q < 2; ++q) { ei[q][k] = bi[q]; ev[q][k] = bv[q]; if (e_l == bi[q]) lv[q] = -INFINITY; } }
    if (lane < 2) { const int q = lane;
      float ex[4], su = 0.f;
#pragma unroll
      for (int k = 0; k < 4; ++k) { ex[k] = __expf((q ? ev[1][k] : ev[0][k]) - (q ? ev[1][0] : ev[0][0])); su += ex[k]; }
      const float inv = 1.f / su; const int tok = tok0 + q;
      const int e0 = q ? ei[1][0] : ei[0][0], e1 = q ? ei[1][1] : ei[0][1], e2 = q ? ei[1][2] : ei[0][2], e3 = q ? ei[1][3] : ei[0][3];
      *(int4*)(m.tok_e + tok * 4) = make_int4(e0, e1, e2, e3);
      *(float4*)(m.tok_g + tok * 4) = make_float4(ex[0] * inv, ex[1] * inv, ex[2] * inv, ex[3] * inv);
      atomicAdd(&cnt[e0], 1); atomicAdd(&cnt[e1], 1); atomicAdd(&cnt[e2], 1); atomicAdd(&cnt[e3], 1); }
  }
  __syncthreads();
  if (tid < 32) m.blkcnt[blk * 32 + tid] = cnt[tid];
  __syncthreads();
}

__device__ __forceinline__ void ph_moe_scatter(const MoeBufs m, int* ilds) {
  const int tid = TIDX(), lane = tid & 63, wave = tid >> 6, blk = BIDX(); (void)lane;
  int* tot = ilds; int* bef = ilds + 32; int* pst = ilds + 64; int* es = ilds + 128; int* rk = ilds + 384; int* sl = ilds + 640; int* part = ilds + 896; int* wcnt = ilds + 1408;
  { const int e = tid & 31, pa = tid >> 5; int sum = 0;
#pragma unroll
    for (int q = 0; q < 16; ++q) sum += m.blkcnt[(pa * 16 + q) * 32 + e];
    part[pa * 32 + e] = sum; }
  if (tid < 256) es[tid] = m.tok_e[blk * 256 + tid];
  __syncthreads();
  if (tid < 32) { const int e = tid; int t_ = 0, b_ = 0; const int pb_ = blk >> 4;
    for (int q = 0; q < 16; ++q) { const int v = part[q * 32 + e]; t_ += v; if (q < pb_) b_ += v; }
    for (int q = pb_ * 16; q < blk; ++q) b_ += m.blkcnt[q * 32 + e];
    tot[e] = t_; bef[e] = b_; }
  if (tid < 256) { const int e = es[tid]; const unsigned long long lt = (1ull << lane) - 1ull; int r = 0;
    for (int ee = 0; ee < 32; ++ee) { const unsigned long long mk = __ballot(e == ee); if (e == ee) r = __builtin_popcountll(mk & lt); if (lane == ee) wcnt[wave * 32 + ee] = __builtin_popcountll(mk); }
    rk[tid] = r; }
  __syncthreads();
  if (tid == 0) { int acc = 0; for (int e = 0; e < 32; ++e) { pst[e] = acc; acc += ((tot[e] + 255) >> 8) << 8; } pst[32] = acc;
    if (blk == 0) { *m.nblk = acc >> 8; for (int e = 0; e < 32; ++e) for (int q = pst[e] >> 8; q < (pst[e + 1] >> 8); ++q) m.blk_e[q] = e; } }
  __syncthreads();
  if (tid < 256) { const int e = es[tid]; int rank = rk[tid]; for (int w2 = 0; w2 < wave; ++w2) rank += wcnt[w2 * 32 + e];
    const int slot = pst[e] + bef[e] + rank; m.slot_of[blk * 256 + tid] = slot; m.slot_gate[slot] = m.tok_g[blk * 256 + tid]; m.slot_tok[slot] = blk * 64 + (tid >> 2); }
  __syncthreads();
  __syncthreads();
}

__device__ __forceinline__ void ph_combine_ln(const bf16_t* x1b, const bf16_t* Ys, const int* slot_of, const float* g, const float* bb, float* out, bf16_t* outb) {
  const int tid = TIDX(), lane = tid & 63, gw = BIDX() * 8 + (tid >> 6), NGW = (int)gridDim.x * 8;
  f32x4 g4[4], b4[4];
#pragma unroll
  for (int j = 0; j < 4; ++j) { const int c = lane * 4 + 256 * j; g4[j] = *(const f32x4*)(g + c); b4[j] = *(const f32x4*)(bb + c); }
  v2u ys[4][4], xs[4];
#define CLN_RAW(r_, s_) { const int sl_[4] = {(s_).x, (s_).y, (s_).z, (s_).w}; _Pragma("unroll") for (int j = 0; j < 4; ++j) { const int c = lane * 4 + 256 * j; \
    _Pragma("unroll") for (int k = 0; k < 4; ++k) ys[j][k] = *(const v2u*)(Ys + (size_t)sl_[k] * D + c); xs[j] = *(const v2u*)(x1b + (size_t)(r_) * D + c); } }
  int row = gw;
  if (row >= NT) return;
  int4 s4n;
  { const int4 s4 = *(const int4*)(slot_of + row * 4); CLN_RAW(row, s4) s4n = *(const int4*)(slot_of + (row + NGW < NT ? row + NGW : row) * 4); }
#pragma unroll 1
  for (; row < NT; row += NGW) {
    f32x4 v[4]; float s = 0.f;
#pragma unroll
    for (int j = 0; j < 4; ++j) { f32x4 f = (f32x4){0.f, 0.f, 0.f, 0.f};
#pragma unroll
      for (int k = 0; k < 4; ++k) { const v2u y = ys[j][k]; f += (f32x4){bf_lo(y[0]), bf_hi(y[0]), bf_lo(y[1]), bf_hi(y[1])}; }
      const v2u xv = xs[j]; const f32x4 a = (f32x4){bf_lo(xv[0]), bf_hi(xv[0]), bf_lo(xv[1]), bf_hi(xv[1])}; v[j] = a * ALPHA + f; s += (v[j][0] + v[j][1]) + (v[j][2] + v[j][3]); }
    if (row + NGW < NT) { const int4 s4 = s4n; CLN_RAW(row + NGW, s4) s4n = *(const int4*)(slot_of + (row + 2 * NGW < NT ? row + 2 * NGW : row) * 4); }
    const float mu = wave_sum(s) * (1.f / D); float q = 0.f;
#pragma unroll
    for (int j = 0; j < 4; ++j) { v[j] = v[j] - mu; q += (v[j][0] * v[j][0] + v[j][1] * v[j][1]) + (v[j][2] * v[j][2] + v[j][3] * v[j][3]); }
    const float r = rsqrtf(wave_sum(q) * (1.f / D) + 1e-5f);
#pragma unroll
    for (int j = 0; j < 4; ++j) { const int c = lane * 4 + 256 * j; const f32x4 o = v[j] * r * g4[j] + b4[j];
      if (out) *(f32x4*)(out + (size_t)row * D + c) = o; if (outb) *(v2u*)(outb + (size_t)row * D + c) = (v2u){cvt_pk_bf16(o[0], o[1]), cvt_pk_bf16(o[2], o[3])}; }
  }
#undef CLN_RAW
}

namespace pg8 {
template <bool GATHER_> struct MoeOrderT {
    static constexpr bool GATHER = GATHER_; const int* rowmap;
    StaticOrder so; const int* blk_e; const char* W; size_t wexp; int obn;
    __device__ void init(const void* A, int lda, const void* W_, int ldb, size_t wexp_, int nM, int nN, int obn_, const int* blk_e_, int G, int c) { so.init(A, lda, W_, ldb, nM * BM, nN * BM, G, c); blk_e = blk_e_; W = (const char*)W_; wexp = wexp_; obn = obn_; }
    __device__ bool next(int i, Unit& u) const { int pm, pn; if (!so.tile(i, pm, pn)) return false; const int e = __builtin_amdgcn_readfirstlane(blk_e[pm]); u.pa = GATHER_ ? so.A : so.A + (size_t)pm * so.ta; u.pb = W + (size_t)e * wexp + (size_t)pn * so.tb; u.orow = pm * BM; u.ocol = pn * obn; u.e = e; u.kind = 0; return true; }
    __device__ __forceinline__ int rowof(const Unit&, int r) const { return GATHER_ ? rowmap[r] : r; }
    __device__ __forceinline__ void a_ready(const Unit&) const {}
    __device__ __forceinline__ void done(const Unit&) const {}
};
typedef MoeOrderT<false> MoeOrder; typedef MoeOrderT<true> MoeOrderG;
struct EpiSwiglu {
    static constexpr bool PERM = true, AFTER_DRAIN = false;
    bf16_t* O; int ldc; const float* b1;
    __device__ __forceinline__ void operator()(const f32x4 (&acc)[2][2][4][2], const Unit& u, int wr, int wc, int fr, int fq) const {
        const int row0 = u.orow + wr * 64 + fr, cl = wc * 32 + 8 * fq, col0 = u.ocol + cl;
        const float* bg = b1 + (size_t)u.e * 2048 + col0; const float* bu = bg + 1024;
        const f32x4 bg0 = *(const f32x4*)bg, bg1 = *(const f32x4*)(bg + 4), bu0 = *(const f32x4*)bu, bu1 = *(const f32x4*)(bu + 4);
#pragma unroll
        for (int ai = 0; ai < 2; ++ai)
#pragma unroll
            for (int m = 0; m < 4; ++m) {
                f32x4 gv[2] = {acc[ai][0][m][0] + bg0, acc[ai][0][m][1] + bg1}, uv[2] = {acc[ai][1][m][0] + bu0, acc[ai][1][m][1] + bu1}; float o[8];
#pragma unroll
                for (int n = 0; n < 2; ++n)
#pragma unroll
                    for (int i = 0; i < 4; ++i) { const float gg = fminf(gv[n][i], 7.f), uu = fminf(fmaxf(uv[n][i], -7.f), 7.f);
                        const float sg = __builtin_amdgcn_rcpf(1.f + __builtin_amdgcn_exp2f(-1.702f * 1.4426950408889634f * gg)); o[4 * n + i] = (uu + 1.f) * gg * sg; }
                u32x4 w; w.x = cvt_pk_bf16(o[0], o[1]); w.y = cvt_pk_bf16(o[2], o[3]); w.z = cvt_pk_bf16(o[4], o[5]); w.w = cvt_pk_bf16(o[6], o[7]);
                *(u32x4*)(O + (size_t)(row0 + ai * HALF + m * 16) * ldc + col0) = w; asm volatile("" ::: "memory"); }
    }
};
struct EpiMoe2 {
    static constexpr bool PERM = true, AFTER_DRAIN = false;
    bf16_t* O; int ldc; const float* b2; const float* gate;
    __device__ __forceinline__ void operator()(const f32x4 (&acc)[2][2][4][2], const Unit& u, int wr, int wc, int fr, int fq) const {
        const int row0 = u.orow + wr * 64 + fr, col0 = u.ocol + wc * 32 + 8 * fq;
        const float* bp = b2 + (size_t)u.e * 1024 + col0;
        f32x4 bv[2][2]; float gts[2][4];
#pragma unroll
        for (int bj = 0; bj < 2; ++bj) { bv[bj][0] = *(const f32x4*)(bp + bj * HALF); bv[bj][1] = *(const f32x4*)(bp + bj * HALF + 4); }
#pragma unroll
        for (int ai = 0; ai < 2; ++ai)
#pragma unroll
            for (int m = 0; m < 4; ++m) gts[ai][m] = gate[row0 + ai * HALF + m * 16];
#pragma unroll
        for (int bj = 0; bj < 2; ++bj) {
            const f32x4 bv0 = bv[bj][0], bv1 = bv[bj][1];
#pragma unroll
            for (int ai = 0; ai < 2; ++ai)
#pragma unroll
                for (int m = 0; m < 4; ++m) { const int row = row0 + ai * HALF + m * 16; const float gt = gts[ai][m];
                    const f32x4 v0 = (acc[ai][bj][m][0] + bv0) * gt, v1 = (acc[ai][bj][m][1] + bv1) * gt;
                    u32x4 w; w.x = cvt_pk_bf16(v0[0], v0[1]); w.y = cvt_pk_bf16(v0[2], v0[3]); w.z = cvt_pk_bf16(v1[0], v1[1]); w.w = cvt_pk_bf16(v1[2], v1[3]);
                    *(u32x4*)(O + (size_t)row * ldc + col0 + bj * HALF) = w; asm volatile("" ::: "memory"); }
        }
    }
};

struct MoeFusedOrder {
    static constexpr bool GATHER = true;
    const int* rowmap; const int* blk_e; const char* X; const char* ACT; const char* W1; const char* W2; unsigned* ready; unsigned* tmo; int nblk, NG, G, c, total, mode;
    __device__ void init(const void* X_, const void* ACT_, const void* W1_, const void* W2_, const int* rowmap_, const int* blk_e_, unsigned* ready_, unsigned* tmo_, int nblk_, int G_, int c_) {
        X = (const char*)X_; ACT = (const char*)ACT_; W1 = (const char*)W1_; W2 = (const char*)W2_; rowmap = rowmap_; blk_e = blk_e_; ready = ready_; tmo = tmo_; nblk = nblk_; NG = (nblk_ + 31) >> 5; G = G_; c = c_; total = nblk_ * 12; }
    __device__ bool next(int i, Unit& u) const {
        int Lq = i * G + c; if (Lq >= total) return false;
#if defined(FUSE_SPLIT)
        if (c >= 0) { const int kind = mode - 1; if (Lq >= nblk * (kind ? 4 : 8)) return false; const int q = Lq; const int pm = q % nblk, pn = q / nblk, e = __builtin_amdgcn_readfirstlane(blk_e[pm]);
          u.kind = kind; u.e = e; u.orow = pm * BM;
          if (kind == 0) { u.pa = X; u.pb = W1 + ((size_t)e * 2048 + (size_t)pn * 256) * 2048; u.ocol = pn * 128; }
          else { u.pa = ACT; u.pb = W2 + ((size_t)e * 1024 + (size_t)pn * 256) * 2048; u.ocol = pn * 256; }
          return true; }
#endif
#if defined(FUSE_SERIAL)
        { const int n1 = nblk * 8; int kind = Lq < n1 ? 0 : 1; int q = kind ? Lq - n1 : Lq; const int pm = q % nblk, pn = q / nblk, e = __builtin_amdgcn_readfirstlane(blk_e[pm]);
          u.kind = kind; u.e = e; u.orow = pm * BM;
          if (kind == 0) { u.pa = X; u.pb = W1 + ((size_t)e * 2048 + (size_t)pn * 256) * 2048; u.ocol = pn * 128; }
          else { u.pa = ACT; u.pb = W2 + ((size_t)e * 1024 + (size_t)pn * 256) * 2048; u.ocol = pn * 256; }
          return true; }
#endif
        int kind = 0, g = 0;
        for (int sgm = 0; ; ++sgm) {
            if (sgm < 3) { kind = 0; g = sgm; }
            else if (sgm < 3 + 2 * (NG - 3)) { const int j = (sgm - 3) >> 1; if (((sgm - 3) & 1) == 0) { kind = 0; g = j + 3; } else { kind = 1; g = j; } }
            else { kind = 1; g = NG - 3 + (sgm - (3 + 2 * (NG - 3))); }
            const int mg = min(32, nblk - 32 * g), sz = mg * (kind ? 4 : 8);
            if (Lq < sz) { const int pm = 32 * g + Lq % mg, pn = Lq / mg, e = __builtin_amdgcn_readfirstlane(blk_e[pm]);
                u.kind = kind; u.e = e; u.orow = pm * BM;
                if (kind == 0) { u.pa = X; u.pb = W1 + ((size_t)e * 2048 + (size_t)pn * 256) * 2048; u.ocol = pn * 128; }
                else { u.pa = ACT; u.pb = W2 + ((size_t)e * 1024 + (size_t)pn * 256) * 2048; u.ocol = pn * 256; }
                return true; }
            Lq -= sz;
        }
    }
    __device__ __forceinline__ int rowof(const Unit& u, int r) const { return u.kind == 0 ? rowmap[r] : r; }
    __device__ __forceinline__ void a_ready(const Unit& u) const {
        if (u.kind == 0) return;
#if defined(FUSE_SPLIT)
        return;
#endif
        if (threadIdx.x < 64) {
#if defined(FUSE_GLOBAL_WAIT)
            const unsigned long long t0 = __builtin_amdgcn_s_memrealtime(); unsigned polls = 0; unsigned* rp = ready + 64 * 500; const unsigned want = (unsigned)nblk * 64u;
#else
            const unsigned long long t0 = __builtin_amdgcn_s_memrealtime(); unsigned polls = 0; unsigned* rp = ready + 64 * (u.orow >> 8); const unsigned want = 64u;
#endif
            while ((unsigned)__builtin_amdgcn_readfirstlane(__hip_atomic_load(rp, __ATOMIC_RELAXED, __HIP_MEMORY_SCOPE_AGENT)) < want) {
                if ((++polls & 255u) == 0u && __builtin_amdgcn_readfirstlane(__hip_atomic_load(tmo, __ATOMIC_RELAXED, __HIP_MEMORY_SCOPE_AGENT)) != 0u) break;
                if (__builtin_amdgcn_s_memrealtime() - t0 > 2000000ull) { if (threadIdx.x == 0) __hip_atomic_store(tmo, 1u, __ATOMIC_RELAXED, __HIP_MEMORY_SCOPE_AGENT); break; }
                __builtin_amdgcn_s_sleep(2); }
#if defined(FUSE_CONSUMER_WB)
            __builtin_amdgcn_fence(__ATOMIC_RELEASE, "agent"); asm volatile("s_waitcnt vmcnt(0)" ::: "memory");
#endif
#if defined(FUSE_DELAY)
            { const unsigned long long t1 = __builtin_amdgcn_s_memrealtime(); while (__builtin_amdgcn_s_memrealtime() - t1 < 2000ull) __builtin_amdgcn_s_sleep(8); }
#endif
            __builtin_amdgcn_fence(__ATOMIC_ACQUIRE, "agent");
            asm volatile("s_waitcnt vmcnt(0)" ::: "memory");
        }
        asm volatile("" ::: "memory"); __builtin_amdgcn_s_barrier(); asm volatile("" ::: "memory");
    }
    __device__ __forceinline__ void done(const Unit& u) const {
        if (u.kind != 0) return;
        asm volatile("s_waitcnt vmcnt(0)" ::: "memory");
#if defined(FUSE_HEAVY_RELEASE)
        __builtin_amdgcn_fence(__ATOMIC_RELEASE, "agent"); asm volatile("s_waitcnt vmcnt(0)" ::: "memory");
#endif
#if defined(FUSE_GLOBAL_WAIT)
        if ((threadIdx.x & 63) == 0) __hip_atomic_fetch_add(ready + 64 * 500, 1u, __ATOMIC_RELAXED, __HIP_MEMORY_SCOPE_AGENT);
#else
        if ((threadIdx.x & 63) == 0) __hip_atomic_fetch_add(ready + 64 * (u.orow >> 8), 1u, __ATOMIC_RELAXED, __HIP_MEMORY_SCOPE_AGENT);
#endif
    }
};
__device__ __forceinline__ void store16_sc1(void* p, u32x4 v) { asm volatile("global_store_dwordx4 %0, %1, off sc1\n\ts_nop 1" :: "v"(p), "v"(v) : "memory"); }
struct EpiMoeFused {
    static constexpr bool PERM = true, AFTER_DRAIN = false;
    bf16_t* ACTo; const float* b1; bf16_t* Yo; const float* b2; const float* gate;
    __device__ __forceinline__ void operator()(const f32x4 (&acc)[2][2][4][2], const Unit& u, int wr, int wc, int fr, int fq) const {
        if (u.kind == 0) {
            const int row0 = u.orow + wr * 64 + fr, cl = wc * 32 + 8 * fq, col0 = u.ocol + cl;
            const float* bg = b1 + (size_t)u.e * 2048 + col0; const float* bu = bg + 1024;
            const f32x4 bg0 = *(const f32x4*)bg, bg1 = *(const f32x4*)(bg + 4), bu0 = *(const f32x4*)bu, bu1 = *(const f32x4*)(bu + 4);
#pragma unroll
            for (int ai = 0; ai < 2; ++ai)
#pragma unroll
                for (int m = 0; m < 4; ++m) {
                    f32x4 gv[2] = {acc[ai][0][m][0] + bg0, acc[ai][0][m][1] + bg1}, uv[2] = {acc[ai][1][m][0] + bu0, acc[ai][1][m][1] + bu1}; float o[8];
#pragma unroll
                    for (int n = 0; n < 2; ++n)
#pragma unroll
                        for (int i = 0; i < 4; ++i) { const float gg = fminf(gv[n][i], 7.f), uu = fminf(fmaxf(uv[n][i], -7.f), 7.f);
                            const float sg = __builtin_amdgcn_rcpf(1.f + __builtin_amdgcn_exp2f(-1.702f * 1.4426950408889634f * gg)); o[4 * n + i] = (uu + 1.f) * gg * sg; }
                    u32x4 w; w.x = cvt_pk_bf16(o[0], o[1]); w.y = cvt_pk_bf16(o[2], o[3]); w.z = cvt_pk_bf16(o[4], o[5]); w.w = cvt_pk_bf16(o[6], o[7]);
#if defined(FUSE_PLAIN_STORE)
                    *(u32x4*)(ACTo + (size_t)(row0 + ai * HALF + m * 16) * 1024 + col0) = w; }
#else
                    store16_sc1(ACTo + (size_t)(row0 + ai * HALF + m * 16) * 1024 + col0, w); }
#endif
        } else {
            const int row0 = u.orow + wr * 64 + fr, col0 = u.ocol + wc * 32 + 8 * fq;
            const float* bp = b2 + (size_t)u.e * 1024 + col0;
#pragma unroll
            for (int bj = 0; bj < 2; ++bj) {
                const f32x4 bv0 = *(const f32x4*)(bp + bj * HALF), bv1 = *(const f32x4*)(bp + bj * HALF + 4);
#pragma unroll
                for (int ai = 0; ai < 2; ++ai)
#pragma unroll
                    for (int m = 0; m < 4; ++m) { const int row = row0 + ai * HALF + m * 16; const float gt = gate[row];
                        const f32x4 v0 = (acc[ai][bj][m][0] + bv0) * gt, v1 = (acc[ai][bj][m][1] + bv1) * gt;
                        u32x4 w; w.x = cvt_pk_bf16(v0[0], v0[1]); w.y = cvt_pk_bf16(v0[2], v0[3]); w.z = cvt_pk_bf16(v1[0], v1[1]); w.w = cvt_pk_bf16(v1[2], v1[3]);
                        *(u32x4*)(Yo + (size_t)row * 1024 + col0 + bj * HALF) = w; asm volatile("" ::: "memory"); }
            }
        }
    }
};
}
typedef short v4i16_t __attribute__((ext_vector_type(4)));
__device__ __forceinline__ unsigned f2key_u(float f) { f = f + 0.0f; const unsigned u = __float_as_uint(f); return (u & 0x80000000u) ? ~u : (u | 0x80000000u); }

__device__ __forceinline__ void ph_cnorm_b(const bf16_t* pa, const float* g, bf16_t* cnb) {
  const int tid = TIDX(), lane = tid & 63, gw = BIDX() * 8 + (tid >> 6), NGW = (int)gridDim.x * 8;
  const f32x4 g4 = *(const f32x4*)(g + lane * 4);
  for (int row = gw; row < NT; row += NGW) {
    const v2u v = *(const v2u*)(pa + (size_t)row * 2048 + 1024 + lane * 4);
    const f32x4 f = (f32x4){bf_lo(v[0]), bf_hi(v[0]), bf_lo(v[1]), bf_hi(v[1])};
    const float r = rsqrtf(wave_sum((f[0] * f[0] + f[1] * f[1]) + (f[2] * f[2] + f[3] * f[3])) * (1.f / 256.f) + 1e-6f);
    const f32x4 o = f * r * g4;
    *(v2u*)(cnb + (size_t)row * 256 + lane * 4) = (v2u){cvt_pk_bf16(o[0], o[1]), cvt_pk_bf16(o[2], o[3])};
  }
}

__device__ __forceinline__ int moe_layer_tile(int layer, int j) { return j < 8192 ? layer * 8192 + j : 16384 + layer * 4096 + (j - 8192); }
template <int NOST = 0> __device__ __forceinline__ void moe_weight_tile(int T, const float* w1, const float* w2, bf16_t* W1_t, bf16_t* W2_t, int lane, LAS unsigned char* stage, unsigned* sink = nullptr) {
  if (T < 16384) { const int le = T >> 8; transpose_tile<NOST>(mk_tjob(w1 + (size_t)le * D * 2048, 2048, D, 2048, W1_t + (size_t)le * 2048 * D, D, 0, 0, 1), T & 255, lane, stage, sink); }
  else if (T < 24576) { const int t2 = T - 16384, le = t2 >> 7; transpose_tile<NOST>(mk_tjob(w2 + (size_t)le * D * D, D, D, D, W2_t + (size_t)le * D * D, D, 0, 0, 0), t2 & 127, lane, stage, sink); }
}
typedef _Float16 h16x2_t __attribute__((ext_vector_type(2)));
typedef int i32x4_t __attribute__((ext_vector_type(4)));
__device__ __forceinline__ unsigned cvt_pk_f16(float lo, float hi) { const f32x2_t v = {lo, hi}; const h16x2_t h = __builtin_convertvector(v, h16x2_t); return __builtin_bit_cast(unsigned, h); }
constexpr int ISC_NU = 1088;
__device__ __forceinline__ void isc_decode(unsigned u, int& b, int& j, int& c) { b = (int)(u / 544u); int v = (int)u - b * 544; j = 63; while (v >= ((j + 4) >> 2)) { v -= (j + 4) >> 2; --j; } c = v; }
template <int HOT = 0> __device__ __forceinline__ void ph_iscore(const bf16_t* pa, const bf16_t* kib, unsigned short* sc, unsigned* ctr, LAS unsigned char* lds) {
  const int tid = TIDX(), lane = tid & 63, wave = __builtin_amdgcn_readfirstlane(tid >> 6);
  const int n16 = lane & 15, g = lane >> 4;
  volatile LAS unsigned* slot = (volatile LAS unsigned*)(lds + MISC_OFF + 80);
  __syncthreads();
  if (tid == 0) { slot[0] = __hip_atomic_fetch_add(ctr, 1u, __ATOMIC_RELAXED, __HIP_MEMORY_SCOPE_AGENT); slot[1] = __hip_atomic_fetch_add(ctr, 1u, __ATOMIC_RELAXED, __HIP_MEMORY_SCOPE_AGENT); }
  __syncthreads();
  unsigned cur = slot[0], nxt = slot[1];
  __syncthreads();
  const unsigned lofs = (unsigned)(n16 * 128 + 16 * (g ^ (n16 >> 1))), lofs1 = (unsigned)(n16 * 128 + 16 * ((4 + g) ^ (n16 >> 1)));
#define ISC_DMA(u_, pb_) { int b_, j_, c_; isc_decode((u_), b_, j_, c_); const bf16_t* src0 = kib + (size_t)(b_ * L + 512 * c_) * 64; \
    _Pragma("unroll") for (int i = 0; i < 8; ++i) { const int rl = 8 * (8 * wave + i) + (lane >> 3), ch = (lane & 7) ^ ((rl >> 1) & 7); \
      __builtin_amdgcn_global_load_lds((const unsigned*)(src0 + (size_t)rl * 64 + ch * 8), (LAS unsigned*)(lds + (pb_) * 65536 + (8 * wave + i) * 1024), 16, 0, 0); } }
  int pb = 0;
  bf16x8 qn[8][2], wvn;
#define ISC_QLOAD(u_) { int b_, j_, c_; isc_decode((u_), b_, j_, c_); const bf16_t* qr_ = pa + (size_t)(b_ * L + (8 * j_ + wave) * 16 + n16) * 2048; wvn = *(const bf16x8*)(qr_ + 1856); \
    _Pragma("unroll") for (int h = 0; h < 8; ++h) { qn[h][0] = *(const bf16x8*)(qr_ + 1280 + h * 64 + 8 * g); qn[h][1] = *(const bf16x8*)(qr_ + 1280 + h * 64 + 32 + 8 * g); } }
  if (cur < (unsigned)ISC_NU) { ISC_DMA(cur, 0) ISC_QLOAD(cur) }
  asm volatile("s_waitcnt vmcnt(0)" ::: "memory");
  __syncthreads();
  int itp = 0;
#pragma unroll 1
  while (cur < (unsigned)ISC_NU) {
    bf16x8 qf[8][2]; float w[8];
#pragma unroll
    for (int h = 0; h < 8; ++h) { qf[h][0] = qn[h][0]; qf[h][1] = qn[h][1]; w[h] = bf2f((bf16_t)wvn[h]) * (0.35355339059327373f * 0.125f); }
    if (nxt < (unsigned)ISC_NU) { ISC_DMA(nxt, pb ^ 1) ISC_QLOAD(nxt) }
    unsigned grabbed = 0u; if (tid == 0) grabbed = __hip_atomic_fetch_add(ctr, 1u, __ATOMIC_RELAXED, __HIP_MEMORY_SCOPE_AGENT);
    int b, j, c; isc_decode(cur, b, j, c);
    const int qg = 8 * j + wave, t0 = qg * 16, ntl = min(32, qg + 1 - 32 * c);
    unsigned short* srow = sc + (size_t)(HOT ? ((t0 + n16) & 63) : (b * L + t0 + n16)) * L + 4 * g + 32 * c * 16;
    const LAS unsigned char* kb0 = lds + pb * 65536 + lofs; const LAS unsigned char* kb1 = lds + pb * 65536 + lofs1;
#pragma unroll 1
    for (int tl = 0; tl < ntl; tl += 4) {
      bf16x8 k0[4], k1[4];
#pragma unroll
      for (int p = 0; p < 4; ++p) { k0[p] = *(const LAS bf16x8*)(kb0 + (tl + p) * 2048); k1[p] = *(const LAS bf16x8*)(kb1 + (tl + p) * 2048); }
#pragma unroll
      for (int p = 0; p < 4; ++p) {
        f32x4 score = (f32x4){0.f, 0.f, 0.f, 0.f};
#pragma unroll
        for (int h = 0; h < 8; h += 2) {
          f32x4 acc0 = __builtin_amdgcn_mfma_f32_16x16x32_bf16(k0[p], qf[h][0], (f32x4){0.f, 0.f, 0.f, 0.f}, 0, 0, 0);
          f32x4 acc1 = __builtin_amdgcn_mfma_f32_16x16x32_bf16(k0[p], qf[h + 1][0], (f32x4){0.f, 0.f, 0.f, 0.f}, 0, 0, 0);
          acc0 = __builtin_amdgcn_mfma_f32_16x16x32_bf16(k1[p], qf[h][1], acc0, 0, 0, 0);
          acc1 = __builtin_amdgcn_mfma_f32_16x16x32_bf16(k1[p], qf[h + 1][1], acc1, 0, 0, 0);
          const f32x4 r0 = __builtin_bit_cast(f32x4, __builtin_elementwise_max(__builtin_bit_cast(i32x4_t, acc0), (i32x4_t){0, 0, 0, 0}));
          const f32x4 r1 = __builtin_bit_cast(f32x4, __builtin_elementwise_max(__builtin_bit_cast(i32x4_t, acc1), (i32x4_t){0, 0, 0, 0}));
#pragma unroll
          for (int i = 0; i < 4; ++i) score[i] = fmaf(r1[i], w[h + 1], fmaf(r0[i], w[h], score[i]));
        }
        if (tl + p < ntl) *(v2u*)(srow + (tl + p) * 16) = (v2u){cvt_pk_f16(score[0], score[1]), cvt_pk_f16(score[2], score[3])};
      }
    }
    if (tid == 0) slot[itp] = grabbed;
    asm volatile("s_waitcnt vmcnt(0)" ::: "memory");
    __syncthreads();
    cur = nxt; nxt = slot[itp]; itp ^= 1; pb ^= 1;
  }
#undef ISC_DMA
#undef ISC_QLOAD
  __syncthreads();
}

constexpr int DW_STRIDE = 17152;
__device__ __forceinline__ unsigned offb(unsigned row, unsigned ch) { return 256u * row + 16u * (ch ^ (((row & 3u) << 2) | ((row >> 2) & 3u))); }
__device__ __forceinline__ void glds16(const void* gsrc, unsigned lds_dst) { unsigned keep;
  asm volatile("s_mov_b32 %0, m0\n\ts_mov_b32 m0, %2\n\ts_nop 0\n\tglobal_load_lds_dwordx4 %1, off\n\ts_mov_b32 m0, %0" : "=&s"(keep) : "v"(gsrc), "s"(lds_dst) : "memory"); }
__device__ __forceinline__ int wave_excl_scan(int v, int lane, int& total) {
  int x = v;
#pragma unroll
  for (int o = 1; o < 64; o <<= 1) { const int y = __shfl_up(x, o); if (lane >= o) x += y; }
  total = __shfl(x, 63); return x - v;
}
#define LDSW() asm volatile("s_waitcnt lgkmcnt(0)" ::: "memory")
__device__ __forceinline__ int wave_incl_scan_dpp(int v, int lane, int& total) {
  int x = v;
  x += __builtin_amdgcn_update_dpp(0, x, 0x111, 0xf, 0xf, true);
  x += __builtin_amdgcn_update_dpp(0, x, 0x112, 0xf, 0xf, true);
  x += __builtin_amdgcn_update_dpp(0, x, 0x114, 0xf, 0xf, true);
  x += __builtin_amdgcn_update_dpp(0, x, 0x118, 0xf, 0xf, true);
  const int t0 = __builtin_amdgcn_readlane(x, 15), t1 = __builtin_amdgcn_readlane(x, 31), t2 = __builtin_amdgcn_readlane(x, 47), t3 = __builtin_amdgcn_readlane(x, 63);
  const int row = lane >> 4;
  x += (row >= 1 ? t0 : 0) + (row >= 2 ? t1 : 0) + (row >= 3 ? t2 : 0);
  total = t0 + t1 + t2 + t3; return x;
}

__device__ __forceinline__ unsigned h2key(unsigned h) { return (h & 0x8000u) ? (~h & 0xFFFFu) : (h | 0x8000u); }
template <int MODE = 0> __device__ __forceinline__ int wave_select(const unsigned short* srow, int t, LAS unsigned char* wl, LAS unsigned short* idx16, int lane) {
  const int n = t + 1;
  if (n <= 256) { for (int i = lane; i < 256; i += 64) idx16[i] = (unsigned short)(i < n ? i : 0); LDSW(); return n; }
  LAS unsigned* hist = (LAS unsigned*)wl;
  { unsigned z = 0u; asm volatile("" : "+v"(z));
    for (int i = lane; i < 1024; i += 64) ((LAS v4u*)hist)[i] = (v4u){z, z, z, z}; }
  unsigned bk[16][4];
#pragma unroll
  for (int hb = 0; hb < 2; ++hb) { v4u f[8]; int lane_l = lane; asm volatile("" : "+v"(lane_l));
#pragma unroll
    for (int grp = 0; grp < 2; ++grp) if ((2 * hb + grp) * 2048 < n) {
#pragma unroll
      for (int k = 0; k < 4; ++k) f[4 * grp + k] = *(const v4u*)(srow + ((8 * hb + 4 * grp + k) * 64 + lane_l) * 8); }
#pragma unroll
    for (int ii = 0; ii < 8; ++ii) { const int i = 8 * hb + ii;
      bk[i][0] = 0u; bk[i][1] = 0u; bk[i][2] = 0u; bk[i][3] = 0u;
      if (i * 512 < n) { const int e0 = (i * 64 + lane_l) * 8;
#pragma unroll
        for (int c = 0; c < 4; ++c) { const unsigned lo = f[ii][c] & 0xFFFFu, hi = f[ii][c] >> 16;
          const unsigned m0 = (e0 + 2 * c <= t) ? 0xFFFFu : 0u, m1 = (e0 + 2 * c + 1 <= t) ? 0xFFFFu : 0u;
          const unsigned b0 = (h2key(lo == 0x8000u ? 0u : lo) >> 4) & m0, b1 = (h2key(hi == 0x8000u ? 0u : hi) >> 4) & m1;
          bk[i][c] = b0 | (b1 << 16); } }
    }
    asm volatile("" ::: "memory"); }
#define BIN_OF(i, c) ((bk[i][(c) >> 1] >> (((c) & 1) * 16)) & 0xFFFFu)
  LDSW();
#if defined(SEL_REP_HIST)
#pragma unroll 1
  for (int rep_ = 0; rep_ < 2; ++rep_) {
  for (int i = lane; i < 1024; i += 64) ((LAS v4u*)hist)[i] = (v4u){0u, 0u, 0u, 0u};
  LDSW();
#endif
#pragma unroll
  for (int i = 0; i < 16; ++i) if (i * 512 < n) {
#pragma unroll
    for (int c = 0; c < 8; ++c) { const unsigned bin = BIN_OF(i, c); __hip_atomic_fetch_add(hist + bin, 1u, __ATOMIC_RELAXED, __HIP_MEMORY_SCOPE_WORKGROUP); }
    asm volatile("" ::: "memory"); }
  LDSW();
#if defined(SEL_REP_HIST)
  }
#endif
  if (MODE == 1) return 0;
  const int bbase = 4096 - 64 * (lane + 1); int ssum = 0;
#pragma unroll 16
  for (int k = 0; k < 64; ++k) ssum += (int)hist[bbase + ((k + lane) & 63)];
  int tot; const int pre = wave_incl_scan_dpp(ssum, lane, tot) - ssum;
  const unsigned long long bal = __ballot(pre < 256 && pre + ssum >= 256);
  const int Ls = (int)__builtin_ctzll(bal);
  const int cum0 = __builtin_amdgcn_readlane(pre, Ls), sb = 4096 - 64 * (Ls + 1);
  const int ck = (int)hist[sb + 63 - lane]; int t2_; const int inc = wave_incl_scan_dpp(ck, lane, t2_);
  const unsigned long long bal2 = __ballot(cum0 + inc >= 256);
  const int kk = (int)__builtin_ctzll(bal2);
  const int B1 = sb + 63 - kk, cnt_gt = cum0 + __builtin_amdgcn_readlane(inc, kk) - __builtin_amdgcn_readlane(ck, kk), need1 = 256 - cnt_gt;
  LDSW();
  if (MODE == 2) { idx16[lane] = (unsigned short)(B1 + need1); return 0; }
  const unsigned kg = (0x7FFFu - (unsigned)B1) * 0x00010001u, kge = kg + 0x00010001u;
  int ngt = 0, neq = 0;
#pragma unroll
  for (int i = 0; i < 16; ++i) if (i * 512 < n) {
#pragma unroll
    for (int c2 = 0; c2 < 4; ++c2) { const unsigned x = bk[i][c2], fg = (x + kg) & 0x80008000u, fe = ((x + kge) & 0x80008000u) & ~fg; ngt += __builtin_popcount(fg); neq += __builtin_popcount(fe); } }
  int tg, te; int pg = wave_incl_scan_dpp(ngt, lane, tg) - ngt; int pe = wave_incl_scan_dpp(neq, lane, te) - neq;
  LAS unsigned short* cand = (LAS unsigned short*)wl;
#pragma unroll
  for (int i = 0; i < 16; ++i) if (i * 512 < n) {
#pragma unroll
    for (int c2 = 0; c2 < 4; ++c2) { const unsigned x = bk[i][c2], fg = (x + kg) & 0x80008000u, fe = ((x + kge) & 0x80008000u) & ~fg; const int e = (i * 64 + lane) * 8 + 2 * c2;
      if (fg & 0x8000u) { idx16[pg] = (unsigned short)e; ++pg; }
      if (fg & 0x80000000u) { idx16[pg] = (unsigned short)(e + 1); ++pg; }
      if (fe & 0x8000u) { cand[pe] = (unsigned short)e; ++pe; }
      if (fe & 0x80000000u) { cand[pe] = (unsigned short)(e + 1); ++pe; } }
    asm volatile("" ::: "memory"); }
#undef BIN_OF
  LDSW();
  const int m = te;
  if (MODE == 3) return m;
  unsigned lo = 0u;
  if (m <= 64) {
    unsigned cpv = 0u; if (lane < m) { const unsigned ci = cand[lane]; unsigned hv = srow[ci]; hv = (hv == 0x8000u) ? 0u : hv; cpv = ((h2key(hv) & 15u) << 13) | (8191u - ci) | (1u << 20); }
    int rank = 0;
    for (int k = 0; k < m; ++k) { const unsigned ok = (unsigned)__builtin_amdgcn_readlane((int)cpv, k); rank += (ok > cpv) ? 1 : 0; }
    const bool sel = (lane < m) && (rank < need1);
    const unsigned long long bs = __ballot(sel);
    if (sel) idx16[cnt_gt + __builtin_popcountll(bs & ((1ull << lane) - 1ull))] = (unsigned short)(8191u - (cpv & 0x1FFFu));
  } else if (m <= 256) {
    unsigned cp[4];
#pragma unroll
    for (int j = 0; j < 4; ++j) { const int q = lane + 64 * j; cp[j] = 0u; if (q < m) { const unsigned ci = cand[q]; unsigned hv = srow[ci]; hv = (hv == 0x8000u) ? 0u : hv; cp[j] = ((h2key(hv) & 15u) << 13) | (8191u - ci) | (1u << 20); } }
    for (int bit = 16; bit >= 0; --bit) { const unsigned trial = lo | (1u << bit); int tc = 0;
#pragma unroll
      for (int j = 0; j < 4; ++j) tc += __builtin_popcountll(__ballot((cp[j] >> 20) && ((cp[j] & 0x1FFFFu) >= trial)));
      if (tc >= need1) lo = trial; }
    int pos = cnt_gt;
#pragma unroll
    for (int j = 0; j < 4; ++j) { const bool sel = (cp[j] >> 20) && ((cp[j] & 0x1FFFFu) >= lo); const unsigned long long bs = __ballot(sel);
      if (sel) idx16[pos + __builtin_popcountll(bs & ((1ull << lane) - 1ull))] = (unsigned short)(8191u - (cp[j] & 0x1FFFu)); pos += __builtin_popcountll(bs); }
  } else {
    for (int bit = 16; bit >= 0; --bit) { const unsigned trial = lo | (1u << bit); int c = 0;
      for (int q = lane; q < m; q += 64) { const unsigned ci = cand[q]; unsigned hv = srow[ci]; hv = (hv == 0x8000u) ? 0u : hv; const unsigned cpq = ((h2key(hv) & 15u) << 13) | (8191u - ci); c += (cpq >= trial) ? 1 : 0; }
      int tc; (void)wave_excl_scan(c, lane, tc); if (tc >= need1) lo = trial; }
    int base = cnt_gt;
    for (int q0 = 0; q0 < m; q0 += 64) { const int q = q0 + lane; bool sel = false; unsigned ci = 0;
      if (q < m) { ci = cand[q]; unsigned hv = srow[ci]; hv = (hv == 0x8000u) ? 0u : hv; const unsigned cpq = ((h2key(hv) & 15u) << 13) | (8191u - ci); sel = cpq >= lo; }
      int tc; const int pos = base + wave_excl_scan(sel ? 1 : 0, lane, tc); if (sel) idx16[pos] = (unsigned short)ci; base += tc; }
  }
  LDSW();
  return 256;
}

template <int HOT = 0> __device__ __forceinline__ void wave_attend(int b, int t, int cnt, const bf16_t* qlat, const bf16_t* cnb, LAS unsigned char* wl, LAS unsigned short* idx16, bf16_t* olat, int lane) {
  const int n16 = lane & 15, g = lane >> 4, q4 = (lane & 15) >> 2, p4 = lane & 3;
  const bf16_t* qrow = qlat + (size_t)(b * L + t) * 4096 + n16 * 256 + 8 * g;
  bf16x8 qf[8];
#pragma unroll
  for (int s = 0; s < 8; ++s) qf[s] = *(const bf16x8*)(qrow + 32 * s);
  f32x4 o[16];
  { float z = 0.f; asm volatile("" : "+v"(z));
#pragma unroll
    for (int c = 0; c < 16; ++c) o[c] = (f32x4){z, z, z, z}; }
  float mrun = -INFINITY, lrun = 0.f;
  const int ntile = (cnt + 31) >> 5;
  const char* cb = (const char*)(cnb + (size_t)b * L * 256);
  const unsigned slot = lane & 15, rsub = lane >> 4;
  constexpr float SC = 0.125f * 1.4426950408889634f;
  v4u stg[16];
#define GATHER_TILE(itn) do { _Pragma("unroll") for (int rg = 0; rg < 8; ++rg) { const unsigned row = 4 * rg + rsub; const unsigned key = HOT ? (idx16[32 * (itn) + row] & 255u) : idx16[32 * (itn) + row]; \
      const unsigned ch = slot ^ (((row & 3u) << 2) | ((row >> 2) & 3u)); const unsigned off = key * 512u + ch * 16u;     \
      stg[rg] = *(const v4u*)(cb + off); stg[8 + rg] = *(const v4u*)(cb + off + 256u); } } while (0)
  GATHER_TILE(0);
#pragma unroll 1
  for (int it = 0; it < ntile; ++it) {
#pragma unroll
    for (int rg = 0; rg < 8; ++rg) { *(LAS v4u*)(wl + rg * 1024 + lane * 16) = stg[rg]; *(LAS v4u*)(wl + 8192 + rg * 1024 + lane * 16) = stg[8 + rg]; }
    LDSW();
    if (it + 1 < ntile) GATHER_TILE(it + 1);
    f32x4 s0 = (f32x4){0.f, 0.f, 0.f, 0.f}, s1 = (f32x4){0.f, 0.f, 0.f, 0.f};
    { bf16x8 fa[4];
#define QK_RD(s_, d0, d1) { const unsigned ib = ((s_) >> 2) * 8192, chq = 4 * ((s_) & 3) + g; d0 = *(const LAS bf16x8*)(wl + ib + offb(n16, chq)); d1 = *(const LAS bf16x8*)(wl + ib + offb(16 + n16, chq)); }
#pragma unroll
      for (int s = 0; s < 2; ++s) QK_RD(s, fa[2 * s], fa[2 * s + 1])
      __builtin_amdgcn_sched_barrier(0);
#pragma unroll
      for (int s = 0; s < 8; ++s) {
        s0 = __builtin_amdgcn_mfma_f32_16x16x32_bf16(fa[2 * (s & 1)], qf[s], s0, 0, 0, 0); s1 = __builtin_amdgcn_mfma_f32_16x16x32_bf16(fa[2 * (s & 1) + 1], qf[s], s1, 0, 0, 0);
        if (s < 6) QK_RD(s + 2, fa[2 * (s & 1)], fa[2 * (s & 1) + 1])
        __builtin_amdgcn_sched_barrier(0);
      } }
    const int sl0 = 32 * it + 4 * g;
    float mx = -INFINITY;
#pragma unroll
    for (int r = 0; r < 4; ++r) { s0[r] = (sl0 + r < cnt) ? s0[r] * SC : -INFINITY; s1[r] = (sl0 + 16 + r < cnt) ? s1[r] * SC : -INFINITY; mx = fmaxf(mx, fmaxf(s0[r], s1[r])); }
    { const auto r16 = __builtin_amdgcn_permlane16_swap(__float_as_uint(mx), __float_as_uint(mx), false, false); mx = fmaxf(__uint_as_float(r16[0]), __uint_as_float(r16[1]));
      const auto r32 = __builtin_amdgcn_permlane32_swap(__float_as_uint(mx), __float_as_uint(mx), false, false); mx = fmaxf(__uint_as_float(r32[0]), __uint_as_float(r32[1])); }
    const float mnew = fmaxf(mrun, mx), alpha = __builtin_amdgcn_exp2f(mrun - mnew);
    float ls = 0.f; float pv[8];
#pragma unroll
    for (int r = 0; r < 4; ++r) { pv[r] = __builtin_amdgcn_exp2f(s0[r] - mnew); pv[4 + r] = __builtin_amdgcn_exp2f(s1[r] - mnew); ls += pv[r] + pv[4 + r]; }
    lrun = lrun * alpha + ls; mrun = mnew;
#pragma unroll
    for (int c = 0; c < 16; ++c) o[c] = o[c] * alpha;
    const v4u pbw = (v4u){cvt_pk_bf16(pv[0], pv[1]), cvt_pk_bf16(pv[2], pv[3]), cvt_pk_bf16(pv[4], pv[5]), cvt_pk_bf16(pv[6], pv[7])};
    const bf16x8 pb = __builtin_bit_cast(bf16x8, pbw);
    { v4i16_t ft[4][2];
#define PV_RD(c_, d) { const unsigned ib = ((c_) >> 3) * 8192, chc = 2 * ((c_) & 7) + (p4 >> 1); \
        d[0] = __builtin_amdgcn_ds_read_tr16_b64_v4i16((LAS v4i16_t*)(wl + ib + offb(4 * g + q4, chc) + 8 * (p4 & 1))); \
        d[1] = __builtin_amdgcn_ds_read_tr16_b64_v4i16((LAS v4i16_t*)(wl + ib + offb(16 + 4 * g + q4, chc) + 8 * (p4 & 1))); }
#pragma unroll
      for (int c = 0; c < 4; ++c) PV_RD(c, ft[c])
      __builtin_amdgcn_sched_barrier(0);
#pragma unroll
      for (int c = 0; c < 16; ++c) { const v4i16_t t0 = ft[c & 3][0], t1 = ft[c & 3][1];
        const bf16x8 af = (bf16x8){t0[0], t0[1], t0[2], t0[3], t1[0], t1[1], t1[2], t1[3]};
        o[c] = __builtin_amdgcn_mfma_f32_16x16x32_bf16(af, pb, o[c], 0, 0, 0);
        if (c < 12) PV_RD(c + 4, ft[c & 3])
        __builtin_amdgcn_sched_barrier(0);
      } }
    LDSW();
  }
  lrun += __shfl_xor(lrun, 16); lrun += __shfl_xor(lrun, 32);
  const float inv = 1.f / lrun;
  bf16_t* orow = olat + (size_t)(b * L + t) * 4096 + n16 * 256 + 4 * g;
#pragma unroll
  for (int c = 0; c < 16; ++c) { const f32x4 v = o[c] * inv; *(v2u*)(orow + 16 * c) = (v2u){cvt_pk_bf16(v[0], v[1]), cvt_pk_bf16(v[2], v[3])}; }
}

#ifndef CONV_CAP
#define CONV_CAP 2
#endif
__device__ __forceinline__ unsigned wave_ctr_add(LAS unsigned* p, unsigned v, int lane) {
  unsigned r = 0u; if (lane == 0) r = __hip_atomic_fetch_add(p, v, __ATOMIC_RELAXED, __HIP_MEMORY_SCOPE_WORKGROUP);
  return (unsigned)__builtin_amdgcn_readfirstlane((int)r); }
template <int NOCONV = 0> __device__ __forceinline__ void ph_select_attend(const unsigned short* sc, const bf16_t* qlat, const bf16_t* cnb, bf16_t* olat, LAS unsigned char* lds, const float* w1, const float* w2, bf16_t* W1_t, bf16_t* W2_t, void* scratch_olat = nullptr) {
  const int tid = TIDX(), lane = tid & 63, wave = __builtin_amdgcn_readfirstlane(tid >> 6), blk = BIDX();
  LAS unsigned char* wl = lds + wave * DW_STRIDE; LAS unsigned short* idx16 = (LAS unsigned short*)(wl + 16384);
  LAS unsigned* ctl = (LAS unsigned*)(lds + MISC_OFF + 64);
  if (tid < 3) ctl[tid] = 0u;
  __syncthreads();
  const int b = blk & 1, NGW = (int)gridDim.x * 8; (void)scratch_olat;
  constexpr unsigned NQ = 64u, NC = NOCONV ? 0u : 96u;
  const bool conv_first = wave < CONV_CAP;
#pragma unroll 1
  for (;;) {
#define WADD(p_, v_) wave_ctr_add((p_), (v_), lane)
    unsigned item = 0xFFFFFFFFu;
    if (NC && conv_first) { const unsigned ci = WADD(ctl + 1, 1u); if (ci < NC) item = 64u + ci; }
    if (item == 0xFFFFFFFFu) { const unsigned qi = WADD(ctl, 1u); if (qi < NQ) item = qi; }
    if (NC && !conv_first && item == 0xFFFFFFFFu) { const unsigned ci = WADD(ctl + 1, 1u); if (ci < NC) item = 64u + ci; }
    if (item == 0xFFFFFFFFu) break;
    if (item < 64u) {
      const unsigned qn = item;
      const int t = (blk >> 1) * 8 + (int)(qn & 7u) + 1024 * (7 - (int)(qn >> 3));
      int lane_s = lane; asm volatile("" : "+v"(lane_s));
#ifdef SELMODE
      { int lane_x = lane; asm volatile("" : "+v"(lane_x)); const int cx = wave_select<SELMODE>(sc + (size_t)(b * L + t) * L, t, wl, idx16, lane_x); if (cx == 12345) olat[0] = 0; }
#endif
      const int cnt = wave_select(sc + (size_t)(b * L + t) * L, t, wl, idx16, lane_s);
      int lane_a = lane; asm volatile("" : "+v"(lane_a));
      wave_attend(b, t, cnt, qlat, cnb, wl, idx16, olat, lane_a);
    } else {
      const unsigned cn = item - 64u;
      const int wt = blk * 8 + (int)(cn & 7u) + (int)(cn >> 3) * NGW;
      int lane_t = lane; asm volatile("" : "+v"(lane_t));
      moe_weight_tile(wt < 12288 ? moe_layer_tile(0, wt) : moe_layer_tile(1, wt - 12288), w1, w2, W1_t, W2_t, lane_t, wl);
    }
  }
}

#ifdef GBENCH
__device__ __forceinline__ void ph_gbench(const bf16_t* cnb, unsigned* sink) {
  const int tid = TIDX(), lane = tid & 63, wave = tid >> 6, blk = BIDX();
  const int b = blk & 1; const char* cb = (const char*)(cnb + (size_t)b * L * 256);
  const unsigned slot = lane & 15, rsub = lane >> 4;
  v4u accx = (v4u){0u, 0u, 0u, 0u};
#pragma unroll 1
  for (int qi = 0; qi < 8; ++qi) {
    const unsigned t = (unsigned)((blk >> 1) * 8 + wave + 1024 * qi);
#if GBENCH == 1
    v4u stg[16];
#define GB_TILE(itn) { _Pragma("unroll") for (int rg = 0; rg < 8; ++rg) { const unsigned row = 4 * rg + rsub; const unsigned key = (((32u * (itn) + row) * 2654435761u + t * 40503u) >> 13) & 8191u; \
      const unsigned off = key * 512u + slot * 16u; stg[rg] = *(const v4u*)(cb + off); stg[8 + rg] = *(const v4u*)(cb + off + 256u); } }
    GB_TILE(0)
#pragma unroll 1
    for (int it = 0; it < 8; ++it) {
      v4u f = (v4u){0u, 0u, 0u, 0u};
#pragma unroll
      for (int k = 0; k < 16; ++k) f ^= stg[k];
      accx ^= f;
      if (it + 1 < 8) GB_TILE(it + 1)
    }
#undef GB_TILE
#elif GBENCH == 2
    v4u sa[16], sb[16];
#define GB_TILE(dst, itn) { _Pragma("unroll") for (int rg = 0; rg < 8; ++rg) { const unsigned row = 4 * rg + rsub; const unsigned key = (((32u * (itn) + row) * 2654435761u + t * 40503u) >> 13) & 8191u; \
      const unsigned off = key * 512u + slot * 16u; dst[rg] = *(const v4u*)(cb + off); dst[8 + rg] = *(const v4u*)(cb + off + 256u); } }
    GB_TILE(sa, 0) GB_TILE(sb, 1)
#pragma unroll 1
    for (int it = 0; it < 8; it += 2) {
      v4u f = (v4u){0u, 0u, 0u, 0u};
#pragma unroll
      for (int k = 0; k < 16; ++k) f ^= sa[k];
      accx ^= f;
      if (it + 2 < 8) GB_TILE(sa, it + 2)
      f = (v4u){0u, 0u, 0u, 0u};
#pragma unroll
      for (int k = 0; k < 16; ++k) f ^= sb[k];
      accx ^= f;
      if (it + 3 < 8) GB_TILE(sb, it + 3)
    }
#undef GB_TILE
#endif
  }
  if ((accx[0] ^ accx[1] ^ accx[2] ^ accx[3]) == 0x12345678u) sink[tid] = 1u;
}
#endif

__device__ __forceinline__ void ph_qlat(const bf16_t* pa, const bf16_t* WqT, bf16_t* qlat) {
  const int tid = TIDX(), lane = tid & 63, gw = BIDX() * 8 + (tid >> 6), NGW = (int)gridDim.x * 8;
  const int n16 = lane & 15, g = lane >> 4;
#pragma unroll 1
  for (int it = gw; it < 16 * 512; it += NGW) {
    const int h = it & 15, rt = it >> 4;
    bf16x8 qb[2][2];
#pragma unroll
    for (int mt = 0; mt < 2; ++mt)
#pragma unroll
      for (int ks = 0; ks < 2; ++ks) qb[mt][ks] = *(const bf16x8*)(pa + (size_t)(rt * 32 + mt * 16 + n16) * 2048 + h * 64 + 32 * ks + 8 * g);
    const bf16_t* wp = WqT + (size_t)h * 256 * 64 + (size_t)n16 * 64 + 8 * g;
    bf16_t* op = qlat + (size_t)(rt * 32 + n16) * 4096 + h * 256 + 4 * g;
#pragma unroll 4
    for (int ct = 0; ct < 16; ++ct) {
      const bf16x8 a0 = *(const bf16x8*)(wp + (size_t)(16 * ct) * 64), a1 = *(const bf16x8*)(wp + (size_t)(16 * ct) * 64 + 32);
#pragma unroll
      for (int mt = 0; mt < 2; ++mt) { f32x4 acc = __builtin_amdgcn_mfma_f32_16x16x32_bf16(a0, qb[mt][0], (f32x4){0.f, 0.f, 0.f, 0.f}, 0, 0, 0);
        acc = __builtin_amdgcn_mfma_f32_16x16x32_bf16(a1, qb[mt][1], acc, 0, 0, 0);
        *(v2u*)(op + (size_t)(mt * 16) * 4096 + 16 * ct) = (v2u){cvt_pk_bf16(acc[0], acc[1]), cvt_pk_bf16(acc[2], acc[3])}; }
    }
  }
}
__device__ __forceinline__ void ph_o2(const bf16_t* olat, const bf16_t* WuvT, bf16_t* o2b) {
  const int tid = TIDX(), lane = tid & 63, gw = BIDX() * 8 + (tid >> 6), NGW = (int)gridDim.x * 8;
  const int n16 = lane & 15, g = lane >> 4;
#pragma unroll 1
  for (int it = gw; it < 16 * 512; it += NGW) {
    const int h = it & 15, rt = it >> 4;
    f32x4 acc[4][2];
#pragma unroll
    for (int vt = 0; vt < 4; ++vt) { acc[vt][0] = (f32x4){0.f, 0.f, 0.f, 0.f}; acc[vt][1] = (f32x4){0.f, 0.f, 0.f, 0.f}; }
    const bf16_t* ap = olat + (size_t)(rt * 32 + n16) * 4096 + h * 256 + 8 * g;
    const bf16_t* wp = WuvT + (size_t)h * 64 * 256 + (size_t)n16 * 256 + 8 * g;
#pragma unroll
    for (int ks = 0; ks < 8; ++ks) {
      const bf16x8 b0 = *(const bf16x8*)(ap + 32 * ks), b1 = *(const bf16x8*)(ap + (size_t)16 * 4096 + 32 * ks);
#pragma unroll
      for (int vt = 0; vt < 4; ++vt) { const bf16x8 a = *(const bf16x8*)(wp + (size_t)(16 * vt) * 256 + 32 * ks);
        acc[vt][0] = __builtin_amdgcn_mfma_f32_16x16x32_bf16(a, b0, acc[vt][0], 0, 0, 0); acc[vt][1] = __builtin_amdgcn_mfma_f32_16x16x32_bf16(a, b1, acc[vt][1], 0, 0, 0); }
    }
    bf16_t* op = o2b + (size_t)(rt * 32 + n16) * 1024 + h * 64 + 4 * g;
#pragma unroll
    for (int vt = 0; vt < 4; ++vt)
#pragma unroll
      for (int mt = 0; mt < 2; ++mt) *(v2u*)(op + (size_t)(mt * 16) * 1024 + 16 * vt) = (v2u){cvt_pk_bf16(acc[vt][mt][0], acc[vt][mt][1]), cvt_pk_bf16(acc[vt][mt][2], acc[vt][mt][3])};
  }
}

namespace pg8 {
struct GroupAOrder {
    static constexpr bool GATHER = false; const int* rowmap;
    StaticOrder so; int png; size_t acol_bytes;
    __device__ void init(const void* A, int lda, const void* Bt, int ldb, int M, int N, int png_, size_t acol_bytes_, int G, int c) { so.init(A, lda, Bt, ldb, M, N, G, c); png = png_; acol_bytes = acol_bytes_; }
    __device__ bool next(int i, Unit& u) const { int pm, pn; if (!so.tile(i, pm, pn)) return false; u.pa = so.A + (size_t)pm * so.ta + (size_t)(pn / png) * acol_bytes; u.pb = so.Bt + (size_t)pn * so.tb; u.orow = pm * BM; u.ocol = pn * BM; u.e = 0; u.kind = 0; return true; }
    __device__ __forceinline__ int rowof(const Unit&, int r) const { return r; }
    __device__ __forceinline__ void a_ready(const Unit&) const {}
    __device__ __forceinline__ void done(const Unit&) const {}
};
}
constexpr int GLA_LDSU = 65536;

__device__ __forceinline__ v4i16_t trrd(LAS unsigned char* p) { return __builtin_amdgcn_ds_read_tr16_b64_v4i16((LAS v4i16_t*)p); }
__device__ __forceinline__ bf16x8 cat44(v4i16_t a, v4i16_t b) { return (bf16x8){a[0], a[1], a[2], a[3], b[0], b[1], b[2], b[3]}; }

__device__ __forceinline__ void ph_gla_a1(const bf16_t* pb, const float* gbias, bf16_t* qt, bf16_t* og, bf16_t* kvt, float* dcy, LAS unsigned char* lds, const float* w1, const float* w2, bf16_t* W1_t, bf16_t* W2_t) {
  const int tid = TIDX(), lane = tid & 63, wave = __builtin_amdgcn_readfirstlane(tid >> 6), blk = BIDX();
  const int half = wave >> 2, wq = wave & 3;
  LAS unsigned char* X = lds + half * GLA_LDSU; LAS unsigned char* Y = X + 16384; LAS unsigned char* V = X + 32768;
  LAS float* EX = (LAS float*)(lds + 131072 + half * 2048);
  const unsigned v_addr = (unsigned)__builtin_amdgcn_readfirstlane((int)(unsigned)(size_t)V);
  const int n16 = lane & 15, g = lane >> 4, q4 = (lane & 15) >> 2, p4 = lane & 3;
#pragma unroll 1
  for (int uu = 0; uu < 2; ++uu) {
    const int u = blk * 4 + half * 2 + uu;
    const int h = u & 3, bc = u >> 2, r0 = bc * 64;
    { const unsigned slot = lane & 15, rsub = lane >> 4; const int im = wq;
#pragma unroll
      for (int rg = 0; rg < 8; ++rg) { const unsigned row = 4 * rg + rsub; const unsigned ch = slot ^ (((row & 3u) << 2) | ((row >> 2) & 3u));
        const char* src = (const char*)(pb + (size_t)(r0 + 32 * (im >> 1) + row) * 3584 + 1024 + h * 256 + (im & 1) * 128) + ch * 16;
        glds16(src, v_addr + im * 8192 + rg * 1024); } }
    const int d0 = 2 * lane; const float gb0 = gbias[h * 128 + d0], gb1 = gbias[h * 128 + d0 + 1];
    const unsigned wofs = 16u * ((unsigned)(d0 >> 3)), wsub = (unsigned)(d0 & 7) * 2u;
    unsigned gq[16], qq[16], kq[16]; float bl0[16], bl1[16];
#pragma unroll
    for (int jj = 0; jj < 16; ++jj) { const bf16_t* rp = pb + (size_t)(r0 + wq * 16 + jj) * 3584 + h * 128 + d0;
      gq[jj] = *(const unsigned*)(rp + 3072); qq[jj] = *(const unsigned*)rp; kq[jj] = *(const unsigned*)(rp + 512); }
    float bc0 = 0.f, bc1 = 0.f;
#pragma unroll
    for (int jj = 0; jj < 16; ++jj) { const float a0 = bf_lo(gq[jj]) + gb0, a1 = bf_hi(gq[jj]) + gb1;
      bc0 += (fminf(a0, 0.f) - __logf(1.f + __expf(-fabsf(a0)))) * (1.f / 16.f); bc1 += (fminf(a1, 0.f) - __logf(1.f + __expf(-fabsf(a1)))) * (1.f / 16.f);
      bl0[jj] = bc0; bl1[jj] = bc1; }
    *(LAS f32x2_t*)(EX + wq * 128 + d0) = (f32x2_t){bc0, bc1};
    LDSW(); __syncthreads();
    float of0 = 0.f, of1 = 0.f, tt0 = 0.f, tt1 = 0.f;
#pragma unroll
    for (int w2_ = 0; w2_ < 4; ++w2_) { const f32x2_t e = *(const LAS f32x2_t*)(EX + w2_ * 128 + d0); tt0 += e[0]; tt1 += e[1]; if (w2_ < wq) { of0 += e[0]; of1 += e[1]; } }
#pragma unroll
    for (int jj = 0; jj < 16; ++jj) { const int j = wq * 16 + jj; const float b0 = bl0[jj] + of0, b1 = bl1[jj] + of1;
      const float e0 = __expf(b0), e1 = __expf(b1), i0 = __expf(fminf(-b0, 80.f)), i1 = __expf(fminf(-b1, 80.f));
      const unsigned qo = cvt_pk_bf16(bf_lo(qq[jj]) * 0.08838834764831845f * e0, bf_hi(qq[jj]) * 0.08838834764831845f * e1);
      const unsigned ko = cvt_pk_bf16(bf_lo(kq[jj]) * i0, bf_hi(kq[jj]) * i1);
      *(unsigned*)(qt + (size_t)(r0 + j) * 512 + h * 128 + d0) = qo;
      const unsigned row = (unsigned)(j & 31); const unsigned off = (unsigned)(j >> 5) * 8192u + 256u * row + ((wofs ^ (16u * (((row & 3u) << 2) | ((row >> 2) & 3u))))) + wsub;
      *(LAS unsigned*)(X + off) = qo; *(LAS unsigned*)(Y + off) = ko; }
    if (wq == 3) *(float2*)(dcy + (size_t)u * 128 + d0) = make_float2(__expf(tt0), __expf(tt1));
    asm volatile("s_waitcnt vmcnt(0) lgkmcnt(0)" ::: "memory");
    __syncthreads();
    const int it = wq;
    bf16x8 afr[2];
#pragma unroll
    for (int ks = 0; ks < 2; ++ks) {
      unsigned pk[4] = {0u, 0u, 0u, 0u};
#pragma unroll
      for (int jh = 0; jh < 2; ++jh) { const int jt = 2 * ks + jh;
        if (jt <= it) { f32x4 acc = (f32x4){0.f, 0.f, 0.f, 0.f};
#pragma unroll
          for (int s = 0; s < 4; ++s) { const bf16x8 ya = *(const LAS bf16x8*)(Y + (jt >> 1) * 8192 + offb(n16 + 16 * (jt & 1), 4 * s + g)), xb = *(const LAS bf16x8*)(X + (it >> 1) * 8192 + offb(n16 + 16 * (it & 1), 4 * s + g));
            acc = __builtin_amdgcn_mfma_f32_16x16x32_bf16(ya, xb, acc, 0, 0, 0); }
          const int i_ = 16 * it + n16, jbase = 16 * jt + 4 * g;
#pragma unroll
          for (int r = 0; r < 4; ++r) if (jbase + r > i_) acc[r] = 0.f;
          pk[2 * jh] = cvt_pk_bf16(acc[0], acc[1]); pk[2 * jh + 1] = cvt_pk_bf16(acc[2], acc[3]); } }
      afr[ks] = __builtin_bit_cast(bf16x8, (v4u){pk[0], pk[1], pk[2], pk[3]});
    }
    bf16_t* ogp = og + (size_t)u * 16384 + (size_t)(it * 16) * 256 + lane * 4; bf16_t* kvp = kvt + (size_t)u * 32768 + (size_t)n16 * 128 + 4 * g;
#pragma unroll 2
    for (int nt = 0; nt < 16; ++nt) {
      const unsigned vimg = (unsigned)(nt >> 3) * 8192u, chv = 2u * (unsigned)(nt & 7) + (unsigned)(p4 >> 1), sub = 8u * (unsigned)(p4 & 1);
      f32x4 acc = (f32x4){0.f, 0.f, 0.f, 0.f};
      { LAS unsigned char* vb = V + vimg; const bf16x8 bi0 = cat44(trrd(vb + offb(4 * g + q4, chv) + sub), trrd(vb + offb(16 + 4 * g + q4, chv) + sub));
        acc = __builtin_amdgcn_mfma_f32_16x16x32_bf16(afr[0], bi0, acc, 0, 0, 0); }
      if (it >= 2) { LAS unsigned char* vb = V + 16384 + vimg; const bf16x8 bi1 = cat44(trrd(vb + offb(4 * g + q4, chv) + sub), trrd(vb + offb(16 + 4 * g + q4, chv) + sub));
        acc = __builtin_amdgcn_mfma_f32_16x16x32_bf16(afr[1], bi1, acc, 0, 0, 0); }
      *(v2u*)(ogp + (size_t)nt * 256) = (v2u){cvt_pk_bf16(acc[0], acc[1]), cvt_pk_bf16(acc[2], acc[3])};
    }
#pragma unroll 1
    for (int nq = 0; nq < 4; ++nq) { const int nt = 4 * wq + nq;
      const unsigned vimg = (unsigned)(nt >> 3) * 8192u, chv = 2u * (unsigned)(nt & 7) + (unsigned)(p4 >> 1), sub = 8u * (unsigned)(p4 & 1);
      bf16x8 bn[2];
#pragma unroll
      for (int ks = 0; ks < 2; ++ks) { LAS unsigned char* vb = V + ks * 16384 + vimg; bn[ks] = cat44(trrd(vb + offb(8 * g + q4, chv) + sub), trrd(vb + offb(8 * g + 4 + q4, chv) + sub)); }
#pragma unroll
      for (int mt = 0; mt < 8; ++mt) { const unsigned chy = 2u * (unsigned)mt + (unsigned)(p4 >> 1);
        const bf16x8 a0 = cat44(trrd(Y + offb(8 * g + q4, chy) + sub), trrd(Y + offb(8 * g + 4 + q4, chy) + sub));
        const bf16x8 a1 = cat44(trrd(Y + 8192 + offb(8 * g + q4, chy) + sub), trrd(Y + 8192 + offb(8 * g + 4 + q4, chy) + sub));
        f32x4 acc = __builtin_amdgcn_mfma_f32_16x16x32_bf16(a0, bn[0], (f32x4){0.f, 0.f, 0.f, 0.f}, 0, 0, 0);
        acc = __builtin_amdgcn_mfma_f32_16x16x32_bf16(a1, bn[1], acc, 0, 0, 0);
        *(v2u*)(kvp + (size_t)(16 * nt) * 128 + 16 * mt) = (v2u){cvt_pk_bf16(acc[0], acc[1]), cvt_pk_bf16(acc[2], acc[3])}; }
    }
    LDSW(); __syncthreads();
  }
}

__device__ __forceinline__ void ph_gla_a2(const bf16_t* kvt, const float* dcy, bf16_t* spt) {
  const int gtid = BIDX() * NTHR + TIDX();
  if (gtid >= 8 * 256 * 32) return;
  const int g4 = gtid & 31, dv = (gtid >> 5) & 255, bh = gtid >> 13, b = bh >> 2, h = bh & 3;
  f32x4 S = (f32x4){0.f, 0.f, 0.f, 0.f};
#pragma unroll 4
  for (int c = 0; c < 128; ++c) { const size_t u = (size_t)((b * 128 + c) * 4 + h);
    const v2u kvb = *(const v2u*)(kvt + u * 32768 + (size_t)dv * 128 + 4 * g4); const f32x4 kv = (f32x4){bf_lo(kvb[0]), bf_hi(kvb[0]), bf_lo(kvb[1]), bf_hi(kvb[1])}, dc = *(const f32x4*)(dcy + u * 128 + 4 * g4);
    *(v2u*)(spt + u * 32768 + (size_t)dv * 128 + 4 * g4) = (v2u){cvt_pk_bf16(S[0], S[1]), cvt_pk_bf16(S[2], S[3])};
    S = dc * (S + kv); }
}

constexpr int A3_LD = 272;
__device__ __forceinline__ void ph_gla_a3(const bf16_t* pb, const bf16_t* qt, const bf16_t* og, const bf16_t* spt, const float* ng, bf16_t* ob, LAS unsigned char* lds) {
  const int tid = TIDX(), lane = tid & 63, wave = __builtin_amdgcn_readfirstlane(tid >> 6), gw = BIDX() * 8 + wave, NGW = (int)gridDim.x * 8;
  const int n16 = lane & 15, g = lane >> 4, row16 = lane >> 2, cq = lane & 3;
  LAS float* T = (LAS float*)(lds + wave * (16 * A3_LD * 4));
#pragma unroll 1
  for (int w = gw; w < 4096; w += NGW) {
    const int u = w >> 2, it = w & 3, h = u & 3, r0 = (u >> 2) * 64;
    const bf16_t* sp = spt + (size_t)u * 32768 + (size_t)n16 * 128 + 8 * g;
    bf16x8 qa[4];
#pragma unroll
    for (int ks = 0; ks < 4; ++ks) qa[ks] = *(const bf16x8*)(qt + (size_t)(r0 + 16 * it + n16) * 512 + h * 128 + 32 * ks + 8 * g);
    const bf16_t* ogp = og + (size_t)u * 16384 + (size_t)(it * 16) * 256 + lane * 4;
#pragma unroll
    for (int nt = 0; nt < 16; ++nt) {
      const v2u ogb = *(const v2u*)(ogp + nt * 256); f32x4 acc = (f32x4){bf_lo(ogb[0]), bf_hi(ogb[0]), bf_lo(ogb[1]), bf_hi(ogb[1])};
#pragma unroll
      for (int ks = 0; ks < 4; ++ks) { const bf16x8 sb = *(const bf16x8*)(sp + (size_t)(16 * nt) * 128 + 32 * ks); acc = __builtin_amdgcn_mfma_f32_16x16x32_bf16(qa[ks], sb, acc, 0, 0, 0); }
#pragma unroll
      for (int r = 0; r < 4; ++r) T[(4 * g + r) * A3_LD + 16 * nt + n16] = acc[r];
    }
    LDSW();
    const size_t row = (size_t)(r0 + 16 * it + row16);
    f32x4 v[16]; float ss = 0.f;
#pragma unroll
    for (int k = 0; k < 16; ++k) { v[k] = *(const LAS f32x4*)(T + row16 * A3_LD + 16 * k + 4 * cq); ss += (v[k][0] * v[k][0] + v[k][1] * v[k][1]) + (v[k][2] * v[k][2] + v[k][3] * v[k][3]); }
    ss += __shfl_xor(ss, 1); ss += __shfl_xor(ss, 2);
    const float rs = rsqrtf(ss * (1.f / 256.f) + 1e-6f);
#pragma unroll
    for (int k = 0; k < 16; ++k) { const int col = h * 256 + 16 * k + 4 * cq; const v2u rg = *(const v2u*)(pb + row * 3584 + 2048 + col); const f32x4 gn = *(const f32x4*)(ng + col);
      const float rr[4] = {bf_lo(rg[0]), bf_hi(rg[0]), bf_lo(rg[1]), bf_hi(rg[1])}; float o[4];
#pragma unroll
      for (int z = 0; z < 4; ++z) o[z] = v[k][z] * rs * gn[z] * (rr[z] * __builtin_amdgcn_rcpf(1.f + __expf(-rr[z])));
      *(v2u*)(ob + row * 1024 + col) = (v2u){cvt_pk_bf16(o[0], o[1]), cvt_pk_bf16(o[2], o[3])}; }
    LDSW();
  }
}
#ifndef PROBE
#define PROBE 0
#endif
#ifndef PROBE_S
#define PROBE_S 10.0f
#endif
constexpr size_t MiB = 1u << 20;
constexpr size_t WS_CTL = 0, CTL_ZERO_BYTES = 1 * MiB;
constexpr int CW_BAR = 4096, CW_TMO = 64, CW_RDY = 65536, CW_ISC = 1024;
constexpr size_t WS_NEEDED = 2048 * MiB;

struct Args { In in; float* out; unsigned char* ws; };

struct Opt { bf16_t *qt, *spt, *og, *kvt; float *dcy; bf16_t *Wql_t, *Wuv_t, *cnb, *kib, *qlat, *olat; unsigned short* sc; bf16_t *xb, *WA_t, *WoutA_t, *WB_t, *WoutB_t, *W1_t, *W2_t, *projA_b, *hbf, *o2b, *xs, *act, *Ys, *projB_b; MoeBufs m; };
__device__ __forceinline__ nvp::Ws carve_ws(unsigned char* ws) {
  nvp::Ws w; auto at = [&](size_t mib) { return (char*)ws + mib * MiB; };
  w.projA = (float*)at(2); w.cn = (float*)at(119); w.sc = (float*)at(135); w.idx = (int*)at(647); w.o2 = (float*)at(663);
  w.x1 = (float*)at(727); w.x2 = (float*)at(791);
  w.projB = (float*)at(135); w.adec = (float*)at(135 + 194); w.og = (float*)at(135 + 194 + 32); w.on = (float*)at(135 + 194 + 32 + 64);
  w.counts = nullptr; w.h = nullptr; w.hb = nullptr; w.ys = nullptr; w.tok_e = nullptr; w.tok_g = nullptr; w.slot_of = nullptr; w.row_tok = nullptr; w.row_gate = nullptr; w.blk_e = nullptr;
  return w;
}
__device__ __forceinline__ Opt carve_opt(unsigned char* ws) {
  Opt o; auto at = [&](size_t mib) { return (bf16_t*)((char*)ws + mib * MiB); };
  char* sm = (char*)ws + 855 * MiB;
  o.m.tok_e = (int*)sm; o.m.tok_g = (float*)(sm + 256 * 1024); o.m.slot_of = (int*)(sm + 512 * 1024); o.m.slot_gate = (float*)(sm + 768 * 1024); o.m.blk_e = (int*)(sm + 1088 * 1024); o.m.blkcnt = (int*)(sm + 1096 * 1024); o.m.nblk = (int*)(sm + 1160 * 1024); o.m.slot_tok = (int*)(sm + 1200 * 1024);
  o.WA_t = at(860); o.WoutA_t = at(864); o.WB_t = at(866); o.WoutB_t = at(873);
  o.Wql_t = at(875); o.Wuv_t = at(877); o.olat = at(2); o.cnb = at(647); o.kib = at(656); o.qlat = at(1856); o.sc = (unsigned short*)at(135);
  o.qt = at(135); o.dcy = (float*)at(151); o.og = at(152); o.kvt = at(216); o.spt = at(344);
  o.W1_t = at(880); o.W2_t = at(1136);
  o.xb = at(1264); o.projA_b = at(1296); o.hbf = at(1360); o.o2b = at(1392);
  o.xs = at(1424); o.act = at(1568); o.Ys = at(1712); o.projB_b = at(1856);
  return o;
}

struct ProIn { const float *a_w_uk, *a_w_uv, *x, *a_w_in, *a_w_out, *b_w_in, *b_w_g2, *b_w_out, *m_w1, *m_w2; };
__device__ __forceinline__ void ph_prologue(const ProIn I, const Opt& o, LAS unsigned char* lds) {
  const int tid = TIDX(), lane = tid & 63, gw = BIDX() * 8 + (tid >> 6), NGW = (int)gridDim.x * 8, gtid = BIDX() * NTHR + tid, NGT = (int)gridDim.x * NTHR;
  cvt_f32_to_bf16(I.x, D, o.xb, D, NT, D, gtid, NGT);
  zero_rect(o.WA_t, D, DINA, 2048 - DINA, 0, D * 2, gtid, NGT);
  for (int i = gtid; i < 512 * 256; i += NGT) { const int n = i >> 8, k4 = (i & 255) * 4; float a[4];
#pragma unroll
    for (int z = 0; z < 4; ++z) { const float* gl = I.b_w_in + (size_t)(k4 + z) * DINB + 2048; float s = 0.f;
#pragma unroll
      for (int j = 0; j < 16; ++j) s = fmaf(gl[j], I.b_w_g2[j * 512 + n], s);
      a[z] = s; }
    *(v2u*)(o.WB_t + (size_t)(3072 + n) * D + k4) = (v2u){cvt_pk_bf16(a[0], a[1]), cvt_pk_bf16(a[2], a[3])}; }
  int w0 = 0; LAS unsigned char* stage = lds + (tid >> 6) * 16384;
#pragma unroll 1
  for (int h = 0; h < 16; ++h) {
    transpose_job(mk_tjob(I.a_w_uk + (size_t)h * 64 * 256, 256, 64, 256, o.Wql_t, 256, h * 256, (h & 3) * 64, 0), w0, gw, NGW, lane, stage);
    transpose_job(mk_tjob(I.a_w_uv + (size_t)h * 256 * 64, 64, 256, 64, o.Wuv_t, 1024, h * 64, (h & 3) * 256, 0), w0, gw, NGW, lane, stage);
    for (int hp = 0; hp < 4; ++hp) if (hp != (h & 3)) { zero_rect(o.Wql_t, 256, h * 256, 256, hp * 128, 128, gtid, NGT); zero_rect(o.Wuv_t, 1024, h * 64, 64, hp * 512, 512, gtid, NGT); }
  }
  transpose_job(mk_tjob(I.a_w_in, DINA, D, DINA, o.WA_t, D, 0, 0, 0), w0, gw, NGW, lane, stage);
  transpose_job(mk_tjob(I.a_w_out, D, D, D, o.WoutA_t, D, 0, 0, 0), w0, gw, NGW, lane, stage);
  transpose_job(mk_tjob(I.b_w_in, DINB, D, 2048, o.WB_t, D, 0, 0, 0), w0, gw, NGW, lane, stage);
  transpose_job(mk_tjob(I.b_w_in + 2064, DINB, D, 1024, o.WB_t, D, 2048, 0, 0), w0, gw, NGW, lane, stage);
  transpose_job(mk_tjob(I.b_w_out, D, D, D, o.WoutB_t, D, 0, 0, 0), w0, gw, NGW, lane, stage);
}
__device__ __forceinline__ void ph_gla_shim(const bf16_t* pb, const float* gbias, float* projB, float* adec) {
  const int gtid = BIDX() * NTHR + TIDX(), NGT = (int)gridDim.x * NTHR;
  for (size_t i = gtid; i < (size_t)NT * 896; i += NGT) { const size_t r = i / 896; const int c = (int)(i % 896) * 4; const v2u v = *(const v2u*)(pb + r * 3584 + c);
    const f32x4 f = (f32x4){bf_lo(v[0]), bf_hi(v[0]), bf_lo(v[1]), bf_hi(v[1])};
    if (c < 2048) *(f32x4*)(projB + r * DINB + c) = f;
    else if (c < 3072) *(f32x4*)(projB + r * DINB + 2064 + (c - 2048)) = f;
    else { f32x4 o;
#pragma unroll
      for (int z = 0; z < 4; ++z) { const float a = f[z] + gbias[c - 3072 + z]; const float ls = fminf(a, 0.f) - log1pf(expf(-fabsf(a))); o[z] = expf(ls * (1.f / 16.f)); }
      *(f32x4*)(adec + r * 512 + (c - 3072)) = o; } }
}

#if PROBE == 3
#define GLA_PHASES \
      PH_BEGIN ph_gla_shim(o.projB_b, I.b_g_bias, w.projB, w.adec); PH_END \
      GRID_BAR(); \
      PH_BEGIN nvp::np_gla_scan(w.projB, w.adec, w.og, fl); PH_END \
      GRID_BAR(); \
      PH_BEGIN nvp::np_gla_norm(w.og, w.projB, I.b_norm, w.on); PH_END \
      GRID_BAR(); \
      PH_BEGIN cvt_f32_to_bf16(w.on, D, o.o2b, D, NT, D, gtid_, NGT_); PH_END \
      GRID_BAR(); \
      PH_BEGIN ph_gla_a1(o.projB_b, I.b_g_bias, (bf16_t*)(wsb_ + 489 * MiB), (bf16_t*)(wsb_ + 506 * MiB), (bf16_t*)(wsb_ + 880 * MiB), (float*)(wsb_ + 505 * MiB), ll, I.m_w1, I.m_w2, o.W1_t, o.W2_t); PH_END \
      GRID_BAR(); \
      PH_BEGIN ph_gla_a2((bf16_t*)(wsb_ + 880 * MiB), (float*)(wsb_ + 505 * MiB), (bf16_t*)(wsb_ + 1136 * MiB)); PH_END \
      GRID_BAR(); \
      PH_BEGIN ph_gla_a3(o.projB_b, (bf16_t*)(wsb_ + 489 * MiB), (bf16_t*)(wsb_ + 506 * MiB), (bf16_t*)(wsb_ + 1136 * MiB), I.b_norm, (bf16_t*)(wsb_ + 570 * MiB), ll); PH_END \
      GRID_BAR(); \
      PH_BEGIN { unsigned* fl_ = (unsigned*)(wsb_ + 512 * 1024); unsigned bits = 0u; \
        { const bf16_t* a = (const bf16_t*)(wsb_ + 489 * MiB); for (size_t i = gtid_; i < (size_t)NT * 512; i += NGT_) { const float v = bf2f(a[i]); if (!(fabsf(v) < 1e30f)) bits |= 1u; } } \
        { const float* a = (const float*)(wsb_ + 506 * MiB); for (size_t i = gtid_; i < (size_t)NT * 1024; i += NGT_) { const float v = a[i]; if (!(fabsf(v) < 1e30f)) bits |= 2u; } } \
        { const float* a = (const float*)(wsb_ + 880 * MiB); for (size_t i = gtid_; i < (size_t)1024 * 32768; i += NGT_) { const float v = a[i]; if (!(fabsf(v) < 1e30f)) bits |= 4u; } } \
        { const bf16_t* a = (const bf16_t*)(wsb_ + 1136 * MiB); for (size_t i = gtid_; i < (size_t)1024 * 32768; i += NGT_) { const float v = bf2f(a[i]); if (!(fabsf(v) < 1e30f)) bits |= 8u; } } \
        { const bf16_t* a = (const bf16_t*)(wsb_ + 570 * MiB); for (size_t i = gtid_; i < (size_t)NT * 1024; i += NGT_) { const float v = bf2f(a[i]); if (!(fabsf(v) < 1e30f)) bits |= 16u; } } \
        { const float* a = (const float*)(wsb_ + 505 * MiB); for (size_t i = gtid_; i < (size_t)1024 * 128; i += NGT_) { const float v = a[i]; if (!(fabsf(v) < 1e30f)) bits |= 32u; } } \
        if (bits) atomicOr(fl_, bits); \
        { float* pd = (float*)(wsb_ + 1968 * MiB); const bf16_t* ob = (const bf16_t*)(wsb_ + 570 * MiB); for (size_t i = gtid_; i < (size_t)NT * D; i += NGT_) pd[i] = bf2f(ob[i]) - w.on[i]; } } PH_END \
      GRID_BAR();
#else
#define GLA_PHASES \
      PH_BEGIN ph_gla_a1(o.projB_b, I.b_g_bias, o.qt, o.og, o.kvt, o.dcy, ll, I.m_w1, I.m_w2, o.W1_t, o.W2_t); PH_END \
      GRID_BAR(); \
      PH_BEGIN ph_gla_a2(o.kvt, o.dcy, o.spt); PH_END \
      GRID_BAR(); \
      PH_BEGIN ph_gla_a3(o.projB_b, o.qt, o.og, o.spt, I.b_norm, o.o2b, ll); PH_END \
      GRID_BAR();
#endif
#if defined(FUSE_ON)
#define MOE_GEMM_PHASES(li) \
    PH_BEGIN pg8::MoeFusedOrder S; S.init(o.xs, o.act, o.W1_t + (size_t)li * 32 * 2048 * D, o.W2_t + (size_t)li * 32 * D * D, o.m.slot_tok, o.m.blk_e, (unsigned*)(wsb_ + WS_CTL) + CW_RDY + li * 32768, (unsigned*)(wsb_ + WS_CTL) + CW_TMO, __builtin_amdgcn_readfirstlane(*o.m.nblk), G_, BIDX()); S.mode = 0; \
      gemm_phase<pg8::EpiMoeFused, pg8::MoeFusedOrder, true, true>(ll, Gemm{D, D, D}, S, pg8::EpiMoeFused{o.act, I.m_b1 + (size_t)li * 32 * 2048, o.Ys, I.m_b2 + (size_t)li * 32 * D, o.m.slot_gate}); PH_END \
    GRID_BAR();
#else
#define MOE_GEMM_PHASES(li) \
    PH_BEGIN pg8::MoeOrderG S; S.init(o.xs, D, o.W1_t + (size_t)li * 32 * 2048 * D, D, (size_t)2048 * D * 2, __builtin_amdgcn_readfirstlane(*o.m.nblk), 8, 128, o.m.blk_e, G_, BIDX()); S.rowmap = o.m.slot_tok; \
      gemm_phase<pg8::EpiSwiglu, pg8::MoeOrderG, true, true>(ll, Gemm{D, D, D}, S, pg8::EpiSwiglu{o.act, D, I.m_b1 + (size_t)li * 32 * 2048}); PH_END \
    GRID_BAR(); \
    PH_BEGIN MoeOrder S; S.init(o.act, D, o.W2_t + (size_t)li * 32 * D * D, D, (size_t)D * D * 2, __builtin_amdgcn_readfirstlane(*o.m.nblk), 4, 256, o.m.blk_e, G_, BIDX()); \
      gemm_phase<pg8::EpiMoe2, MoeOrder, true, true>(ll, Gemm{D, D, D}, S, pg8::EpiMoe2{o.Ys, D, I.m_b2 + (size_t)li * 32 * D, o.m.slot_gate}); PH_END \
    GRID_BAR();
#endif
#ifdef LNR_MODE
#define LNR_EXTRA(li) PH_BEGIN if (li == 0) ph_ln_router<false, LNR_MODE>(I.x, o.hbf, I.ln1_g + li * D, I.ln1_b + li * D, I.m_w_router + (size_t)li * D * 32, I.m_b_router + li * 32, o.xs, o.m, fl); else ph_ln_router<true, LNR_MODE>(o.xb, o.hbf, I.ln1_g + li * D, I.ln1_b + li * D, I.m_w_router + (size_t)li * D * 32, I.m_b_router + li * 32, o.xs, o.m, fl); PH_END GRID_BAR();
#else
#define LNR_EXTRA(li)
#endif
#define LAYER_BODY(li) \
    if (li == 1) { \
      PH_BEGIN StaticOrder S; S.init(o.xb, D, o.WB_t, D, NT, 3584, G_, BIDX()); gemm_phase<EpiStore, StaticOrder, true, true>(ll, Gemm{D, D, D}, S, EpiStore{o.projB_b, 3584}); PH_END \
      GRID_BAR(); \
      GLA_PHASES \
      PH_BEGIN StaticOrder S; S.init(o.o2b, D, o.WoutB_t, D, NT, D, G_, BIDX()); gemm_phase<EpiStore, StaticOrder, true, true>(ll, Gemm{D, D, D}, S, EpiStore{o.hbf, D}); PH_END \
      GRID_BAR(); \
    } \
LNR_EXTRA(li) \
    PH_BEGIN if (li == 0) ph_ln_router<false>(I.x, o.hbf, I.ln1_g + li * D, I.ln1_b + li * D, I.m_w_router + (size_t)li * D * 32, I.m_b_router + li * 32, o.xs, o.m, fl); else ph_ln_router<true>(o.xb, o.hbf, I.ln1_g + li * D, I.ln1_b + li * D, I.m_w_router + (size_t)li * D * 32, I.m_b_router + li * 32, o.xs, o.m, fl); PH_END \
    GRID_BAR(); \
    PH_BEGIN ph_moe_scatter(o.m, (int*)lds); PH_END \
    GRID_BAR(); \
MOE_GEMM_PHASES(li) \
    PH_BEGIN ph_combine_ln(o.xs, o.Ys, o.m.slot_of, I.ln2_g + li * D, I.ln2_b + li * D, li == 0 ? nullptr : out_, li == 0 ? o.xb : nullptr); PH_END \
    if (li == 0) GRID_BAR();
__global__ void __launch_bounds__(NTHR, 2) mk_fwd(Args args) {
  extern __shared__ __attribute__((aligned(16))) unsigned char lds[];
  volatile LAS unsigned* MISC = (volatile LAS unsigned*)((LAS unsigned char*)lds + MISC_OFF);
  if (threadIdx.x < 32) MISC[threadIdx.x] = 0u;
  __syncthreads();
  XcdBarrier bar; { const __attribute__((address_space(4))) Args* ka0 = (const __attribute__((address_space(4))) Args*)__builtin_amdgcn_kernarg_segment_ptr(); bar = xcd_barrier_post((unsigned*)(ka0->ws + WS_CTL) + CW_BAR, MISC + 8); }
#define GRID_BAR() xcd_barrier(bar)
#define PH_BEGIN { const __attribute__((address_space(4))) Args* ka_ = (const __attribute__((address_space(4))) Args*)__builtin_amdgcn_kernarg_segment_ptr(); asm volatile("" : "+s"(ka_)); \
    float* const out_ = ka_->out; (void)out_; unsigned char* wsb_ = ka_->ws; const nvp::Ws w = carve_ws(wsb_); (void)w; const Opt o = carve_opt(wsb_); (void)o; \
    const int gtid_ = BIDX() * NTHR + TIDX(), NGT_ = (int)gridDim.x * NTHR; (void)gtid_; (void)NGT_; const int G_ = (int)gridDim.x; (void)G_;
#define PH_END }
#define I (ka_->in)
  float* fl = (float*)lds; LAS unsigned char* ll = (LAS unsigned char*)lds;
  using pg8::gemm_phase; using pg8::StaticOrder; using pg8::MoeOrder; using pg8::Gemm; using pg8::EpiStore;
  PH_BEGIN ph_prologue(ProIn{I.a_w_uk, I.a_w_uv, I.x, I.a_w_in, I.a_w_out, I.b_w_in, I.b_w_g2, I.b_w_out, I.m_w1, I.m_w2}, o, ll); PH_END
  GRID_BAR();
  PH_BEGIN StaticOrder S; S.init(o.xb, D, o.WA_t, D, NT, 2048, G_, BIDX()); gemm_phase<pg8::EpiStoreKi, StaticOrder, true, true>(ll, Gemm{D, D, D}, S, pg8::EpiStoreKi{o.projA_b, 2048, o.kib, 1792}); PH_END
  GRID_BAR();
  PH_BEGIN ph_cnorm_b(o.projA_b, I.a_kv_norm, o.cnb); PH_END
  PH_BEGIN pg8::GroupAOrder S; S.init(o.projA_b, 2048, o.Wql_t, 256, NT, 4096, 4, 512, G_, BIDX()); gemm_phase<EpiStore, pg8::GroupAOrder, true, true>(ll, Gemm{2048, 256, 256}, S, EpiStore{o.qlat, 4096}); PH_END
#ifdef ISC_HOT
  PH_BEGIN ph_iscore<ISC_HOT>(o.projA_b, o.kib, (unsigned short*)o.act, (unsigned*)(wsb_ + WS_CTL) + CW_ISC + 64, ll); PH_END
  GRID_BAR();
#endif
  PH_BEGIN ph_iscore(o.projA_b, o.kib, o.sc, (unsigned*)(wsb_ + WS_CTL) + CW_ISC, ll); PH_END
  GRID_BAR();
  PH_BEGIN ph_select_attend(o.sc, o.qlat, o.cnb, o.olat, ll, I.m_w1, I.m_w2, o.W1_t, o.W2_t, o.act); PH_END
  GRID_BAR();
#ifdef GBENCH
#if GBENCH == 5
  PH_BEGIN ph_select_attend<1>(o.sc, o.qlat, o.cnb, (bf16_t*)o.act, ll, I.m_w1, I.m_w2, o.W1_t, o.W2_t, o.act); PH_END
#elif GBENCH == 4
  PH_BEGIN { const int lane_ = TIDX() & 63, gw_ = BIDX() * 8 + (TIDX() >> 6); for (int wt = gw_; wt < 24576; wt += G_ * 8) { int lane_t = lane_; asm volatile("" : "+v"(lane_t)); moe_weight_tile<1>(wt < 12288 ? moe_layer_tile(0, wt) : moe_layer_tile(1, wt - 12288), I.m_w1, I.m_w2, o.W1_t, o.W2_t, lane_t, ll + (TIDX() >> 6) * 16384, (unsigned*)(wsb_ + 1968 * MiB)); } } PH_END
#elif GBENCH == 3
  PH_BEGIN { const int lane_ = TIDX() & 63, gw_ = BIDX() * 8 + (TIDX() >> 6); for (int wt = gw_; wt < 24576; wt += G_ * 8) { int lane_t = lane_; asm volatile("" : "+v"(lane_t)); moe_weight_tile(wt < 12288 ? moe_layer_tile(0, wt) : moe_layer_tile(1, wt - 12288), I.m_w1, I.m_w2, o.W1_t, o.W2_t, lane_t, ll + (TIDX() >> 6) * 16384); } } PH_END
#else
  PH_BEGIN ph_gbench(o.cnb, (unsigned*)(wsb_ + 1968 * MiB)); PH_END
#endif
  GRID_BAR();
#endif
  PH_BEGIN pg8::GroupAOrder S; S.init(o.olat, 4096, o.Wuv_t, 1024, NT, 1024, 1, 2048, G_, BIDX()); gemm_phase<EpiStore, pg8::GroupAOrder, true, true>(ll, Gemm{4096, 1024, 1024}, S, EpiStore{o.o2b, D}); PH_END
  GRID_BAR();
#if PROBE == 2
  PH_BEGIN cvt_bf16_to_f32(o.projA_b, 2048, w.projA, DINA, NT, DINA, gtid_, NGT_); PH_END
  GRID_BAR();
  PH_BEGIN nvp::np_cnorm(w.projA, I.a_kv_norm, w.cn); PH_END
  PH_BEGIN nvp::np_iscore(w.projA, w.sc, fl); PH_END
  GRID_BAR();
  PH_BEGIN nvp::np_topk(w.sc, w.idx, (char*)lds); PH_END
  GRID_BAR();
  PH_BEGIN nvp::np_dsa_attn(w.projA, w.cn, w.idx, I.a_w_uk, I.a_w_uv, w.o2, fl); PH_END
  GRID_BAR();
  PH_BEGIN { float* pd = (float*)(wsb_ + 1968 * MiB); for (size_t i = gtid_; i < (size_t)NT * D; i += NGT_) pd[i] = bf2f(o.o2b[i]) - w.o2[i]; } PH_END
  GRID_BAR();
#endif
  PH_BEGIN StaticOrder S; S.init(o.o2b, D, o.WoutA_t, D, NT, D, G_, BIDX()); gemm_phase<EpiStore, StaticOrder, true, true>(ll, Gemm{D, D, D}, S, EpiStore{o.hbf, D}); PH_END
  GRID_BAR();
  { LAYER_BODY(0) }
  { LAYER_BODY(1) }
#if PROBE == 2 || PROBE == 3
  GRID_BAR();
#if PROBE == 3
  PH_BEGIN { if (gtid_ == 0) { const unsigned fb = *(const unsigned*)(wsb_ + 512 * 1024); out_[5] += (float)fb; } const float* pd = (const float*)(wsb_ + 1968 * MiB); for (size_t i = gtid_; i < (size_t)NT * D; i += NGT_) out_[i] += PROBE_S * pd[i]; } PH_END
#else
  PH_BEGIN { const float* pd = (const float*)(wsb_ + 1968 * MiB); for (size_t i = gtid_; i < (size_t)NT * D; i += NGT_) out_[i] += PROBE_S * pd[i]; } PH_END
#endif
#endif
}

extern "C" void kernel_launch(void* const* d_in, const int* in_sizes, int n_in, void* d_out, int out_size, void* d_ws, size_t ws_size, hipStream_t stream) {
  static int grid = 0;
  if (grid == 0) {
    if (n_in != 21 || ws_size < WS_NEEDED) { fprintf(stderr, "kernel_launch: bad inputs (n_in %d) or workspace too small (%zu needed, %zu given)\n", n_in, (size_t)WS_NEEDED, ws_size); grid = -1; return; }
    int dev = 0, cus = 0, per_cu = 0;
    if (hipGetDevice(&dev) != hipSuccess || hipDeviceGetAttribute(&cus, hipDeviceAttributeMultiprocessorCount, dev) != hipSuccess) { grid = -1; return; }
    if (hipFuncSetAttribute((const void*)mk_fwd, hipFuncAttributeMaxDynamicSharedMemorySize, LDS_BYTES) != hipSuccess) { fprintf(stderr, "kernel_launch: hipFuncSetAttribute failed\n"); grid = -1; return; }
    if (hipOccupancyMaxActiveBlocksPerMultiprocessor(&per_cu, (const void*)mk_fwd, NTHR, LDS_BYTES) != hipSuccess || per_cu < 1) fprintf(stderr, "kernel_launch: note: occupancy query reports %d\n", per_cu);
    (void)hipGetLastError();
    grid = cus;
    if (grid != 256) fprintf(stderr, "kernel_launch: built for 256 CUs (token ownership per workgroup); got %d\n", grid);
  }
  if (grid < 0) return;
  if (hipMemsetAsync((char*)d_ws + WS_CTL, 0, CTL_ZERO_BYTES, stream) != hipSuccess) { fprintf(stderr, "kernel_launch: memset failed\n"); return; }
  Args a; memset(&a, 0, sizeof(a));
  const float** f = (const float**)&a.in;
  for (int i = 0; i < 21; ++i) f[i] = (const float*)d_in[i];
  a.out = (float*)d_out; a.ws = (unsigned char*)d_ws;
  hipLaunchKernelGGL(mk_fwd, dim3(grid), dim3(NTHR), LDS_BYTES, stream, a);
  const hipError_t le = hipPeekAtLastError();
  if (le != hipSuccess) fprintf(stderr, "kernel_launch: launch failed: %s\n", hipGetErrorName(le));
}
```

```cpp
#include <hip/hip_runtime.h>
#include <cstdio>
#include <cstdint>
#include <cstring>

#define GAS __attribute__((address_space(1)))
#define LAS __attribute__((address_space(3)))
#define NTHR 512
constexpr int LDS_BYTES = 147456;
constexpr int MISC_OFF = 131072 + 8192;

#define XB_TMO      128
#define XB_XCNT(j)  (256  + 64 * (j))
#define XB_XSUB(j)  (1280 + 64 * (j))
#define XB_XGEN(j)  (2304 + 64 * (j))
#define XB_TOP      3328
#define XB_TOPGEN   3392
#define XCD_BAR_WORDS 3456
#define XB_SPIN_CAP (1u << 25)
__device__ __forceinline__ unsigned xb_ld(unsigned* p)              { return __hip_atomic_load(p, __ATOMIC_RELAXED, __HIP_MEMORY_SCOPE_AGENT); }
__device__ __forceinline__ unsigned xb_add(unsigned* p, unsigned v) { return __hip_atomic_fetch_add(p, v, __ATOMIC_RELAXED, __HIP_MEMORY_SCOPE_AGENT); }
__device__ __forceinline__ unsigned xb_xcc_id() { return (unsigned)__builtin_amdgcn_s_getreg((3 << 11) | 20) & 0xFu; }
#define XB_SPIN(cond, bar) do { unsigned _sp = 0; while (cond) { __builtin_amdgcn_s_sleep(1); \
    if ((++_sp & 255u) == 0u) { if (xb_ld(&(bar)[XB_TMO])) break; if (_sp > XB_SPIN_CAP) { atomicAdd(&(bar)[XB_TMO], 1u); break; } } } } while (0)
struct XcdBarrier { unsigned* bar; unsigned x; volatile LAS unsigned* st; };
__device__ __forceinline__ XcdBarrier xcd_barrier_post(unsigned* bar, volatile LAS unsigned* st) {
    XcdBarrier b; b.bar = bar; b.x = xb_xcc_id(); b.st = st;
    if (threadIdx.x == 0) (void)xb_add(&bar[XB_XCNT(b.x)], 1u);
    return b;
}
__device__ __forceinline__ void xcd_barrier_complete(unsigned* bar, unsigned x, unsigned& nloc, unsigned& nx) {
    const unsigned G = gridDim.x * gridDim.y * gridDim.z;
    unsigned sum, cnt, mine, sp = 0u;
    for (;;) {
        sum = 0u; cnt = 0u; mine = 0u;
#pragma unroll
        for (unsigned j = 0; j < 16; ++j) { const unsigned c = xb_ld(&bar[XB_XCNT(j)]); sum += c; cnt += (c > 0u) ? 1u : 0u; mine = (j == x) ? c : mine; }
        if (sum == G) break;
        __builtin_amdgcn_s_sleep(1);
        if ((++sp & 255u) == 0u) { if (xb_ld(&bar[XB_TMO])) break; if (sp > XB_SPIN_CAP) { atomicAdd(&bar[XB_TMO], 1u); break; } }
    }
    nloc = mine > 0u ? mine : 1u; nx = cnt > 0u ? cnt : 1u;
}
__device__ __forceinline__ void xcd_barrier(const XcdBarrier& b) {
    asm volatile("s_waitcnt vmcnt(0)" ::: "memory");
    __syncthreads();
    if (threadIdx.x == 0) {
        unsigned* bar = b.bar;
        __builtin_amdgcn_s_waitcnt(0);
        unsigned nloc = b.st[0], nx = b.st[1];
        if (nloc == 0u) { xcd_barrier_complete(bar, b.x, nloc, nx); b.st[0] = nloc; b.st[1] = nx; }
        const unsigned old = xb_add(&bar[XB_XSUB(b.x)], 1u);
        const unsigned gen = old / nloc;
        if (old + 1u == (gen + 1u) * nloc) {
            __builtin_amdgcn_fence(__ATOMIC_RELEASE, "agent");
            asm volatile("s_waitcnt vmcnt(0)" ::: "memory");
            const unsigned og = xb_add(&bar[XB_TOP], 1u);
            const unsigned tg = og / nx;
            if (og + 1u == (tg + 1u) * nx) xb_add(&bar[XB_TOPGEN], 1u);
            else XB_SPIN(xb_ld(&bar[XB_TOPGEN]) == tg, bar);
            __builtin_amdgcn_fence(__ATOMIC_ACQUIRE, "agent");
            xb_add(&bar[XB_XGEN(b.x)], 1u);
            asm volatile("s_waitcnt vmcnt(0)" ::: "memory");
        } else {
            XB_SPIN(xb_ld(&bar[XB_XGEN(b.x)]) == gen, bar);
            __builtin_amdgcn_fence(__ATOMIC_ACQUIRE, "agent");
            asm volatile("s_waitcnt vmcnt(0)" ::: "memory");
        }
    }
    __syncthreads();
}

constexpr int NT = 16384, D = 1024, L = 8192, NB = 2;
constexpr int DINA = 1864, DINB = 3088;
constexpr int PMAX = 73728;
constexpr float ALPHA = 1.4142135623730951f;

struct In { const float *x, *a_w_in, *a_kv_norm, *a_w_uk, *a_w_uv, *a_w_out, *b_w_in, *b_w_g2, *b_g_bias, *b_norm, *b_w_out, *m_w_router, *m_b_router, *m_w1, *m_b1, *m_w2, *m_b2, *ln1_g, *ln1_b, *ln2_g, *ln2_b; };

__device__ __forceinline__ int TIDX() { int t = threadIdx.x; asm volatile("" : "+v"(t)); return t; }
__device__ __forceinline__ int BIDX() { int t = blockIdx.x; asm volatile("" : "+s"(t)); return t; }
__device__ __forceinline__ float wave_sum(float v) {
#pragma unroll
    for (int o = 1; o < 64; o <<= 1) v += __shfl_xor(v, o);
    return v;
}
namespace nvp {
#define WSYNC() asm volatile("s_waitcnt lgkmcnt(0)" ::: "memory")
struct GemmP {
  const float* A; int lda; const int* arow;
  const float* B; int ldb; float* C; int ldc; int M, N, K;
  const int* blk_e; const int* nblk_used; size_t bstride; const float* bias; size_t bias_stride;
};
__device__ __forceinline__ GemmP mkg(const float* A, int lda, const int* arow, const float* B, int ldb, float* C, int ldc, int M, int N, int K, const int* blk_e, const int* nblk_used, size_t bstride, const float* bias, size_t bias_stride) {
  GemmP p; p.A = A; p.lda = lda; p.arow = arow; p.B = B; p.ldb = ldb; p.C = C; p.ldc = ldc; p.M = M; p.N = N; p.K = K; p.blk_e = blk_e; p.nblk_used = nblk_used; p.bstride = bstride; p.bias = bias; p.bias_stride = bias_stride; return p; }

template <int MODE>
__device__ __forceinline__ void np_sgemm(const GemmP p, float* lds) {
  float (*As)[132] = (float (*)[132])lds;
  float (*Bs)[68] = (float (*)[68])(lds + 16 * 132);
  float (*Bu)[68] = (float (*)[68])(lds + 16 * 132 + 16 * 68);
  const int tid = TIDX(), tx = tid & 15, ty = tid >> 4;
  const int ntn = (p.N + 63) / 64, ntm = p.M / 128;
  const int ar = tid >> 2, ak = (tid & 3) * 4;
  const int bk = (tid & 255) >> 4, bn4 = (tid & 15) * 4;
  for (int t = BIDX(); t < ntm * ntn; t += gridDim.x) {
    const int bm = t / ntn, bn = t % ntn;
    const float* B = p.B; const float* bias = p.bias;
    if (MODE != 0) { const int blk = (bm * 128) / 256; if (blk >= *p.nblk_used) continue; const int e = p.blk_e[blk]; B += (size_t)e * p.bstride; bias += (size_t)e * p.bias_stride; }
    const int m0 = bm * 128, n0 = bn * 64;
    const int arow = p.arow ? p.arow[m0 + ar] : (m0 + ar);
    const float* Ap = p.A + (size_t)arow * p.lda + ak;
    const bool bok = (n0 + bn4) < p.N;
    float acc[4][4] = {}, accu[4][4] = {};
    for (int k0 = 0; k0 < p.K; k0 += 16) {
      const float4 av = *(const float4*)(Ap + k0);
      As[ak + 0][ar] = av.x; As[ak + 1][ar] = av.y; As[ak + 2][ar] = av.z; As[ak + 3][ar] = av.w;
      if (tid < 256) { float4 bv = make_float4(0.f, 0.f, 0.f, 0.f); if (bok) bv = *(const float4*)(B + (size_t)(k0 + bk) * p.ldb + n0 + bn4); *(float4*)&Bs[bk][bn4] = bv; }
      else if (MODE == 1) { const float4 uv = *(const float4*)(B + (size_t)(k0 + bk) * p.ldb + 1024 + n0 + bn4); *(float4*)&Bu[bk][bn4] = uv; }
      __syncthreads();
#pragma unroll
      for (int kk = 0; kk < 16; ++kk) {
        const float4 a = *(const float4*)&As[kk][ty * 4];
        const float4 b = *(const float4*)&Bs[kk][tx * 4];
        const float aa[4] = {a.x, a.y, a.z, a.w}, bb[4] = {b.x, b.y, b.z, b.w};
#pragma unroll
        for (int i = 0; i < 4; ++i)
#pragma unroll
          for (int j = 0; j < 4; ++j) acc[i][j] = fmaf(aa[i], bb[j], acc[i][j]);
        if (MODE == 1) {
          const float4 u = *(const float4*)&Bu[kk][tx * 4]; const float uu[4] = {u.x, u.y, u.z, u.w};
#pragma unroll
          for (int i = 0; i < 4; ++i)
#pragma unroll
            for (int j = 0; j < 4; ++j) accu[i][j] = fmaf(aa[i], uu[j], accu[i][j]);
        }
      }
      __syncthreads();
    }
#pragma unroll
    for (int i = 0; i < 4; ++i) {
      const int m = m0 + ty * 4 + i;
#pragma unroll
      for (int j = 0; j < 4; ++j) {
        const int n = n0 + tx * 4 + j; if (n >= p.N) continue;
        float v = acc[i][j];
        if (MODE == 1) {
          float g = v + bias[n], u = accu[i][j] + bias[1024 + n];
          g = fminf(g, 7.f); u = fminf(fmaxf(u, -7.f), 7.f);
          const float glu = g / (1.f + expf(-1.702f * g));
          v = (u + 1.f) * glu;
        } else if (MODE == 2) v += bias[n];
        p.C[(size_t)m * p.ldc + n] = v;
      }
    }
  }
}

#define GW_INIT const int lane = TIDX() & 63, wave = TIDX() >> 6, gw = BIDX() * 8 + wave, NGW = gridDim.x * 8; (void)lane; (void)wave; (void)gw; (void)NGW

__device__ __forceinline__ void np_cnorm(const float* projA, const float* g, float* cn) {
  GW_INIT;
  for (int row = gw; row < NT; row += NGW) {
    const float4 v = *(const float4*)(projA + (size_t)row * DINA + 1024 + lane * 4);
    const float ss = wave_sum(v.x * v.x + v.y * v.y + v.z * v.z + v.w * v.w);
    const float r = rsqrtf(ss * (1.f / 256.f) + 1e-6f); const float4 g4 = *(const float4*)(g + lane * 4);
    *(float4*)(cn + (size_t)row * 256 + lane * 4) = make_float4(v.x * r * g4.x, v.y * r * g4.y, v.z * r * g4.z, v.w * r * g4.w);
  }
}

__device__ __forceinline__ void np_iscore(const float* projA, float* sc, float* lds) {
  float (*As)[132] = (float (*)[132])lds;
  float (*Bs)[68] = (float (*)[68])(lds + 16 * 132);
  const int tid = TIDX(), tx = tid & 15, ty = tid >> 4;
  const int ar = tid >> 2, ak = (tid & 3) * 4;
  const int br = (tid & 255) >> 2;
  for (int u = BIDX(); u < NB * 64 * 128; u += gridDim.x) {
    const int b = u / (64 * 128), tt = (u / 128) % 64, st = u % 128;
    if (st > 2 * tt + 1) continue;
    const int t0 = tt * 128, s0 = st * 64;
    const float* Qp = projA + (size_t)(b * L + t0 + ar) * DINA + 1280 + ak;
    const float* Kp = projA + (size_t)(b * L + s0 + br) * DINA + 1792 + ak;
    float score[4][4] = {};
    for (int h = 0; h < 8; ++h) {
      float acc[4][4] = {};
      for (int k0 = 0; k0 < 64; k0 += 16) {
        const float4 av = *(const float4*)(Qp + h * 64 + k0);
        As[ak + 0][ar] = av.x; As[ak + 1][ar] = av.y; As[ak + 2][ar] = av.z; As[ak + 3][ar] = av.w;
        if (tid < 256) { const float4 bv = *(const float4*)(Kp + k0); Bs[ak + 0][br] = bv.x; Bs[ak + 1][br] = bv.y; Bs[ak + 2][br] = bv.z; Bs[ak + 3][br] = bv.w; }
        __syncthreads();
#pragma unroll
        for (int kk = 0; kk < 16; ++kk) {
          const float4 a = *(const float4*)&As[kk][ty * 4]; const float4 bq = *(const float4*)&Bs[kk][tx * 4];
          const float aa[4] = {a.x, a.y, a.z, a.w}, bb[4] = {bq.x, bq.y, bq.z, bq.w};
#pragma unroll
          for (int i = 0; i < 4; ++i)
#pragma unroll
            for (int j = 0; j < 4; ++j) acc[i][j] = fmaf(aa[i], bb[j], acc[i][j]);
        }
        __syncthreads();
      }
#pragma unroll
      for (int i = 0; i < 4; ++i) {
        const float w = projA[(size_t)(b * L + t0 + ty * 4 + i) * DINA + 1856 + h] * 0.35355339059327373f;
#pragma unroll
        for (int j = 0; j < 4; ++j) score[i][j] += w * fmaxf(acc[i][j] * 0.125f, 0.f);
      }
    }
#pragma unroll
    for (int i = 0; i < 4; ++i)
#pragma unroll
      for (int j = 0; j < 4; ++j) sc[((size_t)(b * L + t0 + ty * 4 + i)) * L + s0 + tx * 4 + j] = score[i][j];
  }
}

__device__ __forceinline__ unsigned f2key(float f) { f = f + 0.0f; const unsigned u = __float_as_uint(f); return (u & 0x80000000u) ? ~u : (u | 0x80000000u); }

__device__ __forceinline__ void np_topk(const float* sc, int* idx_out, char* lds) {
  GW_INIT;
  unsigned* hist = (unsigned*)(lds + wave * 1280); unsigned* cntw = hist + 256;
  for (int row = gw; row < NT; row += NGW) {
    const int t = row % L, n = t + 1;
    const float* s = sc + (size_t)row * L; int* out = idx_out + (size_t)row * 256;
    if (n <= 256) { for (int i = lane; i < 256; i += 64) out[i] = i < n ? i : -1; continue; }
    unsigned prefix = 0, need = 256;
    for (int pass = 3; pass >= 0; --pass) {
      const int shift = pass * 8;
      for (int i = lane; i < 256; i += 64) hist[i] = 0;
      WSYNC();
      for (int i = lane; i < n; i += 64) { const unsigned k = f2key(s[i]); const bool m = (pass == 3) || ((k >> (shift + 8)) == (prefix >> (shift + 8))); if (m) atomicAdd(&hist[(k >> shift) & 255u], 1u); }
      WSYNC();
      unsigned cum = 0; int d = 255; for (; d > 0; --d) { const unsigned hv = hist[d]; if (cum + hv >= need) break; cum += hv; }
      prefix |= ((unsigned)d << shift); need -= cum;
      WSYNC();
    }
    if (lane == 0) *cntw = 0; WSYNC();
    for (int i = lane; i < n; i += 64) { if (f2key(s[i]) > prefix) { const unsigned pos = atomicAdd(cntw, 1u); out[pos] = i; } }
    WSYNC();
    if (lane == 0) { unsigned c = *cntw; unsigned nd = need; for (int i = 0; i < n && nd > 0; ++i) if (f2key(s[i]) == prefix) { out[c++] = i; --nd; } }
    WSYNC();
  }
}

__device__ __forceinline__ void np_dsa_attn(const float* projA, const float* cn, const int* idx, const float* w_uk, const float* w_uv, float* o2, float* lds) {
  const int half = TIDX() >> 8, tid = TIDX() & 255;
  float* base = lds + half * 14336;
  float* qs = base; float (*ql)[256] = (float (*)[256])(base + 1024); float (*pr)[257] = (float (*)[257])(base + 1024 + 4096);
  float (*ol)[256] = (float (*)[256])(base + 1024 + 4096 + 4112); float* red = base + 1024 + 4096 + 4112 + 4096; int* sid = (int*)(red + 16);
  for (int r0 = BIDX() * 2; r0 < NT; r0 += gridDim.x * 2) {
    const int row = r0 + half, b = row / L;
    __syncthreads();
    for (int i = tid; i < 1024; i += 256) qs[i] = projA[(size_t)row * DINA + i];
    sid[tid] = idx[(size_t)row * 256 + tid];
    __syncthreads();
    { const int c = tid;
#pragma unroll 1
      for (int h = 0; h < 16; ++h) { float a = 0.f;
#pragma unroll 8
        for (int d = 0; d < 64; ++d) a = fmaf(qs[h * 64 + d], w_uk[((size_t)h * 64 + d) * 256 + c], a); ql[h][c] = a; } }
    __syncthreads();
    { const int k = tid, key = sid[k];
      float lg[16];
      if (key >= 0) { const float* cr = cn + (size_t)(b * L + key) * 256;
        for (int h = 0; h < 16; ++h) lg[h] = 0.f;
#pragma unroll 2
        for (int c = 0; c < 256; ++c) { const float cv = cr[c];
#pragma unroll
          for (int h = 0; h < 16; ++h) lg[h] = fmaf(ql[h][c], cv, lg[h]); }
#pragma unroll
        for (int h = 0; h < 16; ++h) pr[h][k] = lg[h] * 0.125f;
      } else {
#pragma unroll
        for (int h = 0; h < 16; ++h) pr[h][k] = -INFINITY; } }
    __syncthreads();
    if (tid < 16) { const int h = tid; float m = -INFINITY; for (int k = 0; k < 256; ++k) m = fmaxf(m, pr[h][k]); float su = 0.f; for (int k = 0; k < 256; ++k) { const float e = expf(pr[h][k] - m); pr[h][k] = e; su += e; } red[h] = 1.f / su; }
    __syncthreads();
    { const int c = tid; float a[16];
#pragma unroll
      for (int h = 0; h < 16; ++h) a[h] = 0.f;
#pragma unroll 2
      for (int k = 0; k < 256; ++k) { const int key = sid[k]; if (key < 0) continue; const float cv = cn[(size_t)(b * L + key) * 256 + c];
#pragma unroll
        for (int h = 0; h < 16; ++h) a[h] = fmaf(pr[h][k], cv, a[h]); }
#pragma unroll
      for (int h = 0; h < 16; ++h) ol[h][c] = a[h] * red[h]; }
    __syncthreads();
#pragma unroll 1
    for (int o = tid; o < 1024; o += 256) { const int h = o >> 6, v = o & 63; float a = 0.f;
#pragma unroll 8
      for (int c = 0; c < 256; ++c) a = fmaf(ol[h][c], w_uv[((size_t)h * 256 + c) * 64 + v], a); o2[(size_t)row * 1024 + o] = a; }
  }
  __syncthreads();
}

__device__ __forceinline__ void np_ln_res(const float* x, const float* h, const float* g, const float* bb, float* out) {
  GW_INIT;
  for (int row = gw; row < NT; row += NGW) {
    float4 v[4]; float s = 0.f;
#pragma unroll
    for (int j = 0; j < 4; ++j) { const float4 a = *(const float4*)(x + (size_t)row * D + lane * 4 + 256 * j), hh = *(const float4*)(h + (size_t)row * D + lane * 4 + 256 * j);
      v[j] = make_float4(ALPHA * a.x + hh.x, ALPHA * a.y + hh.y, ALPHA * a.z + hh.z, ALPHA * a.w + hh.w); s += (v[j].x + v[j].y) + (v[j].z + v[j].w); }
    const float mu = wave_sum(s) * (1.f / D); float q = 0.f;
#pragma unroll
    for (int j = 0; j < 4; ++j) { v[j].x -= mu; v[j].y -= mu; v[j].z -= mu; v[j].w -= mu; q += (v[j].x * v[j].x + v[j].y * v[j].y) + (v[j].z * v[j].z + v[j].w * v[j].w); }
    const float r = rsqrtf(wave_sum(q) * (1.f / D) + 1e-5f);
#pragma unroll
    for (int j = 0; j < 4; ++j) { const int c = lane * 4 + 256 * j; const float4 g4 = *(const float4*)(g + c), b4 = *(const float4*)(bb + c);
      *(float4*)(out + (size_t)row * D + c) = make_float4(v[j].x * r * g4.x + b4.x, v[j].y * r * g4.y + b4.y, v[j].z * r * g4.z + b4.z, v[j].w * r * g4.w + b4.w); }
  }
}

__device__ __forceinline__ void np_router(const float* x, const float* wr, const float* br, int* tok_e, float* tok_g, int* counts, int* row_tok, char* lds) {
  GW_INIT;
  for (int i = BIDX() * NTHR + TIDX(); i < PMAX; i += gridDim.x * NTHR) row_tok[i] = 0;
  float* lg = (float*)(lds + wave * 256);
  const int e = lane & 31, hf = lane >> 5;
  for (int tok = gw; tok < NT; tok += NGW) {
    const float* xr = x + (size_t)tok * D + hf * 512; const float* wp = wr + (size_t)hf * 512 * 32 + e; float a = 0.f;
#pragma unroll 8
    for (int d = 0; d < 512; ++d) a = fmaf(xr[d], wp[d * 32], a);
    a += __shfl_xor(a, 32);
    if (hf == 0) lg[e] = a + br[e];
    WSYNC();
    if (lane == 0) { int ei[4]; float ev[4];
      for (int k = 0; k < 4; ++k) { int bi = 0; float bv = -INFINITY; for (int j = 0; j < 32; ++j) if (lg[j] > bv) { bv = lg[j]; bi = j; } ei[k] = bi; ev[k] = bv; lg[bi] = -INFINITY; }
      float su = 0.f, ex[4]; for (int k = 0; k < 4; ++k) { ex[k] = expf(ev[k] - ev[0]); su += ex[k]; }
      for (int k = 0; k < 4; ++k) { tok_e[tok * 4 + k] = ei[k]; tok_g[tok * 4 + k] = ex[k] / su; atomicAdd(&counts[ei[k]], 1); } }
    WSYNC();
  }
}
__device__ __forceinline__ void np_moe_sort(const int* tok_e, const float* tok_g, const int* counts, int* row_tok, float* row_gate, int* slot_of, int* blk_e, int* nblk_used, char* lds) {
  if (BIDX() != 0) return;
  const int e = TIDX(); int* pstart = (int*)lds; int* stage = pstart + 64;
  if (e == 0) { int acc = 0; for (int j = 0; j < 32; ++j) { pstart[j] = acc; const int nb = (counts[j] + 255) / 256; for (int q = 0; q < nb; ++q) blk_e[acc / 256 + q] = j; acc += nb * 256; } pstart[32] = acc; *nblk_used = acc / 256; }
  __syncthreads();
  int pos = e < 32 ? pstart[e] : 0;
  for (int c0 = 0; c0 < NT * 4; c0 += 2048) {
    __syncthreads();
    for (int i = e; i < 2048; i += NTHR) stage[i] = tok_e[c0 + i];
    __syncthreads();
    if (e < 32) for (int i = 0; i < 2048; ++i) if (stage[i] == e) { const int gi = c0 + i; row_tok[pos] = gi >> 2; row_gate[pos] = tok_g[gi]; slot_of[gi] = pos; ++pos; }
  }
  __syncthreads();
}
__device__ __forceinline__ void np_moe_combine_ln(const float* x1, const float* ys, const int* slot_of, const float* tok_g, const float* g, const float* bb, float* out) {
  GW_INIT;
  for (int row = gw; row < NT; row += NGW) {
    float4 v[4]; float s = 0.f; int sl[4]; float gg[4];
#pragma unroll
    for (int k = 0; k < 4; ++k) { sl[k] = slot_of[row * 4 + k]; gg[k] = tok_g[row * 4 + k]; }
#pragma unroll
    for (int j = 0; j < 4; ++j) { const int c = lane * 4 + 256 * j; float4 f = make_float4(0.f, 0.f, 0.f, 0.f);
#pragma unroll
      for (int k = 0; k < 4; ++k) { const float4 y = *(const float4*)(ys + (size_t)sl[k] * D + c); f.x += gg[k] * y.x; f.y += gg[k] * y.y; f.z += gg[k] * y.z; f.w += gg[k] * y.w; }
      const float4 a = *(const float4*)(x1 + (size_t)row * D + c);
      v[j] = make_float4(ALPHA * a.x + f.x, ALPHA * a.y + f.y, ALPHA * a.z + f.z, ALPHA * a.w + f.w); s += (v[j].x + v[j].y) + (v[j].z + v[j].w); }
    const float mu = wave_sum(s) * (1.f / D); float q = 0.f;
#pragma unroll
    for (int j = 0; j < 4; ++j) { v[j].x -= mu; v[j].y -= mu; v[j].z -= mu; v[j].w -= mu; q += (v[j].x * v[j].x + v[j].y * v[j].y) + (v[j].z * v[j].z + v[j].w * v[j].w); }
    const float r = rsqrtf(wave_sum(q) * (1.f / D) + 1e-5f);
#pragma unroll
    for (int j = 0; j < 4; ++j) { const int c = lane * 4 + 256 * j; const float4 g4 = *(const float4*)(g + c), b4 = *(const float4*)(bb + c);
      *(float4*)(out + (size_t)row * D + c) = make_float4(v[j].x * r * g4.x + b4.x, v[j].y * r * g4.y + b4.y, v[j].z * r * g4.z + b4.z, v[j].w * r * g4.w + b4.w); }
  }
}

__device__ __forceinline__ void np_gla_gate(const float* projB, const float* w_g2, const float* gb, float* adec) {
  GW_INIT;
  for (int row = gw; row < NT; row += NGW) {
    float glr[16];
#pragma unroll
    for (int j = 0; j < 16; ++j) glr[j] = projB[(size_t)row * DINB + 2048 + j];
    for (int c = lane; c < 512; c += 64) { float a = gb[c];
#pragma unroll
      for (int j = 0; j < 16; ++j) a = fmaf(glr[j], w_g2[j * 512 + c], a);
      const float ls = fminf(a, 0.f) - log1pf(expf(-fabsf(a))); adec[(size_t)row * 512 + c] = expf(ls * (1.f / 16.f)); }
  }
}
__device__ __forceinline__ void np_gla_scan(const float* projB, const float* adec, float* og, float* lds) {
  if (BIDX() >= 8) return;
  const int b = BIDX() >> 2, h = BIDX() & 3, tid = TIDX(), dv = tid & 255, dh = tid >> 8;
  float (*qs)[128] = (float (*)[128])lds; float (*ks)[128] = (float (*)[128])(lds + 2048); float (*as)[128] = (float (*)[128])(lds + 4096);
  float (*po)[16][256] = (float (*)[16][256])(lds + 6144);
  float S[64];
#pragma unroll
  for (int d = 0; d < 64; ++d) S[d] = 0.f;
  for (int t0 = 0; t0 < L; t0 += 16) {
    __syncthreads();
    for (int i = tid; i < 16 * 128; i += NTHR) { const int tt = i >> 7, d = i & 127; const size_t r = (size_t)(b * L + t0 + tt);
      qs[tt][d] = projB[r * DINB + h * 128 + d] * 0.08838834764831845f; ks[tt][d] = projB[r * DINB + 512 + h * 128 + d]; as[tt][d] = adec[r * 512 + h * 128 + d]; }
    __syncthreads();
#pragma unroll 1
    for (int tt = 0; tt < 16; ++tt) { const size_t r = (size_t)(b * L + t0 + tt); const float v = projB[r * DINB + 1024 + h * 256 + dv]; float o = 0.f;
#pragma unroll
      for (int d = 0; d < 64; ++d) { S[d] = fmaf(as[tt][dh * 64 + d], S[d], ks[tt][dh * 64 + d] * v); o = fmaf(qs[tt][dh * 64 + d], S[d], o); }
      po[dh][tt][dv] = o; }
    __syncthreads();
    for (int i = tid; i < 16 * 256; i += NTHR) { const int tt = i >> 8, c = i & 255; og[(size_t)(b * L + t0 + tt) * 1024 + h * 256 + c] = po[0][tt][c] + po[1][tt][c]; }
  }
  __syncthreads();
}
__device__ __forceinline__ void np_gla_norm(const float* og, const float* projB, const float* ng, float* on) {
  GW_INIT;
  for (int u = gw; u < NT * 4; u += NGW) {
    const int row = u >> 2, h = u & 3; const int c = h * 256 + lane * 4;
    const float4 v = *(const float4*)(og + (size_t)row * 1024 + c);
    const float r = rsqrtf(wave_sum(v.x * v.x + v.y * v.y + v.z * v.z + v.w * v.w) * (1.f / 256.f) + 1e-6f);
    const float4 rr = *(const float4*)(projB + (size_t)row * DINB + 2064 + c), g4 = *(const float4*)(ng + c);
    *(float4*)(on + (size_t)row * 1024 + c) = make_float4(v.x * r * g4.x * (rr.x / (1.f + expf(-rr.x))), v.y * r * g4.y * (rr.y / (1.f + expf(-rr.y))), v.z * r * g4.z * (rr.z / (1.f + expf(-rr.z))), v.w * r * g4.w * (rr.w / (1.f + expf(-rr.w))));
  }
}

struct Ws { float *projA, *cn, *sc, *o2, *h, *x1, *x2, *hb, *ys, *projB, *adec, *og, *on, *tok_g, *row_gate; int *idx, *tok_e, *slot_of, *row_tok, *blk_e, *counts; };
}
typedef unsigned short bf16_t;
typedef unsigned v4u __attribute__((ext_vector_type(4)));
typedef unsigned v2u __attribute__((ext_vector_type(2)));
typedef float f32x4 __attribute__((ext_vector_type(4)));
typedef short bf16x8 __attribute__((ext_vector_type(8)));
typedef float f32x2_t __attribute__((ext_vector_type(2))); typedef __bf16 bf16x2_t __attribute__((ext_vector_type(2)));
__device__ __forceinline__ unsigned cvt_pk_bf16(float lo, float hi) { const f32x2_t v = {lo, hi}; const bf16x2_t b = __builtin_convertvector(v, bf16x2_t); return __builtin_bit_cast(unsigned, b); }
__device__ __forceinline__ float bf_lo(unsigned u) { return __uint_as_float(u << 16); }
__device__ __forceinline__ float bf_hi(unsigned u) { return __uint_as_float(u & 0xffff0000u); }
__device__ __forceinline__ float bf2f(bf16_t h) { return __uint_as_float(((unsigned)h) << 16); }

struct TJob { const float* src; int lds_; int K, N; bf16_t* dst; int ldd; int drow0, dcol0; int rowmap; int ntk, ntn; };
__device__ __forceinline__ TJob mk_tjob(const float* src, int lds_, int K, int N, bf16_t* dst, int ldd, int drow0, int dcol0, int rowmap) {
  TJob j; j.src = src; j.lds_ = lds_; j.K = K; j.N = N; j.dst = dst; j.ldd = ldd; j.drow0 = drow0; j.dcol0 = dcol0; j.rowmap = rowmap; j.ntk = K / 64; j.ntn = (N + 127) / 128; return j; }
__device__ __forceinline__ int tjob_tiles(const TJob& j) { return j.ntk * j.ntn; }
template <int NOST = 0> __device__ __forceinline__ void transpose_tile(const TJob& j, int tile, int lane, LAS unsigned char* stage, unsigned* sink = nullptr) {
  const int kt = tile / j.ntn, nt_ = tile % j.ntn, k0 = kt * 64, n0 = nt_ * 128;
  const int q = lane & 31, par = lane >> 5;
  const bool ok = (n0 + 4 * q) < j.N;
  f32x4 v[32];
  const float* sp = j.src + (size_t)(k0 + par) * j.lds_ + (ok ? n0 + 4 * q : 0);
#pragma unroll
  for (int i = 0; i < 32; ++i) v[i] = __builtin_nontemporal_load((const f32x4*)(sp + (size_t)(2 * i) * j.lds_));
  __builtin_amdgcn_sched_barrier(0);
  unsigned ra[32], rb[32];
#pragma unroll
  for (int i = 0; i < 32; ++i) {
    auto s0 = __builtin_amdgcn_permlane32_swap(__float_as_uint(v[i][0]), __float_as_uint(v[i][2]), false, false);
    auto s1 = __builtin_amdgcn_permlane32_swap(__float_as_uint(v[i][1]), __float_as_uint(v[i][3]), false, false);
    ra[i] = cvt_pk_bf16(__uint_as_float(s0[0]), __uint_as_float(s0[1]));
    rb[i] = cvt_pk_bf16(__uint_as_float(s1[0]), __uint_as_float(s1[1]));
  }
  if (NOST) { unsigned x = 0u;
#pragma unroll
    for (int i = 0; i < 32; ++i) x ^= ra[i] ^ rb[i];
    if (x == 0x12345678u) sink[lane] = x; return; }
  { const unsigned sw = (unsigned)(q & 7); LAS unsigned char* wp = stage + (4 * q + 2 * par) * 128;
#pragma unroll
    for (int c = 0; c < 8; ++c) { *(LAS v4u*)(wp + 16 * ((unsigned)c ^ sw)) = (v4u){ra[4 * c], ra[4 * c + 1], ra[4 * c + 2], ra[4 * c + 3]}; *(LAS v4u*)(wp + 128 + 16 * ((unsigned)c ^ sw)) = (v4u){rb[4 * c], rb[4 * c + 1], rb[4 * c + 2], rb[4 * c + 3]}; } }
  const int jj = lane & 7, rl = lane >> 3;
  v4u d[16];
#pragma unroll
  for (int c2 = 0; c2 < 16; ++c2) { const int r = 8 * c2 + rl; d[c2] = *(const LAS v4u*)(stage + r * 128 + 16 * (jj ^ ((r >> 2) & 7))); }
#pragma unroll
  for (int c2 = 0; c2 < 16; ++c2) { const int n = n0 + 8 * c2 + rl;
    if (n < j.N) { int rr = n; if (j.rowmap == 1) { const int j0 = rr & 1023; rr = 256 * (j0 >> 7) + ((rr >> 10) << 7) + (j0 & 127); }
      __builtin_nontemporal_store(d[c2], (v4u*)(j.dst + (size_t)(j.drow0 + rr) * j.ldd + j.dcol0 + k0 + 8 * jj)); } }
  asm volatile("s_waitcnt lgkmcnt(0)" ::: "memory");
}
__device__ __forceinline__ void transpose_job(const TJob j, int& w0, int gw, int NGW, int lane, LAS unsigned char* stage) {
  const int nt_ = tjob_tiles(j);
  int first = gw - (w0 % NGW); if (first < 0) first += NGW;
#pragma unroll 1
  for (int t = first; t < nt_; t += NGW) transpose_tile(j, t, lane, stage);
  w0 += nt_;
}
__device__ __forceinline__ void zero_rect(bf16_t* dst, int ldd, int r0, int nr, int cb0, int nbytes, int gtid, int NGT) {
  const int per = nbytes / 16;
  for (int i = gtid; i < nr * per; i += NGT) { const int r = i / per, c = i % per; *(v4u*)((char*)(dst + (size_t)(r0 + r) * ldd) + cb0 + 16 * c) = (v4u){0u, 0u, 0u, 0u}; }
}
__device__ __forceinline__ void cvt_f32_to_bf16(const float* src, int lds_, bf16_t* dst, int ldd, int rows, int ncols, int gtid, int NGT) {
  const int per = ncols / 4;
  for (size_t i = gtid; i < (size_t)rows * per; i += NGT) { const size_t r = i / per; const int c = (int)(i % per) * 4; const f32x4 v = *(const f32x4*)(src + r * lds_ + c);
    *(v2u*)(dst + r * ldd + c) = (v2u){cvt_pk_bf16(v[0], v[1]), cvt_pk_bf16(v[2], v[3])}; }
}
__device__ __forceinline__ void cvt_f32_to_bf16_flat(const float* src, bf16_t* dst, size_t n4, int gtid, int NGT) {
#pragma unroll 1
  for (size_t base = (size_t)gtid; base < n4; base += (size_t)NGT * 8) { f32x4 v[8];
#pragma unroll
    for (int k = 0; k < 8; ++k) { const size_t i = base + (size_t)k * NGT; v[k] = __builtin_nontemporal_load((const f32x4*)(src + 4 * (i < n4 ? i : base))); }
#pragma unroll
    for (int k = 0; k < 8; ++k) { const size_t i = base + (size_t)k * NGT; if (i < n4) *(v2u*)(dst + 4 * i) = (v2u){cvt_pk_bf16(v[k][0], v[k][1]), cvt_pk_bf16(v[k][2], v[k][3])}; } }
}
__device__ __forceinline__ void cvt_bf16_to_f32(const bf16_t* src, int lds_, float* dst, int ldd, int rows, int ncols, int gtid, int NGT) {
  const int per = ncols / 4;
  for (size_t i = gtid; i < (size_t)rows * per; i += NGT) { const size_t r = i / per; const int c = (int)(i % per) * 4; const v2u v = *(const v2u*)(src + r * lds_ + c);
    *(f32x4*)(dst + r * ldd + c) = (f32x4){bf_lo(v[0]), bf_hi(v[0]), bf_lo(v[1]), bf_hi(v[1])}; }
}

namespace pg8 {
#define PG8_LAS __attribute__((address_space(3)))
typedef unsigned u32x4 __attribute__((ext_vector_type(4)));
constexpr int BM = 256, BK = 64, HALF = 128, HTB = HALF * BK * 2, STAGE_BYTES = 8 * HTB, NXCD = 8, WGM = 8;
__host__ __device__ __forceinline__ int lds_byte(int r, int c) { const int st = (r >> 4) * 2 + (c >> 5), rr = r & 15, cc = c & 31, ob = rr * 64 + cc * 2; return st * 1024 + (ob ^ (((ob >> 9) & 1) << 5)); }
__host__ __device__ __forceinline__ void stage_rc(int b, int& R, int& C) { const int st = b / 1024, sb = b % 1024, swz = sb ^ (((sb >> 9) & 1) << 5); R = (st >> 1) * 16 + swz / 64; C = (st & 1) * 32 + (swz % 64) / 2; }
__host__ __device__ __forceinline__ int perm32(int rho) { const int n = rho >> 4, i = rho & 15; return 8 * (i >> 2) + 4 * n + (i & 3); }
struct Unit { const char* pa; const char* pb; int orow, ocol, e, kind; };
struct Gemm { int lda, ldb, K; };
struct StaticOrder {
    static constexpr bool GATHER = false; const int* rowmap;
    const char* A; const char* Bt; size_t ta, tb; int nM, nN, nwg, G, c;
    __device__ void init(const void* A_, int lda, const void* Bt_, int ldb, int M, int N, int G_, int c_) { A = (const char*)A_; Bt = (const char*)Bt_; ta = (size_t)BM * lda * 2; tb = (size_t)BM * ldb * 2; nM = M / BM; nN = N / BM; nwg = nM * nN; G = G_; c = c_; }
    __device__ bool tile(int i, int& pm, int& pn) const {
        const long L = (long)i * G + c; if (L >= nwg) return false;
        int wgid = (int)L; { const int q = nwg / NXCD, r = nwg % NXCD, xcd = wgid % NXCD, off = wgid / NXCD; wgid = (xcd < r ? xcd * (q + 1) : r * (q + 1) + (xcd - r) * q) + off; }
        const int nig = WGM * nN, gid = wgid / nig, fm = gid * WGM, gsz = (nM - fm) < WGM ? (nM - fm) : WGM;
        pm = fm + ((wgid % nig) % gsz); pn = (wgid % nig) / gsz; return true;
    }
    __device__ bool next(int i, Unit& u) const { int pm, pn; if (!tile(i, pm, pn)) return false; u.pa = A + (size_t)pm * ta; u.pb = Bt + (size_t)pn * tb; u.orow = pm * BM; u.ocol = pn * BM; u.e = 0; u.kind = 0; return true; }
    __device__ __forceinline__ int rowof(const Unit&, int r) const { return r; }
    __device__ __forceinline__ void a_ready(const Unit&) const {}
    __device__ __forceinline__ void done(const Unit&) const {}
};
struct EpiStore {
    static constexpr bool PERM = true, AFTER_DRAIN = false;
    bf16_t* O; int ldc;
    __device__ __forceinline__ void operator()(const f32x4 (&acc)[2][2][4][2], const Unit& u, int wr, int wc, int fr, int fq) const {
        const int row0 = u.orow + wr * 64 + fr, col0 = u.ocol + wc * 32 + 8 * fq;
#pragma unroll
        for (int ai = 0; ai < 2; ++ai)
#pragma unroll
            for (int m = 0; m < 4; ++m) { bf16_t* rowp = O + (size_t)(row0 + ai * HALF + m * 16) * ldc + col0;
#pragma unroll
                for (int bj = 0; bj < 2; ++bj) { const f32x4 v0 = acc[ai][bj][m][0], v1 = acc[ai][bj][m][1];
                    u32x4 w; w.x = cvt_pk_bf16(v0[0], v0[1]); w.y = cvt_pk_bf16(v0[2], v0[3]); w.z = cvt_pk_bf16(v1[0], v1[1]); w.w = cvt_pk_bf16(v1[2], v1[3]);
                    *(u32x4*)(rowp + bj * HALF) = w; } }
    }
};
struct EpiStoreKi {
    static constexpr bool PERM = true, AFTER_DRAIN = false;
    bf16_t* O; int ldc; bf16_t* Ki; int kcol;
    __device__ __forceinline__ void operator()(const f32x4 (&acc)[2][2][4][2], const Unit& u, int wr, int wc, int fr, int fq) const {
        const int row0 = u.orow + wr * 64 + fr, col0 = u.ocol + wc * 32 + 8 * fq;
        const bool kt = (u.ocol == kcol) && (wc < 2);
#pragma unroll
        for (int ai = 0; ai < 2; ++ai)
#pragma unroll
            for (int m = 0; m < 4; ++m) { bf16_t* rowp = O + (size_t)(row0 + ai * HALF + m * 16) * ldc + col0;
#pragma unroll
                for (int bj = 0; bj < 2; ++bj) { const f32x4 v0 = acc[ai][bj][m][0], v1 = acc[ai][bj][m][1];
                    u32x4 w; w.x = cvt_pk_bf16(v0[0], v0[1]); w.y = cvt_pk_bf16(v0[2], v0[3]); w.z = cvt_pk_bf16(v1[0], v1[1]); w.w = cvt_pk_bf16(v1[2], v1[3]);
                    *(u32x4*)(rowp + bj * HALF) = w;
                    if (bj == 0 && kt) *(u32x4*)(Ki + (size_t)(row0 + ai * HALF + m * 16) * 64 + wc * 32 + 8 * fq) = w; } }
    }
};
template <class Epi, class Sched, bool ALIGN_EPI = false, bool SP2 = false>
__device__ __forceinline__ void gemm_phase(PG8_LAS unsigned char* lds, const Gemm g, const Sched& S, const Epi& E) {
    const int tid = TIDX(), wid = __builtin_amdgcn_readfirstlane(tid >> 6), lane = tid & 63, wr = wid >> 2, wc = wid & 3, fr = lane & 15, fq = lane >> 4;
    const int K = g.K, nt = K / BK;
    unsigned voffA[2], voffB[2];
#pragma unroll
    for (int i = 0; i < 2; ++i) { int R, C; stage_rc(tid * 16 + i * 8192, R, C); const int Rb = Epi::PERM ? ((R & ~31) + perm32(R & 31)) : R;
        voffA[i] = (unsigned)(R * g.lda + C) * 2u; voffB[i] = (unsigned)(Rb * g.ldb + C) * 2u; }
    unsigned voffG[2][2][2]; int gR[2], gC[2];
#pragma unroll
    for (int i = 0; i < 2; ++i) { int R, C; stage_rc(tid * 16 + i * 8192, R, C); gR[i] = R; gC[i] = C; }
#define PG8_GOFF(dst, unit_) do { if constexpr (Sched::GATHER) { _Pragma("unroll") for (int _h = 0; _h < 2; ++_h) _Pragma("unroll") for (int _i = 0; _i < 2; ++_i) \
        dst[_h][_i] = (unsigned)S.rowof(unit_, (unit_).orow + _h * HALF + gR[_i]) * (unsigned)(g.lda * 2) + (unsigned)gC[_i] * 2u; } } while (0)
#define PG8_STAGE_A(bufoff, gptr, half, vsel) do { if constexpr (Sched::GATHER) { PG8_STAGE(bufoff, gptr, vsel); } else { PG8_STAGE(bufoff, (gptr) + (half) * hstepA, voffA); } } while (0)
    const size_t kstep = (size_t)(BK * 2);
    const size_t hstepA = (size_t)HALF * g.lda * 2, hstepB = (size_t)HALF * g.ldb * 2;
    const unsigned ldsw = (unsigned)wid * 1024u;
    const int aoff = lds_byte(wr * 64 + fr, fq * 8), boff = lds_byte(wc * 32 + fr, fq * 8);
#define PG8_SA(b, h) (((b) * 2 + (h)) * HTB)
#define PG8_SB(b, h) ((4 + (b) * 2 + (h)) * HTB)
#define PG8_STAGE(bufoff, gbase, voff) do { _Pragma("unroll") for (int _i = 0; _i < 2; ++_i) \
        __builtin_amdgcn_global_load_lds((const unsigned*)((const char*)(gbase) + (voff)[_i]), (PG8_LAS unsigned*)(lds + (bufoff) + ldsw + _i * 8192), 16, 0, 0); } while (0)
#define PG8_LDA(dst, b, h) do { _Pragma("unroll") for (int m = 0; m < 4; ++m) _Pragma("unroll") for (int k = 0; k < 2; ++k) dst[m][k] = *(const PG8_LAS bf16x8*)(lds + PG8_SA(b, h) + aoff + m * 2048 + k * 1024); } while (0)
#define PG8_LDB(dst, b, h) do { _Pragma("unroll") for (int n = 0; n < 2; ++n) _Pragma("unroll") for (int k = 0; k < 2; ++k) dst[n][k] = *(const PG8_LAS bf16x8*)(lds + PG8_SB(b, h) + boff + n * 2048 + k * 1024); } while (0)
#define PG8_MMA(ai, bj, At, Bt) do { __builtin_amdgcn_s_setprio(1); _Pragma("unroll") for (int m = 0; m < 4; ++m) _Pragma("unroll") for (int n = 0; n < 2; ++n) _Pragma("unroll") for (int k = 0; k < 2; ++k) \
        acc[ai][bj][m][n] = __builtin_amdgcn_mfma_f32_16x16x32_bf16(Bt[n][k], At[m][k], acc[ai][bj][m][n], 0, 0, 0); __builtin_amdgcn_s_setprio(0); } while (0)
#define PG8_WAIT_V(n) asm volatile("s_waitcnt vmcnt(" #n ")" ::: "memory")
#define PG8_WAIT_L(n) asm volatile("s_waitcnt lgkmcnt(" #n ")" ::: "memory")
#define PG8_BAR __builtin_amdgcn_s_barrier()
#define PG8_SCHED __builtin_amdgcn_sched_barrier(0)
    Unit cur, nxt; int ui = 0;
    if (!S.next(0, cur)) return;
    f32x4 acc[2][2][4][2];
#pragma unroll
    for (int a = 0; a < 2; ++a)
#pragma unroll
        for (int b = 0; b < 2; ++b)
#pragma unroll
            for (int m = 0; m < 4; ++m)
#pragma unroll
                for (int n = 0; n < 2; ++n) acc[a][b][m][n] = (f32x4){0.f, 0.f, 0.f, 0.f};
    bf16x8 At[4][2], B0[2][2], B1[2][2];
    const char* cA = cur.pa; const char* cB = cur.pb;
    S.a_ready(cur);
    PG8_GOFF(voffG[0], cur);
    if constexpr (SP2) {
        PG8_STAGE(PG8_SB(0, 0), cB, voffB); PG8_STAGE(PG8_SB(0, 1), cB + hstepB, voffB); PG8_STAGE_A(PG8_SA(0, 0), cA, 0, voffG[0][0]); PG8_STAGE_A(PG8_SA(0, 1), cA, 1, voffG[0][1]);
        if (wr == 1) PG8_BAR;
        PG8_WAIT_V(2); PG8_BAR;
        PG8_STAGE(PG8_SB(1, 0), cB + kstep, voffB); PG8_STAGE_A(PG8_SA(1, 0), cA + kstep, 0, voffG[0][0]); PG8_STAGE(PG8_SB(1, 1), cB + hstepB + kstep, voffB);
        PG8_WAIT_V(6); PG8_BAR;
    } else {
        PG8_STAGE(PG8_SB(0, 0), cB, voffB); PG8_STAGE_A(PG8_SA(0, 0), cA, 0, voffG[0][0]); PG8_STAGE(PG8_SB(0, 1), cB + hstepB, voffB); PG8_STAGE_A(PG8_SA(0, 1), cA, 1, voffG[0][1]);
        if (wr == 1) PG8_BAR;
        PG8_WAIT_V(4); PG8_BAR;
        PG8_STAGE(PG8_SB(1, 0), cB + kstep, voffB); PG8_STAGE_A(PG8_SA(1, 0), cA + kstep, 0, voffG[0][0]); PG8_STAGE(PG8_SB(1, 1), cB + hstepB + kstep, voffB);
        PG8_WAIT_V(6); PG8_BAR;
    }
    for (;;) {
        const bool has_next = S.next(ui + 1, nxt);
        if constexpr (Sched::GATHER) { if (has_next) { PG8_GOFF(voffG[1], nxt); } else {
#pragma unroll
            for (int _h = 0; _h < 2; ++_h)
#pragma unroll
                for (int _i = 0; _i < 2; ++_i) voffG[1][_h][_i] = voffG[0][_h][_i]; } }
        const char* nA = has_next ? nxt.pa : cA; const char* nB = has_next ? nxt.pb : cB;
        for (int t = 0; t < nt; t += 2) {
            const bool last = (t == nt - 2);
            const char* a1 = cA + (size_t)(t + 1) * kstep;
            const char* a2 = last ? nA : cA + (size_t)(t + 2) * kstep; const char* b2 = last ? nB : cB + (size_t)(t + 2) * kstep;
            const char* a3 = a2 + kstep; const char* b3 = b2 + kstep;
            unsigned vs0[2], vs1[2];
#pragma unroll
            for (int _i = 0; _i < 2; ++_i) { vs0[_i] = last ? voffG[1][0][_i] : voffG[0][0][_i]; vs1[_i] = last ? voffG[1][1][_i] : voffG[0][1][_i]; }
            if (last && has_next) S.a_ready(nxt);
            if constexpr (SP2) {
            PG8_LDB(B0, 0, 0); PG8_LDB(B1, 0, 1); PG8_SCHED; PG8_LDA(At, 0, 0); PG8_STAGE_A(PG8_SA(1, 1), a1, 1, voffG[0][1]);
            PG8_WAIT_V(8); PG8_WAIT_L(0); PG8_BAR; PG8_MMA(0, 0, At, B0); PG8_MMA(0, 1, At, B1); PG8_BAR; PG8_SCHED;
            PG8_LDA(At, 0, 1); PG8_STAGE(PG8_SB(0, 0), b2, voffB); PG8_STAGE(PG8_SB(0, 1), b2 + hstepB, voffB); PG8_STAGE_A(PG8_SA(0, 0), a2, 0, vs0);
            PG8_WAIT_V(8); PG8_WAIT_L(0); PG8_BAR; PG8_MMA(1, 0, At, B0); PG8_MMA(1, 1, At, B1); PG8_BAR; PG8_SCHED;
            PG8_LDB(B0, 1, 0); PG8_LDB(B1, 1, 1); PG8_SCHED; PG8_LDA(At, 1, 0); PG8_STAGE_A(PG8_SA(0, 1), a2, 1, vs1);
            PG8_WAIT_V(8); PG8_WAIT_L(0); PG8_BAR; PG8_MMA(0, 0, At, B0); PG8_MMA(0, 1, At, B1); PG8_BAR; PG8_SCHED;
            PG8_LDA(At, 1, 1); PG8_STAGE(PG8_SB(1, 0), b3, voffB); PG8_STAGE(PG8_SB(1, 1), b3 + hstepB, voffB); PG8_STAGE_A(PG8_SA(1, 0), a3, 0, vs0);
            PG8_WAIT_V(8); PG8_WAIT_L(0); PG8_BAR; PG8_MMA(1, 0, At, B0); PG8_MMA(1, 1, At, B1); PG8_BAR; PG8_SCHED;
            } else {
            PG8_LDB(B0, 0, 0); PG8_SCHED; PG8_LDA(At, 0, 0); PG8_STAGE_A(PG8_SA(1, 1), a1, 1, voffG[0][1]);
            PG8_WAIT_L(8); PG8_BAR; PG8_WAIT_L(0); PG8_MMA(0, 0, At, B0); PG8_BAR; PG8_SCHED;
            PG8_LDB(B1, 0, 1); PG8_STAGE(PG8_SB(0, 0), b2, voffB);
            PG8_BAR; PG8_WAIT_L(0); PG8_MMA(0, 1, At, B1); PG8_BAR;
            PG8_LDA(At, 0, 1); PG8_STAGE_A(PG8_SA(0, 0), a2, 0, vs0);
            PG8_BAR; PG8_WAIT_L(0); PG8_MMA(1, 0, At, B0); PG8_BAR; PG8_SCHED;
            PG8_STAGE(PG8_SB(0, 1), b2 + hstepB, voffB);
            PG8_WAIT_V(6); PG8_BAR; PG8_MMA(1, 1, At, B1); PG8_BAR;
            PG8_LDB(B0, 1, 0); PG8_SCHED; PG8_LDA(At, 1, 0); PG8_STAGE_A(PG8_SA(0, 1), a2, 1, vs1);
            PG8_WAIT_L(8); PG8_BAR; PG8_WAIT_L(0); PG8_MMA(0, 0, At, B0); PG8_BAR; PG8_SCHED;
            PG8_LDB(B1, 1, 1); PG8_STAGE(PG8_SB(1, 0), b3, voffB);
            PG8_BAR; PG8_WAIT_L(0); PG8_MMA(0, 1, At, B1); PG8_BAR;
            PG8_LDA(At, 1, 1); PG8_STAGE_A(PG8_SA(1, 0), a3, 0, vs0);
            PG8_BAR; PG8_WAIT_L(0); PG8_MMA(1, 0, At, B0); PG8_BAR; PG8_SCHED;
            PG8_STAGE(PG8_SB(1, 1), b3 + hstepB, voffB);
            PG8_WAIT_V(6); PG8_BAR; PG8_MMA(1, 1, At, B1); PG8_BAR;
            }
        }
        if constexpr (ALIGN_EPI) { if (wr == 0) PG8_BAR; }
        if constexpr (!Epi::AFTER_DRAIN) { E(acc, cur, wr, wc, fr, fq); S.done(cur); }
        if (!has_next) break;
#pragma unroll
        for (int a = 0; a < 2; ++a)
#pragma unroll
            for (int b = 0; b < 2; ++b)
#pragma unroll
                for (int m = 0; m < 4; ++m)
#pragma unroll
                    for (int n = 0; n < 2; ++n) acc[a][b][m][n] = (f32x4){0.f, 0.f, 0.f, 0.f};
        cur = nxt; cA = nA; cB = nB; ++ui;
        if constexpr (Sched::GATHER) {
#pragma unroll
            for (int _h = 0; _h < 2; ++_h)
#pragma unroll
                for (int _i = 0; _i < 2; ++_i) voffG[0][_h][_i] = voffG[1][_h][_i]; }
        if constexpr (ALIGN_EPI) { if (wr == 1) PG8_BAR; }
    }
    PG8_WAIT_V(0);
    if constexpr (!ALIGN_EPI) { if (wr == 0) PG8_BAR; }
    PG8_BAR;
    if constexpr (Epi::AFTER_DRAIN) { E.fused(acc, cur, wr, wc, fr, fq, lds, wid, lane); S.done(cur); }
#undef PG8_SA
#undef PG8_SB
#undef PG8_STAGE
#undef PG8_STAGE_A
#undef PG8_GOFF
#undef PG8_LDA
#undef PG8_LDB
#undef PG8_MMA
#undef PG8_WAIT_V
#undef PG8_WAIT_L
#undef PG8_BAR
#undef PG8_SCHED
}

}
#define WSYNC2() asm volatile("s_waitcnt lgkmcnt(0)" ::: "memory")
#define DPPF(v_, ctrl_) __builtin_bit_cast(float, __builtin_amdgcn_update_dpp(0, __builtin_bit_cast(int, (v_)), (ctrl_), 0xf, 0xf, true))
__device__ __forceinline__ float wave_allsum(float v) {
  v += DPPF(v, 0xB1); v += DPPF(v, 0x4E); v += DPPF(v, 0x141); v += DPPF(v, 0x140);
  { const auto r = __builtin_amdgcn_permlane16_swap(__float_as_uint(v), __float_as_uint(v), false, false); v = __uint_as_float(r[0]) + __uint_as_float(r[1]); }
  { const auto r = __builtin_amdgcn_permlane32_swap(__float_as_uint(v), __float_as_uint(v), false, false); v = __uint_as_float(r[0]) + __uint_as_float(r[1]); }
  return v;
}
struct MoeBufs { int* tok_e; float* tok_g; int* slot_of; float* slot_gate; int* blk_e; int* blkcnt; int* nblk; int* slot_tok; };
constexpr int WRT_LD = 1028;

template <bool XB, int MODE = 0> __device__ __forceinline__ void ph_ln_router(const void* xin_, const bf16_t* hb, const float* g, const float* bb, const float* wr, const float* br, bf16_t* x1b, const MoeBufs m, float* lds) {
  const float* xin = (const float*)xin_; const bf16_t* xinb = (const bf16_t*)xin_;
  for (int i = BIDX() * NTHR + TIDX(); i < PMAX; i += (int)gridDim.x * NTHR) m.slot_tok[i] = 0;
  const int tid = TIDX(), lane = tid & 63, wave = tid >> 6, blk = BIDX();
  float* wT = lds;
  float* lg = lds + 32 * WRT_LD + wave * 64;
  int* cnt = (int*)(lds + 32 * WRT_LD + 8 * 64);
  float* sel = lds + 32 * WRT_LD + 8 * 64 + 32 + wave * 16;
  f32x4 raf[2][4]; v2u rab[2][4], rh[2][4];
#define LNR_LOAD(tk) { _Pragma("unroll") for (int q = 0; q < 2; ++q) _Pragma("unroll") for (int j = 0; j < 4; ++j) { const int c = lane * 4 + 256 * j; \
      if (XB) rab[q][j] = __builtin_nontemporal_load((const v2u*)(xinb + (size_t)((tk) + q) * D + c)); else raf[q][j] = __builtin_nontemporal_load((const f32x4*)(xin + (size_t)((tk) + q) * D + c)); \
      rh[q][j] = __builtin_nontemporal_load((const v2u*)(hb + (size_t)((tk) + q) * D + c)); } }
  LNR_LOAD(blk * 64 + wave * 8)
  { f32x4 wv[16];
#pragma unroll
    for (int k = 0; k < 16; ++k) wv[k] = *(const f32x4*)(wr + (size_t)(tid + NTHR * k) * 4);
#pragma unroll
    for (int k = 0; k < 16; ++k) { const int i = (tid + NTHR * k) * 4, d = i >> 5, e = i & 31;
#pragma unroll
      for (int z = 0; z < 4; ++z) wT[(e + z) * WRT_LD + d] = wv[k][z]; } }
  if (tid < 32) cnt[tid] = 0;
  __syncthreads();
#pragma unroll 1
  for (int it = 0; it < 8; it += 2) {
    const int tok0 = blk * 64 + wave * 8 + it;
    f32x4 v[2][4]; float s[2] = {0.f, 0.f};
#pragma unroll
    for (int q = 0; q < 2; ++q)
#pragma unroll
      for (int j = 0; j < 4; ++j) { f32x4 a;
        if (XB) { const v2u xv = rab[q][j]; a = (f32x4){bf_lo(xv[0]), bf_hi(xv[0]), bf_lo(xv[1]), bf_hi(xv[1])}; } else a = raf[q][j];
        const v2u hh = rh[q][j];
        v[q][j] = (f32x4){ALPHA * a[0] + bf_lo(hh[0]), ALPHA * a[1] + bf_hi(hh[0]), ALPHA * a[2] + bf_lo(hh[1]), ALPHA * a[3] + bf_hi(hh[1])}; s[q] += (v[q][j][0] + v[q][j][1]) + (v[q][j][2] + v[q][j][3]); }
    if (it + 2 < 8) LNR_LOAD(tok0 + 2)
    f32x4 gl[4], bl[4];
#pragma unroll
    for (int j = 0; j < 4; ++j) { const int c = lane * 4 + 256 * j; gl[j] = *(const f32x4*)(g + c); bl[j] = *(const f32x4*)(bb + c); }
    s[0] = wave_allsum(s[0]); s[1] = wave_allsum(s[1]);
    float qq[2] = {0.f, 0.f};
#pragma unroll
    for (int q = 0; q < 2; ++q) { const float mu = s[q] * (1.f / D);
#pragma unroll
      for (int j = 0; j < 4; ++j) { v[q][j] = v[q][j] - mu; qq[q] += (v[q][j][0] * v[q][j][0] + v[q][j][1] * v[q][j][1]) + (v[q][j][2] * v[q][j][2] + v[q][j][3] * v[q][j][3]); } }
    qq[0] = wave_allsum(qq[0]); qq[1] = wave_allsum(qq[1]);
#pragma unroll
    for (int q = 0; q < 2; ++q) { const float r = rsqrtf(qq[q] * (1.f / D) + 1e-5f);
#pragma unroll
      for (int j = 0; j < 4; ++j) { const int c = lane * 4 + 256 * j; const f32x4 g4 = gl[j], b4 = bl[j]; v[q][j] = v[q][j] * r * g4 + b4; *(v2u*)(x1b + (size_t)(tok0 + q) * D + c) = (v2u){cvt_pk_bf16(v[q][j][0], v[q][j][1]), cvt_pk_bf16(v[q][j][2], v[q][j][3])}; } }
    if (MODE == 1) continue;
    float p[2][32];
    { const float* wl = wT + lane * 4; f32x4 wb[2][4];
#pragma unroll
      for (int j = 0; j < 4; ++j) wb[0][j] = *(const f32x4*)(wl + 256 * j);
#pragma unroll
      for (int e = 0; e < 32; ++e) {
        if (e < 31) {
#pragma unroll
          for (int j = 0; j < 4; ++j) wb[(e + 1) & 1][j] = *(const f32x4*)(wl + (e + 1) * WRT_LD + 256 * j); }
        __builtin_amdgcn_sched_barrier(0);
        f32x2_t a0 = {0.f, 0.f}, a1 = {0.f, 0.f};
#pragma unroll
        for (int j = 0; j < 4; ++j) { const f32x4 w4 = wb[e & 1][j]; const f32x2_t wlo = {w4[0], w4[1]}, whi = {w4[2], w4[3]};
          a0 = __builtin_elementwise_fma((f32x2_t){v[0][j][0], v[0][j][1]}, wlo, a0); a0 = __builtin_elementwise_fma((f32x2_t){v[0][j][2], v[0][j][3]}, whi, a0);
          a1 = __builtin_elementwise_fma((f32x2_t){v[1][j][0], v[1][j][1]}, wlo, a1); a1 = __builtin_elementwise_fma((f32x2_t){v[1][j][2], v[1][j][3]}, whi, a1); }
        p[0][e] = a0[0] + a0[1]; p[1][e] = a1[0] + a1[1];
        __builtin_amdgcn_sched_barrier(0);
      } }
#pragma unroll
    for (int i = 0; i < 16; ++i) { const bool hi = (lane & 32) != 0;
#pragma unroll
      for (int q = 0; q < 2; ++q) { const float send = hi ? p[q][i] : p[q][i + 16]; const float keep = hi ? p[q][i + 16] : p[q][i]; p[q][i] = keep + __shfl_xor(send, 32); } }
#pragma unroll
    for (int i = 0; i < 8; ++i) { const bool hi = (lane & 16) != 0;
#pragma unroll
      for (int q = 0; q < 2; ++q) { const float send = hi ? p[q][i] : p[q][i + 8]; const float keep = hi ? p[q][i + 8] : p[q][i]; p[q][i] = keep + __shfl_xor(send, 16); } }
#pragma unroll
    for (int i = 0; i < 4; ++i) { const bool hi = (lane & 8) != 0;
#pragma unroll
      for (int q = 0; q < 2; ++q) { const float send = hi ? p[q][i] : p[q][i + 4]; const float keep = hi ? p[q][i + 4] : p[q][i]; p[q][i] = keep + __shfl_xor(send, 8); } }
#pragma unroll
    for (int i = 0; i < 2; ++i) { const bool hi = (lane & 4) != 0;
#pragma unroll
      for (int q = 0; q < 2; ++q) { const float send = hi ? p[q][i] : p[q][i + 2]; const float keep = hi ? p[q][i + 2] : p[q][i]; p[q][i] = keep + __shfl_xor(send, 4); } }
#pragma unroll
    for (int q = 0; q < 2; ++q) { const bool hi = (lane & 2) != 0; const float send = hi ? p[q][0] : p[q][1]; const float keep = hi ? p[q][1] : p[q][0]; p[q][0] = keep + __shfl_xor(send, 2); }
    p[0][0] += __shfl_xor(p[0][0], 1); p[1][0] += __shfl_xor(p[1][0], 1);
    const int e_l = ((lane >> 5) & 1) * 16 + ((lane >> 4) & 1) * 8 + ((lane >> 3) & 1) * 4 + ((lane >> 2) & 1) * 2 + ((lane >> 1) & 1);
    const float brl = br[e_l];
    const float lv[2] = {p[0][0] + brl, p[1][0] + brl};
    if ((lane & 1) == 0) lg[e_l] = lv[0]; else lg[32 + e_l] = lv[1];
    WSYNC2();
    { const int qh = lane >> 5, ee = lane & 31; const float xe = lg[32 * qh + ee]; int rank = 0;
#pragma unroll
      for (int j4 = 0; j4 < 8; ++j4) { const f32x4 x4 = *(const f32x4*)(lg + 32 * qh + 4 * j4);
#pragma unroll
        for (int z = 0; z < 4; ++z) { const int j = 4 * j4 + z; rank += ((x4[z] > xe) || (x4[z] == xe && j < ee)) ? 1 : 0; } }
      if (rank < 4 && MODE != 2) { sel[8 * qh + rank] = xe; ((int*)sel)[8 * qh + 4 + rank] = ee; } }
    WSYNC2();
    if (lane < 2) { const int q = lane;
      const f32x4 ev4 = *(const f32x4*)(sel + 8 * q); const int4 ei4 = *(const int4*)(sel + 8 * q + 4);
      float ex[4], su = 0.f;
      const float evv[4] = {ev4[0], ev4[1], ev4[2], ev4[3]};
#pragma unroll
      for (int k = 0; k < 4; ++k) { ex[k] = __expf(evv[k] - evv[0]); su += ex[k]; }
      const float inv = 1.f / su; const int tok = tok0 + q;
      *(int4*)(m.tok_e + tok * 4) = ei4;
      *(float4*)(m.tok_g + tok * 4) = make_float4(ex[0] * inv, ex[1] * inv, ex[2] * inv, ex[3] * inv);
      atomicAdd(&cnt[ei4.x], 1); atomicAdd(&cnt[ei4.y], 1); atomicAdd(&cnt[ei4.z], 1); atomicAdd(&cnt[ei4.w], 1); }
    WSYNC2();
  }
  __syncthreads();
  if (tid < 32) m.blkcnt[blk * 32 + tid] = cnt[tid];
  __syncthreads();
}

__device__ __forceinline__ void ph_moe_scatter(const MoeBufs m, int* ilds) {
  const int tid = TIDX(), lane = tid & 63, wave = tid >> 6, blk = BIDX(); (void)lane;
  int* tot = ilds; int* bef = ilds + 32; int* pst = ilds + 64; int* es = ilds + 128; int* rk = ilds + 384; int* sl = ilds + 640; int* part = ilds + 896; int* wcnt = ilds + 1408;
  { const int e = tid & 31, pa = tid >> 5; int sum = 0;
#pragma unroll
    for (int q = 0; q < 16; ++q) sum += m.blkcnt[(pa * 16 + q) * 32 + e];
    part[pa * 32 + e] = sum; }
  if (tid < 256) es[tid] = m.tok_e[blk * 256 + tid];
  __syncthreads();
  if (tid < 32) { const int e = tid; int t_ = 0, b_ = 0; const int pb_ = blk >> 4;
    for (int q = 0; q < 16; ++q) { const int v = part[q * 32 + e]; t_ += v; if (q < pb_) b_ += v; }
    { int vq[16];
#pragma unroll
      for (int q = 0; q < 16; ++q) vq[q] = m.blkcnt[(pb_ * 16 + q) * 32 + e];
#pragma unroll
      for (int q = 0; q < 16; ++q) if (pb_ * 16 + q < blk) b_ += vq[q]; }
    tot[e] = t_; bef[e] = b_; }
  if (tid < 256) { const int e = es[tid]; const unsigned long long lt = (1ull << lane) - 1ull; int r = 0;
    for (int ee = 0; ee < 32; ++ee) { const unsigned long long mk = __ballot(e == ee); if (e == ee) r = __builtin_popcountll(mk & lt); if (lane == ee) wcnt[wave * 32 + ee] = __builtin_popcountll(mk); }
    rk[tid] = r; }
  __syncthreads();
  if (tid == 0) { int acc = 0; for (int e = 0; e < 32; ++e) { pst[e] = acc; acc += ((tot[e] + 255) >> 8) << 8; } pst[32] = acc;
    if (blk == 0) { *m.nblk = acc >> 8; for (int e = 0; e < 32; ++e) for (int q = pst[e] >> 8; q < (pst[e + 1] >> 8); ++q) m.blk_e[q] = e; } }
  __syncthreads();
  if (tid < 256) { const int e = es[tid]; int rank = rk[tid]; for (int w2 = 0; w2 < wave; ++w2) rank += wcnt[w2 * 32 + e];
    const int slot = pst[e] + bef[e] + rank; m.slot_of[blk * 256 + tid] = slot; m.slot_gate[slot] = m.tok_g[blk * 256 + tid]; m.slot_tok[slot] = blk * 64 + (tid >> 2); }
  __syncthreads();
  __syncthreads();
}

__device__ __forceinline__ void ph_combine_ln(const bf16_t* x1b, const bf16_t* Ys, const int* slot_of, const float* g, const float* bb, float* out, bf16_t* outb) {
  const int tid = TIDX(), lane = tid & 63, gw = BIDX() * 8 + (tid >> 6), NGW = (int)gridDim.x * 8;
  f32x4 g4[4], b4[4];
#pragma unroll
  for (int j = 0; j < 4; ++j) { const int c = lane * 4 + 256 * j; g4[j] = *(const f32x4*)(g + c); b4[j] = *(const f32x4*)(bb + c); }
  v2u ys[4][4], xs[4];
#define CLN_RAW(r_, s_) { const int sl_[4] = {(s_).x, (s_).y, (s_).z, (s_).w}; _Pragma("unroll") for (int j = 0; j < 4; ++j) { const int c = lane * 4 + 256 * j; \
    _Pragma("unroll") for (int k = 0; k < 4; ++k) ys[j][k] = __builtin_nontemporal_load((const v2u*)(Ys + (size_t)sl_[k] * D + c)); xs[j] = __builtin_nontemporal_load((const v2u*)(x1b + (size_t)(r_) * D + c)); } }
  int row = gw;
  if (row >= NT) return;
  int4 s4n;
  { const int4 s4 = *(const int4*)(slot_of + row * 4); CLN_RAW(row, s4) s4n = *(const int4*)(slot_of + (row + NGW < NT ? row + NGW : row) * 4); }
#pragma unroll 1
  for (; row < NT; row += NGW) {
    f32x4 v[4]; float s = 0.f;
#pragma unroll
    for (int j = 0; j < 4; ++j) { f32x4 f = (f32x4){0.f, 0.f, 0.f, 0.f};
#pragma unroll
      for (int k = 0; k < 4; ++k) { const v2u y = ys[j][k]; f += (f32x4){bf_lo(y[0]), bf_hi(y[0]), bf_lo(y[1]), bf_hi(y[1])}; }
      const v2u xv = xs[j]; const f32x4 a = (f32x4){bf_lo(xv[0]), bf_hi(xv[0]), bf_lo(xv[1]), bf_hi(xv[1])}; v[j] = a * ALPHA + f; s += (v[j][0] + v[j][1]) + (v[j][2] + v[j][3]); }
    if (row + NGW < NT) { const int4 s4 = s4n; CLN_RAW(row + NGW, s4) s4n = *(const int4*)(slot_of + (row + 2 * NGW < NT ? row + 2 * NGW : row) * 4); }
    const float mu = wave_allsum(s) * (1.f / D); float q = 0.f;
#pragma unroll
    for (int j = 0; j < 4; ++j) { v[j] = v[j] - mu; q += (v[j][0] * v[j][0] + v[j][1] * v[j][1]) + (v[j][2] * v[j][2] + v[j][3] * v[j][3]); }
    const float r = rsqrtf(wave_allsum(q) * (1.f / D) + 1e-5f);
#pragma unroll
    for (int j = 0; j < 4; ++j) { const int c = lane * 4 + 256 * j; const f32x4 o = v[j] * r * g4[j] + b4[j];
      if (out) __builtin_nontemporal_store(o, (f32x4*)(out + (size_t)row * D + c)); if (outb) *(v2u*)(outb + (size_t)row * D + c) = (v2u){cvt_pk_bf16(o[0], o[1]), cvt_pk_bf16(o[2], o[3])}; }
  }
#undef CLN_RAW
}

namespace pg8 {
template <bool GATHER_> struct MoeOrderT {
    static constexpr bool GATHER = GATHER_; const int* rowmap;
    StaticOrder so; const LAS int* blk_e; const char* W; size_t wexp; int obn;
    __device__ void init(const void* A, int lda, const void* W_, int ldb, size_t wexp_, int nM, int nN, int obn_, const LAS int* blk_e_, int G, int c) { so.init(A, lda, W_, ldb, nM * BM, nN * BM, G, c); blk_e = blk_e_; W = (const char*)W_; wexp = wexp_; obn = obn_; }
    __device__ bool next(int i, Unit& u) const { int pm, pn; if (!so.tile(i, pm, pn)) return false; const int e = __builtin_amdgcn_readfirstlane(blk_e[pm]); u.pa = GATHER_ ? so.A : so.A + (size_t)pm * so.ta; u.pb = W + (size_t)e * wexp + (size_t)pn * so.tb; u.orow = pm * BM; u.ocol = pn * obn; u.e = e; u.kind = 0; return true; }
    __device__ __forceinline__ int rowof(const Unit&, int r) const { return GATHER_ ? rowmap[r] : r; }
    __device__ __forceinline__ void a_ready(const Unit&) const {}
    __device__ __forceinline__ void done(const Unit&) const {}
};
typedef MoeOrderT<false> MoeOrder; typedef MoeOrderT<true> MoeOrderG;
struct EpiSwiglu {
    static constexpr bool PERM = true, AFTER_DRAIN = false;
    bf16_t* O; int ldc; const float* b1;
    __device__ __forceinline__ void operator()(const f32x4 (&acc)[2][2][4][2], const Unit& u, int wr, int wc, int fr, int fq) const {
        const int row0 = u.orow + wr * 64 + fr, cl = wc * 32 + 8 * fq, col0 = u.ocol + cl;
        const float* bg = b1 + (size_t)u.e * 2048 + col0; const float* bu = bg + 1024;
        const f32x4 bg0 = *(const f32x4*)bg, bg1 = *(const f32x4*)(bg + 4), bu0 = *(const f32x4*)bu, bu1 = *(const f32x4*)(bu + 4);
#pragma unroll
        for (int ai = 0; ai < 2; ++ai)
#pragma unroll
            for (int m = 0; m < 4; ++m) {
                f32x4 gv[2] = {acc[ai][0][m][0] + bg0, acc[ai][0][m][1] + bg1}, uv[2] = {acc[ai][1][m][0] + bu0, acc[ai][1][m][1] + bu1}; float o[8];
#pragma unroll
                for (int n = 0; n < 2; ++n)
#pragma unroll
                    for (int i = 0; i < 4; ++i) { const float gg = fminf(gv[n][i], 7.f), uu = fminf(fmaxf(uv[n][i], -7.f), 7.f);
                        const float sg = __builtin_amdgcn_rcpf(1.f + __builtin_amdgcn_exp2f(-1.702f * 1.4426950408889634f * gg)); o[4 * n + i] = (uu + 1.f) * gg * sg; }
                u32x4 w; w.x = cvt_pk_bf16(o[0], o[1]); w.y = cvt_pk_bf16(o[2], o[3]); w.z = cvt_pk_bf16(o[4], o[5]); w.w = cvt_pk_bf16(o[6], o[7]);
                *(u32x4*)(O + (size_t)(row0 + ai * HALF + m * 16) * ldc + col0) = w; asm volatile("" ::: "memory"); }
    }
};
struct EpiMoe2 {
    static constexpr bool PERM = true, AFTER_DRAIN = false;
    bf16_t* O; int ldc; const float* b2; const float* gate;
    __device__ __forceinline__ void operator()(const f32x4 (&acc)[2][2][4][2], const Unit& u, int wr, int wc, int fr, int fq) const {
        const int row0 = u.orow + wr * 64 + fr, col0 = u.ocol + wc * 32 + 8 * fq;
        const float* bp = b2 + (size_t)u.e * 1024 + col0;
        f32x4 bv[2][2]; float gts[2][4];
#pragma unroll
        for (int bj = 0; bj < 2; ++bj) { bv[bj][0] = *(const f32x4*)(bp + bj * HALF); bv[bj][1] = *(const f32x4*)(bp + bj * HALF + 4); }
#pragma unroll
        for (int ai = 0; ai < 2; ++ai)
#pragma unroll
            for (int m = 0; m < 4; ++m) gts[ai][m] = gate[row0 + ai * HALF + m * 16];
#pragma unroll
        for (int bj = 0; bj < 2; ++bj) {
            const f32x4 bv0 = bv[bj][0], bv1 = bv[bj][1];
#pragma unroll
            for (int ai = 0; ai < 2; ++ai)
#pragma unroll
                for (int m = 0; m < 4; ++m) { const int row = row0 + ai * HALF + m * 16; const float gt = gts[ai][m];
                    const f32x4 v0 = (acc[ai][bj][m][0] + bv0) * gt, v1 = (acc[ai][bj][m][1] + bv1) * gt;
                    u32x4 w; w.x = cvt_pk_bf16(v0[0], v0[1]); w.y = cvt_pk_bf16(v0[2], v0[3]); w.z = cvt_pk_bf16(v1[0], v1[1]); w.w = cvt_pk_bf16(v1[2], v1[3]);
                    *(u32x4*)(O + (size_t)row * ldc + col0 + bj * HALF) = w; asm volatile("" ::: "memory"); }
        }
    }
};

struct MoeFusedOrder {
    static constexpr bool GATHER = true;
    const int* rowmap; const int* blk_e; const char* X; const char* ACT; const char* W1; const char* W2; unsigned* ready; unsigned* tmo; int nblk, NG, G, c, total, mode;
    __device__ void init(const void* X_, const void* ACT_, const void* W1_, const void* W2_, const int* rowmap_, const int* blk_e_, unsigned* ready_, unsigned* tmo_, int nblk_, int G_, int c_) {
        X = (const char*)X_; ACT = (const char*)ACT_; W1 = (const char*)W1_; W2 = (const char*)W2_; rowmap = rowmap_; blk_e = blk_e_; ready = ready_; tmo = tmo_; nblk = nblk_; NG = (nblk_ + 31) >> 5; G = G_; c = c_; total = nblk_ * 12; }
    __device__ bool next(int i, Unit& u) const {
        int Lq = i * G + c; if (Lq >= total) return false;
#if defined(FUSE_SPLIT)
        if (c >= 0) { const int kind = mode - 1; if (Lq >= nblk * (kind ? 4 : 8)) return false; const int q = Lq; const int pm = q % nblk, pn = q / nblk, e = __builtin_amdgcn_readfirstlane(blk_e[pm]);
          u.kind = kind; u.e = e; u.orow = pm * BM;
          if (kind == 0) { u.pa = X; u.pb = W1 + ((size_t)e * 2048 + (size_t)pn * 256) * 2048; u.ocol = pn * 128; }
          else { u.pa = ACT; u.pb = W2 + ((size_t)e * 1024 + (size_t)pn * 256) * 2048; u.ocol = pn * 256; }
          return true; }
#endif
#if defined(FUSE_SERIAL)
        { const int n1 = nblk * 8; int kind = Lq < n1 ? 0 : 1; int q = kind ? Lq - n1 : Lq; const int pm = q % nblk, pn = q / nblk, e = __builtin_amdgcn_readfirstlane(blk_e[pm]);
          u.kind = kind; u.e = e; u.orow = pm * BM;
          if (kind == 0) { u.pa = X; u.pb = W1 + ((size_t)e * 2048 + (size_t)pn * 256) * 2048; u.ocol = pn * 128; }
          else { u.pa = ACT; u.pb = W2 + ((size_t)e * 1024 + (size_t)pn * 256) * 2048; u.ocol = pn * 256; }
          return true; }
#endif
        int kind = 0, g = 0;
        for (int sgm = 0; ; ++sgm) {
            if (sgm < 3) { kind = 0; g = sgm; }
            else if (sgm < 3 + 2 * (NG - 3)) { const int j = (sgm - 3) >> 1; if (((sgm - 3) & 1) == 0) { kind = 0; g = j + 3; } else { kind = 1; g = j; } }
            else { kind = 1; g = NG - 3 + (sgm - (3 + 2 * (NG - 3))); }
            const int mg = min(32, nblk - 32 * g), sz = mg * (kind ? 4 : 8);
            if (Lq < sz) { const int pm = 32 * g + Lq % mg, pn = Lq / mg, e = __builtin_amdgcn_readfirstlane(blk_e[pm]);
                u.kind = kind; u.e = e; u.orow = pm * BM;
                if (kind == 0) { u.pa = X; u.pb = W1 + ((size_t)e * 2048 + (size_t)pn * 256) * 2048; u.ocol = pn * 128; }
                else { u.pa = ACT; u.pb = W2 + ((size_t)e * 1024 + (size_t)pn * 256) * 2048; u.ocol = pn * 256; }
                return true; }
            Lq -= sz;
        }
    }
    __device__ __forceinline__ int rowof(const Unit& u, int r) const { return u.kind == 0 ? rowmap[r] : r; }
    __device__ __forceinline__ void a_ready(const Unit& u) const {
        if (u.kind == 0) return;
#if defined(FUSE_SPLIT)
        return;
#endif
        if (threadIdx.x < 64) {
#if defined(FUSE_GLOBAL_WAIT)
            const unsigned long long t0 = __builtin_amdgcn_s_memrealtime(); unsigned polls = 0; unsigned* rp = ready + 64 * 500; const unsigned want = (unsigned)nblk * 64u;
#else
            const unsigned long long t0 = __builtin_amdgcn_s_memrealtime(); unsigned polls = 0; unsigned* rp = ready + 64 * (u.orow >> 8); const unsigned want = 64u;
#endif
            while ((unsigned)__builtin_amdgcn_readfirstlane(__hip_atomic_load(rp, __ATOMIC_RELAXED, __HIP_MEMORY_SCOPE_AGENT)) < want) {
                if ((++polls & 255u) == 0u && __builtin_amdgcn_readfirstlane(__hip_atomic_load(tmo, __ATOMIC_RELAXED, __HIP_MEMORY_SCOPE_AGENT)) != 0u) break;
                if (__builtin_amdgcn_s_memrealtime() - t0 > 2000000ull) { if (threadIdx.x == 0) __hip_atomic_store(tmo, 1u, __ATOMIC_RELAXED, __HIP_MEMORY_SCOPE_AGENT); break; }
                __builtin_amdgcn_s_sleep(2); }
#if defined(FUSE_CONSUMER_WB)
            __builtin_amdgcn_fence(__ATOMIC_RELEASE, "agent"); asm volatile("s_waitcnt vmcnt(0)" ::: "memory");
#endif
#if defined(FUSE_DELAY)
            { const unsigned long long t1 = __builtin_amdgcn_s_memrealtime(); while (__builtin_amdgcn_s_memrealtime() - t1 < 2000ull) __builtin_amdgcn_s_sleep(8); }
#endif
#if !defined(FUSE_NO_ACQ)
            __builtin_amdgcn_fence(__ATOMIC_ACQUIRE, "agent");
#endif
            asm volatile("s_waitcnt vmcnt(0)" ::: "memory");
        }
        asm volatile("" ::: "memory"); __builtin_amdgcn_s_barrier(); asm volatile("" ::: "memory");
    }
    __device__ __forceinline__ void done(const Unit& u) const {
        if (u.kind != 0) return;
        asm volatile("s_waitcnt vmcnt(0)" ::: "memory");
#if defined(FUSE_HEAVY_RELEASE)
        __builtin_amdgcn_fence(__ATOMIC_RELEASE, "agent"); asm volatile("s_waitcnt vmcnt(0)" ::: "memory");
#endif
#if defined(FUSE_GLOBAL_WAIT)
        if ((threadIdx.x & 63) == 0) __hip_atomic_fetch_add(ready + 64 * 500, 1u, __ATOMIC_RELAXED, __HIP_MEMORY_SCOPE_AGENT);
#else
        if ((threadIdx.x & 63) == 0) __hip_atomic_fetch_add(ready + 64 * (u.orow >> 8), 1u, __ATOMIC_RELAXED, __HIP_MEMORY_SCOPE_AGENT);
#endif
    }
};
__device__ __forceinline__ void store16_sc1(void* p, u32x4 v) { asm volatile("global_store_dwordx4 %0, %1, off sc1\n\ts_nop 1" :: "v"(p), "v"(v) : "memory"); }
struct EpiMoeFused {
    static constexpr bool PERM = true, AFTER_DRAIN = false;
    bf16_t* ACTo; const float* b1; bf16_t* Yo; const float* b2; const float* gate;
    __device__ __forceinline__ void operator()(const f32x4 (&acc)[2][2][4][2], const Unit& u, int wr, int wc, int fr, int fq) const {
        if (u.kind == 0) {
            const int row0 = u.orow + wr * 64 + fr, cl = wc * 32 + 8 * fq, col0 = u.ocol + cl;
            const float* bg = b1 + (size_t)u.e * 2048 + col0; const float* bu = bg + 1024;
            const f32x4 bg0 = *(const f32x4*)bg, bg1 = *(const f32x4*)(bg + 4), bu0 = *(const f32x4*)bu, bu1 = *(const f32x4*)(bu + 4);
#pragma unroll
            for (int ai = 0; ai < 2; ++ai)
#pragma unroll
                for (int m = 0; m < 4; ++m) {
                    f32x4 gv[2] = {acc[ai][0][m][0] + bg0, acc[ai][0][m][1] + bg1}, uv[2] = {acc[ai][1][m][0] + bu0, acc[ai][1][m][1] + bu1}; float o[8];
#pragma unroll
                    for (int n = 0; n < 2; ++n)
#pragma unroll
                        for (int i = 0; i < 4; ++i) { const float gg = fminf(gv[n][i], 7.f), uu = fminf(fmaxf(uv[n][i], -7.f), 7.f);
                            const float sg = __builtin_amdgcn_rcpf(1.f + __builtin_amdgcn_exp2f(-1.702f * 1.4426950408889634f * gg)); o[4 * n + i] = (uu + 1.f) * gg * sg; }
                    u32x4 w; w.x = cvt_pk_bf16(o[0], o[1]); w.y = cvt_pk_bf16(o[2], o[3]); w.z = cvt_pk_bf16(o[4], o[5]); w.w = cvt_pk_bf16(o[6], o[7]);
#if defined(FUSE_PLAIN_STORE)
                    *(u32x4*)(ACTo + (size_t)(row0 + ai * HALF + m * 16) * 1024 + col0) = w; }
#else
                    store16_sc1(ACTo + (size_t)(row0 + ai * HALF + m * 16) * 1024 + col0, w); }
#endif
        } else {
            const int row0 = u.orow + wr * 64 + fr, col0 = u.ocol + wc * 32 + 8 * fq;
            const float* bp = b2 + (size_t)u.e * 1024 + col0;
            f32x4 bv[2][2]; float gts[2][4];
#pragma unroll
            for (int bj = 0; bj < 2; ++bj) { bv[bj][0] = *(const f32x4*)(bp + bj * HALF); bv[bj][1] = *(const f32x4*)(bp + bj * HALF + 4); }
#pragma unroll
            for (int ai = 0; ai < 2; ++ai)
#pragma unroll
                for (int m = 0; m < 4; ++m) gts[ai][m] = gate[row0 + ai * HALF + m * 16];
#pragma unroll
            for (int bj = 0; bj < 2; ++bj) {
                const f32x4 bv0 = bv[bj][0], bv1 = bv[bj][1];
#pragma unroll
                for (int ai = 0; ai < 2; ++ai)
#pragma unroll
                    for (int m = 0; m < 4; ++m) { const int row = row0 + ai * HALF + m * 16; const float gt = gts[ai][m];
                        const f32x4 v0 = (acc[ai][bj][m][0] + bv0) * gt, v1 = (acc[ai][bj][m][1] + bv1) * gt;
                        u32x4 w; w.x = cvt_pk_bf16(v0[0], v0[1]); w.y = cvt_pk_bf16(v0[2], v0[3]); w.z = cvt_pk_bf16(v1[0], v1[1]); w.w = cvt_pk_bf16(v1[2], v1[3]);
                        *(u32x4*)(Yo + (size_t)row * 1024 + col0 + bj * HALF) = w; asm volatile("" ::: "memory"); }
            }
        }
    }
};
}
typedef short v4i16_t __attribute__((ext_vector_type(4)));
__device__ __forceinline__ unsigned f2key_u(float f) { f = f + 0.0f; const unsigned u = __float_as_uint(f); return (u & 0x80000000u) ? ~u : (u | 0x80000000u); }

__device__ __forceinline__ void ph_cnorm_b(const bf16_t* pa, const float* g, bf16_t* cnb) {
  const int tid = TIDX(), lane = tid & 63, gw = BIDX() * 8 + (tid >> 6), NGW = (int)gridDim.x * 8;
  const f32x4 g4 = *(const f32x4*)(g + lane * 4);
#pragma unroll 1
  for (int row0 = gw; row0 < NT; row0 += 4 * NGW) {
    v2u v[4]; f32x4 f[4]; float ss[4];
#pragma unroll
    for (int k = 0; k < 4; ++k) { const int row = row0 + k * NGW; v[k] = __builtin_nontemporal_load((const v2u*)(pa + (size_t)(row < NT ? row : row0) * 2048 + 1024 + lane * 4)); }
#pragma unroll
    for (int k = 0; k < 4; ++k) { f[k] = (f32x4){bf_lo(v[k][0]), bf_hi(v[k][0]), bf_lo(v[k][1]), bf_hi(v[k][1])}; ss[k] = (f[k][0] * f[k][0] + f[k][1] * f[k][1]) + (f[k][2] * f[k][2] + f[k][3] * f[k][3]); }
#pragma unroll
    for (int o = 1; o < 64; o <<= 1) {
#pragma unroll
      for (int k = 0; k < 4; ++k) ss[k] += __shfl_xor(ss[k], o); }
#pragma unroll
    for (int k = 0; k < 4; ++k) { const int row = row0 + k * NGW; if (row < NT) { const float r = rsqrtf(ss[k] * (1.f / 256.f) + 1e-6f); const f32x4 o = f[k] * r * g4;
      *(v2u*)(cnb + (size_t)row * 256 + lane * 4) = (v2u){cvt_pk_bf16(o[0], o[1]), cvt_pk_bf16(o[2], o[3])}; } }
  }
}

__device__ __forceinline__ int moe_layer_tile(int layer, int j) { return j < 8192 ? layer * 8192 + j : 16384 + layer * 4096 + (j - 8192); }
template <int NOST = 0> __device__ __forceinline__ void moe_weight_tile(int T, const float* w1, const float* w2, bf16_t* W1_t, bf16_t* W2_t, int lane, LAS unsigned char* stage, unsigned* sink = nullptr) {
  if (T < 16384) { const int le = T >> 8; transpose_tile<NOST>(mk_tjob(w1 + (size_t)le * D * 2048, 2048, D, 2048, W1_t + (size_t)le * 2048 * D, D, 0, 0, 1), T & 255, lane, stage, sink); }
  else if (T < 24576) { const int t2 = T - 16384, le = t2 >> 7; transpose_tile<NOST>(mk_tjob(w2 + (size_t)le * D * D, D, D, D, W2_t + (size_t)le * D * D, D, 0, 0, 0), t2 & 127, lane, stage, sink); }
}
typedef _Float16 h16x2_t __attribute__((ext_vector_type(2)));
typedef int i32x4_t __attribute__((ext_vector_type(4)));
__device__ __forceinline__ unsigned cvt_pk_f16(float lo, float hi) { const f32x2_t v = {lo, hi}; const h16x2_t h = __builtin_convertvector(v, h16x2_t); return __builtin_bit_cast(unsigned, h); }
constexpr int ISC_NU = 1088;
__device__ __forceinline__ void isc_decode(unsigned u, int& b, int& j, int& c) { b = (int)(u / 544u); int v = (int)u - b * 544; j = 63; while (v >= ((j + 4) >> 2)) { v -= (j + 4) >> 2; --j; } c = v; }
template <int HOT = 0> __device__ __forceinline__ void ph_iscore(const bf16_t* pa, const bf16_t* kib, unsigned short* sc, unsigned* ctr, LAS unsigned char* lds) {
  const int tid = TIDX(), lane = tid & 63, wave = __builtin_amdgcn_readfirstlane(tid >> 6);
  const int n16 = lane & 15, g = lane >> 4;
  volatile LAS unsigned* slot = (volatile LAS unsigned*)(lds + MISC_OFF + 80);
  __syncthreads();
  if (tid == 0) { const unsigned b0_ = __hip_atomic_fetch_add(ctr, 2u, __ATOMIC_RELAXED, __HIP_MEMORY_SCOPE_AGENT); slot[0] = b0_; slot[1] = b0_ + 1u; }
  __syncthreads();
  unsigned cur = slot[0], nxt = slot[1];
  __syncthreads();
  const unsigned lofs = (unsigned)(n16 * 128 + 16 * (g ^ (n16 >> 1))), lofs1 = (unsigned)(n16 * 128 + 16 * ((4 + g) ^ (n16 >> 1)));
#define ISC_DMA(u_, pb_) { int b_, j_, c_; isc_decode((u_), b_, j_, c_); const bf16_t* src0 = kib + (size_t)(b_ * L + 512 * c_) * 64; \
    _Pragma("unroll") for (int i = 0; i < 8; ++i) { const int rl = 8 * (8 * wave + i) + (lane >> 3), ch = (lane & 7) ^ ((rl >> 1) & 7); \
      __builtin_amdgcn_global_load_lds((const unsigned*)(src0 + (size_t)rl * 64 + ch * 8), (LAS unsigned*)(lds + (pb_) * 65536 + (8 * wave + i) * 1024), 16, 0, 0); } }
  int pb = 0;
  bf16x8 qn[8][2], wvn;
#define ISC_QLOAD(u_) { int b_, j_, c_; isc_decode((u_), b_, j_, c_); const bf16_t* qr_ = pa + (size_t)(b_ * L + (8 * j_ + wave) * 16 + n16) * 2048; wvn = *(const bf16x8*)(qr_ + 1856); \
    _Pragma("unroll") for (int h = 0; h < 8; ++h) { qn[h][0] = *(const bf16x8*)(qr_ + 1280 + h * 64 + 8 * g); qn[h][1] = *(const bf16x8*)(qr_ + 1280 + h * 64 + 32 + 8 * g); } }
  if (cur < (unsigned)ISC_NU) { ISC_DMA(cur, 0) ISC_QLOAD(cur) }
  asm volatile("s_waitcnt vmcnt(0)" ::: "memory");
  __syncthreads();
  int itp = 0;
#pragma unroll 1
  while (cur < (unsigned)ISC_NU) {
    bf16x8 qf[8][2]; float w[8];
    if (nxt < (unsigned)ISC_NU) { ISC_DMA(nxt, pb ^ 1) }
#pragma unroll
    for (int h = 0; h < 8; ++h) { qf[h][0] = qn[h][0]; qf[h][1] = qn[h][1]; w[h] = bf2f((bf16_t)wvn[h]) * (0.35355339059327373f * 0.125f); }
    unsigned grabbed = 0u; if (tid == 0) grabbed = __hip_atomic_fetch_add(ctr, 1u, __ATOMIC_RELAXED, __HIP_MEMORY_SCOPE_AGENT);
    int b, j, c; isc_decode(cur, b, j, c);
    const int qg = 8 * j + wave, t0 = qg * 16, ntl = min(32, qg + 1 - 32 * c);
    unsigned short* srow2 = sc + (size_t)(HOT ? ((t0 + n16) & 63) : (b * L + t0 + n16)) * L + 32 * c * 16 + 16 * (g & 1) + 8 * (g >> 1);
    const LAS unsigned char* kb0 = lds + pb * 65536 + lofs; const LAS unsigned char* kb1 = lds + pb * 65536 + lofs1;
#define ISC_MFMA(A_, p_) { _Pragma("unroll") for (int h = 0; h < 8; ++h) A_[h] = __builtin_amdgcn_mfma_f32_16x16x32_bf16(k0[p_], qf[h][0], (f32x4){0.f, 0.f, 0.f, 0.f}, 0, 0, 0); \
      _Pragma("unroll") for (int h = 0; h < 8; ++h) A_[h] = __builtin_amdgcn_mfma_f32_16x16x32_bf16(k1[p_], qf[h][1], A_[h], 0, 0, 0); }
#define ISC_EPI(A_, p_) { f32x4 score = (f32x4){0.f, 0.f, 0.f, 0.f}; _Pragma("unroll") for (int h = 0; h < 8; ++h) { \
        const f32x4 r_ = __builtin_bit_cast(f32x4, __builtin_elementwise_max(__builtin_bit_cast(i32x4_t, A_[h]), (i32x4_t){0, 0, 0, 0})); \
        _Pragma("unroll") for (int i = 0; i < 4; ++i) score[i] = fmaf(r_[i], w[h], score[i]); } \
      sv[p_][0] = cvt_pk_f16(score[0], score[1]); sv[p_][1] = cvt_pk_f16(score[2], score[3]); }
#define ISC_MIX() { _Pragma("unroll") for (int z = 0; z < 16; ++z) { __builtin_amdgcn_sched_group_barrier(0x008, 1, 0); __builtin_amdgcn_sched_group_barrier(0x002, 3, 0); } }
#pragma unroll 1
    for (int tl = 0; tl < ntl; tl += 4) {
      bf16x8 k0[4], k1[4];
#pragma unroll
      for (int p = 0; p < 4; ++p) { k0[p] = *(const LAS bf16x8*)(kb0 + (tl + p) * 2048); k1[p] = *(const LAS bf16x8*)(kb1 + (tl + p) * 2048); }
      f32x4 aA[8], aB[8]; unsigned sv[4][2];
      ISC_MFMA(aA, 0)
      ISC_MFMA(aB, 1) ISC_EPI(aA, 0) ISC_MIX()
      ISC_MFMA(aA, 2) ISC_EPI(aB, 1) ISC_MIX()
      ISC_MFMA(aB, 3) ISC_EPI(aA, 2) ISC_MIX()
      ISC_EPI(aB, 3)
#pragma unroll
      for (int p1 = 0; p1 < 2; ++p1) {
        const auto r0 = __builtin_amdgcn_permlane16_swap(sv[2 * p1][0], sv[2 * p1 + 1][0], false, false);
        const auto r1 = __builtin_amdgcn_permlane16_swap(sv[2 * p1][1], sv[2 * p1 + 1][1], false, false);
        *(v4u*)(srow2 + tl * 16 + 32 * p1) = (v4u){r0[0], r1[0], r0[1], r1[1]}; }
    }
#undef ISC_MFMA
#undef ISC_EPI
#undef ISC_MIX
    if (tid == 0) slot[itp] = grabbed;
    if (nxt < (unsigned)ISC_NU) { ISC_QLOAD(nxt) }
    asm volatile("s_waitcnt vmcnt(0)" ::: "memory");
    __syncthreads();
    cur = nxt; nxt = slot[itp]; itp ^= 1; pb ^= 1;
  }
#undef ISC_DMA
#undef ISC_QLOAD
  __syncthreads();
}

constexpr int DW_STRIDE = 17152;
__device__ __forceinline__ unsigned offb(unsigned row, unsigned ch) { return 256u * row + 16u * (ch ^ (((row & 3u) << 2) | ((row >> 2) & 3u))); }
__device__ __forceinline__ void glds16(const void* gsrc, unsigned lds_dst) { unsigned keep;
  asm volatile("s_mov_b32 %0, m0\n\ts_mov_b32 m0, %2\n\ts_nop 0\n\tglobal_load_lds_dwordx4 %1, off\n\ts_mov_b32 m0, %0" : "=&s"(keep) : "v"(gsrc), "s"(lds_dst) : "memory"); }
__device__ __forceinline__ int wave_excl_scan(int v, int lane, int& total) {
  int x = v;
#pragma unroll
  for (int o = 1; o < 64; o <<= 1) { const int y = __shfl_up(x, o); if (lane >= o) x += y; }
  total = __shfl(x, 63); return x - v;
}
#define LDSW() asm volatile("s_waitcnt lgkmcnt(0)" ::: "memory")
__device__ __forceinline__ int wave_incl_scan_dpp(int v, int lane, int& total) {
  int x = v;
  x += __builtin_amdgcn_update_dpp(0, x, 0x111, 0xf, 0xf, true);
  x += __builtin_amdgcn_update_dpp(0, x, 0x112, 0xf, 0xf, true);
  x += __builtin_amdgcn_update_dpp(0, x, 0x114, 0xf, 0xf, true);
  x += __builtin_amdgcn_update_dpp(0, x, 0x118, 0xf, 0xf, true);
  const int t0 = __builtin_amdgcn_readlane(x, 15), t1 = __builtin_amdgcn_readlane(x, 31), t2 = __builtin_amdgcn_readlane(x, 47), t3 = __builtin_amdgcn_readlane(x, 63);
  const int row = lane >> 4;
  x += (row >= 1 ? t0 : 0) + (row >= 2 ? t1 : 0) + (row >= 3 ? t2 : 0);
  total = t0 + t1 + t2 + t3; return x;
}

__device__ __forceinline__ unsigned h2key(unsigned h) { return (h & 0x8000u) ? (~h & 0xFFFFu) : (h | 0x8000u); }
struct NoEarly { __device__ __forceinline__ void operator()(int) const {} };
template <int MODE = 0, class Early = NoEarly> __device__ __forceinline__ int wave_select(const unsigned short* srow, int t, LAS unsigned char* wl, LAS unsigned short* idx16, int lane, const Early& early = Early()) {
  const int n = t + 1;
  if (n <= 256) { for (int i = lane; i < 256; i += 64) idx16[i] = (unsigned short)(i < n ? i : 0); LDSW(); early(256); return n; }
  LAS unsigned* hist = (LAS unsigned*)wl;
  unsigned bk[16][4];
#pragma unroll
  for (int hb = 0; hb < 2; ++hb) { v4u f[8]; int lane_l = lane; asm volatile("" : "+v"(lane_l));
#pragma unroll
    for (int grp = 0; grp < 2; ++grp) if ((2 * hb + grp) * 2048 < n) {
#pragma unroll
      for (int k = 0; k < 4; ++k) f[4 * grp + k] = __builtin_nontemporal_load((const v4u*)(srow + ((8 * hb + 4 * grp + k) * 64 + lane_l) * 8)); }
    if (hb == 0) { unsigned z = 0u; asm volatile("" : "+v"(z));
      for (int i = lane; i < 1024; i += 64) ((LAS v4u*)hist)[i] = (v4u){z, z, z, z}; }
#pragma unroll
    for (int ii = 0; ii < 8; ++ii) { const int i = 8 * hb + ii;
      bk[i][0] = 0u; bk[i][1] = 0u; bk[i][2] = 0u; bk[i][3] = 0u;
      if (i * 512 < n) { const int e0 = (i * 64 + lane_l) * 8;
#pragma unroll
        for (int c = 0; c < 4; ++c) { const unsigned lo = f[ii][c] & 0xFFFFu, hi = f[ii][c] >> 16;
          const unsigned m0 = (e0 + 2 * c <= t) ? 0xFFFFu : 0u, m1 = (e0 + 2 * c + 1 <= t) ? 0xFFFFu : 0u;
          const unsigned b0 = (h2key(lo == 0x8000u ? 0u : lo) >> 4) & m0, b1 = (h2key(hi == 0x8000u ? 0u : hi) >> 4) & m1;
          bk[i][c] = b0 | (b1 << 16); } }
    }
    asm volatile("" ::: "memory"); }
#define BIN_OF(i, c) ((bk[i][(c) >> 1] >> (((c) & 1) * 16)) & 0xFFFFu)
  LDSW();
#if defined(SEL_REP_HIST)
#pragma unroll 1
  for (int rep_ = 0; rep_ < 2; ++rep_) {
  for (int i = lane; i < 1024; i += 64) ((LAS v4u*)hist)[i] = (v4u){0u, 0u, 0u, 0u};
  LDSW();
#endif
#pragma unroll
  for (int i = 0; i < 16; ++i) if (i * 512 < n) {
#pragma unroll
    for (int c = 0; c < 8; ++c) { const unsigned bin = BIN_OF(i, c); __hip_atomic_fetch_add(hist + bin, 1u, __ATOMIC_RELAXED, __HIP_MEMORY_SCOPE_WORKGROUP); }
    asm volatile("" ::: "memory"); }
  LDSW();
#if defined(SEL_REP_HIST)
  }
#endif
  if (MODE == 1) return 0;
  const int bbase = 4096 - 64 * (lane + 1); int ssum = 0;
#pragma unroll 16
  for (int k = 0; k < 64; ++k) ssum += (int)hist[bbase + ((k + lane) & 63)];
  int tot; const int pre = wave_incl_scan_dpp(ssum, lane, tot) - ssum;
  const unsigned long long bal = __ballot(pre < 256 && pre + ssum >= 256);
  const int Ls = (int)__builtin_ctzll(bal);
  const int cum0 = __builtin_amdgcn_readlane(pre, Ls), sb = 4096 - 64 * (Ls + 1);
  const int ck = (int)hist[sb + 63 - lane]; int t2_; const int inc = wave_incl_scan_dpp(ck, lane, t2_);
  const unsigned long long bal2 = __ballot(cum0 + inc >= 256);
  const int kk = (int)__builtin_ctzll(bal2);
  const int B1 = sb + 63 - kk, cnt_gt = cum0 + __builtin_amdgcn_readlane(inc, kk) - __builtin_amdgcn_readlane(ck, kk), need1 = 256 - cnt_gt;
  LDSW();
  if (MODE == 2) { idx16[lane] = (unsigned short)(B1 + need1); return 0; }
  const unsigned kg = (0x7FFFu - (unsigned)B1) * 0x00010001u, kge = kg + 0x00010001u;
  unsigned mg[4] = {0u, 0u, 0u, 0u}, me[4] = {0u, 0u, 0u, 0u};
#pragma unroll
  for (int i = 0; i < 16; ++i) if (i * 512 < n) {
#pragma unroll
    for (int c2 = 0; c2 < 4; ++c2) { const unsigned x = bk[i][c2], fg = (x + kg) & 0x80008000u, fe = ((x + kge) & 0x80008000u) & ~fg;
      const unsigned tg_ = fg >> 15, te_ = fe >> 15; const int sh = (i & 3) * 8 + c2 * 2;
      mg[i >> 2] |= ((tg_ | (tg_ >> 15)) & 3u) << sh; me[i >> 2] |= ((te_ | (te_ >> 15)) & 3u) << sh; } }
  const int ngt = __builtin_popcount(mg[0]) + __builtin_popcount(mg[1]) + __builtin_popcount(mg[2]) + __builtin_popcount(mg[3]);
  const int neq = __builtin_popcount(me[0]) + __builtin_popcount(me[1]) + __builtin_popcount(me[2]) + __builtin_popcount(me[3]);
  int tg, te; int pg = wave_incl_scan_dpp(ngt, lane, tg) - ngt; int pe = wave_incl_scan_dpp(neq, lane, te) - neq;
  LAS unsigned short* cand = (LAS unsigned short*)wl;
#pragma unroll
  for (int w = 0; w < 4; ++w) if (w * 2048 < n) {
    unsigned m = mg[w];
    while (m) { const unsigned bb = 32u * w + (unsigned)__builtin_ctz(m); m &= m - 1u; idx16[pg] = (unsigned short)((((bb >> 3) * 64u + (unsigned)lane) << 3) + (bb & 7u)); ++pg; }
    m = me[w];
    while (m) { const unsigned bb = 32u * w + (unsigned)__builtin_ctz(m); m &= m - 1u; cand[pe] = (unsigned short)((((bb >> 3) * 64u + (unsigned)lane) << 3) + (bb & 7u)); ++pe; }
  }
#undef BIN_OF
  LDSW();
  early(cnt_gt);
  const int m = te;
  if (MODE == 3) return m;
  unsigned lo = 0u;
  if (m <= 64) {
    unsigned cpv = 0u; if (lane < m) { const unsigned ci = cand[lane]; unsigned hv = srow[ci]; hv = (hv == 0x8000u) ? 0u : hv; cpv = ((h2key(hv) & 15u) << 13) | (8191u - ci) | (1u << 20); }
    int rank = 0;
    for (int k = 0; k < m; ++k) { const unsigned ok = (unsigned)__builtin_amdgcn_readlane((int)cpv, k); rank += (ok > cpv) ? 1 : 0; }
    const bool sel = (lane < m) && (rank < need1);
    const unsigned long long bs = __ballot(sel);
    if (sel) idx16[cnt_gt + __builtin_popcountll(bs & ((1ull << lane) - 1ull))] = (unsigned short)(8191u - (cpv & 0x1FFFu));
  } else if (m <= 256) {
    unsigned cp[4];
#pragma unroll
    for (int j = 0; j < 4; ++j) { const int q = lane + 64 * j; cp[j] = 0u; if (q < m) { const unsigned ci = cand[q]; unsigned hv = srow[ci]; hv = (hv == 0x8000u) ? 0u : hv; cp[j] = ((h2key(hv) & 15u) << 13) | (8191u - ci) | (1u << 20); } }
    for (int bit = 16; bit >= 0; --bit) { const unsigned trial = lo | (1u << bit); int tc = 0;
#pragma unroll
      for (int j = 0; j < 4; ++j) tc += __builtin_popcountll(__ballot((cp[j] >> 20) && ((cp[j] & 0x1FFFFu) >= trial)));
      if (tc >= need1) lo = trial; }
    int pos = cnt_gt;
#pragma unroll
    for (int j = 0; j < 4; ++j) { const bool sel = (cp[j] >> 20) && ((cp[j] & 0x1FFFFu) >= lo); const unsigned long long bs = __ballot(sel);
      if (sel) idx16[pos + __builtin_popcountll(bs & ((1ull << lane) - 1ull))] = (unsigned short)(8191u - (cp[j] & 0x1FFFu)); pos += __builtin_popcountll(bs); }
  } else {
    for (int bit = 16; bit >= 0; --bit) { const unsigned trial = lo | (1u << bit); int c = 0;
      for (int q = lane; q < m; q += 64) { const unsigned ci = cand[q]; unsigned hv = srow[ci]; hv = (hv == 0x8000u) ? 0u : hv; const unsigned cpq = ((h2key(hv) & 15u) << 13) | (8191u - ci); c += (cpq >= trial) ? 1 : 0; }
      int tc; (void)wave_excl_scan(c, lane, tc); if (tc >= need1) lo = trial; }
    int base = cnt_gt;
    for (int q0 = 0; q0 < m; q0 += 64) { const int q = q0 + lane; bool sel = false; unsigned ci = 0;
      if (q < m) { ci = cand[q]; unsigned hv = srow[ci]; hv = (hv == 0x8000u) ? 0u : hv; const unsigned cpq = ((h2key(hv) & 15u) << 13) | (8191u - ci); sel = cpq >= lo; }
      int tc; const int pos = base + wave_excl_scan(sel ? 1 : 0, lane, tc); if (sel) idx16[pos] = (unsigned short)ci; base += tc; }
  }
  LDSW();
  return 256;
}

#define ATT_QLOAD(qf_, b_, t_, lane_) { const bf16_t* qrow_ = qlat + (size_t)((b_) * L + (t_)) * 4096 + ((lane_) & 15) * 256 + 8 * ((lane_) >> 4); \
    _Pragma("unroll") for (int s_ = 0; s_ < 8; ++s_) qf_[s_] = __builtin_nontemporal_load((const bf16x8*)(qrow_ + 32 * s_)); }
#ifndef ATT_QKD
#define ATT_QKD 2
#endif
#ifndef ATT_PVD
#define ATT_PVD 4
#endif
template <int HOT = 0> __device__ __forceinline__ void wave_attend(int b, int t, int cnt, const bf16_t* qlat, const bf16_t* cnb, LAS unsigned char* wl, LAS unsigned short* idx16, bf16_t* olat, int lane, const bf16x8 (&qf)[8], v4u (&stg)[16], bool pre) {
  const int n16 = lane & 15, g = lane >> 4, q4 = (lane & 15) >> 2, p4 = lane & 3; (void)qlat;
  f32x4 o[16];
  { float z = 0.f; asm volatile("" : "+v"(z));
#pragma unroll
    for (int c = 0; c < 16; ++c) o[c] = (f32x4){z, z, z, z}; }
  float mrun = -INFINITY, lrun = 0.f;
  const int ntile = (cnt + 31) >> 5;
  const char* cb = (const char*)(cnb + (size_t)b * L * 256);
  const unsigned slot = lane & 15, rsub = lane >> 4;
  constexpr float SC = 0.125f * 1.4426950408889634f;
#define GATHER_TILE(itn) do { _Pragma("unroll") for (int rg = 0; rg < 8; ++rg) { const unsigned row = 4 * rg + rsub; const unsigned key = HOT ? (idx16[32 * (itn) + row] & 255u) : idx16[32 * (itn) + row]; \
      const unsigned ch = slot ^ (((row & 3u) << 2) | ((row >> 2) & 3u)); const unsigned off = key * 512u + ch * 16u;     \
      stg[rg] = *(const v4u*)(cb + off); stg[8 + rg] = *(const v4u*)(cb + off + 256u); } } while (0)
  if (!pre) GATHER_TILE(0);
#pragma unroll 1
  for (int it = 0; it < ntile; ++it) {
#pragma unroll
    for (int rg = 0; rg < 8; ++rg) { *(LAS v4u*)(wl + rg * 1024 + lane * 16) = stg[rg]; *(LAS v4u*)(wl + 8192 + rg * 1024 + lane * 16) = stg[8 + rg]; }
    if (!(HOT & 2) && it + 1 < ntile) GATHER_TILE(it + 1);
    f32x4 s0 = (f32x4){0.f, 0.f, 0.f, 0.f}, s1 = (f32x4){0.f, 0.f, 0.f, 0.f};
    { bf16x8 fa[2 * ATT_QKD];
#define QK_RD(s_, d0, d1) { const unsigned ib = ((s_) >> 2) * 8192, chq = 4 * ((s_) & 3) + g; d0 = *(const LAS bf16x8*)(wl + ib + offb(n16, chq)); d1 = *(const LAS bf16x8*)(wl + ib + offb(16 + n16, chq)); }
#pragma unroll
      for (int s = 0; s < ATT_QKD; ++s) QK_RD(s, fa[2 * s], fa[2 * s + 1])
      __builtin_amdgcn_sched_barrier(0);
#pragma unroll
      for (int s = 0; s < 8; ++s) {
        s0 = __builtin_amdgcn_mfma_f32_16x16x32_bf16(fa[2 * (s % ATT_QKD)], qf[s], s0, 0, 0, 0); s1 = __builtin_amdgcn_mfma_f32_16x16x32_bf16(fa[2 * (s % ATT_QKD) + 1], qf[s], s1, 0, 0, 0);
        if (s < 8 - ATT_QKD) QK_RD(s + ATT_QKD, fa[2 * (s % ATT_QKD)], fa[2 * (s % ATT_QKD) + 1])
        __builtin_amdgcn_sched_barrier(0);
      } }
    const int sl0 = 32 * it + 4 * g;
    float mx = -INFINITY;
#pragma unroll
    for (int r = 0; r < 4; ++r) { s0[r] = (sl0 + r < cnt) ? s0[r] * SC : -INFINITY; s1[r] = (sl0 + 16 + r < cnt) ? s1[r] * SC : -INFINITY; mx = fmaxf(mx, fmaxf(s0[r], s1[r])); }
    { const auto r16 = __builtin_amdgcn_permlane16_swap(__float_as_uint(mx), __float_as_uint(mx), false, false); mx = fmaxf(__uint_as_float(r16[0]), __uint_as_float(r16[1]));
      const auto r32 = __builtin_amdgcn_permlane32_swap(__float_as_uint(mx), __float_as_uint(mx), false, false); mx = fmaxf(__uint_as_float(r32[0]), __uint_as_float(r32[1])); }
    const float mnew = fmaxf(mrun, mx), alpha = __builtin_amdgcn_exp2f(mrun - mnew);
    float ls = 0.f; float pv[8];
#pragma unroll
    for (int r = 0; r < 4; ++r) { pv[r] = __builtin_amdgcn_exp2f(s0[r] - mnew); pv[4 + r] = __builtin_amdgcn_exp2f(s1[r] - mnew); ls += pv[r] + pv[4 + r]; }
    lrun = lrun * alpha + ls; mrun = mnew;
#pragma unroll
    for (int c = 0; c < 16; ++c) o[c] = o[c] * alpha;
    const v4u pbw = (v4u){cvt_pk_bf16(pv[0], pv[1]), cvt_pk_bf16(pv[2], pv[3]), cvt_pk_bf16(pv[4], pv[5]), cvt_pk_bf16(pv[6], pv[7])};
    const bf16x8 pb = __builtin_bit_cast(bf16x8, pbw);
    { v4i16_t ft[ATT_PVD][2];
#define PV_RD(c_, d) { const unsigned ib = ((c_) >> 3) * 8192, chc = 2 * ((c_) & 7) + (p4 >> 1); \
        d[0] = __builtin_amdgcn_ds_read_tr16_b64_v4i16((LAS v4i16_t*)(wl + ib + offb(4 * g + q4, chc) + 8 * (p4 & 1))); \
        d[1] = __builtin_amdgcn_ds_read_tr16_b64_v4i16((LAS v4i16_t*)(wl + ib + offb(16 + 4 * g + q4, chc) + 8 * (p4 & 1))); }
#pragma unroll
      for (int c = 0; c < ATT_PVD; ++c) PV_RD(c, ft[c])
      __builtin_amdgcn_sched_barrier(0);
#pragma unroll
      for (int c = 0; c < 16; ++c) { const v4i16_t t0 = ft[c % ATT_PVD][0], t1 = ft[c % ATT_PVD][1];
        const bf16x8 af = (bf16x8){t0[0], t0[1], t0[2], t0[3], t1[0], t1[1], t1[2], t1[3]};
        o[c] = __builtin_amdgcn_mfma_f32_16x16x32_bf16(af, pb, o[c], 0, 0, 0);
        if (c < 16 - ATT_PVD) PV_RD(c + ATT_PVD, ft[c % ATT_PVD])
        __builtin_amdgcn_sched_barrier(0);
      } }
    LDSW();
  }
  lrun += __shfl_xor(lrun, 16); lrun += __shfl_xor(lrun, 32);
  const float inv = 1.f / lrun;
  bf16_t* orow = olat + (size_t)(b * L + t) * 4096 + n16 * 256 + 4 * g;
  (void)orow;
#pragma unroll
  for (int c = 0; c < 16; ++c) { const f32x4 v = o[c] * inv; *(LAS v2u*)(wl + n16 * 528 + 32 * c + 8 * g) = (v2u){cvt_pk_bf16(v[0], v[1]), cvt_pk_bf16(v[2], v[3])}; }
  LDSW();
  { v4u d[8]; bf16_t* obase = olat + (size_t)(b * L + t) * 4096 + 8 * lane;
#pragma unroll
    for (int k = 0; k < 8; ++k) d[k] = *(const LAS v4u*)(wl + (2 * k + (lane >> 5)) * 528 + 16 * (lane & 31));
#pragma unroll
    for (int k = 0; k < 8; ++k) __builtin_nontemporal_store(d[k], (v4u*)(obase + 512 * k)); }
  LDSW();
}

#ifndef CONV_CAP
#define CONV_CAP 1
#endif
#ifndef CONV_HELP
#define CONV_HELP 2
#endif
__device__ __forceinline__ unsigned wave_ctr_add(LAS unsigned* p, unsigned v, int lane) {
  unsigned r = 0u; if (lane == 0) r = __hip_atomic_fetch_add(p, v, __ATOMIC_RELAXED, __HIP_MEMORY_SCOPE_WORKGROUP);
  return (unsigned)__builtin_amdgcn_readfirstlane((int)r); }
template <int NOCONV = 0> __device__ __forceinline__ void ph_select_attend(const unsigned short* sc, const bf16_t* qlat, const bf16_t* cnb, bf16_t* olat, LAS unsigned char* lds, const float* w1, const float* w2, bf16_t* W1_t, bf16_t* W2_t, void* scratch_olat = nullptr) {
  const int tid = TIDX(), lane = tid & 63, wave = __builtin_amdgcn_readfirstlane(tid >> 6), blk = BIDX();
  LAS unsigned char* wl = lds + wave * DW_STRIDE; LAS unsigned short* idx16 = (LAS unsigned short*)(wl + 16384);
  LAS unsigned* ctl = (LAS unsigned*)(lds + MISC_OFF + 64);
  if (tid < 3) ctl[tid] = 0u;
  __syncthreads();
  const int b = blk & 1, NGW = (int)gridDim.x * 8; (void)scratch_olat;
  constexpr unsigned NQ = 64u, NC = NOCONV ? 0u : 96u;
  bool help = false; int nq_done = 0;
  const bool conv_first = wave < CONV_CAP;
#pragma unroll 1
  for (;;) {
#define WADD(p_, v_) wave_ctr_add((p_), (v_), lane)
    unsigned item = 0xFFFFFFFFu;
    if (NC && (conv_first || help)) { const unsigned ci = WADD(ctl + 1, 1u); if (ci < NC) item = 64u + ci; help = false; }
    if (item == 0xFFFFFFFFu) { const unsigned qi = WADD(ctl, 1u); if (qi < NQ) item = qi; }
    if (NC && !conv_first && item == 0xFFFFFFFFu) { const unsigned ci = WADD(ctl + 1, 1u); if (ci < NC) item = 64u + ci; }
    if (item == 0xFFFFFFFFu) break;
    if (item < 64u) {
      const unsigned qn = item;
      const int t = (blk >> 1) * 8 + (int)(qn & 7u) + 1024 * (7 - (int)(qn >> 3));
      int lane_s = lane; asm volatile("" : "+v"(lane_s));
#ifdef SELMODE
      { int lane_x = lane; asm volatile("" : "+v"(lane_x)); const int cx = wave_select<SELMODE>(sc + (size_t)(b * L + t) * L, t, wl, idx16, lane_x, NoEarly()); if (cx == 12345) olat[0] = 0; }
#endif
      bf16x8 qfq[8]; ATT_QLOAD(qfq, b, t, lane_s)
      v4u stg0[16]; bool pre = false;
      const char* cb0 = (const char*)(cnb + (size_t)b * L * 256);
      auto early = [&](int kfin) { if (kfin >= 32) { pre = true; const unsigned slot = lane_s & 15, rsub = lane_s >> 4;
#pragma unroll
          for (int rg = 0; rg < 8; ++rg) { const unsigned row = 4 * rg + rsub; const unsigned key = idx16[row];
            const unsigned ch = slot ^ (((row & 3u) << 2) | ((row >> 2) & 3u)); const unsigned off = key * 512u + ch * 16u;
            stg0[rg] = *(const v4u*)(cb0 + off); stg0[8 + rg] = *(const v4u*)(cb0 + off + 256u); } } };
      const int cnt = wave_select<0>(sc + (size_t)(b * L + t) * L, t, wl, idx16, lane_s, early);
      int lane_a = lane; asm volatile("" : "+v"(lane_a));
      wave_attend(b, t, cnt, qlat, cnb, wl, idx16, olat, lane_a, qfq, stg0, pre);
      ++nq_done; help = (nq_done % CONV_HELP) == 0;
    } else {
      const unsigned cn = item - 64u;
      const int wt = blk * 8 + (int)(cn & 7u) + (int)(cn >> 3) * NGW;
      int lane_t = lane; asm volatile("" : "+v"(lane_t));
      moe_weight_tile(wt < 12288 ? moe_layer_tile(0, wt) : moe_layer_tile(1, wt - 12288), w1, w2, W1_t, W2_t, lane_t, wl);
    }
  }
}

#ifdef GBENCH
#ifndef ABM
#define ABM 0
#endif
__device__ __forceinline__ void ph_attbench(const bf16_t* qlat, const bf16_t* cnb, bf16_t* scratch_olat, LAS unsigned char* lds) {
  const int tid = TIDX(), lane = tid & 63, wave = __builtin_amdgcn_readfirstlane(tid >> 6), blk = BIDX();
  LAS unsigned char* wl = lds + wave * DW_STRIDE; LAS unsigned short* idx16 = (LAS unsigned short*)(wl + 16384);
  const int b = blk & 1;
#pragma unroll 1
  for (int qi = 0; qi < 8; ++qi) {
    const int t = (blk >> 1) * 8 + wave + 1024 * qi;
    for (int i = lane; i < 256; i += 64) idx16[i] = (unsigned short)((((unsigned)i * 2654435761u + (unsigned)t * 40503u) >> 13) % (unsigned)(t + 1));
    LDSW();
    int lane_a = lane; asm volatile("" : "+v"(lane_a));
    bf16x8 qfq[8]; ATT_QLOAD(qfq, b, t, lane_a) v4u stgb[16];
    wave_attend<ABM & 7>(b, t, (ABM & 32) ? 32 : (t + 1 < 256 ? t + 1 : 256), qlat, cnb, wl, idx16, scratch_olat, lane_a, qfq, stgb, false);
  }
}
#endif
#ifdef GBENCH
__device__ __forceinline__ void ph_gbench(const bf16_t* cnb, unsigned* sink) {
  const int tid = TIDX(), lane = tid & 63, wave = tid >> 6, blk = BIDX();
  const int b = blk & 1; const char* cb = (const char*)(cnb + (size_t)b * L * 256);
  const unsigned slot = lane & 15, rsub = lane >> 4;
  v4u accx = (v4u){0u, 0u, 0u, 0u};
#pragma unroll 1
  for (int qi = 0; qi < 8; ++qi) {
    const unsigned t = (unsigned)((blk >> 1) * 8 + wave + 1024 * qi);
#if GBENCH == 1
    v4u stg[16];
#define GB_TILE(itn) { _Pragma("unroll") for (int rg = 0; rg < 8; ++rg) { const unsigned row = 4 * rg + rsub; const unsigned key = (((32u * (itn) + row) * 2654435761u + t * 40503u) >> 13) & 8191u; \
      const unsigned off = key * 512u + slot * 16u; stg[rg] = *(const v4u*)(cb + off); stg[8 + rg] = *(const v4u*)(cb + off + 256u); } }
    GB_TILE(0)
#pragma unroll 1
    for (int it = 0; it < 8; ++it) {
      v4u f = (v4u){0u, 0u, 0u, 0u};
#pragma unroll
      for (int k = 0; k < 16; ++k) f ^= stg[k];
      accx ^= f;
      if (it + 1 < 8) GB_TILE(it + 1)
    }
#undef GB_TILE
#elif GBENCH == 2
    v4u sa[16], sb[16];
#define GB_TILE(dst, itn) { _Pragma("unroll") for (int rg = 0; rg < 8; ++rg) { const unsigned row = 4 * rg + rsub; const unsigned key = (((32u * (itn) + row) * 2654435761u + t * 40503u) >> 13) & 8191u; \
      const unsigned off = key * 512u + slot * 16u; dst[rg] = *(const v4u*)(cb + off); dst[8 + rg] = *(const v4u*)(cb + off + 256u); } }
    GB_TILE(sa, 0) GB_TILE(sb, 1)
#pragma unroll 1
    for (int it = 0; it < 8; it += 2) {
      v4u f = (v4u){0u, 0u, 0u, 0u};
#pragma unroll
      for (int k = 0; k < 16; ++k) f ^= sa[k];
      accx ^= f;
      if (it + 2 < 8) GB_TILE(sa, it + 2)
      f = (v4u){0u, 0u, 0u, 0u};
#pragma unroll
      for (int k = 0; k < 16; ++k) f ^= sb[k];
      accx ^= f;
      if (it + 3 < 8) GB_TILE(sb, it + 3)
    }
#undef GB_TILE
#endif
  }
  if ((accx[0] ^ accx[1] ^ accx[2] ^ accx[3]) == 0x12345678u) sink[tid] = 1u;
}
#endif

__device__ __forceinline__ void ph_qlat(const bf16_t* pa, const bf16_t* WqT, bf16_t* qlat) {
  const int tid = TIDX(), lane = tid & 63, gw = BIDX() * 8 + (tid >> 6), NGW = (int)gridDim.x * 8;
  const int n16 = lane & 15, g = lane >> 4;
#pragma unroll 1
  for (int it = gw; it < 16 * 512; it += NGW) {
    const int h = it & 15, rt = it >> 4;
    bf16x8 qb[2][2];
#pragma unroll
    for (int mt = 0; mt < 2; ++mt)
#pragma unroll
      for (int ks = 0; ks < 2; ++ks) qb[mt][ks] = *(const bf16x8*)(pa + (size_t)(rt * 32 + mt * 16 + n16) * 2048 + h * 64 + 32 * ks + 8 * g);
    const bf16_t* wp = WqT + (size_t)h * 256 * 64 + (size_t)n16 * 64 + 8 * g;
    bf16_t* op = qlat + (size_t)(rt * 32 + n16) * 4096 + h * 256 + 4 * g;
#pragma unroll 4
    for (int ct = 0; ct < 16; ++ct) {
      const bf16x8 a0 = *(const bf16x8*)(wp + (size_t)(16 * ct) * 64), a1 = *(const bf16x8*)(wp + (size_t)(16 * ct) * 64 + 32);
#pragma unroll
      for (int mt = 0; mt < 2; ++mt) { f32x4 acc = __builtin_amdgcn_mfma_f32_16x16x32_bf16(a0, qb[mt][0], (f32x4){0.f, 0.f, 0.f, 0.f}, 0, 0, 0);
        acc = __builtin_amdgcn_mfma_f32_16x16x32_bf16(a1, qb[mt][1], acc, 0, 0, 0);
        *(v2u*)(op + (size_t)(mt * 16) * 4096 + 16 * ct) = (v2u){cvt_pk_bf16(acc[0], acc[1]), cvt_pk_bf16(acc[2], acc[3])}; }
    }
  }
}
__device__ __forceinline__ void ph_o2(const bf16_t* olat, const bf16_t* WuvT, bf16_t* o2b) {
  const int tid = TIDX(), lane = tid & 63, gw = BIDX() * 8 + (tid >> 6), NGW = (int)gridDim.x * 8;
  const int n16 = lane & 15, g = lane >> 4;
#pragma unroll 1
  for (int it = gw; it < 16 * 512; it += NGW) {
    const int h = it & 15, rt = it >> 4;
    f32x4 acc[4][2];
#pragma unroll
    for (int vt = 0; vt < 4; ++vt) { acc[vt][0] = (f32x4){0.f, 0.f, 0.f, 0.f}; acc[vt][1] = (f32x4){0.f, 0.f, 0.f, 0.f}; }
    const bf16_t* ap = olat + (size_t)(rt * 32 + n16) * 4096 + h * 256 + 8 * g;
    const bf16_t* wp = WuvT + (size_t)h * 64 * 256 + (size_t)n16 * 256 + 8 * g;
#pragma unroll
    for (int ks = 0; ks < 8; ++ks) {
      const bf16x8 b0 = *(const bf16x8*)(ap + 32 * ks), b1 = *(const bf16x8*)(ap + (size_t)16 * 4096 + 32 * ks);
#pragma unroll
      for (int vt = 0; vt < 4; ++vt) { const bf16x8 a = *(const bf16x8*)(wp + (size_t)(16 * vt) * 256 + 32 * ks);
        acc[vt][0] = __builtin_amdgcn_mfma_f32_16x16x32_bf16(a, b0, acc[vt][0], 0, 0, 0); acc[vt][1] = __builtin_amdgcn_mfma_f32_16x16x32_bf16(a, b1, acc[vt][1], 0, 0, 0); }
    }
    bf16_t* op = o2b + (size_t)(rt * 32 + n16) * 1024 + h * 64 + 4 * g;
#pragma unroll
    for (int vt = 0; vt < 4; ++vt)
#pragma unroll
      for (int mt = 0; mt < 2; ++mt) *(v2u*)(op + (size_t)(mt * 16) * 1024 + 16 * vt) = (v2u){cvt_pk_bf16(acc[vt][mt][0], acc[vt][mt][1]), cvt_pk_bf16(acc[vt][mt][2], acc[vt][mt][3])};
  }
}

namespace pg8 {
struct GroupAOrder {
    static constexpr bool GATHER = false; const int* rowmap;
    StaticOrder so; int png; size_t acol_bytes;
    __device__ void init(const void* A, int lda, const void* Bt, int ldb, int M, int N, int png_, size_t acol_bytes_, int G, int c) { so.init(A, lda, Bt, ldb, M, N, G, c); png = png_; acol_bytes = acol_bytes_; }
    __device__ bool next(int i, Unit& u) const { int pm, pn; if (!so.tile(i, pm, pn)) return false; u.pa = so.A + (size_t)pm * so.ta + (size_t)(pn / png) * acol_bytes; u.pb = so.Bt + (size_t)pn * so.tb; u.orow = pm * BM; u.ocol = pn * BM; u.e = 0; u.kind = 0; return true; }
    __device__ __forceinline__ int rowof(const Unit&, int r) const { return r; }
    __device__ __forceinline__ void a_ready(const Unit&) const {}
    __device__ __forceinline__ void done(const Unit&) const {}
};
}
constexpr int GLA_LDSU = 65536;

__device__ __forceinline__ v4i16_t trrd(LAS unsigned char* p) { return __builtin_amdgcn_ds_read_tr16_b64_v4i16((LAS v4i16_t*)p); }
__device__ __forceinline__ bf16x8 cat44(v4i16_t a, v4i16_t b) { return (bf16x8){a[0], a[1], a[2], a[3], b[0], b[1], b[2], b[3]}; }

__device__ __forceinline__ void ph_gla_a1(const bf16_t* pb, const float* gbias, bf16_t* qt, bf16_t* og, bf16_t* kvt, float* dcy, LAS unsigned char* lds, const bf16_t* xbin, const bf16_t* WzT, const float* wg2) {
  const int tid = TIDX(), lane = tid & 63, wave = __builtin_amdgcn_readfirstlane(tid >> 6), blk = BIDX();
  const int half = wave >> 2, wq = wave & 3;
  LAS unsigned char* X = lds + half * GLA_LDSU; LAS unsigned char* Y = X + 16384; LAS unsigned char* V = X + 32768;
  LAS float* EX = (LAS float*)(lds + 131072 + half * 2048);
  const unsigned v_addr = (unsigned)__builtin_amdgcn_readfirstlane((int)(unsigned)(size_t)V);
  const int n16 = lane & 15, g = lane >> 4, q4 = (lane & 15) >> 2, p4 = lane & 3;
  LAS float* ZL = (LAS float*)(lds + 135168);
  { const int mt = wave & 3, kh = wave >> 2;
    const bf16_t* ap = xbin + (size_t)(blk * 64 + 16 * mt + n16) * D + kh * 512 + 8 * g;
    const bf16_t* bp = WzT + (size_t)n16 * D + kh * 512 + 8 * g;
    bf16x8 af[16], bfz[16];
#pragma unroll
    for (int s_ = 0; s_ < 16; ++s_) { af[s_] = *(const bf16x8*)(ap + 32 * s_); bfz[s_] = *(const bf16x8*)(bp + 32 * s_); }
    f32x4 zacc = (f32x4){0.f, 0.f, 0.f, 0.f};
#pragma unroll
    for (int s_ = 0; s_ < 16; ++s_) zacc = __builtin_amdgcn_mfma_f32_16x16x32_bf16(af[s_], bfz[s_], zacc, 0, 0, 0);
    if (kh == 1) {
#pragma unroll
      for (int r = 0; r < 4; ++r) ZL[(16 * mt + 4 * g + r) * 16 + n16] = zacc[r]; }
    LDSW(); __syncthreads();
    if (kh == 0) {
#pragma unroll
      for (int r = 0; r < 4; ++r) ZL[(16 * mt + 4 * g + r) * 16 + n16] += zacc[r]; }
    LDSW(); __syncthreads(); }
#pragma unroll 1
  for (int uu = 0; uu < 2; ++uu) {
    const int u = blk * 4 + half * 2 + uu;
    const int h = u & 3, bc = u >> 2, r0 = bc * 64;
    { const unsigned slot = lane & 15, rsub = lane >> 4; const int im = wq;
#pragma unroll
      for (int rg = 0; rg < 8; ++rg) { const unsigned row = 4 * rg + rsub; const unsigned ch = slot ^ (((row & 3u) << 2) | ((row >> 2) & 3u));
        const char* src = (const char*)(pb + (size_t)(r0 + 32 * (im >> 1) + row) * 3584 + 1024 + h * 256 + (im & 1) * 128) + ch * 16;
        glds16(src, v_addr + im * 8192 + rg * 1024); } }
    const int d0 = 2 * lane; const float gb0 = gbias[h * 128 + d0], gb1 = gbias[h * 128 + d0 + 1];
    const unsigned wofs = 16u * ((unsigned)(d0 >> 3)), wsub = (unsigned)(d0 & 7) * 2u;
    unsigned qq[16], kq[16]; float bl0[16], bl1[16];
#pragma unroll
    for (int jj = 0; jj < 16; ++jj) { const bf16_t* rp = pb + (size_t)(r0 + wq * 16 + jj) * 3584 + h * 128 + d0;
      qq[jj] = __builtin_nontemporal_load((const unsigned*)rp); kq[jj] = __builtin_nontemporal_load((const unsigned*)(rp + 512)); }
    f32x2_t wz[16];
#pragma unroll
    for (int j = 0; j < 16; ++j) wz[j] = *(const f32x2_t*)(wg2 + j * 512 + h * 128 + d0);
    float bc0 = 0.f, bc1 = 0.f;
#pragma unroll
    for (int jj = 0; jj < 16; ++jj) { f32x2_t ga = (f32x2_t){gb0, gb1};
#pragma unroll
      for (int j4 = 0; j4 < 4; ++j4) { const f32x4 z4 = *(const LAS f32x4*)(ZL + (wq * 16 + jj) * 16 + 4 * j4);
#pragma unroll
        for (int z_ = 0; z_ < 4; ++z_) ga = __builtin_elementwise_fma((f32x2_t){z4[z_], z4[z_]}, wz[4 * j4 + z_], ga); }
      const float a0 = ga[0], a1 = ga[1];
      bc0 += (fminf(a0, 0.f) - __logf(1.f + __expf(-fabsf(a0)))) * (1.f / 16.f); bc1 += (fminf(a1, 0.f) - __logf(1.f + __expf(-fabsf(a1)))) * (1.f / 16.f);
      bl0[jj] = bc0; bl1[jj] = bc1; }
    *(LAS f32x2_t*)(EX + wq * 128 + d0) = (f32x2_t){bc0, bc1};
    LDSW(); __syncthreads();
    float of0 = 0.f, of1 = 0.f, tt0 = 0.f, tt1 = 0.f;
#pragma unroll
    for (int w2_ = 0; w2_ < 4; ++w2_) { const f32x2_t e = *(const LAS f32x2_t*)(EX + w2_ * 128 + d0); tt0 += e[0]; tt1 += e[1]; if (w2_ < wq) { of0 += e[0]; of1 += e[1]; } }
#pragma unroll
    for (int jj = 0; jj < 16; ++jj) { const int j = wq * 16 + jj; const float b0 = bl0[jj] + of0, b1 = bl1[jj] + of1;
      const float e0 = __expf(b0), e1 = __expf(b1), i0 = __expf(fminf(-b0, 80.f)), i1 = __expf(fminf(-b1, 80.f));
      const unsigned qo = cvt_pk_bf16(bf_lo(qq[jj]) * 0.08838834764831845f * e0, bf_hi(qq[jj]) * 0.08838834764831845f * e1);
      const unsigned ko = cvt_pk_bf16(bf_lo(kq[jj]) * i0, bf_hi(kq[jj]) * i1);
      *(unsigned*)(qt + (size_t)(r0 + j) * 512 + h * 128 + d0) = qo;
      const unsigned row = (unsigned)(j & 31); const unsigned off = (unsigned)(j >> 5) * 8192u + 256u * row + ((wofs ^ (16u * (((row & 3u) << 2) | ((row >> 2) & 3u))))) + wsub;
      *(LAS unsigned*)(X + off) = qo; *(LAS unsigned*)(Y + off) = ko; }
    if (wq == 3) *(float2*)(dcy + (size_t)u * 128 + d0) = make_float2(__expf(tt0), __expf(tt1));
    asm volatile("s_waitcnt vmcnt(0) lgkmcnt(0)" ::: "memory");
    __syncthreads();
    const int it = wq;
    bf16x8 afr[2];
#pragma unroll
    for (int ks = 0; ks < 2; ++ks) {
      unsigned pk[4] = {0u, 0u, 0u, 0u};
#pragma unroll
      for (int jh = 0; jh < 2; ++jh) { const int jt = 2 * ks + jh;
        if (jt <= it) { f32x4 acc = (f32x4){0.f, 0.f, 0.f, 0.f};
#pragma unroll
          for (int s = 0; s < 4; ++s) { const bf16x8 ya = *(const LAS bf16x8*)(Y + (jt >> 1) * 8192 + offb(n16 + 16 * (jt & 1), 4 * s + g)), xb = *(const LAS bf16x8*)(X + (it >> 1) * 8192 + offb(n16 + 16 * (it & 1), 4 * s + g));
            acc = __builtin_amdgcn_mfma_f32_16x16x32_bf16(ya, xb, acc, 0, 0, 0); }
          const int i_ = 16 * it + n16, jbase = 16 * jt + 4 * g;
#pragma unroll
          for (int r = 0; r < 4; ++r) if (jbase + r > i_) acc[r] = 0.f;
          pk[2 * jh] = cvt_pk_bf16(acc[0], acc[1]); pk[2 * jh + 1] = cvt_pk_bf16(acc[2], acc[3]); } }
      afr[ks] = __builtin_bit_cast(bf16x8, (v4u){pk[0], pk[1], pk[2], pk[3]});
    }
    bf16_t* ogp = og + (size_t)u * 16384 + (size_t)(it * 16) * 256 + lane * 4; bf16_t* kvp = kvt + (size_t)u * 32768 + (size_t)n16 * 128 + 4 * g;
#pragma unroll 2
    for (int nt = 0; nt < 16; ++nt) {
      const unsigned vimg = (unsigned)(nt >> 3) * 8192u, chv = 2u * (unsigned)(nt & 7) + (unsigned)(p4 >> 1), sub = 8u * (unsigned)(p4 & 1);
      f32x4 acc = (f32x4){0.f, 0.f, 0.f, 0.f};
      { LAS unsigned char* vb = V + vimg; const bf16x8 bi0 = cat44(trrd(vb + offb(4 * g + q4, chv) + sub), trrd(vb + offb(16 + 4 * g + q4, chv) + sub));
        acc = __builtin_amdgcn_mfma_f32_16x16x32_bf16(afr[0], bi0, acc, 0, 0, 0); }
      if (it >= 2) { LAS unsigned char* vb = V + 16384 + vimg; const bf16x8 bi1 = cat44(trrd(vb + offb(4 * g + q4, chv) + sub), trrd(vb + offb(16 + 4 * g + q4, chv) + sub));
        acc = __builtin_amdgcn_mfma_f32_16x16x32_bf16(afr[1], bi1, acc, 0, 0, 0); }
      *(v2u*)(ogp + (size_t)nt * 256) = (v2u){cvt_pk_bf16(acc[0], acc[1]), cvt_pk_bf16(acc[2], acc[3])};
    }
#pragma unroll 1
    for (int nq = 0; nq < 4; ++nq) { const int nt = 4 * wq + nq;
      const unsigned vimg = (unsigned)(nt >> 3) * 8192u, chv = 2u * (unsigned)(nt & 7) + (unsigned)(p4 >> 1), sub = 8u * (unsigned)(p4 & 1);
      bf16x8 bn[2];
#pragma unroll
      for (int ks = 0; ks < 2; ++ks) { LAS unsigned char* vb = V + ks * 16384 + vimg; bn[ks] = cat44(trrd(vb + offb(8 * g + q4, chv) + sub), trrd(vb + offb(8 * g + 4 + q4, chv) + sub)); }
#pragma unroll
      for (int mt = 0; mt < 8; ++mt) { const unsigned chy = 2u * (unsigned)mt + (unsigned)(p4 >> 1);
        const bf16x8 a0 = cat44(trrd(Y + offb(8 * g + q4, chy) + sub), trrd(Y + offb(8 * g + 4 + q4, chy) + sub));
        const bf16x8 a1 = cat44(trrd(Y + 8192 + offb(8 * g + q4, chy) + sub), trrd(Y + 8192 + offb(8 * g + 4 + q4, chy) + sub));
        f32x4 acc = __builtin_amdgcn_mfma_f32_16x16x32_bf16(a0, bn[0], (f32x4){0.f, 0.f, 0.f, 0.f}, 0, 0, 0);
        acc = __builtin_amdgcn_mfma_f32_16x16x32_bf16(a1, bn[1], acc, 0, 0, 0);
        *(v2u*)(kvp + (size_t)(16 * nt) * 128 + 16 * mt) = (v2u){cvt_pk_bf16(acc[0], acc[1]), cvt_pk_bf16(acc[2], acc[3])}; }
    }
    LDSW(); __syncthreads();
  }
}

__device__ __forceinline__ void ph_gla_a2(const bf16_t* kvt, const float* dcy, bf16_t* spt) {
  const int gtid = BIDX() * NTHR + TIDX();
  if (gtid >= 8 * 256 * 32) return;
  const int g4 = gtid & 31, dv = (gtid >> 5) & 255, bh = gtid >> 13, b = bh >> 2, h = bh & 3;
  f32x4 S = (f32x4){0.f, 0.f, 0.f, 0.f};
#pragma unroll 4
  for (int c = 0; c < 128; ++c) { const size_t u = (size_t)((b * 128 + c) * 4 + h);
    const v2u kvb = __builtin_nontemporal_load((const v2u*)(kvt + u * 32768 + (size_t)dv * 128 + 4 * g4)); const f32x4 kv = (f32x4){bf_lo(kvb[0]), bf_hi(kvb[0]), bf_lo(kvb[1]), bf_hi(kvb[1])}, dc = *(const f32x4*)(dcy + u * 128 + 4 * g4);
    *(v2u*)(spt + u * 32768 + (size_t)dv * 128 + 4 * g4) = (v2u){cvt_pk_bf16(S[0], S[1]), cvt_pk_bf16(S[2], S[3])};
    S = dc * (S + kv); }
}

constexpr int A3_LD = 272;
__device__ __forceinline__ void ph_gla_a3(const bf16_t* pb, const bf16_t* qt, const bf16_t* og, const bf16_t* spt, const float* ng, bf16_t* ob, LAS unsigned char* lds) {
  const int tid = TIDX(), lane = tid & 63, wave = __builtin_amdgcn_readfirstlane(tid >> 6), gw = BIDX() * 8 + wave, NGW = (int)gridDim.x * 8;
  const int n16 = lane & 15, g = lane >> 4, row16 = lane >> 2, cq = lane & 3;
  LAS float* T = (LAS float*)(lds + wave * (16 * A3_LD * 4));
#pragma unroll 1
  for (int w = gw; w < 4096; w += NGW) {
    const int u = w >> 2, it = w & 3, h = u & 3, r0 = (u >> 2) * 64;
    const bf16_t* sp = spt + (size_t)u * 32768 + (size_t)n16 * 128 + 8 * g;
    bf16x8 qa[4];
#pragma unroll
    for (int ks = 0; ks < 4; ++ks) qa[ks] = __builtin_nontemporal_load((const bf16x8*)(qt + (size_t)(r0 + 16 * it + n16) * 512 + h * 128 + 32 * ks + 8 * g));
    const bf16_t* ogp = og + (size_t)u * 16384 + (size_t)(it * 16) * 256 + lane * 4;
    v2u rgv[16];
#pragma unroll
    for (int k = 0; k < 16; ++k) rgv[k] = __builtin_nontemporal_load((const v2u*)(pb + (size_t)(r0 + 16 * it + row16) * 3584 + 2048 + h * 256 + 16 * k + 4 * cq));
#pragma unroll
    for (int nt = 0; nt < 16; ++nt) {
      const v2u ogb = __builtin_nontemporal_load((const v2u*)(ogp + nt * 256)); f32x4 acc = (f32x4){bf_lo(ogb[0]), bf_hi(ogb[0]), bf_lo(ogb[1]), bf_hi(ogb[1])};
#pragma unroll
      for (int ks = 0; ks < 4; ++ks) { const bf16x8 sb = *(const bf16x8*)(sp + (size_t)(16 * nt) * 128 + 32 * ks); acc = __builtin_amdgcn_mfma_f32_16x16x32_bf16(qa[ks], sb, acc, 0, 0, 0); }
#pragma unroll
      for (int r = 0; r < 4; ++r) T[(4 * g + r) * A3_LD + 16 * nt + n16] = acc[r];
    }
    LDSW();
    const size_t row = (size_t)(r0 + 16 * it + row16);
    f32x4 v[16]; float ss = 0.f;
#pragma unroll
    for (int k = 0; k < 16; ++k) { v[k] = *(const LAS f32x4*)(T + row16 * A3_LD + 16 * k + 4 * cq); ss += (v[k][0] * v[k][0] + v[k][1] * v[k][1]) + (v[k][2] * v[k][2] + v[k][3] * v[k][3]); }
    ss += __shfl_xor(ss, 1); ss += __shfl_xor(ss, 2);
    const float rs = rsqrtf(ss * (1.f / 256.f) + 1e-6f);
#pragma unroll
    for (int k = 0; k < 16; ++k) { const int col = h * 256 + 16 * k + 4 * cq; const v2u rg = rgv[k]; const f32x4 gn = *(const f32x4*)(ng + col);
      const float rr[4] = {bf_lo(rg[0]), bf_hi(rg[0]), bf_lo(rg[1]), bf_hi(rg[1])}; float o[4];
#pragma unroll
      for (int z = 0; z < 4; ++z) o[z] = v[k][z] * rs * gn[z] * (rr[z] * __builtin_amdgcn_rcpf(1.f + __expf(-rr[z])));
      *(v2u*)(ob + row * 1024 + col) = (v2u){cvt_pk_bf16(o[0], o[1]), cvt_pk_bf16(o[2], o[3])}; }
    LDSW();
  }
}
#ifndef PROBE
#define PROBE 0
#endif
#ifndef PROBE_S
#define PROBE_S 10.0f
#endif
constexpr size_t MiB = 1u << 20;
#if defined(FUSE_ON) || PROBE != 0
constexpr size_t WS_CTL = 0, CTL_ZERO_BYTES = 1 * MiB;
#else
constexpr size_t WS_CTL = 0, CTL_ZERO_BYTES = 64 * 1024;
#endif
constexpr int CW_BAR = 4096, CW_TMO = 64, CW_RDY = 65536, CW_ISC = 1024;
constexpr size_t WS_NEEDED = 2048 * MiB;

struct Args { In in; float* out; unsigned char* ws; };

struct Opt { bf16_t *qt, *spt, *og, *kvt; float *dcy; bf16_t *Wql_t, *Wuv_t, *cnb, *kib, *qlat, *olat; unsigned short* sc; bf16_t *xb, *WA_t, *WoutA_t, *WB_t, *WoutB_t, *W1_t, *W2_t, *projA_b, *hbf, *o2b, *xs, *act, *Ys, *projB_b; MoeBufs m; };
__device__ __forceinline__ nvp::Ws carve_ws(unsigned char* ws) {
  nvp::Ws w; auto at = [&](size_t mib) { return (char*)ws + mib * MiB; };
  w.projA = (float*)at(2); w.cn = (float*)at(119); w.sc = (float*)at(135); w.idx = (int*)at(647); w.o2 = (float*)at(663);
  w.x1 = (float*)at(727); w.x2 = (float*)at(791);
  w.projB = (float*)at(135); w.adec = (float*)at(135 + 194); w.og = (float*)at(135 + 194 + 32); w.on = (float*)at(135 + 194 + 32 + 64);
  w.counts = nullptr; w.h = nullptr; w.hb = nullptr; w.ys = nullptr; w.tok_e = nullptr; w.tok_g = nullptr; w.slot_of = nullptr; w.row_tok = nullptr; w.row_gate = nullptr; w.blk_e = nullptr;
  return w;
}
__device__ __forceinline__ Opt carve_opt(unsigned char* ws) {
  Opt o; auto at = [&](size_t mib) { return (bf16_t*)((char*)ws + mib * MiB); };
  char* sm = (char*)ws + 855 * MiB;
  o.m.tok_e = (int*)sm; o.m.tok_g = (float*)(sm + 256 * 1024); o.m.slot_of = (int*)(sm + 512 * 1024); o.m.slot_gate = (float*)(sm + 768 * 1024); o.m.blk_e = (int*)(sm + 1088 * 1024); o.m.blkcnt = (int*)(sm + 1096 * 1024); o.m.nblk = (int*)(sm + 1160 * 1024); o.m.slot_tok = (int*)(sm + 1200 * 1024);
  o.WA_t = at(860); o.WoutA_t = at(864); o.WB_t = at(866); o.WoutB_t = at(873);
  o.Wql_t = at(875); o.Wuv_t = at(877); o.olat = at(2); o.cnb = at(647); o.kib = at(656); o.qlat = at(1856); o.sc = (unsigned short*)at(135);
  o.qt = at(135); o.dcy = (float*)at(151); o.og = at(152); o.kvt = at(216); o.spt = at(344);
  o.W1_t = at(880); o.W2_t = at(1136);
  o.xb = at(1264); o.projA_b = at(1296); o.hbf = at(1360); o.o2b = at(1392);
  o.xs = at(1424); o.act = at(1568); o.Ys = at(1712); o.projB_b = at(1856);
  return o;
}

struct ProIn { const float *a_w_uk, *a_w_uv, *x, *a_w_in, *a_w_out, *b_w_in, *b_w_g2, *b_w_out, *m_w1, *m_w2; };
__device__ __forceinline__ void ph_prologue(const ProIn I, const Opt& o, LAS unsigned char* lds) {
  const int tid = TIDX(), lane = tid & 63, gw = BIDX() * 8 + (tid >> 6), NGW = (int)gridDim.x * 8, gtid = BIDX() * NTHR + tid, NGT = (int)gridDim.x * NTHR;
  cvt_f32_to_bf16_flat(I.x, o.xb, (size_t)NT * D / 4, gtid, NGT);
  zero_rect(o.WA_t, D, DINA, 2048 - DINA, 0, D * 2, gtid, NGT);
  for (int i = gtid; i < 16 * D; i += NGT) { const int j = i >> 10, k = i & 1023; o.WB_t[(size_t)(3072 + j) * D + k] = (bf16_t)(cvt_pk_bf16(I.b_w_in[(size_t)k * DINB + 2048 + j], 0.f) & 0xFFFFu); }
  int w0 = 0; LAS unsigned char* stage = lds + (tid >> 6) * 16384;
#pragma unroll 1
  for (int h = 0; h < 16; ++h) {
    transpose_job(mk_tjob(I.a_w_uk + (size_t)h * 64 * 256, 256, 64, 256, o.Wql_t, 256, h * 256, (h & 3) * 64, 0), w0, gw, NGW, lane, stage);
    transpose_job(mk_tjob(I.a_w_uv + (size_t)h * 256 * 64, 64, 256, 64, o.Wuv_t, 1024, h * 64, (h & 3) * 256, 0), w0, gw, NGW, lane, stage);
    for (int hp = 0; hp < 4; ++hp) if (hp != (h & 3)) { zero_rect(o.Wql_t, 256, h * 256, 256, hp * 128, 128, gtid, NGT); zero_rect(o.Wuv_t, 1024, h * 64, 64, hp * 512, 512, gtid, NGT); }
  }
  transpose_job(mk_tjob(I.a_w_in, DINA, D, DINA, o.WA_t, D, 0, 0, 0), w0, gw, NGW, lane, stage);
  transpose_job(mk_tjob(I.a_w_out, D, D, D, o.WoutA_t, D, 0, 0, 0), w0, gw, NGW, lane, stage);
  transpose_job(mk_tjob(I.b_w_in, DINB, D, 2048, o.WB_t, D, 0, 0, 0), w0, gw, NGW, lane, stage);
  transpose_job(mk_tjob(I.b_w_in + 2064, DINB, D, 1024, o.WB_t, D, 2048, 0, 0), w0, gw, NGW, lane, stage);
  transpose_job(mk_tjob(I.b_w_out, D, D, D, o.WoutB_t, D, 0, 0, 0), w0, gw, NGW, lane, stage);
}
__device__ __forceinline__ void ph_gla_shim(const bf16_t* pb, const float* gbias, float* projB, float* adec) {
  const int gtid = BIDX() * NTHR + TIDX(), NGT = (int)gridDim.x * NTHR;
  for (size_t i = gtid; i < (size_t)NT * 896; i += NGT) { const size_t r = i / 896; const int c = (int)(i % 896) * 4; const v2u v = *(const v2u*)(pb + r * 3584 + c);
    const f32x4 f = (f32x4){bf_lo(v[0]), bf_hi(v[0]), bf_lo(v[1]), bf_hi(v[1])};
    if (c < 2048) *(f32x4*)(projB + r * DINB + c) = f;
    else if (c < 3072) *(f32x4*)(projB + r * DINB + 2064 + (c - 2048)) = f;
    else { f32x4 o;
#pragma unroll
      for (int z = 0; z < 4; ++z) { const float a = f[z] + gbias[c - 3072 + z]; const float ls = fminf(a, 0.f) - log1pf(expf(-fabsf(a))); o[z] = expf(ls * (1.f / 16.f)); }
      *(f32x4*)(adec + r * 512 + (c - 3072)) = o; } }
}

#if PROBE == 3
#define GLA_PHASES \
      PH_BEGIN ph_gla_shim(o.projB_b, I.b_g_bias, w.projB, w.adec); PH_END \
      GRID_BAR(); \
      PH_BEGIN nvp::np_gla_scan(w.projB, w.adec, w.og, fl); PH_END \
      GRID_BAR(); \
      PH_BEGIN nvp::np_gla_norm(w.og, w.projB, I.b_norm, w.on); PH_END \
      GRID_BAR(); \
      PH_BEGIN cvt_f32_to_bf16(w.on, D, o.o2b, D, NT, D, gtid_, NGT_); PH_END \
      GRID_BAR(); \
      PH_BEGIN ph_gla_a1(o.projB_b, I.b_g_bias, (bf16_t*)(wsb_ + 489 * MiB), (bf16_t*)(wsb_ + 506 * MiB), (bf16_t*)(wsb_ + 880 * MiB), (float*)(wsb_ + 505 * MiB), ll, I.m_w1, I.m_w2, o.W1_t, o.W2_t); PH_END \
      GRID_BAR(); \
      PH_BEGIN ph_gla_a2((bf16_t*)(wsb_ + 880 * MiB), (float*)(wsb_ + 505 * MiB), (bf16_t*)(wsb_ + 1136 * MiB)); PH_END \
      GRID_BAR(); \
      PH_BEGIN ph_gla_a3(o.projB_b, (bf16_t*)(wsb_ + 489 * MiB), (bf16_t*)(wsb_ + 506 * MiB), (bf16_t*)(wsb_ + 1136 * MiB), I.b_norm, (bf16_t*)(wsb_ + 570 * MiB), ll); PH_END \
      GRID_BAR(); \
      PH_BEGIN { unsigned* fl_ = (unsigned*)(wsb_ + 512 * 1024); unsigned bits = 0u; \
        { const bf16_t* a = (const bf16_t*)(wsb_ + 489 * MiB); for (size_t i = gtid_; i < (size_t)NT * 512; i += NGT_) { const float v = bf2f(a[i]); if (!(fabsf(v) < 1e30f)) bits |= 1u; } } \
        { const float* a = (const float*)(wsb_ + 506 * MiB); for (size_t i = gtid_; i < (size_t)NT * 1024; i += NGT_) { const float v = a[i]; if (!(fabsf(v) < 1e30f)) bits |= 2u; } } \
        { const float* a = (const float*)(wsb_ + 880 * MiB); for (size_t i = gtid_; i < (size_t)1024 * 32768; i += NGT_) { const float v = a[i]; if (!(fabsf(v) < 1e30f)) bits |= 4u; } } \
        { const bf16_t* a = (const bf16_t*)(wsb_ + 1136 * MiB); for (size_t i = gtid_; i < (size_t)1024 * 32768; i += NGT_) { const float v = bf2f(a[i]); if (!(fabsf(v) < 1e30f)) bits |= 8u; } } \
        { const bf16_t* a = (const bf16_t*)(wsb_ + 570 * MiB); for (size_t i = gtid_; i < (size_t)NT * 1024; i += NGT_) { const float v = bf2f(a[i]); if (!(fabsf(v) < 1e30f)) bits |= 16u; } } \
        { const float* a = (const float*)(wsb_ + 505 * MiB); for (size_t i = gtid_; i < (size_t)1024 * 128; i += NGT_) { const float v = a[i]; if (!(fabsf(v) < 1e30f)) bits |= 32u; } } \
        if (bits) atomicOr(fl_, bits); \
        { float* pd = (float*)(wsb_ + 1968 * MiB); const bf16_t* ob = (const bf16_t*)(wsb_ + 570 * MiB); for (size_t i = gtid_; i < (size_t)NT * D; i += NGT_) pd[i] = bf2f(ob[i]) - w.on[i]; } } PH_END \
      GRID_BAR();
#else
#define GLA_PHASES \
      PH_BEGIN ph_gla_a1(o.projB_b, I.b_g_bias, o.qt, o.og, o.kvt, o.dcy, ll, o.xb, o.WB_t + (size_t)3072 * D, I.b_w_g2); PH_END \
      GRID_BAR(); \
      PH_BEGIN ph_gla_a2(o.kvt, o.dcy, o.spt); PH_END \
      GRID_BAR(); \
      PH_BEGIN ph_gla_a3(o.projB_b, o.qt, o.og, o.spt, I.b_norm, o.o2b, ll); PH_END \
      GRID_BAR();
#endif
#if defined(FUSE_ON)
#define MOE_GEMM_PHASES(li) \
    PH_BEGIN pg8::MoeFusedOrder S; S.init(o.xs, o.act, o.W1_t + (size_t)li * 32 * 2048 * D, o.W2_t + (size_t)li * 32 * D * D, o.m.slot_tok, o.m.blk_e, (unsigned*)(wsb_ + WS_CTL) + CW_RDY + li * 32768, (unsigned*)(wsb_ + WS_CTL) + CW_TMO, __builtin_amdgcn_readfirstlane(*o.m.nblk), G_, BIDX()); S.mode = 0; \
      gemm_phase<pg8::EpiMoeFused, pg8::MoeFusedOrder, true, true>(ll, Gemm{D, D, D}, S, pg8::EpiMoeFused{o.act, I.m_b1 + (size_t)li * 32 * 2048, o.Ys, I.m_b2 + (size_t)li * 32 * D, o.m.slot_gate}); PH_END \
    GRID_BAR();
#else
#define MOE_BLKE_TO_LDS const int nblk_ = __builtin_amdgcn_readfirstlane(*o.m.nblk); LAS int* bt_ = (LAS int*)(ll + 131072); \
      for (int i_ = TIDX(); i_ < nblk_; i_ += NTHR) bt_[i_] = o.m.blk_e[i_]; __syncthreads();
#define MOE_GEMM_PHASES(li) \
    PH_BEGIN MOE_BLKE_TO_LDS pg8::MoeOrderG S; S.init(o.xs, D, o.W1_t + (size_t)li * 32 * 2048 * D, D, (size_t)2048 * D * 2, nblk_, 8, 128, bt_, G_, BIDX()); S.rowmap = o.m.slot_tok; \
      gemm_phase<pg8::EpiSwiglu, pg8::MoeOrderG, true, true>(ll, Gemm{D, D, D}, S, pg8::EpiSwiglu{o.act, D, I.m_b1 + (size_t)li * 32 * 2048}); PH_END \
    GRID_BAR(); \
    PH_BEGIN MOE_BLKE_TO_LDS MoeOrder S; S.init(o.act, D, o.W2_t + (size_t)li * 32 * D * D, D, (size_t)D * D * 2, nblk_, 4, 256, bt_, G_, BIDX()); \
      gemm_phase<pg8::EpiMoe2, MoeOrder, true, true>(ll, Gemm{D, D, D}, S, pg8::EpiMoe2{o.Ys, D, I.m_b2 + (size_t)li * 32 * D, o.m.slot_gate}); PH_END \
    GRID_BAR();
#endif
#ifdef LNR_MODE
#define LNR_EXTRA(li) PH_BEGIN if (li == 0) ph_ln_router<false, LNR_MODE>(I.x, o.hbf, I.ln1_g + li * D, I.ln1_b + li * D, I.m_w_router + (size_t)li * D * 32, I.m_b_router + li * 32, o.xs, o.m, fl); else ph_ln_router<true, LNR_MODE>(o.xb, o.hbf, I.ln1_g + li * D, I.ln1_b + li * D, I.m_w_router + (size_t)li * D * 32, I.m_b_router + li * 32, o.xs, o.m, fl); PH_END GRID_BAR();
#else
#define LNR_EXTRA(li)
#endif
#define LAYER_BODY(li) \
    if (li == 1) { \
      PH_BEGIN StaticOrder S; S.init(o.xb, D, o.WB_t, D, NT, 3072, G_, BIDX()); gemm_phase<EpiStore, StaticOrder, true, true>(ll, Gemm{D, D, D}, S, EpiStore{o.projB_b, 3584}); PH_END \
      GRID_BAR(); \
      GLA_PHASES \
      PH_BEGIN StaticOrder S; S.init(o.o2b, D, o.WoutB_t, D, NT, D, G_, BIDX()); gemm_phase<EpiStore, StaticOrder, true, true>(ll, Gemm{D, D, D}, S, EpiStore{o.hbf, D}); PH_END \
      GRID_BAR(); \
    } \
LNR_EXTRA(li) \
    PH_BEGIN if (li == 0) ph_ln_router<false>(I.x, o.hbf, I.ln1_g + li * D, I.ln1_b + li * D, I.m_w_router + (size_t)li * D * 32, I.m_b_router + li * 32, o.xs, o.m, fl); else ph_ln_router<true>(o.xb, o.hbf, I.ln1_g + li * D, I.ln1_b + li * D, I.m_w_router + (size_t)li * D * 32, I.m_b_router + li * 32, o.xs, o.m, fl); PH_END \
    GRID_BAR(); \
    PH_BEGIN ph_moe_scatter(o.m, (int*)lds); PH_END \
    GRID_BAR(); \
MOE_GEMM_PHASES(li) \
    PH_BEGIN ph_combine_ln(o.xs, o.Ys, o.m.slot_of, I.ln2_g + li * D, I.ln2_b + li * D, li == 0 ? nullptr : out_, li == 0 ? o.xb : nullptr); PH_END \
    if (li == 0) GRID_BAR();
__global__ void __launch_bounds__(NTHR, 2) mk_fwd(Args args) {
  extern __shared__ __attribute__((aligned(16))) unsigned char lds[];
  volatile LAS unsigned* MISC = (volatile LAS unsigned*)((LAS unsigned char*)lds + MISC_OFF);
  if (threadIdx.x < 32) MISC[threadIdx.x] = 0u;
  __syncthreads();
  XcdBarrier bar; { const __attribute__((address_space(4))) Args* ka0 = (const __attribute__((address_space(4))) Args*)__builtin_amdgcn_kernarg_segment_ptr(); bar = xcd_barrier_post((unsigned*)(ka0->ws + WS_CTL) + CW_BAR, MISC + 8); }
#define GRID_BAR() xcd_barrier(bar)
#define PH_BEGIN { const __attribute__((address_space(4))) Args* ka_ = (const __attribute__((address_space(4))) Args*)__builtin_amdgcn_kernarg_segment_ptr(); asm volatile("" : "+s"(ka_)); \
    float* const out_ = ka_->out; (void)out_; unsigned char* wsb_ = ka_->ws; const nvp::Ws w = carve_ws(wsb_); (void)w; const Opt o = carve_opt(wsb_); (void)o; \
    const int gtid_ = BIDX() * NTHR + TIDX(), NGT_ = (int)gridDim.x * NTHR; (void)gtid_; (void)NGT_; const int G_ = (int)gridDim.x; (void)G_;
#define PH_END }
#define I (ka_->in)
  float* fl = (float*)lds; LAS unsigned char* ll = (LAS unsigned char*)lds;
  using pg8::gemm_phase; using pg8::StaticOrder; using pg8::MoeOrder; using pg8::Gemm; using pg8::EpiStore;
  PH_BEGIN ph_prologue(ProIn{I.a_w_uk, I.a_w_uv, I.x, I.a_w_in, I.a_w_out, I.b_w_in, I.b_w_g2, I.b_w_out, I.m_w1, I.m_w2}, o, ll); PH_END
  GRID_BAR();
  PH_BEGIN StaticOrder S; S.init(o.xb, D, o.WA_t, D, NT, 2048, G_, BIDX()); gemm_phase<pg8::EpiStoreKi, StaticOrder, true, true>(ll, Gemm{D, D, D}, S, pg8::EpiStoreKi{o.projA_b, 2048, o.kib, 1792}); PH_END
  GRID_BAR();
  PH_BEGIN ph_cnorm_b(o.projA_b, I.a_kv_norm, o.cnb); PH_END
  PH_BEGIN pg8::GroupAOrder S; S.init(o.projA_b, 2048, o.Wql_t, 256, NT, 4096, 4, 512, G_, BIDX()); gemm_phase<EpiStore, pg8::GroupAOrder, true, true>(ll, Gemm{2048, 256, 256}, S, EpiStore{o.qlat, 4096}); PH_END
#ifdef ISC_HOT
  PH_BEGIN ph_iscore<ISC_HOT>(o.projA_b, o.kib, (unsigned short*)o.act, (unsigned*)(wsb_ + WS_CTL) + CW_ISC + 64, ll); PH_END
  GRID_BAR();
#endif
  PH_BEGIN ph_iscore(o.projA_b, o.kib, o.sc, (unsigned*)(wsb_ + WS_CTL) + CW_ISC, ll); PH_END
  GRID_BAR();
  PH_BEGIN ph_select_attend(o.sc, o.qlat, o.cnb, o.olat, ll, I.m_w1, I.m_w2, o.W1_t, o.W2_t, o.act); PH_END
  GRID_BAR();
#ifdef GBENCH
#if GBENCH == 6
  PH_BEGIN ph_attbench(o.qlat, o.cnb, (bf16_t*)o.act, ll); PH_END
#elif GBENCH == 5
  PH_BEGIN ph_select_attend<1>(o.sc, o.qlat, o.cnb, (bf16_t*)o.act, ll, I.m_w1, I.m_w2, o.W1_t, o.W2_t, o.act); PH_END
#elif GBENCH == 4
  PH_BEGIN { const int lane_ = TIDX() & 63, gw_ = BIDX() * 8 + (TIDX() >> 6); for (int wt = gw_; wt < 24576; wt += G_ * 8) { int lane_t = lane_; asm volatile("" : "+v"(lane_t)); moe_weight_tile<1>(wt < 12288 ? moe_layer_tile(0, wt) : moe_layer_tile(1, wt - 12288), I.m_w1, I.m_w2, o.W1_t, o.W2_t, lane_t, ll + (TIDX() >> 6) * 16384, (unsigned*)(wsb_ + 1968 * MiB)); } } PH_END
#elif GBENCH == 3
  PH_BEGIN { const int lane_ = TIDX() & 63, gw_ = BIDX() * 8 + (TIDX() >> 6); for (int wt = gw_; wt < 24576; wt += G_ * 8) { int lane_t = lane_; asm volatile("" : "+v"(lane_t)); moe_weight_tile(wt < 12288 ? moe_layer_tile(0, wt) : moe_layer_tile(1, wt - 12288), I.m_w1, I.m_w2, o.W1_t, o.W2_t, lane_t, ll + (TIDX() >> 6) * 16384); } } PH_END
#else
  PH_BEGIN ph_gbench(o.cnb, (unsigned*)(wsb_ + 1968 * MiB)); PH_END
#endif
  GRID_BAR();
#endif
  PH_BEGIN pg8::GroupAOrder S; S.init(o.olat, 4096, o.Wuv_t, 1024, NT, 1024, 1, 2048, G_, BIDX()); gemm_phase<EpiStore, pg8::GroupAOrder, true, true>(ll, Gemm{4096, 1024, 1024}, S, EpiStore{o.o2b, D}); PH_END
  GRID_BAR();
#if PROBE == 2
  PH_BEGIN cvt_bf16_to_f32(o.projA_b, 2048, w.projA, DINA, NT, DINA, gtid_, NGT_); PH_END
  GRID_BAR();
  PH_BEGIN nvp::np_cnorm(w.projA, I.a_kv_norm, w.cn); PH_END
  PH_BEGIN nvp::np_iscore(w.projA, w.sc, fl); PH_END
  GRID_BAR();
  PH_BEGIN nvp::np_topk(w.sc, w.idx, (char*)lds); PH_END
  GRID_BAR();
  PH_BEGIN nvp::np_dsa_attn(w.projA, w.cn, w.idx, I.a_w_uk, I.a_w_uv, w.o2, fl); PH_END
  GRID_BAR();
  PH_BEGIN { float* pd = (float*)(wsb_ + 1968 * MiB); for (size_t i = gtid_; i < (size_t)NT * D; i += NGT_) pd[i] = bf2f(o.o2b[i]) - w.o2[i]; } PH_END
  GRID_BAR();
#endif
  PH_BEGIN StaticOrder S; S.init(o.o2b, D, o.WoutA_t, D, NT, D, G_, BIDX()); gemm_phase<EpiStore, StaticOrder, true, true>(ll, Gemm{D, D, D}, S, EpiStore{o.hbf, D}); PH_END
  GRID_BAR();
  { LAYER_BODY(0) }
  { LAYER_BODY(1) }
#if PROBE == 2 || PROBE == 3
  GRID_BAR();
#if PROBE == 3
  PH_BEGIN { if (gtid_ == 0) { const unsigned fb = *(const unsigned*)(wsb_ + 512 * 1024); out_[5] += (float)fb; } const float* pd = (const float*)(wsb_ + 1968 * MiB); for (size_t i = gtid_; i < (size_t)NT * D; i += NGT_) out_[i] += PROBE_S * pd[i]; } PH_END
#else
  PH_BEGIN { const float* pd = (const float*)(wsb_ + 1968 * MiB); for (size_t i = gtid_; i < (size_t)NT * D; i += NGT_) out_[i] += PROBE_S * pd[i]; } PH_END
#endif
#endif
}

extern "C" void kernel_launch(void* const* d_in, const int* in_sizes, int n_in, void* d_out, int out_size, void* d_ws, size_t ws_size, hipStream_t stream) {
  static int grid = 0;
  if (grid == 0) {
    if (n_in != 21 || ws_size < WS_NEEDED) { fprintf(stderr, "kernel_launch: bad inputs (n_in %d) or workspace too small (%zu needed, %zu given)\n", n_in, (size_t)WS_NEEDED, ws_size); grid = -1; return; }
    int dev = 0, cus = 0, per_cu = 0;
    if (hipGetDevice(&dev) != hipSuccess || hipDeviceGetAttribute(&cus, hipDeviceAttributeMultiprocessorCount, dev) != hipSuccess) { grid = -1; return; }
    if (hipFuncSetAttribute((const void*)mk_fwd, hipFuncAttributeMaxDynamicSharedMemorySize, LDS_BYTES) != hipSuccess) { fprintf(stderr, "kernel_launch: hipFuncSetAttribute failed\n"); grid = -1; return; }
    if (hipOccupancyMaxActiveBlocksPerMultiprocessor(&per_cu, (const void*)mk_fwd, NTHR, LDS_BYTES) != hipSuccess || per_cu < 1) fprintf(stderr, "kernel_launch: note: occupancy query reports %d\n", per_cu);
    (void)hipGetLastError();
    grid = cus;
    if (grid != 256) fprintf(stderr, "kernel_launch: built for 256 CUs (token ownership per workgroup); got %d\n", grid);
  }
  if (grid < 0) return;
  if (hipMemsetAsync((char*)d_ws + WS_CTL, 0, CTL_ZERO_BYTES, stream) != hipSuccess) { fprintf(stderr, "kernel_launch: memset failed\n"); return; }
  Args a; memset(&a, 0, sizeof(a));
  const float** f = (const float**)&a.in;
  for (int i = 0; i < 21; ++i) f[i] = (const float*)d_in[i];
  a.out = (float*)d_out; a.ws = (unsigned char*)d_ws;
  hipLaunchKernelGGL(mk_fwd, dim3(grid), dim3(NTHR), LDS_BYTES, stream, a);
  const hipError_t le = hipPeekAtLastError();
  if (le != hipSuccess) fprintf(stderr, "kernel_launch: launch failed: %s\n", hipGetErrorName(le));
}
```
